# Optimizing an MI355X kernel written in HIP

```python
import math
import jax, jax.numpy as jnp
from jax import lax
import numpy as np

D_MODEL = 2048
BATCH = 8
SEQ = 2048
DEPTH = 4

N_A_LAYERS = DEPTH // 2
N_B_LAYERS = DEPTH - N_A_LAYERS
SB_HEADS = 16
SB_HEAD_DIM = D_MODEL // SB_HEADS
DIFF_HEADS = 16
DIFF_QK_DIM = D_MODEL // DIFF_HEADS // 2
DIFF_V_DIM = 2 * DIFF_QK_DIM
ROPE_THETA = 10000.0
N_GROUPS = 4
EXPERTS_PER_GROUP = 4
N_EXPERTS = N_GROUPS * EXPERTS_PER_GROUP
TOP_K_INNER = 2
D_EXPERT = D_MODEL // 2
Q_BLOCK = 128
DEEPNORM_ALPHA = (2.0 * DEPTH) ** 0.25
DEEPNORM_BETA = (8.0 * DEPTH) ** -0.25
LN_EPS = 1e-5
SUBLN_EPS = 1e-5

kernel_name = "yoco_stickbreak_diffattn_hmoe"


def layer_norm(x, g, b):
    xf = x.astype(jnp.float32)
    mu = jnp.mean(xf, axis=-1, keepdims=True)
    var = jnp.mean(jnp.square(xf - mu), axis=-1, keepdims=True)
    y = (xf - mu) * lax.rsqrt(var + LN_EPS) * g.astype(jnp.float32) + b.astype(jnp.float32)
    return y.astype(x.dtype)


def rope(x, pos):
    d = x.shape[-1]
    half = d // 2
    inv_freq = ROPE_THETA ** (-jnp.arange(half, dtype=jnp.float32) / half)
    ang = pos.astype(jnp.float32)[:, None] * inv_freq[None, :]
    cos, sin = jnp.cos(ang), jnp.sin(ang)
    xf = x.astype(jnp.float32)
    x1, x2 = xf[..., :half], xf[..., half:]
    out = jnp.concatenate([x1 * cos - x2 * sin, x2 * cos + x1 * sin], axis=-1)
    return out.astype(x.dtype)


def to_blocks(t):
    B, H, S, d = t.shape
    return t.reshape(B, H, S // Q_BLOCK, Q_BLOCK, d).transpose(2, 0, 1, 3, 4)


def from_blocks(t):
    nb, B, H, qb, d = t.shape
    return t.transpose(1, 2, 0, 3, 4).reshape(B, H, nb * qb, d)


def stick_breaking_attention(q, k, v):
    S = q.shape[2]
    scale = q.shape[-1] ** -0.5
    kf = k.astype(jnp.float32)
    vf = v.astype(jnp.float32)
    key_pos = jnp.arange(S)

    def block(args):
        qb, start = args
        q_pos = start + jnp.arange(Q_BLOCK)
        z = jnp.einsum('bhqd,bhkd->bhqk', qb.astype(jnp.float32), kf) * scale
        past = key_pos[None, :] < q_pos[:, None]
        log_beta = jax.nn.log_sigmoid(z)
        log_keep = jnp.where(past, jax.nn.log_sigmoid(-z), 0.0)
        tail = lax.cumsum(log_keep, axis=3, reverse=True) - log_keep
        w = jnp.where(past, jnp.exp(log_beta + tail), 0.0)
        return jnp.einsum('bhqk,bhkd->bhqd', w, vf)

    starts = jnp.arange(S // Q_BLOCK, dtype=jnp.int32) * Q_BLOCK
    o = lax.map(block, (to_blocks(q), starts))
    return from_blocks(o).astype(v.dtype)


def differential_attention(q1, q2, k1, k2, v, lam):
    S = q1.shape[2]
    scale = q1.shape[-1] ** -0.5
    k1f, k2f, vf = k1.astype(jnp.float32), k2.astype(jnp.float32), v.astype(jnp.float32)
    key_pos = jnp.arange(S)

    def block(args):
        qb1, qb2, start = args
        q_pos = start + jnp.arange(Q_BLOCK)
        causal = key_pos[None, :] <= q_pos[:, None]

        def probs(qb, kf):
            s = jnp.einsum('bhqd,bhkd->bhqk', qb.astype(jnp.float32), kf) * scale
            return jax.nn.softmax(jnp.where(causal, s, -jnp.inf), axis=-1)

        a = probs(qb1, k1f) - lam * probs(qb2, k2f)
        return jnp.einsum('bhqk,bhkd->bhqd', a, vf)

    starts = jnp.arange(S // Q_BLOCK, dtype=jnp.int32) * Q_BLOCK
    o = lax.map(block, (to_blocks(q1), to_blocks(q2), starts))
    return from_blocks(o)


def stick_breaking_mixer(h, w_qkv, w_o):
    B, S, D = h.shape
    qkv = jnp.einsum('bsd,de->bse', h, w_qkv).reshape(B, S, 3, SB_HEADS, SB_HEAD_DIM)
    qkv = qkv.transpose(2, 0, 3, 1, 4)
    o = stick_breaking_attention(qkv[0], qkv[1], qkv[2])
    o = o.transpose(0, 2, 1, 3).reshape(B, S, SB_HEADS * SB_HEAD_DIM)
    return jnp.einsum('bse,ed->bsd', o, w_o)


def shared_kv(h, w_kv, pos):
    B, S, D = h.shape
    kv = jnp.einsum('bsd,de->bse', h, w_kv)
    kd = DIFF_HEADS * 2 * DIFF_QK_DIM
    k = kv[..., :kd].reshape(B, S, DIFF_HEADS, 2, DIFF_QK_DIM).transpose(3, 0, 2, 1, 4)
    v = kv[..., kd:].reshape(B, S, DIFF_HEADS, DIFF_V_DIM).transpose(0, 2, 1, 3)
    return rope(k[0], pos), rope(k[1], pos), v


def diff_mixer(h, k1, k2, v, w_q, w_o, lam_params, subln_g, layer_idx, pos):
    B, S, D = h.shape
    q = jnp.einsum('bsd,de->bse', h, w_q).reshape(B, S, DIFF_HEADS, 2, DIFF_QK_DIM)
    q = q.transpose(3, 0, 2, 1, 4)
    q1, q2 = rope(q[0], pos), rope(q[1], pos)
    lam_init = 0.8 - 0.6 * math.exp(-0.3 * layer_idx)
    lp = lam_params.astype(jnp.float32)
    lam = jnp.exp(jnp.sum(lp[0] * lp[1])) - jnp.exp(jnp.sum(lp[2] * lp[3])) + lam_init
    o = differential_attention(q1, q2, k1, k2, v, lam)
    o = o * lax.rsqrt(jnp.mean(jnp.square(o), axis=-1, keepdims=True) + SUBLN_EPS)
    o = o * subln_g.astype(jnp.float32) * (1.0 - lam_init)
    o = o.transpose(0, 2, 1, 3).reshape(B, S, DIFF_HEADS * DIFF_V_DIM).astype(h.dtype)
    return jnp.einsum('bse,ed->bsd', o, w_o)


def hierarchical_moe(h, w_group, w_inner, w_gate, w_up, w_down):
    B, S, D = h.shape
    t = h.reshape(B * S, D)
    group_logits = jnp.einsum('nd,dg->ng', t, w_group).astype(jnp.float32)
    group_prob = jax.nn.softmax(group_logits, axis=-1)
    g_sel = jnp.argmax(group_logits, axis=-1)
    g_w = jnp.take_along_axis(group_prob, g_sel[:, None], axis=1)
    inner_logits = jnp.einsum('nd,gde->nge', t, w_inner).astype(jnp.float32)
    inner_sel = jnp.take_along_axis(inner_logits, g_sel[:, None, None], axis=1)[:, 0]
    top_v, top_i = lax.top_k(inner_sel, TOP_K_INNER)
    top_w = jax.nn.softmax(top_v, axis=-1) * g_w
    expert_id = g_sel[:, None] * EXPERTS_PER_GROUP + top_i
    gates = jnp.sum(jax.nn.one_hot(expert_id, N_EXPERTS, dtype=jnp.float32) * top_w[..., None], axis=1)
    y = jnp.zeros((B * S, D), jnp.float32)
    for e in range(N_EXPERTS):
        a = jax.nn.silu(t @ w_gate[e]) * (t @ w_up[e])
        y = y + gates[:, e:e + 1] * (a @ w_down[e]).astype(jnp.float32)
    return y.reshape(B, S, D).astype(h.dtype)


def setup_inputs(seed: int = 0) -> dict:
    key = jax.random.key(seed)
    ks = jax.random.split(key, 20)
    D = D_MODEL
    f32 = jnp.float32

    def nrm(k, shape, scale):
        return jax.random.normal(k, shape, f32) * scale

    x = nrm(ks[0], (BATCH, SEQ, D), 1.0)
    sb_col = jnp.concatenate([jnp.ones((2 * D,), f32), jnp.full((D,), DEEPNORM_BETA, f32)]) * D ** -0.5
    sb_w_qkv = nrm(ks[1], (N_A_LAYERS, D, 3 * D), 1.0) * sb_col
    sb_w_o = nrm(ks[2], (N_A_LAYERS, D, D), D ** -0.5 * DEEPNORM_BETA)
    kd = DIFF_HEADS * 2 * DIFF_QK_DIM
    vd = DIFF_HEADS * DIFF_V_DIM
    kv_col = jnp.concatenate([jnp.ones((kd,), f32), jnp.full((vd,), DEEPNORM_BETA, f32)]) * D ** -0.5
    shared_w_kv = nrm(ks[3], (D, kd + vd), 1.0) * kv_col
    diff_w_q = nrm(ks[4], (N_B_LAYERS, D, kd), D ** -0.5)
    diff_w_o = nrm(ks[5], (N_B_LAYERS, vd, D), vd ** -0.5 * DEEPNORM_BETA)
    diff_lambda = nrm(ks[6], (N_B_LAYERS, 4, DIFF_QK_DIM), 0.1)
    diff_subln_g = 1.0 + nrm(ks[7], (N_B_LAYERS, DIFF_V_DIM), 0.01)
    ln_mix_g = 1.0 + nrm(ks[8], (DEPTH, D), 0.01)
    ln_mix_b = nrm(ks[9], (DEPTH, D), 0.01)
    ln_ffn_g = 1.0 + nrm(ks[10], (DEPTH, D), 0.01)
    ln_ffn_b = nrm(ks[11], (DEPTH, D), 0.01)
    moe_w_group = nrm(ks[12], (DEPTH, D, N_GROUPS), D ** -0.5)
    moe_w_inner = nrm(ks[13], (DEPTH, N_GROUPS, D, EXPERTS_PER_GROUP), D ** -0.5)
    moe_w_gate = nrm(ks[14], (DEPTH, N_EXPERTS, D, D_EXPERT), D ** -0.5)
    moe_w_up = nrm(ks[15], (DEPTH, N_EXPERTS, D, D_EXPERT), D ** -0.5)
    moe_w_down = nrm(ks[16], (DEPTH, N_EXPERTS, D_EXPERT, D), D_EXPERT ** -0.5 * DEEPNORM_BETA)
    return {"x": x, "sb_w_qkv": sb_w_qkv, "sb_w_o": sb_w_o, "shared_w_kv": shared_w_kv,
            "diff_w_q": diff_w_q, "diff_w_o": diff_w_o, "diff_lambda": diff_lambda,
            "diff_subln_g": diff_subln_g, "ln_mix_g": ln_mix_g, "ln_mix_b": ln_mix_b,
            "ln_ffn_g": ln_ffn_g, "ln_ffn_b": ln_ffn_b, "moe_w_group": moe_w_group,
            "moe_w_inner": moe_w_inner, "moe_w_gate": moe_w_gate, "moe_w_up": moe_w_up,
            "moe_w_down": moe_w_down}


def reference(x, sb_w_qkv, sb_w_o, shared_w_kv, diff_w_q, diff_w_o, diff_lambda, diff_subln_g,
              ln_mix_g, ln_mix_b, ln_ffn_g, ln_ffn_b, moe_w_group, moe_w_inner, moe_w_gate,
              moe_w_up, moe_w_down):
    S = x.shape[1]
    pos = jnp.arange(S, dtype=jnp.int32)
    h = x
    k1 = k2 = v = None
    for layer in range(DEPTH):
        if layer < N_A_LAYERS:
            mix = stick_breaking_mixer(h, sb_w_qkv[layer], sb_w_o[layer])
        else:
            if layer == N_A_LAYERS:
                k1, k2, v = shared_kv(h, shared_w_kv, pos)
            i = layer - N_A_LAYERS
            mix = diff_mixer(h, k1, k2, v, diff_w_q[i], diff_w_o[i], diff_lambda[i],
                             diff_subln_g[i], layer, pos)
        h = layer_norm(DEEPNORM_ALPHA * h + mix, ln_mix_g[layer], ln_mix_b[layer])
        ffn = hierarchical_moe(h, moe_w_group[layer], moe_w_inner[layer], moe_w_gate[layer],
                               moe_w_up[layer], moe_w_down[layer])
        h = layer_norm(DEEPNORM_ALPHA * h + ffn, ln_ffn_g[layer], ln_ffn_b[layer])
    return h
```

```cpp
#include <hip/hip_runtime.h>
#include <cstdio>
#include <cstdint>

namespace pg8 {
#define PG8_LAS __attribute__((address_space(3)))
typedef unsigned short bf16_t;
typedef short bf16x8 __attribute__((ext_vector_type(8)));
typedef float f32x4 __attribute__((ext_vector_type(4)));
typedef unsigned u32x4 __attribute__((ext_vector_type(4)));
constexpr int BM = 256, BK = 64, HALF = 128, HTB = HALF * BK * 2  , STAGE_BYTES = 8 * HTB, NXCD = 8, WGM = 8;

__host__ __device__ __forceinline__ int lds_byte(int r, int c) { const int st = (r >> 4) * 2 + (c >> 5), rr = r & 15, cc = c & 31, ob = rr * 64 + cc * 2; return st * 1024 + (ob ^ (((ob >> 9) & 1) << 5)); }
__host__ __device__ __forceinline__ void stage_rc(int b, int& R, int& C) { const int st = b / 1024, sb = b % 1024, swz = sb ^ (((sb >> 9) & 1) << 5); R = (st >> 1) * 16 + swz / 64; C = (st & 1) * 32 + (swz % 64) / 2; }
__host__ __device__ __forceinline__ int perm32(int rho) { const int n = rho >> 4, i = rho & 15; return 8 * (i >> 2) + 4 * n + (i & 3); }

struct Unit { int pm, pn; };
struct Gemm { const bf16_t* A; const bf16_t* Bt; int M, N, K; };

struct StaticOrder {
    int nM, nN, nwg, G, c;
    __host__ __device__ void init(int M, int N, int G_, int c_) { nM = M / BM; nN = N / BM; nwg = nM * nN; G = G_; c = c_; }
    __host__ __device__ bool next(int i, Unit& u) const {
        const long L = (long)i * G + c; if (L >= nwg) return false;
        int wgid = (int)L; { const int q = nwg / NXCD, r = nwg % NXCD, xcd = wgid % NXCD, off = wgid / NXCD; wgid = (xcd < r ? xcd * (q + 1) : r * (q + 1) + (xcd - r) * q) + off; }
        const int nig = WGM * nN, gid = wgid / nig, fm = gid * WGM, gsz = (nM - fm) < WGM ? (nM - fm) : WGM;
        u.pm = fm + ((wgid % nig) % gsz); u.pn = (wgid % nig) / gsz; return true;
    }
    __device__ __forceinline__ void a_ready(const Unit&) const {}
    __device__ __forceinline__ void done(const Unit&) const {}
};

__device__ __forceinline__ unsigned cvt_pk_bf16(float lo, float hi) { unsigned r; asm volatile("v_cvt_pk_bf16_f32 %0, %1, %2" : "=v"(r) : "v"(lo), "v"(hi)); return r; }
typedef float f32x2 __attribute__((ext_vector_type(2)));

typedef unsigned u32x2 __attribute__((ext_vector_type(2)));
__device__ __forceinline__ u32x4 pack8_bf16(const f32x4 a, const f32x4 b) { u32x4 w; w.x = cvt_pk_bf16(a[0], a[1]); w.y = cvt_pk_bf16(a[2], a[3]); w.z = cvt_pk_bf16(b[0], b[1]); w.w = cvt_pk_bf16(b[2], b[3]); return w; }

struct EpiQkv {
    static constexpr bool PERM = true, AFTER_DRAIN = false;
    bf16_t* O; int ldc; int qcols; float qscale;
    __device__ __forceinline__ void operator()(const f32x4 (&acc)[2][2][4][2], const Unit& u, int wr, int wc, int fr, int fq) const {
        const int row0 = u.pm * BM + wr * 64 + fr, colt = u.pn * BM; const float sc = colt < qcols ? qscale : 1.f;
        const int col0 = colt + wc * 32 + 8 * fq;
#pragma unroll
        for (int ai = 0; ai < 2; ++ai)
#pragma unroll
            for (int m = 0; m < 4; ++m) { bf16_t* rowp = O + (size_t)(row0 + ai * HALF + m * 16) * ldc + col0;
#pragma unroll
                for (int bj = 0; bj < 2; ++bj) *(u32x4*)(rowp + bj * HALF) = pack8_bf16(acc[ai][bj][m][0] * sc, acc[ai][bj][m][1] * sc); }
    }
};
struct EpiResid {
    static constexpr bool PERM = false, AFTER_DRAIN = false;
    float* H; int ldc; float alpha;
    __device__ __forceinline__ void operator()(const f32x4 (&acc)[2][2][4][2], const Unit& u, int wr, int wc, int fr, int fq) const {
        const int row0 = u.pm * BM + wr * 64 + fr, col0 = u.pn * BM + wc * 32 + 4 * fq;
#pragma unroll
        for (int ai = 0; ai < 2; ++ai)
#pragma unroll
            for (int m = 0; m < 4; ++m) { float* rowp = H + (size_t)(row0 + ai * HALF + m * 16) * ldc + col0;
#pragma unroll
                for (int bj = 0; bj < 2; ++bj)
#pragma unroll
                    for (int n = 0; n < 2; ++n) { f32x4* q = (f32x4*)(rowp + bj * HALF + n * 16); const f32x4 h = *q; *q = h * alpha + acc[ai][bj][m][n]; } }
    }
};
struct EpiRope {
    static constexpr bool PERM = true, AFTER_DRAIN = false;
    bf16_t* O; int ldc; int qcols, ropecols; float qscale; const float* ctab; const float* stab;
    __device__ __forceinline__ void operator()(const f32x4 (&acc)[2][2][4][2], const Unit& u, int wr, int wc, int fr, int fq) const {
        const int row0 = u.pm * BM + wr * 64 + fr, colt = u.pn * BM;
        if (colt >= ropecols) {
            const int col0 = colt + wc * 32 + 8 * fq;
#pragma unroll
            for (int ai = 0; ai < 2; ++ai)
#pragma unroll
                for (int m = 0; m < 4; ++m) { bf16_t* rowp = O + (size_t)(row0 + ai * HALF + m * 16) * ldc + col0;
#pragma unroll
                    for (int bj = 0; bj < 2; ++bj) *(u32x4*)(rowp + bj * HALF) = pack8_bf16(acc[ai][bj][m][0], acc[ai][bj][m][1]); }
        } else {
            const float sc = colt < qcols ? qscale : 1.f;
            const int col0 = colt + wc * 64 + 8 * fq;
#pragma unroll
            for (int ai = 0; ai < 2; ++ai)
#pragma unroll
                for (int m = 0; m < 4; ++m) { const int row = row0 + ai * HALF + m * 16; const int pos = row & 2047;
                    const f32x4 c0 = *(const f32x4*)(ctab + pos * 32 + 8 * fq), c1 = *(const f32x4*)(ctab + pos * 32 + 8 * fq + 4);
                    const f32x4 s0 = *(const f32x4*)(stab + pos * 32 + 8 * fq), s1 = *(const f32x4*)(stab + pos * 32 + 8 * fq + 4);
                    const f32x4 a0 = acc[ai][0][m][0], a1 = acc[ai][0][m][1], b0 = acc[ai][1][m][0], b1 = acc[ai][1][m][1];
                    bf16_t* rowp = O + (size_t)row * ldc + col0;
                    *(u32x4*)(rowp) = pack8_bf16((a0 * c0 - b0 * s0) * sc, (a1 * c1 - b1 * s1) * sc);
                    *(u32x4*)(rowp + 32) = pack8_bf16((b0 * c0 + a0 * s0) * sc, (b1 * c1 + a1 * s1) * sc); }
        }
    }
};
struct EpiGateUp {
    static constexpr bool PERM = true, AFTER_DRAIN = false;
    bf16_t* O;
    __device__ __forceinline__ void operator()(const f32x4 (&acc)[2][2][4][2], const Unit& u, int wr, int wc, int fr, int fq) const {
        const int row0 = u.pm * BM + wr * 64 + fr, col0 = (u.pn & 7) * 128 + wc * 32 + 8 * fq;
#pragma unroll
        for (int ai = 0; ai < 2; ++ai)
#pragma unroll
            for (int m = 0; m < 4; ++m) { f32x4 r[2];
#pragma unroll
                for (int n = 0; n < 2; ++n) { const f32x4 g = acc[ai][0][m][n], up = acc[ai][1][m][n];
#pragma unroll
                    for (int i = 0; i < 4; ++i) { const float e = __builtin_amdgcn_exp2f(g[i] * -1.4426950408889634f); r[n][i] = g[i] * __builtin_amdgcn_rcpf(1.f + e) * up[i]; } }
                *(u32x4*)(O + (size_t)(row0 + ai * HALF + m * 16) * 1024 + col0) = pack8_bf16(r[0], r[1]); }
    }
};
struct EpiDown {
    static constexpr bool PERM = true, AFTER_DRAIN = false;
    bf16_t* O;
    __device__ __forceinline__ void operator()(const f32x4 (&acc)[2][2][4][2], const Unit& u, int wr, int wc, int fr, int fq) const {
        const int row0 = u.pm * BM + wr * 64 + fr, col0 = (u.pn & 7) * BM + wc * 32 + 8 * fq;
#pragma unroll
        for (int ai = 0; ai < 2; ++ai)
#pragma unroll
            for (int m = 0; m < 4; ++m) { bf16_t* rowp = O + (size_t)(row0 + ai * HALF + m * 16) * 2048 + col0;
#pragma unroll
                for (int bj = 0; bj < 2; ++bj) *(u32x4*)(rowp + bj * HALF) = pack8_bf16(acc[ai][bj][m][0], acc[ai][bj][m][1]); }
    }
};
struct MoeOrder {
    int nunits, G, c; const PG8_LAS int* tile_e;
    __device__ __forceinline__ bool next(int i, Unit& u) const {
        int idx;
        if ((G & 7) == 0) { const int per = G >> 3; idx = (i * 8 + (c & 7)) * per + (c >> 3); } else idx = i * G + c;
        if (idx >= nunits) return false;
        const int mt = idx >> 3; u.pm = mt; u.pn = tile_e[mt] * 8 + (idx & 7); return true;
    }
    __device__ __forceinline__ void a_ready(const Unit&) const {}
    __device__ __forceinline__ void done(const Unit&) const {}
};

template <class Epi, class Sched, bool ALIGN_EPI = false, bool SP2 = false>
__device__ __forceinline__ void gemm_phase(PG8_LAS unsigned char* lds, const Gemm g, const Sched& S, const Epi& E) {
    int tid_ = threadIdx.x; asm volatile("" : "+v"(tid_));
    const int tid = tid_, wid = __builtin_amdgcn_readfirstlane(tid >> 6), lane = tid & 63, wr = wid >> 2, wc = wid & 3, fr = lane & 15, fq = lane >> 4;
    const int K = g.K, nt = K / BK;
    unsigned voffA[2], voffB[2];
#pragma unroll
    for (int i = 0; i < 2; ++i) { int R, C; stage_rc(tid * 16 + i * 8192, R, C); const int Rb = Epi::PERM ? ((R & ~31) + perm32(R & 31)) : R;
        voffA[i] = (unsigned)(R * K + C) * 2u; voffB[i] = (unsigned)(Rb * K + C) * 2u; }
    const size_t kstep = (size_t)(BK * 2);
    const size_t hstep = (size_t)HALF * K * 2;
    const size_t tstep = 2 * hstep;
    const unsigned ldsw = (unsigned)wid * 1024u;
    const int aoff = lds_byte(wr * 64 + fr, fq * 8), boff = lds_byte(wc * 32 + fr, fq * 8);
#define PG8_SA(b, h) (((b) * 2 + (h)) * HTB)
#define PG8_SB(b, h) ((4 + (b) * 2 + (h)) * HTB)
#define PG8_STAGE(bufoff, gbase, voff) do { _Pragma("unroll") for (int _i = 0; _i < 2; ++_i) \
        __builtin_amdgcn_global_load_lds((const unsigned*)((const char*)(gbase) + (voff)[_i]), (PG8_LAS unsigned*)(lds + (bufoff) + ldsw + _i * 8192), 16, 0, 0); } while (0)
#define PG8_LDA(dst, b, h) do { _Pragma("unroll") for (int m = 0; m < 4; ++m) _Pragma("unroll") for (int k = 0; k < 2; ++k) dst[m][k] = *(const PG8_LAS bf16x8*)(lds + PG8_SA(b, h) + aoff + m * 2048 + k * 1024); } while (0)
#define PG8_LDB(dst, b, h) do { _Pragma("unroll") for (int n = 0; n < 2; ++n) _Pragma("unroll") for (int k = 0; k < 2; ++k) dst[n][k] = *(const PG8_LAS bf16x8*)(lds + PG8_SB(b, h) + boff + n * 2048 + k * 1024); } while (0)
#define PG8_MMA(ai, bj, At, Bt) do { __builtin_amdgcn_s_setprio(1); _Pragma("unroll") for (int m = 0; m < 4; ++m) _Pragma("unroll") for (int n = 0; n < 2; ++n) _Pragma("unroll") for (int k = 0; k < 2; ++k) \
        acc[ai][bj][m][n] = __builtin_amdgcn_mfma_f32_16x16x32_bf16(Bt[n][k], At[m][k], acc[ai][bj][m][n], 0, 0, 0); __builtin_amdgcn_s_setprio(0); } while (0)
#define PG8_WAIT_V(n) asm volatile("s_waitcnt vmcnt(" #n ")" ::: "memory")
#define PG8_WAIT_L(n) asm volatile("s_waitcnt lgkmcnt(" #n ")" ::: "memory")
#define PG8_BAR __builtin_amdgcn_s_barrier()
#define PG8_SCHED __builtin_amdgcn_sched_barrier(0)
    Unit cur, nxt; int ui = 0;
    if (!S.next(0, cur)) return;
    f32x4 acc[2][2][4][2];
#pragma unroll
    for (int a = 0; a < 2; ++a)
#pragma unroll
        for (int b = 0; b < 2; ++b)
#pragma unroll
            for (int m = 0; m < 4; ++m)
#pragma unroll
                for (int n = 0; n < 2; ++n) acc[a][b][m][n] = (f32x4){0.f, 0.f, 0.f, 0.f};
    bf16x8 At[4][2], B0[2][2], B1[2][2];
    const char* cA = (const char*)g.A + (size_t)cur.pm * tstep; const char* cB = (const char*)g.Bt + (size_t)cur.pn * tstep;
    S.a_ready(cur);
    if constexpr (SP2) {
        PG8_STAGE(PG8_SB(0, 0), cB, voffB); PG8_STAGE(PG8_SB(0, 1), cB + hstep, voffB); PG8_STAGE(PG8_SA(0, 0), cA, voffA); PG8_STAGE(PG8_SA(0, 1), cA + hstep, voffA);
        if (wr == 1) PG8_BAR;
        PG8_WAIT_V(2); PG8_BAR;
        PG8_STAGE(PG8_SB(1, 0), cB + kstep, voffB); PG8_STAGE(PG8_SA(1, 0), cA + kstep, voffA); PG8_STAGE(PG8_SB(1, 1), cB + hstep + kstep, voffB);
        PG8_WAIT_V(6); PG8_BAR;
    } else {
        PG8_STAGE(PG8_SB(0, 0), cB, voffB); PG8_STAGE(PG8_SA(0, 0), cA, voffA); PG8_STAGE(PG8_SB(0, 1), cB + hstep, voffB); PG8_STAGE(PG8_SA(0, 1), cA + hstep, voffA);
        if (wr == 1) PG8_BAR;
        PG8_WAIT_V(4); PG8_BAR;
        PG8_STAGE(PG8_SB(1, 0), cB + kstep, voffB); PG8_STAGE(PG8_SA(1, 0), cA + kstep, voffA); PG8_STAGE(PG8_SB(1, 1), cB + hstep + kstep, voffB);
        PG8_WAIT_V(6); PG8_BAR;
    }
    for (;;) {
        const bool has_next = S.next(ui + 1, nxt);
        const char* nA = has_next ? (const char*)g.A + (size_t)nxt.pm * tstep : cA; const char* nB = has_next ? (const char*)g.Bt + (size_t)nxt.pn * tstep : cB;
        for (int t = 0; t < nt; t += 2) {
            const bool last = (t == nt - 2);
            const char* a1 = cA + (size_t)(t + 1) * kstep;
            const char* a2 = last ? nA : cA + (size_t)(t + 2) * kstep; const char* b2 = last ? nB : cB + (size_t)(t + 2) * kstep;
            const char* a3 = a2 + kstep; const char* b3 = b2 + kstep;
            if (last && has_next) S.a_ready(nxt);
            if constexpr (SP2) {
            PG8_LDB(B0, 0, 0); PG8_LDB(B1, 0, 1); PG8_SCHED; PG8_LDA(At, 0, 0); PG8_STAGE(PG8_SA(1, 1), a1 + hstep, voffA);
            PG8_WAIT_V(8); PG8_WAIT_L(0); PG8_BAR; PG8_MMA(0, 0, At, B0); PG8_MMA(0, 1, At, B1); PG8_BAR; PG8_SCHED;
            PG8_LDA(At, 0, 1); PG8_STAGE(PG8_SB(0, 0), b2, voffB); PG8_STAGE(PG8_SB(0, 1), b2 + hstep, voffB); PG8_STAGE(PG8_SA(0, 0), a2, voffA);
            PG8_WAIT_V(8); PG8_WAIT_L(0); PG8_BAR; PG8_MMA(1, 0, At, B0); PG8_MMA(1, 1, At, B1); PG8_BAR; PG8_SCHED;
            PG8_LDB(B0, 1, 0); PG8_LDB(B1, 1, 1); PG8_SCHED; PG8_LDA(At, 1, 0); PG8_STAGE(PG8_SA(0, 1), a2 + hstep, voffA);
            PG8_WAIT_V(8); PG8_WAIT_L(0); PG8_BAR; PG8_MMA(0, 0, At, B0); PG8_MMA(0, 1, At, B1); PG8_BAR; PG8_SCHED;
            PG8_LDA(At, 1, 1); PG8_STAGE(PG8_SB(1, 0), b3, voffB); PG8_STAGE(PG8_SB(1, 1), b3 + hstep, voffB); PG8_STAGE(PG8_SA(1, 0), a3, voffA);
            PG8_WAIT_V(8); PG8_WAIT_L(0); PG8_BAR; PG8_MMA(1, 0, At, B0); PG8_MMA(1, 1, At, B1); PG8_BAR; PG8_SCHED;
            } else {
            PG8_LDB(B0, 0, 0); PG8_SCHED; PG8_LDA(At, 0, 0); PG8_STAGE(PG8_SA(1, 1), a1 + hstep, voffA);
            PG8_WAIT_L(8); PG8_BAR; PG8_WAIT_L(0); PG8_MMA(0, 0, At, B0); PG8_BAR; PG8_SCHED;
            PG8_LDB(B1, 0, 1); PG8_STAGE(PG8_SB(0, 0), b2, voffB);
            PG8_BAR; PG8_WAIT_L(0); PG8_MMA(0, 1, At, B1); PG8_BAR;
            PG8_LDA(At, 0, 1); PG8_STAGE(PG8_SA(0, 0), a2, voffA);
            PG8_BAR; PG8_WAIT_L(0); PG8_MMA(1, 0, At, B0); PG8_BAR; PG8_SCHED;
            PG8_STAGE(PG8_SB(0, 1), b2 + hstep, voffB);
            PG8_WAIT_V(6); PG8_BAR; PG8_MMA(1, 1, At, B1); PG8_BAR;
            PG8_LDB(B0, 1, 0); PG8_SCHED; PG8_LDA(At, 1, 0); PG8_STAGE(PG8_SA(0, 1), a2 + hstep, voffA);
            PG8_WAIT_L(8); PG8_BAR; PG8_WAIT_L(0); PG8_MMA(0, 0, At, B0); PG8_BAR; PG8_SCHED;
            PG8_LDB(B1, 1, 1); PG8_STAGE(PG8_SB(1, 0), b3, voffB);
            PG8_BAR; PG8_WAIT_L(0); PG8_MMA(0, 1, At, B1); PG8_BAR;
            PG8_LDA(At, 1, 1); PG8_STAGE(PG8_SA(1, 0), a3, voffA);
            PG8_BAR; PG8_WAIT_L(0); PG8_MMA(1, 0, At, B0); PG8_BAR; PG8_SCHED;
            PG8_STAGE(PG8_SB(1, 1), b3 + hstep, voffB);
            PG8_WAIT_V(6); PG8_BAR; PG8_MMA(1, 1, At, B1); PG8_BAR;
            }
        }
        if constexpr (ALIGN_EPI) { if (wr == 0) PG8_BAR; }
        if constexpr (!Epi::AFTER_DRAIN) { E(acc, cur, wr, wc, fr, fq); S.done(cur); }
        if (!has_next) break;
#pragma unroll
        for (int a = 0; a < 2; ++a)
#pragma unroll
            for (int b = 0; b < 2; ++b)
#pragma unroll
                for (int m = 0; m < 4; ++m)
#pragma unroll
                    for (int n = 0; n < 2; ++n) acc[a][b][m][n] = (f32x4){0.f, 0.f, 0.f, 0.f};
        cur = nxt; cA = nA; cB = nB; ++ui;
        if constexpr (ALIGN_EPI) { if (wr == 1) PG8_BAR; }
    }
    PG8_WAIT_V(0);
    if constexpr (!ALIGN_EPI) { if (wr == 0) PG8_BAR; }
    PG8_BAR;
    if constexpr (Epi::AFTER_DRAIN) { E.fused(acc, cur, wr, wc, fr, fq, lds, wid, lane); S.done(cur); }
#undef PG8_SA
#undef PG8_SB
#undef PG8_STAGE
#undef PG8_LDA
#undef PG8_LDB
#undef PG8_MMA
#undef PG8_WAIT_V
#undef PG8_WAIT_L
#undef PG8_BAR
#undef PG8_SCHED
}
}

namespace att {
#define ALAS __attribute__((address_space(3)))
typedef unsigned short bf16_t;
typedef short bf16x8 __attribute__((ext_vector_type(8)));
typedef short s16x4 __attribute__((ext_vector_type(4)));
typedef float f32x16 __attribute__((ext_vector_type(16)));
typedef float f32x4 __attribute__((ext_vector_type(4)));
typedef unsigned u32x4 __attribute__((ext_vector_type(4)));
typedef ALAS char* ldsp;
constexpr int QP = 6144;
constexpr int OP = 2048;
constexpr int SHM_V = 16384, SHM_K = 16384;
constexpr int LDS_V = 0, LDS_K = 2 * SHM_V, LDS_WS = LDS_K + 2 * SHM_K, ATT_LDS_BYTES = LDS_WS + 8 * 256;
#define KSWZ(row, colB) ((row) * 256 + ((colB) ^ (((row) & 7) << 4)))
#define KSWZ64(row, colB) ((row) * 128 + ((colB) ^ (((row) & 7) << 4)))
#define SBAR() __builtin_amdgcn_sched_barrier(0)
__device__ __forceinline__ int v_st(int k, int c) { const int kk = (k & ~0xC) | ((k & 4) << 1) | ((k & 8) >> 1); return ((kk >> 3) * 4 + (c >> 5)) * 512 + ((kk & 7) * 32 + (c & 31)) * 2; }
__device__ __forceinline__ int v_rd_base(int lane) { return ((lane & 3) << 3) | (((lane >> 2) & 3) << 6) | (((lane >> 4) & 1) << 5) | (((lane >> 5) & 1) << 8); }
constexpr int v_rd_off(int d0, int ks, int half) { return d0 * 512 + ks * 4096 + half * 2048; }
__device__ __forceinline__ int crow(int r, int hi) { return (r & 3) + 8 * (r >> 2) + 4 * hi; }
__device__ __forceinline__ unsigned cvtpk(float lo, float hi) { unsigned r; asm volatile("v_cvt_pk_bf16_f32 %0, %1, %2" : "=v"(r) : "v"(lo), "v"(hi)); return r; }
__device__ __forceinline__ bf16x8 ldg8(const bf16_t* p) { return *reinterpret_cast<const bf16x8*>(p); }
__device__ __forceinline__ float xhalf(float v, int hi) {
    auto rr = __builtin_amdgcn_permlane32_swap(__float_as_uint(v), __float_as_uint(v), false, false);
    return __uint_as_float(hi ? rr[0] : rr[1]);
}
#define ATT_PK4(P, B_, OUT) do { unsigned a0 = cvtpk(P[B_+0], P[B_+1]), a1 = cvtpk(P[B_+2], P[B_+3]);                      \
        unsigned b0 = cvtpk(P[B_+4], P[B_+5]), b1 = cvtpk(P[B_+6], P[B_+7]);                                             \
        auto r0 = __builtin_amdgcn_permlane32_swap(a0, b0, false, false); auto r1 = __builtin_amdgcn_permlane32_swap(a1, b1, false, false); \
        u32x4 w = {r0[0], r1[0], r0[1], r1[1]}; OUT = *reinterpret_cast<bf16x8*>(&w); } while (0)
__device__ __forceinline__ void pv_tile(f32x16* o, int vb, bf16x8 pa0, bf16x8 pa1, bf16x8 pa2, bf16x8 pa3) {
#define TRRD(dst, off) asm volatile("ds_read_b64_tr_b16 %0, %1 offset:%2" : "=&v"(dst) : "v"(vb), "i"(off) : "memory")
#define PV_D0(d0) do { s16x4 l0, l1, l2, l3, h0, h1, h2, h3; constexpr int b_ = v_rd_off(d0, 0, 0); \
        TRRD(l0, b_); TRRD(h0, b_ + 2048); TRRD(l1, b_ + 4096); TRRD(h1, b_ + 6144); TRRD(l2, b_ + 8192); TRRD(h2, b_ + 10240); TRRD(l3, b_ + 12288); TRRD(h3, b_ + 14336); \
        asm volatile("s_waitcnt lgkmcnt(0)" ::: "memory"); SBAR(); \
        o[d0] = __builtin_amdgcn_mfma_f32_32x32x16_bf16(pa0, (bf16x8){l0[0], l0[1], l0[2], l0[3], h0[0], h0[1], h0[2], h0[3]}, o[d0], 0, 0, 0);   \
        o[d0] = __builtin_amdgcn_mfma_f32_32x32x16_bf16(pa1, (bf16x8){l1[0], l1[1], l1[2], l1[3], h1[0], h1[1], h1[2], h1[3]}, o[d0], 0, 0, 0);   \
        o[d0] = __builtin_amdgcn_mfma_f32_32x32x16_bf16(pa2, (bf16x8){l2[0], l2[1], l2[2], l2[3], h2[0], h2[1], h2[2], h2[3]}, o[d0], 0, 0, 0);   \
        o[d0] = __builtin_amdgcn_mfma_f32_32x32x16_bf16(pa3, (bf16x8){l3[0], l3[1], l3[2], l3[3], h3[0], h3[1], h3[2], h3[3]}, o[d0], 0, 0, 0); } while (0)
    PV_D0(0); PV_D0(1); PV_D0(2); PV_D0(3);
#undef PV_D0
#undef TRRD
}

__device__ __forceinline__ void sb_block(const bf16_t* __restrict__ Qg, const bf16_t* __restrict__ Kg, const bf16_t* __restrict__ Vg, bf16_t* __restrict__ Og, int qb, ldsp lds) {
    int tid_ = threadIdx.x; asm volatile("" : "+v"(tid_));
    const int tid = tid_, wid = __builtin_amdgcn_readfirstlane(tid >> 6), lane = tid & 63, r32 = lane & 31, hi = lane >> 5;
    const int NT = 4 * qb + 4, R0 = 256 * qb + 32 * wid, myrow = R0 + r32;
    const ldsp V_lds = lds + LDS_V; const ldsp K_lds = lds + LDS_K;
    bf16x8 qr[8];
    { const bf16_t* Qw = Qg + (size_t)R0 * QP; const unsigned qoff = (unsigned)(r32 * QP + hi * 8);
#pragma unroll
      for (int d0 = 0; d0 < 8; ++d0) qr[d0] = ldg8(Qw + (qoff + d0 * 16)); }
    const int sr = tid >> 4, sc = (tid & 15) * 8, kws = KSWZ(sr, sc * 2), vst0 = v_st(sr, sc), vst1 = v_st(32 + sr, sc);
    const unsigned kvoff = (unsigned)(sr * QP + sc);
    const int vb0 = (int)(unsigned)(uintptr_t)V_lds + v_rd_base(lane);
    bf16x8 sk0, sk1, sv0, sv1;
#define SB_LOAD(j) do { const bf16_t* kp_ = Kg + (size_t)(64 * (j)) * QP; const bf16_t* vp_ = Vg + (size_t)(64 * (j)) * QP; \
        sk0 = ldg8(kp_ + kvoff); sk1 = ldg8(kp_ + (size_t)32 * QP + kvoff); sv0 = ldg8(vp_ + kvoff); sv1 = ldg8(vp_ + (size_t)32 * QP + kvoff); } while (0)
#define SB_WRITE(bf) do { *(ALAS bf16x8*)(K_lds + (bf) * SHM_K + kws) = sk0; *(ALAS bf16x8*)(K_lds + (bf) * SHM_K + kws + 32 * 256) = sk1; \
        *(ALAS bf16x8*)(V_lds + (bf) * SHM_V + vst0) = sv0; *(ALAS bf16x8*)(V_lds + (bf) * SHM_V + vst1) = sv1; } while (0)
    SB_LOAD(NT - 1); SB_WRITE(0);
    __syncthreads();
    float carry = 0.f; f32x16 o[4] = {};
    for (int t = 0; t < NT; ++t) {
        const int j = NT - 1 - t, buf = t & 1, kb = 64 * j;
        if (t + 1 < NT) SB_LOAD(j - 1);
        if (kb <= R0 + 30) {
            f32x16 p0 = {}, p1 = {};
            { const ldsp Kb = K_lds + buf * SHM_K;
#pragma unroll
              for (int d0 = 0; d0 < 8; ++d0) { const ldsp a = Kb + KSWZ(r32, ((d0 & 3) * 16 + hi * 8) * 2) + (d0 >> 2) * 128;
                  const bf16x8 b0 = *(const ALAS bf16x8*)a, b1 = *(const ALAS bf16x8*)(a + 32 * 256);
                  p0 = __builtin_amdgcn_mfma_f32_32x32x16_bf16(b0, qr[d0], p0, 0, 0, 0);
                  p1 = __builtin_amdgcn_mfma_f32_32x32x16_bf16(b1, qr[d0], p1, 0, 0, 0); } }
            f32x16 lb0, lb1;
#pragma unroll
            for (int r = 0; r < 16; ++r) {
                { const float z = p0[r]; const float e = __builtin_amdgcn_exp2f(-__builtin_fabsf(z)); const float sp = __builtin_fmaxf(z, 0.f) + __builtin_amdgcn_logf(1.f + e); p0[r] = -sp; lb0[r] = z - sp; }
                { const float z = p1[r]; const float e = __builtin_amdgcn_exp2f(-__builtin_fabsf(z)); const float sp = __builtin_fmaxf(z, 0.f) + __builtin_amdgcn_logf(1.f + e); p1[r] = -sp; lb1[r] = z - sp; }
            }
            if (kb + 63 >= R0) {
                const int dq = myrow - kb - 4 * hi; const float NEG = -__builtin_inff();
#pragma unroll
                for (int r = 0; r < 16; ++r) { const int c = (r & 3) + 8 * (r >> 2);
                    if (c >= dq) { p0[r] = 0.f; lb0[r] = NEG; }
                    if (c + 32 >= dq) { p1[r] = 0.f; lb1[r] = NEG; } }
            }
            float gs[8], go[8];
#pragma unroll
            for (int g = 0; g < 4; ++g) { gs[g] = (p0[4 * g] + p0[4 * g + 1]) + (p0[4 * g + 2] + p0[4 * g + 3]); gs[4 + g] = (p1[4 * g] + p1[4 * g + 1]) + (p1[4 * g + 2] + p1[4 * g + 3]); }
#pragma unroll
            for (int i = 0; i < 8; ++i) go[i] = xhalf(gs[i], hi);
            float acc = carry;
#pragma unroll
            for (int idx = 7; idx >= 0; --idx) { const int g = idx & 3; const float base = acc + (hi ? 0.f : go[idx]);
                if (idx >= 4) { const float t3 = base, t2 = t3 + p1[4 * g + 3], t1 = t2 + p1[4 * g + 2], t0 = t1 + p1[4 * g + 1];
                    lb1[4 * g + 3] = __builtin_amdgcn_exp2f(lb1[4 * g + 3] + t3); lb1[4 * g + 2] = __builtin_amdgcn_exp2f(lb1[4 * g + 2] + t2);
                    lb1[4 * g + 1] = __builtin_amdgcn_exp2f(lb1[4 * g + 1] + t1); lb1[4 * g] = __builtin_amdgcn_exp2f(lb1[4 * g] + t0); }
                else { const float t3 = base, t2 = t3 + p0[4 * g + 3], t1 = t2 + p0[4 * g + 2], t0 = t1 + p0[4 * g + 1];
                    lb0[4 * g + 3] = __builtin_amdgcn_exp2f(lb0[4 * g + 3] + t3); lb0[4 * g + 2] = __builtin_amdgcn_exp2f(lb0[4 * g + 2] + t2);
                    lb0[4 * g + 1] = __builtin_amdgcn_exp2f(lb0[4 * g + 1] + t1); lb0[4 * g] = __builtin_amdgcn_exp2f(lb0[4 * g] + t0); }
                acc += gs[idx] + go[idx]; }
            carry = acc;
            bf16x8 pa0, pa1, pa2, pa3;
            ATT_PK4(lb0, 0, pa0); ATT_PK4(lb0, 8, pa1); ATT_PK4(lb1, 0, pa2); ATT_PK4(lb1, 8, pa3);
            SBAR();
            pv_tile(o, vb0 + buf * SHM_V, pa0, pa1, pa2, pa3);
        }
        if (t + 1 < NT) SB_WRITE(buf ^ 1);
        __syncthreads();
    }
#undef SB_LOAD
#undef SB_WRITE
    bf16_t* Ow = Og + (size_t)R0 * OP; const unsigned ooff = (unsigned)(4 * hi * OP + r32);
#pragma unroll
    for (int r = 0; r < 16; ++r) { bf16_t* rowp = Ow + (size_t)((r & 3) + 8 * (r >> 2)) * OP;
#pragma unroll
        for (int d0 = 0; d0 < 4; ++d0) { const float v = o[d0][r]; const float vn = __shfl_xor(v, 1);
            if ((r32 & 1) == 0) *(unsigned*)(rowp + (ooff + d0 * 32)) = cvtpk(v, vn); } }
}

constexpr float ATT_THR = 8.f;
template <bool SECOND>
__device__ __forceinline__ void diff_pass(const bf16_t* __restrict__ Qg, const bf16_t* __restrict__ Kg, const bf16_t* __restrict__ Vg, float* S1, bf16_t* __restrict__ Og,
                                          int qb, float lam, const float* __restrict__ gsub, float gmul, ldsp lds) {
    int tid_ = threadIdx.x; asm volatile("" : "+v"(tid_));
    const int tid = tid_, wid = __builtin_amdgcn_readfirstlane(tid >> 6), lane = tid & 63, r32 = lane & 31, hi = lane >> 5;
    const int NT = 4 * qb + 4, R0 = 256 * qb + 32 * wid, myrow = R0 + r32;
    const ldsp V_lds = lds + LDS_V; const ldsp K_lds = lds + LDS_K;
    ALAS float* wsf = (ALAS float*)(lds + LDS_WS) + wid * 64; ALAS float* li_l = wsf; ALAS float* al_l = wsf + 32;
    bf16x8 qr[4];
    { const bf16_t* Qw = Qg + (size_t)R0 * QP; const unsigned qoff = (unsigned)(r32 * QP + hi * 8);
#pragma unroll
      for (int d0 = 0; d0 < 4; ++d0) qr[d0] = ldg8(Qw + (qoff + d0 * 16)); }
    const int sr = tid >> 4, sc = (tid & 15) * 8, vst0 = v_st(sr, sc), vst1 = v_st(32 + sr, sc);
    const int kr = tid >> 3, kc = (tid & 7) * 8, kws = KSWZ64(kr, kc * 2);
    const unsigned voff = (unsigned)(sr * QP + sc), koff = (unsigned)(kr * QP + kc);
    const int vb0 = (int)(unsigned)(uintptr_t)V_lds + v_rd_base(lane);
    bf16x8 sk0, sv0, sv1;
#define DF_LOAD(j) do { const bf16_t* vp_ = Vg + (size_t)(64 * (j)) * QP; sk0 = ldg8(Kg + (size_t)(64 * (j)) * QP + koff); sv0 = ldg8(vp_ + voff); sv1 = ldg8(vp_ + (size_t)32 * QP + voff); } while (0)
#define DF_WRITE(bf) do { *(ALAS bf16x8*)(K_lds + (bf) * SHM_K + kws) = sk0; *(ALAS bf16x8*)(V_lds + (bf) * SHM_V + vst0) = sv0; *(ALAS bf16x8*)(V_lds + (bf) * SHM_V + vst1) = sv1; } while (0)
    DF_LOAD(0); DF_WRITE(0);
    __syncthreads();
    float m_reg = -1e30f, l_reg = 0.f; f32x16 o[4] = {};
    for (int t = 0; t < NT; ++t) {
        const int buf = t & 1, kb = 64 * t;
        if (t + 1 < NT) DF_LOAD(t + 1);
        if (kb <= R0 + 31) {
            f32x16 p0 = {}, p1 = {};
            { const ldsp Kb = K_lds + buf * SHM_K;
#pragma unroll
              for (int d0 = 0; d0 < 4; ++d0) { const ldsp a = Kb + KSWZ64(r32, (d0 * 16 + hi * 8) * 2);
                  const bf16x8 b0 = *(const ALAS bf16x8*)a, b1 = *(const ALAS bf16x8*)(a + 32 * 128);
                  p0 = __builtin_amdgcn_mfma_f32_32x32x16_bf16(b0, qr[d0], p0, 0, 0, 0);
                  p1 = __builtin_amdgcn_mfma_f32_32x32x16_bf16(b1, qr[d0], p1, 0, 0, 0); } }
            if (kb + 63 > R0) {
                const int dq = myrow - kb - 4 * hi; const float NEG = -__builtin_inff();
#pragma unroll
                for (int r = 0; r < 16; ++r) { const int c = (r & 3) + 8 * (r >> 2);
                    if (c > dq) p0[r] = NEG;
                    if (c + 32 > dq) p1[r] = NEG; }
            }
            float pmax = p0[0];
#pragma unroll
            for (int r = 1; r < 16; ++r) pmax = __builtin_fmaxf(pmax, p0[r]);
#pragma unroll
            for (int r = 0; r < 16; ++r) pmax = __builtin_fmaxf(pmax, p1[r]);
            pmax = __builtin_fmaxf(pmax, xhalf(pmax, hi));
            float alpha = 1.f, mn = m_reg;
            if (!__all(pmax - m_reg <= ATT_THR)) { mn = __builtin_fmaxf(m_reg, pmax); alpha = __builtin_amdgcn_exp2f(m_reg - mn); m_reg = mn; }
            float ps = 0.f;
#pragma unroll
            for (int r = 0; r < 16; ++r) { p0[r] = __builtin_amdgcn_exp2f(p0[r] - mn); p1[r] = __builtin_amdgcn_exp2f(p1[r] - mn); ps += p0[r] + p1[r]; }
            ps += xhalf(ps, hi);
            l_reg = l_reg * alpha + ps;
            if (__any(alpha < 1.f)) { if (hi == 0) al_l[r32] = alpha; asm volatile("s_waitcnt lgkmcnt(0)" ::: "memory");
#pragma unroll
                for (int d_ = 0; d_ < 4; ++d_)
#pragma unroll
                    for (int r = 0; r < 16; ++r) o[d_][r] *= al_l[crow(r, hi)]; }
            bf16x8 pa0, pa1, pa2, pa3;
            ATT_PK4(p0, 0, pa0); ATT_PK4(p0, 8, pa1); ATT_PK4(p1, 0, pa2); ATT_PK4(p1, 8, pa3);
            SBAR();
            pv_tile(o, vb0 + buf * SHM_V, pa0, pa1, pa2, pa3);
        }
        if (t + 1 < NT) DF_WRITE(buf ^ 1);
        __syncthreads();
    }
#undef DF_LOAD
#undef DF_WRITE
    if (hi == 0) li_l[r32] = l_reg; asm volatile("s_waitcnt lgkmcnt(0)" ::: "memory");
    float rli[16];
#pragma unroll
    for (int r = 0; r < 16; ++r) rli[r] = __builtin_amdgcn_rcpf(li_l[crow(r, hi)]);
    if constexpr (!SECOND) {
        float* Sw = S1 + (size_t)R0 * OP; const unsigned ooff = (unsigned)(4 * hi * OP + r32);
#pragma unroll
        for (int r = 0; r < 16; ++r) { float* rowp = Sw + (size_t)((r & 3) + 8 * (r >> 2)) * OP;
#pragma unroll
            for (int d0 = 0; d0 < 4; ++d0) rowp[ooff + d0 * 32] = o[d0][r] * rli[r]; }
    } else {
        const float* Sw = S1 + (size_t)R0 * OP; bf16_t* Ow = Og + (size_t)R0 * OP; const unsigned ooff = (unsigned)(4 * hi * OP + r32);
        float gn[4];
#pragma unroll
        for (int d0 = 0; d0 < 4; ++d0) gn[d0] = gsub[d0 * 32 + r32] * gmul;
#pragma unroll
        for (int r = 0; r < 16; ++r) { const float* srow = Sw + (size_t)((r & 3) + 8 * (r >> 2)) * OP; bf16_t* orowp = Ow + (size_t)((r & 3) + 8 * (r >> 2)) * OP; float d[4]; float ss = 0.f;
#pragma unroll
            for (int d0 = 0; d0 < 4; ++d0) { d[d0] = srow[ooff + d0 * 32] - lam * (o[d0][r] * rli[r]); ss += d[d0] * d[d0]; }
            ss += __shfl_xor(ss, 1); ss += __shfl_xor(ss, 2); ss += __shfl_xor(ss, 4); ss += __shfl_xor(ss, 8); ss += __shfl_xor(ss, 16);
            const float rs = __builtin_amdgcn_rsqf(ss * (1.f / 128.f) + 1e-5f);
#pragma unroll
            for (int d0 = 0; d0 < 4; ++d0) { const float v = d[d0] * rs * gn[d0]; const float vn = __shfl_xor(v, 1);
                if ((r32 & 1) == 0) *(unsigned*)(orowp + (ooff + d0 * 32)) = cvtpk(v, vn); }
            if ((r & 1) == 1) asm volatile("" ::: "memory"); }
    }
    __syncthreads();
}
#undef SBAR
}

#define LAS __attribute__((address_space(3)))

#define XB_TMO      128
#define XB_XCNT(j)  (256  + 64 * (j))
#define XB_XSUB(j)  (1280 + 64 * (j))
#define XB_XGEN(j)  (2304 + 64 * (j))
#define XB_TOP      3328
#define XB_TOPGEN   3392
#define XCD_BAR_WORDS 3456
#define XB_SPIN_CAP (1u << 18)

__device__ __forceinline__ unsigned xb_ld(unsigned* p)              { return __hip_atomic_load(p, __ATOMIC_RELAXED, __HIP_MEMORY_SCOPE_AGENT); }
__device__ __forceinline__ unsigned xb_add(unsigned* p, unsigned v) { return __hip_atomic_fetch_add(p, v, __ATOMIC_RELAXED, __HIP_MEMORY_SCOPE_AGENT); }
__device__ __forceinline__ unsigned xb_xcc_id() { return (unsigned)__builtin_amdgcn_s_getreg((3 << 11) | 20) & 0xFu; }
#define XB_SPIN(cond, bar) do { unsigned _sp = 0; while (cond) { __builtin_amdgcn_s_sleep(1); \
    if ((++_sp & 255u) == 0u) { if (xb_ld(&(bar)[XB_TMO])) break; if (_sp > XB_SPIN_CAP) { atomicAdd(&(bar)[XB_TMO], 1u); break; } } } } while (0)

struct XcdBarrier {
    unsigned* bar; unsigned x;
    volatile LAS unsigned* st;
};

__device__ __forceinline__ XcdBarrier xcd_barrier_post(unsigned* bar, volatile LAS unsigned* st) {
    XcdBarrier b; b.bar = bar; b.x = xb_xcc_id(); b.st = st;
    if (threadIdx.x == 0) (void)xb_add(&bar[XB_XCNT(b.x)], 1u);
    return b;
}
__device__ __forceinline__ void xcd_barrier_complete(unsigned* bar, unsigned x, unsigned& nloc, unsigned& nx) {
    const unsigned G = gridDim.x * gridDim.y * gridDim.z;
    unsigned sum, cnt, mine, sp = 0u;
    for (;;) {
        sum = 0u; cnt = 0u; mine = 0u;
#pragma unroll
        for (unsigned j = 0; j < 16; ++j) { const unsigned c = xb_ld(&bar[XB_XCNT(j)]); sum += c; cnt += (c > 0u) ? 1u : 0u; mine = (j == x) ? c : mine; }
        if (sum == G) break;
        __builtin_amdgcn_s_sleep(1);
        if ((++sp & 255u) == 0u) { if (xb_ld(&bar[XB_TMO])) break; if (sp > XB_SPIN_CAP) { atomicAdd(&bar[XB_TMO], 1u); break; } }
    }
    nloc = mine > 0u ? mine : 1u; nx = cnt > 0u ? cnt : 1u;
}

__device__ __forceinline__ void xcd_barrier(const XcdBarrier& b) {
    asm volatile("s_waitcnt vmcnt(0)" ::: "memory");
    __syncthreads();
    if (threadIdx.x == 0) {
        unsigned* bar = b.bar;
        __builtin_amdgcn_s_waitcnt(0);
        unsigned nloc = b.st[0], nx = b.st[1];
        if (nloc == 0u) { xcd_barrier_complete(bar, b.x, nloc, nx); b.st[0] = nloc; b.st[1] = nx; }
        const unsigned old = xb_add(&bar[XB_XSUB(b.x)], 1u);
        const unsigned gen = old / nloc;
        if (old + 1u == (gen + 1u) * nloc) {
            __builtin_amdgcn_fence(__ATOMIC_RELEASE, "agent");
            asm volatile("s_waitcnt vmcnt(0)" ::: "memory");
            const unsigned og = xb_add(&bar[XB_TOP], 1u);
            const unsigned tg = og / nx;
            if (og + 1u == (tg + 1u) * nx) xb_add(&bar[XB_TOPGEN], 1u);
            else XB_SPIN(xb_ld(&bar[XB_TOPGEN]) == tg, bar);
            __builtin_amdgcn_fence(__ATOMIC_ACQUIRE, "agent");
            xb_add(&bar[XB_XGEN(b.x)], 1u);
            asm volatile("s_waitcnt vmcnt(0)" ::: "memory");
        } else {
            XB_SPIN(xb_ld(&bar[XB_XGEN(b.x)]) == gen, bar);
            __builtin_amdgcn_fence(__ATOMIC_ACQUIRE, "agent");
            asm volatile("s_waitcnt vmcnt(0)" ::: "memory");
        }
    }
    __syncthreads();
}

constexpr int NWAVES = 8;
constexpr int NTOK = 16384, DM = 2048, SEQ = 2048, NHEAD = 16, NLAYER = 4, NEXP = 16, DEXP = 1024;
constexpr int XS_ROWS = 36864;
constexpr float LN_EPS = 1e-5f;
constexpr float DN_ALPHA = 1.6817928305074292f;
constexpr float LOG2E = 1.4426950408889634f;
constexpr float SB_QSCALE = 0.08838834764831845f * LOG2E;
constexpr float DF_QSCALE = 0.125f * LOG2E;
#ifndef MK_MULTI
#define MK_MULTI 0
#endif
constexpr int NSTEPS = 1 + 8 * NLAYER;

constexpr size_t MiB = 1u << 20;
constexpr size_t WS_CTL = 0, CTL_ZERO_BYTES = 64 * 1024;
constexpr size_t WS_COS = 1 * MiB, WS_SIN = WS_COS + 256 * 1024;
constexpr size_t WS_WR = 2 * MiB;
constexpr size_t WS_CNT = 3 * MiB;
constexpr size_t WS_RE = WS_CNT + 64 * 1024;
constexpr size_t WS_RW = WS_RE + 64 * 1024;
constexpr size_t WS_RP = WS_RW + 128 * 1024;
constexpr size_t WS_WQKVA = 4 * MiB;
constexpr size_t WS_WOA = WS_WQKVA + 48 * MiB;
constexpr size_t WS_WQKVB = WS_WOA + 16 * MiB;
constexpr size_t WS_WOB = WS_WQKVB + 32 * MiB;
constexpr size_t WS_WGU = WS_WOB + 16 * MiB;
constexpr size_t WS_WDN = WS_WGU + 512 * MiB;
constexpr size_t WS_H = WS_WDN + 256 * MiB;
constexpr size_t WS_HB = WS_H + 128 * MiB;
constexpr size_t WS_QKV = WS_HB + 64 * MiB;
constexpr size_t WS_OB = WS_QKV + 192 * MiB;
constexpr size_t WS_XS = WS_OB + 64 * MiB;
constexpr size_t WS_ACT = WS_XS + 144 * MiB;
constexpr size_t WS_YD = WS_ACT + 72 * MiB;
constexpr size_t WS_END = WS_YD + 144 * MiB;
static_assert(WS_END <= (size_t)2040 * MiB, "workspace map");
constexpr int CW_BAR = 1024;
constexpr int LDS_BYTES = 147456;
constexpr int LDSCTL_OFF = 145408;
constexpr int RING_OFF = 0;

#define GAS __attribute__((address_space(1)))
typedef unsigned short bf16;
typedef unsigned v4u __attribute__((ext_vector_type(4)));
typedef unsigned v2u __attribute__((ext_vector_type(2)));
typedef float f32x4 __attribute__((ext_vector_type(4)));
typedef float f32x2 __attribute__((ext_vector_type(2)));
#define LDS_WAIT() asm volatile("s_waitcnt lgkmcnt(0)" ::: "memory")
#define VM_WAIT() asm volatile("s_waitcnt vmcnt(0)" ::: "memory")
__device__ __forceinline__ unsigned pk2(float lo, float hi) { unsigned r; asm volatile("v_cvt_pk_bf16_f32 %0, %1, %2" : "=v"(r) : "v"(lo), "v"(hi)); return r; }
__device__ __forceinline__ int opq_tid() { int t = threadIdx.x; asm volatile("" : "+v"(t)); return t; }
__device__ __forceinline__ float wave_sum(float v) {
#pragma unroll
    for (int o = 1; o < 64; o <<= 1) v += __shfl_xor(v, o);
    return v;
}

struct Args { const float* in[17]; float* out; unsigned char* ws; int s_lo, s_hi; };

__device__ __forceinline__ int map_row(int n, int mode) {
    if (mode == 0) return n;
    if (mode == 1) { const int c = n & 255, blk = c >> 6, d = c & 63; return (n & ~255) + ((d >> 5) << 7) + (blk << 5) + (d & 31); }
    return ((n >> 7) << 8) + (n & 127) + (mode == 3 ? 128 : 0);
}
__device__ __forceinline__ void cvt_item(const float* __restrict__ src, int pitch, int K, bf16* __restrict__ dst, int mode, int k0, int n0, LAS float* scr, int lane) {
    const int kr = lane >> 4, n4 = (lane & 15) * 4;
    f32x4 v[16];
#pragma unroll
    for (int i = 0; i < 16; ++i) v[i] = __builtin_nontemporal_load((const f32x4*)(src + (size_t)(k0 + 4 * i + kr) * pitch + n0 + n4));
#pragma unroll
    for (int i = 0; i < 16; ++i) { LAS float* s = scr + (4 * i + kr) * 65 + n4; s[0] = v[i][0]; s[1] = v[i][1]; s[2] = v[i][2]; s[3] = v[i][3]; }
    LDS_WAIT();
    const int c = lane & 7;
#pragma unroll
    for (int j = 0; j < 8; ++j) { const int nl = (lane >> 3) + 8 * j; const int row = map_row(n0 + nl, mode);
        const LAS float* s = scr + (8 * c) * 65 + nl;
        v4u o; o.x = pk2(s[0], s[65]); o.y = pk2(s[130], s[195]); o.z = pk2(s[260], s[325]); o.w = pk2(s[390], s[455]);
        *(v4u*)(dst + (size_t)row * K + k0 + 8 * c) = o; }
    LDS_WAIT();
}

__global__ void __launch_bounds__(NWAVES * 64, 2) yoco_fwd(Args args) {
    extern __shared__ __attribute__((aligned(16))) unsigned char lds_raw[];
    LAS unsigned char* const lds = (LAS unsigned char*)lds_raw;
    const int tid = threadIdx.x, lane = tid & 63, wave = __builtin_amdgcn_readfirstlane(tid >> 6);
    const int G = gridDim.x, bx = blockIdx.x;
    const int vcu = (G % 8 == 0) ? (bx % 8) * (G / 8) + bx / 8 : bx;
    unsigned char* const ws = args.ws;
    volatile LAS unsigned* const CTL = (volatile LAS unsigned*)(lds + LDSCTL_OFF);
    LAS int* const TAB = (LAS int*)(lds + LDSCTL_OFF + 64);
    for (int u = tid; u < (LDS_BYTES - LDSCTL_OFF) / 4; u += NWAVES * 64) ((LAS unsigned*)(lds + LDSCTL_OFF))[u] = 0u;
    __syncthreads();
    const int s_lo = args.s_lo, s_hi = args.s_hi;
    XcdBarrier bar; bar.bar = (unsigned*)(ws + WS_CTL) + CW_BAR; bar.x = 0; bar.st = nullptr;
    if (s_hi - s_lo > 1) bar = xcd_barrier_post((unsigned*)(ws + WS_CTL) + CW_BAR, CTL);
#ifndef PH_MASK
#define PH_MASK 0xFFFF
#endif
#define PHM(b) (((PH_MASK) >> (b)) & 1)
#define IN(k) (s_lo <= (k) && (k) < s_hi)
#define SEAM(k) do { if ((k) + 1 < s_hi) xcd_barrier(bar); } while (0)

    const float* const x_in = args.in[0];
    float* const H = (float*)(ws + WS_H); bf16* const HB = (bf16*)(ws + WS_HB); bf16* const QKV = (bf16*)(ws + WS_QKV); bf16* const OB = (bf16*)(ws + WS_OB);
    bf16* const XS = (bf16*)(ws + WS_XS); float* const S1 = (float*)(ws + WS_XS); bf16* const ACT = (bf16*)(ws + WS_ACT); bf16* const YD = (bf16*)(ws + WS_YD);
    float* const COS = (float*)(ws + WS_COS); float* const SIN = (float*)(ws + WS_SIN); float* const WR = (float*)(ws + WS_WR);
    int* const CNT = (int*)(ws + WS_CNT); unsigned* const RE = (unsigned*)(ws + WS_RE); f32x2* const RW = (f32x2*)(ws + WS_RW); int* const RP = (int*)(ws + WS_RP);

    if (IN(0) && PHM(0)) {
        const int tid = opq_tid(), lane = tid & 63;
        LAS float* scr = (LAS float*)(lds + RING_OFF + wave * 16640);
        const int gw = vcu * NWAVES + wave, NGW = G * NWAVES;
        constexpr int I0 = 2 * 3072, I1 = 8 * 1024, I2 = 128 * 512, I3 = 64 * 512, NITEMS = I0 + I1 + I2 + I3;
        for (int it = gw; it < NITEMS; it += NGW) {
            int r = it;
            if (r < I0) { const int job = r / 3072; r -= job * 3072; const int kb = r / 96, nb = r - kb * 96;
                cvt_item(args.in[1] + (size_t)job * 2048 * 6144, 6144, 2048, (bf16*)(ws + WS_WQKVA) + (size_t)job * 6144 * 2048, 0, kb * 64, nb * 64, scr, lane); continue; }
            r -= I0;
            if (r < I1) { const int job = r >> 10; r &= 1023; const int kb = r >> 5, nb = r & 31;
                const float* src; int pitch = 2048, mode = 0; bf16* dst;
                if (job < 2) { src = args.in[2] + (size_t)job * 2048 * 2048; dst = (bf16*)(ws + WS_WOA) + (size_t)job * 2048 * 2048; }
                else if (job == 2) { src = args.in[4]; dst = (bf16*)(ws + WS_WQKVB); mode = 1; }
                else if (job == 3) { src = args.in[3]; pitch = 4096; dst = (bf16*)(ws + WS_WQKVB) + (size_t)2048 * 2048; mode = 1; }
                else if (job == 4) { src = args.in[3] + 2048; pitch = 4096; dst = (bf16*)(ws + WS_WQKVB) + (size_t)4096 * 2048; }
                else if (job == 5) { src = args.in[4] + (size_t)2048 * 2048; dst = (bf16*)(ws + WS_WQKVB) + (size_t)6144 * 2048; mode = 1; }
                else { src = args.in[5] + (size_t)(job - 6) * 2048 * 2048; dst = (bf16*)(ws + WS_WOB) + (size_t)(job - 6) * 2048 * 2048; }
                cvt_item(src, pitch, 2048, dst, mode, kb * 64, nb * 64, scr, lane); continue; }
            r -= I1;
            if (r < I2) { const int job = r >> 9; r &= 511; const int kb = r >> 4, nb = r & 15; const int le = job >> 1, up = job & 1;
                cvt_item((up ? args.in[15] : args.in[14]) + (size_t)le * 2048 * 1024, 1024, 2048, (bf16*)(ws + WS_WGU) + (size_t)le * 2048 * 2048, 2 + up, kb * 64, nb * 64, scr, lane); continue; }
            r -= I2;
            { const int le = r >> 9; r &= 511; const int kb = r >> 5, nb = r & 31;
                cvt_item(args.in[16] + (size_t)le * 1024 * 2048, 2048, 1024, (bf16*)(ws + WS_WDN) + (size_t)le * 2048 * 1024, 0, kb * 64, nb * 64, scr, lane); }
        }
        for (size_t i = (size_t)gw * 64 + lane; i < (size_t)NTOK * DM / 4; i += (size_t)NGW * 64) {
            const f32x4 v = __builtin_nontemporal_load((const f32x4*)x_in + i); ((f32x4*)H)[i] = v;
            v2u o; o.x = pk2(v[0], v[1]); o.y = pk2(v[2], v[3]); ((v2u*)HB)[i] = o; }
        for (int i = bx * (NWAVES * 64) + tid; i < 2048 * 32; i += G * NWAVES * 64) { const int pos = i >> 5, f = i & 31;
            const float inv = __builtin_amdgcn_exp2f(-(float)f * 0.4152410118609203f); const float ang = (float)pos * inv;
            const double tr = (double)ang * 0.15915494309189535; const float fr = (float)(tr - __builtin_rint(tr));
            COS[i] = __builtin_amdgcn_cosf(fr); SIN[i] = __builtin_amdgcn_sinf(fr); }
        for (int i = bx * (NWAVES * 64) + tid; i < NLAYER * 20 * 2048; i += G * NWAVES * 64) { const int k = i & 2047, c = (i >> 11) % 20, l = i / (20 * 2048);
            WR[i] = c < 4 ? args.in[12][((size_t)l * 2048 + k) * 4 + c] : args.in[13][(((size_t)l * 4 + ((c - 4) >> 2)) * 2048 + k) * 4 + ((c - 4) & 3)]; }
        SEAM(0);
    }

    for (int L = 0; L < NLAYER; ++L) {
        const int sb = 1 + 8 * L; const bool typeA = L < 2;
        if (IN(sb + 0)) {
            if (typeA && PHM(1)) {
                pg8::Gemm g{HB, (const bf16*)(ws + WS_WQKVA) + (size_t)L * 6144 * 2048, NTOK, 6144, DM}; pg8::StaticOrder S; S.init(NTOK, 6144, G, bx);
                pg8::EpiQkv E{QKV, 6144, 2048, SB_QSCALE};
                pg8::gemm_phase<pg8::EpiQkv, pg8::StaticOrder, true, true>(lds + RING_OFF, g, S, E);
            } else if (!typeA && PHM(2)) {
                const int N = (L == 2) ? 6144 : 2048;
                pg8::Gemm g{HB, (const bf16*)(ws + WS_WQKVB) + (L == 2 ? (size_t)0 : (size_t)6144 * 2048), NTOK, N, DM}; pg8::StaticOrder S; S.init(NTOK, N, G, bx);
                pg8::EpiRope E{QKV, 6144, 2048, 4096, DF_QSCALE, COS, SIN};
                pg8::gemm_phase<pg8::EpiRope, pg8::StaticOrder, true, true>(lds + RING_OFF, g, S, E);
            }
            SEAM(sb + 0);
        }
        if (IN(sb + 1)) {
            if (typeA && PHM(3)) {
                for (int id = vcu; id < 512; id += G) { const int bh = id >> 2, p = id & 3, b = bh >> 4, h = bh & 15;
                    const bf16* Qg = QKV + (size_t)b * SEQ * 6144 + h * 128; bf16* Og = OB + (size_t)b * SEQ * DM + h * 128;
                    att::sb_block(Qg, Qg + 2048, Qg + 4096, Og, 7 - p, (att::ldsp)(lds + RING_OFF));
                    att::sb_block(Qg, Qg + 2048, Qg + 4096, Og, p, (att::ldsp)(lds + RING_OFF)); }
            } else if (!typeA && PHM(4)) {
                const int lane = opq_tid() & 63;
                const int i = L - 2; const float lam_init = (L == 2) ? 0.47071301834264183f : 0.5560582041556061f;
                const float* lp = args.in[6] + (size_t)i * 256;
                const float sa = wave_sum(lp[lane] * lp[64 + lane]), sb2 = wave_sum(lp[128 + lane] * lp[192 + lane]);
                const float lam = __builtin_amdgcn_exp2f(sa * LOG2E) - __builtin_amdgcn_exp2f(sb2 * LOG2E) + lam_init;
                const float* gsub = args.in[7] + (size_t)i * 128; const float gmul = 1.f - lam_init;
                for (int id = vcu; id < 512; id += G) { const int bh = id >> 2, p = id & 3, b = bh >> 4, h = bh & 15;
                    const bf16* Qg = QKV + (size_t)b * SEQ * 6144 + h * 128; bf16* Og = OB + (size_t)b * SEQ * DM + h * 128; float* Sg = S1 + (size_t)b * SEQ * DM + h * 128;
#pragma unroll 1
                    for (int w = 0; w < 2; ++w) { const int qb = w ? p : 7 - p;
                        att::diff_pass<false>(Qg, Qg + 2048, Qg + 4096, Sg, Og, qb, lam, gsub, gmul, (att::ldsp)(lds + RING_OFF));
                        att::diff_pass<true>(Qg + 64, Qg + 2048 + 64, Qg + 4096, Sg, Og, qb, lam, gsub, gmul, (att::ldsp)(lds + RING_OFF)); } }
            }
            SEAM(sb + 1);
        }
        if (IN(sb + 2)) { if (PHM(5)) {
            pg8::Gemm g{OB, (const bf16*)(ws + (typeA ? WS_WOA : WS_WOB)) + (size_t)(L & 1) * 2048 * 2048, NTOK, DM, DM}; pg8::StaticOrder S; S.init(NTOK, DM, G, bx);
            pg8::EpiResid E{H, DM, DN_ALPHA};
            pg8::gemm_phase<pg8::EpiResid, pg8::StaticOrder, true, true>(lds + RING_OFF, g, S, E); }
            SEAM(sb + 2);
        }
        if (IN(sb + 3)) { if (PHM(6)) {
            const int tid = opq_tid(), lane = tid & 63;
            const float* lng = args.in[8] + (size_t)L * DM; const float* lnb = args.in[9] + (size_t)L * DM; const float* wr = WR + (size_t)L * 20 * 2048;
            LAS int* eid = (LAS int*)(lds + RING_OFF);
            LAS float* lgt = (LAS float*)(lds + RING_OFF + 2048);
            for (int c = bx; c < 256; c += G) {
#pragma unroll 1
                for (int grp = 0; grp < 4; ++grp) {
                    const int rloc = wave * 8 + grp * 2; const size_t row0 = (size_t)64 * c + rloc;
                    f32x4 v[2][8]; float mu[2], rstd[2];
#pragma unroll
                    for (int rr = 0; rr < 2; ++rr) { const f32x4* hp = (const f32x4*)(H + (row0 + rr) * DM) + lane; float s = 0.f;
#pragma unroll
                        for (int j = 0; j < 8; ++j) { v[rr][j] = hp[64 * j]; s += (v[rr][j][0] + v[rr][j][1]) + (v[rr][j][2] + v[rr][j][3]); }
                        mu[rr] = wave_sum(s) * (1.f / DM); float q = 0.f;
#pragma unroll
                        for (int j = 0; j < 8; ++j) { const f32x4 d = v[rr][j] - mu[rr]; q += (d[0] * d[0] + d[1] * d[1]) + (d[2] * d[2] + d[3] * d[3]); }
                        rstd[rr] = 1.f / sqrtf(wave_sum(q) * (1.f / DM) + LN_EPS); }
#pragma unroll
                    for (int j = 0; j < 8; ++j) { const f32x4 gg = ((const f32x4*)lng)[64 * j + lane], bb = ((const f32x4*)lnb)[64 * j + lane];
#pragma unroll
                        for (int rr = 0; rr < 2; ++rr) { v[rr][j] = (v[rr][j] - mu[rr]) * rstd[rr] * gg + bb; ((f32x4*)(H + (row0 + rr) * DM))[64 * j + lane] = v[rr][j]; } }
#pragma unroll 1
                    for (int cc = 0; cc < 20; ++cc) { const f32x4* wp = (const f32x4*)(wr + cc * 2048) + lane; float a0 = 0.f, a1 = 0.f;
#pragma unroll
                        for (int j = 0; j < 8; ++j) { const f32x4 w = wp[64 * j];
                            a0 += (v[0][j][0] * w[0] + v[0][j][1] * w[1]) + (v[0][j][2] * w[2] + v[0][j][3] * w[3]);
                            a1 += (v[1][j][0] * w[0] + v[1][j][1] * w[1]) + (v[1][j][2] * w[2] + v[1][j][3] * w[3]); }
                        a0 = wave_sum(a0); a1 = wave_sum(a1);
                        if (lane == 0) { lgt[rloc * 20 + cc] = a0; lgt[(rloc + 1) * 20 + cc] = a1; } }
                }
                LDS_WAIT();
                if (lane < 8) {
                    const int rl = wave * 8 + lane; const LAS float* lg = lgt + rl * 20;
                    int gsel = 0; float gm = lg[0];
#pragma unroll
                    for (int i = 1; i < 4; ++i) { const float x = lg[i]; if (x > gm) { gm = x; gsel = i; } }
                    float gden = 0.f;
#pragma unroll
                    for (int i = 0; i < 4; ++i) gden += __builtin_amdgcn_exp2f((lg[i] - gm) * LOG2E);
                    const float gw_ = 1.f / gden;
                    const LAS float* li = lg + 4 + 4 * gsel;
                    const float l0 = li[0], l1 = li[1], l2 = li[2], l3 = li[3];
                    int i0 = 0; float v0 = l0;
                    if (l1 > v0) { v0 = l1; i0 = 1; } if (l2 > v0) { v0 = l2; i0 = 2; } if (l3 > v0) { v0 = l3; i0 = 3; }
                    int i1 = -1; float v1 = 0.f;
                    if (i0 != 0) { v1 = l0; i1 = 0; }
                    if (i0 != 1 && (i1 < 0 || l1 > v1)) { v1 = l1; i1 = 1; }
                    if (i0 != 2 && (i1 < 0 || l2 > v1)) { v1 = l2; i1 = 2; }
                    if (i0 != 3 && (i1 < 0 || l3 > v1)) { v1 = l3; i1 = 3; }
                    const float t = __builtin_amdgcn_exp2f((v1 - v0) * LOG2E); const float w0 = gw_ / (1.f + t), w1 = gw_ * t / (1.f + t);
                    eid[2 * rl] = gsel * 4 + i0; eid[2 * rl + 1] = gsel * 4 + i1; RW[(size_t)64 * c + rl] = (f32x2){w0, w1};
                }
                __syncthreads();
                if (wave == 0) {
                    const int ea = eid[lane], eb = eid[64 + lane]; int ra = 0, rb = 0, cnt = 0; const unsigned long long lt = (1ull << lane) - 1ull;
#pragma unroll
                    for (int e = 0; e < 16; ++e) { const unsigned long long ma = __ballot(ea == e), mb = __ballot(eb == e);
                        if (ea == e) ra = __popcll(ma & lt); if (eb == e) rb = __popcll(ma) + __popcll(mb & lt); if (lane == e) cnt = __popcll(ma) + __popcll(mb); }
                    if (lane < 16) CNT[c * 16 + lane] = cnt;
                    LAS int* rk = (LAS int*)(lds + RING_OFF + 1024); rk[lane] = ra; rk[64 + lane] = rb; LDS_WAIT();
                    const int r = lane; const unsigned word = (unsigned)eid[2 * r] | ((unsigned)eid[2 * r + 1] << 8) | ((unsigned)rk[2 * r] << 16) | ((unsigned)rk[2 * r + 1] << 24);
                    RE[(size_t)64 * c + r] = word;
                }
                __syncthreads();
            } }
            SEAM(sb + 3);
        }
        if ((IN(sb + 4) || IN(sb + 5) || IN(sb + 6)) && PHM(7)) {
            const int tid = opq_tid();
            LAS int* part = (LAS int*)(lds + RING_OFF);
            { const int e = tid & 15, s = tid >> 4; int a = 0;
#pragma unroll
              for (int i = 0; i < 8; ++i) a += CNT[(8 * s + i) * 16 + e];
              part[s * 16 + e] = a; }
            __syncthreads();
            if (tid < 16) { int run = 0; for (int s = 0; s < 32; ++s) run += part[s * 16 + tid]; TAB[tid] = run; }
            __syncthreads();
            if (tid == 0) { int off = 0, mt = 0; for (int e = 0; e < 16; ++e) { TAB[16 + e] = off; const int nt = (TAB[e] + 255) >> 8; for (int i = 0; i < nt; ++i) TAB[64 + mt++] = e; off += nt * 256; } TAB[32] = off; TAB[33] = mt; }
            __syncthreads();
        }
        if (IN(sb + 4)) { if (PHM(7)) {
            const int tid = opq_tid(), lane = tid & 63;
            LAS int* part = (LAS int*)(lds + RING_OFF);
            for (int c = bx; c < 256; c += G) {
                if (tid < 16) { int pre = 0; for (int s = 0; s < (c >> 3); ++s) pre += part[s * 16 + tid]; for (int cc = c & ~7; cc < c; ++cc) pre += CNT[cc * 16 + tid]; TAB[48 + tid] = TAB[16 + tid] + pre; }
                __syncthreads();
#pragma unroll 1
                for (int rr = 0; rr < 8; ++rr) { const size_t row = (size_t)64 * c + wave * 8 + rr; const unsigned word = RE[row];
                    const int p0 = TAB[48 + (word & 255)] + ((word >> 16) & 255), p1 = TAB[48 + ((word >> 8) & 255)] + (word >> 24);
                    if (lane == 0) { RP[2 * row] = p0; RP[2 * row + 1] = p1; }
                    const f32x4* hp = (const f32x4*)(H + row * DM) + lane; v2u* o0 = (v2u*)(XS + (size_t)p0 * DM) + lane; v2u* o1 = (v2u*)(XS + (size_t)p1 * DM) + lane;
#pragma unroll
                    for (int j = 0; j < 8; ++j) { const f32x4 v = hp[64 * j]; v2u o; o.x = pk2(v[0], v[1]); o.y = pk2(v[2], v[3]); o0[64 * j] = o; o1[64 * j] = o; } }
                __syncthreads();
            } }
            SEAM(sb + 4);
        }
        if (IN(sb + 5)) { if (PHM(8)) {
            pg8::Gemm g{XS, (const bf16*)(ws + WS_WGU) + (size_t)L * 16 * 2048 * 2048, XS_ROWS, 2048, DM};
            pg8::MoeOrder S{TAB[33] * 8, G, bx, TAB + 64}; pg8::EpiGateUp E{ACT};
            pg8::gemm_phase<pg8::EpiGateUp, pg8::MoeOrder, true, true>(lds + RING_OFF, g, S, E); }
            SEAM(sb + 5);
        }
        if (IN(sb + 6)) { if (PHM(9)) {
            pg8::Gemm g{ACT, (const bf16*)(ws + WS_WDN) + (size_t)L * 16 * 2048 * 1024, XS_ROWS, 2048, DEXP};
            pg8::MoeOrder S{TAB[33] * 8, G, bx, TAB + 64}; pg8::EpiDown E{YD};
            pg8::gemm_phase<pg8::EpiDown, pg8::MoeOrder, true, true>(lds + RING_OFF, g, S, E); }
            SEAM(sb + 6);
        }
        if (IN(sb + 7)) { if (PHM(10)) {
            const int tid = opq_tid(), lane = tid & 63;
            const float* lng = args.in[10] + (size_t)L * DM; const float* lnb = args.in[11] + (size_t)L * DM; const bool last = (L == NLAYER - 1);
            const int gw = vcu * NWAVES + wave, NGW = G * NWAVES;
            for (int row = gw; row < NTOK; row += NGW) {
                const int p0 = RP[2 * row], p1 = RP[2 * row + 1]; const f32x2 w = RW[row];
                const f32x4* hp = (const f32x4*)(H + (size_t)row * DM) + lane; const v2u* y0 = (const v2u*)(YD + (size_t)p0 * DM) + lane; const v2u* y1 = (const v2u*)(YD + (size_t)p1 * DM) + lane;
                f32x4 v[8]; float s = 0.f;
#pragma unroll
                for (int j = 0; j < 8; ++j) { const f32x4 h = hp[64 * j]; const v2u a = y0[64 * j], b = y1[64 * j];
                    const f32x4 fa = {__uint_as_float(a.x << 16), __uint_as_float(a.x & 0xffff0000u), __uint_as_float(a.y << 16), __uint_as_float(a.y & 0xffff0000u)};
                    const f32x4 fb = {__uint_as_float(b.x << 16), __uint_as_float(b.x & 0xffff0000u), __uint_as_float(b.y << 16), __uint_as_float(b.y & 0xffff0000u)};
                    v[j] = h * DN_ALPHA + fa * w.x + fb * w.y; s += (v[j][0] + v[j][1]) + (v[j][2] + v[j][3]); }
                const float mu = wave_sum(s) * (1.f / DM); float q = 0.f;
#pragma unroll
                for (int j = 0; j < 8; ++j) { const f32x4 d = v[j] - mu; q += (d[0] * d[0] + d[1] * d[1]) + (d[2] * d[2] + d[3] * d[3]); }
                const float rstd = 1.f / sqrtf(wave_sum(q) * (1.f / DM) + LN_EPS);
                f32x4* op = (f32x4*)((last ? args.out : H) + (size_t)row * DM) + lane; v2u* ob = (v2u*)(HB + (size_t)row * DM) + lane;
#pragma unroll
                for (int j = 0; j < 8; ++j) { const f32x4 gg = ((const f32x4*)lng)[64 * j + lane], bb = ((const f32x4*)lnb)[64 * j + lane];
                    const f32x4 y = (v[j] - mu) * rstd * gg + bb; op[64 * j] = y;
                    if (!last) { v2u o; o.x = pk2(y[0], y[1]); o.y = pk2(y[2], y[3]); ob[64 * j] = o; } }
            } }
            SEAM(sb + 7);
        }
    }
#undef IN
#undef SEAM
}

extern "C" void kernel_launch(void* const* d_in, const int* in_sizes, int n_in, void* d_out, int out_size, void* d_ws, size_t ws_size, hipStream_t stream) {
    static int grid = 0;
    if (grid == 0) {
        if (n_in != 17 || in_sizes[0] != NTOK * DM || out_size != NTOK * DM || ws_size < WS_END) { fprintf(stderr, "kernel_launch: unexpected shapes / workspace (n_in %d, ws %zu, need %zu)\n", n_in, ws_size, (size_t)WS_END); grid = -1; return; }
        int dev = 0, cus = 0, per_cu = 0;
        if (hipGetDevice(&dev) != hipSuccess || hipDeviceGetAttribute(&cus, hipDeviceAttributeMultiprocessorCount, dev) != hipSuccess) { grid = -1; return; }
        if (hipFuncSetAttribute((const void*)yoco_fwd, hipFuncAttributeMaxDynamicSharedMemorySize, LDS_BYTES) != hipSuccess) { fprintf(stderr, "kernel_launch: hipFuncSetAttribute failed\n"); grid = -1; return; }
        if (hipOccupancyMaxActiveBlocksPerMultiprocessor(&per_cu, (const void*)yoco_fwd, NWAVES * 64, LDS_BYTES) != hipSuccess || per_cu < 1) { fprintf(stderr, "kernel_launch: occupancy query says %d\n", per_cu); per_cu = 1; }
        (void)hipGetLastError();
        grid = cus;
    }
    if (grid < 0) return;
    (void)hipMemsetAsync((char*)d_ws + WS_CTL, 0, CTL_ZERO_BYTES, stream);
    Args a{};
    for (int i = 0; i < 17; ++i) a.in[i] = (const float*)d_in[i];
    a.out = (float*)d_out; a.ws = (unsigned char*)d_ws;
#if MK_MULTI
    for (int s = 0; s < NSTEPS; ++s) { a.s_lo = s; a.s_hi = s + 1; hipLaunchKernelGGL(yoco_fwd, dim3(grid), dim3(NWAVES * 64), LDS_BYTES, stream, a); }
#else
    a.s_lo = 0; a.s_hi = NSTEPS;
    hipLaunchKernelGGL(yoco_fwd, dim3(grid), dim3(NWAVES * 64), LDS_BYTES, stream, a);
#endif
    const hipError_t le = hipPeekAtLastError();
    if (le != hipSuccess) fprintf(stderr, "kernel_launch: launch failed: %s\n", hipGetErrorName(le));
}
```

```cpp
#include <hip/hip_runtime.h>
#include <cstdio>
#include <cstdint>

namespace pg8 {
#define PG8_LAS __attribute__((address_space(3)))
typedef unsigned short bf16_t;
typedef short bf16x8 __attribute__((ext_vector_type(8)));
typedef float f32x4 __attribute__((ext_vector_type(4)));
typedef unsigned u32x4 __attribute__((ext_vector_type(4)));
constexpr int BM = 256, BK = 64, HALF = 128, HTB = HALF * BK * 2  , STAGE_BYTES = 8 * HTB, NXCD = 8, WGM = 8;

__host__ __device__ __forceinline__ int lds_byte(int r, int c) { const int st = (r >> 4) * 2 + (c >> 5), rr = r & 15, cc = c & 31, ob = rr * 64 + cc * 2; return st * 1024 + (ob ^ (((ob >> 9) & 1) << 5)); }
__host__ __device__ __forceinline__ void stage_rc(int b, int& R, int& C) { const int st = b / 1024, sb = b % 1024, swz = sb ^ (((sb >> 9) & 1) << 5); R = (st >> 1) * 16 + swz / 64; C = (st & 1) * 32 + (swz % 64) / 2; }
__host__ __device__ __forceinline__ int perm32(int rho) { const int n = rho >> 4, i = rho & 15; return 8 * (i >> 2) + 4 * n + (i & 3); }

struct Unit { int pm, pn; };
struct Gemm { const bf16_t* A; const bf16_t* Bt; int M, N, K; };

struct StaticOrder {
    int nM, nN, nwg, G, c;
    __host__ __device__ void init(int M, int N, int G_, int c_) { nM = M / BM; nN = N / BM; nwg = nM * nN; G = G_; c = c_; }
    __host__ __device__ bool next(int i, Unit& u) const {
        const long L = (long)i * G + c; if (L >= nwg) return false;
        int wgid = (int)L; { const int q = nwg / NXCD, r = nwg % NXCD, xcd = wgid % NXCD, off = wgid / NXCD; wgid = (xcd < r ? xcd * (q + 1) : r * (q + 1) + (xcd - r) * q) + off; }
        const int nig = WGM * nN, gid = wgid / nig, fm = gid * WGM, gsz = (nM - fm) < WGM ? (nM - fm) : WGM;
        u.pm = fm + ((wgid % nig) % gsz); u.pn = (wgid % nig) / gsz; return true;
    }
    __device__ __forceinline__ void a_ready(const Unit&) const {}
    __device__ __forceinline__ void done(const Unit&) const {}
};

__device__ __forceinline__ unsigned cvt_pk_bf16(float lo, float hi) { unsigned r; asm volatile("v_cvt_pk_bf16_f32 %0, %1, %2" : "=v"(r) : "v"(lo), "v"(hi)); return r; }
typedef float f32x2 __attribute__((ext_vector_type(2)));

typedef unsigned u32x2 __attribute__((ext_vector_type(2)));
__device__ __forceinline__ u32x4 pack8_bf16(const f32x4 a, const f32x4 b) { u32x4 w; w.x = cvt_pk_bf16(a[0], a[1]); w.y = cvt_pk_bf16(a[2], a[3]); w.z = cvt_pk_bf16(b[0], b[1]); w.w = cvt_pk_bf16(b[2], b[3]); return w; }

struct EpiQkv {
    static constexpr bool PERM = true, AFTER_DRAIN = false;
    bf16_t* O; int ldc; int qcols; float qscale;
    __device__ __forceinline__ void operator()(const f32x4 (&acc)[2][2][4][2], const Unit& u, int wr, int wc, int fr, int fq) const {
        const int row0 = u.pm * BM + wr * 64 + fr, colt = u.pn * BM; const float sc = colt < qcols ? qscale : 1.f;
        const int col0 = colt + wc * 32 + 8 * fq;
#pragma unroll
        for (int ai = 0; ai < 2; ++ai)
#pragma unroll
            for (int m = 0; m < 4; ++m) { bf16_t* rowp = O + (size_t)(row0 + ai * HALF + m * 16) * ldc + col0;
#pragma unroll
                for (int bj = 0; bj < 2; ++bj) *(u32x4*)(rowp + bj * HALF) = pack8_bf16(acc[ai][bj][m][0] * sc, acc[ai][bj][m][1] * sc); }
    }
};
struct EpiResid {
    static constexpr bool PERM = false, AFTER_DRAIN = false;
    float* H; int ldc; float alpha;
    __device__ __forceinline__ void operator()(const f32x4 (&acc)[2][2][4][2], const Unit& u, int wr, int wc, int fr, int fq) const {
        const int row0 = u.pm * BM + wr * 64 + fr, col0 = u.pn * BM + wc * 32 + 4 * fq;
#pragma unroll
        for (int ai = 0; ai < 2; ++ai)
#pragma unroll
            for (int m = 0; m < 4; ++m) { float* rowp = H + (size_t)(row0 + ai * HALF + m * 16) * ldc + col0;
#pragma unroll
                for (int bj = 0; bj < 2; ++bj)
#pragma unroll
                    for (int n = 0; n < 2; ++n) { f32x4* q = (f32x4*)(rowp + bj * HALF + n * 16); const f32x4 h = *q; *q = h * alpha + acc[ai][bj][m][n]; } }
    }
};
struct EpiRope {
    static constexpr bool PERM = true, AFTER_DRAIN = false;
    bf16_t* O; int ldc; int qcols, ropecols; float qscale; const float* ctab; const float* stab;
    __device__ __forceinline__ void operator()(const f32x4 (&acc)[2][2][4][2], const Unit& u, int wr, int wc, int fr, int fq) const {
        const int row0 = u.pm * BM + wr * 64 + fr, colt = u.pn * BM;
        if (colt >= ropecols) {
            const int col0 = colt + wc * 32 + 8 * fq;
#pragma unroll
            for (int ai = 0; ai < 2; ++ai)
#pragma unroll
                for (int m = 0; m < 4; ++m) { bf16_t* rowp = O + (size_t)(row0 + ai * HALF + m * 16) * ldc + col0;
#pragma unroll
                    for (int bj = 0; bj < 2; ++bj) *(u32x4*)(rowp + bj * HALF) = pack8_bf16(acc[ai][bj][m][0], acc[ai][bj][m][1]); }
        } else {
            const float sc = colt < qcols ? qscale : 1.f;
            const int col0 = colt + wc * 64 + 8 * fq;
#pragma unroll
            for (int ai = 0; ai < 2; ++ai)
#pragma unroll
                for (int m = 0; m < 4; ++m) { const int row = row0 + ai * HALF + m * 16; const int pos = row & 2047;
                    const f32x4 c0 = *(const f32x4*)(ctab + pos * 32 + 8 * fq), c1 = *(const f32x4*)(ctab + pos * 32 + 8 * fq + 4);
                    const f32x4 s0 = *(const f32x4*)(stab + pos * 32 + 8 * fq), s1 = *(const f32x4*)(stab + pos * 32 + 8 * fq + 4);
                    const f32x4 a0 = acc[ai][0][m][0], a1 = acc[ai][0][m][1], b0 = acc[ai][1][m][0], b1 = acc[ai][1][m][1];
                    bf16_t* rowp = O + (size_t)row * ldc + col0;
                    *(u32x4*)(rowp) = pack8_bf16((a0 * c0 - b0 * s0) * sc, (a1 * c1 - b1 * s1) * sc);
                    *(u32x4*)(rowp + 32) = pack8_bf16((b0 * c0 + a0 * s0) * sc, (b1 * c1 + a1 * s1) * sc); }
        }
    }
};
struct EpiGateUp {
    static constexpr bool PERM = true, AFTER_DRAIN = false;
    bf16_t* O;
    __device__ __forceinline__ void operator()(const f32x4 (&acc)[2][2][4][2], const Unit& u, int wr, int wc, int fr, int fq) const {
        const int row0 = u.pm * BM + wr * 64 + fr, col0 = (u.pn & 7) * 128 + wc * 32 + 8 * fq;
#pragma unroll
        for (int ai = 0; ai < 2; ++ai)
#pragma unroll
            for (int m = 0; m < 4; ++m) { f32x4 r[2];
#pragma unroll
                for (int n = 0; n < 2; ++n) { const f32x4 g = acc[ai][0][m][n], up = acc[ai][1][m][n];
#pragma unroll
                    for (int i = 0; i < 4; ++i) { const float e = __builtin_amdgcn_exp2f(g[i] * -1.4426950408889634f); r[n][i] = g[i] * __builtin_amdgcn_rcpf(1.f + e) * up[i]; } }
                *(u32x4*)(O + (size_t)(row0 + ai * HALF + m * 16) * 1024 + col0) = pack8_bf16(r[0], r[1]); }
    }
};
struct EpiDown {
    static constexpr bool PERM = true, AFTER_DRAIN = false;
    bf16_t* O;
    __device__ __forceinline__ void operator()(const f32x4 (&acc)[2][2][4][2], const Unit& u, int wr, int wc, int fr, int fq) const {
        const int row0 = u.pm * BM + wr * 64 + fr, col0 = (u.pn & 7) * BM + wc * 32 + 8 * fq;
#pragma unroll
        for (int ai = 0; ai < 2; ++ai)
#pragma unroll
            for (int m = 0; m < 4; ++m) { bf16_t* rowp = O + (size_t)(row0 + ai * HALF + m * 16) * 2048 + col0;
#pragma unroll
                for (int bj = 0; bj < 2; ++bj) *(u32x4*)(rowp + bj * HALF) = pack8_bf16(acc[ai][bj][m][0], acc[ai][bj][m][1]); }
    }
};
struct MoeOrder {
    int nunits, G, c; const PG8_LAS int* tile_e;
    __device__ __forceinline__ bool next(int i, Unit& u) const {
        int idx;
        if ((G & 7) == 0) { const int per = G >> 3; idx = (i * 8 + (c & 7)) * per + (c >> 3); } else idx = i * G + c;
        if (idx >= nunits) return false;
        const int mt = idx >> 3; u.pm = mt; u.pn = tile_e[mt] * 8 + (idx & 7); return true;
    }
    __device__ __forceinline__ void a_ready(const Unit&) const {}
    __device__ __forceinline__ void done(const Unit&) const {}
};

template <class Epi, class Sched, bool ALIGN_EPI = false, bool SP2 = false>
__device__ __forceinline__ void gemm_phase(PG8_LAS unsigned char* lds, const Gemm g, const Sched& S, const Epi& E) {
    int tid_ = threadIdx.x; asm volatile("" : "+v"(tid_));
    const int tid = tid_, wid = __builtin_amdgcn_readfirstlane(tid >> 6), lane = tid & 63, wr = wid >> 2, wc = wid & 3, fr = lane & 15, fq = lane >> 4;
    const int K = g.K, nt = K / BK;
    unsigned voffA[2], voffB[2];
#pragma unroll
    for (int i = 0; i < 2; ++i) { int R, C; stage_rc(tid * 16 + i * 8192, R, C); const int Rb = Epi::PERM ? ((R & ~31) + perm32(R & 31)) : R;
        voffA[i] = (unsigned)(R * K + C) * 2u; voffB[i] = (unsigned)(Rb * K + C) * 2u; }
    const size_t kstep = (size_t)(BK * 2);
    const size_t hstep = (size_t)HALF * K * 2;
    const size_t tstep = 2 * hstep;
    const unsigned ldsw = (unsigned)wid * 1024u;
    const int aoff = lds_byte(wr * 64 + fr, fq * 8), boff = lds_byte(wc * 32 + fr, fq * 8);
#define PG8_SA(b, h) (((b) * 2 + (h)) * HTB)
#define PG8_SB(b, h) ((4 + (b) * 2 + (h)) * HTB)
#define PG8_STAGE(bufoff, gbase, voff) do { _Pragma("unroll") for (int _i = 0; _i < 2; ++_i) \
        __builtin_amdgcn_global_load_lds((const unsigned*)((const char*)(gbase) + (voff)[_i]), (PG8_LAS unsigned*)(lds + (bufoff) + ldsw + _i * 8192), 16, 0, 0); } while (0)
#define PG8_LDA(dst, b, h) do { _Pragma("unroll") for (int m = 0; m < 4; ++m) _Pragma("unroll") for (int k = 0; k < 2; ++k) dst[m][k] = *(const PG8_LAS bf16x8*)(lds + PG8_SA(b, h) + aoff + m * 2048 + k * 1024); } while (0)
#define PG8_LDB(dst, b, h) do { _Pragma("unroll") for (int n = 0; n < 2; ++n) _Pragma("unroll") for (int k = 0; k < 2; ++k) dst[n][k] = *(const PG8_LAS bf16x8*)(lds + PG8_SB(b, h) + boff + n * 2048 + k * 1024); } while (0)
#define PG8_MMA(ai, bj, At, Bt) do { __builtin_amdgcn_s_setprio(1); _Pragma("unroll") for (int m = 0; m < 4; ++m) _Pragma("unroll") for (int n = 0; n < 2; ++n) _Pragma("unroll") for (int k = 0; k < 2; ++k) \
        acc[ai][bj][m][n] = __builtin_amdgcn_mfma_f32_16x16x32_bf16(Bt[n][k], At[m][k], acc[ai][bj][m][n], 0, 0, 0); __builtin_amdgcn_s_setprio(0); } while (0)
#define PG8_WAIT_V(n) asm volatile("s_waitcnt vmcnt(" #n ")" ::: "memory")
#define PG8_WAIT_L(n) asm volatile("s_waitcnt lgkmcnt(" #n ")" ::: "memory")
#define PG8_BAR __builtin_amdgcn_s_barrier()
#define PG8_SCHED __builtin_amdgcn_sched_barrier(0)
    Unit cur, nxt; int ui = 0;
    if (!S.next(0, cur)) return;
    f32x4 acc[2][2][4][2];
#pragma unroll
    for (int a = 0; a < 2; ++a)
#pragma unroll
        for (int b = 0; b < 2; ++b)
#pragma unroll
            for (int m = 0; m < 4; ++m)
#pragma unroll
                for (int n = 0; n < 2; ++n) acc[a][b][m][n] = (f32x4){0.f, 0.f, 0.f, 0.f};
    bf16x8 At[4][2], B0[2][2], B1[2][2];
    const char* cA = (const char*)g.A + (size_t)cur.pm * tstep; const char* cB = (const char*)g.Bt + (size_t)cur.pn * tstep;
    S.a_ready(cur);
    if constexpr (SP2) {
        PG8_STAGE(PG8_SB(0, 0), cB, voffB); PG8_STAGE(PG8_SB(0, 1), cB + hstep, voffB); PG8_STAGE(PG8_SA(0, 0), cA, voffA); PG8_STAGE(PG8_SA(0, 1), cA + hstep, voffA);
        if (wr == 1) PG8_BAR;
        PG8_WAIT_V(2); PG8_BAR;
        PG8_STAGE(PG8_SB(1, 0), cB + kstep, voffB); PG8_STAGE(PG8_SA(1, 0), cA + kstep, voffA); PG8_STAGE(PG8_SB(1, 1), cB + hstep + kstep, voffB);
        PG8_WAIT_V(6); PG8_BAR;
    } else {
        PG8_STAGE(PG8_SB(0, 0), cB, voffB); PG8_STAGE(PG8_SA(0, 0), cA, voffA); PG8_STAGE(PG8_SB(0, 1), cB + hstep, voffB); PG8_STAGE(PG8_SA(0, 1), cA + hstep, voffA);
        if (wr == 1) PG8_BAR;
        PG8_WAIT_V(4); PG8_BAR;
        PG8_STAGE(PG8_SB(1, 0), cB + kstep, voffB); PG8_STAGE(PG8_SA(1, 0), cA + kstep, voffA); PG8_STAGE(PG8_SB(1, 1), cB + hstep + kstep, voffB);
        PG8_WAIT_V(6); PG8_BAR;
    }
    for (;;) {
        const bool has_next = S.next(ui + 1, nxt);
        const char* nA = has_next ? (const char*)g.A + (size_t)nxt.pm * tstep : cA; const char* nB = has_next ? (const char*)g.Bt + (size_t)nxt.pn * tstep : cB;
        for (int t = 0; t < nt; t += 2) {
            const bool last = (t == nt - 2);
            const char* a1 = cA + (size_t)(t + 1) * kstep;
            const char* a2 = last ? nA : cA + (size_t)(t + 2) * kstep; const char* b2 = last ? nB : cB + (size_t)(t + 2) * kstep;
            const char* a3 = a2 + kstep; const char* b3 = b2 + kstep;
            if (last && has_next) S.a_ready(nxt);
            if constexpr (SP2) {
            PG8_LDB(B0, 0, 0); PG8_LDB(B1, 0, 1); PG8_SCHED; PG8_LDA(At, 0, 0); PG8_STAGE(PG8_SA(1, 1), a1 + hstep, voffA);
            PG8_WAIT_V(8); PG8_WAIT_L(0); PG8_BAR; PG8_MMA(0, 0, At, B0); PG8_MMA(0, 1, At, B1); PG8_BAR; PG8_SCHED;
            PG8_LDA(At, 0, 1); PG8_STAGE(PG8_SB(0, 0), b2, voffB); PG8_STAGE(PG8_SB(0, 1), b2 + hstep, voffB); PG8_STAGE(PG8_SA(0, 0), a2, voffA);
            PG8_WAIT_V(8); PG8_WAIT_L(0); PG8_BAR; PG8_MMA(1, 0, At, B0); PG8_MMA(1, 1, At, B1); PG8_BAR; PG8_SCHED;
            PG8_LDB(B0, 1, 0); PG8_LDB(B1, 1, 1); PG8_SCHED; PG8_LDA(At, 1, 0); PG8_STAGE(PG8_SA(0, 1), a2 + hstep, voffA);
            PG8_WAIT_V(8); PG8_WAIT_L(0); PG8_BAR; PG8_MMA(0, 0, At, B0); PG8_MMA(0, 1, At, B1); PG8_BAR; PG8_SCHED;
            PG8_LDA(At, 1, 1); PG8_STAGE(PG8_SB(1, 0), b3, voffB); PG8_STAGE(PG8_SB(1, 1), b3 + hstep, voffB); PG8_STAGE(PG8_SA(1, 0), a3, voffA);
            PG8_WAIT_V(8); PG8_WAIT_L(0); PG8_BAR; PG8_MMA(1, 0, At, B0); PG8_MMA(1, 1, At, B1); PG8_BAR; PG8_SCHED;
            } else {
            PG8_LDB(B0, 0, 0); PG8_SCHED; PG8_LDA(At, 0, 0); PG8_STAGE(PG8_SA(1, 1), a1 + hstep, voffA);
            PG8_WAIT_L(8); PG8_BAR; PG8_WAIT_L(0); PG8_MMA(0, 0, At, B0); PG8_BAR; PG8_SCHED;
            PG8_LDB(B1, 0, 1); PG8_STAGE(PG8_SB(0, 0), b2, voffB);
            PG8_BAR; PG8_WAIT_L(0); PG8_MMA(0, 1, At, B1); PG8_BAR;
            PG8_LDA(At, 0, 1); PG8_STAGE(PG8_SA(0, 0), a2, voffA);
            PG8_BAR; PG8_WAIT_L(0); PG8_MMA(1, 0, At, B0); PG8_BAR; PG8_SCHED;
            PG8_STAGE(PG8_SB(0, 1), b2 + hstep, voffB);
            PG8_WAIT_V(6); PG8_BAR; PG8_MMA(1, 1, At, B1); PG8_BAR;
            PG8_LDB(B0, 1, 0); PG8_SCHED; PG8_LDA(At, 1, 0); PG8_STAGE(PG8_SA(0, 1), a2 + hstep, voffA);
            PG8_WAIT_L(8); PG8_BAR; PG8_WAIT_L(0); PG8_MMA(0, 0, At, B0); PG8_BAR; PG8_SCHED;
            PG8_LDB(B1, 1, 1); PG8_STAGE(PG8_SB(1, 0), b3, voffB);
            PG8_BAR; PG8_WAIT_L(0); PG8_MMA(0, 1, At, B1); PG8_BAR;
            PG8_LDA(At, 1, 1); PG8_STAGE(PG8_SA(1, 0), a3, voffA);
            PG8_BAR; PG8_WAIT_L(0); PG8_MMA(1, 0, At, B0); PG8_BAR; PG8_SCHED;
            PG8_STAGE(PG8_SB(1, 1), b3 + hstep, voffB);
            PG8_WAIT_V(6); PG8_BAR; PG8_MMA(1, 1, At, B1); PG8_BAR;
            }
        }
        if constexpr (ALIGN_EPI) { if (wr == 0) PG8_BAR; }
        if constexpr (!Epi::AFTER_DRAIN) { E(acc, cur, wr, wc, fr, fq); S.done(cur); }
        if (!has_next) break;
#pragma unroll
        for (int a = 0; a < 2; ++a)
#pragma unroll
            for (int b = 0; b < 2; ++b)
#pragma unroll
                for (int m = 0; m < 4; ++m)
#pragma unroll
                    for (int n = 0; n < 2; ++n) acc[a][b][m][n] = (f32x4){0.f, 0.f, 0.f, 0.f};
        cur = nxt; cA = nA; cB = nB; ++ui;
        if constexpr (ALIGN_EPI) { if (wr == 1) PG8_BAR; }
    }
    PG8_WAIT_V(0);
    if constexpr (!ALIGN_EPI) { if (wr == 0) PG8_BAR; }
    PG8_BAR;
    if constexpr (Epi::AFTER_DRAIN) { E.fused(acc, cur, wr, wc, fr, fq, lds, wid, lane); S.done(cur); }
#undef PG8_SA
#undef PG8_SB
#undef PG8_STAGE
#undef PG8_LDA
#undef PG8_LDB
#undef PG8_MMA
#undef PG8_WAIT_V
#undef PG8_WAIT_L
#undef PG8_BAR
#undef PG8_SCHED
}
}

namespace att {
#define ALAS __attribute__((address_space(3)))
typedef unsigned short bf16_t;
typedef short bf16x8 __attribute__((ext_vector_type(8)));
typedef short s16x4 __attribute__((ext_vector_type(4)));
typedef float f32x16 __attribute__((ext_vector_type(16)));
typedef float f32x4 __attribute__((ext_vector_type(4)));
typedef unsigned u32x4 __attribute__((ext_vector_type(4)));
typedef ALAS char* ldsp;
constexpr int QP = 6144;
constexpr int OP = 2048;
constexpr int SHM_V = 16384, SHM_K = 16384;
constexpr int LDS_V = 0, LDS_K = 2 * SHM_V, LDS_WS = LDS_K + 2 * SHM_K, ATT_LDS_BYTES = LDS_WS + 8 * 256;
#define KSWZ(row, colB) ((row) * 256 + ((colB) ^ (((row) & 7) << 4)))
#define KSWZ64(row, colB) ((row) * 128 + ((colB) ^ (((row) & 7) << 4)))
#define SBAR() __builtin_amdgcn_sched_barrier(0)
__device__ __forceinline__ int v_st(int k, int c) { const int kk = (k & ~0xC) | ((k & 4) << 1) | ((k & 8) >> 1); return ((kk >> 3) * 4 + (c >> 5)) * 512 + ((kk & 7) * 32 + (c & 31)) * 2; }
__device__ __forceinline__ int v_rd_base(int lane) { return ((lane & 3) << 3) | (((lane >> 2) & 3) << 6) | (((lane >> 4) & 1) << 5) | (((lane >> 5) & 1) << 8); }
constexpr int v_rd_off(int d0, int ks, int half) { return d0 * 512 + ks * 4096 + half * 2048; }
__device__ __forceinline__ int crow(int r, int hi) { return (r & 3) + 8 * (r >> 2) + 4 * hi; }
__device__ __forceinline__ unsigned cvtpk(float lo, float hi) { unsigned r; asm volatile("v_cvt_pk_bf16_f32 %0, %1, %2" : "=v"(r) : "v"(lo), "v"(hi)); return r; }
__device__ __forceinline__ bf16x8 ldg8(const bf16_t* p) { return *reinterpret_cast<const bf16x8*>(p); }
__device__ __forceinline__ float xhalf(float v, int hi) {
    auto rr = __builtin_amdgcn_permlane32_swap(__float_as_uint(v), __float_as_uint(v), false, false);
    return __uint_as_float(hi ? rr[0] : rr[1]);
}
#define ATT_PK4(P, B_, OUT) do { unsigned a0 = cvtpk(P[B_+0], P[B_+1]), a1 = cvtpk(P[B_+2], P[B_+3]);                      \
        unsigned b0 = cvtpk(P[B_+4], P[B_+5]), b1 = cvtpk(P[B_+6], P[B_+7]);                                             \
        auto r0 = __builtin_amdgcn_permlane32_swap(a0, b0, false, false); auto r1 = __builtin_amdgcn_permlane32_swap(a1, b1, false, false); \
        u32x4 w = {r0[0], r1[0], r0[1], r1[1]}; OUT = *reinterpret_cast<bf16x8*>(&w); } while (0)
__device__ __forceinline__ void pv_tile(f32x16* o, int vb, bf16x8 pa0, bf16x8 pa1, bf16x8 pa2, bf16x8 pa3) {
#define TRRD(dst, off) asm volatile("ds_read_b64_tr_b16 %0, %1 offset:%2" : "=&v"(dst) : "v"(vb), "i"(off) : "memory")
#define PV_D0(d0) do { s16x4 l0, l1, l2, l3, h0, h1, h2, h3; constexpr int b_ = v_rd_off(d0, 0, 0); \
        TRRD(l0, b_); TRRD(h0, b_ + 2048); TRRD(l1, b_ + 4096); TRRD(h1, b_ + 6144); TRRD(l2, b_ + 8192); TRRD(h2, b_ + 10240); TRRD(l3, b_ + 12288); TRRD(h3, b_ + 14336); \
        asm volatile("s_waitcnt lgkmcnt(0)" ::: "memory"); SBAR(); \
        o[d0] = __builtin_amdgcn_mfma_f32_32x32x16_bf16(pa0, (bf16x8){l0[0], l0[1], l0[2], l0[3], h0[0], h0[1], h0[2], h0[3]}, o[d0], 0, 0, 0);   \
        o[d0] = __builtin_amdgcn_mfma_f32_32x32x16_bf16(pa1, (bf16x8){l1[0], l1[1], l1[2], l1[3], h1[0], h1[1], h1[2], h1[3]}, o[d0], 0, 0, 0);   \
        o[d0] = __builtin_amdgcn_mfma_f32_32x32x16_bf16(pa2, (bf16x8){l2[0], l2[1], l2[2], l2[3], h2[0], h2[1], h2[2], h2[3]}, o[d0], 0, 0, 0);   \
        o[d0] = __builtin_amdgcn_mfma_f32_32x32x16_bf16(pa3, (bf16x8){l3[0], l3[1], l3[2], l3[3], h3[0], h3[1], h3[2], h3[3]}, o[d0], 0, 0, 0); } while (0)
    PV_D0(0); PV_D0(1); PV_D0(2); PV_D0(3);
#undef PV_D0
#undef TRRD
}

__device__ __forceinline__ void sb_block(const bf16_t* __restrict__ Qg, const bf16_t* __restrict__ Kg, const bf16_t* __restrict__ Vg, bf16_t* __restrict__ Og, int qb, ldsp lds) {
    int tid_ = threadIdx.x; asm volatile("" : "+v"(tid_));
    const int tid = tid_, wid = __builtin_amdgcn_readfirstlane(tid >> 6), lane = tid & 63, r32 = lane & 31, hi = lane >> 5;
    const int NT = 4 * qb + 4, R0 = 256 * qb + 32 * wid, myrow = R0 + r32;
    const ldsp V_lds = lds + LDS_V; const ldsp K_lds = lds + LDS_K;
    bf16x8 qr[8];
    { const bf16_t* Qw = Qg + (size_t)R0 * QP; const unsigned qoff = (unsigned)(r32 * QP + hi * 8);
#pragma unroll
      for (int d0 = 0; d0 < 8; ++d0) qr[d0] = ldg8(Qw + (qoff + d0 * 16)); }
    const int sr = tid >> 4, sc = (tid & 15) * 8, kws = KSWZ(sr, sc * 2), vst0 = v_st(sr, sc), vst1 = v_st(32 + sr, sc);
    const unsigned kvoff = (unsigned)(sr * QP + sc);
    const int vb0 = (int)(unsigned)(uintptr_t)V_lds + v_rd_base(lane);
    bf16x8 sk0, sk1, sv0, sv1;
#define SB_LOAD(j) do { const bf16_t* kp_ = Kg + (size_t)(64 * (j)) * QP; const bf16_t* vp_ = Vg + (size_t)(64 * (j)) * QP; \
        sk0 = ldg8(kp_ + kvoff); sk1 = ldg8(kp_ + (size_t)32 * QP + kvoff); sv0 = ldg8(vp_ + kvoff); sv1 = ldg8(vp_ + (size_t)32 * QP + kvoff); } while (0)
#define SB_WRITE(bf) do { *(ALAS bf16x8*)(K_lds + (bf) * SHM_K + kws) = sk0; *(ALAS bf16x8*)(K_lds + (bf) * SHM_K + kws + 32 * 256) = sk1; \
        *(ALAS bf16x8*)(V_lds + (bf) * SHM_V + vst0) = sv0; *(ALAS bf16x8*)(V_lds + (bf) * SHM_V + vst1) = sv1; } while (0)
    SB_LOAD(NT - 1); SB_WRITE(0);
    __syncthreads();
    float carry = 0.f; f32x16 o[4] = {};
    ALAS int* fl = (ALAS int*)(lds + LDS_WS); bool wdone = false;
    for (int t = 0; t < NT; ++t) {
        const int j = NT - 1 - t, buf = t & 1, kb = 64 * j;
        if (t + 1 < NT) SB_LOAD(j - 1);
        if (kb <= R0 + 30 && !wdone) {
            f32x16 p0 = {}, p1 = {};
            { const ldsp Kb = K_lds + buf * SHM_K;
#pragma unroll
              for (int d0 = 0; d0 < 8; ++d0) { const ldsp a = Kb + KSWZ(r32, ((d0 & 3) * 16 + hi * 8) * 2) + (d0 >> 2) * 128;
                  const bf16x8 b0 = *(const ALAS bf16x8*)a, b1 = *(const ALAS bf16x8*)(a + 32 * 256);
                  p0 = __builtin_amdgcn_mfma_f32_32x32x16_bf16(b0, qr[d0], p0, 0, 0, 0);
                  p1 = __builtin_amdgcn_mfma_f32_32x32x16_bf16(b1, qr[d0], p1, 0, 0, 0); } }
            f32x16 lb0, lb1;
#pragma unroll
            for (int r = 0; r < 16; ++r) {
                { const float z = p0[r]; const float e = __builtin_amdgcn_exp2f(-__builtin_fabsf(z)); const float sp = __builtin_fmaxf(z, 0.f) + __builtin_amdgcn_logf(1.f + e); p0[r] = -sp; lb0[r] = z - sp; }
                { const float z = p1[r]; const float e = __builtin_amdgcn_exp2f(-__builtin_fabsf(z)); const float sp = __builtin_fmaxf(z, 0.f) + __builtin_amdgcn_logf(1.f + e); p1[r] = -sp; lb1[r] = z - sp; }
            }
            if (kb + 63 >= R0) {
                const int dq = myrow - kb - 4 * hi; const float NEG = -__builtin_inff();
#pragma unroll
                for (int r = 0; r < 16; ++r) { const int c = (r & 3) + 8 * (r >> 2);
                    if (c >= dq) { p0[r] = 0.f; lb0[r] = NEG; }
                    if (c + 32 >= dq) { p1[r] = 0.f; lb1[r] = NEG; } }
            }
            float gs[8], go[8];
#pragma unroll
            for (int g = 0; g < 4; ++g) { gs[g] = (p0[4 * g] + p0[4 * g + 1]) + (p0[4 * g + 2] + p0[4 * g + 3]); gs[4 + g] = (p1[4 * g] + p1[4 * g + 1]) + (p1[4 * g + 2] + p1[4 * g + 3]); }
#pragma unroll
            for (int i = 0; i < 8; ++i) go[i] = xhalf(gs[i], hi);
            float acc = carry;
#pragma unroll
            for (int idx = 7; idx >= 0; --idx) { const int g = idx & 3; const float base = acc + (hi ? 0.f : go[idx]);
                if (idx >= 4) { const float t3 = base, t2 = t3 + p1[4 * g + 3], t1 = t2 + p1[4 * g + 2], t0 = t1 + p1[4 * g + 1];
                    lb1[4 * g + 3] = __builtin_amdgcn_exp2f(lb1[4 * g + 3] + t3); lb1[4 * g + 2] = __builtin_amdgcn_exp2f(lb1[4 * g + 2] + t2);
                    lb1[4 * g + 1] = __builtin_amdgcn_exp2f(lb1[4 * g + 1] + t1); lb1[4 * g] = __builtin_amdgcn_exp2f(lb1[4 * g] + t0); }
                else { const float t3 = base, t2 = t3 + p0[4 * g + 3], t1 = t2 + p0[4 * g + 2], t0 = t1 + p0[4 * g + 1];
                    lb0[4 * g + 3] = __builtin_amdgcn_exp2f(lb0[4 * g + 3] + t3); lb0[4 * g + 2] = __builtin_amdgcn_exp2f(lb0[4 * g + 2] + t2);
                    lb0[4 * g + 1] = __builtin_amdgcn_exp2f(lb0[4 * g + 1] + t1); lb0[4 * g] = __builtin_amdgcn_exp2f(lb0[4 * g] + t0); }
                acc += gs[idx] + go[idx]; }
            carry = acc;
            bf16x8 pa0, pa1, pa2, pa3;
            ATT_PK4(lb0, 0, pa0); ATT_PK4(lb0, 8, pa1); ATT_PK4(lb1, 0, pa2); ATT_PK4(lb1, 8, pa3);
            SBAR();
            pv_tile(o, vb0 + buf * SHM_V, pa0, pa1, pa2, pa3);
            wdone = __all(carry < -127.f);
        }
        if (lane == 0) fl[buf * 8 + wid] = wdone ? 1 : 0;
        if (t + 1 < NT) SB_WRITE(buf ^ 1);
        __syncthreads();
        { const ALAS int* f = fl + buf * 8; if ((f[0] & f[1] & f[2] & f[3] & f[4] & f[5] & f[6] & f[7]) != 0) break; }
    }
#undef SB_LOAD
#undef SB_WRITE
    bf16_t* Ow = Og + (size_t)R0 * OP; const unsigned ooff = (unsigned)(4 * hi * OP + r32);
#pragma unroll
    for (int r = 0; r < 16; ++r) { bf16_t* rowp = Ow + (size_t)((r & 3) + 8 * (r >> 2)) * OP;
#pragma unroll
        for (int d0 = 0; d0 < 4; ++d0) { const float v = o[d0][r]; const float vn = __shfl_xor(v, 1);
            if ((r32 & 1) == 0) *(unsigned*)(rowp + (ooff + d0 * 32)) = cvtpk(v, vn); } }
}

constexpr float ATT_THR = 8.f;
template <bool SECOND>
__device__ __forceinline__ void diff_pass(const bf16_t* __restrict__ Qg, const bf16_t* __restrict__ Kg, const bf16_t* __restrict__ Vg, float* S1, bf16_t* __restrict__ Og,
                                          int qb, float lam, const float* __restrict__ gsub, float gmul, ldsp lds) {
    int tid_ = threadIdx.x; asm volatile("" : "+v"(tid_));
    const int tid = tid_, wid = __builtin_amdgcn_readfirstlane(tid >> 6), lane = tid & 63, r32 = lane & 31, hi = lane >> 5;
    const int NT = 4 * qb + 4, R0 = 256 * qb + 32 * wid, myrow = R0 + r32;
    const ldsp V_lds = lds + LDS_V; const ldsp K_lds = lds + LDS_K;
    ALAS float* wsf = (ALAS float*)(lds + LDS_WS) + wid * 64; ALAS float* li_l = wsf; ALAS float* al_l = wsf + 32;
    bf16x8 qr[4];
    { const bf16_t* Qw = Qg + (size_t)R0 * QP; const unsigned qoff = (unsigned)(r32 * QP + hi * 8);
#pragma unroll
      for (int d0 = 0; d0 < 4; ++d0) qr[d0] = ldg8(Qw + (qoff + d0 * 16)); }
    const int sr = tid >> 4, sc = (tid & 15) * 8, vst0 = v_st(sr, sc), vst1 = v_st(32 + sr, sc);
    const int kr = tid >> 3, kc = (tid & 7) * 8, kws = KSWZ64(kr, kc * 2);
    const unsigned voff = (unsigned)(sr * QP + sc), koff = (unsigned)(kr * QP + kc);
    const int vb0 = (int)(unsigned)(uintptr_t)V_lds + v_rd_base(lane);
    bf16x8 sk0, sv0, sv1;
#define DF_LOAD(j) do { const bf16_t* vp_ = Vg + (size_t)(64 * (j)) * QP; sk0 = ldg8(Kg + (size_t)(64 * (j)) * QP + koff); sv0 = ldg8(vp_ + voff); sv1 = ldg8(vp_ + (size_t)32 * QP + voff); } while (0)
#define DF_WRITE(bf) do { *(ALAS bf16x8*)(K_lds + (bf) * SHM_K + kws) = sk0; *(ALAS bf16x8*)(V_lds + (bf) * SHM_V + vst0) = sv0; *(ALAS bf16x8*)(V_lds + (bf) * SHM_V + vst1) = sv1; } while (0)
    DF_LOAD(0); DF_WRITE(0);
    __syncthreads();
    float m_reg = -1e30f, l_reg = 0.f; f32x16 o[4] = {};
    for (int t = 0; t < NT; ++t) {
        const int buf = t & 1, kb = 64 * t;
        if (t + 1 < NT) DF_LOAD(t + 1);
        if (kb <= R0 + 31) {
            f32x16 p0 = {}, p1 = {};
            { const ldsp Kb = K_lds + buf * SHM_K;
#pragma unroll
              for (int d0 = 0; d0 < 4; ++d0) { const ldsp a = Kb + KSWZ64(r32, (d0 * 16 + hi * 8) * 2);
                  const bf16x8 b0 = *(const ALAS bf16x8*)a, b1 = *(const ALAS bf16x8*)(a + 32 * 128);
                  p0 = __builtin_amdgcn_mfma_f32_32x32x16_bf16(b0, qr[d0], p0, 0, 0, 0);
                  p1 = __builtin_amdgcn_mfma_f32_32x32x16_bf16(b1, qr[d0], p1, 0, 0, 0); } }
            if (kb + 63 > R0) {
                const int dq = myrow - kb - 4 * hi; const float NEG = -__builtin_inff();
#pragma unroll
                for (int r = 0; r < 16; ++r) { const int c = (r & 3) + 8 * (r >> 2);
                    if (c > dq) p0[r] = NEG;
                    if (c + 32 > dq) p1[r] = NEG; }
            }
            float pmax = p0[0];
#pragma unroll
            for (int r = 1; r < 16; ++r) pmax = __builtin_fmaxf(pmax, p0[r]);
#pragma unroll
            for (int r = 0; r < 16; ++r) pmax = __builtin_fmaxf(pmax, p1[r]);
            pmax = __builtin_fmaxf(pmax, xhalf(pmax, hi));
            float alpha = 1.f, mn = m_reg;
            if (!__all(pmax - m_reg <= ATT_THR)) { mn = __builtin_fmaxf(m_reg, pmax); alpha = __builtin_amdgcn_exp2f(m_reg - mn); m_reg = mn; }
            float ps = 0.f;
#pragma unroll
            for (int r = 0; r < 16; ++r) { p0[r] = __builtin_amdgcn_exp2f(p0[r] - mn); p1[r] = __builtin_amdgcn_exp2f(p1[r] - mn); ps += p0[r] + p1[r]; }
            ps += xhalf(ps, hi);
            l_reg = l_reg * alpha + ps;
            if (__any(alpha < 1.f)) { if (hi == 0) al_l[r32] = alpha; asm volatile("s_waitcnt lgkmcnt(0)" ::: "memory");
#pragma unroll
                for (int d_ = 0; d_ < 4; ++d_)
#pragma unroll
                    for (int r = 0; r < 16; ++r) o[d_][r] *= al_l[crow(r, hi)]; }
            bf16x8 pa0, pa1, pa2, pa3;
            ATT_PK4(p0, 0, pa0); ATT_PK4(p0, 8, pa1); ATT_PK4(p1, 0, pa2); ATT_PK4(p1, 8, pa3);
            SBAR();
            pv_tile(o, vb0 + buf * SHM_V, pa0, pa1, pa2, pa3);
        }
        if (t + 1 < NT) DF_WRITE(buf ^ 1);
        __syncthreads();
    }
#undef DF_LOAD
#undef DF_WRITE
    if (hi == 0) li_l[r32] = l_reg; asm volatile("s_waitcnt lgkmcnt(0)" ::: "memory");
    float rli[16];
#pragma unroll
    for (int r = 0; r < 16; ++r) rli[r] = __builtin_amdgcn_rcpf(li_l[crow(r, hi)]);
    if constexpr (!SECOND) {
        float* Sw = S1 + (size_t)R0 * OP; const unsigned ooff = (unsigned)(4 * hi * OP + r32);
#pragma unroll
        for (int r = 0; r < 16; ++r) { float* rowp = Sw + (size_t)((r & 3) + 8 * (r >> 2)) * OP;
#pragma unroll
            for (int d0 = 0; d0 < 4; ++d0) rowp[ooff + d0 * 32] = o[d0][r] * rli[r]; }
    } else {
        const float* Sw = S1 + (size_t)R0 * OP; bf16_t* Ow = Og + (size_t)R0 * OP; const unsigned ooff = (unsigned)(4 * hi * OP + r32);
        float gn[4];
#pragma unroll
        for (int d0 = 0; d0 < 4; ++d0) gn[d0] = gsub[d0 * 32 + r32] * gmul;
#pragma unroll
        for (int r = 0; r < 16; ++r) { const float* srow = Sw + (size_t)((r & 3) + 8 * (r >> 2)) * OP; bf16_t* orowp = Ow + (size_t)((r & 3) + 8 * (r >> 2)) * OP; float d[4]; float ss = 0.f;
#pragma unroll
            for (int d0 = 0; d0 < 4; ++d0) { d[d0] = srow[ooff + d0 * 32] - lam * (o[d0][r] * rli[r]); ss += d[d0] * d[d0]; }
            ss += __shfl_xor(ss, 1); ss += __shfl_xor(ss, 2); ss += __shfl_xor(ss, 4); ss += __shfl_xor(ss, 8); ss += __shfl_xor(ss, 16);
            const float rs = __builtin_amdgcn_rsqf(ss * (1.f / 128.f) + 1e-5f);
#pragma unroll
            for (int d0 = 0; d0 < 4; ++d0) { const float v = d[d0] * rs * gn[d0]; const float vn = __shfl_xor(v, 1);
                if ((r32 & 1) == 0) *(unsigned*)(orowp + (ooff + d0 * 32)) = cvtpk(v, vn); }
            if ((r & 1) == 1) asm volatile("" ::: "memory"); }
    }
    __syncthreads();
}
#undef SBAR
}

#define LAS __attribute__((address_space(3)))

#define XB_TMO      128
#define XB_XCNT(j)  (256  + 64 * (j))
#define XB_XSUB(j)  (1280 + 64 * (j))
#define XB_XGEN(j)  (2304 + 64 * (j))
#define XB_TOP      3328
#define XB_TOPGEN   3392
#define XCD_BAR_WORDS 3456
#define XB_SPIN_CAP (1u << 18)

__device__ __forceinline__ unsigned xb_ld(unsigned* p)              { return __hip_atomic_load(p, __ATOMIC_RELAXED, __HIP_MEMORY_SCOPE_AGENT); }
__device__ __forceinline__ unsigned xb_add(unsigned* p, unsigned v) { return __hip_atomic_fetch_add(p, v, __ATOMIC_RELAXED, __HIP_MEMORY_SCOPE_AGENT); }
__device__ __forceinline__ unsigned xb_xcc_id() { return (unsigned)__builtin_amdgcn_s_getreg((3 << 11) | 20) & 0xFu; }
#define XB_SPIN(cond, bar) do { unsigned _sp = 0; while (cond) { __builtin_amdgcn_s_sleep(1); \
    if ((++_sp & 255u) == 0u) { if (xb_ld(&(bar)[XB_TMO])) break; if (_sp > XB_SPIN_CAP) { atomicAdd(&(bar)[XB_TMO], 1u); break; } } } } while (0)

struct XcdBarrier {
    unsigned* bar; unsigned x;
    volatile LAS unsigned* st;
};

__device__ __forceinline__ XcdBarrier xcd_barrier_post(unsigned* bar, volatile LAS unsigned* st) {
    XcdBarrier b; b.bar = bar; b.x = xb_xcc_id(); b.st = st;
    if (threadIdx.x == 0) (void)xb_add(&bar[XB_XCNT(b.x)], 1u);
    return b;
}
__device__ __forceinline__ void xcd_barrier_complete(unsigned* bar, unsigned x, unsigned& nloc, unsigned& nx) {
    const unsigned G = gridDim.x * gridDim.y * gridDim.z;
    unsigned sum, cnt, mine, sp = 0u;
    for (;;) {
        sum = 0u; cnt = 0u; mine = 0u;
#pragma unroll
        for (unsigned j = 0; j < 16; ++j) { const unsigned c = xb_ld(&bar[XB_XCNT(j)]); sum += c; cnt += (c > 0u) ? 1u : 0u; mine = (j == x) ? c : mine; }
        if (sum == G) break;
        __builtin_amdgcn_s_sleep(1);
        if ((++sp & 255u) == 0u) { if (xb_ld(&bar[XB_TMO])) break; if (sp > XB_SPIN_CAP) { atomicAdd(&bar[XB_TMO], 1u); break; } }
    }
    nloc = mine > 0u ? mine : 1u; nx = cnt > 0u ? cnt : 1u;
}

__device__ __forceinline__ void xcd_barrier(const XcdBarrier& b) {
    asm volatile("s_waitcnt vmcnt(0)" ::: "memory");
    __syncthreads();
    if (threadIdx.x == 0) {
        unsigned* bar = b.bar;
        __builtin_amdgcn_s_waitcnt(0);
        unsigned nloc = b.st[0], nx = b.st[1];
        if (nloc == 0u) { xcd_barrier_complete(bar, b.x, nloc, nx); b.st[0] = nloc; b.st[1] = nx; }
        const unsigned old = xb_add(&bar[XB_XSUB(b.x)], 1u);
        const unsigned gen = old / nloc;
        if (old + 1u == (gen + 1u) * nloc) {
            __builtin_amdgcn_fence(__ATOMIC_RELEASE, "agent");
            asm volatile("s_waitcnt vmcnt(0)" ::: "memory");
            const unsigned og = xb_add(&bar[XB_TOP], 1u);
            const unsigned tg = og / nx;
            if (og + 1u == (tg + 1u) * nx) xb_add(&bar[XB_TOPGEN], 1u);
            else XB_SPIN(xb_ld(&bar[XB_TOPGEN]) == tg, bar);
            __builtin_amdgcn_fence(__ATOMIC_ACQUIRE, "agent");
            xb_add(&bar[XB_XGEN(b.x)], 1u);
            asm volatile("s_waitcnt vmcnt(0)" ::: "memory");
        } else {
            XB_SPIN(xb_ld(&bar[XB_XGEN(b.x)]) == gen, bar);
            __builtin_amdgcn_fence(__ATOMIC_ACQUIRE, "agent");
            asm volatile("s_waitcnt vmcnt(0)" ::: "memory");
        }
    }
    __syncthreads();
}

constexpr int NWAVES = 8;
constexpr int NTOK = 16384, DM = 2048, SEQ = 2048, NHEAD = 16, NLAYER = 4, NEXP = 16, DEXP = 1024;
constexpr int XS_ROWS = 36864;
constexpr float LN_EPS = 1e-5f;
constexpr float DN_ALPHA = 1.6817928305074292f;
constexpr float LOG2E = 1.4426950408889634f;
constexpr float SB_QSCALE = 0.08838834764831845f * LOG2E;
constexpr float DF_QSCALE = 0.125f * LOG2E;
#ifndef MK_MULTI
#define MK_MULTI 0
#endif
constexpr int NSTEPS = 1 + 8 * NLAYER;

constexpr size_t MiB = 1u << 20;
constexpr size_t WS_CTL = 0, CTL_ZERO_BYTES = 64 * 1024;
constexpr size_t WS_COS = 1 * MiB, WS_SIN = WS_COS + 256 * 1024;
constexpr size_t WS_WR = 2 * MiB;
constexpr size_t WS_CNT = 3 * MiB;
constexpr size_t WS_RE = WS_CNT + 64 * 1024;
constexpr size_t WS_RW = WS_RE + 64 * 1024;
constexpr size_t WS_RP = WS_RW + 128 * 1024;
constexpr size_t WS_WQKVA = 4 * MiB;
constexpr size_t WS_WOA = WS_WQKVA + 48 * MiB;
constexpr size_t WS_WQKVB = WS_WOA + 16 * MiB;
constexpr size_t WS_WOB = WS_WQKVB + 32 * MiB;
constexpr size_t WS_WGU = WS_WOB + 16 * MiB;
constexpr size_t WS_WDN = WS_WGU + 512 * MiB;
constexpr size_t WS_H = WS_WDN + 256 * MiB;
constexpr size_t WS_HB = WS_H + 128 * MiB;
constexpr size_t WS_QKV = WS_HB + 64 * MiB;
constexpr size_t WS_OB = WS_QKV + 192 * MiB;
constexpr size_t WS_XS = WS_OB + 64 * MiB;
constexpr size_t WS_ACT = WS_XS + 144 * MiB;
constexpr size_t WS_YD = WS_ACT + 72 * MiB;
constexpr size_t WS_END = WS_YD + 144 * MiB;
static_assert(WS_END <= (size_t)2040 * MiB, "workspace map");
constexpr int CW_BAR = 1024;
constexpr int LDS_BYTES = 147456;
constexpr int LDSCTL_OFF = 145408;
constexpr int RING_OFF = 0;

#define GAS __attribute__((address_space(1)))
typedef unsigned short bf16;
typedef unsigned v4u __attribute__((ext_vector_type(4)));
typedef unsigned v2u __attribute__((ext_vector_type(2)));
typedef float f32x4 __attribute__((ext_vector_type(4)));
typedef float f32x2 __attribute__((ext_vector_type(2)));
#define LDS_WAIT() asm volatile("s_waitcnt lgkmcnt(0)" ::: "memory")
#define VM_WAIT() asm volatile("s_waitcnt vmcnt(0)" ::: "memory")
__device__ __forceinline__ unsigned pk2(float lo, float hi) { unsigned r; asm volatile("v_cvt_pk_bf16_f32 %0, %1, %2" : "=v"(r) : "v"(lo), "v"(hi)); return r; }
__device__ __forceinline__ int opq_tid() { int t = threadIdx.x; asm volatile("" : "+v"(t)); return t; }
__device__ __forceinline__ float dpp_sum(float v) {
    v += __builtin_bit_cast(float, __builtin_amdgcn_update_dpp(0, __builtin_bit_cast(int, v), 0xB1, 0xf, 0xf, true));
    v += __builtin_bit_cast(float, __builtin_amdgcn_update_dpp(0, __builtin_bit_cast(int, v), 0x4E, 0xf, 0xf, true));
    v += __builtin_bit_cast(float, __builtin_amdgcn_update_dpp(0, __builtin_bit_cast(int, v), 0x141, 0xf, 0xf, true));
    v += __builtin_bit_cast(float, __builtin_amdgcn_update_dpp(0, __builtin_bit_cast(int, v), 0x140, 0xf, 0xf, true));
    const int b = __builtin_bit_cast(int, v);
    const float s0 = __builtin_bit_cast(float, __builtin_amdgcn_readlane(b, 0)), s1 = __builtin_bit_cast(float, __builtin_amdgcn_readlane(b, 16));
    const float s2 = __builtin_bit_cast(float, __builtin_amdgcn_readlane(b, 32)), s3 = __builtin_bit_cast(float, __builtin_amdgcn_readlane(b, 48));
    return (s0 + s1) + (s2 + s3);
}
__device__ __forceinline__ float wave_sum(float v) {
#pragma unroll
    for (int o = 1; o < 64; o <<= 1) v += __shfl_xor(v, o);
    return v;
}

struct Args { const float* in[17]; float* out; unsigned char* ws; int s_lo, s_hi; };

__device__ __forceinline__ int map_row(int n, int mode) {
    if (mode == 0) return n;
    if (mode == 1) { const int c = n & 255, blk = c >> 6, d = c & 63; return (n & ~255) + ((d >> 5) << 7) + (blk << 5) + (d & 31); }
    return ((n >> 7) << 8) + (n & 127) + (mode == 3 ? 128 : 0);
}
__device__ __forceinline__ void cvt_item(const float* __restrict__ src, int pitch, int K, bf16* __restrict__ dst, int mode, int k0, int n0, LAS float* scr, int lane) {
    const int kr = lane >> 4, n4 = (lane & 15) * 4;
    f32x4 v[16];
#pragma unroll
    for (int i = 0; i < 16; ++i) v[i] = __builtin_nontemporal_load((const f32x4*)(src + (size_t)(k0 + 4 * i + kr) * pitch + n0 + n4));
#pragma unroll
    for (int i = 0; i < 16; ++i) { LAS float* s = scr + (4 * i + kr) * 65 + n4; s[0] = v[i][0]; s[1] = v[i][1]; s[2] = v[i][2]; s[3] = v[i][3]; }
    LDS_WAIT();
    const int c = lane & 7;
#pragma unroll
    for (int j = 0; j < 8; ++j) { const int nl = (lane >> 3) + 8 * j; const int row = map_row(n0 + nl, mode);
        const LAS float* s = scr + (8 * c) * 65 + nl;
        v4u o; o.x = pk2(s[0], s[65]); o.y = pk2(s[130], s[195]); o.z = pk2(s[260], s[325]); o.w = pk2(s[390], s[455]);
        *(v4u*)(dst + (size_t)row * K + k0 + 8 * c) = o; }
    LDS_WAIT();
}

__global__ void __launch_bounds__(NWAVES * 64, 2) yoco_fwd(Args args) {
    extern __shared__ __attribute__((aligned(16))) unsigned char lds_raw[];
    LAS unsigned char* const lds = (LAS unsigned char*)lds_raw;
    const int tid = threadIdx.x, lane = tid & 63, wave = __builtin_amdgcn_readfirstlane(tid >> 6);
    const int G = gridDim.x, bx = blockIdx.x;
    const int vcu = (G % 8 == 0) ? (bx % 8) * (G / 8) + bx / 8 : bx;
    unsigned char* const ws = args.ws;
    volatile LAS unsigned* const CTL = (volatile LAS unsigned*)(lds + LDSCTL_OFF);
    LAS int* const TAB = (LAS int*)(lds + LDSCTL_OFF + 64);
    for (int u = tid; u < (LDS_BYTES - LDSCTL_OFF) / 4; u += NWAVES * 64) ((LAS unsigned*)(lds + LDSCTL_OFF))[u] = 0u;
    __syncthreads();
    const int s_lo = args.s_lo, s_hi = args.s_hi;
    XcdBarrier bar; bar.bar = (unsigned*)(ws + WS_CTL) + CW_BAR; bar.x = 0; bar.st = nullptr;
    if (s_hi - s_lo > 1) bar = xcd_barrier_post((unsigned*)(ws + WS_CTL) + CW_BAR, CTL);
#ifndef PH_MASK
#define PH_MASK 0xFFFF
#endif
#define PHM(b) (((PH_MASK) >> (b)) & 1)
#ifndef PROBE_DUP
#define PROBE_DUP 0
#endif
#define PREP(b) _Pragma("unroll 1") for (int rep_ = 0; rep_ < ((((PROBE_DUP) >> (b)) & 1) ? 2 : 1); ++rep_)
#define IN(k) (s_lo <= (k) && (k) < s_hi)
#define SEAM(k) do { if ((k) + 1 < s_hi) xcd_barrier(bar); } while (0)

    const float* const x_in = args.in[0];
    float* const H = (float*)(ws + WS_H); bf16* const HB = (bf16*)(ws + WS_HB); bf16* const QKV = (bf16*)(ws + WS_QKV); bf16* const OB = (bf16*)(ws + WS_OB);
    bf16* const XS = (bf16*)(ws + WS_XS); float* const S1 = (float*)(ws + WS_XS); bf16* const ACT = (bf16*)(ws + WS_ACT); bf16* const YD = (bf16*)(ws + WS_YD);
    float* const COS = (float*)(ws + WS_COS); float* const SIN = (float*)(ws + WS_SIN); float* const WR = (float*)(ws + WS_WR);
    int* const CNT = (int*)(ws + WS_CNT); unsigned* const RE = (unsigned*)(ws + WS_RE); f32x2* const RW = (f32x2*)(ws + WS_RW); int* const RP = (int*)(ws + WS_RP);

    if (IN(0) && PHM(0)) { PREP(0) {
        const int tid = opq_tid(), lane = tid & 63;
        LAS float* scr = (LAS float*)(lds + RING_OFF + wave * 16640);
        const int gw = vcu * NWAVES + wave, NGW = G * NWAVES;
        constexpr int I0 = 2 * 3072, I1 = 8 * 1024, I2 = 128 * 512, I3 = 64 * 512, NITEMS = I0 + I1 + I2 + I3;
        for (int it = gw; it < NITEMS; it += NGW) {
            int r = it;
            if (r < I0) { const int job = r / 3072; r -= job * 3072; const int kb = r / 96, nb = r - kb * 96;
                cvt_item(args.in[1] + (size_t)job * 2048 * 6144, 6144, 2048, (bf16*)(ws + WS_WQKVA) + (size_t)job * 6144 * 2048, 0, kb * 64, nb * 64, scr, lane); continue; }
            r -= I0;
            if (r < I1) { const int job = r >> 10; r &= 1023; const int kb = r >> 5, nb = r & 31;
                const float* src; int pitch = 2048, mode = 0; bf16* dst;
                if (job < 2) { src = args.in[2] + (size_t)job * 2048 * 2048; dst = (bf16*)(ws + WS_WOA) + (size_t)job * 2048 * 2048; }
                else if (job == 2) { src = args.in[4]; dst = (bf16*)(ws + WS_WQKVB); mode = 1; }
                else if (job == 3) { src = args.in[3]; pitch = 4096; dst = (bf16*)(ws + WS_WQKVB) + (size_t)2048 * 2048; mode = 1; }
                else if (job == 4) { src = args.in[3] + 2048; pitch = 4096; dst = (bf16*)(ws + WS_WQKVB) + (size_t)4096 * 2048; }
                else if (job == 5) { src = args.in[4] + (size_t)2048 * 2048; dst = (bf16*)(ws + WS_WQKVB) + (size_t)6144 * 2048; mode = 1; }
                else { src = args.in[5] + (size_t)(job - 6) * 2048 * 2048; dst = (bf16*)(ws + WS_WOB) + (size_t)(job - 6) * 2048 * 2048; }
                cvt_item(src, pitch, 2048, dst, mode, kb * 64, nb * 64, scr, lane); continue; }
            r -= I1;
            if (r < I2) { const int job = r >> 9; r &= 511; const int kb = r >> 4, nb = r & 15; const int le = job >> 1, up = job & 1;
                cvt_item((up ? args.in[15] : args.in[14]) + (size_t)le * 2048 * 1024, 1024, 2048, (bf16*)(ws + WS_WGU) + (size_t)le * 2048 * 2048, 2 + up, kb * 64, nb * 64, scr, lane); continue; }
            r -= I2;
            { const int le = r >> 9; r &= 511; const int kb = r >> 5, nb = r & 31;
                cvt_item(args.in[16] + (size_t)le * 1024 * 2048, 2048, 1024, (bf16*)(ws + WS_WDN) + (size_t)le * 2048 * 1024, 0, kb * 64, nb * 64, scr, lane); }
        }
        for (size_t i = (size_t)gw * 64 + lane; i < (size_t)NTOK * DM / 4; i += (size_t)NGW * 64) {
            const f32x4 v = __builtin_nontemporal_load((const f32x4*)x_in + i); ((f32x4*)H)[i] = v;
            v2u o; o.x = pk2(v[0], v[1]); o.y = pk2(v[2], v[3]); ((v2u*)HB)[i] = o; }
        for (int i = bx * (NWAVES * 64) + tid; i < 2048 * 32; i += G * NWAVES * 64) { const int pos = i >> 5, f = i & 31;
            const float inv = __builtin_amdgcn_exp2f(-(float)f * 0.4152410118609203f); const float ang = (float)pos * inv;
            const double tr = (double)ang * 0.15915494309189535; const float fr = (float)(tr - __builtin_rint(tr));
            COS[i] = __builtin_amdgcn_cosf(fr); SIN[i] = __builtin_amdgcn_sinf(fr); }
        for (int i = bx * (NWAVES * 64) + tid; i < NLAYER * 20 * 2048; i += G * NWAVES * 64) { const int k = i & 2047, c = (i >> 11) % 20, l = i / (20 * 2048);
            WR[i] = c < 4 ? args.in[12][((size_t)l * 2048 + k) * 4 + c] : args.in[13][(((size_t)l * 4 + ((c - 4) >> 2)) * 2048 + k) * 4 + ((c - 4) & 3)]; }
        }
        SEAM(0);
    }

    for (int L = 0; L < NLAYER; ++L) {
        const int sb = 1 + 8 * L; const bool typeA = L < 2;
        if (IN(sb + 0)) {
            if (typeA && PHM(1)) { PREP(1) {
                pg8::Gemm g{HB, (const bf16*)(ws + WS_WQKVA) + (size_t)L * 6144 * 2048, NTOK, 6144, DM}; pg8::StaticOrder S; S.init(NTOK, 6144, G, bx);
                pg8::EpiQkv E{QKV, 6144, 2048, SB_QSCALE};
                pg8::gemm_phase<pg8::EpiQkv, pg8::StaticOrder, true, true>(lds + RING_OFF, g, S, E); }
            } else if (!typeA && PHM(2)) { PREP(2) {
                const int N = (L == 2) ? 6144 : 2048;
                pg8::Gemm g{HB, (const bf16*)(ws + WS_WQKVB) + (L == 2 ? (size_t)0 : (size_t)6144 * 2048), NTOK, N, DM}; pg8::StaticOrder S; S.init(NTOK, N, G, bx);
                pg8::EpiRope E{QKV, 6144, 2048, 4096, DF_QSCALE, COS, SIN};
                pg8::gemm_phase<pg8::EpiRope, pg8::StaticOrder, true, true>(lds + RING_OFF, g, S, E); }
            }
            SEAM(sb + 0);
        }
        if (IN(sb + 1)) {
            if (typeA && PHM(3)) {
                for (int id_ = vcu; id_ < 512 * (1 + ((PROBE_DUP >> 3) & 1)); id_ += G) { const int id = id_ & 511; const int bh = id >> 2, p = id & 3, b = bh >> 4, h = bh & 15;
                    const bf16* Qg = QKV + (size_t)b * SEQ * 6144 + h * 128; bf16* Og = OB + (size_t)b * SEQ * DM + h * 128;
                    att::sb_block(Qg, Qg + 2048, Qg + 4096, Og, 7 - p, (att::ldsp)(lds + RING_OFF));
                    att::sb_block(Qg, Qg + 2048, Qg + 4096, Og, p, (att::ldsp)(lds + RING_OFF)); }
            } else if (!typeA && PHM(4)) {
                const int lane = opq_tid() & 63;
                const int i = L - 2; const float lam_init = (L == 2) ? 0.47071301834264183f : 0.5560582041556061f;
                const float* lp = args.in[6] + (size_t)i * 256;
                const float sa = wave_sum(lp[lane] * lp[64 + lane]), sb2 = wave_sum(lp[128 + lane] * lp[192 + lane]);
                const float lam = __builtin_amdgcn_exp2f(sa * LOG2E) - __builtin_amdgcn_exp2f(sb2 * LOG2E) + lam_init;
                const float* gsub = args.in[7] + (size_t)i * 128; const float gmul = 1.f - lam_init;
                for (int id_ = vcu; id_ < 512 * (1 + ((PROBE_DUP >> 4) & 1)); id_ += G) { const int id = id_ & 511; const int bh = id >> 2, p = id & 3, b = bh >> 4, h = bh & 15;
                    const bf16* Qg = QKV + (size_t)b * SEQ * 6144 + h * 128; bf16* Og = OB + (size_t)b * SEQ * DM + h * 128; float* Sg = S1 + (size_t)b * SEQ * DM + h * 128;
#pragma unroll 1
                    for (int w = 0; w < 2; ++w) { const int qb = w ? p : 7 - p;
                        att::diff_pass<false>(Qg, Qg + 2048, Qg + 4096, Sg, Og, qb, lam, gsub, gmul, (att::ldsp)(lds + RING_OFF));
                        att::diff_pass<true>(Qg + 64, Qg + 2048 + 64, Qg + 4096, Sg, Og, qb, lam, gsub, gmul, (att::ldsp)(lds + RING_OFF)); } }
            }
            SEAM(sb + 1);
        }
        if (IN(sb + 2)) { if (PHM(5)) {
            pg8::Gemm g{OB, (const bf16*)(ws + (typeA ? WS_WOA : WS_WOB)) + (size_t)(L & 1) * 2048 * 2048, NTOK, DM, DM}; pg8::StaticOrder S; S.init(NTOK, DM, G, bx);
            if ((PROBE_DUP >> 5) & 1) { pg8::EpiResid E2{S1, DM, DN_ALPHA}; pg8::gemm_phase<pg8::EpiResid, pg8::StaticOrder, true, true>(lds + RING_OFF, g, S, E2); }
            pg8::EpiResid E{H, DM, DN_ALPHA};
            pg8::gemm_phase<pg8::EpiResid, pg8::StaticOrder, true, true>(lds + RING_OFF, g, S, E); }
            SEAM(sb + 2);
        }
        if (IN(sb + 3)) { if (PHM(6)) {
            const int tid = opq_tid(), lane = tid & 63;
            const float* lng = args.in[8] + (size_t)L * DM; const float* lnb = args.in[9] + (size_t)L * DM; const float* wr = WR + (size_t)L * 20 * 2048;
            LAS int* eid = (LAS int*)(lds + RING_OFF);
            LAS float* lgt = (LAS float*)(lds + RING_OFF + 2048);
            for (int c = bx; c < 256; c += G) {
#pragma unroll 1
                for (int grp = 0; grp < 2; ++grp) {
                    const int rloc = wave * 8 + grp * 4; const size_t row0 = (size_t)64 * c + rloc;
                    f32x4 v[4][8]; float mu[4], rstd[4];
#pragma unroll
                    for (int rr = 0; rr < 4; ++rr) { const f32x4* hp = (const f32x4*)(H + (row0 + rr) * DM) + lane;
#pragma unroll
                        for (int j = 0; j < 8; ++j) v[rr][j] = hp[64 * j]; }
#pragma unroll
                    for (int rr = 0; rr < 4; ++rr) { float s = 0.f;
#pragma unroll
                        for (int j = 0; j < 8; ++j) s += (v[rr][j][0] + v[rr][j][1]) + (v[rr][j][2] + v[rr][j][3]);
                        mu[rr] = dpp_sum(s) * (1.f / DM); float q = 0.f;
#pragma unroll
                        for (int j = 0; j < 8; ++j) { const f32x4 d = v[rr][j] - mu[rr]; q += (d[0] * d[0] + d[1] * d[1]) + (d[2] * d[2] + d[3] * d[3]); }
                        rstd[rr] = 1.f / sqrtf(dpp_sum(q) * (1.f / DM) + LN_EPS); }
#pragma unroll
                    for (int j = 0; j < 8; ++j) { const f32x4 gg = ((const f32x4*)lng)[64 * j + lane], bb = ((const f32x4*)lnb)[64 * j + lane];
#pragma unroll
                        for (int rr = 0; rr < 4; ++rr) { v[rr][j] = (v[rr][j] - mu[rr]) * rstd[rr] * gg + bb; ((f32x4*)(H + (row0 + rr) * DM))[64 * j + lane] = v[rr][j]; } }
#pragma unroll 1
                    for (int cc = 0; cc < 20; ++cc) { const f32x4* wp = (const f32x4*)(wr + cc * 2048) + lane; float a[4] = {0.f, 0.f, 0.f, 0.f};
#pragma unroll
                        for (int j = 0; j < 8; ++j) { const f32x4 w = wp[64 * j];
#pragma unroll
                            for (int rr = 0; rr < 4; ++rr) a[rr] += (v[rr][j][0] * w[0] + v[rr][j][1] * w[1]) + (v[rr][j][2] * w[2] + v[rr][j][3] * w[3]); }
#pragma unroll
                        for (int rr = 0; rr < 4; ++rr) a[rr] = dpp_sum(a[rr]);
                        if (lane == 0) { lgt[rloc * 20 + cc] = a[0]; lgt[(rloc + 1) * 20 + cc] = a[1]; lgt[(rloc + 2) * 20 + cc] = a[2]; lgt[(rloc + 3) * 20 + cc] = a[3]; } }
                }
                LDS_WAIT();
                if (lane < 8) {
                    const int rl = wave * 8 + lane; const LAS float* lg = lgt + rl * 20;
                    int gsel = 0; float gm = lg[0];
#pragma unroll
                    for (int i = 1; i < 4; ++i) { const float x = lg[i]; if (x > gm) { gm = x; gsel = i; } }
                    float gden = 0.f;
#pragma unroll
                    for (int i = 0; i < 4; ++i) gden += __builtin_amdgcn_exp2f((lg[i] - gm) * LOG2E);
                    const float gw_ = 1.f / gden;
                    const LAS float* li = lg + 4 + 4 * gsel;
                    const float l0 = li[0], l1 = li[1], l2 = li[2], l3 = li[3];
                    int i0 = 0; float v0 = l0;
                    if (l1 > v0) { v0 = l1; i0 = 1; } if (l2 > v0) { v0 = l2; i0 = 2; } if (l3 > v0) { v0 = l3; i0 = 3; }
                    int i1 = -1; float v1 = 0.f;
                    if (i0 != 0) { v1 = l0; i1 = 0; }
                    if (i0 != 1 && (i1 < 0 || l1 > v1)) { v1 = l1; i1 = 1; }
                    if (i0 != 2 && (i1 < 0 || l2 > v1)) { v1 = l2; i1 = 2; }
                    if (i0 != 3 && (i1 < 0 || l3 > v1)) { v1 = l3; i1 = 3; }
                    const float t = __builtin_amdgcn_exp2f((v1 - v0) * LOG2E); const float w0 = gw_ / (1.f + t), w1 = gw_ * t / (1.f + t);
                    eid[2 * rl] = gsel * 4 + i0; eid[2 * rl + 1] = gsel * 4 + i1; RW[(size_t)64 * c + rl] = (f32x2){w0, w1};
                }
                __syncthreads();
                if (wave == 0) {
                    const int ea = eid[lane], eb = eid[64 + lane]; int ra = 0, rb = 0, cnt = 0; const unsigned long long lt = (1ull << lane) - 1ull;
#pragma unroll
                    for (int e = 0; e < 16; ++e) { const unsigned long long ma = __ballot(ea == e), mb = __ballot(eb == e);
                        if (ea == e) ra = __popcll(ma & lt); if (eb == e) rb = __popcll(ma) + __popcll(mb & lt); if (lane == e) cnt = __popcll(ma) + __popcll(mb); }
                    if (lane < 16) CNT[c * 16 + lane] = cnt;
                    LAS int* rk = (LAS int*)(lds + RING_OFF + 1024); rk[lane] = ra; rk[64 + lane] = rb; LDS_WAIT();
                    const int r = lane; const unsigned word = (unsigned)eid[2 * r] | ((unsigned)eid[2 * r + 1] << 8) | ((unsigned)rk[2 * r] << 16) | ((unsigned)rk[2 * r + 1] << 24);
                    RE[(size_t)64 * c + r] = word;
                }
                __syncthreads();
            } }
            SEAM(sb + 3);
        }
        if ((IN(sb + 4) || IN(sb + 5) || IN(sb + 6)) && PHM(7)) {
            const int tid = opq_tid();
            LAS int* part = (LAS int*)(lds + RING_OFF);
            { const int e = tid & 15, s = tid >> 4; int a = 0;
#pragma unroll
              for (int i = 0; i < 8; ++i) a += CNT[(8 * s + i) * 16 + e];
              part[s * 16 + e] = a; }
            __syncthreads();
            if (tid < 16) { int run = 0; for (int s = 0; s < 32; ++s) run += part[s * 16 + tid]; TAB[tid] = run; }
            __syncthreads();
            if (tid == 0) { int off = 0, mt = 0; for (int e = 0; e < 16; ++e) { TAB[16 + e] = off; const int nt = (TAB[e] + 255) >> 8; for (int i = 0; i < nt; ++i) TAB[64 + mt++] = e; off += nt * 256; } TAB[32] = off; TAB[33] = mt; }
            __syncthreads();
        }
        if (IN(sb + 4)) { if (PHM(7)) PREP(7) {
            const int tid = opq_tid(), lane = tid & 63;
            LAS int* part = (LAS int*)(lds + RING_OFF);
            for (int c = bx; c < 256; c += G) {
                if (tid < 16) { int pre = 0; for (int s = 0; s < (c >> 3); ++s) pre += part[s * 16 + tid]; for (int cc = c & ~7; cc < c; ++cc) pre += CNT[cc * 16 + tid]; TAB[48 + tid] = TAB[16 + tid] + pre; }
                __syncthreads();
#pragma unroll 1
                for (int rr = 0; rr < 8; ++rr) { const size_t row = (size_t)64 * c + wave * 8 + rr; const unsigned word = RE[row];
                    const int p0 = TAB[48 + (word & 255)] + ((word >> 16) & 255), p1 = TAB[48 + ((word >> 8) & 255)] + (word >> 24);
                    if (lane == 0) { RP[2 * row] = p0; RP[2 * row + 1] = p1; }
                    const f32x4* hp = (const f32x4*)(H + row * DM) + lane; v2u* o0 = (v2u*)(XS + (size_t)p0 * DM) + lane; v2u* o1 = (v2u*)(XS + (size_t)p1 * DM) + lane;
#pragma unroll
                    for (int j = 0; j < 8; ++j) { const f32x4 v = hp[64 * j]; v2u o; o.x = pk2(v[0], v[1]); o.y = pk2(v[2], v[3]); o0[64 * j] = o; o1[64 * j] = o; } }
                __syncthreads();
            } }
            SEAM(sb + 4);
        }
        if (IN(sb + 5)) { if (PHM(8)) PREP(8) {
            pg8::Gemm g{XS, (const bf16*)(ws + WS_WGU) + (size_t)L * 16 * 2048 * 2048, XS_ROWS, 2048, DM};
            pg8::MoeOrder S{TAB[33] * 8, G, bx, TAB + 64}; pg8::EpiGateUp E{ACT};
            pg8::gemm_phase<pg8::EpiGateUp, pg8::MoeOrder, true, true>(lds + RING_OFF, g, S, E); }
            SEAM(sb + 5);
        }
        if (IN(sb + 6)) { if (PHM(9)) PREP(9) {
            pg8::Gemm g{ACT, (const bf16*)(ws + WS_WDN) + (size_t)L * 16 * 2048 * 1024, XS_ROWS, 2048, DEXP};
            pg8::MoeOrder S{TAB[33] * 8, G, bx, TAB + 64}; pg8::EpiDown E{YD};
            pg8::gemm_phase<pg8::EpiDown, pg8::MoeOrder, true, true>(lds + RING_OFF, g, S, E); }
            SEAM(sb + 6);
        }
        if (IN(sb + 7)) { if (PHM(10)) for (int rep_ = 0; rep_ < ((((PROBE_DUP) >> 10) & 1) && L == NLAYER - 1 ? 5 : 1); ++rep_) {
            const int tid = opq_tid(), lane = tid & 63;
            const float* lng = args.in[10] + (size_t)L * DM; const float* lnb = args.in[11] + (size_t)L * DM; const bool last = (L == NLAYER - 1);
            const int gw = vcu * NWAVES + wave, NGW = G * NWAVES;
            for (int row = gw; row < NTOK; row += NGW) {
                const int p0 = RP[2 * row], p1 = RP[2 * row + 1]; const f32x2 w = RW[row];
                const f32x4* hp = (const f32x4*)(H + (size_t)row * DM) + lane; const v2u* y0 = (const v2u*)(YD + (size_t)p0 * DM) + lane; const v2u* y1 = (const v2u*)(YD + (size_t)p1 * DM) + lane;
                f32x4 v[8]; float s = 0.f;
#pragma unroll
                for (int j = 0; j < 8; ++j) { const f32x4 h = hp[64 * j]; const v2u a = y0[64 * j], b = y1[64 * j];
                    const f32x4 fa = {__uint_as_float(a.x << 16), __uint_as_float(a.x & 0xffff0000u), __uint_as_float(a.y << 16), __uint_as_float(a.y & 0xffff0000u)};
                    const f32x4 fb = {__uint_as_float(b.x << 16), __uint_as_float(b.x & 0xffff0000u), __uint_as_float(b.y << 16), __uint_as_float(b.y & 0xffff0000u)};
                    v[j] = h * DN_ALPHA + fa * w.x + fb * w.y; s += (v[j][0] + v[j][1]) + (v[j][2] + v[j][3]); }
                const float mu = wave_sum(s) * (1.f / DM); float q = 0.f;
#pragma unroll
                for (int j = 0; j < 8; ++j) { const f32x4 d = v[j] - mu; q += (d[0] * d[0] + d[1] * d[1]) + (d[2] * d[2] + d[3] * d[3]); }
                const float rstd = 1.f / sqrtf(wave_sum(q) * (1.f / DM) + LN_EPS);
                f32x4* op = (f32x4*)((last ? args.out : H) + (size_t)row * DM) + lane; v2u* ob = (v2u*)(HB + (size_t)row * DM) + lane;
#pragma unroll
                for (int j = 0; j < 8; ++j) { const f32x4 gg = ((const f32x4*)lng)[64 * j + lane], bb = ((const f32x4*)lnb)[64 * j + lane];
                    const f32x4 y = (v[j] - mu) * rstd * gg + bb; op[64 * j] = y;
                    if (!last) { v2u o; o.x = pk2(y[0], y[1]); o.y = pk2(y[2], y[3]); ob[64 * j] = o; } }
            } }
            SEAM(sb + 7);
        }
    }
#undef IN
#undef SEAM
}

extern "C" void kernel_launch(void* const* d_in, const int* in_sizes, int n_in, void* d_out, int out_size, void* d_ws, size_t ws_size, hipStream_t stream) {
    static int grid = 0;
    if (grid == 0) {
        if (n_in != 17 || in_sizes[0] != NTOK * DM || out_size != NTOK * DM || ws_size < WS_END) { fprintf(stderr, "kernel_launch: unexpected shapes / workspace (n_in %d, ws %zu, need %zu)\n", n_in, ws_size, (size_t)WS_END); grid = -1; return; }
        int dev = 0, cus = 0, per_cu = 0;
        if (hipGetDevice(&dev) != hipSuccess || hipDeviceGetAttribute(&cus, hipDeviceAttributeMultiprocessorCount, dev) != hipSuccess) { grid = -1; return; }
        if (hipFuncSetAttribute((const void*)yoco_fwd, hipFuncAttributeMaxDynamicSharedMemorySize, LDS_BYTES) != hipSuccess) { fprintf(stderr, "kernel_launch: hipFuncSetAttribute failed\n"); grid = -1; return; }
        if (hipOccupancyMaxActiveBlocksPerMultiprocessor(&per_cu, (const void*)yoco_fwd, NWAVES * 64, LDS_BYTES) != hipSuccess || per_cu < 1) { fprintf(stderr, "kernel_launch: occupancy query says %d\n", per_cu); per_cu = 1; }
        (void)hipGetLastError();
        grid = cus;
    }
    if (grid < 0) return;
    (void)hipMemsetAsync((char*)d_ws + WS_CTL, 0, CTL_ZERO_BYTES, stream);
    Args a{};
    for (int i = 0; i < 17; ++i) a.in[i] = (const float*)d_in[i];
    a.out = (float*)d_out; a.ws = (unsigned char*)d_ws;
#if MK_MULTI
    for (int s = 0; s < NSTEPS; ++s) { a.s_lo = s; a.s_hi = s + 1; hipLaunchKernelGGL(yoco_fwd, dim3(grid), dim3(NWAVES * 64), LDS_BYTES, stream, a); }
#else
    a.s_lo = 0; a.s_hi = NSTEPS;
    hipLaunchKernelGGL(yoco_fwd, dim3(grid), dim3(NWAVES * 64), LDS_BYTES, stream, a);
#endif
    const hipError_t le = hipPeekAtLastError();
    if (le != hipSuccess) fprintf(stderr, "kernel_launch: launch failed: %s\n", hipGetErrorName(le));
}
```

```cpp
#include <hip/hip_runtime.h>
#include <cstdio>
#include <cstdint>

namespace pg8 {
#define PG8_LAS __attribute__((address_space(3)))
typedef unsigned short bf16_t;
typedef short bf16x8 __attribute__((ext_vector_type(8)));
typedef float f32x4 __attribute__((ext_vector_type(4)));
typedef unsigned u32x4 __attribute__((ext_vector_type(4)));
typedef int pg8_v8i __attribute__((ext_vector_type(8)));
constexpr int BM = 256, BK = 64, HALF = 128, HTB = HALF * BK * 2  , STAGE_BYTES = 8 * HTB, NXCD = 8, WGM = 8;

__host__ __device__ __forceinline__ int lds_byte(int r, int c) { const int st = (r >> 4) * 2 + (c >> 5), rr = r & 15, cc = c & 31, ob = rr * 64 + cc * 2; return st * 1024 + (ob ^ (((ob >> 9) & 1) << 5)); }
__host__ __device__ __forceinline__ void stage_rc(int b, int& R, int& C) { const int st = b / 1024, sb = b % 1024, swz = sb ^ (((sb >> 9) & 1) << 5); R = (st >> 1) * 16 + swz / 64; C = (st & 1) * 32 + (swz % 64) / 2; }
__host__ __device__ __forceinline__ int perm32(int rho) { const int n = rho >> 4, i = rho & 15; return 8 * (i >> 2) + 4 * n + (i & 3); }

struct Unit { int pm, pn; };
struct Gemm { const bf16_t* A; const bf16_t* Bt; int M, N, K; };

struct StaticOrder {
    int nM, nN, nwg, G, c;
    __host__ __device__ void init(int M, int N, int G_, int c_) { nM = M / BM; nN = N / BM; nwg = nM * nN; G = G_; c = c_; }
    __host__ __device__ bool next(int i, Unit& u) const {
        const long L = (long)i * G + c; if (L >= nwg) return false;
        int wgid = (int)L; { const int q = nwg / NXCD, r = nwg % NXCD, xcd = wgid % NXCD, off = wgid / NXCD; wgid = (xcd < r ? xcd * (q + 1) : r * (q + 1) + (xcd - r) * q) + off; }
        const int nig = WGM * nN, gid = wgid / nig, fm = gid * WGM, gsz = (nM - fm) < WGM ? (nM - fm) : WGM;
        u.pm = fm + ((wgid % nig) % gsz); u.pn = (wgid % nig) / gsz; return true;
    }
    __device__ __forceinline__ void a_ready(const Unit&) const {}
    __device__ __forceinline__ void done(const Unit&) const {}
};

__device__ __forceinline__ unsigned cvt_pk_bf16(float lo, float hi) { unsigned r; asm volatile("v_cvt_pk_bf16_f32 %0, %1, %2" : "=v"(r) : "v"(lo), "v"(hi)); return r; }
typedef float f32x2 __attribute__((ext_vector_type(2)));

typedef unsigned u32x2 __attribute__((ext_vector_type(2)));
__device__ __forceinline__ u32x4 pack8_bf16(const f32x4 a, const f32x4 b) { u32x4 w; w.x = cvt_pk_bf16(a[0], a[1]); w.y = cvt_pk_bf16(a[2], a[3]); w.z = cvt_pk_bf16(b[0], b[1]); w.w = cvt_pk_bf16(b[2], b[3]); return w; }

struct EpiQkv {
    static constexpr bool PERM = true, AFTER_DRAIN = false;
    bf16_t* O; int ldc; int qcols; float qscale;
    __device__ __forceinline__ void operator()(const f32x4 (&acc)[2][2][4][2], const Unit& u, int wr, int wc, int fr, int fq) const {
        const int row0 = u.pm * BM + wr * 64 + fr, colt = u.pn * BM; const float sc = colt < qcols ? qscale : 1.f;
        const int col0 = colt + wc * 32 + 8 * fq;
#pragma unroll
        for (int ai = 0; ai < 2; ++ai)
#pragma unroll
            for (int m = 0; m < 4; ++m) { bf16_t* rowp = O + (size_t)(row0 + ai * HALF + m * 16) * ldc + col0;
#pragma unroll
                for (int bj = 0; bj < 2; ++bj) *(u32x4*)(rowp + bj * HALF) = pack8_bf16(acc[ai][bj][m][0] * sc, acc[ai][bj][m][1] * sc); }
    }
};
struct EpiResid {
    static constexpr bool PERM = false, AFTER_DRAIN = false;
    float* H; int ldc; float alpha;
    __device__ __forceinline__ void operator()(const f32x4 (&acc)[2][2][4][2], const Unit& u, int wr, int wc, int fr, int fq) const {
        const int row0 = u.pm * BM + wr * 64 + fr, col0 = u.pn * BM + wc * 32 + 4 * fq;
#pragma unroll
        for (int ai = 0; ai < 2; ++ai)
#pragma unroll
            for (int m = 0; m < 4; ++m) { float* rowp = H + (size_t)(row0 + ai * HALF + m * 16) * ldc + col0;
#pragma unroll
                for (int bj = 0; bj < 2; ++bj)
#pragma unroll
                    for (int n = 0; n < 2; ++n) { f32x4* q = (f32x4*)(rowp + bj * HALF + n * 16); const f32x4 h = *q; *q = h * alpha + acc[ai][bj][m][n]; } }
    }
};
struct EpiRope {
    static constexpr bool PERM = true, AFTER_DRAIN = false;
    bf16_t* O; int ldc; int qcols, ropecols; float qscale; const float* ctab; const float* stab;
    __device__ __forceinline__ void operator()(const f32x4 (&acc)[2][2][4][2], const Unit& u, int wr, int wc, int fr, int fq) const {
        const int row0 = u.pm * BM + wr * 64 + fr, colt = u.pn * BM;
        if (colt >= ropecols) {
            const int col0 = colt + wc * 32 + 8 * fq;
#pragma unroll
            for (int ai = 0; ai < 2; ++ai)
#pragma unroll
                for (int m = 0; m < 4; ++m) { bf16_t* rowp = O + (size_t)(row0 + ai * HALF + m * 16) * ldc + col0;
#pragma unroll
                    for (int bj = 0; bj < 2; ++bj) *(u32x4*)(rowp + bj * HALF) = pack8_bf16(acc[ai][bj][m][0], acc[ai][bj][m][1]); }
        } else {
            const float sc = colt < qcols ? qscale : 1.f;
            const int col0 = colt + wc * 64 + 8 * fq;
#pragma unroll
            for (int ai = 0; ai < 2; ++ai)
#pragma unroll
                for (int m = 0; m < 4; ++m) { const int row = row0 + ai * HALF + m * 16; const int pos = row & 2047;
                    const f32x4 c0 = *(const f32x4*)(ctab + pos * 32 + 8 * fq), c1 = *(const f32x4*)(ctab + pos * 32 + 8 * fq + 4);
                    const f32x4 s0 = *(const f32x4*)(stab + pos * 32 + 8 * fq), s1 = *(const f32x4*)(stab + pos * 32 + 8 * fq + 4);
                    const f32x4 a0 = acc[ai][0][m][0], a1 = acc[ai][0][m][1], b0 = acc[ai][1][m][0], b1 = acc[ai][1][m][1];
                    bf16_t* rowp = O + (size_t)row * ldc + col0;
                    *(u32x4*)(rowp) = pack8_bf16((a0 * c0 - b0 * s0) * sc, (a1 * c1 - b1 * s1) * sc);
                    *(u32x4*)(rowp + 32) = pack8_bf16((b0 * c0 + a0 * s0) * sc, (b1 * c1 + a1 * s1) * sc); }
        }
    }
};
struct EpiGateUp {
    static constexpr bool PERM = true, AFTER_DRAIN = false;
    bf16_t* O;
    __device__ __forceinline__ void operator()(const f32x4 (&acc)[2][2][4][2], const Unit& u, int wr, int wc, int fr, int fq) const {
        const int row0 = u.pm * BM + wr * 64 + fr, col0 = (u.pn & 7) * 128 + wc * 32 + 8 * fq;
#pragma unroll
        for (int ai = 0; ai < 2; ++ai)
#pragma unroll
            for (int m = 0; m < 4; ++m) { f32x4 r[2];
#pragma unroll
                for (int n = 0; n < 2; ++n) { const f32x4 g = acc[ai][0][m][n], up = acc[ai][1][m][n];
#pragma unroll
                    for (int i = 0; i < 4; ++i) { const float e = __builtin_amdgcn_exp2f(g[i] * -1.4426950408889634f); r[n][i] = g[i] * __builtin_amdgcn_rcpf(1.f + e) * up[i]; } }
                *(u32x4*)(O + (size_t)(row0 + ai * HALF + m * 16) * 1024 + col0) = pack8_bf16(r[0], r[1]); }
    }
};
struct EpiDown {
    static constexpr bool PERM = true, AFTER_DRAIN = false;
    bf16_t* O;
    __device__ __forceinline__ void operator()(const f32x4 (&acc)[2][2][4][2], const Unit& u, int wr, int wc, int fr, int fq) const {
        const int row0 = u.pm * BM + wr * 64 + fr, col0 = (u.pn & 7) * BM + wc * 32 + 8 * fq;
#pragma unroll
        for (int ai = 0; ai < 2; ++ai)
#pragma unroll
            for (int m = 0; m < 4; ++m) { bf16_t* rowp = O + (size_t)(row0 + ai * HALF + m * 16) * 2048 + col0;
#pragma unroll
                for (int bj = 0; bj < 2; ++bj) *(u32x4*)(rowp + bj * HALF) = pack8_bf16(acc[ai][bj][m][0], acc[ai][bj][m][1]); }
    }
};
constexpr float W8_SCALE = 64.f, ACT8_SCALE = 4.f;
__device__ __forceinline__ unsigned pack4_fp8(float a, float b, float c, float d) { int w; asm volatile("" : "=v"(w));
    w = __builtin_amdgcn_cvt_pk_fp8_f32(a, b, w, false); w = __builtin_amdgcn_cvt_pk_fp8_f32(c, d, w, true); return (unsigned)w; }
struct EpiGateUp8 {
    static constexpr bool PERM = true, AFTER_DRAIN = false;
    unsigned char* O;
    __device__ __forceinline__ void operator()(const f32x4 (&acc)[2][2][4][2], const Unit& u, int wr, int wc, int fr, int fq) const {
        const int row0 = u.pm * BM + wr * 64 + fr, col0 = (u.pn & 7) * 128 + wc * 32 + 8 * fq;
        constexpr float SI = 1.f / W8_SCALE;
#pragma unroll
        for (int ai = 0; ai < 2; ++ai)
#pragma unroll
            for (int m = 0; m < 4; ++m) { f32x4 r[2];
#pragma unroll
                for (int n = 0; n < 2; ++n) { const f32x4 g = acc[ai][0][m][n] * SI, up = acc[ai][1][m][n] * (SI * ACT8_SCALE);
#pragma unroll
                    for (int i = 0; i < 4; ++i) { const float e = __builtin_amdgcn_exp2f(g[i] * -1.4426950408889634f); r[n][i] = g[i] * __builtin_amdgcn_rcpf(1.f + e) * up[i]; } }
                u32x2 w; w.x = pack4_fp8(r[0][0], r[0][1], r[0][2], r[0][3]); w.y = pack4_fp8(r[1][0], r[1][1], r[1][2], r[1][3]);
                *(u32x2*)(O + (size_t)(row0 + ai * HALF + m * 16) * 1024 + col0) = w; }
    }
};
struct EpiDown8 {
    static constexpr bool PERM = true, AFTER_DRAIN = false;
    bf16_t* O;
    __device__ __forceinline__ void operator()(const f32x4 (&acc)[2][2][4][2], const Unit& u, int wr, int wc, int fr, int fq) const {
        const int row0 = u.pm * BM + wr * 64 + fr, col0 = (u.pn & 7) * BM + wc * 32 + 8 * fq;
        constexpr float SI = 1.f / (W8_SCALE * ACT8_SCALE);
#pragma unroll
        for (int ai = 0; ai < 2; ++ai)
#pragma unroll
            for (int m = 0; m < 4; ++m) { bf16_t* rowp = O + (size_t)(row0 + ai * HALF + m * 16) * 2048 + col0;
#pragma unroll
                for (int bj = 0; bj < 2; ++bj) *(u32x4*)(rowp + bj * HALF) = pack8_bf16(acc[ai][bj][m][0] * SI, acc[ai][bj][m][1] * SI); }
    }
};
struct MoeOrder {
    int nunits, G, c; const PG8_LAS int* tile_e;
    __device__ __forceinline__ bool next(int i, Unit& u) const {
        int idx;
        if ((G & 7) == 0) { const int per = G >> 3; idx = (i * 8 + (c & 7)) * per + (c >> 3); } else idx = i * G + c;
        if (idx >= nunits) return false;
        const int mt = idx >> 3; u.pm = mt; u.pn = tile_e[mt] * 8 + (idx & 7); return true;
    }
    __device__ __forceinline__ void a_ready(const Unit&) const {}
    __device__ __forceinline__ void done(const Unit&) const {}
};

template <class Epi, class Sched, bool ALIGN_EPI = false, bool SP2 = false, bool F8 = false>
__device__ __forceinline__ void gemm_phase(PG8_LAS unsigned char* lds, const Gemm g, const Sched& S, const Epi& E) {
    int tid_ = threadIdx.x; asm volatile("" : "+v"(tid_));
    const int tid = tid_, wid = __builtin_amdgcn_readfirstlane(tid >> 6), lane = tid & 63, wr = wid >> 2, wc = wid & 3, fr = lane & 15, fq = lane >> 4;
    const int K = g.K, nt = K / BK;
    unsigned voffA, voffB;
    { int R, C; stage_rc(tid * 16, R, C); const int Rb = Epi::PERM ? ((R & ~31) + perm32(R & 31)) : R;
        voffA = (unsigned)(R * K + C) * 2u; voffB = (unsigned)(Rb * K + C) * 2u; }
    const size_t pstep = (size_t)64 * K * 2;
    const size_t kstep = (size_t)(BK * 2);
    const size_t hstep = (size_t)HALF * K * 2;
    const size_t tstep = 2 * hstep;
    const unsigned ldsbase = (unsigned)(uintptr_t)lds;
    const unsigned ldsw = (unsigned)wid * 1024u;
    const int aoff = lds_byte(wr * 64 + fr, fq * 8), boff = lds_byte(wc * 32 + fr, fq * 8);
#define PG8_SA(b, h) (((b) * 2 + (h)) * HTB)
#define PG8_SB(b, h) ((4 + (b) * 2 + (h)) * HTB)
#define PG8_STAGE(bufoff, gbase, voff) do { _Pragma("unroll") for (int _i = 0; _i < 2; ++_i) { unsigned keep_; \
        asm volatile("s_mov_b32 %0, m0\n\ts_mov_b32 m0, %3\n\ts_nop 0\n\tglobal_load_lds_dwordx4 %1, %2\n\ts_mov_b32 m0, %0" : "=&s"(keep_) \
            : "v"(voff), "s"((const char*)(gbase) + _i * pstep), "s"(ldsbase + (unsigned)(bufoff) + ldsw + (unsigned)(_i * 8192))); } } while (0)
#define PG8_CAT(a, b) __builtin_bit_cast(pg8_v8i, __builtin_shufflevector(a, b, 0, 1, 2, 3, 4, 5, 6, 7, 8, 9, 10, 11, 12, 13, 14, 15))
#define PG8_LDA(dst, b, h) do { if constexpr (F8) { _Pragma("unroll") for (int m = 0; m < 4; ++m) { const bf16x8 lo_ = *(const PG8_LAS bf16x8*)(lds + PG8_SA(b, h) + aoff + m * 2048), hi_ = *(const PG8_LAS bf16x8*)(lds + PG8_SA(b, h) + aoff + m * 2048 + 1024); dst##8[m] = PG8_CAT(lo_, hi_); } } \
        else { _Pragma("unroll") for (int m = 0; m < 4; ++m) _Pragma("unroll") for (int k = 0; k < 2; ++k) dst[m][k] = *(const PG8_LAS bf16x8*)(lds + PG8_SA(b, h) + aoff + m * 2048 + k * 1024); } } while (0)
#define PG8_LDB(dst, b, h) do { if constexpr (F8) { _Pragma("unroll") for (int n = 0; n < 2; ++n) { const bf16x8 lo_ = *(const PG8_LAS bf16x8*)(lds + PG8_SB(b, h) + boff + n * 2048), hi_ = *(const PG8_LAS bf16x8*)(lds + PG8_SB(b, h) + boff + n * 2048 + 1024); dst##8[n] = PG8_CAT(lo_, hi_); } } \
        else { _Pragma("unroll") for (int n = 0; n < 2; ++n) _Pragma("unroll") for (int k = 0; k < 2; ++k) dst[n][k] = *(const PG8_LAS bf16x8*)(lds + PG8_SB(b, h) + boff + n * 2048 + k * 1024); } } while (0)
#define PG8_MMA(ai, bj, At, Bt) do { __builtin_amdgcn_s_setprio(1); \
        if constexpr (F8) { _Pragma("unroll") for (int m = 0; m < 4; ++m) _Pragma("unroll") for (int n = 0; n < 2; ++n) \
            acc[ai][bj][m][n] = __builtin_amdgcn_mfma_scale_f32_16x16x128_f8f6f4(Bt##8[n], At##8[m], acc[ai][bj][m][n], 0, 0, 0, 0, 0, 0); } \
        else { _Pragma("unroll") for (int m = 0; m < 4; ++m) _Pragma("unroll") for (int n = 0; n < 2; ++n) _Pragma("unroll") for (int k = 0; k < 2; ++k) \
            acc[ai][bj][m][n] = __builtin_amdgcn_mfma_f32_16x16x32_bf16(Bt[n][k], At[m][k], acc[ai][bj][m][n], 0, 0, 0); } \
        __builtin_amdgcn_s_setprio(0); } while (0)
#define PG8_WAIT_V(n) asm volatile("s_waitcnt vmcnt(" #n ")" ::: "memory")
#define PG8_WAIT_L(n) asm volatile("s_waitcnt lgkmcnt(" #n ")" ::: "memory")
#define PG8_BAR __builtin_amdgcn_s_barrier()
#define PG8_SCHED __builtin_amdgcn_sched_barrier(0)
    Unit cur, nxt; int ui = 0;
    if (!S.next(0, cur)) return;
    f32x4 acc[2][2][4][2];
{ float zero_; asm volatile("v_mov_b32 %0, 0" : "=v"(zero_));
#pragma unroll
    for (int a = 0; a < 2; ++a)
#pragma unroll
        for (int b = 0; b < 2; ++b)
#pragma unroll
            for (int m = 0; m < 4; ++m)
#pragma unroll
                for (int n = 0; n < 2; ++n) acc[a][b][m][n] = (f32x4){zero_, zero_, zero_, zero_}; }
    bf16x8 At[4][2], B0[2][2], B1[2][2]; pg8_v8i At8[4], B08[2], B18[2];
    const char* cA = (const char*)g.A + (size_t)cur.pm * tstep; const char* cB = (const char*)g.Bt + (size_t)cur.pn * tstep;
    S.a_ready(cur);
    if constexpr (SP2) {
        PG8_STAGE(PG8_SB(0, 0), cB, voffB); PG8_STAGE(PG8_SB(0, 1), cB + hstep, voffB); PG8_STAGE(PG8_SA(0, 0), cA, voffA); PG8_STAGE(PG8_SA(0, 1), cA + hstep, voffA);
        if (wr == 1) PG8_BAR;
        PG8_WAIT_V(2); PG8_BAR;
        PG8_STAGE(PG8_SB(1, 0), cB + kstep, voffB); PG8_STAGE(PG8_SA(1, 0), cA + kstep, voffA); PG8_STAGE(PG8_SB(1, 1), cB + hstep + kstep, voffB);
        PG8_WAIT_V(6); PG8_BAR;
    } else {
        PG8_STAGE(PG8_SB(0, 0), cB, voffB); PG8_STAGE(PG8_SA(0, 0), cA, voffA); PG8_STAGE(PG8_SB(0, 1), cB + hstep, voffB); PG8_STAGE(PG8_SA(0, 1), cA + hstep, voffA);
        if (wr == 1) PG8_BAR;
        PG8_WAIT_V(4); PG8_BAR;
        PG8_STAGE(PG8_SB(1, 0), cB + kstep, voffB); PG8_STAGE(PG8_SA(1, 0), cA + kstep, voffA); PG8_STAGE(PG8_SB(1, 1), cB + hstep + kstep, voffB);
        PG8_WAIT_V(6); PG8_BAR;
    }
    for (;;) {
        const bool has_next = S.next(ui + 1, nxt);
        const char* nA = has_next ? (const char*)g.A + (size_t)nxt.pm * tstep : cA; const char* nB = has_next ? (const char*)g.Bt + (size_t)nxt.pn * tstep : cB;
#pragma unroll 1
        for (int t = 0; t < nt; t += 2) {
            const bool last = (t == nt - 2);
            const char* a1 = cA + (size_t)(t + 1) * kstep;
            const char* a2 = last ? nA : cA + (size_t)(t + 2) * kstep; const char* b2 = last ? nB : cB + (size_t)(t + 2) * kstep;
            const char* a3 = a2 + kstep; const char* b3 = b2 + kstep;
            if (last && has_next) S.a_ready(nxt);
            if constexpr (SP2) {
            PG8_LDB(B0, 0, 0); PG8_LDB(B1, 0, 1); PG8_SCHED; PG8_LDA(At, 0, 0); PG8_STAGE(PG8_SA(1, 1), a1 + hstep, voffA);
            PG8_WAIT_V(8); PG8_WAIT_L(0); PG8_BAR; PG8_MMA(0, 0, At, B0); PG8_MMA(0, 1, At, B1); PG8_BAR; PG8_SCHED;
            PG8_LDA(At, 0, 1); PG8_STAGE(PG8_SB(0, 0), b2, voffB); PG8_STAGE(PG8_SB(0, 1), b2 + hstep, voffB); PG8_STAGE(PG8_SA(0, 0), a2, voffA);
            PG8_WAIT_V(8); PG8_WAIT_L(0); PG8_BAR; PG8_MMA(1, 0, At, B0); PG8_MMA(1, 1, At, B1); PG8_BAR; PG8_SCHED;
            PG8_LDB(B0, 1, 0); PG8_LDB(B1, 1, 1); PG8_SCHED; PG8_LDA(At, 1, 0); PG8_STAGE(PG8_SA(0, 1), a2 + hstep, voffA);
            PG8_WAIT_V(8); PG8_WAIT_L(0); PG8_BAR; PG8_MMA(0, 0, At, B0); PG8_MMA(0, 1, At, B1); PG8_BAR; PG8_SCHED;
            PG8_LDA(At, 1, 1); PG8_STAGE(PG8_SB(1, 0), b3, voffB); PG8_STAGE(PG8_SB(1, 1), b3 + hstep, voffB); PG8_STAGE(PG8_SA(1, 0), a3, voffA);
            PG8_WAIT_V(8); PG8_WAIT_L(0); PG8_BAR; PG8_MMA(1, 0, At, B0); PG8_MMA(1, 1, At, B1); PG8_BAR; PG8_SCHED;
            } else {
            PG8_LDB(B0, 0, 0); PG8_SCHED; PG8_LDA(At, 0, 0); PG8_STAGE(PG8_SA(1, 1), a1 + hstep, voffA);
            PG8_WAIT_L(8); PG8_BAR; PG8_WAIT_L(0); PG8_MMA(0, 0, At, B0); PG8_BAR; PG8_SCHED;
            PG8_LDB(B1, 0, 1); PG8_STAGE(PG8_SB(0, 0), b2, voffB);
            PG8_BAR; PG8_WAIT_L(0); PG8_MMA(0, 1, At, B1); PG8_BAR;
            PG8_LDA(At, 0, 1); PG8_STAGE(PG8_SA(0, 0), a2, voffA);
            PG8_BAR; PG8_WAIT_L(0); PG8_MMA(1, 0, At, B0); PG8_BAR; PG8_SCHED;
            PG8_STAGE(PG8_SB(0, 1), b2 + hstep, voffB);
            PG8_WAIT_V(6); PG8_BAR; PG8_MMA(1, 1, At, B1); PG8_BAR;
            PG8_LDB(B0, 1, 0); PG8_SCHED; PG8_LDA(At, 1, 0); PG8_STAGE(PG8_SA(0, 1), a2 + hstep, voffA);
            PG8_WAIT_L(8); PG8_BAR; PG8_WAIT_L(0); PG8_MMA(0, 0, At, B0); PG8_BAR; PG8_SCHED;
            PG8_LDB(B1, 1, 1); PG8_STAGE(PG8_SB(1, 0), b3, voffB);
            PG8_BAR; PG8_WAIT_L(0); PG8_MMA(0, 1, At, B1); PG8_BAR;
            PG8_LDA(At, 1, 1); PG8_STAGE(PG8_SA(1, 0), a3, voffA);
            PG8_BAR; PG8_WAIT_L(0); PG8_MMA(1, 0, At, B0); PG8_BAR; PG8_SCHED;
            PG8_STAGE(PG8_SB(1, 1), b3 + hstep, voffB);
            PG8_WAIT_V(6); PG8_BAR; PG8_MMA(1, 1, At, B1); PG8_BAR;
            }
        }
        if constexpr (ALIGN_EPI) { if (wr == 0) PG8_BAR; }
        if constexpr (!Epi::AFTER_DRAIN) { E(acc, cur, wr, wc, fr, fq); S.done(cur); }
        if (!has_next) break;
{ float zero_; asm volatile("v_mov_b32 %0, 0" : "=v"(zero_));
#pragma unroll
        for (int a = 0; a < 2; ++a)
#pragma unroll
            for (int b = 0; b < 2; ++b)
#pragma unroll
                for (int m = 0; m < 4; ++m)
#pragma unroll
                    for (int n = 0; n < 2; ++n) acc[a][b][m][n] = (f32x4){zero_, zero_, zero_, zero_}; }
        cur = nxt; cA = nA; cB = nB; ++ui;
        if constexpr (ALIGN_EPI) { if (wr == 1) PG8_BAR; }
    }
    PG8_WAIT_V(0);
    if constexpr (!ALIGN_EPI) { if (wr == 0) PG8_BAR; }
    PG8_BAR;
    if constexpr (Epi::AFTER_DRAIN) { E.fused(acc, cur, wr, wc, fr, fq, lds, wid, lane); S.done(cur); }
#undef PG8_SA
#undef PG8_SB
#undef PG8_STAGE
#undef PG8_LDA
#undef PG8_LDB
#undef PG8_MMA
#undef PG8_CAT
#undef PG8_WAIT_V
#undef PG8_WAIT_L
#undef PG8_BAR
#undef PG8_SCHED
}
}

namespace att {
#define ALAS __attribute__((address_space(3)))
typedef unsigned short bf16_t;
typedef short bf16x8 __attribute__((ext_vector_type(8)));
typedef short s16x4 __attribute__((ext_vector_type(4)));
typedef float f32x16 __attribute__((ext_vector_type(16)));
typedef float f32x4 __attribute__((ext_vector_type(4)));
typedef unsigned u32x4 __attribute__((ext_vector_type(4)));
typedef ALAS char* ldsp;
constexpr int QP = 6144;
constexpr int OP = 2048;
constexpr int SHM_V = 16384, SHM_K = 16384;
constexpr int LDS_V = 0, LDS_K = 2 * SHM_V, LDS_WS = LDS_K + 2 * SHM_K, ATT_LDS_BYTES = LDS_WS + 8 * 256;
#define KSWZ(row, colB) ((row) * 256 + ((colB) ^ (((row) & 7) << 4)))
#define KSWZ64(row, colB) ((row) * 128 + ((colB) ^ (((row) & 7) << 4)))
#define SBAR() __builtin_amdgcn_sched_barrier(0)
__device__ __forceinline__ int v_st(int k, int c) { const int kk = (k & ~0xC) | ((k & 4) << 1) | ((k & 8) >> 1); return ((kk >> 3) * 4 + (c >> 5)) * 512 + ((kk & 7) * 32 + (c & 31)) * 2; }
__device__ __forceinline__ int v_rd_base(int lane) { return ((lane & 3) << 3) | (((lane >> 2) & 3) << 6) | (((lane >> 4) & 1) << 5) | (((lane >> 5) & 1) << 8); }
constexpr int v_rd_off(int d0, int ks, int half) { return d0 * 512 + ks * 4096 + half * 2048; }
__device__ __forceinline__ int crow(int r, int hi) { return (r & 3) + 8 * (r >> 2) + 4 * hi; }
__device__ __forceinline__ unsigned cvtpk(float lo, float hi) { unsigned r; asm volatile("v_cvt_pk_bf16_f32 %0, %1, %2" : "=v"(r) : "v"(lo), "v"(hi)); return r; }
__device__ __forceinline__ bf16x8 ldg8(const bf16_t* p) { return *reinterpret_cast<const bf16x8*>(p); }
__device__ __forceinline__ float xhalf(float v, int hi) {
    auto rr = __builtin_amdgcn_permlane32_swap(__float_as_uint(v), __float_as_uint(v), false, false);
    return __uint_as_float(hi ? rr[0] : rr[1]);
}
#define ATT_PK4(P, B_, OUT) do { unsigned a0 = cvtpk(P[B_+0], P[B_+1]), a1 = cvtpk(P[B_+2], P[B_+3]);                      \
        unsigned b0 = cvtpk(P[B_+4], P[B_+5]), b1 = cvtpk(P[B_+6], P[B_+7]);                                             \
        auto r0 = __builtin_amdgcn_permlane32_swap(a0, b0, false, false); auto r1 = __builtin_amdgcn_permlane32_swap(a1, b1, false, false); \
        u32x4 w = {r0[0], r1[0], r0[1], r1[1]}; OUT = *reinterpret_cast<bf16x8*>(&w); } while (0)
__device__ __forceinline__ void pv_tile(f32x16* o, int vb, bf16x8 pa0, bf16x8 pa1, bf16x8 pa2, bf16x8 pa3) {
#define TRRD(dst, off) asm volatile("ds_read_b64_tr_b16 %0, %1 offset:%2" : "=&v"(dst) : "v"(vb), "i"(off) : "memory")
#define PV_D0(d0) do { s16x4 l0, l1, l2, l3, h0, h1, h2, h3; constexpr int b_ = v_rd_off(d0, 0, 0); \
        TRRD(l0, b_); TRRD(h0, b_ + 2048); TRRD(l1, b_ + 4096); TRRD(h1, b_ + 6144); TRRD(l2, b_ + 8192); TRRD(h2, b_ + 10240); TRRD(l3, b_ + 12288); TRRD(h3, b_ + 14336); \
        asm volatile("s_waitcnt lgkmcnt(0)" ::: "memory"); SBAR(); \
        o[d0] = __builtin_amdgcn_mfma_f32_32x32x16_bf16(pa0, (bf16x8){l0[0], l0[1], l0[2], l0[3], h0[0], h0[1], h0[2], h0[3]}, o[d0], 0, 0, 0);   \
        o[d0] = __builtin_amdgcn_mfma_f32_32x32x16_bf16(pa1, (bf16x8){l1[0], l1[1], l1[2], l1[3], h1[0], h1[1], h1[2], h1[3]}, o[d0], 0, 0, 0);   \
        o[d0] = __builtin_amdgcn_mfma_f32_32x32x16_bf16(pa2, (bf16x8){l2[0], l2[1], l2[2], l2[3], h2[0], h2[1], h2[2], h2[3]}, o[d0], 0, 0, 0);   \
        o[d0] = __builtin_amdgcn_mfma_f32_32x32x16_bf16(pa3, (bf16x8){l3[0], l3[1], l3[2], l3[3], h3[0], h3[1], h3[2], h3[3]}, o[d0], 0, 0, 0); } while (0)
    PV_D0(0); PV_D0(1); PV_D0(2); PV_D0(3);
#undef PV_D0
#undef TRRD
}

__device__ __forceinline__ void sb_block(const bf16_t* __restrict__ Qg, const bf16_t* __restrict__ Kg, const bf16_t* __restrict__ Vg, bf16_t* __restrict__ Og, int qb, ldsp lds) {
    int tid_ = threadIdx.x; asm volatile("" : "+v"(tid_));
    const int tid = tid_, wid = __builtin_amdgcn_readfirstlane(tid >> 6), lane = tid & 63, r32 = lane & 31, hi = lane >> 5;
    const int NT = 4 * qb + 4, R0 = 256 * qb + 32 * wid, myrow = R0 + r32;
    const ldsp V_lds = lds + LDS_V; const ldsp K_lds = lds + LDS_K;
    bf16x8 qr[8];
    { const bf16_t* Qw = Qg + (size_t)R0 * QP; const unsigned qoff = (unsigned)(r32 * QP + hi * 8);
#pragma unroll
      for (int d0 = 0; d0 < 8; ++d0) qr[d0] = ldg8(Qw + (qoff + d0 * 16)); }
    const int sr = tid >> 4, sc = (tid & 15) * 8, kws = KSWZ(sr, sc * 2), vst0 = v_st(sr, sc), vst1 = v_st(32 + sr, sc);
    const unsigned kvoff = (unsigned)(sr * QP + sc);
    const int vb0 = (int)(unsigned)(uintptr_t)V_lds + v_rd_base(lane);
    bf16x8 sk0, sk1, sv0, sv1;
#define SB_LOAD(j) do { const bf16_t* kp_ = Kg + (size_t)(64 * (j)) * QP; const bf16_t* vp_ = Vg + (size_t)(64 * (j)) * QP; \
        sk0 = ldg8(kp_ + kvoff); sk1 = ldg8(kp_ + (size_t)32 * QP + kvoff); sv0 = ldg8(vp_ + kvoff); sv1 = ldg8(vp_ + (size_t)32 * QP + kvoff); } while (0)
#define SB_WRITE(bf) do { *(ALAS bf16x8*)(K_lds + (bf) * SHM_K + kws) = sk0; *(ALAS bf16x8*)(K_lds + (bf) * SHM_K + kws + 32 * 256) = sk1; \
        *(ALAS bf16x8*)(V_lds + (bf) * SHM_V + vst0) = sv0; *(ALAS bf16x8*)(V_lds + (bf) * SHM_V + vst1) = sv1; } while (0)
    SB_LOAD(NT - 1); SB_WRITE(0);
    __syncthreads();
    float carry = 0.f; f32x16 o[4] = {};
    ALAS int* fl = (ALAS int*)(lds + LDS_WS); bool wdone = false;
    for (int t = 0; t < NT; ++t) {
        const int j = NT - 1 - t, buf = t & 1, kb = 64 * j;
        if (t + 1 < NT) SB_LOAD(j - 1);
        if (kb <= R0 + 30 && !wdone) {
            f32x16 p0 = {}, p1 = {};
            { const ldsp Kb = K_lds + buf * SHM_K;
#pragma unroll
              for (int d0 = 0; d0 < 8; ++d0) { const ldsp a = Kb + KSWZ(r32, ((d0 & 3) * 16 + hi * 8) * 2) + (d0 >> 2) * 128;
                  const bf16x8 b0 = *(const ALAS bf16x8*)a, b1 = *(const ALAS bf16x8*)(a + 32 * 256);
                  p0 = __builtin_amdgcn_mfma_f32_32x32x16_bf16(b0, qr[d0], p0, 0, 0, 0);
                  p1 = __builtin_amdgcn_mfma_f32_32x32x16_bf16(b1, qr[d0], p1, 0, 0, 0); } }
            f32x16 lb0, lb1;
#pragma unroll
            for (int r = 0; r < 16; ++r) {
                { const float z = p0[r]; const float e = __builtin_amdgcn_exp2f(-__builtin_fabsf(z)); const float sp = __builtin_fmaxf(z, 0.f) + __builtin_amdgcn_logf(1.f + e); p0[r] = -sp; lb0[r] = z - sp; }
                { const float z = p1[r]; const float e = __builtin_amdgcn_exp2f(-__builtin_fabsf(z)); const float sp = __builtin_fmaxf(z, 0.f) + __builtin_amdgcn_logf(1.f + e); p1[r] = -sp; lb1[r] = z - sp; }
            }
            if (kb + 63 >= R0) {
                const int dq = myrow - kb - 4 * hi; const float NEG = -__builtin_inff();
#pragma unroll
                for (int r = 0; r < 16; ++r) { const int c = (r & 3) + 8 * (r >> 2);
                    if (c >= dq) { p0[r] = 0.f; lb0[r] = NEG; }
                    if (c + 32 >= dq) { p1[r] = 0.f; lb1[r] = NEG; } }
            }
            float gs[8], go[8];
#pragma unroll
            for (int g = 0; g < 4; ++g) { gs[g] = (p0[4 * g] + p0[4 * g + 1]) + (p0[4 * g + 2] + p0[4 * g + 3]); gs[4 + g] = (p1[4 * g] + p1[4 * g + 1]) + (p1[4 * g + 2] + p1[4 * g + 3]); }
#pragma unroll
            for (int i = 0; i < 8; ++i) go[i] = xhalf(gs[i], hi);
            float acc = carry;
#pragma unroll
            for (int idx = 7; idx >= 0; --idx) { const int g = idx & 3; const float base = acc + (hi ? 0.f : go[idx]);
                if (idx >= 4) { const float t3 = base, t2 = t3 + p1[4 * g + 3], t1 = t2 + p1[4 * g + 2], t0 = t1 + p1[4 * g + 1];
                    lb1[4 * g + 3] = __builtin_amdgcn_exp2f(lb1[4 * g + 3] + t3); lb1[4 * g + 2] = __builtin_amdgcn_exp2f(lb1[4 * g + 2] + t2);
                    lb1[4 * g + 1] = __builtin_amdgcn_exp2f(lb1[4 * g + 1] + t1); lb1[4 * g] = __builtin_amdgcn_exp2f(lb1[4 * g] + t0); }
                else { const float t3 = base, t2 = t3 + p0[4 * g + 3], t1 = t2 + p0[4 * g + 2], t0 = t1 + p0[4 * g + 1];
                    lb0[4 * g + 3] = __builtin_amdgcn_exp2f(lb0[4 * g + 3] + t3); lb0[4 * g + 2] = __builtin_amdgcn_exp2f(lb0[4 * g + 2] + t2);
                    lb0[4 * g + 1] = __builtin_amdgcn_exp2f(lb0[4 * g + 1] + t1); lb0[4 * g] = __builtin_amdgcn_exp2f(lb0[4 * g] + t0); }
                acc += gs[idx] + go[idx]; }
            carry = acc;
            bf16x8 pa0, pa1, pa2, pa3;
            ATT_PK4(lb0, 0, pa0); ATT_PK4(lb0, 8, pa1); ATT_PK4(lb1, 0, pa2); ATT_PK4(lb1, 8, pa3);
            SBAR();
            pv_tile(o, vb0 + buf * SHM_V, pa0, pa1, pa2, pa3);
            wdone = __all(carry < -127.f);
        }
        if (lane == 0) fl[buf * 8 + wid] = wdone ? 1 : 0;
        if (t + 1 < NT) SB_WRITE(buf ^ 1);
        __syncthreads();
        { const ALAS int* f = fl + buf * 8; if ((f[0] & f[1] & f[2] & f[3] & f[4] & f[5] & f[6] & f[7]) != 0) break; }
    }
#undef SB_LOAD
#undef SB_WRITE
    bf16_t* Ow = Og + (size_t)R0 * OP; const unsigned ooff = (unsigned)(4 * hi * OP + r32);
#pragma unroll
    for (int r = 0; r < 16; ++r) { bf16_t* rowp = Ow + (size_t)((r & 3) + 8 * (r >> 2)) * OP;
#pragma unroll
        for (int d0 = 0; d0 < 4; ++d0) { const float v = o[d0][r]; const float vn = __shfl_xor(v, 1);
            if ((r32 & 1) == 0) *(unsigned*)(rowp + (ooff + d0 * 32)) = cvtpk(v, vn); } }
}

constexpr float ATT_THR = 8.f;
__device__ __forceinline__ void qkt64(f32x16& p0, f32x16& p1, ldsp Kb, int r32, int hi, const bf16x8* qr) {
    p0 = f32x16{}; p1 = f32x16{};
#pragma unroll
    for (int d0 = 0; d0 < 4; ++d0) { const ldsp a = Kb + KSWZ64(r32, (d0 * 16 + hi * 8) * 2);
        const bf16x8 b0 = *(const ALAS bf16x8*)a, b1 = *(const ALAS bf16x8*)(a + 32 * 128);
        p0 = __builtin_amdgcn_mfma_f32_32x32x16_bf16(b0, qr[d0], p0, 0, 0, 0);
        p1 = __builtin_amdgcn_mfma_f32_32x32x16_bf16(b1, qr[d0], p1, 0, 0, 0); }
}
__device__ __forceinline__ void partial_sm(f32x16& p0, f32x16& p1, float& m_reg, float& alpha, int hi) {
    float pmax = p0[0];
#pragma unroll
    for (int r = 1; r < 16; ++r) pmax = __builtin_fmaxf(pmax, p0[r]);
#pragma unroll
    for (int r = 0; r < 16; ++r) pmax = __builtin_fmaxf(pmax, p1[r]);
    pmax = __builtin_fmaxf(pmax, xhalf(pmax, hi));
    float mn;
    if (__builtin_expect(__all(pmax - m_reg <= ATT_THR), 1)) { mn = m_reg; alpha = 1.f; }
    else { mn = __builtin_fmaxf(m_reg, pmax); alpha = __builtin_amdgcn_exp2f(m_reg - mn); m_reg = mn; }
#pragma unroll
    for (int r = 0; r < 16; ++r) { p0[r] -= mn; p1[r] -= mn; }
#pragma unroll
    for (int r = 0; r < 16; ++r) p0[r] = __builtin_amdgcn_exp2f(p0[r]);
}
__device__ __forceinline__ void finish_sm(f32x16& p0, f32x16& p1, float alpha, float& l_reg, bf16x8& pa0, bf16x8& pa1, bf16x8& pa2, bf16x8& pa3, int hi) {
#pragma unroll
    for (int r = 0; r < 16; ++r) p1[r] = __builtin_amdgcn_exp2f(p1[r]);
    float ps = 0.f;
#pragma unroll
    for (int r = 0; r < 16; ++r) ps += p0[r];
#pragma unroll
    for (int r = 0; r < 16; ++r) ps += p1[r];
    ps += xhalf(ps, hi);
    l_reg = l_reg * alpha + ps;
    ATT_PK4(p0, 0, pa0); ATT_PK4(p0, 8, pa1); ATT_PK4(p1, 0, pa2); ATT_PK4(p1, 8, pa3);
}
__device__ __forceinline__ void mask_gt(f32x16& p0, f32x16& p1, int dq) {
    const float NEG = -__builtin_inff();
#pragma unroll
    for (int r = 0; r < 16; ++r) { const int c = (r & 3) + 8 * (r >> 2);
        if (c > dq) p0[r] = NEG;
        if (c + 32 > dq) p1[r] = NEG; }
}
template <bool SECOND>
__device__ __forceinline__ void diff_pass(const bf16_t* __restrict__ Qg, const bf16_t* __restrict__ Kg, const bf16_t* __restrict__ Vg, float* S1, bf16_t* __restrict__ Og,
                                          int qb, float lam, const float* __restrict__ gsub, float gmul, ldsp lds) {
    int tid_ = threadIdx.x; asm volatile("" : "+v"(tid_));
    const int tid = tid_, wid = __builtin_amdgcn_readfirstlane(tid >> 6), lane = tid & 63, r32 = lane & 31, hi = lane >> 5;
    const int NT = 4 * qb + 4, R0 = 256 * qb + 32 * wid, myrow = R0 + r32;
    const ldsp V_lds = lds + LDS_V; const ldsp K_lds = lds + LDS_K;
    ALAS float* wsf = (ALAS float*)(lds + LDS_WS) + wid * 64; ALAS float* li_l = wsf; ALAS float* al_l = wsf + 32;
    bf16x8 qr[4];
    { const bf16_t* Qw = Qg + (size_t)R0 * QP; const unsigned qoff = (unsigned)(r32 * QP + hi * 8);
#pragma unroll
      for (int d0 = 0; d0 < 4; ++d0) qr[d0] = ldg8(Qw + (qoff + d0 * 16)); }
    const int sr = tid >> 4, sc = (tid & 15) * 8, vst0 = v_st(sr, sc), vst1 = v_st(32 + sr, sc);
    const int kr = tid >> 3, kc = (tid & 7) * 8, kws = KSWZ64(kr, kc * 2);
    const unsigned voff = (unsigned)(sr * QP + sc), koff = (unsigned)(kr * QP + kc);
    const int vb0 = (int)(unsigned)(uintptr_t)V_lds + v_rd_base(lane);
    const int qm = myrow - 4 * hi;
    bf16x8 sk0, sv0, sv1;
#define DF_LOAD(j) do { const bf16_t* vp_ = Vg + (size_t)(64 * (j)) * QP; sk0 = ldg8(Kg + (size_t)(64 * (j)) * QP + koff); sv0 = ldg8(vp_ + voff); sv1 = ldg8(vp_ + (size_t)32 * QP + voff); } while (0)
#define DF_WRITE(bf) do { *(ALAS bf16x8*)(K_lds + (bf) * SHM_K + kws) = sk0; *(ALAS bf16x8*)(V_lds + (bf) * SHM_V + vst0) = sv0; *(ALAS bf16x8*)(V_lds + (bf) * SHM_V + vst1) = sv1; } while (0)
#define DF_MASK(P0, P1, t) do { if (64 * (t) + 63 > R0) mask_gt(P0, P1, qm - 64 * (t)); } while (0)
#define DF_RESC(a) do { if (__any((a) < 1.f)) { if (hi == 0) al_l[r32] = (a); asm volatile("s_waitcnt lgkmcnt(0)" ::: "memory"); \
        _Pragma("unroll") for (int d_ = 0; d_ < 4; ++d_) _Pragma("unroll") for (int r = 0; r < 16; ++r) o[d_][r] *= al_l[crow(r, hi)]; } } while (0)
    float m_reg = -1e30f, l_reg = 0.f; f32x16 o[4] = {};
    f32x16 pA0, pA1, pB0, pB1; float alA = 1.f, alB = 1.f; bf16x8 pa0, pa1, pa2, pa3;
    DF_LOAD(0); DF_WRITE(0);
    __syncthreads();
    DF_LOAD(1);
    qkt64(pA0, pA1, K_lds, r32, hi, qr); DF_MASK(pA0, pA1, 0); partial_sm(pA0, pA1, m_reg, alA, hi);
    DF_WRITE(1);
    DF_RESC(alA);
    __syncthreads();
#define DF_HALF(PX0, PX1, alX, PY0, PY1, alY, t, KB, VB, SB, MORE) do { \
        SBAR(); qkt64(PX0, PX1, K_lds + (KB) * SHM_K, r32, hi, qr); \
        finish_sm(PY0, PY1, alY, l_reg, pa0, pa1, pa2, pa3, hi); SBAR(); \
        if (MORE) { DF_LOAD((t) + 1); SBAR(); } \
        pv_tile(o, vb0 + (VB) * SHM_V, pa0, pa1, pa2, pa3); DF_MASK(PX0, PX1, (t)); partial_sm(PX0, PX1, m_reg, alX, hi); \
        __syncthreads(); \
        if (MORE) DF_WRITE(SB); \
        DF_RESC(alX); __syncthreads(); } while (0)
    for (int t = 1; t + 1 < NT; t += 2) {
        DF_HALF(pB0, pB1, alB, pA0, pA1, alA, t, 1, 0, 0, true);
        DF_HALF(pA0, pA1, alA, pB0, pB1, alB, t + 1, 0, 1, 1, true);
    }
    DF_HALF(pB0, pB1, alB, pA0, pA1, alA, NT - 1, 1, 0, 0, false);
    finish_sm(pB0, pB1, alB, l_reg, pa0, pa1, pa2, pa3, hi); SBAR();
    pv_tile(o, vb0 + 1 * SHM_V, pa0, pa1, pa2, pa3);
#undef DF_LOAD
#undef DF_WRITE
#undef DF_MASK
#undef DF_RESC
#undef DF_HALF
    if (hi == 0) li_l[r32] = l_reg; asm volatile("s_waitcnt lgkmcnt(0)" ::: "memory");
    float rli[16];
#pragma unroll
    for (int r = 0; r < 16; ++r) rli[r] = __builtin_amdgcn_rcpf(li_l[crow(r, hi)]);
    if constexpr (!SECOND) {
        float* Sw = S1 + (size_t)R0 * OP; const unsigned ooff = (unsigned)(4 * hi * OP + r32);
#pragma unroll
        for (int r = 0; r < 16; ++r) { float* rowp = Sw + (size_t)((r & 3) + 8 * (r >> 2)) * OP;
#pragma unroll
            for (int d0 = 0; d0 < 4; ++d0) rowp[ooff + d0 * 32] = o[d0][r] * rli[r]; }
    } else {
        const float* Sw = S1 + (size_t)R0 * OP; bf16_t* Ow = Og + (size_t)R0 * OP; const unsigned ooff = (unsigned)(4 * hi * OP + r32);
        float gn[4];
#pragma unroll
        for (int d0 = 0; d0 < 4; ++d0) gn[d0] = gsub[d0 * 32 + r32] * gmul;
#pragma unroll
        for (int r = 0; r < 16; ++r) { const float* srow = Sw + (size_t)((r & 3) + 8 * (r >> 2)) * OP; bf16_t* orowp = Ow + (size_t)((r & 3) + 8 * (r >> 2)) * OP; float d[4]; float ss = 0.f;
#pragma unroll
            for (int d0 = 0; d0 < 4; ++d0) { d[d0] = srow[ooff + d0 * 32] - lam * (o[d0][r] * rli[r]); ss += d[d0] * d[d0]; }
            ss += __shfl_xor(ss, 1); ss += __shfl_xor(ss, 2); ss += __shfl_xor(ss, 4); ss += __shfl_xor(ss, 8); ss += __shfl_xor(ss, 16);
            const float rs = __builtin_amdgcn_rsqf(ss * (1.f / 128.f) + 1e-5f);
#pragma unroll
            for (int d0 = 0; d0 < 4; ++d0) { const float v = d[d0] * rs * gn[d0]; const float vn = __shfl_xor(v, 1);
                if ((r32 & 1) == 0) *(unsigned*)(orowp + (ooff + d0 * 32)) = cvtpk(v, vn); }
            if ((r & 1) == 1) asm volatile("" ::: "memory"); }
    }
    __syncthreads();
}
#undef SBAR
}

#define LAS __attribute__((address_space(3)))

#define XB_TMO      128
#define XB_XCNT(j)  (256  + 64 * (j))
#define XB_XSUB(j)  (1280 + 64 * (j))
#define XB_XGEN(j)  (2304 + 64 * (j))
#define XB_TOP      3328
#define XB_TOPGEN   3392
#define XCD_BAR_WORDS 3456
#define XB_SPIN_CAP (1u << 18)

__device__ __forceinline__ unsigned xb_ld(unsigned* p)              { return __hip_atomic_load(p, __ATOMIC_RELAXED, __HIP_MEMORY_SCOPE_AGENT); }
__device__ __forceinline__ unsigned xb_add(unsigned* p, unsigned v) { return __hip_atomic_fetch_add(p, v, __ATOMIC_RELAXED, __HIP_MEMORY_SCOPE_AGENT); }
__device__ __forceinline__ unsigned xb_xcc_id() { return (unsigned)__builtin_amdgcn_s_getreg((3 << 11) | 20) & 0xFu; }
#define XB_SPIN(cond, bar) do { unsigned _sp = 0; while (cond) { __builtin_amdgcn_s_sleep(1); \
    if ((++_sp & 255u) == 0u) { if (xb_ld(&(bar)[XB_TMO])) break; if (_sp > XB_SPIN_CAP) { atomicAdd(&(bar)[XB_TMO], 1u); break; } } } } while (0)

struct XcdBarrier {
    unsigned* bar; unsigned x;
    volatile LAS unsigned* st;
};

__device__ __forceinline__ XcdBarrier xcd_barrier_post(unsigned* bar, volatile LAS unsigned* st) {
    XcdBarrier b; b.bar = bar; b.x = xb_xcc_id(); b.st = st;
    if (threadIdx.x == 0) (void)xb_add(&bar[XB_XCNT(b.x)], 1u);
    return b;
}
__device__ __forceinline__ void xcd_barrier_complete(unsigned* bar, unsigned x, unsigned& nloc, unsigned& nx) {
    const unsigned G = gridDim.x * gridDim.y * gridDim.z;
    unsigned sum, cnt, mine, sp = 0u;
    for (;;) {
        sum = 0u; cnt = 0u; mine = 0u;
#pragma unroll
        for (unsigned j = 0; j < 16; ++j) { const unsigned c = xb_ld(&bar[XB_XCNT(j)]); sum += c; cnt += (c > 0u) ? 1u : 0u; mine = (j == x) ? c : mine; }
        if (sum == G) break;
        __builtin_amdgcn_s_sleep(1);
        if ((++sp & 255u) == 0u) { if (xb_ld(&bar[XB_TMO])) break; if (sp > XB_SPIN_CAP) { atomicAdd(&bar[XB_TMO], 1u); break; } }
    }
    nloc = mine > 0u ? mine : 1u; nx = cnt > 0u ? cnt : 1u;
}

__device__ __forceinline__ void xcd_barrier(const XcdBarrier& b) {
    asm volatile("s_waitcnt vmcnt(0)" ::: "memory");
    __syncthreads();
    if (threadIdx.x == 0) {
        unsigned* bar = b.bar;
        __builtin_amdgcn_s_waitcnt(0);
        unsigned nloc = b.st[0], nx = b.st[1];
        if (nloc == 0u) { xcd_barrier_complete(bar, b.x, nloc, nx); b.st[0] = nloc; b.st[1] = nx; }
        const unsigned old = xb_add(&bar[XB_XSUB(b.x)], 1u);
        const unsigned gen = old / nloc;
        if (old + 1u == (gen + 1u) * nloc) {
            __builtin_amdgcn_fence(__ATOMIC_RELEASE, "agent");
            asm volatile("s_waitcnt vmcnt(0)" ::: "memory");
            const unsigned og = xb_add(&bar[XB_TOP], 1u);
            const unsigned tg = og / nx;
            if (og + 1u == (tg + 1u) * nx) xb_add(&bar[XB_TOPGEN], 1u);
            else XB_SPIN(xb_ld(&bar[XB_TOPGEN]) == tg, bar);
            __builtin_amdgcn_fence(__ATOMIC_ACQUIRE, "agent");
            xb_add(&bar[XB_XGEN(b.x)], 1u);
            asm volatile("s_waitcnt vmcnt(0)" ::: "memory");
        } else {
            XB_SPIN(xb_ld(&bar[XB_XGEN(b.x)]) == gen, bar);
            __builtin_amdgcn_fence(__ATOMIC_ACQUIRE, "agent");
            asm volatile("s_waitcnt vmcnt(0)" ::: "memory");
        }
    }
    __syncthreads();
}

constexpr int NWAVES = 8;
constexpr int NTOK = 16384, DM = 2048, SEQ = 2048, NHEAD = 16, NLAYER = 4, NEXP = 16, DEXP = 1024;
constexpr int XS_ROWS = 36864;
constexpr float LN_EPS = 1e-5f;
constexpr float DN_ALPHA = 1.6817928305074292f;
constexpr float LOG2E = 1.4426950408889634f;
constexpr float SB_QSCALE = 0.08838834764831845f * LOG2E;
constexpr float DF_QSCALE = 0.125f * LOG2E;
#ifndef MK_MULTI
#define MK_MULTI 0
#endif
#ifndef MOE_F8
#define MOE_F8 1
#endif
constexpr int NSTEPS = 1 + 8 * NLAYER;

constexpr size_t MiB = 1u << 20;
constexpr size_t WS_CTL = 0, CTL_ZERO_BYTES = 64 * 1024;
constexpr size_t WS_COS = 1 * MiB, WS_SIN = WS_COS + 256 * 1024;
constexpr size_t WS_WR = 2 * MiB;
constexpr size_t WS_CNT = 3 * MiB;
constexpr size_t WS_RE = WS_CNT + 64 * 1024;
constexpr size_t WS_RW = WS_RE + 64 * 1024;
constexpr size_t WS_RP = WS_RW + 128 * 1024;
constexpr size_t WS_WQKVA = 4 * MiB;
constexpr size_t WS_WOA = WS_WQKVA + 48 * MiB;
constexpr size_t WS_WQKVB = WS_WOA + 16 * MiB;
constexpr size_t WS_WOB = WS_WQKVB + 32 * MiB;
constexpr size_t WS_WGU = WS_WOB + 16 * MiB;
constexpr size_t WS_WDN = WS_WGU + 512 * MiB;
constexpr size_t WS_H = WS_WDN + 256 * MiB;
constexpr size_t WS_HB = WS_H + 128 * MiB;
constexpr size_t WS_QKV = WS_HB + 64 * MiB;
constexpr size_t WS_OB = WS_QKV + 192 * MiB;
constexpr size_t WS_XS = WS_OB + 64 * MiB;
constexpr size_t WS_ACT = WS_XS + 144 * MiB;
constexpr size_t WS_YD = WS_ACT + 72 * MiB;
constexpr size_t WS_END = WS_YD + 144 * MiB;
static_assert(WS_END <= (size_t)2040 * MiB, "workspace map");
constexpr int CW_BAR = 1024;
constexpr int LDS_BYTES = 147456;
constexpr int LDSCTL_OFF = 145408;
constexpr int RING_OFF = 0;

#define GAS __attribute__((address_space(1)))
typedef unsigned short bf16;
typedef unsigned v4u __attribute__((ext_vector_type(4)));
typedef unsigned v2u __attribute__((ext_vector_type(2)));
typedef float f32x4 __attribute__((ext_vector_type(4)));
typedef float f32x2 __attribute__((ext_vector_type(2)));
#define LDS_WAIT() asm volatile("s_waitcnt lgkmcnt(0)" ::: "memory")
#define VM_WAIT() asm volatile("s_waitcnt vmcnt(0)" ::: "memory")
__device__ __forceinline__ unsigned pk2(float lo, float hi) { unsigned r; asm volatile("v_cvt_pk_bf16_f32 %0, %1, %2" : "=v"(r) : "v"(lo), "v"(hi)); return r; }
__device__ __forceinline__ int opq_tid() { int t = threadIdx.x; asm volatile("" : "+v"(t)); return t; }
__device__ __forceinline__ float dpp_sum(float v) {
    v += __builtin_bit_cast(float, __builtin_amdgcn_update_dpp(0, __builtin_bit_cast(int, v), 0xB1, 0xf, 0xf, true));
    v += __builtin_bit_cast(float, __builtin_amdgcn_update_dpp(0, __builtin_bit_cast(int, v), 0x4E, 0xf, 0xf, true));
    v += __builtin_bit_cast(float, __builtin_amdgcn_update_dpp(0, __builtin_bit_cast(int, v), 0x141, 0xf, 0xf, true));
    v += __builtin_bit_cast(float, __builtin_amdgcn_update_dpp(0, __builtin_bit_cast(int, v), 0x140, 0xf, 0xf, true));
    const int b = __builtin_bit_cast(int, v);
    const float s0 = __builtin_bit_cast(float, __builtin_amdgcn_readlane(b, 0)), s1 = __builtin_bit_cast(float, __builtin_amdgcn_readlane(b, 16));
    const float s2 = __builtin_bit_cast(float, __builtin_amdgcn_readlane(b, 32)), s3 = __builtin_bit_cast(float, __builtin_amdgcn_readlane(b, 48));
    return (s0 + s1) + (s2 + s3);
}
__device__ __forceinline__ float wave_sum(float v) {
#pragma unroll
    for (int o = 1; o < 64; o <<= 1) v += __shfl_xor(v, o);
    return v;
}

struct Args { const float* in[17]; float* out; unsigned char* ws; int s_lo, s_hi; };

__device__ __forceinline__ int map_row(int n, int mode) {
    if (mode == 0) return n;
    if (mode == 1) { const int c = n & 255, blk = c >> 6, d = c & 63; return (n & ~255) + ((d >> 5) << 7) + (blk << 5) + (d & 31); }
    return ((n >> 7) << 8) + (n & 127) + (mode == 3 ? 128 : 0);
}
__device__ __forceinline__ void cvt_item(const float* __restrict__ src, int pitch, int K, bf16* __restrict__ dst, int mode, int k0, int n0, LAS float* scr, int lane) {
    const int kr = lane >> 4, n4 = (lane & 15) * 4;
    f32x4 v[16];
#pragma unroll
    for (int i = 0; i < 16; ++i) v[i] = __builtin_nontemporal_load((const f32x4*)(src + (size_t)(k0 + 4 * i + kr) * pitch + n0 + n4));
#pragma unroll
    for (int i = 0; i < 16; ++i) { LAS float* s = scr + (4 * i + kr) * 65 + n4; s[0] = v[i][0]; s[1] = v[i][1]; s[2] = v[i][2]; s[3] = v[i][3]; }
    LDS_WAIT();
    const int c = lane & 7;
#pragma unroll
    for (int j = 0; j < 8; ++j) { const int nl = (lane >> 3) + 8 * j; const int row = map_row(n0 + nl, mode);
        const LAS float* s = scr + (8 * c) * 65 + nl;
        v4u o; o.x = pk2(s[0], s[65]); o.y = pk2(s[130], s[195]); o.z = pk2(s[260], s[325]); o.w = pk2(s[390], s[455]);
        *(v4u*)(dst + (size_t)row * K + k0 + 8 * c) = o; }
    LDS_WAIT();
}

__device__ __forceinline__ void cvt_item8(const float* __restrict__ src, int pitch, int K, unsigned char* __restrict__ dst, int mode, int k0, int n0, float scale, LAS float* scr, int lane) {
    const int kr = lane >> 4, n4 = (lane & 15) * 4;
    f32x4 v[16];
#pragma unroll
    for (int i = 0; i < 16; ++i) v[i] = __builtin_nontemporal_load((const f32x4*)(src + (size_t)(k0 + 4 * i + kr) * pitch + n0 + n4));
#pragma unroll
    for (int i = 0; i < 16; ++i) { LAS float* s = scr + (4 * i + kr) * 65 + n4; s[0] = v[i][0] * scale; s[1] = v[i][1] * scale; s[2] = v[i][2] * scale; s[3] = v[i][3] * scale; }
    LDS_WAIT();
    const int c = lane & 3;
#pragma unroll
    for (int j = 0; j < 4; ++j) { const int nl = (lane >> 2) + 16 * j; const int row = map_row(n0 + nl, mode);
        const LAS float* s = scr + (16 * c) * 65 + nl;
        v4u o; o.x = pg8::pack4_fp8(s[0], s[65], s[130], s[195]); o.y = pg8::pack4_fp8(s[260], s[325], s[390], s[455]);
        o.z = pg8::pack4_fp8(s[520], s[585], s[650], s[715]); o.w = pg8::pack4_fp8(s[780], s[845], s[910], s[975]);
        *(v4u*)(dst + (size_t)row * K + k0 + 16 * c) = o; }
    LDS_WAIT();
}

__global__ void __launch_bounds__(NWAVES * 64, 2) yoco_fwd(Args args) {
    extern __shared__ __attribute__((aligned(16))) unsigned char lds_raw[];
    LAS unsigned char* const lds = (LAS unsigned char*)lds_raw;
    const int tid = threadIdx.x, lane = tid & 63, wave = __builtin_amdgcn_readfirstlane(tid >> 6);
    const int G = gridDim.x, bx = blockIdx.x;
    const int vcu = (G % 8 == 0) ? (bx % 8) * (G / 8) + bx / 8 : bx;
    unsigned char* const ws = args.ws;
    volatile LAS unsigned* const CTL = (volatile LAS unsigned*)(lds + LDSCTL_OFF);
    LAS int* const TAB = (LAS int*)(lds + LDSCTL_OFF + 64);
    for (int u = tid; u < (LDS_BYTES - LDSCTL_OFF) / 4; u += NWAVES * 64) ((LAS unsigned*)(lds + LDSCTL_OFF))[u] = 0u;
    __syncthreads();
    const int s_lo = args.s_lo, s_hi = args.s_hi;
    XcdBarrier bar; bar.bar = (unsigned*)(ws + WS_CTL) + CW_BAR; bar.x = 0; bar.st = nullptr;
    if (s_hi - s_lo > 1) bar = xcd_barrier_post((unsigned*)(ws + WS_CTL) + CW_BAR, CTL);
#ifndef PH_MASK
#define PH_MASK 0xFFFF
#endif
#define PHM(b) (((PH_MASK) >> (b)) & 1)
#ifndef PROBE_DUP
#define PROBE_DUP 0
#endif
#define PREP(b) _Pragma("unroll 1") for (int rep_ = 0; rep_ < ((((PROBE_DUP) >> (b)) & 1) ? 2 : 1); ++rep_)
#define IN(k) (s_lo <= (k) && (k) < s_hi)
#define SEAM(k) do { if ((k) + 1 < s_hi) xcd_barrier(bar); } while (0)

    const float* const x_in = args.in[0];
    float* const H = (float*)(ws + WS_H); bf16* const HB = (bf16*)(ws + WS_HB); bf16* const QKV = (bf16*)(ws + WS_QKV); bf16* const OB = (bf16*)(ws + WS_OB);
    bf16* const XS = (bf16*)(ws + WS_XS); float* const S1 = (float*)(ws + WS_XS); bf16* const ACT = (bf16*)(ws + WS_ACT); bf16* const YD = (bf16*)(ws + WS_YD);
    float* const COS = (float*)(ws + WS_COS); float* const SIN = (float*)(ws + WS_SIN); float* const WR = (float*)(ws + WS_WR);
    int* const CNT = (int*)(ws + WS_CNT); unsigned* const RE = (unsigned*)(ws + WS_RE); f32x2* const RW = (f32x2*)(ws + WS_RW); int* const RP = (int*)(ws + WS_RP);

    if (IN(0) && PHM(0)) { PREP(0) {
        const int tid = opq_tid(), lane = tid & 63;
        LAS float* scr = (LAS float*)(lds + RING_OFF + wave * 16640);
        const int gw = vcu * NWAVES + wave, NGW = G * NWAVES;
        constexpr int I0 = 2 * 3072, I1 = 8 * 1024, I2 = 128 * 512, I3 = 64 * 512, NITEMS = I0 + I1 + I2 + I3;
        for (int it = gw; it < NITEMS; it += NGW) {
            int r = it;
            if (r < I0) { const int job = r / 3072; r -= job * 3072; const int kb = r / 96, nb = r - kb * 96;
                cvt_item(args.in[1] + (size_t)job * 2048 * 6144, 6144, 2048, (bf16*)(ws + WS_WQKVA) + (size_t)job * 6144 * 2048, 0, kb * 64, nb * 64, scr, lane); continue; }
            r -= I0;
            if (r < I1) { const int job = r >> 10; r &= 1023; const int kb = r >> 5, nb = r & 31;
                const float* src; int pitch = 2048, mode = 0; bf16* dst;
                if (job < 2) { src = args.in[2] + (size_t)job * 2048 * 2048; dst = (bf16*)(ws + WS_WOA) + (size_t)job * 2048 * 2048; }
                else if (job == 2) { src = args.in[4]; dst = (bf16*)(ws + WS_WQKVB); mode = 1; }
                else if (job == 3) { src = args.in[3]; pitch = 4096; dst = (bf16*)(ws + WS_WQKVB) + (size_t)2048 * 2048; mode = 1; }
                else if (job == 4) { src = args.in[3] + 2048; pitch = 4096; dst = (bf16*)(ws + WS_WQKVB) + (size_t)4096 * 2048; }
                else if (job == 5) { src = args.in[4] + (size_t)2048 * 2048; dst = (bf16*)(ws + WS_WQKVB) + (size_t)6144 * 2048; mode = 1; }
                else { src = args.in[5] + (size_t)(job - 6) * 2048 * 2048; dst = (bf16*)(ws + WS_WOB) + (size_t)(job - 6) * 2048 * 2048; }
                cvt_item(src, pitch, 2048, dst, mode, kb * 64, nb * 64, scr, lane); continue; }
            r -= I1;
            if (r < I2) { const int job = r >> 9; r &= 511; const int kb = r >> 4, nb = r & 15; const int le = job >> 1, up = job & 1;
#if MOE_F8
                cvt_item8((up ? args.in[15] : args.in[14]) + (size_t)le * 2048 * 1024, 1024, 2048, (unsigned char*)(ws + WS_WGU) + (size_t)le * 2048 * 2048, 2 + up, kb * 64, nb * 64, pg8::W8_SCALE, scr, lane); continue; }
#else
                cvt_item((up ? args.in[15] : args.in[14]) + (size_t)le * 2048 * 1024, 1024, 2048, (bf16*)(ws + WS_WGU) + (size_t)le * 2048 * 2048, 2 + up, kb * 64, nb * 64, scr, lane); continue; }
#endif
            r -= I2;
            { const int le = r >> 9; r &= 511; const int kb = r >> 5, nb = r & 31;
#if MOE_F8
                cvt_item8(args.in[16] + (size_t)le * 1024 * 2048, 2048, 1024, (unsigned char*)(ws + WS_WDN) + (size_t)le * 2048 * 1024, 0, kb * 64, nb * 64, pg8::W8_SCALE, scr, lane); }
#else
                cvt_item(args.in[16] + (size_t)le * 1024 * 2048, 2048, 1024, (bf16*)(ws + WS_WDN) + (size_t)le * 2048 * 1024, 0, kb * 64, nb * 64, scr, lane); }
#endif
        }
        for (size_t i = (size_t)gw * 64 + lane; i < (size_t)NTOK * DM / 4; i += (size_t)NGW * 64) {
            const f32x4 v = __builtin_nontemporal_load((const f32x4*)x_in + i); ((f32x4*)H)[i] = v;
            v2u o; o.x = pk2(v[0], v[1]); o.y = pk2(v[2], v[3]); ((v2u*)HB)[i] = o; }
        for (int i = bx * (NWAVES * 64) + tid; i < 2048 * 32; i += G * NWAVES * 64) { const int pos = i >> 5, f = i & 31;
            const float inv = __builtin_amdgcn_exp2f(-(float)f * 0.4152410118609203f); const float ang = (float)pos * inv;
            const double tr = (double)ang * 0.15915494309189535; const float fr = (float)(tr - __builtin_rint(tr));
            COS[i] = __builtin_amdgcn_cosf(fr); SIN[i] = __builtin_amdgcn_sinf(fr); }
        for (int i = bx * (NWAVES * 64) + tid; i < NLAYER * 20 * 2048; i += G * NWAVES * 64) { const int k = i & 2047, c = (i >> 11) % 20, l = i / (20 * 2048);
            WR[i] = c < 4 ? args.in[12][((size_t)l * 2048 + k) * 4 + c] : args.in[13][(((size_t)l * 4 + ((c - 4) >> 2)) * 2048 + k) * 4 + ((c - 4) & 3)]; }
        }
        SEAM(0);
    }

    for (int L = 0; L < NLAYER; ++L) {
        const int sb = 1 + 8 * L; const bool typeA = L < 2;
        if (IN(sb + 0)) {
            if (typeA && PHM(1)) { PREP(1) {
                pg8::Gemm g{HB, (const bf16*)(ws + WS_WQKVA) + (size_t)L * 6144 * 2048, NTOK, 6144, DM}; pg8::StaticOrder S; S.init(NTOK, 6144, G, bx);
                pg8::EpiQkv E{QKV, 6144, 2048, SB_QSCALE};
                pg8::gemm_phase<pg8::EpiQkv, pg8::StaticOrder, true, true>(lds + RING_OFF, g, S, E); }
            } else if (!typeA && PHM(2)) { PREP(2) {
                const int N = (L == 2) ? 6144 : 2048;
                pg8::Gemm g{HB, (const bf16*)(ws + WS_WQKVB) + (L == 2 ? (size_t)0 : (size_t)6144 * 2048), NTOK, N, DM}; pg8::StaticOrder S; S.init(NTOK, N, G, bx);
                pg8::EpiRope E{QKV, 6144, 2048, 4096, DF_QSCALE, COS, SIN};
                pg8::gemm_phase<pg8::EpiRope, pg8::StaticOrder, true, true>(lds + RING_OFF, g, S, E); }
            }
            SEAM(sb + 0);
        }
        if (IN(sb + 1)) {
            if (typeA && PHM(3)) {
                for (int id_ = vcu; id_ < 512 * (1 + ((PROBE_DUP >> 3) & 1)); id_ += G) { const int id = id_ & 511; const int bh = id >> 2, p = id & 3, b = bh >> 4, h = bh & 15;
                    const bf16* Qg = QKV + (size_t)b * SEQ * 6144 + h * 128; bf16* Og = OB + (size_t)b * SEQ * DM + h * 128;
                    att::sb_block(Qg, Qg + 2048, Qg + 4096, Og, 7 - p, (att::ldsp)(lds + RING_OFF));
                    att::sb_block(Qg, Qg + 2048, Qg + 4096, Og, p, (att::ldsp)(lds + RING_OFF)); }
            } else if (!typeA && PHM(4)) {
                const int lane = opq_tid() & 63;
                const int i = L - 2; const float lam_init = (L == 2) ? 0.47071301834264183f : 0.5560582041556061f;
                const float* lp = args.in[6] + (size_t)i * 256;
                const float sa = wave_sum(lp[lane] * lp[64 + lane]), sb2 = wave_sum(lp[128 + lane] * lp[192 + lane]);
                const float lam = __builtin_amdgcn_exp2f(sa * LOG2E) - __builtin_amdgcn_exp2f(sb2 * LOG2E) + lam_init;
                const float* gsub = args.in[7] + (size_t)i * 128; const float gmul = 1.f - lam_init;
                for (int id_ = vcu; id_ < 512 * (1 + ((PROBE_DUP >> 4) & 1)); id_ += G) { const int id = id_ & 511; const int bh = id >> 2, p = id & 3, b = bh >> 4, h = bh & 15;
                    const bf16* Qg = QKV + (size_t)b * SEQ * 6144 + h * 128; bf16* Og = OB + (size_t)b * SEQ * DM + h * 128; float* Sg = S1 + (size_t)b * SEQ * DM + h * 128;
#pragma unroll 1
                    for (int w = 0; w < 2; ++w) { const int qb = w ? p : 7 - p;
                        att::diff_pass<false>(Qg, Qg + 2048, Qg + 4096, Sg, Og, qb, lam, gsub, gmul, (att::ldsp)(lds + RING_OFF));
                        att::diff_pass<true>(Qg + 64, Qg + 2048 + 64, Qg + 4096, Sg, Og, qb, lam, gsub, gmul, (att::ldsp)(lds + RING_OFF)); } }
            }
            SEAM(sb + 1);
        }
        if (IN(sb + 2)) { if (PHM(5)) {
            pg8::Gemm g{OB, (const bf16*)(ws + (typeA ? WS_WOA : WS_WOB)) + (size_t)(L & 1) * 2048 * 2048, NTOK, DM, DM}; pg8::StaticOrder S; S.init(NTOK, DM, G, bx);
            if ((PROBE_DUP >> 5) & 1) { pg8::EpiResid E2{S1, DM, DN_ALPHA}; pg8::gemm_phase<pg8::EpiResid, pg8::StaticOrder, true, true>(lds + RING_OFF, g, S, E2); }
            pg8::EpiResid E{H, DM, DN_ALPHA};
            pg8::gemm_phase<pg8::EpiResid, pg8::StaticOrder, true, true>(lds + RING_OFF, g, S, E); }
            SEAM(sb + 2);
        }
        if (IN(sb + 3)) { if (PHM(6)) {
            const int tid = opq_tid(), lane = tid & 63;
            const float* lng = args.in[8] + (size_t)L * DM; const float* lnb = args.in[9] + (size_t)L * DM; const float* wr = WR + (size_t)L * 20 * 2048;
            LAS int* eid = (LAS int*)(lds + RING_OFF);
            LAS float* lgt = (LAS float*)(lds + RING_OFF + 2048);
            for (int c = bx; c < 256; c += G) {
#pragma unroll 1
                for (int grp = 0; grp < 2; ++grp) {
                    const int rloc = wave * 8 + grp * 4; const size_t row0 = (size_t)64 * c + rloc;
                    f32x4 v[4][8]; float mu[4], rstd[4];
#pragma unroll
                    for (int rr = 0; rr < 4; ++rr) { const f32x4* hp = (const f32x4*)(H + (row0 + rr) * DM) + lane;
#pragma unroll
                        for (int j = 0; j < 8; ++j) v[rr][j] = hp[64 * j]; }
#pragma unroll
                    for (int rr = 0; rr < 4; ++rr) { float s = 0.f;
#pragma unroll
                        for (int j = 0; j < 8; ++j) s += (v[rr][j][0] + v[rr][j][1]) + (v[rr][j][2] + v[rr][j][3]);
                        mu[rr] = dpp_sum(s) * (1.f / DM); float q = 0.f;
#pragma unroll
                        for (int j = 0; j < 8; ++j) { const f32x4 d = v[rr][j] - mu[rr]; q += (d[0] * d[0] + d[1] * d[1]) + (d[2] * d[2] + d[3] * d[3]); }
                        rstd[rr] = 1.f / sqrtf(dpp_sum(q) * (1.f / DM) + LN_EPS); }
#pragma unroll
                    for (int j = 0; j < 8; ++j) { const f32x4 gg = ((const f32x4*)lng)[64 * j + lane], bb = ((const f32x4*)lnb)[64 * j + lane];
#pragma unroll
                        for (int rr = 0; rr < 4; ++rr) { v[rr][j] = (v[rr][j] - mu[rr]) * rstd[rr] * gg + bb; ((f32x4*)(H + (row0 + rr) * DM))[64 * j + lane] = v[rr][j]; } }
#pragma unroll 1
                    for (int cc = 0; cc < 20; ++cc) { const f32x4* wp = (const f32x4*)(wr + cc * 2048) + lane; float a[4] = {0.f, 0.f, 0.f, 0.f};
#pragma unroll
                        for (int j = 0; j < 8; ++j) { const f32x4 w = wp[64 * j];
#pragma unroll
                            for (int rr = 0; rr < 4; ++rr) a[rr] += (v[rr][j][0] * w[0] + v[rr][j][1] * w[1]) + (v[rr][j][2] * w[2] + v[rr][j][3] * w[3]); }
#pragma unroll
                        for (int rr = 0; rr < 4; ++rr) a[rr] = dpp_sum(a[rr]);
                        if (lane == 0) { lgt[rloc * 20 + cc] = a[0]; lgt[(rloc + 1) * 20 + cc] = a[1]; lgt[(rloc + 2) * 20 + cc] = a[2]; lgt[(rloc + 3) * 20 + cc] = a[3]; } }
                }
                LDS_WAIT();
                if (lane < 8) {
                    const int rl = wave * 8 + lane; const LAS float* lg = lgt + rl * 20;
                    int gsel = 0; float gm = lg[0];
#pragma unroll
                    for (int i = 1; i < 4; ++i) { const float x = lg[i]; if (x > gm) { gm = x; gsel = i; } }
                    float gden = 0.f;
#pragma unroll
                    for (int i = 0; i < 4; ++i) gden += __builtin_amdgcn_exp2f((lg[i] - gm) * LOG2E);
                    const float gw_ = 1.f / gden;
                    const LAS float* li = lg + 4 + 4 * gsel;
                    const float l0 = li[0], l1 = li[1], l2 = li[2], l3 = li[3];
                    int i0 = 0; float v0 = l0;
                    if (l1 > v0) { v0 = l1; i0 = 1; } if (l2 > v0) { v0 = l2; i0 = 2; } if (l3 > v0) { v0 = l3; i0 = 3; }
                    int i1 = -1; float v1 = 0.f;
                    if (i0 != 0) { v1 = l0; i1 = 0; }
                    if (i0 != 1 && (i1 < 0 || l1 > v1)) { v1 = l1; i1 = 1; }
                    if (i0 != 2 && (i1 < 0 || l2 > v1)) { v1 = l2; i1 = 2; }
                    if (i0 != 3 && (i1 < 0 || l3 > v1)) { v1 = l3; i1 = 3; }
                    const float t = __builtin_amdgcn_exp2f((v1 - v0) * LOG2E); const float w0 = gw_ / (1.f + t), w1 = gw_ * t / (1.f + t);
                    eid[2 * rl] = gsel * 4 + i0; eid[2 * rl + 1] = gsel * 4 + i1; RW[(size_t)64 * c + rl] = (f32x2){w0, w1};
                }
                __syncthreads();
                if (wave == 0) {
                    const int ea = eid[lane], eb = eid[64 + lane]; int ra = 0, rb = 0, cnt = 0; const unsigned long long lt = (1ull << lane) - 1ull;
#pragma unroll
                    for (int e = 0; e < 16; ++e) { const unsigned long long ma = __ballot(ea == e), mb = __ballot(eb == e);
                        if (ea == e) ra = __popcll(ma & lt); if (eb == e) rb = __popcll(ma) + __popcll(mb & lt); if (lane == e) cnt = __popcll(ma) + __popcll(mb); }
                    if (lane < 16) CNT[c * 16 + lane] = cnt;
                    LAS int* rk = (LAS int*)(lds + RING_OFF + 1024); rk[lane] = ra; rk[64 + lane] = rb; LDS_WAIT();
                    const int r = lane; const unsigned word = (unsigned)eid[2 * r] | ((unsigned)eid[2 * r + 1] << 8) | ((unsigned)rk[2 * r] << 16) | ((unsigned)rk[2 * r + 1] << 24);
                    RE[(size_t)64 * c + r] = word;
                }
                __syncthreads();
            } }
            SEAM(sb + 3);
        }
        if ((IN(sb + 4) || IN(sb + 5) || IN(sb + 6)) && PHM(7)) {
            const int tid = opq_tid();
            LAS int* part = (LAS int*)(lds + RING_OFF);
            { const int e = tid & 15, s = tid >> 4; int a = 0;
#pragma unroll
              for (int i = 0; i < 8; ++i) a += CNT[(8 * s + i) * 16 + e];
              part[s * 16 + e] = a; }
            __syncthreads();
            if (tid < 16) { int run = 0;
#pragma clang loop vectorize(disable) unroll(disable)
                for (int s = 0; s < 32; ++s) run += part[s * 16 + tid];
                TAB[tid] = run; }
            __syncthreads();
            if (tid == 0) { int off = 0, mt = 0;
#pragma clang loop vectorize(disable) unroll(disable)
                for (int e = 0; e < 16; ++e) { TAB[16 + e] = off; const int nt = (TAB[e] + 255) >> 8;
#pragma clang loop vectorize(disable) unroll(disable)
                    for (int i = 0; i < nt; ++i) TAB[64 + mt++] = e;
                    off += nt * 256; }
                TAB[32] = off; TAB[33] = mt; }
            __syncthreads();
        }
        if (IN(sb + 4)) { if (PHM(7)) PREP(7) {
            const int tid = opq_tid(), lane = tid & 63;
            LAS int* part = (LAS int*)(lds + RING_OFF);
            for (int c = bx; c < 256; c += G) {
                if (tid < 16) { int pre = 0;
#pragma clang loop vectorize(disable) unroll(disable)
                    for (int s = 0; s < (c >> 3); ++s) pre += part[s * 16 + tid];
#pragma clang loop vectorize(disable) unroll(disable)
                    for (int cc = c & ~7; cc < c; ++cc) pre += CNT[cc * 16 + tid];
                    TAB[48 + tid] = TAB[16 + tid] + pre; }
                __syncthreads();
#pragma unroll 1
                for (int rr = 0; rr < 8; ++rr) { const size_t row = (size_t)64 * c + wave * 8 + rr; const unsigned word = RE[row];
                    const int p0 = TAB[48 + (word & 255)] + ((word >> 16) & 255), p1 = TAB[48 + ((word >> 8) & 255)] + (word >> 24);
                    if (lane == 0) { RP[2 * row] = p0; RP[2 * row + 1] = p1; }
#if MOE_F8
                    const f32x4* hp = (const f32x4*)(H + row * DM) + lane; unsigned* o0 = (unsigned*)((unsigned char*)XS + (size_t)p0 * DM) + lane; unsigned* o1 = (unsigned*)((unsigned char*)XS + (size_t)p1 * DM) + lane;
#pragma unroll
                    for (int j = 0; j < 8; ++j) { const f32x4 v = hp[64 * j]; const unsigned o = pg8::pack4_fp8(v[0], v[1], v[2], v[3]); o0[64 * j] = o; o1[64 * j] = o; } }
#else
                    const f32x4* hp = (const f32x4*)(H + row * DM) + lane; v2u* o0 = (v2u*)(XS + (size_t)p0 * DM) + lane; v2u* o1 = (v2u*)(XS + (size_t)p1 * DM) + lane;
#pragma unroll
                    for (int j = 0; j < 8; ++j) { const f32x4 v = hp[64 * j]; v2u o; o.x = pk2(v[0], v[1]); o.y = pk2(v[2], v[3]); o0[64 * j] = o; o1[64 * j] = o; } }
#endif
                __syncthreads();
            } }
            SEAM(sb + 4);
        }
        if (IN(sb + 5)) { if (PHM(8)) PREP(8) {
#if MOE_F8
            pg8::Gemm g{XS, (const bf16*)(ws + WS_WGU + (size_t)L * 16 * 2048 * 2048), XS_ROWS, 2048, DM / 2};
            pg8::MoeOrder S{TAB[33] * 8, G, bx, TAB + 64}; pg8::EpiGateUp8 E{(unsigned char*)ACT};
            pg8::gemm_phase<pg8::EpiGateUp8, pg8::MoeOrder, true, true, true>(lds + RING_OFF, g, S, E); }
#else
            pg8::Gemm g{XS, (const bf16*)(ws + WS_WGU) + (size_t)L * 16 * 2048 * 2048, XS_ROWS, 2048, DM};
            pg8::MoeOrder S{TAB[33] * 8, G, bx, TAB + 64}; pg8::EpiGateUp E{ACT};
            pg8::gemm_phase<pg8::EpiGateUp, pg8::MoeOrder, true, true>(lds + RING_OFF, g, S, E); }
#endif
            SEAM(sb + 5);
        }
        if (IN(sb + 6)) { if (PHM(9)) PREP(9) {
#if MOE_F8
            pg8::Gemm g{ACT, (const bf16*)(ws + WS_WDN + (size_t)L * 16 * 2048 * 1024), XS_ROWS, 2048, DEXP / 2};
            pg8::MoeOrder S{TAB[33] * 8, G, bx, TAB + 64}; pg8::EpiDown8 E{YD};
            pg8::gemm_phase<pg8::EpiDown8, pg8::MoeOrder, true, true, true>(lds + RING_OFF, g, S, E); }
#else
            pg8::Gemm g{ACT, (const bf16*)(ws + WS_WDN) + (size_t)L * 16 * 2048 * 1024, XS_ROWS, 2048, DEXP};
            pg8::MoeOrder S{TAB[33] * 8, G, bx, TAB + 64}; pg8::EpiDown E{YD};
            pg8::gemm_phase<pg8::EpiDown, pg8::MoeOrder, true, true>(lds + RING_OFF, g, S, E); }
#endif
            SEAM(sb + 6);
        }
        if (IN(sb + 7)) { if (PHM(10)) for (int rep_ = 0; rep_ < ((((PROBE_DUP) >> 10) & 1) && L == NLAYER - 1 ? 5 : 1); ++rep_) {
            const int tid = opq_tid(), lane = tid & 63;
            const float* lng = args.in[10] + (size_t)L * DM; const float* lnb = args.in[11] + (size_t)L * DM; const bool last = (L == NLAYER - 1);
            const int gw = vcu * NWAVES + wave, NGW = G * NWAVES;
            for (int row = gw; row < NTOK; row += NGW) {
                const int p0 = RP[2 * row], p1 = RP[2 * row + 1]; const f32x2 w = RW[row];
                const f32x4* hp = (const f32x4*)(H + (size_t)row * DM) + lane; const v2u* y0 = (const v2u*)(YD + (size_t)p0 * DM) + lane; const v2u* y1 = (const v2u*)(YD + (size_t)p1 * DM) + lane;
                f32x4 v[8]; float s = 0.f;
#pragma unroll
                for (int j = 0; j < 8; ++j) { const f32x4 h = hp[64 * j]; const v2u a = y0[64 * j], b = y1[64 * j];
                    const f32x4 fa = {__uint_as_float(a.x << 16), __uint_as_float(a.x & 0xffff0000u), __uint_as_float(a.y << 16), __uint_as_float(a.y & 0xffff0000u)};
                    const f32x4 fb = {__uint_as_float(b.x << 16), __uint_as_float(b.x & 0xffff0000u), __uint_as_float(b.y << 16), __uint_as_float(b.y & 0xffff0000u)};
                    v[j] = h * DN_ALPHA + fa * w.x + fb * w.y; s += (v[j][0] + v[j][1]) + (v[j][2] + v[j][3]); }
                const float mu = wave_sum(s) * (1.f / DM); float q = 0.f;
#pragma unroll
                for (int j = 0; j < 8; ++j) { const f32x4 d = v[j] - mu; q += (d[0] * d[0] + d[1] * d[1]) + (d[2] * d[2] + d[3] * d[3]); }
                const float rstd = 1.f / sqrtf(wave_sum(q) * (1.f / DM) + LN_EPS);
                f32x4* op = (f32x4*)((last ? args.out : H) + (size_t)row * DM) + lane; v2u* ob = (v2u*)(HB + (size_t)row * DM) + lane;
#pragma unroll
                for (int j = 0; j < 8; ++j) { const f32x4 gg = ((const f32x4*)lng)[64 * j + lane], bb = ((const f32x4*)lnb)[64 * j + lane];
                    const f32x4 y = (v[j] - mu) * rstd * gg + bb; op[64 * j] = y;
                    if (!last) { v2u o; o.x = pk2(y[0], y[1]); o.y = pk2(y[2], y[3]); ob[64 * j] = o; } }
            } }
            SEAM(sb + 7);
        }
    }
#undef IN
#undef SEAM
}

extern "C" void kernel_launch(void* const* d_in, const int* in_sizes, int n_in, void* d_out, int out_size, void* d_ws, size_t ws_size, hipStream_t stream) {
    static int grid = 0;
    if (grid == 0) {
        if (n_in != 17 || in_sizes[0] != NTOK * DM || out_size != NTOK * DM || ws_size < WS_END) { fprintf(stderr, "kernel_launch: unexpected shapes / workspace (n_in %d, ws %zu, need %zu)\n", n_in, ws_size, (size_t)WS_END); grid = -1; return; }
        int dev = 0, cus = 0, per_cu = 0;
        if (hipGetDevice(&dev) != hipSuccess || hipDeviceGetAttribute(&cus, hipDeviceAttributeMultiprocessorCount, dev) != hipSuccess) { grid = -1; return; }
        if (hipFuncSetAttribute((const void*)yoco_fwd, hipFuncAttributeMaxDynamicSharedMemorySize, LDS_BYTES) != hipSuccess) { fprintf(stderr, "kernel_launch: hipFuncSetAttribute failed\n"); grid = -1; return; }
        if (hipOccupancyMaxActiveBlocksPerMultiprocessor(&per_cu, (const void*)yoco_fwd, NWAVES * 64, LDS_BYTES) != hipSuccess || per_cu < 1) { fprintf(stderr, "kernel_launch: occupancy query says %d\n", per_cu); per_cu = 1; }
        (void)hipGetLastError();
        grid = cus;
    }
    if (grid < 0) return;
    (void)hipMemsetAsync((char*)d_ws + WS_CTL, 0, CTL_ZERO_BYTES, stream);
    Args a{};
    for (int i = 0; i < 17; ++i) a.in[i] = (const float*)d_in[i];
    a.out = (float*)d_out; a.ws = (unsigned char*)d_ws;
#if MK_MULTI
    for (int s = 0; s < NSTEPS; ++s) { a.s_lo = s; a.s_hi = s + 1; hipLaunchKernelGGL(yoco_fwd, dim3(grid), dim3(NWAVES * 64), LDS_BYTES, stream, a); }
#else
    a.s_lo = 0; a.s_hi = NSTEPS;
    hipLaunchKernelGGL(yoco_fwd, dim3(grid), dim3(NWAVES * 64), LDS_BYTES, stream, a);
#endif
    const hipError_t le = hipPeekAtLastError();
    if (le != hipSuccess) fprintf(stderr, "kernel_launch: launch failed: %s\n", hipGetErrorName(le));
}
```

```cpp
#include <hip/hip_runtime.h>
#include <cstdio>
#include <cstdint>

namespace pg8 {
#define PG8_LAS __attribute__((address_space(3)))
typedef unsigned short bf16_t;
typedef short bf16x8 __attribute__((ext_vector_type(8)));
typedef float f32x4 __attribute__((ext_vector_type(4)));
typedef unsigned u32x4 __attribute__((ext_vector_type(4)));
typedef int pg8_v8i __attribute__((ext_vector_type(8)));
constexpr int BM = 256, BK = 64, HALF = 128, HTB = HALF * BK * 2  , STAGE_BYTES = 8 * HTB, NXCD = 8, WGM = 8;

__host__ __device__ __forceinline__ int lds_byte(int r, int c) { const int st = (r >> 4) * 2 + (c >> 5), rr = r & 15, cc = c & 31, ob = rr * 64 + cc * 2; return st * 1024 + (ob ^ (((ob >> 9) & 1) << 5)); }
__host__ __device__ __forceinline__ void stage_rc(int b, int& R, int& C) { const int st = b / 1024, sb = b % 1024, swz = sb ^ (((sb >> 9) & 1) << 5); R = (st >> 1) * 16 + swz / 64; C = (st & 1) * 32 + (swz % 64) / 2; }
__host__ __device__ __forceinline__ int perm32(int rho) { const int n = rho >> 4, i = rho & 15; return 8 * (i >> 2) + 4 * n + (i & 3); }

struct Unit { int pm, pn; };
struct Gemm { const bf16_t* A; const bf16_t* Bt; int M, N, K; };

struct StaticOrder {
    int nM, nN, nwg, G, c;
    __host__ __device__ void init(int M, int N, int G_, int c_) { nM = M / BM; nN = N / BM; nwg = nM * nN; G = G_; c = c_; }
    __host__ __device__ bool next(int i, Unit& u) const {
        const long L = (long)i * G + c; if (L >= nwg) return false;
        int wgid = (int)L; { const int q = nwg / NXCD, r = nwg % NXCD, xcd = wgid % NXCD, off = wgid / NXCD; wgid = (xcd < r ? xcd * (q + 1) : r * (q + 1) + (xcd - r) * q) + off; }
        const int nig = WGM * nN, gid = wgid / nig, fm = gid * WGM, gsz = (nM - fm) < WGM ? (nM - fm) : WGM;
        u.pm = fm + ((wgid % nig) % gsz); u.pn = (wgid % nig) / gsz; return true;
    }
    __device__ __forceinline__ void a_ready(const Unit&) const {}
    __device__ __forceinline__ void done(const Unit&) const {}
};

__device__ __forceinline__ unsigned cvt_pk_bf16(float lo, float hi) { unsigned r; asm volatile("v_cvt_pk_bf16_f32 %0, %1, %2" : "=v"(r) : "v"(lo), "v"(hi)); return r; }
typedef float f32x2 __attribute__((ext_vector_type(2)));

typedef unsigned u32x2 __attribute__((ext_vector_type(2)));
__device__ __forceinline__ u32x4 pack8_bf16(const f32x4 a, const f32x4 b) { u32x4 w; w.x = cvt_pk_bf16(a[0], a[1]); w.y = cvt_pk_bf16(a[2], a[3]); w.z = cvt_pk_bf16(b[0], b[1]); w.w = cvt_pk_bf16(b[2], b[3]); return w; }

struct EpiQkv {
    static constexpr bool PERM = true, AFTER_DRAIN = false;
    bf16_t* O; int ldc; int qcols; float qscale;
    __device__ __forceinline__ void operator()(const f32x4 (&acc)[2][2][4][2], const Unit& u, int wr, int wc, int fr, int fq) const {
        const int row0 = u.pm * BM + wr * 64 + fr, colt = u.pn * BM; const float sc = colt < qcols ? qscale : 1.f;
        const int col0 = colt + wc * 32 + 8 * fq;
#pragma unroll
        for (int ai = 0; ai < 2; ++ai)
#pragma unroll
            for (int m = 0; m < 4; ++m) { bf16_t* rowp = O + (size_t)(row0 + ai * HALF + m * 16) * ldc + col0;
#pragma unroll
                for (int bj = 0; bj < 2; ++bj) *(u32x4*)(rowp + bj * HALF) = pack8_bf16(acc[ai][bj][m][0] * sc, acc[ai][bj][m][1] * sc); }
    }
};
template <int ACCS_INV> struct EpiResid {
    static constexpr bool PERM = false, AFTER_DRAIN = false;
    static constexpr int ldc = 2048; static constexpr float alpha = 1.6817928305074292f, accs = 1.f / (float)ACCS_INV;
    float* H; const float* Hsrc;
    __device__ __forceinline__ void operator()(const f32x4 (&acc)[2][2][4][2], const Unit& u, int wr, int wc, int fr, int fq) const {
        const int row0 = u.pm * BM + wr * 64 + fr, col0 = u.pn * BM + wc * 32 + 4 * fq;
#pragma unroll
        for (int ai = 0; ai < 2; ++ai)
#pragma unroll
            for (int m = 0; m < 4; ++m) { const size_t ro = (size_t)(row0 + ai * HALF + m * 16) * ldc + col0; float* rowp = H + ro; const float* srcp = Hsrc + ro;
#pragma unroll
                for (int bj = 0; bj < 2; ++bj)
#pragma unroll
                    for (int n = 0; n < 2; ++n) { const f32x4 h = *(const f32x4*)(srcp + bj * HALF + n * 16); *(f32x4*)(rowp + bj * HALF + n * 16) = h * alpha + acc[ai][bj][m][n] * accs; } }
    }
};
struct EpiRope {
    static constexpr bool PERM = true, AFTER_DRAIN = false;
    bf16_t* O; int ldc; int qcols, ropecols; float qscale; const float* ctab; const float* stab;
    __device__ __forceinline__ void operator()(const f32x4 (&acc)[2][2][4][2], const Unit& u, int wr, int wc, int fr, int fq) const {
        const int row0 = u.pm * BM + wr * 64 + fr, colt = u.pn * BM;
        if (colt >= ropecols) {
            const int col0 = colt + wc * 32 + 8 * fq;
#pragma unroll
            for (int ai = 0; ai < 2; ++ai)
#pragma unroll
                for (int m = 0; m < 4; ++m) { bf16_t* rowp = O + (size_t)(row0 + ai * HALF + m * 16) * ldc + col0;
#pragma unroll
                    for (int bj = 0; bj < 2; ++bj) *(u32x4*)(rowp + bj * HALF) = pack8_bf16(acc[ai][bj][m][0], acc[ai][bj][m][1]); }
        } else {
            const float sc = colt < qcols ? qscale : 1.f;
            const int col0 = colt + wc * 64 + 8 * fq;
#pragma unroll
            for (int ai = 0; ai < 2; ++ai)
#pragma unroll
                for (int m = 0; m < 4; ++m) { const int row = row0 + ai * HALF + m * 16; const int pos = row & 2047;
                    const f32x4 c0 = *(const f32x4*)(ctab + pos * 32 + 8 * fq), c1 = *(const f32x4*)(ctab + pos * 32 + 8 * fq + 4);
                    const f32x4 s0 = *(const f32x4*)(stab + pos * 32 + 8 * fq), s1 = *(const f32x4*)(stab + pos * 32 + 8 * fq + 4);
                    const f32x4 a0 = acc[ai][0][m][0], a1 = acc[ai][0][m][1], b0 = acc[ai][1][m][0], b1 = acc[ai][1][m][1];
                    bf16_t* rowp = O + (size_t)row * ldc + col0;
                    *(u32x4*)(rowp) = pack8_bf16((a0 * c0 - b0 * s0) * sc, (a1 * c1 - b1 * s1) * sc);
                    *(u32x4*)(rowp + 32) = pack8_bf16((b0 * c0 + a0 * s0) * sc, (b1 * c1 + a1 * s1) * sc); }
        }
    }
};
struct EpiGateUp {
    static constexpr bool PERM = true, AFTER_DRAIN = false;
    bf16_t* O;
    __device__ __forceinline__ void operator()(const f32x4 (&acc)[2][2][4][2], const Unit& u, int wr, int wc, int fr, int fq) const {
        const int row0 = u.pm * BM + wr * 64 + fr, col0 = (u.pn & 7) * 128 + wc * 32 + 8 * fq;
#pragma unroll
        for (int ai = 0; ai < 2; ++ai)
#pragma unroll
            for (int m = 0; m < 4; ++m) { f32x4 r[2];
#pragma unroll
                for (int n = 0; n < 2; ++n) { const f32x4 g = acc[ai][0][m][n], up = acc[ai][1][m][n];
#pragma unroll
                    for (int i = 0; i < 4; ++i) { const float e = __builtin_amdgcn_exp2f(g[i] * -1.4426950408889634f); r[n][i] = g[i] * __builtin_amdgcn_rcpf(1.f + e) * up[i]; } }
                *(u32x4*)(O + (size_t)(row0 + ai * HALF + m * 16) * 1024 + col0) = pack8_bf16(r[0], r[1]); }
    }
};
struct EpiDown {
    static constexpr bool PERM = true, AFTER_DRAIN = false;
    bf16_t* O;
    __device__ __forceinline__ void operator()(const f32x4 (&acc)[2][2][4][2], const Unit& u, int wr, int wc, int fr, int fq) const {
        const int row0 = u.pm * BM + wr * 64 + fr, col0 = (u.pn & 7) * BM + wc * 32 + 8 * fq;
#pragma unroll
        for (int ai = 0; ai < 2; ++ai)
#pragma unroll
            for (int m = 0; m < 4; ++m) { bf16_t* rowp = O + (size_t)(row0 + ai * HALF + m * 16) * 2048 + col0;
#pragma unroll
                for (int bj = 0; bj < 2; ++bj) *(u32x4*)(rowp + bj * HALF) = pack8_bf16(acc[ai][bj][m][0], acc[ai][bj][m][1]); }
    }
};
constexpr float W8_SCALE = 64.f, ACT8_SCALE = 4.f;
__device__ __forceinline__ unsigned pack4_fp8(float a, float b, float c, float d) { int w; asm volatile("" : "=v"(w));
    w = __builtin_amdgcn_cvt_pk_fp8_f32(a, b, w, false); w = __builtin_amdgcn_cvt_pk_fp8_f32(c, d, w, true); return (unsigned)w; }
struct EpiGateUp8 {
    static constexpr bool PERM = true, AFTER_DRAIN = false;
    unsigned char* O;
    __device__ __forceinline__ void operator()(const f32x4 (&acc)[2][2][4][2], const Unit& u, int wr, int wc, int fr, int fq) const {
        const int row0 = u.pm * BM + wr * 64 + fr, col0 = (u.pn & 7) * 128 + wc * 32 + 8 * fq;
        constexpr float SI = 1.f / W8_SCALE;
#pragma unroll
        for (int ai = 0; ai < 2; ++ai)
#pragma unroll
            for (int m = 0; m < 4; ++m) { f32x4 r[2];
#pragma unroll
                for (int n = 0; n < 2; ++n) { const f32x4 g = acc[ai][0][m][n] * SI, up = acc[ai][1][m][n] * (SI * ACT8_SCALE);
#pragma unroll
                    for (int i = 0; i < 4; ++i) { const float e = __builtin_amdgcn_exp2f(g[i] * -1.4426950408889634f); r[n][i] = g[i] * __builtin_amdgcn_rcpf(1.f + e) * up[i]; } }
                u32x2 w; w.x = pack4_fp8(r[0][0], r[0][1], r[0][2], r[0][3]); w.y = pack4_fp8(r[1][0], r[1][1], r[1][2], r[1][3]);
                *(u32x2*)(O + (size_t)(row0 + ai * HALF + m * 16) * 1024 + col0) = w; }
    }
};
struct EpiDown8 {
    static constexpr bool PERM = true, AFTER_DRAIN = false;
    bf16_t* O;
    __device__ __forceinline__ void operator()(const f32x4 (&acc)[2][2][4][2], const Unit& u, int wr, int wc, int fr, int fq) const {
        const int row0 = u.pm * BM + wr * 64 + fr, col0 = (u.pn & 7) * BM + wc * 32 + 8 * fq;
        constexpr float SI = 1.f / (W8_SCALE * ACT8_SCALE);
#pragma unroll
        for (int ai = 0; ai < 2; ++ai)
#pragma unroll
            for (int m = 0; m < 4; ++m) { bf16_t* rowp = O + (size_t)(row0 + ai * HALF + m * 16) * 2048 + col0;
#pragma unroll
                for (int bj = 0; bj < 2; ++bj) *(u32x4*)(rowp + bj * HALF) = pack8_bf16(acc[ai][bj][m][0] * SI, acc[ai][bj][m][1] * SI); }
    }
};
struct MoeOrder {
    int nunits, G, c; const PG8_LAS int* tile_e;
    __device__ __forceinline__ bool next(int i, Unit& u) const {
        int idx;
        if ((G & 7) == 0) { const int per = G >> 3; idx = (i * 8 + (c & 7)) * per + (c >> 3); } else idx = i * G + c;
        if (idx >= nunits) return false;
        const int mt = idx >> 3; u.pm = mt; u.pn = tile_e[mt] * 8 + (idx & 7); return true;
    }
    __device__ __forceinline__ void a_ready(const Unit&) const {}
    __device__ __forceinline__ void done(const Unit&) const {}
};

template <class Epi, class Sched, bool ALIGN_EPI = false, bool SP2 = false, bool F8 = false>
__device__ __forceinline__ void gemm_phase(PG8_LAS unsigned char* lds, const Gemm g, const Sched& S, const Epi& E) {
    int tid_ = threadIdx.x; asm volatile("" : "+v"(tid_));
    const int tid = tid_, wid = __builtin_amdgcn_readfirstlane(tid >> 6), lane = tid & 63, wr = wid >> 2, wc = wid & 3, fr = lane & 15, fq = lane >> 4;
    const int K = g.K, nt = K / BK;
    unsigned voffA, voffB;
    { int R, C; stage_rc(tid * 16, R, C); const int Rb = Epi::PERM ? ((R & ~31) + perm32(R & 31)) : R;
        voffA = (unsigned)(R * K + C) * 2u; voffB = (unsigned)(Rb * K + C) * 2u; }
    const size_t pstep = (size_t)64 * K * 2;
    const size_t kstep = (size_t)(BK * 2);
    const size_t hstep = (size_t)HALF * K * 2;
    const size_t tstep = 2 * hstep;
    const unsigned ldsbase = (unsigned)(uintptr_t)lds;
    const unsigned ldsw = (unsigned)wid * 1024u;
    const int aoff = lds_byte(wr * 64 + fr, fq * 8), boff = lds_byte(wc * 32 + fr, fq * 8);
#define PG8_SA(b, h) (((b) * 2 + (h)) * HTB)
#define PG8_SB(b, h) ((4 + (b) * 2 + (h)) * HTB)
#define PG8_STAGE(bufoff, gbase, voff) do { _Pragma("unroll") for (int _i = 0; _i < 2; ++_i) { unsigned keep_; \
        asm volatile("s_mov_b32 %0, m0\n\ts_mov_b32 m0, %3\n\ts_nop 0\n\tglobal_load_lds_dwordx4 %1, %2\n\ts_mov_b32 m0, %0" : "=&s"(keep_) \
            : "v"(voff), "s"((const char*)(gbase) + _i * pstep), "s"(ldsbase + (unsigned)(bufoff) + ldsw + (unsigned)(_i * 8192))); } } while (0)
#define PG8_CAT(a, b) __builtin_bit_cast(pg8_v8i, __builtin_shufflevector(a, b, 0, 1, 2, 3, 4, 5, 6, 7, 8, 9, 10, 11, 12, 13, 14, 15))
#define PG8_LDA(dst, b, h) do { if constexpr (F8) { _Pragma("unroll") for (int m = 0; m < 4; ++m) { const bf16x8 lo_ = *(const PG8_LAS bf16x8*)(lds + PG8_SA(b, h) + aoff + m * 2048), hi_ = *(const PG8_LAS bf16x8*)(lds + PG8_SA(b, h) + aoff + m * 2048 + 1024); dst##8[m] = PG8_CAT(lo_, hi_); } } \
        else { _Pragma("unroll") for (int m = 0; m < 4; ++m) _Pragma("unroll") for (int k = 0; k < 2; ++k) dst[m][k] = *(const PG8_LAS bf16x8*)(lds + PG8_SA(b, h) + aoff + m * 2048 + k * 1024); } } while (0)
#define PG8_LDB(dst, b, h) do { if constexpr (F8) { _Pragma("unroll") for (int n = 0; n < 2; ++n) { const bf16x8 lo_ = *(const PG8_LAS bf16x8*)(lds + PG8_SB(b, h) + boff + n * 2048), hi_ = *(const PG8_LAS bf16x8*)(lds + PG8_SB(b, h) + boff + n * 2048 + 1024); dst##8[n] = PG8_CAT(lo_, hi_); } } \
        else { _Pragma("unroll") for (int n = 0; n < 2; ++n) _Pragma("unroll") for (int k = 0; k < 2; ++k) dst[n][k] = *(const PG8_LAS bf16x8*)(lds + PG8_SB(b, h) + boff + n * 2048 + k * 1024); } } while (0)
#define PG8_MMA(ai, bj, At, Bt) do { __builtin_amdgcn_s_setprio(1); \
        if constexpr (F8) { _Pragma("unroll") for (int m = 0; m < 4; ++m) _Pragma("unroll") for (int n = 0; n < 2; ++n) \
            acc[ai][bj][m][n] = __builtin_amdgcn_mfma_scale_f32_16x16x128_f8f6f4(Bt##8[n], At##8[m], acc[ai][bj][m][n], 0, 0, 0, 0, 0, 0); } \
        else { _Pragma("unroll") for (int m = 0; m < 4; ++m) _Pragma("unroll") for (int n = 0; n < 2; ++n) _Pragma("unroll") for (int k = 0; k < 2; ++k) \
            acc[ai][bj][m][n] = __builtin_amdgcn_mfma_f32_16x16x32_bf16(Bt[n][k], At[m][k], acc[ai][bj][m][n], 0, 0, 0); } \
        __builtin_amdgcn_s_setprio(0); } while (0)
#define PG8_WAIT_V(n) asm volatile("s_waitcnt vmcnt(" #n ")" ::: "memory")
#define PG8_WAIT_L(n) asm volatile("s_waitcnt lgkmcnt(" #n ")" ::: "memory")
#define PG8_BAR __builtin_amdgcn_s_barrier()
#define PG8_SCHED __builtin_amdgcn_sched_barrier(0)
    Unit cur, nxt; int ui = 0;
    if (!S.next(0, cur)) return;
    f32x4 acc[2][2][4][2];
{ float zero_; asm volatile("v_mov_b32 %0, 0" : "=v"(zero_));
#pragma unroll
    for (int a = 0; a < 2; ++a)
#pragma unroll
        for (int b = 0; b < 2; ++b)
#pragma unroll
            for (int m = 0; m < 4; ++m)
#pragma unroll
                for (int n = 0; n < 2; ++n) acc[a][b][m][n] = (f32x4){zero_, zero_, zero_, zero_}; }
    bf16x8 At[4][2], B0[2][2], B1[2][2]; pg8_v8i At8[4], B08[2], B18[2];
    const char* cA = (const char*)g.A + (size_t)cur.pm * tstep; const char* cB = (const char*)g.Bt + (size_t)cur.pn * tstep;
    S.a_ready(cur);
    if constexpr (SP2) {
        PG8_STAGE(PG8_SB(0, 0), cB, voffB); PG8_STAGE(PG8_SB(0, 1), cB + hstep, voffB); PG8_STAGE(PG8_SA(0, 0), cA, voffA); PG8_STAGE(PG8_SA(0, 1), cA + hstep, voffA);
        if (wr == 1) PG8_BAR;
        PG8_WAIT_V(2); PG8_BAR;
        PG8_STAGE(PG8_SB(1, 0), cB + kstep, voffB); PG8_STAGE(PG8_SA(1, 0), cA + kstep, voffA); PG8_STAGE(PG8_SB(1, 1), cB + hstep + kstep, voffB);
        PG8_WAIT_V(6); PG8_BAR;
    } else {
        PG8_STAGE(PG8_SB(0, 0), cB, voffB); PG8_STAGE(PG8_SA(0, 0), cA, voffA); PG8_STAGE(PG8_SB(0, 1), cB + hstep, voffB); PG8_STAGE(PG8_SA(0, 1), cA + hstep, voffA);
        if (wr == 1) PG8_BAR;
        PG8_WAIT_V(4); PG8_BAR;
        PG8_STAGE(PG8_SB(1, 0), cB + kstep, voffB); PG8_STAGE(PG8_SA(1, 0), cA + kstep, voffA); PG8_STAGE(PG8_SB(1, 1), cB + hstep + kstep, voffB);
        PG8_WAIT_V(6); PG8_BAR;
    }
    for (;;) {
        const bool has_next = S.next(ui + 1, nxt);
        const char* nA = has_next ? (const char*)g.A + (size_t)nxt.pm * tstep : cA; const char* nB = has_next ? (const char*)g.Bt + (size_t)nxt.pn * tstep : cB;
#pragma unroll 1
        for (int t = 0; t < nt; t += 2) {
            const bool last = (t == nt - 2);
            const char* a1 = cA + (size_t)(t + 1) * kstep;
            const char* a2 = last ? nA : cA + (size_t)(t + 2) * kstep; const char* b2 = last ? nB : cB + (size_t)(t + 2) * kstep;
            const char* a3 = a2 + kstep; const char* b3 = b2 + kstep;
            if (last && has_next) S.a_ready(nxt);
            if constexpr (SP2) {
            PG8_LDB(B0, 0, 0); PG8_LDB(B1, 0, 1); PG8_SCHED; PG8_LDA(At, 0, 0); PG8_STAGE(PG8_SA(1, 1), a1 + hstep, voffA);
            PG8_WAIT_V(8); PG8_WAIT_L(0); PG8_BAR; PG8_MMA(0, 0, At, B0); PG8_MMA(0, 1, At, B1); PG8_BAR; PG8_SCHED;
            PG8_LDA(At, 0, 1); PG8_STAGE(PG8_SB(0, 0), b2, voffB); PG8_STAGE(PG8_SB(0, 1), b2 + hstep, voffB); PG8_STAGE(PG8_SA(0, 0), a2, voffA);
            PG8_WAIT_V(8); PG8_WAIT_L(0); PG8_BAR; PG8_MMA(1, 0, At, B0); PG8_MMA(1, 1, At, B1); PG8_BAR; PG8_SCHED;
            PG8_LDB(B0, 1, 0); PG8_LDB(B1, 1, 1); PG8_SCHED; PG8_LDA(At, 1, 0); PG8_STAGE(PG8_SA(0, 1), a2 + hstep, voffA);
            PG8_WAIT_V(8); PG8_WAIT_L(0); PG8_BAR; PG8_MMA(0, 0, At, B0); PG8_MMA(0, 1, At, B1); PG8_BAR; PG8_SCHED;
            PG8_LDA(At, 1, 1); PG8_STAGE(PG8_SB(1, 0), b3, voffB); PG8_STAGE(PG8_SB(1, 1), b3 + hstep, voffB); PG8_STAGE(PG8_SA(1, 0), a3, voffA);
            PG8_WAIT_V(8); PG8_WAIT_L(0); PG8_BAR; PG8_MMA(1, 0, At, B0); PG8_MMA(1, 1, At, B1); PG8_BAR; PG8_SCHED;
            } else {
            PG8_LDB(B0, 0, 0); PG8_SCHED; PG8_LDA(At, 0, 0); PG8_STAGE(PG8_SA(1, 1), a1 + hstep, voffA);
            PG8_WAIT_L(8); PG8_BAR; PG8_WAIT_L(0); PG8_MMA(0, 0, At, B0); PG8_BAR; PG8_SCHED;
            PG8_LDB(B1, 0, 1); PG8_STAGE(PG8_SB(0, 0), b2, voffB);
            PG8_BAR; PG8_WAIT_L(0); PG8_MMA(0, 1, At, B1); PG8_BAR;
            PG8_LDA(At, 0, 1); PG8_STAGE(PG8_SA(0, 0), a2, voffA);
            PG8_BAR; PG8_WAIT_L(0); PG8_MMA(1, 0, At, B0); PG8_BAR; PG8_SCHED;
            PG8_STAGE(PG8_SB(0, 1), b2 + hstep, voffB);
            PG8_WAIT_V(6); PG8_BAR; PG8_MMA(1, 1, At, B1); PG8_BAR;
            PG8_LDB(B0, 1, 0); PG8_SCHED; PG8_LDA(At, 1, 0); PG8_STAGE(PG8_SA(0, 1), a2 + hstep, voffA);
            PG8_WAIT_L(8); PG8_BAR; PG8_WAIT_L(0); PG8_MMA(0, 0, At, B0); PG8_BAR; PG8_SCHED;
            PG8_LDB(B1, 1, 1); PG8_STAGE(PG8_SB(1, 0), b3, voffB);
            PG8_BAR; PG8_WAIT_L(0); PG8_MMA(0, 1, At, B1); PG8_BAR;
            PG8_LDA(At, 1, 1); PG8_STAGE(PG8_SA(1, 0), a3, voffA);
            PG8_BAR; PG8_WAIT_L(0); PG8_MMA(1, 0, At, B0); PG8_BAR; PG8_SCHED;
            PG8_STAGE(PG8_SB(1, 1), b3 + hstep, voffB);
            PG8_WAIT_V(6); PG8_BAR; PG8_MMA(1, 1, At, B1); PG8_BAR;
            }
        }
        if constexpr (ALIGN_EPI) { if (wr == 0) PG8_BAR; }
        if constexpr (!Epi::AFTER_DRAIN) { E(acc, cur, wr, wc, fr, fq); S.done(cur); }
        if (!has_next) break;
{ float zero_; asm volatile("v_mov_b32 %0, 0" : "=v"(zero_));
#pragma unroll
        for (int a = 0; a < 2; ++a)
#pragma unroll
            for (int b = 0; b < 2; ++b)
#pragma unroll
                for (int m = 0; m < 4; ++m)
#pragma unroll
                    for (int n = 0; n < 2; ++n) acc[a][b][m][n] = (f32x4){zero_, zero_, zero_, zero_}; }
        cur = nxt; cA = nA; cB = nB; ++ui;
        if constexpr (ALIGN_EPI) { if (wr == 1) PG8_BAR; }
    }
    PG8_WAIT_V(0);
    if constexpr (!ALIGN_EPI) { if (wr == 0) PG8_BAR; }
    PG8_BAR;
    if constexpr (Epi::AFTER_DRAIN) { E.fused(acc, cur, wr, wc, fr, fq, lds, wid, lane); S.done(cur); }
#undef PG8_SA
#undef PG8_SB
#undef PG8_STAGE
#undef PG8_LDA
#undef PG8_LDB
#undef PG8_MMA
#undef PG8_CAT
#undef PG8_WAIT_V
#undef PG8_WAIT_L
#undef PG8_BAR
#undef PG8_SCHED
}
}

namespace att {
#define ALAS __attribute__((address_space(3)))
typedef unsigned short bf16_t;
typedef short bf16x8 __attribute__((ext_vector_type(8)));
typedef short s16x4 __attribute__((ext_vector_type(4)));
typedef float f32x16 __attribute__((ext_vector_type(16)));
typedef float f32x4 __attribute__((ext_vector_type(4)));
typedef unsigned u32x4 __attribute__((ext_vector_type(4)));
typedef ALAS char* ldsp;
#ifndef WO_F8
#define WO_F8 1
#endif
constexpr float OB8_SCALE = 8.f;
constexpr int QP = 6144;
constexpr int OP = 2048;
constexpr int SHM_V = 16384, SHM_K = 16384;
constexpr int LDS_V = 0, LDS_K = 2 * SHM_V, LDS_WS = LDS_K + 2 * SHM_K, ATT_LDS_BYTES = LDS_WS + 8 * 256;
#define KSWZ(row, colB) ((row) * 256 + ((colB) ^ (((row) & 7) << 4)))
#define KSWZ64(row, colB) ((row) * 128 + ((colB) ^ (((row) & 7) << 4)))
#define SBAR() __builtin_amdgcn_sched_barrier(0)
__device__ __forceinline__ int v_st(int k, int c) { const int kk = (k & ~0xC) | ((k & 4) << 1) | ((k & 8) >> 1); return ((kk >> 3) * 4 + (c >> 5)) * 512 + ((kk & 7) * 32 + (c & 31)) * 2; }
__device__ __forceinline__ int v_rd_base(int lane) { return ((lane & 3) << 3) | (((lane >> 2) & 3) << 6) | (((lane >> 4) & 1) << 5) | (((lane >> 5) & 1) << 8); }
constexpr int v_rd_off(int d0, int ks, int half) { return d0 * 512 + ks * 4096 + half * 2048; }
__device__ __forceinline__ int crow(int r, int hi) { return (r & 3) + 8 * (r >> 2) + 4 * hi; }
__device__ __forceinline__ unsigned cvtpk(float lo, float hi) { unsigned r; asm volatile("v_cvt_pk_bf16_f32 %0, %1, %2" : "=v"(r) : "v"(lo), "v"(hi)); return r; }
__device__ __forceinline__ bf16x8 ldg8(const bf16_t* p) { return *reinterpret_cast<const bf16x8*>(p); }
__device__ __forceinline__ unsigned quad_pack_fp8(float v) {
    const int b = __builtin_bit_cast(int, v);
    const float v1 = __builtin_bit_cast(float, __builtin_amdgcn_update_dpp(b, b, 0x55, 0xf, 0xf, false));
    const float v2 = __builtin_bit_cast(float, __builtin_amdgcn_update_dpp(b, b, 0xAA, 0xf, 0xf, false));
    const float v3 = __builtin_bit_cast(float, __builtin_amdgcn_update_dpp(b, b, 0xFF, 0xf, 0xf, false));
    int w; asm volatile("" : "=v"(w));
    w = __builtin_amdgcn_cvt_pk_fp8_f32(v, v1, w, false); w = __builtin_amdgcn_cvt_pk_fp8_f32(v2, v3, w, true); return (unsigned)w;
}
__device__ __forceinline__ float xhalf(float v, int hi) {
    auto rr = __builtin_amdgcn_permlane32_swap(__float_as_uint(v), __float_as_uint(v), false, false);
    return __uint_as_float(hi ? rr[0] : rr[1]);
}
#define ATT_PK4(P, B_, OUT) do { unsigned a0 = cvtpk(P[B_+0], P[B_+1]), a1 = cvtpk(P[B_+2], P[B_+3]);                      \
        unsigned b0 = cvtpk(P[B_+4], P[B_+5]), b1 = cvtpk(P[B_+6], P[B_+7]);                                             \
        auto r0 = __builtin_amdgcn_permlane32_swap(a0, b0, false, false); auto r1 = __builtin_amdgcn_permlane32_swap(a1, b1, false, false); \
        u32x4 w = {r0[0], r1[0], r0[1], r1[1]}; OUT = *reinterpret_cast<bf16x8*>(&w); } while (0)
__device__ __forceinline__ void pv_tile(f32x16* o, int vb, bf16x8 pa0, bf16x8 pa1, bf16x8 pa2, bf16x8 pa3) {
#define TRRD(dst, off) asm volatile("ds_read_b64_tr_b16 %0, %1 offset:%2" : "=&v"(dst) : "v"(vb), "i"(off) : "memory")
#define PV_D0(d0) do { s16x4 l0, l1, l2, l3, h0, h1, h2, h3; constexpr int b_ = v_rd_off(d0, 0, 0); \
        TRRD(l0, b_); TRRD(h0, b_ + 2048); TRRD(l1, b_ + 4096); TRRD(h1, b_ + 6144); TRRD(l2, b_ + 8192); TRRD(h2, b_ + 10240); TRRD(l3, b_ + 12288); TRRD(h3, b_ + 14336); \
        asm volatile("s_waitcnt lgkmcnt(0)" ::: "memory"); SBAR(); \
        o[d0] = __builtin_amdgcn_mfma_f32_32x32x16_bf16(pa0, (bf16x8){l0[0], l0[1], l0[2], l0[3], h0[0], h0[1], h0[2], h0[3]}, o[d0], 0, 0, 0);   \
        o[d0] = __builtin_amdgcn_mfma_f32_32x32x16_bf16(pa1, (bf16x8){l1[0], l1[1], l1[2], l1[3], h1[0], h1[1], h1[2], h1[3]}, o[d0], 0, 0, 0);   \
        o[d0] = __builtin_amdgcn_mfma_f32_32x32x16_bf16(pa2, (bf16x8){l2[0], l2[1], l2[2], l2[3], h2[0], h2[1], h2[2], h2[3]}, o[d0], 0, 0, 0);   \
        o[d0] = __builtin_amdgcn_mfma_f32_32x32x16_bf16(pa3, (bf16x8){l3[0], l3[1], l3[2], l3[3], h3[0], h3[1], h3[2], h3[3]}, o[d0], 0, 0, 0); } while (0)
    PV_D0(0); PV_D0(1); PV_D0(2); PV_D0(3);
#undef PV_D0
#undef TRRD
}

__device__ __forceinline__ void sb_block(const bf16_t* __restrict__ Qg, const bf16_t* __restrict__ Kg, const bf16_t* __restrict__ Vg, bf16_t* __restrict__ Og, int qb, ldsp lds) {
    int tid_ = threadIdx.x; asm volatile("" : "+v"(tid_));
    const int tid = tid_, wid = __builtin_amdgcn_readfirstlane(tid >> 6), lane = tid & 63, r32 = lane & 31, hi = lane >> 5;
    const int NT = 4 * qb + 4, R0 = 256 * qb + 32 * wid, myrow = R0 + r32;
    const ldsp V_lds = lds + LDS_V; const ldsp K_lds = lds + LDS_K;
    bf16x8 qr[8];
    { const bf16_t* Qw = Qg + (size_t)R0 * QP; const unsigned qoff = (unsigned)(r32 * QP + hi * 8);
#pragma unroll
      for (int d0 = 0; d0 < 8; ++d0) qr[d0] = ldg8(Qw + (qoff + d0 * 16)); }
    const int sr = tid >> 4, sc = (tid & 15) * 8, kws = KSWZ(sr, sc * 2), vst0 = v_st(sr, sc), vst1 = v_st(32 + sr, sc);
    const unsigned kvoff = (unsigned)(sr * QP + sc);
    const int vb0 = (int)(unsigned)(uintptr_t)V_lds + v_rd_base(lane);
    bf16x8 sk0, sk1, sv0, sv1;
#define SB_LOAD(j) do { const bf16_t* kp_ = Kg + (size_t)(64 * (j)) * QP; const bf16_t* vp_ = Vg + (size_t)(64 * (j)) * QP; \
        sk0 = ldg8(kp_ + kvoff); sk1 = ldg8(kp_ + (size_t)32 * QP + kvoff); sv0 = ldg8(vp_ + kvoff); sv1 = ldg8(vp_ + (size_t)32 * QP + kvoff); } while (0)
#define SB_WRITE(bf) do { *(ALAS bf16x8*)(K_lds + (bf) * SHM_K + kws) = sk0; *(ALAS bf16x8*)(K_lds + (bf) * SHM_K + kws + 32 * 256) = sk1; \
        *(ALAS bf16x8*)(V_lds + (bf) * SHM_V + vst0) = sv0; *(ALAS bf16x8*)(V_lds + (bf) * SHM_V + vst1) = sv1; } while (0)
    SB_LOAD(NT - 1); SB_WRITE(0);
    __syncthreads();
    float carry = 0.f; f32x16 o[4] = {};
    ALAS int* fl = (ALAS int*)(lds + LDS_WS); bool wdone = false;
    for (int t = 0; t < NT; ++t) {
        const int j = NT - 1 - t, buf = t & 1, kb = 64 * j;
        if (t + 1 < NT) SB_LOAD(j - 1);
        if (kb <= R0 + 30 && !wdone) {
            f32x16 p0 = {}, p1 = {};
            { const ldsp Kb = K_lds + buf * SHM_K;
#pragma unroll
              for (int d0 = 0; d0 < 8; ++d0) { const ldsp a = Kb + KSWZ(r32, ((d0 & 3) * 16 + hi * 8) * 2) + (d0 >> 2) * 128;
                  const bf16x8 b0 = *(const ALAS bf16x8*)a, b1 = *(const ALAS bf16x8*)(a + 32 * 256);
                  p0 = __builtin_amdgcn_mfma_f32_32x32x16_bf16(b0, qr[d0], p0, 0, 0, 0);
                  p1 = __builtin_amdgcn_mfma_f32_32x32x16_bf16(b1, qr[d0], p1, 0, 0, 0); } }
            f32x16 lb0, lb1;
#pragma unroll
            for (int r = 0; r < 16; ++r) {
                { const float z = p0[r]; const float e = __builtin_amdgcn_exp2f(-__builtin_fabsf(z)); const float sp = __builtin_fmaxf(z, 0.f) + __builtin_amdgcn_logf(1.f + e); p0[r] = -sp; lb0[r] = z - sp; }
                { const float z = p1[r]; const float e = __builtin_amdgcn_exp2f(-__builtin_fabsf(z)); const float sp = __builtin_fmaxf(z, 0.f) + __builtin_amdgcn_logf(1.f + e); p1[r] = -sp; lb1[r] = z - sp; }
            }
            if (kb + 63 >= R0) {
                const int dq = myrow - kb - 4 * hi; const float NEG = -__builtin_inff();
#pragma unroll
                for (int r = 0; r < 16; ++r) { const int c = (r & 3) + 8 * (r >> 2);
                    if (c >= dq) { p0[r] = 0.f; lb0[r] = NEG; }
                    if (c + 32 >= dq) { p1[r] = 0.f; lb1[r] = NEG; } }
            }
            float gs[8], go[8];
#pragma unroll
            for (int g = 0; g < 4; ++g) { gs[g] = (p0[4 * g] + p0[4 * g + 1]) + (p0[4 * g + 2] + p0[4 * g + 3]); gs[4 + g] = (p1[4 * g] + p1[4 * g + 1]) + (p1[4 * g + 2] + p1[4 * g + 3]); }
#pragma unroll
            for (int i = 0; i < 8; ++i) go[i] = xhalf(gs[i], hi);
            float acc = carry;
#pragma unroll
            for (int idx = 7; idx >= 0; --idx) { const int g = idx & 3; const float base = acc + (hi ? 0.f : go[idx]);
                if (idx >= 4) { const float t3 = base, t2 = t3 + p1[4 * g + 3], t1 = t2 + p1[4 * g + 2], t0 = t1 + p1[4 * g + 1];
                    lb1[4 * g + 3] = __builtin_amdgcn_exp2f(lb1[4 * g + 3] + t3); lb1[4 * g + 2] = __builtin_amdgcn_exp2f(lb1[4 * g + 2] + t2);
                    lb1[4 * g + 1] = __builtin_amdgcn_exp2f(lb1[4 * g + 1] + t1); lb1[4 * g] = __builtin_amdgcn_exp2f(lb1[4 * g] + t0); }
                else { const float t3 = base, t2 = t3 + p0[4 * g + 3], t1 = t2 + p0[4 * g + 2], t0 = t1 + p0[4 * g + 1];
                    lb0[4 * g + 3] = __builtin_amdgcn_exp2f(lb0[4 * g + 3] + t3); lb0[4 * g + 2] = __builtin_amdgcn_exp2f(lb0[4 * g + 2] + t2);
                    lb0[4 * g + 1] = __builtin_amdgcn_exp2f(lb0[4 * g + 1] + t1); lb0[4 * g] = __builtin_amdgcn_exp2f(lb0[4 * g] + t0); }
                acc += gs[idx] + go[idx]; }
            carry = acc;
            bf16x8 pa0, pa1, pa2, pa3;
            ATT_PK4(lb0, 0, pa0); ATT_PK4(lb0, 8, pa1); ATT_PK4(lb1, 0, pa2); ATT_PK4(lb1, 8, pa3);
            SBAR();
            pv_tile(o, vb0 + buf * SHM_V, pa0, pa1, pa2, pa3);
            wdone = __all(carry < -127.f);
        }
        if (lane == 0) fl[buf * 8 + wid] = wdone ? 1 : 0;
        if (t + 1 < NT) SB_WRITE(buf ^ 1);
        __syncthreads();
        { const ALAS int* f = fl + buf * 8; if ((f[0] & f[1] & f[2] & f[3] & f[4] & f[5] & f[6] & f[7]) != 0) break; }
    }
#undef SB_LOAD
#undef SB_WRITE
#if WO_F8
    unsigned char* Ow = (unsigned char*)Og + (size_t)R0 * OP; const unsigned ooff = (unsigned)(4 * hi * OP + r32);
#pragma unroll
    for (int r = 0; r < 16; ++r) { unsigned char* rowp = Ow + (size_t)((r & 3) + 8 * (r >> 2)) * OP;
#pragma unroll
        for (int d0 = 0; d0 < 4; ++d0) { const unsigned w = quad_pack_fp8(o[d0][r] * OB8_SCALE);
            if ((r32 & 3) == 0) *(unsigned*)(rowp + (ooff + d0 * 32)) = w; } }
#else
    bf16_t* Ow = Og + (size_t)R0 * OP; const unsigned ooff = (unsigned)(4 * hi * OP + r32);
#pragma unroll
    for (int r = 0; r < 16; ++r) { bf16_t* rowp = Ow + (size_t)((r & 3) + 8 * (r >> 2)) * OP;
#pragma unroll
        for (int d0 = 0; d0 < 4; ++d0) { const float v = o[d0][r]; const float vn = __shfl_xor(v, 1);
            if ((r32 & 1) == 0) *(unsigned*)(rowp + (ooff + d0 * 32)) = cvtpk(v, vn); } }
#endif
}

constexpr float ATT_THR = 8.f;
__device__ __forceinline__ void qkt64(f32x16& p0, f32x16& p1, ldsp Kb, int r32, int hi, const bf16x8* qr) {
    p0 = f32x16{}; p1 = f32x16{};
#pragma unroll
    for (int d0 = 0; d0 < 4; ++d0) { const ldsp a = Kb + KSWZ64(r32, (d0 * 16 + hi * 8) * 2);
        const bf16x8 b0 = *(const ALAS bf16x8*)a, b1 = *(const ALAS bf16x8*)(a + 32 * 128);
        p0 = __builtin_amdgcn_mfma_f32_32x32x16_bf16(b0, qr[d0], p0, 0, 0, 0);
        p1 = __builtin_amdgcn_mfma_f32_32x32x16_bf16(b1, qr[d0], p1, 0, 0, 0); }
}
__device__ __forceinline__ void partial_sm(f32x16& p0, f32x16& p1, float& m_reg, float& alpha, int hi) {
    float pmax = p0[0];
#pragma unroll
    for (int r = 1; r < 16; ++r) pmax = __builtin_fmaxf(pmax, p0[r]);
#pragma unroll
    for (int r = 0; r < 16; ++r) pmax = __builtin_fmaxf(pmax, p1[r]);
    pmax = __builtin_fmaxf(pmax, xhalf(pmax, hi));
    float mn;
    if (__builtin_expect(__all(pmax - m_reg <= ATT_THR), 1)) { mn = m_reg; alpha = 1.f; }
    else { mn = __builtin_fmaxf(m_reg, pmax); alpha = __builtin_amdgcn_exp2f(m_reg - mn); m_reg = mn; }
#pragma unroll
    for (int r = 0; r < 16; ++r) { p0[r] -= mn; p1[r] -= mn; }
#pragma unroll
    for (int r = 0; r < 16; ++r) p0[r] = __builtin_amdgcn_exp2f(p0[r]);
}
__device__ __forceinline__ void finish_sm(f32x16& p0, f32x16& p1, float alpha, float& l_reg, bf16x8& pa0, bf16x8& pa1, bf16x8& pa2, bf16x8& pa3, int hi) {
#pragma unroll
    for (int r = 0; r < 16; ++r) p1[r] = __builtin_amdgcn_exp2f(p1[r]);
    float ps = 0.f;
#pragma unroll
    for (int r = 0; r < 16; ++r) ps += p0[r];
#pragma unroll
    for (int r = 0; r < 16; ++r) ps += p1[r];
    ps += xhalf(ps, hi);
    l_reg = l_reg * alpha + ps;
    ATT_PK4(p0, 0, pa0); ATT_PK4(p0, 8, pa1); ATT_PK4(p1, 0, pa2); ATT_PK4(p1, 8, pa3);
}
__device__ __forceinline__ void mask_gt(f32x16& p0, f32x16& p1, int dq) {
    const float NEG = -__builtin_inff();
#pragma unroll
    for (int r = 0; r < 16; ++r) { const int c = (r & 3) + 8 * (r >> 2);
        if (c > dq) p0[r] = NEG;
        if (c + 32 > dq) p1[r] = NEG; }
}
template <bool SECOND>
__device__ __forceinline__ void diff_pass(const bf16_t* __restrict__ Qg, const bf16_t* __restrict__ Kg, const bf16_t* __restrict__ Vg, float* S1, bf16_t* __restrict__ Og,
                                          int qb, float lam, const float* __restrict__ gsub, float gmul, ldsp lds) {
    int tid_ = threadIdx.x; asm volatile("" : "+v"(tid_));
    const int tid = tid_, wid = __builtin_amdgcn_readfirstlane(tid >> 6), lane = tid & 63, r32 = lane & 31, hi = lane >> 5;
    const int NT = 4 * qb + 4, R0 = 256 * qb + 32 * wid, myrow = R0 + r32;
    const ldsp V_lds = lds + LDS_V; const ldsp K_lds = lds + LDS_K;
    ALAS float* wsf = (ALAS float*)(lds + LDS_WS) + wid * 64; ALAS float* li_l = wsf; ALAS float* al_l = wsf + 32;
    bf16x8 qr[4];
    { const bf16_t* Qw = Qg + (size_t)R0 * QP; const unsigned qoff = (unsigned)(r32 * QP + hi * 8);
#pragma unroll
      for (int d0 = 0; d0 < 4; ++d0) qr[d0] = ldg8(Qw + (qoff + d0 * 16)); }
    const int sr = tid >> 4, sc = (tid & 15) * 8, vst0 = v_st(sr, sc), vst1 = v_st(32 + sr, sc);
    const int kr = tid >> 3, kc = (tid & 7) * 8, kws = KSWZ64(kr, kc * 2);
    const unsigned voff = (unsigned)(sr * QP + sc), koff = (unsigned)(kr * QP + kc);
    const int vb0 = (int)(unsigned)(uintptr_t)V_lds + v_rd_base(lane);
    const int qm = myrow - 4 * hi;
    bf16x8 sk0, sv0, sv1;
#define DF_LOAD(j) do { const bf16_t* vp_ = Vg + (size_t)(64 * (j)) * QP; sk0 = ldg8(Kg + (size_t)(64 * (j)) * QP + koff); sv0 = ldg8(vp_ + voff); sv1 = ldg8(vp_ + (size_t)32 * QP + voff); } while (0)
#define DF_WRITE(bf) do { *(ALAS bf16x8*)(K_lds + (bf) * SHM_K + kws) = sk0; *(ALAS bf16x8*)(V_lds + (bf) * SHM_V + vst0) = sv0; *(ALAS bf16x8*)(V_lds + (bf) * SHM_V + vst1) = sv1; } while (0)
#define DF_MASK(P0, P1, t) do { if (64 * (t) + 63 > R0) mask_gt(P0, P1, qm - 64 * (t)); } while (0)
#define DF_RESC(a) do { if (__any((a) < 1.f)) { if (hi == 0) al_l[r32] = (a); asm volatile("s_waitcnt lgkmcnt(0)" ::: "memory"); \
        _Pragma("unroll") for (int d_ = 0; d_ < 4; ++d_) _Pragma("unroll") for (int r = 0; r < 16; ++r) o[d_][r] *= al_l[crow(r, hi)]; } } while (0)
    float m_reg = -1e30f, l_reg = 0.f; f32x16 o[4] = {};
    f32x16 pA0, pA1, pB0, pB1; float alA = 1.f, alB = 1.f; bf16x8 pa0, pa1, pa2, pa3;
    DF_LOAD(0); DF_WRITE(0);
    __syncthreads();
    DF_LOAD(1);
    qkt64(pA0, pA1, K_lds, r32, hi, qr); DF_MASK(pA0, pA1, 0); partial_sm(pA0, pA1, m_reg, alA, hi);
    DF_WRITE(1);
    DF_RESC(alA);
    __syncthreads();
#define DF_HALF(PX0, PX1, alX, PY0, PY1, alY, t, KB, VB, SB, MORE) do { \
        SBAR(); qkt64(PX0, PX1, K_lds + (KB) * SHM_K, r32, hi, qr); \
        finish_sm(PY0, PY1, alY, l_reg, pa0, pa1, pa2, pa3, hi); SBAR(); \
        if (MORE) { DF_LOAD((t) + 1); SBAR(); } \
        pv_tile(o, vb0 + (VB) * SHM_V, pa0, pa1, pa2, pa3); DF_MASK(PX0, PX1, (t)); partial_sm(PX0, PX1, m_reg, alX, hi); \
        __syncthreads(); \
        if (MORE) DF_WRITE(SB); \
        DF_RESC(alX); __syncthreads(); } while (0)
    for (int t = 1; t + 1 < NT; t += 2) {
        DF_HALF(pB0, pB1, alB, pA0, pA1, alA, t, 1, 0, 0, true);
        DF_HALF(pA0, pA1, alA, pB0, pB1, alB, t + 1, 0, 1, 1, true);
    }
    DF_HALF(pB0, pB1, alB, pA0, pA1, alA, NT - 1, 1, 0, 0, false);
    finish_sm(pB0, pB1, alB, l_reg, pa0, pa1, pa2, pa3, hi); SBAR();
    pv_tile(o, vb0 + 1 * SHM_V, pa0, pa1, pa2, pa3);
#undef DF_LOAD
#undef DF_WRITE
#undef DF_MASK
#undef DF_RESC
#undef DF_HALF
    if (hi == 0) li_l[r32] = l_reg; asm volatile("s_waitcnt lgkmcnt(0)" ::: "memory");
    float rli[16];
#pragma unroll
    for (int r = 0; r < 16; ++r) rli[r] = __builtin_amdgcn_rcpf(li_l[crow(r, hi)]);
    if constexpr (!SECOND) {
        float* Sw = S1 + (size_t)R0 * OP; const unsigned ooff = (unsigned)(4 * hi * OP + r32);
#pragma unroll
        for (int r = 0; r < 16; ++r) { float* rowp = Sw + (size_t)((r & 3) + 8 * (r >> 2)) * OP;
#pragma unroll
            for (int d0 = 0; d0 < 4; ++d0) rowp[ooff + d0 * 32] = o[d0][r] * rli[r]; }
    } else {
        const float* Sw = S1 + (size_t)R0 * OP; bf16_t* Ow = Og + (size_t)R0 * OP; (void)Ow; const unsigned ooff = (unsigned)(4 * hi * OP + r32);
        float gn[4];
#pragma unroll
        for (int d0 = 0; d0 < 4; ++d0) gn[d0] = gsub[d0 * 32 + r32] * gmul;
#pragma unroll
        for (int r = 0; r < 16; ++r) { const float* srow = Sw + (size_t)((r & 3) + 8 * (r >> 2)) * OP; float d[4]; float ss = 0.f;
#if WO_F8
            unsigned char* orowp = (unsigned char*)Og + (size_t)(R0 + (r & 3) + 8 * (r >> 2)) * OP;
#else
            bf16_t* orowp = Ow + (size_t)((r & 3) + 8 * (r >> 2)) * OP;
#endif
#pragma unroll
            for (int d0 = 0; d0 < 4; ++d0) { d[d0] = srow[ooff + d0 * 32] - lam * (o[d0][r] * rli[r]); ss += d[d0] * d[d0]; }
            ss += __builtin_bit_cast(float, __builtin_amdgcn_update_dpp(0, __builtin_bit_cast(int, ss), 0xB1, 0xf, 0xf, true));
            ss += __builtin_bit_cast(float, __builtin_amdgcn_update_dpp(0, __builtin_bit_cast(int, ss), 0x4E, 0xf, 0xf, true));
            ss += __builtin_bit_cast(float, __builtin_amdgcn_update_dpp(0, __builtin_bit_cast(int, ss), 0x141, 0xf, 0xf, true));
            ss += __builtin_bit_cast(float, __builtin_amdgcn_update_dpp(0, __builtin_bit_cast(int, ss), 0x140, 0xf, 0xf, true));
            { auto rr = __builtin_amdgcn_permlane16_swap(__float_as_uint(ss), __float_as_uint(ss), false, false); ss = __uint_as_float(rr[0]) + __uint_as_float(rr[1]); }
            const float rs = __builtin_amdgcn_rsqf(ss * (1.f / 128.f) + 1e-5f);
#pragma unroll
#if WO_F8
            for (int d0 = 0; d0 < 4; ++d0) { const unsigned w = quad_pack_fp8(d[d0] * rs * gn[d0] * OB8_SCALE);
                if ((r32 & 3) == 0) *(unsigned*)(orowp + (ooff + d0 * 32)) = w; }
#else
            for (int d0 = 0; d0 < 4; ++d0) { const float v = d[d0] * rs * gn[d0]; const float vn = __shfl_xor(v, 1);
                if ((r32 & 1) == 0) *(unsigned*)(orowp + (ooff + d0 * 32)) = cvtpk(v, vn); }
#endif
            if ((r & 1) == 1) asm volatile("" ::: "memory"); }
    }
    __syncthreads();
}
#undef SBAR
}

#define LAS __attribute__((address_space(3)))

#define XB_TMO      128
#define XB_XCNT(j)  (256  + 64 * (j))
#define XB_XSUB(j)  (1280 + 64 * (j))
#define XB_XGEN(j)  (2304 + 64 * (j))
#define XB_TOP      3328
#define XB_TOPGEN   3392
#define XCD_BAR_WORDS 3456
#define XB_SPIN_CAP (1u << 18)

__device__ __forceinline__ unsigned xb_ld(unsigned* p)              { return __hip_atomic_load(p, __ATOMIC_RELAXED, __HIP_MEMORY_SCOPE_AGENT); }
__device__ __forceinline__ unsigned xb_add(unsigned* p, unsigned v) { return __hip_atomic_fetch_add(p, v, __ATOMIC_RELAXED, __HIP_MEMORY_SCOPE_AGENT); }
__device__ __forceinline__ unsigned xb_xcc_id() { return (unsigned)__builtin_amdgcn_s_getreg((3 << 11) | 20) & 0xFu; }
#define XB_SPIN(cond, bar) do { unsigned _sp = 0; while (cond) { __builtin_amdgcn_s_sleep(1); \
    if ((++_sp & 255u) == 0u) { if (xb_ld(&(bar)[XB_TMO])) break; if (_sp > XB_SPIN_CAP) { atomicAdd(&(bar)[XB_TMO], 1u); break; } } } } while (0)

struct XcdBarrier {
    unsigned* bar; unsigned x;
    volatile LAS unsigned* st;
};

__device__ __forceinline__ XcdBarrier xcd_barrier_post(unsigned* bar, volatile LAS unsigned* st) {
    XcdBarrier b; b.bar = bar; b.x = xb_xcc_id(); b.st = st;
    if (threadIdx.x == 0) (void)xb_add(&bar[XB_XCNT(b.x)], 1u);
    return b;
}
__device__ __forceinline__ void xcd_barrier_complete(unsigned* bar, unsigned x, unsigned& nloc, unsigned& nx) {
    const unsigned G = gridDim.x * gridDim.y * gridDim.z;
    unsigned sum, cnt, mine, sp = 0u;
    for (;;) {
        sum = 0u; cnt = 0u; mine = 0u;
#pragma unroll
        for (unsigned j = 0; j < 16; ++j) { const unsigned c = xb_ld(&bar[XB_XCNT(j)]); sum += c; cnt += (c > 0u) ? 1u : 0u; mine = (j == x) ? c : mine; }
        if (sum == G) break;
        __builtin_amdgcn_s_sleep(1);
        if ((++sp & 255u) == 0u) { if (xb_ld(&bar[XB_TMO])) break; if (sp > XB_SPIN_CAP) { atomicAdd(&bar[XB_TMO], 1u); break; } }
    }
    nloc = mine > 0u ? mine : 1u; nx = cnt > 0u ? cnt : 1u;
}

__device__ __forceinline__ void xcd_barrier(const XcdBarrier& b) {
    asm volatile("s_waitcnt vmcnt(0)" ::: "memory");
    __syncthreads();
    if (threadIdx.x == 0) {
        unsigned* bar = b.bar;
        __builtin_amdgcn_s_waitcnt(0);
        unsigned nloc = b.st[0], nx = b.st[1];
        if (nloc == 0u) { xcd_barrier_complete(bar, b.x, nloc, nx); b.st[0] = nloc; b.st[1] = nx; }
        const unsigned old = xb_add(&bar[XB_XSUB(b.x)], 1u);
        const unsigned gen = old / nloc;
        if (old + 1u == (gen + 1u) * nloc) {
            __builtin_amdgcn_fence(__ATOMIC_RELEASE, "agent");
            asm volatile("s_waitcnt vmcnt(0)" ::: "memory");
            const unsigned og = xb_add(&bar[XB_TOP], 1u);
            const unsigned tg = og / nx;
            if (og + 1u == (tg + 1u) * nx) xb_add(&bar[XB_TOPGEN], 1u);
            else XB_SPIN(xb_ld(&bar[XB_TOPGEN]) == tg, bar);
            __builtin_amdgcn_fence(__ATOMIC_ACQUIRE, "agent");
            xb_add(&bar[XB_XGEN(b.x)], 1u);
            asm volatile("s_waitcnt vmcnt(0)" ::: "memory");
        } else {
            XB_SPIN(xb_ld(&bar[XB_XGEN(b.x)]) == gen, bar);
            __builtin_amdgcn_fence(__ATOMIC_ACQUIRE, "agent");
            asm volatile("s_waitcnt vmcnt(0)" ::: "memory");
        }
    }
    __syncthreads();
}

constexpr int NWAVES = 8;
constexpr int NTOK = 16384, DM = 2048, SEQ = 2048, NHEAD = 16, NLAYER = 4, NEXP = 16, DEXP = 1024;
constexpr int XS_ROWS = 36864;
constexpr float LN_EPS = 1e-5f;
constexpr float DN_ALPHA = 1.6817928305074292f;
constexpr float LOG2E = 1.4426950408889634f;
constexpr float SB_QSCALE = 0.08838834764831845f * LOG2E;
constexpr float DF_QSCALE = 0.125f * LOG2E;
#ifndef MK_MULTI
#define MK_MULTI 0
#endif
#ifndef MOE_F8
#define MOE_F8 1
#endif
constexpr int NSTEPS = 1 + 8 * NLAYER;

constexpr size_t MiB = 1u << 20;
constexpr size_t WS_CTL = 0, CTL_ZERO_BYTES = 64 * 1024;
constexpr size_t WS_COS = 1 * MiB, WS_SIN = WS_COS + 256 * 1024;
constexpr size_t WS_WR = 2 * MiB;
constexpr size_t WS_CNT = 3 * MiB;
constexpr size_t WS_RE = WS_CNT + 64 * 1024;
constexpr size_t WS_RW = WS_RE + 64 * 1024;
constexpr size_t WS_RP = WS_RW + 128 * 1024;
constexpr size_t WS_WQKVA = 4 * MiB;
constexpr size_t WS_WOA = WS_WQKVA + 48 * MiB;
constexpr size_t WS_WQKVB = WS_WOA + 16 * MiB;
constexpr size_t WS_WOB = WS_WQKVB + 32 * MiB;
constexpr size_t WS_WGU = WS_WOB + 16 * MiB;
constexpr size_t WS_WDN = WS_WGU + 512 * MiB;
constexpr size_t WS_H = WS_WDN + 256 * MiB;
constexpr size_t WS_HB = WS_H + 128 * MiB;
constexpr size_t WS_QKV = WS_HB + 64 * MiB;
constexpr size_t WS_OB = WS_QKV + 192 * MiB;
constexpr size_t WS_XS = WS_OB + 64 * MiB;
constexpr size_t WS_ACT = WS_XS + 144 * MiB;
constexpr size_t WS_YD = WS_ACT + 72 * MiB;
constexpr size_t WS_END = WS_YD + 144 * MiB;
static_assert(WS_END <= (size_t)2040 * MiB, "workspace map");
constexpr int CW_BAR = 1024;
constexpr int LDS_BYTES = 147456;
constexpr int LDSCTL_OFF = 145408;
constexpr int RING_OFF = 0;

#define GAS __attribute__((address_space(1)))
typedef unsigned short bf16;
typedef unsigned v4u __attribute__((ext_vector_type(4)));
typedef unsigned v2u __attribute__((ext_vector_type(2)));
typedef float f32x4 __attribute__((ext_vector_type(4)));
typedef float f32x2 __attribute__((ext_vector_type(2)));
#define LDS_WAIT() asm volatile("s_waitcnt lgkmcnt(0)" ::: "memory")
#define VM_WAIT() asm volatile("s_waitcnt vmcnt(0)" ::: "memory")
__device__ __forceinline__ unsigned pk2(float lo, float hi) { unsigned r; asm volatile("v_cvt_pk_bf16_f32 %0, %1, %2" : "=v"(r) : "v"(lo), "v"(hi)); return r; }
__device__ __forceinline__ int opq_tid() { int t = threadIdx.x; asm volatile("" : "+v"(t)); return t; }
__device__ __forceinline__ float dpp_sum(float v) {
    v += __builtin_bit_cast(float, __builtin_amdgcn_update_dpp(0, __builtin_bit_cast(int, v), 0xB1, 0xf, 0xf, true));
    v += __builtin_bit_cast(float, __builtin_amdgcn_update_dpp(0, __builtin_bit_cast(int, v), 0x4E, 0xf, 0xf, true));
    v += __builtin_bit_cast(float, __builtin_amdgcn_update_dpp(0, __builtin_bit_cast(int, v), 0x141, 0xf, 0xf, true));
    v += __builtin_bit_cast(float, __builtin_amdgcn_update_dpp(0, __builtin_bit_cast(int, v), 0x140, 0xf, 0xf, true));
    const int b = __builtin_bit_cast(int, v);
    const float s0 = __builtin_bit_cast(float, __builtin_amdgcn_readlane(b, 0)), s1 = __builtin_bit_cast(float, __builtin_amdgcn_readlane(b, 16));
    const float s2 = __builtin_bit_cast(float, __builtin_amdgcn_readlane(b, 32)), s3 = __builtin_bit_cast(float, __builtin_amdgcn_readlane(b, 48));
    return (s0 + s1) + (s2 + s3);
}
__device__ __forceinline__ float wave_sum(float v) {
#pragma unroll
    for (int o = 1; o < 64; o <<= 1) v += __shfl_xor(v, o);
    return v;
}

struct Args { const float* in[17]; float* out; unsigned char* ws; int s_lo, s_hi; };

__device__ __forceinline__ int map_row(int n, int mode) {
    if (mode == 0) return n;
    if (mode == 1) { const int c = n & 255, blk = c >> 6, d = c & 63; return (n & ~255) + ((d >> 5) << 7) + (blk << 5) + (d & 31); }
    return ((n >> 7) << 8) + (n & 127) + (mode == 3 ? 128 : 0);
}
__device__ __forceinline__ void cvt_item(const float* __restrict__ src, int pitch, int K, bf16* __restrict__ dst, int mode, int k0, int n0, LAS float* scr, int lane) {
    const int kr = lane >> 4, n4 = (lane & 15) * 4;
    f32x4 v[16];
#pragma unroll
    for (int i = 0; i < 16; ++i) v[i] = __builtin_nontemporal_load((const f32x4*)(src + (size_t)(k0 + 4 * i + kr) * pitch + n0 + n4));
#pragma unroll
    for (int i = 0; i < 16; ++i) { LAS float* s = scr + (4 * i + kr) * 65 + n4; s[0] = v[i][0]; s[1] = v[i][1]; s[2] = v[i][2]; s[3] = v[i][3]; }
    LDS_WAIT();
    const int c = lane & 7;
#pragma unroll
    for (int j = 0; j < 8; ++j) { const int nl = (lane >> 3) + 8 * j; const int row = map_row(n0 + nl, mode);
        const LAS float* s = scr + (8 * c) * 65 + nl;
        v4u o; o.x = pk2(s[0], s[65]); o.y = pk2(s[130], s[195]); o.z = pk2(s[260], s[325]); o.w = pk2(s[390], s[455]);
        *(v4u*)(dst + (size_t)row * K + k0 + 8 * c) = o; }
    LDS_WAIT();
}

__device__ __forceinline__ void cvt_item8(const float* __restrict__ src, int pitch, int K, unsigned char* __restrict__ dst, int mode, int k0, int n0, float scale, LAS float* scr, int lane) {
    const int kr = lane >> 4, n4 = (lane & 15) * 4;
    f32x4 v[16];
#pragma unroll
    for (int i = 0; i < 16; ++i) v[i] = __builtin_nontemporal_load((const f32x4*)(src + (size_t)(k0 + 4 * i + kr) * pitch + n0 + n4));
#pragma unroll
    for (int i = 0; i < 16; ++i) { LAS float* s = scr + (4 * i + kr) * 65 + n4; s[0] = v[i][0] * scale; s[1] = v[i][1] * scale; s[2] = v[i][2] * scale; s[3] = v[i][3] * scale; }
    LDS_WAIT();
    const int c = lane & 3;
#pragma unroll
    for (int j = 0; j < 4; ++j) { const int nl = (lane >> 2) + 16 * j; const int row = map_row(n0 + nl, mode);
        const LAS float* s = scr + (16 * c) * 65 + nl;
        v4u o; o.x = pg8::pack4_fp8(s[0], s[65], s[130], s[195]); o.y = pg8::pack4_fp8(s[260], s[325], s[390], s[455]);
        o.z = pg8::pack4_fp8(s[520], s[585], s[650], s[715]); o.w = pg8::pack4_fp8(s[780], s[845], s[910], s[975]);
        *(v4u*)(dst + (size_t)row * K + k0 + 16 * c) = o; }
    LDS_WAIT();
}

__global__ void __launch_bounds__(NWAVES * 64, 2) yoco_fwd(Args args) {
    extern __shared__ __attribute__((aligned(16))) unsigned char lds_raw[];
    LAS unsigned char* const lds = (LAS unsigned char*)lds_raw;
    const int tid = threadIdx.x, lane = tid & 63, wave = __builtin_amdgcn_readfirstlane(tid >> 6);
    const int G = gridDim.x, bx = blockIdx.x;
    const int vcu = (G % 8 == 0) ? (bx % 8) * (G / 8) + bx / 8 : bx;
    unsigned char* const ws = args.ws;
    volatile LAS unsigned* const CTL = (volatile LAS unsigned*)(lds + LDSCTL_OFF);
    LAS int* const TAB = (LAS int*)(lds + LDSCTL_OFF + 64);
    for (int u = tid; u < (LDS_BYTES - LDSCTL_OFF) / 4; u += NWAVES * 64) ((LAS unsigned*)(lds + LDSCTL_OFF))[u] = 0u;
    __syncthreads();
    const int s_lo = args.s_lo, s_hi = args.s_hi;
    XcdBarrier bar; bar.bar = (unsigned*)(ws + WS_CTL) + CW_BAR; bar.x = 0; bar.st = nullptr;
    if (s_hi - s_lo > 1) bar = xcd_barrier_post((unsigned*)(ws + WS_CTL) + CW_BAR, CTL);
#ifndef PH_MASK
#define PH_MASK 0xFFFF
#endif
#define PHM(b) (((PH_MASK) >> (b)) & 1)
#ifndef PROBE_DUP
#define PROBE_DUP 0
#endif
#define PREP(b) _Pragma("unroll 1") for (int rep_ = 0; rep_ < ((((PROBE_DUP) >> (b)) & 1) ? 2 : 1); ++rep_)
#define IN(k) (s_lo <= (k) && (k) < s_hi)
#define SEAM(k) do { if ((k) + 1 < s_hi) xcd_barrier(bar); } while (0)

    const float* const x_in = args.in[0];
    float* const H = (float*)(ws + WS_H); bf16* const HB = (bf16*)(ws + WS_HB); bf16* const QKV = (bf16*)(ws + WS_QKV); bf16* const OB = (bf16*)(ws + WS_OB);
    bf16* const XS = (bf16*)(ws + WS_XS); float* const S1 = (float*)(ws + WS_XS); bf16* const ACT = (bf16*)(ws + WS_ACT); bf16* const YD = (bf16*)(ws + WS_YD);
    float* const COS = (float*)(ws + WS_COS); float* const SIN = (float*)(ws + WS_SIN); float* const WR = (float*)(ws + WS_WR);
    int* const CNT = (int*)(ws + WS_CNT); unsigned* const RE = (unsigned*)(ws + WS_RE); f32x2* const RW = (f32x2*)(ws + WS_RW); int* const RP = (int*)(ws + WS_RP);

    if (IN(0) && PHM(0)) { PREP(0) {
        const int tid = opq_tid(), lane = tid & 63;
        LAS float* scr = (LAS float*)(lds + RING_OFF + wave * 16640);
        const int gw = vcu * NWAVES + wave, NGW = G * NWAVES;
        constexpr int I0 = 2 * 3072, I1 = 8 * 1024, I2 = 128 * 512, I3 = 64 * 512, NITEMS = I0 + I1 + I2 + I3;
        for (int it = gw; it < NITEMS; it += NGW) {
            int r = it;
            if (r < I0) { const int job = r / 3072; r -= job * 3072; const int kb = r / 96, nb = r - kb * 96;
                cvt_item(args.in[1] + (size_t)job * 2048 * 6144, 6144, 2048, (bf16*)(ws + WS_WQKVA) + (size_t)job * 6144 * 2048, 0, kb * 64, nb * 64, scr, lane); continue; }
            r -= I0;
            if (r < I1) { const int job = r >> 10; r &= 1023; const int kb = r >> 5, nb = r & 31;
                const float* src; int pitch = 2048, mode = 0; bf16* dst;
                if (job < 2) { src = args.in[2] + (size_t)job * 2048 * 2048; dst = (bf16*)(ws + WS_WOA) + (size_t)job * 2048 * 2048; }
                else if (job == 2) { src = args.in[4]; dst = (bf16*)(ws + WS_WQKVB); mode = 1; }
                else if (job == 3) { src = args.in[3]; pitch = 4096; dst = (bf16*)(ws + WS_WQKVB) + (size_t)2048 * 2048; mode = 1; }
                else if (job == 4) { src = args.in[3] + 2048; pitch = 4096; dst = (bf16*)(ws + WS_WQKVB) + (size_t)4096 * 2048; }
                else if (job == 5) { src = args.in[4] + (size_t)2048 * 2048; dst = (bf16*)(ws + WS_WQKVB) + (size_t)6144 * 2048; mode = 1; }
                else { src = args.in[5] + (size_t)(job - 6) * 2048 * 2048; dst = (bf16*)(ws + WS_WOB) + (size_t)(job - 6) * 2048 * 2048; }
#if WO_F8
                if (job < 2 || job >= 6) { cvt_item8(src, pitch, 2048, (unsigned char*)dst, mode, kb * 64, nb * 64, pg8::W8_SCALE, scr, lane); continue; }
#endif
                cvt_item(src, pitch, 2048, dst, mode, kb * 64, nb * 64, scr, lane); continue; }
            r -= I1;
            if (r < I2) { const int job = r >> 9; r &= 511; const int kb = r >> 4, nb = r & 15; const int le = job >> 1, up = job & 1;
#if MOE_F8
                cvt_item8((up ? args.in[15] : args.in[14]) + (size_t)le * 2048 * 1024, 1024, 2048, (unsigned char*)(ws + WS_WGU) + (size_t)le * 2048 * 2048, 2 + up, kb * 64, nb * 64, pg8::W8_SCALE, scr, lane); continue; }
#else
                cvt_item((up ? args.in[15] : args.in[14]) + (size_t)le * 2048 * 1024, 1024, 2048, (bf16*)(ws + WS_WGU) + (size_t)le * 2048 * 2048, 2 + up, kb * 64, nb * 64, scr, lane); continue; }
#endif
            r -= I2;
            { const int le = r >> 9; r &= 511; const int kb = r >> 5, nb = r & 31;
#if MOE_F8
                cvt_item8(args.in[16] + (size_t)le * 1024 * 2048, 2048, 1024, (unsigned char*)(ws + WS_WDN) + (size_t)le * 2048 * 1024, 0, kb * 64, nb * 64, pg8::W8_SCALE, scr, lane); }
#else
                cvt_item(args.in[16] + (size_t)le * 1024 * 2048, 2048, 1024, (bf16*)(ws + WS_WDN) + (size_t)le * 2048 * 1024, 0, kb * 64, nb * 64, scr, lane); }
#endif
        }
        for (size_t i = (size_t)gw * 64 + lane; i < (size_t)NTOK * DM / 4; i += (size_t)NGW * 64) {
            const f32x4 v = ((const f32x4*)x_in)[i];
            v2u o; o.x = pk2(v[0], v[1]); o.y = pk2(v[2], v[3]); ((v2u*)HB)[i] = o; }
        for (int i = bx * (NWAVES * 64) + tid; i < 2048 * 32; i += G * NWAVES * 64) { const int pos = i >> 5, f = i & 31;
            const float inv = __builtin_amdgcn_exp2f(-(float)f * 0.4152410118609203f); const float ang = (float)pos * inv;
            const double tr = (double)ang * 0.15915494309189535; const float fr = (float)(tr - __builtin_rint(tr));
            COS[i] = __builtin_amdgcn_cosf(fr); SIN[i] = __builtin_amdgcn_sinf(fr); }
        for (int i = bx * (NWAVES * 64) + tid; i < NLAYER * 20 * 2048; i += G * NWAVES * 64) { const int k = i & 2047, c = (i >> 11) % 20, l = i / (20 * 2048);
            WR[i] = c < 4 ? args.in[12][((size_t)l * 2048 + k) * 4 + c] : args.in[13][(((size_t)l * 4 + ((c - 4) >> 2)) * 2048 + k) * 4 + ((c - 4) & 3)]; }
        }
        SEAM(0);
    }

    for (int L = 0; L < NLAYER; ++L) {
        const int sb = 1 + 8 * L; const bool typeA = L < 2;
        if (IN(sb + 0)) {
            if (typeA && PHM(1)) { PREP(1) {
                pg8::Gemm g{HB, (const bf16*)(ws + WS_WQKVA) + (size_t)L * 6144 * 2048, NTOK, 6144, DM}; pg8::StaticOrder S; S.init(NTOK, 6144, G, bx);
                pg8::EpiQkv E{QKV, 6144, 2048, SB_QSCALE};
                pg8::gemm_phase<pg8::EpiQkv, pg8::StaticOrder, true, true>(lds + RING_OFF, g, S, E); }
            } else if (!typeA && PHM(2)) { PREP(2) {
                const int N = (L == 2) ? 6144 : 2048;
                pg8::Gemm g{HB, (const bf16*)(ws + WS_WQKVB) + (L == 2 ? (size_t)0 : (size_t)6144 * 2048), NTOK, N, DM}; pg8::StaticOrder S; S.init(NTOK, N, G, bx);
                pg8::EpiRope E{QKV, 6144, 2048, 4096, DF_QSCALE, COS, SIN};
                pg8::gemm_phase<pg8::EpiRope, pg8::StaticOrder, true, true>(lds + RING_OFF, g, S, E); }
            }
            SEAM(sb + 0);
        }
        if (IN(sb + 1)) {
            if (typeA && PHM(3)) {
                for (int id_ = vcu; id_ < 512 * (1 + ((PROBE_DUP >> 3) & 1)); id_ += G) { const int id = id_ & 511; const int bh = id >> 2, p = id & 3, b = bh >> 4, h = bh & 15;
                    const bf16* Qg = QKV + (size_t)b * SEQ * 6144 + h * 128; bf16* Og = (bf16*)((unsigned char*)OB + ((size_t)b * SEQ * DM + h * 128) * (WO_F8 ? 1 : 2));
                    att::sb_block(Qg, Qg + 2048, Qg + 4096, Og, 7 - p, (att::ldsp)(lds + RING_OFF));
                    att::sb_block(Qg, Qg + 2048, Qg + 4096, Og, p, (att::ldsp)(lds + RING_OFF)); }
            } else if (!typeA && PHM(4)) {
                const int lane = opq_tid() & 63;
                const int i = L - 2; const float lam_init = (L == 2) ? 0.47071301834264183f : 0.5560582041556061f;
                const float* lp = args.in[6] + (size_t)i * 256;
                const float sa = dpp_sum(lp[lane] * lp[64 + lane]), sb2 = dpp_sum(lp[128 + lane] * lp[192 + lane]);
                const float lam = __builtin_amdgcn_exp2f(sa * LOG2E) - __builtin_amdgcn_exp2f(sb2 * LOG2E) + lam_init;
                const float* gsub = args.in[7] + (size_t)i * 128; const float gmul = 1.f - lam_init;
                for (int id_ = vcu; id_ < 512 * (1 + ((PROBE_DUP >> 4) & 1)); id_ += G) { const int id = id_ & 511; const int bh = id >> 2, p = id & 3, b = bh >> 4, h = bh & 15;
                    const bf16* Qg = QKV + (size_t)b * SEQ * 6144 + h * 128; bf16* Og = (bf16*)((unsigned char*)OB + ((size_t)b * SEQ * DM + h * 128) * (WO_F8 ? 1 : 2)); float* Sg = S1 + (size_t)b * SEQ * DM + h * 128;
#pragma unroll 1
                    for (int w = 0; w < 2; ++w) { const int qb = w ? p : 7 - p;
                        att::diff_pass<false>(Qg, Qg + 2048, Qg + 4096, Sg, Og, qb, lam, gsub, gmul, (att::ldsp)(lds + RING_OFF));
                        att::diff_pass<true>(Qg + 64, Qg + 2048 + 64, Qg + 4096, Sg, Og, qb, lam, gsub, gmul, (att::ldsp)(lds + RING_OFF)); } }
            }
            SEAM(sb + 1);
        }
        if (IN(sb + 2)) { if (PHM(5)) {
            const float* hsrc = (L == 0) ? x_in : H;
#if WO_F8
            pg8::Gemm g{OB, (const bf16*)(ws + (typeA ? WS_WOA : WS_WOB)) + (size_t)(L & 1) * 2048 * 2048, NTOK, DM, DM / 2}; pg8::StaticOrder S; S.init(NTOK, DM, G, bx);
            pg8::EpiResid<512> E{H, hsrc};
            pg8::gemm_phase<pg8::EpiResid<512>, pg8::StaticOrder, true, true, true>(lds + RING_OFF, g, S, E); }
#else
            pg8::Gemm g{OB, (const bf16*)(ws + (typeA ? WS_WOA : WS_WOB)) + (size_t)(L & 1) * 2048 * 2048, NTOK, DM, DM}; pg8::StaticOrder S; S.init(NTOK, DM, G, bx);
            pg8::EpiResid<1> E{H, hsrc};
            pg8::gemm_phase<pg8::EpiResid<1>, pg8::StaticOrder, true, true>(lds + RING_OFF, g, S, E); }
#endif
            SEAM(sb + 2);
        }
        if (IN(sb + 3)) { if (PHM(6)) {
            const int tid = opq_tid(), lane = tid & 63;
            const float* lng = args.in[8] + (size_t)L * DM; const float* lnb = args.in[9] + (size_t)L * DM; const float* wr = WR + (size_t)L * 20 * 2048;
            LAS int* eid = (LAS int*)(lds + RING_OFF);
            LAS float* lgt = (LAS float*)(lds + RING_OFF + 2048);
            for (int c = bx; c < 256; c += G) {
#pragma unroll 1
                for (int grp = 0; grp < 2; ++grp) {
                    const int rloc = wave * 8 + grp * 4; const size_t row0 = (size_t)64 * c + rloc;
                    f32x4 v[4][8]; float mu[4], rstd[4];
#pragma unroll
                    for (int rr = 0; rr < 4; ++rr) { const f32x4* hp = (const f32x4*)(H + (row0 + rr) * DM) + lane;
#pragma unroll
                        for (int j = 0; j < 8; ++j) v[rr][j] = hp[64 * j]; }
#pragma unroll
                    for (int rr = 0; rr < 4; ++rr) { float s = 0.f;
#pragma unroll
                        for (int j = 0; j < 8; ++j) s += (v[rr][j][0] + v[rr][j][1]) + (v[rr][j][2] + v[rr][j][3]);
                        mu[rr] = dpp_sum(s) * (1.f / DM); float q = 0.f;
#pragma unroll
                        for (int j = 0; j < 8; ++j) { const f32x4 d = v[rr][j] - mu[rr]; q += (d[0] * d[0] + d[1] * d[1]) + (d[2] * d[2] + d[3] * d[3]); }
                        rstd[rr] = 1.f / sqrtf(dpp_sum(q) * (1.f / DM) + LN_EPS); }
#pragma unroll
                    for (int j = 0; j < 8; ++j) { const f32x4 gg = ((const f32x4*)lng)[64 * j + lane], bb = ((const f32x4*)lnb)[64 * j + lane];
#pragma unroll
                        for (int rr = 0; rr < 4; ++rr) { v[rr][j] = (v[rr][j] - mu[rr]) * rstd[rr] * gg + bb; ((f32x4*)(H + (row0 + rr) * DM))[64 * j + lane] = v[rr][j]; } }
#pragma unroll 1
                    for (int cc = 0; cc < 20; ++cc) { const f32x4* wp = (const f32x4*)(wr + cc * 2048) + lane; float a[4] = {0.f, 0.f, 0.f, 0.f};
#pragma unroll
                        for (int j = 0; j < 8; ++j) { const f32x4 w = wp[64 * j];
#pragma unroll
                            for (int rr = 0; rr < 4; ++rr) a[rr] += (v[rr][j][0] * w[0] + v[rr][j][1] * w[1]) + (v[rr][j][2] * w[2] + v[rr][j][3] * w[3]); }
#pragma unroll
                        for (int rr = 0; rr < 4; ++rr) a[rr] = dpp_sum(a[rr]);
                        if (lane == 0) { lgt[rloc * 20 + cc] = a[0]; lgt[(rloc + 1) * 20 + cc] = a[1]; lgt[(rloc + 2) * 20 + cc] = a[2]; lgt[(rloc + 3) * 20 + cc] = a[3]; } }
                }
                LDS_WAIT();
                if (lane < 8) {
                    const int rl = wave * 8 + lane; const LAS float* lg = lgt + rl * 20;
                    int gsel = 0; float gm = lg[0];
#pragma unroll
                    for (int i = 1; i < 4; ++i) { const float x = lg[i]; if (x > gm) { gm = x; gsel = i; } }
                    float gden = 0.f;
#pragma unroll
                    for (int i = 0; i < 4; ++i) gden += __builtin_amdgcn_exp2f((lg[i] - gm) * LOG2E);
                    const float gw_ = 1.f / gden;
                    const LAS float* li = lg + 4 + 4 * gsel;
                    const float l0 = li[0], l1 = li[1], l2 = li[2], l3 = li[3];
                    int i0 = 0; float v0 = l0;
                    if (l1 > v0) { v0 = l1; i0 = 1; } if (l2 > v0) { v0 = l2; i0 = 2; } if (l3 > v0) { v0 = l3; i0 = 3; }
                    int i1 = -1; float v1 = 0.f;
                    if (i0 != 0) { v1 = l0; i1 = 0; }
                    if (i0 != 1 && (i1 < 0 || l1 > v1)) { v1 = l1; i1 = 1; }
                    if (i0 != 2 && (i1 < 0 || l2 > v1)) { v1 = l2; i1 = 2; }
                    if (i0 != 3 && (i1 < 0 || l3 > v1)) { v1 = l3; i1 = 3; }
                    const float t = __builtin_amdgcn_exp2f((v1 - v0) * LOG2E); const float w0 = gw_ / (1.f + t), w1 = gw_ * t / (1.f + t);
                    eid[2 * rl] = gsel * 4 + i0; eid[2 * rl + 1] = gsel * 4 + i1; RW[(size_t)64 * c + rl] = (f32x2){w0, w1};
                }
                __syncthreads();
                if (wave == 0) {
                    const int ea = eid[lane], eb = eid[64 + lane]; int ra = 0, rb = 0, cnt = 0; const unsigned long long lt = (1ull << lane) - 1ull;
#pragma unroll
                    for (int e = 0; e < 16; ++e) { const unsigned long long ma = __ballot(ea == e), mb = __ballot(eb == e);
                        if (ea == e) ra = __popcll(ma & lt); if (eb == e) rb = __popcll(ma) + __popcll(mb & lt); if (lane == e) cnt = __popcll(ma) + __popcll(mb); }
                    if (lane < 16) CNT[c * 16 + lane] = cnt;
                    LAS int* rk = (LAS int*)(lds + RING_OFF + 1024); rk[lane] = ra; rk[64 + lane] = rb; LDS_WAIT();
                    const int r = lane; const unsigned word = (unsigned)eid[2 * r] | ((unsigned)eid[2 * r + 1] << 8) | ((unsigned)rk[2 * r] << 16) | ((unsigned)rk[2 * r + 1] << 24);
                    RE[(size_t)64 * c + r] = word;
                }
                __syncthreads();
            } }
            SEAM(sb + 3);
        }
        if ((IN(sb + 4) || IN(sb + 5) || IN(sb + 6)) && PHM(7)) {
            const int tid = opq_tid();
            LAS int* part = (LAS int*)(lds + RING_OFF);
            { const int e = tid & 15, s = tid >> 4; int a = 0;
#pragma unroll
              for (int i = 0; i < 8; ++i) a += CNT[(8 * s + i) * 16 + e];
              part[s * 16 + e] = a; }
            __syncthreads();
            if (tid < 16) { int run = 0;
#pragma clang loop vectorize(disable) unroll(disable)
                for (int s = 0; s < 32; ++s) run += part[s * 16 + tid];
                TAB[tid] = run; }
            __syncthreads();
            if (tid == 0) { int off = 0, mt = 0;
#pragma clang loop vectorize(disable) unroll(disable)
                for (int e = 0; e < 16; ++e) { TAB[16 + e] = off; const int nt = (TAB[e] + 255) >> 8;
#pragma clang loop vectorize(disable) unroll(disable)
                    for (int i = 0; i < nt; ++i) TAB[64 + mt++] = e;
                    off += nt * 256; }
                TAB[32] = off; TAB[33] = mt; }
            __syncthreads();
        }
        if (IN(sb + 4)) { if (PHM(7)) PREP(7) {
            const int tid = opq_tid(), lane = tid & 63;
            LAS int* part = (LAS int*)(lds + RING_OFF);
            for (int c = bx; c < 256; c += G) {
                if (tid < 16) { int pre = 0;
#pragma clang loop vectorize(disable) unroll(disable)
                    for (int s = 0; s < (c >> 3); ++s) pre += part[s * 16 + tid];
#pragma clang loop vectorize(disable) unroll(disable)
                    for (int cc = c & ~7; cc < c; ++cc) pre += CNT[cc * 16 + tid];
                    TAB[48 + tid] = TAB[16 + tid] + pre; }
                __syncthreads();
#pragma unroll 1
                for (int rr = 0; rr < 8; ++rr) { const size_t row = (size_t)64 * c + wave * 8 + rr; const unsigned word = RE[row];
                    const int p0 = TAB[48 + (word & 255)] + ((word >> 16) & 255), p1 = TAB[48 + ((word >> 8) & 255)] + (word >> 24);
                    if (lane == 0) { RP[2 * row] = p0; RP[2 * row + 1] = p1; }
#if MOE_F8
                    const f32x4* hp = (const f32x4*)(H + row * DM) + lane; unsigned* o0 = (unsigned*)((unsigned char*)XS + (size_t)p0 * DM) + lane; unsigned* o1 = (unsigned*)((unsigned char*)XS + (size_t)p1 * DM) + lane;
#pragma unroll
                    for (int j = 0; j < 8; ++j) { const f32x4 v = hp[64 * j]; const unsigned o = pg8::pack4_fp8(v[0], v[1], v[2], v[3]); o0[64 * j] = o; o1[64 * j] = o; } }
#else
                    const f32x4* hp = (const f32x4*)(H + row * DM) + lane; v2u* o0 = (v2u*)(XS + (size_t)p0 * DM) + lane; v2u* o1 = (v2u*)(XS + (size_t)p1 * DM) + lane;
#pragma unroll
                    for (int j = 0; j < 8; ++j) { const f32x4 v = hp[64 * j]; v2u o; o.x = pk2(v[0], v[1]); o.y = pk2(v[2], v[3]); o0[64 * j] = o; o1[64 * j] = o; } }
#endif
                __syncthreads();
            } }
            SEAM(sb + 4);
        }
        if (IN(sb + 5)) { if (PHM(8)) PREP(8) {
#if MOE_F8
            pg8::Gemm g{XS, (const bf16*)(ws + WS_WGU + (size_t)L * 16 * 2048 * 2048), XS_ROWS, 2048, DM / 2};
            pg8::MoeOrder S{TAB[33] * 8, G, bx, TAB + 64}; pg8::EpiGateUp8 E{(unsigned char*)ACT};
            pg8::gemm_phase<pg8::EpiGateUp8, pg8::MoeOrder, true, true, true>(lds + RING_OFF, g, S, E); }
#else
            pg8::Gemm g{XS, (const bf16*)(ws + WS_WGU) + (size_t)L * 16 * 2048 * 2048, XS_ROWS, 2048, DM};
            pg8::MoeOrder S{TAB[33] * 8, G, bx, TAB + 64}; pg8::EpiGateUp E{ACT};
            pg8::gemm_phase<pg8::EpiGateUp, pg8::MoeOrder, true, true>(lds + RING_OFF, g, S, E); }
#endif
            SEAM(sb + 5);
        }
        if (IN(sb + 6)) { if (PHM(9)) PREP(9) {
#if MOE_F8
            pg8::Gemm g{ACT, (const bf16*)(ws + WS_WDN + (size_t)L * 16 * 2048 * 1024), XS_ROWS, 2048, DEXP / 2};
            pg8::MoeOrder S{TAB[33] * 8, G, bx, TAB + 64}; pg8::EpiDown8 E{YD};
            pg8::gemm_phase<pg8::EpiDown8, pg8::MoeOrder, true, true, true>(lds + RING_OFF, g, S, E); }
#else
            pg8::Gemm g{ACT, (const bf16*)(ws + WS_WDN) + (size_t)L * 16 * 2048 * 1024, XS_ROWS, 2048, DEXP};
            pg8::MoeOrder S{TAB[33] * 8, G, bx, TAB + 64}; pg8::EpiDown E{YD};
            pg8::gemm_phase<pg8::EpiDown, pg8::MoeOrder, true, true>(lds + RING_OFF, g, S, E); }
#endif
            SEAM(sb + 6);
        }
        if (IN(sb + 7)) { if (PHM(10)) for (int rep_ = 0; rep_ < ((((PROBE_DUP) >> 10) & 1) && L == NLAYER - 1 ? 5 : 1); ++rep_) {
            const int tid = opq_tid(), lane = tid & 63;
            const float* lng = args.in[10] + (size_t)L * DM; const float* lnb = args.in[11] + (size_t)L * DM; const bool last = (L == NLAYER - 1);
            const int gw = vcu * NWAVES + wave, NGW = G * NWAVES;
            for (int row = gw; row < NTOK; row += NGW) {
                const int p0 = RP[2 * row], p1 = RP[2 * row + 1]; const f32x2 w = RW[row];
                const f32x4* hp = (const f32x4*)(H + (size_t)row * DM) + lane; const v2u* y0 = (const v2u*)(YD + (size_t)p0 * DM) + lane; const v2u* y1 = (const v2u*)(YD + (size_t)p1 * DM) + lane;
                f32x4 v[8]; float s = 0.f;
#pragma unroll
                for (int j = 0; j < 8; ++j) { const f32x4 h = hp[64 * j]; const v2u a = y0[64 * j], b = y1[64 * j];
                    const f32x4 fa = {__uint_as_float(a.x << 16), __uint_as_float(a.x & 0xffff0000u), __uint_as_float(a.y << 16), __uint_as_float(a.y & 0xffff0000u)};
                    const f32x4 fb = {__uint_as_float(b.x << 16), __uint_as_float(b.x & 0xffff0000u), __uint_as_float(b.y << 16), __uint_as_float(b.y & 0xffff0000u)};
                    v[j] = h * DN_ALPHA + fa * w.x + fb * w.y; s += (v[j][0] + v[j][1]) + (v[j][2] + v[j][3]); }
                const float mu = dpp_sum(s) * (1.f / DM); float q = 0.f;
#pragma unroll
                for (int j = 0; j < 8; ++j) { const f32x4 d = v[j] - mu; q += (d[0] * d[0] + d[1] * d[1]) + (d[2] * d[2] + d[3] * d[3]); }
                const float rstd = 1.f / sqrtf(dpp_sum(q) * (1.f / DM) + LN_EPS);
                f32x4* op = (f32x4*)((last ? args.out : H) + (size_t)row * DM) + lane; v2u* ob = (v2u*)(HB + (size_t)row * DM) + lane;
#pragma unroll
                for (int j = 0; j < 8; ++j) { const f32x4 gg = ((const f32x4*)lng)[64 * j + lane], bb = ((const f32x4*)lnb)[64 * j + lane];
                    const f32x4 y = (v[j] - mu) * rstd * gg + bb; op[64 * j] = y;
                    if (!last) { v2u o; o.x = pk2(y[0], y[1]); o.y = pk2(y[2], y[3]); ob[64 * j] = o; } }
            } }
            SEAM(sb + 7);
        }
    }
#undef IN
#undef SEAM
}

extern "C" void kernel_launch(void* const* d_in, const int* in_sizes, int n_in, void* d_out, int out_size, void* d_ws, size_t ws_size, hipStream_t stream) {
    static int grid = 0;
    if (grid == 0) {
        if (n_in != 17 || in_sizes[0] != NTOK * DM || out_size != NTOK * DM || ws_size < WS_END) { fprintf(stderr, "kernel_launch: unexpected shapes / workspace (n_in %d, ws %zu, need %zu)\n", n_in, ws_size, (size_t)WS_END); grid = -1; return; }
        int dev = 0, cus = 0, per_cu = 0;
        if (hipGetDevice(&dev) != hipSuccess || hipDeviceGetAttribute(&cus, hipDeviceAttributeMultiprocessorCount, dev) != hipSuccess) { grid = -1; return; }
        if (hipFuncSetAttribute((const void*)yoco_fwd, hipFuncAttributeMaxDynamicSharedMemorySize, LDS_BYTES) != hipSuccess) { fprintf(stderr, "kernel_launch: hipFuncSetAttribute failed\n"); grid = -1; return; }
        if (hipOccupancyMaxActiveBlocksPerMultiprocessor(&per_cu, (const void*)yoco_fwd, NWAVES * 64, LDS_BYTES) != hipSuccess || per_cu < 1) { fprintf(stderr, "kernel_launch: occupancy query says %d\n", per_cu); per_cu = 1; }
        (void)hipGetLastError();
        grid = cus;
    }
    if (grid < 0) return;
    (void)hipMemsetAsync((char*)d_ws + WS_CTL, 0, CTL_ZERO_BYTES, stream);
    Args a{};
    for (int i = 0; i < 17; ++i) a.in[i] = (const float*)d_in[i];
    a.out = (float*)d_out; a.ws = (unsigned char*)d_ws;
#if MK_MULTI
    for (int s = 0; s < NSTEPS; ++s) { a.s_lo = s; a.s_hi = s + 1; hipLaunchKernelGGL(yoco_fwd, dim3(grid), dim3(NWAVES * 64), LDS_BYTES, stream, a); }
#else
    a.s_lo = 0; a.s_hi = NSTEPS;
    hipLaunchKernelGGL(yoco_fwd, dim3(grid), dim3(NWAVES * 64), LDS_BYTES, stream, a);
#endif
    const hipError_t le = hipPeekAtLastError();
    if (le != hipSuccess) fprintf(stderr, "kernel_launch: launch failed: %s\n", hipGetErrorName(le));
}
```

```cpp
#include <hip/hip_runtime.h>
#include <cstdio>
#include <cstdint>

namespace pg8 {
#define PG8_LAS __attribute__((address_space(3)))
typedef unsigned short bf16_t;
typedef short bf16x8 __attribute__((ext_vector_type(8)));
typedef float f32x4 __attribute__((ext_vector_type(4)));
typedef unsigned u32x4 __attribute__((ext_vector_type(4)));
typedef int pg8_v8i __attribute__((ext_vector_type(8)));
constexpr int BM = 256, BK = 64, HALF = 128, HTB = HALF * BK * 2  , STAGE_BYTES = 8 * HTB, NXCD = 8, WGM = 8;

__host__ __device__ __forceinline__ int lds_byte(int r, int c) { const int st = (r >> 4) * 2 + (c >> 5), rr = r & 15, cc = c & 31, ob = rr * 64 + cc * 2; return st * 1024 + (ob ^ (((ob >> 9) & 1) << 5)); }
__host__ __device__ __forceinline__ void stage_rc(int b, int& R, int& C) { const int st = b / 1024, sb = b % 1024, swz = sb ^ (((sb >> 9) & 1) << 5); R = (st >> 1) * 16 + swz / 64; C = (st & 1) * 32 + (swz % 64) / 2; }
__host__ __device__ __forceinline__ int perm32(int rho) { const int n = rho >> 4, i = rho & 15; return 8 * (i >> 2) + 4 * n + (i & 3); }

struct Unit { int pm, pn; };
struct Gemm { const bf16_t* A; const bf16_t* Bt; int M, N, K, ld; };

struct StaticOrder {
    int nM, nN, nwg, G, c;
    __host__ __device__ void init(int M, int N, int G_, int c_) { nM = M / BM; nN = N / BM; nwg = nM * nN; G = G_; c = c_; }
    __host__ __device__ bool next(int i, Unit& u) const {
        const long L = (long)i * G + c; if (L >= nwg) return false;
        int wgid = (int)L; { const int q = nwg / NXCD, r = nwg % NXCD, xcd = wgid % NXCD, off = wgid / NXCD; wgid = (xcd < r ? xcd * (q + 1) : r * (q + 1) + (xcd - r) * q) + off; }
        const int nig = WGM * nN, gid = wgid / nig, fm = gid * WGM, gsz = (nM - fm) < WGM ? (nM - fm) : WGM;
        u.pm = fm + ((wgid % nig) % gsz); u.pn = (wgid % nig) / gsz; return true;
    }
    __device__ __forceinline__ void a_ready(const Unit&) const {}
    __device__ __forceinline__ void done(const Unit&) const {}
};

__device__ __forceinline__ unsigned cvt_pk_bf16(float lo, float hi) { unsigned r; asm volatile("v_cvt_pk_bf16_f32 %0, %1, %2" : "=v"(r) : "v"(lo), "v"(hi)); return r; }
typedef float f32x2 __attribute__((ext_vector_type(2)));

typedef unsigned u32x2 __attribute__((ext_vector_type(2)));
__device__ __forceinline__ u32x4 pack8_bf16(const f32x4 a, const f32x4 b) { u32x4 w; w.x = cvt_pk_bf16(a[0], a[1]); w.y = cvt_pk_bf16(a[2], a[3]); w.z = cvt_pk_bf16(b[0], b[1]); w.w = cvt_pk_bf16(b[2], b[3]); return w; }

struct EpiQkv {
    static constexpr bool PERM = true, AFTER_DRAIN = false;
    bf16_t* O; int ldc; int qcols; float qscale;
    __device__ __forceinline__ void operator()(const f32x4 (&acc)[2][2][4][2], const Unit& u, int wr, int wc, int fr, int fq) const {
        const int row0 = u.pm * BM + wr * 64 + fr, colt = u.pn * BM; const float sc = colt < qcols ? qscale : 1.f;
        const int col0 = colt + wc * 32 + 8 * fq;
#pragma unroll
        for (int ai = 0; ai < 2; ++ai)
#pragma unroll
            for (int m = 0; m < 4; ++m) { bf16_t* rowp = O + (size_t)(row0 + ai * HALF + m * 16) * ldc + col0;
#pragma unroll
                for (int bj = 0; bj < 2; ++bj) *(u32x4*)(rowp + bj * HALF) = pack8_bf16(acc[ai][bj][m][0] * sc, acc[ai][bj][m][1] * sc); }
    }
};
template <int ACCS_INV> struct EpiResid {
    static constexpr bool PERM = false, AFTER_DRAIN = false;
    static constexpr int ldc = 2048; static constexpr float alpha = 1.6817928305074292f, accs = 1.f / (float)ACCS_INV;
    float* H; const float* Hsrc;
    __device__ __forceinline__ void operator()(const f32x4 (&acc)[2][2][4][2], const Unit& u, int wr, int wc, int fr, int fq) const {
        const int row0 = u.pm * BM + wr * 64 + fr, col0 = u.pn * BM + wc * 32 + 4 * fq;
#pragma unroll
        for (int ai = 0; ai < 2; ++ai)
#pragma unroll
            for (int m = 0; m < 4; ++m) { const size_t ro = (size_t)(row0 + ai * HALF + m * 16) * ldc + col0; float* rowp = H + ro; const float* srcp = Hsrc + ro;
#pragma unroll
                for (int bj = 0; bj < 2; ++bj)
#pragma unroll
                    for (int n = 0; n < 2; ++n) { const f32x4 h = *(const f32x4*)(srcp + bj * HALF + n * 16); *(f32x4*)(rowp + bj * HALF + n * 16) = h * alpha + acc[ai][bj][m][n] * accs; } }
    }
};
struct EpiRope {
    static constexpr bool PERM = true, AFTER_DRAIN = false;
    bf16_t* O; int ldc; int qcols, ropecols; float qscale; const float* ctab; const float* stab;
    __device__ __forceinline__ void operator()(const f32x4 (&acc)[2][2][4][2], const Unit& u, int wr, int wc, int fr, int fq) const {
        const int row0 = u.pm * BM + wr * 64 + fr, colt = u.pn * BM;
        if (colt >= ropecols) {
            const int col0 = colt + wc * 32 + 8 * fq;
#pragma unroll
            for (int ai = 0; ai < 2; ++ai)
#pragma unroll
                for (int m = 0; m < 4; ++m) { bf16_t* rowp = O + (size_t)(row0 + ai * HALF + m * 16) * ldc + col0;
#pragma unroll
                    for (int bj = 0; bj < 2; ++bj) *(u32x4*)(rowp + bj * HALF) = pack8_bf16(acc[ai][bj][m][0], acc[ai][bj][m][1]); }
        } else {
            const float sc = colt < qcols ? qscale : 1.f;
            const int col0 = colt + wc * 64 + 8 * fq;
#pragma unroll
            for (int ai = 0; ai < 2; ++ai)
#pragma unroll
                for (int m = 0; m < 4; ++m) { const int row = row0 + ai * HALF + m * 16; const int pos = row & 2047;
                    const f32x4 c0 = *(const f32x4*)(ctab + pos * 32 + 8 * fq), c1 = *(const f32x4*)(ctab + pos * 32 + 8 * fq + 4);
                    const f32x4 s0 = *(const f32x4*)(stab + pos * 32 + 8 * fq), s1 = *(const f32x4*)(stab + pos * 32 + 8 * fq + 4);
                    const f32x4 a0 = acc[ai][0][m][0], a1 = acc[ai][0][m][1], b0 = acc[ai][1][m][0], b1 = acc[ai][1][m][1];
                    bf16_t* rowp = O + (size_t)row * ldc + col0;
                    *(u32x4*)(rowp) = pack8_bf16((a0 * c0 - b0 * s0) * sc, (a1 * c1 - b1 * s1) * sc);
                    *(u32x4*)(rowp + 32) = pack8_bf16((b0 * c0 + a0 * s0) * sc, (b1 * c1 + a1 * s1) * sc); }
        }
    }
};
struct EpiGateUp {
    static constexpr bool PERM = true, AFTER_DRAIN = false;
    bf16_t* O;
    __device__ __forceinline__ void operator()(const f32x4 (&acc)[2][2][4][2], const Unit& u, int wr, int wc, int fr, int fq) const {
        const int row0 = u.pm * BM + wr * 64 + fr, col0 = (u.pn & 7) * 128 + wc * 32 + 8 * fq;
#pragma unroll
        for (int ai = 0; ai < 2; ++ai)
#pragma unroll
            for (int m = 0; m < 4; ++m) { f32x4 r[2];
#pragma unroll
                for (int n = 0; n < 2; ++n) { const f32x4 g = acc[ai][0][m][n], up = acc[ai][1][m][n];
#pragma unroll
                    for (int i = 0; i < 4; ++i) { const float e = __builtin_amdgcn_exp2f(g[i] * -1.4426950408889634f); r[n][i] = g[i] * __builtin_amdgcn_rcpf(1.f + e) * up[i]; } }
                *(u32x4*)(O + (size_t)(row0 + ai * HALF + m * 16) * 1024 + col0) = pack8_bf16(r[0], r[1]); }
    }
};
struct EpiDown {
    static constexpr bool PERM = true, AFTER_DRAIN = false;
    bf16_t* O;
    __device__ __forceinline__ void operator()(const f32x4 (&acc)[2][2][4][2], const Unit& u, int wr, int wc, int fr, int fq) const {
        const int row0 = u.pm * BM + wr * 64 + fr, col0 = (u.pn & 7) * BM + wc * 32 + 8 * fq;
#pragma unroll
        for (int ai = 0; ai < 2; ++ai)
#pragma unroll
            for (int m = 0; m < 4; ++m) { bf16_t* rowp = O + (size_t)(row0 + ai * HALF + m * 16) * 2048 + col0;
#pragma unroll
                for (int bj = 0; bj < 2; ++bj) *(u32x4*)(rowp + bj * HALF) = pack8_bf16(acc[ai][bj][m][0], acc[ai][bj][m][1]); }
    }
};
constexpr float W8_SCALE = 64.f, ACT8_SCALE = 4.f;
__device__ __forceinline__ unsigned pack4_fp8(float a, float b, float c, float d) { int w; asm volatile("" : "=v"(w));
    w = __builtin_amdgcn_cvt_pk_fp8_f32(a, b, w, false); w = __builtin_amdgcn_cvt_pk_fp8_f32(c, d, w, true); return (unsigned)w; }
struct EpiGateUp8 {
    static constexpr bool PERM = true, AFTER_DRAIN = false;
    unsigned char* O;
    __device__ __forceinline__ void operator()(const f32x4 (&acc)[2][2][4][2], const Unit& u, int wr, int wc, int fr, int fq) const {
        const int row0 = u.pm * BM + wr * 64 + fr, col0 = (u.pn & 7) * 128 + wc * 32 + 8 * fq;
        constexpr float SI = 1.f / W8_SCALE;
#pragma unroll
        for (int ai = 0; ai < 2; ++ai)
#pragma unroll
            for (int m = 0; m < 4; ++m) { f32x4 r[2];
#pragma unroll
                for (int n = 0; n < 2; ++n) { const f32x4 g = acc[ai][0][m][n] * SI, up = acc[ai][1][m][n] * (SI * ACT8_SCALE);
#pragma unroll
                    for (int i = 0; i < 4; ++i) { const float e = __builtin_amdgcn_exp2f(g[i] * -1.4426950408889634f); r[n][i] = g[i] * __builtin_amdgcn_rcpf(1.f + e) * up[i]; } }
                u32x2 w; w.x = pack4_fp8(r[0][0], r[0][1], r[0][2], r[0][3]); w.y = pack4_fp8(r[1][0], r[1][1], r[1][2], r[1][3]);
                *(u32x2*)(O + (size_t)(row0 + ai * HALF + m * 16) * 1024 + col0) = w; }
    }
};
constexpr float YD8_SCALE = 16.f;
struct EpiDown8 {
    static constexpr bool PERM = true, AFTER_DRAIN = false;
    unsigned char* O;
    __device__ __forceinline__ void operator()(const f32x4 (&acc)[2][2][4][2], const Unit& u, int wr, int wc, int fr, int fq) const {
        const int row0 = u.pm * BM + wr * 64 + fr, col0 = (u.pn & 7) * BM + wc * 32 + 8 * fq;
        constexpr float SI = YD8_SCALE / (W8_SCALE * ACT8_SCALE);
#pragma unroll
        for (int ai = 0; ai < 2; ++ai)
#pragma unroll
            for (int m = 0; m < 4; ++m) { unsigned char* rowp = O + (size_t)(row0 + ai * HALF + m * 16) * 2048 + col0;
#pragma unroll
                for (int bj = 0; bj < 2; ++bj) { const f32x4 a = acc[ai][bj][m][0] * SI, c = acc[ai][bj][m][1] * SI; u32x2 w; w.x = pack4_fp8(a[0], a[1], a[2], a[3]); w.y = pack4_fp8(c[0], c[1], c[2], c[3]);
                    *(u32x2*)(rowp + bj * HALF) = w; } }
    }
};
struct MoeOrder {
    int nunits, G, c; const PG8_LAS int* tile_e;
    __device__ __forceinline__ bool next(int i, Unit& u) const {
        int idx;
        if ((G & 7) == 0) { const int per = G >> 3; idx = (i * 8 + (c & 7)) * per + (c >> 3); } else idx = i * G + c;
        if (idx >= nunits) return false;
        const int mt = idx >> 3; u.pm = mt; u.pn = tile_e[mt] * 8 + (idx & 7); return true;
    }
    __device__ __forceinline__ void a_ready(const Unit&) const {}
    __device__ __forceinline__ void done(const Unit&) const {}
};

template <class Epi, class Sched, bool ALIGN_EPI = false, bool SP2 = false, bool F8 = false>
__device__ __forceinline__ void gemm_phase(PG8_LAS unsigned char* lds, const Gemm g, const Sched& S, const Epi& E) {
    int tid_ = threadIdx.x; asm volatile("" : "+v"(tid_));
    const int tid = tid_, wid = __builtin_amdgcn_readfirstlane(tid >> 6), lane = tid & 63, wr = wid >> 2, wc = wid & 3, fr = lane & 15, fq = lane >> 4;
    const int K = g.K, LD = g.ld, nt = K / BK;
    unsigned voffA, voffB;
    { int R, C; stage_rc(tid * 16, R, C); const int Rb = Epi::PERM ? ((R & ~31) + perm32(R & 31)) : R;
        voffA = (unsigned)(R * LD + C) * 2u; voffB = (unsigned)(Rb * LD + C) * 2u; }
    const size_t pstep = (size_t)64 * LD * 2;
    const size_t kstep = (size_t)(BK * 2);
    const size_t hstep = (size_t)HALF * LD * 2;
    const size_t tstep = 2 * hstep;
    const unsigned ldsbase = (unsigned)(uintptr_t)lds;
    const unsigned ldsw = (unsigned)wid * 1024u;
    const int aoff = lds_byte(wr * 64 + fr, fq * 8), boff = lds_byte(wc * 32 + fr, fq * 8);
#define PG8_SA(b, h) (((b) * 2 + (h)) * HTB)
#define PG8_SB(b, h) ((4 + (b) * 2 + (h)) * HTB)
#define PG8_STAGE(bufoff, gbase, voff) do { _Pragma("unroll") for (int _i = 0; _i < 2; ++_i) { unsigned keep_; \
        asm volatile("s_mov_b32 %0, m0\n\ts_mov_b32 m0, %3\n\ts_nop 0\n\tglobal_load_lds_dwordx4 %1, %2\n\ts_mov_b32 m0, %0" : "=&s"(keep_) \
            : "v"(voff), "s"((const char*)(gbase) + _i * pstep), "s"(ldsbase + (unsigned)(bufoff) + ldsw + (unsigned)(_i * 8192))); } } while (0)
#define PG8_CAT(a, b) __builtin_bit_cast(pg8_v8i, __builtin_shufflevector(a, b, 0, 1, 2, 3, 4, 5, 6, 7, 8, 9, 10, 11, 12, 13, 14, 15))
#define PG8_LDA(dst, b, h) do { if constexpr (F8) { _Pragma("unroll") for (int m = 0; m < 4; ++m) { const bf16x8 lo_ = *(const PG8_LAS bf16x8*)(lds + PG8_SA(b, h) + aoff + m * 2048), hi_ = *(const PG8_LAS bf16x8*)(lds + PG8_SA(b, h) + aoff + m * 2048 + 1024); dst##8[m] = PG8_CAT(lo_, hi_); } } \
        else { _Pragma("unroll") for (int m = 0; m < 4; ++m) _Pragma("unroll") for (int k = 0; k < 2; ++k) dst[m][k] = *(const PG8_LAS bf16x8*)(lds + PG8_SA(b, h) + aoff + m * 2048 + k * 1024); } } while (0)
#define PG8_LDB(dst, b, h) do { if constexpr (F8) { _Pragma("unroll") for (int n = 0; n < 2; ++n) { const bf16x8 lo_ = *(const PG8_LAS bf16x8*)(lds + PG8_SB(b, h) + boff + n * 2048), hi_ = *(const PG8_LAS bf16x8*)(lds + PG8_SB(b, h) + boff + n * 2048 + 1024); dst##8[n] = PG8_CAT(lo_, hi_); } } \
        else { _Pragma("unroll") for (int n = 0; n < 2; ++n) _Pragma("unroll") for (int k = 0; k < 2; ++k) dst[n][k] = *(const PG8_LAS bf16x8*)(lds + PG8_SB(b, h) + boff + n * 2048 + k * 1024); } } while (0)
#define PG8_MMA(ai, bj, At, Bt) do { __builtin_amdgcn_s_setprio(1); \
        if constexpr (F8) { _Pragma("unroll") for (int m = 0; m < 4; ++m) _Pragma("unroll") for (int n = 0; n < 2; ++n) \
            acc[ai][bj][m][n] = __builtin_amdgcn_mfma_scale_f32_16x16x128_f8f6f4(Bt##8[n], At##8[m], acc[ai][bj][m][n], 0, 0, 0, 0, 0, 0); } \
        else { _Pragma("unroll") for (int m = 0; m < 4; ++m) _Pragma("unroll") for (int n = 0; n < 2; ++n) _Pragma("unroll") for (int k = 0; k < 2; ++k) \
            acc[ai][bj][m][n] = __builtin_amdgcn_mfma_f32_16x16x32_bf16(Bt[n][k], At[m][k], acc[ai][bj][m][n], 0, 0, 0); } \
        __builtin_amdgcn_s_setprio(0); } while (0)
#define PG8_WAIT_V(n) asm volatile("s_waitcnt vmcnt(" #n ")" ::: "memory")
#define PG8_WAIT_L(n) asm volatile("s_waitcnt lgkmcnt(" #n ")" ::: "memory")
#define PG8_BAR __builtin_amdgcn_s_barrier()
#define PG8_SCHED __builtin_amdgcn_sched_barrier(0)
    Unit cur, nxt; int ui = 0;
    if (!S.next(0, cur)) return;
    f32x4 acc[2][2][4][2];
{ float zero_; asm volatile("v_mov_b32 %0, 0" : "=v"(zero_));
#pragma unroll
    for (int a = 0; a < 2; ++a)
#pragma unroll
        for (int b = 0; b < 2; ++b)
#pragma unroll
            for (int m = 0; m < 4; ++m)
#pragma unroll
                for (int n = 0; n < 2; ++n) acc[a][b][m][n] = (f32x4){zero_, zero_, zero_, zero_}; }
    bf16x8 At[4][2], B0[2][2], B1[2][2]; pg8_v8i At8[4], B08[2], B18[2];
    const char* cA = (const char*)g.A + (size_t)cur.pm * tstep; const char* cB = (const char*)g.Bt + (size_t)cur.pn * tstep;
    S.a_ready(cur);
    if constexpr (SP2) {
        PG8_STAGE(PG8_SB(0, 0), cB, voffB); PG8_STAGE(PG8_SB(0, 1), cB + hstep, voffB); PG8_STAGE(PG8_SA(0, 0), cA, voffA); PG8_STAGE(PG8_SA(0, 1), cA + hstep, voffA);
        if (wr == 1) PG8_BAR;
        PG8_WAIT_V(2); PG8_BAR;
        PG8_STAGE(PG8_SB(1, 0), cB + kstep, voffB); PG8_STAGE(PG8_SA(1, 0), cA + kstep, voffA); PG8_STAGE(PG8_SB(1, 1), cB + hstep + kstep, voffB);
        PG8_WAIT_V(6); PG8_BAR;
    } else {
        PG8_STAGE(PG8_SB(0, 0), cB, voffB); PG8_STAGE(PG8_SA(0, 0), cA, voffA); PG8_STAGE(PG8_SB(0, 1), cB + hstep, voffB); PG8_STAGE(PG8_SA(0, 1), cA + hstep, voffA);
        if (wr == 1) PG8_BAR;
        PG8_WAIT_V(4); PG8_BAR;
        PG8_STAGE(PG8_SB(1, 0), cB + kstep, voffB); PG8_STAGE(PG8_SA(1, 0), cA + kstep, voffA); PG8_STAGE(PG8_SB(1, 1), cB + hstep + kstep, voffB);
        PG8_WAIT_V(6); PG8_BAR;
    }
    for (;;) {
        const bool has_next = S.next(ui + 1, nxt);
        const char* nA = has_next ? (const char*)g.A + (size_t)nxt.pm * tstep : cA; const char* nB = has_next ? (const char*)g.Bt + (size_t)nxt.pn * tstep : cB;
#pragma unroll 1
        for (int t = 0; t < nt; t += 2) {
            const bool last = (t == nt - 2);
            const char* a1 = cA + (size_t)(t + 1) * kstep;
            const char* a2 = last ? nA : cA + (size_t)(t + 2) * kstep; const char* b2 = last ? nB : cB + (size_t)(t + 2) * kstep;
            const char* a3 = a2 + kstep; const char* b3 = b2 + kstep;
            if (last && has_next) S.a_ready(nxt);
            if constexpr (SP2) {
            PG8_LDB(B0, 0, 0); PG8_LDB(B1, 0, 1); PG8_SCHED; PG8_LDA(At, 0, 0); PG8_STAGE(PG8_SA(1, 1), a1 + hstep, voffA);
            PG8_WAIT_V(8); PG8_WAIT_L(0); PG8_BAR; PG8_MMA(0, 0, At, B0); PG8_MMA(0, 1, At, B1); PG8_BAR; PG8_SCHED;
            PG8_LDA(At, 0, 1); PG8_STAGE(PG8_SB(0, 0), b2, voffB); PG8_STAGE(PG8_SB(0, 1), b2 + hstep, voffB); PG8_STAGE(PG8_SA(0, 0), a2, voffA);
            PG8_WAIT_V(8); PG8_WAIT_L(0); PG8_BAR; PG8_MMA(1, 0, At, B0); PG8_MMA(1, 1, At, B1); PG8_BAR; PG8_SCHED;
            PG8_LDB(B0, 1, 0); PG8_LDB(B1, 1, 1); PG8_SCHED; PG8_LDA(At, 1, 0); PG8_STAGE(PG8_SA(0, 1), a2 + hstep, voffA);
            PG8_WAIT_V(8); PG8_WAIT_L(0); PG8_BAR; PG8_MMA(0, 0, At, B0); PG8_MMA(0, 1, At, B1); PG8_BAR; PG8_SCHED;
            PG8_LDA(At, 1, 1); PG8_STAGE(PG8_SB(1, 0), b3, voffB); PG8_STAGE(PG8_SB(1, 1), b3 + hstep, voffB); PG8_STAGE(PG8_SA(1, 0), a3, voffA);
            PG8_WAIT_V(8); PG8_WAIT_L(0); PG8_BAR; PG8_MMA(1, 0, At, B0); PG8_MMA(1, 1, At, B1); PG8_BAR; PG8_SCHED;
            } else {
            PG8_LDB(B0, 0, 0); PG8_SCHED; PG8_LDA(At, 0, 0); PG8_STAGE(PG8_SA(1, 1), a1 + hstep, voffA);
            PG8_WAIT_L(8); PG8_BAR; PG8_WAIT_L(0); PG8_MMA(0, 0, At, B0); PG8_BAR; PG8_SCHED;
            PG8_LDB(B1, 0, 1); PG8_STAGE(PG8_SB(0, 0), b2, voffB);
            PG8_BAR; PG8_WAIT_L(0); PG8_MMA(0, 1, At, B1); PG8_BAR;
            PG8_LDA(At, 0, 1); PG8_STAGE(PG8_SA(0, 0), a2, voffA);
            PG8_BAR; PG8_WAIT_L(0); PG8_MMA(1, 0, At, B0); PG8_BAR; PG8_SCHED;
            PG8_STAGE(PG8_SB(0, 1), b2 + hstep, voffB);
            PG8_WAIT_V(6); PG8_BAR; PG8_MMA(1, 1, At, B1); PG8_BAR;
            PG8_LDB(B0, 1, 0); PG8_SCHED; PG8_LDA(At, 1, 0); PG8_STAGE(PG8_SA(0, 1), a2 + hstep, voffA);
            PG8_WAIT_L(8); PG8_BAR; PG8_WAIT_L(0); PG8_MMA(0, 0, At, B0); PG8_BAR; PG8_SCHED;
            PG8_LDB(B1, 1, 1); PG8_STAGE(PG8_SB(1, 0), b3, voffB);
            PG8_BAR; PG8_WAIT_L(0); PG8_MMA(0, 1, At, B1); PG8_BAR;
            PG8_LDA(At, 1, 1); PG8_STAGE(PG8_SA(1, 0), a3, voffA);
            PG8_BAR; PG8_WAIT_L(0); PG8_MMA(1, 0, At, B0); PG8_BAR; PG8_SCHED;
            PG8_STAGE(PG8_SB(1, 1), b3 + hstep, voffB);
            PG8_WAIT_V(6); PG8_BAR; PG8_MMA(1, 1, At, B1); PG8_BAR;
            }
        }
        if constexpr (ALIGN_EPI) { if (wr == 0) PG8_BAR; }
        if constexpr (!Epi::AFTER_DRAIN) { E(acc, cur, wr, wc, fr, fq); S.done(cur); }
        if (!has_next) break;
{ float zero_; asm volatile("v_mov_b32 %0, 0" : "=v"(zero_));
#pragma unroll
        for (int a = 0; a < 2; ++a)
#pragma unroll
            for (int b = 0; b < 2; ++b)
#pragma unroll
                for (int m = 0; m < 4; ++m)
#pragma unroll
                    for (int n = 0; n < 2; ++n) acc[a][b][m][n] = (f32x4){zero_, zero_, zero_, zero_}; }
        cur = nxt; cA = nA; cB = nB; ++ui;
        if constexpr (ALIGN_EPI) { if (wr == 1) PG8_BAR; }
    }
    PG8_WAIT_V(0);
    if constexpr (!ALIGN_EPI) { if (wr == 0) PG8_BAR; }
    PG8_BAR;
    if constexpr (Epi::AFTER_DRAIN) { E.fused(acc, cur, wr, wc, fr, fq, lds, wid, lane); S.done(cur); }
#undef PG8_SA
#undef PG8_SB
#undef PG8_STAGE
#undef PG8_LDA
#undef PG8_LDB
#undef PG8_MMA
#undef PG8_CAT
#undef PG8_WAIT_V
#undef PG8_WAIT_L
#undef PG8_BAR
#undef PG8_SCHED
}
}

namespace att {
#define ALAS __attribute__((address_space(3)))
typedef unsigned short bf16_t;
typedef short bf16x8 __attribute__((ext_vector_type(8)));
typedef short s16x4 __attribute__((ext_vector_type(4)));
typedef float f32x16 __attribute__((ext_vector_type(16)));
typedef float f32x4 __attribute__((ext_vector_type(4)));
typedef unsigned u32x4 __attribute__((ext_vector_type(4)));
typedef ALAS char* ldsp;
#ifndef WO_F8
#define WO_F8 1
#endif
constexpr float OB8_SCALE = 8.f;
constexpr int QP = 6144;
constexpr int OP = 2048;
constexpr int OBP = 2048;
constexpr int SHM_V = 16384, SHM_K = 16384;
constexpr int LDS_V = 0, LDS_K = 2 * SHM_V, LDS_WS = LDS_K + 2 * SHM_K, ATT_LDS_BYTES = LDS_WS + 8 * 256;
#define KSWZ(row, colB) ((row) * 256 + ((colB) ^ (((row) & 7) << 4)))
#define KSWZ64(row, colB) ((row) * 128 + ((colB) ^ (((row) & 7) << 4)))
#define SBAR() __builtin_amdgcn_sched_barrier(0)
__device__ __forceinline__ int v_st(int k, int c) { const int kk = (k & ~0xC) | ((k & 4) << 1) | ((k & 8) >> 1); return ((kk >> 3) * 4 + (c >> 5)) * 512 + ((kk & 7) * 32 + (c & 31)) * 2; }
__device__ __forceinline__ int v_rd_base(int lane) { return ((lane & 3) << 3) | (((lane >> 2) & 3) << 6) | (((lane >> 4) & 1) << 5) | (((lane >> 5) & 1) << 8); }
constexpr int v_rd_off(int d0, int ks, int half) { return d0 * 512 + ks * 4096 + half * 2048; }
__device__ __forceinline__ int crow(int r, int hi) { return (r & 3) + 8 * (r >> 2) + 4 * hi; }
__device__ __forceinline__ unsigned cvtpk(float lo, float hi) { unsigned r; asm volatile("v_cvt_pk_bf16_f32 %0, %1, %2" : "=v"(r) : "v"(lo), "v"(hi)); return r; }
__device__ __forceinline__ bf16x8 ldg8(const bf16_t* p) { return *reinterpret_cast<const bf16x8*>(p); }
__device__ __forceinline__ unsigned quad_pack_fp8(float v) {
    const int b = __builtin_bit_cast(int, v);
    const float v1 = __builtin_bit_cast(float, __builtin_amdgcn_update_dpp(b, b, 0x55, 0xf, 0xf, false));
    const float v2 = __builtin_bit_cast(float, __builtin_amdgcn_update_dpp(b, b, 0xAA, 0xf, 0xf, false));
    const float v3 = __builtin_bit_cast(float, __builtin_amdgcn_update_dpp(b, b, 0xFF, 0xf, 0xf, false));
    int w; asm volatile("" : "=v"(w));
    w = __builtin_amdgcn_cvt_pk_fp8_f32(v, v1, w, false); w = __builtin_amdgcn_cvt_pk_fp8_f32(v2, v3, w, true); return (unsigned)w;
}
__device__ __forceinline__ float xhalf(float v, int hi) {
    auto rr = __builtin_amdgcn_permlane32_swap(__float_as_uint(v), __float_as_uint(v), false, false);
    return __uint_as_float(hi ? rr[0] : rr[1]);
}
#define ATT_PK4(P, B_, OUT) do { unsigned a0 = cvtpk(P[B_+0], P[B_+1]), a1 = cvtpk(P[B_+2], P[B_+3]);                      \
        unsigned b0 = cvtpk(P[B_+4], P[B_+5]), b1 = cvtpk(P[B_+6], P[B_+7]);                                             \
        auto r0 = __builtin_amdgcn_permlane32_swap(a0, b0, false, false); auto r1 = __builtin_amdgcn_permlane32_swap(a1, b1, false, false); \
        u32x4 w = {r0[0], r1[0], r0[1], r1[1]}; OUT = *reinterpret_cast<bf16x8*>(&w); } while (0)
__device__ __forceinline__ void pv_tile(f32x16* o, int vb, bf16x8 pa0, bf16x8 pa1, bf16x8 pa2, bf16x8 pa3) {
#define TRRD(dst, off) asm volatile("ds_read_b64_tr_b16 %0, %1 offset:%2" : "=&v"(dst) : "v"(vb), "i"(off) : "memory")
#define PV_D0(d0) do { s16x4 l0, l1, l2, l3, h0, h1, h2, h3; constexpr int b_ = v_rd_off(d0, 0, 0); \
        TRRD(l0, b_); TRRD(h0, b_ + 2048); TRRD(l1, b_ + 4096); TRRD(h1, b_ + 6144); TRRD(l2, b_ + 8192); TRRD(h2, b_ + 10240); TRRD(l3, b_ + 12288); TRRD(h3, b_ + 14336); \
        asm volatile("s_waitcnt lgkmcnt(0)" ::: "memory"); SBAR(); \
        o[d0] = __builtin_amdgcn_mfma_f32_32x32x16_bf16(pa0, (bf16x8){l0[0], l0[1], l0[2], l0[3], h0[0], h0[1], h0[2], h0[3]}, o[d0], 0, 0, 0);   \
        o[d0] = __builtin_amdgcn_mfma_f32_32x32x16_bf16(pa1, (bf16x8){l1[0], l1[1], l1[2], l1[3], h1[0], h1[1], h1[2], h1[3]}, o[d0], 0, 0, 0);   \
        o[d0] = __builtin_amdgcn_mfma_f32_32x32x16_bf16(pa2, (bf16x8){l2[0], l2[1], l2[2], l2[3], h2[0], h2[1], h2[2], h2[3]}, o[d0], 0, 0, 0);   \
        o[d0] = __builtin_amdgcn_mfma_f32_32x32x16_bf16(pa3, (bf16x8){l3[0], l3[1], l3[2], l3[3], h3[0], h3[1], h3[2], h3[3]}, o[d0], 0, 0, 0); } while (0)
    PV_D0(0); PV_D0(1); PV_D0(2); PV_D0(3);
#undef PV_D0
#undef TRRD
}

__device__ __forceinline__ void sb_block(const bf16_t* __restrict__ Qg, const bf16_t* __restrict__ Kg, const bf16_t* __restrict__ Vg, bf16_t* __restrict__ Og, int qb, ldsp lds) {
    int tid_ = threadIdx.x; asm volatile("" : "+v"(tid_));
    const int tid = tid_, wid = __builtin_amdgcn_readfirstlane(tid >> 6), lane = tid & 63, r32 = lane & 31, hi = lane >> 5;
    const int NT = 4 * qb + 4, R0 = 256 * qb + 32 * wid, myrow = R0 + r32;
    const ldsp V_lds = lds + LDS_V; const ldsp K_lds = lds + LDS_K;
    bf16x8 qr[8];
    { const bf16_t* Qw = Qg + (size_t)R0 * QP; const unsigned qoff = (unsigned)(r32 * QP + hi * 8);
#pragma unroll
      for (int d0 = 0; d0 < 8; ++d0) qr[d0] = ldg8(Qw + (qoff + d0 * 16)); }
    const int sr = tid >> 4, sc = (tid & 15) * 8, kws = KSWZ(sr, sc * 2), vst0 = v_st(sr, sc), vst1 = v_st(32 + sr, sc);
    const unsigned kvoff = (unsigned)(sr * QP + sc);
    const int vb0 = (int)(unsigned)(uintptr_t)V_lds + v_rd_base(lane);
    bf16x8 sk0, sk1, sv0, sv1;
#define SB_LOAD(j) do { const bf16_t* kp_ = Kg + (size_t)(64 * (j)) * QP; const bf16_t* vp_ = Vg + (size_t)(64 * (j)) * QP; \
        sk0 = ldg8(kp_ + kvoff); sk1 = ldg8(kp_ + (size_t)32 * QP + kvoff); sv0 = ldg8(vp_ + kvoff); sv1 = ldg8(vp_ + (size_t)32 * QP + kvoff); } while (0)
#define SB_WRITE(bf) do { *(ALAS bf16x8*)(K_lds + (bf) * SHM_K + kws) = sk0; *(ALAS bf16x8*)(K_lds + (bf) * SHM_K + kws + 32 * 256) = sk1; \
        *(ALAS bf16x8*)(V_lds + (bf) * SHM_V + vst0) = sv0; *(ALAS bf16x8*)(V_lds + (bf) * SHM_V + vst1) = sv1; } while (0)
    SB_LOAD(NT - 1); SB_WRITE(0);
    __syncthreads();
    float carry = 0.f; f32x16 o[4] = {};
    ALAS int* fl = (ALAS int*)(lds + LDS_WS); bool wdone = false;
    for (int t = 0; t < NT; ++t) {
        const int j = NT - 1 - t, buf = t & 1, kb = 64 * j;
        if (t + 1 < NT) SB_LOAD(j - 1);
        if (kb <= R0 + 30 && !wdone) {
            f32x16 p0 = {}, p1 = {};
            { const ldsp Kb = K_lds + buf * SHM_K;
#pragma unroll
              for (int d0 = 0; d0 < 8; ++d0) { const ldsp a = Kb + KSWZ(r32, ((d0 & 3) * 16 + hi * 8) * 2) + (d0 >> 2) * 128;
                  const bf16x8 b0 = *(const ALAS bf16x8*)a, b1 = *(const ALAS bf16x8*)(a + 32 * 256);
                  p0 = __builtin_amdgcn_mfma_f32_32x32x16_bf16(b0, qr[d0], p0, 0, 0, 0);
                  p1 = __builtin_amdgcn_mfma_f32_32x32x16_bf16(b1, qr[d0], p1, 0, 0, 0); } }
            f32x16 lb0, lb1;
#pragma unroll
            for (int r = 0; r < 16; ++r) {
                { const float z = p0[r]; const float e = __builtin_amdgcn_exp2f(-__builtin_fabsf(z)); const float sp = __builtin_fmaxf(z, 0.f) + __builtin_amdgcn_logf(1.f + e); p0[r] = -sp; lb0[r] = z - sp; }
                { const float z = p1[r]; const float e = __builtin_amdgcn_exp2f(-__builtin_fabsf(z)); const float sp = __builtin_fmaxf(z, 0.f) + __builtin_amdgcn_logf(1.f + e); p1[r] = -sp; lb1[r] = z - sp; }
            }
            if (kb + 63 >= R0) {
                const int dq = myrow - kb - 4 * hi; const float NEG = -__builtin_inff();
#pragma unroll
                for (int r = 0; r < 16; ++r) { const int c = (r & 3) + 8 * (r >> 2);
                    if (c >= dq) { p0[r] = 0.f; lb0[r] = NEG; }
                    if (c + 32 >= dq) { p1[r] = 0.f; lb1[r] = NEG; } }
            }
            float gs[8], go[8];
#pragma unroll
            for (int g = 0; g < 4; ++g) { gs[g] = (p0[4 * g] + p0[4 * g + 1]) + (p0[4 * g + 2] + p0[4 * g + 3]); gs[4 + g] = (p1[4 * g] + p1[4 * g + 1]) + (p1[4 * g + 2] + p1[4 * g + 3]); }
#pragma unroll
            for (int i = 0; i < 8; ++i) go[i] = xhalf(gs[i], hi);
            float acc = carry;
#pragma unroll
            for (int idx = 7; idx >= 0; --idx) { const int g = idx & 3; const float base = acc + (hi ? 0.f : go[idx]);
                if (idx >= 4) { const float t3 = base, t2 = t3 + p1[4 * g + 3], t1 = t2 + p1[4 * g + 2], t0 = t1 + p1[4 * g + 1];
                    lb1[4 * g + 3] = __builtin_amdgcn_exp2f(lb1[4 * g + 3] + t3); lb1[4 * g + 2] = __builtin_amdgcn_exp2f(lb1[4 * g + 2] + t2);
                    lb1[4 * g + 1] = __builtin_amdgcn_exp2f(lb1[4 * g + 1] + t1); lb1[4 * g] = __builtin_amdgcn_exp2f(lb1[4 * g] + t0); }
                else { const float t3 = base, t2 = t3 + p0[4 * g + 3], t1 = t2 + p0[4 * g + 2], t0 = t1 + p0[4 * g + 1];
                    lb0[4 * g + 3] = __builtin_amdgcn_exp2f(lb0[4 * g + 3] + t3); lb0[4 * g + 2] = __builtin_amdgcn_exp2f(lb0[4 * g + 2] + t2);
                    lb0[4 * g + 1] = __builtin_amdgcn_exp2f(lb0[4 * g + 1] + t1); lb0[4 * g] = __builtin_amdgcn_exp2f(lb0[4 * g] + t0); }
                acc += gs[idx] + go[idx]; }
            carry = acc;
            bf16x8 pa0, pa1, pa2, pa3;
            ATT_PK4(lb0, 0, pa0); ATT_PK4(lb0, 8, pa1); ATT_PK4(lb1, 0, pa2); ATT_PK4(lb1, 8, pa3);
            SBAR();
            pv_tile(o, vb0 + buf * SHM_V, pa0, pa1, pa2, pa3);
            wdone = __all(carry < -127.f);
        }
        if (lane == 0) fl[buf * 8 + wid] = wdone ? 1 : 0;
        if (t + 1 < NT) SB_WRITE(buf ^ 1);
        __syncthreads();
        { const ALAS int* f = fl + buf * 8; if ((f[0] & f[1] & f[2] & f[3] & f[4] & f[5] & f[6] & f[7]) != 0) break; }
    }
#undef SB_LOAD
#undef SB_WRITE
#if WO_F8
    unsigned char* Ow = (unsigned char*)Og + (size_t)R0 * OBP; const unsigned ooff = (unsigned)(4 * hi * OBP + r32);
#pragma unroll
    for (int r = 0; r < 16; ++r) { unsigned char* rowp = Ow + (size_t)((r & 3) + 8 * (r >> 2)) * OBP;
#pragma unroll
        for (int d0 = 0; d0 < 4; ++d0) { const unsigned w = quad_pack_fp8(o[d0][r] * OB8_SCALE);
            if ((r32 & 3) == 0) *(unsigned*)(rowp + (ooff + d0 * 32)) = w; } }
#else
    bf16_t* Ow = Og + (size_t)R0 * OP; const unsigned ooff = (unsigned)(4 * hi * OP + r32);
#pragma unroll
    for (int r = 0; r < 16; ++r) { bf16_t* rowp = Ow + (size_t)((r & 3) + 8 * (r >> 2)) * OP;
#pragma unroll
        for (int d0 = 0; d0 < 4; ++d0) { const float v = o[d0][r]; const float vn = __shfl_xor(v, 1);
            if ((r32 & 1) == 0) *(unsigned*)(rowp + (ooff + d0 * 32)) = cvtpk(v, vn); } }
#endif
}

constexpr float ATT_THR = 8.f;
__device__ __forceinline__ void qkt64(f32x16& p0, f32x16& p1, ldsp Kb, int r32, int hi, const bf16x8* qr) {
    p0 = f32x16{}; p1 = f32x16{};
#pragma unroll
    for (int d0 = 0; d0 < 4; ++d0) { const ldsp a = Kb + KSWZ64(r32, (d0 * 16 + hi * 8) * 2);
        const bf16x8 b0 = *(const ALAS bf16x8*)a, b1 = *(const ALAS bf16x8*)(a + 32 * 128);
        p0 = __builtin_amdgcn_mfma_f32_32x32x16_bf16(b0, qr[d0], p0, 0, 0, 0);
        p1 = __builtin_amdgcn_mfma_f32_32x32x16_bf16(b1, qr[d0], p1, 0, 0, 0); }
}
__device__ __forceinline__ void partial_sm(f32x16& p0, f32x16& p1, float& m_reg, float& alpha, int hi) {
    float pmax = p0[0];
#pragma unroll
    for (int r = 1; r < 16; ++r) pmax = __builtin_fmaxf(pmax, p0[r]);
#pragma unroll
    for (int r = 0; r < 16; ++r) pmax = __builtin_fmaxf(pmax, p1[r]);
    pmax = __builtin_fmaxf(pmax, xhalf(pmax, hi));
    float mn;
    if (__builtin_expect(__all(pmax - m_reg <= ATT_THR), 1)) { mn = m_reg; alpha = 1.f; }
    else { mn = __builtin_fmaxf(m_reg, pmax); alpha = __builtin_amdgcn_exp2f(m_reg - mn); m_reg = mn; }
#pragma unroll
    for (int r = 0; r < 16; ++r) { p0[r] -= mn; p1[r] -= mn; }
#pragma unroll
    for (int r = 0; r < 16; ++r) p0[r] = __builtin_amdgcn_exp2f(p0[r]);
}
__device__ __forceinline__ void finish_sm(f32x16& p0, f32x16& p1, float alpha, float& l_reg, bf16x8& pa0, bf16x8& pa1, bf16x8& pa2, bf16x8& pa3, int hi) {
#pragma unroll
    for (int r = 0; r < 16; ++r) p1[r] = __builtin_amdgcn_exp2f(p1[r]);
    float ps = 0.f;
#pragma unroll
    for (int r = 0; r < 16; ++r) ps += p0[r];
#pragma unroll
    for (int r = 0; r < 16; ++r) ps += p1[r];
    ps += xhalf(ps, hi);
    l_reg = l_reg * alpha + ps;
    ATT_PK4(p0, 0, pa0); ATT_PK4(p0, 8, pa1); ATT_PK4(p1, 0, pa2); ATT_PK4(p1, 8, pa3);
}
__device__ __forceinline__ void mask_gt(f32x16& p0, f32x16& p1, int dq) {
    const float NEG = -__builtin_inff();
#pragma unroll
    for (int r = 0; r < 16; ++r) { const int c = (r & 3) + 8 * (r >> 2);
        if (c > dq) p0[r] = NEG;
        if (c + 32 > dq) p1[r] = NEG; }
}
template <bool SECOND>
__device__ __forceinline__ void diff_pass(const bf16_t* __restrict__ Qg, const bf16_t* __restrict__ Kg, const bf16_t* __restrict__ Vg, float* S1, bf16_t* __restrict__ Og,
                                          int qb, float lam, const float* __restrict__ gsub, float gmul, ldsp lds) {
    int tid_ = threadIdx.x; asm volatile("" : "+v"(tid_));
    const int tid = tid_, wid = __builtin_amdgcn_readfirstlane(tid >> 6), lane = tid & 63, r32 = lane & 31, hi = lane >> 5;
    const int NT = 4 * qb + 4, R0 = 256 * qb + 32 * wid, myrow = R0 + r32;
    const ldsp V_lds = lds + LDS_V; const ldsp K_lds = lds + LDS_K;
    ALAS float* wsf = (ALAS float*)(lds + LDS_WS) + wid * 64; ALAS float* li_l = wsf; ALAS float* al_l = wsf + 32;
    bf16x8 qr[4];
    { const bf16_t* Qw = Qg + (size_t)R0 * QP; const unsigned qoff = (unsigned)(r32 * QP + hi * 8);
#pragma unroll
      for (int d0 = 0; d0 < 4; ++d0) qr[d0] = ldg8(Qw + (qoff + d0 * 16)); }
    const int sr = tid >> 4, sc = (tid & 15) * 8, vst0 = v_st(sr, sc), vst1 = v_st(32 + sr, sc);
    const int kr = tid >> 3, kc = (tid & 7) * 8, kws = KSWZ64(kr, kc * 2);
    const unsigned voff = (unsigned)(sr * QP + sc), koff = (unsigned)(kr * QP + kc);
    const int vb0 = (int)(unsigned)(uintptr_t)V_lds + v_rd_base(lane);
    const int qm = myrow - 4 * hi;
    bf16x8 sk0A, sv0A, sv1A, sk0B, sv0B, sv1B;
#define DF_LOAD(S_, j) do { const bf16_t* vp_ = Vg + (size_t)(64 * (j)) * QP; sk0##S_ = ldg8(Kg + (size_t)(64 * (j)) * QP + koff); sv0##S_ = ldg8(vp_ + voff); sv1##S_ = ldg8(vp_ + (size_t)32 * QP + voff); } while (0)
#define DF_WRITE(S_, bf) do { *(ALAS bf16x8*)(K_lds + (bf) * SHM_K + kws) = sk0##S_; *(ALAS bf16x8*)(V_lds + (bf) * SHM_V + vst0) = sv0##S_; *(ALAS bf16x8*)(V_lds + (bf) * SHM_V + vst1) = sv1##S_; } while (0)
#define DF_MASK(P0, P1, t) do { if (64 * (t) + 63 > R0) mask_gt(P0, P1, qm - 64 * (t)); } while (0)
#define DF_RESC(a) do { if (__any((a) < 1.f)) { if (hi == 0) al_l[r32] = (a); asm volatile("s_waitcnt lgkmcnt(0)" ::: "memory"); \
        _Pragma("unroll") for (int d_ = 0; d_ < 4; ++d_) _Pragma("unroll") for (int r = 0; r < 16; ++r) o[d_][r] *= al_l[crow(r, hi)]; } } while (0)
    float m_reg = -1e30f, l_reg = 0.f; f32x16 o[4] = {};
    f32x16 pA0, pA1, pB0, pB1; float alA = 1.f, alB = 1.f; bf16x8 pa0, pa1, pa2, pa3;
    DF_LOAD(A, 0); DF_WRITE(A, 0);
    __syncthreads();
    DF_LOAD(A, 1); DF_LOAD(B, 2);
    qkt64(pA0, pA1, K_lds, r32, hi, qr); DF_MASK(pA0, pA1, 0); partial_sm(pA0, pA1, m_reg, alA, hi);
    DF_WRITE(A, 1);
    DF_RESC(alA);
    __syncthreads();
#define DF_HALF(PX0, PX1, alX, PY0, PY1, alY, t, KB, VB, SB, LS, WS) do { \
        SBAR(); qkt64(PX0, PX1, K_lds + (KB) * SHM_K, r32, hi, qr); \
        finish_sm(PY0, PY1, alY, l_reg, pa0, pa1, pa2, pa3, hi); SBAR(); \
        if ((t) + 2 < NT) { DF_LOAD(LS, (t) + 2); SBAR(); } \
        pv_tile(o, vb0 + (VB) * SHM_V, pa0, pa1, pa2, pa3); DF_MASK(PX0, PX1, (t)); partial_sm(PX0, PX1, m_reg, alX, hi); \
        __syncthreads(); \
        if ((t) + 1 < NT) DF_WRITE(WS, SB); \
        DF_RESC(alX); __syncthreads(); } while (0)
    for (int t = 1; t + 1 < NT; t += 2) {
        DF_HALF(pB0, pB1, alB, pA0, pA1, alA, t, 1, 0, 0, A, B);
        DF_HALF(pA0, pA1, alA, pB0, pB1, alB, t + 1, 0, 1, 1, B, A);
    }
    DF_HALF(pB0, pB1, alB, pA0, pA1, alA, NT - 1, 1, 0, 0, A, B);
    finish_sm(pB0, pB1, alB, l_reg, pa0, pa1, pa2, pa3, hi); SBAR();
    pv_tile(o, vb0 + 1 * SHM_V, pa0, pa1, pa2, pa3);
#undef DF_LOAD
#undef DF_WRITE
#undef DF_MASK
#undef DF_RESC
#undef DF_HALF
    if (hi == 0) li_l[r32] = l_reg; asm volatile("s_waitcnt lgkmcnt(0)" ::: "memory");
    float rli[16];
#pragma unroll
    for (int r = 0; r < 16; ++r) rli[r] = __builtin_amdgcn_rcpf(li_l[crow(r, hi)]);
    if constexpr (!SECOND) {
        float* Sw = S1 + (size_t)R0 * OP; const unsigned ooff = (unsigned)(4 * hi * OP + r32);
#pragma unroll
        for (int r = 0; r < 16; ++r) { float* rowp = Sw + (size_t)((r & 3) + 8 * (r >> 2)) * OP;
#pragma unroll
            for (int d0 = 0; d0 < 4; ++d0) rowp[ooff + d0 * 32] = o[d0][r] * rli[r]; }
    } else {
        const float* Sw = S1 + (size_t)R0 * OP; bf16_t* Ow = Og + (size_t)R0 * OP; (void)Ow; const unsigned ooff = (unsigned)(4 * hi * OP + r32), ooff8 = (unsigned)(4 * hi * OBP + r32);
        float gn[4];
#pragma unroll
        for (int d0 = 0; d0 < 4; ++d0) gn[d0] = gsub[d0 * 32 + r32] * gmul;
#pragma unroll
        for (int r = 0; r < 16; ++r) { const float* srow = Sw + (size_t)((r & 3) + 8 * (r >> 2)) * OP; float d[4]; float ss = 0.f;
#if WO_F8
            unsigned char* orowp = (unsigned char*)Og + (size_t)(R0 + (r & 3) + 8 * (r >> 2)) * OBP;
#else
            bf16_t* orowp = Ow + (size_t)((r & 3) + 8 * (r >> 2)) * OP;
#endif
#pragma unroll
            for (int d0 = 0; d0 < 4; ++d0) { d[d0] = srow[ooff + d0 * 32] - lam * (o[d0][r] * rli[r]); ss += d[d0] * d[d0]; }
            ss += __builtin_bit_cast(float, __builtin_amdgcn_update_dpp(0, __builtin_bit_cast(int, ss), 0xB1, 0xf, 0xf, true));
            ss += __builtin_bit_cast(float, __builtin_amdgcn_update_dpp(0, __builtin_bit_cast(int, ss), 0x4E, 0xf, 0xf, true));
            ss += __builtin_bit_cast(float, __builtin_amdgcn_update_dpp(0, __builtin_bit_cast(int, ss), 0x141, 0xf, 0xf, true));
            ss += __builtin_bit_cast(float, __builtin_amdgcn_update_dpp(0, __builtin_bit_cast(int, ss), 0x140, 0xf, 0xf, true));
            { auto rr = __builtin_amdgcn_permlane16_swap(__float_as_uint(ss), __float_as_uint(ss), false, false); ss = __uint_as_float(rr[0]) + __uint_as_float(rr[1]); }
            const float rs = __builtin_amdgcn_rsqf(ss * (1.f / 128.f) + 1e-5f);
#pragma unroll
#if WO_F8
            for (int d0 = 0; d0 < 4; ++d0) { const unsigned w = quad_pack_fp8(d[d0] * rs * gn[d0] * OB8_SCALE);
                if ((r32 & 3) == 0) *(unsigned*)(orowp + (ooff8 + d0 * 32)) = w; }
#else
            for (int d0 = 0; d0 < 4; ++d0) { const float v = d[d0] * rs * gn[d0]; const float vn = __shfl_xor(v, 1);
                if ((r32 & 1) == 0) *(unsigned*)(orowp + (ooff + d0 * 32)) = cvtpk(v, vn); }
#endif
            if ((r & 1) == 1) asm volatile("" ::: "memory"); }
    }
    __syncthreads();
}
#undef SBAR
}

#define LAS __attribute__((address_space(3)))

#define XB_TMO      128
#define XB_XCNT(j)  (256  + 64 * (j))
#define XB_XSUB(j)  (1280 + 64 * (j))
#define XB_XGEN(j)  (2304 + 64 * (j))
#define XB_TOP      3328
#define XB_TOPGEN   3392
#define XCD_BAR_WORDS 3456
#define XB_SPIN_CAP (1u << 18)

__device__ __forceinline__ unsigned xb_ld(unsigned* p)              { return __hip_atomic_load(p, __ATOMIC_RELAXED, __HIP_MEMORY_SCOPE_AGENT); }
__device__ __forceinline__ unsigned xb_add(unsigned* p, unsigned v) { return __hip_atomic_fetch_add(p, v, __ATOMIC_RELAXED, __HIP_MEMORY_SCOPE_AGENT); }
__device__ __forceinline__ unsigned xb_xcc_id() { return (unsigned)__builtin_amdgcn_s_getreg((3 << 11) | 20) & 0xFu; }
#define XB_SPIN(cond, bar) do { unsigned _sp = 0; while (cond) { __builtin_amdgcn_s_sleep(1); \
    if ((++_sp & 255u) == 0u) { if (xb_ld(&(bar)[XB_TMO])) break; if (_sp > XB_SPIN_CAP) { atomicAdd(&(bar)[XB_TMO], 1u); break; } } } } while (0)

struct XcdBarrier {
    unsigned* bar; unsigned x;
    volatile LAS unsigned* st;
};

__device__ __forceinline__ XcdBarrier xcd_barrier_post(unsigned* bar, volatile LAS unsigned* st) {
    XcdBarrier b; b.bar = bar; b.x = xb_xcc_id(); b.st = st;
    if (threadIdx.x == 0) (void)xb_add(&bar[XB_XCNT(b.x)], 1u);
    return b;
}
__device__ __forceinline__ void xcd_barrier_complete(unsigned* bar, unsigned x, unsigned& nloc, unsigned& nx) {
    const unsigned G = gridDim.x * gridDim.y * gridDim.z;
    unsigned sum, cnt, mine, sp = 0u;
    for (;;) {
        sum = 0u; cnt = 0u; mine = 0u;
#pragma unroll
        for (unsigned j = 0; j < 16; ++j) { const unsigned c = xb_ld(&bar[XB_XCNT(j)]); sum += c; cnt += (c > 0u) ? 1u : 0u; mine = (j == x) ? c : mine; }
        if (sum == G) break;
        __builtin_amdgcn_s_sleep(1);
        if ((++sp & 255u) == 0u) { if (xb_ld(&bar[XB_TMO])) break; if (sp > XB_SPIN_CAP) { atomicAdd(&bar[XB_TMO], 1u); break; } }
    }
    nloc = mine > 0u ? mine : 1u; nx = cnt > 0u ? cnt : 1u;
}

__device__ __forceinline__ void xcd_barrier(const XcdBarrier& b) {
    asm volatile("s_waitcnt vmcnt(0)" ::: "memory");
    __syncthreads();
    if (threadIdx.x == 0) {
        unsigned* bar = b.bar;
        __builtin_amdgcn_s_waitcnt(0);
        unsigned nloc = b.st[0], nx = b.st[1];
        if (nloc == 0u) { xcd_barrier_complete(bar, b.x, nloc, nx); b.st[0] = nloc; b.st[1] = nx; }
        const unsigned old = xb_add(&bar[XB_XSUB(b.x)], 1u);
        const unsigned gen = old / nloc;
        if (old + 1u == (gen + 1u) * nloc) {
            __builtin_amdgcn_fence(__ATOMIC_RELEASE, "agent");
            asm volatile("s_waitcnt vmcnt(0)" ::: "memory");
            const unsigned og = xb_add(&bar[XB_TOP], 1u);
            const unsigned tg = og / nx;
            if (og + 1u == (tg + 1u) * nx) xb_add(&bar[XB_TOPGEN], 1u);
            else XB_SPIN(xb_ld(&bar[XB_TOPGEN]) == tg, bar);
            __builtin_amdgcn_fence(__ATOMIC_ACQUIRE, "agent");
            xb_add(&bar[XB_XGEN(b.x)], 1u);
            asm volatile("s_waitcnt vmcnt(0)" ::: "memory");
        } else {
            XB_SPIN(xb_ld(&bar[XB_XGEN(b.x)]) == gen, bar);
            __builtin_amdgcn_fence(__ATOMIC_ACQUIRE, "agent");
            asm volatile("s_waitcnt vmcnt(0)" ::: "memory");
        }
    }
    __syncthreads();
}

constexpr int NWAVES = 8;
constexpr int NTOK = 16384, DM = 2048, SEQ = 2048, NHEAD = 16, NLAYER = 4, NEXP = 16, DEXP = 1024;
constexpr int XS_ROWS = 36864;
constexpr float LN_EPS = 1e-5f;
constexpr float DN_ALPHA = 1.6817928305074292f;
constexpr float LOG2E = 1.4426950408889634f;
constexpr float SB_QSCALE = 0.08838834764831845f * LOG2E;
constexpr float DF_QSCALE = 0.125f * LOG2E;
#ifndef MK_MULTI
#define MK_MULTI 0
#endif
#ifndef MOE_F8
#define MOE_F8 1
#endif
constexpr int NSTEPS = 1 + 8 * NLAYER;

constexpr size_t MiB = 1u << 20;
constexpr size_t WS_CTL = 0, CTL_ZERO_BYTES = 64 * 1024;
constexpr size_t WS_COS = 1 * MiB, WS_SIN = WS_COS + 256 * 1024;
constexpr size_t WS_WR = 2 * MiB;
constexpr size_t WS_CNT = 3 * MiB;
constexpr size_t WS_RE = WS_CNT + 64 * 1024;
constexpr size_t WS_RW = WS_RE + 64 * 1024;
constexpr size_t WS_RP = WS_RW + 128 * 1024;
constexpr int LDH = 2048;
constexpr int P8K2 = 2048, P8K1 = 1024;
constexpr size_t WS_WQKVA = 4 * MiB;
constexpr size_t WS_WOA = WS_WQKVA + 56 * MiB;
constexpr size_t WS_WQKVB = WS_WOA + 16 * MiB;
constexpr size_t WS_WOB = WS_WQKVB + 36 * MiB;
constexpr size_t WS_WGU = WS_WOB + 16 * MiB;
constexpr size_t WS_WDN = WS_WGU + 512 * MiB;
constexpr size_t WS_H = WS_WDN + 256 * MiB;
constexpr size_t WS_HB = WS_H + 128 * MiB;
constexpr size_t WS_QKV = WS_HB + 68 * MiB;
constexpr size_t WS_OB = WS_QKV + 192 * MiB;
constexpr size_t WS_XS = WS_OB + 64 * MiB;
constexpr size_t WS_ACT = WS_XS + 144 * MiB;
constexpr size_t WS_YD = WS_ACT + 72 * MiB;
constexpr size_t WS_END = WS_YD + 144 * MiB;
static_assert(WS_END <= (size_t)2040 * MiB, "workspace map");
static_assert((size_t)2 * 6144 * LDH * 2 <= 56 * MiB && (size_t)8192 * LDH * 2 <= 36 * MiB && (size_t)2 * 2048 * P8K2 <= 16 * MiB && (size_t)64 * 2048 * P8K2 <= 512 * MiB && (size_t)64 * 2048 * P8K1 <= 256 * MiB, "weight regions");
static_assert((size_t)NTOK * LDH * 2 <= 68 * MiB && (size_t)NTOK * P8K2 <= 64 * MiB && (size_t)XS_ROWS * P8K2 <= 144 * MiB && (size_t)XS_ROWS * P8K1 <= 72 * MiB, "activation regions");
constexpr int CW_BAR = 1024;
constexpr int LDS_BYTES = 147456;
constexpr int LDSCTL_OFF = 145408;
constexpr int RING_OFF = 0;

#define GAS __attribute__((address_space(1)))
typedef unsigned short bf16;
typedef unsigned v4u __attribute__((ext_vector_type(4)));
typedef unsigned v2u __attribute__((ext_vector_type(2)));
typedef float f32x4 __attribute__((ext_vector_type(4)));
typedef float f32x2 __attribute__((ext_vector_type(2)));
#define LDS_WAIT() asm volatile("s_waitcnt lgkmcnt(0)" ::: "memory")
#define VM_WAIT() asm volatile("s_waitcnt vmcnt(0)" ::: "memory")
__device__ __forceinline__ unsigned pk2(float lo, float hi) { unsigned r; asm volatile("v_cvt_pk_bf16_f32 %0, %1, %2" : "=v"(r) : "v"(lo), "v"(hi)); return r; }
__device__ __forceinline__ int opq_tid() { int t = threadIdx.x; asm volatile("" : "+v"(t)); return t; }
__device__ __forceinline__ float dpp_sum(float v) {
    v += __builtin_bit_cast(float, __builtin_amdgcn_update_dpp(0, __builtin_bit_cast(int, v), 0xB1, 0xf, 0xf, true));
    v += __builtin_bit_cast(float, __builtin_amdgcn_update_dpp(0, __builtin_bit_cast(int, v), 0x4E, 0xf, 0xf, true));
    v += __builtin_bit_cast(float, __builtin_amdgcn_update_dpp(0, __builtin_bit_cast(int, v), 0x141, 0xf, 0xf, true));
    v += __builtin_bit_cast(float, __builtin_amdgcn_update_dpp(0, __builtin_bit_cast(int, v), 0x140, 0xf, 0xf, true));
    const int b = __builtin_bit_cast(int, v);
    const float s0 = __builtin_bit_cast(float, __builtin_amdgcn_readlane(b, 0)), s1 = __builtin_bit_cast(float, __builtin_amdgcn_readlane(b, 16));
    const float s2 = __builtin_bit_cast(float, __builtin_amdgcn_readlane(b, 32)), s3 = __builtin_bit_cast(float, __builtin_amdgcn_readlane(b, 48));
    return (s0 + s1) + (s2 + s3);
}
__device__ __forceinline__ float wave_sum(float v) {
#pragma unroll
    for (int o = 1; o < 64; o <<= 1) v += __shfl_xor(v, o);
    return v;
}

struct Args { const float* in[17]; float* out; unsigned char* ws; int s_lo, s_hi; };

__device__ __forceinline__ int map_row(int n, int mode) {
    if (mode == 0) return n;
    if (mode == 1) { const int c = n & 255, blk = c >> 6, d = c & 63; return (n & ~255) + ((d >> 5) << 7) + (blk << 5) + (d & 31); }
    return ((n >> 7) << 8) + (n & 127) + (mode == 3 ? 128 : 0);
}
__device__ __forceinline__ void cvt_item(const float* __restrict__ src, int pitch, int K, bf16* __restrict__ dst, int mode, int k0, int n0, LAS float* scr, int lane) {
    const int kr = lane >> 4, n4 = (lane & 15) * 4;
    f32x4 v[16];
#pragma unroll
    for (int i = 0; i < 16; ++i) v[i] = __builtin_nontemporal_load((const f32x4*)(src + (size_t)(k0 + 4 * i + kr) * pitch + n0 + n4));
#pragma unroll
    for (int i = 0; i < 16; ++i) { LAS float* s = scr + (4 * i + kr) * 65 + n4; s[0] = v[i][0]; s[1] = v[i][1]; s[2] = v[i][2]; s[3] = v[i][3]; }
    LDS_WAIT();
    const int c = lane & 7;
#pragma unroll
    for (int j = 0; j < 8; ++j) { const int nl = (lane >> 3) + 8 * j; const int row = map_row(n0 + nl, mode);
        const LAS float* s = scr + (8 * c) * 65 + nl;
        v4u o; o.x = pk2(s[0], s[65]); o.y = pk2(s[130], s[195]); o.z = pk2(s[260], s[325]); o.w = pk2(s[390], s[455]);
        *(v4u*)(dst + (size_t)row * K + k0 + 8 * c) = o; }
    LDS_WAIT();
}

__device__ __forceinline__ void cvt_item8(const float* __restrict__ src, int pitch, int K, unsigned char* __restrict__ dst, int mode, int k0, int n0, float scale, LAS float* scr, int lane) {
    const int kr = lane >> 4, n4 = (lane & 15) * 4;
    f32x4 v[16];
#pragma unroll
    for (int i = 0; i < 16; ++i) v[i] = __builtin_nontemporal_load((const f32x4*)(src + (size_t)(k0 + 4 * i + kr) * pitch + n0 + n4));
#pragma unroll
    for (int i = 0; i < 16; ++i) { LAS float* s = scr + (4 * i + kr) * 65 + n4; s[0] = v[i][0] * scale; s[1] = v[i][1] * scale; s[2] = v[i][2] * scale; s[3] = v[i][3] * scale; }
    LDS_WAIT();
    const int c = lane & 3;
#pragma unroll
    for (int j = 0; j < 4; ++j) { const int nl = (lane >> 2) + 16 * j; const int row = map_row(n0 + nl, mode);
        const LAS float* s = scr + (16 * c) * 65 + nl;
        v4u o; o.x = pg8::pack4_fp8(s[0], s[65], s[130], s[195]); o.y = pg8::pack4_fp8(s[260], s[325], s[390], s[455]);
        o.z = pg8::pack4_fp8(s[520], s[585], s[650], s[715]); o.w = pg8::pack4_fp8(s[780], s[845], s[910], s[975]);
        *(v4u*)(dst + (size_t)row * K + k0 + 16 * c) = o; }
    LDS_WAIT();
}

__global__ void __launch_bounds__(NWAVES * 64, 2) yoco_fwd(Args args) {
    extern __shared__ __attribute__((aligned(16))) unsigned char lds_raw[];
    LAS unsigned char* const lds = (LAS unsigned char*)lds_raw;
    const int tid = threadIdx.x, lane = tid & 63, wave = __builtin_amdgcn_readfirstlane(tid >> 6);
    const int G = gridDim.x, bx = blockIdx.x;
    const int vcu = (G % 8 == 0) ? (bx % 8) * (G / 8) + bx / 8 : bx;
    unsigned char* const ws = args.ws;
    volatile LAS unsigned* const CTL = (volatile LAS unsigned*)(lds + LDSCTL_OFF);
    LAS int* const TAB = (LAS int*)(lds + LDSCTL_OFF + 64);
    for (int u = tid; u < (LDS_BYTES - LDSCTL_OFF) / 4; u += NWAVES * 64) ((LAS unsigned*)(lds + LDSCTL_OFF))[u] = 0u;
    __syncthreads();
    const int s_lo = args.s_lo, s_hi = args.s_hi;
    XcdBarrier bar; bar.bar = (unsigned*)(ws + WS_CTL) + CW_BAR; bar.x = 0; bar.st = nullptr;
    if (s_hi - s_lo > 1) bar = xcd_barrier_post((unsigned*)(ws + WS_CTL) + CW_BAR, CTL);
#ifndef PH_MASK
#define PH_MASK 0xFFFF
#endif
#define PHM(b) (((PH_MASK) >> (b)) & 1)
#ifndef PROBE_DUP
#define PROBE_DUP 0
#endif
#define PREP(b) _Pragma("unroll 1") for (int rep_ = 0; rep_ < ((((PROBE_DUP) >> (b)) & 1) ? 2 : 1); ++rep_)
#define IN(k) (s_lo <= (k) && (k) < s_hi)
#define SEAM(k) do { if ((k) + 1 < s_hi) xcd_barrier(bar); } while (0)

    const float* const x_in = args.in[0];
    float* const H = (float*)(ws + WS_H); bf16* const HB = (bf16*)(ws + WS_HB); bf16* const QKV = (bf16*)(ws + WS_QKV); bf16* const OB = (bf16*)(ws + WS_OB);
    bf16* const MIX = (bf16*)(ws + WS_YD);     bf16* const XS = (bf16*)(ws + WS_XS); float* const S1 = (float*)(ws + WS_XS); bf16* const ACT = (bf16*)(ws + WS_ACT); bf16* const YD = (bf16*)(ws + WS_YD);
    float* const COS = (float*)(ws + WS_COS); float* const SIN = (float*)(ws + WS_SIN); float* const WR = (float*)(ws + WS_WR);
    int* const CNT = (int*)(ws + WS_CNT); unsigned* const RE = (unsigned*)(ws + WS_RE); f32x2* const RW = (f32x2*)(ws + WS_RW); int* const RP = (int*)(ws + WS_RP);

    if (IN(0) && PHM(0)) { PREP(0) {
        const int tid = opq_tid(), lane = tid & 63;
        LAS float* scr = (LAS float*)(lds + RING_OFF + wave * 16640);
        const int gw = vcu * NWAVES + wave, NGW = G * NWAVES;
        constexpr int I0 = 2 * 3072, I1 = 8 * 1024, I2 = 128 * 512, I3 = 64 * 512, NITEMS = I0 + I1 + I2 + I3;
        for (int it = gw; it < NITEMS; it += NGW) {
            int r = it;
            if (r < I0) { const int job = r / 3072; r -= job * 3072; const int kb = r / 96, nb = r - kb * 96;
                cvt_item(args.in[1] + (size_t)job * 2048 * 6144, 6144, LDH, (bf16*)(ws + WS_WQKVA) + (size_t)job * 6144 * LDH, 0, kb * 64, nb * 64, scr, lane); continue; }
            r -= I0;
            if (r < I1) { const int job = r >> 10; r &= 1023; const int kb = r >> 5, nb = r & 31;
                const float* src; int pitch = 2048, mode = 0; bf16* dst;
                if (job < 2) { src = args.in[2] + (size_t)job * 2048 * 2048; dst = (bf16*)(ws + WS_WOA + (size_t)job * 2048 * P8K2); }
                else if (job == 2) { src = args.in[4]; dst = (bf16*)(ws + WS_WQKVB); mode = 1; }
                else if (job == 3) { src = args.in[3]; pitch = 4096; dst = (bf16*)(ws + WS_WQKVB) + (size_t)2048 * LDH; mode = 1; }
                else if (job == 4) { src = args.in[3] + 2048; pitch = 4096; dst = (bf16*)(ws + WS_WQKVB) + (size_t)4096 * LDH; }
                else if (job == 5) { src = args.in[4] + (size_t)2048 * 2048; dst = (bf16*)(ws + WS_WQKVB) + (size_t)6144 * LDH; mode = 1; }
                else { src = args.in[5] + (size_t)(job - 6) * 2048 * 2048; dst = (bf16*)(ws + WS_WOB + (size_t)(job - 6) * 2048 * P8K2); }
                if (job < 2 || job >= 6) { cvt_item8(src, pitch, P8K2, (unsigned char*)dst, mode, kb * 64, nb * 64, pg8::W8_SCALE, scr, lane); continue; }
                cvt_item(src, pitch, LDH, dst, mode, kb * 64, nb * 64, scr, lane); continue; }
            r -= I1;
            if (r < I2) { const int job = r >> 9; r &= 511; const int kb = r >> 4, nb = r & 15; const int le = job >> 1, up = job & 1;
                cvt_item8((up ? args.in[15] : args.in[14]) + (size_t)le * 2048 * 1024, 1024, P8K2, (unsigned char*)(ws + WS_WGU) + (size_t)le * 2048 * P8K2, 2 + up, kb * 64, nb * 64, pg8::W8_SCALE, scr, lane); continue; }
            r -= I2;
            { const int le = r >> 9; r &= 511; const int kb = r >> 5, nb = r & 31;
                cvt_item8(args.in[16] + (size_t)le * 1024 * 2048, 2048, P8K1, (unsigned char*)(ws + WS_WDN) + (size_t)le * 2048 * P8K1, 0, kb * 64, nb * 64, pg8::W8_SCALE, scr, lane); }
        }
        for (size_t i = (size_t)gw * 64 + lane; i < (size_t)NTOK * DM / 4; i += (size_t)NGW * 64) {
            const f32x4 v = ((const f32x4*)x_in)[i];
            v2u o; o.x = pk2(v[0], v[1]); o.y = pk2(v[2], v[3]); *(v2u*)(HB + (i >> 9) * LDH + (i & 511) * 4) = o; }
        for (int i = bx * (NWAVES * 64) + tid; i < 2048 * 32; i += G * NWAVES * 64) { const int pos = i >> 5, f = i & 31;
            const float inv = __builtin_amdgcn_exp2f(-(float)f * 0.4152410118609203f); const float ang = (float)pos * inv;
            const double tr = (double)ang * 0.15915494309189535; const float fr = (float)(tr - __builtin_rint(tr));
            COS[i] = __builtin_amdgcn_cosf(fr); SIN[i] = __builtin_amdgcn_sinf(fr); }
        for (int i = bx * (NWAVES * 64) + tid; i < NLAYER * 20 * 2048; i += G * NWAVES * 64) { const int k = i & 2047, c = (i >> 11) % 20, l = i / (20 * 2048);
            WR[i] = c < 4 ? args.in[12][((size_t)l * 2048 + k) * 4 + c] : args.in[13][(((size_t)l * 4 + ((c - 4) >> 2)) * 2048 + k) * 4 + ((c - 4) & 3)]; }
        }
        SEAM(0);
    }

    for (int L = 0; L < NLAYER; ++L) {
        const int sb = 1 + 8 * L; const bool typeA = L < 2;
        if (IN(sb + 0)) {
            if (typeA && PHM(1)) { PREP(1) {
                pg8::Gemm g{HB, (const bf16*)(ws + WS_WQKVA) + (size_t)L * 6144 * LDH, NTOK, 6144, DM, LDH}; pg8::StaticOrder S; S.init(NTOK, 6144, G, bx);
                pg8::EpiQkv E{QKV, 6144, 2048, SB_QSCALE};
                pg8::gemm_phase<pg8::EpiQkv, pg8::StaticOrder, true, true>(lds + RING_OFF, g, S, E); }
                if ((PROBE_DUP >> 11) & 1) {
                    struct LocalOrder { int n, G, c; __device__ bool next(int i, pg8::Unit& u) const { if (i * G + c >= n) return false; u.pm = 0; u.pn = 0; return true; }
                        __device__ void a_ready(const pg8::Unit&) const {} __device__ void done(const pg8::Unit&) const {} } S2{1536, G, bx};
                    pg8::Gemm g2{HB, (const bf16*)(ws + WS_WQKVA) + (size_t)L * 6144 * LDH, NTOK, 6144, DM, LDH}; pg8::EpiQkv E2{XS, 6144, 2048, SB_QSCALE};
                    pg8::gemm_phase<pg8::EpiQkv, LocalOrder, true, true>(lds + RING_OFF, g2, S2, E2); }
            } else if (!typeA && PHM(2)) { PREP(2) {
                const int N = (L == 2) ? 6144 : 2048;
                pg8::Gemm g{HB, (const bf16*)(ws + WS_WQKVB) + (L == 2 ? (size_t)0 : (size_t)6144 * LDH), NTOK, N, DM, LDH}; pg8::StaticOrder S; S.init(NTOK, N, G, bx);
                pg8::EpiRope E{QKV, 6144, 2048, 4096, DF_QSCALE, COS, SIN};
                pg8::gemm_phase<pg8::EpiRope, pg8::StaticOrder, true, true>(lds + RING_OFF, g, S, E); }
            }
            SEAM(sb + 0);
        }
        if (IN(sb + 1)) {
            if (typeA && PHM(3)) {
                for (int id_ = vcu; id_ < 512 * (1 + ((PROBE_DUP >> 3) & 1)); id_ += G) { const int id = id_ & 511; const int bh = id >> 2, p = id & 3, b = bh >> 4, h = bh & 15;
                    const bf16* Qg = QKV + (size_t)b * SEQ * 6144 + h * 128; bf16* Og = (bf16*)((unsigned char*)OB + (size_t)b * SEQ * P8K2 + h * 128);
                    att::sb_block(Qg, Qg + 2048, Qg + 4096, Og, 7 - p, (att::ldsp)(lds + RING_OFF));
                    att::sb_block(Qg, Qg + 2048, Qg + 4096, Og, p, (att::ldsp)(lds + RING_OFF)); }
            } else if (!typeA && PHM(4)) {
                const int lane = opq_tid() & 63;
                const int i = L - 2; const float lam_init = (L == 2) ? 0.47071301834264183f : 0.5560582041556061f;
                const float* lp = args.in[6] + (size_t)i * 256;
                const float sa = dpp_sum(lp[lane] * lp[64 + lane]), sb2 = dpp_sum(lp[128 + lane] * lp[192 + lane]);
                const float lam = __builtin_amdgcn_exp2f(sa * LOG2E) - __builtin_amdgcn_exp2f(sb2 * LOG2E) + lam_init;
                const float* gsub = args.in[7] + (size_t)i * 128; const float gmul = 1.f - lam_init;
                for (int id_ = vcu; id_ < 512 * (1 + ((PROBE_DUP >> 4) & 1)); id_ += G) { const int id = id_ & 511; const int bh = id >> 2, p = id & 3, b = bh >> 4, h = bh & 15;
                    const bf16* Qg = QKV + (size_t)b * SEQ * 6144 + h * 128; bf16* Og = (bf16*)((unsigned char*)OB + (size_t)b * SEQ * P8K2 + h * 128); float* Sg = S1 + (size_t)b * SEQ * DM + h * 128;
#pragma unroll 1
                    for (int w = 0; w < 2; ++w) { const int qb = w ? p : 7 - p;
                        att::diff_pass<false>(Qg, Qg + 2048, Qg + 4096, Sg, Og, qb, lam, gsub, gmul, (att::ldsp)(lds + RING_OFF));
                        att::diff_pass<true>(Qg + 64, Qg + 2048 + 64, Qg + 4096, Sg, Og, qb, lam, gsub, gmul, (att::ldsp)(lds + RING_OFF)); } }
            }
            SEAM(sb + 1);
        }
        if (IN(sb + 2)) { if (PHM(5)) {
            pg8::Gemm g{OB, (const bf16*)(ws + (typeA ? WS_WOA : WS_WOB) + (size_t)(L & 1) * 2048 * P8K2), NTOK, DM, DM / 2, P8K2 / 2}; pg8::StaticOrder S; S.init(NTOK, DM, G, bx);
            pg8::EpiQkv E{MIX, DM, DM, 1.f / (pg8::W8_SCALE * att::OB8_SCALE)};
            pg8::gemm_phase<pg8::EpiQkv, pg8::StaticOrder, true, true, true>(lds + RING_OFF, g, S, E); }
            SEAM(sb + 2);
        }
        if (IN(sb + 3)) { if (PHM(6)) {
            const int tid = opq_tid(), lane = tid & 63;
            const float* lng = args.in[8] + (size_t)L * DM; const float* lnb = args.in[9] + (size_t)L * DM; const float* wr = WR + (size_t)L * 20 * 2048;
            const float* hsrc = (L == 0) ? x_in : H;
            LAS int* eid = (LAS int*)(lds + RING_OFF);
            LAS float* lgt = (LAS float*)(lds + RING_OFF + 2048);
            for (int c = bx; c < 256; c += G) {
#pragma unroll 1
                for (int grp = 0; grp < 2; ++grp) {
                    const int rloc = wave * 8 + grp * 4; const size_t row0 = (size_t)64 * c + rloc;
                    f32x4 v[4][8]; float mu[4], rstd[4];
#pragma unroll
                    for (int rr = 0; rr < 4; ++rr) { const f32x4* hp = (const f32x4*)(hsrc + (row0 + rr) * DM) + lane; const v2u* mp = (const v2u*)(MIX + (row0 + rr) * DM) + lane;
#pragma unroll
                        for (int j = 0; j < 8; ++j) { const f32x4 h = hp[64 * j]; const v2u a = mp[64 * j];
                            const f32x4 fa = {__uint_as_float(a.x << 16), __uint_as_float(a.x & 0xffff0000u), __uint_as_float(a.y << 16), __uint_as_float(a.y & 0xffff0000u)};
                            v[rr][j] = h * DN_ALPHA + fa; } }
#pragma unroll
                    for (int rr = 0; rr < 4; ++rr) { float s = 0.f;
#pragma unroll
                        for (int j = 0; j < 8; ++j) s += (v[rr][j][0] + v[rr][j][1]) + (v[rr][j][2] + v[rr][j][3]);
                        mu[rr] = dpp_sum(s) * (1.f / DM); float q = 0.f;
#pragma unroll
                        for (int j = 0; j < 8; ++j) { const f32x4 d = v[rr][j] - mu[rr]; q += (d[0] * d[0] + d[1] * d[1]) + (d[2] * d[2] + d[3] * d[3]); }
                        rstd[rr] = 1.f / sqrtf(dpp_sum(q) * (1.f / DM) + LN_EPS); }
#pragma unroll
                    for (int j = 0; j < 8; ++j) { const f32x4 gg = ((const f32x4*)lng)[64 * j + lane], bb = ((const f32x4*)lnb)[64 * j + lane];
#pragma unroll
                        for (int rr = 0; rr < 4; ++rr) { v[rr][j] = (v[rr][j] - mu[rr]) * rstd[rr] * gg + bb; ((f32x4*)(H + (row0 + rr) * DM))[64 * j + lane] = v[rr][j]; } }
#pragma unroll 1
                    for (int cc = 0; cc < 20; ++cc) { const f32x4* wp = (const f32x4*)(wr + cc * 2048) + lane; float a[4] = {0.f, 0.f, 0.f, 0.f};
#pragma unroll
                        for (int j = 0; j < 8; ++j) { const f32x4 w = wp[64 * j];
#pragma unroll
                            for (int rr = 0; rr < 4; ++rr) a[rr] += (v[rr][j][0] * w[0] + v[rr][j][1] * w[1]) + (v[rr][j][2] * w[2] + v[rr][j][3] * w[3]); }
#pragma unroll
                        for (int rr = 0; rr < 4; ++rr) a[rr] = dpp_sum(a[rr]);
                        if (lane == 0) { lgt[rloc * 20 + cc] = a[0]; lgt[(rloc + 1) * 20 + cc] = a[1]; lgt[(rloc + 2) * 20 + cc] = a[2]; lgt[(rloc + 3) * 20 + cc] = a[3]; } }
                }
                LDS_WAIT();
                if (lane < 8) {
                    const int rl = wave * 8 + lane; const LAS float* lg = lgt + rl * 20;
                    int gsel = 0; float gm = lg[0];
#pragma unroll
                    for (int i = 1; i < 4; ++i) { const float x = lg[i]; if (x > gm) { gm = x; gsel = i; } }
                    float gden = 0.f;
#pragma unroll
                    for (int i = 0; i < 4; ++i) gden += __builtin_amdgcn_exp2f((lg[i] - gm) * LOG2E);
                    const float gw_ = 1.f / gden;
                    const LAS float* li = lg + 4 + 4 * gsel;
                    const float l0 = li[0], l1 = li[1], l2 = li[2], l3 = li[3];
                    int i0 = 0; float v0 = l0;
                    if (l1 > v0) { v0 = l1; i0 = 1; } if (l2 > v0) { v0 = l2; i0 = 2; } if (l3 > v0) { v0 = l3; i0 = 3; }
                    int i1 = -1; float v1 = 0.f;
                    if (i0 != 0) { v1 = l0; i1 = 0; }
                    if (i0 != 1 && (i1 < 0 || l1 > v1)) { v1 = l1; i1 = 1; }
                    if (i0 != 2 && (i1 < 0 || l2 > v1)) { v1 = l2; i1 = 2; }
                    if (i0 != 3 && (i1 < 0 || l3 > v1)) { v1 = l3; i1 = 3; }
                    const float t = __builtin_amdgcn_exp2f((v1 - v0) * LOG2E); const float w0 = gw_ / (1.f + t), w1 = gw_ * t / (1.f + t);
                    eid[2 * rl] = gsel * 4 + i0; eid[2 * rl + 1] = gsel * 4 + i1; RW[(size_t)64 * c + rl] = (f32x2){w0, w1};
                }
                __syncthreads();
                if (wave == 0) {
                    const int ea = eid[lane], eb = eid[64 + lane]; int ra = 0, rb = 0, cnt = 0; const unsigned long long lt = (1ull << lane) - 1ull;
#pragma unroll
                    for (int e = 0; e < 16; ++e) { const unsigned long long ma = __ballot(ea == e), mb = __ballot(eb == e);
                        if (ea == e) ra = __popcll(ma & lt); if (eb == e) rb = __popcll(ma) + __popcll(mb & lt); if (lane == e) cnt = __popcll(ma) + __popcll(mb); }
                    if (lane < 16) CNT[c * 16 + lane] = cnt;
                    LAS int* rk = (LAS int*)(lds + RING_OFF + 1024); rk[lane] = ra; rk[64 + lane] = rb; LDS_WAIT();
                    const int r = lane; const unsigned word = (unsigned)eid[2 * r] | ((unsigned)eid[2 * r + 1] << 8) | ((unsigned)rk[2 * r] << 16) | ((unsigned)rk[2 * r + 1] << 24);
                    RE[(size_t)64 * c + r] = word;
                }
                __syncthreads();
            } }
            SEAM(sb + 3);
        }
        if ((IN(sb + 4) || IN(sb + 5) || IN(sb + 6)) && PHM(7)) {
            const int tid = opq_tid();
            LAS int* part = (LAS int*)(lds + RING_OFF);
            { const int e = tid & 15, s = tid >> 4; int a = 0;
#pragma unroll
              for (int i = 0; i < 8; ++i) a += CNT[(8 * s + i) * 16 + e];
              part[s * 16 + e] = a; }
            __syncthreads();
            if (tid < 16) { int run = 0;
#pragma clang loop vectorize(disable) unroll(disable)
                for (int s = 0; s < 32; ++s) run += part[s * 16 + tid];
                TAB[tid] = run; }
            __syncthreads();
            if (tid == 0) { int off = 0, mt = 0;
#pragma clang loop vectorize(disable) unroll(disable)
                for (int e = 0; e < 16; ++e) { TAB[16 + e] = off; const int nt = (TAB[e] + 255) >> 8;
#pragma clang loop vectorize(disable) unroll(disable)
                    for (int i = 0; i < nt; ++i) TAB[64 + mt++] = e;
                    off += nt * 256; }
                TAB[32] = off; TAB[33] = mt; }
            __syncthreads();
        }
        if (IN(sb + 4)) { if (PHM(7)) PREP(7) {
            const int tid = opq_tid(), lane = tid & 63;
            LAS int* part = (LAS int*)(lds + RING_OFF);
            for (int c = bx; c < 256; c += G) {
                if (tid < 16) { int pre = 0;
#pragma clang loop vectorize(disable) unroll(disable)
                    for (int s = 0; s < (c >> 3); ++s) pre += part[s * 16 + tid];
#pragma clang loop vectorize(disable) unroll(disable)
                    for (int cc = c & ~7; cc < c; ++cc) pre += CNT[cc * 16 + tid];
                    TAB[48 + tid] = TAB[16 + tid] + pre; }
                __syncthreads();
#pragma unroll 1
                for (int rr = 0; rr < 8; ++rr) { const size_t row = (size_t)64 * c + wave * 8 + rr; const unsigned word = RE[row];
                    const int p0 = TAB[48 + (word & 255)] + ((word >> 16) & 255), p1 = TAB[48 + ((word >> 8) & 255)] + (word >> 24);
                    if (lane == 0) { RP[2 * row] = p0; RP[2 * row + 1] = p1; }
                    const f32x4* hp = (const f32x4*)(H + row * DM) + lane; unsigned* o0 = (unsigned*)((unsigned char*)XS + (size_t)p0 * P8K2) + lane; unsigned* o1 = (unsigned*)((unsigned char*)XS + (size_t)p1 * P8K2) + lane;
#pragma unroll
                    for (int j = 0; j < 8; ++j) { const f32x4 v = hp[64 * j]; const unsigned o = pg8::pack4_fp8(v[0], v[1], v[2], v[3]); o0[64 * j] = o; o1[64 * j] = o; } }
                __syncthreads();
            } }
            SEAM(sb + 4);
        }
        if (IN(sb + 5)) { if (PHM(8)) PREP(8) {
            pg8::Gemm g{XS, (const bf16*)(ws + WS_WGU + (size_t)L * 16 * 2048 * P8K2), XS_ROWS, 2048, DM / 2, P8K2 / 2};
            pg8::MoeOrder S{TAB[33] * 8, G, bx, TAB + 64}; pg8::EpiGateUp8 E{(unsigned char*)ACT};
            pg8::gemm_phase<pg8::EpiGateUp8, pg8::MoeOrder, true, true, true>(lds + RING_OFF, g, S, E); }
            SEAM(sb + 5);
        }
        if (IN(sb + 6)) { if (PHM(9)) PREP(9) {
            pg8::Gemm g{ACT, (const bf16*)(ws + WS_WDN + (size_t)L * 16 * 2048 * P8K1), XS_ROWS, 2048, DEXP / 2, P8K1 / 2};
            pg8::MoeOrder S{TAB[33] * 8, G, bx, TAB + 64}; pg8::EpiDown8 E{(unsigned char*)YD};
            pg8::gemm_phase<pg8::EpiDown8, pg8::MoeOrder, true, true, true>(lds + RING_OFF, g, S, E); }
            SEAM(sb + 6);
        }
        if (IN(sb + 7)) { if (PHM(10)) for (int rep_ = 0; rep_ < ((((PROBE_DUP) >> 10) & 1) && L == NLAYER - 1 ? 5 : 1); ++rep_) {
            const int tid = opq_tid(), lane = tid & 63;
            const float* lng = args.in[10] + (size_t)L * DM; const float* lnb = args.in[11] + (size_t)L * DM; const bool last = (L == NLAYER - 1);
            const int gw = vcu * NWAVES + wave, NGW = G * NWAVES;
            for (int row = gw; row < NTOK; row += NGW) {
                const int p0 = RP[2 * row], p1 = RP[2 * row + 1]; const f32x2 w = RW[row];
                const f32x4* hp = (const f32x4*)(H + (size_t)row * DM) + lane; const unsigned* y0 = (const unsigned*)((const unsigned char*)YD + (size_t)p0 * DM) + lane; const unsigned* y1 = (const unsigned*)((const unsigned char*)YD + (size_t)p1 * DM) + lane;
                const float w0s = w.x * (1.f / pg8::YD8_SCALE), w1s = w.y * (1.f / pg8::YD8_SCALE);
                f32x4 v[8]; float s = 0.f;
#pragma unroll
                for (int j = 0; j < 8; ++j) { const f32x4 h = hp[64 * j]; const unsigned a = y0[64 * j], b = y1[64 * j];
                    const f32x2 a0 = __builtin_amdgcn_cvt_pk_f32_fp8((int)a, false), a1 = __builtin_amdgcn_cvt_pk_f32_fp8((int)a, true), b0 = __builtin_amdgcn_cvt_pk_f32_fp8((int)b, false), b1 = __builtin_amdgcn_cvt_pk_f32_fp8((int)b, true);
                    const f32x4 fa = {a0[0], a0[1], a1[0], a1[1]}, fb = {b0[0], b0[1], b1[0], b1[1]};
                    v[j] = h * DN_ALPHA + fa * w0s + fb * w1s; s += (v[j][0] + v[j][1]) + (v[j][2] + v[j][3]); }
                const float mu = dpp_sum(s) * (1.f / DM); float q = 0.f;
#pragma unroll
                for (int j = 0; j < 8; ++j) { const f32x4 d = v[j] - mu; q += (d[0] * d[0] + d[1] * d[1]) + (d[2] * d[2] + d[3] * d[3]); }
                const float rstd = 1.f / sqrtf(dpp_sum(q) * (1.f / DM) + LN_EPS);
                f32x4* op = (f32x4*)((last ? args.out : H) + (size_t)row * DM) + lane; v2u* ob = (v2u*)(HB + (size_t)row * LDH) + lane;
#pragma unroll
                for (int j = 0; j < 8; ++j) { const f32x4 gg = ((const f32x4*)lng)[64 * j + lane], bb = ((const f32x4*)lnb)[64 * j + lane];
                    const f32x4 y = (v[j] - mu) * rstd * gg + bb; op[64 * j] = y;
                    if (!last) { v2u o; o.x = pk2(y[0], y[1]); o.y = pk2(y[2], y[3]); ob[64 * j] = o; } }
            } }
            SEAM(sb + 7);
        }
    }
#undef IN
#undef SEAM
}

extern "C" void kernel_launch(void* const* d_in, const int* in_sizes, int n_in, void* d_out, int out_size, void* d_ws, size_t ws_size, hipStream_t stream) {
    static int grid = 0;
    if (grid == 0) {
        if (n_in != 17 || in_sizes[0] != NTOK * DM || out_size != NTOK * DM || ws_size < WS_END) { fprintf(stderr, "kernel_launch: unexpected shapes / workspace (n_in %d, ws %zu, need %zu)\n", n_in, ws_size, (size_t)WS_END); grid = -1; return; }
        int dev = 0, cus = 0, per_cu = 0;
        if (hipGetDevice(&dev) != hipSuccess || hipDeviceGetAttribute(&cus, hipDeviceAttributeMultiprocessorCount, dev) != hipSuccess) { grid = -1; return; }
        if (hipFuncSetAttribute((const void*)yoco_fwd, hipFuncAttributeMaxDynamicSharedMemorySize, LDS_BYTES) != hipSuccess) { fprintf(stderr, "kernel_launch: hipFuncSetAttribute failed\n"); grid = -1; return; }
        if (hipOccupancyMaxActiveBlocksPerMultiprocessor(&per_cu, (const void*)yoco_fwd, NWAVES * 64, LDS_BYTES) != hipSuccess || per_cu < 1) { fprintf(stderr, "kernel_launch: occupancy query says %d\n", per_cu); per_cu = 1; }
        (void)hipGetLastError();
        grid = cus;
    }
    if (grid < 0) return;
    (void)hipMemsetAsync((char*)d_ws + WS_CTL, 0, CTL_ZERO_BYTES, stream);
    Args a{};
    for (int i = 0; i < 17; ++i) a.in[i] = (const float*)d_in[i];
    a.out = (float*)d_out; a.ws = (unsigned char*)d_ws;
#if MK_MULTI
    for (int s = 0; s < NSTEPS; ++s) { a.s_lo = s; a.s_hi = s + 1; hipLaunchKernelGGL(yoco_fwd, dim3(grid), dim3(NWAVES * 64), LDS_BYTES, stream, a); }
#else
    a.s_lo = 0; a.s_hi = NSTEPS;
    hipLaunchKernelGGL(yoco_fwd, dim3(grid), dim3(NWAVES * 64), LDS_BYTES, stream, a);
#endif
    const hipError_t le = hipPeekAtLastError();
    if (le != hipSuccess) fprintf(stderr, "kernel_launch: launch failed: %s\n", hipGetErrorName(le));
}
```

```cpp
#include <hip/hip_runtime.h>
#include <cstdio>
#include <cstdint>

namespace pg8 {
#define PG8_LAS __attribute__((address_space(3)))
typedef unsigned short bf16_t;
typedef short bf16x8 __attribute__((ext_vector_type(8)));
typedef float f32x4 __attribute__((ext_vector_type(4)));
typedef unsigned u32x4 __attribute__((ext_vector_type(4)));
typedef int pg8_v8i __attribute__((ext_vector_type(8)));
constexpr int BM = 256, BK = 64, HALF = 128, HTB = HALF * BK * 2  , STAGE_BYTES = 8 * HTB, NXCD = 8, WGM = 8;

__host__ __device__ __forceinline__ int lds_byte(int r, int c) { const int st = (r >> 4) * 2 + (c >> 5), rr = r & 15, cc = c & 31, ob = rr * 64 + cc * 2; return st * 1024 + (ob ^ (((ob >> 9) & 1) << 5)); }
__host__ __device__ __forceinline__ void stage_rc(int b, int& R, int& C) { const int st = b / 1024, sb = b % 1024, swz = sb ^ (((sb >> 9) & 1) << 5); R = (st >> 1) * 16 + swz / 64; C = (st & 1) * 32 + (swz % 64) / 2; }
__host__ __device__ __forceinline__ int perm32(int rho) { const int n = rho >> 4, i = rho & 15; return 8 * (i >> 2) + 4 * n + (i & 3); }

struct Unit { int pm, pn; };
struct Gemm { const bf16_t* A; const bf16_t* Bt; int M, N, K, ld; };

struct StaticOrder {
    int nM, nN, nwg, G, c;
    __host__ __device__ void init(int M, int N, int G_, int c_) { nM = M / BM; nN = N / BM; nwg = nM * nN; G = G_; c = c_; }
    __host__ __device__ bool next(int i, Unit& u) const {
        const long L = (long)i * G + c; if (L >= nwg) return false;
        int wgid = (int)L; { const int q = nwg / NXCD, r = nwg % NXCD, xcd = wgid % NXCD, off = wgid / NXCD; wgid = (xcd < r ? xcd * (q + 1) : r * (q + 1) + (xcd - r) * q) + off; }
        const int nig = WGM * nN, gid = wgid / nig, fm = gid * WGM, gsz = (nM - fm) < WGM ? (nM - fm) : WGM;
        u.pm = fm + ((wgid % nig) % gsz); u.pn = (wgid % nig) / gsz; return true;
    }
    __device__ __forceinline__ void a_ready(const Unit&) const {}
    __device__ __forceinline__ void done(const Unit&) const {}
};

__device__ __forceinline__ unsigned cvt_pk_bf16(float lo, float hi) { unsigned r; asm volatile("v_cvt_pk_bf16_f32 %0, %1, %2" : "=v"(r) : "v"(lo), "v"(hi)); return r; }
typedef float f32x2 __attribute__((ext_vector_type(2)));

typedef unsigned u32x2 __attribute__((ext_vector_type(2)));
__device__ __forceinline__ u32x4 pack8_bf16(const f32x4 a, const f32x4 b) { u32x4 w; w.x = cvt_pk_bf16(a[0], a[1]); w.y = cvt_pk_bf16(a[2], a[3]); w.z = cvt_pk_bf16(b[0], b[1]); w.w = cvt_pk_bf16(b[2], b[3]); return w; }

struct EpiQkv {
    static constexpr bool PERM = true, AFTER_DRAIN = false;
    bf16_t* O; int ldc; int qcols; float qscale; float osc;
    __device__ __forceinline__ void operator()(const f32x4 (&acc)[2][2][4][2], const Unit& u, int wr, int wc, int fr, int fq) const {
        const int row0 = u.pm * BM + wr * 64 + fr, colt = u.pn * BM; const float sc = (colt < qcols ? qscale : 1.f) * osc;
        const int col0 = colt + wc * 32 + 8 * fq;
#pragma unroll
        for (int ai = 0; ai < 2; ++ai)
#pragma unroll
            for (int m = 0; m < 4; ++m) { bf16_t* rowp = O + (size_t)(row0 + ai * HALF + m * 16) * ldc + col0;
#pragma unroll
                for (int bj = 0; bj < 2; ++bj) *(u32x4*)(rowp + bj * HALF) = pack8_bf16(acc[ai][bj][m][0] * sc, acc[ai][bj][m][1] * sc); }
    }
};
template <int ACCS_INV> struct EpiResid {
    static constexpr bool PERM = false, AFTER_DRAIN = false;
    static constexpr int ldc = 2048; static constexpr float alpha = 1.6817928305074292f, accs = 1.f / (float)ACCS_INV;
    float* H; const float* Hsrc;
    __device__ __forceinline__ void operator()(const f32x4 (&acc)[2][2][4][2], const Unit& u, int wr, int wc, int fr, int fq) const {
        const int row0 = u.pm * BM + wr * 64 + fr, col0 = u.pn * BM + wc * 32 + 4 * fq;
#pragma unroll
        for (int ai = 0; ai < 2; ++ai)
#pragma unroll
            for (int m = 0; m < 4; ++m) { const size_t ro = (size_t)(row0 + ai * HALF + m * 16) * ldc + col0; float* rowp = H + ro; const float* srcp = Hsrc + ro;
#pragma unroll
                for (int bj = 0; bj < 2; ++bj)
#pragma unroll
                    for (int n = 0; n < 2; ++n) { const f32x4 h = *(const f32x4*)(srcp + bj * HALF + n * 16); *(f32x4*)(rowp + bj * HALF + n * 16) = h * alpha + acc[ai][bj][m][n] * accs; } }
    }
};
struct EpiRope {
    static constexpr bool PERM = true, AFTER_DRAIN = false;
    bf16_t* O; int ldc; int qcols, ropecols; float qscale; const float* ctab; const float* stab; float osc;
    __device__ __forceinline__ void operator()(const f32x4 (&acc)[2][2][4][2], const Unit& u, int wr, int wc, int fr, int fq) const {
        const int row0 = u.pm * BM + wr * 64 + fr, colt = u.pn * BM;
        if (colt >= ropecols) {
            const int col0 = colt + wc * 32 + 8 * fq;
#pragma unroll
            for (int ai = 0; ai < 2; ++ai)
#pragma unroll
                for (int m = 0; m < 4; ++m) { bf16_t* rowp = O + (size_t)(row0 + ai * HALF + m * 16) * ldc + col0;
#pragma unroll
                    for (int bj = 0; bj < 2; ++bj) *(u32x4*)(rowp + bj * HALF) = pack8_bf16(acc[ai][bj][m][0] * osc, acc[ai][bj][m][1] * osc); }
        } else {
            const float sc = (colt < qcols ? qscale : 1.f) * osc;
            const int col0 = colt + wc * 64 + 8 * fq;
#pragma unroll
            for (int ai = 0; ai < 2; ++ai)
#pragma unroll
                for (int m = 0; m < 4; ++m) { const int row = row0 + ai * HALF + m * 16; const int pos = row & 2047;
                    const f32x4 c0 = *(const f32x4*)(ctab + pos * 32 + 8 * fq), c1 = *(const f32x4*)(ctab + pos * 32 + 8 * fq + 4);
                    const f32x4 s0 = *(const f32x4*)(stab + pos * 32 + 8 * fq), s1 = *(const f32x4*)(stab + pos * 32 + 8 * fq + 4);
                    const f32x4 a0 = acc[ai][0][m][0], a1 = acc[ai][0][m][1], b0 = acc[ai][1][m][0], b1 = acc[ai][1][m][1];
                    bf16_t* rowp = O + (size_t)row * ldc + col0;
                    *(u32x4*)(rowp) = pack8_bf16((a0 * c0 - b0 * s0) * sc, (a1 * c1 - b1 * s1) * sc);
                    *(u32x4*)(rowp + 32) = pack8_bf16((b0 * c0 + a0 * s0) * sc, (b1 * c1 + a1 * s1) * sc);
                    asm volatile("" ::: "memory"); }
        }
    }
};
struct EpiGateUp {
    static constexpr bool PERM = true, AFTER_DRAIN = false;
    bf16_t* O;
    __device__ __forceinline__ void operator()(const f32x4 (&acc)[2][2][4][2], const Unit& u, int wr, int wc, int fr, int fq) const {
        const int row0 = u.pm * BM + wr * 64 + fr, col0 = (u.pn & 7) * 128 + wc * 32 + 8 * fq;
#pragma unroll
        for (int ai = 0; ai < 2; ++ai)
#pragma unroll
            for (int m = 0; m < 4; ++m) { f32x4 r[2];
#pragma unroll
                for (int n = 0; n < 2; ++n) { const f32x4 g = acc[ai][0][m][n], up = acc[ai][1][m][n];
#pragma unroll
                    for (int i = 0; i < 4; ++i) { const float e = __builtin_amdgcn_exp2f(g[i] * -1.4426950408889634f); r[n][i] = g[i] * __builtin_amdgcn_rcpf(1.f + e) * up[i]; } }
                *(u32x4*)(O + (size_t)(row0 + ai * HALF + m * 16) * 1024 + col0) = pack8_bf16(r[0], r[1]); }
    }
};
struct EpiDown {
    static constexpr bool PERM = true, AFTER_DRAIN = false;
    bf16_t* O;
    __device__ __forceinline__ void operator()(const f32x4 (&acc)[2][2][4][2], const Unit& u, int wr, int wc, int fr, int fq) const {
        const int row0 = u.pm * BM + wr * 64 + fr, col0 = (u.pn & 7) * BM + wc * 32 + 8 * fq;
#pragma unroll
        for (int ai = 0; ai < 2; ++ai)
#pragma unroll
            for (int m = 0; m < 4; ++m) { bf16_t* rowp = O + (size_t)(row0 + ai * HALF + m * 16) * 2048 + col0;
#pragma unroll
                for (int bj = 0; bj < 2; ++bj) *(u32x4*)(rowp + bj * HALF) = pack8_bf16(acc[ai][bj][m][0], acc[ai][bj][m][1]); }
    }
};
constexpr float W8_SCALE = 64.f, ACT8_SCALE = 4.f;
__device__ __forceinline__ unsigned pack4_fp8(float a, float b, float c, float d) { int w; asm volatile("" : "=v"(w));
    w = __builtin_amdgcn_cvt_pk_fp8_f32(a, b, w, false); w = __builtin_amdgcn_cvt_pk_fp8_f32(c, d, w, true); return (unsigned)w; }
struct EpiGateUp8 {
    static constexpr bool PERM = true, AFTER_DRAIN = false;
    unsigned char* O;
    __device__ __forceinline__ void operator()(const f32x4 (&acc)[2][2][4][2], const Unit& u, int wr, int wc, int fr, int fq) const {
        const int row0 = u.pm * BM + wr * 64 + fr, col0 = (u.pn & 7) * 128 + wc * 32 + 8 * fq;
        constexpr float SI = 1.f / W8_SCALE;
#pragma unroll
        for (int ai = 0; ai < 2; ++ai)
#pragma unroll
            for (int m = 0; m < 4; ++m) { f32x4 r[2];
#pragma unroll
                for (int n = 0; n < 2; ++n) { const f32x4 g = acc[ai][0][m][n] * SI, up = acc[ai][1][m][n] * (SI * ACT8_SCALE);
#pragma unroll
                    for (int i = 0; i < 4; ++i) { const float e = __builtin_amdgcn_exp2f(g[i] * -1.4426950408889634f); r[n][i] = g[i] * __builtin_amdgcn_rcpf(1.f + e) * up[i]; } }
                u32x2 w; w.x = pack4_fp8(r[0][0], r[0][1], r[0][2], r[0][3]); w.y = pack4_fp8(r[1][0], r[1][1], r[1][2], r[1][3]);
                *(u32x2*)(O + (size_t)(row0 + ai * HALF + m * 16) * 1024 + col0) = w; }
    }
};
constexpr float YD8_SCALE = 16.f;
struct EpiDown8 {
    static constexpr bool PERM = true, AFTER_DRAIN = false;
    unsigned char* O;
    __device__ __forceinline__ void operator()(const f32x4 (&acc)[2][2][4][2], const Unit& u, int wr, int wc, int fr, int fq) const {
        const int row0 = u.pm * BM + wr * 64 + fr, col0 = (u.pn & 7) * BM + wc * 32 + 8 * fq;
        constexpr float SI = YD8_SCALE / (W8_SCALE * ACT8_SCALE);
#pragma unroll
        for (int ai = 0; ai < 2; ++ai)
#pragma unroll
            for (int m = 0; m < 4; ++m) { unsigned char* rowp = O + (size_t)(row0 + ai * HALF + m * 16) * 2048 + col0;
#pragma unroll
                for (int bj = 0; bj < 2; ++bj) { const f32x4 a = acc[ai][bj][m][0] * SI, c = acc[ai][bj][m][1] * SI; u32x2 w; w.x = pack4_fp8(a[0], a[1], a[2], a[3]); w.y = pack4_fp8(c[0], c[1], c[2], c[3]);
                    *(u32x2*)(rowp + bj * HALF) = w; } }
    }
};
struct MoeOrder {
    int nunits, G, c; const PG8_LAS int* tile_e;
    __device__ __forceinline__ bool next(int i, Unit& u) const {
        int idx;
        if ((G & 7) == 0) { const int per = G >> 3; idx = (i * 8 + (c & 7)) * per + (c >> 3); } else idx = i * G + c;
        if (idx >= nunits) return false;
        const int mt = idx >> 3; u.pm = mt; u.pn = tile_e[mt] * 8 + (idx & 7); return true;
    }
    __device__ __forceinline__ void a_ready(const Unit&) const {}
    __device__ __forceinline__ void done(const Unit&) const {}
};

template <class Epi, class Sched, bool ALIGN_EPI = false, bool SP2 = false, bool F8 = false>
__device__ __forceinline__ void gemm_phase(PG8_LAS unsigned char* lds, const Gemm g, const Sched& S, const Epi& E) {
    int tid_ = threadIdx.x; asm volatile("" : "+v"(tid_));
    const int tid = tid_, wid = __builtin_amdgcn_readfirstlane(tid >> 6), lane = tid & 63, wr = wid >> 2, wc = wid & 3, fr = lane & 15, fq = lane >> 4;
    const int K = g.K, LD = g.ld, nt = K / BK;
    unsigned voffA, voffB;
    { int R, C; stage_rc(tid * 16, R, C); const int Rb = Epi::PERM ? ((R & ~31) + perm32(R & 31)) : R;
        voffA = (unsigned)(R * LD + C) * 2u; voffB = (unsigned)(Rb * LD + C) * 2u; }
    const size_t pstep = (size_t)64 * LD * 2;
    const size_t kstep = (size_t)(BK * 2);
    const size_t hstep = (size_t)HALF * LD * 2;
    const size_t tstep = 2 * hstep;
    const unsigned ldsbase = (unsigned)(uintptr_t)lds;
    const unsigned ldsw = (unsigned)wid * 1024u;
    const int aoff = lds_byte(wr * 64 + fr, fq * 8), boff = lds_byte(wc * 32 + fr, fq * 8);
#define PG8_SA(b, h) (((b) * 2 + (h)) * HTB)
#define PG8_SB(b, h) ((4 + (b) * 2 + (h)) * HTB)
#define PG8_STAGE(bufoff, gbase, voff) do { _Pragma("unroll") for (int _i = 0; _i < 2; ++_i) { unsigned keep_; \
        asm volatile("s_mov_b32 %0, m0\n\ts_mov_b32 m0, %3\n\ts_nop 0\n\tglobal_load_lds_dwordx4 %1, %2\n\ts_mov_b32 m0, %0" : "=&s"(keep_) \
            : "v"(voff), "s"((const char*)(gbase) + _i * pstep), "s"(ldsbase + (unsigned)(bufoff) + ldsw + (unsigned)(_i * 8192))); } } while (0)
#define PG8_CAT(a, b) __builtin_bit_cast(pg8_v8i, __builtin_shufflevector(a, b, 0, 1, 2, 3, 4, 5, 6, 7, 8, 9, 10, 11, 12, 13, 14, 15))
#define PG8_LDA(dst, b, h) do { if constexpr (F8) { _Pragma("unroll") for (int m = 0; m < 4; ++m) { const bf16x8 lo_ = *(const PG8_LAS bf16x8*)(lds + PG8_SA(b, h) + aoff + m * 2048), hi_ = *(const PG8_LAS bf16x8*)(lds + PG8_SA(b, h) + aoff + m * 2048 + 1024); dst##8[m] = PG8_CAT(lo_, hi_); } } \
        else { _Pragma("unroll") for (int m = 0; m < 4; ++m) _Pragma("unroll") for (int k = 0; k < 2; ++k) dst[m][k] = *(const PG8_LAS bf16x8*)(lds + PG8_SA(b, h) + aoff + m * 2048 + k * 1024); } } while (0)
#define PG8_LDB(dst, b, h) do { if constexpr (F8) { _Pragma("unroll") for (int n = 0; n < 2; ++n) { const bf16x8 lo_ = *(const PG8_LAS bf16x8*)(lds + PG8_SB(b, h) + boff + n * 2048), hi_ = *(const PG8_LAS bf16x8*)(lds + PG8_SB(b, h) + boff + n * 2048 + 1024); dst##8[n] = PG8_CAT(lo_, hi_); } } \
        else { _Pragma("unroll") for (int n = 0; n < 2; ++n) _Pragma("unroll") for (int k = 0; k < 2; ++k) dst[n][k] = *(const PG8_LAS bf16x8*)(lds + PG8_SB(b, h) + boff + n * 2048 + k * 1024); } } while (0)
#define PG8_MMA(ai, bj, At, Bt) do { __builtin_amdgcn_s_setprio(1); \
        if constexpr (F8) { _Pragma("unroll") for (int m = 0; m < 4; ++m) _Pragma("unroll") for (int n = 0; n < 2; ++n) \
            acc[ai][bj][m][n] = __builtin_amdgcn_mfma_scale_f32_16x16x128_f8f6f4(Bt##8[n], At##8[m], acc[ai][bj][m][n], 0, 0, 0, 0, 0, 0); } \
        else { _Pragma("unroll") for (int m = 0; m < 4; ++m) _Pragma("unroll") for (int n = 0; n < 2; ++n) _Pragma("unroll") for (int k = 0; k < 2; ++k) \
            acc[ai][bj][m][n] = __builtin_amdgcn_mfma_f32_16x16x32_bf16(Bt[n][k], At[m][k], acc[ai][bj][m][n], 0, 0, 0); } \
        __builtin_amdgcn_s_setprio(0); } while (0)
#define PG8_WAIT_V(n) asm volatile("s_waitcnt vmcnt(" #n ")" ::: "memory")
#define PG8_WAIT_L(n) asm volatile("s_waitcnt lgkmcnt(" #n ")" ::: "memory")
#define PG8_BAR __builtin_amdgcn_s_barrier()
#define PG8_SCHED __builtin_amdgcn_sched_barrier(0)
    Unit cur, nxt; int ui = 0;
    if (!S.next(0, cur)) return;
    f32x4 acc[2][2][4][2];
{ float zero_; asm volatile("v_mov_b32 %0, 0" : "=v"(zero_));
#pragma unroll
    for (int a = 0; a < 2; ++a)
#pragma unroll
        for (int b = 0; b < 2; ++b)
#pragma unroll
            for (int m = 0; m < 4; ++m)
#pragma unroll
                for (int n = 0; n < 2; ++n) acc[a][b][m][n] = (f32x4){zero_, zero_, zero_, zero_}; }
    bf16x8 At[4][2], B0[2][2], B1[2][2]; pg8_v8i At8[4], B08[2], B18[2];
    const char* cA = (const char*)g.A + (size_t)cur.pm * tstep; const char* cB = (const char*)g.Bt + (size_t)cur.pn * tstep;
    S.a_ready(cur);
    if constexpr (SP2) {
        PG8_STAGE(PG8_SB(0, 0), cB, voffB); PG8_STAGE(PG8_SB(0, 1), cB + hstep, voffB); PG8_STAGE(PG8_SA(0, 0), cA, voffA); PG8_STAGE(PG8_SA(0, 1), cA + hstep, voffA);
        if (wr == 1) PG8_BAR;
        PG8_WAIT_V(2); PG8_BAR;
        PG8_STAGE(PG8_SB(1, 0), cB + kstep, voffB); PG8_STAGE(PG8_SA(1, 0), cA + kstep, voffA); PG8_STAGE(PG8_SB(1, 1), cB + hstep + kstep, voffB);
        PG8_WAIT_V(6); PG8_BAR;
    } else {
        PG8_STAGE(PG8_SB(0, 0), cB, voffB); PG8_STAGE(PG8_SA(0, 0), cA, voffA); PG8_STAGE(PG8_SB(0, 1), cB + hstep, voffB); PG8_STAGE(PG8_SA(0, 1), cA + hstep, voffA);
        if (wr == 1) PG8_BAR;
        PG8_WAIT_V(4); PG8_BAR;
        PG8_STAGE(PG8_SB(1, 0), cB + kstep, voffB); PG8_STAGE(PG8_SA(1, 0), cA + kstep, voffA); PG8_STAGE(PG8_SB(1, 1), cB + hstep + kstep, voffB);
        PG8_WAIT_V(6); PG8_BAR;
    }
    for (;;) {
        const bool has_next = S.next(ui + 1, nxt);
        const char* nA = has_next ? (const char*)g.A + (size_t)nxt.pm * tstep : cA; const char* nB = has_next ? (const char*)g.Bt + (size_t)nxt.pn * tstep : cB;
#pragma unroll 1
        for (int t = 0; t < nt; t += 2) {
            const bool last = (t == nt - 2);
            const char* a1 = cA + (size_t)(t + 1) * kstep;
            const char* a2 = last ? nA : cA + (size_t)(t + 2) * kstep; const char* b2 = last ? nB : cB + (size_t)(t + 2) * kstep;
            const char* a3 = a2 + kstep; const char* b3 = b2 + kstep;
            if (last && has_next) S.a_ready(nxt);
            if constexpr (SP2) {
            PG8_LDB(B0, 0, 0); PG8_LDB(B1, 0, 1); PG8_SCHED; PG8_LDA(At, 0, 0); PG8_STAGE(PG8_SA(1, 1), a1 + hstep, voffA);
            PG8_WAIT_V(8); PG8_WAIT_L(0); PG8_BAR; PG8_MMA(0, 0, At, B0); PG8_MMA(0, 1, At, B1); PG8_BAR; PG8_SCHED;
            PG8_LDA(At, 0, 1); PG8_STAGE(PG8_SB(0, 0), b2, voffB); PG8_STAGE(PG8_SB(0, 1), b2 + hstep, voffB); PG8_STAGE(PG8_SA(0, 0), a2, voffA);
            PG8_WAIT_V(8); PG8_WAIT_L(0); PG8_BAR; PG8_MMA(1, 0, At, B0); PG8_MMA(1, 1, At, B1); PG8_BAR; PG8_SCHED;
            PG8_LDB(B0, 1, 0); PG8_LDB(B1, 1, 1); PG8_SCHED; PG8_LDA(At, 1, 0); PG8_STAGE(PG8_SA(0, 1), a2 + hstep, voffA);
            PG8_WAIT_V(8); PG8_WAIT_L(0); PG8_BAR; PG8_MMA(0, 0, At, B0); PG8_MMA(0, 1, At, B1); PG8_BAR; PG8_SCHED;
            PG8_LDA(At, 1, 1); PG8_STAGE(PG8_SB(1, 0), b3, voffB); PG8_STAGE(PG8_SB(1, 1), b3 + hstep, voffB); PG8_STAGE(PG8_SA(1, 0), a3, voffA);
            PG8_WAIT_V(8); PG8_WAIT_L(0); PG8_BAR; PG8_MMA(1, 0, At, B0); PG8_MMA(1, 1, At, B1); PG8_BAR; PG8_SCHED;
            } else {
            PG8_LDB(B0, 0, 0); PG8_SCHED; PG8_LDA(At, 0, 0); PG8_STAGE(PG8_SA(1, 1), a1 + hstep, voffA);
            PG8_WAIT_L(8); PG8_BAR; PG8_WAIT_L(0); PG8_MMA(0, 0, At, B0); PG8_BAR; PG8_SCHED;
            PG8_LDB(B1, 0, 1); PG8_STAGE(PG8_SB(0, 0), b2, voffB);
            PG8_BAR; PG8_WAIT_L(0); PG8_MMA(0, 1, At, B1); PG8_BAR;
            PG8_LDA(At, 0, 1); PG8_STAGE(PG8_SA(0, 0), a2, voffA);
            PG8_BAR; PG8_WAIT_L(0); PG8_MMA(1, 0, At, B0); PG8_BAR; PG8_SCHED;
            PG8_STAGE(PG8_SB(0, 1), b2 + hstep, voffB);
            PG8_WAIT_V(6); PG8_BAR; PG8_MMA(1, 1, At, B1); PG8_BAR;
            PG8_LDB(B0, 1, 0); PG8_SCHED; PG8_LDA(At, 1, 0); PG8_STAGE(PG8_SA(0, 1), a2 + hstep, voffA);
            PG8_WAIT_L(8); PG8_BAR; PG8_WAIT_L(0); PG8_MMA(0, 0, At, B0); PG8_BAR; PG8_SCHED;
            PG8_LDB(B1, 1, 1); PG8_STAGE(PG8_SB(1, 0), b3, voffB);
            PG8_BAR; PG8_WAIT_L(0); PG8_MMA(0, 1, At, B1); PG8_BAR;
            PG8_LDA(At, 1, 1); PG8_STAGE(PG8_SA(1, 0), a3, voffA);
            PG8_BAR; PG8_WAIT_L(0); PG8_MMA(1, 0, At, B0); PG8_BAR; PG8_SCHED;
            PG8_STAGE(PG8_SB(1, 1), b3 + hstep, voffB);
            PG8_WAIT_V(6); PG8_BAR; PG8_MMA(1, 1, At, B1); PG8_BAR;
            }
        }
        if constexpr (ALIGN_EPI) { if (wr == 0) PG8_BAR; }
        if constexpr (!Epi::AFTER_DRAIN) { E(acc, cur, wr, wc, fr, fq); S.done(cur); }
        if (!has_next) break;
{ float zero_; asm volatile("v_mov_b32 %0, 0" : "=v"(zero_));
#pragma unroll
        for (int a = 0; a < 2; ++a)
#pragma unroll
            for (int b = 0; b < 2; ++b)
#pragma unroll
                for (int m = 0; m < 4; ++m)
#pragma unroll
                    for (int n = 0; n < 2; ++n) acc[a][b][m][n] = (f32x4){zero_, zero_, zero_, zero_}; }
        cur = nxt; cA = nA; cB = nB; ++ui;
        if constexpr (ALIGN_EPI) { if (wr == 1) PG8_BAR; }
    }
    PG8_WAIT_V(0);
    if constexpr (!ALIGN_EPI) { if (wr == 0) PG8_BAR; }
    PG8_BAR;
    if constexpr (Epi::AFTER_DRAIN) { E.fused(acc, cur, wr, wc, fr, fq, lds, wid, lane); S.done(cur); }
#undef PG8_SA
#undef PG8_SB
#undef PG8_STAGE
#undef PG8_LDA
#undef PG8_LDB
#undef PG8_MMA
#undef PG8_CAT
#undef PG8_WAIT_V
#undef PG8_WAIT_L
#undef PG8_BAR
#undef PG8_SCHED
}
}

namespace att {
#define ALAS __attribute__((address_space(3)))
typedef unsigned short bf16_t;
typedef short bf16x8 __attribute__((ext_vector_type(8)));
typedef short s16x4 __attribute__((ext_vector_type(4)));
typedef float f32x16 __attribute__((ext_vector_type(16)));
typedef float f32x4 __attribute__((ext_vector_type(4)));
typedef unsigned u32x4 __attribute__((ext_vector_type(4)));
typedef ALAS char* ldsp;
#ifndef WO_F8
#define WO_F8 1
#endif
constexpr float OB8_SCALE = 8.f;
constexpr int QP = 6144;
constexpr int OP = 2048;
constexpr int OBP = 2048;
constexpr int SHM_V = 16384, SHM_K = 16384;
constexpr int LDS_V = 0, LDS_K = 2 * SHM_V, LDS_WS = LDS_K + 2 * SHM_K, ATT_LDS_BYTES = LDS_WS + 8 * 256;
#define KSWZ(row, colB) ((row) * 256 + ((colB) ^ (((row) & 7) << 4)))
#define KSWZ64(row, colB) ((row) * 128 + ((colB) ^ (((row) & 7) << 4)))
#define SBAR() __builtin_amdgcn_sched_barrier(0)
__device__ __forceinline__ int v_st(int k, int c) { const int kk = (k & ~0xC) | ((k & 4) << 1) | ((k & 8) >> 1); return ((kk >> 3) * 4 + (c >> 5)) * 512 + ((kk & 7) * 32 + (c & 31)) * 2; }
__device__ __forceinline__ int v_rd_base(int lane) { return ((lane & 3) << 3) | (((lane >> 2) & 3) << 6) | (((lane >> 4) & 1) << 5) | (((lane >> 5) & 1) << 8); }
constexpr int v_rd_off(int d0, int ks, int half) { return d0 * 512 + ks * 4096 + half * 2048; }
__device__ __forceinline__ int crow(int r, int hi) { return (r & 3) + 8 * (r >> 2) + 4 * hi; }
__device__ __forceinline__ unsigned cvtpk(float lo, float hi) { unsigned r; asm volatile("v_cvt_pk_bf16_f32 %0, %1, %2" : "=v"(r) : "v"(lo), "v"(hi)); return r; }
__device__ __forceinline__ bf16x8 ldg8(const bf16_t* p) { return *reinterpret_cast<const bf16x8*>(p); }
__device__ __forceinline__ unsigned quad_pack_fp8(float v) {
    const int b = __builtin_bit_cast(int, v);
    const float v1 = __builtin_bit_cast(float, __builtin_amdgcn_update_dpp(b, b, 0x55, 0xf, 0xf, false));
    const float v2 = __builtin_bit_cast(float, __builtin_amdgcn_update_dpp(b, b, 0xAA, 0xf, 0xf, false));
    const float v3 = __builtin_bit_cast(float, __builtin_amdgcn_update_dpp(b, b, 0xFF, 0xf, 0xf, false));
    int w; asm volatile("" : "=v"(w));
    w = __builtin_amdgcn_cvt_pk_fp8_f32(v, v1, w, false); w = __builtin_amdgcn_cvt_pk_fp8_f32(v2, v3, w, true); return (unsigned)w;
}
__device__ __forceinline__ float xhalf(float v, int hi) {
    auto rr = __builtin_amdgcn_permlane32_swap(__float_as_uint(v), __float_as_uint(v), false, false);
    return __uint_as_float(hi ? rr[0] : rr[1]);
}
#define ATT_PK4(P, B_, OUT) do { unsigned a0 = cvtpk(P[B_+0], P[B_+1]), a1 = cvtpk(P[B_+2], P[B_+3]);                      \
        unsigned b0 = cvtpk(P[B_+4], P[B_+5]), b1 = cvtpk(P[B_+6], P[B_+7]);                                             \
        auto r0 = __builtin_amdgcn_permlane32_swap(a0, b0, false, false); auto r1 = __builtin_amdgcn_permlane32_swap(a1, b1, false, false); \
        u32x4 w = {r0[0], r1[0], r0[1], r1[1]}; OUT = *reinterpret_cast<bf16x8*>(&w); } while (0)
__device__ __forceinline__ void pv_tile(f32x16* o, int vb, bf16x8 pa0, bf16x8 pa1, bf16x8 pa2, bf16x8 pa3) {
#define TRRD(dst, off) asm volatile("ds_read_b64_tr_b16 %0, %1 offset:%2" : "=&v"(dst) : "v"(vb), "i"(off) : "memory")
#define PV_D0(d0) do { s16x4 l0, l1, l2, l3, h0, h1, h2, h3; constexpr int b_ = v_rd_off(d0, 0, 0); \
        TRRD(l0, b_); TRRD(h0, b_ + 2048); TRRD(l1, b_ + 4096); TRRD(h1, b_ + 6144); TRRD(l2, b_ + 8192); TRRD(h2, b_ + 10240); TRRD(l3, b_ + 12288); TRRD(h3, b_ + 14336); \
        asm volatile("s_waitcnt lgkmcnt(0)" ::: "memory"); SBAR(); \
        o[d0] = __builtin_amdgcn_mfma_f32_32x32x16_bf16(pa0, (bf16x8){l0[0], l0[1], l0[2], l0[3], h0[0], h0[1], h0[2], h0[3]}, o[d0], 0, 0, 0);   \
        o[d0] = __builtin_amdgcn_mfma_f32_32x32x16_bf16(pa1, (bf16x8){l1[0], l1[1], l1[2], l1[3], h1[0], h1[1], h1[2], h1[3]}, o[d0], 0, 0, 0);   \
        o[d0] = __builtin_amdgcn_mfma_f32_32x32x16_bf16(pa2, (bf16x8){l2[0], l2[1], l2[2], l2[3], h2[0], h2[1], h2[2], h2[3]}, o[d0], 0, 0, 0);   \
        o[d0] = __builtin_amdgcn_mfma_f32_32x32x16_bf16(pa3, (bf16x8){l3[0], l3[1], l3[2], l3[3], h3[0], h3[1], h3[2], h3[3]}, o[d0], 0, 0, 0); } while (0)
    PV_D0(0); PV_D0(1); PV_D0(2); PV_D0(3);
#undef PV_D0
#undef TRRD
}

__device__ __forceinline__ void sb_block(const bf16_t* __restrict__ Qg, const bf16_t* __restrict__ Kg, const bf16_t* __restrict__ Vg, bf16_t* __restrict__ Og, int qb, ldsp lds) {
    int tid_ = threadIdx.x; asm volatile("" : "+v"(tid_));
    const int tid = tid_, wid = __builtin_amdgcn_readfirstlane(tid >> 6), lane = tid & 63, r32 = lane & 31, hi = lane >> 5;
    const int NT = 4 * qb + 4, R0 = 256 * qb + 32 * wid, myrow = R0 + r32;
    const ldsp V_lds = lds + LDS_V; const ldsp K_lds = lds + LDS_K;
    bf16x8 qr[8];
    { const bf16_t* Qw = Qg + (size_t)R0 * QP; const unsigned qoff = (unsigned)(r32 * QP + hi * 8);
#pragma unroll
      for (int d0 = 0; d0 < 8; ++d0) qr[d0] = ldg8(Qw + (qoff + d0 * 16)); }
    const int sr = tid >> 4, sc = (tid & 15) * 8, kws = KSWZ(sr, sc * 2), vst0 = v_st(sr, sc), vst1 = v_st(32 + sr, sc);
    const unsigned kvoff = (unsigned)(sr * QP + sc);
    const int vb0 = (int)(unsigned)(uintptr_t)V_lds + v_rd_base(lane);
    bf16x8 sk0, sk1, sv0, sv1;
#define SB_LOAD(j) do { const bf16_t* kp_ = Kg + (size_t)(64 * (j)) * QP; const bf16_t* vp_ = Vg + (size_t)(64 * (j)) * QP; \
        sk0 = ldg8(kp_ + kvoff); sk1 = ldg8(kp_ + (size_t)32 * QP + kvoff); sv0 = ldg8(vp_ + kvoff); sv1 = ldg8(vp_ + (size_t)32 * QP + kvoff); } while (0)
#define SB_WRITE(bf) do { *(ALAS bf16x8*)(K_lds + (bf) * SHM_K + kws) = sk0; *(ALAS bf16x8*)(K_lds + (bf) * SHM_K + kws + 32 * 256) = sk1; \
        *(ALAS bf16x8*)(V_lds + (bf) * SHM_V + vst0) = sv0; *(ALAS bf16x8*)(V_lds + (bf) * SHM_V + vst1) = sv1; } while (0)
    SB_LOAD(NT - 1); SB_WRITE(0);
    __syncthreads();
    float carry = 0.f; f32x16 o[4] = {};
    ALAS int* fl = (ALAS int*)(lds + LDS_WS); bool wdone = false;
    for (int t = 0; t < NT; ++t) {
        const int j = NT - 1 - t, buf = t & 1, kb = 64 * j;
        if (t + 1 < NT) SB_LOAD(j - 1);
        if (kb <= R0 + 30 && !wdone) {
            f32x16 p0 = {}, p1 = {};
            { const ldsp Kb = K_lds + buf * SHM_K;
#pragma unroll
              for (int d0 = 0; d0 < 8; ++d0) { const ldsp a = Kb + KSWZ(r32, ((d0 & 3) * 16 + hi * 8) * 2) + (d0 >> 2) * 128;
                  const bf16x8 b0 = *(const ALAS bf16x8*)a, b1 = *(const ALAS bf16x8*)(a + 32 * 256);
                  p0 = __builtin_amdgcn_mfma_f32_32x32x16_bf16(b0, qr[d0], p0, 0, 0, 0);
                  p1 = __builtin_amdgcn_mfma_f32_32x32x16_bf16(b1, qr[d0], p1, 0, 0, 0); } }
            f32x16 lb0, lb1;
#pragma unroll
            for (int r = 0; r < 16; ++r) {
                { const float z = p0[r]; const float e = __builtin_amdgcn_exp2f(-__builtin_fabsf(z)); const float sp = __builtin_fmaxf(z, 0.f) + __builtin_amdgcn_logf(1.f + e); p0[r] = -sp; lb0[r] = z - sp; }
                { const float z = p1[r]; const float e = __builtin_amdgcn_exp2f(-__builtin_fabsf(z)); const float sp = __builtin_fmaxf(z, 0.f) + __builtin_amdgcn_logf(1.f + e); p1[r] = -sp; lb1[r] = z - sp; }
            }
            if (kb + 63 >= R0) {
                const int dq = myrow - kb - 4 * hi; const float NEG = -__builtin_inff();
#pragma unroll
                for (int r = 0; r < 16; ++r) { const int c = (r & 3) + 8 * (r >> 2);
                    if (c >= dq) { p0[r] = 0.f; lb0[r] = NEG; }
                    if (c + 32 >= dq) { p1[r] = 0.f; lb1[r] = NEG; } }
            }
            float gs[8], go[8];
#pragma unroll
            for (int g = 0; g < 4; ++g) { gs[g] = (p0[4 * g] + p0[4 * g + 1]) + (p0[4 * g + 2] + p0[4 * g + 3]); gs[4 + g] = (p1[4 * g] + p1[4 * g + 1]) + (p1[4 * g + 2] + p1[4 * g + 3]); }
#pragma unroll
            for (int i = 0; i < 8; ++i) go[i] = xhalf(gs[i], hi);
            float acc = carry;
#pragma unroll
            for (int idx = 7; idx >= 0; --idx) { const int g = idx & 3; const float base = acc + (hi ? 0.f : go[idx]);
                if (idx >= 4) { const float t3 = base, t2 = t3 + p1[4 * g + 3], t1 = t2 + p1[4 * g + 2], t0 = t1 + p1[4 * g + 1];
                    lb1[4 * g + 3] = __builtin_amdgcn_exp2f(lb1[4 * g + 3] + t3); lb1[4 * g + 2] = __builtin_amdgcn_exp2f(lb1[4 * g + 2] + t2);
                    lb1[4 * g + 1] = __builtin_amdgcn_exp2f(lb1[4 * g + 1] + t1); lb1[4 * g] = __builtin_amdgcn_exp2f(lb1[4 * g] + t0); }
                else { const float t3 = base, t2 = t3 + p0[4 * g + 3], t1 = t2 + p0[4 * g + 2], t0 = t1 + p0[4 * g + 1];
                    lb0[4 * g + 3] = __builtin_amdgcn_exp2f(lb0[4 * g + 3] + t3); lb0[4 * g + 2] = __builtin_amdgcn_exp2f(lb0[4 * g + 2] + t2);
                    lb0[4 * g + 1] = __builtin_amdgcn_exp2f(lb0[4 * g + 1] + t1); lb0[4 * g] = __builtin_amdgcn_exp2f(lb0[4 * g] + t0); }
                acc += gs[idx] + go[idx]; }
            carry = acc;
            bf16x8 pa0, pa1, pa2, pa3;
            ATT_PK4(lb0, 0, pa0); ATT_PK4(lb0, 8, pa1); ATT_PK4(lb1, 0, pa2); ATT_PK4(lb1, 8, pa3);
            SBAR();
            pv_tile(o, vb0 + buf * SHM_V, pa0, pa1, pa2, pa3);
            wdone = __all(carry < -127.f);
        }
        if (lane == 0) fl[buf * 8 + wid] = wdone ? 1 : 0;
        if (t + 1 < NT) SB_WRITE(buf ^ 1);
        __syncthreads();
        { const ALAS int* f = fl + buf * 8; if ((f[0] & f[1] & f[2] & f[3] & f[4] & f[5] & f[6] & f[7]) != 0) break; }
    }
#undef SB_LOAD
#undef SB_WRITE
#if WO_F8
    unsigned char* Ow = (unsigned char*)Og + (size_t)R0 * OBP; const unsigned ooff = (unsigned)(4 * hi * OBP + r32);
#pragma unroll
    for (int r = 0; r < 16; ++r) { unsigned char* rowp = Ow + (size_t)((r & 3) + 8 * (r >> 2)) * OBP;
#pragma unroll
        for (int d0 = 0; d0 < 4; ++d0) { const unsigned w = quad_pack_fp8(o[d0][r] * OB8_SCALE);
            if ((r32 & 3) == 0) *(unsigned*)(rowp + (ooff + d0 * 32)) = w; } }
#else
    bf16_t* Ow = Og + (size_t)R0 * OP; const unsigned ooff = (unsigned)(4 * hi * OP + r32);
#pragma unroll
    for (int r = 0; r < 16; ++r) { bf16_t* rowp = Ow + (size_t)((r & 3) + 8 * (r >> 2)) * OP;
#pragma unroll
        for (int d0 = 0; d0 < 4; ++d0) { const float v = o[d0][r]; const float vn = __shfl_xor(v, 1);
            if ((r32 & 1) == 0) *(unsigned*)(rowp + (ooff + d0 * 32)) = cvtpk(v, vn); } }
#endif
}

constexpr float ATT_THR = 8.f;
__device__ __forceinline__ void qkt64(f32x16& p0, f32x16& p1, ldsp Kb, int r32, int hi, const bf16x8* qr) {
    p0 = f32x16{}; p1 = f32x16{};
#pragma unroll
    for (int d0 = 0; d0 < 4; ++d0) { const ldsp a = Kb + KSWZ64(r32, (d0 * 16 + hi * 8) * 2);
        const bf16x8 b0 = *(const ALAS bf16x8*)a, b1 = *(const ALAS bf16x8*)(a + 32 * 128);
        p0 = __builtin_amdgcn_mfma_f32_32x32x16_bf16(b0, qr[d0], p0, 0, 0, 0);
        p1 = __builtin_amdgcn_mfma_f32_32x32x16_bf16(b1, qr[d0], p1, 0, 0, 0); }
}
__device__ __forceinline__ void partial_sm(f32x16& p0, f32x16& p1, float& m_reg, float& alpha, int hi) {
    float pmax = p0[0];
#pragma unroll
    for (int r = 1; r < 16; ++r) pmax = __builtin_fmaxf(pmax, p0[r]);
#pragma unroll
    for (int r = 0; r < 16; ++r) pmax = __builtin_fmaxf(pmax, p1[r]);
    pmax = __builtin_fmaxf(pmax, xhalf(pmax, hi));
    float mn;
    if (__builtin_expect(__all(pmax - m_reg <= ATT_THR), 1)) { mn = m_reg; alpha = 1.f; }
    else { mn = __builtin_fmaxf(m_reg, pmax); alpha = __builtin_amdgcn_exp2f(m_reg - mn); m_reg = mn; }
#pragma unroll
    for (int r = 0; r < 16; ++r) { p0[r] -= mn; p1[r] -= mn; }
#pragma unroll
    for (int r = 0; r < 16; ++r) p0[r] = __builtin_amdgcn_exp2f(p0[r]);
}
__device__ __forceinline__ void finish_sm(f32x16& p0, f32x16& p1, float alpha, float& l_reg, bf16x8& pa0, bf16x8& pa1, bf16x8& pa2, bf16x8& pa3, int hi) {
#pragma unroll
    for (int r = 0; r < 16; ++r) p1[r] = __builtin_amdgcn_exp2f(p1[r]);
    float ps = 0.f;
#pragma unroll
    for (int r = 0; r < 16; ++r) ps += p0[r];
#pragma unroll
    for (int r = 0; r < 16; ++r) ps += p1[r];
    ps += xhalf(ps, hi);
    l_reg = l_reg * alpha + ps;
    ATT_PK4(p0, 0, pa0); ATT_PK4(p0, 8, pa1); ATT_PK4(p1, 0, pa2); ATT_PK4(p1, 8, pa3);
}
__device__ __forceinline__ void mask_gt(f32x16& p0, f32x16& p1, int dq) {
    const float NEG = -__builtin_inff();
#pragma unroll
    for (int r = 0; r < 16; ++r) { const int c = (r & 3) + 8 * (r >> 2);
        if (c > dq) p0[r] = NEG;
        if (c + 32 > dq) p1[r] = NEG; }
}
template <bool SECOND>
__device__ __forceinline__ void diff_pass(const bf16_t* __restrict__ Qg, const bf16_t* __restrict__ Kg, const bf16_t* __restrict__ Vg, float* S1, bf16_t* __restrict__ Og,
                                          int qb, float lam, const float* __restrict__ gsub, float gmul, ldsp lds) {
    int tid_ = threadIdx.x; asm volatile("" : "+v"(tid_));
    const int tid = tid_, wid = __builtin_amdgcn_readfirstlane(tid >> 6), lane = tid & 63, r32 = lane & 31, hi = lane >> 5;
    const int NT = 4 * qb + 4, R0 = 256 * qb + 32 * wid, myrow = R0 + r32;
    const ldsp V_lds = lds + LDS_V; const ldsp K_lds = lds + LDS_K;
    ALAS float* wsf = (ALAS float*)(lds + LDS_WS) + wid * 64; ALAS float* li_l = wsf; ALAS float* al_l = wsf + 32;
    bf16x8 qr[4];
    { const bf16_t* Qw = Qg + (size_t)R0 * QP; const unsigned qoff = (unsigned)(r32 * QP + hi * 8);
#pragma unroll
      for (int d0 = 0; d0 < 4; ++d0) qr[d0] = ldg8(Qw + (qoff + d0 * 16)); }
    const int sr = tid >> 4, sc = (tid & 15) * 8, vst0 = v_st(sr, sc), vst1 = v_st(32 + sr, sc);
    const int kr = tid >> 3, kc = (tid & 7) * 8, kws = KSWZ64(kr, kc * 2);
    const unsigned voff = (unsigned)(sr * QP + sc), koff = (unsigned)(kr * QP + kc);
    const int vb0 = (int)(unsigned)(uintptr_t)V_lds + v_rd_base(lane);
    const int qm = myrow - 4 * hi;
    bf16x8 sk0A, sv0A, sv1A, sk0B, sv0B, sv1B;
#define DF_LOAD(S_, j) do { const bf16_t* vp_ = Vg + (size_t)(64 * (j)) * QP; sk0##S_ = ldg8(Kg + (size_t)(64 * (j)) * QP + koff); sv0##S_ = ldg8(vp_ + voff); sv1##S_ = ldg8(vp_ + (size_t)32 * QP + voff); } while (0)
#define DF_WRITE(S_, bf) do { *(ALAS bf16x8*)(K_lds + (bf) * SHM_K + kws) = sk0##S_; *(ALAS bf16x8*)(V_lds + (bf) * SHM_V + vst0) = sv0##S_; *(ALAS bf16x8*)(V_lds + (bf) * SHM_V + vst1) = sv1##S_; } while (0)
#define DF_MASK(P0, P1, t) do { if (64 * (t) + 63 > R0) mask_gt(P0, P1, qm - 64 * (t)); } while (0)
#define DF_RESC(a) do { if (__any((a) < 1.f)) { if (hi == 0) al_l[r32] = (a); asm volatile("s_waitcnt lgkmcnt(0)" ::: "memory"); \
        _Pragma("unroll") for (int d_ = 0; d_ < 4; ++d_) _Pragma("unroll") for (int r = 0; r < 16; ++r) o[d_][r] *= al_l[crow(r, hi)]; } } while (0)
    float m_reg = -1e30f, l_reg = 0.f; f32x16 o[4] = {};
    f32x16 pA0, pA1, pB0, pB1; float alA = 1.f, alB = 1.f; bf16x8 pa0, pa1, pa2, pa3;
    DF_LOAD(A, 0); DF_WRITE(A, 0);
    __syncthreads();
    DF_LOAD(A, 1); DF_LOAD(B, 2);
    qkt64(pA0, pA1, K_lds, r32, hi, qr); DF_MASK(pA0, pA1, 0); partial_sm(pA0, pA1, m_reg, alA, hi);
    DF_WRITE(A, 1);
    DF_RESC(alA);
    __syncthreads();
#define DF_HALF(PX0, PX1, alX, PY0, PY1, alY, t, KB, VB, SB, LS, WS) do { \
        SBAR(); qkt64(PX0, PX1, K_lds + (KB) * SHM_K, r32, hi, qr); \
        finish_sm(PY0, PY1, alY, l_reg, pa0, pa1, pa2, pa3, hi); SBAR(); \
        if ((t) + 2 < NT) { DF_LOAD(LS, (t) + 2); SBAR(); } \
        pv_tile(o, vb0 + (VB) * SHM_V, pa0, pa1, pa2, pa3); DF_MASK(PX0, PX1, (t)); partial_sm(PX0, PX1, m_reg, alX, hi); \
        __syncthreads(); \
        if ((t) + 1 < NT) DF_WRITE(WS, SB); \
        DF_RESC(alX); __syncthreads(); } while (0)
    for (int t = 1; t + 1 < NT; t += 2) {
        DF_HALF(pB0, pB1, alB, pA0, pA1, alA, t, 1, 0, 0, A, B);
        DF_HALF(pA0, pA1, alA, pB0, pB1, alB, t + 1, 0, 1, 1, B, A);
    }
    DF_HALF(pB0, pB1, alB, pA0, pA1, alA, NT - 1, 1, 0, 0, A, B);
    finish_sm(pB0, pB1, alB, l_reg, pa0, pa1, pa2, pa3, hi); SBAR();
    pv_tile(o, vb0 + 1 * SHM_V, pa0, pa1, pa2, pa3);
#undef DF_LOAD
#undef DF_WRITE
#undef DF_MASK
#undef DF_RESC
#undef DF_HALF
    if (hi == 0) li_l[r32] = l_reg; asm volatile("s_waitcnt lgkmcnt(0)" ::: "memory");
    float rli[16];
#pragma unroll
    for (int r = 0; r < 16; ++r) rli[r] = __builtin_amdgcn_rcpf(li_l[crow(r, hi)]);
    if constexpr (!SECOND) {
        float* Sw = S1 + (size_t)R0 * OP; const unsigned ooff = (unsigned)(4 * hi * OP + r32);
#pragma unroll
        for (int r = 0; r < 16; ++r) { float* rowp = Sw + (size_t)((r & 3) + 8 * (r >> 2)) * OP;
#pragma unroll
            for (int d0 = 0; d0 < 4; ++d0) rowp[ooff + d0 * 32] = o[d0][r] * rli[r]; }
    } else {
        const float* Sw = S1 + (size_t)R0 * OP; bf16_t* Ow = Og + (size_t)R0 * OP; (void)Ow; const unsigned ooff = (unsigned)(4 * hi * OP + r32), ooff8 = (unsigned)(4 * hi * OBP + r32);
        float gn[4];
#pragma unroll
        for (int d0 = 0; d0 < 4; ++d0) gn[d0] = gsub[d0 * 32 + r32] * gmul;
#pragma unroll
        for (int r = 0; r < 16; ++r) { const float* srow = Sw + (size_t)((r & 3) + 8 * (r >> 2)) * OP; float d[4]; float ss = 0.f;
#if WO_F8
            unsigned char* orowp = (unsigned char*)Og + (size_t)(R0 + (r & 3) + 8 * (r >> 2)) * OBP;
#else
            bf16_t* orowp = Ow + (size_t)((r & 3) + 8 * (r >> 2)) * OP;
#endif
#pragma unroll
            for (int d0 = 0; d0 < 4; ++d0) { d[d0] = srow[ooff + d0 * 32] - lam * (o[d0][r] * rli[r]); ss += d[d0] * d[d0]; }
            ss += __builtin_bit_cast(float, __builtin_amdgcn_update_dpp(0, __builtin_bit_cast(int, ss), 0xB1, 0xf, 0xf, true));
            ss += __builtin_bit_cast(float, __builtin_amdgcn_update_dpp(0, __builtin_bit_cast(int, ss), 0x4E, 0xf, 0xf, true));
            ss += __builtin_bit_cast(float, __builtin_amdgcn_update_dpp(0, __builtin_bit_cast(int, ss), 0x141, 0xf, 0xf, true));
            ss += __builtin_bit_cast(float, __builtin_amdgcn_update_dpp(0, __builtin_bit_cast(int, ss), 0x140, 0xf, 0xf, true));
            { auto rr = __builtin_amdgcn_permlane16_swap(__float_as_uint(ss), __float_as_uint(ss), false, false); ss = __uint_as_float(rr[0]) + __uint_as_float(rr[1]); }
            const float rs = __builtin_amdgcn_rsqf(ss * (1.f / 128.f) + 1e-5f);
#pragma unroll
#if WO_F8
            for (int d0 = 0; d0 < 4; ++d0) { const unsigned w = quad_pack_fp8(d[d0] * rs * gn[d0] * OB8_SCALE);
                if ((r32 & 3) == 0) *(unsigned*)(orowp + (ooff8 + d0 * 32)) = w; }
#else
            for (int d0 = 0; d0 < 4; ++d0) { const float v = d[d0] * rs * gn[d0]; const float vn = __shfl_xor(v, 1);
                if ((r32 & 1) == 0) *(unsigned*)(orowp + (ooff + d0 * 32)) = cvtpk(v, vn); }
#endif
            if ((r & 1) == 1) asm volatile("" ::: "memory"); }
    }
    __syncthreads();
}
#undef SBAR
}

#define LAS __attribute__((address_space(3)))

#define XB_TMO      128
#define XB_XCNT(j)  (256  + 64 * (j))
#define XB_XSUB(j)  (1280 + 64 * (j))
#define XB_XGEN(j)  (2304 + 64 * (j))
#define XB_TOP      3328
#define XB_TOPGEN   3392
#define XCD_BAR_WORDS 3456
#define XB_SPIN_CAP (1u << 18)

__device__ __forceinline__ unsigned xb_ld(unsigned* p)              { return __hip_atomic_load(p, __ATOMIC_RELAXED, __HIP_MEMORY_SCOPE_AGENT); }
__device__ __forceinline__ unsigned xb_add(unsigned* p, unsigned v) { return __hip_atomic_fetch_add(p, v, __ATOMIC_RELAXED, __HIP_MEMORY_SCOPE_AGENT); }
__device__ __forceinline__ unsigned xb_xcc_id() { return (unsigned)__builtin_amdgcn_s_getreg((3 << 11) | 20) & 0xFu; }
#define XB_SPIN(cond, bar) do { unsigned _sp = 0; while (cond) { __builtin_amdgcn_s_sleep(1); \
    if ((++_sp & 255u) == 0u) { if (xb_ld(&(bar)[XB_TMO])) break; if (_sp > XB_SPIN_CAP) { atomicAdd(&(bar)[XB_TMO], 1u); break; } } } } while (0)

struct XcdBarrier {
    unsigned* bar; unsigned x;
    volatile LAS unsigned* st;
};

__device__ __forceinline__ XcdBarrier xcd_barrier_post(unsigned* bar, volatile LAS unsigned* st) {
    XcdBarrier b; b.bar = bar; b.x = xb_xcc_id(); b.st = st;
    if (threadIdx.x == 0) (void)xb_add(&bar[XB_XCNT(b.x)], 1u);
    return b;
}
__device__ __forceinline__ void xcd_barrier_complete(unsigned* bar, unsigned x, unsigned& nloc, unsigned& nx) {
    const unsigned G = gridDim.x * gridDim.y * gridDim.z;
    unsigned sum, cnt, mine, sp = 0u;
    for (;;) {
        sum = 0u; cnt = 0u; mine = 0u;
#pragma unroll
        for (unsigned j = 0; j < 16; ++j) { const unsigned c = xb_ld(&bar[XB_XCNT(j)]); sum += c; cnt += (c > 0u) ? 1u : 0u; mine = (j == x) ? c : mine; }
        if (sum == G) break;
        __builtin_amdgcn_s_sleep(1);
        if ((++sp & 255u) == 0u) { if (xb_ld(&bar[XB_TMO])) break; if (sp > XB_SPIN_CAP) { atomicAdd(&bar[XB_TMO], 1u); break; } }
    }
    nloc = mine > 0u ? mine : 1u; nx = cnt > 0u ? cnt : 1u;
}

__device__ __forceinline__ void xcd_barrier(const XcdBarrier& b) {
    asm volatile("s_waitcnt vmcnt(0)" ::: "memory");
    __syncthreads();
    if (threadIdx.x == 0) {
        unsigned* bar = b.bar;
        __builtin_amdgcn_s_waitcnt(0);
        unsigned nloc = b.st[0], nx = b.st[1];
        if (nloc == 0u) { xcd_barrier_complete(bar, b.x, nloc, nx); b.st[0] = nloc; b.st[1] = nx; }
        const unsigned old = xb_add(&bar[XB_XSUB(b.x)], 1u);
        const unsigned gen = old / nloc;
        if (old + 1u == (gen + 1u) * nloc) {
            __builtin_amdgcn_fence(__ATOMIC_RELEASE, "agent");
            asm volatile("s_waitcnt vmcnt(0)" ::: "memory");
            const unsigned og = xb_add(&bar[XB_TOP], 1u);
            const unsigned tg = og / nx;
            if (og + 1u == (tg + 1u) * nx) xb_add(&bar[XB_TOPGEN], 1u);
            else XB_SPIN(xb_ld(&bar[XB_TOPGEN]) == tg, bar);
            __builtin_amdgcn_fence(__ATOMIC_ACQUIRE, "agent");
            xb_add(&bar[XB_XGEN(b.x)], 1u);
            asm volatile("s_waitcnt vmcnt(0)" ::: "memory");
        } else {
            XB_SPIN(xb_ld(&bar[XB_XGEN(b.x)]) == gen, bar);
            __builtin_amdgcn_fence(__ATOMIC_ACQUIRE, "agent");
            asm volatile("s_waitcnt vmcnt(0)" ::: "memory");
        }
    }
    __syncthreads();
}

constexpr int NWAVES = 8;
constexpr int NTOK = 16384, DM = 2048, SEQ = 2048, NHEAD = 16, NLAYER = 4, NEXP = 16, DEXP = 1024;
constexpr int XS_ROWS = 36864;
constexpr float LN_EPS = 1e-5f;
constexpr float DN_ALPHA = 1.6817928305074292f;
constexpr float LOG2E = 1.4426950408889634f;
constexpr float SB_QSCALE = 0.08838834764831845f * LOG2E;
constexpr float DF_QSCALE = 0.125f * LOG2E;
#ifndef MK_MULTI
#define MK_MULTI 0
#endif
#ifndef MOE_F8
#define MOE_F8 1
#endif
#ifndef QKV8_A
#define QKV8_A 1
#endif
#ifndef QKV8_B
#define QKV8_B 0
#endif
constexpr int NSTEPS = 1 + 8 * NLAYER;

constexpr size_t MiB = 1u << 20;
constexpr size_t WS_CTL = 0, CTL_ZERO_BYTES = 64 * 1024;
constexpr size_t WS_COS = 1 * MiB, WS_SIN = WS_COS + 256 * 1024;
constexpr size_t WS_WR = 2 * MiB;
constexpr size_t WS_CNT = 3 * MiB;
constexpr size_t WS_RE = WS_CNT + 64 * 1024;
constexpr size_t WS_RW = WS_RE + 64 * 1024;
constexpr size_t WS_RP = WS_RW + 128 * 1024;
constexpr int LDH = 2048;
constexpr int P8K2 = 2048, P8K1 = 1024;
constexpr size_t WS_WQKVA = 4 * MiB;
constexpr size_t WS_WOA = WS_WQKVA + 56 * MiB;
constexpr size_t WS_WQKVB = WS_WOA + 16 * MiB;
constexpr size_t WS_WOB = WS_WQKVB + 36 * MiB;
constexpr size_t WS_WGU = WS_WOB + 16 * MiB;
constexpr size_t WS_WDN = WS_WGU + 512 * MiB;
constexpr size_t WS_H = WS_WDN + 256 * MiB;
constexpr size_t WS_HB = WS_H + 128 * MiB;
constexpr size_t WS_QKV = WS_HB + 68 * MiB;
constexpr size_t WS_OB = WS_QKV + 192 * MiB;
constexpr size_t WS_XS = WS_OB + 64 * MiB;
constexpr size_t WS_ACT = WS_XS + 144 * MiB;
constexpr size_t WS_YD = WS_ACT + 72 * MiB;
constexpr size_t WS_END = WS_YD + 144 * MiB;
static_assert(WS_END <= (size_t)2040 * MiB, "workspace map");
static_assert((size_t)2 * 6144 * LDH * 2 <= 56 * MiB && (size_t)8192 * LDH * 2 <= 36 * MiB && (size_t)2 * 2048 * P8K2 <= 16 * MiB && (size_t)64 * 2048 * P8K2 <= 512 * MiB && (size_t)64 * 2048 * P8K1 <= 256 * MiB, "weight regions");
static_assert((size_t)NTOK * LDH * 2 <= 68 * MiB && (size_t)NTOK * P8K2 <= 64 * MiB && (size_t)XS_ROWS * P8K2 <= 144 * MiB && (size_t)XS_ROWS * P8K1 <= 72 * MiB, "activation regions");
constexpr int CW_BAR = 1024;
constexpr int LDS_BYTES = 147456;
constexpr int LDSCTL_OFF = 145408;
constexpr int RING_OFF = 0;

#define GAS __attribute__((address_space(1)))
typedef unsigned short bf16;
typedef unsigned v4u __attribute__((ext_vector_type(4)));
typedef unsigned v2u __attribute__((ext_vector_type(2)));
typedef float f32x4 __attribute__((ext_vector_type(4)));
typedef float f32x2 __attribute__((ext_vector_type(2)));
#define LDS_WAIT() asm volatile("s_waitcnt lgkmcnt(0)" ::: "memory")
#define VM_WAIT() asm volatile("s_waitcnt vmcnt(0)" ::: "memory")
__device__ __forceinline__ unsigned pk2(float lo, float hi) { unsigned r; asm volatile("v_cvt_pk_bf16_f32 %0, %1, %2" : "=v"(r) : "v"(lo), "v"(hi)); return r; }
__device__ __forceinline__ int opq_tid() { int t = threadIdx.x; asm volatile("" : "+v"(t)); return t; }
__device__ __forceinline__ float dpp_sum(float v) {
    v += __builtin_bit_cast(float, __builtin_amdgcn_update_dpp(0, __builtin_bit_cast(int, v), 0xB1, 0xf, 0xf, true));
    v += __builtin_bit_cast(float, __builtin_amdgcn_update_dpp(0, __builtin_bit_cast(int, v), 0x4E, 0xf, 0xf, true));
    v += __builtin_bit_cast(float, __builtin_amdgcn_update_dpp(0, __builtin_bit_cast(int, v), 0x141, 0xf, 0xf, true));
    v += __builtin_bit_cast(float, __builtin_amdgcn_update_dpp(0, __builtin_bit_cast(int, v), 0x140, 0xf, 0xf, true));
    const int b = __builtin_bit_cast(int, v);
    const float s0 = __builtin_bit_cast(float, __builtin_amdgcn_readlane(b, 0)), s1 = __builtin_bit_cast(float, __builtin_amdgcn_readlane(b, 16));
    const float s2 = __builtin_bit_cast(float, __builtin_amdgcn_readlane(b, 32)), s3 = __builtin_bit_cast(float, __builtin_amdgcn_readlane(b, 48));
    return (s0 + s1) + (s2 + s3);
}
__device__ __forceinline__ float wave_sum(float v) {
#pragma unroll
    for (int o = 1; o < 64; o <<= 1) v += __shfl_xor(v, o);
    return v;
}

struct Args { const float* in[17]; float* out; unsigned char* ws; int s_lo, s_hi; };

__device__ __forceinline__ int map_row(int n, int mode) {
    if (mode == 0) return n;
    if (mode == 1) { const int c = n & 255, blk = c >> 6, d = c & 63; return (n & ~255) + ((d >> 5) << 7) + (blk << 5) + (d & 31); }
    return ((n >> 7) << 8) + (n & 127) + (mode == 3 ? 128 : 0);
}
__device__ __forceinline__ void cvt_item(const float* __restrict__ src, int pitch, int K, bf16* __restrict__ dst, int mode, int k0, int n0, LAS float* scr, int lane) {
    const int kr = lane >> 4, n4 = (lane & 15) * 4;
    f32x4 v[16];
#pragma unroll
    for (int i = 0; i < 16; ++i) v[i] = __builtin_nontemporal_load((const f32x4*)(src + (size_t)(k0 + 4 * i + kr) * pitch + n0 + n4));
#pragma unroll
    for (int i = 0; i < 16; ++i) { LAS float* s = scr + (4 * i + kr) * 65 + n4; s[0] = v[i][0]; s[1] = v[i][1]; s[2] = v[i][2]; s[3] = v[i][3]; }
    LDS_WAIT();
    const int c = lane & 7;
#pragma unroll
    for (int j = 0; j < 8; ++j) { const int nl = (lane >> 3) + 8 * j; const int row = map_row(n0 + nl, mode);
        const LAS float* s = scr + (8 * c) * 65 + nl;
        v4u o; o.x = pk2(s[0], s[65]); o.y = pk2(s[130], s[195]); o.z = pk2(s[260], s[325]); o.w = pk2(s[390], s[455]);
        *(v4u*)(dst + (size_t)row * K + k0 + 8 * c) = o; }
    LDS_WAIT();
}

__device__ __forceinline__ void cvt_item8(const float* __restrict__ src, int pitch, int K, unsigned char* __restrict__ dst, int mode, int k0, int n0, float scale, LAS float* scr, int lane) {
    const int kr = lane >> 4, n4 = (lane & 15) * 4;
    f32x4 v[16];
#pragma unroll
    for (int i = 0; i < 16; ++i) v[i] = __builtin_nontemporal_load((const f32x4*)(src + (size_t)(k0 + 4 * i + kr) * pitch + n0 + n4));
#pragma unroll
    for (int i = 0; i < 16; ++i) { LAS float* s = scr + (4 * i + kr) * 65 + n4; s[0] = v[i][0] * scale; s[1] = v[i][1] * scale; s[2] = v[i][2] * scale; s[3] = v[i][3] * scale; }
    LDS_WAIT();
    const int c = lane & 3;
#pragma unroll
    for (int j = 0; j < 4; ++j) { const int nl = (lane >> 2) + 16 * j; const int row = map_row(n0 + nl, mode);
        const LAS float* s = scr + (16 * c) * 65 + nl;
        v4u o; o.x = pg8::pack4_fp8(s[0], s[65], s[130], s[195]); o.y = pg8::pack4_fp8(s[260], s[325], s[390], s[455]);
        o.z = pg8::pack4_fp8(s[520], s[585], s[650], s[715]); o.w = pg8::pack4_fp8(s[780], s[845], s[910], s[975]);
        *(v4u*)(dst + (size_t)row * K + k0 + 16 * c) = o; }
    LDS_WAIT();
}

__global__ void __launch_bounds__(NWAVES * 64, 2) yoco_fwd(Args args) {
    extern __shared__ __attribute__((aligned(16))) unsigned char lds_raw[];
    LAS unsigned char* const lds = (LAS unsigned char*)lds_raw;
    const int tid = threadIdx.x, lane = tid & 63, wave = __builtin_amdgcn_readfirstlane(tid >> 6);
    const int G = gridDim.x, bx = blockIdx.x;
    const int vcu = (G % 8 == 0) ? (bx % 8) * (G / 8) + bx / 8 : bx;
    unsigned char* const ws = args.ws;
    volatile LAS unsigned* const CTL = (volatile LAS unsigned*)(lds + LDSCTL_OFF);
    LAS int* const TAB = (LAS int*)(lds + LDSCTL_OFF + 64);
    for (int u = tid; u < (LDS_BYTES - LDSCTL_OFF) / 4; u += NWAVES * 64) ((LAS unsigned*)(lds + LDSCTL_OFF))[u] = 0u;
    __syncthreads();
    const int s_lo = args.s_lo, s_hi = args.s_hi;
    XcdBarrier bar; bar.bar = (unsigned*)(ws + WS_CTL) + CW_BAR; bar.x = 0; bar.st = nullptr;
    if (s_hi - s_lo > 1) bar = xcd_barrier_post((unsigned*)(ws + WS_CTL) + CW_BAR, CTL);
#ifndef PH_MASK
#define PH_MASK 0xFFFF
#endif
#define PHM(b) (((PH_MASK) >> (b)) & 1)
#ifndef PROBE_DUP
#define PROBE_DUP 0
#endif
#define PREP(b) _Pragma("unroll 1") for (int rep_ = 0; rep_ < ((((PROBE_DUP) >> (b)) & 1) ? 2 : 1); ++rep_)
#define IN(k) (s_lo <= (k) && (k) < s_hi)
#define SEAM(k) do { if ((k) + 1 < s_hi) xcd_barrier(bar); } while (0)

    const float* const x_in = args.in[0];
    float* const H = (float*)(ws + WS_H); bf16* const HB = (bf16*)(ws + WS_HB); unsigned char* const HB8 = (unsigned char*)(ws + WS_OB + 32 * MiB);     bf16* const QKV = (bf16*)(ws + WS_QKV); bf16* const OB = (bf16*)(ws + WS_OB);
    bf16* const MIX = (bf16*)(ws + WS_YD);     bf16* const XS = (bf16*)(ws + WS_XS); float* const S1 = (float*)(ws + WS_XS); bf16* const ACT = (bf16*)(ws + WS_ACT); bf16* const YD = (bf16*)(ws + WS_YD);
    float* const COS = (float*)(ws + WS_COS); float* const SIN = (float*)(ws + WS_SIN); float* const WR = (float*)(ws + WS_WR);
    int* const CNT = (int*)(ws + WS_CNT); unsigned* const RE = (unsigned*)(ws + WS_RE); f32x2* const RW = (f32x2*)(ws + WS_RW); int* const RP = (int*)(ws + WS_RP);

    if (IN(0) && PHM(0)) { PREP(0) {
        const int tid = opq_tid(), lane = tid & 63;
        LAS float* scr = (LAS float*)(lds + RING_OFF + wave * 16640);
        const int gw = vcu * NWAVES + wave, NGW = G * NWAVES;
        constexpr int I0 = 2 * 3072, I1 = 8 * 1024, I2 = 128 * 512, I3 = 64 * 512, NITEMS = I0 + I1 + I2 + I3;
        for (int it = gw; it < NITEMS; it += NGW) {
            int r = it;
            if (r < I0) { const int job = r / 3072; r -= job * 3072; const int kb = r / 96, nb = r - kb * 96;
                if (QKV8_A) cvt_item8(args.in[1] + (size_t)job * 2048 * 6144, 6144, 2048, (unsigned char*)(ws + WS_WQKVA) + (size_t)job * 6144 * 2048, 0, kb * 64, nb * 64, pg8::W8_SCALE, scr, lane);
                else cvt_item(args.in[1] + (size_t)job * 2048 * 6144, 6144, LDH, (bf16*)(ws + WS_WQKVA) + (size_t)job * 6144 * LDH, 0, kb * 64, nb * 64, scr, lane);
                continue; }
            r -= I0;
            if (r < I1) { const int job = r >> 10; r &= 1023; const int kb = r >> 5, nb = r & 31;
                const float* src; int pitch = 2048, mode = 0; bf16* dst;
                if (job < 2) { src = args.in[2] + (size_t)job * 2048 * 2048; dst = (bf16*)(ws + WS_WOA + (size_t)job * 2048 * P8K2); }
                else if (job == 2) { src = args.in[4]; dst = (bf16*)(ws + WS_WQKVB); mode = 1; }
                else if (job == 3) { src = args.in[3]; pitch = 4096; dst = (bf16*)(ws + WS_WQKVB) + (size_t)2048 * LDH; mode = 1; }
                else if (job == 4) { src = args.in[3] + 2048; pitch = 4096; dst = (bf16*)(ws + WS_WQKVB) + (size_t)4096 * LDH; }
                else if (job == 5) { src = args.in[4] + (size_t)2048 * 2048; dst = (bf16*)(ws + WS_WQKVB) + (size_t)6144 * LDH; mode = 1; }
                else { src = args.in[5] + (size_t)(job - 6) * 2048 * 2048; dst = (bf16*)(ws + WS_WOB + (size_t)(job - 6) * 2048 * P8K2); }
                if (job < 2 || job >= 6) { cvt_item8(src, pitch, P8K2, (unsigned char*)dst, mode, kb * 64, nb * 64, pg8::W8_SCALE, scr, lane); continue; }
                if (QKV8_B) { cvt_item8(src, pitch, 2048, (unsigned char*)(ws + WS_WQKVB) + (size_t)((job == 2) ? 0 : (job == 3) ? 2048 : (job == 4) ? 4096 : 6144) * 2048, mode, kb * 64, nb * 64, pg8::W8_SCALE, scr, lane); continue; }
                cvt_item(src, pitch, LDH, dst, mode, kb * 64, nb * 64, scr, lane); continue; }
            r -= I1;
            if (r < I2) { const int job = r >> 9; r &= 511; const int kb = r >> 4, nb = r & 15; const int le = job >> 1, up = job & 1;
                cvt_item8((up ? args.in[15] : args.in[14]) + (size_t)le * 2048 * 1024, 1024, P8K2, (unsigned char*)(ws + WS_WGU) + (size_t)le * 2048 * P8K2, 2 + up, kb * 64, nb * 64, pg8::W8_SCALE, scr, lane); continue; }
            r -= I2;
            { const int le = r >> 9; r &= 511; const int kb = r >> 5, nb = r & 31;
                cvt_item8(args.in[16] + (size_t)le * 1024 * 2048, 2048, P8K1, (unsigned char*)(ws + WS_WDN) + (size_t)le * 2048 * P8K1, 0, kb * 64, nb * 64, pg8::W8_SCALE, scr, lane); }
        }
        for (size_t i = (size_t)gw * 64 + lane; i < (size_t)NTOK * DM / 4; i += (size_t)NGW * 64) {
            const f32x4 v = ((const f32x4*)x_in)[i];
            if (QKV8_A) ((unsigned*)HB8)[i] = pg8::pack4_fp8(v[0], v[1], v[2], v[3]);
            else { v2u o; o.x = pk2(v[0], v[1]); o.y = pk2(v[2], v[3]); *(v2u*)(HB + (i >> 9) * LDH + (i & 511) * 4) = o; } }
        for (int i = bx * (NWAVES * 64) + tid; i < 2048 * 32; i += G * NWAVES * 64) { const int pos = i >> 5, f = i & 31;
            const float inv = __builtin_amdgcn_exp2f(-(float)f * 0.4152410118609203f); const float ang = (float)pos * inv;
            const double tr = (double)ang * 0.15915494309189535; const float fr = (float)(tr - __builtin_rint(tr));
            COS[i] = __builtin_amdgcn_cosf(fr); SIN[i] = __builtin_amdgcn_sinf(fr); }
        for (int i = bx * (NWAVES * 64) + tid; i < NLAYER * 20 * 2048; i += G * NWAVES * 64) { const int k = i & 2047, c = (i >> 11) % 20, l = i / (20 * 2048);
            WR[i] = c < 4 ? args.in[12][((size_t)l * 2048 + k) * 4 + c] : args.in[13][(((size_t)l * 4 + ((c - 4) >> 2)) * 2048 + k) * 4 + ((c - 4) & 3)]; }
        }
        SEAM(0);
    }

    for (int L = 0; L < NLAYER; ++L) {
        const int sb = 1 + 8 * L; const bool typeA = L < 2;
        if (IN(sb + 0)) {
            if (typeA && PHM(1)) { PREP(1) {
                pg8::StaticOrder S; S.init(NTOK, 6144, G, bx);
                if (QKV8_A) { pg8::Gemm g{(const bf16*)HB8, (const bf16*)(ws + WS_WQKVA + (size_t)L * 6144 * 2048), NTOK, 6144, DM / 2, DM / 2}; pg8::EpiQkv E{QKV, 6144, 2048, SB_QSCALE, 1.f / pg8::W8_SCALE};
                    pg8::gemm_phase<pg8::EpiQkv, pg8::StaticOrder, true, true, true>(lds + RING_OFF, g, S, E); }
                else { pg8::Gemm g{HB, (const bf16*)(ws + WS_WQKVA) + (size_t)L * 6144 * LDH, NTOK, 6144, DM, LDH}; pg8::EpiQkv E{QKV, 6144, 2048, SB_QSCALE, 1.f};
                    pg8::gemm_phase<pg8::EpiQkv, pg8::StaticOrder, true, true>(lds + RING_OFF, g, S, E); } }
                if ((PROBE_DUP >> 11) & 1) {
                    struct LocalOrder { int n, G, c; __device__ bool next(int i, pg8::Unit& u) const { if (i * G + c >= n) return false; u.pm = 0; u.pn = 0; return true; }
                        __device__ void a_ready(const pg8::Unit&) const {} __device__ void done(const pg8::Unit&) const {} } S2{1536, G, bx};
                    pg8::Gemm g2{HB, (const bf16*)(ws + WS_WQKVA) + (size_t)L * 6144 * LDH, NTOK, 6144, DM, LDH}; pg8::EpiQkv E2{XS, 6144, 2048, SB_QSCALE, 1.f};
                    pg8::gemm_phase<pg8::EpiQkv, LocalOrder, true, true>(lds + RING_OFF, g2, S2, E2); }
            } else if (!typeA && PHM(2)) { PREP(2) {
                const int N = (L == 2) ? 6144 : 2048;
                pg8::StaticOrder S; S.init(NTOK, N, G, bx);
                if (QKV8_B) { pg8::Gemm g{(const bf16*)HB8, (const bf16*)(ws + WS_WQKVB + (L == 2 ? (size_t)0 : (size_t)6144 * 2048)), NTOK, N, DM / 2, DM / 2};
                    pg8::EpiRope E{QKV, 6144, 2048, 4096, DF_QSCALE, COS, SIN, 1.f / pg8::W8_SCALE};
                    pg8::gemm_phase<pg8::EpiRope, pg8::StaticOrder, true, true, true>(lds + RING_OFF, g, S, E); }
                else { pg8::Gemm g{HB, (const bf16*)(ws + WS_WQKVB) + (L == 2 ? (size_t)0 : (size_t)6144 * LDH), NTOK, N, DM, LDH};
                    pg8::EpiRope E{QKV, 6144, 2048, 4096, DF_QSCALE, COS, SIN, 1.f};
                    pg8::gemm_phase<pg8::EpiRope, pg8::StaticOrder, true, true>(lds + RING_OFF, g, S, E); } }
            }
            SEAM(sb + 0);
        }
        if (IN(sb + 1)) {
            if (typeA && PHM(3)) {
                for (int id_ = vcu; id_ < 512 * (1 + ((PROBE_DUP >> 3) & 1)); id_ += G) { const int id = id_ & 511; const int bh = id >> 2, p = id & 3, b = bh >> 4, h = bh & 15;
                    const bf16* Qg = QKV + (size_t)b * SEQ * 6144 + h * 128; bf16* Og = (bf16*)((unsigned char*)OB + (size_t)b * SEQ * P8K2 + h * 128);
                    att::sb_block(Qg, Qg + 2048, Qg + 4096, Og, 7 - p, (att::ldsp)(lds + RING_OFF));
                    att::sb_block(Qg, Qg + 2048, Qg + 4096, Og, p, (att::ldsp)(lds + RING_OFF)); }
            } else if (!typeA && PHM(4)) {
                const int lane = opq_tid() & 63;
                const int i = L - 2; const float lam_init = (L == 2) ? 0.47071301834264183f : 0.5560582041556061f;
                const float* lp = args.in[6] + (size_t)i * 256;
                const float sa = dpp_sum(lp[lane] * lp[64 + lane]), sb2 = dpp_sum(lp[128 + lane] * lp[192 + lane]);
                const float lam = __builtin_amdgcn_exp2f(sa * LOG2E) - __builtin_amdgcn_exp2f(sb2 * LOG2E) + lam_init;
                const float* gsub = args.in[7] + (size_t)i * 128; const float gmul = 1.f - lam_init;
                for (int id_ = vcu; id_ < 512 * (1 + ((PROBE_DUP >> 4) & 1)); id_ += G) { const int id = id_ & 511; const int bh = id >> 2, p = id & 3, b = bh >> 4, h = bh & 15;
                    const bf16* Qg = QKV + (size_t)b * SEQ * 6144 + h * 128; bf16* Og = (bf16*)((unsigned char*)OB + (size_t)b * SEQ * P8K2 + h * 128); float* Sg = S1 + (size_t)b * SEQ * DM + h * 128;
#pragma unroll 1
                    for (int w = 0; w < 2; ++w) { const int qb = w ? p : 7 - p;
                        att::diff_pass<false>(Qg, Qg + 2048, Qg + 4096, Sg, Og, qb, lam, gsub, gmul, (att::ldsp)(lds + RING_OFF));
                        att::diff_pass<true>(Qg + 64, Qg + 2048 + 64, Qg + 4096, Sg, Og, qb, lam, gsub, gmul, (att::ldsp)(lds + RING_OFF)); } }
            }
            SEAM(sb + 1);
        }
        if (IN(sb + 2)) { if (PHM(5)) {
            pg8::Gemm g{OB, (const bf16*)(ws + (typeA ? WS_WOA : WS_WOB) + (size_t)(L & 1) * 2048 * P8K2), NTOK, DM, DM / 2, P8K2 / 2}; pg8::StaticOrder S; S.init(NTOK, DM, G, bx);
            pg8::EpiQkv E{MIX, DM, 0, 1.f, 1.f / (pg8::W8_SCALE * att::OB8_SCALE)};
            pg8::gemm_phase<pg8::EpiQkv, pg8::StaticOrder, true, true, true>(lds + RING_OFF, g, S, E); }
            SEAM(sb + 2);
        }
        if (IN(sb + 3)) { if (PHM(6)) {
            const int tid = opq_tid(), lane = tid & 63;
            const float* lng = args.in[8] + (size_t)L * DM; const float* lnb = args.in[9] + (size_t)L * DM; const float* wr = WR + (size_t)L * 20 * 2048;
            const float* hsrc = (L == 0) ? x_in : H;
            LAS int* eid = (LAS int*)(lds + RING_OFF);
            LAS float* lgt = (LAS float*)(lds + RING_OFF + 2048);
            for (int c = bx; c < 256; c += G) {
#pragma unroll 1
                for (int grp = 0; grp < 2; ++grp) {
                    const int rloc = wave * 8 + grp * 4; const size_t row0 = (size_t)64 * c + rloc;
                    f32x4 v[4][8]; float mu[4], rstd[4];
#pragma unroll
                    for (int rr = 0; rr < 4; ++rr) { const f32x4* hp = (const f32x4*)(hsrc + (row0 + rr) * DM) + lane; const v2u* mp = (const v2u*)(MIX + (row0 + rr) * DM) + lane;
#pragma unroll
                        for (int j = 0; j < 8; ++j) { const f32x4 h = hp[64 * j]; const v2u a = mp[64 * j];
                            const f32x4 fa = {__uint_as_float(a.x << 16), __uint_as_float(a.x & 0xffff0000u), __uint_as_float(a.y << 16), __uint_as_float(a.y & 0xffff0000u)};
                            v[rr][j] = h * DN_ALPHA + fa; } }
#pragma unroll
                    for (int rr = 0; rr < 4; ++rr) { float s = 0.f;
#pragma unroll
                        for (int j = 0; j < 8; ++j) s += (v[rr][j][0] + v[rr][j][1]) + (v[rr][j][2] + v[rr][j][3]);
                        mu[rr] = dpp_sum(s) * (1.f / DM); float q = 0.f;
#pragma unroll
                        for (int j = 0; j < 8; ++j) { const f32x4 d = v[rr][j] - mu[rr]; q += (d[0] * d[0] + d[1] * d[1]) + (d[2] * d[2] + d[3] * d[3]); }
                        rstd[rr] = 1.f / sqrtf(dpp_sum(q) * (1.f / DM) + LN_EPS); }
#pragma unroll
                    for (int j = 0; j < 8; ++j) { const f32x4 gg = ((const f32x4*)lng)[64 * j + lane], bb = ((const f32x4*)lnb)[64 * j + lane];
#pragma unroll
                        for (int rr = 0; rr < 4; ++rr) { v[rr][j] = (v[rr][j] - mu[rr]) * rstd[rr] * gg + bb; ((f32x4*)(H + (row0 + rr) * DM))[64 * j + lane] = v[rr][j]; } }
#pragma unroll 1
                    for (int cc = 0; cc < 20; ++cc) { const f32x4* wp = (const f32x4*)(wr + cc * 2048) + lane; float a[4] = {0.f, 0.f, 0.f, 0.f};
#pragma unroll
                        for (int j = 0; j < 8; ++j) { const f32x4 w = wp[64 * j];
#pragma unroll
                            for (int rr = 0; rr < 4; ++rr) a[rr] += (v[rr][j][0] * w[0] + v[rr][j][1] * w[1]) + (v[rr][j][2] * w[2] + v[rr][j][3] * w[3]); }
#pragma unroll
                        for (int rr = 0; rr < 4; ++rr) a[rr] = dpp_sum(a[rr]);
                        if (lane == 0) { lgt[rloc * 20 + cc] = a[0]; lgt[(rloc + 1) * 20 + cc] = a[1]; lgt[(rloc + 2) * 20 + cc] = a[2]; lgt[(rloc + 3) * 20 + cc] = a[3]; } }
                }
                LDS_WAIT();
                if (lane < 8) {
                    const int rl = wave * 8 + lane; const LAS float* lg = lgt + rl * 20;
                    int gsel = 0; float gm = lg[0];
#pragma unroll
                    for (int i = 1; i < 4; ++i) { const float x = lg[i]; if (x > gm) { gm = x; gsel = i; } }
                    float gden = 0.f;
#pragma unroll
                    for (int i = 0; i < 4; ++i) gden += __builtin_amdgcn_exp2f((lg[i] - gm) * LOG2E);
                    const float gw_ = 1.f / gden;
                    const LAS float* li = lg + 4 + 4 * gsel;
                    const float l0 = li[0], l1 = li[1], l2 = li[2], l3 = li[3];
                    int i0 = 0; float v0 = l0;
                    if (l1 > v0) { v0 = l1; i0 = 1; } if (l2 > v0) { v0 = l2; i0 = 2; } if (l3 > v0) { v0 = l3; i0 = 3; }
                    int i1 = -1; float v1 = 0.f;
                    if (i0 != 0) { v1 = l0; i1 = 0; }
                    if (i0 != 1 && (i1 < 0 || l1 > v1)) { v1 = l1; i1 = 1; }
                    if (i0 != 2 && (i1 < 0 || l2 > v1)) { v1 = l2; i1 = 2; }
                    if (i0 != 3 && (i1 < 0 || l3 > v1)) { v1 = l3; i1 = 3; }
                    const float t = __builtin_amdgcn_exp2f((v1 - v0) * LOG2E); const float w0 = gw_ / (1.f + t), w1 = gw_ * t / (1.f + t);
                    eid[2 * rl] = gsel * 4 + i0; eid[2 * rl + 1] = gsel * 4 + i1; RW[(size_t)64 * c + rl] = (f32x2){w0, w1};
                }
                __syncthreads();
                if (wave == 0) {
                    const int ea = eid[lane], eb = eid[64 + lane]; int ra = 0, rb = 0, cnt = 0; const unsigned long long lt = (1ull << lane) - 1ull;
#pragma unroll
                    for (int e = 0; e < 16; ++e) { const unsigned long long ma = __ballot(ea == e), mb = __ballot(eb == e);
                        if (ea == e) ra = __popcll(ma & lt); if (eb == e) rb = __popcll(ma) + __popcll(mb & lt); if (lane == e) cnt = __popcll(ma) + __popcll(mb); }
                    if (lane < 16) CNT[c * 16 + lane] = cnt;
                    LAS int* rk = (LAS int*)(lds + RING_OFF + 1024); rk[lane] = ra; rk[64 + lane] = rb; LDS_WAIT();
                    const int r = lane; const unsigned word = (unsigned)eid[2 * r] | ((unsigned)eid[2 * r + 1] << 8) | ((unsigned)rk[2 * r] << 16) | ((unsigned)rk[2 * r + 1] << 24);
                    RE[(size_t)64 * c + r] = word;
                }
                __syncthreads();
            } }
            SEAM(sb + 3);
        }
        if ((IN(sb + 4) || IN(sb + 5) || IN(sb + 6)) && PHM(7)) {
            const int tid = opq_tid();
            LAS int* part = (LAS int*)(lds + RING_OFF);
            { const int e = tid & 15, s = tid >> 4; int a = 0;
#pragma unroll
              for (int i = 0; i < 8; ++i) a += CNT[(8 * s + i) * 16 + e];
              part[s * 16 + e] = a; }
            __syncthreads();
            if (tid < 16) { int run = 0;
#pragma clang loop vectorize(disable) unroll(disable)
                for (int s = 0; s < 32; ++s) run += part[s * 16 + tid];
                TAB[tid] = run; }
            __syncthreads();
            if (tid == 0) { int off = 0, mt = 0;
#pragma clang loop vectorize(disable) unroll(disable)
                for (int e = 0; e < 16; ++e) { TAB[16 + e] = off; const int nt = (TAB[e] + 255) >> 8;
#pragma clang loop vectorize(disable) unroll(disable)
                    for (int i = 0; i < nt; ++i) TAB[64 + mt++] = e;
                    off += nt * 256; }
                TAB[32] = off; TAB[33] = mt; }
            __syncthreads();
        }
        if (IN(sb + 4)) { if (PHM(7)) PREP(7) {
            const int tid = opq_tid(), lane = tid & 63;
            LAS int* part = (LAS int*)(lds + RING_OFF);
            for (int c = bx; c < 256; c += G) {
                if (tid < 16) { int pre = 0;
#pragma clang loop vectorize(disable) unroll(disable)
                    for (int s = 0; s < (c >> 3); ++s) pre += part[s * 16 + tid];
#pragma clang loop vectorize(disable) unroll(disable)
                    for (int cc = c & ~7; cc < c; ++cc) pre += CNT[cc * 16 + tid];
                    TAB[48 + tid] = TAB[16 + tid] + pre; }
                __syncthreads();
#pragma unroll 1
                for (int rr = 0; rr < 8; ++rr) { const size_t row = (size_t)64 * c + wave * 8 + rr; const unsigned word = RE[row];
                    const int p0 = TAB[48 + (word & 255)] + ((word >> 16) & 255), p1 = TAB[48 + ((word >> 8) & 255)] + (word >> 24);
                    if (lane == 0) { RP[2 * row] = p0; RP[2 * row + 1] = p1; }
                    const f32x4* hp = (const f32x4*)(H + row * DM) + lane; unsigned* o0 = (unsigned*)((unsigned char*)XS + (size_t)p0 * P8K2) + lane; unsigned* o1 = (unsigned*)((unsigned char*)XS + (size_t)p1 * P8K2) + lane;
#pragma unroll
                    for (int j = 0; j < 8; ++j) { const f32x4 v = hp[64 * j]; const unsigned o = pg8::pack4_fp8(v[0], v[1], v[2], v[3]); o0[64 * j] = o; o1[64 * j] = o; } }
                __syncthreads();
            } }
            SEAM(sb + 4);
        }
        if (IN(sb + 5)) { if (PHM(8)) PREP(8) {
            pg8::Gemm g{XS, (const bf16*)(ws + WS_WGU + (size_t)L * 16 * 2048 * P8K2), XS_ROWS, 2048, DM / 2, P8K2 / 2};
            pg8::MoeOrder S{TAB[33] * 8, G, bx, TAB + 64}; pg8::EpiGateUp8 E{(unsigned char*)ACT};
            pg8::gemm_phase<pg8::EpiGateUp8, pg8::MoeOrder, true, true, true>(lds + RING_OFF, g, S, E); }
            SEAM(sb + 5);
        }
        if (IN(sb + 6)) { if (PHM(9)) PREP(9) {
            pg8::Gemm g{ACT, (const bf16*)(ws + WS_WDN + (size_t)L * 16 * 2048 * P8K1), XS_ROWS, 2048, DEXP / 2, P8K1 / 2};
            pg8::MoeOrder S{TAB[33] * 8, G, bx, TAB + 64}; pg8::EpiDown8 E{(unsigned char*)YD};
            pg8::gemm_phase<pg8::EpiDown8, pg8::MoeOrder, true, true, true>(lds + RING_OFF, g, S, E); }
            SEAM(sb + 6);
        }
        if (IN(sb + 7)) { if (PHM(10)) for (int rep_ = 0; rep_ < ((((PROBE_DUP) >> 10) & 1) && L == NLAYER - 1 ? 5 : 1); ++rep_) {
            const int tid = opq_tid(), lane = tid & 63;
            const float* lng = args.in[10] + (size_t)L * DM; const float* lnb = args.in[11] + (size_t)L * DM; const bool last = (L == NLAYER - 1); const bool next8 = (L + 1 < 2) ? (QKV8_A != 0) : (QKV8_B != 0);
            const int gw = vcu * NWAVES + wave, NGW = G * NWAVES;
            for (int row = gw; row < NTOK; row += NGW) {
                const int p0 = RP[2 * row], p1 = RP[2 * row + 1]; const f32x2 w = RW[row];
                const f32x4* hp = (const f32x4*)(H + (size_t)row * DM) + lane; const unsigned* y0 = (const unsigned*)((const unsigned char*)YD + (size_t)p0 * DM) + lane; const unsigned* y1 = (const unsigned*)((const unsigned char*)YD + (size_t)p1 * DM) + lane;
                const float w0s = w.x * (1.f / pg8::YD8_SCALE), w1s = w.y * (1.f / pg8::YD8_SCALE);
                f32x4 v[8]; float s = 0.f;
#pragma unroll
                for (int j = 0; j < 8; ++j) { const f32x4 h = hp[64 * j]; const unsigned a = y0[64 * j], b = y1[64 * j];
                    const f32x2 a0 = __builtin_amdgcn_cvt_pk_f32_fp8((int)a, false), a1 = __builtin_amdgcn_cvt_pk_f32_fp8((int)a, true), b0 = __builtin_amdgcn_cvt_pk_f32_fp8((int)b, false), b1 = __builtin_amdgcn_cvt_pk_f32_fp8((int)b, true);
                    const f32x4 fa = {a0[0], a0[1], a1[0], a1[1]}, fb = {b0[0], b0[1], b1[0], b1[1]};
                    v[j] = h * DN_ALPHA + fa * w0s + fb * w1s; s += (v[j][0] + v[j][1]) + (v[j][2] + v[j][3]); }
                const float mu = dpp_sum(s) * (1.f / DM); float q = 0.f;
#pragma unroll
                for (int j = 0; j < 8; ++j) { const f32x4 d = v[j] - mu; q += (d[0] * d[0] + d[1] * d[1]) + (d[2] * d[2] + d[3] * d[3]); }
                const float rstd = 1.f / sqrtf(dpp_sum(q) * (1.f / DM) + LN_EPS);
                f32x4* op = (f32x4*)((last ? args.out : H) + (size_t)row * DM) + lane; v2u* ob = (v2u*)(HB + (size_t)row * LDH) + lane;
#pragma unroll
                for (int j = 0; j < 8; ++j) { const f32x4 gg = ((const f32x4*)lng)[64 * j + lane], bb = ((const f32x4*)lnb)[64 * j + lane];
                    const f32x4 y = (v[j] - mu) * rstd * gg + bb; op[64 * j] = y;
                    if (!last) { if (next8) ((unsigned*)(HB8 + (size_t)row * DM))[64 * j + lane] = pg8::pack4_fp8(y[0], y[1], y[2], y[3]);
                        else { v2u o; o.x = pk2(y[0], y[1]); o.y = pk2(y[2], y[3]); ob[64 * j] = o; } } }
            } }
            SEAM(sb + 7);
        }
    }
#undef IN
#undef SEAM
}

extern "C" void kernel_launch(void* const* d_in, const int* in_sizes, int n_in, void* d_out, int out_size, void* d_ws, size_t ws_size, hipStream_t stream) {
    static int grid = 0;
    if (grid == 0) {
        if (n_in != 17 || in_sizes[0] != NTOK * DM || out_size != NTOK * DM || ws_size < WS_END) { fprintf(stderr, "kernel_launch: unexpected shapes / workspace (n_in %d, ws %zu, need %zu)\n", n_in, ws_size, (size_t)WS_END); grid = -1; return; }
        int dev = 0, cus = 0, per_cu = 0;
        if (hipGetDevice(&dev) != hipSuccess || hipDeviceGetAttribute(&cus, hipDeviceAttributeMultiprocessorCount, dev) != hipSuccess) { grid = -1; return; }
        if (hipFuncSetAttribute((const void*)yoco_fwd, hipFuncAttributeMaxDynamicSharedMemorySize, LDS_BYTES) != hipSuccess) { fprintf(stderr, "kernel_launch: hipFuncSetAttribute failed\n"); grid = -1; return; }
        if (hipOccupancyMaxActiveBlocksPerMultiprocessor(&per_cu, (const void*)yoco_fwd, NWAVES * 64, LDS_BYTES) != hipSuccess || per_cu < 1) { fprintf(stderr, "kernel_launch: occupancy query says %d\n", per_cu); per_cu = 1; }
        (void)hipGetLastError();
        grid = cus;
    }
    if (grid < 0) return;
    (void)hipMemsetAsync((char*)d_ws + WS_CTL, 0, CTL_ZERO_BYTES, stream);
    Args a{};
    for (int i = 0; i < 17; ++i) a.in[i] = (const float*)d_in[i];
    a.out = (float*)d_out; a.ws = (unsigned char*)d_ws;
#if MK_MULTI
    for (int s = 0; s < NSTEPS; ++s) { a.s_lo = s; a.s_hi = s + 1; hipLaunchKernelGGL(yoco_fwd, dim3(grid), dim3(NWAVES * 64), LDS_BYTES, stream, a); }
#else
    a.s_lo = 0; a.s_hi = NSTEPS;
    hipLaunchKernelGGL(yoco_fwd, dim3(grid), dim3(NWAVES * 64), LDS_BYTES, stream, a);
#endif
    const hipError_t le = hipPeekAtLastError();
    if (le != hipSuccess) fprintf(stderr, "kernel_launch: launch failed: %s\n", hipGetErrorName(le));
}
```

```cpp
#include <hip/hip_runtime.h>
#include <cstdio>
#include <cstdint>

__device__ __forceinline__ int tid_from_wave(int wave) { int l; asm volatile("v_mbcnt_lo_u32_b32 %0, -1, 0\n\tv_mbcnt_hi_u32_b32 %0, -1, %0" : "=v"(l)); return wave * 64 + l; }
namespace pg8 {
#define PG8_LAS __attribute__((address_space(3)))
typedef unsigned short bf16_t;
typedef short bf16x8 __attribute__((ext_vector_type(8)));
typedef float f32x4 __attribute__((ext_vector_type(4)));
typedef unsigned u32x4 __attribute__((ext_vector_type(4)));
typedef int pg8_v8i __attribute__((ext_vector_type(8)));
constexpr int BM = 256, BK = 64, HALF = 128, HTB = HALF * BK * 2  , STAGE_BYTES = 8 * HTB, NXCD = 8, WGM = 8;

__host__ __device__ __forceinline__ int lds_byte(int r, int c) { const int st = (r >> 4) * 2 + (c >> 5), rr = r & 15, cc = c & 31, ob = rr * 64 + cc * 2; return st * 1024 + (ob ^ (((ob >> 9) & 1) << 5)); }
__host__ __device__ __forceinline__ void stage_rc(int b, int& R, int& C) { const int st = b / 1024, sb = b % 1024, swz = sb ^ (((sb >> 9) & 1) << 5); R = (st >> 1) * 16 + swz / 64; C = (st & 1) * 32 + (swz % 64) / 2; }
__host__ __device__ __forceinline__ int perm32(int rho) { const int n = rho >> 4, i = rho & 15; return 8 * (i >> 2) + 4 * n + (i & 3); }

struct Unit { int pm, pn; };
struct Gemm { const bf16_t* A; const bf16_t* Bt; int M, N, K, ld, wave; };

struct StaticOrder {
    int nM, nN, nwg, G, c;
    __host__ __device__ void init(int M, int N, int G_, int c_) { nM = M / BM; nN = N / BM; nwg = nM * nN; G = G_; c = c_; }
    __host__ __device__ bool next(int i, Unit& u) const {
        const long L = (long)i * G + c; if (L >= nwg) return false;
        int wgid = (int)L; { const int q = nwg / NXCD, r = nwg % NXCD, xcd = wgid % NXCD, off = wgid / NXCD; wgid = (xcd < r ? xcd * (q + 1) : r * (q + 1) + (xcd - r) * q) + off; }
        const int nig = WGM * nN, gid = wgid / nig, fm = gid * WGM, gsz = (nM - fm) < WGM ? (nM - fm) : WGM;
        u.pm = fm + ((wgid % nig) % gsz); u.pn = (wgid % nig) / gsz; return true;
    }
    __device__ __forceinline__ void a_ready(const Unit&) const {}
    __device__ __forceinline__ void done(const Unit&) const {}
};

__device__ __forceinline__ unsigned cvt_pk_bf16(float lo, float hi) { unsigned r; asm volatile("v_cvt_pk_bf16_f32 %0, %1, %2" : "=v"(r) : "v"(lo), "v"(hi)); return r; }
typedef float f32x2 __attribute__((ext_vector_type(2)));

typedef unsigned u32x2 __attribute__((ext_vector_type(2)));
__device__ __forceinline__ u32x4 pack8_bf16(const f32x4 a, const f32x4 b) { u32x4 w; w.x = cvt_pk_bf16(a[0], a[1]); w.y = cvt_pk_bf16(a[2], a[3]); w.z = cvt_pk_bf16(b[0], b[1]); w.w = cvt_pk_bf16(b[2], b[3]); return w; }

struct EpiQkv {
    static constexpr bool PERM = true, AFTER_DRAIN = false;
    bf16_t* O; int ldc; int qcols; float qscale; float osc;
    __device__ __forceinline__ void operator()(const f32x4 (&acc)[2][2][4][2], const Unit& u, int wr, int wc, int fr, int fq) const {
        const int row0 = u.pm * BM + wr * 64 + fr, colt = u.pn * BM; const float sc = (colt < qcols ? qscale : 1.f) * osc;
        const int col0 = colt + wc * 32 + 8 * fq;
#pragma unroll
        for (int ai = 0; ai < 2; ++ai)
#pragma unroll
            for (int m = 0; m < 4; ++m) { bf16_t* rowp = O + (size_t)(row0 + ai * HALF + m * 16) * ldc + col0;
#pragma unroll
                for (int bj = 0; bj < 2; ++bj) *(u32x4*)(rowp + bj * HALF) = pack8_bf16(acc[ai][bj][m][0] * sc, acc[ai][bj][m][1] * sc); }
    }
};
template <int ACCS_INV> struct EpiResid {
    static constexpr bool PERM = false, AFTER_DRAIN = false;
    static constexpr int ldc = 2048; static constexpr float alpha = 1.6817928305074292f, accs = 1.f / (float)ACCS_INV;
    float* H; const float* Hsrc;
    __device__ __forceinline__ void operator()(const f32x4 (&acc)[2][2][4][2], const Unit& u, int wr, int wc, int fr, int fq) const {
        const int row0 = u.pm * BM + wr * 64 + fr, col0 = u.pn * BM + wc * 32 + 4 * fq;
#pragma unroll
        for (int ai = 0; ai < 2; ++ai)
#pragma unroll
            for (int m = 0; m < 4; ++m) { const size_t ro = (size_t)(row0 + ai * HALF + m * 16) * ldc + col0; float* rowp = H + ro; const float* srcp = Hsrc + ro;
#pragma unroll
                for (int bj = 0; bj < 2; ++bj)
#pragma unroll
                    for (int n = 0; n < 2; ++n) { const f32x4 h = *(const f32x4*)(srcp + bj * HALF + n * 16); *(f32x4*)(rowp + bj * HALF + n * 16) = h * alpha + acc[ai][bj][m][n] * accs; } }
    }
};
struct EpiRope {
    static constexpr bool PERM = true, AFTER_DRAIN = false;
    bf16_t* O; int ldc; int qcols, ropecols; float qscale; const float* ctab; const float* stab; float osc;
    __device__ __forceinline__ void operator()(const f32x4 (&acc)[2][2][4][2], const Unit& u, int wr, int wc, int fr, int fq) const {
        const int row0 = u.pm * BM + wr * 64 + fr, colt = u.pn * BM;
        if (colt >= ropecols) {
            const int col0 = colt + wc * 32 + 8 * fq;
#pragma unroll
            for (int ai = 0; ai < 2; ++ai)
#pragma unroll
                for (int m = 0; m < 4; ++m) { bf16_t* rowp = O + (size_t)(row0 + ai * HALF + m * 16) * ldc + col0;
#pragma unroll
                    for (int bj = 0; bj < 2; ++bj) *(u32x4*)(rowp + bj * HALF) = pack8_bf16(acc[ai][bj][m][0] * osc, acc[ai][bj][m][1] * osc); }
        } else {
            const float sc = (colt < qcols ? qscale : 1.f) * osc;
            const int col0 = colt + wc * 64 + 8 * fq;
#pragma unroll
            for (int ai = 0; ai < 2; ++ai)
#pragma unroll
                for (int m = 0; m < 4; ++m) { const int row = row0 + ai * HALF + m * 16; const int pos = row & 2047;
                    const f32x4 c0 = *(const f32x4*)(ctab + pos * 32 + 8 * fq), c1 = *(const f32x4*)(ctab + pos * 32 + 8 * fq + 4);
                    const f32x4 s0 = *(const f32x4*)(stab + pos * 32 + 8 * fq), s1 = *(const f32x4*)(stab + pos * 32 + 8 * fq + 4);
                    const f32x4 a0 = acc[ai][0][m][0], a1 = acc[ai][0][m][1], b0 = acc[ai][1][m][0], b1 = acc[ai][1][m][1];
                    bf16_t* rowp = O + (size_t)row * ldc + col0;
                    *(u32x4*)(rowp) = pack8_bf16((a0 * c0 - b0 * s0) * sc, (a1 * c1 - b1 * s1) * sc);
                    *(u32x4*)(rowp + 32) = pack8_bf16((b0 * c0 + a0 * s0) * sc, (b1 * c1 + a1 * s1) * sc);
                    asm volatile("" ::: "memory"); }
        }
    }
};
struct EpiGateUp {
    static constexpr bool PERM = true, AFTER_DRAIN = false;
    bf16_t* O;
    __device__ __forceinline__ void operator()(const f32x4 (&acc)[2][2][4][2], const Unit& u, int wr, int wc, int fr, int fq) const {
        const int row0 = u.pm * BM + wr * 64 + fr, col0 = (u.pn & 7) * 128 + wc * 32 + 8 * fq;
#pragma unroll
        for (int ai = 0; ai < 2; ++ai)
#pragma unroll
            for (int m = 0; m < 4; ++m) { f32x4 r[2];
#pragma unroll
                for (int n = 0; n < 2; ++n) { const f32x4 g = acc[ai][0][m][n], up = acc[ai][1][m][n];
#pragma unroll
                    for (int i = 0; i < 4; ++i) { const float e = __builtin_amdgcn_exp2f(g[i] * -1.4426950408889634f); r[n][i] = g[i] * __builtin_amdgcn_rcpf(1.f + e) * up[i]; } }
                *(u32x4*)(O + (size_t)(row0 + ai * HALF + m * 16) * 1024 + col0) = pack8_bf16(r[0], r[1]); }
    }
};
struct EpiDown {
    static constexpr bool PERM = true, AFTER_DRAIN = false;
    bf16_t* O;
    __device__ __forceinline__ void operator()(const f32x4 (&acc)[2][2][4][2], const Unit& u, int wr, int wc, int fr, int fq) const {
        const int row0 = u.pm * BM + wr * 64 + fr, col0 = (u.pn & 7) * BM + wc * 32 + 8 * fq;
#pragma unroll
        for (int ai = 0; ai < 2; ++ai)
#pragma unroll
            for (int m = 0; m < 4; ++m) { bf16_t* rowp = O + (size_t)(row0 + ai * HALF + m * 16) * 2048 + col0;
#pragma unroll
                for (int bj = 0; bj < 2; ++bj) *(u32x4*)(rowp + bj * HALF) = pack8_bf16(acc[ai][bj][m][0], acc[ai][bj][m][1]); }
    }
};
constexpr float W8_SCALE = 64.f, ACT8_SCALE = 4.f;
__device__ __forceinline__ unsigned pack4_fp8(float a, float b, float c, float d) { int w; asm volatile("" : "=v"(w));
    w = __builtin_amdgcn_cvt_pk_fp8_f32(a, b, w, false); w = __builtin_amdgcn_cvt_pk_fp8_f32(c, d, w, true); return (unsigned)w; }
struct EpiGateUp8 {
    static constexpr bool PERM = true, AFTER_DRAIN = false;
    unsigned char* O;
    __device__ __forceinline__ void operator()(const f32x4 (&acc)[2][2][4][2], const Unit& u, int wr, int wc, int fr, int fq) const {
        const int row0 = u.pm * BM + wr * 64 + fr, col0 = (u.pn & 7) * 128 + wc * 32 + 8 * fq;
        constexpr float SI = 1.f / W8_SCALE;
#pragma unroll
        for (int ai = 0; ai < 2; ++ai)
#pragma unroll
            for (int m = 0; m < 4; ++m) { f32x4 r[2];
#pragma unroll
                for (int n = 0; n < 2; ++n) { const f32x4 g = acc[ai][0][m][n] * SI, up = acc[ai][1][m][n] * (SI * ACT8_SCALE);
#pragma unroll
                    for (int i = 0; i < 4; ++i) { const float e = __builtin_amdgcn_exp2f(g[i] * -1.4426950408889634f); r[n][i] = g[i] * __builtin_amdgcn_rcpf(1.f + e) * up[i]; } }
                u32x2 w; w.x = pack4_fp8(r[0][0], r[0][1], r[0][2], r[0][3]); w.y = pack4_fp8(r[1][0], r[1][1], r[1][2], r[1][3]);
                *(u32x2*)(O + (size_t)(row0 + ai * HALF + m * 16) * 1024 + col0) = w; }
    }
};
constexpr float YD8_SCALE = 16.f;
struct EpiDown8 {
    static constexpr bool PERM = true, AFTER_DRAIN = false;
    unsigned char* O;
    __device__ __forceinline__ void operator()(const f32x4 (&acc)[2][2][4][2], const Unit& u, int wr, int wc, int fr, int fq) const {
        const int row0 = u.pm * BM + wr * 64 + fr, col0 = (u.pn & 7) * BM + wc * 32 + 8 * fq;
        constexpr float SI = YD8_SCALE / (W8_SCALE * ACT8_SCALE);
#pragma unroll
        for (int ai = 0; ai < 2; ++ai)
#pragma unroll
            for (int m = 0; m < 4; ++m) { unsigned char* rowp = O + (size_t)(row0 + ai * HALF + m * 16) * 2048 + col0;
#pragma unroll
                for (int bj = 0; bj < 2; ++bj) { const f32x4 a = acc[ai][bj][m][0] * SI, c = acc[ai][bj][m][1] * SI; u32x2 w; w.x = pack4_fp8(a[0], a[1], a[2], a[3]); w.y = pack4_fp8(c[0], c[1], c[2], c[3]);
                    *(u32x2*)(rowp + bj * HALF) = w; } }
    }
};
struct MoeOrder {
    int nunits, G, c; const PG8_LAS int* tile_e;
    __device__ __forceinline__ bool next(int i, Unit& u) const {
        int idx;
        if ((G & 7) == 0) { const int per = G >> 3; idx = (i * 8 + (c & 7)) * per + (c >> 3); } else idx = i * G + c;
        if (idx >= nunits) return false;
        const int mt = idx >> 3; u.pm = mt; u.pn = tile_e[mt] * 8 + (idx & 7); return true;
    }
    __device__ __forceinline__ void a_ready(const Unit&) const {}
    __device__ __forceinline__ void done(const Unit&) const {}
};

template <class Epi, class Sched, bool ALIGN_EPI = false, bool SP2 = false, bool F8 = false>
__device__ __forceinline__ void gemm_phase(PG8_LAS unsigned char* lds, const Gemm g, const Sched& S, const Epi& E) {
    int tid_ = tid_from_wave(g.wave); asm volatile("" : "+v"(tid_));
    const int tid = tid_, wid = __builtin_amdgcn_readfirstlane(tid >> 6), lane = tid & 63, wr = wid >> 2, wc = wid & 3, fr = lane & 15, fq = lane >> 4;
    const int K = g.K, LD = g.ld, nt = K / BK;
    unsigned voffA, voffB;
    { int R, C; stage_rc(tid * 16, R, C); const int Rb = Epi::PERM ? ((R & ~31) + perm32(R & 31)) : R;
        voffA = (unsigned)(R * LD + C) * 2u; voffB = (unsigned)(Rb * LD + C) * 2u; }
    const size_t pstep = (size_t)64 * LD * 2;
    const size_t kstep = (size_t)(BK * 2);
    const size_t hstep = (size_t)HALF * LD * 2;
    const size_t tstep = 2 * hstep;
    const unsigned ldsbase = (unsigned)(uintptr_t)lds;
    const unsigned ldsw = (unsigned)wid * 1024u;
    const int aoff = lds_byte(wr * 64 + fr, fq * 8), boff = lds_byte(wc * 32 + fr, fq * 8);
#define PG8_SA(b, h) (((b) * 2 + (h)) * HTB)
#define PG8_SB(b, h) ((4 + (b) * 2 + (h)) * HTB)
#define PG8_STAGE(bufoff, gbase, voff) do { _Pragma("unroll") for (int _i = 0; _i < 2; ++_i) { unsigned keep_; \
        asm volatile("s_mov_b32 %0, m0\n\ts_mov_b32 m0, %3\n\ts_nop 0\n\tglobal_load_lds_dwordx4 %1, %2\n\ts_mov_b32 m0, %0" : "=&s"(keep_) \
            : "v"(voff), "s"((const char*)(gbase) + _i * pstep), "s"(ldsbase + (unsigned)(bufoff) + ldsw + (unsigned)(_i * 8192))); } } while (0)
#define PG8_CAT(a, b) __builtin_bit_cast(pg8_v8i, __builtin_shufflevector(a, b, 0, 1, 2, 3, 4, 5, 6, 7, 8, 9, 10, 11, 12, 13, 14, 15))
#define PG8_LDA(dst, b, h) do { if constexpr (F8) { _Pragma("unroll") for (int m = 0; m < 4; ++m) { const bf16x8 lo_ = *(const PG8_LAS bf16x8*)(lds + PG8_SA(b, h) + aoff + m * 2048), hi_ = *(const PG8_LAS bf16x8*)(lds + PG8_SA(b, h) + aoff + m * 2048 + 1024); dst##8[m] = PG8_CAT(lo_, hi_); } } \
        else { _Pragma("unroll") for (int m = 0; m < 4; ++m) _Pragma("unroll") for (int k = 0; k < 2; ++k) dst[m][k] = *(const PG8_LAS bf16x8*)(lds + PG8_SA(b, h) + aoff + m * 2048 + k * 1024); } } while (0)
#define PG8_LDB(dst, b, h) do { if constexpr (F8) { _Pragma("unroll") for (int n = 0; n < 2; ++n) { const bf16x8 lo_ = *(const PG8_LAS bf16x8*)(lds + PG8_SB(b, h) + boff + n * 2048), hi_ = *(const PG8_LAS bf16x8*)(lds + PG8_SB(b, h) + boff + n * 2048 + 1024); dst##8[n] = PG8_CAT(lo_, hi_); } } \
        else { _Pragma("unroll") for (int n = 0; n < 2; ++n) _Pragma("unroll") for (int k = 0; k < 2; ++k) dst[n][k] = *(const PG8_LAS bf16x8*)(lds + PG8_SB(b, h) + boff + n * 2048 + k * 1024); } } while (0)
#define PG8_MMA(ai, bj, At, Bt) do { __builtin_amdgcn_s_setprio(1); \
        if constexpr (F8) { _Pragma("unroll") for (int m = 0; m < 4; ++m) _Pragma("unroll") for (int n = 0; n < 2; ++n) \
            acc[ai][bj][m][n] = __builtin_amdgcn_mfma_scale_f32_16x16x128_f8f6f4(Bt##8[n], At##8[m], acc[ai][bj][m][n], 0, 0, 0, 0, 0, 0); } \
        else { _Pragma("unroll") for (int m = 0; m < 4; ++m) _Pragma("unroll") for (int n = 0; n < 2; ++n) _Pragma("unroll") for (int k = 0; k < 2; ++k) \
            acc[ai][bj][m][n] = __builtin_amdgcn_mfma_f32_16x16x32_bf16(Bt[n][k], At[m][k], acc[ai][bj][m][n], 0, 0, 0); } \
        __builtin_amdgcn_s_setprio(0); } while (0)
#define PG8_WAIT_V(n) asm volatile("s_waitcnt vmcnt(" #n ")" ::: "memory")
#define PG8_WAIT_L(n) asm volatile("s_waitcnt lgkmcnt(" #n ")" ::: "memory")
#define PG8_BAR __builtin_amdgcn_s_barrier()
#define PG8_SCHED __builtin_amdgcn_sched_barrier(0)
    Unit cur, nxt; int ui = 0;
    if (!S.next(0, cur)) return;
    f32x4 acc[2][2][4][2];
{ float zero_; asm volatile("v_mov_b32 %0, 0" : "=v"(zero_));
#pragma unroll
    for (int a = 0; a < 2; ++a)
#pragma unroll
        for (int b = 0; b < 2; ++b)
#pragma unroll
            for (int m = 0; m < 4; ++m)
#pragma unroll
                for (int n = 0; n < 2; ++n) acc[a][b][m][n] = (f32x4){zero_, zero_, zero_, zero_}; }
    bf16x8 At[4][2], B0[2][2], B1[2][2]; pg8_v8i At8[4], B08[2], B18[2];
    const char* cA = (const char*)g.A + (size_t)cur.pm * tstep; const char* cB = (const char*)g.Bt + (size_t)cur.pn * tstep;
    S.a_ready(cur);
    if constexpr (SP2) {
        PG8_STAGE(PG8_SB(0, 0), cB, voffB); PG8_STAGE(PG8_SB(0, 1), cB + hstep, voffB); PG8_STAGE(PG8_SA(0, 0), cA, voffA); PG8_STAGE(PG8_SA(0, 1), cA + hstep, voffA);
        if (wr == 1) PG8_BAR;
        PG8_WAIT_V(2); PG8_BAR;
        PG8_STAGE(PG8_SB(1, 0), cB + kstep, voffB); PG8_STAGE(PG8_SA(1, 0), cA + kstep, voffA); PG8_STAGE(PG8_SB(1, 1), cB + hstep + kstep, voffB);
        PG8_WAIT_V(6); PG8_BAR;
    } else {
        PG8_STAGE(PG8_SB(0, 0), cB, voffB); PG8_STAGE(PG8_SA(0, 0), cA, voffA); PG8_STAGE(PG8_SB(0, 1), cB + hstep, voffB); PG8_STAGE(PG8_SA(0, 1), cA + hstep, voffA);
        if (wr == 1) PG8_BAR;
        PG8_WAIT_V(4); PG8_BAR;
        PG8_STAGE(PG8_SB(1, 0), cB + kstep, voffB); PG8_STAGE(PG8_SA(1, 0), cA + kstep, voffA); PG8_STAGE(PG8_SB(1, 1), cB + hstep + kstep, voffB);
        PG8_WAIT_V(6); PG8_BAR;
    }
    for (;;) {
        const bool has_next = S.next(ui + 1, nxt);
        const char* nA = has_next ? (const char*)g.A + (size_t)nxt.pm * tstep : cA; const char* nB = has_next ? (const char*)g.Bt + (size_t)nxt.pn * tstep : cB;
#pragma unroll 1
        for (int t = 0; t < nt; t += 2) {
            const bool last = (t == nt - 2);
            const char* a1 = cA + (size_t)(t + 1) * kstep;
            const char* a2 = last ? nA : cA + (size_t)(t + 2) * kstep; const char* b2 = last ? nB : cB + (size_t)(t + 2) * kstep;
            const char* a3 = a2 + kstep; const char* b3 = b2 + kstep;
            if (last && has_next) S.a_ready(nxt);
            if constexpr (SP2) {
            PG8_LDB(B0, 0, 0); PG8_LDB(B1, 0, 1); PG8_SCHED; PG8_LDA(At, 0, 0); PG8_STAGE(PG8_SA(1, 1), a1 + hstep, voffA);
            PG8_WAIT_V(8); PG8_WAIT_L(0); PG8_BAR; PG8_MMA(0, 0, At, B0); PG8_MMA(0, 1, At, B1); PG8_BAR; PG8_SCHED;
            PG8_LDA(At, 0, 1); PG8_STAGE(PG8_SB(0, 0), b2, voffB); PG8_STAGE(PG8_SB(0, 1), b2 + hstep, voffB); PG8_STAGE(PG8_SA(0, 0), a2, voffA);
            PG8_WAIT_V(8); PG8_WAIT_L(0); PG8_BAR; PG8_MMA(1, 0, At, B0); PG8_MMA(1, 1, At, B1); PG8_BAR; PG8_SCHED;
            PG8_LDB(B0, 1, 0); PG8_LDB(B1, 1, 1); PG8_SCHED; PG8_LDA(At, 1, 0); PG8_STAGE(PG8_SA(0, 1), a2 + hstep, voffA);
            PG8_WAIT_V(8); PG8_WAIT_L(0); PG8_BAR; PG8_MMA(0, 0, At, B0); PG8_MMA(0, 1, At, B1); PG8_BAR; PG8_SCHED;
            PG8_LDA(At, 1, 1); PG8_STAGE(PG8_SB(1, 0), b3, voffB); PG8_STAGE(PG8_SB(1, 1), b3 + hstep, voffB); PG8_STAGE(PG8_SA(1, 0), a3, voffA);
            PG8_WAIT_V(8); PG8_WAIT_L(0); PG8_BAR; PG8_MMA(1, 0, At, B0); PG8_MMA(1, 1, At, B1); PG8_BAR; PG8_SCHED;
            } else {
            PG8_LDB(B0, 0, 0); PG8_SCHED; PG8_LDA(At, 0, 0); PG8_STAGE(PG8_SA(1, 1), a1 + hstep, voffA);
            PG8_WAIT_L(8); PG8_BAR; PG8_WAIT_L(0); PG8_MMA(0, 0, At, B0); PG8_BAR; PG8_SCHED;
            PG8_LDB(B1, 0, 1); PG8_STAGE(PG8_SB(0, 0), b2, voffB);
            PG8_BAR; PG8_WAIT_L(0); PG8_MMA(0, 1, At, B1); PG8_BAR;
            PG8_LDA(At, 0, 1); PG8_STAGE(PG8_SA(0, 0), a2, voffA);
            PG8_BAR; PG8_WAIT_L(0); PG8_MMA(1, 0, At, B0); PG8_BAR; PG8_SCHED;
            PG8_STAGE(PG8_SB(0, 1), b2 + hstep, voffB);
            PG8_WAIT_V(6); PG8_BAR; PG8_MMA(1, 1, At, B1); PG8_BAR;
            PG8_LDB(B0, 1, 0); PG8_SCHED; PG8_LDA(At, 1, 0); PG8_STAGE(PG8_SA(0, 1), a2 + hstep, voffA);
            PG8_WAIT_L(8); PG8_BAR; PG8_WAIT_L(0); PG8_MMA(0, 0, At, B0); PG8_BAR; PG8_SCHED;
            PG8_LDB(B1, 1, 1); PG8_STAGE(PG8_SB(1, 0), b3, voffB);
            PG8_BAR; PG8_WAIT_L(0); PG8_MMA(0, 1, At, B1); PG8_BAR;
            PG8_LDA(At, 1, 1); PG8_STAGE(PG8_SA(1, 0), a3, voffA);
            PG8_BAR; PG8_WAIT_L(0); PG8_MMA(1, 0, At, B0); PG8_BAR; PG8_SCHED;
            PG8_STAGE(PG8_SB(1, 1), b3 + hstep, voffB);
            PG8_WAIT_V(6); PG8_BAR; PG8_MMA(1, 1, At, B1); PG8_BAR;
            }
        }
        if constexpr (ALIGN_EPI) { if (wr == 0) PG8_BAR; }
        if constexpr (!Epi::AFTER_DRAIN) { const int t2_ = tid_from_wave(g.wave);
            E(acc, cur, wr, wc, t2_ & 15, (t2_ >> 4) & 3); S.done(cur); }
        if (!has_next) break;
{ float zero_; asm volatile("v_mov_b32 %0, 0" : "=v"(zero_));
#pragma unroll
        for (int a = 0; a < 2; ++a)
#pragma unroll
            for (int b = 0; b < 2; ++b)
#pragma unroll
                for (int m = 0; m < 4; ++m)
#pragma unroll
                    for (int n = 0; n < 2; ++n) acc[a][b][m][n] = (f32x4){zero_, zero_, zero_, zero_}; }
        cur = nxt; cA = nA; cB = nB; ++ui;
        if constexpr (ALIGN_EPI) { if (wr == 1) PG8_BAR; }
    }
    PG8_WAIT_V(0);
    if constexpr (!ALIGN_EPI) { if (wr == 0) PG8_BAR; }
    PG8_BAR;
    if constexpr (Epi::AFTER_DRAIN) { E.fused(acc, cur, wr, wc, fr, fq, lds, wid, lane); S.done(cur); }
#undef PG8_SA
#undef PG8_SB
#undef PG8_STAGE
#undef PG8_LDA
#undef PG8_LDB
#undef PG8_MMA
#undef PG8_CAT
#undef PG8_WAIT_V
#undef PG8_WAIT_L
#undef PG8_BAR
#undef PG8_SCHED
}
}

namespace att {
#define ALAS __attribute__((address_space(3)))
typedef unsigned short bf16_t;
typedef short bf16x8 __attribute__((ext_vector_type(8)));
typedef short s16x4 __attribute__((ext_vector_type(4)));
typedef float f32x16 __attribute__((ext_vector_type(16)));
typedef float f32x4 __attribute__((ext_vector_type(4)));
typedef unsigned u32x4 __attribute__((ext_vector_type(4)));
typedef ALAS char* ldsp;
#ifndef WO_F8
#define WO_F8 1
#endif
constexpr float OB8_SCALE = 8.f;
constexpr int QP = 6144;
constexpr int OP = 2048;
constexpr int OBP = 2048;
constexpr int SHM_V = 16384, SHM_K = 16384;
constexpr int LDS_V = 0, LDS_K = 2 * SHM_V, LDS_WS = LDS_K + 2 * SHM_K, ATT_LDS_BYTES = LDS_WS + 8 * 256;
#define KSWZ(row, colB) ((row) * 256 + ((colB) ^ (((row) & 7) << 4)))
#define KSWZ64(row, colB) ((row) * 128 + ((colB) ^ (((row) & 7) << 4)))
#define SBAR() __builtin_amdgcn_sched_barrier(0)
__device__ __forceinline__ int v_st(int k, int c) { const int kk = (k & ~0xC) | ((k & 4) << 1) | ((k & 8) >> 1); return ((kk >> 3) * 4 + (c >> 5)) * 512 + ((kk & 7) * 32 + (c & 31)) * 2; }
__device__ __forceinline__ int v_rd_base(int lane) { return ((lane & 3) << 3) | (((lane >> 2) & 3) << 6) | (((lane >> 4) & 1) << 5) | (((lane >> 5) & 1) << 8); }
constexpr int v_rd_off(int d0, int ks, int half) { return d0 * 512 + ks * 4096 + half * 2048; }
__device__ __forceinline__ int crow(int r, int hi) { return (r & 3) + 8 * (r >> 2) + 4 * hi; }
__device__ __forceinline__ unsigned cvtpk(float lo, float hi) { unsigned r; asm volatile("v_cvt_pk_bf16_f32 %0, %1, %2" : "=v"(r) : "v"(lo), "v"(hi)); return r; }
__device__ __forceinline__ bf16x8 ldg8(const bf16_t* p) { return *reinterpret_cast<const bf16x8*>(p); }
__device__ __forceinline__ unsigned quad_pack_fp8(float v) {
    const int b = __builtin_bit_cast(int, v);
    const float v1 = __builtin_bit_cast(float, __builtin_amdgcn_update_dpp(b, b, 0x55, 0xf, 0xf, false));
    const float v2 = __builtin_bit_cast(float, __builtin_amdgcn_update_dpp(b, b, 0xAA, 0xf, 0xf, false));
    const float v3 = __builtin_bit_cast(float, __builtin_amdgcn_update_dpp(b, b, 0xFF, 0xf, 0xf, false));
    int w; asm volatile("" : "=v"(w));
    w = __builtin_amdgcn_cvt_pk_fp8_f32(v, v1, w, false); w = __builtin_amdgcn_cvt_pk_fp8_f32(v2, v3, w, true); return (unsigned)w;
}
__device__ __forceinline__ float xhalf(float v, int hi) {
    auto rr = __builtin_amdgcn_permlane32_swap(__float_as_uint(v), __float_as_uint(v), false, false);
    return __uint_as_float(hi ? rr[0] : rr[1]);
}
#define ATT_PK4(P, B_, OUT) do { unsigned a0 = cvtpk(P[B_+0], P[B_+1]), a1 = cvtpk(P[B_+2], P[B_+3]);                      \
        unsigned b0 = cvtpk(P[B_+4], P[B_+5]), b1 = cvtpk(P[B_+6], P[B_+7]);                                             \
        auto r0 = __builtin_amdgcn_permlane32_swap(a0, b0, false, false); auto r1 = __builtin_amdgcn_permlane32_swap(a1, b1, false, false); \
        u32x4 w = {r0[0], r1[0], r0[1], r1[1]}; OUT = *reinterpret_cast<bf16x8*>(&w); } while (0)
__device__ __forceinline__ void pv_tile(f32x16* o, int vb, bf16x8 pa0, bf16x8 pa1, bf16x8 pa2, bf16x8 pa3) {
#define TRRD(dst, off) asm volatile("ds_read_b64_tr_b16 %0, %1 offset:%2" : "=&v"(dst) : "v"(vb), "i"(off) : "memory")
#define PV_D0(d0) do { s16x4 l0, l1, l2, l3, h0, h1, h2, h3; constexpr int b_ = v_rd_off(d0, 0, 0); \
        TRRD(l0, b_); TRRD(h0, b_ + 2048); TRRD(l1, b_ + 4096); TRRD(h1, b_ + 6144); TRRD(l2, b_ + 8192); TRRD(h2, b_ + 10240); TRRD(l3, b_ + 12288); TRRD(h3, b_ + 14336); \
        asm volatile("s_waitcnt lgkmcnt(0)" ::: "memory"); SBAR(); \
        o[d0] = __builtin_amdgcn_mfma_f32_32x32x16_bf16(pa0, (bf16x8){l0[0], l0[1], l0[2], l0[3], h0[0], h0[1], h0[2], h0[3]}, o[d0], 0, 0, 0);   \
        o[d0] = __builtin_amdgcn_mfma_f32_32x32x16_bf16(pa1, (bf16x8){l1[0], l1[1], l1[2], l1[3], h1[0], h1[1], h1[2], h1[3]}, o[d0], 0, 0, 0);   \
        o[d0] = __builtin_amdgcn_mfma_f32_32x32x16_bf16(pa2, (bf16x8){l2[0], l2[1], l2[2], l2[3], h2[0], h2[1], h2[2], h2[3]}, o[d0], 0, 0, 0);   \
        o[d0] = __builtin_amdgcn_mfma_f32_32x32x16_bf16(pa3, (bf16x8){l3[0], l3[1], l3[2], l3[3], h3[0], h3[1], h3[2], h3[3]}, o[d0], 0, 0, 0); } while (0)
    PV_D0(0); PV_D0(1); PV_D0(2); PV_D0(3);
#undef PV_D0
#undef TRRD
}

__device__ __forceinline__ void sb_block(const bf16_t* __restrict__ Qg, const bf16_t* __restrict__ Kg, const bf16_t* __restrict__ Vg, bf16_t* __restrict__ Og, int qb, ldsp lds, int wave_) {
    int tid_ = tid_from_wave(wave_); asm volatile("" : "+v"(tid_));
    const int tid = tid_, wid = __builtin_amdgcn_readfirstlane(tid >> 6), lane = tid & 63, r32 = lane & 31, hi = lane >> 5;
    const int NT = 4 * qb + 4, R0 = 256 * qb + 32 * wid, myrow = R0 + r32;
    const ldsp V_lds = lds + LDS_V; const ldsp K_lds = lds + LDS_K;
    bf16x8 qr[8];
    { const bf16_t* Qw = Qg + (size_t)R0 * QP; const unsigned qoff = (unsigned)(r32 * QP + hi * 8);
#pragma unroll
      for (int d0 = 0; d0 < 8; ++d0) qr[d0] = ldg8(Qw + (qoff + d0 * 16)); }
    const int sr = tid >> 4, sc = (tid & 15) * 8, kws = KSWZ(sr, sc * 2), vst0 = v_st(sr, sc), vst1 = v_st(32 + sr, sc);
    const unsigned kvoff = (unsigned)(sr * QP + sc);
    const int vb0 = (int)(unsigned)(uintptr_t)V_lds + v_rd_base(lane);
    bf16x8 sk0, sk1, sv0, sv1;
#define SB_LOAD(j) do { const bf16_t* kp_ = Kg + (size_t)(64 * (j)) * QP; const bf16_t* vp_ = Vg + (size_t)(64 * (j)) * QP; \
        sk0 = ldg8(kp_ + kvoff); sk1 = ldg8(kp_ + (size_t)32 * QP + kvoff); sv0 = ldg8(vp_ + kvoff); sv1 = ldg8(vp_ + (size_t)32 * QP + kvoff); } while (0)
#define SB_WRITE(bf) do { *(ALAS bf16x8*)(K_lds + (bf) * SHM_K + kws) = sk0; *(ALAS bf16x8*)(K_lds + (bf) * SHM_K + kws + 32 * 256) = sk1; \
        *(ALAS bf16x8*)(V_lds + (bf) * SHM_V + vst0) = sv0; *(ALAS bf16x8*)(V_lds + (bf) * SHM_V + vst1) = sv1; } while (0)
    SB_LOAD(NT - 1); SB_WRITE(0);
    __syncthreads();
    float carry = 0.f; f32x16 o[4] = {};
    ALAS int* fl = (ALAS int*)(lds + LDS_WS); bool wdone = false;
    for (int t = 0; t < NT; ++t) {
        const int j = NT - 1 - t, buf = t & 1, kb = 64 * j;
        if (t + 1 < NT) SB_LOAD(j - 1);
        if (kb <= R0 + 30 && !wdone) {
            f32x16 p0 = {}, p1 = {};
            { const ldsp Kb = K_lds + buf * SHM_K;
#pragma unroll
              for (int d0 = 0; d0 < 8; ++d0) { const ldsp a = Kb + KSWZ(r32, ((d0 & 3) * 16 + hi * 8) * 2) + (d0 >> 2) * 128;
                  const bf16x8 b0 = *(const ALAS bf16x8*)a, b1 = *(const ALAS bf16x8*)(a + 32 * 256);
                  p0 = __builtin_amdgcn_mfma_f32_32x32x16_bf16(b0, qr[d0], p0, 0, 0, 0);
                  p1 = __builtin_amdgcn_mfma_f32_32x32x16_bf16(b1, qr[d0], p1, 0, 0, 0); } }
            f32x16 lb0, lb1;
#pragma unroll
            for (int r = 0; r < 16; ++r) {
                { const float z = p0[r]; const float e = __builtin_amdgcn_exp2f(-__builtin_fabsf(z)); const float sp = __builtin_fmaxf(z, 0.f) + __builtin_amdgcn_logf(1.f + e); p0[r] = -sp; lb0[r] = z - sp; }
                { const float z = p1[r]; const float e = __builtin_amdgcn_exp2f(-__builtin_fabsf(z)); const float sp = __builtin_fmaxf(z, 0.f) + __builtin_amdgcn_logf(1.f + e); p1[r] = -sp; lb1[r] = z - sp; }
            }
            if (kb + 63 >= R0) {
                const int dq = myrow - kb - 4 * hi; const float NEG = -__builtin_inff();
#pragma unroll
                for (int r = 0; r < 16; ++r) { const int c = (r & 3) + 8 * (r >> 2);
                    if (c >= dq) { p0[r] = 0.f; lb0[r] = NEG; }
                    if (c + 32 >= dq) { p1[r] = 0.f; lb1[r] = NEG; } }
            }
            float gs[8], go[8];
#pragma unroll
            for (int g = 0; g < 4; ++g) { gs[g] = (p0[4 * g] + p0[4 * g + 1]) + (p0[4 * g + 2] + p0[4 * g + 3]); gs[4 + g] = (p1[4 * g] + p1[4 * g + 1]) + (p1[4 * g + 2] + p1[4 * g + 3]); }
#pragma unroll
            for (int i = 0; i < 8; ++i) go[i] = xhalf(gs[i], hi);
            float acc = carry;
#pragma unroll
            for (int idx = 7; idx >= 0; --idx) { const int g = idx & 3; const float base = acc + (hi ? 0.f : go[idx]);
                if (idx >= 4) { const float t3 = base, t2 = t3 + p1[4 * g + 3], t1 = t2 + p1[4 * g + 2], t0 = t1 + p1[4 * g + 1];
                    lb1[4 * g + 3] = __builtin_amdgcn_exp2f(lb1[4 * g + 3] + t3); lb1[4 * g + 2] = __builtin_amdgcn_exp2f(lb1[4 * g + 2] + t2);
                    lb1[4 * g + 1] = __builtin_amdgcn_exp2f(lb1[4 * g + 1] + t1); lb1[4 * g] = __builtin_amdgcn_exp2f(lb1[4 * g] + t0); }
                else { const float t3 = base, t2 = t3 + p0[4 * g + 3], t1 = t2 + p0[4 * g + 2], t0 = t1 + p0[4 * g + 1];
                    lb0[4 * g + 3] = __builtin_amdgcn_exp2f(lb0[4 * g + 3] + t3); lb0[4 * g + 2] = __builtin_amdgcn_exp2f(lb0[4 * g + 2] + t2);
                    lb0[4 * g + 1] = __builtin_amdgcn_exp2f(lb0[4 * g + 1] + t1); lb0[4 * g] = __builtin_amdgcn_exp2f(lb0[4 * g] + t0); }
                acc += gs[idx] + go[idx]; }
            carry = acc;
            bf16x8 pa0, pa1, pa2, pa3;
            ATT_PK4(lb0, 0, pa0); ATT_PK4(lb0, 8, pa1); ATT_PK4(lb1, 0, pa2); ATT_PK4(lb1, 8, pa3);
            SBAR();
            pv_tile(o, vb0 + buf * SHM_V, pa0, pa1, pa2, pa3);
            wdone = __all(carry < -127.f);
        }
        if (lane == 0) fl[buf * 8 + wid] = wdone ? 1 : 0;
        if (t + 1 < NT) SB_WRITE(buf ^ 1);
        __syncthreads();
        { const ALAS int* f = fl + buf * 8; if ((f[0] & f[1] & f[2] & f[3] & f[4] & f[5] & f[6] & f[7]) != 0) break; }
    }
#undef SB_LOAD
#undef SB_WRITE
#if WO_F8
    unsigned char* Ow = (unsigned char*)Og + (size_t)R0 * OBP; const unsigned ooff = (unsigned)(4 * hi * OBP + r32);
#pragma unroll
    for (int r = 0; r < 16; ++r) { unsigned char* rowp = Ow + (size_t)((r & 3) + 8 * (r >> 2)) * OBP;
#pragma unroll
        for (int d0 = 0; d0 < 4; ++d0) { const unsigned w = quad_pack_fp8(o[d0][r] * OB8_SCALE);
            if ((r32 & 3) == 0) *(unsigned*)(rowp + (ooff + d0 * 32)) = w; } }
#else
    bf16_t* Ow = Og + (size_t)R0 * OP; const unsigned ooff = (unsigned)(4 * hi * OP + r32);
#pragma unroll
    for (int r = 0; r < 16; ++r) { bf16_t* rowp = Ow + (size_t)((r & 3) + 8 * (r >> 2)) * OP;
#pragma unroll
        for (int d0 = 0; d0 < 4; ++d0) { const float v = o[d0][r]; const float vn = __shfl_xor(v, 1);
            if ((r32 & 1) == 0) *(unsigned*)(rowp + (ooff + d0 * 32)) = cvtpk(v, vn); } }
#endif
}

constexpr float ATT_THR = 8.f;
__device__ __forceinline__ void qkt64(f32x16& p0, f32x16& p1, ldsp Kb, int r32, int hi, const bf16x8* qr) {
    p0 = f32x16{}; p1 = f32x16{};
#pragma unroll
    for (int d0 = 0; d0 < 4; ++d0) { const ldsp a = Kb + KSWZ64(r32, (d0 * 16 + hi * 8) * 2);
        const bf16x8 b0 = *(const ALAS bf16x8*)a, b1 = *(const ALAS bf16x8*)(a + 32 * 128);
        p0 = __builtin_amdgcn_mfma_f32_32x32x16_bf16(b0, qr[d0], p0, 0, 0, 0);
        p1 = __builtin_amdgcn_mfma_f32_32x32x16_bf16(b1, qr[d0], p1, 0, 0, 0); }
}
__device__ __forceinline__ void partial_sm(f32x16& p0, f32x16& p1, float& m_reg, float& alpha, int hi) {
    float pmax = p0[0];
#pragma unroll
    for (int r = 1; r < 16; ++r) pmax = __builtin_fmaxf(pmax, p0[r]);
#pragma unroll
    for (int r = 0; r < 16; ++r) pmax = __builtin_fmaxf(pmax, p1[r]);
    pmax = __builtin_fmaxf(pmax, xhalf(pmax, hi));
    float mn;
    if (__builtin_expect(__all(pmax - m_reg <= ATT_THR), 1)) { mn = m_reg; alpha = 1.f; }
    else { mn = __builtin_fmaxf(m_reg, pmax); alpha = __builtin_amdgcn_exp2f(m_reg - mn); m_reg = mn; }
#pragma unroll
    for (int r = 0; r < 16; ++r) { p0[r] -= mn; p1[r] -= mn; }
#pragma unroll
    for (int r = 0; r < 16; ++r) p0[r] = __builtin_amdgcn_exp2f(p0[r]);
}
__device__ __forceinline__ void finish_sm(f32x16& p0, f32x16& p1, float alpha, float& l_reg, bf16x8& pa0, bf16x8& pa1, bf16x8& pa2, bf16x8& pa3, int hi) {
#pragma unroll
    for (int r = 0; r < 16; ++r) p1[r] = __builtin_amdgcn_exp2f(p1[r]);
    float ps = 0.f;
#pragma unroll
    for (int r = 0; r < 16; ++r) ps += p0[r];
#pragma unroll
    for (int r = 0; r < 16; ++r) ps += p1[r];
    ps += xhalf(ps, hi);
    l_reg = l_reg * alpha + ps;
    ATT_PK4(p0, 0, pa0); ATT_PK4(p0, 8, pa1); ATT_PK4(p1, 0, pa2); ATT_PK4(p1, 8, pa3);
}
__device__ __forceinline__ void mask_gt(f32x16& p0, f32x16& p1, int dq) {
    const float NEG = -__builtin_inff();
#pragma unroll
    for (int r = 0; r < 16; ++r) { const int c = (r & 3) + 8 * (r >> 2);
        if (c > dq) p0[r] = NEG;
        if (c + 32 > dq) p1[r] = NEG; }
}
template <bool SECOND>
__device__ __forceinline__ void diff_pass(const bf16_t* __restrict__ Qg, const bf16_t* __restrict__ Kg, const bf16_t* __restrict__ Vg, float* S1, bf16_t* __restrict__ Og,
                                          int qb, float lam, const float* __restrict__ gsub, float gmul, ldsp lds, int wave_) {
    int tid_ = tid_from_wave(wave_); asm volatile("" : "+v"(tid_));
    const int tid = tid_, wid = __builtin_amdgcn_readfirstlane(tid >> 6), lane = tid & 63, r32 = lane & 31, hi = lane >> 5;
    const int NT = 4 * qb + 4, R0 = 256 * qb + 32 * wid, myrow = R0 + r32;
    const ldsp V_lds = lds + LDS_V; const ldsp K_lds = lds + LDS_K;
    ALAS float* wsf = (ALAS float*)(lds + LDS_WS) + wid * 64; ALAS float* li_l = wsf; ALAS float* al_l = wsf + 32;
    bf16x8 qr[4];
    { const bf16_t* Qw = Qg + (size_t)R0 * QP; const unsigned qoff = (unsigned)(r32 * QP + hi * 8);
#pragma unroll
      for (int d0 = 0; d0 < 4; ++d0) qr[d0] = ldg8(Qw + (qoff + d0 * 16)); }
    const int sr = tid >> 4, sc = (tid & 15) * 8, vst0 = v_st(sr, sc), vst1 = v_st(32 + sr, sc);
    const int kr = tid >> 3, kc = (tid & 7) * 8, kws = KSWZ64(kr, kc * 2);
    const unsigned voff = (unsigned)(sr * QP + sc), koff = (unsigned)(kr * QP + kc);
    const int vb0 = (int)(unsigned)(uintptr_t)V_lds + v_rd_base(lane);
    const int qm = myrow - 4 * hi;
    bf16x8 sk0A, sv0A, sv1A, sk0B, sv0B, sv1B;
#define DF_LOAD(S_, j) do { const bf16_t* vp_ = Vg + (size_t)(64 * (j)) * QP; sk0##S_ = ldg8(Kg + (size_t)(64 * (j)) * QP + koff); sv0##S_ = ldg8(vp_ + voff); sv1##S_ = ldg8(vp_ + (size_t)32 * QP + voff); } while (0)
#define DF_WRITE(S_, bf) do { *(ALAS bf16x8*)(K_lds + (bf) * SHM_K + kws) = sk0##S_; *(ALAS bf16x8*)(V_lds + (bf) * SHM_V + vst0) = sv0##S_; *(ALAS bf16x8*)(V_lds + (bf) * SHM_V + vst1) = sv1##S_; } while (0)
#define DF_MASK(P0, P1, t) do { if (64 * (t) + 63 > R0) mask_gt(P0, P1, qm - 64 * (t)); } while (0)
#define DF_RESC(a) do { if (__any((a) < 1.f)) { if (hi == 0) al_l[r32] = (a); asm volatile("s_waitcnt lgkmcnt(0)" ::: "memory"); \
        _Pragma("unroll") for (int d_ = 0; d_ < 4; ++d_) _Pragma("unroll") for (int r = 0; r < 16; ++r) o[d_][r] *= al_l[crow(r, hi)]; } } while (0)
    float m_reg = -1e30f, l_reg = 0.f; f32x16 o[4] = {};
    f32x16 pA0, pA1, pB0, pB1; float alA = 1.f, alB = 1.f; bf16x8 pa0, pa1, pa2, pa3;
    DF_LOAD(A, 0); DF_WRITE(A, 0);
    __syncthreads();
    DF_LOAD(A, 1); DF_LOAD(B, 2);
    qkt64(pA0, pA1, K_lds, r32, hi, qr); DF_MASK(pA0, pA1, 0); partial_sm(pA0, pA1, m_reg, alA, hi);
    DF_WRITE(A, 1);
    DF_RESC(alA);
    __syncthreads();
#define DF_HALF(PX0, PX1, alX, PY0, PY1, alY, t, KB, VB, SB, LS, WS) do { \
        SBAR(); qkt64(PX0, PX1, K_lds + (KB) * SHM_K, r32, hi, qr); \
        finish_sm(PY0, PY1, alY, l_reg, pa0, pa1, pa2, pa3, hi); SBAR(); \
        if ((t) + 2 < NT) { DF_LOAD(LS, (t) + 2); SBAR(); } \
        pv_tile(o, vb0 + (VB) * SHM_V, pa0, pa1, pa2, pa3); DF_MASK(PX0, PX1, (t)); partial_sm(PX0, PX1, m_reg, alX, hi); \
        __syncthreads(); \
        if ((t) + 1 < NT) DF_WRITE(WS, SB); \
        DF_RESC(alX); __syncthreads(); } while (0)
    for (int t = 1; t + 1 < NT; t += 2) {
        DF_HALF(pB0, pB1, alB, pA0, pA1, alA, t, 1, 0, 0, A, B);
        DF_HALF(pA0, pA1, alA, pB0, pB1, alB, t + 1, 0, 1, 1, B, A);
    }
    DF_HALF(pB0, pB1, alB, pA0, pA1, alA, NT - 1, 1, 0, 0, A, B);
    finish_sm(pB0, pB1, alB, l_reg, pa0, pa1, pa2, pa3, hi); SBAR();
    pv_tile(o, vb0 + 1 * SHM_V, pa0, pa1, pa2, pa3);
#undef DF_LOAD
#undef DF_WRITE
#undef DF_MASK
#undef DF_RESC
#undef DF_HALF
    if (hi == 0) li_l[r32] = l_reg; asm volatile("s_waitcnt lgkmcnt(0)" ::: "memory");
    float rli[16];
#pragma unroll
    for (int r = 0; r < 16; ++r) rli[r] = __builtin_amdgcn_rcpf(li_l[crow(r, hi)]);
    if constexpr (!SECOND) {
        float* Sw = S1 + (size_t)R0 * OP; const unsigned ooff = (unsigned)(4 * hi * OP + r32);
#pragma unroll
        for (int r = 0; r < 16; ++r) { float* rowp = Sw + (size_t)((r & 3) + 8 * (r >> 2)) * OP;
#pragma unroll
            for (int d0 = 0; d0 < 4; ++d0) rowp[ooff + d0 * 32] = o[d0][r] * rli[r]; }
    } else {
        const float* Sw = S1 + (size_t)R0 * OP; bf16_t* Ow = Og + (size_t)R0 * OP; (void)Ow; const unsigned ooff = (unsigned)(4 * hi * OP + r32), ooff8 = (unsigned)(4 * hi * OBP + r32);
        float gn[4];
#pragma unroll
        for (int d0 = 0; d0 < 4; ++d0) gn[d0] = gsub[d0 * 32 + r32] * gmul;
#pragma unroll
        for (int r = 0; r < 16; ++r) { const float* srow = Sw + (size_t)((r & 3) + 8 * (r >> 2)) * OP; float d[4]; float ss = 0.f;
#if WO_F8
            unsigned char* orowp = (unsigned char*)Og + (size_t)(R0 + (r & 3) + 8 * (r >> 2)) * OBP;
#else
            bf16_t* orowp = Ow + (size_t)((r & 3) + 8 * (r >> 2)) * OP;
#endif
#pragma unroll
            for (int d0 = 0; d0 < 4; ++d0) { d[d0] = srow[ooff + d0 * 32] - lam * (o[d0][r] * rli[r]); ss += d[d0] * d[d0]; }
            ss += __builtin_bit_cast(float, __builtin_amdgcn_update_dpp(0, __builtin_bit_cast(int, ss), 0xB1, 0xf, 0xf, true));
            ss += __builtin_bit_cast(float, __builtin_amdgcn_update_dpp(0, __builtin_bit_cast(int, ss), 0x4E, 0xf, 0xf, true));
            ss += __builtin_bit_cast(float, __builtin_amdgcn_update_dpp(0, __builtin_bit_cast(int, ss), 0x141, 0xf, 0xf, true));
            ss += __builtin_bit_cast(float, __builtin_amdgcn_update_dpp(0, __builtin_bit_cast(int, ss), 0x140, 0xf, 0xf, true));
            { auto rr = __builtin_amdgcn_permlane16_swap(__float_as_uint(ss), __float_as_uint(ss), false, false); ss = __uint_as_float(rr[0]) + __uint_as_float(rr[1]); }
            const float rs = __builtin_amdgcn_rsqf(ss * (1.f / 128.f) + 1e-5f);
#pragma unroll
#if WO_F8
            for (int d0 = 0; d0 < 4; ++d0) { const unsigned w = quad_pack_fp8(d[d0] * rs * gn[d0] * OB8_SCALE);
                if ((r32 & 3) == 0) *(unsigned*)(orowp + (ooff8 + d0 * 32)) = w; }
#else
            for (int d0 = 0; d0 < 4; ++d0) { const float v = d[d0] * rs * gn[d0]; const float vn = __shfl_xor(v, 1);
                if ((r32 & 1) == 0) *(unsigned*)(orowp + (ooff + d0 * 32)) = cvtpk(v, vn); }
#endif
            if ((r & 1) == 1) asm volatile("" ::: "memory"); }
    }
    __syncthreads();
}
#undef SBAR
}

#define LAS __attribute__((address_space(3)))

#define XB_TMO      128
#define XB_XCNT(j)  (256  + 64 * (j))
#define XB_XSUB(j)  (1280 + 64 * (j))
#define XB_XGEN(j)  (2304 + 64 * (j))
#define XB_TOP      3328
#define XB_TOPGEN   3392
#define XCD_BAR_WORDS 3456
#define XB_SPIN_CAP (1u << 18)

__device__ __forceinline__ unsigned xb_ld(unsigned* p)              { return __hip_atomic_load(p, __ATOMIC_RELAXED, __HIP_MEMORY_SCOPE_AGENT); }
__device__ __forceinline__ unsigned xb_add(unsigned* p, unsigned v) { return __hip_atomic_fetch_add(p, v, __ATOMIC_RELAXED, __HIP_MEMORY_SCOPE_AGENT); }
__device__ __forceinline__ unsigned xb_xcc_id() { return (unsigned)__builtin_amdgcn_s_getreg((3 << 11) | 20) & 0xFu; }
#define XB_SPIN(cond, bar) do { unsigned _sp = 0; while (cond) { __builtin_amdgcn_s_sleep(1); \
    if ((++_sp & 255u) == 0u) { if (xb_ld(&(bar)[XB_TMO])) break; if (_sp > XB_SPIN_CAP) { atomicAdd(&(bar)[XB_TMO], 1u); break; } } } } while (0)

struct XcdBarrier {
    unsigned* bar; unsigned x;
    volatile LAS unsigned* st;
};

__device__ __forceinline__ XcdBarrier xcd_barrier_post(unsigned* bar, volatile LAS unsigned* st, bool thread0) {
    XcdBarrier b; b.bar = bar; b.x = xb_xcc_id(); b.st = st;
    if (thread0) (void)xb_add(&bar[XB_XCNT(b.x)], 1u);
    return b;
}
__device__ __forceinline__ void xcd_barrier_complete(unsigned* bar, unsigned x, unsigned& nloc, unsigned& nx) {
    const unsigned G = gridDim.x * gridDim.y * gridDim.z;
    unsigned sum, cnt, mine, sp = 0u;
    for (;;) {
        sum = 0u; cnt = 0u; mine = 0u;
#pragma unroll
        for (unsigned j = 0; j < 16; ++j) { const unsigned c = xb_ld(&bar[XB_XCNT(j)]); sum += c; cnt += (c > 0u) ? 1u : 0u; mine = (j == x) ? c : mine; }
        if (sum == G) break;
        __builtin_amdgcn_s_sleep(1);
        if ((++sp & 255u) == 0u) { if (xb_ld(&bar[XB_TMO])) break; if (sp > XB_SPIN_CAP) { atomicAdd(&bar[XB_TMO], 1u); break; } }
    }
    nloc = mine > 0u ? mine : 1u; nx = cnt > 0u ? cnt : 1u;
}

__device__ __forceinline__ void xcd_barrier(const XcdBarrier& b, bool thread0) {
    asm volatile("s_waitcnt vmcnt(0)" ::: "memory");
    __syncthreads();
    if (thread0) {
        unsigned* bar = b.bar;
        __builtin_amdgcn_s_waitcnt(0);
        unsigned nloc = b.st[0], nx = b.st[1];
        if (nloc == 0u) { xcd_barrier_complete(bar, b.x, nloc, nx); b.st[0] = nloc; b.st[1] = nx; }
        const unsigned old = xb_add(&bar[XB_XSUB(b.x)], 1u);
        const unsigned gen = old / nloc;
        if (old + 1u == (gen + 1u) * nloc) {
            __builtin_amdgcn_fence(__ATOMIC_RELEASE, "agent");
            asm volatile("s_waitcnt vmcnt(0)" ::: "memory");
            const unsigned og = xb_add(&bar[XB_TOP], 1u);
            const unsigned tg = og / nx;
            if (og + 1u == (tg + 1u) * nx) xb_add(&bar[XB_TOPGEN], 1u);
            else XB_SPIN(xb_ld(&bar[XB_TOPGEN]) == tg, bar);
            __builtin_amdgcn_fence(__ATOMIC_ACQUIRE, "agent");
            xb_add(&bar[XB_XGEN(b.x)], 1u);
            asm volatile("s_waitcnt vmcnt(0)" ::: "memory");
        } else {
            XB_SPIN(xb_ld(&bar[XB_XGEN(b.x)]) == gen, bar);
            __builtin_amdgcn_fence(__ATOMIC_ACQUIRE, "agent");
            asm volatile("s_waitcnt vmcnt(0)" ::: "memory");
        }
    }
    __syncthreads();
}

constexpr int NWAVES = 8;
constexpr int NTOK = 16384, DM = 2048, SEQ = 2048, NHEAD = 16, NLAYER = 4, NEXP = 16, DEXP = 1024;
constexpr int XS_ROWS = 36864;
constexpr float LN_EPS = 1e-5f;
constexpr float DN_ALPHA = 1.6817928305074292f;
constexpr float LOG2E = 1.4426950408889634f;
constexpr float SB_QSCALE = 0.08838834764831845f * LOG2E;
constexpr float DF_QSCALE = 0.125f * LOG2E;
#ifndef MK_MULTI
#define MK_MULTI 0
#endif
#ifndef MOE_F8
#define MOE_F8 1
#endif
#ifndef QKV8_A
#define QKV8_A 1
#endif
#ifndef QKV8_B
#define QKV8_B 0
#endif
constexpr int NSTEPS = 1 + 8 * NLAYER;

constexpr size_t MiB = 1u << 20;
constexpr size_t WS_CTL = 0, CTL_ZERO_BYTES = 64 * 1024;
constexpr size_t WS_COS = 1 * MiB, WS_SIN = WS_COS + 256 * 1024;
constexpr size_t WS_WR = 2 * MiB;
constexpr size_t WS_CNT = 3 * MiB;
constexpr size_t WS_RE = WS_CNT + 64 * 1024;
constexpr size_t WS_RW = WS_RE + 64 * 1024;
constexpr size_t WS_RP = WS_RW + 128 * 1024;
constexpr int LDH = 2048;
constexpr int P8K2 = 2048, P8K1 = 1024;
constexpr size_t WS_WQKVA = 4 * MiB;
constexpr size_t WS_WOA = WS_WQKVA + 56 * MiB;
constexpr size_t WS_WQKVB = WS_WOA + 16 * MiB;
constexpr size_t WS_WOB = WS_WQKVB + 36 * MiB;
constexpr size_t WS_WGU = WS_WOB + 16 * MiB;
constexpr size_t WS_WDN = WS_WGU + 512 * MiB;
constexpr size_t WS_H = WS_WDN + 256 * MiB;
constexpr size_t WS_HB = WS_H + 128 * MiB;
constexpr size_t WS_QKV = WS_HB + 68 * MiB;
constexpr size_t WS_OB = WS_QKV + 192 * MiB;
constexpr size_t WS_XS = WS_OB + 64 * MiB;
constexpr size_t WS_ACT = WS_XS + 144 * MiB;
constexpr size_t WS_YD = WS_ACT + 72 * MiB;
constexpr size_t WS_END = WS_YD + 144 * MiB;
static_assert(WS_END <= (size_t)2040 * MiB, "workspace map");
static_assert((size_t)2 * 6144 * LDH * 2 <= 56 * MiB && (size_t)8192 * LDH * 2 <= 36 * MiB && (size_t)2 * 2048 * P8K2 <= 16 * MiB && (size_t)64 * 2048 * P8K2 <= 512 * MiB && (size_t)64 * 2048 * P8K1 <= 256 * MiB, "weight regions");
static_assert((size_t)NTOK * LDH * 2 <= 68 * MiB && (size_t)NTOK * P8K2 <= 64 * MiB && (size_t)XS_ROWS * P8K2 <= 144 * MiB && (size_t)XS_ROWS * P8K1 <= 72 * MiB, "activation regions");
constexpr int CW_BAR = 1024;
constexpr int LDS_BYTES = 147456;
constexpr int LDSCTL_OFF = 145408;
constexpr int RING_OFF = 0;
constexpr int LNX_OFF = 131072;

#define GAS __attribute__((address_space(1)))
typedef unsigned short bf16;
typedef unsigned v4u __attribute__((ext_vector_type(4)));
typedef unsigned v2u __attribute__((ext_vector_type(2)));
typedef float f32x4 __attribute__((ext_vector_type(4)));
typedef float f32x2 __attribute__((ext_vector_type(2)));
#define LDS_WAIT() asm volatile("s_waitcnt lgkmcnt(0)" ::: "memory")
#define VM_WAIT() asm volatile("s_waitcnt vmcnt(0)" ::: "memory")
__device__ __forceinline__ unsigned pk2(float lo, float hi) { unsigned r; asm volatile("v_cvt_pk_bf16_f32 %0, %1, %2" : "=v"(r) : "v"(lo), "v"(hi)); return r; }
__device__ __forceinline__ int opq_tid(int wave) { int t = tid_from_wave(wave); asm volatile("" : "+v"(t)); return t; }
__device__ __forceinline__ float dpp_sum(float v) {
    v += __builtin_bit_cast(float, __builtin_amdgcn_update_dpp(0, __builtin_bit_cast(int, v), 0xB1, 0xf, 0xf, true));
    v += __builtin_bit_cast(float, __builtin_amdgcn_update_dpp(0, __builtin_bit_cast(int, v), 0x4E, 0xf, 0xf, true));
    v += __builtin_bit_cast(float, __builtin_amdgcn_update_dpp(0, __builtin_bit_cast(int, v), 0x141, 0xf, 0xf, true));
    v += __builtin_bit_cast(float, __builtin_amdgcn_update_dpp(0, __builtin_bit_cast(int, v), 0x140, 0xf, 0xf, true));
    const int b = __builtin_bit_cast(int, v);
    const float s0 = __builtin_bit_cast(float, __builtin_amdgcn_readlane(b, 0)), s1 = __builtin_bit_cast(float, __builtin_amdgcn_readlane(b, 16));
    const float s2 = __builtin_bit_cast(float, __builtin_amdgcn_readlane(b, 32)), s3 = __builtin_bit_cast(float, __builtin_amdgcn_readlane(b, 48));
    return (s0 + s1) + (s2 + s3);
}
__device__ __forceinline__ float wave_sum(float v) {
#pragma unroll
    for (int o = 1; o < 64; o <<= 1) v += __shfl_xor(v, o);
    return v;
}

struct Args { const float* in[17]; float* out; unsigned char* ws; int s_lo, s_hi; };

__device__ __forceinline__ int map_row(int n, int mode) {
    if (mode == 0) return n;
    if (mode == 1) { const int c = n & 255, blk = c >> 6, d = c & 63; return (n & ~255) + ((d >> 5) << 7) + (blk << 5) + (d & 31); }
    return ((n >> 7) << 8) + (n & 127) + (mode == 3 ? 128 : 0);
}
__device__ __forceinline__ void cvt_item(const float* __restrict__ src, int pitch, int K, bf16* __restrict__ dst, int mode, int k0, int n0, LAS float* scr, int lane) {
    const int kr = lane >> 4, n4 = (lane & 15) * 4;
    f32x4 v[16];
#pragma unroll
    for (int i = 0; i < 16; ++i) v[i] = __builtin_nontemporal_load((const f32x4*)(src + (size_t)(k0 + 4 * i + kr) * pitch + n0 + n4));
#pragma unroll
    for (int i = 0; i < 16; ++i) { LAS float* s = scr + (4 * i + kr) * 65 + n4; s[0] = v[i][0]; s[1] = v[i][1]; s[2] = v[i][2]; s[3] = v[i][3]; }
    LDS_WAIT();
    const int c = lane & 7;
#pragma unroll
    for (int j = 0; j < 8; ++j) { const int nl = (lane >> 3) + 8 * j; const int row = map_row(n0 + nl, mode);
        const LAS float* s = scr + (8 * c) * 65 + nl;
        v4u o; o.x = pk2(s[0], s[65]); o.y = pk2(s[130], s[195]); o.z = pk2(s[260], s[325]); o.w = pk2(s[390], s[455]);
        *(v4u*)(dst + (size_t)row * K + k0 + 8 * c) = o; }
    LDS_WAIT();
}

__device__ __forceinline__ void cvt_item8(const float* __restrict__ src, int pitch, int K, unsigned char* __restrict__ dst, int mode, int k0, int n0, float scale, LAS float* scr, int lane) {
    const int kr = lane >> 4, n4 = (lane & 15) * 4;
    f32x4 v[16];
#pragma unroll
    for (int i = 0; i < 16; ++i) v[i] = __builtin_nontemporal_load((const f32x4*)(src + (size_t)(k0 + 4 * i + kr) * pitch + n0 + n4));
#pragma unroll
    for (int i = 0; i < 16; ++i) { LAS float* s = scr + (4 * i + kr) * 65 + n4; s[0] = v[i][0] * scale; s[1] = v[i][1] * scale; s[2] = v[i][2] * scale; s[3] = v[i][3] * scale; }
    LDS_WAIT();
    const int c = lane & 3;
#pragma unroll
    for (int j = 0; j < 4; ++j) { const int nl = (lane >> 2) + 16 * j; const int row = map_row(n0 + nl, mode);
        const LAS float* s = scr + (16 * c) * 65 + nl;
        v4u o; o.x = pg8::pack4_fp8(s[0], s[65], s[130], s[195]); o.y = pg8::pack4_fp8(s[260], s[325], s[390], s[455]);
        o.z = pg8::pack4_fp8(s[520], s[585], s[650], s[715]); o.w = pg8::pack4_fp8(s[780], s[845], s[910], s[975]);
        *(v4u*)(dst + (size_t)row * K + k0 + 16 * c) = o; }
    LDS_WAIT();
}

__global__ void __launch_bounds__(NWAVES * 64, 2) yoco_fwd(Args args) {
    extern __shared__ __attribute__((aligned(16))) unsigned char lds_raw[];
    LAS unsigned char* const lds = (LAS unsigned char*)lds_raw;
    const int tid = threadIdx.x, lane = tid & 63, wave = __builtin_amdgcn_readfirstlane(tid >> 6);
    const int G = gridDim.x, bx = blockIdx.x;
    const int vcu = (G % 8 == 0) ? (bx % 8) * (G / 8) + bx / 8 : bx;
    unsigned char* const ws = args.ws;
    volatile LAS unsigned* const CTL = (volatile LAS unsigned*)(lds + LDSCTL_OFF);
    LAS int* const TAB = (LAS int*)(lds + LDSCTL_OFF + 64);
    for (int u = tid; u < (LDS_BYTES - LDSCTL_OFF) / 4; u += NWAVES * 64) ((LAS unsigned*)(lds + LDSCTL_OFF))[u] = 0u;
    __syncthreads();
    const int s_lo = args.s_lo, s_hi = args.s_hi;
    XcdBarrier bar; bar.bar = (unsigned*)(ws + WS_CTL) + CW_BAR; bar.x = 0; bar.st = nullptr;
    if (s_hi - s_lo > 1) bar = xcd_barrier_post((unsigned*)(ws + WS_CTL) + CW_BAR, CTL, tid == 0);
#ifndef PH_MASK
#define PH_MASK 0xFFFF
#endif
#define PHM(b) (((PH_MASK) >> (b)) & 1)
#ifndef PROBE_DUP
#define PROBE_DUP 0
#endif
#define PREP(b) _Pragma("unroll 1") for (int rep_ = 0; rep_ < ((((PROBE_DUP) >> (b)) & 1) ? 2 : 1); ++rep_)
#define IN(k) (s_lo <= (k) && (k) < s_hi)
#define SEAM(k) do { if ((k) + 1 < s_hi) xcd_barrier(bar, tid_from_wave(wave) == 0); } while (0)

    const float* const x_in = args.in[0];
    float* const H = (float*)(ws + WS_H); bf16* const HB = (bf16*)(ws + WS_HB); unsigned char* const HB8 = (unsigned char*)(ws + WS_OB + 32 * MiB);     bf16* const QKV = (bf16*)(ws + WS_QKV); bf16* const OB = (bf16*)(ws + WS_OB);
    bf16* const MIX = (bf16*)(ws + WS_YD);     bf16* const XS = (bf16*)(ws + WS_XS); float* const S1 = (float*)(ws + WS_XS); bf16* const ACT = (bf16*)(ws + WS_ACT); bf16* const YD = (bf16*)(ws + WS_YD);
    float* const COS = (float*)(ws + WS_COS); float* const SIN = (float*)(ws + WS_SIN); float* const WR = (float*)(ws + WS_WR);
    int* const CNT = (int*)(ws + WS_CNT); unsigned* const RE = (unsigned*)(ws + WS_RE); f32x2* const RW = (f32x2*)(ws + WS_RW); int* const RP = (int*)(ws + WS_RP);

    if (IN(0) && PHM(0)) { PREP(0) {
        const int tid = opq_tid(wave), lane = tid & 63;
        LAS float* scr = (LAS float*)(lds + RING_OFF + wave * 16640);
        const int gw = vcu * NWAVES + wave, NGW = G * NWAVES;
        constexpr int I0 = 2 * 3072, I1 = 8 * 1024, I2 = 128 * 512, I3 = 64 * 512, NITEMS = I0 + I1 + I2 + I3;
        for (int it = gw; it < NITEMS; it += NGW) {
            int r = it;
            if (r < I0) { const int job = r / 3072; r -= job * 3072; const int kb = r / 96, nb = r - kb * 96;
                if (QKV8_A) cvt_item8(args.in[1] + (size_t)job * 2048 * 6144, 6144, 2048, (unsigned char*)(ws + WS_WQKVA) + (size_t)job * 6144 * 2048, 0, kb * 64, nb * 64, pg8::W8_SCALE, scr, lane);
                else cvt_item(args.in[1] + (size_t)job * 2048 * 6144, 6144, LDH, (bf16*)(ws + WS_WQKVA) + (size_t)job * 6144 * LDH, 0, kb * 64, nb * 64, scr, lane);
                continue; }
            r -= I0;
            if (r < I1) { const int job = r >> 10; r &= 1023; const int kb = r >> 5, nb = r & 31;
                const float* src; int pitch = 2048, mode = 0; bf16* dst;
                if (job < 2) { src = args.in[2] + (size_t)job * 2048 * 2048; dst = (bf16*)(ws + WS_WOA + (size_t)job * 2048 * P8K2); }
                else if (job == 2) { src = args.in[4]; dst = (bf16*)(ws + WS_WQKVB); mode = 1; }
                else if (job == 3) { src = args.in[3]; pitch = 4096; dst = (bf16*)(ws + WS_WQKVB) + (size_t)2048 * LDH; mode = 1; }
                else if (job == 4) { src = args.in[3] + 2048; pitch = 4096; dst = (bf16*)(ws + WS_WQKVB) + (size_t)4096 * LDH; }
                else if (job == 5) { src = args.in[4] + (size_t)2048 * 2048; dst = (bf16*)(ws + WS_WQKVB) + (size_t)6144 * LDH; mode = 1; }
                else { src = args.in[5] + (size_t)(job - 6) * 2048 * 2048; dst = (bf16*)(ws + WS_WOB + (size_t)(job - 6) * 2048 * P8K2); }
                if (job < 2 || job >= 6) { cvt_item8(src, pitch, P8K2, (unsigned char*)dst, mode, kb * 64, nb * 64, pg8::W8_SCALE, scr, lane); continue; }
                if (QKV8_B) { cvt_item8(src, pitch, 2048, (unsigned char*)(ws + WS_WQKVB) + (size_t)((job == 2) ? 0 : (job == 3) ? 2048 : (job == 4) ? 4096 : 6144) * 2048, mode, kb * 64, nb * 64, pg8::W8_SCALE, scr, lane); continue; }
                cvt_item(src, pitch, LDH, dst, mode, kb * 64, nb * 64, scr, lane); continue; }
            r -= I1;
            if (r < I2) { const int job = r >> 9; r &= 511; const int kb = r >> 4, nb = r & 15; const int le = job >> 1, up = job & 1;
                cvt_item8((up ? args.in[15] : args.in[14]) + (size_t)le * 2048 * 1024, 1024, P8K2, (unsigned char*)(ws + WS_WGU) + (size_t)le * 2048 * P8K2, 2 + up, kb * 64, nb * 64, pg8::W8_SCALE, scr, lane); continue; }
            r -= I2;
            { const int le = r >> 9; r &= 511; const int kb = r >> 5, nb = r & 31;
                cvt_item8(args.in[16] + (size_t)le * 1024 * 2048, 2048, P8K1, (unsigned char*)(ws + WS_WDN) + (size_t)le * 2048 * P8K1, 0, kb * 64, nb * 64, pg8::W8_SCALE, scr, lane); }
        }
        for (size_t i = (size_t)gw * 64 + lane; i < (size_t)NTOK * DM / 4; i += (size_t)NGW * 64) {
            const f32x4 v = ((const f32x4*)x_in)[i];
            if (QKV8_A) ((unsigned*)HB8)[i] = pg8::pack4_fp8(v[0], v[1], v[2], v[3]);
            else { v2u o; o.x = pk2(v[0], v[1]); o.y = pk2(v[2], v[3]); *(v2u*)(HB + (i >> 9) * LDH + (i & 511) * 4) = o; } }
        for (int i = bx * (NWAVES * 64) + tid; i < 2048 * 32; i += G * NWAVES * 64) { const int pos = i >> 5, f = i & 31;
            const float inv = __builtin_amdgcn_exp2f(-(float)f * 0.4152410118609203f); const float ang = (float)pos * inv;
            const double tr = (double)ang * 0.15915494309189535; const float fr = (float)(tr - __builtin_rint(tr));
            COS[i] = __builtin_amdgcn_cosf(fr); SIN[i] = __builtin_amdgcn_sinf(fr); }
        for (int i = bx * (NWAVES * 64) + tid; i < NLAYER * 20 * 2048; i += G * NWAVES * 64) { const int k = i & 2047, c = (i >> 11) % 20, l = i / (20 * 2048);
            WR[i] = c < 4 ? args.in[12][((size_t)l * 2048 + k) * 4 + c] : args.in[13][(((size_t)l * 4 + ((c - 4) >> 2)) * 2048 + k) * 4 + ((c - 4) & 3)]; }
        }
        SEAM(0);
    }

    for (int L = 0; L < NLAYER; ++L) {
        const int sb = 1 + 8 * L; const bool typeA = L < 2;
        if (IN(sb + 0)) {
            if (typeA && PHM(1)) { PREP(1) {
                pg8::StaticOrder S; S.init(NTOK, 6144, G, bx);
                if (QKV8_A) { pg8::Gemm g{(const bf16*)HB8, (const bf16*)(ws + WS_WQKVA + (size_t)L * 6144 * 2048), NTOK, 6144, DM / 2, DM / 2, wave}; pg8::EpiQkv E{QKV, 6144, 2048, SB_QSCALE, 1.f / pg8::W8_SCALE};
                    pg8::gemm_phase<pg8::EpiQkv, pg8::StaticOrder, true, true, true>(lds + RING_OFF, g, S, E); }
                else { pg8::Gemm g{HB, (const bf16*)(ws + WS_WQKVA) + (size_t)L * 6144 * LDH, NTOK, 6144, DM, LDH, wave}; pg8::EpiQkv E{QKV, 6144, 2048, SB_QSCALE, 1.f};
                    pg8::gemm_phase<pg8::EpiQkv, pg8::StaticOrder, true, true>(lds + RING_OFF, g, S, E); } }
                if ((PROBE_DUP >> 11) & 1) {
                    struct LocalOrder { int n, G, c; __device__ bool next(int i, pg8::Unit& u) const { if (i * G + c >= n) return false; u.pm = 0; u.pn = 0; return true; }
                        __device__ void a_ready(const pg8::Unit&) const {} __device__ void done(const pg8::Unit&) const {} } S2{1536, G, bx};
                    pg8::Gemm g2{HB, (const bf16*)(ws + WS_WQKVA) + (size_t)L * 6144 * LDH, NTOK, 6144, DM, LDH, wave}; pg8::EpiQkv E2{XS, 6144, 2048, SB_QSCALE, 1.f};
                    pg8::gemm_phase<pg8::EpiQkv, LocalOrder, true, true>(lds + RING_OFF, g2, S2, E2); }
            } else if (!typeA && PHM(2)) { PREP(2) {
                const int N = (L == 2) ? 6144 : 2048;
                pg8::StaticOrder S; S.init(NTOK, N, G, bx);
                if (QKV8_B) { pg8::Gemm g{(const bf16*)HB8, (const bf16*)(ws + WS_WQKVB + (L == 2 ? (size_t)0 : (size_t)6144 * 2048)), NTOK, N, DM / 2, DM / 2, wave};
                    pg8::EpiRope E{QKV, 6144, 2048, 4096, DF_QSCALE, COS, SIN, 1.f / pg8::W8_SCALE};
                    pg8::gemm_phase<pg8::EpiRope, pg8::StaticOrder, true, true, true>(lds + RING_OFF, g, S, E); }
                else { pg8::Gemm g{HB, (const bf16*)(ws + WS_WQKVB) + (L == 2 ? (size_t)0 : (size_t)6144 * LDH), NTOK, N, DM, LDH, wave};
                    pg8::EpiRope E{QKV, 6144, 2048, 4096, DF_QSCALE, COS, SIN, 1.f};
                    pg8::gemm_phase<pg8::EpiRope, pg8::StaticOrder, true, true>(lds + RING_OFF, g, S, E); } }
            }
            SEAM(sb + 0);
        }
        if (IN(sb + 1)) {
            if (typeA && PHM(3)) {
                for (int id_ = vcu; id_ < 512 * (1 + ((PROBE_DUP >> 3) & 1)); id_ += G) { const int id = id_ & 511; const int bh = id >> 2, p = id & 3, b = bh >> 4, h = bh & 15;
                    const bf16* Qg = QKV + (size_t)b * SEQ * 6144 + h * 128; bf16* Og = (bf16*)((unsigned char*)OB + (size_t)b * SEQ * P8K2 + h * 128);
                    att::sb_block(Qg, Qg + 2048, Qg + 4096, Og, 7 - p, (att::ldsp)(lds + RING_OFF), wave);
                    att::sb_block(Qg, Qg + 2048, Qg + 4096, Og, p, (att::ldsp)(lds + RING_OFF), wave); }
            } else if (!typeA && PHM(4)) {
                const int lane = opq_tid(wave) & 63;
                const int i = L - 2; const float lam_init = (L == 2) ? 0.47071301834264183f : 0.5560582041556061f;
                const float* lp = args.in[6] + (size_t)i * 256;
                const float sa = dpp_sum(lp[lane] * lp[64 + lane]), sb2 = dpp_sum(lp[128 + lane] * lp[192 + lane]);
                const float lam = __builtin_amdgcn_exp2f(sa * LOG2E) - __builtin_amdgcn_exp2f(sb2 * LOG2E) + lam_init;
                const float* gsub = args.in[7] + (size_t)i * 128; const float gmul = 1.f - lam_init;
                for (int id_ = vcu; id_ < 512 * (1 + ((PROBE_DUP >> 4) & 1)); id_ += G) { const int id = id_ & 511; const int bh = id >> 2, p = id & 3, b = bh >> 4, h = bh & 15;
                    const bf16* Qg = QKV + (size_t)b * SEQ * 6144 + h * 128; bf16* Og = (bf16*)((unsigned char*)OB + (size_t)b * SEQ * P8K2 + h * 128); float* Sg = S1 + (size_t)b * SEQ * DM + h * 128;
#pragma unroll 1
                    for (int w = 0; w < 2; ++w) { const int qb = w ? p : 7 - p;
                        att::diff_pass<false>(Qg, Qg + 2048, Qg + 4096, Sg, Og, qb, lam, gsub, gmul, (att::ldsp)(lds + RING_OFF), wave);
                        att::diff_pass<true>(Qg + 64, Qg + 2048 + 64, Qg + 4096, Sg, Og, qb, lam, gsub, gmul, (att::ldsp)(lds + RING_OFF), wave); } }
            }
            SEAM(sb + 1);
        }
        if (IN(sb + 2)) { if (PHM(5)) {
            pg8::Gemm g{OB, (const bf16*)(ws + (typeA ? WS_WOA : WS_WOB) + (size_t)(L & 1) * 2048 * P8K2), NTOK, DM, DM / 2, P8K2 / 2, wave}; pg8::StaticOrder S; S.init(NTOK, DM, G, bx);
            pg8::EpiQkv E{MIX, DM, 0, 1.f, 1.f / (pg8::W8_SCALE * att::OB8_SCALE)};
            pg8::gemm_phase<pg8::EpiQkv, pg8::StaticOrder, true, true, true>(lds + RING_OFF, g, S, E); }
            SEAM(sb + 2);
        }
        if (IN(sb + 3)) { if (PHM(6)) {
            const int tid = opq_tid(wave), lane = tid & 63;
            const float* lng = args.in[8] + (size_t)L * DM; const float* lnb = args.in[9] + (size_t)L * DM; const float* wr = WR + (size_t)L * 20 * 2048;
            const float* hsrc = (L == 0) ? x_in : H;
            LAS int* eid = (LAS int*)(lds + LNX_OFF + 2048);
            LAS float* lgt = (LAS float*)(lds + LNX_OFF + 4096);
            LAS unsigned* rows8 = (LAS unsigned*)(lds + RING_OFF);
            for (int c = bx; c < 256; c += G) {
#pragma unroll 1
                for (int grp = 0; grp < 2; ++grp) {
                    const int rloc = wave * 8 + grp * 4; const size_t row0 = (size_t)64 * c + rloc;
                    f32x4 v[4][8]; float mu[4], rstd[4];
#pragma unroll
                    for (int rr = 0; rr < 4; ++rr) { const f32x4* hp = (const f32x4*)(hsrc + (row0 + rr) * DM) + lane; const v2u* mp = (const v2u*)(MIX + (row0 + rr) * DM) + lane;
#pragma unroll
                        for (int j = 0; j < 8; ++j) { const f32x4 h = hp[64 * j]; const v2u a = mp[64 * j];
                            const f32x4 fa = {__uint_as_float(a.x << 16), __uint_as_float(a.x & 0xffff0000u), __uint_as_float(a.y << 16), __uint_as_float(a.y & 0xffff0000u)};
                            v[rr][j] = h * DN_ALPHA + fa; } }
#pragma unroll
                    for (int rr = 0; rr < 4; ++rr) { float s = 0.f;
#pragma unroll
                        for (int j = 0; j < 8; ++j) s += (v[rr][j][0] + v[rr][j][1]) + (v[rr][j][2] + v[rr][j][3]);
                        mu[rr] = dpp_sum(s) * (1.f / DM); float q = 0.f;
#pragma unroll
                        for (int j = 0; j < 8; ++j) { const f32x4 d = v[rr][j] - mu[rr]; q += (d[0] * d[0] + d[1] * d[1]) + (d[2] * d[2] + d[3] * d[3]); }
                        rstd[rr] = 1.f / sqrtf(dpp_sum(q) * (1.f / DM) + LN_EPS); }
#pragma unroll
                    for (int j = 0; j < 8; ++j) { const f32x4 gg = ((const f32x4*)lng)[64 * j + lane], bb = ((const f32x4*)lnb)[64 * j + lane];
#pragma unroll
                        for (int rr = 0; rr < 4; ++rr) { v[rr][j] = (v[rr][j] - mu[rr]) * rstd[rr] * gg + bb; ((f32x4*)(H + (row0 + rr) * DM))[64 * j + lane] = v[rr][j];
                            if (c == bx) rows8[(rloc + rr) * 512 + 64 * j + lane] = pg8::pack4_fp8(v[rr][j][0], v[rr][j][1], v[rr][j][2], v[rr][j][3]); } }
#pragma unroll 1
                    for (int cc = 0; cc < 20; ++cc) { const f32x4* wp = (const f32x4*)(wr + cc * 2048) + lane; float a[4] = {0.f, 0.f, 0.f, 0.f};
#pragma unroll
                        for (int j = 0; j < 8; ++j) { const f32x4 w = wp[64 * j];
#pragma unroll
                            for (int rr = 0; rr < 4; ++rr) a[rr] += (v[rr][j][0] * w[0] + v[rr][j][1] * w[1]) + (v[rr][j][2] * w[2] + v[rr][j][3] * w[3]); }
#pragma unroll
                        for (int rr = 0; rr < 4; ++rr) a[rr] = dpp_sum(a[rr]);
                        if (lane == 0) { lgt[rloc * 20 + cc] = a[0]; lgt[(rloc + 1) * 20 + cc] = a[1]; lgt[(rloc + 2) * 20 + cc] = a[2]; lgt[(rloc + 3) * 20 + cc] = a[3]; } }
                }
                LDS_WAIT();
                if (lane < 8) {
                    const int rl = wave * 8 + lane; const LAS float* lg = lgt + rl * 20;
                    int gsel = 0; float gm = lg[0];
#pragma unroll
                    for (int i = 1; i < 4; ++i) { const float x = lg[i]; if (x > gm) { gm = x; gsel = i; } }
                    float gden = 0.f;
#pragma unroll
                    for (int i = 0; i < 4; ++i) gden += __builtin_amdgcn_exp2f((lg[i] - gm) * LOG2E);
                    const float gw_ = 1.f / gden;
                    const LAS float* li = lg + 4 + 4 * gsel;
                    const float l0 = li[0], l1 = li[1], l2 = li[2], l3 = li[3];
                    int i0 = 0; float v0 = l0;
                    if (l1 > v0) { v0 = l1; i0 = 1; } if (l2 > v0) { v0 = l2; i0 = 2; } if (l3 > v0) { v0 = l3; i0 = 3; }
                    int i1 = -1; float v1 = 0.f;
                    if (i0 != 0) { v1 = l0; i1 = 0; }
                    if (i0 != 1 && (i1 < 0 || l1 > v1)) { v1 = l1; i1 = 1; }
                    if (i0 != 2 && (i1 < 0 || l2 > v1)) { v1 = l2; i1 = 2; }
                    if (i0 != 3 && (i1 < 0 || l3 > v1)) { v1 = l3; i1 = 3; }
                    const float t = __builtin_amdgcn_exp2f((v1 - v0) * LOG2E); const float w0 = gw_ / (1.f + t), w1 = gw_ * t / (1.f + t);
                    eid[2 * rl] = gsel * 4 + i0; eid[2 * rl + 1] = gsel * 4 + i1; RW[(size_t)64 * c + rl] = (f32x2){w0, w1};
                }
                __syncthreads();
                if (wave == 0) {
                    const int ea = eid[lane], eb = eid[64 + lane]; int ra = 0, rb = 0, cnt = 0; const unsigned long long lt = (1ull << lane) - 1ull;
#pragma unroll
                    for (int e = 0; e < 16; ++e) { const unsigned long long ma = __ballot(ea == e), mb = __ballot(eb == e);
                        if (ea == e) ra = __popcll(ma & lt); if (eb == e) rb = __popcll(ma) + __popcll(mb & lt); if (lane == e) cnt = __popcll(ma) + __popcll(mb); }
                    if (lane < 16) CNT[c * 16 + lane] = cnt;
                    LAS int* rk = (LAS int*)(lds + LNX_OFF + 3072); rk[lane] = ra; rk[64 + lane] = rb; LDS_WAIT();
                    const int r = lane; const unsigned word = (unsigned)eid[2 * r] | ((unsigned)eid[2 * r + 1] << 8) | ((unsigned)rk[2 * r] << 16) | ((unsigned)rk[2 * r + 1] << 24);
                    RE[(size_t)64 * c + r] = word;
                }
                __syncthreads();
            } }
            SEAM(sb + 3);
        }
        if ((IN(sb + 4) || IN(sb + 5) || IN(sb + 6)) && PHM(7)) {
            const int tid = opq_tid(wave);
            LAS int* part = (LAS int*)(lds + LNX_OFF);
            { const int e = tid & 15, s = tid >> 4; int a = 0;
#pragma unroll
              for (int i = 0; i < 8; ++i) a += CNT[(8 * s + i) * 16 + e];
              part[s * 16 + e] = a; }
            __syncthreads();
            if (tid < 16) { int run = 0;
#pragma clang loop vectorize(disable) unroll(disable)
                for (int s = 0; s < 32; ++s) run += part[s * 16 + tid];
                TAB[tid] = run; }
            __syncthreads();
            if (tid == 0) { int off = 0, mt = 0;
#pragma clang loop vectorize(disable) unroll(disable)
                for (int e = 0; e < 16; ++e) { TAB[16 + e] = off; const int nt = (TAB[e] + 255) >> 8;
#pragma clang loop vectorize(disable) unroll(disable)
                    for (int i = 0; i < nt; ++i) TAB[64 + mt++] = e;
                    off += nt * 256; }
                TAB[32] = off; TAB[33] = mt; }
            __syncthreads();
        }
        if (IN(sb + 4)) { if (PHM(7)) PREP(7) {
            const int tid = opq_tid(wave), lane = tid & 63;
            LAS int* part = (LAS int*)(lds + LNX_OFF);
            for (int c = bx; c < 256; c += G) {
                if (tid < 16) { int pre = 0;
#pragma clang loop vectorize(disable) unroll(disable)
                    for (int s = 0; s < (c >> 3); ++s) pre += part[s * 16 + tid];
#pragma clang loop vectorize(disable) unroll(disable)
                    for (int cc = c & ~7; cc < c; ++cc) pre += CNT[cc * 16 + tid];
                    TAB[48 + tid] = TAB[16 + tid] + pre; }
                __syncthreads();
#pragma unroll 1
                for (int rr = 0; rr < 8; ++rr) { const size_t row = (size_t)64 * c + wave * 8 + rr; const unsigned word = RE[row];
                    const int p0 = TAB[48 + (word & 255)] + ((word >> 16) & 255), p1 = TAB[48 + ((word >> 8) & 255)] + (word >> 24);
                    if (lane == 0) { RP[2 * row] = p0; RP[2 * row + 1] = p1; }
                    if (c == bx && IN(sb + 3)) {
                        const LAS v4u* src = (const LAS v4u*)(lds + RING_OFF + (wave * 8 + rr) * 2048) + lane; v4u* o0 = (v4u*)((unsigned char*)XS + (size_t)p0 * P8K2) + lane; v4u* o1 = (v4u*)((unsigned char*)XS + (size_t)p1 * P8K2) + lane;
                        const v4u a = src[0], b = src[64]; o0[0] = a; o0[64] = b; o1[0] = a; o1[64] = b;
                    } else {
                        const f32x4* hp = (const f32x4*)(H + row * DM) + lane; unsigned* o0 = (unsigned*)((unsigned char*)XS + (size_t)p0 * P8K2) + lane; unsigned* o1 = (unsigned*)((unsigned char*)XS + (size_t)p1 * P8K2) + lane;
#pragma unroll
                        for (int j = 0; j < 8; ++j) { const f32x4 v = hp[64 * j]; const unsigned o = pg8::pack4_fp8(v[0], v[1], v[2], v[3]); o0[64 * j] = o; o1[64 * j] = o; } } }
                __syncthreads();
            } }
            SEAM(sb + 4);
        }
        if (IN(sb + 5)) { if (PHM(8)) PREP(8) {
            pg8::Gemm g{XS, (const bf16*)(ws + WS_WGU + (size_t)L * 16 * 2048 * P8K2), XS_ROWS, 2048, DM / 2, P8K2 / 2, wave};
            pg8::MoeOrder S{TAB[33] * 8, G, bx, TAB + 64}; pg8::EpiGateUp8 E{(unsigned char*)ACT};
            pg8::gemm_phase<pg8::EpiGateUp8, pg8::MoeOrder, true, true, true>(lds + RING_OFF, g, S, E); }
            SEAM(sb + 5);
        }
        if (IN(sb + 6)) { if (PHM(9)) PREP(9) {
            pg8::Gemm g{ACT, (const bf16*)(ws + WS_WDN + (size_t)L * 16 * 2048 * P8K1), XS_ROWS, 2048, DEXP / 2, P8K1 / 2, wave};
            pg8::MoeOrder S{TAB[33] * 8, G, bx, TAB + 64}; pg8::EpiDown8 E{(unsigned char*)YD};
            pg8::gemm_phase<pg8::EpiDown8, pg8::MoeOrder, true, true, true>(lds + RING_OFF, g, S, E); }
            SEAM(sb + 6);
        }
        if (IN(sb + 7)) { if (PHM(10)) for (int rep_ = 0; rep_ < ((((PROBE_DUP) >> 10) & 1) && L == NLAYER - 1 ? 5 : 1); ++rep_) {
            const int tid = opq_tid(wave), lane = tid & 63;
            const float* lng = args.in[10] + (size_t)L * DM; const float* lnb = args.in[11] + (size_t)L * DM; const bool last = (L == NLAYER - 1); const bool next8 = (L + 1 < 2) ? (QKV8_A != 0) : (QKV8_B != 0);
            const int gw = vcu * NWAVES + wave, NGW = G * NWAVES;
            for (int row = gw; row < NTOK; row += NGW) {
                const int p0 = RP[2 * row], p1 = RP[2 * row + 1]; const f32x2 w = RW[row];
                const f32x4* hp = (const f32x4*)(H + (size_t)row * DM) + lane; const unsigned* y0 = (const unsigned*)((const unsigned char*)YD + (size_t)p0 * DM) + lane; const unsigned* y1 = (const unsigned*)((const unsigned char*)YD + (size_t)p1 * DM) + lane;
                const float w0s = w.x * (1.f / pg8::YD8_SCALE), w1s = w.y * (1.f / pg8::YD8_SCALE);
                f32x4 v[8]; float s = 0.f;
#pragma unroll
                for (int j = 0; j < 8; ++j) { const f32x4 h = hp[64 * j]; const unsigned a = y0[64 * j], b = y1[64 * j];
                    const f32x2 a0 = __builtin_amdgcn_cvt_pk_f32_fp8((int)a, false), a1 = __builtin_amdgcn_cvt_pk_f32_fp8((int)a, true), b0 = __builtin_amdgcn_cvt_pk_f32_fp8((int)b, false), b1 = __builtin_amdgcn_cvt_pk_f32_fp8((int)b, true);
                    const f32x4 fa = {a0[0], a0[1], a1[0], a1[1]}, fb = {b0[0], b0[1], b1[0], b1[1]};
                    v[j] = h * DN_ALPHA + fa * w0s + fb * w1s; s += (v[j][0] + v[j][1]) + (v[j][2] + v[j][3]); }
                const float mu = dpp_sum(s) * (1.f / DM); float q = 0.f;
#pragma unroll
                for (int j = 0; j < 8; ++j) { const f32x4 d = v[j] - mu; q += (d[0] * d[0] + d[1] * d[1]) + (d[2] * d[2] + d[3] * d[3]); }
                const float rstd = 1.f / sqrtf(dpp_sum(q) * (1.f / DM) + LN_EPS);
                f32x4* op = (f32x4*)((last ? args.out : H) + (size_t)row * DM) + lane; v2u* ob = (v2u*)(HB + (size_t)row * LDH) + lane;
#pragma unroll
                for (int j = 0; j < 8; ++j) { const f32x4 gg = ((const f32x4*)lng)[64 * j + lane], bb = ((const f32x4*)lnb)[64 * j + lane];
                    const f32x4 y = (v[j] - mu) * rstd * gg + bb; op[64 * j] = y;
                    if (!last) { if (next8) ((unsigned*)(HB8 + (size_t)row * DM))[64 * j + lane] = pg8::pack4_fp8(y[0], y[1], y[2], y[3]);
                        else { v2u o; o.x = pk2(y[0], y[1]); o.y = pk2(y[2], y[3]); ob[64 * j] = o; } } }
            } }
            SEAM(sb + 7);
        }
    }
#undef IN
#undef SEAM
}

extern "C" void kernel_launch(void* const* d_in, const int* in_sizes, int n_in, void* d_out, int out_size, void* d_ws, size_t ws_size, hipStream_t stream) {
    static int grid = 0;
    if (grid == 0) {
        if (n_in != 17 || in_sizes[0] != NTOK * DM || out_size != NTOK * DM || ws_size < WS_END) { fprintf(stderr, "kernel_launch: unexpected shapes / workspace (n_in %d, ws %zu, need %zu)\n", n_in, ws_size, (size_t)WS_END); grid = -1; return; }
        int dev = 0, cus = 0, per_cu = 0;
        if (hipGetDevice(&dev) != hipSuccess || hipDeviceGetAttribute(&cus, hipDeviceAttributeMultiprocessorCount, dev) != hipSuccess) { grid = -1; return; }
        if (hipFuncSetAttribute((const void*)yoco_fwd, hipFuncAttributeMaxDynamicSharedMemorySize, LDS_BYTES) != hipSuccess) { fprintf(stderr, "kernel_launch: hipFuncSetAttribute failed\n"); grid = -1; return; }
        if (hipOccupancyMaxActiveBlocksPerMultiprocessor(&per_cu, (const void*)yoco_fwd, NWAVES * 64, LDS_BYTES) != hipSuccess || per_cu < 1) { fprintf(stderr, "kernel_launch: occupancy query says %d\n", per_cu); per_cu = 1; }
        (void)hipGetLastError();
        grid = cus;
    }
    if (grid < 0) return;
    (void)hipMemsetAsync((char*)d_ws + WS_CTL, 0, CTL_ZERO_BYTES, stream);
    Args a{};
    for (int i = 0; i < 17; ++i) a.in[i] = (const float*)d_in[i];
    a.out = (float*)d_out; a.ws = (unsigned char*)d_ws;
#if MK_MULTI
    for (int s = 0; s < NSTEPS; ++s) { a.s_lo = s; a.s_hi = s + 1; hipLaunchKernelGGL(yoco_fwd, dim3(grid), dim3(NWAVES * 64), LDS_BYTES, stream, a); }
#else
    a.s_lo = 0; a.s_hi = NSTEPS;
    hipLaunchKernelGGL(yoco_fwd, dim3(grid), dim3(NWAVES * 64), LDS_BYTES, stream, a);
#endif
    const hipError_t le = hipPeekAtLastError();
    if (le != hipSuccess) fprintf(stderr, "kernel_launch: launch failed: %s\n", hipGetErrorName(le));
}
```

```cpp
#include <hip/hip_runtime.h>
#include <cstdio>
#include <cstdint>

__device__ __forceinline__ int tid_from_wave(int wave) { int l; asm volatile("v_mbcnt_lo_u32_b32 %0, -1, 0\n\tv_mbcnt_hi_u32_b32 %0, -1, %0" : "=v"(l)); return wave * 64 + l; }
namespace pg8 {
#define PG8_LAS __attribute__((address_space(3)))
typedef unsigned short bf16_t;
typedef short bf16x8 __attribute__((ext_vector_type(8)));
typedef float f32x4 __attribute__((ext_vector_type(4)));
typedef unsigned u32x4 __attribute__((ext_vector_type(4)));
typedef int pg8_v8i __attribute__((ext_vector_type(8)));
typedef _Float16 pg8_h8 __attribute__((ext_vector_type(8)));
constexpr int BM = 256, BK = 64, HALF = 128, HTB = HALF * BK * 2  , STAGE_BYTES = 8 * HTB, NXCD = 8, WGM = 8;

__host__ __device__ __forceinline__ int lds_byte(int r, int c) { const int st = (r >> 4) * 2 + (c >> 5), rr = r & 15, cc = c & 31, ob = rr * 64 + cc * 2; return st * 1024 + (ob ^ (((ob >> 9) & 1) << 5)); }
__host__ __device__ __forceinline__ void stage_rc(int b, int& R, int& C) { const int st = b / 1024, sb = b % 1024, swz = sb ^ (((sb >> 9) & 1) << 5); R = (st >> 1) * 16 + swz / 64; C = (st & 1) * 32 + (swz % 64) / 2; }
__host__ __device__ __forceinline__ int perm32(int rho) { const int n = rho >> 4, i = rho & 15; return 8 * (i >> 2) + 4 * n + (i & 3); }

struct Unit { int pm, pn; };
struct Gemm { const bf16_t* A; const bf16_t* Bt; int M, N, K, ld, wave; };

struct StaticOrder {
    int nM, nN, nwg, G, c;
    __host__ __device__ void init(int M, int N, int G_, int c_) { nM = M / BM; nN = N / BM; nwg = nM * nN; G = G_; c = c_; }
    __host__ __device__ bool next(int i, Unit& u) const {
        const long L = (long)i * G + c; if (L >= nwg) return false;
        int wgid = (int)L; { const int q = nwg / NXCD, r = nwg % NXCD, xcd = wgid % NXCD, off = wgid / NXCD; wgid = (xcd < r ? xcd * (q + 1) : r * (q + 1) + (xcd - r) * q) + off; }
        const int nig = WGM * nN, gid = wgid / nig, fm = gid * WGM, gsz = (nM - fm) < WGM ? (nM - fm) : WGM;
        u.pm = fm + ((wgid % nig) % gsz); u.pn = (wgid % nig) / gsz; return true;
    }
    __device__ __forceinline__ void a_ready(const Unit&) const {}
    __device__ __forceinline__ void done(const Unit&) const {}
};

__device__ __forceinline__ unsigned cvt_pk_bf16(float lo, float hi) { unsigned r; asm volatile("v_cvt_pk_bf16_f32 %0, %1, %2" : "=v"(r) : "v"(lo), "v"(hi)); return r; }
typedef float f32x2 __attribute__((ext_vector_type(2)));

typedef unsigned u32x2 __attribute__((ext_vector_type(2)));
__device__ __forceinline__ u32x4 pack8_bf16(const f32x4 a, const f32x4 b) { u32x4 w; w.x = cvt_pk_bf16(a[0], a[1]); w.y = cvt_pk_bf16(a[2], a[3]); w.z = cvt_pk_bf16(b[0], b[1]); w.w = cvt_pk_bf16(b[2], b[3]); return w; }

struct EpiQkv {
    static constexpr bool PERM = true, AFTER_DRAIN = false;
    bf16_t* O; int ldc; int qcols; float qscale; float osc;
    __device__ __forceinline__ void operator()(const f32x4 (&acc)[2][2][4][2], const Unit& u, int wr, int wc, int fr, int fq) const {
        const int row0 = u.pm * BM + wr * 64 + fr, colt = u.pn * BM; const float sc = (colt < qcols ? qscale : 1.f) * osc;
        const int col0 = colt + wc * 32 + 8 * fq;
#pragma unroll
        for (int ai = 0; ai < 2; ++ai)
#pragma unroll
            for (int m = 0; m < 4; ++m) { bf16_t* rowp = O + (size_t)(row0 + ai * HALF + m * 16) * ldc + col0;
#pragma unroll
                for (int bj = 0; bj < 2; ++bj) *(u32x4*)(rowp + bj * HALF) = pack8_bf16(acc[ai][bj][m][0] * sc, acc[ai][bj][m][1] * sc); }
    }
};
template <int ACCS_INV> struct EpiResid {
    static constexpr bool PERM = false, AFTER_DRAIN = false;
    static constexpr int ldc = 2048; static constexpr float alpha = 1.6817928305074292f, accs = 1.f / (float)ACCS_INV;
    float* H; const float* Hsrc;
    __device__ __forceinline__ void operator()(const f32x4 (&acc)[2][2][4][2], const Unit& u, int wr, int wc, int fr, int fq) const {
        const int row0 = u.pm * BM + wr * 64 + fr, col0 = u.pn * BM + wc * 32 + 4 * fq;
#pragma unroll
        for (int ai = 0; ai < 2; ++ai)
#pragma unroll
            for (int m = 0; m < 4; ++m) { const size_t ro = (size_t)(row0 + ai * HALF + m * 16) * ldc + col0; float* rowp = H + ro; const float* srcp = Hsrc + ro;
#pragma unroll
                for (int bj = 0; bj < 2; ++bj)
#pragma unroll
                    for (int n = 0; n < 2; ++n) { const f32x4 h = *(const f32x4*)(srcp + bj * HALF + n * 16); *(f32x4*)(rowp + bj * HALF + n * 16) = h * alpha + acc[ai][bj][m][n] * accs; } }
    }
};
struct EpiRope {
    static constexpr bool PERM = true, AFTER_DRAIN = false;
    bf16_t* O; int ldc; int qcols, ropecols; float qscale; const float* ctab; const float* stab; float osc;
    __device__ __forceinline__ void operator()(const f32x4 (&acc)[2][2][4][2], const Unit& u, int wr, int wc, int fr, int fq) const {
        const int row0 = u.pm * BM + wr * 64 + fr, colt = u.pn * BM;
        if (colt >= ropecols) {
            const int col0 = colt + wc * 32 + 8 * fq;
#pragma unroll
            for (int ai = 0; ai < 2; ++ai)
#pragma unroll
                for (int m = 0; m < 4; ++m) { bf16_t* rowp = O + (size_t)(row0 + ai * HALF + m * 16) * ldc + col0;
#pragma unroll
                    for (int bj = 0; bj < 2; ++bj) *(u32x4*)(rowp + bj * HALF) = pack8_bf16(acc[ai][bj][m][0] * osc, acc[ai][bj][m][1] * osc); }
        } else {
            const float sc = (colt < qcols ? qscale : 1.f) * osc;
            const int col0 = colt + wc * 64 + 8 * fq;
#pragma unroll
            for (int ai = 0; ai < 2; ++ai)
#pragma unroll
                for (int m = 0; m < 4; ++m) { const int row = row0 + ai * HALF + m * 16; const int pos = row & 2047;
                    const f32x4 c0 = *(const f32x4*)(ctab + pos * 32 + 8 * fq), c1 = *(const f32x4*)(ctab + pos * 32 + 8 * fq + 4);
                    const f32x4 s0 = *(const f32x4*)(stab + pos * 32 + 8 * fq), s1 = *(const f32x4*)(stab + pos * 32 + 8 * fq + 4);
                    const f32x4 a0 = acc[ai][0][m][0], a1 = acc[ai][0][m][1], b0 = acc[ai][1][m][0], b1 = acc[ai][1][m][1];
                    bf16_t* rowp = O + (size_t)row * ldc + col0;
                    *(u32x4*)(rowp) = pack8_bf16((a0 * c0 - b0 * s0) * sc, (a1 * c1 - b1 * s1) * sc);
                    *(u32x4*)(rowp + 32) = pack8_bf16((b0 * c0 + a0 * s0) * sc, (b1 * c1 + a1 * s1) * sc);
                    asm volatile("" ::: "memory"); }
        }
    }
};
struct EpiGateUp {
    static constexpr bool PERM = true, AFTER_DRAIN = false;
    bf16_t* O;
    __device__ __forceinline__ void operator()(const f32x4 (&acc)[2][2][4][2], const Unit& u, int wr, int wc, int fr, int fq) const {
        const int row0 = u.pm * BM + wr * 64 + fr, col0 = (u.pn & 7) * 128 + wc * 32 + 8 * fq;
#pragma unroll
        for (int ai = 0; ai < 2; ++ai)
#pragma unroll
            for (int m = 0; m < 4; ++m) { f32x4 r[2];
#pragma unroll
                for (int n = 0; n < 2; ++n) { const f32x4 g = acc[ai][0][m][n], up = acc[ai][1][m][n];
#pragma unroll
                    for (int i = 0; i < 4; ++i) { const float e = __builtin_amdgcn_exp2f(g[i] * -1.4426950408889634f); r[n][i] = g[i] * __builtin_amdgcn_rcpf(1.f + e) * up[i]; } }
                *(u32x4*)(O + (size_t)(row0 + ai * HALF + m * 16) * 1024 + col0) = pack8_bf16(r[0], r[1]); }
    }
};
struct EpiDown {
    static constexpr bool PERM = true, AFTER_DRAIN = false;
    bf16_t* O;
    __device__ __forceinline__ void operator()(const f32x4 (&acc)[2][2][4][2], const Unit& u, int wr, int wc, int fr, int fq) const {
        const int row0 = u.pm * BM + wr * 64 + fr, col0 = (u.pn & 7) * BM + wc * 32 + 8 * fq;
#pragma unroll
        for (int ai = 0; ai < 2; ++ai)
#pragma unroll
            for (int m = 0; m < 4; ++m) { bf16_t* rowp = O + (size_t)(row0 + ai * HALF + m * 16) * 2048 + col0;
#pragma unroll
                for (int bj = 0; bj < 2; ++bj) *(u32x4*)(rowp + bj * HALF) = pack8_bf16(acc[ai][bj][m][0], acc[ai][bj][m][1]); }
    }
};
constexpr float W8_SCALE = 64.f, ACT8_SCALE = 4.f;
__device__ __forceinline__ unsigned pack4_fp8(float a, float b, float c, float d) { int w; asm volatile("" : "=v"(w));
    w = __builtin_amdgcn_cvt_pk_fp8_f32(a, b, w, false); w = __builtin_amdgcn_cvt_pk_fp8_f32(c, d, w, true); return (unsigned)w; }
struct EpiGateUp8 {
    static constexpr bool PERM = true, AFTER_DRAIN = false;
    unsigned char* O;
    __device__ __forceinline__ void operator()(const f32x4 (&acc)[2][2][4][2], const Unit& u, int wr, int wc, int fr, int fq) const {
        const int row0 = u.pm * BM + wr * 64 + fr, col0 = (u.pn & 7) * 128 + wc * 32 + 8 * fq;
        constexpr float SI = 1.f / W8_SCALE;
#pragma unroll
        for (int ai = 0; ai < 2; ++ai)
#pragma unroll
            for (int m = 0; m < 4; ++m) { f32x4 r[2];
#pragma unroll
                for (int n = 0; n < 2; ++n) { const f32x4 g = acc[ai][0][m][n] * SI, up = acc[ai][1][m][n] * (SI * ACT8_SCALE);
#pragma unroll
                    for (int i = 0; i < 4; ++i) { const float e = __builtin_amdgcn_exp2f(g[i] * -1.4426950408889634f); r[n][i] = g[i] * __builtin_amdgcn_rcpf(1.f + e) * up[i]; } }
                u32x2 w; w.x = pack4_fp8(r[0][0], r[0][1], r[0][2], r[0][3]); w.y = pack4_fp8(r[1][0], r[1][1], r[1][2], r[1][3]);
                *(u32x2*)(O + (size_t)(row0 + ai * HALF + m * 16) * 1024 + col0) = w; }
    }
};
constexpr float YD8_SCALE = 16.f;
struct EpiDown8 {
    static constexpr bool PERM = true, AFTER_DRAIN = false;
    unsigned char* O;
    __device__ __forceinline__ void operator()(const f32x4 (&acc)[2][2][4][2], const Unit& u, int wr, int wc, int fr, int fq) const {
        const int row0 = u.pm * BM + wr * 64 + fr, col0 = (u.pn & 7) * BM + wc * 32 + 8 * fq;
        constexpr float SI = YD8_SCALE / (W8_SCALE * ACT8_SCALE);
#pragma unroll
        for (int ai = 0; ai < 2; ++ai)
#pragma unroll
            for (int m = 0; m < 4; ++m) { unsigned char* rowp = O + (size_t)(row0 + ai * HALF + m * 16) * 2048 + col0;
#pragma unroll
                for (int bj = 0; bj < 2; ++bj) { const f32x4 a = acc[ai][bj][m][0] * SI, c = acc[ai][bj][m][1] * SI; u32x2 w; w.x = pack4_fp8(a[0], a[1], a[2], a[3]); w.y = pack4_fp8(c[0], c[1], c[2], c[3]);
                    *(u32x2*)(rowp + bj * HALF) = w; } }
    }
};
struct MoeOrder {
    int nunits, G, c; const PG8_LAS int* tile_e;
    __device__ __forceinline__ bool next(int i, Unit& u) const {
        int idx;
        if ((G & 7) == 0) { const int per = G >> 3; idx = (i * 8 + (c & 7)) * per + (c >> 3); } else idx = i * G + c;
        if (idx >= nunits) return false;
        const int mt = idx >> 3; u.pm = mt; u.pn = tile_e[mt] * 8 + (idx & 7); return true;
    }
    __device__ __forceinline__ void a_ready(const Unit&) const {}
    __device__ __forceinline__ void done(const Unit&) const {}
};

template <class Epi, class Sched, bool ALIGN_EPI = false, bool SP2 = false, bool F8 = false, bool F16 = false>
__device__ __forceinline__ void gemm_phase(PG8_LAS unsigned char* lds, const Gemm g, const Sched& S, const Epi& E) {
    int tid_ = tid_from_wave(g.wave); asm volatile("" : "+v"(tid_));
    const int tid = tid_, wid = __builtin_amdgcn_readfirstlane(tid >> 6), lane = tid & 63, wr = wid >> 2, wc = wid & 3, fr = lane & 15, fq = lane >> 4;
    const int K = g.K, LD = g.ld, nt = K / BK;
    unsigned voffA, voffB;
    { int R, C; stage_rc(tid * 16, R, C); const int Rb = Epi::PERM ? ((R & ~31) + perm32(R & 31)) : R;
        voffA = (unsigned)(R * LD + C) * 2u; voffB = (unsigned)(Rb * LD + C) * 2u; }
    const size_t pstep = (size_t)64 * LD * 2;
    const size_t kstep = (size_t)(BK * 2);
    const size_t hstep = (size_t)HALF * LD * 2;
    const size_t tstep = 2 * hstep;
    const unsigned ldsbase = (unsigned)(uintptr_t)lds;
    const unsigned ldsw = (unsigned)wid * 1024u;
    const int aoff = lds_byte(wr * 64 + fr, fq * 8), boff = lds_byte(wc * 32 + fr, fq * 8);
#define PG8_SA(b, h) (((b) * 2 + (h)) * HTB)
#define PG8_SB(b, h) ((4 + (b) * 2 + (h)) * HTB)
#define PG8_STAGE(bufoff, gbase, voff) do { _Pragma("unroll") for (int _i = 0; _i < 2; ++_i) { unsigned keep_; \
        asm volatile("s_mov_b32 %0, m0\n\ts_mov_b32 m0, %3\n\ts_nop 0\n\tglobal_load_lds_dwordx4 %1, %2\n\ts_mov_b32 m0, %0" : "=&s"(keep_) \
            : "v"(voff), "s"((const char*)(gbase) + _i * pstep), "s"(ldsbase + (unsigned)(bufoff) + ldsw + (unsigned)(_i * 8192))); } } while (0)
#define PG8_CAT(a, b) __builtin_bit_cast(pg8_v8i, __builtin_shufflevector(a, b, 0, 1, 2, 3, 4, 5, 6, 7, 8, 9, 10, 11, 12, 13, 14, 15))
#define PG8_LDA(dst, b, h) do { if constexpr (F8) { _Pragma("unroll") for (int m = 0; m < 4; ++m) { const bf16x8 lo_ = *(const PG8_LAS bf16x8*)(lds + PG8_SA(b, h) + aoff + m * 2048), hi_ = *(const PG8_LAS bf16x8*)(lds + PG8_SA(b, h) + aoff + m * 2048 + 1024); dst##8[m] = PG8_CAT(lo_, hi_); } } \
        else { _Pragma("unroll") for (int m = 0; m < 4; ++m) _Pragma("unroll") for (int k = 0; k < 2; ++k) dst[m][k] = *(const PG8_LAS bf16x8*)(lds + PG8_SA(b, h) + aoff + m * 2048 + k * 1024); } } while (0)
#define PG8_LDB(dst, b, h) do { if constexpr (F8) { _Pragma("unroll") for (int n = 0; n < 2; ++n) { const bf16x8 lo_ = *(const PG8_LAS bf16x8*)(lds + PG8_SB(b, h) + boff + n * 2048), hi_ = *(const PG8_LAS bf16x8*)(lds + PG8_SB(b, h) + boff + n * 2048 + 1024); dst##8[n] = PG8_CAT(lo_, hi_); } } \
        else { _Pragma("unroll") for (int n = 0; n < 2; ++n) _Pragma("unroll") for (int k = 0; k < 2; ++k) dst[n][k] = *(const PG8_LAS bf16x8*)(lds + PG8_SB(b, h) + boff + n * 2048 + k * 1024); } } while (0)
#define PG8_MMA(ai, bj, At, Bt) do { __builtin_amdgcn_s_setprio(1); \
        if constexpr (F8) { _Pragma("unroll") for (int m = 0; m < 4; ++m) _Pragma("unroll") for (int n = 0; n < 2; ++n) \
            acc[ai][bj][m][n] = __builtin_amdgcn_mfma_scale_f32_16x16x128_f8f6f4(Bt##8[n], At##8[m], acc[ai][bj][m][n], 0, 0, 0, 0, 0, 0); } \
        else { _Pragma("unroll") for (int m = 0; m < 4; ++m) _Pragma("unroll") for (int n = 0; n < 2; ++n) _Pragma("unroll") for (int k = 0; k < 2; ++k) \
            acc[ai][bj][m][n] = F16 ? __builtin_amdgcn_mfma_f32_16x16x32_f16(__builtin_bit_cast(pg8_h8, Bt[n][k]), __builtin_bit_cast(pg8_h8, At[m][k]), acc[ai][bj][m][n], 0, 0, 0) \
                                    : __builtin_amdgcn_mfma_f32_16x16x32_bf16(Bt[n][k], At[m][k], acc[ai][bj][m][n], 0, 0, 0); } \
        __builtin_amdgcn_s_setprio(0); } while (0)
#define PG8_WAIT_V(n) asm volatile("s_waitcnt vmcnt(" #n ")" ::: "memory")
#define PG8_WAIT_L(n) asm volatile("s_waitcnt lgkmcnt(" #n ")" ::: "memory")
#define PG8_BAR __builtin_amdgcn_s_barrier()
#define PG8_SCHED __builtin_amdgcn_sched_barrier(0)
    Unit cur, nxt; int ui = 0;
    if (!S.next(0, cur)) return;
    f32x4 acc[2][2][4][2];
{ float zero_; asm volatile("v_mov_b32 %0, 0" : "=v"(zero_));
#pragma unroll
    for (int a = 0; a < 2; ++a)
#pragma unroll
        for (int b = 0; b < 2; ++b)
#pragma unroll
            for (int m = 0; m < 4; ++m)
#pragma unroll
                for (int n = 0; n < 2; ++n) acc[a][b][m][n] = (f32x4){zero_, zero_, zero_, zero_}; }
    bf16x8 At[4][2], B0[2][2], B1[2][2]; pg8_v8i At8[4], B08[2], B18[2];
    const char* cA = (const char*)g.A + (size_t)cur.pm * tstep; const char* cB = (const char*)g.Bt + (size_t)cur.pn * tstep;
    S.a_ready(cur);
    if constexpr (SP2) {
        PG8_STAGE(PG8_SB(0, 0), cB, voffB); PG8_STAGE(PG8_SB(0, 1), cB + hstep, voffB); PG8_STAGE(PG8_SA(0, 0), cA, voffA); PG8_STAGE(PG8_SA(0, 1), cA + hstep, voffA);
        if (wr == 1) PG8_BAR;
        PG8_WAIT_V(2); PG8_BAR;
        PG8_STAGE(PG8_SB(1, 0), cB + kstep, voffB); PG8_STAGE(PG8_SA(1, 0), cA + kstep, voffA); PG8_STAGE(PG8_SB(1, 1), cB + hstep + kstep, voffB);
        PG8_WAIT_V(6); PG8_BAR;
    } else {
        PG8_STAGE(PG8_SB(0, 0), cB, voffB); PG8_STAGE(PG8_SA(0, 0), cA, voffA); PG8_STAGE(PG8_SB(0, 1), cB + hstep, voffB); PG8_STAGE(PG8_SA(0, 1), cA + hstep, voffA);
        if (wr == 1) PG8_BAR;
        PG8_WAIT_V(4); PG8_BAR;
        PG8_STAGE(PG8_SB(1, 0), cB + kstep, voffB); PG8_STAGE(PG8_SA(1, 0), cA + kstep, voffA); PG8_STAGE(PG8_SB(1, 1), cB + hstep + kstep, voffB);
        PG8_WAIT_V(6); PG8_BAR;
    }
    for (;;) {
        const bool has_next = S.next(ui + 1, nxt);
        const char* nA = has_next ? (const char*)g.A + (size_t)nxt.pm * tstep : cA; const char* nB = has_next ? (const char*)g.Bt + (size_t)nxt.pn * tstep : cB;
#pragma unroll 1
        for (int t = 0; t < nt; t += 2) {
            const bool last = (t == nt - 2);
            const char* a1 = cA + (size_t)(t + 1) * kstep;
            const char* a2 = last ? nA : cA + (size_t)(t + 2) * kstep; const char* b2 = last ? nB : cB + (size_t)(t + 2) * kstep;
            const char* a3 = a2 + kstep; const char* b3 = b2 + kstep;
            if (last && has_next) S.a_ready(nxt);
            if constexpr (SP2) {
            PG8_LDB(B0, 0, 0); PG8_LDB(B1, 0, 1); PG8_SCHED; PG8_LDA(At, 0, 0); PG8_STAGE(PG8_SA(1, 1), a1 + hstep, voffA);
            PG8_WAIT_V(8); PG8_WAIT_L(0); PG8_BAR; PG8_MMA(0, 0, At, B0); PG8_MMA(0, 1, At, B1); PG8_BAR; PG8_SCHED;
            PG8_LDA(At, 0, 1); PG8_STAGE(PG8_SB(0, 0), b2, voffB); PG8_STAGE(PG8_SB(0, 1), b2 + hstep, voffB); PG8_STAGE(PG8_SA(0, 0), a2, voffA);
            PG8_WAIT_V(8); PG8_WAIT_L(0); PG8_BAR; PG8_MMA(1, 0, At, B0); PG8_MMA(1, 1, At, B1); PG8_BAR; PG8_SCHED;
            PG8_LDB(B0, 1, 0); PG8_LDB(B1, 1, 1); PG8_SCHED; PG8_LDA(At, 1, 0); PG8_STAGE(PG8_SA(0, 1), a2 + hstep, voffA);
            PG8_WAIT_V(8); PG8_WAIT_L(0); PG8_BAR; PG8_MMA(0, 0, At, B0); PG8_MMA(0, 1, At, B1); PG8_BAR; PG8_SCHED;
            PG8_LDA(At, 1, 1); PG8_STAGE(PG8_SB(1, 0), b3, voffB); PG8_STAGE(PG8_SB(1, 1), b3 + hstep, voffB); PG8_STAGE(PG8_SA(1, 0), a3, voffA);
            PG8_WAIT_V(8); PG8_WAIT_L(0); PG8_BAR; PG8_MMA(1, 0, At, B0); PG8_MMA(1, 1, At, B1); PG8_BAR; PG8_SCHED;
            } else {
            PG8_LDB(B0, 0, 0); PG8_SCHED; PG8_LDA(At, 0, 0); PG8_STAGE(PG8_SA(1, 1), a1 + hstep, voffA);
            PG8_WAIT_L(8); PG8_BAR; PG8_WAIT_L(0); PG8_MMA(0, 0, At, B0); PG8_BAR; PG8_SCHED;
            PG8_LDB(B1, 0, 1); PG8_STAGE(PG8_SB(0, 0), b2, voffB);
            PG8_BAR; PG8_WAIT_L(0); PG8_MMA(0, 1, At, B1); PG8_BAR;
            PG8_LDA(At, 0, 1); PG8_STAGE(PG8_SA(0, 0), a2, voffA);
            PG8_BAR; PG8_WAIT_L(0); PG8_MMA(1, 0, At, B0); PG8_BAR; PG8_SCHED;
            PG8_STAGE(PG8_SB(0, 1), b2 + hstep, voffB);
            PG8_WAIT_V(6); PG8_BAR; PG8_MMA(1, 1, At, B1); PG8_BAR;
            PG8_LDB(B0, 1, 0); PG8_SCHED; PG8_LDA(At, 1, 0); PG8_STAGE(PG8_SA(0, 1), a2 + hstep, voffA);
            PG8_WAIT_L(8); PG8_BAR; PG8_WAIT_L(0); PG8_MMA(0, 0, At, B0); PG8_BAR; PG8_SCHED;
            PG8_LDB(B1, 1, 1); PG8_STAGE(PG8_SB(1, 0), b3, voffB);
            PG8_BAR; PG8_WAIT_L(0); PG8_MMA(0, 1, At, B1); PG8_BAR;
            PG8_LDA(At, 1, 1); PG8_STAGE(PG8_SA(1, 0), a3, voffA);
            PG8_BAR; PG8_WAIT_L(0); PG8_MMA(1, 0, At, B0); PG8_BAR; PG8_SCHED;
            PG8_STAGE(PG8_SB(1, 1), b3 + hstep, voffB);
            PG8_WAIT_V(6); PG8_BAR; PG8_MMA(1, 1, At, B1); PG8_BAR;
            }
        }
        if constexpr (ALIGN_EPI) { if (wr == 0) PG8_BAR; }
        if constexpr (!Epi::AFTER_DRAIN) { const int t2_ = tid_from_wave(g.wave);
            E(acc, cur, wr, wc, t2_ & 15, (t2_ >> 4) & 3); S.done(cur); }
        if (!has_next) break;
{ float zero_; asm volatile("v_mov_b32 %0, 0" : "=v"(zero_));
#pragma unroll
        for (int a = 0; a < 2; ++a)
#pragma unroll
            for (int b = 0; b < 2; ++b)
#pragma unroll
                for (int m = 0; m < 4; ++m)
#pragma unroll
                    for (int n = 0; n < 2; ++n) acc[a][b][m][n] = (f32x4){zero_, zero_, zero_, zero_}; }
        cur = nxt; cA = nA; cB = nB; ++ui;
        if constexpr (ALIGN_EPI) { if (wr == 1) PG8_BAR; }
    }
    PG8_WAIT_V(0);
    if constexpr (!ALIGN_EPI) { if (wr == 0) PG8_BAR; }
    PG8_BAR;
    if constexpr (Epi::AFTER_DRAIN) { E.fused(acc, cur, wr, wc, fr, fq, lds, wid, lane); S.done(cur); }
#undef PG8_SA
#undef PG8_SB
#undef PG8_STAGE
#undef PG8_LDA
#undef PG8_LDB
#undef PG8_MMA
#undef PG8_CAT
#undef PG8_WAIT_V
#undef PG8_WAIT_L
#undef PG8_BAR
#undef PG8_SCHED
}
}

namespace att {
#define ALAS __attribute__((address_space(3)))
typedef unsigned short bf16_t;
typedef short bf16x8 __attribute__((ext_vector_type(8)));
typedef short s16x4 __attribute__((ext_vector_type(4)));
typedef float f32x16 __attribute__((ext_vector_type(16)));
typedef float f32x4 __attribute__((ext_vector_type(4)));
typedef unsigned u32x4 __attribute__((ext_vector_type(4)));
typedef ALAS char* ldsp;
#ifndef WO_F8
#define WO_F8 1
#endif
constexpr float OB8_SCALE = 8.f;
constexpr int QP = 6144;
constexpr int OP = 2048;
constexpr int OBP = 2048;
constexpr int SHM_V = 16384, SHM_K = 16384;
constexpr int LDS_V = 0, LDS_K = 2 * SHM_V, LDS_WS = LDS_K + 2 * SHM_K, ATT_LDS_BYTES = LDS_WS + 8 * 256;
#define KSWZ(row, colB) ((row) * 256 + ((colB) ^ (((row) & 7) << 4)))
#define KSWZ64(row, colB) ((row) * 128 + ((colB) ^ (((row) & 7) << 4)))
#define SBAR() __builtin_amdgcn_sched_barrier(0)
__device__ __forceinline__ int v_st(int k, int c) { const int kk = (k & ~0xC) | ((k & 4) << 1) | ((k & 8) >> 1); return ((kk >> 3) * 4 + (c >> 5)) * 512 + ((kk & 7) * 32 + (c & 31)) * 2; }
__device__ __forceinline__ int v_rd_base(int lane) { return ((lane & 3) << 3) | (((lane >> 2) & 3) << 6) | (((lane >> 4) & 1) << 5) | (((lane >> 5) & 1) << 8); }
constexpr int v_rd_off(int d0, int ks, int half) { return d0 * 512 + ks * 4096 + half * 2048; }
__device__ __forceinline__ int crow(int r, int hi) { return (r & 3) + 8 * (r >> 2) + 4 * hi; }
__device__ __forceinline__ unsigned cvtpk(float lo, float hi) { unsigned r; asm volatile("v_cvt_pk_bf16_f32 %0, %1, %2" : "=v"(r) : "v"(lo), "v"(hi)); return r; }
__device__ __forceinline__ bf16x8 ldg8(const bf16_t* p) { return *reinterpret_cast<const bf16x8*>(p); }
__device__ __forceinline__ unsigned quad_pack_fp8(float v) {
    const int b = __builtin_bit_cast(int, v);
    const float v1 = __builtin_bit_cast(float, __builtin_amdgcn_update_dpp(b, b, 0x55, 0xf, 0xf, false));
    const float v2 = __builtin_bit_cast(float, __builtin_amdgcn_update_dpp(b, b, 0xAA, 0xf, 0xf, false));
    const float v3 = __builtin_bit_cast(float, __builtin_amdgcn_update_dpp(b, b, 0xFF, 0xf, 0xf, false));
    int w; asm volatile("" : "=v"(w));
    w = __builtin_amdgcn_cvt_pk_fp8_f32(v, v1, w, false); w = __builtin_amdgcn_cvt_pk_fp8_f32(v2, v3, w, true); return (unsigned)w;
}
__device__ __forceinline__ float xhalf(float v, int hi) {
    auto rr = __builtin_amdgcn_permlane32_swap(__float_as_uint(v), __float_as_uint(v), false, false);
    return __uint_as_float(hi ? rr[0] : rr[1]);
}
#define ATT_PK4(P, B_, OUT) do { unsigned a0 = cvtpk(P[B_+0], P[B_+1]), a1 = cvtpk(P[B_+2], P[B_+3]);                      \
        unsigned b0 = cvtpk(P[B_+4], P[B_+5]), b1 = cvtpk(P[B_+6], P[B_+7]);                                             \
        auto r0 = __builtin_amdgcn_permlane32_swap(a0, b0, false, false); auto r1 = __builtin_amdgcn_permlane32_swap(a1, b1, false, false); \
        u32x4 w = {r0[0], r1[0], r0[1], r1[1]}; OUT = *reinterpret_cast<bf16x8*>(&w); } while (0)
__device__ __forceinline__ void pv_tile(f32x16* o, int vb, bf16x8 pa0, bf16x8 pa1, bf16x8 pa2, bf16x8 pa3) {
#define TRRD(dst, off) asm volatile("ds_read_b64_tr_b16 %0, %1 offset:%2" : "=&v"(dst) : "v"(vb), "i"(off) : "memory")
#define PV_D0(d0) do { s16x4 l0, l1, l2, l3, h0, h1, h2, h3; constexpr int b_ = v_rd_off(d0, 0, 0); \
        TRRD(l0, b_); TRRD(h0, b_ + 2048); TRRD(l1, b_ + 4096); TRRD(h1, b_ + 6144); TRRD(l2, b_ + 8192); TRRD(h2, b_ + 10240); TRRD(l3, b_ + 12288); TRRD(h3, b_ + 14336); \
        asm volatile("s_waitcnt lgkmcnt(0)" ::: "memory"); SBAR(); \
        o[d0] = __builtin_amdgcn_mfma_f32_32x32x16_bf16(pa0, (bf16x8){l0[0], l0[1], l0[2], l0[3], h0[0], h0[1], h0[2], h0[3]}, o[d0], 0, 0, 0);   \
        o[d0] = __builtin_amdgcn_mfma_f32_32x32x16_bf16(pa1, (bf16x8){l1[0], l1[1], l1[2], l1[3], h1[0], h1[1], h1[2], h1[3]}, o[d0], 0, 0, 0);   \
        o[d0] = __builtin_amdgcn_mfma_f32_32x32x16_bf16(pa2, (bf16x8){l2[0], l2[1], l2[2], l2[3], h2[0], h2[1], h2[2], h2[3]}, o[d0], 0, 0, 0);   \
        o[d0] = __builtin_amdgcn_mfma_f32_32x32x16_bf16(pa3, (bf16x8){l3[0], l3[1], l3[2], l3[3], h3[0], h3[1], h3[2], h3[3]}, o[d0], 0, 0, 0); } while (0)
    PV_D0(0); PV_D0(1); PV_D0(2); PV_D0(3);
#undef PV_D0
#undef TRRD
}

__device__ __forceinline__ void sb_block(const bf16_t* __restrict__ Qg, const bf16_t* __restrict__ Kg, const bf16_t* __restrict__ Vg, bf16_t* __restrict__ Og, int qb, ldsp lds, int wave_) {
    int tid_ = tid_from_wave(wave_); asm volatile("" : "+v"(tid_));
    const int tid = tid_, wid = __builtin_amdgcn_readfirstlane(tid >> 6), lane = tid & 63, r32 = lane & 31, hi = lane >> 5;
    const int NT = 4 * qb + 4, R0 = 256 * qb + 32 * wid, myrow = R0 + r32;
    const ldsp V_lds = lds + LDS_V; const ldsp K_lds = lds + LDS_K;
    bf16x8 qr[8];
    { const bf16_t* Qw = Qg + (size_t)R0 * QP; const unsigned qoff = (unsigned)(r32 * QP + hi * 8);
#pragma unroll
      for (int d0 = 0; d0 < 8; ++d0) qr[d0] = ldg8(Qw + (qoff + d0 * 16)); }
    const int sr = tid >> 4, sc = (tid & 15) * 8, kws = KSWZ(sr, sc * 2), vst0 = v_st(sr, sc), vst1 = v_st(32 + sr, sc);
    const unsigned kvoff = (unsigned)(sr * QP + sc);
    const int vb0 = (int)(unsigned)(uintptr_t)V_lds + v_rd_base(lane);
    bf16x8 sk0, sk1, sv0, sv1;
#define SB_LOAD(j) do { const bf16_t* kp_ = Kg + (size_t)(64 * (j)) * QP; const bf16_t* vp_ = Vg + (size_t)(64 * (j)) * QP; \
        sk0 = ldg8(kp_ + kvoff); sk1 = ldg8(kp_ + (size_t)32 * QP + kvoff); sv0 = ldg8(vp_ + kvoff); sv1 = ldg8(vp_ + (size_t)32 * QP + kvoff); } while (0)
#define SB_WRITE(bf) do { *(ALAS bf16x8*)(K_lds + (bf) * SHM_K + kws) = sk0; *(ALAS bf16x8*)(K_lds + (bf) * SHM_K + kws + 32 * 256) = sk1; \
        *(ALAS bf16x8*)(V_lds + (bf) * SHM_V + vst0) = sv0; *(ALAS bf16x8*)(V_lds + (bf) * SHM_V + vst1) = sv1; } while (0)
    SB_LOAD(NT - 1); SB_WRITE(0);
    __syncthreads();
    float carry = 0.f; f32x16 o[4] = {};
    ALAS int* fl = (ALAS int*)(lds + LDS_WS); bool wdone = false;
    for (int t = 0; t < NT; ++t) {
        const int j = NT - 1 - t, buf = t & 1, kb = 64 * j;
        if (t + 1 < NT) SB_LOAD(j - 1);
        if (kb <= R0 + 30 && !wdone) {
            f32x16 p0 = {}, p1 = {};
            { const ldsp Kb = K_lds + buf * SHM_K;
#pragma unroll
              for (int d0 = 0; d0 < 8; ++d0) { const ldsp a = Kb + KSWZ(r32, ((d0 & 3) * 16 + hi * 8) * 2) + (d0 >> 2) * 128;
                  const bf16x8 b0 = *(const ALAS bf16x8*)a, b1 = *(const ALAS bf16x8*)(a + 32 * 256);
                  p0 = __builtin_amdgcn_mfma_f32_32x32x16_bf16(b0, qr[d0], p0, 0, 0, 0);
                  p1 = __builtin_amdgcn_mfma_f32_32x32x16_bf16(b1, qr[d0], p1, 0, 0, 0); } }
            f32x16 lb0, lb1;
#pragma unroll
            for (int r = 0; r < 16; ++r) {
                { const float z = p0[r]; const float e = __builtin_amdgcn_exp2f(-__builtin_fabsf(z)); const float sp = __builtin_fmaxf(z, 0.f) + __builtin_amdgcn_logf(1.f + e); p0[r] = -sp; lb0[r] = z - sp; }
                { const float z = p1[r]; const float e = __builtin_amdgcn_exp2f(-__builtin_fabsf(z)); const float sp = __builtin_fmaxf(z, 0.f) + __builtin_amdgcn_logf(1.f + e); p1[r] = -sp; lb1[r] = z - sp; }
            }
            if (kb + 63 >= R0) {
                const int dq = myrow - kb - 4 * hi; const float NEG = -__builtin_inff();
#pragma unroll
                for (int r = 0; r < 16; ++r) { const int c = (r & 3) + 8 * (r >> 2);
                    if (c >= dq) { p0[r] = 0.f; lb0[r] = NEG; }
                    if (c + 32 >= dq) { p1[r] = 0.f; lb1[r] = NEG; } }
            }
            float gs[8], go[8];
#pragma unroll
            for (int g = 0; g < 4; ++g) { gs[g] = (p0[4 * g] + p0[4 * g + 1]) + (p0[4 * g + 2] + p0[4 * g + 3]); gs[4 + g] = (p1[4 * g] + p1[4 * g + 1]) + (p1[4 * g + 2] + p1[4 * g + 3]); }
#pragma unroll
            for (int i = 0; i < 8; ++i) go[i] = xhalf(gs[i], hi);
            float acc = carry;
#pragma unroll
            for (int idx = 7; idx >= 0; --idx) { const int g = idx & 3; const float base = acc + (hi ? 0.f : go[idx]);
                if (idx >= 4) { const float t3 = base, t2 = t3 + p1[4 * g + 3], t1 = t2 + p1[4 * g + 2], t0 = t1 + p1[4 * g + 1];
                    lb1[4 * g + 3] = __builtin_amdgcn_exp2f(lb1[4 * g + 3] + t3); lb1[4 * g + 2] = __builtin_amdgcn_exp2f(lb1[4 * g + 2] + t2);
                    lb1[4 * g + 1] = __builtin_amdgcn_exp2f(lb1[4 * g + 1] + t1); lb1[4 * g] = __builtin_amdgcn_exp2f(lb1[4 * g] + t0); }
                else { const float t3 = base, t2 = t3 + p0[4 * g + 3], t1 = t2 + p0[4 * g + 2], t0 = t1 + p0[4 * g + 1];
                    lb0[4 * g + 3] = __builtin_amdgcn_exp2f(lb0[4 * g + 3] + t3); lb0[4 * g + 2] = __builtin_amdgcn_exp2f(lb0[4 * g + 2] + t2);
                    lb0[4 * g + 1] = __builtin_amdgcn_exp2f(lb0[4 * g + 1] + t1); lb0[4 * g] = __builtin_amdgcn_exp2f(lb0[4 * g] + t0); }
                acc += gs[idx] + go[idx]; }
            carry = acc;
            bf16x8 pa0, pa1, pa2, pa3;
            ATT_PK4(lb0, 0, pa0); ATT_PK4(lb0, 8, pa1); ATT_PK4(lb1, 0, pa2); ATT_PK4(lb1, 8, pa3);
            SBAR();
            pv_tile(o, vb0 + buf * SHM_V, pa0, pa1, pa2, pa3);
            wdone = __all(carry < -127.f);
        }
        if (lane == 0) fl[buf * 8 + wid] = wdone ? 1 : 0;
        if (t + 1 < NT) SB_WRITE(buf ^ 1);
        __syncthreads();
        { const ALAS int* f = fl + buf * 8; if ((f[0] & f[1] & f[2] & f[3] & f[4] & f[5] & f[6] & f[7]) != 0) break; }
    }
#undef SB_LOAD
#undef SB_WRITE
#if WO_F8
    unsigned char* Ow = (unsigned char*)Og + (size_t)R0 * OBP; const unsigned ooff = (unsigned)(4 * hi * OBP + r32);
#pragma unroll
    for (int r = 0; r < 16; ++r) { unsigned char* rowp = Ow + (size_t)((r & 3) + 8 * (r >> 2)) * OBP;
#pragma unroll
        for (int d0 = 0; d0 < 4; ++d0) { const unsigned w = quad_pack_fp8(o[d0][r] * OB8_SCALE);
            if ((r32 & 3) == 0) *(unsigned*)(rowp + (ooff + d0 * 32)) = w; } }
#else
    bf16_t* Ow = Og + (size_t)R0 * OP; const unsigned ooff = (unsigned)(4 * hi * OP + r32);
#pragma unroll
    for (int r = 0; r < 16; ++r) { bf16_t* rowp = Ow + (size_t)((r & 3) + 8 * (r >> 2)) * OP;
#pragma unroll
        for (int d0 = 0; d0 < 4; ++d0) { const float v = o[d0][r]; const float vn = __shfl_xor(v, 1);
            if ((r32 & 1) == 0) *(unsigned*)(rowp + (ooff + d0 * 32)) = cvtpk(v, vn); } }
#endif
}

constexpr float ATT_THR = 8.f;
__device__ __forceinline__ void qkt64(f32x16& p0, f32x16& p1, ldsp Kb, int r32, int hi, const bf16x8* qr) {
    p0 = f32x16{}; p1 = f32x16{};
#pragma unroll
    for (int d0 = 0; d0 < 4; ++d0) { const ldsp a = Kb + KSWZ64(r32, (d0 * 16 + hi * 8) * 2);
        const bf16x8 b0 = *(const ALAS bf16x8*)a, b1 = *(const ALAS bf16x8*)(a + 32 * 128);
        p0 = __builtin_amdgcn_mfma_f32_32x32x16_bf16(b0, qr[d0], p0, 0, 0, 0);
        p1 = __builtin_amdgcn_mfma_f32_32x32x16_bf16(b1, qr[d0], p1, 0, 0, 0); }
}
__device__ __forceinline__ void partial_sm(f32x16& p0, f32x16& p1, float& m_reg, float& alpha, int hi) {
    float pmax = p0[0];
#pragma unroll
    for (int r = 1; r < 16; ++r) pmax = __builtin_fmaxf(pmax, p0[r]);
#pragma unroll
    for (int r = 0; r < 16; ++r) pmax = __builtin_fmaxf(pmax, p1[r]);
    pmax = __builtin_fmaxf(pmax, xhalf(pmax, hi));
    float mn;
    if (__builtin_expect(__all(pmax - m_reg <= ATT_THR), 1)) { mn = m_reg; alpha = 1.f; }
    else { mn = __builtin_fmaxf(m_reg, pmax); alpha = __builtin_amdgcn_exp2f(m_reg - mn); m_reg = mn; }
#pragma unroll
    for (int r = 0; r < 16; ++r) { p0[r] -= mn; p1[r] -= mn; }
#pragma unroll
    for (int r = 0; r < 16; ++r) p0[r] = __builtin_amdgcn_exp2f(p0[r]);
}
__device__ __forceinline__ void finish_sm(f32x16& p0, f32x16& p1, float alpha, float& l_reg, bf16x8& pa0, bf16x8& pa1, bf16x8& pa2, bf16x8& pa3, int hi) {
#pragma unroll
    for (int r = 0; r < 16; ++r) p1[r] = __builtin_amdgcn_exp2f(p1[r]);
    float ps = 0.f;
#pragma unroll
    for (int r = 0; r < 16; ++r) ps += p0[r];
#pragma unroll
    for (int r = 0; r < 16; ++r) ps += p1[r];
    ps += xhalf(ps, hi);
    l_reg = l_reg * alpha + ps;
    ATT_PK4(p0, 0, pa0); ATT_PK4(p0, 8, pa1); ATT_PK4(p1, 0, pa2); ATT_PK4(p1, 8, pa3);
}
__device__ __forceinline__ void mask_gt(f32x16& p0, f32x16& p1, int dq) {
    const float NEG = -__builtin_inff();
#pragma unroll
    for (int r = 0; r < 16; ++r) { const int c = (r & 3) + 8 * (r >> 2);
        if (c > dq) p0[r] = NEG;
        if (c + 32 > dq) p1[r] = NEG; }
}
template <bool SECOND>
__device__ __forceinline__ void diff_pass(const bf16_t* __restrict__ Qg, const bf16_t* __restrict__ Kg, const bf16_t* __restrict__ Vg, float* S1, bf16_t* __restrict__ Og,
                                          int qb, float lam, const float* __restrict__ gsub, float gmul, ldsp lds, int wave_) {
    int tid_ = tid_from_wave(wave_); asm volatile("" : "+v"(tid_));
    const int tid = tid_, wid = __builtin_amdgcn_readfirstlane(tid >> 6), lane = tid & 63, r32 = lane & 31, hi = lane >> 5;
    const int NT = 4 * qb + 4, R0 = 256 * qb + 32 * wid, myrow = R0 + r32;
    const ldsp V_lds = lds + LDS_V; const ldsp K_lds = lds + LDS_K;
    ALAS float* wsf = (ALAS float*)(lds + LDS_WS) + wid * 64; ALAS float* li_l = wsf; ALAS float* al_l = wsf + 32;
    bf16x8 qr[4];
    { const bf16_t* Qw = Qg + (size_t)R0 * QP; const unsigned qoff = (unsigned)(r32 * QP + hi * 8);
#pragma unroll
      for (int d0 = 0; d0 < 4; ++d0) qr[d0] = ldg8(Qw + (qoff + d0 * 16)); }
    const int sr = tid >> 4, sc = (tid & 15) * 8, vst0 = v_st(sr, sc), vst1 = v_st(32 + sr, sc);
    const int kr = tid >> 3, kc = (tid & 7) * 8, kws = KSWZ64(kr, kc * 2);
    const unsigned voff = (unsigned)(sr * QP + sc), koff = (unsigned)(kr * QP + kc);
    const int vb0 = (int)(unsigned)(uintptr_t)V_lds + v_rd_base(lane);
    const int qm = myrow - 4 * hi;
    bf16x8 sk0A, sv0A, sv1A, sk0B, sv0B, sv1B;
#define DF_LOAD(S_, j) do { const bf16_t* vp_ = Vg + (size_t)(64 * (j)) * QP; sk0##S_ = ldg8(Kg + (size_t)(64 * (j)) * QP + koff); sv0##S_ = ldg8(vp_ + voff); sv1##S_ = ldg8(vp_ + (size_t)32 * QP + voff); } while (0)
#define DF_WRITE(S_, bf) do { *(ALAS bf16x8*)(K_lds + (bf) * SHM_K + kws) = sk0##S_; *(ALAS bf16x8*)(V_lds + (bf) * SHM_V + vst0) = sv0##S_; *(ALAS bf16x8*)(V_lds + (bf) * SHM_V + vst1) = sv1##S_; } while (0)
#define DF_MASK(P0, P1, t) do { if (64 * (t) + 63 > R0) mask_gt(P0, P1, qm - 64 * (t)); } while (0)
#define DF_RESC(a) do { if (__any((a) < 1.f)) { if (hi == 0) al_l[r32] = (a); asm volatile("s_waitcnt lgkmcnt(0)" ::: "memory"); \
        _Pragma("unroll") for (int d_ = 0; d_ < 4; ++d_) _Pragma("unroll") for (int r = 0; r < 16; ++r) o[d_][r] *= al_l[crow(r, hi)]; } } while (0)
    float m_reg = -1e30f, l_reg = 0.f; f32x16 o[4] = {};
    f32x16 pA0, pA1, pB0, pB1; float alA = 1.f, alB = 1.f; bf16x8 pa0, pa1, pa2, pa3;
    DF_LOAD(A, 0); DF_WRITE(A, 0);
    __syncthreads();
    DF_LOAD(A, 1); DF_LOAD(B, 2);
    qkt64(pA0, pA1, K_lds, r32, hi, qr); DF_MASK(pA0, pA1, 0); partial_sm(pA0, pA1, m_reg, alA, hi);
    DF_WRITE(A, 1);
    DF_RESC(alA);
    __syncthreads();
#define DF_HALF(PX0, PX1, alX, PY0, PY1, alY, t, KB, VB, SB, LS, WS) do { \
        SBAR(); qkt64(PX0, PX1, K_lds + (KB) * SHM_K, r32, hi, qr); \
        finish_sm(PY0, PY1, alY, l_reg, pa0, pa1, pa2, pa3, hi); SBAR(); \
        if ((t) + 2 < NT) { DF_LOAD(LS, (t) + 2); SBAR(); } \
        pv_tile(o, vb0 + (VB) * SHM_V, pa0, pa1, pa2, pa3); DF_MASK(PX0, PX1, (t)); partial_sm(PX0, PX1, m_reg, alX, hi); \
        __syncthreads(); \
        if ((t) + 1 < NT) DF_WRITE(WS, SB); \
        DF_RESC(alX); __syncthreads(); } while (0)
    for (int t = 1; t + 1 < NT; t += 2) {
        DF_HALF(pB0, pB1, alB, pA0, pA1, alA, t, 1, 0, 0, A, B);
        DF_HALF(pA0, pA1, alA, pB0, pB1, alB, t + 1, 0, 1, 1, B, A);
    }
    DF_HALF(pB0, pB1, alB, pA0, pA1, alA, NT - 1, 1, 0, 0, A, B);
    finish_sm(pB0, pB1, alB, l_reg, pa0, pa1, pa2, pa3, hi); SBAR();
    pv_tile(o, vb0 + 1 * SHM_V, pa0, pa1, pa2, pa3);
#undef DF_LOAD
#undef DF_WRITE
#undef DF_MASK
#undef DF_RESC
#undef DF_HALF
    if (hi == 0) li_l[r32] = l_reg; asm volatile("s_waitcnt lgkmcnt(0)" ::: "memory");
    float rli[16];
#pragma unroll
    for (int r = 0; r < 16; ++r) rli[r] = __builtin_amdgcn_rcpf(li_l[crow(r, hi)]);
    if constexpr (!SECOND) {
        float* Sw = S1 + (size_t)R0 * OP; const unsigned ooff = (unsigned)(4 * hi * OP + r32);
#pragma unroll
        for (int r = 0; r < 16; ++r) { float* rowp = Sw + (size_t)((r & 3) + 8 * (r >> 2)) * OP;
#pragma unroll
            for (int d0 = 0; d0 < 4; ++d0) rowp[ooff + d0 * 32] = o[d0][r] * rli[r]; }
    } else {
        const float* Sw = S1 + (size_t)R0 * OP; bf16_t* Ow = Og + (size_t)R0 * OP; (void)Ow; const unsigned ooff = (unsigned)(4 * hi * OP + r32), ooff8 = (unsigned)(4 * hi * OBP + r32);
        float gn[4];
#pragma unroll
        for (int d0 = 0; d0 < 4; ++d0) gn[d0] = gsub[d0 * 32 + r32] * gmul;
#pragma unroll
        for (int r = 0; r < 16; ++r) { const float* srow = Sw + (size_t)((r & 3) + 8 * (r >> 2)) * OP; float d[4]; float ss = 0.f;
#if WO_F8
            unsigned char* orowp = (unsigned char*)Og + (size_t)(R0 + (r & 3) + 8 * (r >> 2)) * OBP;
#else
            bf16_t* orowp = Ow + (size_t)((r & 3) + 8 * (r >> 2)) * OP;
#endif
#pragma unroll
            for (int d0 = 0; d0 < 4; ++d0) { d[d0] = srow[ooff + d0 * 32] - lam * (o[d0][r] * rli[r]); ss += d[d0] * d[d0]; }
            ss += __builtin_bit_cast(float, __builtin_amdgcn_update_dpp(0, __builtin_bit_cast(int, ss), 0xB1, 0xf, 0xf, true));
            ss += __builtin_bit_cast(float, __builtin_amdgcn_update_dpp(0, __builtin_bit_cast(int, ss), 0x4E, 0xf, 0xf, true));
            ss += __builtin_bit_cast(float, __builtin_amdgcn_update_dpp(0, __builtin_bit_cast(int, ss), 0x141, 0xf, 0xf, true));
            ss += __builtin_bit_cast(float, __builtin_amdgcn_update_dpp(0, __builtin_bit_cast(int, ss), 0x140, 0xf, 0xf, true));
            { auto rr = __builtin_amdgcn_permlane16_swap(__float_as_uint(ss), __float_as_uint(ss), false, false); ss = __uint_as_float(rr[0]) + __uint_as_float(rr[1]); }
            const float rs = __builtin_amdgcn_rsqf(ss * (1.f / 128.f) + 1e-5f);
#pragma unroll
#if WO_F8
            for (int d0 = 0; d0 < 4; ++d0) { const unsigned w = quad_pack_fp8(d[d0] * rs * gn[d0] * OB8_SCALE);
                if ((r32 & 3) == 0) *(unsigned*)(orowp + (ooff8 + d0 * 32)) = w; }
#else
            for (int d0 = 0; d0 < 4; ++d0) { const float v = d[d0] * rs * gn[d0]; const float vn = __shfl_xor(v, 1);
                if ((r32 & 1) == 0) *(unsigned*)(orowp + (ooff + d0 * 32)) = cvtpk(v, vn); }
#endif
            if ((r & 1) == 1) asm volatile("" ::: "memory"); }
    }
    __syncthreads();
}
#undef SBAR
}

#define LAS __attribute__((address_space(3)))

#define XB_TMO      128
#define XB_XCNT(j)  (256  + 64 * (j))
#define XB_XSUB(j)  (1280 + 64 * (j))
#define XB_XGEN(j)  (2304 + 64 * (j))
#define XB_TOP      3328
#define XB_TOPGEN   3392
#define XCD_BAR_WORDS 3456
#define XB_SPIN_CAP (1u << 18)

__device__ __forceinline__ unsigned xb_ld(unsigned* p)              { return __hip_atomic_load(p, __ATOMIC_RELAXED, __HIP_MEMORY_SCOPE_AGENT); }
__device__ __forceinline__ unsigned xb_add(unsigned* p, unsigned v) { return __hip_atomic_fetch_add(p, v, __ATOMIC_RELAXED, __HIP_MEMORY_SCOPE_AGENT); }
__device__ __forceinline__ unsigned xb_xcc_id() { return (unsigned)__builtin_amdgcn_s_getreg((3 << 11) | 20) & 0xFu; }
#define XB_SPIN(cond, bar) do { unsigned _sp = 0; while (cond) { __builtin_amdgcn_s_sleep(1); \
    if ((++_sp & 255u) == 0u) { if (xb_ld(&(bar)[XB_TMO])) break; if (_sp > XB_SPIN_CAP) { atomicAdd(&(bar)[XB_TMO], 1u); break; } } } } while (0)

struct XcdBarrier {
    unsigned* bar; unsigned x;
    volatile LAS unsigned* st;
};

__device__ __forceinline__ XcdBarrier xcd_barrier_post(unsigned* bar, volatile LAS unsigned* st, bool thread0) {
    XcdBarrier b; b.bar = bar; b.x = xb_xcc_id(); b.st = st;
    if (thread0) (void)xb_add(&bar[XB_XCNT(b.x)], 1u);
    return b;
}
__device__ __forceinline__ void xcd_barrier_complete(unsigned* bar, unsigned x, unsigned& nloc, unsigned& nx) {
    const unsigned G = gridDim.x * gridDim.y * gridDim.z;
    unsigned sum, cnt, mine, sp = 0u;
    for (;;) {
        sum = 0u; cnt = 0u; mine = 0u;
#pragma unroll
        for (unsigned j = 0; j < 16; ++j) { const unsigned c = xb_ld(&bar[XB_XCNT(j)]); sum += c; cnt += (c > 0u) ? 1u : 0u; mine = (j == x) ? c : mine; }
        if (sum == G) break;
        __builtin_amdgcn_s_sleep(1);
        if ((++sp & 255u) == 0u) { if (xb_ld(&bar[XB_TMO])) break; if (sp > XB_SPIN_CAP) { atomicAdd(&bar[XB_TMO], 1u); break; } }
    }
    nloc = mine > 0u ? mine : 1u; nx = cnt > 0u ? cnt : 1u;
}

__device__ __forceinline__ void xcd_barrier(const XcdBarrier& b, bool thread0) {
    asm volatile("s_waitcnt vmcnt(0)" ::: "memory");
    __syncthreads();
    if (thread0) {
        unsigned* bar = b.bar;
        __builtin_amdgcn_s_waitcnt(0);
        unsigned nloc = b.st[0], nx = b.st[1];
        if (nloc == 0u) { xcd_barrier_complete(bar, b.x, nloc, nx); b.st[0] = nloc; b.st[1] = nx; }
        const unsigned old = xb_add(&bar[XB_XSUB(b.x)], 1u);
        const unsigned gen = old / nloc;
        if (old + 1u == (gen + 1u) * nloc) {
            __builtin_amdgcn_fence(__ATOMIC_RELEASE, "agent");
            asm volatile("s_waitcnt vmcnt(0)" ::: "memory");
            const unsigned og = xb_add(&bar[XB_TOP], 1u);
            const unsigned tg = og / nx;
            if (og + 1u == (tg + 1u) * nx) xb_add(&bar[XB_TOPGEN], 1u);
            else XB_SPIN(xb_ld(&bar[XB_TOPGEN]) == tg, bar);
            __builtin_amdgcn_fence(__ATOMIC_ACQUIRE, "agent");
            xb_add(&bar[XB_XGEN(b.x)], 1u);
            asm volatile("s_waitcnt vmcnt(0)" ::: "memory");
        } else {
            XB_SPIN(xb_ld(&bar[XB_XGEN(b.x)]) == gen, bar);
            __builtin_amdgcn_fence(__ATOMIC_ACQUIRE, "agent");
            asm volatile("s_waitcnt vmcnt(0)" ::: "memory");
        }
    }
    __syncthreads();
}

constexpr int NWAVES = 8;
constexpr int NTOK = 16384, DM = 2048, SEQ = 2048, NHEAD = 16, NLAYER = 4, NEXP = 16, DEXP = 1024;
constexpr int XS_ROWS = 36864;
constexpr float LN_EPS = 1e-5f;
constexpr float DN_ALPHA = 1.6817928305074292f;
constexpr float LOG2E = 1.4426950408889634f;
constexpr float SB_QSCALE = 0.08838834764831845f * LOG2E;
constexpr float DF_QSCALE = 0.125f * LOG2E;
#ifndef MK_MULTI
#define MK_MULTI 0
#endif
#ifndef MOE_F8
#define MOE_F8 1
#endif
#ifndef QKV8_A
#define QKV8_A 1
#endif
#ifndef QKV8_B
#define QKV8_B 0
#endif
constexpr int NSTEPS = 1 + 8 * NLAYER;

constexpr size_t MiB = 1u << 20;
constexpr size_t WS_CTL = 0, CTL_ZERO_BYTES = 64 * 1024;
constexpr size_t WS_COS = 1 * MiB, WS_SIN = WS_COS + 256 * 1024;
constexpr size_t WS_WR = 2 * MiB;
constexpr size_t WS_CNT = 3 * MiB;
constexpr size_t WS_RE = WS_CNT + 64 * 1024;
constexpr size_t WS_RW = WS_RE + 64 * 1024;
constexpr size_t WS_RP = WS_RW + 128 * 1024;
constexpr int LDH = 2048;
constexpr int P8K2 = 2048, P8K1 = 1024;
constexpr size_t WS_WQKVA = 4 * MiB;
constexpr size_t WS_WOA = WS_WQKVA + 56 * MiB;
constexpr size_t WS_WQKVB = WS_WOA + 16 * MiB;
constexpr size_t WS_WOB = WS_WQKVB + 36 * MiB;
constexpr size_t WS_WGU = WS_WOB + 16 * MiB;
constexpr size_t WS_WDN = WS_WGU + 512 * MiB;
constexpr size_t WS_H = WS_WDN + 256 * MiB;
constexpr size_t WS_HB = WS_H + 128 * MiB;
constexpr size_t WS_QKV = WS_HB + 68 * MiB;
constexpr size_t WS_OB = WS_QKV + 192 * MiB;
constexpr size_t WS_XS = WS_OB + 64 * MiB;
constexpr size_t WS_ACT = WS_XS + 144 * MiB;
constexpr size_t WS_YD = WS_ACT + 72 * MiB;
constexpr size_t WS_END = WS_YD + 144 * MiB;
static_assert(WS_END <= (size_t)2040 * MiB, "workspace map");
static_assert((size_t)2 * 6144 * LDH * 2 <= 56 * MiB && (size_t)8192 * LDH * 2 <= 36 * MiB && (size_t)2 * 2048 * P8K2 <= 16 * MiB && (size_t)64 * 2048 * P8K2 <= 512 * MiB && (size_t)64 * 2048 * P8K1 <= 256 * MiB, "weight regions");
static_assert((size_t)NTOK * LDH * 2 <= 68 * MiB && (size_t)NTOK * P8K2 <= 64 * MiB && (size_t)XS_ROWS * P8K2 <= 144 * MiB && (size_t)XS_ROWS * P8K1 <= 72 * MiB, "activation regions");
constexpr int CW_BAR = 1024;
constexpr int LDS_BYTES = 147456;
constexpr int LDSCTL_OFF = 145408;
constexpr int RING_OFF = 0;
constexpr int LNX_OFF = 131072;

#define GAS __attribute__((address_space(1)))
typedef unsigned short bf16;
typedef unsigned v4u __attribute__((ext_vector_type(4)));
typedef unsigned v2u __attribute__((ext_vector_type(2)));
typedef float f32x4 __attribute__((ext_vector_type(4)));
typedef float f32x2 __attribute__((ext_vector_type(2)));
typedef _Float16 f16x4 __attribute__((ext_vector_type(4)));
__device__ __forceinline__ f32x4 ldh4(const _Float16* p) { return __builtin_convertvector(*(const f16x4*)p, f32x4); }
__device__ __forceinline__ void sth4(_Float16* p, f32x4 v) { *(f16x4*)p = __builtin_convertvector(v, f16x4); }
#define LDS_WAIT() asm volatile("s_waitcnt lgkmcnt(0)" ::: "memory")
#define VM_WAIT() asm volatile("s_waitcnt vmcnt(0)" ::: "memory")
__device__ __forceinline__ unsigned pk2(float lo, float hi) { unsigned r; asm volatile("v_cvt_pk_bf16_f32 %0, %1, %2" : "=v"(r) : "v"(lo), "v"(hi)); return r; }
__device__ __forceinline__ int opq_tid(int wave) { int t = tid_from_wave(wave); asm volatile("" : "+v"(t)); return t; }
__device__ __forceinline__ float dpp_sum(float v) {
    v += __builtin_bit_cast(float, __builtin_amdgcn_update_dpp(0, __builtin_bit_cast(int, v), 0xB1, 0xf, 0xf, true));
    v += __builtin_bit_cast(float, __builtin_amdgcn_update_dpp(0, __builtin_bit_cast(int, v), 0x4E, 0xf, 0xf, true));
    v += __builtin_bit_cast(float, __builtin_amdgcn_update_dpp(0, __builtin_bit_cast(int, v), 0x141, 0xf, 0xf, true));
    v += __builtin_bit_cast(float, __builtin_amdgcn_update_dpp(0, __builtin_bit_cast(int, v), 0x140, 0xf, 0xf, true));
    const int b = __builtin_bit_cast(int, v);
    const float s0 = __builtin_bit_cast(float, __builtin_amdgcn_readlane(b, 0)), s1 = __builtin_bit_cast(float, __builtin_amdgcn_readlane(b, 16));
    const float s2 = __builtin_bit_cast(float, __builtin_amdgcn_readlane(b, 32)), s3 = __builtin_bit_cast(float, __builtin_amdgcn_readlane(b, 48));
    return (s0 + s1) + (s2 + s3);
}
__device__ __forceinline__ float wave_sum(float v) {
#pragma unroll
    for (int o = 1; o < 64; o <<= 1) v += __shfl_xor(v, o);
    return v;
}

struct Args { const float* in[17]; float* out; unsigned char* ws; int s_lo, s_hi; };

__device__ __forceinline__ int map_row(int n, int mode) {
    if (mode == 0) return n;
    if (mode == 1) { const int c = n & 255, blk = c >> 6, d = c & 63; return (n & ~255) + ((d >> 5) << 7) + (blk << 5) + (d & 31); }
    return ((n >> 7) << 8) + (n & 127) + (mode == 3 ? 128 : 0);
}
__device__ __forceinline__ unsigned pk2h(float lo, float hi) { typedef _Float16 h2 __attribute__((ext_vector_type(2))); const f32x2 v = {lo, hi}; return __builtin_bit_cast(unsigned, __builtin_convertvector(v, h2)); }
template <bool HALF = false>
__device__ __forceinline__ void cvt_item(const float* __restrict__ src, int pitch, int K, bf16* __restrict__ dst, int mode, int k0, int n0, LAS float* scr, int lane) {
    const int kr = lane >> 4, n4 = (lane & 15) * 4;
    f32x4 v[16];
#pragma unroll
    for (int i = 0; i < 16; ++i) v[i] = __builtin_nontemporal_load((const f32x4*)(src + (size_t)(k0 + 4 * i + kr) * pitch + n0 + n4));
#pragma unroll
    for (int i = 0; i < 16; ++i) { LAS float* s = scr + (4 * i + kr) * 65 + n4; s[0] = v[i][0]; s[1] = v[i][1]; s[2] = v[i][2]; s[3] = v[i][3]; }
    LDS_WAIT();
    const int c = lane & 7;
#pragma unroll
    for (int j = 0; j < 8; ++j) { const int nl = (lane >> 3) + 8 * j; const int row = map_row(n0 + nl, mode);
        const LAS float* s = scr + (8 * c) * 65 + nl;
        v4u o; if (HALF) { o.x = pk2h(s[0], s[65]); o.y = pk2h(s[130], s[195]); o.z = pk2h(s[260], s[325]); o.w = pk2h(s[390], s[455]); }
        else { o.x = pk2(s[0], s[65]); o.y = pk2(s[130], s[195]); o.z = pk2(s[260], s[325]); o.w = pk2(s[390], s[455]); }
        *(v4u*)(dst + (size_t)row * K + k0 + 8 * c) = o; }
    LDS_WAIT();
}

__device__ __forceinline__ void cvt_item8(const float* __restrict__ src, int pitch, int K, unsigned char* __restrict__ dst, int mode, int k0, int n0, float scale, LAS float* scr, int lane) {
    const int kr = lane >> 4, n4 = (lane & 15) * 4;
    f32x4 v[16];
#pragma unroll
    for (int i = 0; i < 16; ++i) v[i] = __builtin_nontemporal_load((const f32x4*)(src + (size_t)(k0 + 4 * i + kr) * pitch + n0 + n4));
#pragma unroll
    for (int i = 0; i < 16; ++i) { LAS float* s = scr + (4 * i + kr) * 65 + n4; s[0] = v[i][0] * scale; s[1] = v[i][1] * scale; s[2] = v[i][2] * scale; s[3] = v[i][3] * scale; }
    LDS_WAIT();
    const int c = lane & 3;
#pragma unroll
    for (int j = 0; j < 4; ++j) { const int nl = (lane >> 2) + 16 * j; const int row = map_row(n0 + nl, mode);
        const LAS float* s = scr + (16 * c) * 65 + nl;
        v4u o; o.x = pg8::pack4_fp8(s[0], s[65], s[130], s[195]); o.y = pg8::pack4_fp8(s[260], s[325], s[390], s[455]);
        o.z = pg8::pack4_fp8(s[520], s[585], s[650], s[715]); o.w = pg8::pack4_fp8(s[780], s[845], s[910], s[975]);
        *(v4u*)(dst + (size_t)row * K + k0 + 16 * c) = o; }
    LDS_WAIT();
}

__global__ void __launch_bounds__(NWAVES * 64, 2) yoco_fwd(Args args) {
    extern __shared__ __attribute__((aligned(16))) unsigned char lds_raw[];
    LAS unsigned char* const lds = (LAS unsigned char*)lds_raw;
    const int tid = threadIdx.x, lane = tid & 63, wave = __builtin_amdgcn_readfirstlane(tid >> 6);
    const int G = gridDim.x, bx = blockIdx.x;
    const int vcu = (G % 8 == 0) ? (bx % 8) * (G / 8) + bx / 8 : bx;
    unsigned char* const ws = args.ws;
    volatile LAS unsigned* const CTL = (volatile LAS unsigned*)(lds + LDSCTL_OFF);
    LAS int* const TAB = (LAS int*)(lds + LDSCTL_OFF + 64);
    for (int u = tid; u < (LDS_BYTES - LDSCTL_OFF) / 4; u += NWAVES * 64) ((LAS unsigned*)(lds + LDSCTL_OFF))[u] = 0u;
    __syncthreads();
    const int s_lo = args.s_lo, s_hi = args.s_hi;
    XcdBarrier bar; bar.bar = (unsigned*)(ws + WS_CTL) + CW_BAR; bar.x = 0; bar.st = nullptr;
    if (s_hi - s_lo > 1) bar = xcd_barrier_post((unsigned*)(ws + WS_CTL) + CW_BAR, CTL, tid == 0);
#ifndef PH_MASK
#define PH_MASK 0xFFFF
#endif
#define PHM(b) (((PH_MASK) >> (b)) & 1)
#ifndef PROBE_DUP
#define PROBE_DUP 0
#endif
#define PREP(b) _Pragma("unroll 1") for (int rep_ = 0; rep_ < ((((PROBE_DUP) >> (b)) & 1) ? 2 : 1); ++rep_)
#define IN(k) (s_lo <= (k) && (k) < s_hi)
#define SEAM(k) do { if ((k) + 1 < s_hi) xcd_barrier(bar, tid_from_wave(wave) == 0); } while (0)

    const float* const x_in = args.in[0];
    _Float16* const H = (_Float16*)(ws + WS_H); unsigned char* const HB8 = (unsigned char*)(ws + WS_OB + 32 * MiB);     bf16* const QKV = (bf16*)(ws + WS_QKV); bf16* const OB = (bf16*)(ws + WS_OB);
    bf16* const MIX = (bf16*)(ws + WS_YD);     bf16* const XS = (bf16*)(ws + WS_XS); float* const S1 = (float*)(ws + WS_XS); bf16* const ACT = (bf16*)(ws + WS_ACT); bf16* const YD = (bf16*)(ws + WS_YD);
    float* const COS = (float*)(ws + WS_COS); float* const SIN = (float*)(ws + WS_SIN); float* const WR = (float*)(ws + WS_WR);
    int* const CNT = (int*)(ws + WS_CNT); unsigned* const RE = (unsigned*)(ws + WS_RE); f32x2* const RW = (f32x2*)(ws + WS_RW); int* const RP = (int*)(ws + WS_RP);

    if (IN(0) && PHM(0)) { PREP(0) {
        const int tid = opq_tid(wave), lane = tid & 63;
        LAS float* scr = (LAS float*)(lds + RING_OFF + wave * 16640);
        const int gw = vcu * NWAVES + wave, NGW = G * NWAVES;
        constexpr int I0 = 2 * 3072, I1 = 8 * 1024, I2 = 128 * 512, I3 = 64 * 512, NITEMS = I0 + I1 + I2 + I3;
        for (int it = gw; it < NITEMS; it += NGW) {
            int r = it;
            if (r < I0) { const int job = r / 3072; r -= job * 3072; const int kb = r / 96, nb = r - kb * 96;
                if (QKV8_A) cvt_item8(args.in[1] + (size_t)job * 2048 * 6144, 6144, 2048, (unsigned char*)(ws + WS_WQKVA) + (size_t)job * 6144 * 2048, 0, kb * 64, nb * 64, pg8::W8_SCALE, scr, lane);
                else cvt_item(args.in[1] + (size_t)job * 2048 * 6144, 6144, LDH, (bf16*)(ws + WS_WQKVA) + (size_t)job * 6144 * LDH, 0, kb * 64, nb * 64, scr, lane);
                continue; }
            r -= I0;
            if (r < I1) { const int job = r >> 10; r &= 1023; const int kb = r >> 5, nb = r & 31;
                const float* src; int pitch = 2048, mode = 0; bf16* dst;
                if (job < 2) { src = args.in[2] + (size_t)job * 2048 * 2048; dst = (bf16*)(ws + WS_WOA + (size_t)job * 2048 * P8K2); }
                else if (job == 2) { src = args.in[4]; dst = (bf16*)(ws + WS_WQKVB); mode = 1; }
                else if (job == 3) { src = args.in[3]; pitch = 4096; dst = (bf16*)(ws + WS_WQKVB) + (size_t)2048 * LDH; mode = 1; }
                else if (job == 4) { src = args.in[3] + 2048; pitch = 4096; dst = (bf16*)(ws + WS_WQKVB) + (size_t)4096 * LDH; }
                else if (job == 5) { src = args.in[4] + (size_t)2048 * 2048; dst = (bf16*)(ws + WS_WQKVB) + (size_t)6144 * LDH; mode = 1; }
                else { src = args.in[5] + (size_t)(job - 6) * 2048 * 2048; dst = (bf16*)(ws + WS_WOB + (size_t)(job - 6) * 2048 * P8K2); }
                if (job < 2 || job >= 6) { cvt_item8(src, pitch, P8K2, (unsigned char*)dst, mode, kb * 64, nb * 64, pg8::W8_SCALE, scr, lane); continue; }
                if (QKV8_B) { cvt_item8(src, pitch, 2048, (unsigned char*)(ws + WS_WQKVB) + (size_t)((job == 2) ? 0 : (job == 3) ? 2048 : (job == 4) ? 4096 : 6144) * 2048, mode, kb * 64, nb * 64, pg8::W8_SCALE, scr, lane); continue; }
                cvt_item<true>(src, pitch, LDH, dst, mode, kb * 64, nb * 64, scr, lane); continue; }
            r -= I1;
            if (r < I2) { const int job = r >> 9; r &= 511; const int kb = r >> 4, nb = r & 15; const int le = job >> 1, up = job & 1;
                cvt_item8((up ? args.in[15] : args.in[14]) + (size_t)le * 2048 * 1024, 1024, P8K2, (unsigned char*)(ws + WS_WGU) + (size_t)le * 2048 * P8K2, 2 + up, kb * 64, nb * 64, pg8::W8_SCALE, scr, lane); continue; }
            r -= I2;
            { const int le = r >> 9; r &= 511; const int kb = r >> 5, nb = r & 31;
                cvt_item8(args.in[16] + (size_t)le * 1024 * 2048, 2048, P8K1, (unsigned char*)(ws + WS_WDN) + (size_t)le * 2048 * P8K1, 0, kb * 64, nb * 64, pg8::W8_SCALE, scr, lane); }
        }
        for (size_t i = (size_t)gw * 64 + lane; i < (size_t)NTOK * DM / 4; i += (size_t)NGW * 64) {
            const f32x4 v = ((const f32x4*)x_in)[i];
            ((unsigned*)HB8)[i] = pg8::pack4_fp8(v[0], v[1], v[2], v[3]); }
        for (int i = bx * (NWAVES * 64) + tid; i < 2048 * 32; i += G * NWAVES * 64) { const int pos = i >> 5, f = i & 31;
            const float inv = __builtin_amdgcn_exp2f(-(float)f * 0.4152410118609203f); const float ang = (float)pos * inv;
            const double tr = (double)ang * 0.15915494309189535; const float fr = (float)(tr - __builtin_rint(tr));
            COS[i] = __builtin_amdgcn_cosf(fr); SIN[i] = __builtin_amdgcn_sinf(fr); }
        for (int i = bx * (NWAVES * 64) + tid; i < NLAYER * 20 * 2048; i += G * NWAVES * 64) { const int k = i & 2047, c = (i >> 11) % 20, l = i / (20 * 2048);
            WR[i] = c < 4 ? args.in[12][((size_t)l * 2048 + k) * 4 + c] : args.in[13][(((size_t)l * 4 + ((c - 4) >> 2)) * 2048 + k) * 4 + ((c - 4) & 3)]; }
        }
        SEAM(0);
    }

    for (int L = 0; L < NLAYER; ++L) {
        const int sb = 1 + 8 * L; const bool typeA = L < 2;
        if (IN(sb + 0)) {
            if (typeA && PHM(1)) { PREP(1) {
                pg8::StaticOrder S; S.init(NTOK, 6144, G, bx);
                if (QKV8_A) { pg8::Gemm g{(const bf16*)HB8, (const bf16*)(ws + WS_WQKVA + (size_t)L * 6144 * 2048), NTOK, 6144, DM / 2, DM / 2, wave}; pg8::EpiQkv E{QKV, 6144, 2048, SB_QSCALE, 1.f / pg8::W8_SCALE};
                    pg8::gemm_phase<pg8::EpiQkv, pg8::StaticOrder, true, true, true>(lds + RING_OFF, g, S, E); }
                } static_assert(QKV8_A == 1, "the stick-breaking layers' q|k|v GEMM takes the e4m3 copy of the stream");
            } else if (!typeA && PHM(2)) { PREP(2) {
                const int N = (L == 2) ? 6144 : 2048;
                pg8::StaticOrder S; S.init(NTOK, N, G, bx);
                if (QKV8_B) { pg8::Gemm g{(const bf16*)HB8, (const bf16*)(ws + WS_WQKVB + (L == 2 ? (size_t)0 : (size_t)6144 * 2048)), NTOK, N, DM / 2, DM / 2, wave};
                    pg8::EpiRope E{QKV, 6144, 2048, 4096, DF_QSCALE, COS, SIN, 1.f / pg8::W8_SCALE};
                    pg8::gemm_phase<pg8::EpiRope, pg8::StaticOrder, true, true, true>(lds + RING_OFF, g, S, E); }
                else { pg8::Gemm g{(const bf16*)H, (const bf16*)(ws + WS_WQKVB) + (L == 2 ? (size_t)0 : (size_t)6144 * LDH), NTOK, N, DM, LDH, wave};
                    pg8::EpiRope E{QKV, 6144, 2048, 4096, DF_QSCALE, COS, SIN, 1.f};
                    pg8::gemm_phase<pg8::EpiRope, pg8::StaticOrder, true, true, false, true>(lds + RING_OFF, g, S, E); } }
            }
            SEAM(sb + 0);
        }
        if (IN(sb + 1)) {
            if (typeA && PHM(3)) {
                for (int id_ = vcu; id_ < 512 * (1 + ((PROBE_DUP >> 3) & 1)); id_ += G) { const int id = id_ & 511; const int bh = id >> 2, p = id & 3, b = bh >> 4, h = bh & 15;
                    const bf16* Qg = QKV + (size_t)b * SEQ * 6144 + h * 128; bf16* Og = (bf16*)((unsigned char*)OB + (size_t)b * SEQ * P8K2 + h * 128);
                    att::sb_block(Qg, Qg + 2048, Qg + 4096, Og, 7 - p, (att::ldsp)(lds + RING_OFF), wave);
                    att::sb_block(Qg, Qg + 2048, Qg + 4096, Og, p, (att::ldsp)(lds + RING_OFF), wave); }
            } else if (!typeA && PHM(4)) {
                const int lane = opq_tid(wave) & 63;
                const int i = L - 2; const float lam_init = (L == 2) ? 0.47071301834264183f : 0.5560582041556061f;
                const float* lp = args.in[6] + (size_t)i * 256;
                const float sa = dpp_sum(lp[lane] * lp[64 + lane]), sb2 = dpp_sum(lp[128 + lane] * lp[192 + lane]);
                const float lam = __builtin_amdgcn_exp2f(sa * LOG2E) - __builtin_amdgcn_exp2f(sb2 * LOG2E) + lam_init;
                const float* gsub = args.in[7] + (size_t)i * 128; const float gmul = 1.f - lam_init;
                for (int id_ = vcu; id_ < 512 * (1 + ((PROBE_DUP >> 4) & 1)); id_ += G) { const int id = id_ & 511; const int bh = id >> 2, p = id & 3, b = bh >> 4, h = bh & 15;
                    const bf16* Qg = QKV + (size_t)b * SEQ * 6144 + h * 128; bf16* Og = (bf16*)((unsigned char*)OB + (size_t)b * SEQ * P8K2 + h * 128); float* Sg = S1 + (size_t)b * SEQ * DM + h * 128;
#pragma unroll 1
                    for (int w = 0; w < 2; ++w) { const int qb = w ? p : 7 - p;
                        att::diff_pass<false>(Qg, Qg + 2048, Qg + 4096, Sg, Og, qb, lam, gsub, gmul, (att::ldsp)(lds + RING_OFF), wave);
                        att::diff_pass<true>(Qg + 64, Qg + 2048 + 64, Qg + 4096, Sg, Og, qb, lam, gsub, gmul, (att::ldsp)(lds + RING_OFF), wave); } }
            }
            SEAM(sb + 1);
        }
        if (IN(sb + 2)) { if (PHM(5)) {
            pg8::Gemm g{OB, (const bf16*)(ws + (typeA ? WS_WOA : WS_WOB) + (size_t)(L & 1) * 2048 * P8K2), NTOK, DM, DM / 2, P8K2 / 2, wave}; pg8::StaticOrder S; S.init(NTOK, DM, G, bx);
            pg8::EpiQkv E{MIX, DM, 0, 1.f, 1.f / (pg8::W8_SCALE * att::OB8_SCALE)};
            pg8::gemm_phase<pg8::EpiQkv, pg8::StaticOrder, true, true, true>(lds + RING_OFF, g, S, E); }
            SEAM(sb + 2);
        }
        if (IN(sb + 3)) { if (PHM(6)) {
            const int tid = opq_tid(wave), lane = tid & 63;
            const float* lng = args.in[8] + (size_t)L * DM; const float* lnb = args.in[9] + (size_t)L * DM; const float* wr = WR + (size_t)L * 20 * 2048;
            LAS int* eid = (LAS int*)(lds + LNX_OFF + 2048);
            LAS float* lgt = (LAS float*)(lds + LNX_OFF + 4096);
            LAS unsigned* rows8 = (LAS unsigned*)(lds + RING_OFF);
            for (int c = bx; c < 256; c += G) {
#pragma unroll 1
                for (int grp = 0; grp < 2; ++grp) {
                    const int rloc = wave * 8 + grp * 4; const size_t row0 = (size_t)64 * c + rloc;
                    f32x4 v[4][8]; float mu[4], rstd[4];
#pragma unroll
                    for (int rr = 0; rr < 4; ++rr) {
                        if (L == 0) { const f32x4* hp = (const f32x4*)(x_in + (row0 + rr) * DM) + lane;
#pragma unroll
                            for (int j = 0; j < 8; ++j) v[rr][j] = hp[64 * j]; }
                        else { const _Float16* hq = H + (row0 + rr) * DM + 4 * lane;
#pragma unroll
                            for (int j = 0; j < 8; ++j) v[rr][j] = ldh4(hq + 256 * j); } }
#pragma unroll
                    for (int rr = 0; rr < 4; ++rr) { const v2u* mp = (const v2u*)(MIX + (row0 + rr) * DM) + lane;
#pragma unroll
                        for (int j = 0; j < 8; ++j) { const v2u a = mp[64 * j];
                            const f32x4 fa = {__uint_as_float(a.x << 16), __uint_as_float(a.x & 0xffff0000u), __uint_as_float(a.y << 16), __uint_as_float(a.y & 0xffff0000u)};
                            v[rr][j] = v[rr][j] * DN_ALPHA + fa; } }
#pragma unroll
                    for (int rr = 0; rr < 4; ++rr) { float s = 0.f;
#pragma unroll
                        for (int j = 0; j < 8; ++j) s += (v[rr][j][0] + v[rr][j][1]) + (v[rr][j][2] + v[rr][j][3]);
                        mu[rr] = dpp_sum(s) * (1.f / DM); float q = 0.f;
#pragma unroll
                        for (int j = 0; j < 8; ++j) { const f32x4 d = v[rr][j] - mu[rr]; q += (d[0] * d[0] + d[1] * d[1]) + (d[2] * d[2] + d[3] * d[3]); }
                        rstd[rr] = 1.f / sqrtf(dpp_sum(q) * (1.f / DM) + LN_EPS); }
#pragma unroll
                    for (int j = 0; j < 8; ++j) { const f32x4 gg = ((const f32x4*)lng)[64 * j + lane], bb = ((const f32x4*)lnb)[64 * j + lane];
#pragma unroll
                        for (int rr = 0; rr < 4; ++rr) { v[rr][j] = (v[rr][j] - mu[rr]) * rstd[rr] * gg + bb; sth4(H + (row0 + rr) * DM + 256 * j + 4 * lane, v[rr][j]);
                            if (c == bx) rows8[(rloc + rr) * 512 + 64 * j + lane] = pg8::pack4_fp8(v[rr][j][0], v[rr][j][1], v[rr][j][2], v[rr][j][3]); } }
#pragma unroll 1
                    for (int cc = 0; cc < 20; ++cc) { const f32x4* wp = (const f32x4*)(wr + cc * 2048) + lane; float a[4] = {0.f, 0.f, 0.f, 0.f};
#pragma unroll
                        for (int j = 0; j < 8; ++j) { const f32x4 w = wp[64 * j];
#pragma unroll
                            for (int rr = 0; rr < 4; ++rr) a[rr] += (v[rr][j][0] * w[0] + v[rr][j][1] * w[1]) + (v[rr][j][2] * w[2] + v[rr][j][3] * w[3]); }
#pragma unroll
                        for (int rr = 0; rr < 4; ++rr) a[rr] = dpp_sum(a[rr]);
                        if (lane == 0) { lgt[rloc * 20 + cc] = a[0]; lgt[(rloc + 1) * 20 + cc] = a[1]; lgt[(rloc + 2) * 20 + cc] = a[2]; lgt[(rloc + 3) * 20 + cc] = a[3]; } }
                }
                LDS_WAIT();
                if (lane < 8) {
                    const int rl = wave * 8 + lane; const LAS float* lg = lgt + rl * 20;
                    int gsel = 0; float gm = lg[0];
#pragma unroll
                    for (int i = 1; i < 4; ++i) { const float x = lg[i]; if (x > gm) { gm = x; gsel = i; } }
                    float gden = 0.f;
#pragma unroll
                    for (int i = 0; i < 4; ++i) gden += __builtin_amdgcn_exp2f((lg[i] - gm) * LOG2E);
                    const float gw_ = 1.f / gden;
                    const LAS float* li = lg + 4 + 4 * gsel;
                    const float l0 = li[0], l1 = li[1], l2 = li[2], l3 = li[3];
                    int i0 = 0; float v0 = l0;
                    if (l1 > v0) { v0 = l1; i0 = 1; } if (l2 > v0) { v0 = l2; i0 = 2; } if (l3 > v0) { v0 = l3; i0 = 3; }
                    int i1 = -1; float v1 = 0.f;
                    if (i0 != 0) { v1 = l0; i1 = 0; }
                    if (i0 != 1 && (i1 < 0 || l1 > v1)) { v1 = l1; i1 = 1; }
                    if (i0 != 2 && (i1 < 0 || l2 > v1)) { v1 = l2; i1 = 2; }
                    if (i0 != 3 && (i1 < 0 || l3 > v1)) { v1 = l3; i1 = 3; }
                    const float t = __builtin_amdgcn_exp2f((v1 - v0) * LOG2E); const float w0 = gw_ / (1.f + t), w1 = gw_ * t / (1.f + t);
                    eid[2 * rl] = gsel * 4 + i0; eid[2 * rl + 1] = gsel * 4 + i1; RW[(size_t)64 * c + rl] = (f32x2){w0, w1};
                }
                __syncthreads();
                if (wave == 0) {
                    const int ea = eid[lane], eb = eid[64 + lane]; int ra = 0, rb = 0, cnt = 0; const unsigned long long lt = (1ull << lane) - 1ull;
#pragma unroll
                    for (int e = 0; e < 16; ++e) { const unsigned long long ma = __ballot(ea == e), mb = __ballot(eb == e);
                        if (ea == e) ra = __popcll(ma & lt); if (eb == e) rb = __popcll(ma) + __popcll(mb & lt); if (lane == e) cnt = __popcll(ma) + __popcll(mb); }
                    if (lane < 16) CNT[c * 16 + lane] = cnt;
                    LAS int* rk = (LAS int*)(lds + LNX_OFF + 3072); rk[lane] = ra; rk[64 + lane] = rb; LDS_WAIT();
                    const int r = lane; const unsigned word = (unsigned)eid[2 * r] | ((unsigned)eid[2 * r + 1] << 8) | ((unsigned)rk[2 * r] << 16) | ((unsigned)rk[2 * r + 1] << 24);
                    RE[(size_t)64 * c + r] = word;
                }
                __syncthreads();
            } }
            SEAM(sb + 3);
        }
        if ((IN(sb + 4) || IN(sb + 5) || IN(sb + 6)) && PHM(7)) {
            const int tid = opq_tid(wave);
            LAS int* part = (LAS int*)(lds + LNX_OFF);
            { const int e = tid & 15, s = tid >> 4; int a = 0;
#pragma unroll
              for (int i = 0; i < 8; ++i) a += CNT[(8 * s + i) * 16 + e];
              part[s * 16 + e] = a; }
            __syncthreads();
            if (tid < 16) { int run = 0;
#pragma clang loop vectorize(disable) unroll(disable)
                for (int s = 0; s < 32; ++s) run += part[s * 16 + tid];
                TAB[tid] = run; }
            __syncthreads();
            if (tid == 0) { int off = 0, mt = 0;
#pragma clang loop vectorize(disable) unroll(disable)
                for (int e = 0; e < 16; ++e) { TAB[16 + e] = off; const int nt = (TAB[e] + 255) >> 8;
#pragma clang loop vectorize(disable) unroll(disable)
                    for (int i = 0; i < nt; ++i) TAB[64 + mt++] = e;
                    off += nt * 256; }
                TAB[32] = off; TAB[33] = mt; }
            __syncthreads();
        }
        if (IN(sb + 4)) { if (PHM(7)) PREP(7) {
            const int tid = opq_tid(wave), lane = tid & 63;
            LAS int* part = (LAS int*)(lds + LNX_OFF);
            for (int c = bx; c < 256; c += G) {
                if (tid < 16) { int pre = 0;
#pragma clang loop vectorize(disable) unroll(disable)
                    for (int s = 0; s < (c >> 3); ++s) pre += part[s * 16 + tid];
#pragma clang loop vectorize(disable) unroll(disable)
                    for (int cc = c & ~7; cc < c; ++cc) pre += CNT[cc * 16 + tid];
                    TAB[48 + tid] = TAB[16 + tid] + pre; }
                __syncthreads();
#pragma unroll 1
                for (int rr = 0; rr < 8; ++rr) { const size_t row = (size_t)64 * c + wave * 8 + rr; const unsigned word = RE[row];
                    const int p0 = TAB[48 + (word & 255)] + ((word >> 16) & 255), p1 = TAB[48 + ((word >> 8) & 255)] + (word >> 24);
                    if (lane == 0) { RP[2 * row] = p0; RP[2 * row + 1] = p1; }
                    if (c == bx && IN(sb + 3)) {
                        const LAS v4u* src = (const LAS v4u*)(lds + RING_OFF + (wave * 8 + rr) * 2048) + lane; v4u* o0 = (v4u*)((unsigned char*)XS + (size_t)p0 * P8K2) + lane; v4u* o1 = (v4u*)((unsigned char*)XS + (size_t)p1 * P8K2) + lane;
                        const v4u a = src[0], b = src[64]; o0[0] = a; o0[64] = b; o1[0] = a; o1[64] = b;
                    } else {
                        const _Float16* hq = H + row * DM + 4 * lane; unsigned* o0 = (unsigned*)((unsigned char*)XS + (size_t)p0 * P8K2) + lane; unsigned* o1 = (unsigned*)((unsigned char*)XS + (size_t)p1 * P8K2) + lane;
#pragma unroll
                        for (int j = 0; j < 8; ++j) { const f32x4 v = ldh4(hq + 256 * j); const unsigned o = pg8::pack4_fp8(v[0], v[1], v[2], v[3]); o0[64 * j] = o; o1[64 * j] = o; } } }
                __syncthreads();
            } }
            SEAM(sb + 4);
        }
        if (IN(sb + 5)) { if (PHM(8)) PREP(8) {
            pg8::Gemm g{XS, (const bf16*)(ws + WS_WGU + (size_t)L * 16 * 2048 * P8K2), XS_ROWS, 2048, DM / 2, P8K2 / 2, wave};
            pg8::MoeOrder S{TAB[33] * 8, G, bx, TAB + 64}; pg8::EpiGateUp8 E{(unsigned char*)ACT};
            pg8::gemm_phase<pg8::EpiGateUp8, pg8::MoeOrder, true, true, true>(lds + RING_OFF, g, S, E); }
            SEAM(sb + 5);
        }
        if (IN(sb + 6)) { if (PHM(9)) PREP(9) {
            pg8::Gemm g{ACT, (const bf16*)(ws + WS_WDN + (size_t)L * 16 * 2048 * P8K1), XS_ROWS, 2048, DEXP / 2, P8K1 / 2, wave};
            pg8::MoeOrder S{TAB[33] * 8, G, bx, TAB + 64}; pg8::EpiDown8 E{(unsigned char*)YD};
            pg8::gemm_phase<pg8::EpiDown8, pg8::MoeOrder, true, true, true>(lds + RING_OFF, g, S, E); }
            SEAM(sb + 6);
        }
        if (IN(sb + 7)) { if (PHM(10)) for (int rep_ = 0; rep_ < ((((PROBE_DUP) >> 10) & 1) && L == NLAYER - 1 ? 5 : 1); ++rep_) {
            const int tid = opq_tid(wave), lane = tid & 63;
            const float* lng = args.in[10] + (size_t)L * DM; const float* lnb = args.in[11] + (size_t)L * DM; const bool last = (L == NLAYER - 1); const bool next8 = (L + 1 < 2) ? (QKV8_A != 0) : (QKV8_B != 0);
            const int gw = vcu * NWAVES + wave, NGW = G * NWAVES;
            for (int row = gw; row < NTOK; row += NGW) {
                const int p0 = RP[2 * row], p1 = RP[2 * row + 1]; const f32x2 w = RW[row];
                const _Float16* hq = H + (size_t)row * DM + 4 * lane; const unsigned* y0 = (const unsigned*)((const unsigned char*)YD + (size_t)p0 * DM) + lane; const unsigned* y1 = (const unsigned*)((const unsigned char*)YD + (size_t)p1 * DM) + lane;
                const float w0s = w.x * (1.f / pg8::YD8_SCALE), w1s = w.y * (1.f / pg8::YD8_SCALE);
                f32x4 v[8]; float s = 0.f;
#pragma unroll
                for (int j = 0; j < 8; ++j) { const f32x4 h = ldh4(hq + 256 * j); const unsigned a = y0[64 * j], b = y1[64 * j];
                    const f32x2 a0 = __builtin_amdgcn_cvt_pk_f32_fp8((int)a, false), a1 = __builtin_amdgcn_cvt_pk_f32_fp8((int)a, true), b0 = __builtin_amdgcn_cvt_pk_f32_fp8((int)b, false), b1 = __builtin_amdgcn_cvt_pk_f32_fp8((int)b, true);
                    const f32x4 fa = {a0[0], a0[1], a1[0], a1[1]}, fb = {b0[0], b0[1], b1[0], b1[1]};
                    v[j] = h * DN_ALPHA + fa * w0s + fb * w1s; s += (v[j][0] + v[j][1]) + (v[j][2] + v[j][3]); }
                const float mu = dpp_sum(s) * (1.f / DM); float q = 0.f;
#pragma unroll
                for (int j = 0; j < 8; ++j) { const f32x4 d = v[j] - mu; q += (d[0] * d[0] + d[1] * d[1]) + (d[2] * d[2] + d[3] * d[3]); }
                const float rstd = 1.f / sqrtf(dpp_sum(q) * (1.f / DM) + LN_EPS);
                f32x4* op = (f32x4*)(args.out + (size_t)row * DM) + lane; _Float16* oh = H + (size_t)row * DM + 4 * lane;
#pragma unroll
                for (int j = 0; j < 8; ++j) { const f32x4 gg = ((const f32x4*)lng)[64 * j + lane], bb = ((const f32x4*)lnb)[64 * j + lane];
                    const f32x4 y = (v[j] - mu) * rstd * gg + bb;
                    if (last) op[64 * j] = y;
                    else { sth4(oh + 256 * j, y); if (next8) ((unsigned*)(HB8 + (size_t)row * DM))[64 * j + lane] = pg8::pack4_fp8(y[0], y[1], y[2], y[3]); } }
            } }
            SEAM(sb + 7);
        }
    }
#undef IN
#undef SEAM
}

extern "C" void kernel_launch(void* const* d_in, const int* in_sizes, int n_in, void* d_out, int out_size, void* d_ws, size_t ws_size, hipStream_t stream) {
    static int grid = 0;
    if (grid == 0) {
        if (n_in != 17 || in_sizes[0] != NTOK * DM || out_size != NTOK * DM || ws_size < WS_END) { fprintf(stderr, "kernel_launch: unexpected shapes / workspace (n_in %d, ws %zu, need %zu)\n", n_in, ws_size, (size_t)WS_END); grid = -1; return; }
        int dev = 0, cus = 0, per_cu = 0;
        if (hipGetDevice(&dev) != hipSuccess || hipDeviceGetAttribute(&cus, hipDeviceAttributeMultiprocessorCount, dev) != hipSuccess) { grid = -1; return; }
        if (hipFuncSetAttribute((const void*)yoco_fwd, hipFuncAttributeMaxDynamicSharedMemorySize, LDS_BYTES) != hipSuccess) { fprintf(stderr, "kernel_launch: hipFuncSetAttribute failed\n"); grid = -1; return; }
        if (hipOccupancyMaxActiveBlocksPerMultiprocessor(&per_cu, (const void*)yoco_fwd, NWAVES * 64, LDS_BYTES) != hipSuccess || per_cu < 1) { fprintf(stderr, "kernel_launch: occupancy query says %d\n", per_cu); per_cu = 1; }
        (void)hipGetLastError();
        grid = cus;
    }
    if (grid < 0) return;
    (void)hipMemsetAsync((char*)d_ws + WS_CTL, 0, CTL_ZERO_BYTES, stream);
    Args a{};
    for (int i = 0; i < 17; ++i) a.in[i] = (const float*)d_in[i];
    a.out = (float*)d_out; a.ws = (unsigned char*)d_ws;
#if MK_MULTI
    for (int s = 0; s < NSTEPS; ++s) { a.s_lo = s; a.s_hi = s + 1; hipLaunchKernelGGL(yoco_fwd, dim3(grid), dim3(NWAVES * 64), LDS_BYTES, stream, a); }
#else
    a.s_lo = 0; a.s_hi = NSTEPS;
    hipLaunchKernelGGL(yoco_fwd, dim3(grid), dim3(NWAVES * 64), LDS_BYTES, stream, a);
#endif
    const hipError_t le = hipPeekAtLastError();
    if (le != hipSuccess) fprintf(stderr, "kernel_launch: launch failed: %s\n", hipGetErrorName(le));
}
```

```cpp
#include <hip/hip_runtime.h>
#include <cstdio>
#include <cstdint>

__device__ __forceinline__ int tid_from_wave(int wave) { int l; asm volatile("v_mbcnt_lo_u32_b32 %0, -1, 0\n\tv_mbcnt_hi_u32_b32 %0, -1, %0" : "=v"(l)); return wave * 64 + l; }
namespace pg8 {
#define PG8_LAS __attribute__((address_space(3)))
typedef unsigned short bf16_t;
typedef short bf16x8 __attribute__((ext_vector_type(8)));
typedef float f32x4 __attribute__((ext_vector_type(4)));
typedef unsigned u32x4 __attribute__((ext_vector_type(4)));
typedef int pg8_v8i __attribute__((ext_vector_type(8)));
typedef _Float16 pg8_h8 __attribute__((ext_vector_type(8)));
constexpr int BM = 256, BK = 64, HALF = 128, HTB = HALF * BK * 2  , STAGE_BYTES = 8 * HTB, NXCD = 8, WGM = 8;

__host__ __device__ __forceinline__ int lds_byte(int r, int c) { const int st = (r >> 4) * 2 + (c >> 5), rr = r & 15, cc = c & 31, ob = rr * 64 + cc * 2; return st * 1024 + (ob ^ (((ob >> 9) & 1) << 5)); }
__host__ __device__ __forceinline__ void stage_rc(int b, int& R, int& C) { const int st = b / 1024, sb = b % 1024, swz = sb ^ (((sb >> 9) & 1) << 5); R = (st >> 1) * 16 + swz / 64; C = (st & 1) * 32 + (swz % 64) / 2; }
__host__ __device__ __forceinline__ int perm32(int rho) { const int n = rho >> 4, i = rho & 15; return 8 * (i >> 2) + 4 * n + (i & 3); }

struct Unit { int pm, pn; };
struct Gemm { const bf16_t* A; const bf16_t* Bt; int M, N, K, ld, wave; };

struct StaticOrder {
    int nM, nN, nwg, G, c;
    __host__ __device__ void init(int M, int N, int G_, int c_) { nM = M / BM; nN = N / BM; nwg = nM * nN; G = G_; c = c_; }
    __host__ __device__ bool next(int i, Unit& u) const {
        const long L = (long)i * G + c; if (L >= nwg) return false;
        int wgid = (int)L; { const int q = nwg / NXCD, r = nwg % NXCD, xcd = wgid % NXCD, off = wgid / NXCD; wgid = (xcd < r ? xcd * (q + 1) : r * (q + 1) + (xcd - r) * q) + off; }
        const int nig = WGM * nN, gid = wgid / nig, fm = gid * WGM, gsz = (nM - fm) < WGM ? (nM - fm) : WGM;
        u.pm = fm + ((wgid % nig) % gsz); u.pn = (wgid % nig) / gsz; return true;
    }
    __device__ __forceinline__ void a_ready(const Unit&) const {}
    __device__ __forceinline__ void done(const Unit&) const {}
};

__device__ __forceinline__ unsigned cvt_pk_bf16(float lo, float hi) { unsigned r; asm volatile("v_cvt_pk_bf16_f32 %0, %1, %2" : "=v"(r) : "v"(lo), "v"(hi)); return r; }
typedef float f32x2 __attribute__((ext_vector_type(2)));

typedef unsigned u32x2 __attribute__((ext_vector_type(2)));
__device__ __forceinline__ u32x4 pack8_bf16(const f32x4 a, const f32x4 b) { u32x4 w; w.x = cvt_pk_bf16(a[0], a[1]); w.y = cvt_pk_bf16(a[2], a[3]); w.z = cvt_pk_bf16(b[0], b[1]); w.w = cvt_pk_bf16(b[2], b[3]); return w; }

struct EpiQkv {
    static constexpr bool PERM = true, AFTER_DRAIN = false;
    bf16_t* O; int ldc; int qcols; float qscale; float osc;
    __device__ __forceinline__ void operator()(const f32x4 (&acc)[2][2][4][2], const Unit& u, int wr, int wc, int fr, int fq) const {
        const int row0 = u.pm * BM + wr * 64 + fr, colt = u.pn * BM; const float sc = (colt < qcols ? qscale : 1.f) * osc;
        const int col0 = colt + wc * 32 + 8 * fq;
#pragma unroll
        for (int ai = 0; ai < 2; ++ai)
#pragma unroll
            for (int m = 0; m < 4; ++m) { bf16_t* rowp = O + (size_t)(row0 + ai * HALF + m * 16) * ldc + col0;
#pragma unroll
                for (int bj = 0; bj < 2; ++bj) *(u32x4*)(rowp + bj * HALF) = pack8_bf16(acc[ai][bj][m][0] * sc, acc[ai][bj][m][1] * sc); }
    }
};
template <int ACCS_INV> struct EpiResid {
    static constexpr bool PERM = false, AFTER_DRAIN = false;
    static constexpr int ldc = 2048; static constexpr float alpha = 1.6817928305074292f, accs = 1.f / (float)ACCS_INV;
    float* H; const float* Hsrc;
    __device__ __forceinline__ void operator()(const f32x4 (&acc)[2][2][4][2], const Unit& u, int wr, int wc, int fr, int fq) const {
        const int row0 = u.pm * BM + wr * 64 + fr, col0 = u.pn * BM + wc * 32 + 4 * fq;
#pragma unroll
        for (int ai = 0; ai < 2; ++ai)
#pragma unroll
            for (int m = 0; m < 4; ++m) { const size_t ro = (size_t)(row0 + ai * HALF + m * 16) * ldc + col0; float* rowp = H + ro; const float* srcp = Hsrc + ro;
#pragma unroll
                for (int bj = 0; bj < 2; ++bj)
#pragma unroll
                    for (int n = 0; n < 2; ++n) { const f32x4 h = *(const f32x4*)(srcp + bj * HALF + n * 16); *(f32x4*)(rowp + bj * HALF + n * 16) = h * alpha + acc[ai][bj][m][n] * accs; } }
    }
};
struct EpiRope {
    static constexpr bool PERM = true, AFTER_DRAIN = false;
    bf16_t* O; int ldc; int qcols, ropecols; float qscale; const float* ctab; const float* stab; float osc;
    __device__ __forceinline__ void operator()(const f32x4 (&acc)[2][2][4][2], const Unit& u, int wr, int wc, int fr, int fq) const {
        const int row0 = u.pm * BM + wr * 64 + fr, colt = u.pn * BM;
        if (colt >= ropecols) {
            const int col0 = colt + wc * 32 + 8 * fq;
#pragma unroll
            for (int ai = 0; ai < 2; ++ai)
#pragma unroll
                for (int m = 0; m < 4; ++m) { bf16_t* rowp = O + (size_t)(row0 + ai * HALF + m * 16) * ldc + col0;
#pragma unroll
                    for (int bj = 0; bj < 2; ++bj) *(u32x4*)(rowp + bj * HALF) = pack8_bf16(acc[ai][bj][m][0] * osc, acc[ai][bj][m][1] * osc); }
        } else {
            const float sc = (colt < qcols ? qscale : 1.f) * osc;
            const int col0 = colt + wc * 64 + 8 * fq;
#pragma unroll
            for (int ai = 0; ai < 2; ++ai)
#pragma unroll
                for (int m = 0; m < 4; ++m) { const int row = row0 + ai * HALF + m * 16; const int pos = row & 2047;
                    const f32x4 c0 = *(const f32x4*)(ctab + pos * 32 + 8 * fq), c1 = *(const f32x4*)(ctab + pos * 32 + 8 * fq + 4);
                    const f32x4 s0 = *(const f32x4*)(stab + pos * 32 + 8 * fq), s1 = *(const f32x4*)(stab + pos * 32 + 8 * fq + 4);
                    const f32x4 a0 = acc[ai][0][m][0], a1 = acc[ai][0][m][1], b0 = acc[ai][1][m][0], b1 = acc[ai][1][m][1];
                    bf16_t* rowp = O + (size_t)row * ldc + col0;
                    *(u32x4*)(rowp) = pack8_bf16((a0 * c0 - b0 * s0) * sc, (a1 * c1 - b1 * s1) * sc);
                    *(u32x4*)(rowp + 32) = pack8_bf16((b0 * c0 + a0 * s0) * sc, (b1 * c1 + a1 * s1) * sc);
                    asm volatile("" ::: "memory"); }
        }
    }
};
struct EpiGateUp {
    static constexpr bool PERM = true, AFTER_DRAIN = false;
    bf16_t* O;
    __device__ __forceinline__ void operator()(const f32x4 (&acc)[2][2][4][2], const Unit& u, int wr, int wc, int fr, int fq) const {
        const int row0 = u.pm * BM + wr * 64 + fr, col0 = (u.pn & 7) * 128 + wc * 32 + 8 * fq;
#pragma unroll
        for (int ai = 0; ai < 2; ++ai)
#pragma unroll
            for (int m = 0; m < 4; ++m) { f32x4 r[2];
#pragma unroll
                for (int n = 0; n < 2; ++n) { const f32x4 g = acc[ai][0][m][n], up = acc[ai][1][m][n];
#pragma unroll
                    for (int i = 0; i < 4; ++i) { const float e = __builtin_amdgcn_exp2f(g[i] * -1.4426950408889634f); r[n][i] = g[i] * __builtin_amdgcn_rcpf(1.f + e) * up[i]; } }
                *(u32x4*)(O + (size_t)(row0 + ai * HALF + m * 16) * 1024 + col0) = pack8_bf16(r[0], r[1]); }
    }
};
struct EpiDown {
    static constexpr bool PERM = true, AFTER_DRAIN = false;
    bf16_t* O;
    __device__ __forceinline__ void operator()(const f32x4 (&acc)[2][2][4][2], const Unit& u, int wr, int wc, int fr, int fq) const {
        const int row0 = u.pm * BM + wr * 64 + fr, col0 = (u.pn & 7) * BM + wc * 32 + 8 * fq;
#pragma unroll
        for (int ai = 0; ai < 2; ++ai)
#pragma unroll
            for (int m = 0; m < 4; ++m) { bf16_t* rowp = O + (size_t)(row0 + ai * HALF + m * 16) * 2048 + col0;
#pragma unroll
                for (int bj = 0; bj < 2; ++bj) *(u32x4*)(rowp + bj * HALF) = pack8_bf16(acc[ai][bj][m][0], acc[ai][bj][m][1]); }
    }
};
constexpr float W8_SCALE = 64.f, ACT8_SCALE = 4.f;
__device__ __forceinline__ unsigned pack4_fp8(float a, float b, float c, float d) { int w; asm volatile("" : "=v"(w));
    w = __builtin_amdgcn_cvt_pk_fp8_f32(a, b, w, false); w = __builtin_amdgcn_cvt_pk_fp8_f32(c, d, w, true); return (unsigned)w; }
struct EpiGateUp8 {
    static constexpr bool PERM = true, AFTER_DRAIN = false;
    unsigned char* O;
    __device__ __forceinline__ void operator()(const f32x4 (&acc)[2][2][4][2], const Unit& u, int wr, int wc, int fr, int fq) const {
        const int row0 = u.pm * BM + wr * 64 + fr, col0 = (u.pn & 7) * 128 + wc * 32 + 8 * fq;
        constexpr float SI = 1.f / W8_SCALE;
#pragma unroll
        for (int ai = 0; ai < 2; ++ai)
#pragma unroll
            for (int m = 0; m < 4; ++m) { f32x4 r[2];
#pragma unroll
                for (int n = 0; n < 2; ++n) { const f32x4 g = acc[ai][0][m][n] * SI, up = acc[ai][1][m][n] * (SI * ACT8_SCALE);
#pragma unroll
                    for (int i = 0; i < 4; ++i) { const float e = __builtin_amdgcn_exp2f(g[i] * -1.4426950408889634f); r[n][i] = g[i] * __builtin_amdgcn_rcpf(1.f + e) * up[i]; } }
                u32x2 w; w.x = pack4_fp8(r[0][0], r[0][1], r[0][2], r[0][3]); w.y = pack4_fp8(r[1][0], r[1][1], r[1][2], r[1][3]);
                *(u32x2*)(O + (size_t)(row0 + ai * HALF + m * 16) * 1024 + col0) = w; }
    }
};
constexpr float YD8_SCALE = 16.f;
struct EpiDown8 {
    static constexpr bool PERM = true, AFTER_DRAIN = false;
    unsigned char* O;
    __device__ __forceinline__ void operator()(const f32x4 (&acc)[2][2][4][2], const Unit& u, int wr, int wc, int fr, int fq) const {
        const int row0 = u.pm * BM + wr * 64 + fr, col0 = (u.pn & 7) * BM + wc * 32 + 8 * fq;
        constexpr float SI = YD8_SCALE / (W8_SCALE * ACT8_SCALE);
#pragma unroll
        for (int ai = 0; ai < 2; ++ai)
#pragma unroll
            for (int m = 0; m < 4; ++m) { unsigned char* rowp = O + (size_t)(row0 + ai * HALF + m * 16) * 2048 + col0;
#pragma unroll
                for (int bj = 0; bj < 2; ++bj) { const f32x4 a = acc[ai][bj][m][0] * SI, c = acc[ai][bj][m][1] * SI; u32x2 w; w.x = pack4_fp8(a[0], a[1], a[2], a[3]); w.y = pack4_fp8(c[0], c[1], c[2], c[3]);
                    *(u32x2*)(rowp + bj * HALF) = w; } }
    }
};
struct MoeOrder {
    int nunits, G, c; const PG8_LAS int* tile_e;
    __device__ __forceinline__ bool next(int i, Unit& u) const {
        int idx;
        if ((G & 7) == 0) { const int per = G >> 3; idx = (i * 8 + (c & 7)) * per + (c >> 3); } else idx = i * G + c;
        if (idx >= nunits) return false;
        const int mt = idx >> 3; u.pm = mt; u.pn = tile_e[mt] * 8 + (idx & 7); return true;
    }
    __device__ __forceinline__ void a_ready(const Unit&) const {}
    __device__ __forceinline__ void done(const Unit&) const {}
};

template <class Epi, class Sched, bool ALIGN_EPI = false, bool SP2 = false, bool F8 = false, bool F16 = false>
__device__ __forceinline__ void gemm_phase(PG8_LAS unsigned char* lds, const Gemm g, const Sched& S, const Epi& E) {
    int tid_ = tid_from_wave(g.wave); asm volatile("" : "+v"(tid_));
    const int tid = tid_, wid = __builtin_amdgcn_readfirstlane(tid >> 6), lane = tid & 63, wr = wid >> 2, wc = wid & 3, fr = lane & 15, fq = lane >> 4;
    const int K = g.K, LD = g.ld, nt = K / BK;
    unsigned voffA, voffB;
    { int R, C; stage_rc(tid * 16, R, C); const int Rb = Epi::PERM ? ((R & ~31) + perm32(R & 31)) : R;
        voffA = (unsigned)(R * LD + C) * 2u; voffB = (unsigned)(Rb * LD + C) * 2u; }
    const size_t pstep = (size_t)64 * LD * 2;
    const size_t kstep = (size_t)(BK * 2);
    const size_t hstep = (size_t)HALF * LD * 2;
    const size_t tstep = 2 * hstep;
    const unsigned ldsbase = (unsigned)(uintptr_t)lds;
    const unsigned ldsw = (unsigned)wid * 1024u;
    const int aoff = lds_byte(wr * 64 + fr, fq * 8), boff = lds_byte(wc * 32 + fr, fq * 8);
#define PG8_SA(b, h) (((b) * 2 + (h)) * HTB)
#define PG8_SB(b, h) ((4 + (b) * 2 + (h)) * HTB)
#define PG8_STAGE(bufoff, gbase, voff) do { _Pragma("unroll") for (int _i = 0; _i < 2; ++_i) { unsigned keep_; \
        asm volatile("s_mov_b32 %0, m0\n\ts_mov_b32 m0, %3\n\ts_nop 0\n\tglobal_load_lds_dwordx4 %1, %2\n\ts_mov_b32 m0, %0" : "=&s"(keep_) \
            : "v"(voff), "s"((const char*)(gbase) + _i * pstep), "s"(ldsbase + (unsigned)(bufoff) + ldsw + (unsigned)(_i * 8192))); } } while (0)
#define PG8_CAT(a, b) __builtin_bit_cast(pg8_v8i, __builtin_shufflevector(a, b, 0, 1, 2, 3, 4, 5, 6, 7, 8, 9, 10, 11, 12, 13, 14, 15))
#define PG8_LDA(dst, b, h) do { if constexpr (F8) { _Pragma("unroll") for (int m = 0; m < 4; ++m) { const bf16x8 lo_ = *(const PG8_LAS bf16x8*)(lds + PG8_SA(b, h) + aoff + m * 2048), hi_ = *(const PG8_LAS bf16x8*)(lds + PG8_SA(b, h) + aoff + m * 2048 + 1024); dst##8[m] = PG8_CAT(lo_, hi_); } } \
        else { _Pragma("unroll") for (int m = 0; m < 4; ++m) _Pragma("unroll") for (int k = 0; k < 2; ++k) dst[m][k] = *(const PG8_LAS bf16x8*)(lds + PG8_SA(b, h) + aoff + m * 2048 + k * 1024); } } while (0)
#define PG8_LDB(dst, b, h) do { if constexpr (F8) { _Pragma("unroll") for (int n = 0; n < 2; ++n) { const bf16x8 lo_ = *(const PG8_LAS bf16x8*)(lds + PG8_SB(b, h) + boff + n * 2048), hi_ = *(const PG8_LAS bf16x8*)(lds + PG8_SB(b, h) + boff + n * 2048 + 1024); dst##8[n] = PG8_CAT(lo_, hi_); } } \
        else { _Pragma("unroll") for (int n = 0; n < 2; ++n) _Pragma("unroll") for (int k = 0; k < 2; ++k) dst[n][k] = *(const PG8_LAS bf16x8*)(lds + PG8_SB(b, h) + boff + n * 2048 + k * 1024); } } while (0)
#define PG8_MMA(ai, bj, At, Bt) do { __builtin_amdgcn_s_setprio(1); \
        if constexpr (F8) { _Pragma("unroll") for (int m = 0; m < 4; ++m) _Pragma("unroll") for (int n = 0; n < 2; ++n) \
            acc[ai][bj][m][n] = __builtin_amdgcn_mfma_scale_f32_16x16x128_f8f6f4(Bt##8[n], At##8[m], acc[ai][bj][m][n], 0, 0, 0, 0, 0, 0); } \
        else { _Pragma("unroll") for (int m = 0; m < 4; ++m) _Pragma("unroll") for (int n = 0; n < 2; ++n) _Pragma("unroll") for (int k = 0; k < 2; ++k) \
            acc[ai][bj][m][n] = F16 ? __builtin_amdgcn_mfma_f32_16x16x32_f16(__builtin_bit_cast(pg8_h8, Bt[n][k]), __builtin_bit_cast(pg8_h8, At[m][k]), acc[ai][bj][m][n], 0, 0, 0) \
                                    : __builtin_amdgcn_mfma_f32_16x16x32_bf16(Bt[n][k], At[m][k], acc[ai][bj][m][n], 0, 0, 0); } \
        __builtin_amdgcn_s_setprio(0); } while (0)
#define PG8_WAIT_V(n) asm volatile("s_waitcnt vmcnt(" #n ")" ::: "memory")
#define PG8_WAIT_L(n) asm volatile("s_waitcnt lgkmcnt(" #n ")" ::: "memory")
#define PG8_BAR __builtin_amdgcn_s_barrier()
#define PG8_SCHED __builtin_amdgcn_sched_barrier(0)
    Unit cur, nxt; int ui = 0;
    if (!S.next(0, cur)) return;
    f32x4 acc[2][2][4][2];
{ float zero_; asm volatile("v_mov_b32 %0, 0" : "=v"(zero_));
#pragma unroll
    for (int a = 0; a < 2; ++a)
#pragma unroll
        for (int b = 0; b < 2; ++b)
#pragma unroll
            for (int m = 0; m < 4; ++m)
#pragma unroll
                for (int n = 0; n < 2; ++n) acc[a][b][m][n] = (f32x4){zero_, zero_, zero_, zero_}; }
    bf16x8 At[4][2], B0[2][2], B1[2][2]; pg8_v8i At8[4], B08[2], B18[2];
    const char* cA = (const char*)g.A + (size_t)cur.pm * tstep; const char* cB = (const char*)g.Bt + (size_t)cur.pn * tstep;
    S.a_ready(cur);
    if constexpr (SP2) {
        PG8_STAGE(PG8_SB(0, 0), cB, voffB); PG8_STAGE(PG8_SB(0, 1), cB + hstep, voffB); PG8_STAGE(PG8_SA(0, 0), cA, voffA); PG8_STAGE(PG8_SA(0, 1), cA + hstep, voffA);
        if (wr == 1) PG8_BAR;
        PG8_WAIT_V(2); PG8_BAR;
        PG8_STAGE(PG8_SB(1, 0), cB + kstep, voffB); PG8_STAGE(PG8_SA(1, 0), cA + kstep, voffA); PG8_STAGE(PG8_SB(1, 1), cB + hstep + kstep, voffB);
        PG8_WAIT_V(6); PG8_BAR;
    } else {
        PG8_STAGE(PG8_SB(0, 0), cB, voffB); PG8_STAGE(PG8_SA(0, 0), cA, voffA); PG8_STAGE(PG8_SB(0, 1), cB + hstep, voffB); PG8_STAGE(PG8_SA(0, 1), cA + hstep, voffA);
        if (wr == 1) PG8_BAR;
        PG8_WAIT_V(4); PG8_BAR;
        PG8_STAGE(PG8_SB(1, 0), cB + kstep, voffB); PG8_STAGE(PG8_SA(1, 0), cA + kstep, voffA); PG8_STAGE(PG8_SB(1, 1), cB + hstep + kstep, voffB);
        PG8_WAIT_V(6); PG8_BAR;
    }
    for (;;) {
        const bool has_next = S.next(ui + 1, nxt);
        const char* nA = has_next ? (const char*)g.A + (size_t)nxt.pm * tstep : cA; const char* nB = has_next ? (const char*)g.Bt + (size_t)nxt.pn * tstep : cB;
#pragma unroll 1
        for (int t = 0; t < nt; t += 2) {
            const bool last = (t == nt - 2);
            const char* a1 = cA + (size_t)(t + 1) * kstep;
            const char* a2 = last ? nA : cA + (size_t)(t + 2) * kstep; const char* b2 = last ? nB : cB + (size_t)(t + 2) * kstep;
            const char* a3 = a2 + kstep; const char* b3 = b2 + kstep;
            if (last && has_next) S.a_ready(nxt);
            if constexpr (SP2) {
            PG8_LDB(B0, 0, 0); PG8_LDB(B1, 0, 1); PG8_SCHED; PG8_LDA(At, 0, 0); PG8_STAGE(PG8_SA(1, 1), a1 + hstep, voffA);
            PG8_WAIT_V(8); PG8_WAIT_L(0); PG8_BAR; PG8_MMA(0, 0, At, B0); PG8_MMA(0, 1, At, B1); PG8_BAR; PG8_SCHED;
            PG8_LDA(At, 0, 1); PG8_STAGE(PG8_SB(0, 0), b2, voffB); PG8_STAGE(PG8_SB(0, 1), b2 + hstep, voffB); PG8_STAGE(PG8_SA(0, 0), a2, voffA);
            PG8_WAIT_V(8); PG8_WAIT_L(0); PG8_BAR; PG8_MMA(1, 0, At, B0); PG8_MMA(1, 1, At, B1); PG8_BAR; PG8_SCHED;
            PG8_LDB(B0, 1, 0); PG8_LDB(B1, 1, 1); PG8_SCHED; PG8_LDA(At, 1, 0); PG8_STAGE(PG8_SA(0, 1), a2 + hstep, voffA);
            PG8_WAIT_V(8); PG8_WAIT_L(0); PG8_BAR; PG8_MMA(0, 0, At, B0); PG8_MMA(0, 1, At, B1); PG8_BAR; PG8_SCHED;
            PG8_LDA(At, 1, 1); PG8_STAGE(PG8_SB(1, 0), b3, voffB); PG8_STAGE(PG8_SB(1, 1), b3 + hstep, voffB); PG8_STAGE(PG8_SA(1, 0), a3, voffA);
            PG8_WAIT_V(8); PG8_WAIT_L(0); PG8_BAR; PG8_MMA(1, 0, At, B0); PG8_MMA(1, 1, At, B1); PG8_BAR; PG8_SCHED;
            } else {
            PG8_LDB(B0, 0, 0); PG8_SCHED; PG8_LDA(At, 0, 0); PG8_STAGE(PG8_SA(1, 1), a1 + hstep, voffA);
            PG8_WAIT_L(8); PG8_BAR; PG8_WAIT_L(0); PG8_MMA(0, 0, At, B0); PG8_BAR; PG8_SCHED;
            PG8_LDB(B1, 0, 1); PG8_STAGE(PG8_SB(0, 0), b2, voffB);
            PG8_BAR; PG8_WAIT_L(0); PG8_MMA(0, 1, At, B1); PG8_BAR;
            PG8_LDA(At, 0, 1); PG8_STAGE(PG8_SA(0, 0), a2, voffA);
            PG8_BAR; PG8_WAIT_L(0); PG8_MMA(1, 0, At, B0); PG8_BAR; PG8_SCHED;
            PG8_STAGE(PG8_SB(0, 1), b2 + hstep, voffB);
            PG8_WAIT_V(6); PG8_BAR; PG8_MMA(1, 1, At, B1); PG8_BAR;
            PG8_LDB(B0, 1, 0); PG8_SCHED; PG8_LDA(At, 1, 0); PG8_STAGE(PG8_SA(0, 1), a2 + hstep, voffA);
            PG8_WAIT_L(8); PG8_BAR; PG8_WAIT_L(0); PG8_MMA(0, 0, At, B0); PG8_BAR; PG8_SCHED;
            PG8_LDB(B1, 1, 1); PG8_STAGE(PG8_SB(1, 0), b3, voffB);
            PG8_BAR; PG8_WAIT_L(0); PG8_MMA(0, 1, At, B1); PG8_BAR;
            PG8_LDA(At, 1, 1); PG8_STAGE(PG8_SA(1, 0), a3, voffA);
            PG8_BAR; PG8_WAIT_L(0); PG8_MMA(1, 0, At, B0); PG8_BAR; PG8_SCHED;
            PG8_STAGE(PG8_SB(1, 1), b3 + hstep, voffB);
            PG8_WAIT_V(6); PG8_BAR; PG8_MMA(1, 1, At, B1); PG8_BAR;
            }
        }
        if constexpr (ALIGN_EPI) { if (wr == 0) PG8_BAR; }
        if constexpr (!Epi::AFTER_DRAIN) { const int t2_ = tid_from_wave(g.wave);
            E(acc, cur, wr, wc, t2_ & 15, (t2_ >> 4) & 3); S.done(cur); }
        if (!has_next) break;
{ float zero_; asm volatile("v_mov_b32 %0, 0" : "=v"(zero_));
#pragma unroll
        for (int a = 0; a < 2; ++a)
#pragma unroll
            for (int b = 0; b < 2; ++b)
#pragma unroll
                for (int m = 0; m < 4; ++m)
#pragma unroll
                    for (int n = 0; n < 2; ++n) acc[a][b][m][n] = (f32x4){zero_, zero_, zero_, zero_}; }
        cur = nxt; cA = nA; cB = nB; ++ui;
        if constexpr (ALIGN_EPI) { if (wr == 1) PG8_BAR; }
    }
    PG8_WAIT_V(0);
    if constexpr (!ALIGN_EPI) { if (wr == 0) PG8_BAR; }
    PG8_BAR;
    if constexpr (Epi::AFTER_DRAIN) { E.fused(acc, cur, wr, wc, fr, fq, lds, wid, lane); S.done(cur); }
#undef PG8_SA
#undef PG8_SB
#undef PG8_STAGE
#undef PG8_LDA
#undef PG8_LDB
#undef PG8_MMA
#undef PG8_CAT
#undef PG8_WAIT_V
#undef PG8_WAIT_L
#undef PG8_BAR
#undef PG8_SCHED
}
}

namespace att {
#define ALAS __attribute__((address_space(3)))
typedef unsigned short bf16_t;
typedef short bf16x8 __attribute__((ext_vector_type(8)));
typedef short s16x4 __attribute__((ext_vector_type(4)));
typedef float f32x16 __attribute__((ext_vector_type(16)));
typedef float f32x4 __attribute__((ext_vector_type(4)));
typedef unsigned u32x4 __attribute__((ext_vector_type(4)));
typedef ALAS char* ldsp;
#ifndef WO_F8
#define WO_F8 1
#endif
constexpr float OB8_SCALE = 8.f;
constexpr int QP = 6144;
constexpr int OP = 2048;
constexpr int OBP = 2048;
constexpr int SHM_V = 16384, SHM_K = 16384;
constexpr int LDS_V = 0, LDS_K = 2 * SHM_V, LDS_WS = LDS_K + 2 * SHM_K, ATT_LDS_BYTES = LDS_WS + 8 * 256;
#define KSWZ(row, colB) ((row) * 256 + ((colB) ^ (((row) & 7) << 4)))
#define KSWZ64(row, colB) ((row) * 128 + ((colB) ^ (((row) & 7) << 4)))
#define SBAR() __builtin_amdgcn_sched_barrier(0)
__device__ __forceinline__ int v_st(int k, int c) { const int kk = (k & ~0xC) | ((k & 4) << 1) | ((k & 8) >> 1); return ((kk >> 3) * 4 + (c >> 5)) * 512 + ((kk & 7) * 32 + (c & 31)) * 2; }
__device__ __forceinline__ int v_rd_base(int lane) { return ((lane & 3) << 3) | (((lane >> 2) & 3) << 6) | (((lane >> 4) & 1) << 5) | (((lane >> 5) & 1) << 8); }
constexpr int v_rd_off(int d0, int ks, int half) { return d0 * 512 + ks * 4096 + half * 2048; }
__device__ __forceinline__ int crow(int r, int hi) { return (r & 3) + 8 * (r >> 2) + 4 * hi; }
__device__ __forceinline__ unsigned cvtpk(float lo, float hi) { unsigned r; asm volatile("v_cvt_pk_bf16_f32 %0, %1, %2" : "=v"(r) : "v"(lo), "v"(hi)); return r; }
__device__ __forceinline__ bf16x8 ldg8(const bf16_t* p) { return *reinterpret_cast<const bf16x8*>(p); }
__device__ __forceinline__ unsigned quad_pack_fp8(float v) {
    const int b = __builtin_bit_cast(int, v);
    const float v1 = __builtin_bit_cast(float, __builtin_amdgcn_update_dpp(b, b, 0x55, 0xf, 0xf, false));
    const float v2 = __builtin_bit_cast(float, __builtin_amdgcn_update_dpp(b, b, 0xAA, 0xf, 0xf, false));
    const float v3 = __builtin_bit_cast(float, __builtin_amdgcn_update_dpp(b, b, 0xFF, 0xf, 0xf, false));
    int w; asm volatile("" : "=v"(w));
    w = __builtin_amdgcn_cvt_pk_fp8_f32(v, v1, w, false); w = __builtin_amdgcn_cvt_pk_fp8_f32(v2, v3, w, true); return (unsigned)w;
}
__device__ __forceinline__ float xhalf(float v, int hi) {
    auto rr = __builtin_amdgcn_permlane32_swap(__float_as_uint(v), __float_as_uint(v), false, false);
    return __uint_as_float(hi ? rr[0] : rr[1]);
}
#define ATT_PK4(P, B_, OUT) do { unsigned a0 = cvtpk(P[B_+0], P[B_+1]), a1 = cvtpk(P[B_+2], P[B_+3]);                      \
        unsigned b0 = cvtpk(P[B_+4], P[B_+5]), b1 = cvtpk(P[B_+6], P[B_+7]);                                             \
        auto r0 = __builtin_amdgcn_permlane32_swap(a0, b0, false, false); auto r1 = __builtin_amdgcn_permlane32_swap(a1, b1, false, false); \
        u32x4 w = {r0[0], r1[0], r0[1], r1[1]}; OUT = *reinterpret_cast<bf16x8*>(&w); } while (0)
__device__ __forceinline__ void pv_tile(f32x16* o, int vb, bf16x8 pa0, bf16x8 pa1, bf16x8 pa2, bf16x8 pa3) {
#define TRRD(dst, off) asm volatile("ds_read_b64_tr_b16 %0, %1 offset:%2" : "=&v"(dst) : "v"(vb), "i"(off) : "memory")
#define PV_D0(d0) do { s16x4 l0, l1, l2, l3, h0, h1, h2, h3; constexpr int b_ = v_rd_off(d0, 0, 0); \
        TRRD(l0, b_); TRRD(h0, b_ + 2048); TRRD(l1, b_ + 4096); TRRD(h1, b_ + 6144); TRRD(l2, b_ + 8192); TRRD(h2, b_ + 10240); TRRD(l3, b_ + 12288); TRRD(h3, b_ + 14336); \
        asm volatile("s_waitcnt lgkmcnt(0)" ::: "memory"); SBAR(); \
        o[d0] = __builtin_amdgcn_mfma_f32_32x32x16_bf16(pa0, (bf16x8){l0[0], l0[1], l0[2], l0[3], h0[0], h0[1], h0[2], h0[3]}, o[d0], 0, 0, 0);   \
        o[d0] = __builtin_amdgcn_mfma_f32_32x32x16_bf16(pa1, (bf16x8){l1[0], l1[1], l1[2], l1[3], h1[0], h1[1], h1[2], h1[3]}, o[d0], 0, 0, 0);   \
        o[d0] = __builtin_amdgcn_mfma_f32_32x32x16_bf16(pa2, (bf16x8){l2[0], l2[1], l2[2], l2[3], h2[0], h2[1], h2[2], h2[3]}, o[d0], 0, 0, 0);   \
        o[d0] = __builtin_amdgcn_mfma_f32_32x32x16_bf16(pa3, (bf16x8){l3[0], l3[1], l3[2], l3[3], h3[0], h3[1], h3[2], h3[3]}, o[d0], 0, 0, 0); } while (0)
    PV_D0(0); PV_D0(1); PV_D0(2); PV_D0(3);
#undef PV_D0
#undef TRRD
}

__device__ __forceinline__ void sb_block(const bf16_t* __restrict__ Qg, const bf16_t* __restrict__ Kg, const bf16_t* __restrict__ Vg, bf16_t* __restrict__ Og, int qb, ldsp lds, int wave_) {
    int tid_ = tid_from_wave(wave_); asm volatile("" : "+v"(tid_));
    const int tid = tid_, wid = __builtin_amdgcn_readfirstlane(tid >> 6), lane = tid & 63, r32 = lane & 31, hi = lane >> 5;
    const int NT = 4 * qb + 4, R0 = 256 * qb + 32 * wid, myrow = R0 + r32;
    const ldsp V_lds = lds + LDS_V; const ldsp K_lds = lds + LDS_K;
    bf16x8 qr[8];
    { const bf16_t* Qw = Qg + (size_t)R0 * QP; const unsigned qoff = (unsigned)(r32 * QP + hi * 8);
#pragma unroll
      for (int d0 = 0; d0 < 8; ++d0) qr[d0] = ldg8(Qw + (qoff + d0 * 16)); }
    const int sr = tid >> 4, sc = (tid & 15) * 8, kws = KSWZ(sr, sc * 2), vst0 = v_st(sr, sc), vst1 = v_st(32 + sr, sc);
    const unsigned kvoff = (unsigned)(sr * QP + sc);
    const int vb0 = (int)(unsigned)(uintptr_t)V_lds + v_rd_base(lane);
    bf16x8 sk0, sk1, sv0, sv1;
#define SB_LOAD(j) do { const bf16_t* kp_ = Kg + (size_t)(64 * (j)) * QP; const bf16_t* vp_ = Vg + (size_t)(64 * (j)) * QP; \
        sk0 = ldg8(kp_ + kvoff); sk1 = ldg8(kp_ + (size_t)32 * QP + kvoff); sv0 = ldg8(vp_ + kvoff); sv1 = ldg8(vp_ + (size_t)32 * QP + kvoff); } while (0)
#define SB_WRITE(bf) do { *(ALAS bf16x8*)(K_lds + (bf) * SHM_K + kws) = sk0; *(ALAS bf16x8*)(K_lds + (bf) * SHM_K + kws + 32 * 256) = sk1; \
        *(ALAS bf16x8*)(V_lds + (bf) * SHM_V + vst0) = sv0; *(ALAS bf16x8*)(V_lds + (bf) * SHM_V + vst1) = sv1; } while (0)
    SB_LOAD(NT - 1); SB_WRITE(0);
    __syncthreads();
    float carry = 0.f; f32x16 o[4] = {};
    ALAS int* fl = (ALAS int*)(lds + LDS_WS); bool wdone = false;
    for (int t = 0; t < NT; ++t) {
        const int j = NT - 1 - t, buf = t & 1, kb = 64 * j;
        if (t + 1 < NT) SB_LOAD(j - 1);
        if (kb <= R0 + 30 && !wdone) {
            f32x16 p0 = {}, p1 = {};
            { const ldsp Kb = K_lds + buf * SHM_K;
#pragma unroll
              for (int d0 = 0; d0 < 8; ++d0) { const ldsp a = Kb + KSWZ(r32, ((d0 & 3) * 16 + hi * 8) * 2) + (d0 >> 2) * 128;
                  const bf16x8 b0 = *(const ALAS bf16x8*)a, b1 = *(const ALAS bf16x8*)(a + 32 * 256);
                  p0 = __builtin_amdgcn_mfma_f32_32x32x16_bf16(b0, qr[d0], p0, 0, 0, 0);
                  p1 = __builtin_amdgcn_mfma_f32_32x32x16_bf16(b1, qr[d0], p1, 0, 0, 0); } }
            f32x16 lb0, lb1;
#pragma unroll
            for (int r = 0; r < 16; ++r) {
                { const float z = p0[r]; const float e = __builtin_amdgcn_exp2f(-__builtin_fabsf(z)); const float sp = __builtin_fmaxf(z, 0.f) + __builtin_amdgcn_logf(1.f + e); p0[r] = -sp; lb0[r] = z - sp; }
                { const float z = p1[r]; const float e = __builtin_amdgcn_exp2f(-__builtin_fabsf(z)); const float sp = __builtin_fmaxf(z, 0.f) + __builtin_amdgcn_logf(1.f + e); p1[r] = -sp; lb1[r] = z - sp; }
            }
            if (kb + 63 >= R0) {
                const int dq = myrow - kb - 4 * hi; const float NEG = -__builtin_inff();
#pragma unroll
                for (int r = 0; r < 16; ++r) { const int c = (r & 3) + 8 * (r >> 2);
                    if (c >= dq) { p0[r] = 0.f; lb0[r] = NEG; }
                    if (c + 32 >= dq) { p1[r] = 0.f; lb1[r] = NEG; } }
            }
            float gs[8], go[8];
#pragma unroll
            for (int g = 0; g < 4; ++g) { gs[g] = (p0[4 * g] + p0[4 * g + 1]) + (p0[4 * g + 2] + p0[4 * g + 3]); gs[4 + g] = (p1[4 * g] + p1[4 * g + 1]) + (p1[4 * g + 2] + p1[4 * g + 3]); }
#pragma unroll
            for (int i = 0; i < 8; ++i) go[i] = xhalf(gs[i], hi);
            float acc = carry;
#pragma unroll
            for (int idx = 7; idx >= 0; --idx) { const int g = idx & 3; const float base = acc + (hi ? 0.f : go[idx]);
                if (idx >= 4) { const float t3 = base, t2 = t3 + p1[4 * g + 3], t1 = t2 + p1[4 * g + 2], t0 = t1 + p1[4 * g + 1];
                    lb1[4 * g + 3] = __builtin_amdgcn_exp2f(lb1[4 * g + 3] + t3); lb1[4 * g + 2] = __builtin_amdgcn_exp2f(lb1[4 * g + 2] + t2);
                    lb1[4 * g + 1] = __builtin_amdgcn_exp2f(lb1[4 * g + 1] + t1); lb1[4 * g] = __builtin_amdgcn_exp2f(lb1[4 * g] + t0); }
                else { const float t3 = base, t2 = t3 + p0[4 * g + 3], t1 = t2 + p0[4 * g + 2], t0 = t1 + p0[4 * g + 1];
                    lb0[4 * g + 3] = __builtin_amdgcn_exp2f(lb0[4 * g + 3] + t3); lb0[4 * g + 2] = __builtin_amdgcn_exp2f(lb0[4 * g + 2] + t2);
                    lb0[4 * g + 1] = __builtin_amdgcn_exp2f(lb0[4 * g + 1] + t1); lb0[4 * g] = __builtin_amdgcn_exp2f(lb0[4 * g] + t0); }
                acc += gs[idx] + go[idx]; }
            carry = acc;
            bf16x8 pa0, pa1, pa2, pa3;
            ATT_PK4(lb0, 0, pa0); ATT_PK4(lb0, 8, pa1); ATT_PK4(lb1, 0, pa2); ATT_PK4(lb1, 8, pa3);
            SBAR();
            pv_tile(o, vb0 + buf * SHM_V, pa0, pa1, pa2, pa3);
            wdone = __all(carry < -127.f);
        }
        if (lane == 0) fl[buf * 8 + wid] = wdone ? 1 : 0;
        if (t + 1 < NT) SB_WRITE(buf ^ 1);
        __syncthreads();
        { const ALAS int* f = fl + buf * 8; if ((f[0] & f[1] & f[2] & f[3] & f[4] & f[5] & f[6] & f[7]) != 0) break; }
    }
#undef SB_LOAD
#undef SB_WRITE
#if WO_F8
    unsigned char* Ow = (unsigned char*)Og + (size_t)R0 * OBP; const unsigned ooff = (unsigned)(4 * hi * OBP + r32);
#pragma unroll
    for (int r = 0; r < 16; ++r) { unsigned char* rowp = Ow + (size_t)((r & 3) + 8 * (r >> 2)) * OBP;
#pragma unroll
        for (int d0 = 0; d0 < 4; ++d0) { const unsigned w = quad_pack_fp8(o[d0][r] * OB8_SCALE);
            if ((r32 & 3) == 0) *(unsigned*)(rowp + (ooff + d0 * 32)) = w; } }
#else
    bf16_t* Ow = Og + (size_t)R0 * OP; const unsigned ooff = (unsigned)(4 * hi * OP + r32);
#pragma unroll
    for (int r = 0; r < 16; ++r) { bf16_t* rowp = Ow + (size_t)((r & 3) + 8 * (r >> 2)) * OP;
#pragma unroll
        for (int d0 = 0; d0 < 4; ++d0) { const float v = o[d0][r]; const float vn = __shfl_xor(v, 1);
            if ((r32 & 1) == 0) *(unsigned*)(rowp + (ooff + d0 * 32)) = cvtpk(v, vn); } }
#endif
}

constexpr float ATT_THR = 8.f;
__device__ __forceinline__ void qkt64(f32x16& p0, f32x16& p1, ldsp Kb, int r32, int hi, const bf16x8* qr) {
    p0 = f32x16{}; p1 = f32x16{};
#pragma unroll
    for (int d0 = 0; d0 < 4; ++d0) { const ldsp a = Kb + KSWZ64(r32, (d0 * 16 + hi * 8) * 2);
        const bf16x8 b0 = *(const ALAS bf16x8*)a, b1 = *(const ALAS bf16x8*)(a + 32 * 128);
        p0 = __builtin_amdgcn_mfma_f32_32x32x16_bf16(b0, qr[d0], p0, 0, 0, 0);
        p1 = __builtin_amdgcn_mfma_f32_32x32x16_bf16(b1, qr[d0], p1, 0, 0, 0); }
}
__device__ __forceinline__ void partial_sm(f32x16& p0, f32x16& p1, float& m_reg, float& alpha, int hi) {
    float pmax = p0[0];
#pragma unroll
    for (int r = 1; r < 16; ++r) pmax = __builtin_fmaxf(pmax, p0[r]);
#pragma unroll
    for (int r = 0; r < 16; ++r) pmax = __builtin_fmaxf(pmax, p1[r]);
    pmax = __builtin_fmaxf(pmax, xhalf(pmax, hi));
    float mn;
    if (__builtin_expect(__all(pmax - m_reg <= ATT_THR), 1)) { mn = m_reg; alpha = 1.f; }
    else { mn = __builtin_fmaxf(m_reg, pmax); alpha = __builtin_amdgcn_exp2f(m_reg - mn); m_reg = mn; }
#pragma unroll
    for (int r = 0; r < 16; ++r) { p0[r] -= mn; p1[r] -= mn; }
#pragma unroll
    for (int r = 0; r < 16; ++r) p0[r] = __builtin_amdgcn_exp2f(p0[r]);
}
__device__ __forceinline__ void finish_sm(f32x16& p0, f32x16& p1, float alpha, float& l_reg, bf16x8& pa0, bf16x8& pa1, bf16x8& pa2, bf16x8& pa3, int hi) {
#pragma unroll
    for (int r = 0; r < 16; ++r) p1[r] = __builtin_amdgcn_exp2f(p1[r]);
    float ps = 0.f;
#pragma unroll
    for (int r = 0; r < 16; ++r) ps += p0[r];
#pragma unroll
    for (int r = 0; r < 16; ++r) ps += p1[r];
    ps += xhalf(ps, hi);
    l_reg = l_reg * alpha + ps;
    ATT_PK4(p0, 0, pa0); ATT_PK4(p0, 8, pa1); ATT_PK4(p1, 0, pa2); ATT_PK4(p1, 8, pa3);
}
__device__ __forceinline__ void mask_gt(f32x16& p0, f32x16& p1, int dq) {
    const float NEG = -__builtin_inff();
#pragma unroll
    for (int r = 0; r < 16; ++r) { const int c = (r & 3) + 8 * (r >> 2);
        if (c > dq) p0[r] = NEG;
        if (c + 32 > dq) p1[r] = NEG; }
}
template <bool SECOND>
__device__ __forceinline__ void diff_pass(const bf16_t* __restrict__ Qg, const bf16_t* __restrict__ Kg, const bf16_t* __restrict__ Vg, float* S1, bf16_t* __restrict__ Og,
                                          int qb, float lam, const float* __restrict__ gsub, float gmul, ldsp lds, int wave_) {
    int tid_ = tid_from_wave(wave_); asm volatile("" : "+v"(tid_));
    const int tid = tid_, wid = __builtin_amdgcn_readfirstlane(tid >> 6), lane = tid & 63, r32 = lane & 31, hi = lane >> 5;
    const int NT = 4 * qb + 4, R0 = 256 * qb + 32 * wid, myrow = R0 + r32;
    const ldsp V_lds = lds + LDS_V; const ldsp K_lds = lds + LDS_K;
    ALAS float* wsf = (ALAS float*)(lds + LDS_WS) + wid * 64; ALAS float* li_l = wsf; ALAS float* al_l = wsf + 32;
    bf16x8 qr[4];
    { const bf16_t* Qw = Qg + (size_t)R0 * QP; const unsigned qoff = (unsigned)(r32 * QP + hi * 8);
#pragma unroll
      for (int d0 = 0; d0 < 4; ++d0) qr[d0] = ldg8(Qw + (qoff + d0 * 16)); }
    const int sr = tid >> 4, sc = (tid & 15) * 8, vst0 = v_st(sr, sc), vst1 = v_st(32 + sr, sc);
    const int kr = tid >> 3, kc = (tid & 7) * 8, kws = KSWZ64(kr, kc * 2);
    const unsigned voff = (unsigned)(sr * QP + sc), koff = (unsigned)(kr * QP + kc);
    const int vb0 = (int)(unsigned)(uintptr_t)V_lds + v_rd_base(lane);
    const int qm = myrow - 4 * hi;
    bf16x8 sk0A, sv0A, sv1A, sk0B, sv0B, sv1B;
#define DF_LOAD(S_, j) do { const bf16_t* vp_ = Vg + (size_t)(64 * (j)) * QP; sk0##S_ = ldg8(Kg + (size_t)(64 * (j)) * QP + koff); sv0##S_ = ldg8(vp_ + voff); sv1##S_ = ldg8(vp_ + (size_t)32 * QP + voff); } while (0)
#define DF_WRITE(S_, bf) do { *(ALAS bf16x8*)(K_lds + (bf) * SHM_K + kws) = sk0##S_; *(ALAS bf16x8*)(V_lds + (bf) * SHM_V + vst0) = sv0##S_; *(ALAS bf16x8*)(V_lds + (bf) * SHM_V + vst1) = sv1##S_; } while (0)
#define DF_MASK(P0, P1, t) do { if (64 * (t) + 63 > R0) mask_gt(P0, P1, qm - 64 * (t)); } while (0)
#define DF_RESC(a) do { if (__any((a) < 1.f)) { if (hi == 0) al_l[r32] = (a); asm volatile("s_waitcnt lgkmcnt(0)" ::: "memory"); \
        _Pragma("unroll") for (int d_ = 0; d_ < 4; ++d_) _Pragma("unroll") for (int r = 0; r < 16; ++r) o[d_][r] *= al_l[crow(r, hi)]; } } while (0)
    float m_reg = -1e30f, l_reg = 0.f; f32x16 o[4] = {};
    f32x16 pA0, pA1, pB0, pB1; float alA = 1.f, alB = 1.f; bf16x8 pa0, pa1, pa2, pa3;
    DF_LOAD(A, 0); DF_WRITE(A, 0);
    __syncthreads();
    DF_LOAD(A, 1); DF_LOAD(B, 2);
    qkt64(pA0, pA1, K_lds, r32, hi, qr); DF_MASK(pA0, pA1, 0); partial_sm(pA0, pA1, m_reg, alA, hi);
    DF_WRITE(A, 1);
    DF_RESC(alA);
    __syncthreads();
#define DF_HALF(PX0, PX1, alX, PY0, PY1, alY, t, KB, VB, SB, LS, WS) do { \
        SBAR(); qkt64(PX0, PX1, K_lds + (KB) * SHM_K, r32, hi, qr); \
        finish_sm(PY0, PY1, alY, l_reg, pa0, pa1, pa2, pa3, hi); SBAR(); \
        if ((t) + 2 < NT) { DF_LOAD(LS, (t) + 2); SBAR(); } \
        pv_tile(o, vb0 + (VB) * SHM_V, pa0, pa1, pa2, pa3); DF_MASK(PX0, PX1, (t)); partial_sm(PX0, PX1, m_reg, alX, hi); \
        __syncthreads(); \
        if ((t) + 1 < NT) DF_WRITE(WS, SB); \
        DF_RESC(alX); __syncthreads(); } while (0)
    for (int t = 1; t + 1 < NT; t += 2) {
        DF_HALF(pB0, pB1, alB, pA0, pA1, alA, t, 1, 0, 0, A, B);
        DF_HALF(pA0, pA1, alA, pB0, pB1, alB, t + 1, 0, 1, 1, B, A);
    }
    DF_HALF(pB0, pB1, alB, pA0, pA1, alA, NT - 1, 1, 0, 0, A, B);
    finish_sm(pB0, pB1, alB, l_reg, pa0, pa1, pa2, pa3, hi); SBAR();
    pv_tile(o, vb0 + 1 * SHM_V, pa0, pa1, pa2, pa3);
#undef DF_LOAD
#undef DF_WRITE
#undef DF_MASK
#undef DF_RESC
#undef DF_HALF
    if (hi == 0) li_l[r32] = l_reg; asm volatile("s_waitcnt lgkmcnt(0)" ::: "memory");
    float rli[16];
#pragma unroll
    for (int r = 0; r < 16; ++r) rli[r] = __builtin_amdgcn_rcpf(li_l[crow(r, hi)]);
    if constexpr (!SECOND) {
        float* Sw = S1 + (size_t)R0 * OP; const unsigned ooff = (unsigned)(4 * hi * OP + r32);
#pragma unroll
        for (int r = 0; r < 16; ++r) { float* rowp = Sw + (size_t)((r & 3) + 8 * (r >> 2)) * OP;
#pragma unroll
            for (int d0 = 0; d0 < 4; ++d0) rowp[ooff + d0 * 32] = o[d0][r] * rli[r]; }
    } else {
        const float* Sw = S1 + (size_t)R0 * OP; bf16_t* Ow = Og + (size_t)R0 * OP; (void)Ow; const unsigned ooff = (unsigned)(4 * hi * OP + r32), ooff8 = (unsigned)(4 * hi * OBP + r32);
        float gn[4];
#pragma unroll
        for (int d0 = 0; d0 < 4; ++d0) gn[d0] = gsub[d0 * 32 + r32] * gmul;
#pragma unroll
        for (int r = 0; r < 16; ++r) { const float* srow = Sw + (size_t)((r & 3) + 8 * (r >> 2)) * OP; float d[4]; float ss = 0.f;
#if WO_F8
            unsigned char* orowp = (unsigned char*)Og + (size_t)(R0 + (r & 3) + 8 * (r >> 2)) * OBP;
#else
            bf16_t* orowp = Ow + (size_t)((r & 3) + 8 * (r >> 2)) * OP;
#endif
#pragma unroll
            for (int d0 = 0; d0 < 4; ++d0) { d[d0] = srow[ooff + d0 * 32] - lam * (o[d0][r] * rli[r]); ss += d[d0] * d[d0]; }
            ss += __builtin_bit_cast(float, __builtin_amdgcn_update_dpp(0, __builtin_bit_cast(int, ss), 0xB1, 0xf, 0xf, true));
            ss += __builtin_bit_cast(float, __builtin_amdgcn_update_dpp(0, __builtin_bit_cast(int, ss), 0x4E, 0xf, 0xf, true));
            ss += __builtin_bit_cast(float, __builtin_amdgcn_update_dpp(0, __builtin_bit_cast(int, ss), 0x141, 0xf, 0xf, true));
            ss += __builtin_bit_cast(float, __builtin_amdgcn_update_dpp(0, __builtin_bit_cast(int, ss), 0x140, 0xf, 0xf, true));
            { auto rr = __builtin_amdgcn_permlane16_swap(__float_as_uint(ss), __float_as_uint(ss), false, false); ss = __uint_as_float(rr[0]) + __uint_as_float(rr[1]); }
            const float rs = __builtin_amdgcn_rsqf(ss * (1.f / 128.f) + 1e-5f);
#pragma unroll
#if WO_F8
            for (int d0 = 0; d0 < 4; ++d0) { const unsigned w = quad_pack_fp8(d[d0] * rs * gn[d0] * OB8_SCALE);
                if ((r32 & 3) == 0) *(unsigned*)(orowp + (ooff8 + d0 * 32)) = w; }
#else
            for (int d0 = 0; d0 < 4; ++d0) { const float v = d[d0] * rs * gn[d0]; const float vn = __shfl_xor(v, 1);
                if ((r32 & 1) == 0) *(unsigned*)(orowp + (ooff + d0 * 32)) = cvtpk(v, vn); }
#endif
            if ((r & 1) == 1) asm volatile("" ::: "memory"); }
    }
    __syncthreads();
}
#undef SBAR
}

#define LAS __attribute__((address_space(3)))

#define XB_TMO      128
#define XB_XCNT(j)  (256  + 64 * (j))
#define XB_XSUB(j)  (1280 + 64 * (j))
#define XB_XGEN(j)  (2304 + 64 * (j))
#define XB_TOP      3328
#define XB_TOPGEN   3392
#define XCD_BAR_WORDS 3456
#define XB_SPIN_CAP (1u << 18)

__device__ __forceinline__ unsigned xb_ld(unsigned* p)              { return __hip_atomic_load(p, __ATOMIC_RELAXED, __HIP_MEMORY_SCOPE_AGENT); }
__device__ __forceinline__ unsigned xb_add(unsigned* p, unsigned v) { return __hip_atomic_fetch_add(p, v, __ATOMIC_RELAXED, __HIP_MEMORY_SCOPE_AGENT); }
__device__ __forceinline__ unsigned xb_xcc_id() { return (unsigned)__builtin_amdgcn_s_getreg((3 << 11) | 20) & 0xFu; }
#define XB_SPIN(cond, bar) do { unsigned _sp = 0; while (cond) { __builtin_amdgcn_s_sleep(1); \
    if ((++_sp & 255u) == 0u) { if (xb_ld(&(bar)[XB_TMO])) break; if (_sp > XB_SPIN_CAP) { atomicAdd(&(bar)[XB_TMO], 1u); break; } } } } while (0)

struct XcdBarrier {
    unsigned* bar; unsigned x;
    volatile LAS unsigned* st;
};

__device__ __forceinline__ XcdBarrier xcd_barrier_post(unsigned* bar, volatile LAS unsigned* st, bool thread0) {
    XcdBarrier b; b.bar = bar; b.x = xb_xcc_id(); b.st = st;
    if (thread0) (void)xb_add(&bar[XB_XCNT(b.x)], 1u);
    return b;
}
__device__ __forceinline__ void xcd_barrier_complete(unsigned* bar, unsigned x, unsigned& nloc, unsigned& nx) {
    const unsigned G = gridDim.x * gridDim.y * gridDim.z;
    unsigned sum, cnt, mine, sp = 0u;
    for (;;) {
        sum = 0u; cnt = 0u; mine = 0u;
#pragma unroll
        for (unsigned j = 0; j < 16; ++j) { const unsigned c = xb_ld(&bar[XB_XCNT(j)]); sum += c; cnt += (c > 0u) ? 1u : 0u; mine = (j == x) ? c : mine; }
        if (sum == G) break;
        __builtin_amdgcn_s_sleep(1);
        if ((++sp & 255u) == 0u) { if (xb_ld(&bar[XB_TMO])) break; if (sp > XB_SPIN_CAP) { atomicAdd(&bar[XB_TMO], 1u); break; } }
    }
    nloc = mine > 0u ? mine : 1u; nx = cnt > 0u ? cnt : 1u;
}

__device__ __forceinline__ void xcd_barrier(const XcdBarrier& b, bool thread0) {
    asm volatile("s_waitcnt vmcnt(0)" ::: "memory");
    __syncthreads();
    if (thread0) {
        unsigned* bar = b.bar;
        __builtin_amdgcn_s_waitcnt(0);
        unsigned nloc = b.st[0], nx = b.st[1];
        if (nloc == 0u) { xcd_barrier_complete(bar, b.x, nloc, nx); b.st[0] = nloc; b.st[1] = nx; }
        const unsigned old = xb_add(&bar[XB_XSUB(b.x)], 1u);
        const unsigned gen = old / nloc;
        if (old + 1u == (gen + 1u) * nloc) {
            __builtin_amdgcn_fence(__ATOMIC_RELEASE, "agent");
            asm volatile("s_waitcnt vmcnt(0)" ::: "memory");
            const unsigned og = xb_add(&bar[XB_TOP], 1u);
            const unsigned tg = og / nx;
            if (og + 1u == (tg + 1u) * nx) xb_add(&bar[XB_TOPGEN], 1u);
            else XB_SPIN(xb_ld(&bar[XB_TOPGEN]) == tg, bar);
            __builtin_amdgcn_fence(__ATOMIC_ACQUIRE, "agent");
            xb_add(&bar[XB_XGEN(b.x)], 1u);
            asm volatile("s_waitcnt vmcnt(0)" ::: "memory");
        } else {
            XB_SPIN(xb_ld(&bar[XB_XGEN(b.x)]) == gen, bar);
            __builtin_amdgcn_fence(__ATOMIC_ACQUIRE, "agent");
            asm volatile("s_waitcnt vmcnt(0)" ::: "memory");
        }
    }
    __syncthreads();
}

constexpr int NWAVES = 8;
constexpr int NTOK = 16384, DM = 2048, SEQ = 2048, NHEAD = 16, NLAYER = 4, NEXP = 16, DEXP = 1024;
constexpr int XS_ROWS = 36864;
constexpr float LN_EPS = 1e-5f;
constexpr float DN_ALPHA = 1.6817928305074292f;
constexpr float LOG2E = 1.4426950408889634f;
constexpr float SB_QSCALE = 0.08838834764831845f * LOG2E;
constexpr float DF_QSCALE = 0.125f * LOG2E;
#ifndef MK_MULTI
#define MK_MULTI 0
#endif
#ifndef MOE_F8
#define MOE_F8 1
#endif
#ifndef QKV8_A
#define QKV8_A 1
#endif
#ifndef QKV8_B
#define QKV8_B 0
#endif
constexpr int NSTEPS = 1 + 8 * NLAYER;

constexpr size_t MiB = 1u << 20;
constexpr size_t WS_CTL = 0, CTL_ZERO_BYTES = 64 * 1024;
constexpr size_t WS_COS = 1 * MiB, WS_SIN = WS_COS + 256 * 1024;
constexpr size_t WS_WR = 2 * MiB;
constexpr size_t WS_CNT = 3 * MiB;
constexpr size_t WS_RE = WS_CNT + 64 * 1024;
constexpr size_t WS_RW = WS_RE + 64 * 1024;
constexpr size_t WS_RP = WS_RW + 128 * 1024;
constexpr int LDH = 2048;
constexpr int P8K2 = 2048, P8K1 = 1024;
constexpr size_t WS_WQKVA = 4 * MiB;
constexpr size_t WS_WOA = WS_WQKVA + 56 * MiB;
constexpr size_t WS_WQKVB = WS_WOA + 16 * MiB;
constexpr size_t WS_WOB = WS_WQKVB + 36 * MiB;
constexpr size_t WS_WGU = WS_WOB + 16 * MiB;
constexpr size_t WS_WDN = WS_WGU + 512 * MiB;
constexpr size_t WS_H = WS_WDN + 256 * MiB;
constexpr size_t WS_HB = WS_H + 128 * MiB;
constexpr size_t WS_QKV = WS_HB + 68 * MiB;
constexpr size_t WS_OB = WS_QKV + 192 * MiB;
constexpr size_t WS_XS = WS_OB + 64 * MiB;
constexpr size_t WS_ACT = WS_XS + 144 * MiB;
constexpr size_t WS_YD = WS_ACT + 72 * MiB;
constexpr size_t WS_END = WS_YD + 144 * MiB;
static_assert(WS_END <= (size_t)2040 * MiB, "workspace map");
static_assert((size_t)2 * 6144 * LDH * 2 <= 56 * MiB && (size_t)8192 * LDH * 2 <= 36 * MiB && (size_t)2 * 2048 * P8K2 <= 16 * MiB && (size_t)64 * 2048 * P8K2 <= 512 * MiB && (size_t)64 * 2048 * P8K1 <= 256 * MiB, "weight regions");
static_assert((size_t)NTOK * LDH * 2 <= 68 * MiB && (size_t)NTOK * P8K2 <= 64 * MiB && (size_t)XS_ROWS * P8K2 <= 144 * MiB && (size_t)XS_ROWS * P8K1 <= 72 * MiB, "activation regions");
constexpr int CW_BAR = 1024;
constexpr int LDS_BYTES = 147456;
constexpr int LDSCTL_OFF = 145408;
constexpr int RING_OFF = 0;
constexpr int LNX_OFF = 131072;

#define GAS __attribute__((address_space(1)))
typedef unsigned short bf16;
typedef unsigned v4u __attribute__((ext_vector_type(4)));
typedef unsigned v2u __attribute__((ext_vector_type(2)));
typedef float f32x4 __attribute__((ext_vector_type(4)));
typedef float f32x2 __attribute__((ext_vector_type(2)));
typedef _Float16 f16x4 __attribute__((ext_vector_type(4)));
__device__ __forceinline__ f32x4 ldh4(const _Float16* p) { return __builtin_convertvector(*(const f16x4*)p, f32x4); }
__device__ __forceinline__ void sth4(_Float16* p, f32x4 v) { *(f16x4*)p = __builtin_convertvector(v, f16x4); }
#define LDS_WAIT() asm volatile("s_waitcnt lgkmcnt(0)" ::: "memory")
#define VM_WAIT() asm volatile("s_waitcnt vmcnt(0)" ::: "memory")
__device__ __forceinline__ unsigned pk2(float lo, float hi) { unsigned r; asm volatile("v_cvt_pk_bf16_f32 %0, %1, %2" : "=v"(r) : "v"(lo), "v"(hi)); return r; }
__device__ __forceinline__ int opq_tid(int wave) { int t = tid_from_wave(wave); asm volatile("" : "+v"(t)); return t; }
__device__ __forceinline__ float dpp_sum(float v) {
    v += __builtin_bit_cast(float, __builtin_amdgcn_update_dpp(0, __builtin_bit_cast(int, v), 0xB1, 0xf, 0xf, true));
    v += __builtin_bit_cast(float, __builtin_amdgcn_update_dpp(0, __builtin_bit_cast(int, v), 0x4E, 0xf, 0xf, true));
    v += __builtin_bit_cast(float, __builtin_amdgcn_update_dpp(0, __builtin_bit_cast(int, v), 0x141, 0xf, 0xf, true));
    v += __builtin_bit_cast(float, __builtin_amdgcn_update_dpp(0, __builtin_bit_cast(int, v), 0x140, 0xf, 0xf, true));
    const int b = __builtin_bit_cast(int, v);
    const float s0 = __builtin_bit_cast(float, __builtin_amdgcn_readlane(b, 0)), s1 = __builtin_bit_cast(float, __builtin_amdgcn_readlane(b, 16));
    const float s2 = __builtin_bit_cast(float, __builtin_amdgcn_readlane(b, 32)), s3 = __builtin_bit_cast(float, __builtin_amdgcn_readlane(b, 48));
    return (s0 + s1) + (s2 + s3);
}
__device__ __forceinline__ float wave_sum(float v) {
#pragma unroll
    for (int o = 1; o < 64; o <<= 1) v += __shfl_xor(v, o);
    return v;
}

struct Args { const float* in[17]; float* out; unsigned char* ws; int s_lo, s_hi; };

__device__ __forceinline__ int map_row(int n, int mode) {
    if (mode == 0) return n;
    if (mode == 1) { const int c = n & 255, blk = c >> 6, d = c & 63; return (n & ~255) + ((d >> 5) << 7) + (blk << 5) + (d & 31); }
    return ((n >> 7) << 8) + (n & 127) + (mode == 3 ? 128 : 0);
}
__device__ __forceinline__ unsigned pk2h(float lo, float hi) { typedef _Float16 h2 __attribute__((ext_vector_type(2))); const f32x2 v = {lo, hi}; return __builtin_bit_cast(unsigned, __builtin_convertvector(v, h2)); }
template <bool HALF = false>
__device__ __forceinline__ void cvt_item(const float* __restrict__ src, int pitch, int K, bf16* __restrict__ dst, int mode, int k0, int n0, LAS float* scr, int lane) {
    const int kr = lane >> 4, n4 = (lane & 15) * 4;
    f32x4 v[16];
#pragma unroll
    for (int i = 0; i < 16; ++i) v[i] = __builtin_nontemporal_load((const f32x4*)(src + (size_t)(k0 + 4 * i + kr) * pitch + n0 + n4));
#pragma unroll
    for (int i = 0; i < 16; ++i) { LAS float* s = scr + (4 * i + kr) * 65 + n4; s[0] = v[i][0]; s[1] = v[i][1]; s[2] = v[i][2]; s[3] = v[i][3]; }
    LDS_WAIT();
    const int c = lane & 7;
#pragma unroll
    for (int j = 0; j < 8; ++j) { const int nl = (lane >> 3) + 8 * j; const int row = map_row(n0 + nl, mode);
        const LAS float* s = scr + (8 * c) * 65 + nl;
        v4u o; if (HALF) { o.x = pk2h(s[0], s[65]); o.y = pk2h(s[130], s[195]); o.z = pk2h(s[260], s[325]); o.w = pk2h(s[390], s[455]); }
        else { o.x = pk2(s[0], s[65]); o.y = pk2(s[130], s[195]); o.z = pk2(s[260], s[325]); o.w = pk2(s[390], s[455]); }
        *(v4u*)(dst + (size_t)row * K + k0 + 8 * c) = o; }
    LDS_WAIT();
}

__device__ __forceinline__ void cvt_item8(const float* __restrict__ src, int pitch, int K, unsigned char* __restrict__ dst, int mode, int k0, int n0, float scale, LAS float* scr, int lane) {
    const int kr = lane >> 4, n4 = (lane & 15) * 4;
    f32x4 v[16];
#pragma unroll
    for (int i = 0; i < 16; ++i) v[i] = __builtin_nontemporal_load((const f32x4*)(src + (size_t)(k0 + 4 * i + kr) * pitch + n0 + n4));
#pragma unroll
    for (int i = 0; i < 16; ++i) { LAS float* s = scr + (4 * i + kr) * 65 + n4; s[0] = v[i][0] * scale; s[1] = v[i][1] * scale; s[2] = v[i][2] * scale; s[3] = v[i][3] * scale; }
    LDS_WAIT();
    const int c = lane & 3;
#pragma unroll
    for (int j = 0; j < 4; ++j) { const int nl = (lane >> 2) + 16 * j; const int row = map_row(n0 + nl, mode);
        const LAS float* s = scr + (16 * c) * 65 + nl;
        v4u o; o.x = pg8::pack4_fp8(s[0], s[65], s[130], s[195]); o.y = pg8::pack4_fp8(s[260], s[325], s[390], s[455]);
        o.z = pg8::pack4_fp8(s[520], s[585], s[650], s[715]); o.w = pg8::pack4_fp8(s[780], s[845], s[910], s[975]);
        *(v4u*)(dst + (size_t)row * K + k0 + 16 * c) = o; }
    LDS_WAIT();
}

__global__ void __launch_bounds__(NWAVES * 64, 2) yoco_fwd(Args args) {
    extern __shared__ __attribute__((aligned(16))) unsigned char lds_raw[];
    LAS unsigned char* const lds = (LAS unsigned char*)lds_raw;
    const int tid = threadIdx.x, lane = tid & 63, wave = __builtin_amdgcn_readfirstlane(tid >> 6);
    const int G = gridDim.x, bx = blockIdx.x;
    const int vcu = (G % 8 == 0) ? (bx % 8) * (G / 8) + bx / 8 : bx;
    unsigned char* const ws = args.ws;
    volatile LAS unsigned* const CTL = (volatile LAS unsigned*)(lds + LDSCTL_OFF);
    LAS int* const TAB = (LAS int*)(lds + LDSCTL_OFF + 64);
    for (int u = tid; u < (LDS_BYTES - LDSCTL_OFF) / 4; u += NWAVES * 64) ((LAS unsigned*)(lds + LDSCTL_OFF))[u] = 0u;
    __syncthreads();
    const int s_lo = args.s_lo, s_hi = args.s_hi;
    XcdBarrier bar; bar.bar = (unsigned*)(ws + WS_CTL) + CW_BAR; bar.x = 0; bar.st = nullptr;
    if (s_hi - s_lo > 1) bar = xcd_barrier_post((unsigned*)(ws + WS_CTL) + CW_BAR, CTL, tid == 0);
#ifndef PH_MASK
#define PH_MASK 0xFFFF
#endif
#define PHM(b) (((PH_MASK) >> (b)) & 1)
#ifndef PROBE_DUP
#define PROBE_DUP 0
#endif
#define PREP(b) _Pragma("unroll 1") for (int rep_ = 0; rep_ < ((((PROBE_DUP) >> (b)) & 1) ? 2 : 1); ++rep_)
#define IN(k) (s_lo <= (k) && (k) < s_hi)
#define SEAM(k) do { if ((k) + 1 < s_hi) xcd_barrier(bar, tid_from_wave(wave) == 0); } while (0)

    const float* const x_in = args.in[0];
    _Float16* const H = (_Float16*)(ws + WS_H); unsigned char* const HB8 = (unsigned char*)(ws + WS_OB + 32 * MiB);     bf16* const QKV = (bf16*)(ws + WS_QKV); bf16* const OB = (bf16*)(ws + WS_OB);
    bf16* const MIX = (bf16*)(ws + WS_YD);     bf16* const XS = (bf16*)(ws + WS_XS); float* const S1 = (float*)(ws + WS_XS); bf16* const ACT = (bf16*)(ws + WS_ACT); bf16* const YD = (bf16*)(ws + WS_YD);
    float* const COS = (float*)(ws + WS_COS); float* const SIN = (float*)(ws + WS_SIN); float* const WR = (float*)(ws + WS_WR);
    int* const CNT = (int*)(ws + WS_CNT); unsigned* const RE = (unsigned*)(ws + WS_RE); f32x2* const RW = (f32x2*)(ws + WS_RW); int* const RP = (int*)(ws + WS_RP);

    if (IN(0) && PHM(0)) { PREP(0) {
        const int tid = opq_tid(wave), lane = tid & 63;
        LAS float* scr = (LAS float*)(lds + RING_OFF + wave * 16640);
        const int gw = vcu * NWAVES + wave, NGW = G * NWAVES;
        constexpr int I0 = 2 * 3072, I1 = 8 * 1024, I2 = 128 * 512, I3 = 64 * 512, NITEMS = I0 + I1 + I2 + I3;
        for (int it = gw; it < NITEMS; it += NGW) {
            int r = it;
            if (r < I0) { const int job = r / 3072; r -= job * 3072; const int kb = r / 96, nb = r - kb * 96;
                if (QKV8_A) cvt_item8(args.in[1] + (size_t)job * 2048 * 6144, 6144, 2048, (unsigned char*)(ws + WS_WQKVA) + (size_t)job * 6144 * 2048, 0, kb * 64, nb * 64, pg8::W8_SCALE, scr, lane);
                else cvt_item(args.in[1] + (size_t)job * 2048 * 6144, 6144, LDH, (bf16*)(ws + WS_WQKVA) + (size_t)job * 6144 * LDH, 0, kb * 64, nb * 64, scr, lane);
                continue; }
            r -= I0;
            if (r < I1) { const int job = r >> 10; r &= 1023; const int kb = r >> 5, nb = r & 31;
                const float* src; int pitch = 2048, mode = 0; bf16* dst;
                if (job < 2) { src = args.in[2] + (size_t)job * 2048 * 2048; dst = (bf16*)(ws + WS_WOA + (size_t)job * 2048 * P8K2); }
                else if (job == 2) { src = args.in[4]; dst = (bf16*)(ws + WS_WQKVB); mode = 1; }
                else if (job == 3) { src = args.in[3]; pitch = 4096; dst = (bf16*)(ws + WS_WQKVB) + (size_t)2048 * LDH; mode = 1; }
                else if (job == 4) { src = args.in[3] + 2048; pitch = 4096; dst = (bf16*)(ws + WS_WQKVB) + (size_t)4096 * LDH; }
                else if (job == 5) { src = args.in[4] + (size_t)2048 * 2048; dst = (bf16*)(ws + WS_WQKVB) + (size_t)6144 * LDH; mode = 1; }
                else { src = args.in[5] + (size_t)(job - 6) * 2048 * 2048; dst = (bf16*)(ws + WS_WOB + (size_t)(job - 6) * 2048 * P8K2); }
                if (job < 2 || job >= 6) { cvt_item8(src, pitch, P8K2, (unsigned char*)dst, mode, kb * 64, nb * 64, pg8::W8_SCALE, scr, lane); continue; }
                if (QKV8_B) { cvt_item8(src, pitch, 2048, (unsigned char*)(ws + WS_WQKVB) + (size_t)((job == 2) ? 0 : (job == 3) ? 2048 : (job == 4) ? 4096 : 6144) * 2048, mode, kb * 64, nb * 64, pg8::W8_SCALE, scr, lane); continue; }
                cvt_item<true>(src, pitch, LDH, dst, mode, kb * 64, nb * 64, scr, lane); continue; }
            r -= I1;
            if (r < I2) { const int job = r >> 9; r &= 511; const int kb = r >> 4, nb = r & 15; const int le = job >> 1, up = job & 1;
                cvt_item8((up ? args.in[15] : args.in[14]) + (size_t)le * 2048 * 1024, 1024, P8K2, (unsigned char*)(ws + WS_WGU) + (size_t)le * 2048 * P8K2, 2 + up, kb * 64, nb * 64, pg8::W8_SCALE, scr, lane); continue; }
            r -= I2;
            { const int le = r >> 9; r &= 511; const int kb = r >> 5, nb = r & 31;
                cvt_item8(args.in[16] + (size_t)le * 1024 * 2048, 2048, P8K1, (unsigned char*)(ws + WS_WDN) + (size_t)le * 2048 * P8K1, 0, kb * 64, nb * 64, pg8::W8_SCALE, scr, lane); }
        }
        for (size_t i = (size_t)gw * 64 + lane; i < (size_t)NTOK * DM / 4; i += (size_t)NGW * 64) {
            const f32x4 v = ((const f32x4*)x_in)[i];
            ((unsigned*)HB8)[i] = pg8::pack4_fp8(v[0], v[1], v[2], v[3]); }
        for (int i = bx * (NWAVES * 64) + tid; i < 2048 * 32; i += G * NWAVES * 64) { const int pos = i >> 5, f = i & 31;
            const float inv = __builtin_amdgcn_exp2f(-(float)f * 0.4152410118609203f); const float ang = (float)pos * inv;
            const double tr = (double)ang * 0.15915494309189535; const float fr = (float)(tr - __builtin_rint(tr));
            COS[i] = __builtin_amdgcn_cosf(fr); SIN[i] = __builtin_amdgcn_sinf(fr); }
        for (int i = bx * (NWAVES * 64) + tid; i < NLAYER * 20 * 2048; i += G * NWAVES * 64) { const int k = i & 2047, c = (i >> 11) % 20, l = i / (20 * 2048);
            WR[i] = c < 4 ? args.in[12][((size_t)l * 2048 + k) * 4 + c] : args.in[13][(((size_t)l * 4 + ((c - 4) >> 2)) * 2048 + k) * 4 + ((c - 4) & 3)]; }
        }
        SEAM(0);
    }

    for (int L = 0; L < NLAYER; ++L) {
        const int sb = 1 + 8 * L; const bool typeA = L < 2;
        if (IN(sb + 0)) {
            if (typeA && PHM(1)) { PREP(1) {
                pg8::StaticOrder S; S.init(NTOK, 6144, G, bx);
                if (QKV8_A) { pg8::Gemm g{(const bf16*)HB8, (const bf16*)(ws + WS_WQKVA + (size_t)L * 6144 * 2048), NTOK, 6144, DM / 2, DM / 2, wave}; pg8::EpiQkv E{QKV, 6144, 2048, SB_QSCALE, 1.f / pg8::W8_SCALE};
                    pg8::gemm_phase<pg8::EpiQkv, pg8::StaticOrder, true, true, true>(lds + RING_OFF, g, S, E); }
                } static_assert(QKV8_A == 1, "the stick-breaking layers' q|k|v GEMM takes the e4m3 copy of the stream");
            } else if (!typeA && PHM(2)) { PREP(2) {
                const int N = (L == 2) ? 6144 : 2048;
                pg8::StaticOrder S; S.init(NTOK, N, G, bx);
                if (QKV8_B) { pg8::Gemm g{(const bf16*)HB8, (const bf16*)(ws + WS_WQKVB + (L == 2 ? (size_t)0 : (size_t)6144 * 2048)), NTOK, N, DM / 2, DM / 2, wave};
                    pg8::EpiRope E{QKV, 6144, 2048, 4096, DF_QSCALE, COS, SIN, 1.f / pg8::W8_SCALE};
                    pg8::gemm_phase<pg8::EpiRope, pg8::StaticOrder, true, true, true>(lds + RING_OFF, g, S, E); }
                else { pg8::Gemm g{(const bf16*)H, (const bf16*)(ws + WS_WQKVB) + (L == 2 ? (size_t)0 : (size_t)6144 * LDH), NTOK, N, DM, LDH, wave};
                    pg8::EpiRope E{QKV, 6144, 2048, 4096, DF_QSCALE, COS, SIN, 1.f};
                    pg8::gemm_phase<pg8::EpiRope, pg8::StaticOrder, true, true, false, true>(lds + RING_OFF, g, S, E); } }
            }
            SEAM(sb + 0);
        }
        if (IN(sb + 1)) {
            if (typeA && PHM(3)) {
                for (int id_ = vcu; id_ < 512 * (1 + ((PROBE_DUP >> 3) & 1)); id_ += G) { const int id = id_ & 511; const int bh = id >> 2, p = id & 3, b = bh >> 4, h = bh & 15;
                    const bf16* Qg = QKV + (size_t)b * SEQ * 6144 + h * 128; bf16* Og = (bf16*)((unsigned char*)OB + (size_t)b * SEQ * P8K2 + h * 128);
                    att::sb_block(Qg, Qg + 2048, Qg + 4096, Og, 7 - p, (att::ldsp)(lds + RING_OFF), wave);
                    att::sb_block(Qg, Qg + 2048, Qg + 4096, Og, p, (att::ldsp)(lds + RING_OFF), wave); }
            } else if (!typeA && PHM(4)) {
                const int lane = opq_tid(wave) & 63;
                const int i = L - 2; const float lam_init = (L == 2) ? 0.47071301834264183f : 0.5560582041556061f;
                const float* lp = args.in[6] + (size_t)i * 256;
                const float sa = dpp_sum(lp[lane] * lp[64 + lane]), sb2 = dpp_sum(lp[128 + lane] * lp[192 + lane]);
                const float lam = __builtin_amdgcn_exp2f(sa * LOG2E) - __builtin_amdgcn_exp2f(sb2 * LOG2E) + lam_init;
                const float* gsub = args.in[7] + (size_t)i * 128; const float gmul = 1.f - lam_init;
                for (int id_ = vcu; id_ < 512 * (1 + ((PROBE_DUP >> 4) & 1)); id_ += G) { const int id = id_ & 511; const int bh = id >> 2, p = id & 3, b = bh >> 4, h = bh & 15;
                    const bf16* Qg = QKV + (size_t)b * SEQ * 6144 + h * 128; bf16* Og = (bf16*)((unsigned char*)OB + (size_t)b * SEQ * P8K2 + h * 128); float* Sg = S1 + (size_t)b * SEQ * DM + h * 128;
#pragma unroll 1
                    for (int w = 0; w < 2; ++w) { const int qb = w ? p : 7 - p;
                        att::diff_pass<false>(Qg, Qg + 2048, Qg + 4096, Sg, Og, qb, lam, gsub, gmul, (att::ldsp)(lds + RING_OFF), wave);
                        att::diff_pass<true>(Qg + 64, Qg + 2048 + 64, Qg + 4096, Sg, Og, qb, lam, gsub, gmul, (att::ldsp)(lds + RING_OFF), wave); } }
            }
            SEAM(sb + 1);
        }
        if (IN(sb + 2)) { if (PHM(5)) {
            pg8::Gemm g{OB, (const bf16*)(ws + (typeA ? WS_WOA : WS_WOB) + (size_t)(L & 1) * 2048 * P8K2), NTOK, DM, DM / 2, P8K2 / 2, wave}; pg8::StaticOrder S; S.init(NTOK, DM, G, bx);
            pg8::EpiQkv E{MIX, DM, 0, 1.f, 1.f / (pg8::W8_SCALE * att::OB8_SCALE)};
            pg8::gemm_phase<pg8::EpiQkv, pg8::StaticOrder, true, true, true>(lds + RING_OFF, g, S, E); }
            SEAM(sb + 2);
        }
        if (IN(sb + 3)) { if (PHM(6)) {
            const int tid = opq_tid(wave), lane = tid & 63;
            const float* lng = args.in[8] + (size_t)L * DM; const float* lnb = args.in[9] + (size_t)L * DM; const float* wr = WR + (size_t)L * 20 * 2048;
            LAS int* eid = (LAS int*)(lds + LNX_OFF + 2048);
            LAS float* lgt = (LAS float*)(lds + LNX_OFF + 4096);
            LAS unsigned* rows8 = (LAS unsigned*)(lds + RING_OFF);
            for (int c = bx; c < 256; c += G) {
#pragma unroll 1
                for (int grp = 0; grp < 4; ++grp) {
                    const int rloc = wave * 8 + grp * 2; const size_t row0 = (size_t)64 * c + rloc;
                    f32x4 v[2][8]; float mu[2], rstd[2];
#pragma unroll
                    for (int rr = 0; rr < 2; ++rr) {
                        if (L == 0) { const f32x4* hp = (const f32x4*)(x_in + (row0 + rr) * DM) + lane;
#pragma unroll
                            for (int j = 0; j < 8; ++j) v[rr][j] = hp[64 * j]; }
                        else { const _Float16* hq = H + (row0 + rr) * DM + 4 * lane;
#pragma unroll
                            for (int j = 0; j < 8; ++j) v[rr][j] = ldh4(hq + 256 * j); } }
#pragma unroll
                    for (int rr = 0; rr < 2; ++rr) { const v2u* mp = (const v2u*)(MIX + (row0 + rr) * DM) + lane;
#pragma unroll
                        for (int j = 0; j < 8; ++j) { const v2u a = mp[64 * j];
                            const f32x4 fa = {__uint_as_float(a.x << 16), __uint_as_float(a.x & 0xffff0000u), __uint_as_float(a.y << 16), __uint_as_float(a.y & 0xffff0000u)};
                            v[rr][j] = v[rr][j] * DN_ALPHA + fa; } }
#pragma unroll
                    for (int rr = 0; rr < 2; ++rr) { float s = 0.f;
#pragma unroll
                        for (int j = 0; j < 8; ++j) s += (v[rr][j][0] + v[rr][j][1]) + (v[rr][j][2] + v[rr][j][3]);
                        mu[rr] = dpp_sum(s) * (1.f / DM); float q = 0.f;
#pragma unroll
                        for (int j = 0; j < 8; ++j) { const f32x4 d = v[rr][j] - mu[rr]; q += (d[0] * d[0] + d[1] * d[1]) + (d[2] * d[2] + d[3] * d[3]); }
                        rstd[rr] = 1.f / sqrtf(dpp_sum(q) * (1.f / DM) + LN_EPS); }
#pragma unroll
                    for (int j = 0; j < 8; ++j) { const f32x4 gg = ((const f32x4*)lng)[64 * j + lane], bb = ((const f32x4*)lnb)[64 * j + lane];
#pragma unroll
                        for (int rr = 0; rr < 2; ++rr) { v[rr][j] = (v[rr][j] - mu[rr]) * rstd[rr] * gg + bb; sth4(H + (row0 + rr) * DM + 256 * j + 4 * lane, v[rr][j]);
                            if (c == bx) rows8[(rloc + rr) * 512 + 64 * j + lane] = pg8::pack4_fp8(v[rr][j][0], v[rr][j][1], v[rr][j][2], v[rr][j][3]); } }
                    f32x4 wn[8];
                    { const f32x4* wp = (const f32x4*)wr + lane;
#pragma unroll
                      for (int j = 0; j < 8; ++j) wn[j] = wp[64 * j]; }
#pragma unroll 1
                    for (int cc = 0; cc < 20; ++cc) { f32x4 w[8];
#pragma unroll
                        for (int j = 0; j < 8; ++j) w[j] = wn[j];
                        { const f32x4* wp = (const f32x4*)(wr + (cc < 19 ? cc + 1 : 19) * 2048) + lane;
#pragma unroll
                          for (int j = 0; j < 8; ++j) wn[j] = wp[64 * j]; }
                        float a[2] = {0.f, 0.f};
#pragma unroll
                        for (int j = 0; j < 8; ++j) {
#pragma unroll
                            for (int rr = 0; rr < 2; ++rr) a[rr] += (v[rr][j][0] * w[j][0] + v[rr][j][1] * w[j][1]) + (v[rr][j][2] * w[j][2] + v[rr][j][3] * w[j][3]); }
#pragma unroll
                        for (int rr = 0; rr < 2; ++rr) a[rr] = dpp_sum(a[rr]);
                        if (lane == 0) { lgt[rloc * 20 + cc] = a[0]; lgt[(rloc + 1) * 20 + cc] = a[1]; } }
                }
                LDS_WAIT();
                if (lane < 8) {
                    const int rl = wave * 8 + lane; const LAS float* lg = lgt + rl * 20;
                    int gsel = 0; float gm = lg[0];
#pragma unroll
                    for (int i = 1; i < 4; ++i) { const float x = lg[i]; if (x > gm) { gm = x; gsel = i; } }
                    float gden = 0.f;
#pragma unroll
                    for (int i = 0; i < 4; ++i) gden += __builtin_amdgcn_exp2f((lg[i] - gm) * LOG2E);
                    const float gw_ = 1.f / gden;
                    const LAS float* li = lg + 4 + 4 * gsel;
                    const float l0 = li[0], l1 = li[1], l2 = li[2], l3 = li[3];
                    int i0 = 0; float v0 = l0;
                    if (l1 > v0) { v0 = l1; i0 = 1; } if (l2 > v0) { v0 = l2; i0 = 2; } if (l3 > v0) { v0 = l3; i0 = 3; }
                    int i1 = -1; float v1 = 0.f;
                    if (i0 != 0) { v1 = l0; i1 = 0; }
                    if (i0 != 1 && (i1 < 0 || l1 > v1)) { v1 = l1; i1 = 1; }
                    if (i0 != 2 && (i1 < 0 || l2 > v1)) { v1 = l2; i1 = 2; }
                    if (i0 != 3 && (i1 < 0 || l3 > v1)) { v1 = l3; i1 = 3; }
                    const float t = __builtin_amdgcn_exp2f((v1 - v0) * LOG2E); const float w0 = gw_ / (1.f + t), w1 = gw_ * t / (1.f + t);
                    eid[2 * rl] = gsel * 4 + i0; eid[2 * rl + 1] = gsel * 4 + i1; RW[(size_t)64 * c + rl] = (f32x2){w0, w1};
                }
                __syncthreads();
                if (wave == 0) {
                    const int ea = eid[lane], eb = eid[64 + lane]; int ra = 0, rb = 0, cnt = 0; const unsigned long long lt = (1ull << lane) - 1ull;
#pragma unroll
                    for (int e = 0; e < 16; ++e) { const unsigned long long ma = __ballot(ea == e), mb = __ballot(eb == e);
                        if (ea == e) ra = __popcll(ma & lt); if (eb == e) rb = __popcll(ma) + __popcll(mb & lt); if (lane == e) cnt = __popcll(ma) + __popcll(mb); }
                    if (lane < 16) CNT[c * 16 + lane] = cnt;
                    LAS int* rk = (LAS int*)(lds + LNX_OFF + 3072); rk[lane] = ra; rk[64 + lane] = rb; LDS_WAIT();
                    const int r = lane; const unsigned word = (unsigned)eid[2 * r] | ((unsigned)eid[2 * r + 1] << 8) | ((unsigned)rk[2 * r] << 16) | ((unsigned)rk[2 * r + 1] << 24);
                    RE[(size_t)64 * c + r] = word;
                }
                __syncthreads();
            } }
            SEAM(sb + 3);
        }
        if ((IN(sb + 4) || IN(sb + 5) || IN(sb + 6)) && PHM(7)) {
            const int tid = opq_tid(wave);
            LAS int* part = (LAS int*)(lds + LNX_OFF);
            { const int e = tid & 15, s = tid >> 4; int a = 0;
#pragma unroll
              for (int i = 0; i < 8; ++i) a += CNT[(8 * s + i) * 16 + e];
              part[s * 16 + e] = a; }
            __syncthreads();
            if (tid < 16) { int run = 0;
#pragma clang loop vectorize(disable) unroll(disable)
                for (int s = 0; s < 32; ++s) run += part[s * 16 + tid];
                TAB[tid] = run; }
            __syncthreads();
            if (tid == 0) { int off = 0, mt = 0;
#pragma clang loop vectorize(disable) unroll(disable)
                for (int e = 0; e < 16; ++e) { TAB[16 + e] = off; const int nt = (TAB[e] + 255) >> 8;
#pragma clang loop vectorize(disable) unroll(disable)
                    for (int i = 0; i < nt; ++i) TAB[64 + mt++] = e;
                    off += nt * 256; }
                TAB[32] = off; TAB[33] = mt; }
            __syncthreads();
        }
        if (IN(sb + 4)) { if (PHM(7)) PREP(7) {
            const int tid = opq_tid(wave), lane = tid & 63;
            LAS int* part = (LAS int*)(lds + LNX_OFF);
            for (int c = bx; c < 256; c += G) {
                if (tid < 16) { int pre = 0;
#pragma clang loop vectorize(disable) unroll(disable)
                    for (int s = 0; s < (c >> 3); ++s) pre += part[s * 16 + tid];
#pragma clang loop vectorize(disable) unroll(disable)
                    for (int cc = c & ~7; cc < c; ++cc) pre += CNT[cc * 16 + tid];
                    TAB[48 + tid] = TAB[16 + tid] + pre; }
                __syncthreads();
#pragma unroll 1
                for (int rr = 0; rr < 8; ++rr) { const size_t row = (size_t)64 * c + wave * 8 + rr; const unsigned word = RE[row];
                    const int p0 = TAB[48 + (word & 255)] + ((word >> 16) & 255), p1 = TAB[48 + ((word >> 8) & 255)] + (word >> 24);
                    if (lane == 0) { RP[2 * row] = p0; RP[2 * row + 1] = p1; }
                    if (c == bx && IN(sb + 3)) {
                        const LAS v4u* src = (const LAS v4u*)(lds + RING_OFF + (wave * 8 + rr) * 2048) + lane; v4u* o0 = (v4u*)((unsigned char*)XS + (size_t)p0 * P8K2) + lane; v4u* o1 = (v4u*)((unsigned char*)XS + (size_t)p1 * P8K2) + lane;
                        const v4u a = src[0], b = src[64]; o0[0] = a; o0[64] = b; o1[0] = a; o1[64] = b;
                    } else {
                        const _Float16* hq = H + row * DM + 4 * lane; unsigned* o0 = (unsigned*)((unsigned char*)XS + (size_t)p0 * P8K2) + lane; unsigned* o1 = (unsigned*)((unsigned char*)XS + (size_t)p1 * P8K2) + lane;
#pragma unroll
                        for (int j = 0; j < 8; ++j) { const f32x4 v = ldh4(hq + 256 * j); const unsigned o = pg8::pack4_fp8(v[0], v[1], v[2], v[3]); o0[64 * j] = o; o1[64 * j] = o; } } }
                __syncthreads();
            } }
            SEAM(sb + 4);
        }
        if (IN(sb + 5)) { if (PHM(8)) PREP(8) {
            pg8::Gemm g{XS, (const bf16*)(ws + WS_WGU + (size_t)L * 16 * 2048 * P8K2), XS_ROWS, 2048, DM / 2, P8K2 / 2, wave};
            pg8::MoeOrder S{TAB[33] * 8, G, bx, TAB + 64}; pg8::EpiGateUp8 E{(unsigned char*)ACT};
            pg8::gemm_phase<pg8::EpiGateUp8, pg8::MoeOrder, true, true, true>(lds + RING_OFF, g, S, E); }
            SEAM(sb + 5);
        }
        if (IN(sb + 6)) { if (PHM(9)) PREP(9) {
            pg8::Gemm g{ACT, (const bf16*)(ws + WS_WDN + (size_t)L * 16 * 2048 * P8K1), XS_ROWS, 2048, DEXP / 2, P8K1 / 2, wave};
            pg8::MoeOrder S{TAB[33] * 8, G, bx, TAB + 64}; pg8::EpiDown8 E{(unsigned char*)YD};
            pg8::gemm_phase<pg8::EpiDown8, pg8::MoeOrder, true, true, true>(lds + RING_OFF, g, S, E); }
            SEAM(sb + 6);
        }
        if (IN(sb + 7)) { if (PHM(10)) for (int rep_ = 0; rep_ < ((((PROBE_DUP) >> 10) & 1) && L == NLAYER - 1 ? 5 : 1); ++rep_) {
            const int tid = opq_tid(wave), lane = tid & 63;
            const float* lng = args.in[10] + (size_t)L * DM; const float* lnb = args.in[11] + (size_t)L * DM; const bool last = (L == NLAYER - 1); const bool next8 = (L + 1 < 2) ? (QKV8_A != 0) : (QKV8_B != 0);
            const int gw = vcu * NWAVES + wave, NGW = G * NWAVES;
            for (int row0 = 2 * gw; row0 < NTOK; row0 += 2 * NGW) {
                f32x4 v[2][8]; float mu[2], rstd[2];
#pragma unroll
                for (int rr = 0; rr < 2; ++rr) { const int row = row0 + rr;
                    const int p0 = RP[2 * row], p1 = RP[2 * row + 1]; const f32x2 w = RW[row];
                    const _Float16* hq = H + (size_t)row * DM + 4 * lane; const unsigned* y0 = (const unsigned*)((const unsigned char*)YD + (size_t)p0 * DM) + lane; const unsigned* y1 = (const unsigned*)((const unsigned char*)YD + (size_t)p1 * DM) + lane;
                    const float w0s = w.x * (1.f / pg8::YD8_SCALE), w1s = w.y * (1.f / pg8::YD8_SCALE);
#pragma unroll
                    for (int j = 0; j < 8; ++j) { const f32x4 h = ldh4(hq + 256 * j); const unsigned a = y0[64 * j], b = y1[64 * j];
                        const f32x2 a0 = __builtin_amdgcn_cvt_pk_f32_fp8((int)a, false), a1 = __builtin_amdgcn_cvt_pk_f32_fp8((int)a, true), b0 = __builtin_amdgcn_cvt_pk_f32_fp8((int)b, false), b1 = __builtin_amdgcn_cvt_pk_f32_fp8((int)b, true);
                        const f32x4 fa = {a0[0], a0[1], a1[0], a1[1]}, fb = {b0[0], b0[1], b1[0], b1[1]};
                        v[rr][j] = h * DN_ALPHA + fa * w0s + fb * w1s; } }
#pragma unroll
                for (int rr = 0; rr < 2; ++rr) { float s = 0.f;
#pragma unroll
                    for (int j = 0; j < 8; ++j) s += (v[rr][j][0] + v[rr][j][1]) + (v[rr][j][2] + v[rr][j][3]);
                    mu[rr] = dpp_sum(s) * (1.f / DM); float q = 0.f;
#pragma unroll
                    for (int j = 0; j < 8; ++j) { const f32x4 dd = v[rr][j] - mu[rr]; q += (dd[0] * dd[0] + dd[1] * dd[1]) + (dd[2] * dd[2] + dd[3] * dd[3]); }
                    rstd[rr] = 1.f / sqrtf(dpp_sum(q) * (1.f / DM) + LN_EPS); }
#pragma unroll
                for (int j = 0; j < 8; ++j) { const f32x4 gg = ((const f32x4*)lng)[64 * j + lane], bb = ((const f32x4*)lnb)[64 * j + lane];
#pragma unroll
                    for (int rr = 0; rr < 2; ++rr) { const int row = row0 + rr; const f32x4 y = (v[rr][j] - mu[rr]) * rstd[rr] * gg + bb;
                        if (last) ((f32x4*)(args.out + (size_t)row * DM))[64 * j + lane] = y;
                        else { sth4(H + (size_t)row * DM + 256 * j + 4 * lane, y); if (next8) ((unsigned*)(HB8 + (size_t)row * DM))[64 * j + lane] = pg8::pack4_fp8(y[0], y[1], y[2], y[3]); } } }
            } }
            SEAM(sb + 7);
        }
    }
#undef IN
#undef SEAM
}

extern "C" void kernel_launch(void* const* d_in, const int* in_sizes, int n_in, void* d_out, int out_size, void* d_ws, size_t ws_size, hipStream_t stream) {
    static int grid = 0;
    if (grid == 0) {
        if (n_in != 17 || in_sizes[0] != NTOK * DM || out_size != NTOK * DM || ws_size < WS_END) { fprintf(stderr, "kernel_launch: unexpected shapes / workspace (n_in %d, ws %zu, need %zu)\n", n_in, ws_size, (size_t)WS_END); grid = -1; return; }
        int dev = 0, cus = 0, per_cu = 0;
        if (hipGetDevice(&dev) != hipSuccess || hipDeviceGetAttribute(&cus, hipDeviceAttributeMultiprocessorCount, dev) != hipSuccess) { grid = -1; return; }
        if (hipFuncSetAttribute((const void*)yoco_fwd, hipFuncAttributeMaxDynamicSharedMemorySize, LDS_BYTES) != hipSuccess) { fprintf(stderr, "kernel_launch: hipFuncSetAttribute failed\n"); grid = -1; return; }
        if (hipOccupancyMaxActiveBlocksPerMultiprocessor(&per_cu, (const void*)yoco_fwd, NWAVES * 64, LDS_BYTES) != hipSuccess || per_cu < 1) { fprintf(stderr, "kernel_launch: occupancy query says %d\n", per_cu); per_cu = 1; }
        (void)hipGetLastError();
        grid = cus;
    }
    if (grid < 0) return;
    (void)hipMemsetAsync((char*)d_ws + WS_CTL, 0, CTL_ZERO_BYTES, stream);
    Args a{};
    for (int i = 0; i < 17; ++i) a.in[i] = (const float*)d_in[i];
    a.out = (float*)d_out; a.ws = (unsigned char*)d_ws;
#if MK_MULTI
    for (int s = 0; s < NSTEPS; ++s) { a.s_lo = s; a.s_hi = s + 1; hipLaunchKernelGGL(yoco_fwd, dim3(grid), dim3(NWAVES * 64), LDS_BYTES, stream, a); }
#else
    a.s_lo = 0; a.s_hi = NSTEPS;
    hipLaunchKernelGGL(yoco_fwd, dim3(grid), dim3(NWAVES * 64), LDS_BYTES, stream, a);
#endif
    const hipError_t le = hipPeekAtLastError();
    if (le != hipSuccess) fprintf(stderr, "kernel_launch: launch failed: %s\n", hipGetErrorName(le));
}
```

```cpp
#include <hip/hip_runtime.h>
#include <cstdio>
#include <cstdint>

__device__ __forceinline__ int tid_from_wave(int wave) { int l; asm volatile("v_mbcnt_lo_u32_b32 %0, -1, 0\n\tv_mbcnt_hi_u32_b32 %0, -1, %0" : "=v"(l)); return wave * 64 + l; }
namespace pg8 {
#define PG8_LAS __attribute__((address_space(3)))
typedef unsigned short bf16_t;
typedef short bf16x8 __attribute__((ext_vector_type(8)));
typedef float f32x4 __attribute__((ext_vector_type(4)));
typedef unsigned u32x4 __attribute__((ext_vector_type(4)));
typedef int pg8_v8i __attribute__((ext_vector_type(8)));
typedef _Float16 pg8_h8 __attribute__((ext_vector_type(8)));
constexpr int BM = 256, BK = 64, HALF = 128, HTB = HALF * BK * 2  , STAGE_BYTES = 8 * HTB, NXCD = 8, WGM = 8;

__host__ __device__ __forceinline__ int lds_byte(int r, int c) { const int st = (r >> 4) * 2 + (c >> 5), rr = r & 15, cc = c & 31, ob = rr * 64 + cc * 2; return st * 1024 + (ob ^ (((ob >> 9) & 1) << 5)); }
__host__ __device__ __forceinline__ void stage_rc(int b, int& R, int& C) { const int st = b / 1024, sb = b % 1024, swz = sb ^ (((sb >> 9) & 1) << 5); R = (st >> 1) * 16 + swz / 64; C = (st & 1) * 32 + (swz % 64) / 2; }
__host__ __device__ __forceinline__ int perm32(int rho) { const int n = rho >> 4, i = rho & 15; return 8 * (i >> 2) + 4 * n + (i & 3); }

struct Unit { int pm, pn; };
struct Gemm { const bf16_t* A; const bf16_t* Bt; int M, N, K, ld, wave; };

struct StaticOrder {
    int nM, nN, nwg, G, c;
    __host__ __device__ void init(int M, int N, int G_, int c_) { nM = M / BM; nN = N / BM; nwg = nM * nN; G = G_; c = c_; }
    __host__ __device__ bool next(int i, Unit& u) const {
        const long L = (long)i * G + c; if (L >= nwg) return false;
        int wgid = (int)L; { const int q = nwg / NXCD, r = nwg % NXCD, xcd = wgid % NXCD, off = wgid / NXCD; wgid = (xcd < r ? xcd * (q + 1) : r * (q + 1) + (xcd - r) * q) + off; }
        const int nig = WGM * nN, gid = wgid / nig, fm = gid * WGM, gsz = (nM - fm) < WGM ? (nM - fm) : WGM;
        u.pm = fm + ((wgid % nig) % gsz); u.pn = (wgid % nig) / gsz; return true;
    }
    __device__ __forceinline__ void a_ready(const Unit&) const {}
    __device__ __forceinline__ void done(const Unit&) const {}
};

__device__ __forceinline__ unsigned cvt_pk_bf16(float lo, float hi) { unsigned r; asm volatile("v_cvt_pk_bf16_f32 %0, %1, %2" : "=v"(r) : "v"(lo), "v"(hi)); return r; }
typedef float f32x2 __attribute__((ext_vector_type(2)));

typedef unsigned u32x2 __attribute__((ext_vector_type(2)));
__device__ __forceinline__ u32x4 pack8_bf16(const f32x4 a, const f32x4 b) { u32x4 w; w.x = cvt_pk_bf16(a[0], a[1]); w.y = cvt_pk_bf16(a[2], a[3]); w.z = cvt_pk_bf16(b[0], b[1]); w.w = cvt_pk_bf16(b[2], b[3]); return w; }

struct EpiQkv {
    static constexpr bool PERM = true, AFTER_DRAIN = false;
    bf16_t* O; int ldc; int qcols; float qscale; float osc;
    __device__ __forceinline__ void operator()(const f32x4 (&acc)[2][2][4][2], const Unit& u, int wr, int wc, int fr, int fq) const {
        const int row0 = u.pm * BM + wr * 64 + fr, colt = u.pn * BM; const float sc = (colt < qcols ? qscale : 1.f) * osc;
        const int col0 = colt + wc * 32 + 8 * fq;
#pragma unroll
        for (int ai = 0; ai < 2; ++ai)
#pragma unroll
            for (int m = 0; m < 4; ++m) { bf16_t* rowp = O + (size_t)(row0 + ai * HALF + m * 16) * ldc + col0;
#pragma unroll
                for (int bj = 0; bj < 2; ++bj) *(u32x4*)(rowp + bj * HALF) = pack8_bf16(acc[ai][bj][m][0] * sc, acc[ai][bj][m][1] * sc); }
    }
};
template <int ACCS_INV> struct EpiResid {
    static constexpr bool PERM = false, AFTER_DRAIN = false;
    static constexpr int ldc = 2048; static constexpr float alpha = 1.6817928305074292f, accs = 1.f / (float)ACCS_INV;
    float* H; const float* Hsrc;
    __device__ __forceinline__ void operator()(const f32x4 (&acc)[2][2][4][2], const Unit& u, int wr, int wc, int fr, int fq) const {
        const int row0 = u.pm * BM + wr * 64 + fr, col0 = u.pn * BM + wc * 32 + 4 * fq;
#pragma unroll
        for (int ai = 0; ai < 2; ++ai)
#pragma unroll
            for (int m = 0; m < 4; ++m) { const size_t ro = (size_t)(row0 + ai * HALF + m * 16) * ldc + col0; float* rowp = H + ro; const float* srcp = Hsrc + ro;
#pragma unroll
                for (int bj = 0; bj < 2; ++bj)
#pragma unroll
                    for (int n = 0; n < 2; ++n) { const f32x4 h = *(const f32x4*)(srcp + bj * HALF + n * 16); *(f32x4*)(rowp + bj * HALF + n * 16) = h * alpha + acc[ai][bj][m][n] * accs; } }
    }
};
struct EpiRope {
    static constexpr bool PERM = true, AFTER_DRAIN = false;
    bf16_t* O; int ldc; int qcols, ropecols; float qscale; const float* ctab; const float* stab; float osc;
    __device__ __forceinline__ void operator()(const f32x4 (&acc)[2][2][4][2], const Unit& u, int wr, int wc, int fr, int fq) const {
        const int row0 = u.pm * BM + wr * 64 + fr, colt = u.pn * BM;
        if (colt >= ropecols) {
            const int col0 = colt + wc * 32 + 8 * fq;
#pragma unroll
            for (int ai = 0; ai < 2; ++ai)
#pragma unroll
                for (int m = 0; m < 4; ++m) { bf16_t* rowp = O + (size_t)(row0 + ai * HALF + m * 16) * ldc + col0;
#pragma unroll
                    for (int bj = 0; bj < 2; ++bj) *(u32x4*)(rowp + bj * HALF) = pack8_bf16(acc[ai][bj][m][0] * osc, acc[ai][bj][m][1] * osc); }
        } else {
            const float sc = (colt < qcols ? qscale : 1.f) * osc;
            const int col0 = colt + wc * 64 + 8 * fq;
#pragma unroll
            for (int ai = 0; ai < 2; ++ai)
#pragma unroll
                for (int m = 0; m < 4; ++m) { const int row = row0 + ai * HALF + m * 16; const int pos = row & 2047;
                    const f32x4 c0 = *(const f32x4*)(ctab + pos * 32 + 8 * fq), c1 = *(const f32x4*)(ctab + pos * 32 + 8 * fq + 4);
                    const f32x4 s0 = *(const f32x4*)(stab + pos * 32 + 8 * fq), s1 = *(const f32x4*)(stab + pos * 32 + 8 * fq + 4);
                    const f32x4 a0 = acc[ai][0][m][0], a1 = acc[ai][0][m][1], b0 = acc[ai][1][m][0], b1 = acc[ai][1][m][1];
                    bf16_t* rowp = O + (size_t)row * ldc + col0;
                    *(u32x4*)(rowp) = pack8_bf16((a0 * c0 - b0 * s0) * sc, (a1 * c1 - b1 * s1) * sc);
                    *(u32x4*)(rowp + 32) = pack8_bf16((b0 * c0 + a0 * s0) * sc, (b1 * c1 + a1 * s1) * sc);
                    asm volatile("" ::: "memory"); }
        }
    }
};
struct EpiGateUp {
    static constexpr bool PERM = true, AFTER_DRAIN = false;
    bf16_t* O;
    __device__ __forceinline__ void operator()(const f32x4 (&acc)[2][2][4][2], const Unit& u, int wr, int wc, int fr, int fq) const {
        const int row0 = u.pm * BM + wr * 64 + fr, col0 = (u.pn & 7) * 128 + wc * 32 + 8 * fq;
#pragma unroll
        for (int ai = 0; ai < 2; ++ai)
#pragma unroll
            for (int m = 0; m < 4; ++m) { f32x4 r[2];
#pragma unroll
                for (int n = 0; n < 2; ++n) { const f32x4 g = acc[ai][0][m][n], up = acc[ai][1][m][n];
#pragma unroll
                    for (int i = 0; i < 4; ++i) { const float e = __builtin_amdgcn_exp2f(g[i] * -1.4426950408889634f); r[n][i] = g[i] * __builtin_amdgcn_rcpf(1.f + e) * up[i]; } }
                *(u32x4*)(O + (size_t)(row0 + ai * HALF + m * 16) * 1024 + col0) = pack8_bf16(r[0], r[1]); }
    }
};
struct EpiDown {
    static constexpr bool PERM = true, AFTER_DRAIN = false;
    bf16_t* O;
    __device__ __forceinline__ void operator()(const f32x4 (&acc)[2][2][4][2], const Unit& u, int wr, int wc, int fr, int fq) const {
        const int row0 = u.pm * BM + wr * 64 + fr, col0 = (u.pn & 7) * BM + wc * 32 + 8 * fq;
#pragma unroll
        for (int ai = 0; ai < 2; ++ai)
#pragma unroll
            for (int m = 0; m < 4; ++m) { bf16_t* rowp = O + (size_t)(row0 + ai * HALF + m * 16) * 2048 + col0;
#pragma unroll
                for (int bj = 0; bj < 2; ++bj) *(u32x4*)(rowp + bj * HALF) = pack8_bf16(acc[ai][bj][m][0], acc[ai][bj][m][1]); }
    }
};
constexpr float W8_SCALE = 64.f, ACT8_SCALE = 4.f;
__device__ __forceinline__ unsigned pack4_fp8(float a, float b, float c, float d) { int w; asm volatile("" : "=v"(w));
    w = __builtin_amdgcn_cvt_pk_fp8_f32(a, b, w, false); w = __builtin_amdgcn_cvt_pk_fp8_f32(c, d, w, true); return (unsigned)w; }
struct EpiGateUp8 {
    static constexpr bool PERM = true, AFTER_DRAIN = false;
    unsigned char* O;
    __device__ __forceinline__ void operator()(const f32x4 (&acc)[2][2][4][2], const Unit& u, int wr, int wc, int fr, int fq) const {
        const int row0 = u.pm * BM + wr * 64 + fr, col0 = (u.pn & 7) * 128 + wc * 32 + 8 * fq;
        constexpr float SI = 1.f / W8_SCALE;
#pragma unroll
        for (int ai = 0; ai < 2; ++ai)
#pragma unroll
            for (int m = 0; m < 4; ++m) { f32x4 r[2];
#pragma unroll
                for (int n = 0; n < 2; ++n) { const f32x4 g = acc[ai][0][m][n] * SI, up = acc[ai][1][m][n] * (SI * ACT8_SCALE);
#pragma unroll
                    for (int i = 0; i < 4; ++i) { const float e = __builtin_amdgcn_exp2f(g[i] * -1.4426950408889634f); r[n][i] = g[i] * __builtin_amdgcn_rcpf(1.f + e) * up[i]; } }
                u32x2 w; w.x = pack4_fp8(r[0][0], r[0][1], r[0][2], r[0][3]); w.y = pack4_fp8(r[1][0], r[1][1], r[1][2], r[1][3]);
                *(u32x2*)(O + (size_t)(row0 + ai * HALF + m * 16) * 1024 + col0) = w; }
    }
};
constexpr float YD8_SCALE = 16.f;
struct EpiDown8 {
    static constexpr bool PERM = true, AFTER_DRAIN = false;
    unsigned char* O;
    __device__ __forceinline__ void operator()(const f32x4 (&acc)[2][2][4][2], const Unit& u, int wr, int wc, int fr, int fq) const {
        const int row0 = u.pm * BM + wr * 64 + fr, col0 = (u.pn & 7) * BM + wc * 32 + 8 * fq;
        constexpr float SI = YD8_SCALE / (W8_SCALE * ACT8_SCALE);
#pragma unroll
        for (int ai = 0; ai < 2; ++ai)
#pragma unroll
            for (int m = 0; m < 4; ++m) { unsigned char* rowp = O + (size_t)(row0 + ai * HALF + m * 16) * 2048 + col0;
#pragma unroll
                for (int bj = 0; bj < 2; ++bj) { const f32x4 a = acc[ai][bj][m][0] * SI, c = acc[ai][bj][m][1] * SI; u32x2 w; w.x = pack4_fp8(a[0], a[1], a[2], a[3]); w.y = pack4_fp8(c[0], c[1], c[2], c[3]);
                    *(u32x2*)(rowp + bj * HALF) = w; } }
    }
};
struct MoeOrder {
    int nunits, G, c; const PG8_LAS int* tile_e;
    __device__ __forceinline__ bool next(int i, Unit& u) const {
        int idx;
        if ((G & 7) == 0) { const int per = G >> 3; idx = (i * 8 + (c & 7)) * per + (c >> 3); } else idx = i * G + c;
        if (idx >= nunits) return false;
        const int mt = idx >> 3; u.pm = mt; u.pn = tile_e[mt] * 8 + (idx & 7); return true;
    }
    __device__ __forceinline__ void a_ready(const Unit&) const {}
    __device__ __forceinline__ void done(const Unit&) const {}
};

template <class Epi, class Sched, bool ALIGN_EPI = false, bool SP2 = false, bool F8 = false, bool F16 = false>
__device__ __forceinline__ void gemm_phase(PG8_LAS unsigned char* lds, const Gemm g, const Sched& S, const Epi& E) {
    int tid_ = tid_from_wave(g.wave); asm volatile("" : "+v"(tid_));
    const int tid = tid_, wid = __builtin_amdgcn_readfirstlane(tid >> 6), lane = tid & 63, wr = wid >> 2, wc = wid & 3, fr = lane & 15, fq = lane >> 4;
    const int K = g.K, LD = g.ld, nt = K / BK;
    unsigned voffA, voffB;
    { int R, C; stage_rc(tid * 16, R, C); const int Rb = Epi::PERM ? ((R & ~31) + perm32(R & 31)) : R;
        voffA = (unsigned)(R * LD + C) * 2u; voffB = (unsigned)(Rb * LD + C) * 2u; }
    const size_t pstep = (size_t)64 * LD * 2;
    const size_t kstep = (size_t)(BK * 2);
    const size_t hstep = (size_t)HALF * LD * 2;
    const size_t tstep = 2 * hstep;
    const unsigned ldsbase = (unsigned)(uintptr_t)lds;
    const unsigned ldsw = (unsigned)wid * 1024u;
    const int aoff = lds_byte(wr * 64 + fr, fq * 8), boff = lds_byte(wc * 32 + fr, fq * 8);
#define PG8_SA(b, h) (((b) * 2 + (h)) * HTB)
#define PG8_SB(b, h) ((4 + (b) * 2 + (h)) * HTB)
#define PG8_STAGE(bufoff, gbase, voff) do { _Pragma("unroll") for (int _i = 0; _i < 2; ++_i) { unsigned keep_; \
        asm volatile("s_mov_b32 %0, m0\n\ts_mov_b32 m0, %3\n\ts_nop 0\n\tglobal_load_lds_dwordx4 %1, %2\n\ts_mov_b32 m0, %0" : "=&s"(keep_) \
            : "v"(voff), "s"((const char*)(gbase) + _i * pstep), "s"(ldsbase + (unsigned)(bufoff) + ldsw + (unsigned)(_i * 8192))); } } while (0)
#define PG8_CAT(a, b) __builtin_bit_cast(pg8_v8i, __builtin_shufflevector(a, b, 0, 1, 2, 3, 4, 5, 6, 7, 8, 9, 10, 11, 12, 13, 14, 15))
#define PG8_LDA(dst, b, h) do { if constexpr (F8) { _Pragma("unroll") for (int m = 0; m < 4; ++m) { const bf16x8 lo_ = *(const PG8_LAS bf16x8*)(lds + PG8_SA(b, h) + aoff + m * 2048), hi_ = *(const PG8_LAS bf16x8*)(lds + PG8_SA(b, h) + aoff + m * 2048 + 1024); dst##8[m] = PG8_CAT(lo_, hi_); } } \
        else { _Pragma("unroll") for (int m = 0; m < 4; ++m) _Pragma("unroll") for (int k = 0; k < 2; ++k) dst[m][k] = *(const PG8_LAS bf16x8*)(lds + PG8_SA(b, h) + aoff + m * 2048 + k * 1024); } } while (0)
#define PG8_LDB(dst, b, h) do { if constexpr (F8) { _Pragma("unroll") for (int n = 0; n < 2; ++n) { const bf16x8 lo_ = *(const PG8_LAS bf16x8*)(lds + PG8_SB(b, h) + boff + n * 2048), hi_ = *(const PG8_LAS bf16x8*)(lds + PG8_SB(b, h) + boff + n * 2048 + 1024); dst##8[n] = PG8_CAT(lo_, hi_); } } \
        else { _Pragma("unroll") for (int n = 0; n < 2; ++n) _Pragma("unroll") for (int k = 0; k < 2; ++k) dst[n][k] = *(const PG8_LAS bf16x8*)(lds + PG8_SB(b, h) + boff + n * 2048 + k * 1024); } } while (0)
#define PG8_MMA(ai, bj, At, Bt) do { __builtin_amdgcn_s_setprio(1); \
        if constexpr (F8) { _Pragma("unroll") for (int m = 0; m < 4; ++m) _Pragma("unroll") for (int n = 0; n < 2; ++n) \
            acc[ai][bj][m][n] = __builtin_amdgcn_mfma_scale_f32_16x16x128_f8f6f4(Bt##8[n], At##8[m], acc[ai][bj][m][n], 0, 0, 0, 0, 0, 0); } \
        else { _Pragma("unroll") for (int m = 0; m < 4; ++m) _Pragma("unroll") for (int n = 0; n < 2; ++n) _Pragma("unroll") for (int k = 0; k < 2; ++k) \
            acc[ai][bj][m][n] = F16 ? __builtin_amdgcn_mfma_f32_16x16x32_f16(__builtin_bit_cast(pg8_h8, Bt[n][k]), __builtin_bit_cast(pg8_h8, At[m][k]), acc[ai][bj][m][n], 0, 0, 0) \
                                    : __builtin_amdgcn_mfma_f32_16x16x32_bf16(Bt[n][k], At[m][k], acc[ai][bj][m][n], 0, 0, 0); } \
        __builtin_amdgcn_s_setprio(0); } while (0)
#define PG8_WAIT_V(n) asm volatile("s_waitcnt vmcnt(" #n ")" ::: "memory")
#define PG8_WAIT_L(n) asm volatile("s_waitcnt lgkmcnt(" #n ")" ::: "memory")
#define PG8_BAR __builtin_amdgcn_s_barrier()
#define PG8_SCHED __builtin_amdgcn_sched_barrier(0)
    Unit cur, nxt; int ui = 0;
    if (!S.next(0, cur)) return;
    f32x4 acc[2][2][4][2];
{ float zero_; asm volatile("v_mov_b32 %0, 0" : "=v"(zero_));
#pragma unroll
    for (int a = 0; a < 2; ++a)
#pragma unroll
        for (int b = 0; b < 2; ++b)
#pragma unroll
            for (int m = 0; m < 4; ++m)
#pragma unroll
                for (int n = 0; n < 2; ++n) acc[a][b][m][n] = (f32x4){zero_, zero_, zero_, zero_}; }
    bf16x8 At[4][2], B0[2][2], B1[2][2]; pg8_v8i At8[4], B08[2], B18[2];
    const char* cA = (const char*)g.A + (size_t)cur.pm * tstep; const char* cB = (const char*)g.Bt + (size_t)cur.pn * tstep;
    S.a_ready(cur);
    if constexpr (SP2) {
        PG8_STAGE(PG8_SB(0, 0), cB, voffB); PG8_STAGE(PG8_SB(0, 1), cB + hstep, voffB); PG8_STAGE(PG8_SA(0, 0), cA, voffA); PG8_STAGE(PG8_SA(0, 1), cA + hstep, voffA);
        if (wr == 1) PG8_BAR;
        PG8_WAIT_V(2); PG8_BAR;
        PG8_STAGE(PG8_SB(1, 0), cB + kstep, voffB); PG8_STAGE(PG8_SA(1, 0), cA + kstep, voffA); PG8_STAGE(PG8_SB(1, 1), cB + hstep + kstep, voffB);
        PG8_WAIT_V(6); PG8_BAR;
    } else {
        PG8_STAGE(PG8_SB(0, 0), cB, voffB); PG8_STAGE(PG8_SA(0, 0), cA, voffA); PG8_STAGE(PG8_SB(0, 1), cB + hstep, voffB); PG8_STAGE(PG8_SA(0, 1), cA + hstep, voffA);
        if (wr == 1) PG8_BAR;
        PG8_WAIT_V(4); PG8_BAR;
        PG8_STAGE(PG8_SB(1, 0), cB + kstep, voffB); PG8_STAGE(PG8_SA(1, 0), cA + kstep, voffA); PG8_STAGE(PG8_SB(1, 1), cB + hstep + kstep, voffB);
        PG8_WAIT_V(6); PG8_BAR;
    }
    for (;;) {
        const bool has_next = S.next(ui + 1, nxt);
        const char* nA = has_next ? (const char*)g.A + (size_t)nxt.pm * tstep : cA; const char* nB = has_next ? (const char*)g.Bt + (size_t)nxt.pn * tstep : cB;
#pragma unroll 1
        for (int t = 0; t < nt; t += 2) {
            const bool last = (t == nt - 2);
            const char* a1 = cA + (size_t)(t + 1) * kstep;
            const char* a2 = last ? nA : cA + (size_t)(t + 2) * kstep; const char* b2 = last ? nB : cB + (size_t)(t + 2) * kstep;
            const char* a3 = a2 + kstep; const char* b3 = b2 + kstep;
            if (last && has_next) S.a_ready(nxt);
            if constexpr (SP2) {
            PG8_LDB(B0, 0, 0); PG8_LDB(B1, 0, 1); PG8_SCHED; PG8_LDA(At, 0, 0); PG8_STAGE(PG8_SA(1, 1), a1 + hstep, voffA);
            PG8_WAIT_V(8); PG8_WAIT_L(0); PG8_BAR; PG8_MMA(0, 0, At, B0); PG8_MMA(0, 1, At, B1); PG8_BAR; PG8_SCHED;
            PG8_LDA(At, 0, 1); PG8_STAGE(PG8_SB(0, 0), b2, voffB); PG8_STAGE(PG8_SB(0, 1), b2 + hstep, voffB); PG8_STAGE(PG8_SA(0, 0), a2, voffA);
            PG8_WAIT_V(8); PG8_WAIT_L(0); PG8_BAR; PG8_MMA(1, 0, At, B0); PG8_MMA(1, 1, At, B1); PG8_BAR; PG8_SCHED;
            PG8_LDB(B0, 1, 0); PG8_LDB(B1, 1, 1); PG8_SCHED; PG8_LDA(At, 1, 0); PG8_STAGE(PG8_SA(0, 1), a2 + hstep, voffA);
            PG8_WAIT_V(8); PG8_WAIT_L(0); PG8_BAR; PG8_MMA(0, 0, At, B0); PG8_MMA(0, 1, At, B1); PG8_BAR; PG8_SCHED;
            PG8_LDA(At, 1, 1); PG8_STAGE(PG8_SB(1, 0), b3, voffB); PG8_STAGE(PG8_SB(1, 1), b3 + hstep, voffB); PG8_STAGE(PG8_SA(1, 0), a3, voffA);
            PG8_WAIT_V(8); PG8_WAIT_L(0); PG8_BAR; PG8_MMA(1, 0, At, B0); PG8_MMA(1, 1, At, B1); PG8_BAR; PG8_SCHED;
            } else {
            PG8_LDB(B0, 0, 0); PG8_SCHED; PG8_LDA(At, 0, 0); PG8_STAGE(PG8_SA(1, 1), a1 + hstep, voffA);
            PG8_WAIT_L(8); PG8_BAR; PG8_WAIT_L(0); PG8_MMA(0, 0, At, B0); PG8_BAR; PG8_SCHED;
            PG8_LDB(B1, 0, 1); PG8_STAGE(PG8_SB(0, 0), b2, voffB);
            PG8_BAR; PG8_WAIT_L(0); PG8_MMA(0, 1, At, B1); PG8_BAR;
            PG8_LDA(At, 0, 1); PG8_STAGE(PG8_SA(0, 0), a2, voffA);
            PG8_BAR; PG8_WAIT_L(0); PG8_MMA(1, 0, At, B0); PG8_BAR; PG8_SCHED;
            PG8_STAGE(PG8_SB(0, 1), b2 + hstep, voffB);
            PG8_WAIT_V(6); PG8_BAR; PG8_MMA(1, 1, At, B1); PG8_BAR;
            PG8_LDB(B0, 1, 0); PG8_SCHED; PG8_LDA(At, 1, 0); PG8_STAGE(PG8_SA(0, 1), a2 + hstep, voffA);
            PG8_WAIT_L(8); PG8_BAR; PG8_WAIT_L(0); PG8_MMA(0, 0, At, B0); PG8_BAR; PG8_SCHED;
            PG8_LDB(B1, 1, 1); PG8_STAGE(PG8_SB(1, 0), b3, voffB);
            PG8_BAR; PG8_WAIT_L(0); PG8_MMA(0, 1, At, B1); PG8_BAR;
            PG8_LDA(At, 1, 1); PG8_STAGE(PG8_SA(1, 0), a3, voffA);
            PG8_BAR; PG8_WAIT_L(0); PG8_MMA(1, 0, At, B0); PG8_BAR; PG8_SCHED;
            PG8_STAGE(PG8_SB(1, 1), b3 + hstep, voffB);
            PG8_WAIT_V(6); PG8_BAR; PG8_MMA(1, 1, At, B1); PG8_BAR;
            }
        }
        if constexpr (ALIGN_EPI) { if (wr == 0) PG8_BAR; }
        if constexpr (!Epi::AFTER_DRAIN) { const int t2_ = tid_from_wave(g.wave);
            E(acc, cur, wr, wc, t2_ & 15, (t2_ >> 4) & 3); S.done(cur); }
        if (!has_next) break;
{ float zero_; asm volatile("v_mov_b32 %0, 0" : "=v"(zero_));
#pragma unroll
        for (int a = 0; a < 2; ++a)
#pragma unroll
            for (int b = 0; b < 2; ++b)
#pragma unroll
                for (int m = 0; m < 4; ++m)
#pragma unroll
                    for (int n = 0; n < 2; ++n) acc[a][b][m][n] = (f32x4){zero_, zero_, zero_, zero_}; }
        cur = nxt; cA = nA; cB = nB; ++ui;
        if constexpr (ALIGN_EPI) { if (wr == 1) PG8_BAR; }
    }
    PG8_WAIT_V(0);
    if constexpr (!ALIGN_EPI) { if (wr == 0) PG8_BAR; }
    PG8_BAR;
    if constexpr (Epi::AFTER_DRAIN) { E.fused(acc, cur, wr, wc, fr, fq, lds, wid, lane); S.done(cur); }
#undef PG8_SA
#undef PG8_SB
#undef PG8_STAGE
#undef PG8_LDA
#undef PG8_LDB
#undef PG8_MMA
#undef PG8_CAT
#undef PG8_WAIT_V
#undef PG8_WAIT_L
#undef PG8_BAR
#undef PG8_SCHED
}
}

namespace att {
#define ALAS __attribute__((address_space(3)))
typedef unsigned short bf16_t;
typedef short bf16x8 __attribute__((ext_vector_type(8)));
typedef short s16x4 __attribute__((ext_vector_type(4)));
typedef float f32x16 __attribute__((ext_vector_type(16)));
typedef float f32x4 __attribute__((ext_vector_type(4)));
typedef unsigned u32x4 __attribute__((ext_vector_type(4)));
typedef ALAS char* ldsp;
#ifndef WO_F8
#define WO_F8 1
#endif
constexpr float OB8_SCALE = 8.f;
constexpr int QP = 6144;
constexpr int OP = 2048;
constexpr int OBP = 2048;
constexpr int SHM_V = 16384, SHM_K = 16384;
constexpr int LDS_V = 0, LDS_K = 2 * SHM_V, LDS_WS = LDS_K + 2 * SHM_K, ATT_LDS_BYTES = LDS_WS + 8 * 256;
#define KSWZ(row, colB) ((row) * 256 + ((colB) ^ (((row) & 7) << 4)))
#define KSWZ64(row, colB) ((row) * 128 + ((colB) ^ (((row) & 7) << 4)))
#define SBAR() __builtin_amdgcn_sched_barrier(0)
__device__ __forceinline__ int v_st(int k, int c) { const int kk = (k & ~0xC) | ((k & 4) << 1) | ((k & 8) >> 1); return ((kk >> 3) * 4 + (c >> 5)) * 512 + ((kk & 7) * 32 + (c & 31)) * 2; }
__device__ __forceinline__ int v_rd_base(int lane) { return ((lane & 3) << 3) | (((lane >> 2) & 3) << 6) | (((lane >> 4) & 1) << 5) | (((lane >> 5) & 1) << 8); }
constexpr int v_rd_off(int d0, int ks, int half) { return d0 * 512 + ks * 4096 + half * 2048; }
__device__ __forceinline__ int crow(int r, int hi) { return (r & 3) + 8 * (r >> 2) + 4 * hi; }
__device__ __forceinline__ unsigned cvtpk(float lo, float hi) { unsigned r; asm volatile("v_cvt_pk_bf16_f32 %0, %1, %2" : "=v"(r) : "v"(lo), "v"(hi)); return r; }
__device__ __forceinline__ bf16x8 ldg8(const bf16_t* p) { return *reinterpret_cast<const bf16x8*>(p); }
__device__ __forceinline__ unsigned quad_pack_fp8(float v) {
    const int b = __builtin_bit_cast(int, v);
    const float v1 = __builtin_bit_cast(float, __builtin_amdgcn_update_dpp(b, b, 0x55, 0xf, 0xf, false));
    const float v2 = __builtin_bit_cast(float, __builtin_amdgcn_update_dpp(b, b, 0xAA, 0xf, 0xf, false));
    const float v3 = __builtin_bit_cast(float, __builtin_amdgcn_update_dpp(b, b, 0xFF, 0xf, 0xf, false));
    int w; asm volatile("" : "=v"(w));
    w = __builtin_amdgcn_cvt_pk_fp8_f32(v, v1, w, false); w = __builtin_amdgcn_cvt_pk_fp8_f32(v2, v3, w, true); return (unsigned)w;
}
__device__ __forceinline__ float xhalf(float v, int hi) {
    auto rr = __builtin_amdgcn_permlane32_swap(__float_as_uint(v), __float_as_uint(v), false, false);
    return __uint_as_float(hi ? rr[0] : rr[1]);
}
#define ATT_PK4(P, B_, OUT) do { unsigned a0 = cvtpk(P[B_+0], P[B_+1]), a1 = cvtpk(P[B_+2], P[B_+3]);                      \
        unsigned b0 = cvtpk(P[B_+4], P[B_+5]), b1 = cvtpk(P[B_+6], P[B_+7]);                                             \
        auto r0 = __builtin_amdgcn_permlane32_swap(a0, b0, false, false); auto r1 = __builtin_amdgcn_permlane32_swap(a1, b1, false, false); \
        u32x4 w = {r0[0], r1[0], r0[1], r1[1]}; OUT = *reinterpret_cast<bf16x8*>(&w); } while (0)
__device__ __forceinline__ void pv_tile(f32x16* o, int vb, bf16x8 pa0, bf16x8 pa1, bf16x8 pa2, bf16x8 pa3) {
#define TRRD(dst, off) asm volatile("ds_read_b64_tr_b16 %0, %1 offset:%2" : "=&v"(dst) : "v"(vb), "i"(off) : "memory")
#define PV_D0(d0) do { s16x4 l0, l1, l2, l3, h0, h1, h2, h3; constexpr int b_ = v_rd_off(d0, 0, 0); \
        TRRD(l0, b_); TRRD(h0, b_ + 2048); TRRD(l1, b_ + 4096); TRRD(h1, b_ + 6144); TRRD(l2, b_ + 8192); TRRD(h2, b_ + 10240); TRRD(l3, b_ + 12288); TRRD(h3, b_ + 14336); \
        asm volatile("s_waitcnt lgkmcnt(0)" ::: "memory"); SBAR(); \
        o[d0] = __builtin_amdgcn_mfma_f32_32x32x16_bf16(pa0, (bf16x8){l0[0], l0[1], l0[2], l0[3], h0[0], h0[1], h0[2], h0[3]}, o[d0], 0, 0, 0);   \
        o[d0] = __builtin_amdgcn_mfma_f32_32x32x16_bf16(pa1, (bf16x8){l1[0], l1[1], l1[2], l1[3], h1[0], h1[1], h1[2], h1[3]}, o[d0], 0, 0, 0);   \
        o[d0] = __builtin_amdgcn_mfma_f32_32x32x16_bf16(pa2, (bf16x8){l2[0], l2[1], l2[2], l2[3], h2[0], h2[1], h2[2], h2[3]}, o[d0], 0, 0, 0);   \
        o[d0] = __builtin_amdgcn_mfma_f32_32x32x16_bf16(pa3, (bf16x8){l3[0], l3[1], l3[2], l3[3], h3[0], h3[1], h3[2], h3[3]}, o[d0], 0, 0, 0); } while (0)
    PV_D0(0); PV_D0(1); PV_D0(2); PV_D0(3);
#undef PV_D0
#undef TRRD
}

__device__ __forceinline__ void sb_block(const bf16_t* __restrict__ Qg, const bf16_t* __restrict__ Kg, const bf16_t* __restrict__ Vg, bf16_t* __restrict__ Og, int qb, ldsp lds, int wave_) {
    int tid_ = tid_from_wave(wave_); asm volatile("" : "+v"(tid_));
    const int tid = tid_, wid = __builtin_amdgcn_readfirstlane(tid >> 6), lane = tid & 63, r32 = lane & 31, hi = lane >> 5;
    const int NT = 4 * qb + 4, R0 = 256 * qb + 32 * wid, myrow = R0 + r32;
    const ldsp V_lds = lds + LDS_V; const ldsp K_lds = lds + LDS_K;
    bf16x8 qr[8];
    { const bf16_t* Qw = Qg + (size_t)R0 * QP; const unsigned qoff = (unsigned)(r32 * QP + hi * 8);
#pragma unroll
      for (int d0 = 0; d0 < 8; ++d0) qr[d0] = ldg8(Qw + (qoff + d0 * 16)); }
    const int sr = tid >> 4, sc = (tid & 15) * 8, kws = KSWZ(sr, sc * 2), vst0 = v_st(sr, sc), vst1 = v_st(32 + sr, sc);
    const unsigned kvoff = (unsigned)(sr * QP + sc);
    const int vb0 = (int)(unsigned)(uintptr_t)V_lds + v_rd_base(lane);
    bf16x8 sk0, sk1, sv0, sv1;
#define SB_LOAD(j) do { const bf16_t* kp_ = Kg + (size_t)(64 * (j)) * QP; const bf16_t* vp_ = Vg + (size_t)(64 * (j)) * QP; \
        sk0 = ldg8(kp_ + kvoff); sk1 = ldg8(kp_ + (size_t)32 * QP + kvoff); sv0 = ldg8(vp_ + kvoff); sv1 = ldg8(vp_ + (size_t)32 * QP + kvoff); } while (0)
#define SB_WRITE(bf) do { *(ALAS bf16x8*)(K_lds + (bf) * SHM_K + kws) = sk0; *(ALAS bf16x8*)(K_lds + (bf) * SHM_K + kws + 32 * 256) = sk1; \
        *(ALAS bf16x8*)(V_lds + (bf) * SHM_V + vst0) = sv0; *(ALAS bf16x8*)(V_lds + (bf) * SHM_V + vst1) = sv1; } while (0)
    SB_LOAD(NT - 1); SB_WRITE(0);
    __syncthreads();
    float carry = 0.f; f32x16 o[4] = {};
    ALAS int* fl = (ALAS int*)(lds + LDS_WS); bool wdone = false;
    for (int t = 0; t < NT; ++t) {
        const int j = NT - 1 - t, buf = t & 1, kb = 64 * j;
        if (t + 1 < NT) SB_LOAD(j - 1);
        if (kb <= R0 + 30 && !wdone) {
            f32x16 p0 = {}, p1 = {};
            { const ldsp Kb = K_lds + buf * SHM_K;
#pragma unroll
              for (int d0 = 0; d0 < 8; ++d0) { const ldsp a = Kb + KSWZ(r32, ((d0 & 3) * 16 + hi * 8) * 2) + (d0 >> 2) * 128;
                  const bf16x8 b0 = *(const ALAS bf16x8*)a, b1 = *(const ALAS bf16x8*)(a + 32 * 256);
                  p0 = __builtin_amdgcn_mfma_f32_32x32x16_bf16(b0, qr[d0], p0, 0, 0, 0);
                  p1 = __builtin_amdgcn_mfma_f32_32x32x16_bf16(b1, qr[d0], p1, 0, 0, 0); } }
            f32x16 lb0, lb1;
#pragma unroll
            for (int r = 0; r < 16; ++r) {
                { const float z = p0[r]; const float e = __builtin_amdgcn_exp2f(-__builtin_fabsf(z)); const float sp = __builtin_fmaxf(z, 0.f) + __builtin_amdgcn_logf(1.f + e); p0[r] = -sp; lb0[r] = z - sp; }
                { const float z = p1[r]; const float e = __builtin_amdgcn_exp2f(-__builtin_fabsf(z)); const float sp = __builtin_fmaxf(z, 0.f) + __builtin_amdgcn_logf(1.f + e); p1[r] = -sp; lb1[r] = z - sp; }
            }
            if (kb + 63 >= R0) {
                const int dq = myrow - kb - 4 * hi; const float NEG = -__builtin_inff();
#pragma unroll
                for (int r = 0; r < 16; ++r) { const int c = (r & 3) + 8 * (r >> 2);
                    if (c >= dq) { p0[r] = 0.f; lb0[r] = NEG; }
                    if (c + 32 >= dq) { p1[r] = 0.f; lb1[r] = NEG; } }
            }
            float gs[8], go[8];
#pragma unroll
            for (int g = 0; g < 4; ++g) { gs[g] = (p0[4 * g] + p0[4 * g + 1]) + (p0[4 * g + 2] + p0[4 * g + 3]); gs[4 + g] = (p1[4 * g] + p1[4 * g + 1]) + (p1[4 * g + 2] + p1[4 * g + 3]); }
#pragma unroll
            for (int i = 0; i < 8; ++i) go[i] = xhalf(gs[i], hi);
            float acc = carry;
#pragma unroll
            for (int idx = 7; idx >= 0; --idx) { const int g = idx & 3; const float base = acc + (hi ? 0.f : go[idx]);
                if (idx >= 4) { const float t3 = base, t2 = t3 + p1[4 * g + 3], t1 = t2 + p1[4 * g + 2], t0 = t1 + p1[4 * g + 1];
                    lb1[4 * g + 3] = __builtin_amdgcn_exp2f(lb1[4 * g + 3] + t3); lb1[4 * g + 2] = __builtin_amdgcn_exp2f(lb1[4 * g + 2] + t2);
                    lb1[4 * g + 1] = __builtin_amdgcn_exp2f(lb1[4 * g + 1] + t1); lb1[4 * g] = __builtin_amdgcn_exp2f(lb1[4 * g] + t0); }
                else { const float t3 = base, t2 = t3 + p0[4 * g + 3], t1 = t2 + p0[4 * g + 2], t0 = t1 + p0[4 * g + 1];
                    lb0[4 * g + 3] = __builtin_amdgcn_exp2f(lb0[4 * g + 3] + t3); lb0[4 * g + 2] = __builtin_amdgcn_exp2f(lb0[4 * g + 2] + t2);
                    lb0[4 * g + 1] = __builtin_amdgcn_exp2f(lb0[4 * g + 1] + t1); lb0[4 * g] = __builtin_amdgcn_exp2f(lb0[4 * g] + t0); }
                acc += gs[idx] + go[idx]; }
            carry = acc;
            bf16x8 pa0, pa1, pa2, pa3;
            ATT_PK4(lb0, 0, pa0); ATT_PK4(lb0, 8, pa1); ATT_PK4(lb1, 0, pa2); ATT_PK4(lb1, 8, pa3);
            SBAR();
            pv_tile(o, vb0 + buf * SHM_V, pa0, pa1, pa2, pa3);
            wdone = __all(carry < -127.f);
        }
        if (lane == 0) fl[buf * 8 + wid] = wdone ? 1 : 0;
        if (t + 1 < NT) SB_WRITE(buf ^ 1);
        __syncthreads();
        { const ALAS int* f = fl + buf * 8; if ((f[0] & f[1] & f[2] & f[3] & f[4] & f[5] & f[6] & f[7]) != 0) break; }
    }
#undef SB_LOAD
#undef SB_WRITE
#if WO_F8
    unsigned char* Ow = (unsigned char*)Og + (size_t)R0 * OBP; const unsigned ooff = (unsigned)(4 * hi * OBP + r32);
#pragma unroll
    for (int r = 0; r < 16; ++r) { unsigned char* rowp = Ow + (size_t)((r & 3) + 8 * (r >> 2)) * OBP;
#pragma unroll
        for (int d0 = 0; d0 < 4; ++d0) { const unsigned w = quad_pack_fp8(o[d0][r] * OB8_SCALE);
            if ((r32 & 3) == 0) *(unsigned*)(rowp + (ooff + d0 * 32)) = w; } }
#else
    bf16_t* Ow = Og + (size_t)R0 * OP; const unsigned ooff = (unsigned)(4 * hi * OP + r32);
#pragma unroll
    for (int r = 0; r < 16; ++r) { bf16_t* rowp = Ow + (size_t)((r & 3) + 8 * (r >> 2)) * OP;
#pragma unroll
        for (int d0 = 0; d0 < 4; ++d0) { const float v = o[d0][r]; const float vn = __shfl_xor(v, 1);
            if ((r32 & 1) == 0) *(unsigned*)(rowp + (ooff + d0 * 32)) = cvtpk(v, vn); } }
#endif
}

constexpr float ATT_THR = 8.f;
__device__ __forceinline__ void qkt64(f32x16& p0, f32x16& p1, ldsp Kb, int r32, int hi, const bf16x8* qr) {
    p0 = f32x16{}; p1 = f32x16{};
#pragma unroll
    for (int d0 = 0; d0 < 4; ++d0) { const ldsp a = Kb + KSWZ64(r32, (d0 * 16 + hi * 8) * 2);
        const bf16x8 b0 = *(const ALAS bf16x8*)a, b1 = *(const ALAS bf16x8*)(a + 32 * 128);
        p0 = __builtin_amdgcn_mfma_f32_32x32x16_bf16(b0, qr[d0], p0, 0, 0, 0);
        p1 = __builtin_amdgcn_mfma_f32_32x32x16_bf16(b1, qr[d0], p1, 0, 0, 0); }
}
__device__ __forceinline__ void partial_sm(f32x16& p0, f32x16& p1, float& m_reg, float& alpha, int hi) {
    float pmax = p0[0];
#pragma unroll
    for (int r = 1; r < 16; ++r) pmax = __builtin_fmaxf(pmax, p0[r]);
#pragma unroll
    for (int r = 0; r < 16; ++r) pmax = __builtin_fmaxf(pmax, p1[r]);
    pmax = __builtin_fmaxf(pmax, xhalf(pmax, hi));
    float mn;
    if (__builtin_expect(__all(pmax - m_reg <= ATT_THR), 1)) { mn = m_reg; alpha = 1.f; }
    else { mn = __builtin_fmaxf(m_reg, pmax); alpha = __builtin_amdgcn_exp2f(m_reg - mn); m_reg = mn; }
#pragma unroll
    for (int r = 0; r < 16; ++r) { p0[r] -= mn; p1[r] -= mn; }
#pragma unroll
    for (int r = 0; r < 16; ++r) p0[r] = __builtin_amdgcn_exp2f(p0[r]);
}
__device__ __forceinline__ void finish_sm(f32x16& p0, f32x16& p1, float alpha, float& l_reg, bf16x8& pa0, bf16x8& pa1, bf16x8& pa2, bf16x8& pa3, int hi) {
#pragma unroll
    for (int r = 0; r < 16; ++r) p1[r] = __builtin_amdgcn_exp2f(p1[r]);
    float ps = 0.f;
#pragma unroll
    for (int r = 0; r < 16; ++r) ps += p0[r];
#pragma unroll
    for (int r = 0; r < 16; ++r) ps += p1[r];
    ps += xhalf(ps, hi);
    l_reg = l_reg * alpha + ps;
    ATT_PK4(p0, 0, pa0); ATT_PK4(p0, 8, pa1); ATT_PK4(p1, 0, pa2); ATT_PK4(p1, 8, pa3);
}
__device__ __forceinline__ void mask_gt(f32x16& p0, f32x16& p1, int dq) {
    const float NEG = -__builtin_inff();
#pragma unroll
    for (int r = 0; r < 16; ++r) { const int c = (r & 3) + 8 * (r >> 2);
        if (c > dq) p0[r] = NEG;
        if (c + 32 > dq) p1[r] = NEG; }
}
template <bool SECOND>
__device__ __forceinline__ void diff_pass(const bf16_t* __restrict__ Qg, const bf16_t* __restrict__ Kg, const bf16_t* __restrict__ Vg, float* S1, bf16_t* __restrict__ Og,
                                          int qb, float lam, const float* __restrict__ gsub, float gmul, ldsp lds, int wave_) {
    int tid_ = tid_from_wave(wave_); asm volatile("" : "+v"(tid_));
    const int tid = tid_, wid = __builtin_amdgcn_readfirstlane(tid >> 6), lane = tid & 63, r32 = lane & 31, hi = lane >> 5;
    const int NT = 4 * qb + 4, R0 = 256 * qb + 32 * wid, myrow = R0 + r32;
    const ldsp V_lds = lds + LDS_V; const ldsp K_lds = lds + LDS_K;
    ALAS float* wsf = (ALAS float*)(lds + LDS_WS) + wid * 64; ALAS float* li_l = wsf; ALAS float* al_l = wsf + 32;
    bf16x8 qr[4];
    { const bf16_t* Qw = Qg + (size_t)R0 * QP; const unsigned qoff = (unsigned)(r32 * QP + hi * 8);
#pragma unroll
      for (int d0 = 0; d0 < 4; ++d0) qr[d0] = ldg8(Qw + (qoff + d0 * 16)); }
    const int sr = tid >> 4, sc = (tid & 15) * 8, vst0 = v_st(sr, sc), vst1 = v_st(32 + sr, sc);
    const int kr = tid >> 3, kc = (tid & 7) * 8, kws = KSWZ64(kr, kc * 2);
    const unsigned voff = (unsigned)(sr * QP + sc), koff = (unsigned)(kr * QP + kc);
    const int vb0 = (int)(unsigned)(uintptr_t)V_lds + v_rd_base(lane);
    const int qm = myrow - 4 * hi;
    bf16x8 sk0A, sv0A, sv1A, sk0B, sv0B, sv1B;
#define DF_LOAD(S_, j) do { const bf16_t* vp_ = Vg + (size_t)(64 * (j)) * QP; sk0##S_ = ldg8(Kg + (size_t)(64 * (j)) * QP + koff); sv0##S_ = ldg8(vp_ + voff); sv1##S_ = ldg8(vp_ + (size_t)32 * QP + voff); } while (0)
#define DF_WRITE(S_, bf) do { *(ALAS bf16x8*)(K_lds + (bf) * SHM_K + kws) = sk0##S_; *(ALAS bf16x8*)(V_lds + (bf) * SHM_V + vst0) = sv0##S_; *(ALAS bf16x8*)(V_lds + (bf) * SHM_V + vst1) = sv1##S_; } while (0)
#define DF_MASK(P0, P1, t) do { if (64 * (t) + 63 > R0) mask_gt(P0, P1, qm - 64 * (t)); } while (0)
#define DF_RESC(a) do { if (__any((a) < 1.f)) { if (hi == 0) al_l[r32] = (a); asm volatile("s_waitcnt lgkmcnt(0)" ::: "memory"); \
        _Pragma("unroll") for (int d_ = 0; d_ < 4; ++d_) _Pragma("unroll") for (int r = 0; r < 16; ++r) o[d_][r] *= al_l[crow(r, hi)]; } } while (0)
    float m_reg = -1e30f, l_reg = 0.f; f32x16 o[4] = {};
    f32x16 pA0, pA1, pB0, pB1; float alA = 1.f, alB = 1.f; bf16x8 pa0, pa1, pa2, pa3;
    DF_LOAD(A, 0); DF_WRITE(A, 0);
    __syncthreads();
    DF_LOAD(A, 1); DF_LOAD(B, 2);
    qkt64(pA0, pA1, K_lds, r32, hi, qr); DF_MASK(pA0, pA1, 0); partial_sm(pA0, pA1, m_reg, alA, hi);
    DF_WRITE(A, 1);
    DF_RESC(alA);
    __syncthreads();
#define DF_HALF(PX0, PX1, alX, PY0, PY1, alY, t, KB, VB, SB, LS, WS) do { \
        SBAR(); qkt64(PX0, PX1, K_lds + (KB) * SHM_K, r32, hi, qr); \
        finish_sm(PY0, PY1, alY, l_reg, pa0, pa1, pa2, pa3, hi); SBAR(); \
        if ((t) + 2 < NT) { DF_LOAD(LS, (t) + 2); SBAR(); } \
        pv_tile(o, vb0 + (VB) * SHM_V, pa0, pa1, pa2, pa3); DF_MASK(PX0, PX1, (t)); partial_sm(PX0, PX1, m_reg, alX, hi); \
        __syncthreads(); \
        if ((t) + 1 < NT) DF_WRITE(WS, SB); \
        DF_RESC(alX); __syncthreads(); } while (0)
    for (int t = 1; t + 1 < NT; t += 2) {
        DF_HALF(pB0, pB1, alB, pA0, pA1, alA, t, 1, 0, 0, A, B);
        DF_HALF(pA0, pA1, alA, pB0, pB1, alB, t + 1, 0, 1, 1, B, A);
    }
    DF_HALF(pB0, pB1, alB, pA0, pA1, alA, NT - 1, 1, 0, 0, A, B);
    finish_sm(pB0, pB1, alB, l_reg, pa0, pa1, pa2, pa3, hi); SBAR();
    pv_tile(o, vb0 + 1 * SHM_V, pa0, pa1, pa2, pa3);
#undef DF_LOAD
#undef DF_WRITE
#undef DF_MASK
#undef DF_RESC
#undef DF_HALF
    if (hi == 0) li_l[r32] = l_reg; asm volatile("s_waitcnt lgkmcnt(0)" ::: "memory");
    float rli[16];
#pragma unroll
    for (int r = 0; r < 16; ++r) rli[r] = __builtin_amdgcn_rcpf(li_l[crow(r, hi)]);
    if constexpr (!SECOND) {
        float* Sw = S1 + (size_t)R0 * OP; const unsigned ooff = (unsigned)(4 * hi * OP + r32);
#pragma unroll
        for (int r = 0; r < 16; ++r) { float* rowp = Sw + (size_t)((r & 3) + 8 * (r >> 2)) * OP;
#pragma unroll
            for (int d0 = 0; d0 < 4; ++d0) rowp[ooff + d0 * 32] = o[d0][r] * rli[r]; }
    } else {
        const float* Sw = S1 + (size_t)R0 * OP; bf16_t* Ow = Og + (size_t)R0 * OP; (void)Ow; const unsigned ooff = (unsigned)(4 * hi * OP + r32), ooff8 = (unsigned)(4 * hi * OBP + r32);
        float gn[4];
#pragma unroll
        for (int d0 = 0; d0 < 4; ++d0) gn[d0] = gsub[d0 * 32 + r32] * gmul;
#pragma unroll
        for (int r = 0; r < 16; ++r) { const float* srow = Sw + (size_t)((r & 3) + 8 * (r >> 2)) * OP; float d[4]; float ss = 0.f;
#if WO_F8
            unsigned char* orowp = (unsigned char*)Og + (size_t)(R0 + (r & 3) + 8 * (r >> 2)) * OBP;
#else
            bf16_t* orowp = Ow + (size_t)((r & 3) + 8 * (r >> 2)) * OP;
#endif
#pragma unroll
            for (int d0 = 0; d0 < 4; ++d0) { d[d0] = srow[ooff + d0 * 32] - lam * (o[d0][r] * rli[r]); ss += d[d0] * d[d0]; }
            ss += __builtin_bit_cast(float, __builtin_amdgcn_update_dpp(0, __builtin_bit_cast(int, ss), 0xB1, 0xf, 0xf, true));
            ss += __builtin_bit_cast(float, __builtin_amdgcn_update_dpp(0, __builtin_bit_cast(int, ss), 0x4E, 0xf, 0xf, true));
            ss += __builtin_bit_cast(float, __builtin_amdgcn_update_dpp(0, __builtin_bit_cast(int, ss), 0x141, 0xf, 0xf, true));
            ss += __builtin_bit_cast(float, __builtin_amdgcn_update_dpp(0, __builtin_bit_cast(int, ss), 0x140, 0xf, 0xf, true));
            { auto rr = __builtin_amdgcn_permlane16_swap(__float_as_uint(ss), __float_as_uint(ss), false, false); ss = __uint_as_float(rr[0]) + __uint_as_float(rr[1]); }
            const float rs = __builtin_amdgcn_rsqf(ss * (1.f / 128.f) + 1e-5f);
#pragma unroll
#if WO_F8
            for (int d0 = 0; d0 < 4; ++d0) { const unsigned w = quad_pack_fp8(d[d0] * rs * gn[d0] * OB8_SCALE);
                if ((r32 & 3) == 0) *(unsigned*)(orowp + (ooff8 + d0 * 32)) = w; }
#else
            for (int d0 = 0; d0 < 4; ++d0) { const float v = d[d0] * rs * gn[d0]; const float vn = __shfl_xor(v, 1);
                if ((r32 & 1) == 0) *(unsigned*)(orowp + (ooff + d0 * 32)) = cvtpk(v, vn); }
#endif
            if ((r & 1) == 1) asm volatile("" ::: "memory"); }
    }
    __syncthreads();
}
#undef SBAR
}

#define LAS __attribute__((address_space(3)))

#define XB_TMO      128
#define XB_XCNT(j)  (256  + 64 * (j))
#define XB_XSUB(j)  (1280 + 64 * (j))
#define XB_XGEN(j)  (2304 + 64 * (j))
#define XB_TOP      3328
#define XB_TOPGEN   3392
#define XCD_BAR_WORDS 3456
#define XB_SPIN_CAP (1u << 18)

__device__ __forceinline__ unsigned xb_ld(unsigned* p)              { return __hip_atomic_load(p, __ATOMIC_RELAXED, __HIP_MEMORY_SCOPE_AGENT); }
__device__ __forceinline__ unsigned xb_add(unsigned* p, unsigned v) { return __hip_atomic_fetch_add(p, v, __ATOMIC_RELAXED, __HIP_MEMORY_SCOPE_AGENT); }
__device__ __forceinline__ unsigned xb_xcc_id() { return (unsigned)__builtin_amdgcn_s_getreg((3 << 11) | 20) & 0xFu; }
#define XB_SPIN(cond, bar) do { unsigned _sp = 0; while (cond) { __builtin_amdgcn_s_sleep(1); \
    if ((++_sp & 255u) == 0u) { if (xb_ld(&(bar)[XB_TMO])) break; if (_sp > XB_SPIN_CAP) { atomicAdd(&(bar)[XB_TMO], 1u); break; } } } } while (0)

struct XcdBarrier {
    unsigned* bar; unsigned x;
    volatile LAS unsigned* st;
};

__device__ __forceinline__ XcdBarrier xcd_barrier_post(unsigned* bar, volatile LAS unsigned* st, bool thread0) {
    XcdBarrier b; b.bar = bar; b.x = xb_xcc_id(); b.st = st;
    if (thread0) (void)xb_add(&bar[XB_XCNT(b.x)], 1u);
    return b;
}
__device__ __forceinline__ void xcd_barrier_complete(unsigned* bar, unsigned x, unsigned& nloc, unsigned& nx) {
    const unsigned G = gridDim.x * gridDim.y * gridDim.z;
    unsigned sum, cnt, mine, sp = 0u;
    for (;;) {
        sum = 0u; cnt = 0u; mine = 0u;
#pragma unroll
        for (unsigned j = 0; j < 16; ++j) { const unsigned c = xb_ld(&bar[XB_XCNT(j)]); sum += c; cnt += (c > 0u) ? 1u : 0u; mine = (j == x) ? c : mine; }
        if (sum == G) break;
        __builtin_amdgcn_s_sleep(1);
        if ((++sp & 255u) == 0u) { if (xb_ld(&bar[XB_TMO])) break; if (sp > XB_SPIN_CAP) { atomicAdd(&bar[XB_TMO], 1u); break; } }
    }
    nloc = mine > 0u ? mine : 1u; nx = cnt > 0u ? cnt : 1u;
}

__device__ __forceinline__ void xcd_barrier(const XcdBarrier& b, bool thread0) {
    asm volatile("s_waitcnt vmcnt(0)" ::: "memory");
    __syncthreads();
    if (thread0) {
        unsigned* bar = b.bar;
        __builtin_amdgcn_s_waitcnt(0);
        unsigned nloc = b.st[0], nx = b.st[1];
        if (nloc == 0u) { xcd_barrier_complete(bar, b.x, nloc, nx); b.st[0] = nloc; b.st[1] = nx; }
        const unsigned old = xb_add(&bar[XB_XSUB(b.x)], 1u);
        const unsigned gen = old / nloc;
        if (old + 1u == (gen + 1u) * nloc) {
            __builtin_amdgcn_fence(__ATOMIC_RELEASE, "agent");
            asm volatile("s_waitcnt vmcnt(0)" ::: "memory");
            const unsigned og = xb_add(&bar[XB_TOP], 1u);
            const unsigned tg = og / nx;
            if (og + 1u == (tg + 1u) * nx) xb_add(&bar[XB_TOPGEN], 1u);
            else XB_SPIN(xb_ld(&bar[XB_TOPGEN]) == tg, bar);
            __builtin_amdgcn_fence(__ATOMIC_ACQUIRE, "agent");
            xb_add(&bar[XB_XGEN(b.x)], 1u);
            asm volatile("s_waitcnt vmcnt(0)" ::: "memory");
        } else {
            XB_SPIN(xb_ld(&bar[XB_XGEN(b.x)]) == gen, bar);
            __builtin_amdgcn_fence(__ATOMIC_ACQUIRE, "agent");
            asm volatile("s_waitcnt vmcnt(0)" ::: "memory");
        }
    }
    __syncthreads();
}

constexpr int NWAVES = 8;
constexpr int NTOK = 16384, DM = 2048, SEQ = 2048, NHEAD = 16, NLAYER = 4, NEXP = 16, DEXP = 1024;
constexpr int XS_ROWS = 36864;
constexpr float LN_EPS = 1e-5f;
constexpr float DN_ALPHA = 1.6817928305074292f;
constexpr float LOG2E = 1.4426950408889634f;
constexpr float SB_QSCALE = 0.08838834764831845f * LOG2E;
constexpr float DF_QSCALE = 0.125f * LOG2E;
#ifndef MK_MULTI
#define MK_MULTI 0
#endif
#ifndef MOE_F8
#define MOE_F8 1
#endif
#ifndef QKV8_A
#define QKV8_A 1
#endif
#ifndef QKV8_B
#define QKV8_B 0
#endif
constexpr int NSTEPS = 1 + 8 * NLAYER;

constexpr size_t MiB = 1u << 20;
constexpr size_t WS_CTL = 0, CTL_ZERO_BYTES = 64 * 1024;
constexpr size_t WS_COS = 1 * MiB, WS_SIN = WS_COS + 256 * 1024;
constexpr size_t WS_WR = 2 * MiB;
constexpr size_t WS_CNT = 3 * MiB;
constexpr size_t WS_RE = WS_CNT + 64 * 1024;
constexpr size_t WS_RW = WS_RE + 64 * 1024;
constexpr size_t WS_RP = WS_RW + 128 * 1024;
constexpr int LDH = 2048;
constexpr int P8K2 = 2048, P8K1 = 1024;
constexpr size_t WS_WQKVA = 4 * MiB;
constexpr size_t WS_WOA = WS_WQKVA + 56 * MiB;
constexpr size_t WS_WQKVB = WS_WOA + 16 * MiB;
constexpr size_t WS_WOB = WS_WQKVB + 36 * MiB;
constexpr size_t WS_WGU = WS_WOB + 16 * MiB;
constexpr size_t WS_WDN = WS_WGU + 512 * MiB;
constexpr size_t WS_H = WS_WDN + 256 * MiB;
constexpr size_t WS_HB = WS_H + 128 * MiB;
constexpr size_t WS_QKV = WS_HB + 68 * MiB;
constexpr size_t WS_OB = WS_QKV + 192 * MiB;
constexpr size_t WS_XS = WS_OB + 64 * MiB;
constexpr size_t WS_ACT = WS_XS + 144 * MiB;
constexpr size_t WS_YD = WS_ACT + 72 * MiB;
constexpr size_t WS_END = WS_YD + 144 * MiB;
static_assert(WS_END <= (size_t)2040 * MiB, "workspace map");
static_assert((size_t)2 * 6144 * LDH * 2 <= 56 * MiB && (size_t)8192 * LDH * 2 <= 36 * MiB && (size_t)2 * 2048 * P8K2 <= 16 * MiB && (size_t)64 * 2048 * P8K2 <= 512 * MiB && (size_t)64 * 2048 * P8K1 <= 256 * MiB, "weight regions");
static_assert((size_t)NTOK * LDH * 2 <= 68 * MiB && (size_t)NTOK * P8K2 <= 64 * MiB && (size_t)XS_ROWS * P8K2 <= 144 * MiB && (size_t)XS_ROWS * P8K1 <= 72 * MiB, "activation regions");
constexpr int CW_BAR = 1024;
constexpr int LDS_BYTES = 147456;
constexpr int LDSCTL_OFF = 145408;
constexpr int RING_OFF = 0;
constexpr int LNX_OFF = 131072;

#define GAS __attribute__((address_space(1)))
typedef unsigned short bf16;
typedef unsigned v4u __attribute__((ext_vector_type(4)));
typedef unsigned v2u __attribute__((ext_vector_type(2)));
typedef float f32x4 __attribute__((ext_vector_type(4)));
typedef float f32x2 __attribute__((ext_vector_type(2)));
typedef _Float16 f16x4 __attribute__((ext_vector_type(4)));
__device__ __forceinline__ f32x4 ldh4(const _Float16* p) { return __builtin_convertvector(*(const f16x4*)p, f32x4); }
__device__ __forceinline__ void sth4(_Float16* p, f32x4 v) { *(f16x4*)p = __builtin_convertvector(v, f16x4); }
#define LDS_WAIT() asm volatile("s_waitcnt lgkmcnt(0)" ::: "memory")
#define VM_WAIT() asm volatile("s_waitcnt vmcnt(0)" ::: "memory")
__device__ __forceinline__ unsigned pk2(float lo, float hi) { unsigned r; asm volatile("v_cvt_pk_bf16_f32 %0, %1, %2" : "=v"(r) : "v"(lo), "v"(hi)); return r; }
__device__ __forceinline__ int opq_tid(int wave) { int t = tid_from_wave(wave); asm volatile("" : "+v"(t)); return t; }
__device__ __forceinline__ float dpp_sum(float v) {
    v += __builtin_bit_cast(float, __builtin_amdgcn_update_dpp(0, __builtin_bit_cast(int, v), 0xB1, 0xf, 0xf, true));
    v += __builtin_bit_cast(float, __builtin_amdgcn_update_dpp(0, __builtin_bit_cast(int, v), 0x4E, 0xf, 0xf, true));
    v += __builtin_bit_cast(float, __builtin_amdgcn_update_dpp(0, __builtin_bit_cast(int, v), 0x141, 0xf, 0xf, true));
    v += __builtin_bit_cast(float, __builtin_amdgcn_update_dpp(0, __builtin_bit_cast(int, v), 0x140, 0xf, 0xf, true));
    const int b = __builtin_bit_cast(int, v);
    const float s0 = __builtin_bit_cast(float, __builtin_amdgcn_readlane(b, 0)), s1 = __builtin_bit_cast(float, __builtin_amdgcn_readlane(b, 16));
    const float s2 = __builtin_bit_cast(float, __builtin_amdgcn_readlane(b, 32)), s3 = __builtin_bit_cast(float, __builtin_amdgcn_readlane(b, 48));
    return (s0 + s1) + (s2 + s3);
}
__device__ __forceinline__ float wave_sum(float v) {
#pragma unroll
    for (int o = 1; o < 64; o <<= 1) v += __shfl_xor(v, o);
    return v;
}

struct Args { const float* in[17]; float* out; unsigned char* ws; int s_lo, s_hi; };

__device__ __forceinline__ int map_row(int n, int mode) {
    if (mode == 0) return n;
    if (mode == 1) { const int c = n & 255, blk = c >> 6, d = c & 63; return (n & ~255) + ((d >> 5) << 7) + (blk << 5) + (d & 31); }
    return ((n >> 7) << 8) + (n & 127) + (mode == 3 ? 128 : 0);
}
__device__ __forceinline__ unsigned pk2h(float lo, float hi) { typedef _Float16 h2 __attribute__((ext_vector_type(2))); const f32x2 v = {lo, hi}; return __builtin_bit_cast(unsigned, __builtin_convertvector(v, h2)); }
__device__ __forceinline__ void cvt_load(f32x4 (&v)[16], const float* __restrict__ src, int pitch, int k0, int n0, int lane) {
    const int kr = lane >> 4, n4 = (lane & 15) * 4; const float* p = src + (size_t)(k0 + kr) * pitch + n0 + n4;
#pragma unroll
    for (int i = 0; i < 16; ++i) v[i] = __builtin_nontemporal_load((const f32x4*)(p + (size_t)(4 * i) * pitch));
}
__device__ __forceinline__ void cvt_store(const f32x4 (&v)[16], unsigned char* __restrict__ dst, int dp, int mode, int k0, int n0, int kind, LAS float* scr, int lane) {
    const int kr = lane >> 4, n4 = (lane & 15) * 4; const float scale = kind == 2 ? pg8::W8_SCALE : 1.f;
#pragma unroll
    for (int i = 0; i < 16; ++i) { LAS float* s = scr + (4 * i + kr) * 65 + n4; s[0] = v[i][0] * scale; s[1] = v[i][1] * scale; s[2] = v[i][2] * scale; s[3] = v[i][3] * scale; }
    LDS_WAIT();
    if (kind == 2) { const int c = lane & 3;
#pragma unroll
        for (int j = 0; j < 4; ++j) { const int nl = (lane >> 2) + 16 * j; const int row = map_row(n0 + nl, mode);
            const LAS float* s = scr + (16 * c) * 65 + nl;
            v4u o; o.x = pg8::pack4_fp8(s[0], s[65], s[130], s[195]); o.y = pg8::pack4_fp8(s[260], s[325], s[390], s[455]);
            o.z = pg8::pack4_fp8(s[520], s[585], s[650], s[715]); o.w = pg8::pack4_fp8(s[780], s[845], s[910], s[975]);
            *(v4u*)(dst + (size_t)row * dp + k0 + 16 * c) = o; }
    } else { const int c = lane & 7;
#pragma unroll
        for (int j = 0; j < 8; ++j) { const int nl = (lane >> 3) + 8 * j; const int row = map_row(n0 + nl, mode);
            const LAS float* s = scr + (8 * c) * 65 + nl;
            v4u o; o.x = pk2h(s[0], s[65]); o.y = pk2h(s[130], s[195]); o.z = pk2h(s[260], s[325]); o.w = pk2h(s[390], s[455]);
            *(v4u*)(dst + (size_t)row * dp + (k0 + 8 * c) * 2) = o; }
    }
    LDS_WAIT();
}

__global__ void __launch_bounds__(NWAVES * 64, 2) yoco_fwd(Args args) {
    extern __shared__ __attribute__((aligned(16))) unsigned char lds_raw[];
    LAS unsigned char* const lds = (LAS unsigned char*)lds_raw;
    const int tid = threadIdx.x, lane = tid & 63, wave = __builtin_amdgcn_readfirstlane(tid >> 6);
    const int G = gridDim.x, bx = blockIdx.x;
    const int vcu = (G % 8 == 0) ? (bx % 8) * (G / 8) + bx / 8 : bx;
    unsigned char* const ws = args.ws;
    volatile LAS unsigned* const CTL = (volatile LAS unsigned*)(lds + LDSCTL_OFF);
    LAS int* const TAB = (LAS int*)(lds + LDSCTL_OFF + 64);
    for (int u = tid; u < (LDS_BYTES - LDSCTL_OFF) / 4; u += NWAVES * 64) ((LAS unsigned*)(lds + LDSCTL_OFF))[u] = 0u;
    __syncthreads();
    const int s_lo = args.s_lo, s_hi = args.s_hi;
    XcdBarrier bar; bar.bar = (unsigned*)(ws + WS_CTL) + CW_BAR; bar.x = 0; bar.st = nullptr;
    if (s_hi - s_lo > 1) bar = xcd_barrier_post((unsigned*)(ws + WS_CTL) + CW_BAR, CTL, tid == 0);
#ifndef PH_MASK
#define PH_MASK 0xFFFF
#endif
#define PHM(b) (((PH_MASK) >> (b)) & 1)
#ifndef PROBE_DUP
#define PROBE_DUP 0
#endif
#define PREP(b) _Pragma("unroll 1") for (int rep_ = 0; rep_ < ((((PROBE_DUP) >> (b)) & 1) ? 2 : 1); ++rep_)
#define IN(k) (s_lo <= (k) && (k) < s_hi)
#define SEAM(k) do { if ((k) + 1 < s_hi) xcd_barrier(bar, tid_from_wave(wave) == 0); } while (0)

    const float* const x_in = args.in[0];
    _Float16* const H = (_Float16*)(ws + WS_H); unsigned char* const HB8 = (unsigned char*)(ws + WS_OB + 32 * MiB);     bf16* const QKV = (bf16*)(ws + WS_QKV); bf16* const OB = (bf16*)(ws + WS_OB);
    bf16* const MIX = (bf16*)(ws + WS_YD);     bf16* const XS = (bf16*)(ws + WS_XS); float* const S1 = (float*)(ws + WS_XS); bf16* const ACT = (bf16*)(ws + WS_ACT); bf16* const YD = (bf16*)(ws + WS_YD);
    float* const COS = (float*)(ws + WS_COS); float* const SIN = (float*)(ws + WS_SIN); float* const WR = (float*)(ws + WS_WR);
    int* const CNT = (int*)(ws + WS_CNT); unsigned* const RE = (unsigned*)(ws + WS_RE); f32x2* const RW = (f32x2*)(ws + WS_RW); int* const RP = (int*)(ws + WS_RP);

    if (IN(0) && PHM(0)) { PREP(0) {
        const int tid = opq_tid(wave), lane = tid & 63;
        LAS float* scr = (LAS float*)(lds + RING_OFF + wave * 16640);
        const int gw = vcu * NWAVES + wave, NGW = G * NWAVES;
        constexpr int I0 = 2 * 3072, I1 = 8 * 1024, I2 = 128 * 512, I3 = 64 * 512, NITEMS = I0 + I1 + I2 + I3;
        static_assert(QKV8_A == 1 && QKV8_B == 0, "conversion table below: stick-breaking q|k|v and all other fp8 GEMM weights -> e4m3, differential q|k|v weights -> fp16");
#define CVT_DECODE(it_, SRC, PIT, DST, DP, MODE, K0, N0, KIND) do { int r = (it_); \
            if (r < I0) { const int job = r / 3072; r -= job * 3072; const int kb = r / 96, nb = r - kb * 96; \
                SRC = args.in[1] + (size_t)job * 2048 * 6144; PIT = 6144; DST = ws + WS_WQKVA + (size_t)job * 6144 * 2048; DP = 2048; MODE = 0; K0 = kb * 64; N0 = nb * 64; KIND = 2; break; } \
            r -= I0; \
            if (r < I1) { const int job = r >> 10; r &= 1023; K0 = (r >> 5) * 64; N0 = (r & 31) * 64; PIT = 2048; MODE = 0; KIND = 2; DP = P8K2; \
                if (job < 2) { SRC = args.in[2] + (size_t)job * 2048 * 2048; DST = ws + WS_WOA + (size_t)job * 2048 * P8K2; } \
                else if (job >= 6) { SRC = args.in[5] + (size_t)(job - 6) * 2048 * 2048; DST = ws + WS_WOB + (size_t)(job - 6) * 2048 * P8K2; } \
                else { KIND = 1; DP = LDH * 2; \
                    if (job == 2) { SRC = args.in[4]; DST = ws + WS_WQKVB; MODE = 1; } \
                    else if (job == 3) { SRC = args.in[3]; PIT = 4096; DST = ws + WS_WQKVB + (size_t)2048 * LDH * 2; MODE = 1; } \
                    else if (job == 4) { SRC = args.in[3] + 2048; PIT = 4096; DST = ws + WS_WQKVB + (size_t)4096 * LDH * 2; } \
                    else { SRC = args.in[4] + (size_t)2048 * 2048; DST = ws + WS_WQKVB + (size_t)6144 * LDH * 2; MODE = 1; } } \
                break; } \
            r -= I1; \
            if (r < I2) { const int job = r >> 9; r &= 511; const int le = job >> 1, up = job & 1;     \
                SRC = (up ? args.in[15] : args.in[14]) + (size_t)le * 2048 * 1024; PIT = 1024; DST = ws + WS_WGU + (size_t)le * 2048 * P8K2; DP = P8K2; MODE = 2 + up; K0 = (r >> 4) * 64; N0 = (r & 15) * 64; KIND = 2; break; } \
            r -= I2; \
            { const int le = r >> 9; r &= 511; SRC = args.in[16] + (size_t)le * 1024 * 2048; PIT = 2048; DST = ws + WS_WDN + (size_t)le * 2048 * P8K1; DP = P8K1; MODE = 0; K0 = (r >> 5) * 64; N0 = (r & 31) * 64; KIND = 2; } \
        } while (0)
        { const float* sA; const float* sB; unsigned char* dA; unsigned char* dB; int pA, pB, qA, qB, mA, mB, kA, kB, nA, nB, tA, tB; f32x4 va[16], vb[16];
          int it = gw;
          if (it < NITEMS) { CVT_DECODE(it, sA, pA, dA, qA, mA, kA, nA, tA); cvt_load(va, sA, pA, kA, nA, lane);
            for (;;) {
                if (it + NGW < NITEMS) { CVT_DECODE(it + NGW, sB, pB, dB, qB, mB, kB, nB, tB); cvt_load(vb, sB, pB, kB, nB, lane); }
                cvt_store(va, dA, qA, mA, kA, nA, tA, scr, lane); it += NGW; if (it >= NITEMS) break;
                if (it + NGW < NITEMS) { CVT_DECODE(it + NGW, sA, pA, dA, qA, mA, kA, nA, tA); cvt_load(va, sA, pA, kA, nA, lane); }
                cvt_store(vb, dB, qB, mB, kB, nB, tB, scr, lane); it += NGW; if (it >= NITEMS) break;
            } } }
#undef CVT_DECODE
        for (size_t i = (size_t)gw * 64 + lane; i < (size_t)NTOK * DM / 4; i += (size_t)NGW * 64) {
            const f32x4 v = ((const f32x4*)x_in)[i];
            ((unsigned*)HB8)[i] = pg8::pack4_fp8(v[0], v[1], v[2], v[3]); }
        for (int i = bx * (NWAVES * 64) + tid; i < 2048 * 32; i += G * NWAVES * 64) { const int pos = i >> 5, f = i & 31;
            const float inv = __builtin_amdgcn_exp2f(-(float)f * 0.4152410118609203f); const float ang = (float)pos * inv;
            const double tr = (double)ang * 0.15915494309189535; const float fr = (float)(tr - __builtin_rint(tr));
            COS[i] = __builtin_amdgcn_cosf(fr); SIN[i] = __builtin_amdgcn_sinf(fr); }
        for (int i = bx * (NWAVES * 64) + tid; i < NLAYER * 20 * 2048; i += G * NWAVES * 64) { const int k = i & 2047, c = (i >> 11) % 20, l = i / (20 * 2048);
            WR[i] = c < 4 ? args.in[12][((size_t)l * 2048 + k) * 4 + c] : args.in[13][(((size_t)l * 4 + ((c - 4) >> 2)) * 2048 + k) * 4 + ((c - 4) & 3)]; }
        }
        SEAM(0);
    }

    for (int L = 0; L < NLAYER; ++L) {
        const int sb = 1 + 8 * L; const bool typeA = L < 2;
        if (IN(sb + 0)) {
            if (typeA && PHM(1)) { PREP(1) {
                pg8::StaticOrder S; S.init(NTOK, 6144, G, bx);
                if (QKV8_A) { pg8::Gemm g{(const bf16*)HB8, (const bf16*)(ws + WS_WQKVA + (size_t)L * 6144 * 2048), NTOK, 6144, DM / 2, DM / 2, wave}; pg8::EpiQkv E{QKV, 6144, 2048, SB_QSCALE, 1.f / pg8::W8_SCALE};
                    pg8::gemm_phase<pg8::EpiQkv, pg8::StaticOrder, true, true, true>(lds + RING_OFF, g, S, E); }
                } static_assert(QKV8_A == 1, "the stick-breaking layers' q|k|v GEMM takes the e4m3 copy of the stream");
            } else if (!typeA && PHM(2)) { PREP(2) {
                const int N = (L == 2) ? 6144 : 2048;
                pg8::StaticOrder S; S.init(NTOK, N, G, bx);
                if (QKV8_B) { pg8::Gemm g{(const bf16*)HB8, (const bf16*)(ws + WS_WQKVB + (L == 2 ? (size_t)0 : (size_t)6144 * 2048)), NTOK, N, DM / 2, DM / 2, wave};
                    pg8::EpiRope E{QKV, 6144, 2048, 4096, DF_QSCALE, COS, SIN, 1.f / pg8::W8_SCALE};
                    pg8::gemm_phase<pg8::EpiRope, pg8::StaticOrder, true, true, true>(lds + RING_OFF, g, S, E); }
                else { pg8::Gemm g{(const bf16*)H, (const bf16*)(ws + WS_WQKVB) + (L == 2 ? (size_t)0 : (size_t)6144 * LDH), NTOK, N, DM, LDH, wave};
                    pg8::EpiRope E{QKV, 6144, 2048, 4096, DF_QSCALE, COS, SIN, 1.f};
                    pg8::gemm_phase<pg8::EpiRope, pg8::StaticOrder, true, true, false, true>(lds + RING_OFF, g, S, E); } }
            }
            SEAM(sb + 0);
        }
        if (IN(sb + 1)) {
            if (typeA && PHM(3)) {
                for (int id_ = vcu; id_ < 512 * (1 + ((PROBE_DUP >> 3) & 1)); id_ += G) { const int id = id_ & 511; const int bh = id >> 2, p = id & 3, b = bh >> 4, h = bh & 15;
                    const bf16* Qg = QKV + (size_t)b * SEQ * 6144 + h * 128; bf16* Og = (bf16*)((unsigned char*)OB + (size_t)b * SEQ * P8K2 + h * 128);
                    att::sb_block(Qg, Qg + 2048, Qg + 4096, Og, 7 - p, (att::ldsp)(lds + RING_OFF), wave);
                    att::sb_block(Qg, Qg + 2048, Qg + 4096, Og, p, (att::ldsp)(lds + RING_OFF), wave); }
            } else if (!typeA && PHM(4)) {
                const int lane = opq_tid(wave) & 63;
                const int i = L - 2; const float lam_init = (L == 2) ? 0.47071301834264183f : 0.5560582041556061f;
                const float* lp = args.in[6] + (size_t)i * 256;
                const float sa = dpp_sum(lp[lane] * lp[64 + lane]), sb2 = dpp_sum(lp[128 + lane] * lp[192 + lane]);
                const float lam = __builtin_amdgcn_exp2f(sa * LOG2E) - __builtin_amdgcn_exp2f(sb2 * LOG2E) + lam_init;
                const float* gsub = args.in[7] + (size_t)i * 128; const float gmul = 1.f - lam_init;
                for (int id_ = vcu; id_ < 512 * (1 + ((PROBE_DUP >> 4) & 1)); id_ += G) { const int id = id_ & 511; const int bh = id >> 2, p = id & 3, b = bh >> 4, h = bh & 15;
                    const bf16* Qg = QKV + (size_t)b * SEQ * 6144 + h * 128; bf16* Og = (bf16*)((unsigned char*)OB + (size_t)b * SEQ * P8K2 + h * 128); float* Sg = S1 + (size_t)b * SEQ * DM + h * 128;
#pragma unroll 1
                    for (int w = 0; w < 2; ++w) { const int qb = w ? p : 7 - p;
                        att::diff_pass<false>(Qg, Qg + 2048, Qg + 4096, Sg, Og, qb, lam, gsub, gmul, (att::ldsp)(lds + RING_OFF), wave);
                        att::diff_pass<true>(Qg + 64, Qg + 2048 + 64, Qg + 4096, Sg, Og, qb, lam, gsub, gmul, (att::ldsp)(lds + RING_OFF), wave); } }
            }
            SEAM(sb + 1);
        }
        if (IN(sb + 2)) { if (PHM(5)) {
            pg8::Gemm g{OB, (const bf16*)(ws + (typeA ? WS_WOA : WS_WOB) + (size_t)(L & 1) * 2048 * P8K2), NTOK, DM, DM / 2, P8K2 / 2, wave}; pg8::StaticOrder S; S.init(NTOK, DM, G, bx);
            pg8::EpiQkv E{MIX, DM, 0, 1.f, 1.f / (pg8::W8_SCALE * att::OB8_SCALE)};
            pg8::gemm_phase<pg8::EpiQkv, pg8::StaticOrder, true, true, true>(lds + RING_OFF, g, S, E); }
            SEAM(sb + 2);
        }
        if (IN(sb + 3)) { if (PHM(6)) {
            const int tid = opq_tid(wave), lane = tid & 63;
            const float* lng = args.in[8] + (size_t)L * DM; const float* lnb = args.in[9] + (size_t)L * DM; const float* wr = WR + (size_t)L * 20 * 2048;
            LAS int* eid = (LAS int*)(lds + LNX_OFF + 2048);
            LAS float* lgt = (LAS float*)(lds + LNX_OFF + 4096);
            LAS unsigned* rows8 = (LAS unsigned*)(lds + RING_OFF);
            for (int c = bx; c < 256; c += G) {
#pragma unroll 1
                for (int grp = 0; grp < 4; ++grp) {
                    const int rloc = wave * 8 + grp * 2; const size_t row0 = (size_t)64 * c + rloc;
                    f32x4 v[2][8]; float mu[2], rstd[2];
#pragma unroll
                    for (int rr = 0; rr < 2; ++rr) {
                        if (L == 0) { const f32x4* hp = (const f32x4*)(x_in + (row0 + rr) * DM) + lane;
#pragma unroll
                            for (int j = 0; j < 8; ++j) v[rr][j] = hp[64 * j]; }
                        else { const _Float16* hq = H + (row0 + rr) * DM + 4 * lane;
#pragma unroll
                            for (int j = 0; j < 8; ++j) v[rr][j] = ldh4(hq + 256 * j); } }
#pragma unroll
                    for (int rr = 0; rr < 2; ++rr) { const v2u* mp = (const v2u*)(MIX + (row0 + rr) * DM) + lane;
#pragma unroll
                        for (int j = 0; j < 8; ++j) { const v2u a = mp[64 * j];
                            const f32x4 fa = {__uint_as_float(a.x << 16), __uint_as_float(a.x & 0xffff0000u), __uint_as_float(a.y << 16), __uint_as_float(a.y & 0xffff0000u)};
                            v[rr][j] = v[rr][j] * DN_ALPHA + fa; } }
#pragma unroll
                    for (int rr = 0; rr < 2; ++rr) { float s = 0.f;
#pragma unroll
                        for (int j = 0; j < 8; ++j) s += (v[rr][j][0] + v[rr][j][1]) + (v[rr][j][2] + v[rr][j][3]);
                        mu[rr] = dpp_sum(s) * (1.f / DM); float q = 0.f;
#pragma unroll
                        for (int j = 0; j < 8; ++j) { const f32x4 d = v[rr][j] - mu[rr]; q += (d[0] * d[0] + d[1] * d[1]) + (d[2] * d[2] + d[3] * d[3]); }
                        rstd[rr] = 1.f / sqrtf(dpp_sum(q) * (1.f / DM) + LN_EPS); }
#pragma unroll
                    for (int j = 0; j < 8; ++j) { const f32x4 gg = ((const f32x4*)lng)[64 * j + lane], bb = ((const f32x4*)lnb)[64 * j + lane];
#pragma unroll
                        for (int rr = 0; rr < 2; ++rr) { v[rr][j] = (v[rr][j] - mu[rr]) * rstd[rr] * gg + bb; sth4(H + (row0 + rr) * DM + 256 * j + 4 * lane, v[rr][j]);
                            if (c == bx) rows8[(rloc + rr) * 512 + 64 * j + lane] = pg8::pack4_fp8(v[rr][j][0], v[rr][j][1], v[rr][j][2], v[rr][j][3]); } }
                    f32x4 wn[8];
                    { const f32x4* wp = (const f32x4*)wr + lane;
#pragma unroll
                      for (int j = 0; j < 8; ++j) wn[j] = wp[64 * j]; }
#pragma unroll 1
                    for (int cc = 0; cc < 20; ++cc) { f32x4 w[8];
#pragma unroll
                        for (int j = 0; j < 8; ++j) w[j] = wn[j];
                        { const f32x4* wp = (const f32x4*)(wr + (cc < 19 ? cc + 1 : 19) * 2048) + lane;
#pragma unroll
                          for (int j = 0; j < 8; ++j) wn[j] = wp[64 * j]; }
                        float a[2] = {0.f, 0.f};
#pragma unroll
                        for (int j = 0; j < 8; ++j) {
#pragma unroll
                            for (int rr = 0; rr < 2; ++rr) a[rr] += (v[rr][j][0] * w[j][0] + v[rr][j][1] * w[j][1]) + (v[rr][j][2] * w[j][2] + v[rr][j][3] * w[j][3]); }
#pragma unroll
                        for (int rr = 0; rr < 2; ++rr) a[rr] = dpp_sum(a[rr]);
                        if (lane == 0) { lgt[rloc * 20 + cc] = a[0]; lgt[(rloc + 1) * 20 + cc] = a[1]; } }
                }
                LDS_WAIT();
                if (lane < 8) {
                    const int rl = wave * 8 + lane; const LAS float* lg = lgt + rl * 20;
                    int gsel = 0; float gm = lg[0];
#pragma unroll
                    for (int i = 1; i < 4; ++i) { const float x = lg[i]; if (x > gm) { gm = x; gsel = i; } }
                    float gden = 0.f;
#pragma unroll
                    for (int i = 0; i < 4; ++i) gden += __builtin_amdgcn_exp2f((lg[i] - gm) * LOG2E);
                    const float gw_ = 1.f / gden;
                    const LAS float* li = lg + 4 + 4 * gsel;
                    const float l0 = li[0], l1 = li[1], l2 = li[2], l3 = li[3];
                    int i0 = 0; float v0 = l0;
                    if (l1 > v0) { v0 = l1; i0 = 1; } if (l2 > v0) { v0 = l2; i0 = 2; } if (l3 > v0) { v0 = l3; i0 = 3; }
                    int i1 = -1; float v1 = 0.f;
                    if (i0 != 0) { v1 = l0; i1 = 0; }
                    if (i0 != 1 && (i1 < 0 || l1 > v1)) { v1 = l1; i1 = 1; }
                    if (i0 != 2 && (i1 < 0 || l2 > v1)) { v1 = l2; i1 = 2; }
                    if (i0 != 3 && (i1 < 0 || l3 > v1)) { v1 = l3; i1 = 3; }
                    const float t = __builtin_amdgcn_exp2f((v1 - v0) * LOG2E); const float w0 = gw_ / (1.f + t), w1 = gw_ * t / (1.f + t);
                    eid[2 * rl] = gsel * 4 + i0; eid[2 * rl + 1] = gsel * 4 + i1; RW[(size_t)64 * c + rl] = (f32x2){w0, w1};
                }
                __syncthreads();
                if (wave == 0) {
                    const int ea = eid[lane], eb = eid[64 + lane]; int ra = 0, rb = 0, cnt = 0; const unsigned long long lt = (1ull << lane) - 1ull;
#pragma unroll
                    for (int e = 0; e < 16; ++e) { const unsigned long long ma = __ballot(ea == e), mb = __ballot(eb == e);
                        if (ea == e) ra = __popcll(ma & lt); if (eb == e) rb = __popcll(ma) + __popcll(mb & lt); if (lane == e) cnt = __popcll(ma) + __popcll(mb); }
                    if (lane < 16) CNT[c * 16 + lane] = cnt;
                    LAS int* rk = (LAS int*)(lds + LNX_OFF + 3072); rk[lane] = ra; rk[64 + lane] = rb; LDS_WAIT();
                    const int r = lane; const unsigned word = (unsigned)eid[2 * r] | ((unsigned)eid[2 * r + 1] << 8) | ((unsigned)rk[2 * r] << 16) | ((unsigned)rk[2 * r + 1] << 24);
                    RE[(size_t)64 * c + r] = word;
                }
                __syncthreads();
            } }
            SEAM(sb + 3);
        }
        if ((IN(sb + 4) || IN(sb + 5) || IN(sb + 6)) && PHM(7)) {
            const int tid = opq_tid(wave);
            LAS int* part = (LAS int*)(lds + LNX_OFF);
            { const int e = tid & 15, s = tid >> 4; int a = 0;
#pragma unroll
              for (int i = 0; i < 8; ++i) a += CNT[(8 * s + i) * 16 + e];
              part[s * 16 + e] = a; }
            __syncthreads();
            if (tid < 16) { int run = 0;
#pragma clang loop vectorize(disable) unroll(disable)
                for (int s = 0; s < 32; ++s) run += part[s * 16 + tid];
                TAB[tid] = run; }
            __syncthreads();
            if (tid == 0) { int off = 0, mt = 0;
#pragma clang loop vectorize(disable) unroll(disable)
                for (int e = 0; e < 16; ++e) { TAB[16 + e] = off; const int nt = (TAB[e] + 255) >> 8;
#pragma clang loop vectorize(disable) unroll(disable)
                    for (int i = 0; i < nt; ++i) TAB[64 + mt++] = e;
                    off += nt * 256; }
                TAB[32] = off; TAB[33] = mt; }
            __syncthreads();
        }
        if (IN(sb + 4)) { if (PHM(7)) PREP(7) {
            const int tid = opq_tid(wave), lane = tid & 63;
            LAS int* part = (LAS int*)(lds + LNX_OFF);
            for (int c = bx; c < 256; c += G) {
                if (tid < 16) { int pre = 0; int x[8];
#pragma unroll
                    for (int i = 0; i < 8; ++i) x[i] = CNT[((c & ~7) + i) * 16 + tid];
#pragma clang loop vectorize(disable) unroll(disable)
                    for (int s = 0; s < (c >> 3); ++s) pre += part[s * 16 + tid];
#pragma unroll
                    for (int i = 0; i < 8; ++i) pre += (i < (c & 7)) ? x[i] : 0;
                    TAB[48 + tid] = TAB[16 + tid] + pre; }
                __syncthreads();
#pragma unroll 1
                for (int rr = 0; rr < 8; ++rr) { const size_t row = (size_t)64 * c + wave * 8 + rr; const unsigned word = RE[row];
                    const int p0 = TAB[48 + (word & 255)] + ((word >> 16) & 255), p1 = TAB[48 + ((word >> 8) & 255)] + (word >> 24);
                    if (lane == 0) { RP[2 * row] = p0; RP[2 * row + 1] = p1; }
                    if (c == bx && IN(sb + 3)) {
                        const LAS v4u* src = (const LAS v4u*)(lds + RING_OFF + (wave * 8 + rr) * 2048) + lane; v4u* o0 = (v4u*)((unsigned char*)XS + (size_t)p0 * P8K2) + lane; v4u* o1 = (v4u*)((unsigned char*)XS + (size_t)p1 * P8K2) + lane;
                        const v4u a = src[0], b = src[64]; o0[0] = a; o0[64] = b; o1[0] = a; o1[64] = b;
                    } else {
                        const _Float16* hq = H + row * DM + 4 * lane; unsigned* o0 = (unsigned*)((unsigned char*)XS + (size_t)p0 * P8K2) + lane; unsigned* o1 = (unsigned*)((unsigned char*)XS + (size_t)p1 * P8K2) + lane;
#pragma unroll
                        for (int j = 0; j < 8; ++j) { const f32x4 v = ldh4(hq + 256 * j); const unsigned o = pg8::pack4_fp8(v[0], v[1], v[2], v[3]); o0[64 * j] = o; o1[64 * j] = o; } } }
                __syncthreads();
            } }
            SEAM(sb + 4);
        }
        if (IN(sb + 5)) { if (PHM(8)) PREP(8) {
            pg8::Gemm g{XS, (const bf16*)(ws + WS_WGU + (size_t)L * 16 * 2048 * P8K2), XS_ROWS, 2048, DM / 2, P8K2 / 2, wave};
            pg8::MoeOrder S{TAB[33] * 8, G, bx, TAB + 64}; pg8::EpiGateUp8 E{(unsigned char*)ACT};
            pg8::gemm_phase<pg8::EpiGateUp8, pg8::MoeOrder, true, true, true>(lds + RING_OFF, g, S, E); }
            SEAM(sb + 5);
        }
        if (IN(sb + 6)) { if (PHM(9)) PREP(9) {
            pg8::Gemm g{ACT, (const bf16*)(ws + WS_WDN + (size_t)L * 16 * 2048 * P8K1), XS_ROWS, 2048, DEXP / 2, P8K1 / 2, wave};
            pg8::MoeOrder S{TAB[33] * 8, G, bx, TAB + 64}; pg8::EpiDown8 E{(unsigned char*)YD};
            pg8::gemm_phase<pg8::EpiDown8, pg8::MoeOrder, true, true, true>(lds + RING_OFF, g, S, E); }
            SEAM(sb + 6);
        }
        if (IN(sb + 7)) { if (PHM(10)) for (int rep_ = 0; rep_ < ((((PROBE_DUP) >> 10) & 1) && L == NLAYER - 1 ? 5 : 1); ++rep_) {
            const int tid = opq_tid(wave), lane = tid & 63;
            const float* lng = args.in[10] + (size_t)L * DM; const float* lnb = args.in[11] + (size_t)L * DM; const bool last = (L == NLAYER - 1); const bool next8 = (L + 1 < 2) ? (QKV8_A != 0) : (QKV8_B != 0);
            const int gw = vcu * NWAVES + wave, NGW = G * NWAVES;
            for (int row0 = 4 * gw; row0 < NTOK; row0 += 4 * NGW) {
                f32x4 v[4][8]; float mu[4], rstd[4];
#pragma unroll
                for (int rr = 0; rr < 4; ++rr) { const int row = row0 + rr;
                    const int p0 = RP[2 * row], p1 = RP[2 * row + 1]; const f32x2 w = RW[row];
                    const _Float16* hq = H + (size_t)row * DM + 4 * lane; const unsigned* y0 = (const unsigned*)((const unsigned char*)YD + (size_t)p0 * DM) + lane; const unsigned* y1 = (const unsigned*)((const unsigned char*)YD + (size_t)p1 * DM) + lane;
                    const float w0s = w.x * (1.f / pg8::YD8_SCALE), w1s = w.y * (1.f / pg8::YD8_SCALE);
#pragma unroll
                    for (int j = 0; j < 8; ++j) { const f32x4 h = ldh4(hq + 256 * j); const unsigned a = y0[64 * j], b = y1[64 * j];
                        const f32x2 a0 = __builtin_amdgcn_cvt_pk_f32_fp8((int)a, false), a1 = __builtin_amdgcn_cvt_pk_f32_fp8((int)a, true), b0 = __builtin_amdgcn_cvt_pk_f32_fp8((int)b, false), b1 = __builtin_amdgcn_cvt_pk_f32_fp8((int)b, true);
                        const f32x4 fa = {a0[0], a0[1], a1[0], a1[1]}, fb = {b0[0], b0[1], b1[0], b1[1]};
                        v[rr][j] = h * DN_ALPHA + fa * w0s + fb * w1s; } }
#pragma unroll
                for (int rr = 0; rr < 4; ++rr) { float s = 0.f;
#pragma unroll
                    for (int j = 0; j < 8; ++j) s += (v[rr][j][0] + v[rr][j][1]) + (v[rr][j][2] + v[rr][j][3]);
                    mu[rr] = dpp_sum(s) * (1.f / DM); float q = 0.f;
#pragma unroll
                    for (int j = 0; j < 8; ++j) { const f32x4 dd = v[rr][j] - mu[rr]; q += (dd[0] * dd[0] + dd[1] * dd[1]) + (dd[2] * dd[2] + dd[3] * dd[3]); }
                    rstd[rr] = 1.f / sqrtf(dpp_sum(q) * (1.f / DM) + LN_EPS); }
#pragma unroll
                for (int j = 0; j < 8; ++j) { const f32x4 gg = ((const f32x4*)lng)[64 * j + lane], bb = ((const f32x4*)lnb)[64 * j + lane];
#pragma unroll
                    for (int rr = 0; rr < 4; ++rr) { const int row = row0 + rr; const f32x4 y = (v[rr][j] - mu[rr]) * rstd[rr] * gg + bb;
                        if (last) ((f32x4*)(args.out + (size_t)row * DM))[64 * j + lane] = y;
                        else { sth4(H + (size_t)row * DM + 256 * j + 4 * lane, y); if (next8) ((unsigned*)(HB8 + (size_t)row * DM))[64 * j + lane] = pg8::pack4_fp8(y[0], y[1], y[2], y[3]); } } }
            } }
            SEAM(sb + 7);
        }
    }
#undef IN
#undef SEAM
}

extern "C" void kernel_launch(void* const* d_in, const int* in_sizes, int n_in, void* d_out, int out_size, void* d_ws, size_t ws_size, hipStream_t stream) {
    static int grid = 0;
    if (grid == 0) {
        if (n_in != 17 || in_sizes[0] != NTOK * DM || out_size != NTOK * DM || ws_size < WS_END) { fprintf(stderr, "kernel_launch: unexpected shapes / workspace (n_in %d, ws %zu, need %zu)\n", n_in, ws_size, (size_t)WS_END); grid = -1; return; }
        int dev = 0, cus = 0, per_cu = 0;
        if (hipGetDevice(&dev) != hipSuccess || hipDeviceGetAttribute(&cus, hipDeviceAttributeMultiprocessorCount, dev) != hipSuccess) { grid = -1; return; }
        if (hipFuncSetAttribute((const void*)yoco_fwd, hipFuncAttributeMaxDynamicSharedMemorySize, LDS_BYTES) != hipSuccess) { fprintf(stderr, "kernel_launch: hipFuncSetAttribute failed\n"); grid = -1; return; }
        if (hipOccupancyMaxActiveBlocksPerMultiprocessor(&per_cu, (const void*)yoco_fwd, NWAVES * 64, LDS_BYTES) != hipSuccess || per_cu < 1) { fprintf(stderr, "kernel_launch: occupancy query says %d\n", per_cu); per_cu = 1; }
        (void)hipGetLastError();
        grid = cus;
    }
    if (grid < 0) return;
    (void)hipMemsetAsync((char*)d_ws + WS_CTL, 0, CTL_ZERO_BYTES, stream);
    Args a{};
    for (int i = 0; i < 17; ++i) a.in[i] = (const float*)d_in[i];
    a.out = (float*)d_out; a.ws = (unsigned char*)d_ws;
#if MK_MULTI
    for (int s = 0; s < NSTEPS; ++s) { a.s_lo = s; a.s_hi = s + 1; hipLaunchKernelGGL(yoco_fwd, dim3(grid), dim3(NWAVES * 64), LDS_BYTES, stream, a); }
#else
    a.s_lo = 0; a.s_hi = NSTEPS;
    hipLaunchKernelGGL(yoco_fwd, dim3(grid), dim3(NWAVES * 64), LDS_BYTES, stream, a);
#endif
    const hipError_t le = hipPeekAtLastError();
    if (le != hipSuccess) fprintf(stderr, "kernel_launch: launch failed: %s\n", hipGetErrorName(le));
}
```

```cpp
#include <hip/hip_runtime.h>
#include <cstdio>
#include <cstdint>

__device__ __forceinline__ int tid_from_wave(int wave) { int l; asm volatile("v_mbcnt_lo_u32_b32 %0, -1, 0\n\tv_mbcnt_hi_u32_b32 %0, -1, %0" : "=v"(l)); return wave * 64 + l; }
namespace pg8 {
#define PG8_LAS __attribute__((address_space(3)))
typedef unsigned short bf16_t;
typedef short bf16x8 __attribute__((ext_vector_type(8)));
typedef float f32x4 __attribute__((ext_vector_type(4)));
typedef unsigned u32x4 __attribute__((ext_vector_type(4)));
typedef int pg8_v8i __attribute__((ext_vector_type(8)));
typedef _Float16 pg8_h8 __attribute__((ext_vector_type(8)));
constexpr int BM = 256, BK = 64, HALF = 128, HTB = HALF * BK * 2  , STAGE_BYTES = 8 * HTB, NXCD = 8, WGM = 8;

__host__ __device__ __forceinline__ int lds_byte(int r, int c) { const int st = (r >> 4) * 2 + (c >> 5), rr = r & 15, cc = c & 31, ob = rr * 64 + cc * 2; return st * 1024 + (ob ^ (((ob >> 9) & 1) << 5)); }
__host__ __device__ __forceinline__ void stage_rc(int b, int& R, int& C) { const int st = b / 1024, sb = b % 1024, swz = sb ^ (((sb >> 9) & 1) << 5); R = (st >> 1) * 16 + swz / 64; C = (st & 1) * 32 + (swz % 64) / 2; }
__host__ __device__ __forceinline__ int perm32(int rho) { const int n = rho >> 4, i = rho & 15; return 8 * (i >> 2) + 4 * n + (i & 3); }

struct Unit { int pm, pn; };
struct Gemm { const bf16_t* A; const bf16_t* Bt; int M, N, K, ld, wave; };

struct StaticOrder {
    int nM, nN, nwg, G, c;
    __host__ __device__ void init(int M, int N, int G_, int c_) { nM = M / BM; nN = N / BM; nwg = nM * nN; G = G_; c = c_; }
    __host__ __device__ bool next(int i, Unit& u) const {
        const long L = (long)i * G + c; if (L >= nwg) return false;
        int wgid = (int)L; { const int q = nwg / NXCD, r = nwg % NXCD, xcd = wgid % NXCD, off = wgid / NXCD; wgid = (xcd < r ? xcd * (q + 1) : r * (q + 1) + (xcd - r) * q) + off; }
        const int nig = WGM * nN, gid = wgid / nig, fm = gid * WGM, gsz = (nM - fm) < WGM ? (nM - fm) : WGM;
        u.pm = fm + ((wgid % nig) % gsz); u.pn = (wgid % nig) / gsz; return true;
    }
    __device__ __forceinline__ void a_ready(const Unit&) const {}
    __device__ __forceinline__ void done(const Unit&) const {}
};

__device__ __forceinline__ unsigned cvt_pk_bf16(float lo, float hi) { unsigned r; asm volatile("v_cvt_pk_bf16_f32 %0, %1, %2" : "=v"(r) : "v"(lo), "v"(hi)); return r; }
typedef float f32x2 __attribute__((ext_vector_type(2)));

typedef unsigned u32x2 __attribute__((ext_vector_type(2)));
__device__ __forceinline__ u32x4 pack8_bf16(const f32x4 a, const f32x4 b) { u32x4 w; w.x = cvt_pk_bf16(a[0], a[1]); w.y = cvt_pk_bf16(a[2], a[3]); w.z = cvt_pk_bf16(b[0], b[1]); w.w = cvt_pk_bf16(b[2], b[3]); return w; }

struct EpiQkv {
    static constexpr bool PERM = true, AFTER_DRAIN = false;
    bf16_t* O; int ldc; int qcols; float qscale; float osc;
    __device__ __forceinline__ void operator()(const f32x4 (&acc)[2][2][4][2], const Unit& u, int wr, int wc, int fr, int fq) const {
        const int row0 = u.pm * BM + wr * 64 + fr, colt = u.pn * BM; const float sc = (colt < qcols ? qscale : 1.f) * osc;
        const int col0 = colt + wc * 32 + 8 * fq;
#pragma unroll
        for (int ai = 0; ai < 2; ++ai)
#pragma unroll
            for (int m = 0; m < 4; ++m) { bf16_t* rowp = O + (size_t)(row0 + ai * HALF + m * 16) * ldc + col0;
#pragma unroll
                for (int bj = 0; bj < 2; ++bj) *(u32x4*)(rowp + bj * HALF) = pack8_bf16(acc[ai][bj][m][0] * sc, acc[ai][bj][m][1] * sc); }
    }
};
template <int ACCS_INV> struct EpiResid {
    static constexpr bool PERM = false, AFTER_DRAIN = false;
    static constexpr int ldc = 2048; static constexpr float alpha = 1.6817928305074292f, accs = 1.f / (float)ACCS_INV;
    float* H; const float* Hsrc;
    __device__ __forceinline__ void operator()(const f32x4 (&acc)[2][2][4][2], const Unit& u, int wr, int wc, int fr, int fq) const {
        const int row0 = u.pm * BM + wr * 64 + fr, col0 = u.pn * BM + wc * 32 + 4 * fq;
#pragma unroll
        for (int ai = 0; ai < 2; ++ai)
#pragma unroll
            for (int m = 0; m < 4; ++m) { const size_t ro = (size_t)(row0 + ai * HALF + m * 16) * ldc + col0; float* rowp = H + ro; const float* srcp = Hsrc + ro;
#pragma unroll
                for (int bj = 0; bj < 2; ++bj)
#pragma unroll
                    for (int n = 0; n < 2; ++n) { const f32x4 h = *(const f32x4*)(srcp + bj * HALF + n * 16); *(f32x4*)(rowp + bj * HALF + n * 16) = h * alpha + acc[ai][bj][m][n] * accs; } }
    }
};
struct EpiRope {
    static constexpr bool PERM = true, AFTER_DRAIN = false;
    bf16_t* O; int ldc; int qcols, ropecols; float qscale; float osc;
    __device__ __forceinline__ void operator()(const f32x4 (&acc)[2][2][4][2], const Unit& u, int wr, int wc, int fr, int fq) const {
        const int row0 = u.pm * BM + wr * 64 + fr, colt = u.pn * BM;
        if (colt >= ropecols) {
            const int col0 = colt + wc * 32 + 8 * fq;
#pragma unroll
            for (int ai = 0; ai < 2; ++ai)
#pragma unroll
                for (int m = 0; m < 4; ++m) { bf16_t* rowp = O + (size_t)(row0 + ai * HALF + m * 16) * ldc + col0;
#pragma unroll
                    for (int bj = 0; bj < 2; ++bj) *(u32x4*)(rowp + bj * HALF) = pack8_bf16(acc[ai][bj][m][0] * osc, acc[ai][bj][m][1] * osc); }
        } else {
            const float sc = (colt < qcols ? qscale : 1.f) * osc;
            const int col0 = colt + wc * 64 + 8 * fq;
            float ir[8];
#pragma unroll
            for (int i = 0; i < 8; ++i) ir[i] = __builtin_amdgcn_exp2f(-(float)(8 * fq + i) * 0.4152410118609203f) * 0.15915494309189535f;
#pragma unroll
            for (int ai = 0; ai < 2; ++ai)
#pragma unroll
                for (int m = 0; m < 4; ++m) { const int row = row0 + ai * HALF + m * 16; const float pos = (float)(row & 2047);
                    f32x4 c0, c1, s0, s1;
#pragma unroll
                    for (int i = 0; i < 4; ++i) { const float f0 = __builtin_amdgcn_fractf(pos * ir[i]), f1 = __builtin_amdgcn_fractf(pos * ir[4 + i]);
                        c0[i] = __builtin_amdgcn_cosf(f0); s0[i] = __builtin_amdgcn_sinf(f0); c1[i] = __builtin_amdgcn_cosf(f1); s1[i] = __builtin_amdgcn_sinf(f1); }
                    const f32x4 a0 = acc[ai][0][m][0], a1 = acc[ai][0][m][1], b0 = acc[ai][1][m][0], b1 = acc[ai][1][m][1];
                    bf16_t* rowp = O + (size_t)row * ldc + col0;
                    *(u32x4*)(rowp) = pack8_bf16((a0 * c0 - b0 * s0) * sc, (a1 * c1 - b1 * s1) * sc);
                    *(u32x4*)(rowp + 32) = pack8_bf16((b0 * c0 + a0 * s0) * sc, (b1 * c1 + a1 * s1) * sc); }
        }
    }
};
struct EpiGateUp {
    static constexpr bool PERM = true, AFTER_DRAIN = false;
    bf16_t* O;
    __device__ __forceinline__ void operator()(const f32x4 (&acc)[2][2][4][2], const Unit& u, int wr, int wc, int fr, int fq) const {
        const int row0 = u.pm * BM + wr * 64 + fr, col0 = (u.pn & 7) * 128 + wc * 32 + 8 * fq;
#pragma unroll
        for (int ai = 0; ai < 2; ++ai)
#pragma unroll
            for (int m = 0; m < 4; ++m) { f32x4 r[2];
#pragma unroll
                for (int n = 0; n < 2; ++n) { const f32x4 g = acc[ai][0][m][n], up = acc[ai][1][m][n];
#pragma unroll
                    for (int i = 0; i < 4; ++i) { const float e = __builtin_amdgcn_exp2f(g[i] * -1.4426950408889634f); r[n][i] = g[i] * __builtin_amdgcn_rcpf(1.f + e) * up[i]; } }
                *(u32x4*)(O + (size_t)(row0 + ai * HALF + m * 16) * 1024 + col0) = pack8_bf16(r[0], r[1]); }
    }
};
struct EpiDown {
    static constexpr bool PERM = true, AFTER_DRAIN = false;
    bf16_t* O;
    __device__ __forceinline__ void operator()(const f32x4 (&acc)[2][2][4][2], const Unit& u, int wr, int wc, int fr, int fq) const {
        const int row0 = u.pm * BM + wr * 64 + fr, col0 = (u.pn & 7) * BM + wc * 32 + 8 * fq;
#pragma unroll
        for (int ai = 0; ai < 2; ++ai)
#pragma unroll
            for (int m = 0; m < 4; ++m) { bf16_t* rowp = O + (size_t)(row0 + ai * HALF + m * 16) * 2048 + col0;
#pragma unroll
                for (int bj = 0; bj < 2; ++bj) *(u32x4*)(rowp + bj * HALF) = pack8_bf16(acc[ai][bj][m][0], acc[ai][bj][m][1]); }
    }
};
constexpr float W8_SCALE = 64.f, ACT8_SCALE = 4.f;
__device__ __forceinline__ unsigned pack4_fp8(float a, float b, float c, float d) { int w; asm volatile("" : "=v"(w));
    w = __builtin_amdgcn_cvt_pk_fp8_f32(a, b, w, false); w = __builtin_amdgcn_cvt_pk_fp8_f32(c, d, w, true); return (unsigned)w; }
struct EpiGateUp8 {
    static constexpr bool PERM = true, AFTER_DRAIN = false;
    unsigned char* O;
    __device__ __forceinline__ void operator()(const f32x4 (&acc)[2][2][4][2], const Unit& u, int wr, int wc, int fr, int fq) const {
        const int row0 = u.pm * BM + wr * 64 + fr, col0 = (u.pn & 7) * 128 + wc * 32 + 8 * fq;
        constexpr float SI = 1.f / W8_SCALE;
#pragma unroll
        for (int ai = 0; ai < 2; ++ai)
#pragma unroll
            for (int m = 0; m < 4; ++m) { f32x4 r[2];
#pragma unroll
                for (int n = 0; n < 2; ++n) { const f32x4 g = acc[ai][0][m][n] * SI, up = acc[ai][1][m][n] * (SI * ACT8_SCALE);
#pragma unroll
                    for (int i = 0; i < 4; ++i) { const float e = __builtin_amdgcn_exp2f(g[i] * -1.4426950408889634f); r[n][i] = g[i] * __builtin_amdgcn_rcpf(1.f + e) * up[i]; } }
                u32x2 w; w.x = pack4_fp8(r[0][0], r[0][1], r[0][2], r[0][3]); w.y = pack4_fp8(r[1][0], r[1][1], r[1][2], r[1][3]);
                *(u32x2*)(O + (size_t)(row0 + ai * HALF + m * 16) * 1024 + col0) = w; }
    }
};
constexpr float YD8_SCALE = 16.f;
struct EpiDown8 {
    static constexpr bool PERM = true, AFTER_DRAIN = false;
    unsigned char* O;
    __device__ __forceinline__ void operator()(const f32x4 (&acc)[2][2][4][2], const Unit& u, int wr, int wc, int fr, int fq) const {
        const int row0 = u.pm * BM + wr * 64 + fr, col0 = (u.pn & 7) * BM + wc * 32 + 8 * fq;
        constexpr float SI = YD8_SCALE / (W8_SCALE * ACT8_SCALE);
#pragma unroll
        for (int ai = 0; ai < 2; ++ai)
#pragma unroll
            for (int m = 0; m < 4; ++m) { unsigned char* rowp = O + (size_t)(row0 + ai * HALF + m * 16) * 2048 + col0;
#pragma unroll
                for (int bj = 0; bj < 2; ++bj) { const f32x4 a = acc[ai][bj][m][0] * SI, c = acc[ai][bj][m][1] * SI; u32x2 w; w.x = pack4_fp8(a[0], a[1], a[2], a[3]); w.y = pack4_fp8(c[0], c[1], c[2], c[3]);
                    *(u32x2*)(rowp + bj * HALF) = w; } }
    }
};
struct MoeOrder {
    int nunits, G, c; const PG8_LAS int* tile_e;
    __device__ __forceinline__ bool next(int i, Unit& u) const {
        int idx;
        if ((G & 7) == 0) { const int per = G >> 3; idx = (i * 8 + (c & 7)) * per + (c >> 3); } else idx = i * G + c;
        if (idx >= nunits) return false;
        const int mt = idx >> 3; u.pm = mt; u.pn = tile_e[mt] * 8 + (idx & 7); return true;
    }
    __device__ __forceinline__ void a_ready(const Unit&) const {}
    __device__ __forceinline__ void done(const Unit&) const {}
};

template <class Epi, class Sched, bool ALIGN_EPI = false, bool SP2 = false, bool F8 = false, bool F16 = false>
__device__ __forceinline__ void gemm_phase(PG8_LAS unsigned char* lds, const Gemm g, const Sched& S, const Epi& E) {
    int tid_ = tid_from_wave(g.wave); asm volatile("" : "+v"(tid_));
    const int tid = tid_, wid = __builtin_amdgcn_readfirstlane(tid >> 6), lane = tid & 63, wr = wid >> 2, wc = wid & 3, fr = lane & 15, fq = lane >> 4;
    const int K = g.K, LD = g.ld, nt = K / BK;
    unsigned voffA, voffB;
    { int R, C; stage_rc(tid * 16, R, C); const int Rb = Epi::PERM ? ((R & ~31) + perm32(R & 31)) : R;
        voffA = (unsigned)(R * LD + C) * 2u; voffB = (unsigned)(Rb * LD + C) * 2u; }
    const size_t pstep = (size_t)64 * LD * 2;
    const size_t kstep = (size_t)(BK * 2);
    const size_t hstep = (size_t)HALF * LD * 2;
    const size_t tstep = 2 * hstep;
    const unsigned ldsbase = (unsigned)(uintptr_t)lds;
    const unsigned ldsw = (unsigned)wid * 1024u;
    const int aoff = lds_byte(wr * 64 + fr, fq * 8), boff = lds_byte(wc * 32 + fr, fq * 8);
#define PG8_SA(b, h) (((b) * 2 + (h)) * HTB)
#define PG8_SB(b, h) ((4 + (b) * 2 + (h)) * HTB)
#define PG8_STAGE(bufoff, gbase, voff) do { _Pragma("unroll") for (int _i = 0; _i < 2; ++_i) { unsigned keep_; \
        asm volatile("s_mov_b32 %0, m0\n\ts_mov_b32 m0, %3\n\ts_nop 0\n\tglobal_load_lds_dwordx4 %1, %2\n\ts_mov_b32 m0, %0" : "=&s"(keep_) \
            : "v"(voff), "s"((const char*)(gbase) + _i * pstep), "s"(ldsbase + (unsigned)(bufoff) + ldsw + (unsigned)(_i * 8192))); } } while (0)
#define PG8_CAT(a, b) __builtin_bit_cast(pg8_v8i, __builtin_shufflevector(a, b, 0, 1, 2, 3, 4, 5, 6, 7, 8, 9, 10, 11, 12, 13, 14, 15))
#define PG8_LDA(dst, b, h) do { if constexpr (F8) { _Pragma("unroll") for (int m = 0; m < 4; ++m) { const bf16x8 lo_ = *(const PG8_LAS bf16x8*)(lds + PG8_SA(b, h) + aoff + m * 2048), hi_ = *(const PG8_LAS bf16x8*)(lds + PG8_SA(b, h) + aoff + m * 2048 + 1024); dst##8[m] = PG8_CAT(lo_, hi_); } } \
        else { _Pragma("unroll") for (int m = 0; m < 4; ++m) _Pragma("unroll") for (int k = 0; k < 2; ++k) dst[m][k] = *(const PG8_LAS bf16x8*)(lds + PG8_SA(b, h) + aoff + m * 2048 + k * 1024); } } while (0)
#define PG8_LDB(dst, b, h) do { if constexpr (F8) { _Pragma("unroll") for (int n = 0; n < 2; ++n) { const bf16x8 lo_ = *(const PG8_LAS bf16x8*)(lds + PG8_SB(b, h) + boff + n * 2048), hi_ = *(const PG8_LAS bf16x8*)(lds + PG8_SB(b, h) + boff + n * 2048 + 1024); dst##8[n] = PG8_CAT(lo_, hi_); } } \
        else { _Pragma("unroll") for (int n = 0; n < 2; ++n) _Pragma("unroll") for (int k = 0; k < 2; ++k) dst[n][k] = *(const PG8_LAS bf16x8*)(lds + PG8_SB(b, h) + boff + n * 2048 + k * 1024); } } while (0)
#define PG8_MMA(ai, bj, At, Bt) do { __builtin_amdgcn_s_setprio(1); \
        if constexpr (F8) { _Pragma("unroll") for (int m = 0; m < 4; ++m) _Pragma("unroll") for (int n = 0; n < 2; ++n) \
            acc[ai][bj][m][n] = __builtin_amdgcn_mfma_scale_f32_16x16x128_f8f6f4(Bt##8[n], At##8[m], acc[ai][bj][m][n], 0, 0, 0, 0, 0, 0); } \
        else { _Pragma("unroll") for (int m = 0; m < 4; ++m) _Pragma("unroll") for (int n = 0; n < 2; ++n) _Pragma("unroll") for (int k = 0; k < 2; ++k) \
            acc[ai][bj][m][n] = F16 ? __builtin_amdgcn_mfma_f32_16x16x32_f16(__builtin_bit_cast(pg8_h8, Bt[n][k]), __builtin_bit_cast(pg8_h8, At[m][k]), acc[ai][bj][m][n], 0, 0, 0) \
                                    : __builtin_amdgcn_mfma_f32_16x16x32_bf16(Bt[n][k], At[m][k], acc[ai][bj][m][n], 0, 0, 0); } \
        __builtin_amdgcn_s_setprio(0); } while (0)
#define PG8_WAIT_V(n) asm volatile("s_waitcnt vmcnt(" #n ")" ::: "memory")
#define PG8_WAIT_L(n) asm volatile("s_waitcnt lgkmcnt(" #n ")" ::: "memory")
#define PG8_BAR __builtin_amdgcn_s_barrier()
#define PG8_SCHED __builtin_amdgcn_sched_barrier(0)
    Unit cur, nxt; int ui = 0;
    if (!S.next(0, cur)) return;
    f32x4 acc[2][2][4][2];
{ float zero_; asm volatile("v_mov_b32 %0, 0" : "=v"(zero_));
#pragma unroll
    for (int a = 0; a < 2; ++a)
#pragma unroll
        for (int b = 0; b < 2; ++b)
#pragma unroll
            for (int m = 0; m < 4; ++m)
#pragma unroll
                for (int n = 0; n < 2; ++n) acc[a][b][m][n] = (f32x4){zero_, zero_, zero_, zero_}; }
    bf16x8 At[4][2], B0[2][2], B1[2][2]; pg8_v8i At8[4], B08[2], B18[2];
    const char* cA = (const char*)g.A + (size_t)cur.pm * tstep; const char* cB = (const char*)g.Bt + (size_t)cur.pn * tstep;
    S.a_ready(cur);
    if constexpr (SP2) {
        PG8_STAGE(PG8_SB(0, 0), cB, voffB); PG8_STAGE(PG8_SB(0, 1), cB + hstep, voffB); PG8_STAGE(PG8_SA(0, 0), cA, voffA); PG8_STAGE(PG8_SA(0, 1), cA + hstep, voffA);
        if (wr == 1) PG8_BAR;
        PG8_WAIT_V(2); PG8_BAR;
        PG8_STAGE(PG8_SB(1, 0), cB + kstep, voffB); PG8_STAGE(PG8_SA(1, 0), cA + kstep, voffA); PG8_STAGE(PG8_SB(1, 1), cB + hstep + kstep, voffB);
        PG8_WAIT_V(6); PG8_BAR;
    } else {
        PG8_STAGE(PG8_SB(0, 0), cB, voffB); PG8_STAGE(PG8_SA(0, 0), cA, voffA); PG8_STAGE(PG8_SB(0, 1), cB + hstep, voffB); PG8_STAGE(PG8_SA(0, 1), cA + hstep, voffA);
        if (wr == 1) PG8_BAR;
        PG8_WAIT_V(4); PG8_BAR;
        PG8_STAGE(PG8_SB(1, 0), cB + kstep, voffB); PG8_STAGE(PG8_SA(1, 0), cA + kstep, voffA); PG8_STAGE(PG8_SB(1, 1), cB + hstep + kstep, voffB);
        PG8_WAIT_V(6); PG8_BAR;
    }
    for (;;) {
        const bool has_next = S.next(ui + 1, nxt);
        const char* nA = has_next ? (const char*)g.A + (size_t)nxt.pm * tstep : cA; const char* nB = has_next ? (const char*)g.Bt + (size_t)nxt.pn * tstep : cB;
#pragma unroll 1
        for (int t = 0; t < nt; t += 2) {
            const bool last = (t == nt - 2);
            const char* a1 = cA + (size_t)(t + 1) * kstep;
            const char* a2 = last ? nA : cA + (size_t)(t + 2) * kstep; const char* b2 = last ? nB : cB + (size_t)(t + 2) * kstep;
            const char* a3 = a2 + kstep; const char* b3 = b2 + kstep;
            if (last && has_next) S.a_ready(nxt);
            if constexpr (SP2) {
            PG8_LDB(B0, 0, 0); PG8_LDB(B1, 0, 1); PG8_SCHED; PG8_LDA(At, 0, 0); PG8_STAGE(PG8_SA(1, 1), a1 + hstep, voffA);
            PG8_WAIT_V(8); PG8_WAIT_L(0); PG8_BAR; PG8_MMA(0, 0, At, B0); PG8_MMA(0, 1, At, B1); PG8_BAR; PG8_SCHED;
            PG8_LDA(At, 0, 1); PG8_STAGE(PG8_SB(0, 0), b2, voffB); PG8_STAGE(PG8_SB(0, 1), b2 + hstep, voffB); PG8_STAGE(PG8_SA(0, 0), a2, voffA);
            PG8_WAIT_V(8); PG8_WAIT_L(0); PG8_BAR; PG8_MMA(1, 0, At, B0); PG8_MMA(1, 1, At, B1); PG8_BAR; PG8_SCHED;
            PG8_LDB(B0, 1, 0); PG8_LDB(B1, 1, 1); PG8_SCHED; PG8_LDA(At, 1, 0); PG8_STAGE(PG8_SA(0, 1), a2 + hstep, voffA);
            PG8_WAIT_V(8); PG8_WAIT_L(0); PG8_BAR; PG8_MMA(0, 0, At, B0); PG8_MMA(0, 1, At, B1); PG8_BAR; PG8_SCHED;
            PG8_LDA(At, 1, 1); PG8_STAGE(PG8_SB(1, 0), b3, voffB); PG8_STAGE(PG8_SB(1, 1), b3 + hstep, voffB); PG8_STAGE(PG8_SA(1, 0), a3, voffA);
            PG8_WAIT_V(8); PG8_WAIT_L(0); PG8_BAR; PG8_MMA(1, 0, At, B0); PG8_MMA(1, 1, At, B1); PG8_BAR; PG8_SCHED;
            } else {
            PG8_LDB(B0, 0, 0); PG8_SCHED; PG8_LDA(At, 0, 0); PG8_STAGE(PG8_SA(1, 1), a1 + hstep, voffA);
            PG8_WAIT_L(8); PG8_BAR; PG8_WAIT_L(0); PG8_MMA(0, 0, At, B0); PG8_BAR; PG8_SCHED;
            PG8_LDB(B1, 0, 1); PG8_STAGE(PG8_SB(0, 0), b2, voffB);
            PG8_BAR; PG8_WAIT_L(0); PG8_MMA(0, 1, At, B1); PG8_BAR;
            PG8_LDA(At, 0, 1); PG8_STAGE(PG8_SA(0, 0), a2, voffA);
            PG8_BAR; PG8_WAIT_L(0); PG8_MMA(1, 0, At, B0); PG8_BAR; PG8_SCHED;
            PG8_STAGE(PG8_SB(0, 1), b2 + hstep, voffB);
            PG8_WAIT_V(6); PG8_BAR; PG8_MMA(1, 1, At, B1); PG8_BAR;
            PG8_LDB(B0, 1, 0); PG8_SCHED; PG8_LDA(At, 1, 0); PG8_STAGE(PG8_SA(0, 1), a2 + hstep, voffA);
            PG8_WAIT_L(8); PG8_BAR; PG8_WAIT_L(0); PG8_MMA(0, 0, At, B0); PG8_BAR; PG8_SCHED;
            PG8_LDB(B1, 1, 1); PG8_STAGE(PG8_SB(1, 0), b3, voffB);
            PG8_BAR; PG8_WAIT_L(0); PG8_MMA(0, 1, At, B1); PG8_BAR;
            PG8_LDA(At, 1, 1); PG8_STAGE(PG8_SA(1, 0), a3, voffA);
            PG8_BAR; PG8_WAIT_L(0); PG8_MMA(1, 0, At, B0); PG8_BAR; PG8_SCHED;
            PG8_STAGE(PG8_SB(1, 1), b3 + hstep, voffB);
            PG8_WAIT_V(6); PG8_BAR; PG8_MMA(1, 1, At, B1); PG8_BAR;
            }
        }
        if constexpr (ALIGN_EPI) { if (wr == 0) PG8_BAR; }
        if constexpr (!Epi::AFTER_DRAIN) { const int t2_ = tid_from_wave(g.wave);
            E(acc, cur, wr, wc, t2_ & 15, (t2_ >> 4) & 3); S.done(cur); }
        if (!has_next) break;
{ float zero_; asm volatile("v_mov_b32 %0, 0" : "=v"(zero_));
#pragma unroll
        for (int a = 0; a < 2; ++a)
#pragma unroll
            for (int b = 0; b < 2; ++b)
#pragma unroll
                for (int m = 0; m < 4; ++m)
#pragma unroll
                    for (int n = 0; n < 2; ++n) acc[a][b][m][n] = (f32x4){zero_, zero_, zero_, zero_}; }
        cur = nxt; cA = nA; cB = nB; ++ui;
        if constexpr (ALIGN_EPI) { if (wr == 1) PG8_BAR; }
    }
    PG8_WAIT_V(0);
    if constexpr (!ALIGN_EPI) { if (wr == 0) PG8_BAR; }
    PG8_BAR;
    if constexpr (Epi::AFTER_DRAIN) { E.fused(acc, cur, wr, wc, fr, fq, lds, wid, lane); S.done(cur); }
#undef PG8_SA
#undef PG8_SB
#undef PG8_STAGE
#undef PG8_LDA
#undef PG8_LDB
#undef PG8_MMA
#undef PG8_CAT
#undef PG8_WAIT_V
#undef PG8_WAIT_L
#undef PG8_BAR
#undef PG8_SCHED
}
}

namespace att {
#define ALAS __attribute__((address_space(3)))
typedef unsigned short bf16_t;
typedef short bf16x8 __attribute__((ext_vector_type(8)));
typedef short s16x4 __attribute__((ext_vector_type(4)));
typedef float f32x16 __attribute__((ext_vector_type(16)));
typedef float f32x4 __attribute__((ext_vector_type(4)));
typedef unsigned u32x4 __attribute__((ext_vector_type(4)));
typedef ALAS char* ldsp;
#ifndef WO_F8
#define WO_F8 1
#endif
constexpr float OB8_SCALE = 8.f;
constexpr int QP = 6144;
constexpr int OP = 2048;
constexpr int OBP = 2048;
constexpr int SHM_V = 16384, SHM_K = 16384;
constexpr int LDS_V = 0, LDS_K = 2 * SHM_V, LDS_WS = LDS_K + 2 * SHM_K, ATT_LDS_BYTES = LDS_WS + 8 * 256;
#define KSWZ(row, colB) ((row) * 256 + ((colB) ^ (((row) & 7) << 4)))
#define KSWZ64(row, colB) ((row) * 128 + ((colB) ^ (((row) & 7) << 4)))
#define SBAR() __builtin_amdgcn_sched_barrier(0)
__device__ __forceinline__ int v_st(int k, int c) { const int kk = (k & ~0xC) | ((k & 4) << 1) | ((k & 8) >> 1); return ((kk >> 3) * 4 + (c >> 5)) * 512 + ((kk & 7) * 32 + (c & 31)) * 2; }
__device__ __forceinline__ int v_rd_base(int lane) { return ((lane & 3) << 3) | (((lane >> 2) & 3) << 6) | (((lane >> 4) & 1) << 5) | (((lane >> 5) & 1) << 8); }
constexpr int v_rd_off(int d0, int ks, int half) { return d0 * 512 + ks * 4096 + half * 2048; }
__device__ __forceinline__ int crow(int r, int hi) { return (r & 3) + 8 * (r >> 2) + 4 * hi; }
__device__ __forceinline__ unsigned cvtpk(float lo, float hi) { unsigned r; asm volatile("v_cvt_pk_bf16_f32 %0, %1, %2" : "=v"(r) : "v"(lo), "v"(hi)); return r; }
__device__ __forceinline__ bf16x8 ldg8(const bf16_t* p) { return *reinterpret_cast<const bf16x8*>(p); }
__device__ __forceinline__ unsigned quad_pack_fp8(float v) {
    const int b = __builtin_bit_cast(int, v);
    const float v1 = __builtin_bit_cast(float, __builtin_amdgcn_update_dpp(b, b, 0x55, 0xf, 0xf, false));
    const float v2 = __builtin_bit_cast(float, __builtin_amdgcn_update_dpp(b, b, 0xAA, 0xf, 0xf, false));
    const float v3 = __builtin_bit_cast(float, __builtin_amdgcn_update_dpp(b, b, 0xFF, 0xf, 0xf, false));
    int w; asm volatile("" : "=v"(w));
    w = __builtin_amdgcn_cvt_pk_fp8_f32(v, v1, w, false); w = __builtin_amdgcn_cvt_pk_fp8_f32(v2, v3, w, true); return (unsigned)w;
}
__device__ __forceinline__ float xhalf(float v, int hi) {
    auto rr = __builtin_amdgcn_permlane32_swap(__float_as_uint(v), __float_as_uint(v), false, false);
    return __uint_as_float(hi ? rr[0] : rr[1]);
}
#define ATT_PK4(P, B_, OUT) do { unsigned a0 = cvtpk(P[B_+0], P[B_+1]), a1 = cvtpk(P[B_+2], P[B_+3]);                      \
        unsigned b0 = cvtpk(P[B_+4], P[B_+5]), b1 = cvtpk(P[B_+6], P[B_+7]);                                             \
        auto r0 = __builtin_amdgcn_permlane32_swap(a0, b0, false, false); auto r1 = __builtin_amdgcn_permlane32_swap(a1, b1, false, false); \
        u32x4 w = {r0[0], r1[0], r0[1], r1[1]}; OUT = *reinterpret_cast<bf16x8*>(&w); } while (0)
__device__ __forceinline__ void pv_tile(f32x16* o, int vb, bf16x8 pa0, bf16x8 pa1, bf16x8 pa2, bf16x8 pa3) {
#define TRRD(dst, off) asm volatile("ds_read_b64_tr_b16 %0, %1 offset:%2" : "=&v"(dst) : "v"(vb), "i"(off) : "memory")
#define PV_D0(d0) do { s16x4 l0, l1, l2, l3, h0, h1, h2, h3; constexpr int b_ = v_rd_off(d0, 0, 0); \
        TRRD(l0, b_); TRRD(h0, b_ + 2048); TRRD(l1, b_ + 4096); TRRD(h1, b_ + 6144); TRRD(l2, b_ + 8192); TRRD(h2, b_ + 10240); TRRD(l3, b_ + 12288); TRRD(h3, b_ + 14336); \
        asm volatile("s_waitcnt lgkmcnt(0)" ::: "memory"); SBAR(); \
        o[d0] = __builtin_amdgcn_mfma_f32_32x32x16_bf16(pa0, (bf16x8){l0[0], l0[1], l0[2], l0[3], h0[0], h0[1], h0[2], h0[3]}, o[d0], 0, 0, 0);   \
        o[d0] = __builtin_amdgcn_mfma_f32_32x32x16_bf16(pa1, (bf16x8){l1[0], l1[1], l1[2], l1[3], h1[0], h1[1], h1[2], h1[3]}, o[d0], 0, 0, 0);   \
        o[d0] = __builtin_amdgcn_mfma_f32_32x32x16_bf16(pa2, (bf16x8){l2[0], l2[1], l2[2], l2[3], h2[0], h2[1], h2[2], h2[3]}, o[d0], 0, 0, 0);   \
        o[d0] = __builtin_amdgcn_mfma_f32_32x32x16_bf16(pa3, (bf16x8){l3[0], l3[1], l3[2], l3[3], h3[0], h3[1], h3[2], h3[3]}, o[d0], 0, 0, 0); } while (0)
    PV_D0(0); PV_D0(1); PV_D0(2); PV_D0(3);
#undef PV_D0
#undef TRRD
}

__device__ __forceinline__ void sb_block(const bf16_t* __restrict__ Qg, const bf16_t* __restrict__ Kg, const bf16_t* __restrict__ Vg, bf16_t* __restrict__ Og, int qb, ldsp lds, int wave_) {
    int tid_ = tid_from_wave(wave_); asm volatile("" : "+v"(tid_));
    const int tid = tid_, wid = __builtin_amdgcn_readfirstlane(tid >> 6), lane = tid & 63, r32 = lane & 31, hi = lane >> 5;
    const int NT = 4 * qb + 4, R0 = 256 * qb + 32 * wid, myrow = R0 + r32;
    const ldsp V_lds = lds + LDS_V; const ldsp K_lds = lds + LDS_K;
    bf16x8 qr[8];
    { const bf16_t* Qw = Qg + (size_t)R0 * QP; const unsigned qoff = (unsigned)(r32 * QP + hi * 8);
#pragma unroll
      for (int d0 = 0; d0 < 8; ++d0) qr[d0] = ldg8(Qw + (qoff + d0 * 16)); }
    const int sr = tid >> 4, sc = (tid & 15) * 8, kws = KSWZ(sr, sc * 2), vst0 = v_st(sr, sc), vst1 = v_st(32 + sr, sc);
    const unsigned kvoff = (unsigned)(sr * QP + sc);
    const int vb0 = (int)(unsigned)(uintptr_t)V_lds + v_rd_base(lane);
    bf16x8 sk0, sk1, sv0, sv1;
#define SB_LOAD(j) do { const bf16_t* kp_ = Kg + (size_t)(64 * (j)) * QP; const bf16_t* vp_ = Vg + (size_t)(64 * (j)) * QP; \
        sk0 = ldg8(kp_ + kvoff); sk1 = ldg8(kp_ + (size_t)32 * QP + kvoff); sv0 = ldg8(vp_ + kvoff); sv1 = ldg8(vp_ + (size_t)32 * QP + kvoff); } while (0)
#define SB_WRITE(bf) do { *(ALAS bf16x8*)(K_lds + (bf) * SHM_K + kws) = sk0; *(ALAS bf16x8*)(K_lds + (bf) * SHM_K + kws + 32 * 256) = sk1; \
        *(ALAS bf16x8*)(V_lds + (bf) * SHM_V + vst0) = sv0; *(ALAS bf16x8*)(V_lds + (bf) * SHM_V + vst1) = sv1; } while (0)
    SB_LOAD(NT - 1); SB_WRITE(0);
    __syncthreads();
    float carry = 0.f; f32x16 o[4] = {};
    ALAS int* fl = (ALAS int*)(lds + LDS_WS); bool wdone = false;
    for (int t = 0; t < NT; ++t) {
        const int j = NT - 1 - t, buf = t & 1, kb = 64 * j;
        if (t + 1 < NT) SB_LOAD(j - 1);
        if (kb <= R0 + 30 && !wdone) {
            f32x16 p0 = {}, p1 = {};
            { const ldsp Kb = K_lds + buf * SHM_K;
#pragma unroll
              for (int d0 = 0; d0 < 8; ++d0) { const ldsp a = Kb + KSWZ(r32, ((d0 & 3) * 16 + hi * 8) * 2) + (d0 >> 2) * 128;
                  const bf16x8 b0 = *(const ALAS bf16x8*)a, b1 = *(const ALAS bf16x8*)(a + 32 * 256);
                  p0 = __builtin_amdgcn_mfma_f32_32x32x16_bf16(b0, qr[d0], p0, 0, 0, 0);
                  p1 = __builtin_amdgcn_mfma_f32_32x32x16_bf16(b1, qr[d0], p1, 0, 0, 0); } }
            f32x16 lb0, lb1;
#pragma unroll
            for (int r = 0; r < 16; ++r) {
                { const float z = p0[r]; const float e = __builtin_amdgcn_exp2f(-__builtin_fabsf(z)); const float sp = __builtin_fmaxf(z, 0.f) + __builtin_amdgcn_logf(1.f + e); p0[r] = -sp; lb0[r] = z - sp; }
                { const float z = p1[r]; const float e = __builtin_amdgcn_exp2f(-__builtin_fabsf(z)); const float sp = __builtin_fmaxf(z, 0.f) + __builtin_amdgcn_logf(1.f + e); p1[r] = -sp; lb1[r] = z - sp; }
            }
            if (kb + 63 >= R0) {
                const int dq = myrow - kb - 4 * hi; const float NEG = -__builtin_inff();
#pragma unroll
                for (int r = 0; r < 16; ++r) { const int c = (r & 3) + 8 * (r >> 2);
                    if (c >= dq) { p0[r] = 0.f; lb0[r] = NEG; }
                    if (c + 32 >= dq) { p1[r] = 0.f; lb1[r] = NEG; } }
            }
            float gs[8], go[8];
#pragma unroll
            for (int g = 0; g < 4; ++g) { gs[g] = (p0[4 * g] + p0[4 * g + 1]) + (p0[4 * g + 2] + p0[4 * g + 3]); gs[4 + g] = (p1[4 * g] + p1[4 * g + 1]) + (p1[4 * g + 2] + p1[4 * g + 3]); }
#pragma unroll
            for (int i = 0; i < 8; ++i) go[i] = xhalf(gs[i], hi);
            float acc = carry;
#pragma unroll
            for (int idx = 7; idx >= 0; --idx) { const int g = idx & 3; const float base = acc + (hi ? 0.f : go[idx]);
                if (idx >= 4) { const float t3 = base, t2 = t3 + p1[4 * g + 3], t1 = t2 + p1[4 * g + 2], t0 = t1 + p1[4 * g + 1];
                    lb1[4 * g + 3] = __builtin_amdgcn_exp2f(lb1[4 * g + 3] + t3); lb1[4 * g + 2] = __builtin_amdgcn_exp2f(lb1[4 * g + 2] + t2);
                    lb1[4 * g + 1] = __builtin_amdgcn_exp2f(lb1[4 * g + 1] + t1); lb1[4 * g] = __builtin_amdgcn_exp2f(lb1[4 * g] + t0); }
                else { const float t3 = base, t2 = t3 + p0[4 * g + 3], t1 = t2 + p0[4 * g + 2], t0 = t1 + p0[4 * g + 1];
                    lb0[4 * g + 3] = __builtin_amdgcn_exp2f(lb0[4 * g + 3] + t3); lb0[4 * g + 2] = __builtin_amdgcn_exp2f(lb0[4 * g + 2] + t2);
                    lb0[4 * g + 1] = __builtin_amdgcn_exp2f(lb0[4 * g + 1] + t1); lb0[4 * g] = __builtin_amdgcn_exp2f(lb0[4 * g] + t0); }
                acc += gs[idx] + go[idx]; }
            carry = acc;
            bf16x8 pa0, pa1, pa2, pa3;
            ATT_PK4(lb0, 0, pa0); ATT_PK4(lb0, 8, pa1); ATT_PK4(lb1, 0, pa2); ATT_PK4(lb1, 8, pa3);
            SBAR();
            pv_tile(o, vb0 + buf * SHM_V, pa0, pa1, pa2, pa3);
            wdone = __all(carry < -127.f);
        }
        if (lane == 0) fl[buf * 8 + wid] = wdone ? 1 : 0;
        if (t + 1 < NT) SB_WRITE(buf ^ 1);
        __syncthreads();
        { const ALAS int* f = fl + buf * 8; if ((f[0] & f[1] & f[2] & f[3] & f[4] & f[5] & f[6] & f[7]) != 0) break; }
    }
#undef SB_LOAD
#undef SB_WRITE
#if WO_F8
    unsigned char* Ow = (unsigned char*)Og + (size_t)R0 * OBP; const unsigned ooff = (unsigned)(4 * hi * OBP + r32);
#pragma unroll
    for (int r = 0; r < 16; ++r) { unsigned char* rowp = Ow + (size_t)((r & 3) + 8 * (r >> 2)) * OBP;
#pragma unroll
        for (int d0 = 0; d0 < 4; ++d0) { const unsigned w = quad_pack_fp8(o[d0][r] * OB8_SCALE);
            if ((r32 & 3) == 0) *(unsigned*)(rowp + (ooff + d0 * 32)) = w; } }
#else
    bf16_t* Ow = Og + (size_t)R0 * OP; const unsigned ooff = (unsigned)(4 * hi * OP + r32);
#pragma unroll
    for (int r = 0; r < 16; ++r) { bf16_t* rowp = Ow + (size_t)((r & 3) + 8 * (r >> 2)) * OP;
#pragma unroll
        for (int d0 = 0; d0 < 4; ++d0) { const float v = o[d0][r]; const float vn = __shfl_xor(v, 1);
            if ((r32 & 1) == 0) *(unsigned*)(rowp + (ooff + d0 * 32)) = cvtpk(v, vn); } }
#endif
}

constexpr float ATT_THR = 8.f;
__device__ __forceinline__ void qkt64(f32x16& p0, f32x16& p1, ldsp Kb, int r32, int hi, const bf16x8* qr) {
    p0 = f32x16{}; p1 = f32x16{};
#pragma unroll
    for (int d0 = 0; d0 < 4; ++d0) { const ldsp a = Kb + KSWZ64(r32, (d0 * 16 + hi * 8) * 2);
        const bf16x8 b0 = *(const ALAS bf16x8*)a, b1 = *(const ALAS bf16x8*)(a + 32 * 128);
        p0 = __builtin_amdgcn_mfma_f32_32x32x16_bf16(b0, qr[d0], p0, 0, 0, 0);
        p1 = __builtin_amdgcn_mfma_f32_32x32x16_bf16(b1, qr[d0], p1, 0, 0, 0); }
}
__device__ __forceinline__ void partial_sm(f32x16& p0, f32x16& p1, float& m_reg, float& alpha, int hi) {
    float pmax = p0[0];
#pragma unroll
    for (int r = 1; r < 16; ++r) pmax = __builtin_fmaxf(pmax, p0[r]);
#pragma unroll
    for (int r = 0; r < 16; ++r) pmax = __builtin_fmaxf(pmax, p1[r]);
    pmax = __builtin_fmaxf(pmax, xhalf(pmax, hi));
    float mn;
    if (__builtin_expect(__all(pmax - m_reg <= ATT_THR), 1)) { mn = m_reg; alpha = 1.f; }
    else { mn = __builtin_fmaxf(m_reg, pmax); alpha = __builtin_amdgcn_exp2f(m_reg - mn); m_reg = mn; }
#pragma unroll
    for (int r = 0; r < 16; ++r) { p0[r] -= mn; p1[r] -= mn; }
#pragma unroll
    for (int r = 0; r < 16; ++r) p0[r] = __builtin_amdgcn_exp2f(p0[r]);
}
__device__ __forceinline__ void finish_sm(f32x16& p0, f32x16& p1, float alpha, float& l_reg, bf16x8& pa0, bf16x8& pa1, bf16x8& pa2, bf16x8& pa3, int hi) {
#pragma unroll
    for (int r = 0; r < 16; ++r) p1[r] = __builtin_amdgcn_exp2f(p1[r]);
    float ps = 0.f;
#pragma unroll
    for (int r = 0; r < 16; ++r) ps += p0[r];
#pragma unroll
    for (int r = 0; r < 16; ++r) ps += p1[r];
    ps += xhalf(ps, hi);
    l_reg = l_reg * alpha + ps;
    ATT_PK4(p0, 0, pa0); ATT_PK4(p0, 8, pa1); ATT_PK4(p1, 0, pa2); ATT_PK4(p1, 8, pa3);
}
__device__ __forceinline__ void mask_gt(f32x16& p0, f32x16& p1, int dq) {
    const float NEG = -__builtin_inff();
#pragma unroll
    for (int r = 0; r < 16; ++r) { const int c = (r & 3) + 8 * (r >> 2);
        if (c > dq) p0[r] = NEG;
        if (c + 32 > dq) p1[r] = NEG; }
}
template <bool SECOND>
__device__ __forceinline__ void diff_pass(const bf16_t* __restrict__ Qg, const bf16_t* __restrict__ Kg, const bf16_t* __restrict__ Vg, float* S1, bf16_t* __restrict__ Og,
                                          int qb, float lam, const float* __restrict__ gsub, float gmul, ldsp lds, int wave_) {
    int tid_ = tid_from_wave(wave_); asm volatile("" : "+v"(tid_));
    const int tid = tid_, wid = __builtin_amdgcn_readfirstlane(tid >> 6), lane = tid & 63, r32 = lane & 31, hi = lane >> 5;
    const int NT = 4 * qb + 4, R0 = 256 * qb + 32 * wid, myrow = R0 + r32;
    const ldsp V_lds = lds + LDS_V; const ldsp K_lds = lds + LDS_K;
    ALAS float* wsf = (ALAS float*)(lds + LDS_WS) + wid * 64; ALAS float* li_l = wsf; ALAS float* al_l = wsf + 32;
    bf16x8 qr[4];
    { const bf16_t* Qw = Qg + (size_t)R0 * QP; const unsigned qoff = (unsigned)(r32 * QP + hi * 8);
#pragma unroll
      for (int d0 = 0; d0 < 4; ++d0) qr[d0] = ldg8(Qw + (qoff + d0 * 16)); }
    const int sr = tid >> 4, sc = (tid & 15) * 8, vst0 = v_st(sr, sc), vst1 = v_st(32 + sr, sc);
    const int kr = tid >> 3, kc = (tid & 7) * 8, kws = KSWZ64(kr, kc * 2);
    const unsigned voff = (unsigned)(sr * QP + sc), koff = (unsigned)(kr * QP + kc);
    const int vb0 = (int)(unsigned)(uintptr_t)V_lds + v_rd_base(lane);
    const int qm = myrow - 4 * hi;
    bf16x8 sk0A, sv0A, sv1A, sk0B, sv0B, sv1B;
#define DF_LOAD(S_, j) do { const bf16_t* vp_ = Vg + (size_t)(64 * (j)) * QP; sk0##S_ = ldg8(Kg + (size_t)(64 * (j)) * QP + koff); sv0##S_ = ldg8(vp_ + voff); sv1##S_ = ldg8(vp_ + (size_t)32 * QP + voff); } while (0)
#define DF_WRITE(S_, bf) do { *(ALAS bf16x8*)(K_lds + (bf) * SHM_K + kws) = sk0##S_; *(ALAS bf16x8*)(V_lds + (bf) * SHM_V + vst0) = sv0##S_; *(ALAS bf16x8*)(V_lds + (bf) * SHM_V + vst1) = sv1##S_; } while (0)
#define DF_MASK(P0, P1, t) do { if (64 * (t) + 63 > R0) mask_gt(P0, P1, qm - 64 * (t)); } while (0)
#define DF_RESC(a) do { if (__any((a) < 1.f)) { if (hi == 0) al_l[r32] = (a); asm volatile("s_waitcnt lgkmcnt(0)" ::: "memory"); \
        _Pragma("unroll") for (int d_ = 0; d_ < 4; ++d_) _Pragma("unroll") for (int r = 0; r < 16; ++r) o[d_][r] *= al_l[crow(r, hi)]; } } while (0)
    float m_reg = -1e30f, l_reg = 0.f; f32x16 o[4] = {};
    f32x16 pA0, pA1, pB0, pB1; float alA = 1.f, alB = 1.f; bf16x8 pa0, pa1, pa2, pa3;
    DF_LOAD(A, 0); DF_WRITE(A, 0);
    __syncthreads();
    DF_LOAD(A, 1); DF_LOAD(B, 2);
    qkt64(pA0, pA1, K_lds, r32, hi, qr); DF_MASK(pA0, pA1, 0); partial_sm(pA0, pA1, m_reg, alA, hi);
    DF_WRITE(A, 1);
    DF_RESC(alA);
    __syncthreads();
#define DF_HALF(PX0, PX1, alX, PY0, PY1, alY, t, KB, VB, SB, LS, WS) do { \
        SBAR(); qkt64(PX0, PX1, K_lds + (KB) * SHM_K, r32, hi, qr); \
        finish_sm(PY0, PY1, alY, l_reg, pa0, pa1, pa2, pa3, hi); SBAR(); \
        if ((t) + 2 < NT) { DF_LOAD(LS, (t) + 2); SBAR(); } \
        pv_tile(o, vb0 + (VB) * SHM_V, pa0, pa1, pa2, pa3); DF_MASK(PX0, PX1, (t)); partial_sm(PX0, PX1, m_reg, alX, hi); \
        __syncthreads(); \
        if ((t) + 1 < NT) DF_WRITE(WS, SB); \
        DF_RESC(alX); __syncthreads(); } while (0)
    for (int t = 1; t + 1 < NT; t += 2) {
        DF_HALF(pB0, pB1, alB, pA0, pA1, alA, t, 1, 0, 0, A, B);
        DF_HALF(pA0, pA1, alA, pB0, pB1, alB, t + 1, 0, 1, 1, B, A);
    }
    DF_HALF(pB0, pB1, alB, pA0, pA1, alA, NT - 1, 1, 0, 0, A, B);
    finish_sm(pB0, pB1, alB, l_reg, pa0, pa1, pa2, pa3, hi); SBAR();
    pv_tile(o, vb0 + 1 * SHM_V, pa0, pa1, pa2, pa3);
#undef DF_LOAD
#undef DF_WRITE
#undef DF_MASK
#undef DF_RESC
#undef DF_HALF
    if (hi == 0) li_l[r32] = l_reg; asm volatile("s_waitcnt lgkmcnt(0)" ::: "memory");
    float rli[16];
#pragma unroll
    for (int r = 0; r < 16; ++r) rli[r] = __builtin_amdgcn_rcpf(li_l[crow(r, hi)]);
    if constexpr (!SECOND) {
        float* Sw = S1 + (size_t)R0 * OP; const unsigned ooff = (unsigned)(4 * hi * OP + r32);
#pragma unroll
        for (int r = 0; r < 16; ++r) { float* rowp = Sw + (size_t)((r & 3) + 8 * (r >> 2)) * OP;
#pragma unroll
            for (int d0 = 0; d0 < 4; ++d0) rowp[ooff + d0 * 32] = o[d0][r] * rli[r]; }
    } else {
        const float* Sw = S1 + (size_t)R0 * OP; bf16_t* Ow = Og + (size_t)R0 * OP; (void)Ow; const unsigned ooff = (unsigned)(4 * hi * OP + r32), ooff8 = (unsigned)(4 * hi * OBP + r32);
        float gn[4];
#pragma unroll
        for (int d0 = 0; d0 < 4; ++d0) gn[d0] = gsub[d0 * 32 + r32] * gmul;
#pragma unroll
        for (int r = 0; r < 16; ++r) { const float* srow = Sw + (size_t)((r & 3) + 8 * (r >> 2)) * OP; float d[4]; float ss = 0.f;
#if WO_F8
            unsigned char* orowp = (unsigned char*)Og + (size_t)(R0 + (r & 3) + 8 * (r >> 2)) * OBP;
#else
            bf16_t* orowp = Ow + (size_t)((r & 3) + 8 * (r >> 2)) * OP;
#endif
#pragma unroll
            for (int d0 = 0; d0 < 4; ++d0) { d[d0] = srow[ooff + d0 * 32] - lam * (o[d0][r] * rli[r]); ss += d[d0] * d[d0]; }
            ss += __builtin_bit_cast(float, __builtin_amdgcn_update_dpp(0, __builtin_bit_cast(int, ss), 0xB1, 0xf, 0xf, true));
            ss += __builtin_bit_cast(float, __builtin_amdgcn_update_dpp(0, __builtin_bit_cast(int, ss), 0x4E, 0xf, 0xf, true));
            ss += __builtin_bit_cast(float, __builtin_amdgcn_update_dpp(0, __builtin_bit_cast(int, ss), 0x141, 0xf, 0xf, true));
            ss += __builtin_bit_cast(float, __builtin_amdgcn_update_dpp(0, __builtin_bit_cast(int, ss), 0x140, 0xf, 0xf, true));
            { auto rr = __builtin_amdgcn_permlane16_swap(__float_as_uint(ss), __float_as_uint(ss), false, false); ss = __uint_as_float(rr[0]) + __uint_as_float(rr[1]); }
            const float rs = __builtin_amdgcn_rsqf(ss * (1.f / 128.f) + 1e-5f);
#pragma unroll
#if WO_F8
            for (int d0 = 0; d0 < 4; ++d0) { const unsigned w = quad_pack_fp8(d[d0] * rs * gn[d0] * OB8_SCALE);
                if ((r32 & 3) == 0) *(unsigned*)(orowp + (ooff8 + d0 * 32)) = w; }
#else
            for (int d0 = 0; d0 < 4; ++d0) { const float v = d[d0] * rs * gn[d0]; const float vn = __shfl_xor(v, 1);
                if ((r32 & 1) == 0) *(unsigned*)(orowp + (ooff + d0 * 32)) = cvtpk(v, vn); }
#endif
            if ((r & 1) == 1) asm volatile("" ::: "memory"); }
    }
    __syncthreads();
}
#undef SBAR
}

#define LAS __attribute__((address_space(3)))

#define XB_TMO      128
#define XB_XCNT(j)  (256  + 64 * (j))
#define XB_XSUB(j)  (1280 + 64 * (j))
#define XB_XGEN(j)  (2304 + 64 * (j))
#define XB_TOP      3328
#define XB_TOPGEN   3392
#define XCD_BAR_WORDS 3456
#define XB_SPIN_CAP (1u << 18)

__device__ __forceinline__ unsigned xb_ld(unsigned* p)              { return __hip_atomic_load(p, __ATOMIC_RELAXED, __HIP_MEMORY_SCOPE_AGENT); }
__device__ __forceinline__ unsigned xb_add(unsigned* p, unsigned v) { return __hip_atomic_fetch_add(p, v, __ATOMIC_RELAXED, __HIP_MEMORY_SCOPE_AGENT); }
__device__ __forceinline__ unsigned xb_xcc_id() { return (unsigned)__builtin_amdgcn_s_getreg((3 << 11) | 20) & 0xFu; }
#define XB_SPIN(cond, bar) do { unsigned _sp = 0; while (cond) { __builtin_amdgcn_s_sleep(1); \
    if ((++_sp & 255u) == 0u) { if (xb_ld(&(bar)[XB_TMO])) break; if (_sp > XB_SPIN_CAP) { atomicAdd(&(bar)[XB_TMO], 1u); break; } } } } while (0)

struct XcdBarrier {
    unsigned* bar; unsigned x;
    volatile LAS unsigned* st;
};

__device__ __forceinline__ XcdBarrier xcd_barrier_post(unsigned* bar, volatile LAS unsigned* st, bool thread0) {
    XcdBarrier b; b.bar = bar; b.x = xb_xcc_id(); b.st = st;
    if (thread0) (void)xb_add(&bar[XB_XCNT(b.x)], 1u);
    return b;
}
__device__ __forceinline__ void xcd_barrier_complete(unsigned* bar, unsigned x, unsigned& nloc, unsigned& nx) {
    const unsigned G = gridDim.x * gridDim.y * gridDim.z;
    unsigned sum, cnt, mine, sp = 0u;
    for (;;) {
        sum = 0u; cnt = 0u; mine = 0u;
#pragma unroll
        for (unsigned j = 0; j < 16; ++j) { const unsigned c = xb_ld(&bar[XB_XCNT(j)]); sum += c; cnt += (c > 0u) ? 1u : 0u; mine = (j == x) ? c : mine; }
        if (sum == G) break;
        __builtin_amdgcn_s_sleep(1);
        if ((++sp & 255u) == 0u) { if (xb_ld(&bar[XB_TMO])) break; if (sp > XB_SPIN_CAP) { atomicAdd(&bar[XB_TMO], 1u); break; } }
    }
    nloc = mine > 0u ? mine : 1u; nx = cnt > 0u ? cnt : 1u;
}

__device__ __forceinline__ void xcd_barrier(const XcdBarrier& b, bool thread0) {
    asm volatile("s_waitcnt vmcnt(0)" ::: "memory");
    __syncthreads();
    if (thread0) {
        unsigned* bar = b.bar;
        __builtin_amdgcn_s_waitcnt(0);
        unsigned nloc = b.st[0], nx = b.st[1];
        if (nloc == 0u) { xcd_barrier_complete(bar, b.x, nloc, nx); b.st[0] = nloc; b.st[1] = nx; }
        const unsigned old = xb_add(&bar[XB_XSUB(b.x)], 1u);
        const unsigned gen = old / nloc;
        if (old + 1u == (gen + 1u) * nloc) {
            __builtin_amdgcn_fence(__ATOMIC_RELEASE, "agent");
            asm volatile("s_waitcnt vmcnt(0)" ::: "memory");
            const unsigned og = xb_add(&bar[XB_TOP], 1u);
            const unsigned tg = og / nx;
            if (og + 1u == (tg + 1u) * nx) xb_add(&bar[XB_TOPGEN], 1u);
            else XB_SPIN(xb_ld(&bar[XB_TOPGEN]) == tg, bar);
            __builtin_amdgcn_fence(__ATOMIC_ACQUIRE, "agent");
            xb_add(&bar[XB_XGEN(b.x)], 1u);
            asm volatile("s_waitcnt vmcnt(0)" ::: "memory");
        } else {
            XB_SPIN(xb_ld(&bar[XB_XGEN(b.x)]) == gen, bar);
            __builtin_amdgcn_fence(__ATOMIC_ACQUIRE, "agent");
            asm volatile("s_waitcnt vmcnt(0)" ::: "memory");
        }
    }
    __syncthreads();
}

constexpr int NWAVES = 8;
constexpr int NTOK = 16384, DM = 2048, SEQ = 2048, NHEAD = 16, NLAYER = 4, NEXP = 16, DEXP = 1024;
constexpr int XS_ROWS = 36864;
constexpr float LN_EPS = 1e-5f;
constexpr float DN_ALPHA = 1.6817928305074292f;
constexpr float LOG2E = 1.4426950408889634f;
constexpr float SB_QSCALE = 0.08838834764831845f * LOG2E;
constexpr float DF_QSCALE = 0.125f * LOG2E;
#ifndef MK_MULTI
#define MK_MULTI 0
#endif
#ifndef MOE_F8
#define MOE_F8 1
#endif
#ifndef QKV8_A
#define QKV8_A 1
#endif
#ifndef QKV8_B
#define QKV8_B 0
#endif
constexpr int NSTEPS = 1 + 8 * NLAYER;

constexpr size_t MiB = 1u << 20;
constexpr size_t WS_CTL = 0, CTL_ZERO_BYTES = 64 * 1024;
constexpr size_t WS_COS = 1 * MiB, WS_SIN = WS_COS + 256 * 1024;
constexpr size_t WS_WR = 2 * MiB;
constexpr size_t WS_CNT = 3 * MiB;
constexpr size_t WS_RE = WS_CNT + 64 * 1024;
constexpr size_t WS_RW = WS_RE + 64 * 1024;
constexpr size_t WS_RP = WS_RW + 128 * 1024;
constexpr int LDH = 2048;
constexpr int P8K2 = 2048, P8K1 = 1024;
constexpr size_t WS_WQKVA = 4 * MiB;
constexpr size_t WS_WOA = WS_WQKVA + 56 * MiB;
constexpr size_t WS_WQKVB = WS_WOA + 16 * MiB;
constexpr size_t WS_WOB = WS_WQKVB + 36 * MiB;
constexpr size_t WS_WGU = WS_WOB + 16 * MiB;
constexpr size_t WS_WDN = WS_WGU + 512 * MiB;
constexpr size_t WS_H = WS_WDN + 256 * MiB;
constexpr size_t WS_HB = WS_H + 128 * MiB;
constexpr size_t WS_QKV = WS_HB + 68 * MiB;
constexpr size_t WS_OB = WS_QKV + 192 * MiB;
constexpr size_t WS_XS = WS_OB + 64 * MiB;
constexpr size_t WS_ACT = WS_XS + 144 * MiB;
constexpr size_t WS_YD = WS_ACT + 72 * MiB;
constexpr size_t WS_END = WS_YD + 144 * MiB;
static_assert(WS_END <= (size_t)2040 * MiB, "workspace map");
static_assert((size_t)2 * 6144 * LDH * 2 <= 56 * MiB && (size_t)8192 * LDH * 2 <= 36 * MiB && (size_t)2 * 2048 * P8K2 <= 16 * MiB && (size_t)64 * 2048 * P8K2 <= 512 * MiB && (size_t)64 * 2048 * P8K1 <= 256 * MiB, "weight regions");
static_assert((size_t)NTOK * LDH * 2 <= 68 * MiB && (size_t)NTOK * P8K2 <= 64 * MiB && (size_t)XS_ROWS * P8K2 <= 144 * MiB && (size_t)XS_ROWS * P8K1 <= 72 * MiB, "activation regions");
constexpr int CW_BAR = 1024;
constexpr int LDS_BYTES = 147456;
constexpr int LDSCTL_OFF = 145408;
constexpr int RING_OFF = 0;
constexpr int LNX_OFF = 131072;

#define GAS __attribute__((address_space(1)))
typedef unsigned short bf16;
typedef unsigned v4u __attribute__((ext_vector_type(4)));
typedef unsigned v2u __attribute__((ext_vector_type(2)));
typedef float f32x4 __attribute__((ext_vector_type(4)));
typedef float f32x2 __attribute__((ext_vector_type(2)));
typedef _Float16 f16x4 __attribute__((ext_vector_type(4)));
__device__ __forceinline__ f32x4 ldh4(const _Float16* p) { return __builtin_convertvector(*(const f16x4*)p, f32x4); }
__device__ __forceinline__ void sth4(_Float16* p, f32x4 v) { *(f16x4*)p = __builtin_convertvector(v, f16x4); }
#define LDS_WAIT() asm volatile("s_waitcnt lgkmcnt(0)" ::: "memory")
#define VM_WAIT() asm volatile("s_waitcnt vmcnt(0)" ::: "memory")
__device__ __forceinline__ unsigned pk2(float lo, float hi) { unsigned r; asm volatile("v_cvt_pk_bf16_f32 %0, %1, %2" : "=v"(r) : "v"(lo), "v"(hi)); return r; }
__device__ __forceinline__ int opq_tid(int wave) { int t = tid_from_wave(wave); asm volatile("" : "+v"(t)); return t; }
__device__ __forceinline__ float dpp_sum(float v) {
    v += __builtin_bit_cast(float, __builtin_amdgcn_update_dpp(0, __builtin_bit_cast(int, v), 0xB1, 0xf, 0xf, true));
    v += __builtin_bit_cast(float, __builtin_amdgcn_update_dpp(0, __builtin_bit_cast(int, v), 0x4E, 0xf, 0xf, true));
    v += __builtin_bit_cast(float, __builtin_amdgcn_update_dpp(0, __builtin_bit_cast(int, v), 0x141, 0xf, 0xf, true));
    v += __builtin_bit_cast(float, __builtin_amdgcn_update_dpp(0, __builtin_bit_cast(int, v), 0x140, 0xf, 0xf, true));
    const int b = __builtin_bit_cast(int, v);
    const float s0 = __builtin_bit_cast(float, __builtin_amdgcn_readlane(b, 0)), s1 = __builtin_bit_cast(float, __builtin_amdgcn_readlane(b, 16));
    const float s2 = __builtin_bit_cast(float, __builtin_amdgcn_readlane(b, 32)), s3 = __builtin_bit_cast(float, __builtin_amdgcn_readlane(b, 48));
    return (s0 + s1) + (s2 + s3);
}
__device__ __forceinline__ float wave_sum(float v) {
#pragma unroll
    for (int o = 1; o < 64; o <<= 1) v += __shfl_xor(v, o);
    return v;
}

struct Args { const float* in[17]; float* out; unsigned char* ws; int s_lo, s_hi; };

__device__ __forceinline__ int map_row(int n, int mode) {
    if (mode == 0) return n;
    if (mode == 1) { const int c = n & 255, blk = c >> 6, d = c & 63; return (n & ~255) + ((d >> 5) << 7) + (blk << 5) + (d & 31); }
    return ((n >> 7) << 8) + (n & 127) + (mode == 3 ? 128 : 0);
}
__device__ __forceinline__ unsigned pk2h(float lo, float hi) { typedef _Float16 h2 __attribute__((ext_vector_type(2))); const f32x2 v = {lo, hi}; return __builtin_bit_cast(unsigned, __builtin_convertvector(v, h2)); }
__device__ __forceinline__ void cvt_load(f32x4 (&v)[16], const float* __restrict__ src, int pitch, int k0, int n0, int lane) {
    const int kr = lane >> 4, n4 = (lane & 15) * 4; const float* p = src + (size_t)(k0 + kr) * pitch + n0 + n4;
#pragma unroll
    for (int i = 0; i < 16; ++i) v[i] = __builtin_nontemporal_load((const f32x4*)(p + (size_t)(4 * i) * pitch));
}
__device__ __forceinline__ void cvt_store(const f32x4 (&v)[16], unsigned char* __restrict__ dst, int dp, int mode, int k0, int n0, int kind, LAS float* scr, int lane) {
    const int kr = lane >> 4, n4 = (lane & 15) * 4; const float scale = kind == 2 ? pg8::W8_SCALE : 1.f;
#pragma unroll
    for (int i = 0; i < 16; ++i) { LAS float* s = scr + (4 * i + kr) * 65 + n4; s[0] = v[i][0] * scale; s[1] = v[i][1] * scale; s[2] = v[i][2] * scale; s[3] = v[i][3] * scale; }
    LDS_WAIT();
    if (kind == 2) { const int c = lane & 3;
#pragma unroll
        for (int j = 0; j < 4; ++j) { const int nl = (lane >> 2) + 16 * j; const int row = map_row(n0 + nl, mode);
            const LAS float* s = scr + (16 * c) * 65 + nl;
            v4u o; o.x = pg8::pack4_fp8(s[0], s[65], s[130], s[195]); o.y = pg8::pack4_fp8(s[260], s[325], s[390], s[455]);
            o.z = pg8::pack4_fp8(s[520], s[585], s[650], s[715]); o.w = pg8::pack4_fp8(s[780], s[845], s[910], s[975]);
            *(v4u*)(dst + (size_t)row * dp + k0 + 16 * c) = o; }
    } else { const int c = lane & 7;
#pragma unroll
        for (int j = 0; j < 8; ++j) { const int nl = (lane >> 3) + 8 * j; const int row = map_row(n0 + nl, mode);
            const LAS float* s = scr + (8 * c) * 65 + nl;
            v4u o; o.x = pk2h(s[0], s[65]); o.y = pk2h(s[130], s[195]); o.z = pk2h(s[260], s[325]); o.w = pk2h(s[390], s[455]);
            *(v4u*)(dst + (size_t)row * dp + (k0 + 8 * c) * 2) = o; }
    }
    LDS_WAIT();
}

__global__ void __launch_bounds__(NWAVES * 64, 2) yoco_fwd(Args args) {
    extern __shared__ __attribute__((aligned(16))) unsigned char lds_raw[];
    LAS unsigned char* const lds = (LAS unsigned char*)lds_raw;
    const int tid = threadIdx.x, lane = tid & 63, wave = __builtin_amdgcn_readfirstlane(tid >> 6);
    const int G = gridDim.x, bx = blockIdx.x;
    const int vcu = (G % 8 == 0) ? (bx % 8) * (G / 8) + bx / 8 : bx;
    unsigned char* const ws = args.ws;
    volatile LAS unsigned* const CTL = (volatile LAS unsigned*)(lds + LDSCTL_OFF);
    LAS int* const TAB = (LAS int*)(lds + LDSCTL_OFF + 64);
    for (int u = tid; u < (LDS_BYTES - LDSCTL_OFF) / 4; u += NWAVES * 64) ((LAS unsigned*)(lds + LDSCTL_OFF))[u] = 0u;
    __syncthreads();
    const int s_lo = args.s_lo, s_hi = args.s_hi;
    XcdBarrier bar; bar.bar = (unsigned*)(ws + WS_CTL) + CW_BAR; bar.x = 0; bar.st = nullptr;
    if (s_hi - s_lo > 1) bar = xcd_barrier_post((unsigned*)(ws + WS_CTL) + CW_BAR, CTL, tid == 0);
#ifndef PH_MASK
#define PH_MASK 0xFFFF
#endif
#define PHM(b) (((PH_MASK) >> (b)) & 1)
#ifndef PROBE_DUP
#define PROBE_DUP 0
#endif
#define PREP(b) _Pragma("unroll 1") for (int rep_ = 0; rep_ < ((((PROBE_DUP) >> (b)) & 1) ? 2 : 1); ++rep_)
#define IN(k) (s_lo <= (k) && (k) < s_hi)
#define SEAM(k) do { if ((k) + 1 < s_hi) xcd_barrier(bar, tid_from_wave(wave) == 0); } while (0)

    const float* const x_in = args.in[0];
    _Float16* const H = (_Float16*)(ws + WS_H); unsigned char* const HB8 = (unsigned char*)(ws + WS_OB + 32 * MiB);     bf16* const QKV = (bf16*)(ws + WS_QKV); bf16* const OB = (bf16*)(ws + WS_OB);
    bf16* const MIX = (bf16*)(ws + WS_YD);     bf16* const XS = (bf16*)(ws + WS_XS); float* const S1 = (float*)(ws + WS_XS); bf16* const ACT = (bf16*)(ws + WS_ACT); bf16* const YD = (bf16*)(ws + WS_YD);
    float* const WR = (float*)(ws + WS_WR);
    int* const CNT = (int*)(ws + WS_CNT); unsigned* const RE = (unsigned*)(ws + WS_RE); f32x2* const RW = (f32x2*)(ws + WS_RW); int* const RP = (int*)(ws + WS_RP);

    if (IN(0) && PHM(0)) { PREP(0) {
        const int tid = opq_tid(wave), lane = tid & 63;
        LAS float* scr = (LAS float*)(lds + RING_OFF + wave * 16640);
        const int gw = vcu * NWAVES + wave, NGW = G * NWAVES;
        constexpr int I0 = 2 * 3072, I1 = 8 * 1024, I2 = 128 * 512, I3 = 64 * 512, NITEMS = I0 + I1 + I2 + I3;
        static_assert(QKV8_A == 1 && QKV8_B == 0, "conversion table below: stick-breaking q|k|v and all other fp8 GEMM weights -> e4m3, differential q|k|v weights -> fp16");
#define CVT_DECODE(it_, SRC, PIT, DST, DP, MODE, K0, N0, KIND) do { int r = (it_); \
            if (r < I0) { const int job = r / 3072; r -= job * 3072; const int kb = r / 96, nb = r - kb * 96; \
                SRC = args.in[1] + (size_t)job * 2048 * 6144; PIT = 6144; DST = ws + WS_WQKVA + (size_t)job * 6144 * 2048; DP = 2048; MODE = 0; K0 = kb * 64; N0 = nb * 64; KIND = 2; break; } \
            r -= I0; \
            if (r < I1) { const int job = r >> 10; r &= 1023; K0 = (r >> 5) * 64; N0 = (r & 31) * 64; PIT = 2048; MODE = 0; KIND = 2; DP = P8K2; \
                if (job < 2) { SRC = args.in[2] + (size_t)job * 2048 * 2048; DST = ws + WS_WOA + (size_t)job * 2048 * P8K2; } \
                else if (job >= 6) { SRC = args.in[5] + (size_t)(job - 6) * 2048 * 2048; DST = ws + WS_WOB + (size_t)(job - 6) * 2048 * P8K2; } \
                else { KIND = 1; DP = LDH * 2; \
                    if (job == 2) { SRC = args.in[4]; DST = ws + WS_WQKVB; MODE = 1; } \
                    else if (job == 3) { SRC = args.in[3]; PIT = 4096; DST = ws + WS_WQKVB + (size_t)2048 * LDH * 2; MODE = 1; } \
                    else if (job == 4) { SRC = args.in[3] + 2048; PIT = 4096; DST = ws + WS_WQKVB + (size_t)4096 * LDH * 2; } \
                    else { SRC = args.in[4] + (size_t)2048 * 2048; DST = ws + WS_WQKVB + (size_t)6144 * LDH * 2; MODE = 1; } } \
                break; } \
            r -= I1; \
            if (r < I2) { const int job = r >> 9; r &= 511; const int le = job >> 1, up = job & 1;     \
                SRC = (up ? args.in[15] : args.in[14]) + (size_t)le * 2048 * 1024; PIT = 1024; DST = ws + WS_WGU + (size_t)le * 2048 * P8K2; DP = P8K2; MODE = 2 + up; K0 = (r >> 4) * 64; N0 = (r & 15) * 64; KIND = 2; break; } \
            r -= I2; \
            { const int le = r >> 9; r &= 511; SRC = args.in[16] + (size_t)le * 1024 * 2048; PIT = 2048; DST = ws + WS_WDN + (size_t)le * 2048 * P8K1; DP = P8K1; MODE = 0; K0 = (r >> 5) * 64; N0 = (r & 31) * 64; KIND = 2; } \
        } while (0)
        { const float* sA; const float* sB; unsigned char* dA; unsigned char* dB; int pA, pB, qA, qB, mA, mB, kA, kB, nA, nB, tA, tB; f32x4 va[16], vb[16];
          int it = gw;
          if (it < NITEMS) { CVT_DECODE(it, sA, pA, dA, qA, mA, kA, nA, tA); cvt_load(va, sA, pA, kA, nA, lane);
            for (;;) {
                if (it + NGW < NITEMS) { CVT_DECODE(it + NGW, sB, pB, dB, qB, mB, kB, nB, tB); cvt_load(vb, sB, pB, kB, nB, lane); }
                cvt_store(va, dA, qA, mA, kA, nA, tA, scr, lane); it += NGW; if (it >= NITEMS) break;
                if (it + NGW < NITEMS) { CVT_DECODE(it + NGW, sA, pA, dA, qA, mA, kA, nA, tA); cvt_load(va, sA, pA, kA, nA, lane); }
                cvt_store(vb, dB, qB, mB, kB, nB, tB, scr, lane); it += NGW; if (it >= NITEMS) break;
            } } }
#undef CVT_DECODE
        for (size_t i = (size_t)gw * 64 + lane; i < (size_t)NTOK * DM / 4; i += (size_t)NGW * 64) {
            const f32x4 v = ((const f32x4*)x_in)[i];
            ((unsigned*)HB8)[i] = pg8::pack4_fp8(v[0], v[1], v[2], v[3]); }
        for (int i = bx * (NWAVES * 64) + tid; i < NLAYER * 20 * 2048; i += G * NWAVES * 64) { const int k = i & 2047, c = (i >> 11) % 20, l = i / (20 * 2048);
            WR[i] = c < 4 ? args.in[12][((size_t)l * 2048 + k) * 4 + c] : args.in[13][(((size_t)l * 4 + ((c - 4) >> 2)) * 2048 + k) * 4 + ((c - 4) & 3)]; }
        }
        SEAM(0);
    }

    for (int L = 0; L < NLAYER; ++L) {
        const int sb = 1 + 8 * L; const bool typeA = L < 2;
        if (IN(sb + 0)) {
            if (typeA && PHM(1)) { PREP(1) {
                pg8::StaticOrder S; S.init(NTOK, 6144, G, bx);
                if (QKV8_A) { pg8::Gemm g{(const bf16*)HB8, (const bf16*)(ws + WS_WQKVA + (size_t)L * 6144 * 2048), NTOK, 6144, DM / 2, DM / 2, wave}; pg8::EpiQkv E{QKV, 6144, 2048, SB_QSCALE, 1.f / pg8::W8_SCALE};
                    pg8::gemm_phase<pg8::EpiQkv, pg8::StaticOrder, true, true, true>(lds + RING_OFF, g, S, E); }
                } static_assert(QKV8_A == 1, "the stick-breaking layers' q|k|v GEMM takes the e4m3 copy of the stream");
            } else if (!typeA && PHM(2)) { PREP(2) {
                const int N = (L == 2) ? 6144 : 2048;
                pg8::StaticOrder S; S.init(NTOK, N, G, bx);
                if (QKV8_B) { pg8::Gemm g{(const bf16*)HB8, (const bf16*)(ws + WS_WQKVB + (L == 2 ? (size_t)0 : (size_t)6144 * 2048)), NTOK, N, DM / 2, DM / 2, wave};
                    pg8::EpiRope E{QKV, 6144, 2048, 4096, DF_QSCALE, 1.f / pg8::W8_SCALE};
                    pg8::gemm_phase<pg8::EpiRope, pg8::StaticOrder, true, true, true>(lds + RING_OFF, g, S, E); }
                else { pg8::Gemm g{(const bf16*)H, (const bf16*)(ws + WS_WQKVB) + (L == 2 ? (size_t)0 : (size_t)6144 * LDH), NTOK, N, DM, LDH, wave};
                    pg8::EpiRope E{QKV, 6144, 2048, 4096, DF_QSCALE, 1.f};
                    pg8::gemm_phase<pg8::EpiRope, pg8::StaticOrder, true, true, false, true>(lds + RING_OFF, g, S, E); } }
            }
            SEAM(sb + 0);
        }
        if (IN(sb + 1)) {
            if (typeA && PHM(3)) {
                for (int id_ = vcu; id_ < 512 * (1 + ((PROBE_DUP >> 3) & 1)); id_ += G) { const int id = id_ & 511; const int bh = id >> 2, p = id & 3, b = bh >> 4, h = bh & 15;
                    const bf16* Qg = QKV + (size_t)b * SEQ * 6144 + h * 128; bf16* Og = (bf16*)((unsigned char*)OB + (size_t)b * SEQ * P8K2 + h * 128);
                    att::sb_block(Qg, Qg + 2048, Qg + 4096, Og, 7 - p, (att::ldsp)(lds + RING_OFF), wave);
                    att::sb_block(Qg, Qg + 2048, Qg + 4096, Og, p, (att::ldsp)(lds + RING_OFF), wave); }
            } else if (!typeA && PHM(4)) {
                const int lane = opq_tid(wave) & 63;
                const int i = L - 2; const float lam_init = (L == 2) ? 0.47071301834264183f : 0.5560582041556061f;
                const float* lp = args.in[6] + (size_t)i * 256;
                const float sa = dpp_sum(lp[lane] * lp[64 + lane]), sb2 = dpp_sum(lp[128 + lane] * lp[192 + lane]);
                const float lam = __builtin_amdgcn_exp2f(sa * LOG2E) - __builtin_amdgcn_exp2f(sb2 * LOG2E) + lam_init;
                const float* gsub = args.in[7] + (size_t)i * 128; const float gmul = 1.f - lam_init;
                for (int id_ = vcu; id_ < 512 * (1 + ((PROBE_DUP >> 4) & 1)); id_ += G) { const int id = id_ & 511; const int bh = id >> 2, p = id & 3, b = bh >> 4, h = bh & 15;
                    const bf16* Qg = QKV + (size_t)b * SEQ * 6144 + h * 128; bf16* Og = (bf16*)((unsigned char*)OB + (size_t)b * SEQ * P8K2 + h * 128); float* Sg = S1 + (size_t)b * SEQ * DM + h * 128;
#pragma unroll 1
                    for (int w = 0; w < 2; ++w) { const int qb = w ? p : 7 - p;
                        att::diff_pass<false>(Qg, Qg + 2048, Qg + 4096, Sg, Og, qb, lam, gsub, gmul, (att::ldsp)(lds + RING_OFF), wave);
                        att::diff_pass<true>(Qg + 64, Qg + 2048 + 64, Qg + 4096, Sg, Og, qb, lam, gsub, gmul, (att::ldsp)(lds + RING_OFF), wave); } }
            }
            SEAM(sb + 1);
        }
        if (IN(sb + 2)) { if (PHM(5)) {
            pg8::Gemm g{OB, (const bf16*)(ws + (typeA ? WS_WOA : WS_WOB) + (size_t)(L & 1) * 2048 * P8K2), NTOK, DM, DM / 2, P8K2 / 2, wave}; pg8::StaticOrder S; S.init(NTOK, DM, G, bx);
            pg8::EpiQkv E{MIX, DM, 0, 1.f, 1.f / (pg8::W8_SCALE * att::OB8_SCALE)};
            pg8::gemm_phase<pg8::EpiQkv, pg8::StaticOrder, true, true, true>(lds + RING_OFF, g, S, E); }
            SEAM(sb + 2);
        }
        if (IN(sb + 3)) { if (PHM(6)) {
            const int tid = opq_tid(wave), lane = tid & 63;
            const float* lng = args.in[8] + (size_t)L * DM; const float* lnb = args.in[9] + (size_t)L * DM; const float* wr = WR + (size_t)L * 20 * 2048;
            LAS int* eid = (LAS int*)(lds + LNX_OFF + 2048);
            LAS float* lgt = (LAS float*)(lds + LNX_OFF + 4096);
            LAS unsigned* rows8 = (LAS unsigned*)(lds + RING_OFF);
            for (int c = bx; c < 256; c += G) {
#pragma unroll 1
                for (int grp = 0; grp < 4; ++grp) {
                    const int rloc = wave * 8 + grp * 2; const size_t row0 = (size_t)64 * c + rloc;
                    f32x4 v[2][8]; float mu[2], rstd[2];
#pragma unroll
                    for (int rr = 0; rr < 2; ++rr) {
                        if (L == 0) { const f32x4* hp = (const f32x4*)(x_in + (row0 + rr) * DM) + lane;
#pragma unroll
                            for (int j = 0; j < 8; ++j) v[rr][j] = hp[64 * j]; }
                        else { const _Float16* hq = H + (row0 + rr) * DM + 4 * lane;
#pragma unroll
                            for (int j = 0; j < 8; ++j) v[rr][j] = ldh4(hq + 256 * j); } }
#pragma unroll
                    for (int rr = 0; rr < 2; ++rr) { const v2u* mp = (const v2u*)(MIX + (row0 + rr) * DM) + lane;
#pragma unroll
                        for (int j = 0; j < 8; ++j) { const v2u a = mp[64 * j];
                            const f32x4 fa = {__uint_as_float(a.x << 16), __uint_as_float(a.x & 0xffff0000u), __uint_as_float(a.y << 16), __uint_as_float(a.y & 0xffff0000u)};
                            v[rr][j] = v[rr][j] * DN_ALPHA + fa; } }
#pragma unroll
                    for (int rr = 0; rr < 2; ++rr) { float s = 0.f;
#pragma unroll
                        for (int j = 0; j < 8; ++j) s += (v[rr][j][0] + v[rr][j][1]) + (v[rr][j][2] + v[rr][j][3]);
                        mu[rr] = dpp_sum(s) * (1.f / DM); float q = 0.f;
#pragma unroll
                        for (int j = 0; j < 8; ++j) { const f32x4 d = v[rr][j] - mu[rr]; q += (d[0] * d[0] + d[1] * d[1]) + (d[2] * d[2] + d[3] * d[3]); }
                        rstd[rr] = 1.f / sqrtf(dpp_sum(q) * (1.f / DM) + LN_EPS); }
#pragma unroll
                    for (int j = 0; j < 8; ++j) { const f32x4 gg = ((const f32x4*)lng)[64 * j + lane], bb = ((const f32x4*)lnb)[64 * j + lane];
#pragma unroll
                        for (int rr = 0; rr < 2; ++rr) { v[rr][j] = (v[rr][j] - mu[rr]) * rstd[rr] * gg + bb; sth4(H + (row0 + rr) * DM + 256 * j + 4 * lane, v[rr][j]);
                            if (c == bx) rows8[(rloc + rr) * 512 + 64 * j + lane] = pg8::pack4_fp8(v[rr][j][0], v[rr][j][1], v[rr][j][2], v[rr][j][3]); } }
                    f32x4 wn[8];
                    { const f32x4* wp = (const f32x4*)wr + lane;
#pragma unroll
                      for (int j = 0; j < 8; ++j) wn[j] = wp[64 * j]; }
#pragma unroll 1
                    for (int cc = 0; cc < 20; ++cc) { f32x4 w[8];
#pragma unroll
                        for (int j = 0; j < 8; ++j) w[j] = wn[j];
                        { const f32x4* wp = (const f32x4*)(wr + (cc < 19 ? cc + 1 : 19) * 2048) + lane;
#pragma unroll
                          for (int j = 0; j < 8; ++j) wn[j] = wp[64 * j]; }
                        float a[2] = {0.f, 0.f};
#pragma unroll
                        for (int j = 0; j < 8; ++j) {
#pragma unroll
                            for (int rr = 0; rr < 2; ++rr) a[rr] += (v[rr][j][0] * w[j][0] + v[rr][j][1] * w[j][1]) + (v[rr][j][2] * w[j][2] + v[rr][j][3] * w[j][3]); }
#pragma unroll
                        for (int rr = 0; rr < 2; ++rr) a[rr] = dpp_sum(a[rr]);
                        if (lane == 0) { lgt[rloc * 20 + cc] = a[0]; lgt[(rloc + 1) * 20 + cc] = a[1]; } }
                }
                LDS_WAIT();
                if (lane < 8) {
                    const int rl = wave * 8 + lane; const LAS float* lg = lgt + rl * 20;
                    int gsel = 0; float gm = lg[0];
#pragma unroll
                    for (int i = 1; i < 4; ++i) { const float x = lg[i]; if (x > gm) { gm = x; gsel = i; } }
                    float gden = 0.f;
#pragma unroll
                    for (int i = 0; i < 4; ++i) gden += __builtin_amdgcn_exp2f((lg[i] - gm) * LOG2E);
                    const float gw_ = 1.f / gden;
                    const LAS float* li = lg + 4 + 4 * gsel;
                    const float l0 = li[0], l1 = li[1], l2 = li[2], l3 = li[3];
                    int i0 = 0; float v0 = l0;
                    if (l1 > v0) { v0 = l1; i0 = 1; } if (l2 > v0) { v0 = l2; i0 = 2; } if (l3 > v0) { v0 = l3; i0 = 3; }
                    int i1 = -1; float v1 = 0.f;
                    if (i0 != 0) { v1 = l0; i1 = 0; }
                    if (i0 != 1 && (i1 < 0 || l1 > v1)) { v1 = l1; i1 = 1; }
                    if (i0 != 2 && (i1 < 0 || l2 > v1)) { v1 = l2; i1 = 2; }
                    if (i0 != 3 && (i1 < 0 || l3 > v1)) { v1 = l3; i1 = 3; }
                    const float t = __builtin_amdgcn_exp2f((v1 - v0) * LOG2E); const float w0 = gw_ / (1.f + t), w1 = gw_ * t / (1.f + t);
                    eid[2 * rl] = gsel * 4 + i0; eid[2 * rl + 1] = gsel * 4 + i1; RW[(size_t)64 * c + rl] = (f32x2){w0, w1};
                }
                __syncthreads();
                if (wave == 0) {
                    const int ea = eid[lane], eb = eid[64 + lane]; int ra = 0, rb = 0, cnt = 0; const unsigned long long lt = (1ull << lane) - 1ull;
#pragma unroll
                    for (int e = 0; e < 16; ++e) { const unsigned long long ma = __ballot(ea == e), mb = __ballot(eb == e);
                        if (ea == e) ra = __popcll(ma & lt); if (eb == e) rb = __popcll(ma) + __popcll(mb & lt); if (lane == e) cnt = __popcll(ma) + __popcll(mb); }
                    if (lane < 16) CNT[c * 16 + lane] = cnt;
                    LAS int* rk = (LAS int*)(lds + LNX_OFF + 3072); rk[lane] = ra; rk[64 + lane] = rb; LDS_WAIT();
                    const int r = lane; const unsigned word = (unsigned)eid[2 * r] | ((unsigned)eid[2 * r + 1] << 8) | ((unsigned)rk[2 * r] << 16) | ((unsigned)rk[2 * r + 1] << 24);
                    RE[(size_t)64 * c + r] = word;
                }
                __syncthreads();
            } }
            SEAM(sb + 3);
        }
        if ((IN(sb + 4) || IN(sb + 5) || IN(sb + 6)) && PHM(7)) {
            const int tid = opq_tid(wave);
            LAS int* part = (LAS int*)(lds + LNX_OFF);
            { const int e = tid & 15, s = tid >> 4; int a = 0;
#pragma unroll
              for (int i = 0; i < 8; ++i) a += CNT[(8 * s + i) * 16 + e];
              part[s * 16 + e] = a; }
            __syncthreads();
            if (tid < 16) { int run = 0;
#pragma clang loop vectorize(disable) unroll(disable)
                for (int s = 0; s < 32; ++s) run += part[s * 16 + tid];
                TAB[tid] = run; }
            __syncthreads();
            if (tid == 0) { int off = 0, mt = 0;
#pragma clang loop vectorize(disable) unroll(disable)
                for (int e = 0; e < 16; ++e) { TAB[16 + e] = off; const int nt = (TAB[e] + 255) >> 8;
#pragma clang loop vectorize(disable) unroll(disable)
                    for (int i = 0; i < nt; ++i) TAB[64 + mt++] = e;
                    off += nt * 256; }
                TAB[32] = off; TAB[33] = mt; }
            __syncthreads();
        }
        if (IN(sb + 4)) { if (PHM(7)) PREP(7) {
            const int tid = opq_tid(wave), lane = tid & 63;
            LAS int* part = (LAS int*)(lds + LNX_OFF);
            for (int c = bx; c < 256; c += G) {
                if (tid < 16) { int pre = 0; int x[8];
#pragma unroll
                    for (int i = 0; i < 8; ++i) x[i] = CNT[((c & ~7) + i) * 16 + tid];
#pragma clang loop vectorize(disable) unroll(disable)
                    for (int s = 0; s < (c >> 3); ++s) pre += part[s * 16 + tid];
#pragma unroll
                    for (int i = 0; i < 8; ++i) pre += (i < (c & 7)) ? x[i] : 0;
                    TAB[48 + tid] = TAB[16 + tid] + pre; }
                __syncthreads();
#pragma unroll 1
                for (int rr = 0; rr < 8; ++rr) { const size_t row = (size_t)64 * c + wave * 8 + rr; const unsigned word = RE[row];
                    const int p0 = TAB[48 + (word & 255)] + ((word >> 16) & 255), p1 = TAB[48 + ((word >> 8) & 255)] + (word >> 24);
                    if (lane == 0) { RP[2 * row] = p0; RP[2 * row + 1] = p1; }
                    if (c == bx && IN(sb + 3)) {
                        const LAS v4u* src = (const LAS v4u*)(lds + RING_OFF + (wave * 8 + rr) * 2048) + lane; v4u* o0 = (v4u*)((unsigned char*)XS + (size_t)p0 * P8K2) + lane; v4u* o1 = (v4u*)((unsigned char*)XS + (size_t)p1 * P8K2) + lane;
                        const v4u a = src[0], b = src[64]; o0[0] = a; o0[64] = b; o1[0] = a; o1[64] = b;
                    } else {
                        const _Float16* hq = H + row * DM + 4 * lane; unsigned* o0 = (unsigned*)((unsigned char*)XS + (size_t)p0 * P8K2) + lane; unsigned* o1 = (unsigned*)((unsigned char*)XS + (size_t)p1 * P8K2) + lane;
#pragma unroll
                        for (int j = 0; j < 8; ++j) { const f32x4 v = ldh4(hq + 256 * j); const unsigned o = pg8::pack4_fp8(v[0], v[1], v[2], v[3]); o0[64 * j] = o; o1[64 * j] = o; } } }
                __syncthreads();
            } }
            SEAM(sb + 4);
        }
        if (IN(sb + 5)) { if (PHM(8)) PREP(8) {
            pg8::Gemm g{XS, (const bf16*)(ws + WS_WGU + (size_t)L * 16 * 2048 * P8K2), XS_ROWS, 2048, DM / 2, P8K2 / 2, wave};
            pg8::MoeOrder S{TAB[33] * 8, G, bx, TAB + 64}; pg8::EpiGateUp8 E{(unsigned char*)ACT};
            pg8::gemm_phase<pg8::EpiGateUp8, pg8::MoeOrder, true, true, true>(lds + RING_OFF, g, S, E); }
            SEAM(sb + 5);
        }
        if (IN(sb + 6)) { if (PHM(9)) PREP(9) {
            pg8::Gemm g{ACT, (const bf16*)(ws + WS_WDN + (size_t)L * 16 * 2048 * P8K1), XS_ROWS, 2048, DEXP / 2, P8K1 / 2, wave};
            pg8::MoeOrder S{TAB[33] * 8, G, bx, TAB + 64}; pg8::EpiDown8 E{(unsigned char*)YD};
            pg8::gemm_phase<pg8::EpiDown8, pg8::MoeOrder, true, true, true>(lds + RING_OFF, g, S, E); }
            SEAM(sb + 6);
        }
        if (IN(sb + 7)) { if (PHM(10)) for (int rep_ = 0; rep_ < ((((PROBE_DUP) >> 10) & 1) && L == NLAYER - 1 ? 5 : 1); ++rep_) {
            const int tid = opq_tid(wave), lane = tid & 63;
            const float* lng = args.in[10] + (size_t)L * DM; const float* lnb = args.in[11] + (size_t)L * DM; const bool last = (L == NLAYER - 1); const bool next8 = (L + 1 < 2) ? (QKV8_A != 0) : (QKV8_B != 0);
            const int gw = vcu * NWAVES + wave, NGW = G * NWAVES;
            for (int row0 = 4 * gw; row0 < NTOK; row0 += 4 * NGW) {
                f32x4 v[4][8]; float mu[4], rstd[4];
#pragma unroll
                for (int rr = 0; rr < 4; ++rr) { const int row = row0 + rr;
                    const int p0 = RP[2 * row], p1 = RP[2 * row + 1]; const f32x2 w = RW[row];
                    const _Float16* hq = H + (size_t)row * DM + 4 * lane; const unsigned* y0 = (const unsigned*)((const unsigned char*)YD + (size_t)p0 * DM) + lane; const unsigned* y1 = (const unsigned*)((const unsigned char*)YD + (size_t)p1 * DM) + lane;
                    const float w0s = w.x * (1.f / pg8::YD8_SCALE), w1s = w.y * (1.f / pg8::YD8_SCALE);
#pragma unroll
                    for (int j = 0; j < 8; ++j) { const f32x4 h = ldh4(hq + 256 * j); const unsigned a = y0[64 * j], b = y1[64 * j];
                        const f32x2 a0 = __builtin_amdgcn_cvt_pk_f32_fp8((int)a, false), a1 = __builtin_amdgcn_cvt_pk_f32_fp8((int)a, true), b0 = __builtin_amdgcn_cvt_pk_f32_fp8((int)b, false), b1 = __builtin_amdgcn_cvt_pk_f32_fp8((int)b, true);
                        const f32x4 fa = {a0[0], a0[1], a1[0], a1[1]}, fb = {b0[0], b0[1], b1[0], b1[1]};
                        v[rr][j] = h * DN_ALPHA + fa * w0s + fb * w1s; } }
#pragma unroll
                for (int rr = 0; rr < 4; ++rr) { float s = 0.f;
#pragma unroll
                    for (int j = 0; j < 8; ++j) s += (v[rr][j][0] + v[rr][j][1]) + (v[rr][j][2] + v[rr][j][3]);
                    mu[rr] = dpp_sum(s) * (1.f / DM); float q = 0.f;
#pragma unroll
                    for (int j = 0; j < 8; ++j) { const f32x4 dd = v[rr][j] - mu[rr]; q += (dd[0] * dd[0] + dd[1] * dd[1]) + (dd[2] * dd[2] + dd[3] * dd[3]); }
                    rstd[rr] = 1.f / sqrtf(dpp_sum(q) * (1.f / DM) + LN_EPS); }
#pragma unroll
                for (int j = 0; j < 8; ++j) { const f32x4 gg = ((const f32x4*)lng)[64 * j + lane], bb = ((const f32x4*)lnb)[64 * j + lane];
#pragma unroll
                    for (int rr = 0; rr < 4; ++rr) { const int row = row0 + rr; const f32x4 y = (v[rr][j] - mu[rr]) * rstd[rr] * gg + bb;
                        if (last) ((f32x4*)(args.out + (size_t)row * DM))[64 * j + lane] = y;
                        else { sth4(H + (size_t)row * DM + 256 * j + 4 * lane, y); if (next8) ((unsigned*)(HB8 + (size_t)row * DM))[64 * j + lane] = pg8::pack4_fp8(y[0], y[1], y[2], y[3]); } } }
            } }
            SEAM(sb + 7);
        }
    }
#undef IN
#undef SEAM
}

extern "C" void kernel_launch(void* const* d_in, const int* in_sizes, int n_in, void* d_out, int out_size, void* d_ws, size_t ws_size, hipStream_t stream) {
    static int grid = 0;
    if (grid == 0) {
        if (n_in != 17 || in_sizes[0] != NTOK * DM || out_size != NTOK * DM || ws_size < WS_END) { fprintf(stderr, "kernel_launch: unexpected shapes / workspace (n_in %d, ws %zu, need %zu)\n", n_in, ws_size, (size_t)WS_END); grid = -1; return; }
        int dev = 0, cus = 0, per_cu = 0;
        if (hipGetDevice(&dev) != hipSuccess || hipDeviceGetAttribute(&cus, hipDeviceAttributeMultiprocessorCount, dev) != hipSuccess) { grid = -1; return; }
        if (hipFuncSetAttribute((const void*)yoco_fwd, hipFuncAttributeMaxDynamicSharedMemorySize, LDS_BYTES) != hipSuccess) { fprintf(stderr, "kernel_launch: hipFuncSetAttribute failed\n"); grid = -1; return; }
        if (hipOccupancyMaxActiveBlocksPerMultiprocessor(&per_cu, (const void*)yoco_fwd, NWAVES * 64, LDS_BYTES) != hipSuccess || per_cu < 1) { fprintf(stderr, "kernel_launch: occupancy query says %d\n", per_cu); per_cu = 1; }
        (void)hipGetLastError();
        grid = cus;
    }
    if (grid < 0) return;
    (void)hipMemsetAsync((char*)d_ws + WS_CTL, 0, CTL_ZERO_BYTES, stream);
    Args a{};
    for (int i = 0; i < 17; ++i) a.in[i] = (const float*)d_in[i];
    a.out = (float*)d_out; a.ws = (unsigned char*)d_ws;
#if MK_MULTI
    for (int s = 0; s < NSTEPS; ++s) { a.s_lo = s; a.s_hi = s + 1; hipLaunchKernelGGL(yoco_fwd, dim3(grid), dim3(NWAVES * 64), LDS_BYTES, stream, a); }
#else
    a.s_lo = 0; a.s_hi = NSTEPS;
    hipLaunchKernelGGL(yoco_fwd, dim3(grid), dim3(NWAVES * 64), LDS_BYTES, stream, a);
#endif
    const hipError_t le = hipPeekAtLastError();
    if (le != hipSuccess) fprintf(stderr, "kernel_launch: launch failed: %s\n", hipGetErrorName(le));
}
```

```cpp
#include <hip/hip_runtime.h>
#include <cstdio>
#include <cstdint>

__device__ __forceinline__ int tid_from_wave(int wave) { int l; asm volatile("v_mbcnt_lo_u32_b32 %0, -1, 0\n\tv_mbcnt_hi_u32_b32 %0, -1, %0" : "=v"(l)); return wave * 64 + l; }
namespace pg8 {
#define PG8_LAS __attribute__((address_space(3)))
typedef unsigned short bf16_t;
typedef short bf16x8 __attribute__((ext_vector_type(8)));
typedef float f32x4 __attribute__((ext_vector_type(4)));
typedef unsigned u32x4 __attribute__((ext_vector_type(4)));
typedef int pg8_v8i __attribute__((ext_vector_type(8)));
typedef _Float16 pg8_h8 __attribute__((ext_vector_type(8)));
constexpr int BM = 256, BK = 64, HALF = 128, HTB = HALF * BK * 2  , STAGE_BYTES = 8 * HTB, NXCD = 8, WGM = 8;

__host__ __device__ __forceinline__ int lds_byte(int r, int c) { const int st = (r >> 4) * 2 + (c >> 5), rr = r & 15, cc = c & 31, ob = rr * 64 + cc * 2; return st * 1024 + (ob ^ (((ob >> 9) & 1) << 5)); }
__host__ __device__ __forceinline__ void stage_rc(int b, int& R, int& C) { const int st = b / 1024, sb = b % 1024, swz = sb ^ (((sb >> 9) & 1) << 5); R = (st >> 1) * 16 + swz / 64; C = (st & 1) * 32 + (swz % 64) / 2; }
__host__ __device__ __forceinline__ int perm32(int rho) { const int n = rho >> 4, i = rho & 15; return 8 * (i >> 2) + 4 * n + (i & 3); }

struct Unit { int pm, pn; };
struct Gemm { const bf16_t* A; const bf16_t* Bt; int M, N, K, ld, wave; };

struct StaticOrder {
    int nM, nN, nwg, G, c;
    __host__ __device__ void init(int M, int N, int G_, int c_) { nM = M / BM; nN = N / BM; nwg = nM * nN; G = G_; c = c_; }
    __host__ __device__ bool next(int i, Unit& u) const {
        const long L = (long)i * G + c; if (L >= nwg) return false;
        int wgid = (int)L; { const int q = nwg / NXCD, r = nwg % NXCD, xcd = wgid % NXCD, off = wgid / NXCD; wgid = (xcd < r ? xcd * (q + 1) : r * (q + 1) + (xcd - r) * q) + off; }
        const int nig = WGM * nN, gid = wgid / nig, fm = gid * WGM, gsz = (nM - fm) < WGM ? (nM - fm) : WGM;
        u.pm = fm + ((wgid % nig) % gsz); u.pn = (wgid % nig) / gsz; return true;
    }
    __device__ __forceinline__ void a_ready(const Unit&) const {}
    __device__ __forceinline__ void done(const Unit&) const {}
};

__device__ __forceinline__ unsigned cvt_pk_bf16(float lo, float hi) { unsigned r; asm volatile("v_cvt_pk_bf16_f32 %0, %1, %2" : "=v"(r) : "v"(lo), "v"(hi)); return r; }
typedef float f32x2 __attribute__((ext_vector_type(2)));

typedef unsigned u32x2 __attribute__((ext_vector_type(2)));
__device__ __forceinline__ u32x4 pack8_bf16(const f32x4 a, const f32x4 b) { u32x4 w; w.x = cvt_pk_bf16(a[0], a[1]); w.y = cvt_pk_bf16(a[2], a[3]); w.z = cvt_pk_bf16(b[0], b[1]); w.w = cvt_pk_bf16(b[2], b[3]); return w; }

struct EpiQkv {
    static constexpr bool PERM = true, AFTER_DRAIN = false;
    bf16_t* O; int ldc; int qcols; float qscale; float osc;
    __device__ __forceinline__ void operator()(const f32x4 (&acc)[2][2][4][2], const Unit& u, int wr, int wc, int fr, int fq) const {
        const int row0 = u.pm * BM + wr * 64 + fr, colt = u.pn * BM; const float sc = (colt < qcols ? qscale : 1.f) * osc;
        const int col0 = colt + wc * 32 + 8 * fq;
#pragma unroll
        for (int ai = 0; ai < 2; ++ai)
#pragma unroll
            for (int m = 0; m < 4; ++m) { bf16_t* rowp = O + (size_t)(row0 + ai * HALF + m * 16) * ldc + col0;
#pragma unroll
                for (int bj = 0; bj < 2; ++bj) *(u32x4*)(rowp + bj * HALF) = pack8_bf16(acc[ai][bj][m][0] * sc, acc[ai][bj][m][1] * sc); }
    }
};
template <int ACCS_INV> struct EpiResid {
    static constexpr bool PERM = false, AFTER_DRAIN = false;
    static constexpr int ldc = 2048; static constexpr float alpha = 1.6817928305074292f, accs = 1.f / (float)ACCS_INV;
    float* H; const float* Hsrc;
    __device__ __forceinline__ void operator()(const f32x4 (&acc)[2][2][4][2], const Unit& u, int wr, int wc, int fr, int fq) const {
        const int row0 = u.pm * BM + wr * 64 + fr, col0 = u.pn * BM + wc * 32 + 4 * fq;
#pragma unroll
        for (int ai = 0; ai < 2; ++ai)
#pragma unroll
            for (int m = 0; m < 4; ++m) { const size_t ro = (size_t)(row0 + ai * HALF + m * 16) * ldc + col0; float* rowp = H + ro; const float* srcp = Hsrc + ro;
#pragma unroll
                for (int bj = 0; bj < 2; ++bj)
#pragma unroll
                    for (int n = 0; n < 2; ++n) { const f32x4 h = *(const f32x4*)(srcp + bj * HALF + n * 16); *(f32x4*)(rowp + bj * HALF + n * 16) = h * alpha + acc[ai][bj][m][n] * accs; } }
    }
};
struct EpiRope {
    static constexpr bool PERM = true, AFTER_DRAIN = false;
    bf16_t* O; int ldc; int qcols, ropecols; float qscale; float osc;
    __device__ __forceinline__ void operator()(const f32x4 (&acc)[2][2][4][2], const Unit& u, int wr, int wc, int fr, int fq) const {
        const int row0 = u.pm * BM + wr * 64 + fr, colt = u.pn * BM;
        if (colt >= ropecols) {
            const int col0 = colt + wc * 32 + 8 * fq;
#pragma unroll
            for (int ai = 0; ai < 2; ++ai)
#pragma unroll
                for (int m = 0; m < 4; ++m) { bf16_t* rowp = O + (size_t)(row0 + ai * HALF + m * 16) * ldc + col0;
#pragma unroll
                    for (int bj = 0; bj < 2; ++bj) *(u32x4*)(rowp + bj * HALF) = pack8_bf16(acc[ai][bj][m][0] * osc, acc[ai][bj][m][1] * osc); }
        } else {
            const float sc = (colt < qcols ? qscale : 1.f) * osc;
            const int col0 = colt + wc * 64 + 8 * fq;
            float ir[8];
#pragma unroll
            for (int i = 0; i < 8; ++i) ir[i] = __builtin_amdgcn_exp2f(-(float)(8 * fq + i) * 0.4152410118609203f) * 0.15915494309189535f;
#pragma unroll
            for (int ai = 0; ai < 2; ++ai)
#pragma unroll
                for (int m = 0; m < 4; ++m) { const int row = row0 + ai * HALF + m * 16; const float pos = (float)(row & 2047);
                    f32x4 c0, c1, s0, s1;
#pragma unroll
                    for (int i = 0; i < 4; ++i) { const float f0 = __builtin_amdgcn_fractf(pos * ir[i]), f1 = __builtin_amdgcn_fractf(pos * ir[4 + i]);
                        c0[i] = __builtin_amdgcn_cosf(f0); s0[i] = __builtin_amdgcn_sinf(f0); c1[i] = __builtin_amdgcn_cosf(f1); s1[i] = __builtin_amdgcn_sinf(f1); }
                    const f32x4 a0 = acc[ai][0][m][0], a1 = acc[ai][0][m][1], b0 = acc[ai][1][m][0], b1 = acc[ai][1][m][1];
                    bf16_t* rowp = O + (size_t)row * ldc + col0;
                    *(u32x4*)(rowp) = pack8_bf16((a0 * c0 - b0 * s0) * sc, (a1 * c1 - b1 * s1) * sc);
                    *(u32x4*)(rowp + 32) = pack8_bf16((b0 * c0 + a0 * s0) * sc, (b1 * c1 + a1 * s1) * sc); }
        }
    }
};
struct EpiGateUp {
    static constexpr bool PERM = true, AFTER_DRAIN = false;
    bf16_t* O;
    __device__ __forceinline__ void operator()(const f32x4 (&acc)[2][2][4][2], const Unit& u, int wr, int wc, int fr, int fq) const {
        const int row0 = u.pm * BM + wr * 64 + fr, col0 = (u.pn & 7) * 128 + wc * 32 + 8 * fq;
#pragma unroll
        for (int ai = 0; ai < 2; ++ai)
#pragma unroll
            for (int m = 0; m < 4; ++m) { f32x4 r[2];
#pragma unroll
                for (int n = 0; n < 2; ++n) { const f32x4 g = acc[ai][0][m][n], up = acc[ai][1][m][n];
#pragma unroll
                    for (int i = 0; i < 4; ++i) { const float e = __builtin_amdgcn_exp2f(g[i] * -1.4426950408889634f); r[n][i] = g[i] * __builtin_amdgcn_rcpf(1.f + e) * up[i]; } }
                *(u32x4*)(O + (size_t)(row0 + ai * HALF + m * 16) * 1024 + col0) = pack8_bf16(r[0], r[1]); }
    }
};
struct EpiDown {
    static constexpr bool PERM = true, AFTER_DRAIN = false;
    bf16_t* O;
    __device__ __forceinline__ void operator()(const f32x4 (&acc)[2][2][4][2], const Unit& u, int wr, int wc, int fr, int fq) const {
        const int row0 = u.pm * BM + wr * 64 + fr, col0 = (u.pn & 7) * BM + wc * 32 + 8 * fq;
#pragma unroll
        for (int ai = 0; ai < 2; ++ai)
#pragma unroll
            for (int m = 0; m < 4; ++m) { bf16_t* rowp = O + (size_t)(row0 + ai * HALF + m * 16) * 2048 + col0;
#pragma unroll
                for (int bj = 0; bj < 2; ++bj) *(u32x4*)(rowp + bj * HALF) = pack8_bf16(acc[ai][bj][m][0], acc[ai][bj][m][1]); }
    }
};
constexpr float W8_SCALE = 64.f, ACT8_SCALE = 4.f;
__device__ __forceinline__ unsigned pack4_fp8(float a, float b, float c, float d) { int w; asm volatile("" : "=v"(w));
    w = __builtin_amdgcn_cvt_pk_fp8_f32(a, b, w, false); w = __builtin_amdgcn_cvt_pk_fp8_f32(c, d, w, true); return (unsigned)w; }
struct EpiGateUp8 {
    static constexpr bool PERM = true, AFTER_DRAIN = false;
    unsigned char* O;
    __device__ __forceinline__ void operator()(const f32x4 (&acc)[2][2][4][2], const Unit& u, int wr, int wc, int fr, int fq) const {
        const int row0 = u.pm * BM + wr * 64 + fr, col0 = (u.pn & 7) * 128 + wc * 32 + 8 * fq;
        constexpr float SI = 1.f / W8_SCALE;
#pragma unroll
        for (int ai = 0; ai < 2; ++ai)
#pragma unroll
            for (int m = 0; m < 4; ++m) { f32x4 r[2];
#pragma unroll
                for (int n = 0; n < 2; ++n) { const f32x4 g = acc[ai][0][m][n] * SI, up = acc[ai][1][m][n] * (SI * ACT8_SCALE);
#pragma unroll
                    for (int i = 0; i < 4; ++i) { const float e = __builtin_amdgcn_exp2f(g[i] * -1.4426950408889634f); r[n][i] = g[i] * __builtin_amdgcn_rcpf(1.f + e) * up[i]; } }
                u32x2 w; w.x = pack4_fp8(r[0][0], r[0][1], r[0][2], r[0][3]); w.y = pack4_fp8(r[1][0], r[1][1], r[1][2], r[1][3]);
                *(u32x2*)(O + (size_t)(row0 + ai * HALF + m * 16) * 1024 + col0) = w; }
    }
};
constexpr float YD8_SCALE = 16.f;
struct EpiDown8 {
    static constexpr bool PERM = true, AFTER_DRAIN = false;
    unsigned char* O;
    __device__ __forceinline__ void operator()(const f32x4 (&acc)[2][2][4][2], const Unit& u, int wr, int wc, int fr, int fq) const {
        const int row0 = u.pm * BM + wr * 64 + fr, col0 = (u.pn & 7) * BM + wc * 32 + 8 * fq;
        constexpr float SI = YD8_SCALE / (W8_SCALE * ACT8_SCALE);
#pragma unroll
        for (int ai = 0; ai < 2; ++ai)
#pragma unroll
            for (int m = 0; m < 4; ++m) { unsigned char* rowp = O + (size_t)(row0 + ai * HALF + m * 16) * 2048 + col0;
#pragma unroll
                for (int bj = 0; bj < 2; ++bj) { const f32x4 a = acc[ai][bj][m][0] * SI, c = acc[ai][bj][m][1] * SI; u32x2 w; w.x = pack4_fp8(a[0], a[1], a[2], a[3]); w.y = pack4_fp8(c[0], c[1], c[2], c[3]);
                    *(u32x2*)(rowp + bj * HALF) = w; } }
    }
};
template <int ROLE> struct MoeOrder {
    int nunits, G, c; const PG8_LAS int* tile_e; unsigned* cnt; unsigned* tmo; int wave;
    __device__ __forceinline__ bool next(int i, Unit& u) const {
        const int cc = (ROLE == 2) ? G - 1 - c : c; int idx;
        if ((G & 7) == 0) { const int per = G >> 3; idx = (i * 8 + (cc & 7)) * per + (cc >> 3); } else idx = i * G + cc;
        if (idx >= nunits) return false;
        const int mt = idx >> 3; u.pm = mt; u.pn = tile_e[mt] * 8 + (idx & 7); return true;
    }
    __device__ __forceinline__ void a_ready(const Unit& u) const {
        if constexpr (ROLE == 2) {
            if (wave == 0) { const bool lane0 = (tid_from_wave(0) == 0);
                const unsigned long long t0 = __builtin_amdgcn_s_memrealtime(); unsigned polls = 0;
                while ((unsigned)__builtin_amdgcn_readfirstlane(__hip_atomic_load(cnt + 64 * u.pm, __ATOMIC_RELAXED, __HIP_MEMORY_SCOPE_AGENT)) < 64u) {
                    if ((++polls & 255u) == 0u && __builtin_amdgcn_readfirstlane(__hip_atomic_load(tmo, __ATOMIC_RELAXED, __HIP_MEMORY_SCOPE_AGENT)) != 0u) break;
                    if (__builtin_amdgcn_s_memrealtime() - t0 > 2000000ull) { if (lane0) __hip_atomic_store(tmo, 1u, __ATOMIC_RELAXED, __HIP_MEMORY_SCOPE_AGENT); break; }
                    __builtin_amdgcn_s_sleep(2); }
                __builtin_amdgcn_fence(__ATOMIC_ACQUIRE, "agent");
                asm volatile("s_waitcnt vmcnt(0)" ::: "memory");
            }
            asm volatile("" ::: "memory"); __builtin_amdgcn_s_barrier(); asm volatile("" ::: "memory");
        }
    }
    __device__ __forceinline__ void done(const Unit& u) const {
        if constexpr (ROLE == 1) {
            asm volatile("s_waitcnt vmcnt(0)" ::: "memory");
            if (tid_from_wave(0) == 0) __hip_atomic_fetch_add(cnt + 64 * u.pm, 1u, __ATOMIC_RELAXED, __HIP_MEMORY_SCOPE_AGENT);
        }
    }
};

template <class Epi, class Sched, bool ALIGN_EPI = false, bool SP2 = false, bool F8 = false, bool F16 = false>
__device__ __forceinline__ void gemm_phase(PG8_LAS unsigned char* lds, const Gemm g, const Sched& S, const Epi& E) {
    int tid_ = tid_from_wave(g.wave); asm volatile("" : "+v"(tid_));
    const int tid = tid_, wid = __builtin_amdgcn_readfirstlane(tid >> 6), lane = tid & 63, wr = wid >> 2, wc = wid & 3, fr = lane & 15, fq = lane >> 4;
    const int K = g.K, LD = g.ld, nt = K / BK;
    unsigned voffA, voffB;
    { int R, C; stage_rc(tid * 16, R, C); const int Rb = Epi::PERM ? ((R & ~31) + perm32(R & 31)) : R;
        voffA = (unsigned)(R * LD + C) * 2u; voffB = (unsigned)(Rb * LD + C) * 2u; }
    const size_t pstep = (size_t)64 * LD * 2;
    const size_t kstep = (size_t)(BK * 2);
    const size_t hstep = (size_t)HALF * LD * 2;
    const size_t tstep = 2 * hstep;
    const unsigned ldsbase = (unsigned)(uintptr_t)lds;
    const unsigned ldsw = (unsigned)wid * 1024u;
    const int aoff = lds_byte(wr * 64 + fr, fq * 8), boff = lds_byte(wc * 32 + fr, fq * 8);
#define PG8_SA(b, h) (((b) * 2 + (h)) * HTB)
#define PG8_SB(b, h) ((4 + (b) * 2 + (h)) * HTB)
#define PG8_STAGE(bufoff, gbase, voff) do { _Pragma("unroll") for (int _i = 0; _i < 2; ++_i) { unsigned keep_; \
        asm volatile("s_mov_b32 %0, m0\n\ts_mov_b32 m0, %3\n\ts_nop 0\n\tglobal_load_lds_dwordx4 %1, %2\n\ts_mov_b32 m0, %0" : "=&s"(keep_) \
            : "v"(voff), "s"((const char*)(gbase) + _i * pstep), "s"(ldsbase + (unsigned)(bufoff) + ldsw + (unsigned)(_i * 8192))); } } while (0)
#define PG8_CAT(a, b) __builtin_bit_cast(pg8_v8i, __builtin_shufflevector(a, b, 0, 1, 2, 3, 4, 5, 6, 7, 8, 9, 10, 11, 12, 13, 14, 15))
#define PG8_LDA(dst, b, h) do { if constexpr (F8) { _Pragma("unroll") for (int m = 0; m < 4; ++m) { const bf16x8 lo_ = *(const PG8_LAS bf16x8*)(lds + PG8_SA(b, h) + aoff + m * 2048), hi_ = *(const PG8_LAS bf16x8*)(lds + PG8_SA(b, h) + aoff + m * 2048 + 1024); dst##8[m] = PG8_CAT(lo_, hi_); } } \
        else { _Pragma("unroll") for (int m = 0; m < 4; ++m) _Pragma("unroll") for (int k = 0; k < 2; ++k) dst[m][k] = *(const PG8_LAS bf16x8*)(lds + PG8_SA(b, h) + aoff + m * 2048 + k * 1024); } } while (0)
#define PG8_LDB(dst, b, h) do { if constexpr (F8) { _Pragma("unroll") for (int n = 0; n < 2; ++n) { const bf16x8 lo_ = *(const PG8_LAS bf16x8*)(lds + PG8_SB(b, h) + boff + n * 2048), hi_ = *(const PG8_LAS bf16x8*)(lds + PG8_SB(b, h) + boff + n * 2048 + 1024); dst##8[n] = PG8_CAT(lo_, hi_); } } \
        else { _Pragma("unroll") for (int n = 0; n < 2; ++n) _Pragma("unroll") for (int k = 0; k < 2; ++k) dst[n][k] = *(const PG8_LAS bf16x8*)(lds + PG8_SB(b, h) + boff + n * 2048 + k * 1024); } } while (0)
#define PG8_MMA(ai, bj, At, Bt) do { __builtin_amdgcn_s_setprio(1); \
        if constexpr (F8) { _Pragma("unroll") for (int m = 0; m < 4; ++m) _Pragma("unroll") for (int n = 0; n < 2; ++n) \
            acc[ai][bj][m][n] = __builtin_amdgcn_mfma_scale_f32_16x16x128_f8f6f4(Bt##8[n], At##8[m], acc[ai][bj][m][n], 0, 0, 0, 0, 0, 0); } \
        else { _Pragma("unroll") for (int m = 0; m < 4; ++m) _Pragma("unroll") for (int n = 0; n < 2; ++n) _Pragma("unroll") for (int k = 0; k < 2; ++k) \
            acc[ai][bj][m][n] = F16 ? __builtin_amdgcn_mfma_f32_16x16x32_f16(__builtin_bit_cast(pg8_h8, Bt[n][k]), __builtin_bit_cast(pg8_h8, At[m][k]), acc[ai][bj][m][n], 0, 0, 0) \
                                    : __builtin_amdgcn_mfma_f32_16x16x32_bf16(Bt[n][k], At[m][k], acc[ai][bj][m][n], 0, 0, 0); } \
        __builtin_amdgcn_s_setprio(0); } while (0)
#define PG8_WAIT_V(n) asm volatile("s_waitcnt vmcnt(" #n ")" ::: "memory")
#define PG8_WAIT_L(n) asm volatile("s_waitcnt lgkmcnt(" #n ")" ::: "memory")
#define PG8_BAR __builtin_amdgcn_s_barrier()
#define PG8_SCHED __builtin_amdgcn_sched_barrier(0)
    Unit cur, nxt; int ui = 0;
    if (!S.next(0, cur)) return;
    f32x4 acc[2][2][4][2];
{ float zero_; asm volatile("v_mov_b32 %0, 0" : "=v"(zero_));
#pragma unroll
    for (int a = 0; a < 2; ++a)
#pragma unroll
        for (int b = 0; b < 2; ++b)
#pragma unroll
            for (int m = 0; m < 4; ++m)
#pragma unroll
                for (int n = 0; n < 2; ++n) acc[a][b][m][n] = (f32x4){zero_, zero_, zero_, zero_}; }
    bf16x8 At[4][2], B0[2][2], B1[2][2]; pg8_v8i At8[4], B08[2], B18[2];
    const char* cA = (const char*)g.A + (size_t)cur.pm * tstep; const char* cB = (const char*)g.Bt + (size_t)cur.pn * tstep;
    S.a_ready(cur);
    if constexpr (SP2) {
        PG8_STAGE(PG8_SB(0, 0), cB, voffB); PG8_STAGE(PG8_SB(0, 1), cB + hstep, voffB); PG8_STAGE(PG8_SA(0, 0), cA, voffA); PG8_STAGE(PG8_SA(0, 1), cA + hstep, voffA);
        if (wr == 1) PG8_BAR;
        PG8_WAIT_V(2); PG8_BAR;
        PG8_STAGE(PG8_SB(1, 0), cB + kstep, voffB); PG8_STAGE(PG8_SA(1, 0), cA + kstep, voffA); PG8_STAGE(PG8_SB(1, 1), cB + hstep + kstep, voffB);
        PG8_WAIT_V(6); PG8_BAR;
    } else {
        PG8_STAGE(PG8_SB(0, 0), cB, voffB); PG8_STAGE(PG8_SA(0, 0), cA, voffA); PG8_STAGE(PG8_SB(0, 1), cB + hstep, voffB); PG8_STAGE(PG8_SA(0, 1), cA + hstep, voffA);
        if (wr == 1) PG8_BAR;
        PG8_WAIT_V(4); PG8_BAR;
        PG8_STAGE(PG8_SB(1, 0), cB + kstep, voffB); PG8_STAGE(PG8_SA(1, 0), cA + kstep, voffA); PG8_STAGE(PG8_SB(1, 1), cB + hstep + kstep, voffB);
        PG8_WAIT_V(6); PG8_BAR;
    }
    for (;;) {
        const bool has_next = S.next(ui + 1, nxt);
        const char* nA = has_next ? (const char*)g.A + (size_t)nxt.pm * tstep : cA; const char* nB = has_next ? (const char*)g.Bt + (size_t)nxt.pn * tstep : cB;
#pragma unroll 1
        for (int t = 0; t < nt; t += 2) {
            const bool last = (t == nt - 2);
            const char* a1 = cA + (size_t)(t + 1) * kstep;
            const char* a2 = last ? nA : cA + (size_t)(t + 2) * kstep; const char* b2 = last ? nB : cB + (size_t)(t + 2) * kstep;
            const char* a3 = a2 + kstep; const char* b3 = b2 + kstep;
            if (last && has_next) S.a_ready(nxt);
            if constexpr (SP2) {
            PG8_LDB(B0, 0, 0); PG8_LDB(B1, 0, 1); PG8_SCHED; PG8_LDA(At, 0, 0); PG8_STAGE(PG8_SA(1, 1), a1 + hstep, voffA);
            PG8_WAIT_V(8); PG8_WAIT_L(0); PG8_BAR; PG8_MMA(0, 0, At, B0); PG8_MMA(0, 1, At, B1); PG8_BAR; PG8_SCHED;
            PG8_LDA(At, 0, 1); PG8_STAGE(PG8_SB(0, 0), b2, voffB); PG8_STAGE(PG8_SB(0, 1), b2 + hstep, voffB); PG8_STAGE(PG8_SA(0, 0), a2, voffA);
            PG8_WAIT_V(8); PG8_WAIT_L(0); PG8_BAR; PG8_MMA(1, 0, At, B0); PG8_MMA(1, 1, At, B1); PG8_BAR; PG8_SCHED;
            PG8_LDB(B0, 1, 0); PG8_LDB(B1, 1, 1); PG8_SCHED; PG8_LDA(At, 1, 0); PG8_STAGE(PG8_SA(0, 1), a2 + hstep, voffA);
            PG8_WAIT_V(8); PG8_WAIT_L(0); PG8_BAR; PG8_MMA(0, 0, At, B0); PG8_MMA(0, 1, At, B1); PG8_BAR; PG8_SCHED;
            PG8_LDA(At, 1, 1); PG8_STAGE(PG8_SB(1, 0), b3, voffB); PG8_STAGE(PG8_SB(1, 1), b3 + hstep, voffB); PG8_STAGE(PG8_SA(1, 0), a3, voffA);
            PG8_WAIT_V(8); PG8_WAIT_L(0); PG8_BAR; PG8_MMA(1, 0, At, B0); PG8_MMA(1, 1, At, B1); PG8_BAR; PG8_SCHED;
            } else {
            PG8_LDB(B0, 0, 0); PG8_SCHED; PG8_LDA(At, 0, 0); PG8_STAGE(PG8_SA(1, 1), a1 + hstep, voffA);
            PG8_WAIT_L(8); PG8_BAR; PG8_WAIT_L(0); PG8_MMA(0, 0, At, B0); PG8_BAR; PG8_SCHED;
            PG8_LDB(B1, 0, 1); PG8_STAGE(PG8_SB(0, 0), b2, voffB);
            PG8_BAR; PG8_WAIT_L(0); PG8_MMA(0, 1, At, B1); PG8_BAR;
            PG8_LDA(At, 0, 1); PG8_STAGE(PG8_SA(0, 0), a2, voffA);
            PG8_BAR; PG8_WAIT_L(0); PG8_MMA(1, 0, At, B0); PG8_BAR; PG8_SCHED;
            PG8_STAGE(PG8_SB(0, 1), b2 + hstep, voffB);
            PG8_WAIT_V(6); PG8_BAR; PG8_MMA(1, 1, At, B1); PG8_BAR;
            PG8_LDB(B0, 1, 0); PG8_SCHED; PG8_LDA(At, 1, 0); PG8_STAGE(PG8_SA(0, 1), a2 + hstep, voffA);
            PG8_WAIT_L(8); PG8_BAR; PG8_WAIT_L(0); PG8_MMA(0, 0, At, B0); PG8_BAR; PG8_SCHED;
            PG8_LDB(B1, 1, 1); PG8_STAGE(PG8_SB(1, 0), b3, voffB);
            PG8_BAR; PG8_WAIT_L(0); PG8_MMA(0, 1, At, B1); PG8_BAR;
            PG8_LDA(At, 1, 1); PG8_STAGE(PG8_SA(1, 0), a3, voffA);
            PG8_BAR; PG8_WAIT_L(0); PG8_MMA(1, 0, At, B0); PG8_BAR; PG8_SCHED;
            PG8_STAGE(PG8_SB(1, 1), b3 + hstep, voffB);
            PG8_WAIT_V(6); PG8_BAR; PG8_MMA(1, 1, At, B1); PG8_BAR;
            }
        }
        if constexpr (ALIGN_EPI) { if (wr == 0) PG8_BAR; }
        if constexpr (!Epi::AFTER_DRAIN) { const int t2_ = tid_from_wave(g.wave);
            E(acc, cur, wr, wc, t2_ & 15, (t2_ >> 4) & 3); S.done(cur); }
        if (!has_next) break;
{ float zero_; asm volatile("v_mov_b32 %0, 0" : "=v"(zero_));
#pragma unroll
        for (int a = 0; a < 2; ++a)
#pragma unroll
            for (int b = 0; b < 2; ++b)
#pragma unroll
                for (int m = 0; m < 4; ++m)
#pragma unroll
                    for (int n = 0; n < 2; ++n) acc[a][b][m][n] = (f32x4){zero_, zero_, zero_, zero_}; }
        cur = nxt; cA = nA; cB = nB; ++ui;
        if constexpr (ALIGN_EPI) { if (wr == 1) PG8_BAR; }
    }
    PG8_WAIT_V(0);
    if constexpr (!ALIGN_EPI) { if (wr == 0) PG8_BAR; }
    PG8_BAR;
    if constexpr (Epi::AFTER_DRAIN) { E.fused(acc, cur, wr, wc, fr, fq, lds, wid, lane); S.done(cur); }
#undef PG8_SA
#undef PG8_SB
#undef PG8_STAGE
#undef PG8_LDA
#undef PG8_LDB
#undef PG8_MMA
#undef PG8_CAT
#undef PG8_WAIT_V
#undef PG8_WAIT_L
#undef PG8_BAR
#undef PG8_SCHED
}
}

namespace att {
#define ALAS __attribute__((address_space(3)))
typedef unsigned short bf16_t;
typedef short bf16x8 __attribute__((ext_vector_type(8)));
typedef short s16x4 __attribute__((ext_vector_type(4)));
typedef float f32x16 __attribute__((ext_vector_type(16)));
typedef float f32x4 __attribute__((ext_vector_type(4)));
typedef unsigned u32x4 __attribute__((ext_vector_type(4)));
typedef ALAS char* ldsp;
#ifndef WO_F8
#define WO_F8 1
#endif
constexpr float OB8_SCALE = 8.f;
constexpr int QP = 6144;
constexpr int OP = 2048;
constexpr int OBP = 2048;
constexpr int SHM_V = 16384, SHM_K = 16384;
constexpr int LDS_V = 0, LDS_K = 2 * SHM_V, LDS_WS = LDS_K + 2 * SHM_K, ATT_LDS_BYTES = LDS_WS + 8 * 256;
#define KSWZ(row, colB) ((row) * 256 + ((colB) ^ (((row) & 7) << 4)))
#define KSWZ64(row, colB) ((row) * 128 + ((colB) ^ (((row) & 7) << 4)))
#define SBAR() __builtin_amdgcn_sched_barrier(0)
__device__ __forceinline__ int v_st(int k, int c) { const int kk = (k & ~0xC) | ((k & 4) << 1) | ((k & 8) >> 1); return ((kk >> 3) * 4 + (c >> 5)) * 512 + ((kk & 7) * 32 + (c & 31)) * 2; }
__device__ __forceinline__ int v_rd_base(int lane) { return ((lane & 3) << 3) | (((lane >> 2) & 3) << 6) | (((lane >> 4) & 1) << 5) | (((lane >> 5) & 1) << 8); }
constexpr int v_rd_off(int d0, int ks, int half) { return d0 * 512 + ks * 4096 + half * 2048; }
__device__ __forceinline__ int crow(int r, int hi) { return (r & 3) + 8 * (r >> 2) + 4 * hi; }
__device__ __forceinline__ unsigned cvtpk(float lo, float hi) { unsigned r; asm volatile("v_cvt_pk_bf16_f32 %0, %1, %2" : "=v"(r) : "v"(lo), "v"(hi)); return r; }
__device__ __forceinline__ bf16x8 ldg8(const bf16_t* p) { return *reinterpret_cast<const bf16x8*>(p); }
__device__ __forceinline__ unsigned quad_pack_fp8(float v) {
    const int b = __builtin_bit_cast(int, v);
    const float v1 = __builtin_bit_cast(float, __builtin_amdgcn_update_dpp(b, b, 0x55, 0xf, 0xf, false));
    const float v2 = __builtin_bit_cast(float, __builtin_amdgcn_update_dpp(b, b, 0xAA, 0xf, 0xf, false));
    const float v3 = __builtin_bit_cast(float, __builtin_amdgcn_update_dpp(b, b, 0xFF, 0xf, 0xf, false));
    int w; asm volatile("" : "=v"(w));
    w = __builtin_amdgcn_cvt_pk_fp8_f32(v, v1, w, false); w = __builtin_amdgcn_cvt_pk_fp8_f32(v2, v3, w, true); return (unsigned)w;
}
__device__ __forceinline__ float xhalf(float v, int hi) {
    auto rr = __builtin_amdgcn_permlane32_swap(__float_as_uint(v), __float_as_uint(v), false, false);
    return __uint_as_float(hi ? rr[0] : rr[1]);
}
#define ATT_PK4(P, B_, OUT) do { unsigned a0 = cvtpk(P[B_+0], P[B_+1]), a1 = cvtpk(P[B_+2], P[B_+3]);                      \
        unsigned b0 = cvtpk(P[B_+4], P[B_+5]), b1 = cvtpk(P[B_+6], P[B_+7]);                                             \
        auto r0 = __builtin_amdgcn_permlane32_swap(a0, b0, false, false); auto r1 = __builtin_amdgcn_permlane32_swap(a1, b1, false, false); \
        u32x4 w = {r0[0], r1[0], r0[1], r1[1]}; OUT = *reinterpret_cast<bf16x8*>(&w); } while (0)
__device__ __forceinline__ void pv_tile(f32x16* o, int vb, bf16x8 pa0, bf16x8 pa1, bf16x8 pa2, bf16x8 pa3) {
#define TRRD(dst, off) asm volatile("ds_read_b64_tr_b16 %0, %1 offset:%2" : "=&v"(dst) : "v"(vb), "i"(off) : "memory")
#define PV_D0(d0) do { s16x4 l0, l1, l2, l3, h0, h1, h2, h3; constexpr int b_ = v_rd_off(d0, 0, 0); \
        TRRD(l0, b_); TRRD(h0, b_ + 2048); TRRD(l1, b_ + 4096); TRRD(h1, b_ + 6144); TRRD(l2, b_ + 8192); TRRD(h2, b_ + 10240); TRRD(l3, b_ + 12288); TRRD(h3, b_ + 14336); \
        asm volatile("s_waitcnt lgkmcnt(0)" ::: "memory"); SBAR(); \
        o[d0] = __builtin_amdgcn_mfma_f32_32x32x16_bf16(pa0, (bf16x8){l0[0], l0[1], l0[2], l0[3], h0[0], h0[1], h0[2], h0[3]}, o[d0], 0, 0, 0);   \
        o[d0] = __builtin_amdgcn_mfma_f32_32x32x16_bf16(pa1, (bf16x8){l1[0], l1[1], l1[2], l1[3], h1[0], h1[1], h1[2], h1[3]}, o[d0], 0, 0, 0);   \
        o[d0] = __builtin_amdgcn_mfma_f32_32x32x16_bf16(pa2, (bf16x8){l2[0], l2[1], l2[2], l2[3], h2[0], h2[1], h2[2], h2[3]}, o[d0], 0, 0, 0);   \
        o[d0] = __builtin_amdgcn_mfma_f32_32x32x16_bf16(pa3, (bf16x8){l3[0], l3[1], l3[2], l3[3], h3[0], h3[1], h3[2], h3[3]}, o[d0], 0, 0, 0); } while (0)
    PV_D0(0); PV_D0(1); PV_D0(2); PV_D0(3);
#undef PV_D0
#undef TRRD
}

__device__ __forceinline__ void sb_block(const bf16_t* __restrict__ Qg, const bf16_t* __restrict__ Kg, const bf16_t* __restrict__ Vg, bf16_t* __restrict__ Og, int qb, ldsp lds, int wave_) {
    int tid_ = tid_from_wave(wave_); asm volatile("" : "+v"(tid_));
    const int tid = tid_, wid = __builtin_amdgcn_readfirstlane(tid >> 6), lane = tid & 63, r32 = lane & 31, hi = lane >> 5;
    const int NT = 4 * qb + 4, R0 = 256 * qb + 32 * wid, myrow = R0 + r32;
    const ldsp V_lds = lds + LDS_V; const ldsp K_lds = lds + LDS_K;
    bf16x8 qr[8];
    { const bf16_t* Qw = Qg + (size_t)R0 * QP; const unsigned qoff = (unsigned)(r32 * QP + hi * 8);
#pragma unroll
      for (int d0 = 0; d0 < 8; ++d0) qr[d0] = ldg8(Qw + (qoff + d0 * 16)); }
    const int sr = tid >> 4, sc = (tid & 15) * 8, kws = KSWZ(sr, sc * 2), vst0 = v_st(sr, sc), vst1 = v_st(32 + sr, sc);
    const unsigned kvoff = (unsigned)(sr * QP + sc);
    const int vb0 = (int)(unsigned)(uintptr_t)V_lds + v_rd_base(lane);
    bf16x8 sk0, sk1, sv0, sv1;
#define SB_LOAD(j) do { const bf16_t* kp_ = Kg + (size_t)(64 * (j)) * QP; const bf16_t* vp_ = Vg + (size_t)(64 * (j)) * QP; \
        sk0 = ldg8(kp_ + kvoff); sk1 = ldg8(kp_ + (size_t)32 * QP + kvoff); sv0 = ldg8(vp_ + kvoff); sv1 = ldg8(vp_ + (size_t)32 * QP + kvoff); } while (0)
#define SB_WRITE(bf) do { *(ALAS bf16x8*)(K_lds + (bf) * SHM_K + kws) = sk0; *(ALAS bf16x8*)(K_lds + (bf) * SHM_K + kws + 32 * 256) = sk1; \
        *(ALAS bf16x8*)(V_lds + (bf) * SHM_V + vst0) = sv0; *(ALAS bf16x8*)(V_lds + (bf) * SHM_V + vst1) = sv1; } while (0)
    SB_LOAD(NT - 1); SB_WRITE(0);
    __syncthreads();
    float carry = 0.f; f32x16 o[4] = {};
    ALAS int* fl = (ALAS int*)(lds + LDS_WS); bool wdone = false;
    for (int t = 0; t < NT; ++t) {
        const int j = NT - 1 - t, buf = t & 1, kb = 64 * j;
        if (t + 1 < NT) SB_LOAD(j - 1);
        if (kb <= R0 + 30 && !wdone) {
            f32x16 p0 = {}, p1 = {};
            { const ldsp Kb = K_lds + buf * SHM_K;
#pragma unroll
              for (int d0 = 0; d0 < 8; ++d0) { const ldsp a = Kb + KSWZ(r32, ((d0 & 3) * 16 + hi * 8) * 2) + (d0 >> 2) * 128;
                  const bf16x8 b0 = *(const ALAS bf16x8*)a, b1 = *(const ALAS bf16x8*)(a + 32 * 256);
                  p0 = __builtin_amdgcn_mfma_f32_32x32x16_bf16(b0, qr[d0], p0, 0, 0, 0);
                  p1 = __builtin_amdgcn_mfma_f32_32x32x16_bf16(b1, qr[d0], p1, 0, 0, 0); } }
            f32x16 lb0, lb1;
#pragma unroll
            for (int r = 0; r < 16; ++r) {
                { const float z = p0[r]; const float e = __builtin_amdgcn_exp2f(-__builtin_fabsf(z)); const float sp = __builtin_fmaxf(z, 0.f) + __builtin_amdgcn_logf(1.f + e); p0[r] = -sp; lb0[r] = z - sp; }
                { const float z = p1[r]; const float e = __builtin_amdgcn_exp2f(-__builtin_fabsf(z)); const float sp = __builtin_fmaxf(z, 0.f) + __builtin_amdgcn_logf(1.f + e); p1[r] = -sp; lb1[r] = z - sp; }
            }
            if (kb + 63 >= R0) {
                const int dq = myrow - kb - 4 * hi; const float NEG = -__builtin_inff();
#pragma unroll
                for (int r = 0; r < 16; ++r) { const int c = (r & 3) + 8 * (r >> 2);
                    if (c >= dq) { p0[r] = 0.f; lb0[r] = NEG; }
                    if (c + 32 >= dq) { p1[r] = 0.f; lb1[r] = NEG; } }
            }
            float gs[8], go[8];
#pragma unroll
            for (int g = 0; g < 4; ++g) { gs[g] = (p0[4 * g] + p0[4 * g + 1]) + (p0[4 * g + 2] + p0[4 * g + 3]); gs[4 + g] = (p1[4 * g] + p1[4 * g + 1]) + (p1[4 * g + 2] + p1[4 * g + 3]); }
#pragma unroll
            for (int i = 0; i < 8; ++i) go[i] = xhalf(gs[i], hi);
            float acc = carry;
#pragma unroll
            for (int idx = 7; idx >= 0; --idx) { const int g = idx & 3; const float base = acc + (hi ? 0.f : go[idx]);
                if (idx >= 4) { const float t3 = base, t2 = t3 + p1[4 * g + 3], t1 = t2 + p1[4 * g + 2], t0 = t1 + p1[4 * g + 1];
                    lb1[4 * g + 3] = __builtin_amdgcn_exp2f(lb1[4 * g + 3] + t3); lb1[4 * g + 2] = __builtin_amdgcn_exp2f(lb1[4 * g + 2] + t2);
                    lb1[4 * g + 1] = __builtin_amdgcn_exp2f(lb1[4 * g + 1] + t1); lb1[4 * g] = __builtin_amdgcn_exp2f(lb1[4 * g] + t0); }
                else { const float t3 = base, t2 = t3 + p0[4 * g + 3], t1 = t2 + p0[4 * g + 2], t0 = t1 + p0[4 * g + 1];
                    lb0[4 * g + 3] = __builtin_amdgcn_exp2f(lb0[4 * g + 3] + t3); lb0[4 * g + 2] = __builtin_amdgcn_exp2f(lb0[4 * g + 2] + t2);
                    lb0[4 * g + 1] = __builtin_amdgcn_exp2f(lb0[4 * g + 1] + t1); lb0[4 * g] = __builtin_amdgcn_exp2f(lb0[4 * g] + t0); }
                acc += gs[idx] + go[idx]; }
            carry = acc;
            bf16x8 pa0, pa1, pa2, pa3;
            ATT_PK4(lb0, 0, pa0); ATT_PK4(lb0, 8, pa1); ATT_PK4(lb1, 0, pa2); ATT_PK4(lb1, 8, pa3);
            SBAR();
            pv_tile(o, vb0 + buf * SHM_V, pa0, pa1, pa2, pa3);
            wdone = __all(carry < -127.f);
        }
        if (lane == 0) fl[buf * 8 + wid] = wdone ? 1 : 0;
        if (t + 1 < NT) SB_WRITE(buf ^ 1);
        __syncthreads();
        { const ALAS int* f = fl + buf * 8; if ((f[0] & f[1] & f[2] & f[3] & f[4] & f[5] & f[6] & f[7]) != 0) break; }
    }
#undef SB_LOAD
#undef SB_WRITE
#if WO_F8
    unsigned char* Ow = (unsigned char*)Og + (size_t)R0 * OBP; const unsigned ooff = (unsigned)(4 * hi * OBP + r32);
#pragma unroll
    for (int r = 0; r < 16; ++r) { unsigned char* rowp = Ow + (size_t)((r & 3) + 8 * (r >> 2)) * OBP;
#pragma unroll
        for (int d0 = 0; d0 < 4; ++d0) { const unsigned w = quad_pack_fp8(o[d0][r] * OB8_SCALE);
            if ((r32 & 3) == 0) *(unsigned*)(rowp + (ooff + d0 * 32)) = w; } }
#else
    bf16_t* Ow = Og + (size_t)R0 * OP; const unsigned ooff = (unsigned)(4 * hi * OP + r32);
#pragma unroll
    for (int r = 0; r < 16; ++r) { bf16_t* rowp = Ow + (size_t)((r & 3) + 8 * (r >> 2)) * OP;
#pragma unroll
        for (int d0 = 0; d0 < 4; ++d0) { const float v = o[d0][r]; const float vn = __shfl_xor(v, 1);
            if ((r32 & 1) == 0) *(unsigned*)(rowp + (ooff + d0 * 32)) = cvtpk(v, vn); } }
#endif
}

constexpr float ATT_THR = 8.f;
__device__ __forceinline__ void qkt64(f32x16& p0, f32x16& p1, ldsp Kb, int r32, int hi, const bf16x8* qr) {
    p0 = f32x16{}; p1 = f32x16{};
#pragma unroll
    for (int d0 = 0; d0 < 4; ++d0) { const ldsp a = Kb + KSWZ64(r32, (d0 * 16 + hi * 8) * 2);
        const bf16x8 b0 = *(const ALAS bf16x8*)a, b1 = *(const ALAS bf16x8*)(a + 32 * 128);
        p0 = __builtin_amdgcn_mfma_f32_32x32x16_bf16(b0, qr[d0], p0, 0, 0, 0);
        p1 = __builtin_amdgcn_mfma_f32_32x32x16_bf16(b1, qr[d0], p1, 0, 0, 0); }
}
__device__ __forceinline__ void partial_sm(f32x16& p0, f32x16& p1, float& m_reg, float& alpha, int hi) {
    float pmax = p0[0];
#pragma unroll
    for (int r = 1; r < 16; ++r) pmax = __builtin_fmaxf(pmax, p0[r]);
#pragma unroll
    for (int r = 0; r < 16; ++r) pmax = __builtin_fmaxf(pmax, p1[r]);
    pmax = __builtin_fmaxf(pmax, xhalf(pmax, hi));
    float mn;
    if (__builtin_expect(__all(pmax - m_reg <= ATT_THR), 1)) { mn = m_reg; alpha = 1.f; }
    else { mn = __builtin_fmaxf(m_reg, pmax); alpha = __builtin_amdgcn_exp2f(m_reg - mn); m_reg = mn; }
#pragma unroll
    for (int r = 0; r < 16; ++r) { p0[r] -= mn; p1[r] -= mn; }
#pragma unroll
    for (int r = 0; r < 16; ++r) p0[r] = __builtin_amdgcn_exp2f(p0[r]);
}
__device__ __forceinline__ void finish_sm(f32x16& p0, f32x16& p1, float alpha, float& l_reg, bf16x8& pa0, bf16x8& pa1, bf16x8& pa2, bf16x8& pa3, int hi) {
#pragma unroll
    for (int r = 0; r < 16; ++r) p1[r] = __builtin_amdgcn_exp2f(p1[r]);
    float ps = 0.f;
#pragma unroll
    for (int r = 0; r < 16; ++r) ps += p0[r];
#pragma unroll
    for (int r = 0; r < 16; ++r) ps += p1[r];
    ps += xhalf(ps, hi);
    l_reg = l_reg * alpha + ps;
    ATT_PK4(p0, 0, pa0); ATT_PK4(p0, 8, pa1); ATT_PK4(p1, 0, pa2); ATT_PK4(p1, 8, pa3);
}
__device__ __forceinline__ void mask_gt(f32x16& p0, f32x16& p1, int dq) {
    const float NEG = -__builtin_inff();
#pragma unroll
    for (int r = 0; r < 16; ++r) { const int c = (r & 3) + 8 * (r >> 2);
        if (c > dq) p0[r] = NEG;
        if (c + 32 > dq) p1[r] = NEG; }
}
template <bool SECOND>
__device__ __forceinline__ void diff_pass(const bf16_t* __restrict__ Qg, const bf16_t* __restrict__ Kg, const bf16_t* __restrict__ Vg, float* S1, bf16_t* __restrict__ Og,
                                          int qb, float lam, const float* __restrict__ gsub, float gmul, ldsp lds, int wave_) {
    int tid_ = tid_from_wave(wave_); asm volatile("" : "+v"(tid_));
    const int tid = tid_, wid = __builtin_amdgcn_readfirstlane(tid >> 6), lane = tid & 63, r32 = lane & 31, hi = lane >> 5;
    const int NT = 4 * qb + 4, R0 = 256 * qb + 32 * wid, myrow = R0 + r32;
    const ldsp V_lds = lds + LDS_V; const ldsp K_lds = lds + LDS_K;
    ALAS float* wsf = (ALAS float*)(lds + LDS_WS) + wid * 64; ALAS float* li_l = wsf; ALAS float* al_l = wsf + 32;
    bf16x8 qr[4];
    { const bf16_t* Qw = Qg + (size_t)R0 * QP; const unsigned qoff = (unsigned)(r32 * QP + hi * 8);
#pragma unroll
      for (int d0 = 0; d0 < 4; ++d0) qr[d0] = ldg8(Qw + (qoff + d0 * 16)); }
    const int sr = tid >> 4, sc = (tid & 15) * 8, vst0 = v_st(sr, sc), vst1 = v_st(32 + sr, sc);
    const int kr = tid >> 3, kc = (tid & 7) * 8, kws = KSWZ64(kr, kc * 2);
    const unsigned voff = (unsigned)(sr * QP + sc), koff = (unsigned)(kr * QP + kc);
    const int vb0 = (int)(unsigned)(uintptr_t)V_lds + v_rd_base(lane);
    const int qm = myrow - 4 * hi;
    bf16x8 sk0A, sv0A, sv1A, sk0B, sv0B, sv1B;
#define DF_LOAD(S_, j) do { const bf16_t* vp_ = Vg + (size_t)(64 * (j)) * QP; sk0##S_ = ldg8(Kg + (size_t)(64 * (j)) * QP + koff); sv0##S_ = ldg8(vp_ + voff); sv1##S_ = ldg8(vp_ + (size_t)32 * QP + voff); } while (0)
#define DF_WRITE(S_, bf) do { *(ALAS bf16x8*)(K_lds + (bf) * SHM_K + kws) = sk0##S_; *(ALAS bf16x8*)(V_lds + (bf) * SHM_V + vst0) = sv0##S_; *(ALAS bf16x8*)(V_lds + (bf) * SHM_V + vst1) = sv1##S_; } while (0)
#define DF_MASK(P0, P1, t) do { if (64 * (t) + 63 > R0) mask_gt(P0, P1, qm - 64 * (t)); } while (0)
#define DF_RESC(a) do { if (__any((a) < 1.f)) { if (hi == 0) al_l[r32] = (a); asm volatile("s_waitcnt lgkmcnt(0)" ::: "memory"); \
        _Pragma("unroll") for (int d_ = 0; d_ < 4; ++d_) _Pragma("unroll") for (int r = 0; r < 16; ++r) o[d_][r] *= al_l[crow(r, hi)]; } } while (0)
    float m_reg = -1e30f, l_reg = 0.f; f32x16 o[4] = {};
    f32x16 pA0, pA1, pB0, pB1; float alA = 1.f, alB = 1.f; bf16x8 pa0, pa1, pa2, pa3;
    DF_LOAD(A, 0); DF_WRITE(A, 0);
    __syncthreads();
    DF_LOAD(A, 1); DF_LOAD(B, 2);
    qkt64(pA0, pA1, K_lds, r32, hi, qr); DF_MASK(pA0, pA1, 0); partial_sm(pA0, pA1, m_reg, alA, hi);
    DF_WRITE(A, 1);
    DF_RESC(alA);
    __syncthreads();
#define DF_HALF(PX0, PX1, alX, PY0, PY1, alY, t, KB, VB, SB, LS, WS) do { \
        SBAR(); qkt64(PX0, PX1, K_lds + (KB) * SHM_K, r32, hi, qr); \
        finish_sm(PY0, PY1, alY, l_reg, pa0, pa1, pa2, pa3, hi); SBAR(); \
        if ((t) + 2 < NT) { DF_LOAD(LS, (t) + 2); SBAR(); } \
        pv_tile(o, vb0 + (VB) * SHM_V, pa0, pa1, pa2, pa3); DF_MASK(PX0, PX1, (t)); partial_sm(PX0, PX1, m_reg, alX, hi); \
        __syncthreads(); \
        if ((t) + 1 < NT) DF_WRITE(WS, SB); \
        DF_RESC(alX); __syncthreads(); } while (0)
    for (int t = 1; t + 1 < NT; t += 2) {
        DF_HALF(pB0, pB1, alB, pA0, pA1, alA, t, 1, 0, 0, A, B);
        DF_HALF(pA0, pA1, alA, pB0, pB1, alB, t + 1, 0, 1, 1, B, A);
    }
    DF_HALF(pB0, pB1, alB, pA0, pA1, alA, NT - 1, 1, 0, 0, A, B);
    finish_sm(pB0, pB1, alB, l_reg, pa0, pa1, pa2, pa3, hi); SBAR();
    pv_tile(o, vb0 + 1 * SHM_V, pa0, pa1, pa2, pa3);
#undef DF_LOAD
#undef DF_WRITE
#undef DF_MASK
#undef DF_RESC
#undef DF_HALF
    if (hi == 0) li_l[r32] = l_reg; asm volatile("s_waitcnt lgkmcnt(0)" ::: "memory");
    float rli[16];
#pragma unroll
    for (int r = 0; r < 16; ++r) rli[r] = __builtin_amdgcn_rcpf(li_l[crow(r, hi)]);
    if constexpr (!SECOND) {
        float* Sw = S1 + (size_t)R0 * OP; const unsigned ooff = (unsigned)(4 * hi * OP + r32);
#pragma unroll
        for (int r = 0; r < 16; ++r) { float* rowp = Sw + (size_t)((r & 3) + 8 * (r >> 2)) * OP;
#pragma unroll
            for (int d0 = 0; d0 < 4; ++d0) rowp[ooff + d0 * 32] = o[d0][r] * rli[r]; }
    } else {
        const float* Sw = S1 + (size_t)R0 * OP; bf16_t* Ow = Og + (size_t)R0 * OP; (void)Ow; const unsigned ooff = (unsigned)(4 * hi * OP + r32), ooff8 = (unsigned)(4 * hi * OBP + r32);
        float gn[4];
#pragma unroll
        for (int d0 = 0; d0 < 4; ++d0) gn[d0] = gsub[d0 * 32 + r32] * gmul;
#pragma unroll
        for (int r = 0; r < 16; ++r) { const float* srow = Sw + (size_t)((r & 3) + 8 * (r >> 2)) * OP; float d[4]; float ss = 0.f;
#if WO_F8
            unsigned char* orowp = (unsigned char*)Og + (size_t)(R0 + (r & 3) + 8 * (r >> 2)) * OBP;
#else
            bf16_t* orowp = Ow + (size_t)((r & 3) + 8 * (r >> 2)) * OP;
#endif
#pragma unroll
            for (int d0 = 0; d0 < 4; ++d0) { d[d0] = srow[ooff + d0 * 32] - lam * (o[d0][r] * rli[r]); ss += d[d0] * d[d0]; }
            ss += __builtin_bit_cast(float, __builtin_amdgcn_update_dpp(0, __builtin_bit_cast(int, ss), 0xB1, 0xf, 0xf, true));
            ss += __builtin_bit_cast(float, __builtin_amdgcn_update_dpp(0, __builtin_bit_cast(int, ss), 0x4E, 0xf, 0xf, true));
            ss += __builtin_bit_cast(float, __builtin_amdgcn_update_dpp(0, __builtin_bit_cast(int, ss), 0x141, 0xf, 0xf, true));
            ss += __builtin_bit_cast(float, __builtin_amdgcn_update_dpp(0, __builtin_bit_cast(int, ss), 0x140, 0xf, 0xf, true));
            { auto rr = __builtin_amdgcn_permlane16_swap(__float_as_uint(ss), __float_as_uint(ss), false, false); ss = __uint_as_float(rr[0]) + __uint_as_float(rr[1]); }
            const float rs = __builtin_amdgcn_rsqf(ss * (1.f / 128.f) + 1e-5f);
#pragma unroll
#if WO_F8
            for (int d0 = 0; d0 < 4; ++d0) { const unsigned w = quad_pack_fp8(d[d0] * rs * gn[d0] * OB8_SCALE);
                if ((r32 & 3) == 0) *(unsigned*)(orowp + (ooff8 + d0 * 32)) = w; }
#else
            for (int d0 = 0; d0 < 4; ++d0) { const float v = d[d0] * rs * gn[d0]; const float vn = __shfl_xor(v, 1);
                if ((r32 & 1) == 0) *(unsigned*)(orowp + (ooff + d0 * 32)) = cvtpk(v, vn); }
#endif
            if ((r & 1) == 1) asm volatile("" ::: "memory"); }
    }
    __syncthreads();
}
#undef SBAR
}

#define LAS __attribute__((address_space(3)))

#define XB_TMO      128
#define XB_XCNT(j)  (256  + 64 * (j))
#define XB_XSUB(j)  (1280 + 64 * (j))
#define XB_XGEN(j)  (2304 + 64 * (j))
#define XB_TOP      3328
#define XB_TOPGEN   3392
#define XCD_BAR_WORDS 3456
#define XB_SPIN_CAP (1u << 18)

__device__ __forceinline__ unsigned xb_ld(unsigned* p)              { return __hip_atomic_load(p, __ATOMIC_RELAXED, __HIP_MEMORY_SCOPE_AGENT); }
__device__ __forceinline__ unsigned xb_add(unsigned* p, unsigned v) { return __hip_atomic_fetch_add(p, v, __ATOMIC_RELAXED, __HIP_MEMORY_SCOPE_AGENT); }
__device__ __forceinline__ unsigned xb_xcc_id() { return (unsigned)__builtin_amdgcn_s_getreg((3 << 11) | 20) & 0xFu; }
#define XB_SPIN(cond, bar) do { unsigned _sp = 0; while (cond) { __builtin_amdgcn_s_sleep(1); \
    if ((++_sp & 255u) == 0u) { if (xb_ld(&(bar)[XB_TMO])) break; if (_sp > XB_SPIN_CAP) { atomicAdd(&(bar)[XB_TMO], 1u); break; } } } } while (0)

struct XcdBarrier {
    unsigned* bar; unsigned x;
    volatile LAS unsigned* st;
};

__device__ __forceinline__ XcdBarrier xcd_barrier_post(unsigned* bar, volatile LAS unsigned* st, bool thread0) {
    XcdBarrier b; b.bar = bar; b.x = xb_xcc_id(); b.st = st;
    if (thread0) (void)xb_add(&bar[XB_XCNT(b.x)], 1u);
    return b;
}
__device__ __forceinline__ void xcd_barrier_complete(unsigned* bar, unsigned x, unsigned& nloc, unsigned& nx) {
    const unsigned G = gridDim.x * gridDim.y * gridDim.z;
    unsigned sum, cnt, mine, sp = 0u;
    for (;;) {
        sum = 0u; cnt = 0u; mine = 0u;
#pragma unroll
        for (unsigned j = 0; j < 16; ++j) { const unsigned c = xb_ld(&bar[XB_XCNT(j)]); sum += c; cnt += (c > 0u) ? 1u : 0u; mine = (j == x) ? c : mine; }
        if (sum == G) break;
        __builtin_amdgcn_s_sleep(1);
        if ((++sp & 255u) == 0u) { if (xb_ld(&bar[XB_TMO])) break; if (sp > XB_SPIN_CAP) { atomicAdd(&bar[XB_TMO], 1u); break; } }
    }
    nloc = mine > 0u ? mine : 1u; nx = cnt > 0u ? cnt : 1u;
}

__device__ __forceinline__ void xcd_barrier(const XcdBarrier& b, bool thread0) {
    asm volatile("s_waitcnt vmcnt(0)" ::: "memory");
    __syncthreads();
    if (thread0) {
        unsigned* bar = b.bar;
        __builtin_amdgcn_s_waitcnt(0);
        unsigned nloc = b.st[0], nx = b.st[1];
        if (nloc == 0u) { xcd_barrier_complete(bar, b.x, nloc, nx); b.st[0] = nloc; b.st[1] = nx; }
        const unsigned old = xb_add(&bar[XB_XSUB(b.x)], 1u);
        const unsigned gen = old / nloc;
        if (old + 1u == (gen + 1u) * nloc) {
            __builtin_amdgcn_fence(__ATOMIC_RELEASE, "agent");
            asm volatile("s_waitcnt vmcnt(0)" ::: "memory");
            const unsigned og = xb_add(&bar[XB_TOP], 1u);
            const unsigned tg = og / nx;
            if (og + 1u == (tg + 1u) * nx) xb_add(&bar[XB_TOPGEN], 1u);
            else XB_SPIN(xb_ld(&bar[XB_TOPGEN]) == tg, bar);
            __builtin_amdgcn_fence(__ATOMIC_ACQUIRE, "agent");
            xb_add(&bar[XB_XGEN(b.x)], 1u);
            asm volatile("s_waitcnt vmcnt(0)" ::: "memory");
        } else {
            XB_SPIN(xb_ld(&bar[XB_XGEN(b.x)]) == gen, bar);
            __builtin_amdgcn_fence(__ATOMIC_ACQUIRE, "agent");
            asm volatile("s_waitcnt vmcnt(0)" ::: "memory");
        }
    }
    __syncthreads();
}

constexpr int NWAVES = 8;
constexpr int NTOK = 16384, DM = 2048, SEQ = 2048, NHEAD = 16, NLAYER = 4, NEXP = 16, DEXP = 1024;
constexpr int XS_ROWS = 36864;
constexpr float LN_EPS = 1e-5f;
constexpr float DN_ALPHA = 1.6817928305074292f;
constexpr float LOG2E = 1.4426950408889634f;
constexpr float SB_QSCALE = 0.08838834764831845f * LOG2E;
constexpr float DF_QSCALE = 0.125f * LOG2E;
#ifndef MK_MULTI
#define MK_MULTI 0
#endif
#ifndef MOE_F8
#define MOE_F8 1
#endif
#ifndef QKV8_A
#define QKV8_A 1
#endif
#ifndef QKV8_B
#define QKV8_B 0
#endif
constexpr int NSTEPS = 1 + 8 * NLAYER;

constexpr size_t MiB = 1u << 20;
constexpr size_t WS_CTL = 0, CTL_ZERO_BYTES = 256 * 1024;
constexpr size_t WS_COS = 1 * MiB, WS_SIN = WS_COS + 256 * 1024;
constexpr size_t WS_WR = 2 * MiB;
constexpr size_t WS_CNT = 3 * MiB;
constexpr size_t WS_RE = WS_CNT + 64 * 1024;
constexpr size_t WS_RW = WS_RE + 64 * 1024;
constexpr size_t WS_RP = WS_RW + 128 * 1024;
constexpr int LDH = 2048;
constexpr int P8K2 = 2048, P8K1 = 1024;
constexpr size_t WS_WQKVA = 4 * MiB;
constexpr size_t WS_WOA = WS_WQKVA + 56 * MiB;
constexpr size_t WS_WQKVB = WS_WOA + 16 * MiB;
constexpr size_t WS_WOB = WS_WQKVB + 36 * MiB;
constexpr size_t WS_WGU = WS_WOB + 16 * MiB;
constexpr size_t WS_WDN = WS_WGU + 512 * MiB;
constexpr size_t WS_H = WS_WDN + 256 * MiB;
constexpr size_t WS_HB = WS_H + 128 * MiB;
constexpr size_t WS_QKV = WS_HB + 68 * MiB;
constexpr size_t WS_OB = WS_QKV + 192 * MiB;
constexpr size_t WS_XS = WS_OB + 64 * MiB;
constexpr size_t WS_ACT = WS_XS + 144 * MiB;
constexpr size_t WS_YD = WS_ACT + 72 * MiB;
constexpr size_t WS_END = WS_YD + 144 * MiB;
static_assert(WS_END <= (size_t)2040 * MiB, "workspace map");
static_assert((size_t)2 * 6144 * LDH * 2 <= 56 * MiB && (size_t)8192 * LDH * 2 <= 36 * MiB && (size_t)2 * 2048 * P8K2 <= 16 * MiB && (size_t)64 * 2048 * P8K2 <= 512 * MiB && (size_t)64 * 2048 * P8K1 <= 256 * MiB, "weight regions");
static_assert((size_t)NTOK * LDH * 2 <= 68 * MiB && (size_t)NTOK * P8K2 <= 64 * MiB && (size_t)XS_ROWS * P8K2 <= 144 * MiB && (size_t)XS_ROWS * P8K1 <= 72 * MiB, "activation regions");
constexpr int CW_MTC = 8192;
constexpr int CW_BAR = 1024;
constexpr int LDS_BYTES = 147456;
constexpr int LDSCTL_OFF = 145408;
constexpr int RING_OFF = 0;
constexpr int LNX_OFF = 131072;

#define GAS __attribute__((address_space(1)))
typedef unsigned short bf16;
typedef unsigned v4u __attribute__((ext_vector_type(4)));
typedef unsigned v2u __attribute__((ext_vector_type(2)));
typedef float f32x4 __attribute__((ext_vector_type(4)));
typedef float f32x2 __attribute__((ext_vector_type(2)));
typedef _Float16 f16x4 __attribute__((ext_vector_type(4)));
__device__ __forceinline__ f32x4 ldh4(const _Float16* p) { return __builtin_convertvector(*(const f16x4*)p, f32x4); }
__device__ __forceinline__ void sth4(_Float16* p, f32x4 v) { __builtin_nontemporal_store(__builtin_convertvector(v, f16x4), (f16x4*)p); }
#define LDS_WAIT() asm volatile("s_waitcnt lgkmcnt(0)" ::: "memory")
#define VM_WAIT() asm volatile("s_waitcnt vmcnt(0)" ::: "memory")
__device__ __forceinline__ unsigned pk2(float lo, float hi) { unsigned r; asm volatile("v_cvt_pk_bf16_f32 %0, %1, %2" : "=v"(r) : "v"(lo), "v"(hi)); return r; }
__device__ __forceinline__ int opq_tid(int wave) { int t = tid_from_wave(wave); asm volatile("" : "+v"(t)); return t; }
__device__ __forceinline__ float dpp_sum(float v) {
    v += __builtin_bit_cast(float, __builtin_amdgcn_update_dpp(0, __builtin_bit_cast(int, v), 0xB1, 0xf, 0xf, true));
    v += __builtin_bit_cast(float, __builtin_amdgcn_update_dpp(0, __builtin_bit_cast(int, v), 0x4E, 0xf, 0xf, true));
    v += __builtin_bit_cast(float, __builtin_amdgcn_update_dpp(0, __builtin_bit_cast(int, v), 0x141, 0xf, 0xf, true));
    v += __builtin_bit_cast(float, __builtin_amdgcn_update_dpp(0, __builtin_bit_cast(int, v), 0x140, 0xf, 0xf, true));
    const int b = __builtin_bit_cast(int, v);
    const float s0 = __builtin_bit_cast(float, __builtin_amdgcn_readlane(b, 0)), s1 = __builtin_bit_cast(float, __builtin_amdgcn_readlane(b, 16));
    const float s2 = __builtin_bit_cast(float, __builtin_amdgcn_readlane(b, 32)), s3 = __builtin_bit_cast(float, __builtin_amdgcn_readlane(b, 48));
    return (s0 + s1) + (s2 + s3);
}
__device__ __forceinline__ float wave_sum(float v) {
#pragma unroll
    for (int o = 1; o < 64; o <<= 1) v += __shfl_xor(v, o);
    return v;
}

struct Args { const float* in[17]; float* out; unsigned char* ws; int s_lo, s_hi; };

__device__ __forceinline__ int map_row(int n, int mode) {
    if (mode == 0) return n;
    if (mode == 1) { const int c = n & 255, blk = c >> 6, d = c & 63; return (n & ~255) + ((d >> 5) << 7) + (blk << 5) + (d & 31); }
    return ((n >> 7) << 8) + (n & 127) + (mode == 3 ? 128 : 0);
}
__device__ __forceinline__ unsigned pk2h(float lo, float hi) { typedef _Float16 h2 __attribute__((ext_vector_type(2))); const f32x2 v = {lo, hi}; return __builtin_bit_cast(unsigned, __builtin_convertvector(v, h2)); }
__device__ __forceinline__ void cvt_load(f32x4 (&v)[16], const float* __restrict__ src, int pitch, int k0, int n0, int kind, int lane) {
    if (kind == 2) { const int kr = lane >> 3, n4 = (lane & 7) * 4; const float* p = src + (size_t)(k0 + kr) * pitch + n0 + n4;
#pragma unroll
        for (int i = 0; i < 16; ++i) v[i] = __builtin_nontemporal_load((const f32x4*)(p + (size_t)(8 * i) * pitch)); }
    else { const int kr = lane >> 4, n4 = (lane & 15) * 4; const float* p = src + (size_t)(k0 + kr) * pitch + n0 + n4;
#pragma unroll
        for (int i = 0; i < 16; ++i) v[i] = __builtin_nontemporal_load((const f32x4*)(p + (size_t)(4 * i) * pitch)); }
}
__device__ __forceinline__ void cvt_store(const f32x4 (&v)[16], unsigned char* __restrict__ dst, int dp, int mode, int k0, int n0, int kind, LAS float* scr, int lane) {
    if (kind == 2) {
        const int kr = lane >> 3, n4 = (lane & 7) * 4;
#pragma unroll
        for (int i = 0; i < 16; ++i) { LAS float* s = scr + (8 * i + kr) * 33 + n4; s[0] = v[i][0] * pg8::W8_SCALE; s[1] = v[i][1] * pg8::W8_SCALE; s[2] = v[i][2] * pg8::W8_SCALE; s[3] = v[i][3] * pg8::W8_SCALE; }
        LDS_WAIT();
        const int c = lane & 7;
#pragma unroll
        for (int j = 0; j < 4; ++j) { const int nl = (lane >> 3) + 8 * j; const int row = map_row(n0 + nl, mode);
            const LAS float* s = scr + (16 * c) * 33 + nl;
            v4u o; o.x = pg8::pack4_fp8(s[0], s[33], s[66], s[99]); o.y = pg8::pack4_fp8(s[132], s[165], s[198], s[231]);
            o.z = pg8::pack4_fp8(s[264], s[297], s[330], s[363]); o.w = pg8::pack4_fp8(s[396], s[429], s[462], s[495]);
            __builtin_nontemporal_store(o, (v4u*)(dst + (size_t)row * dp + k0 + 16 * c)); }
    } else {
        const int kr = lane >> 4, n4 = (lane & 15) * 4;
#pragma unroll
        for (int i = 0; i < 16; ++i) { LAS float* s = scr + (4 * i + kr) * 65 + n4; s[0] = v[i][0]; s[1] = v[i][1]; s[2] = v[i][2]; s[3] = v[i][3]; }
        LDS_WAIT();
        const int c = lane & 7;
#pragma unroll
        for (int j = 0; j < 8; ++j) { const int nl = (lane >> 3) + 8 * j; const int row = map_row(n0 + nl, mode);
            const LAS float* s = scr + (8 * c) * 65 + nl;
            v4u o; o.x = pk2h(s[0], s[65]); o.y = pk2h(s[130], s[195]); o.z = pk2h(s[260], s[325]); o.w = pk2h(s[390], s[455]);
            __builtin_nontemporal_store(o, (v4u*)(dst + (size_t)row * dp + (k0 + 8 * c) * 2)); }
    }
    LDS_WAIT();
}

__global__ void __launch_bounds__(NWAVES * 64, 2) yoco_fwd(Args args) {
    extern __shared__ __attribute__((aligned(16))) unsigned char lds_raw[];
    LAS unsigned char* const lds = (LAS unsigned char*)lds_raw;
    const int tid = threadIdx.x, lane = tid & 63, wave = __builtin_amdgcn_readfirstlane(tid >> 6);
    const int G = gridDim.x, bx = blockIdx.x;
    const int vcu = (G % 8 == 0) ? (bx % 8) * (G / 8) + bx / 8 : bx;
    unsigned char* const ws = args.ws;
    volatile LAS unsigned* const CTL = (volatile LAS unsigned*)(lds + LDSCTL_OFF);
    LAS int* const TAB = (LAS int*)(lds + LDSCTL_OFF + 64);
    for (int u = tid; u < (LDS_BYTES - LDSCTL_OFF) / 4; u += NWAVES * 64) ((LAS unsigned*)(lds + LDSCTL_OFF))[u] = 0u;
    __syncthreads();
    const int s_lo = args.s_lo, s_hi = args.s_hi;
    XcdBarrier bar; bar.bar = (unsigned*)(ws + WS_CTL) + CW_BAR; bar.x = 0; bar.st = nullptr;
    if (s_hi - s_lo > 1) bar = xcd_barrier_post((unsigned*)(ws + WS_CTL) + CW_BAR, CTL, tid == 0);
#ifndef PH_MASK
#define PH_MASK 0xFFFF
#endif
#define PHM(b) (((PH_MASK) >> (b)) & 1)
#ifndef PROBE_DUP
#define PROBE_DUP 0
#endif
#define PREP(b) _Pragma("unroll 1") for (int rep_ = 0; rep_ < ((((PROBE_DUP) >> (b)) & 1) ? 2 : 1); ++rep_) if ((rep_ == 1 && ((PROBE_DUP >> 12) & 1)) ? (xcd_barrier(bar, tid_from_wave(wave) == 0), true) : true)
#define IN(k) (s_lo <= (k) && (k) < s_hi)
#define SEAM(k) do { if ((k) + 1 < s_hi) xcd_barrier(bar, tid_from_wave(wave) == 0); } while (0)

    const float* const x_in = args.in[0];
    _Float16* const H = (_Float16*)(ws + WS_H); unsigned char* const HB8 = (unsigned char*)(ws + WS_OB + 32 * MiB);     bf16* const QKV = (bf16*)(ws + WS_QKV); bf16* const OB = (bf16*)(ws + WS_OB);
    bf16* const MIX = (bf16*)(ws + WS_YD);     bf16* const XS = (bf16*)(ws + WS_XS); float* const S1 = (float*)(ws + WS_XS); bf16* const ACT = (bf16*)(ws + WS_ACT); bf16* const YD = (bf16*)(ws + WS_YD);
    float* const WR = (float*)(ws + WS_WR);
    int* const CNT = (int*)(ws + WS_CNT); unsigned* const RE = (unsigned*)(ws + WS_RE); f32x2* const RW = (f32x2*)(ws + WS_RW); int* const RP = (int*)(ws + WS_RP);

    if (IN(0) && PHM(0)) { PREP(0) {
        const int tid = opq_tid(wave), lane = tid & 63;
        LAS float* scr = (LAS float*)(lds + RING_OFF + wave * 16896);
        const int gw = vcu * NWAVES + wave, NGW = G * NWAVES;
        constexpr int I0 = 2 * 3072, I1 = 8 * 1024, I2 = 128 * 512, I3 = 64 * 512, NITEMS = I0 + I1 + I2 + I3;
        static_assert(QKV8_A == 1 && QKV8_B == 0, "conversion table below: stick-breaking q|k|v and all other fp8 GEMM weights -> e4m3, differential q|k|v weights -> fp16");
#define CVT_DECODE(it_, SRC, PIT, DST, DP, MODE, K0, N0, KIND) do { int r = (it_); \
            if (r < I0) { const int job = r / 3072; r -= job * 3072; const int kb = r / 192, nb = r - kb * 192; \
                SRC = args.in[1] + (size_t)job * 2048 * 6144; PIT = 6144; DST = ws + WS_WQKVA + (size_t)job * 6144 * 2048; DP = 2048; MODE = 0; K0 = kb * 128; N0 = nb * 32; KIND = 2; break; } \
            r -= I0; \
            if (r < I1) { const int job = r >> 10; r &= 1023; const int r1_ = r; K0 = (r >> 6) * 128; N0 = (r & 63) * 32; PIT = 2048; MODE = 0; KIND = 2; DP = P8K2; \
                if (job < 2) { SRC = args.in[2] + (size_t)job * 2048 * 2048; DST = ws + WS_WOA + (size_t)job * 2048 * P8K2; } \
                else if (job >= 6) { SRC = args.in[5] + (size_t)(job - 6) * 2048 * 2048; DST = ws + WS_WOB + (size_t)(job - 6) * 2048 * P8K2; } \
                else { KIND = 1; DP = LDH * 2; K0 = (r1_ >> 5) * 64; N0 = (r1_ & 31) * 64; \
                    if (job == 2) { SRC = args.in[4]; DST = ws + WS_WQKVB; MODE = 1; } \
                    else if (job == 3) { SRC = args.in[3]; PIT = 4096; DST = ws + WS_WQKVB + (size_t)2048 * LDH * 2; MODE = 1; } \
                    else if (job == 4) { SRC = args.in[3] + 2048; PIT = 4096; DST = ws + WS_WQKVB + (size_t)4096 * LDH * 2; } \
                    else { SRC = args.in[4] + (size_t)2048 * 2048; DST = ws + WS_WQKVB + (size_t)6144 * LDH * 2; MODE = 1; } } \
                break; } \
            r -= I1; \
            if (r < I2) { const int job = r >> 9; r &= 511; const int le = job >> 1, up = job & 1;     \
                SRC = (up ? args.in[15] : args.in[14]) + (size_t)le * 2048 * 1024; PIT = 1024; DST = ws + WS_WGU + (size_t)le * 2048 * P8K2; DP = P8K2; MODE = 2 + up; K0 = (r >> 5) * 128; N0 = (r & 31) * 32; KIND = 2; break; } \
            r -= I2; \
            { const int le = r >> 9; r &= 511; SRC = args.in[16] + (size_t)le * 1024 * 2048; PIT = 2048; DST = ws + WS_WDN + (size_t)le * 2048 * P8K1; DP = P8K1; MODE = 0; K0 = (r >> 6) * 128; N0 = (r & 63) * 32; KIND = 2; } \
        } while (0)
        { const float* sA; const float* sB; unsigned char* dA; unsigned char* dB; int pA, pB, qA, qB, mA, mB, kA, kB, nA, nB, tA, tB; f32x4 va[16], vb[16];
          int it = gw;
          if (it < NITEMS) { CVT_DECODE(it, sA, pA, dA, qA, mA, kA, nA, tA); cvt_load(va, sA, pA, kA, nA, tA, lane);
            for (;;) {
                if (it + NGW < NITEMS) { CVT_DECODE(it + NGW, sB, pB, dB, qB, mB, kB, nB, tB); cvt_load(vb, sB, pB, kB, nB, tB, lane); }
                cvt_store(va, dA, qA, mA, kA, nA, tA, scr, lane); it += NGW; if (it >= NITEMS) break;
                if (it + NGW < NITEMS) { CVT_DECODE(it + NGW, sA, pA, dA, qA, mA, kA, nA, tA); cvt_load(va, sA, pA, kA, nA, tA, lane); }
                cvt_store(vb, dB, qB, mB, kB, nB, tB, scr, lane); it += NGW; if (it >= NITEMS) break;
            } } }
#undef CVT_DECODE
        for (size_t i = (size_t)gw * 64 + lane; i < (size_t)NTOK * DM / 4; i += (size_t)NGW * 64) {
            const f32x4 v = ((const f32x4*)x_in)[i];
            ((unsigned*)HB8)[i] = pg8::pack4_fp8(v[0], v[1], v[2], v[3]); }
        for (int i = bx * (NWAVES * 64) + tid; i < NLAYER * 20 * 2048; i += G * NWAVES * 64) { const int k = i & 2047, c = (i >> 11) % 20, l = i / (20 * 2048);
            WR[i] = c < 4 ? args.in[12][((size_t)l * 2048 + k) * 4 + c] : args.in[13][(((size_t)l * 4 + ((c - 4) >> 2)) * 2048 + k) * 4 + ((c - 4) & 3)]; }
        }
        SEAM(0);
    }

    for (int L = 0; L < NLAYER; ++L) {
        const int sb = 1 + 8 * L; const bool typeA = L < 2;
        if (IN(sb + 0)) {
            if (typeA && PHM(1)) { PREP(1) {
                pg8::StaticOrder S; S.init(NTOK, 6144, G, bx);
                if (QKV8_A) { pg8::Gemm g{(const bf16*)HB8, (const bf16*)(ws + WS_WQKVA + (size_t)L * 6144 * 2048), NTOK, 6144, DM / 2, DM / 2, wave}; pg8::EpiQkv E{QKV, 6144, 2048, SB_QSCALE, 1.f / pg8::W8_SCALE};
                    pg8::gemm_phase<pg8::EpiQkv, pg8::StaticOrder, true, true, true>(lds + RING_OFF, g, S, E); }
                } static_assert(QKV8_A == 1, "the stick-breaking layers' q|k|v GEMM takes the e4m3 copy of the stream");
            } else if (!typeA && PHM(2)) { PREP(2) {
                const int N = (L == 2) ? 6144 : 2048;
                pg8::StaticOrder S; S.init(NTOK, N, G, bx);
                if (QKV8_B) { pg8::Gemm g{(const bf16*)HB8, (const bf16*)(ws + WS_WQKVB + (L == 2 ? (size_t)0 : (size_t)6144 * 2048)), NTOK, N, DM / 2, DM / 2, wave};
                    pg8::EpiRope E{QKV, 6144, 2048, 4096, DF_QSCALE, 1.f / pg8::W8_SCALE};
                    pg8::gemm_phase<pg8::EpiRope, pg8::StaticOrder, true, true, true>(lds + RING_OFF, g, S, E); }
                else { pg8::Gemm g{(const bf16*)H, (const bf16*)(ws + WS_WQKVB) + (L == 2 ? (size_t)0 : (size_t)6144 * LDH), NTOK, N, DM, LDH, wave};
                    pg8::EpiRope E{QKV, 6144, 2048, 4096, DF_QSCALE, 1.f};
                    pg8::gemm_phase<pg8::EpiRope, pg8::StaticOrder, true, true, false, true>(lds + RING_OFF, g, S, E); } }
            }
            SEAM(sb + 0);
        }
        if (IN(sb + 1)) {
            if (typeA && PHM(3)) {
                for (int id_ = vcu; id_ < 512 * (1 + ((PROBE_DUP >> 3) & 1)); id_ += G) { if (((PROBE_DUP >> 12) & 1) && id_ >= 512 && id_ < 512 + G) xcd_barrier(bar, tid_from_wave(wave) == 0); const int id = id_ & 511; const int bh = id >> 2, p = id & 3, b = bh >> 4, h = bh & 15;
                    const bf16* Qg = QKV + (size_t)b * SEQ * 6144 + h * 128; bf16* Og = (bf16*)((unsigned char*)OB + (size_t)b * SEQ * P8K2 + h * 128);
                    att::sb_block(Qg, Qg + 2048, Qg + 4096, Og, 7 - p, (att::ldsp)(lds + RING_OFF), wave);
                    att::sb_block(Qg, Qg + 2048, Qg + 4096, Og, p, (att::ldsp)(lds + RING_OFF), wave); }
            } else if (!typeA && PHM(4)) {
                const int lane = opq_tid(wave) & 63;
                const int i = L - 2; const float lam_init = (L == 2) ? 0.47071301834264183f : 0.5560582041556061f;
                const float* lp = args.in[6] + (size_t)i * 256;
                const float sa = dpp_sum(lp[lane] * lp[64 + lane]), sb2 = dpp_sum(lp[128 + lane] * lp[192 + lane]);
                const float lam = __builtin_amdgcn_exp2f(sa * LOG2E) - __builtin_amdgcn_exp2f(sb2 * LOG2E) + lam_init;
                const float* gsub = args.in[7] + (size_t)i * 128; const float gmul = 1.f - lam_init;
                for (int id_ = vcu; id_ < 512 * (1 + ((PROBE_DUP >> 4) & 1)); id_ += G) { if (((PROBE_DUP >> 12) & 1) && id_ >= 512 && id_ < 512 + G) xcd_barrier(bar, tid_from_wave(wave) == 0); const int id = id_ & 511; const int bh = id >> 2, p = id & 3, b = bh >> 4, h = bh & 15;
                    const bf16* Qg = QKV + (size_t)b * SEQ * 6144 + h * 128; bf16* Og = (bf16*)((unsigned char*)OB + (size_t)b * SEQ * P8K2 + h * 128); float* Sg = S1 + (size_t)b * SEQ * DM + h * 128;
#pragma unroll 1
                    for (int w = 0; w < 2; ++w) { const int qb = w ? p : 7 - p;
                        att::diff_pass<false>(Qg, Qg + 2048, Qg + 4096, Sg, Og, qb, lam, gsub, gmul, (att::ldsp)(lds + RING_OFF), wave);
                        att::diff_pass<true>(Qg + 64, Qg + 2048 + 64, Qg + 4096, Sg, Og, qb, lam, gsub, gmul, (att::ldsp)(lds + RING_OFF), wave); } }
            }
            SEAM(sb + 1);
        }
        if (IN(sb + 2)) { if (PHM(5)) {
            pg8::Gemm g{OB, (const bf16*)(ws + (typeA ? WS_WOA : WS_WOB) + (size_t)(L & 1) * 2048 * P8K2), NTOK, DM, DM / 2, P8K2 / 2, wave}; pg8::StaticOrder S; S.init(NTOK, DM, G, bx);
            pg8::EpiQkv E{MIX, DM, 0, 1.f, 1.f / (pg8::W8_SCALE * att::OB8_SCALE)};
            pg8::gemm_phase<pg8::EpiQkv, pg8::StaticOrder, true, true, true>(lds + RING_OFF, g, S, E); }
            SEAM(sb + 2);
        }
        if (IN(sb + 3)) { if (PHM(6)) {
            const int tid = opq_tid(wave), lane = tid & 63;
            const float* lng = args.in[8] + (size_t)L * DM; const float* lnb = args.in[9] + (size_t)L * DM; const float* wr = WR + (size_t)L * 20 * 2048;
            LAS int* eid = (LAS int*)(lds + LNX_OFF + 2048);
            LAS float* lgt = (LAS float*)(lds + LNX_OFF + 4096);
            LAS unsigned* rows8 = (LAS unsigned*)(lds + RING_OFF);
            for (int c = bx; c < 256; c += G) {
#pragma unroll 1
                for (int grp = 0; grp < 4; ++grp) {
                    const int rloc = wave * 8 + grp * 2; const size_t row0 = (size_t)64 * c + rloc;
                    f32x4 v[2][8]; float mu[2], rstd[2];
#pragma unroll
                    for (int rr = 0; rr < 2; ++rr) {
                        if (L == 0) { const f32x4* hp = (const f32x4*)(x_in + (row0 + rr) * DM) + lane;
#pragma unroll
                            for (int j = 0; j < 8; ++j) v[rr][j] = hp[64 * j]; }
                        else { const _Float16* hq = H + (row0 + rr) * DM + 4 * lane;
#pragma unroll
                            for (int j = 0; j < 8; ++j) v[rr][j] = ldh4(hq + 256 * j); } }
#pragma unroll
                    for (int rr = 0; rr < 2; ++rr) { const v2u* mp = (const v2u*)(MIX + (row0 + rr) * DM) + lane;
#pragma unroll
                        for (int j = 0; j < 8; ++j) { const v2u a = mp[64 * j];
                            const f32x4 fa = {__uint_as_float(a.x << 16), __uint_as_float(a.x & 0xffff0000u), __uint_as_float(a.y << 16), __uint_as_float(a.y & 0xffff0000u)};
                            v[rr][j] = v[rr][j] * DN_ALPHA + fa; } }
#pragma unroll
                    for (int rr = 0; rr < 2; ++rr) { float s = 0.f;
#pragma unroll
                        for (int j = 0; j < 8; ++j) s += (v[rr][j][0] + v[rr][j][1]) + (v[rr][j][2] + v[rr][j][3]);
                        mu[rr] = dpp_sum(s) * (1.f / DM); float q = 0.f;
#pragma unroll
                        for (int j = 0; j < 8; ++j) { const f32x4 d = v[rr][j] - mu[rr]; q += (d[0] * d[0] + d[1] * d[1]) + (d[2] * d[2] + d[3] * d[3]); }
                        rstd[rr] = 1.f / sqrtf(dpp_sum(q) * (1.f / DM) + LN_EPS); }
#pragma unroll
                    for (int j = 0; j < 8; ++j) { const f32x4 gg = ((const f32x4*)lng)[64 * j + lane], bb = ((const f32x4*)lnb)[64 * j + lane];
#pragma unroll
                        for (int rr = 0; rr < 2; ++rr) { v[rr][j] = (v[rr][j] - mu[rr]) * rstd[rr] * gg + bb; sth4(H + (row0 + rr) * DM + 256 * j + 4 * lane, v[rr][j]);
                            if (c == bx) rows8[(rloc + rr) * 512 + 64 * j + lane] = pg8::pack4_fp8(v[rr][j][0], v[rr][j][1], v[rr][j][2], v[rr][j][3]); } }
                    f32x4 wn[8];
                    { const f32x4* wp = (const f32x4*)wr + lane;
#pragma unroll
                      for (int j = 0; j < 8; ++j) wn[j] = wp[64 * j]; }
#pragma unroll 1
                    for (int cc = 0; cc < 20; ++cc) { f32x4 w[8];
#pragma unroll
                        for (int j = 0; j < 8; ++j) w[j] = wn[j];
                        { const f32x4* wp = (const f32x4*)(wr + (cc < 19 ? cc + 1 : 19) * 2048) + lane;
#pragma unroll
                          for (int j = 0; j < 8; ++j) wn[j] = wp[64 * j]; }
                        float a[2] = {0.f, 0.f};
#pragma unroll
                        for (int j = 0; j < 8; ++j) {
#pragma unroll
                            for (int rr = 0; rr < 2; ++rr) a[rr] += (v[rr][j][0] * w[j][0] + v[rr][j][1] * w[j][1]) + (v[rr][j][2] * w[j][2] + v[rr][j][3] * w[j][3]); }
#pragma unroll
                        for (int rr = 0; rr < 2; ++rr) a[rr] = dpp_sum(a[rr]);
                        if (lane == 0) { lgt[rloc * 20 + cc] = a[0]; lgt[(rloc + 1) * 20 + cc] = a[1]; } }
                }
                LDS_WAIT();
                if (lane < 8) {
                    const int rl = wave * 8 + lane; const LAS float* lg = lgt + rl * 20;
                    int gsel = 0; float gm = lg[0];
#pragma unroll
                    for (int i = 1; i < 4; ++i) { const float x = lg[i]; if (x > gm) { gm = x; gsel = i; } }
                    float gden = 0.f;
#pragma unroll
                    for (int i = 0; i < 4; ++i) gden += __builtin_amdgcn_exp2f((lg[i] - gm) * LOG2E);
                    const float gw_ = 1.f / gden;
                    const LAS float* li = lg + 4 + 4 * gsel;
                    const float l0 = li[0], l1 = li[1], l2 = li[2], l3 = li[3];
                    int i0 = 0; float v0 = l0;
                    if (l1 > v0) { v0 = l1; i0 = 1; } if (l2 > v0) { v0 = l2; i0 = 2; } if (l3 > v0) { v0 = l3; i0 = 3; }
                    int i1 = -1; float v1 = 0.f;
                    if (i0 != 0) { v1 = l0; i1 = 0; }
                    if (i0 != 1 && (i1 < 0 || l1 > v1)) { v1 = l1; i1 = 1; }
                    if (i0 != 2 && (i1 < 0 || l2 > v1)) { v1 = l2; i1 = 2; }
                    if (i0 != 3 && (i1 < 0 || l3 > v1)) { v1 = l3; i1 = 3; }
                    const float t = __builtin_amdgcn_exp2f((v1 - v0) * LOG2E); const float w0 = gw_ / (1.f + t), w1 = gw_ * t / (1.f + t);
                    eid[2 * rl] = gsel * 4 + i0; eid[2 * rl + 1] = gsel * 4 + i1; RW[(size_t)64 * c + rl] = (f32x2){w0, w1};
                }
                __syncthreads();
                if (wave == 0) {
                    const int ea = eid[lane], eb = eid[64 + lane]; int ra = 0, rb = 0, cnt = 0; const unsigned long long lt = (1ull << lane) - 1ull;
#pragma unroll
                    for (int e = 0; e < 16; ++e) { const unsigned long long ma = __ballot(ea == e), mb = __ballot(eb == e);
                        if (ea == e) ra = __popcll(ma & lt); if (eb == e) rb = __popcll(ma) + __popcll(mb & lt); if (lane == e) cnt = __popcll(ma) + __popcll(mb); }
                    if (lane < 16) CNT[c * 16 + lane] = cnt;
                    LAS int* rk = (LAS int*)(lds + LNX_OFF + 3072); rk[lane] = ra; rk[64 + lane] = rb; LDS_WAIT();
                    const int r = lane; const unsigned word = (unsigned)eid[2 * r] | ((unsigned)eid[2 * r + 1] << 8) | ((unsigned)rk[2 * r] << 16) | ((unsigned)rk[2 * r + 1] << 24);
                    RE[(size_t)64 * c + r] = word;
                }
                __syncthreads();
            } }
            SEAM(sb + 3);
        }
        if ((IN(sb + 4) || IN(sb + 5) || IN(sb + 6)) && PHM(7)) {
            const int tid = opq_tid(wave);
            LAS int* part = (LAS int*)(lds + LNX_OFF);
            { const int e = tid & 15, s = tid >> 4; int a = 0;
#pragma unroll
              for (int i = 0; i < 8; ++i) a += CNT[(8 * s + i) * 16 + e];
              part[s * 16 + e] = a; }
            __syncthreads();
            if (tid < 16) { int run = 0;
#pragma clang loop vectorize(disable)
#pragma unroll 8
                for (int s = 0; s < 32; ++s) run += part[s * 16 + tid];
                TAB[tid] = run; }
            __syncthreads();
            if (tid < 192) { int off = 0, mt = 0, mine = 15;
#pragma unroll
                for (int e = 0; e < 16; ++e) { const int nt = (TAB[e] + 255) >> 8; if (tid == 0) TAB[16 + e] = off; if (tid >= mt && tid < mt + nt) mine = e; off += nt * 256; mt += nt; }
                if (tid < mt && tid < 160) TAB[64 + tid] = mine;
                if (tid == 0) { TAB[32] = off; TAB[33] = mt; } }
            __syncthreads();
        }
        if (IN(sb + 4)) { if (PHM(7)) PREP(7) {
            const int tid = opq_tid(wave), lane = tid & 63;
            LAS int* part = (LAS int*)(lds + LNX_OFF);
            for (int c = bx; c < 256; c += G) {
                if (tid < 16) { int pre = 0; int x[8];
#pragma unroll
                    for (int i = 0; i < 8; ++i) x[i] = CNT[((c & ~7) + i) * 16 + tid];
#pragma clang loop vectorize(disable) unroll(disable)
                    for (int s = 0; s < (c >> 3); ++s) pre += part[s * 16 + tid];
#pragma unroll
                    for (int i = 0; i < 8; ++i) pre += (i < (c & 7)) ? x[i] : 0;
                    TAB[48 + tid] = TAB[16 + tid] + pre; }
                __syncthreads();
#pragma unroll 1
                for (int rr = 0; rr < 8; ++rr) { const size_t row = (size_t)64 * c + wave * 8 + rr; const unsigned word = RE[row];
                    const int p0 = TAB[48 + (word & 255)] + ((word >> 16) & 255), p1 = TAB[48 + ((word >> 8) & 255)] + (word >> 24);
                    if (lane == 0) { RP[2 * row] = p0; RP[2 * row + 1] = p1; }
                    if (c == bx && IN(sb + 3)) {
                        const LAS v4u* src = (const LAS v4u*)(lds + RING_OFF + (wave * 8 + rr) * 2048) + lane; v4u* o0 = (v4u*)((unsigned char*)XS + (size_t)p0 * P8K2) + lane; v4u* o1 = (v4u*)((unsigned char*)XS + (size_t)p1 * P8K2) + lane;
                        const v4u a = src[0], b = src[64]; __builtin_nontemporal_store(a, o0); __builtin_nontemporal_store(b, o0 + 64); __builtin_nontemporal_store(a, o1); __builtin_nontemporal_store(b, o1 + 64);
                    } else {
                        const _Float16* hq = H + row * DM + 4 * lane; unsigned* o0 = (unsigned*)((unsigned char*)XS + (size_t)p0 * P8K2) + lane; unsigned* o1 = (unsigned*)((unsigned char*)XS + (size_t)p1 * P8K2) + lane;
#pragma unroll
                        for (int j = 0; j < 8; ++j) { const f32x4 v = ldh4(hq + 256 * j); const unsigned o = pg8::pack4_fp8(v[0], v[1], v[2], v[3]); o0[64 * j] = o; o1[64 * j] = o; } } }
                __syncthreads();
            } }
            SEAM(sb + 4);
        }
        if (IN(sb + 5)) { if (PHM(8)) PREP(8) {
            pg8::Gemm g{XS, (const bf16*)(ws + WS_WGU + (size_t)L * 16 * 2048 * P8K2), XS_ROWS, 2048, DM / 2, P8K2 / 2, wave};
            pg8::MoeOrder<0> S{TAB[33] * 8, G, bx, TAB + 64, nullptr, nullptr, wave}; pg8::EpiGateUp8 E{(unsigned char*)ACT};
            pg8::gemm_phase<pg8::EpiGateUp8, pg8::MoeOrder<0>, true, true, true>(lds + RING_OFF, g, S, E); }
            SEAM(sb + 5);
        }
        if (IN(sb + 6)) { if (PHM(9)) PREP(9) {
            pg8::Gemm g{ACT, (const bf16*)(ws + WS_WDN + (size_t)L * 16 * 2048 * P8K1), XS_ROWS, 2048, DEXP / 2, P8K1 / 2, wave};
            pg8::MoeOrder<0> S{TAB[33] * 8, G, bx, TAB + 64, nullptr, nullptr, wave}; pg8::EpiDown8 E{(unsigned char*)YD};
            pg8::gemm_phase<pg8::EpiDown8, pg8::MoeOrder<0>, true, true, true>(lds + RING_OFF, g, S, E); }
            SEAM(sb + 6);
        }
        if (IN(sb + 7)) { if (PHM(10)) for (int rep_ = 0; rep_ < ((((PROBE_DUP) >> 10) & 1) && L == NLAYER - 1 ? 5 : 1); ++rep_) {
            const int tid = opq_tid(wave), lane = tid & 63;
            const float* lng = args.in[10] + (size_t)L * DM; const float* lnb = args.in[11] + (size_t)L * DM; const bool last = (L == NLAYER - 1); const bool next8 = (L + 1 < 2) ? (QKV8_A != 0) : (QKV8_B != 0);
            const int gw = vcu * NWAVES + wave, NGW = G * NWAVES;
            for (int row0 = 4 * gw; row0 < NTOK; row0 += 4 * NGW) {
                f32x4 v[4][8]; float mu[4], rstd[4];
#pragma unroll
                for (int rr = 0; rr < 4; ++rr) { const int row = row0 + rr;
                    const int p0 = RP[2 * row], p1 = RP[2 * row + 1]; const f32x2 w = RW[row];
                    const _Float16* hq = H + (size_t)row * DM + 4 * lane; const unsigned* y0 = (const unsigned*)((const unsigned char*)YD + (size_t)p0 * DM) + lane; const unsigned* y1 = (const unsigned*)((const unsigned char*)YD + (size_t)p1 * DM) + lane;
                    const float w0s = w.x * (1.f / pg8::YD8_SCALE), w1s = w.y * (1.f / pg8::YD8_SCALE);
#pragma unroll
                    for (int j = 0; j < 8; ++j) { const f32x4 h = ldh4(hq + 256 * j); const unsigned a = y0[64 * j], b = y1[64 * j];
                        const f32x2 a0 = __builtin_amdgcn_cvt_pk_f32_fp8((int)a, false), a1 = __builtin_amdgcn_cvt_pk_f32_fp8((int)a, true), b0 = __builtin_amdgcn_cvt_pk_f32_fp8((int)b, false), b1 = __builtin_amdgcn_cvt_pk_f32_fp8((int)b, true);
                        const f32x4 fa = {a0[0], a0[1], a1[0], a1[1]}, fb = {b0[0], b0[1], b1[0], b1[1]};
                        v[rr][j] = h * DN_ALPHA + fa * w0s + fb * w1s; } }
#pragma unroll
                for (int rr = 0; rr < 4; ++rr) { float s = 0.f;
#pragma unroll
                    for (int j = 0; j < 8; ++j) s += (v[rr][j][0] + v[rr][j][1]) + (v[rr][j][2] + v[rr][j][3]);
                    mu[rr] = dpp_sum(s) * (1.f / DM); float q = 0.f;
#pragma unroll
                    for (int j = 0; j < 8; ++j) { const f32x4 dd = v[rr][j] - mu[rr]; q += (dd[0] * dd[0] + dd[1] * dd[1]) + (dd[2] * dd[2] + dd[3] * dd[3]); }
                    rstd[rr] = 1.f / sqrtf(dpp_sum(q) * (1.f / DM) + LN_EPS); }
#pragma unroll
                for (int j = 0; j < 8; ++j) { const f32x4 gg = ((const f32x4*)lng)[64 * j + lane], bb = ((const f32x4*)lnb)[64 * j + lane];
#pragma unroll
                    for (int rr = 0; rr < 4; ++rr) { const int row = row0 + rr; const f32x4 y = (v[rr][j] - mu[rr]) * rstd[rr] * gg + bb;
                        if (last) __builtin_nontemporal_store(y, (f32x4*)(args.out + (size_t)row * DM) + 64 * j + lane);
                        else { sth4(H + (size_t)row * DM + 256 * j + 4 * lane, y); if (next8) __builtin_nontemporal_store(pg8::pack4_fp8(y[0], y[1], y[2], y[3]), (unsigned*)(HB8 + (size_t)row * DM) + 64 * j + lane); } } }
            } }
            SEAM(sb + 7);
        }
    }
#undef IN
#undef SEAM
}

extern "C" void kernel_launch(void* const* d_in, const int* in_sizes, int n_in, void* d_out, int out_size, void* d_ws, size_t ws_size, hipStream_t stream) {
    static int grid = 0;
    if (grid == 0) {
        if (n_in != 17 || in_sizes[0] != NTOK * DM || out_size != NTOK * DM || ws_size < WS_END) { fprintf(stderr, "kernel_launch: unexpected shapes / workspace (n_in %d, ws %zu, need %zu)\n", n_in, ws_size, (size_t)WS_END); grid = -1; return; }
        int dev = 0, cus = 0, per_cu = 0;
        if (hipGetDevice(&dev) != hipSuccess || hipDeviceGetAttribute(&cus, hipDeviceAttributeMultiprocessorCount, dev) != hipSuccess) { grid = -1; return; }
        if (hipFuncSetAttribute((const void*)yoco_fwd, hipFuncAttributeMaxDynamicSharedMemorySize, LDS_BYTES) != hipSuccess) { fprintf(stderr, "kernel_launch: hipFuncSetAttribute failed\n"); grid = -1; return; }
        if (hipOccupancyMaxActiveBlocksPerMultiprocessor(&per_cu, (const void*)yoco_fwd, NWAVES * 64, LDS_BYTES) != hipSuccess || per_cu < 1) { fprintf(stderr, "kernel_launch: occupancy query says %d\n", per_cu); per_cu = 1; }
        (void)hipGetLastError();
        grid = cus;
    }
    if (grid < 0) return;
    (void)hipMemsetAsync((char*)d_ws + WS_CTL, 0, CTL_ZERO_BYTES, stream);
    Args a{};
    for (int i = 0; i < 17; ++i) a.in[i] = (const float*)d_in[i];
    a.out = (float*)d_out; a.ws = (unsigned char*)d_ws;
#if MK_MULTI
    for (int s = 0; s < NSTEPS; ++s) { a.s_lo = s; a.s_hi = s + 1; hipLaunchKernelGGL(yoco_fwd, dim3(grid), dim3(NWAVES * 64), LDS_BYTES, stream, a); }
#else
    a.s_lo = 0; a.s_hi = NSTEPS;
    hipLaunchKernelGGL(yoco_fwd, dim3(grid), dim3(NWAVES * 64), LDS_BYTES, stream, a);
#endif
    const hipError_t le = hipPeekAtLastError();
    if (le != hipSuccess) fprintf(stderr, "kernel_launch: launch failed: %s\n", hipGetErrorName(le));
}
```

```cpp
#include <hip/hip_runtime.h>
#include <cstdio>
#include <cstdint>

__device__ __forceinline__ int tid_from_wave(int wave) { int l; asm volatile("v_mbcnt_lo_u32_b32 %0, -1, 0\n\tv_mbcnt_hi_u32_b32 %0, -1, %0" : "=v"(l)); return wave * 64 + l; }
namespace pg8 {
#define PG8_LAS __attribute__((address_space(3)))
typedef unsigned short bf16_t;
typedef short bf16x8 __attribute__((ext_vector_type(8)));
typedef float f32x4 __attribute__((ext_vector_type(4)));
typedef unsigned u32x4 __attribute__((ext_vector_type(4)));
typedef int pg8_v8i __attribute__((ext_vector_type(8)));
typedef _Float16 pg8_h8 __attribute__((ext_vector_type(8)));
constexpr int BM = 256, BK = 64, HALF = 128, HTB = HALF * BK * 2  , STAGE_BYTES = 8 * HTB, NXCD = 8, WGM = 8;

__host__ __device__ __forceinline__ int lds_byte(int r, int c) { const int st = (r >> 4) * 2 + (c >> 5), rr = r & 15, cc = c & 31, ob = rr * 64 + cc * 2; return st * 1024 + (ob ^ (((ob >> 9) & 1) << 5)); }
__host__ __device__ __forceinline__ void stage_rc(int b, int& R, int& C) { const int st = b / 1024, sb = b % 1024, swz = sb ^ (((sb >> 9) & 1) << 5); R = (st >> 1) * 16 + swz / 64; C = (st & 1) * 32 + (swz % 64) / 2; }
__host__ __device__ __forceinline__ int perm32(int rho) { const int n = rho >> 4, i = rho & 15; return 8 * (i >> 2) + 4 * n + (i & 3); }

struct Unit { int pm, pn; };
struct Gemm { const bf16_t* A; const bf16_t* Bt; int M, N, K, ld, wave; };

struct StaticOrder {
    int nM, nN, nwg, G, c;
    __host__ __device__ void init(int M, int N, int G_, int c_) { nM = M / BM; nN = N / BM; nwg = nM * nN; G = G_; c = c_; }
    __host__ __device__ bool next(int i, Unit& u) const {
        const long L = (long)i * G + c; if (L >= nwg) return false;
        int wgid = (int)L; { const int q = nwg / NXCD, r = nwg % NXCD, xcd = wgid % NXCD, off = wgid / NXCD; wgid = (xcd < r ? xcd * (q + 1) : r * (q + 1) + (xcd - r) * q) + off; }
        const int nig = WGM * nN, gid = wgid / nig, fm = gid * WGM, gsz = (nM - fm) < WGM ? (nM - fm) : WGM;
        u.pm = fm + ((wgid % nig) % gsz); u.pn = (wgid % nig) / gsz; return true;
    }
    __device__ __forceinline__ void a_ready(const Unit&) const {}
    __device__ __forceinline__ void done(const Unit&) const {}
};

__device__ __forceinline__ unsigned cvt_pk_bf16(float lo, float hi) { unsigned r; asm volatile("v_cvt_pk_bf16_f32 %0, %1, %2" : "=v"(r) : "v"(lo), "v"(hi)); return r; }
typedef float f32x2 __attribute__((ext_vector_type(2)));

typedef unsigned u32x2 __attribute__((ext_vector_type(2)));
__device__ __forceinline__ u32x4 pack8_bf16(const f32x4 a, const f32x4 b) { u32x4 w; w.x = cvt_pk_bf16(a[0], a[1]); w.y = cvt_pk_bf16(a[2], a[3]); w.z = cvt_pk_bf16(b[0], b[1]); w.w = cvt_pk_bf16(b[2], b[3]); return w; }

struct EpiQkv {
    static constexpr bool PERM = true, AFTER_DRAIN = false;
    bf16_t* O; int ldc; int qcols; float qscale; float osc;
    __device__ __forceinline__ void operator()(const f32x4 (&acc)[2][2][4][2], const Unit& u, int wr, int wc, int fr, int fq) const {
        const int row0 = u.pm * BM + wr * 64 + fr, colt = u.pn * BM; const float sc = (colt < qcols ? qscale : 1.f) * osc;
        const int col0 = colt + wc * 32 + 8 * fq;
#pragma unroll
        for (int ai = 0; ai < 2; ++ai)
#pragma unroll
            for (int m = 0; m < 4; ++m) { bf16_t* rowp = O + (size_t)(row0 + ai * HALF + m * 16) * ldc + col0;
#pragma unroll
                for (int bj = 0; bj < 2; ++bj) *(u32x4*)(rowp + bj * HALF) = pack8_bf16(acc[ai][bj][m][0] * sc, acc[ai][bj][m][1] * sc); }
    }
};
template <int ACCS_INV> struct EpiResid {
    static constexpr bool PERM = false, AFTER_DRAIN = false;
    static constexpr int ldc = 2048; static constexpr float alpha = 1.6817928305074292f, accs = 1.f / (float)ACCS_INV;
    float* H; const float* Hsrc;
    __device__ __forceinline__ void operator()(const f32x4 (&acc)[2][2][4][2], const Unit& u, int wr, int wc, int fr, int fq) const {
        const int row0 = u.pm * BM + wr * 64 + fr, col0 = u.pn * BM + wc * 32 + 4 * fq;
#pragma unroll
        for (int ai = 0; ai < 2; ++ai)
#pragma unroll
            for (int m = 0; m < 4; ++m) { const size_t ro = (size_t)(row0 + ai * HALF + m * 16) * ldc + col0; float* rowp = H + ro; const float* srcp = Hsrc + ro;
#pragma unroll
                for (int bj = 0; bj < 2; ++bj)
#pragma unroll
                    for (int n = 0; n < 2; ++n) { const f32x4 h = *(const f32x4*)(srcp + bj * HALF + n * 16); *(f32x4*)(rowp + bj * HALF + n * 16) = h * alpha + acc[ai][bj][m][n] * accs; } }
    }
};
struct EpiRope {
    static constexpr bool PERM = true, AFTER_DRAIN = false;
    bf16_t* O; int ldc; int qcols, ropecols; float qscale; float osc;
    __device__ __forceinline__ void operator()(const f32x4 (&acc)[2][2][4][2], const Unit& u, int wr, int wc, int fr, int fq) const {
        const int row0 = u.pm * BM + wr * 64 + fr, colt = u.pn * BM;
        if (colt >= ropecols) {
            const int col0 = colt + wc * 32 + 8 * fq;
#pragma unroll
            for (int ai = 0; ai < 2; ++ai)
#pragma unroll
                for (int m = 0; m < 4; ++m) { bf16_t* rowp = O + (size_t)(row0 + ai * HALF + m * 16) * ldc + col0;
#pragma unroll
                    for (int bj = 0; bj < 2; ++bj) *(u32x4*)(rowp + bj * HALF) = pack8_bf16(acc[ai][bj][m][0] * osc, acc[ai][bj][m][1] * osc); }
        } else {
            const float sc = (colt < qcols ? qscale : 1.f) * osc;
            const int col0 = colt + wc * 64 + 8 * fq;
            float ir[8];
#pragma unroll
            for (int i = 0; i < 8; ++i) ir[i] = __builtin_amdgcn_exp2f(-(float)(8 * fq + i) * 0.4152410118609203f) * 0.15915494309189535f;
#pragma unroll
            for (int ai = 0; ai < 2; ++ai)
#pragma unroll
                for (int m = 0; m < 4; ++m) { const int row = row0 + ai * HALF + m * 16; const float pos = (float)(row & 2047);
                    f32x4 c0, c1, s0, s1;
#pragma unroll
                    for (int i = 0; i < 4; ++i) { const float f0 = __builtin_amdgcn_fractf(pos * ir[i]), f1 = __builtin_amdgcn_fractf(pos * ir[4 + i]);
                        c0[i] = __builtin_amdgcn_cosf(f0); s0[i] = __builtin_amdgcn_sinf(f0); c1[i] = __builtin_amdgcn_cosf(f1); s1[i] = __builtin_amdgcn_sinf(f1); }
                    const f32x4 a0 = acc[ai][0][m][0], a1 = acc[ai][0][m][1], b0 = acc[ai][1][m][0], b1 = acc[ai][1][m][1];
                    bf16_t* rowp = O + (size_t)row * ldc + col0;
                    *(u32x4*)(rowp) = pack8_bf16((a0 * c0 - b0 * s0) * sc, (a1 * c1 - b1 * s1) * sc);
                    *(u32x4*)(rowp + 32) = pack8_bf16((b0 * c0 + a0 * s0) * sc, (b1 * c1 + a1 * s1) * sc); }
        }
    }
};
struct EpiGateUp {
    static constexpr bool PERM = true, AFTER_DRAIN = false;
    bf16_t* O;
    __device__ __forceinline__ void operator()(const f32x4 (&acc)[2][2][4][2], const Unit& u, int wr, int wc, int fr, int fq) const {
        const int row0 = u.pm * BM + wr * 64 + fr, col0 = (u.pn & 7) * 128 + wc * 32 + 8 * fq;
#pragma unroll
        for (int ai = 0; ai < 2; ++ai)
#pragma unroll
            for (int m = 0; m < 4; ++m) { f32x4 r[2];
#pragma unroll
                for (int n = 0; n < 2; ++n) { const f32x4 g = acc[ai][0][m][n], up = acc[ai][1][m][n];
#pragma unroll
                    for (int i = 0; i < 4; ++i) { const float e = __builtin_amdgcn_exp2f(g[i] * -1.4426950408889634f); r[n][i] = g[i] * __builtin_amdgcn_rcpf(1.f + e) * up[i]; } }
                *(u32x4*)(O + (size_t)(row0 + ai * HALF + m * 16) * 1024 + col0) = pack8_bf16(r[0], r[1]); }
    }
};
struct EpiDown {
    static constexpr bool PERM = true, AFTER_DRAIN = false;
    bf16_t* O;
    __device__ __forceinline__ void operator()(const f32x4 (&acc)[2][2][4][2], const Unit& u, int wr, int wc, int fr, int fq) const {
        const int row0 = u.pm * BM + wr * 64 + fr, col0 = (u.pn & 7) * BM + wc * 32 + 8 * fq;
#pragma unroll
        for (int ai = 0; ai < 2; ++ai)
#pragma unroll
            for (int m = 0; m < 4; ++m) { bf16_t* rowp = O + (size_t)(row0 + ai * HALF + m * 16) * 2048 + col0;
#pragma unroll
                for (int bj = 0; bj < 2; ++bj) *(u32x4*)(rowp + bj * HALF) = pack8_bf16(acc[ai][bj][m][0], acc[ai][bj][m][1]); }
    }
};
constexpr float W8_SCALE = 64.f, ACT8_SCALE = 4.f;
__device__ __forceinline__ unsigned pack4_fp8(float a, float b, float c, float d) { int w; asm volatile("" : "=v"(w));
    w = __builtin_amdgcn_cvt_pk_fp8_f32(a, b, w, false); w = __builtin_amdgcn_cvt_pk_fp8_f32(c, d, w, true); return (unsigned)w; }
struct EpiGateUp8 {
    static constexpr bool PERM = true, AFTER_DRAIN = false;
    unsigned char* O;
    __device__ __forceinline__ void operator()(const f32x4 (&acc)[2][2][4][2], const Unit& u, int wr, int wc, int fr, int fq) const {
        const int row0 = u.pm * BM + wr * 64 + fr, col0 = (u.pn & 7) * 128 + wc * 32 + 8 * fq;
        constexpr float SI = 1.f / W8_SCALE;
#pragma unroll
        for (int ai = 0; ai < 2; ++ai)
#pragma unroll
            for (int m = 0; m < 4; ++m) { f32x4 r[2];
#pragma unroll
                for (int n = 0; n < 2; ++n) { const f32x4 g = acc[ai][0][m][n] * SI, up = acc[ai][1][m][n] * (SI * ACT8_SCALE);
#pragma unroll
                    for (int i = 0; i < 4; ++i) { const float e = __builtin_amdgcn_exp2f(g[i] * -1.4426950408889634f); r[n][i] = g[i] * __builtin_amdgcn_rcpf(1.f + e) * up[i]; } }
                u32x2 w; w.x = pack4_fp8(r[0][0], r[0][1], r[0][2], r[0][3]); w.y = pack4_fp8(r[1][0], r[1][1], r[1][2], r[1][3]);
                *(u32x2*)(O + (size_t)(row0 + ai * HALF + m * 16) * 1024 + col0) = w; }
    }
};
constexpr float YD8_SCALE = 16.f;
struct EpiDown8 {
    static constexpr bool PERM = true, AFTER_DRAIN = false;
    unsigned char* O;
    __device__ __forceinline__ void operator()(const f32x4 (&acc)[2][2][4][2], const Unit& u, int wr, int wc, int fr, int fq) const {
        const int row0 = u.pm * BM + wr * 64 + fr, col0 = (u.pn & 7) * BM + wc * 32 + 8 * fq;
        constexpr float SI = YD8_SCALE / (W8_SCALE * ACT8_SCALE);
#pragma unroll
        for (int ai = 0; ai < 2; ++ai)
#pragma unroll
            for (int m = 0; m < 4; ++m) { unsigned char* rowp = O + (size_t)(row0 + ai * HALF + m * 16) * 2048 + col0;
#pragma unroll
                for (int bj = 0; bj < 2; ++bj) { const f32x4 a = acc[ai][bj][m][0] * SI, c = acc[ai][bj][m][1] * SI; u32x2 w; w.x = pack4_fp8(a[0], a[1], a[2], a[3]); w.y = pack4_fp8(c[0], c[1], c[2], c[3]);
                    *(u32x2*)(rowp + bj * HALF) = w; } }
    }
};
template <int ROLE> struct MoeOrder {
    int nunits, G, c; const PG8_LAS int* tile_e; unsigned* cnt; unsigned* tmo; int wave;
    __device__ __forceinline__ bool next(int i, Unit& u) const {
        const int cc = (ROLE == 2) ? G - 1 - c : c; int idx;
        if ((G & 7) == 0) { const int per = G >> 3; idx = (i * 8 + (cc & 7)) * per + (cc >> 3); } else idx = i * G + cc;
        if (idx >= nunits) return false;
        const int mt = idx >> 3; u.pm = mt; u.pn = tile_e[mt] * 8 + (idx & 7); return true;
    }
    __device__ __forceinline__ void a_ready(const Unit& u) const {
        if constexpr (ROLE == 2) {
            if (wave == 0) { const bool lane0 = (tid_from_wave(0) == 0);
                const unsigned long long t0 = __builtin_amdgcn_s_memrealtime(); unsigned polls = 0;
                while ((unsigned)__builtin_amdgcn_readfirstlane(__hip_atomic_load(cnt + 64 * u.pm, __ATOMIC_RELAXED, __HIP_MEMORY_SCOPE_AGENT)) < 64u) {
                    if ((++polls & 255u) == 0u && __builtin_amdgcn_readfirstlane(__hip_atomic_load(tmo, __ATOMIC_RELAXED, __HIP_MEMORY_SCOPE_AGENT)) != 0u) break;
                    if (__builtin_amdgcn_s_memrealtime() - t0 > 2000000ull) { if (lane0) __hip_atomic_store(tmo, 1u, __ATOMIC_RELAXED, __HIP_MEMORY_SCOPE_AGENT); break; }
                    __builtin_amdgcn_s_sleep(2); }
                __builtin_amdgcn_fence(__ATOMIC_ACQUIRE, "agent");
                asm volatile("s_waitcnt vmcnt(0)" ::: "memory");
            }
            asm volatile("" ::: "memory"); __builtin_amdgcn_s_barrier(); asm volatile("" ::: "memory");
        }
    }
    __device__ __forceinline__ void done(const Unit& u) const {
        if constexpr (ROLE == 1) {
            asm volatile("s_waitcnt vmcnt(0)" ::: "memory");
            if (tid_from_wave(0) == 0) __hip_atomic_fetch_add(cnt + 64 * u.pm, 1u, __ATOMIC_RELAXED, __HIP_MEMORY_SCOPE_AGENT);
        }
    }
};

template <class Epi, class Sched, bool ALIGN_EPI = false, bool SP2 = false, bool F8 = false, bool F16 = false>
__device__ __forceinline__ void gemm_phase(PG8_LAS unsigned char* lds, const Gemm g, const Sched& S, const Epi& E) {
    int tid_ = tid_from_wave(g.wave); asm volatile("" : "+v"(tid_));
    const int tid = tid_, wid = __builtin_amdgcn_readfirstlane(tid >> 6), lane = tid & 63, wr = wid >> 2, wc = wid & 3, fr = lane & 15, fq = lane >> 4;
    const int K = g.K, LD = g.ld, nt = K / BK;
    unsigned voffA, voffB;
    { int R, C; stage_rc(tid * 16, R, C); const int Rb = Epi::PERM ? ((R & ~31) + perm32(R & 31)) : R;
        voffA = (unsigned)(R * LD + C) * 2u; voffB = (unsigned)(Rb * LD + C) * 2u; }
    const size_t pstep = (size_t)64 * LD * 2;
    const size_t kstep = (size_t)(BK * 2);
    const size_t hstep = (size_t)HALF * LD * 2;
    const size_t tstep = 2 * hstep;
    const unsigned ldsbase = (unsigned)(uintptr_t)lds;
    const unsigned ldsw = (unsigned)wid * 1024u;
    const int aoff = lds_byte(wr * 64 + fr, fq * 8), boff = lds_byte(wc * 32 + fr, fq * 8);
#define PG8_SA(b, h) (((b) * 2 + (h)) * HTB)
#define PG8_SB(b, h) ((4 + (b) * 2 + (h)) * HTB)
#define PG8_STAGE(bufoff, gbase, voff) do { _Pragma("unroll") for (int _i = 0; _i < 2; ++_i) { unsigned keep_; \
        asm volatile("s_mov_b32 %0, m0\n\ts_mov_b32 m0, %3\n\ts_nop 0\n\tglobal_load_lds_dwordx4 %1, %2\n\ts_mov_b32 m0, %0" : "=&s"(keep_) \
            : "v"(voff), "s"((const char*)(gbase) + _i * pstep), "s"(ldsbase + (unsigned)(bufoff) + ldsw + (unsigned)(_i * 8192))); } } while (0)
#define PG8_CAT(a, b) __builtin_bit_cast(pg8_v8i, __builtin_shufflevector(a, b, 0, 1, 2, 3, 4, 5, 6, 7, 8, 9, 10, 11, 12, 13, 14, 15))
#define PG8_LDA(dst, b, h) do { if constexpr (F8) { _Pragma("unroll") for (int m = 0; m < 4; ++m) { const bf16x8 lo_ = *(const PG8_LAS bf16x8*)(lds + PG8_SA(b, h) + aoff + m * 2048), hi_ = *(const PG8_LAS bf16x8*)(lds + PG8_SA(b, h) + aoff + m * 2048 + 1024); dst##8[m] = PG8_CAT(lo_, hi_); } } \
        else { _Pragma("unroll") for (int m = 0; m < 4; ++m) _Pragma("unroll") for (int k = 0; k < 2; ++k) dst[m][k] = *(const PG8_LAS bf16x8*)(lds + PG8_SA(b, h) + aoff + m * 2048 + k * 1024); } } while (0)
#define PG8_LDB(dst, b, h) do { if constexpr (F8) { _Pragma("unroll") for (int n = 0; n < 2; ++n) { const bf16x8 lo_ = *(const PG8_LAS bf16x8*)(lds + PG8_SB(b, h) + boff + n * 2048), hi_ = *(const PG8_LAS bf16x8*)(lds + PG8_SB(b, h) + boff + n * 2048 + 1024); dst##8[n] = PG8_CAT(lo_, hi_); } } \
        else { _Pragma("unroll") for (int n = 0; n < 2; ++n) _Pragma("unroll") for (int k = 0; k < 2; ++k) dst[n][k] = *(const PG8_LAS bf16x8*)(lds + PG8_SB(b, h) + boff + n * 2048 + k * 1024); } } while (0)
#define PG8_MMA(ai, bj, At, Bt) do { __builtin_amdgcn_s_setprio(1); \
        if constexpr (F8) { _Pragma("unroll") for (int m = 0; m < 4; ++m) _Pragma("unroll") for (int n = 0; n < 2; ++n) \
            acc[ai][bj][m][n] = __builtin_amdgcn_mfma_scale_f32_16x16x128_f8f6f4(Bt##8[n], At##8[m], acc[ai][bj][m][n], 0, 0, 0, 0, 0, 0); } \
        else { _Pragma("unroll") for (int m = 0; m < 4; ++m) _Pragma("unroll") for (int n = 0; n < 2; ++n) _Pragma("unroll") for (int k = 0; k < 2; ++k) \
            acc[ai][bj][m][n] = F16 ? __builtin_amdgcn_mfma_f32_16x16x32_f16(__builtin_bit_cast(pg8_h8, Bt[n][k]), __builtin_bit_cast(pg8_h8, At[m][k]), acc[ai][bj][m][n], 0, 0, 0) \
                                    : __builtin_amdgcn_mfma_f32_16x16x32_bf16(Bt[n][k], At[m][k], acc[ai][bj][m][n], 0, 0, 0); } \
        __builtin_amdgcn_s_setprio(0); } while (0)
#define PG8_WAIT_V(n) asm volatile("s_waitcnt vmcnt(" #n ")" ::: "memory")
#define PG8_WAIT_L(n) asm volatile("s_waitcnt lgkmcnt(" #n ")" ::: "memory")
#define PG8_BAR __builtin_amdgcn_s_barrier()
#define PG8_SCHED __builtin_amdgcn_sched_barrier(0)
    Unit cur, nxt; int ui = 0;
    if (!S.next(0, cur)) return;
    f32x4 acc[2][2][4][2];
{ float zero_; asm volatile("v_mov_b32 %0, 0" : "=v"(zero_));
#pragma unroll
    for (int a = 0; a < 2; ++a)
#pragma unroll
        for (int b = 0; b < 2; ++b)
#pragma unroll
            for (int m = 0; m < 4; ++m)
#pragma unroll
                for (int n = 0; n < 2; ++n) acc[a][b][m][n] = (f32x4){zero_, zero_, zero_, zero_}; }
    bf16x8 At[4][2], B0[2][2], B1[2][2]; pg8_v8i At8[4], B08[2], B18[2];
    const char* cA = (const char*)g.A + (size_t)cur.pm * tstep; const char* cB = (const char*)g.Bt + (size_t)cur.pn * tstep;
    S.a_ready(cur);
    if constexpr (SP2) {
        PG8_STAGE(PG8_SB(0, 0), cB, voffB); PG8_STAGE(PG8_SB(0, 1), cB + hstep, voffB); PG8_STAGE(PG8_SA(0, 0), cA, voffA); PG8_STAGE(PG8_SA(0, 1), cA + hstep, voffA);
        if (wr == 1) PG8_BAR;
        PG8_WAIT_V(2); PG8_BAR;
        PG8_STAGE(PG8_SB(1, 0), cB + kstep, voffB); PG8_STAGE(PG8_SA(1, 0), cA + kstep, voffA); PG8_STAGE(PG8_SB(1, 1), cB + hstep + kstep, voffB);
        PG8_WAIT_V(6); PG8_BAR;
    } else {
        PG8_STAGE(PG8_SB(0, 0), cB, voffB); PG8_STAGE(PG8_SA(0, 0), cA, voffA); PG8_STAGE(PG8_SB(0, 1), cB + hstep, voffB); PG8_STAGE(PG8_SA(0, 1), cA + hstep, voffA);
        if (wr == 1) PG8_BAR;
        PG8_WAIT_V(4); PG8_BAR;
        PG8_STAGE(PG8_SB(1, 0), cB + kstep, voffB); PG8_STAGE(PG8_SA(1, 0), cA + kstep, voffA); PG8_STAGE(PG8_SB(1, 1), cB + hstep + kstep, voffB);
        PG8_WAIT_V(6); PG8_BAR;
    }
    for (;;) {
        const bool has_next = S.next(ui + 1, nxt);
        const char* nA = has_next ? (const char*)g.A + (size_t)nxt.pm * tstep : cA; const char* nB = has_next ? (const char*)g.Bt + (size_t)nxt.pn * tstep : cB;
#pragma unroll 1
        for (int t = 0; t < nt; t += 2) {
            const bool last = (t == nt - 2);
            const char* a1 = cA + (size_t)(t + 1) * kstep;
            const char* a2 = last ? nA : cA + (size_t)(t + 2) * kstep; const char* b2 = last ? nB : cB + (size_t)(t + 2) * kstep;
            const char* a3 = a2 + kstep; const char* b3 = b2 + kstep;
            if (last && has_next) S.a_ready(nxt);
            if constexpr (SP2) {
            PG8_LDB(B0, 0, 0); PG8_LDB(B1, 0, 1); PG8_SCHED; PG8_LDA(At, 0, 0); PG8_STAGE(PG8_SA(1, 1), a1 + hstep, voffA);
            PG8_WAIT_V(8); PG8_WAIT_L(0); PG8_BAR; PG8_MMA(0, 0, At, B0); PG8_MMA(0, 1, At, B1); PG8_BAR; PG8_SCHED;
            PG8_LDA(At, 0, 1); PG8_STAGE(PG8_SB(0, 0), b2, voffB); PG8_STAGE(PG8_SB(0, 1), b2 + hstep, voffB); PG8_STAGE(PG8_SA(0, 0), a2, voffA);
            PG8_WAIT_V(8); PG8_WAIT_L(0); PG8_BAR; PG8_MMA(1, 0, At, B0); PG8_MMA(1, 1, At, B1); PG8_BAR; PG8_SCHED;
            PG8_LDB(B0, 1, 0); PG8_LDB(B1, 1, 1); PG8_SCHED; PG8_LDA(At, 1, 0); PG8_STAGE(PG8_SA(0, 1), a2 + hstep, voffA);
            PG8_WAIT_V(8); PG8_WAIT_L(0); PG8_BAR; PG8_MMA(0, 0, At, B0); PG8_MMA(0, 1, At, B1); PG8_BAR; PG8_SCHED;
            PG8_LDA(At, 1, 1); PG8_STAGE(PG8_SB(1, 0), b3, voffB); PG8_STAGE(PG8_SB(1, 1), b3 + hstep, voffB); PG8_STAGE(PG8_SA(1, 0), a3, voffA);
            PG8_WAIT_V(8); PG8_WAIT_L(0); PG8_BAR; PG8_MMA(1, 0, At, B0); PG8_MMA(1, 1, At, B1); PG8_BAR; PG8_SCHED;
            } else {
            PG8_LDB(B0, 0, 0); PG8_SCHED; PG8_LDA(At, 0, 0); PG8_STAGE(PG8_SA(1, 1), a1 + hstep, voffA);
            PG8_WAIT_L(8); PG8_BAR; PG8_WAIT_L(0); PG8_MMA(0, 0, At, B0); PG8_BAR; PG8_SCHED;
            PG8_LDB(B1, 0, 1); PG8_STAGE(PG8_SB(0, 0), b2, voffB);
            PG8_BAR; PG8_WAIT_L(0); PG8_MMA(0, 1, At, B1); PG8_BAR;
            PG8_LDA(At, 0, 1); PG8_STAGE(PG8_SA(0, 0), a2, voffA);
            PG8_BAR; PG8_WAIT_L(0); PG8_MMA(1, 0, At, B0); PG8_BAR; PG8_SCHED;
            PG8_STAGE(PG8_SB(0, 1), b2 + hstep, voffB);
            PG8_WAIT_V(6); PG8_BAR; PG8_MMA(1, 1, At, B1); PG8_BAR;
            PG8_LDB(B0, 1, 0); PG8_SCHED; PG8_LDA(At, 1, 0); PG8_STAGE(PG8_SA(0, 1), a2 + hstep, voffA);
            PG8_WAIT_L(8); PG8_BAR; PG8_WAIT_L(0); PG8_MMA(0, 0, At, B0); PG8_BAR; PG8_SCHED;
            PG8_LDB(B1, 1, 1); PG8_STAGE(PG8_SB(1, 0), b3, voffB);
            PG8_BAR; PG8_WAIT_L(0); PG8_MMA(0, 1, At, B1); PG8_BAR;
            PG8_LDA(At, 1, 1); PG8_STAGE(PG8_SA(1, 0), a3, voffA);
            PG8_BAR; PG8_WAIT_L(0); PG8_MMA(1, 0, At, B0); PG8_BAR; PG8_SCHED;
            PG8_STAGE(PG8_SB(1, 1), b3 + hstep, voffB);
            PG8_WAIT_V(6); PG8_BAR; PG8_MMA(1, 1, At, B1); PG8_BAR;
            }
        }
        if constexpr (ALIGN_EPI) { if (wr == 0) PG8_BAR; }
        if constexpr (!Epi::AFTER_DRAIN) { const int t2_ = tid_from_wave(g.wave);
            E(acc, cur, wr, wc, t2_ & 15, (t2_ >> 4) & 3); S.done(cur); }
        if (!has_next) break;
{ float zero_; asm volatile("v_mov_b32 %0, 0" : "=v"(zero_));
#pragma unroll
        for (int a = 0; a < 2; ++a)
#pragma unroll
            for (int b = 0; b < 2; ++b)
#pragma unroll
                for (int m = 0; m < 4; ++m)
#pragma unroll
                    for (int n = 0; n < 2; ++n) acc[a][b][m][n] = (f32x4){zero_, zero_, zero_, zero_}; }
        cur = nxt; cA = nA; cB = nB; ++ui;
        if constexpr (ALIGN_EPI) { if (wr == 1) PG8_BAR; }
    }
    PG8_WAIT_V(0);
    if constexpr (!ALIGN_EPI) { if (wr == 0) PG8_BAR; }
    PG8_BAR;
    if constexpr (Epi::AFTER_DRAIN) { E.fused(acc, cur, wr, wc, fr, fq, lds, wid, lane); S.done(cur); }
#undef PG8_SA
#undef PG8_SB
#undef PG8_STAGE
#undef PG8_LDA
#undef PG8_LDB
#undef PG8_MMA
#undef PG8_CAT
#undef PG8_WAIT_V
#undef PG8_WAIT_L
#undef PG8_BAR
#undef PG8_SCHED
}
}

namespace att {
#define ALAS __attribute__((address_space(3)))
typedef unsigned short bf16_t;
typedef short bf16x8 __attribute__((ext_vector_type(8)));
typedef short s16x4 __attribute__((ext_vector_type(4)));
typedef float f32x16 __attribute__((ext_vector_type(16)));
typedef float f32x4 __attribute__((ext_vector_type(4)));
typedef unsigned u32x4 __attribute__((ext_vector_type(4)));
typedef ALAS char* ldsp;
#ifndef WO_F8
#define WO_F8 1
#endif
constexpr float OB8_SCALE = 8.f;
constexpr int QP = 6144;
constexpr int OP = 2048;
constexpr int OBP = 2048;
constexpr int SHM_V = 16384, SHM_K = 16384;
constexpr int LDS_V = 0, LDS_K = 2 * SHM_V, LDS_WS = LDS_K + 2 * SHM_K, ATT_LDS_BYTES = LDS_WS + 8 * 256;
#define KSWZ(row, colB) ((row) * 256 + ((colB) ^ (((row) & 7) << 4)))
#define KSWZ64(row, colB) ((row) * 128 + ((colB) ^ (((row) & 7) << 4)))
#define SBAR() __builtin_amdgcn_sched_barrier(0)
__device__ __forceinline__ int v_st(int k, int c) { const int kk = (k & ~0xC) | ((k & 4) << 1) | ((k & 8) >> 1); return ((kk >> 3) * 4 + (c >> 5)) * 512 + ((kk & 7) * 32 + (c & 31)) * 2; }
__device__ __forceinline__ int v_rd_base(int lane) { return ((lane & 3) << 3) | (((lane >> 2) & 3) << 6) | (((lane >> 4) & 1) << 5) | (((lane >> 5) & 1) << 8); }
constexpr int v_rd_off(int d0, int ks, int half) { return d0 * 512 + ks * 4096 + half * 2048; }
__device__ __forceinline__ int crow(int r, int hi) { return (r & 3) + 8 * (r >> 2) + 4 * hi; }
__device__ __forceinline__ unsigned cvtpk(float lo, float hi) { unsigned r; asm volatile("v_cvt_pk_bf16_f32 %0, %1, %2" : "=v"(r) : "v"(lo), "v"(hi)); return r; }
__device__ __forceinline__ bf16x8 ldg8(const bf16_t* p) { return *reinterpret_cast<const bf16x8*>(p); }
__device__ __forceinline__ unsigned quad_pack_fp8(float v) {
    const int b = __builtin_bit_cast(int, v);
    const float v1 = __builtin_bit_cast(float, __builtin_amdgcn_update_dpp(b, b, 0x55, 0xf, 0xf, false));
    const float v2 = __builtin_bit_cast(float, __builtin_amdgcn_update_dpp(b, b, 0xAA, 0xf, 0xf, false));
    const float v3 = __builtin_bit_cast(float, __builtin_amdgcn_update_dpp(b, b, 0xFF, 0xf, 0xf, false));
    int w; asm volatile("" : "=v"(w));
    w = __builtin_amdgcn_cvt_pk_fp8_f32(v, v1, w, false); w = __builtin_amdgcn_cvt_pk_fp8_f32(v2, v3, w, true); return (unsigned)w;
}
__device__ __forceinline__ float xhalf(float v, int hi) {
    auto rr = __builtin_amdgcn_permlane32_swap(__float_as_uint(v), __float_as_uint(v), false, false);
    return __uint_as_float(hi ? rr[0] : rr[1]);
}
#define ATT_PK4(P, B_, OUT) do { unsigned a0 = cvtpk(P[B_+0], P[B_+1]), a1 = cvtpk(P[B_+2], P[B_+3]);                      \
        unsigned b0 = cvtpk(P[B_+4], P[B_+5]), b1 = cvtpk(P[B_+6], P[B_+7]);                                             \
        auto r0 = __builtin_amdgcn_permlane32_swap(a0, b0, false, false); auto r1 = __builtin_amdgcn_permlane32_swap(a1, b1, false, false); \
        u32x4 w = {r0[0], r1[0], r0[1], r1[1]}; OUT = *reinterpret_cast<bf16x8*>(&w); } while (0)
__device__ __forceinline__ void pv_tile(f32x16* o, int vb, bf16x8 pa0, bf16x8 pa1, bf16x8 pa2, bf16x8 pa3) {
#define TRRD(dst, off) asm volatile("ds_read_b64_tr_b16 %0, %1 offset:%2" : "=&v"(dst) : "v"(vb), "i"(off) : "memory")
#define PV_D0(d0) do { s16x4 l0, l1, l2, l3, h0, h1, h2, h3; constexpr int b_ = v_rd_off(d0, 0, 0); \
        TRRD(l0, b_); TRRD(h0, b_ + 2048); TRRD(l1, b_ + 4096); TRRD(h1, b_ + 6144); TRRD(l2, b_ + 8192); TRRD(h2, b_ + 10240); TRRD(l3, b_ + 12288); TRRD(h3, b_ + 14336); \
        asm volatile("s_waitcnt lgkmcnt(0)" ::: "memory"); SBAR(); \
        o[d0] = __builtin_amdgcn_mfma_f32_32x32x16_bf16(pa0, (bf16x8){l0[0], l0[1], l0[2], l0[3], h0[0], h0[1], h0[2], h0[3]}, o[d0], 0, 0, 0);   \
        o[d0] = __builtin_amdgcn_mfma_f32_32x32x16_bf16(pa1, (bf16x8){l1[0], l1[1], l1[2], l1[3], h1[0], h1[1], h1[2], h1[3]}, o[d0], 0, 0, 0);   \
        o[d0] = __builtin_amdgcn_mfma_f32_32x32x16_bf16(pa2, (bf16x8){l2[0], l2[1], l2[2], l2[3], h2[0], h2[1], h2[2], h2[3]}, o[d0], 0, 0, 0);   \
        o[d0] = __builtin_amdgcn_mfma_f32_32x32x16_bf16(pa3, (bf16x8){l3[0], l3[1], l3[2], l3[3], h3[0], h3[1], h3[2], h3[3]}, o[d0], 0, 0, 0); } while (0)
    PV_D0(0); PV_D0(1); PV_D0(2); PV_D0(3);
#undef PV_D0
#undef TRRD
}

__device__ __forceinline__ void sb_block(const bf16_t* __restrict__ Qg, const bf16_t* __restrict__ Kg, const bf16_t* __restrict__ Vg, bf16_t* __restrict__ Og, int qb, ldsp lds, int wave_) {
    int tid_ = tid_from_wave(wave_); asm volatile("" : "+v"(tid_));
    const int tid = tid_, wid = __builtin_amdgcn_readfirstlane(tid >> 6), lane = tid & 63, r32 = lane & 31, hi = lane >> 5;
    const int NT = 4 * qb + 4, R0 = 256 * qb + 32 * wid, myrow = R0 + r32;
    const ldsp V_lds = lds + LDS_V; const ldsp K_lds = lds + LDS_K;
    bf16x8 qr[8];
    { const bf16_t* Qw = Qg + (size_t)R0 * QP; const unsigned qoff = (unsigned)(r32 * QP + hi * 8);
#pragma unroll
      for (int d0 = 0; d0 < 8; ++d0) qr[d0] = ldg8(Qw + (qoff + d0 * 16)); }
    const int sr = tid >> 4, sc = (tid & 15) * 8, kws = KSWZ(sr, sc * 2), vst0 = v_st(sr, sc), vst1 = v_st(32 + sr, sc);
    const unsigned kvoff = (unsigned)(sr * QP + sc);
    const int vb0 = (int)(unsigned)(uintptr_t)V_lds + v_rd_base(lane);
    bf16x8 sk0, sk1, sv0, sv1;
#define SB_LOAD(j) do { const bf16_t* kp_ = Kg + (size_t)(64 * (j)) * QP; const bf16_t* vp_ = Vg + (size_t)(64 * (j)) * QP; \
        sk0 = ldg8(kp_ + kvoff); sk1 = ldg8(kp_ + (size_t)32 * QP + kvoff); sv0 = ldg8(vp_ + kvoff); sv1 = ldg8(vp_ + (size_t)32 * QP + kvoff); } while (0)
#define SB_WRITE(bf) do { *(ALAS bf16x8*)(K_lds + (bf) * SHM_K + kws) = sk0; *(ALAS bf16x8*)(K_lds + (bf) * SHM_K + kws + 32 * 256) = sk1; \
        *(ALAS bf16x8*)(V_lds + (bf) * SHM_V + vst0) = sv0; *(ALAS bf16x8*)(V_lds + (bf) * SHM_V + vst1) = sv1; } while (0)
    SB_LOAD(NT - 1); SB_WRITE(0);
    __syncthreads();
    float carry = 0.f; f32x16 o[4] = {};
    ALAS int* fl = (ALAS int*)(lds + LDS_WS); bool wdone = false;
    for (int t = 0; t < NT; ++t) {
        const int j = NT - 1 - t, buf = t & 1, kb = 64 * j;
        if (t + 1 < NT) SB_LOAD(j - 1);
        if (kb <= R0 + 30 && !wdone) {
            f32x16 p0 = {}, p1 = {};
            { const ldsp Kb = K_lds + buf * SHM_K;
#pragma unroll
              for (int d0 = 0; d0 < 8; ++d0) { const ldsp a = Kb + KSWZ(r32, ((d0 & 3) * 16 + hi * 8) * 2) + (d0 >> 2) * 128;
                  const bf16x8 b0 = *(const ALAS bf16x8*)a, b1 = *(const ALAS bf16x8*)(a + 32 * 256);
                  p0 = __builtin_amdgcn_mfma_f32_32x32x16_bf16(b0, qr[d0], p0, 0, 0, 0);
                  p1 = __builtin_amdgcn_mfma_f32_32x32x16_bf16(b1, qr[d0], p1, 0, 0, 0); } }
            f32x16 lb0, lb1;
#pragma unroll
            for (int r = 0; r < 16; ++r) {
                { const float z = p0[r]; const float e = __builtin_amdgcn_exp2f(-__builtin_fabsf(z)); const float sp = __builtin_fmaxf(z, 0.f) + __builtin_amdgcn_logf(1.f + e); p0[r] = -sp; lb0[r] = z - sp; }
                { const float z = p1[r]; const float e = __builtin_amdgcn_exp2f(-__builtin_fabsf(z)); const float sp = __builtin_fmaxf(z, 0.f) + __builtin_amdgcn_logf(1.f + e); p1[r] = -sp; lb1[r] = z - sp; }
            }
            if (kb + 63 >= R0) {
                const int dq = myrow - kb - 4 * hi; const float NEG = -__builtin_inff();
#pragma unroll
                for (int r = 0; r < 16; ++r) { const int c = (r & 3) + 8 * (r >> 2);
                    if (c >= dq) { p0[r] = 0.f; lb0[r] = NEG; }
                    if (c + 32 >= dq) { p1[r] = 0.f; lb1[r] = NEG; } }
            }
            float gs[8], go[8];
#pragma unroll
            for (int g = 0; g < 4; ++g) { gs[g] = (p0[4 * g] + p0[4 * g + 1]) + (p0[4 * g + 2] + p0[4 * g + 3]); gs[4 + g] = (p1[4 * g] + p1[4 * g + 1]) + (p1[4 * g + 2] + p1[4 * g + 3]); }
#pragma unroll
            for (int i = 0; i < 8; ++i) go[i] = xhalf(gs[i], hi);
            float acc = carry;
#pragma unroll
            for (int idx = 7; idx >= 0; --idx) { const int g = idx & 3; const float base = acc + (hi ? 0.f : go[idx]);
                if (idx >= 4) { const float t3 = base, t2 = t3 + p1[4 * g + 3], t1 = t2 + p1[4 * g + 2], t0 = t1 + p1[4 * g + 1];
                    lb1[4 * g + 3] = __builtin_amdgcn_exp2f(lb1[4 * g + 3] + t3); lb1[4 * g + 2] = __builtin_amdgcn_exp2f(lb1[4 * g + 2] + t2);
                    lb1[4 * g + 1] = __builtin_amdgcn_exp2f(lb1[4 * g + 1] + t1); lb1[4 * g] = __builtin_amdgcn_exp2f(lb1[4 * g] + t0); }
                else { const float t3 = base, t2 = t3 + p0[4 * g + 3], t1 = t2 + p0[4 * g + 2], t0 = t1 + p0[4 * g + 1];
                    lb0[4 * g + 3] = __builtin_amdgcn_exp2f(lb0[4 * g + 3] + t3); lb0[4 * g + 2] = __builtin_amdgcn_exp2f(lb0[4 * g + 2] + t2);
                    lb0[4 * g + 1] = __builtin_amdgcn_exp2f(lb0[4 * g + 1] + t1); lb0[4 * g] = __builtin_amdgcn_exp2f(lb0[4 * g] + t0); }
                acc += gs[idx] + go[idx]; }
            carry = acc;
            bf16x8 pa0, pa1, pa2, pa3;
            ATT_PK4(lb0, 0, pa0); ATT_PK4(lb0, 8, pa1); ATT_PK4(lb1, 0, pa2); ATT_PK4(lb1, 8, pa3);
            SBAR();
            pv_tile(o, vb0 + buf * SHM_V, pa0, pa1, pa2, pa3);
            wdone = __all(carry < -127.f);
        }
        if (lane == 0) fl[buf * 8 + wid] = wdone ? 1 : 0;
        if (t + 1 < NT) SB_WRITE(buf ^ 1);
        __syncthreads();
        { const ALAS int* f = fl + buf * 8; if ((f[0] & f[1] & f[2] & f[3] & f[4] & f[5] & f[6] & f[7]) != 0) break; }
    }
#undef SB_LOAD
#undef SB_WRITE
#if WO_F8
    unsigned char* Ow = (unsigned char*)Og + (size_t)R0 * OBP; const unsigned ooff = (unsigned)(4 * hi * OBP + r32);
#pragma unroll
    for (int r = 0; r < 16; ++r) { unsigned char* rowp = Ow + (size_t)((r & 3) + 8 * (r >> 2)) * OBP;
#pragma unroll
        for (int d0 = 0; d0 < 4; ++d0) { const unsigned w = quad_pack_fp8(o[d0][r] * OB8_SCALE);
            if ((r32 & 3) == 0) *(unsigned*)(rowp + (ooff + d0 * 32)) = w; } }
#else
    bf16_t* Ow = Og + (size_t)R0 * OP; const unsigned ooff = (unsigned)(4 * hi * OP + r32);
#pragma unroll
    for (int r = 0; r < 16; ++r) { bf16_t* rowp = Ow + (size_t)((r & 3) + 8 * (r >> 2)) * OP;
#pragma unroll
        for (int d0 = 0; d0 < 4; ++d0) { const float v = o[d0][r]; const float vn = __shfl_xor(v, 1);
            if ((r32 & 1) == 0) *(unsigned*)(rowp + (ooff + d0 * 32)) = cvtpk(v, vn); } }
#endif
}

constexpr float ATT_THR = 8.f;
__device__ __forceinline__ void qkt64(f32x16& p0, f32x16& p1, ldsp Kb, int r32, int hi, const bf16x8* qr) {
    p0 = f32x16{}; p1 = f32x16{};
#pragma unroll
    for (int d0 = 0; d0 < 4; ++d0) { const ldsp a = Kb + KSWZ64(r32, (d0 * 16 + hi * 8) * 2);
        const bf16x8 b0 = *(const ALAS bf16x8*)a, b1 = *(const ALAS bf16x8*)(a + 32 * 128);
        p0 = __builtin_amdgcn_mfma_f32_32x32x16_bf16(b0, qr[d0], p0, 0, 0, 0);
        p1 = __builtin_amdgcn_mfma_f32_32x32x16_bf16(b1, qr[d0], p1, 0, 0, 0); }
}
__device__ __forceinline__ void partial_sm(f32x16& p0, f32x16& p1, float& m_reg, float& alpha, int hi) {
    float pmax = p0[0];
#pragma unroll
    for (int r = 1; r < 16; ++r) pmax = __builtin_fmaxf(pmax, p0[r]);
#pragma unroll
    for (int r = 0; r < 16; ++r) pmax = __builtin_fmaxf(pmax, p1[r]);
    pmax = __builtin_fmaxf(pmax, xhalf(pmax, hi));
    float mn;
    if (__builtin_expect(__all(pmax - m_reg <= ATT_THR), 1)) { mn = m_reg; alpha = 1.f; }
    else { mn = __builtin_fmaxf(m_reg, pmax); alpha = __builtin_amdgcn_exp2f(m_reg - mn); m_reg = mn; }
#pragma unroll
    for (int r = 0; r < 16; ++r) { p0[r] -= mn; p1[r] -= mn; }
#pragma unroll
    for (int r = 0; r < 16; ++r) p0[r] = __builtin_amdgcn_exp2f(p0[r]);
}
__device__ __forceinline__ void finish_sm(f32x16& p0, f32x16& p1, float alpha, float& l_reg, bf16x8& pa0, bf16x8& pa1, bf16x8& pa2, bf16x8& pa3, int hi) {
#pragma unroll
    for (int r = 0; r < 16; ++r) p1[r] = __builtin_amdgcn_exp2f(p1[r]);
    float ps = 0.f;
#pragma unroll
    for (int r = 0; r < 16; ++r) ps += p0[r];
#pragma unroll
    for (int r = 0; r < 16; ++r) ps += p1[r];
    ps += xhalf(ps, hi);
    l_reg = l_reg * alpha + ps;
    ATT_PK4(p0, 0, pa0); ATT_PK4(p0, 8, pa1); ATT_PK4(p1, 0, pa2); ATT_PK4(p1, 8, pa3);
}
__device__ __forceinline__ void mask_gt(f32x16& p0, f32x16& p1, int dq) {
    const float NEG = -__builtin_inff();
#pragma unroll
    for (int r = 0; r < 16; ++r) { const int c = (r & 3) + 8 * (r >> 2);
        if (c > dq) p0[r] = NEG;
        if (c + 32 > dq) p1[r] = NEG; }
}
template <bool SECOND>
__device__ __forceinline__ void diff_pass(const bf16_t* __restrict__ Qg, const bf16_t* __restrict__ Kg, const bf16_t* __restrict__ Vg, float* S1, bf16_t* __restrict__ Og,
                                          int qb, float lam, const float* __restrict__ gsub, float gmul, ldsp lds, int wave_) {
    int tid_ = tid_from_wave(wave_); asm volatile("" : "+v"(tid_));
    const int tid = tid_, wid = __builtin_amdgcn_readfirstlane(tid >> 6), lane = tid & 63, r32 = lane & 31, hi = lane >> 5;
    const int NT = 4 * qb + 4, R0 = 256 * qb + 32 * wid, myrow = R0 + r32;
    const ldsp V_lds = lds + LDS_V; const ldsp K_lds = lds + LDS_K;
    ALAS float* wsf = (ALAS float*)(lds + LDS_WS) + wid * 64; ALAS float* li_l = wsf; ALAS float* al_l = wsf + 32;
    bf16x8 qr[4];
    { const bf16_t* Qw = Qg + (size_t)R0 * QP; const unsigned qoff = (unsigned)(r32 * QP + hi * 8);
#pragma unroll
      for (int d0 = 0; d0 < 4; ++d0) qr[d0] = ldg8(Qw + (qoff + d0 * 16)); }
    const int sr = tid >> 4, sc = (tid & 15) * 8, vst0 = v_st(sr, sc), vst1 = v_st(32 + sr, sc);
    const int kr = tid >> 3, kc = (tid & 7) * 8, kws = KSWZ64(kr, kc * 2);
    const unsigned voff = (unsigned)(sr * QP + sc), koff = (unsigned)(kr * QP + kc);
    const int vb0 = (int)(unsigned)(uintptr_t)V_lds + v_rd_base(lane);
    const int qm = myrow - 4 * hi;
    bf16x8 sk0A, sv0A, sv1A, sk0B, sv0B, sv1B;
#define DF_LOAD(S_, j) do { const bf16_t* vp_ = Vg + (size_t)(64 * (j)) * QP; sk0##S_ = ldg8(Kg + (size_t)(64 * (j)) * QP + koff); sv0##S_ = ldg8(vp_ + voff); sv1##S_ = ldg8(vp_ + (size_t)32 * QP + voff); } while (0)
#define DF_WRITE(S_, bf) do { *(ALAS bf16x8*)(K_lds + (bf) * SHM_K + kws) = sk0##S_; *(ALAS bf16x8*)(V_lds + (bf) * SHM_V + vst0) = sv0##S_; *(ALAS bf16x8*)(V_lds + (bf) * SHM_V + vst1) = sv1##S_; } while (0)
#define DF_MASK(P0, P1, t) do { if (64 * (t) + 63 > R0) mask_gt(P0, P1, qm - 64 * (t)); } while (0)
#define DF_RESC(a) do { if (__any((a) < 1.f)) { if (hi == 0) al_l[r32] = (a); asm volatile("s_waitcnt lgkmcnt(0)" ::: "memory"); \
        _Pragma("unroll") for (int d_ = 0; d_ < 4; ++d_) _Pragma("unroll") for (int r = 0; r < 16; ++r) o[d_][r] *= al_l[crow(r, hi)]; } } while (0)
    float m_reg = -1e30f, l_reg = 0.f; f32x16 o[4] = {};
    f32x16 pA0, pA1, pB0, pB1; float alA = 1.f, alB = 1.f; bf16x8 pa0, pa1, pa2, pa3;
    DF_LOAD(A, 0); DF_WRITE(A, 0);
    __syncthreads();
    DF_LOAD(A, 1); DF_LOAD(B, 2);
    qkt64(pA0, pA1, K_lds, r32, hi, qr); DF_MASK(pA0, pA1, 0); partial_sm(pA0, pA1, m_reg, alA, hi);
    DF_WRITE(A, 1);
    DF_RESC(alA);
    __syncthreads();
#define DF_HALF(PX0, PX1, alX, PY0, PY1, alY, t, KB, VB, SB, LS, WS) do { \
        SBAR(); qkt64(PX0, PX1, K_lds + (KB) * SHM_K, r32, hi, qr); \
        finish_sm(PY0, PY1, alY, l_reg, pa0, pa1, pa2, pa3, hi); SBAR(); \
        if ((t) + 2 < NT) { DF_LOAD(LS, (t) + 2); SBAR(); } \
        pv_tile(o, vb0 + (VB) * SHM_V, pa0, pa1, pa2, pa3); DF_MASK(PX0, PX1, (t)); partial_sm(PX0, PX1, m_reg, alX, hi); \
        __syncthreads(); \
        if ((t) + 1 < NT) DF_WRITE(WS, SB); \
        DF_RESC(alX); __syncthreads(); } while (0)
    for (int t = 1; t + 1 < NT; t += 2) {
        DF_HALF(pB0, pB1, alB, pA0, pA1, alA, t, 1, 0, 0, A, B);
        DF_HALF(pA0, pA1, alA, pB0, pB1, alB, t + 1, 0, 1, 1, B, A);
    }
    DF_HALF(pB0, pB1, alB, pA0, pA1, alA, NT - 1, 1, 0, 0, A, B);
    finish_sm(pB0, pB1, alB, l_reg, pa0, pa1, pa2, pa3, hi); SBAR();
    pv_tile(o, vb0 + 1 * SHM_V, pa0, pa1, pa2, pa3);
#undef DF_LOAD
#undef DF_WRITE
#undef DF_MASK
#undef DF_RESC
#undef DF_HALF
    if (hi == 0) li_l[r32] = l_reg; asm volatile("s_waitcnt lgkmcnt(0)" ::: "memory");
    float rli[16];
#pragma unroll
    for (int r = 0; r < 16; ++r) rli[r] = __builtin_amdgcn_rcpf(li_l[crow(r, hi)]);
    if constexpr (!SECOND) {
        float* Sw = S1 + (size_t)R0 * OP; const unsigned ooff = (unsigned)(4 * hi * OP + r32);
#pragma unroll
        for (int r = 0; r < 16; ++r) { float* rowp = Sw + (size_t)((r & 3) + 8 * (r >> 2)) * OP;
#pragma unroll
            for (int d0 = 0; d0 < 4; ++d0) rowp[ooff + d0 * 32] = o[d0][r] * rli[r]; }
    } else {
        const float* Sw = S1 + (size_t)R0 * OP; bf16_t* Ow = Og + (size_t)R0 * OP; (void)Ow; const unsigned ooff = (unsigned)(4 * hi * OP + r32), ooff8 = (unsigned)(4 * hi * OBP + r32);
        float gn[4];
#pragma unroll
        for (int d0 = 0; d0 < 4; ++d0) gn[d0] = gsub[d0 * 32 + r32] * gmul;
#pragma unroll
        for (int r = 0; r < 16; ++r) { const float* srow = Sw + (size_t)((r & 3) + 8 * (r >> 2)) * OP; float d[4]; float ss = 0.f;
#if WO_F8
            unsigned char* orowp = (unsigned char*)Og + (size_t)(R0 + (r & 3) + 8 * (r >> 2)) * OBP;
#else
            bf16_t* orowp = Ow + (size_t)((r & 3) + 8 * (r >> 2)) * OP;
#endif
#pragma unroll
            for (int d0 = 0; d0 < 4; ++d0) { d[d0] = srow[ooff + d0 * 32] - lam * (o[d0][r] * rli[r]); ss += d[d0] * d[d0]; }
            ss += __builtin_bit_cast(float, __builtin_amdgcn_update_dpp(0, __builtin_bit_cast(int, ss), 0xB1, 0xf, 0xf, true));
            ss += __builtin_bit_cast(float, __builtin_amdgcn_update_dpp(0, __builtin_bit_cast(int, ss), 0x4E, 0xf, 0xf, true));
            ss += __builtin_bit_cast(float, __builtin_amdgcn_update_dpp(0, __builtin_bit_cast(int, ss), 0x141, 0xf, 0xf, true));
            ss += __builtin_bit_cast(float, __builtin_amdgcn_update_dpp(0, __builtin_bit_cast(int, ss), 0x140, 0xf, 0xf, true));
            { auto rr = __builtin_amdgcn_permlane16_swap(__float_as_uint(ss), __float_as_uint(ss), false, false); ss = __uint_as_float(rr[0]) + __uint_as_float(rr[1]); }
            const float rs = __builtin_amdgcn_rsqf(ss * (1.f / 128.f) + 1e-5f);
#pragma unroll
#if WO_F8
            for (int d0 = 0; d0 < 4; ++d0) { const unsigned w = quad_pack_fp8(d[d0] * rs * gn[d0] * OB8_SCALE);
                if ((r32 & 3) == 0) *(unsigned*)(orowp + (ooff8 + d0 * 32)) = w; }
#else
            for (int d0 = 0; d0 < 4; ++d0) { const float v = d[d0] * rs * gn[d0]; const float vn = __shfl_xor(v, 1);
                if ((r32 & 1) == 0) *(unsigned*)(orowp + (ooff + d0 * 32)) = cvtpk(v, vn); }
#endif
            if ((r & 1) == 1) asm volatile("" ::: "memory"); }
    }
    __syncthreads();
}

constexpr int D2_SLK = 8192, D2_SLV = 16384, D2_K = 0, D2_V = 3 * D2_SLK, D2_WS = D2_V + 3 * D2_SLV, D2_LDS_BYTES = D2_WS + 8 * 256;
typedef __attribute__((address_space(3))) const char* lds_cptr;
typedef short v4i16_t __attribute__((ext_vector_type(4)));
typedef float f32x2_t __attribute__((ext_vector_type(2))); typedef __bf16 bf16x2_t __attribute__((ext_vector_type(2)));
__device__ __forceinline__ unsigned cvtpk_s(float lo, float hi) { const f32x2_t v = {lo, hi}; const bf16x2_t b = __builtin_convertvector(v, bf16x2_t); return __builtin_bit_cast(unsigned, b); }
__device__ __forceinline__ s16x4 vtr(lds_cptr p) { return __builtin_bit_cast(s16x4, __builtin_amdgcn_ds_read_tr16_b64_v4i16((__attribute__((address_space(3))) v4i16_t*)p)); }
__device__ __forceinline__ void kload2(bf16x8* kf, lds_cptr kp, int j) { kf[2 * j] = *(const ALAS bf16x8*)(kp + j * 2048); kf[2 * j + 1] = *(const ALAS bf16x8*)(kp + j * 2048 + 512); }
__device__ __forceinline__ void glds16s(unsigned voff, const void* gbase, unsigned ldsdst) { unsigned keep;
    asm volatile("s_mov_b32 %0, m0\n\ts_mov_b32 m0, %3\n\ts_nop 0\n\tglobal_load_lds_dwordx4 %1, %2\n\ts_mov_b32 m0, %0" : "=&s"(keep) : "v"(voff), "s"(gbase), "s"(ldsdst) : "memory"); }
#define D2_MX3(a, b, c) __builtin_fmaxf(__builtin_fmaxf((a), (b)), (c))
__device__ __forceinline__ float rowmax2(const f32x16& p0, const f32x16& p1) {
    float a = D2_MX3(p0[0], p0[1], p1[0]), b = D2_MX3(p0[2], p0[3], p1[1]); a = D2_MX3(a, p1[2], p1[3]);
#pragma unroll
    for (int r = 4; r < 16; r += 4) { a = D2_MX3(a, p0[r], p0[r + 1]); b = D2_MX3(b, p0[r + 2], p0[r + 3]); a = D2_MX3(a, p1[r], p1[r + 1]); b = D2_MX3(b, p1[r + 2], p1[r + 3]); }
    const float m = __builtin_fmaxf(a, b); auto rr = __builtin_amdgcn_permlane32_swap(__float_as_uint(m), __float_as_uint(m), false, false);
    return __builtin_fmaxf(__uint_as_float(rr[0]), __uint_as_float(rr[1])); }
__device__ __forceinline__ void cmask2(f32x16& p0, f32x16& p1, int jb, int qrel, int hi) {
    const int kb = 64 * jb + 4 * hi; const float NEG = -__builtin_inff();
#pragma unroll
    for (int r = 0; r < 16; ++r) { const int kv = kb + (r & 3) + 8 * (r >> 2); if (kv > qrel) p0[r] = NEG; if (kv + 32 > qrel) p1[r] = NEG; } }
#define D2_WAIT_BAR(N) asm volatile("s_waitcnt vmcnt(" #N ") lgkmcnt(0)\n\ts_barrier" ::: "memory")
#define D2_PIN(x) asm volatile("" : "+v"(x))
#define D2_MF(a, b, c) __builtin_amdgcn_mfma_f32_32x32x16_bf16(a, b, c, 0, 0, 0)

template <bool SECOND>
__device__ __forceinline__ void diff_pass2(const bf16_t* __restrict__ Qg, const bf16_t* __restrict__ Kg, const bf16_t* __restrict__ Vg, float* S1, bf16_t* __restrict__ Og,
                                           int qb, float lam, const float* __restrict__ gsub, float gmul, ldsp lds, int wave_) {
    int tid_ = tid_from_wave(wave_); asm volatile("" : "+v"(tid_));
    const int tid = tid_, wid = __builtin_amdgcn_readfirstlane(tid >> 6), lane = tid & 63, r32 = lane & 31, hi = lane >> 5;
    const int NT = 4 * qb + 4, R0 = 256 * qb + 32 * wid;
    const unsigned lds0 = (unsigned)(uintptr_t)lds;
    ALAS float* wsf = (ALAS float*)(lds + D2_WS) + wid * 64;
    const unsigned kvo = (unsigned)(lane * QP + wid * 8) * 2u;
    const unsigned vvo = (unsigned)((16 * (wid & 3) + (lane >> 2)) * QP + (wid >> 2) * 32 + (lane & 3) * 8) * 2u;
    const unsigned kdst = lds0 + D2_K + wid * 1024, vdst = lds0 + D2_V + wid * 1024;
#define D2_DMA_K(t, slot) glds16s(kvo, Kg + (size_t)(t) * 64 * QP, (unsigned)__builtin_amdgcn_readfirstlane(kdst + (slot)))
#define D2_DMA_V(t, slot) do { glds16s(vvo, Vg + (size_t)(t) * 64 * QP, (unsigned)__builtin_amdgcn_readfirstlane(vdst + 2 * (slot))); \
                               glds16s(vvo, Vg + (size_t)(t) * 64 * QP + 64, (unsigned)__builtin_amdgcn_readfirstlane(vdst + 2 * (slot) + 8192)); } while (0)
    const lds_cptr kp0 = (lds_cptr)lds + D2_K + hi * 1024 + r32 * 16;
    const lds_cptr vp0 = (lds_cptr)lds + D2_V + ((lane >> 4) & 1) * 32 + (lane & 3) * 8 + (4 * hi + ((lane & 15) >> 2)) * 64;
    D2_DMA_K(0, 0); D2_DMA_V(0, 0); D2_DMA_K(1, D2_SLK);
    bf16x8 qr[4];
    { const bf16_t* Qw = Qg + (size_t)R0 * QP; const unsigned qoff = (unsigned)(r32 * QP + hi * 8);
#pragma unroll
      for (int d0 = 0; d0 < 4; ++d0) qr[d0] = ldg8(Qw + (qoff + d0 * 16)); }
    D2_DMA_K(2, 2 * D2_SLK);
    float mhat = 0.f, l_reg = 0.f; f32x16 o[4] = {};
    const int qrel = 32 * wid + r32; bool resc = false;
    f32x16 pA0, pA1, pB0, pB1; bf16x8 kf[8]; s16x4 vlo[8], vhi[8]; u32x4 pw0, pw1, pw2, pw3;
    int sl_prev = 0, sl_cur = 0, sl_next = D2_SLK;
#define D2_ROT() do { sl_prev = sl_cur; sl_cur = sl_next; sl_next = (sl_next == 2 * D2_SLK) ? 0 : sl_next + D2_SLK; } while (0)
#define D2_EX(v) __builtin_amdgcn_exp2f((v) - mhat)
#define D2_RESC() do { if (resc) { _Pragma("unroll") for (int d_ = 0; d_ < 4; ++d_) _Pragma("unroll") for (int r = 0; r < 16; ++r) o[d_][r] *= wsf[crow(r, hi)]; } } while (0)
#define D2_Z16 (f32x16){}
    D2_WAIT_BAR(4);
#pragma unroll
    for (int d0 = 0; d0 < 4; ++d0) kload2(kf, kp0, d0);
    pA0 = D2_MF(kf[0], qr[0], D2_Z16); pA1 = D2_MF(kf[1], qr[0], D2_Z16); pA0 = D2_MF(kf[2], qr[1], pA0); pA1 = D2_MF(kf[3], qr[1], pA1);
    pA0 = D2_MF(kf[4], qr[2], pA0); pA1 = D2_MF(kf[5], qr[2], pA1); pA0 = D2_MF(kf[6], qr[3], pA0); pA1 = D2_MF(kf[7], qr[3], pA1);
    if (NT == 4) cmask2(pA0, pA1, 0, qrel, hi);
    { mhat = rowmax2(pA0, pA1);
#pragma unroll
      for (int r = 0; r < 16; ++r) { pA0[r] = D2_EX(pA0[r]); pA1[r] = D2_EX(pA1[r]); } }
    D2_WAIT_BAR(0);
    D2_DMA_K(3, 0); D2_DMA_V(1, D2_SLK); D2_ROT();
#pragma unroll
    for (int d0 = 0; d0 < 4; ++d0) kload2(kf, kp0 + sl_cur, d0);
    D2_WAIT_BAR(3);
#define D2_PKW(P, i) cvtpk_s(P[i], P[(i) + 1])
#define D2_PAF(k) __builtin_bit_cast(bf16x8, pw##k)
#define D2_VFR(i) (bf16x8){vlo[i][0], vlo[i][1], vlo[i][2], vlo[i][3], vhi[i][0], vhi[i][1], vhi[i][2], vhi[i][3]}
#define D2_VRD(s, i) do { vlo[s] = vtr(vp_ + ((((i) & 3) * 4096) + (((i) >> 2) * 1024))); vhi[s] = vtr(vp_ + ((((i) & 3) * 4096) + (((i) >> 2) * 1024) + 512)); } while (0)
#define D2_KRD(G, d0) do { if (G) { kload2(kf, kp0 + sl_next, d0); SBAR(); } } while (0)
#define D2_GAPA(MF_, a0, a1, a2, a3, W0, W1, PW) do { MF_; sacc += a0; sacc += a1; sacc += a2; sacc += a3; D2_PIN(sacc); W0; W1; D2_PIN(PW); SBAR(); } while (0)
#define D2_GAPB(j, K_, X, e) do { o[(j) & 3] = D2_MF(D2_PAF(K_), D2_VFR((j) & 7), o[(j) & 3]); X[e] = D2_EX(X[e]); X[(e) + 1] = D2_EX(X[(e) + 1]); D2_PIN(X); SBAR(); } while (0)
#define D2_STEP(C0, C1, P0, P1, t, MASK, GK, GV, GL) do { SBAR(); \
    const lds_cptr vp_ = vp0 + 2 * sl_prev; \
    D2_VRD(0, 0); SBAR(); float sacc = P0[0] + P0[1]; \
                          D2_GAPA(C0 = D2_MF(kf[0], qr[0], D2_Z16), P0[2], P0[3], P0[4], P0[5],     pw0[0] = D2_PKW(P0, 0),  pw0[1] = D2_PKW(P0, 2),  pw0); \
    D2_VRD(1, 1); SBAR(); D2_GAPA(C1 = D2_MF(kf[1], qr[0], D2_Z16), P0[6], P0[7], P0[8], P0[9],     pw0[2] = D2_PKW(P0, 4),  pw0[3] = D2_PKW(P0, 6),  pw0); \
    D2_VRD(2, 2); SBAR(); D2_GAPA(C0 = D2_MF(kf[2], qr[1], C0),     P0[10], P0[11], P0[12], P0[13], pw1[0] = D2_PKW(P0, 8),  pw1[1] = D2_PKW(P0, 10), pw1); \
    D2_VRD(3, 3); SBAR(); D2_GAPA(C1 = D2_MF(kf[3], qr[1], C1),     P0[14], P0[15], P1[0], P1[1],   pw1[2] = D2_PKW(P0, 12), pw1[3] = D2_PKW(P0, 14), pw1); \
    D2_VRD(4, 4); SBAR(); D2_GAPA(C0 = D2_MF(kf[4], qr[2], C0),     P1[2], P1[3], P1[4], P1[5],     pw2[0] = D2_PKW(P1, 0),  pw2[1] = D2_PKW(P1, 2),  pw2); \
    D2_VRD(5, 5); SBAR(); D2_GAPA(C1 = D2_MF(kf[5], qr[2], C1),     P1[6], P1[7], P1[8], P1[9],     pw2[2] = D2_PKW(P1, 4),  pw2[3] = D2_PKW(P1, 6),  pw2); \
    D2_VRD(6, 6); SBAR(); D2_GAPA(C0 = D2_MF(kf[6], qr[3], C0),     P1[10], P1[11], P1[12], P1[13], pw3[0] = D2_PKW(P1, 8),  pw3[1] = D2_PKW(P1, 10), pw3); \
    D2_VRD(7, 7); SBAR(); D2_GAPA(C1 = D2_MF(kf[7], qr[3], C1),     P1[14], P1[15], 0.f, 0.f,       pw3[2] = D2_PKW(P1, 12), pw3[3] = D2_PKW(P1, 14), pw3); \
    l_reg += sacc; \
    if (GK) D2_DMA_K((t) + 3, sl_cur); if (GV) D2_DMA_V((t) + 1, sl_next);                                                  \
    if (MASK) cmask2(C0, C1, (t) - (NT - 4), qrel, hi); \
    { const float rm = rowmax2(C0, C1) - mhat; resc = false;                                                                 \
      if (__builtin_expect(__any(rm > ATT_THR), 0)) { const float dl = __builtin_fmaxf(rm, 0.f); mhat += dl;                \
          const float f = __builtin_amdgcn_exp2f(-dl); l_reg *= f; if (hi == 0) wsf[r32] = f; resc = true; } } \
    SBAR(); \
    D2_GAPB(0, 0, C0, 0);   D2_VRD(0, 8);  SBAR(); D2_GAPB(1, 0, C0, 2);   D2_VRD(1, 9);  SBAR(); D2_GAPB(2, 0, C0, 4);   D2_VRD(2, 10); SBAR(); D2_GAPB(3, 0, C0, 6);   D2_VRD(3, 11); SBAR(); \
    D2_GAPB(4, 1, C0, 8);   D2_VRD(4, 12); SBAR(); D2_GAPB(5, 1, C0, 10);  D2_VRD(5, 13); SBAR(); D2_GAPB(6, 1, C0, 12);  D2_VRD(6, 14); SBAR(); D2_GAPB(7, 1, C0, 14);  D2_VRD(7, 15); SBAR(); \
    D2_KRD(GL, 0); D2_GAPB(8, 2, C1, 0);  D2_KRD(GL, 1); D2_GAPB(9, 2, C1, 2);  D2_KRD(GL, 2); D2_GAPB(10, 2, C1, 4);  D2_KRD(GL, 3); D2_GAPB(11, 2, C1, 6); \
    D2_GAPB(12, 3, C1, 8);  D2_GAPB(13, 3, C1, 10); D2_GAPB(14, 3, C1, 12); D2_GAPB(15, 3, C1, 14); \
    } while (0)
    int t = 1;
    for (; t + 5 < NT; t += 2) {
        D2_STEP(pB0, pB1, pA0, pA1, t, false, true, true, true);     D2_WAIT_BAR(3); D2_RESC(); D2_ROT();
        D2_STEP(pA0, pA1, pB0, pB1, t + 1, false, true, true, true); D2_WAIT_BAR(3); D2_RESC(); D2_ROT();
    }
#define D2_ENDW(tt) do { if ((tt) + 3 < NT) { D2_WAIT_BAR(3); } else if ((tt) + 2 < NT) { D2_WAIT_BAR(2); } else { D2_WAIT_BAR(0); } } while (0)
    for (; t + 1 < NT; t += 2) {
        D2_STEP(pB0, pB1, pA0, pA1, t, true, (t + 3 < NT), (t + 1 < NT), (t + 1 < NT));         D2_ENDW(t);     D2_RESC(); D2_ROT();
        D2_STEP(pA0, pA1, pB0, pB1, t + 1, true, (t + 4 < NT), (t + 2 < NT), (t + 2 < NT));     D2_ENDW(t + 1); D2_RESC(); D2_ROT();
    }
    D2_STEP(pB0, pB1, pA0, pA1, NT - 1, true, false, false, false); D2_RESC();
    { float sacc = pB0[0] + pB0[1];
#pragma unroll
      for (int r = 2; r < 16; ++r) sacc += pB0[r];
#pragma unroll
      for (int r = 0; r < 16; ++r) sacc += pB1[r];
      l_reg += sacc;
      pw0 = (u32x4){D2_PKW(pB0, 0), D2_PKW(pB0, 2), D2_PKW(pB0, 4), D2_PKW(pB0, 6)}; pw1 = (u32x4){D2_PKW(pB0, 8), D2_PKW(pB0, 10), D2_PKW(pB0, 12), D2_PKW(pB0, 14)};
      pw2 = (u32x4){D2_PKW(pB1, 0), D2_PKW(pB1, 2), D2_PKW(pB1, 4), D2_PKW(pB1, 6)}; pw3 = (u32x4){D2_PKW(pB1, 8), D2_PKW(pB1, 10), D2_PKW(pB1, 12), D2_PKW(pB1, 14)};
      const lds_cptr vp_ = vp0 + 2 * sl_cur; SBAR();
#pragma unroll
      for (int i = 0; i < 8; ++i) D2_VRD(i, i);
      o[0] = D2_MF(D2_PAF(0), D2_VFR(0), o[0]); o[1] = D2_MF(D2_PAF(0), D2_VFR(1), o[1]); o[2] = D2_MF(D2_PAF(0), D2_VFR(2), o[2]); o[3] = D2_MF(D2_PAF(0), D2_VFR(3), o[3]);
      o[0] = D2_MF(D2_PAF(1), D2_VFR(4), o[0]); o[1] = D2_MF(D2_PAF(1), D2_VFR(5), o[1]); o[2] = D2_MF(D2_PAF(1), D2_VFR(6), o[2]); o[3] = D2_MF(D2_PAF(1), D2_VFR(7), o[3]);
      SBAR();
#pragma unroll
      for (int i = 0; i < 8; ++i) D2_VRD(i, i + 8);
      o[0] = D2_MF(D2_PAF(2), D2_VFR(0), o[0]); o[1] = D2_MF(D2_PAF(2), D2_VFR(1), o[1]); o[2] = D2_MF(D2_PAF(2), D2_VFR(2), o[2]); o[3] = D2_MF(D2_PAF(2), D2_VFR(3), o[3]);
      o[0] = D2_MF(D2_PAF(3), D2_VFR(4), o[0]); o[1] = D2_MF(D2_PAF(3), D2_VFR(5), o[1]); o[2] = D2_MF(D2_PAF(3), D2_VFR(6), o[2]); o[3] = D2_MF(D2_PAF(3), D2_VFR(7), o[3]); }
#undef D2_DMA_K
#undef D2_DMA_V
#undef D2_ROT
#undef D2_EX
#undef D2_RESC
#undef D2_PKW
#undef D2_PAF
#undef D2_VFR
#undef D2_VRD
#undef D2_KRD
#undef D2_ENDW
#undef D2_GAPA
#undef D2_GAPB
#undef D2_STEP
    { auto rr = __builtin_amdgcn_permlane32_swap(__float_as_uint(l_reg), __float_as_uint(l_reg), false, false); l_reg = __uint_as_float(rr[0]) + __uint_as_float(rr[1]); }
    ALAS float* li_l = wsf + 32;
    if (hi == 0) li_l[r32] = l_reg; asm volatile("s_waitcnt lgkmcnt(0)" ::: "memory");
    float rli[16];
#pragma unroll
    for (int r = 0; r < 16; ++r) rli[r] = __builtin_amdgcn_rcpf(li_l[crow(r, hi)]);
    if constexpr (!SECOND) {
        float* Sw = S1 + (size_t)R0 * OP; const unsigned ooff = (unsigned)(4 * hi * OP + r32);
#pragma unroll
        for (int r = 0; r < 16; ++r) { float* rowp = Sw + (size_t)((r & 3) + 8 * (r >> 2)) * OP;
#pragma unroll
            for (int d0 = 0; d0 < 4; ++d0) rowp[ooff + d0 * 32] = o[d0][r] * rli[r]; }
    } else {
        const float* Sw = S1 + (size_t)R0 * OP; const unsigned ooff = (unsigned)(4 * hi * OP + r32), ooff8 = (unsigned)(4 * hi * OBP + r32);
        float gn[4];
#pragma unroll
        for (int d0 = 0; d0 < 4; ++d0) gn[d0] = gsub[d0 * 32 + r32] * gmul;
#pragma unroll
        for (int r = 0; r < 16; ++r) { const float* srow = Sw + (size_t)((r & 3) + 8 * (r >> 2)) * OP; float d[4]; float ss = 0.f;
            unsigned char* orowp = (unsigned char*)Og + (size_t)(R0 + (r & 3) + 8 * (r >> 2)) * OBP;
#pragma unroll
            for (int d0 = 0; d0 < 4; ++d0) { d[d0] = srow[ooff + d0 * 32] - lam * (o[d0][r] * rli[r]); ss += d[d0] * d[d0]; }
            ss += __builtin_bit_cast(float, __builtin_amdgcn_update_dpp(0, __builtin_bit_cast(int, ss), 0xB1, 0xf, 0xf, true));
            ss += __builtin_bit_cast(float, __builtin_amdgcn_update_dpp(0, __builtin_bit_cast(int, ss), 0x4E, 0xf, 0xf, true));
            ss += __builtin_bit_cast(float, __builtin_amdgcn_update_dpp(0, __builtin_bit_cast(int, ss), 0x141, 0xf, 0xf, true));
            ss += __builtin_bit_cast(float, __builtin_amdgcn_update_dpp(0, __builtin_bit_cast(int, ss), 0x140, 0xf, 0xf, true));
            { auto rr = __builtin_amdgcn_permlane16_swap(__float_as_uint(ss), __float_as_uint(ss), false, false); ss = __uint_as_float(rr[0]) + __uint_as_float(rr[1]); }
            const float rs = __builtin_amdgcn_rsqf(ss * (1.f / 128.f) + 1e-5f);
#pragma unroll
            for (int d0 = 0; d0 < 4; ++d0) { const unsigned w = quad_pack_fp8(d[d0] * rs * gn[d0] * OB8_SCALE);
                if ((r32 & 3) == 0) *(unsigned*)(orowp + (ooff8 + d0 * 32)) = w; }
            if ((r & 1) == 1) asm volatile("" ::: "memory"); }
    }
    asm volatile("s_waitcnt lgkmcnt(0)\n\ts_barrier" ::: "memory");
}
#undef D2_WAIT_BAR
#undef D2_PIN
#undef D2_MF
#undef D2_MX3
#undef D2_Z16
#undef SBAR
}

#define LAS __attribute__((address_space(3)))

#define XB_TMO      128
#define XB_XCNT(j)  (256  + 64 * (j))
#define XB_XSUB(j)  (1280 + 64 * (j))
#define XB_XGEN(j)  (2304 + 64 * (j))
#define XB_TOP      3328
#define XB_TOPGEN   3392
#define XCD_BAR_WORDS 3456
#define XB_SPIN_CAP (1u << 18)

__device__ __forceinline__ unsigned xb_ld(unsigned* p)              { return __hip_atomic_load(p, __ATOMIC_RELAXED, __HIP_MEMORY_SCOPE_AGENT); }
__device__ __forceinline__ unsigned xb_add(unsigned* p, unsigned v) { return __hip_atomic_fetch_add(p, v, __ATOMIC_RELAXED, __HIP_MEMORY_SCOPE_AGENT); }
__device__ __forceinline__ unsigned xb_xcc_id() { return (unsigned)__builtin_amdgcn_s_getreg((3 << 11) | 20) & 0xFu; }
#define XB_SPIN(cond, bar) do { unsigned _sp = 0; while (cond) { __builtin_amdgcn_s_sleep(1); \
    if ((++_sp & 255u) == 0u) { if (xb_ld(&(bar)[XB_TMO])) break; if (_sp > XB_SPIN_CAP) { atomicAdd(&(bar)[XB_TMO], 1u); break; } } } } while (0)

struct XcdBarrier {
    unsigned* bar; unsigned x;
    volatile LAS unsigned* st;
};

__device__ __forceinline__ XcdBarrier xcd_barrier_post(unsigned* bar, volatile LAS unsigned* st, bool thread0) {
    XcdBarrier b; b.bar = bar; b.x = xb_xcc_id(); b.st = st;
    if (thread0) (void)xb_add(&bar[XB_XCNT(b.x)], 1u);
    return b;
}
__device__ __forceinline__ void xcd_barrier_complete(unsigned* bar, unsigned x, unsigned& nloc, unsigned& nx) {
    const unsigned G = gridDim.x * gridDim.y * gridDim.z;
    unsigned sum, cnt, mine, sp = 0u;
    for (;;) {
        sum = 0u; cnt = 0u; mine = 0u;
#pragma unroll
        for (unsigned j = 0; j < 16; ++j) { const unsigned c = xb_ld(&bar[XB_XCNT(j)]); sum += c; cnt += (c > 0u) ? 1u : 0u; mine = (j == x) ? c : mine; }
        if (sum == G) break;
        __builtin_amdgcn_s_sleep(1);
        if ((++sp & 255u) == 0u) { if (xb_ld(&bar[XB_TMO])) break; if (sp > XB_SPIN_CAP) { atomicAdd(&bar[XB_TMO], 1u); break; } }
    }
    nloc = mine > 0u ? mine : 1u; nx = cnt > 0u ? cnt : 1u;
}

__device__ __forceinline__ void xcd_barrier(const XcdBarrier& b, bool thread0) {
    asm volatile("s_waitcnt vmcnt(0)" ::: "memory");
    __syncthreads();
    if (thread0) {
        unsigned* bar = b.bar;
        __builtin_amdgcn_s_waitcnt(0);
        unsigned nloc = b.st[0], nx = b.st[1];
        if (nloc == 0u) { xcd_barrier_complete(bar, b.x, nloc, nx); b.st[0] = nloc; b.st[1] = nx; }
        const unsigned old = xb_add(&bar[XB_XSUB(b.x)], 1u);
        const unsigned gen = old / nloc;
        if (old + 1u == (gen + 1u) * nloc) {
            __builtin_amdgcn_fence(__ATOMIC_RELEASE, "agent");
            asm volatile("s_waitcnt vmcnt(0)" ::: "memory");
            const unsigned og = xb_add(&bar[XB_TOP], 1u);
            const unsigned tg = og / nx;
            if (og + 1u == (tg + 1u) * nx) xb_add(&bar[XB_TOPGEN], 1u);
            else XB_SPIN(xb_ld(&bar[XB_TOPGEN]) == tg, bar);
            __builtin_amdgcn_fence(__ATOMIC_ACQUIRE, "agent");
            xb_add(&bar[XB_XGEN(b.x)], 1u);
            asm volatile("s_waitcnt vmcnt(0)" ::: "memory");
        } else {
            XB_SPIN(xb_ld(&bar[XB_XGEN(b.x)]) == gen, bar);
            __builtin_amdgcn_fence(__ATOMIC_ACQUIRE, "agent");
            asm volatile("s_waitcnt vmcnt(0)" ::: "memory");
        }
    }
    __syncthreads();
}

constexpr int NWAVES = 8;
constexpr int NTOK = 16384, DM = 2048, SEQ = 2048, NHEAD = 16, NLAYER = 4, NEXP = 16, DEXP = 1024;
constexpr int XS_ROWS = 36864;
constexpr float LN_EPS = 1e-5f;
constexpr float DN_ALPHA = 1.6817928305074292f;
constexpr float LOG2E = 1.4426950408889634f;
constexpr float SB_QSCALE = 0.08838834764831845f * LOG2E;
constexpr float DF_QSCALE = 0.125f * LOG2E;
#ifndef MK_MULTI
#define MK_MULTI 0
#endif
#ifndef MOE_F8
#define MOE_F8 1
#endif
#ifndef QKV8_A
#define QKV8_A 1
#endif
#ifndef QKV8_B
#define QKV8_B 0
#endif
#ifndef DF_RING
#define DF_RING 1
#endif
constexpr int NSTEPS = 1 + 8 * NLAYER;

constexpr size_t MiB = 1u << 20;
constexpr size_t WS_CTL = 0, CTL_ZERO_BYTES = 256 * 1024;
constexpr size_t WS_COS = 1 * MiB, WS_SIN = WS_COS + 256 * 1024;
constexpr size_t WS_WR = 2 * MiB;
constexpr size_t WS_CNT = 3 * MiB;
constexpr size_t WS_RE = WS_CNT + 64 * 1024;
constexpr size_t WS_RW = WS_RE + 64 * 1024;
constexpr size_t WS_RP = WS_RW + 128 * 1024;
constexpr int LDH = 2048;
constexpr int P8K2 = 2048, P8K1 = 1024;
constexpr size_t WS_WQKVA = 4 * MiB;
constexpr size_t WS_WOA = WS_WQKVA + 56 * MiB;
constexpr size_t WS_WQKVB = WS_WOA + 16 * MiB;
constexpr size_t WS_WOB = WS_WQKVB + 36 * MiB;
constexpr size_t WS_WGU = WS_WOB + 16 * MiB;
constexpr size_t WS_WDN = WS_WGU + 512 * MiB;
constexpr size_t WS_H = WS_WDN + 256 * MiB;
constexpr size_t WS_HB = WS_H + 128 * MiB;
constexpr size_t WS_QKV = WS_HB + 68 * MiB;
constexpr size_t WS_OB = WS_QKV + 192 * MiB;
constexpr size_t WS_XS = WS_OB + 64 * MiB;
constexpr size_t WS_ACT = WS_XS + 144 * MiB;
constexpr size_t WS_YD = WS_ACT + 72 * MiB;
constexpr size_t WS_END = WS_YD + 144 * MiB;
static_assert(WS_END <= (size_t)2040 * MiB, "workspace map");
static_assert((size_t)2 * 6144 * LDH * 2 <= 56 * MiB && (size_t)8192 * LDH * 2 <= 36 * MiB && (size_t)2 * 2048 * P8K2 <= 16 * MiB && (size_t)64 * 2048 * P8K2 <= 512 * MiB && (size_t)64 * 2048 * P8K1 <= 256 * MiB, "weight regions");
static_assert((size_t)NTOK * LDH * 2 <= 68 * MiB && (size_t)NTOK * P8K2 <= 64 * MiB && (size_t)XS_ROWS * P8K2 <= 144 * MiB && (size_t)XS_ROWS * P8K1 <= 72 * MiB, "activation regions");
constexpr int CW_MTC = 8192;
constexpr int CW_BAR = 1024;
constexpr int LDS_BYTES = 147456;
constexpr int LDSCTL_OFF = 145408;
constexpr int RING_OFF = 0;
constexpr int LNX_OFF = 131072;

#define GAS __attribute__((address_space(1)))
typedef unsigned short bf16;
typedef unsigned v4u __attribute__((ext_vector_type(4)));
typedef unsigned v2u __attribute__((ext_vector_type(2)));
typedef float f32x4 __attribute__((ext_vector_type(4)));
typedef float f32x2 __attribute__((ext_vector_type(2)));
typedef _Float16 f16x4 __attribute__((ext_vector_type(4)));
__device__ __forceinline__ f32x4 ldh4(const _Float16* p) { return __builtin_convertvector(*(const f16x4*)p, f32x4); }
__device__ __forceinline__ void sth4(_Float16* p, f32x4 v) { __builtin_nontemporal_store(__builtin_convertvector(v, f16x4), (f16x4*)p); }
#define LDS_WAIT() asm volatile("s_waitcnt lgkmcnt(0)" ::: "memory")
#define VM_WAIT() asm volatile("s_waitcnt vmcnt(0)" ::: "memory")
__device__ __forceinline__ unsigned pk2(float lo, float hi) { unsigned r; asm volatile("v_cvt_pk_bf16_f32 %0, %1, %2" : "=v"(r) : "v"(lo), "v"(hi)); return r; }
__device__ __forceinline__ int opq_tid(int wave) { int t = tid_from_wave(wave); asm volatile("" : "+v"(t)); return t; }
__device__ __forceinline__ float dpp_sum(float v) {
    v += __builtin_bit_cast(float, __builtin_amdgcn_update_dpp(0, __builtin_bit_cast(int, v), 0xB1, 0xf, 0xf, true));
    v += __builtin_bit_cast(float, __builtin_amdgcn_update_dpp(0, __builtin_bit_cast(int, v), 0x4E, 0xf, 0xf, true));
    v += __builtin_bit_cast(float, __builtin_amdgcn_update_dpp(0, __builtin_bit_cast(int, v), 0x141, 0xf, 0xf, true));
    v += __builtin_bit_cast(float, __builtin_amdgcn_update_dpp(0, __builtin_bit_cast(int, v), 0x140, 0xf, 0xf, true));
    const int b = __builtin_bit_cast(int, v);
    const float s0 = __builtin_bit_cast(float, __builtin_amdgcn_readlane(b, 0)), s1 = __builtin_bit_cast(float, __builtin_amdgcn_readlane(b, 16));
    const float s2 = __builtin_bit_cast(float, __builtin_amdgcn_readlane(b, 32)), s3 = __builtin_bit_cast(float, __builtin_amdgcn_readlane(b, 48));
    return (s0 + s1) + (s2 + s3);
}
__device__ __forceinline__ float wave_sum(float v) {
#pragma unroll
    for (int o = 1; o < 64; o <<= 1) v += __shfl_xor(v, o);
    return v;
}

struct Args { const float* in[17]; float* out; unsigned char* ws; int s_lo, s_hi; };

__device__ __forceinline__ int map_row(int n, int mode) {
    if (mode == 0) return n;
    if (mode == 1) { const int c = n & 255, blk = c >> 6, d = c & 63; return (n & ~255) + ((d >> 5) << 7) + (blk << 5) + (d & 31); }
    return ((n >> 7) << 8) + (n & 127) + (mode == 3 ? 128 : 0);
}
__device__ __forceinline__ unsigned pk2h(float lo, float hi) { typedef _Float16 h2 __attribute__((ext_vector_type(2))); const f32x2 v = {lo, hi}; return __builtin_bit_cast(unsigned, __builtin_convertvector(v, h2)); }
__device__ __forceinline__ void cvt_load(f32x4 (&v)[16], const float* __restrict__ src, int pitch, int k0, int n0, int kind, int lane) {
    if (kind == 2) { const int kr = lane >> 3, n4 = (lane & 7) * 4; const float* p = src + (size_t)(k0 + kr) * pitch + n0 + n4;
#pragma unroll
        for (int i = 0; i < 16; ++i) v[i] = __builtin_nontemporal_load((const f32x4*)(p + (size_t)(8 * i) * pitch)); }
    else { const int kr = lane >> 4, n4 = (lane & 15) * 4; const float* p = src + (size_t)(k0 + kr) * pitch + n0 + n4;
#pragma unroll
        for (int i = 0; i < 16; ++i) v[i] = __builtin_nontemporal_load((const f32x4*)(p + (size_t)(4 * i) * pitch)); }
}
__device__ __forceinline__ void cvt_store(const f32x4 (&v)[16], unsigned char* __restrict__ dst, int dp, int mode, int k0, int n0, int kind, LAS float* scr, int lane) {
    if (kind == 2) {
        const int kr = lane >> 3, n4 = (lane & 7) * 4;
#pragma unroll
        for (int i = 0; i < 16; ++i) { LAS float* s = scr + (8 * i + kr) * 33 + n4; s[0] = v[i][0] * pg8::W8_SCALE; s[1] = v[i][1] * pg8::W8_SCALE; s[2] = v[i][2] * pg8::W8_SCALE; s[3] = v[i][3] * pg8::W8_SCALE; }
        LDS_WAIT();
        const int c = lane & 7;
#pragma unroll
        for (int j = 0; j < 4; ++j) { const int nl = (lane >> 3) + 8 * j; const int row = map_row(n0 + nl, mode);
            const LAS float* s = scr + (16 * c) * 33 + nl;
            v4u o; o.x = pg8::pack4_fp8(s[0], s[33], s[66], s[99]); o.y = pg8::pack4_fp8(s[132], s[165], s[198], s[231]);
            o.z = pg8::pack4_fp8(s[264], s[297], s[330], s[363]); o.w = pg8::pack4_fp8(s[396], s[429], s[462], s[495]);
            __builtin_nontemporal_store(o, (v4u*)(dst + (size_t)row * dp + k0 + 16 * c)); }
    } else {
        const int kr = lane >> 4, n4 = (lane & 15) * 4;
#pragma unroll
        for (int i = 0; i < 16; ++i) { LAS float* s = scr + (4 * i + kr) * 65 + n4; s[0] = v[i][0]; s[1] = v[i][1]; s[2] = v[i][2]; s[3] = v[i][3]; }
        LDS_WAIT();
        const int c = lane & 7;
#pragma unroll
        for (int j = 0; j < 8; ++j) { const int nl = (lane >> 3) + 8 * j; const int row = map_row(n0 + nl, mode);
            const LAS float* s = scr + (8 * c) * 65 + nl;
            v4u o; o.x = pk2h(s[0], s[65]); o.y = pk2h(s[130], s[195]); o.z = pk2h(s[260], s[325]); o.w = pk2h(s[390], s[455]);
            __builtin_nontemporal_store(o, (v4u*)(dst + (size_t)row * dp + (k0 + 8 * c) * 2)); }
    }
    LDS_WAIT();
}

__global__ void __launch_bounds__(NWAVES * 64, 2) yoco_fwd(Args args) {
    extern __shared__ __attribute__((aligned(16))) unsigned char lds_raw[];
    LAS unsigned char* const lds = (LAS unsigned char*)lds_raw;
    const int tid = threadIdx.x, lane = tid & 63, wave = __builtin_amdgcn_readfirstlane(tid >> 6);
    const int G = gridDim.x, bx = blockIdx.x;
    const int vcu = (G % 8 == 0) ? (bx % 8) * (G / 8) + bx / 8 : bx;
    unsigned char* const ws = args.ws;
    volatile LAS unsigned* const CTL = (volatile LAS unsigned*)(lds + LDSCTL_OFF);
    LAS int* const TAB = (LAS int*)(lds + LDSCTL_OFF + 64);
    for (int u = tid; u < (LDS_BYTES - LDSCTL_OFF) / 4; u += NWAVES * 64) ((LAS unsigned*)(lds + LDSCTL_OFF))[u] = 0u;
    __syncthreads();
    const int s_lo = args.s_lo, s_hi = args.s_hi;
    XcdBarrier bar; bar.bar = (unsigned*)(ws + WS_CTL) + CW_BAR; bar.x = 0; bar.st = nullptr;
    if (s_hi - s_lo > 1) bar = xcd_barrier_post((unsigned*)(ws + WS_CTL) + CW_BAR, CTL, tid == 0);
#ifndef PH_MASK
#define PH_MASK 0xFFFF
#endif
#define PHM(b) (((PH_MASK) >> (b)) & 1)
#ifndef PROBE_DUP
#define PROBE_DUP 0
#endif
#define PREP(b) _Pragma("unroll 1") for (int rep_ = 0; rep_ < ((((PROBE_DUP) >> (b)) & 1) ? 2 : 1); ++rep_) if ((rep_ == 1 && ((PROBE_DUP >> 12) & 1)) ? (xcd_barrier(bar, tid_from_wave(wave) == 0), true) : true)
#define IN(k) (s_lo <= (k) && (k) < s_hi)
#define SEAM(k) do { if ((k) + 1 < s_hi) xcd_barrier(bar, tid_from_wave(wave) == 0); } while (0)

    const float* const x_in = args.in[0];
    _Float16* const H = (_Float16*)(ws + WS_H); unsigned char* const HB8 = (unsigned char*)(ws + WS_OB + 32 * MiB);     bf16* const QKV = (bf16*)(ws + WS_QKV); bf16* const OB = (bf16*)(ws + WS_OB);
    bf16* const MIX = (bf16*)(ws + WS_YD);     bf16* const XS = (bf16*)(ws + WS_XS); float* const S1 = (float*)(ws + WS_XS); bf16* const ACT = (bf16*)(ws + WS_ACT); bf16* const YD = (bf16*)(ws + WS_YD);
    float* const WR = (float*)(ws + WS_WR);
    int* const CNT = (int*)(ws + WS_CNT); unsigned* const RE = (unsigned*)(ws + WS_RE); f32x2* const RW = (f32x2*)(ws + WS_RW); int* const RP = (int*)(ws + WS_RP);

    if (IN(0) && PHM(0)) { PREP(0) {
        const int tid = opq_tid(wave), lane = tid & 63;
        LAS float* scr = (LAS float*)(lds + RING_OFF + wave * 16896);
        const int gw = vcu * NWAVES + wave, NGW = G * NWAVES;
        constexpr int I0 = 2 * 3072, I1 = 8 * 1024, I2 = 128 * 512, I3 = 64 * 512, NITEMS = I0 + I1 + I2 + I3;
        static_assert(QKV8_A == 1 && QKV8_B == 0, "conversion table below: stick-breaking q|k|v and all other fp8 GEMM weights -> e4m3, differential q|k|v weights -> fp16");
#define CVT_DECODE(it_, SRC, PIT, DST, DP, MODE, K0, N0, KIND) do { int r = (it_); \
            if (r < I0) { const int job = r / 3072; r -= job * 3072; const int kb = r / 192, nb = r - kb * 192; \
                SRC = args.in[1] + (size_t)job * 2048 * 6144; PIT = 6144; DST = ws + WS_WQKVA + (size_t)job * 6144 * 2048; DP = 2048; MODE = 0; K0 = kb * 128; N0 = nb * 32; KIND = 2; break; } \
            r -= I0; \
            if (r < I1) { const int job = r >> 10; r &= 1023; const int r1_ = r; K0 = (r >> 6) * 128; N0 = (r & 63) * 32; PIT = 2048; MODE = 0; KIND = 2; DP = P8K2; \
                if (job < 2) { SRC = args.in[2] + (size_t)job * 2048 * 2048; DST = ws + WS_WOA + (size_t)job * 2048 * P8K2; } \
                else if (job >= 6) { SRC = args.in[5] + (size_t)(job - 6) * 2048 * 2048; DST = ws + WS_WOB + (size_t)(job - 6) * 2048 * P8K2; } \
                else { KIND = 1; DP = LDH * 2; K0 = (r1_ >> 5) * 64; N0 = (r1_ & 31) * 64; \
                    if (job == 2) { SRC = args.in[4]; DST = ws + WS_WQKVB; MODE = 1; } \
                    else if (job == 3) { SRC = args.in[3]; PIT = 4096; DST = ws + WS_WQKVB + (size_t)2048 * LDH * 2; MODE = 1; } \
                    else if (job == 4) { SRC = args.in[3] + 2048; PIT = 4096; DST = ws + WS_WQKVB + (size_t)4096 * LDH * 2; } \
                    else { SRC = args.in[4] + (size_t)2048 * 2048; DST = ws + WS_WQKVB + (size_t)6144 * LDH * 2; MODE = 1; } } \
                break; } \
            r -= I1; \
            if (r < I2) { const int job = r >> 9; r &= 511; const int le = job >> 1, up = job & 1;     \
                SRC = (up ? args.in[15] : args.in[14]) + (size_t)le * 2048 * 1024; PIT = 1024; DST = ws + WS_WGU + (size_t)le * 2048 * P8K2; DP = P8K2; MODE = 2 + up; K0 = (r >> 5) * 128; N0 = (r & 31) * 32; KIND = 2; break; } \
            r -= I2; \
            { const int le = r >> 9; r &= 511; SRC = args.in[16] + (size_t)le * 1024 * 2048; PIT = 2048; DST = ws + WS_WDN + (size_t)le * 2048 * P8K1; DP = P8K1; MODE = 0; K0 = (r >> 6) * 128; N0 = (r & 63) * 32; KIND = 2; } \
        } while (0)
        { const float* sA; const float* sB; unsigned char* dA; unsigned char* dB; int pA, pB, qA, qB, mA, mB, kA, kB, nA, nB, tA, tB; f32x4 va[16], vb[16];
          int it = gw;
          if (it < NITEMS) { CVT_DECODE(it, sA, pA, dA, qA, mA, kA, nA, tA); cvt_load(va, sA, pA, kA, nA, tA, lane);
            for (;;) {
                if (it + NGW < NITEMS) { CVT_DECODE(it + NGW, sB, pB, dB, qB, mB, kB, nB, tB); cvt_load(vb, sB, pB, kB, nB, tB, lane); }
                cvt_store(va, dA, qA, mA, kA, nA, tA, scr, lane); it += NGW; if (it >= NITEMS) break;
                if (it + NGW < NITEMS) { CVT_DECODE(it + NGW, sA, pA, dA, qA, mA, kA, nA, tA); cvt_load(va, sA, pA, kA, nA, tA, lane); }
                cvt_store(vb, dB, qB, mB, kB, nB, tB, scr, lane); it += NGW; if (it >= NITEMS) break;
            } } }
#undef CVT_DECODE
        for (size_t i = (size_t)gw * 64 + lane; i < (size_t)NTOK * DM / 4; i += (size_t)NGW * 64) {
            const f32x4 v = ((const f32x4*)x_in)[i];
            ((unsigned*)HB8)[i] = pg8::pack4_fp8(v[0], v[1], v[2], v[3]); }
        for (int i = bx * (NWAVES * 64) + tid; i < NLAYER * 20 * 2048; i += G * NWAVES * 64) { const int k = i & 2047, c = (i >> 11) % 20, l = i / (20 * 2048);
            WR[i] = c < 4 ? args.in[12][((size_t)l * 2048 + k) * 4 + c] : args.in[13][(((size_t)l * 4 + ((c - 4) >> 2)) * 2048 + k) * 4 + ((c - 4) & 3)]; }
        }
        SEAM(0);
    }

    for (int L = 0; L < NLAYER; ++L) {
        const int sb = 1 + 8 * L; const bool typeA = L < 2;
        if (IN(sb + 0)) {
            if (typeA && PHM(1)) { PREP(1) {
                pg8::StaticOrder S; S.init(NTOK, 6144, G, bx);
                if (QKV8_A) { pg8::Gemm g{(const bf16*)HB8, (const bf16*)(ws + WS_WQKVA + (size_t)L * 6144 * 2048), NTOK, 6144, DM / 2, DM / 2, wave}; pg8::EpiQkv E{QKV, 6144, 2048, SB_QSCALE, 1.f / pg8::W8_SCALE};
                    pg8::gemm_phase<pg8::EpiQkv, pg8::StaticOrder, true, true, true>(lds + RING_OFF, g, S, E); }
                } static_assert(QKV8_A == 1, "the stick-breaking layers' q|k|v GEMM takes the e4m3 copy of the stream");
            } else if (!typeA && PHM(2)) { PREP(2) {
                const int N = (L == 2) ? 6144 : 2048;
                pg8::StaticOrder S; S.init(NTOK, N, G, bx);
                if (QKV8_B) { pg8::Gemm g{(const bf16*)HB8, (const bf16*)(ws + WS_WQKVB + (L == 2 ? (size_t)0 : (size_t)6144 * 2048)), NTOK, N, DM / 2, DM / 2, wave};
                    pg8::EpiRope E{QKV, 6144, 2048, 4096, DF_QSCALE, 1.f / pg8::W8_SCALE};
                    pg8::gemm_phase<pg8::EpiRope, pg8::StaticOrder, true, true, true>(lds + RING_OFF, g, S, E); }
                else { pg8::Gemm g{(const bf16*)H, (const bf16*)(ws + WS_WQKVB) + (L == 2 ? (size_t)0 : (size_t)6144 * LDH), NTOK, N, DM, LDH, wave};
                    pg8::EpiRope E{QKV, 6144, 2048, 4096, DF_QSCALE, 1.f};
                    pg8::gemm_phase<pg8::EpiRope, pg8::StaticOrder, true, true, false, true>(lds + RING_OFF, g, S, E); } }
            }
            SEAM(sb + 0);
        }
        if (IN(sb + 1)) {
            if (typeA && PHM(3)) {
                for (int id_ = vcu; id_ < 512 * (1 + ((PROBE_DUP >> 3) & 1)); id_ += G) { if (((PROBE_DUP >> 12) & 1) && id_ >= 512 && id_ < 512 + G) xcd_barrier(bar, tid_from_wave(wave) == 0); const int id = id_ & 511; const int bh = id >> 2, p = id & 3, b = bh >> 4, h = bh & 15;
                    const bf16* Qg = QKV + (size_t)b * SEQ * 6144 + h * 128; bf16* Og = (bf16*)((unsigned char*)OB + (size_t)b * SEQ * P8K2 + h * 128);
                    att::sb_block(Qg, Qg + 2048, Qg + 4096, Og, 7 - p, (att::ldsp)(lds + RING_OFF), wave);
                    att::sb_block(Qg, Qg + 2048, Qg + 4096, Og, p, (att::ldsp)(lds + RING_OFF), wave); }
            } else if (!typeA && PHM(4)) {
                const int lane = opq_tid(wave) & 63;
                const int i = L - 2; const float lam_init = (L == 2) ? 0.47071301834264183f : 0.5560582041556061f;
                const float* lp = args.in[6] + (size_t)i * 256;
                const float sa = dpp_sum(lp[lane] * lp[64 + lane]), sb2 = dpp_sum(lp[128 + lane] * lp[192 + lane]);
                const float lam = __builtin_amdgcn_exp2f(sa * LOG2E) - __builtin_amdgcn_exp2f(sb2 * LOG2E) + lam_init;
                const float* gsub = args.in[7] + (size_t)i * 128; const float gmul = 1.f - lam_init;
                for (int id_ = vcu; id_ < 512 * (1 + ((PROBE_DUP >> 4) & 1)); id_ += G) { if (((PROBE_DUP >> 12) & 1) && id_ >= 512 && id_ < 512 + G) xcd_barrier(bar, tid_from_wave(wave) == 0); const int id = id_ & 511; const int bh = id >> 2, p = id & 3, b = bh >> 4, h = bh & 15;
                    const bf16* Qg = QKV + (size_t)b * SEQ * 6144 + h * 128; bf16* Og = (bf16*)((unsigned char*)OB + (size_t)b * SEQ * P8K2 + h * 128); float* Sg = S1 + (size_t)b * SEQ * DM + h * 128;
#pragma unroll 1
                    for (int w = 0; w < 2; ++w) { const int qb = w ? p : 7 - p;
#if DF_RING
                        att::diff_pass2<false>(Qg, Qg + 2048, Qg + 4096, Sg, Og, qb, lam, gsub, gmul, (att::ldsp)(lds + RING_OFF), wave);
                        att::diff_pass2<true>(Qg + 64, Qg + 2048 + 64, Qg + 4096, Sg, Og, qb, lam, gsub, gmul, (att::ldsp)(lds + RING_OFF), wave); } }
#else
                        att::diff_pass<false>(Qg, Qg + 2048, Qg + 4096, Sg, Og, qb, lam, gsub, gmul, (att::ldsp)(lds + RING_OFF), wave);
                        att::diff_pass<true>(Qg + 64, Qg + 2048 + 64, Qg + 4096, Sg, Og, qb, lam, gsub, gmul, (att::ldsp)(lds + RING_OFF), wave); } }
#endif
            }
            SEAM(sb + 1);
        }
        if (IN(sb + 2)) { if (PHM(5)) {
            pg8::Gemm g{OB, (const bf16*)(ws + (typeA ? WS_WOA : WS_WOB) + (size_t)(L & 1) * 2048 * P8K2), NTOK, DM, DM / 2, P8K2 / 2, wave}; pg8::StaticOrder S; S.init(NTOK, DM, G, bx);
            pg8::EpiQkv E{MIX, DM, 0, 1.f, 1.f / (pg8::W8_SCALE * att::OB8_SCALE)};
            pg8::gemm_phase<pg8::EpiQkv, pg8::StaticOrder, true, true, true>(lds + RING_OFF, g, S, E); }
            SEAM(sb + 2);
        }
        if (IN(sb + 3)) { if (PHM(6)) {
            const int tid = opq_tid(wave), lane = tid & 63;
            const float* lng = args.in[8] + (size_t)L * DM; const float* lnb = args.in[9] + (size_t)L * DM; const float* wr = WR + (size_t)L * 20 * 2048;
            LAS int* eid = (LAS int*)(lds + LNX_OFF + 2048);
            LAS float* lgt = (LAS float*)(lds + LNX_OFF + 4096);
            LAS unsigned* rows8 = (LAS unsigned*)(lds + RING_OFF);
            for (int c = bx; c < 256; c += G) {
#pragma unroll 1
                for (int grp = 0; grp < 4; ++grp) {
                    const int rloc = wave * 8 + grp * 2; const size_t row0 = (size_t)64 * c + rloc;
                    f32x4 v[2][8]; float mu[2], rstd[2];
#pragma unroll
                    for (int rr = 0; rr < 2; ++rr) {
                        if (L == 0) { const f32x4* hp = (const f32x4*)(x_in + (row0 + rr) * DM) + lane;
#pragma unroll
                            for (int j = 0; j < 8; ++j) v[rr][j] = hp[64 * j]; }
                        else { const _Float16* hq = H + (row0 + rr) * DM + 4 * lane;
#pragma unroll
                            for (int j = 0; j < 8; ++j) v[rr][j] = ldh4(hq + 256 * j); } }
#pragma unroll
                    for (int rr = 0; rr < 2; ++rr) { const v2u* mp = (const v2u*)(MIX + (row0 + rr) * DM) + lane;
#pragma unroll
                        for (int j = 0; j < 8; ++j) { const v2u a = mp[64 * j];
                            const f32x4 fa = {__uint_as_float(a.x << 16), __uint_as_float(a.x & 0xffff0000u), __uint_as_float(a.y << 16), __uint_as_float(a.y & 0xffff0000u)};
                            v[rr][j] = v[rr][j] * DN_ALPHA + fa; } }
#pragma unroll
                    for (int rr = 0; rr < 2; ++rr) { float s = 0.f;
#pragma unroll
                        for (int j = 0; j < 8; ++j) s += (v[rr][j][0] + v[rr][j][1]) + (v[rr][j][2] + v[rr][j][3]);
                        mu[rr] = dpp_sum(s) * (1.f / DM); float q = 0.f;
#pragma unroll
                        for (int j = 0; j < 8; ++j) { const f32x4 d = v[rr][j] - mu[rr]; q += (d[0] * d[0] + d[1] * d[1]) + (d[2] * d[2] + d[3] * d[3]); }
                        rstd[rr] = 1.f / sqrtf(dpp_sum(q) * (1.f / DM) + LN_EPS); }
#pragma unroll
                    for (int j = 0; j < 8; ++j) { const f32x4 gg = ((const f32x4*)lng)[64 * j + lane], bb = ((const f32x4*)lnb)[64 * j + lane];
#pragma unroll
                        for (int rr = 0; rr < 2; ++rr) { v[rr][j] = (v[rr][j] - mu[rr]) * rstd[rr] * gg + bb; sth4(H + (row0 + rr) * DM + 256 * j + 4 * lane, v[rr][j]);
                            if (c == bx) rows8[(rloc + rr) * 512 + 64 * j + lane] = pg8::pack4_fp8(v[rr][j][0], v[rr][j][1], v[rr][j][2], v[rr][j][3]); } }
                    f32x4 wn[8];
                    { const f32x4* wp = (const f32x4*)wr + lane;
#pragma unroll
                      for (int j = 0; j < 8; ++j) wn[j] = wp[64 * j]; }
#pragma unroll 1
                    for (int cc = 0; cc < 20; ++cc) { f32x4 w[8];
#pragma unroll
                        for (int j = 0; j < 8; ++j) w[j] = wn[j];
                        { const f32x4* wp = (const f32x4*)(wr + (cc < 19 ? cc + 1 : 19) * 2048) + lane;
#pragma unroll
                          for (int j = 0; j < 8; ++j) wn[j] = wp[64 * j]; }
                        float a[2] = {0.f, 0.f};
#pragma unroll
                        for (int j = 0; j < 8; ++j) {
#pragma unroll
                            for (int rr = 0; rr < 2; ++rr) a[rr] += (v[rr][j][0] * w[j][0] + v[rr][j][1] * w[j][1]) + (v[rr][j][2] * w[j][2] + v[rr][j][3] * w[j][3]); }
#pragma unroll
                        for (int rr = 0; rr < 2; ++rr) a[rr] = dpp_sum(a[rr]);
                        if (lane == 0) { lgt[rloc * 20 + cc] = a[0]; lgt[(rloc + 1) * 20 + cc] = a[1]; } }
                }
                LDS_WAIT();
                if (lane < 8) {
                    const int rl = wave * 8 + lane; const LAS float* lg = lgt + rl * 20;
                    int gsel = 0; float gm = lg[0];
#pragma unroll
                    for (int i = 1; i < 4; ++i) { const float x = lg[i]; if (x > gm) { gm = x; gsel = i; } }
                    float gden = 0.f;
#pragma unroll
                    for (int i = 0; i < 4; ++i) gden += __builtin_amdgcn_exp2f((lg[i] - gm) * LOG2E);
                    const float gw_ = 1.f / gden;
                    const LAS float* li = lg + 4 + 4 * gsel;
                    const float l0 = li[0], l1 = li[1], l2 = li[2], l3 = li[3];
                    int i0 = 0; float v0 = l0;
                    if (l1 > v0) { v0 = l1; i0 = 1; } if (l2 > v0) { v0 = l2; i0 = 2; } if (l3 > v0) { v0 = l3; i0 = 3; }
                    int i1 = -1; float v1 = 0.f;
                    if (i0 != 0) { v1 = l0; i1 = 0; }
                    if (i0 != 1 && (i1 < 0 || l1 > v1)) { v1 = l1; i1 = 1; }
                    if (i0 != 2 && (i1 < 0 || l2 > v1)) { v1 = l2; i1 = 2; }
                    if (i0 != 3 && (i1 < 0 || l3 > v1)) { v1 = l3; i1 = 3; }
                    const float t = __builtin_amdgcn_exp2f((v1 - v0) * LOG2E); const float w0 = gw_ / (1.f + t), w1 = gw_ * t / (1.f + t);
                    eid[2 * rl] = gsel * 4 + i0; eid[2 * rl + 1] = gsel * 4 + i1; RW[(size_t)64 * c + rl] = (f32x2){w0, w1};
                }
                __syncthreads();
                if (wave == 0) {
                    const int ea = eid[lane], eb = eid[64 + lane]; int ra = 0, rb = 0, cnt = 0; const unsigned long long lt = (1ull << lane) - 1ull;
#pragma unroll
                    for (int e = 0; e < 16; ++e) { const unsigned long long ma = __ballot(ea == e), mb = __ballot(eb == e);
                        if (ea == e) ra = __popcll(ma & lt); if (eb == e) rb = __popcll(ma) + __popcll(mb & lt); if (lane == e) cnt = __popcll(ma) + __popcll(mb); }
                    if (lane < 16) CNT[c * 16 + lane] = cnt;
                    LAS int* rk = (LAS int*)(lds + LNX_OFF + 3072); rk[lane] = ra; rk[64 + lane] = rb; LDS_WAIT();
                    const int r = lane; const unsigned word = (unsigned)eid[2 * r] | ((unsigned)eid[2 * r + 1] << 8) | ((unsigned)rk[2 * r] << 16) | ((unsigned)rk[2 * r + 1] << 24);
                    RE[(size_t)64 * c + r] = word;
                }
                __syncthreads();
            } }
            SEAM(sb + 3);
        }
        if ((IN(sb + 4) || IN(sb + 5) || IN(sb + 6)) && PHM(7)) {
            const int tid = opq_tid(wave);
            LAS int* part = (LAS int*)(lds + LNX_OFF);
            { const int e = tid & 15, s = tid >> 4; int a = 0;
#pragma unroll
              for (int i = 0; i < 8; ++i) a += CNT[(8 * s + i) * 16 + e];
              part[s * 16 + e] = a; }
            __syncthreads();
            if (tid < 16) { int run = 0;
#pragma clang loop vectorize(disable)
#pragma unroll 8
                for (int s = 0; s < 32; ++s) run += part[s * 16 + tid];
                TAB[tid] = run; }
            __syncthreads();
            if (tid < 192) { int off = 0, mt = 0, mine = 15;
#pragma unroll
                for (int e = 0; e < 16; ++e) { const int nt = (TAB[e] + 255) >> 8; if (tid == 0) TAB[16 + e] = off; if (tid >= mt && tid < mt + nt) mine = e; off += nt * 256; mt += nt; }
                if (tid < mt && tid < 160) TAB[64 + tid] = mine;
                if (tid == 0) { TAB[32] = off; TAB[33] = mt; } }
            __syncthreads();
        }
        if (IN(sb + 4)) { if (PHM(7)) PREP(7) {
            const int tid = opq_tid(wave), lane = tid & 63;
            LAS int* part = (LAS int*)(lds + LNX_OFF);
            for (int c = bx; c < 256; c += G) {
                if (tid < 16) { int pre = 0; int x[8];
#pragma unroll
                    for (int i = 0; i < 8; ++i) x[i] = CNT[((c & ~7) + i) * 16 + tid];
#pragma clang loop vectorize(disable) unroll(disable)
                    for (int s = 0; s < (c >> 3); ++s) pre += part[s * 16 + tid];
#pragma unroll
                    for (int i = 0; i < 8; ++i) pre += (i < (c & 7)) ? x[i] : 0;
                    TAB[48 + tid] = TAB[16 + tid] + pre; }
                __syncthreads();
#pragma unroll 1
                for (int rr = 0; rr < 8; ++rr) { const size_t row = (size_t)64 * c + wave * 8 + rr; const unsigned word = RE[row];
                    const int p0 = TAB[48 + (word & 255)] + ((word >> 16) & 255), p1 = TAB[48 + ((word >> 8) & 255)] + (word >> 24);
                    if (lane == 0) { RP[2 * row] = p0; RP[2 * row + 1] = p1; }
                    if (c == bx && IN(sb + 3)) {
                        const LAS v4u* src = (const LAS v4u*)(lds + RING_OFF + (wave * 8 + rr) * 2048) + lane; v4u* o0 = (v4u*)((unsigned char*)XS + (size_t)p0 * P8K2) + lane; v4u* o1 = (v4u*)((unsigned char*)XS + (size_t)p1 * P8K2) + lane;
                        const v4u a = src[0], b = src[64]; __builtin_nontemporal_store(a, o0); __builtin_nontemporal_store(b, o0 + 64); __builtin_nontemporal_store(a, o1); __builtin_nontemporal_store(b, o1 + 64);
                    } else {
                        const _Float16* hq = H + row * DM + 4 * lane; unsigned* o0 = (unsigned*)((unsigned char*)XS + (size_t)p0 * P8K2) + lane; unsigned* o1 = (unsigned*)((unsigned char*)XS + (size_t)p1 * P8K2) + lane;
#pragma unroll
                        for (int j = 0; j < 8; ++j) { const f32x4 v = ldh4(hq + 256 * j); const unsigned o = pg8::pack4_fp8(v[0], v[1], v[2], v[3]); o0[64 * j] = o; o1[64 * j] = o; } } }
                __syncthreads();
            } }
            SEAM(sb + 4);
        }
        if (IN(sb + 5)) { if (PHM(8)) PREP(8) {
            pg8::Gemm g{XS, (const bf16*)(ws + WS_WGU + (size_t)L * 16 * 2048 * P8K2), XS_ROWS, 2048, DM / 2, P8K2 / 2, wave};
            pg8::MoeOrder<0> S{TAB[33] * 8, G, bx, TAB + 64, nullptr, nullptr, wave}; pg8::EpiGateUp8 E{(unsigned char*)ACT};
            pg8::gemm_phase<pg8::EpiGateUp8, pg8::MoeOrder<0>, true, true, true>(lds + RING_OFF, g, S, E); }
            SEAM(sb + 5);
        }
        if (IN(sb + 6)) { if (PHM(9)) PREP(9) {
            pg8::Gemm g{ACT, (const bf16*)(ws + WS_WDN + (size_t)L * 16 * 2048 * P8K1), XS_ROWS, 2048, DEXP / 2, P8K1 / 2, wave};
            pg8::MoeOrder<0> S{TAB[33] * 8, G, bx, TAB + 64, nullptr, nullptr, wave}; pg8::EpiDown8 E{(unsigned char*)YD};
            pg8::gemm_phase<pg8::EpiDown8, pg8::MoeOrder<0>, true, true, true>(lds + RING_OFF, g, S, E); }
            SEAM(sb + 6);
        }
        if (IN(sb + 7)) { if (PHM(10)) for (int rep_ = 0; rep_ < ((((PROBE_DUP) >> 10) & 1) && L == NLAYER - 1 ? 5 : 1); ++rep_) {
            const int tid = opq_tid(wave), lane = tid & 63;
            const float* lng = args.in[10] + (size_t)L * DM; const float* lnb = args.in[11] + (size_t)L * DM; const bool last = (L == NLAYER - 1); const bool next8 = (L + 1 < 2) ? (QKV8_A != 0) : (QKV8_B != 0);
            const int gw = vcu * NWAVES + wave, NGW = G * NWAVES;
            for (int row0 = 4 * gw; row0 < NTOK; row0 += 4 * NGW) {
                f32x4 v[4][8]; float mu[4], rstd[4];
#pragma unroll
                for (int rr = 0; rr < 4; ++rr) { const int row = row0 + rr;
                    const int p0 = RP[2 * row], p1 = RP[2 * row + 1]; const f32x2 w = RW[row];
                    const _Float16* hq = H + (size_t)row * DM + 4 * lane; const unsigned* y0 = (const unsigned*)((const unsigned char*)YD + (size_t)p0 * DM) + lane; const unsigned* y1 = (const unsigned*)((const unsigned char*)YD + (size_t)p1 * DM) + lane;
                    const float w0s = w.x * (1.f / pg8::YD8_SCALE), w1s = w.y * (1.f / pg8::YD8_SCALE);
#pragma unroll
                    for (int j = 0; j < 8; ++j) { const f32x4 h = ldh4(hq + 256 * j); const unsigned a = y0[64 * j], b = y1[64 * j];
                        const f32x2 a0 = __builtin_amdgcn_cvt_pk_f32_fp8((int)a, false), a1 = __builtin_amdgcn_cvt_pk_f32_fp8((int)a, true), b0 = __builtin_amdgcn_cvt_pk_f32_fp8((int)b, false), b1 = __builtin_amdgcn_cvt_pk_f32_fp8((int)b, true);
                        const f32x4 fa = {a0[0], a0[1], a1[0], a1[1]}, fb = {b0[0], b0[1], b1[0], b1[1]};
                        v[rr][j] = h * DN_ALPHA + fa * w0s + fb * w1s; } }
#pragma unroll
                for (int rr = 0; rr < 4; ++rr) { float s = 0.f;
#pragma unroll
                    for (int j = 0; j < 8; ++j) s += (v[rr][j][0] + v[rr][j][1]) + (v[rr][j][2] + v[rr][j][3]);
                    mu[rr] = dpp_sum(s) * (1.f / DM); float q = 0.f;
#pragma unroll
                    for (int j = 0; j < 8; ++j) { const f32x4 dd = v[rr][j] - mu[rr]; q += (dd[0] * dd[0] + dd[1] * dd[1]) + (dd[2] * dd[2] + dd[3] * dd[3]); }
                    rstd[rr] = 1.f / sqrtf(dpp_sum(q) * (1.f / DM) + LN_EPS); }
#pragma unroll
                for (int j = 0; j < 8; ++j) { const f32x4 gg = ((const f32x4*)lng)[64 * j + lane], bb = ((const f32x4*)lnb)[64 * j + lane];
#pragma unroll
                    for (int rr = 0; rr < 4; ++rr) { const int row = row0 + rr; const f32x4 y = (v[rr][j] - mu[rr]) * rstd[rr] * gg + bb;
                        if (last) __builtin_nontemporal_store(y, (f32x4*)(args.out + (size_t)row * DM) + 64 * j + lane);
                        else { sth4(H + (size_t)row * DM + 256 * j + 4 * lane, y); if (next8) __builtin_nontemporal_store(pg8::pack4_fp8(y[0], y[1], y[2], y[3]), (unsigned*)(HB8 + (size_t)row * DM) + 64 * j + lane); } } }
            } }
            SEAM(sb + 7);
        }
    }
#undef IN
#undef SEAM
}

extern "C" void kernel_launch(void* const* d_in, const int* in_sizes, int n_in, void* d_out, int out_size, void* d_ws, size_t ws_size, hipStream_t stream) {
    static int grid = 0;
    if (grid == 0) {
        if (n_in != 17 || in_sizes[0] != NTOK * DM || out_size != NTOK * DM || ws_size < WS_END) { fprintf(stderr, "kernel_launch: unexpected shapes / workspace (n_in %d, ws %zu, need %zu)\n", n_in, ws_size, (size_t)WS_END); grid = -1; return; }
        int dev = 0, cus = 0, per_cu = 0;
        if (hipGetDevice(&dev) != hipSuccess || hipDeviceGetAttribute(&cus, hipDeviceAttributeMultiprocessorCount, dev) != hipSuccess) { grid = -1; return; }
        if (hipFuncSetAttribute((const void*)yoco_fwd, hipFuncAttributeMaxDynamicSharedMemorySize, LDS_BYTES) != hipSuccess) { fprintf(stderr, "kernel_launch: hipFuncSetAttribute failed\n"); grid = -1; return; }
        if (hipOccupancyMaxActiveBlocksPerMultiprocessor(&per_cu, (const void*)yoco_fwd, NWAVES * 64, LDS_BYTES) != hipSuccess || per_cu < 1) { fprintf(stderr, "kernel_launch: occupancy query says %d\n", per_cu); per_cu = 1; }
        (void)hipGetLastError();
        grid = cus;
    }
    if (grid < 0) return;
    (void)hipMemsetAsync((char*)d_ws + WS_CTL, 0, CTL_ZERO_BYTES, stream);
    Args a{};
    for (int i = 0; i < 17; ++i) a.in[i] = (const float*)d_in[i];
    a.out = (float*)d_out; a.ws = (unsigned char*)d_ws;
#if MK_MULTI
    for (int s = 0; s < NSTEPS; ++s) { a.s_lo = s; a.s_hi = s + 1; hipLaunchKernelGGL(yoco_fwd, dim3(grid), dim3(NWAVES * 64), LDS_BYTES, stream, a); }
#else
    a.s_lo = 0; a.s_hi = NSTEPS;
    hipLaunchKernelGGL(yoco_fwd, dim3(grid), dim3(NWAVES * 64), LDS_BYTES, stream, a);
#endif
    const hipError_t le = hipPeekAtLastError();
    if (le != hipSuccess) fprintf(stderr, "kernel_launch: launch failed: %s\n", hipGetErrorName(le));
}
```

```cpp
#include <hip/hip_runtime.h>
#include <cstdio>
#include <cstdint>

__device__ __forceinline__ int tid_from_wave(int wave) { int l; asm volatile("v_mbcnt_lo_u32_b32 %0, -1, 0\n\tv_mbcnt_hi_u32_b32 %0, -1, %0" : "=v"(l)); return wave * 64 + l; }
namespace pg8 {
#define PG8_LAS __attribute__((address_space(3)))
typedef unsigned short bf16_t;
typedef short bf16x8 __attribute__((ext_vector_type(8)));
typedef float f32x4 __attribute__((ext_vector_type(4)));
typedef unsigned u32x4 __attribute__((ext_vector_type(4)));
typedef int pg8_v8i __attribute__((ext_vector_type(8)));
typedef _Float16 pg8_h8 __attribute__((ext_vector_type(8)));
constexpr int BM = 256, BK = 64, HALF = 128, HTB = HALF * BK * 2  , STAGE_BYTES = 8 * HTB, NXCD = 8, WGM = 8;

__host__ __device__ __forceinline__ int lds_byte(int r, int c) { const int st = (r >> 4) * 2 + (c >> 5), rr = r & 15, cc = c & 31, ob = rr * 64 + cc * 2; return st * 1024 + (ob ^ (((ob >> 9) & 1) << 5)); }
__host__ __device__ __forceinline__ void stage_rc(int b, int& R, int& C) { const int st = b / 1024, sb = b % 1024, swz = sb ^ (((sb >> 9) & 1) << 5); R = (st >> 1) * 16 + swz / 64; C = (st & 1) * 32 + (swz % 64) / 2; }
__host__ __device__ __forceinline__ int perm32(int rho) { const int n = rho >> 4, i = rho & 15; return 8 * (i >> 2) + 4 * n + (i & 3); }

struct Unit { int pm, pn; };
struct Gemm { const bf16_t* A; const bf16_t* Bt; int M, N, K, ld, wave; };

struct StaticOrder {
    int nM, nN, nwg, G, c;
    __host__ __device__ void init(int M, int N, int G_, int c_) { nM = M / BM; nN = N / BM; nwg = nM * nN; G = G_; c = c_; }
    __host__ __device__ bool next(int i, Unit& u) const {
        const long L = (long)i * G + c; if (L >= nwg) return false;
        int wgid = (int)L; { const int q = nwg / NXCD, r = nwg % NXCD, xcd = wgid % NXCD, off = wgid / NXCD; wgid = (xcd < r ? xcd * (q + 1) : r * (q + 1) + (xcd - r) * q) + off; }
        const int nig = WGM * nN, gid = wgid / nig, fm = gid * WGM, gsz = (nM - fm) < WGM ? (nM - fm) : WGM;
        u.pm = fm + ((wgid % nig) % gsz); u.pn = (wgid % nig) / gsz; return true;
    }
    __device__ __forceinline__ void a_ready(const Unit&) const {}
    __device__ __forceinline__ void done(const Unit&) const {}
};

__device__ __forceinline__ unsigned cvt_pk_bf16(float lo, float hi) { unsigned r; asm volatile("v_cvt_pk_bf16_f32 %0, %1, %2" : "=v"(r) : "v"(lo), "v"(hi)); return r; }
typedef float f32x2 __attribute__((ext_vector_type(2)));

typedef unsigned u32x2 __attribute__((ext_vector_type(2)));
__device__ __forceinline__ u32x4 pack8_bf16(const f32x4 a, const f32x4 b) { u32x4 w; w.x = cvt_pk_bf16(a[0], a[1]); w.y = cvt_pk_bf16(a[2], a[3]); w.z = cvt_pk_bf16(b[0], b[1]); w.w = cvt_pk_bf16(b[2], b[3]); return w; }

struct EpiQkv {
    static constexpr bool PERM = true, AFTER_DRAIN = false;
    bf16_t* O; int ldc; int qcols; float qscale; float osc;
    __device__ __forceinline__ void operator()(const f32x4 (&acc)[2][2][4][2], const Unit& u, int wr, int wc, int fr, int fq) const {
        const int row0 = u.pm * BM + wr * 64 + fr, colt = u.pn * BM; const float sc = (colt < qcols ? qscale : 1.f) * osc;
        const int col0 = colt + wc * 32 + 8 * fq;
#pragma unroll
        for (int ai = 0; ai < 2; ++ai)
#pragma unroll
            for (int m = 0; m < 4; ++m) { bf16_t* rowp = O + (size_t)(row0 + ai * HALF + m * 16) * ldc + col0;
#pragma unroll
                for (int bj = 0; bj < 2; ++bj) *(u32x4*)(rowp + bj * HALF) = pack8_bf16(acc[ai][bj][m][0] * sc, acc[ai][bj][m][1] * sc); }
    }
};
template <int ACCS_INV> struct EpiResid {
    static constexpr bool PERM = false, AFTER_DRAIN = false;
    static constexpr int ldc = 2048; static constexpr float alpha = 1.6817928305074292f, accs = 1.f / (float)ACCS_INV;
    float* H; const float* Hsrc;
    __device__ __forceinline__ void operator()(const f32x4 (&acc)[2][2][4][2], const Unit& u, int wr, int wc, int fr, int fq) const {
        const int row0 = u.pm * BM + wr * 64 + fr, col0 = u.pn * BM + wc * 32 + 4 * fq;
#pragma unroll
        for (int ai = 0; ai < 2; ++ai)
#pragma unroll
            for (int m = 0; m < 4; ++m) { const size_t ro = (size_t)(row0 + ai * HALF + m * 16) * ldc + col0; float* rowp = H + ro; const float* srcp = Hsrc + ro;
#pragma unroll
                for (int bj = 0; bj < 2; ++bj)
#pragma unroll
                    for (int n = 0; n < 2; ++n) { const f32x4 h = *(const f32x4*)(srcp + bj * HALF + n * 16); *(f32x4*)(rowp + bj * HALF + n * 16) = h * alpha + acc[ai][bj][m][n] * accs; } }
    }
};
struct EpiRope {
    static constexpr bool PERM = true, AFTER_DRAIN = false;
    bf16_t* O; int ldc; int qcols, ropecols; float qscale; float osc;
    __device__ __forceinline__ void operator()(const f32x4 (&acc)[2][2][4][2], const Unit& u, int wr, int wc, int fr, int fq) const {
        const int row0 = u.pm * BM + wr * 64 + fr, colt = u.pn * BM;
        if (colt >= ropecols) {
            const int col0 = colt + wc * 32 + 8 * fq;
#pragma unroll
            for (int ai = 0; ai < 2; ++ai)
#pragma unroll
                for (int m = 0; m < 4; ++m) { bf16_t* rowp = O + (size_t)(row0 + ai * HALF + m * 16) * ldc + col0;
#pragma unroll
                    for (int bj = 0; bj < 2; ++bj) *(u32x4*)(rowp + bj * HALF) = pack8_bf16(acc[ai][bj][m][0] * osc, acc[ai][bj][m][1] * osc); }
        } else {
            const float sc = (colt < qcols ? qscale : 1.f) * osc;
            const int col0 = colt + wc * 64 + 8 * fq;
            float ir[8];
#pragma unroll
            for (int i = 0; i < 8; ++i) ir[i] = __builtin_amdgcn_exp2f(-(float)(8 * fq + i) * 0.4152410118609203f) * 0.15915494309189535f;
#pragma unroll
            for (int ai = 0; ai < 2; ++ai)
#pragma unroll
                for (int m = 0; m < 4; ++m) { const int row = row0 + ai * HALF + m * 16; const float pos = (float)(row & 2047);
                    f32x4 c0, c1, s0, s1;
#pragma unroll
                    for (int i = 0; i < 4; ++i) { const float f0 = __builtin_amdgcn_fractf(pos * ir[i]), f1 = __builtin_amdgcn_fractf(pos * ir[4 + i]);
                        c0[i] = __builtin_amdgcn_cosf(f0); s0[i] = __builtin_amdgcn_sinf(f0); c1[i] = __builtin_amdgcn_cosf(f1); s1[i] = __builtin_amdgcn_sinf(f1); }
                    const f32x4 a0 = acc[ai][0][m][0], a1 = acc[ai][0][m][1], b0 = acc[ai][1][m][0], b1 = acc[ai][1][m][1];
                    bf16_t* rowp = O + (size_t)row * ldc + col0;
                    *(u32x4*)(rowp) = pack8_bf16((a0 * c0 - b0 * s0) * sc, (a1 * c1 - b1 * s1) * sc);
                    *(u32x4*)(rowp + 32) = pack8_bf16((b0 * c0 + a0 * s0) * sc, (b1 * c1 + a1 * s1) * sc); }
        }
    }
};
struct EpiGateUp {
    static constexpr bool PERM = true, AFTER_DRAIN = false;
    bf16_t* O;
    __device__ __forceinline__ void operator()(const f32x4 (&acc)[2][2][4][2], const Unit& u, int wr, int wc, int fr, int fq) const {
        const int row0 = u.pm * BM + wr * 64 + fr, col0 = (u.pn & 7) * 128 + wc * 32 + 8 * fq;
#pragma unroll
        for (int ai = 0; ai < 2; ++ai)
#pragma unroll
            for (int m = 0; m < 4; ++m) { f32x4 r[2];
#pragma unroll
                for (int n = 0; n < 2; ++n) { const f32x4 g = acc[ai][0][m][n], up = acc[ai][1][m][n];
#pragma unroll
                    for (int i = 0; i < 4; ++i) { const float e = __builtin_amdgcn_exp2f(g[i] * -1.4426950408889634f); r[n][i] = g[i] * __builtin_amdgcn_rcpf(1.f + e) * up[i]; } }
                *(u32x4*)(O + (size_t)(row0 + ai * HALF + m * 16) * 1024 + col0) = pack8_bf16(r[0], r[1]); }
    }
};
struct EpiDown {
    static constexpr bool PERM = true, AFTER_DRAIN = false;
    bf16_t* O;
    __device__ __forceinline__ void operator()(const f32x4 (&acc)[2][2][4][2], const Unit& u, int wr, int wc, int fr, int fq) const {
        const int row0 = u.pm * BM + wr * 64 + fr, col0 = (u.pn & 7) * BM + wc * 32 + 8 * fq;
#pragma unroll
        for (int ai = 0; ai < 2; ++ai)
#pragma unroll
            for (int m = 0; m < 4; ++m) { bf16_t* rowp = O + (size_t)(row0 + ai * HALF + m * 16) * 2048 + col0;
#pragma unroll
                for (int bj = 0; bj < 2; ++bj) *(u32x4*)(rowp + bj * HALF) = pack8_bf16(acc[ai][bj][m][0], acc[ai][bj][m][1]); }
    }
};
constexpr float W8_SCALE = 64.f, ACT8_SCALE = 4.f;
__device__ __forceinline__ unsigned pack4_fp8(float a, float b, float c, float d) { int w; asm volatile("" : "=v"(w));
    w = __builtin_amdgcn_cvt_pk_fp8_f32(a, b, w, false); w = __builtin_amdgcn_cvt_pk_fp8_f32(c, d, w, true); return (unsigned)w; }
struct EpiGateUp8 {
    static constexpr bool PERM = true, AFTER_DRAIN = false;
    unsigned char* O;
    __device__ __forceinline__ void operator()(const f32x4 (&acc)[2][2][4][2], const Unit& u, int wr, int wc, int fr, int fq) const {
        const int row0 = u.pm * BM + wr * 64 + fr, col0 = (u.pn & 7) * 128 + wc * 32 + 8 * fq;
        constexpr float SI = 1.f / W8_SCALE;
#pragma unroll
        for (int ai = 0; ai < 2; ++ai)
#pragma unroll
            for (int m = 0; m < 4; ++m) { f32x4 r[2];
#pragma unroll
                for (int n = 0; n < 2; ++n) { const f32x4 g = acc[ai][0][m][n] * SI, up = acc[ai][1][m][n] * (SI * ACT8_SCALE);
#pragma unroll
                    for (int i = 0; i < 4; ++i) { const float e = __builtin_amdgcn_exp2f(g[i] * -1.4426950408889634f); r[n][i] = g[i] * __builtin_amdgcn_rcpf(1.f + e) * up[i]; } }
                u32x2 w; w.x = pack4_fp8(r[0][0], r[0][1], r[0][2], r[0][3]); w.y = pack4_fp8(r[1][0], r[1][1], r[1][2], r[1][3]);
                *(u32x2*)(O + (size_t)(row0 + ai * HALF + m * 16) * 1024 + col0) = w; }
    }
};
constexpr float YD8_SCALE = 16.f;
struct EpiDown8 {
    static constexpr bool PERM = true, AFTER_DRAIN = false;
    unsigned char* O;
    __device__ __forceinline__ void operator()(const f32x4 (&acc)[2][2][4][2], const Unit& u, int wr, int wc, int fr, int fq) const {
        const int row0 = u.pm * BM + wr * 64 + fr, col0 = (u.pn & 7) * BM + wc * 32 + 8 * fq;
        constexpr float SI = YD8_SCALE / (W8_SCALE * ACT8_SCALE);
#pragma unroll
        for (int ai = 0; ai < 2; ++ai)
#pragma unroll
            for (int m = 0; m < 4; ++m) { unsigned char* rowp = O + (size_t)(row0 + ai * HALF + m * 16) * 2048 + col0;
#pragma unroll
                for (int bj = 0; bj < 2; ++bj) { const f32x4 a = acc[ai][bj][m][0] * SI, c = acc[ai][bj][m][1] * SI; u32x2 w; w.x = pack4_fp8(a[0], a[1], a[2], a[3]); w.y = pack4_fp8(c[0], c[1], c[2], c[3]);
                    *(u32x2*)(rowp + bj * HALF) = w; } }
    }
};
template <int ROLE> struct MoeOrder {
    int nunits, G, c; const PG8_LAS int* tile_e; unsigned* cnt; unsigned* tmo; int wave;
    __device__ __forceinline__ bool next(int i, Unit& u) const {
        const int cc = (ROLE == 2) ? G - 1 - c : c; int idx;
        if ((G & 7) == 0) { const int per = G >> 3; idx = (i * 8 + (cc & 7)) * per + (cc >> 3); } else idx = i * G + cc;
        if (idx >= nunits) return false;
        const int mt = idx >> 3; u.pm = mt; u.pn = tile_e[mt] * 8 + (idx & 7); return true;
    }
    __device__ __forceinline__ void a_ready(const Unit& u) const {
        if constexpr (ROLE == 2) {
            if (wave == 0) { const bool lane0 = (tid_from_wave(0) == 0);
                const unsigned long long t0 = __builtin_amdgcn_s_memrealtime(); unsigned polls = 0;
                while ((unsigned)__builtin_amdgcn_readfirstlane(__hip_atomic_load(cnt + 64 * u.pm, __ATOMIC_RELAXED, __HIP_MEMORY_SCOPE_AGENT)) < 64u) {
                    if ((++polls & 255u) == 0u && __builtin_amdgcn_readfirstlane(__hip_atomic_load(tmo, __ATOMIC_RELAXED, __HIP_MEMORY_SCOPE_AGENT)) != 0u) break;
                    if (__builtin_amdgcn_s_memrealtime() - t0 > 2000000ull) { if (lane0) __hip_atomic_store(tmo, 1u, __ATOMIC_RELAXED, __HIP_MEMORY_SCOPE_AGENT); break; }
                    __builtin_amdgcn_s_sleep(2); }
                __builtin_amdgcn_fence(__ATOMIC_ACQUIRE, "agent");
                asm volatile("s_waitcnt vmcnt(0)" ::: "memory");
            }
            asm volatile("" ::: "memory"); __builtin_amdgcn_s_barrier(); asm volatile("" ::: "memory");
        }
    }
    __device__ __forceinline__ void done(const Unit& u) const {
        if constexpr (ROLE == 1) {
            asm volatile("s_waitcnt vmcnt(0)" ::: "memory");
            if (tid_from_wave(0) == 0) __hip_atomic_fetch_add(cnt + 64 * u.pm, 1u, __ATOMIC_RELAXED, __HIP_MEMORY_SCOPE_AGENT);
        }
    }
};

template <class Epi, class Sched, bool ALIGN_EPI = false, bool SP2 = false, bool F8 = false, bool F16 = false>
__device__ __forceinline__ void gemm_phase(PG8_LAS unsigned char* lds, const Gemm g, const Sched& S, const Epi& E) {
    int tid_ = tid_from_wave(g.wave); asm volatile("" : "+v"(tid_));
    const int tid = tid_, wid = __builtin_amdgcn_readfirstlane(tid >> 6), lane = tid & 63, wr = wid >> 2, wc = wid & 3, fr = lane & 15, fq = lane >> 4;
    const int K = g.K, LD = g.ld, nt = K / BK;
    unsigned voffA, voffB;
    { int R, C; stage_rc(tid * 16, R, C); const int Rb = Epi::PERM ? ((R & ~31) + perm32(R & 31)) : R;
        voffA = (unsigned)(R * LD + C) * 2u; voffB = (unsigned)(Rb * LD + C) * 2u; }
    const size_t pstep = (size_t)64 * LD * 2;
    const size_t kstep = (size_t)(BK * 2);
    const size_t hstep = (size_t)HALF * LD * 2;
    const size_t tstep = 2 * hstep;
    const unsigned ldsbase = (unsigned)(uintptr_t)lds;
    const unsigned ldsw = (unsigned)wid * 1024u;
    const int aoff = lds_byte(wr * 64 + fr, fq * 8), boff = lds_byte(wc * 32 + fr, fq * 8);
#define PG8_SA(b, h) (((b) * 2 + (h)) * HTB)
#define PG8_SB(b, h) ((4 + (b) * 2 + (h)) * HTB)
#define PG8_STAGE(bufoff, gbase, voff) do { _Pragma("unroll") for (int _i = 0; _i < 2; ++_i) { unsigned keep_; \
        asm volatile("s_mov_b32 %0, m0\n\ts_mov_b32 m0, %3\n\ts_nop 0\n\tglobal_load_lds_dwordx4 %1, %2\n\ts_mov_b32 m0, %0" : "=&s"(keep_) \
            : "v"(voff), "s"((const char*)(gbase) + _i * pstep), "s"(ldsbase + (unsigned)(bufoff) + ldsw + (unsigned)(_i * 8192))); } } while (0)
#define PG8_CAT(a, b) __builtin_bit_cast(pg8_v8i, __builtin_shufflevector(a, b, 0, 1, 2, 3, 4, 5, 6, 7, 8, 9, 10, 11, 12, 13, 14, 15))
#define PG8_LDA(dst, b, h) do { if constexpr (F8) { _Pragma("unroll") for (int m = 0; m < 4; ++m) { const bf16x8 lo_ = *(const PG8_LAS bf16x8*)(lds + PG8_SA(b, h) + aoff + m * 2048), hi_ = *(const PG8_LAS bf16x8*)(lds + PG8_SA(b, h) + aoff + m * 2048 + 1024); dst##8[m] = PG8_CAT(lo_, hi_); } } \
        else { _Pragma("unroll") for (int m = 0; m < 4; ++m) _Pragma("unroll") for (int k = 0; k < 2; ++k) dst[m][k] = *(const PG8_LAS bf16x8*)(lds + PG8_SA(b, h) + aoff + m * 2048 + k * 1024); } } while (0)
#define PG8_LDB(dst, b, h) do { if constexpr (F8) { _Pragma("unroll") for (int n = 0; n < 2; ++n) { const bf16x8 lo_ = *(const PG8_LAS bf16x8*)(lds + PG8_SB(b, h) + boff + n * 2048), hi_ = *(const PG8_LAS bf16x8*)(lds + PG8_SB(b, h) + boff + n * 2048 + 1024); dst##8[n] = PG8_CAT(lo_, hi_); } } \
        else { _Pragma("unroll") for (int n = 0; n < 2; ++n) _Pragma("unroll") for (int k = 0; k < 2; ++k) dst[n][k] = *(const PG8_LAS bf16x8*)(lds + PG8_SB(b, h) + boff + n * 2048 + k * 1024); } } while (0)
#define PG8_MMA(ai, bj, At, Bt) do { __builtin_amdgcn_s_setprio(1); \
        if constexpr (F8) { _Pragma("unroll") for (int m = 0; m < 4; ++m) _Pragma("unroll") for (int n = 0; n < 2; ++n) \
            acc[ai][bj][m][n] = __builtin_amdgcn_mfma_scale_f32_16x16x128_f8f6f4(Bt##8[n], At##8[m], acc[ai][bj][m][n], 0, 0, 0, 0, 0, 0); } \
        else { _Pragma("unroll") for (int m = 0; m < 4; ++m) _Pragma("unroll") for (int n = 0; n < 2; ++n) _Pragma("unroll") for (int k = 0; k < 2; ++k) \
            acc[ai][bj][m][n] = F16 ? __builtin_amdgcn_mfma_f32_16x16x32_f16(__builtin_bit_cast(pg8_h8, Bt[n][k]), __builtin_bit_cast(pg8_h8, At[m][k]), acc[ai][bj][m][n], 0, 0, 0) \
                                    : __builtin_amdgcn_mfma_f32_16x16x32_bf16(Bt[n][k], At[m][k], acc[ai][bj][m][n], 0, 0, 0); } \
        __builtin_amdgcn_s_setprio(0); } while (0)
#define PG8_WAIT_V(n) asm volatile("s_waitcnt vmcnt(" #n ")" ::: "memory")
#define PG8_WAIT_L(n) asm volatile("s_waitcnt lgkmcnt(" #n ")" ::: "memory")
#define PG8_BAR __builtin_amdgcn_s_barrier()
#define PG8_SCHED __builtin_amdgcn_sched_barrier(0)
    Unit cur, nxt; int ui = 0;
    if (!S.next(0, cur)) return;
    f32x4 acc[2][2][4][2];
{ float zero_; asm volatile("v_mov_b32 %0, 0" : "=v"(zero_));
#pragma unroll
    for (int a = 0; a < 2; ++a)
#pragma unroll
        for (int b = 0; b < 2; ++b)
#pragma unroll
            for (int m = 0; m < 4; ++m)
#pragma unroll
                for (int n = 0; n < 2; ++n) acc[a][b][m][n] = (f32x4){zero_, zero_, zero_, zero_}; }
    bf16x8 At[4][2], B0[2][2], B1[2][2]; pg8_v8i At8[4], B08[2], B18[2];
    const char* cA = (const char*)g.A + (size_t)cur.pm * tstep; const char* cB = (const char*)g.Bt + (size_t)cur.pn * tstep;
    S.a_ready(cur);
    if constexpr (SP2) {
        PG8_STAGE(PG8_SB(0, 0), cB, voffB); PG8_STAGE(PG8_SB(0, 1), cB + hstep, voffB); PG8_STAGE(PG8_SA(0, 0), cA, voffA); PG8_STAGE(PG8_SA(0, 1), cA + hstep, voffA);
        if (wr == 1) PG8_BAR;
        PG8_WAIT_V(2); PG8_BAR;
        PG8_STAGE(PG8_SB(1, 0), cB + kstep, voffB); PG8_STAGE(PG8_SA(1, 0), cA + kstep, voffA); PG8_STAGE(PG8_SB(1, 1), cB + hstep + kstep, voffB);
        PG8_WAIT_V(6); PG8_BAR;
    } else {
        PG8_STAGE(PG8_SB(0, 0), cB, voffB); PG8_STAGE(PG8_SA(0, 0), cA, voffA); PG8_STAGE(PG8_SB(0, 1), cB + hstep, voffB); PG8_STAGE(PG8_SA(0, 1), cA + hstep, voffA);
        if (wr == 1) PG8_BAR;
        PG8_WAIT_V(4); PG8_BAR;
        PG8_STAGE(PG8_SB(1, 0), cB + kstep, voffB); PG8_STAGE(PG8_SA(1, 0), cA + kstep, voffA); PG8_STAGE(PG8_SB(1, 1), cB + hstep + kstep, voffB);
        PG8_WAIT_V(6); PG8_BAR;
    }
    for (;;) {
        const bool has_next = S.next(ui + 1, nxt);
        const char* nA = has_next ? (const char*)g.A + (size_t)nxt.pm * tstep : cA; const char* nB = has_next ? (const char*)g.Bt + (size_t)nxt.pn * tstep : cB;
#pragma unroll 1
        for (int t = 0; t < nt; t += 2) {
            const bool last = (t == nt - 2);
            const char* a1 = cA + (size_t)(t + 1) * kstep;
            const char* a2 = last ? nA : cA + (size_t)(t + 2) * kstep; const char* b2 = last ? nB : cB + (size_t)(t + 2) * kstep;
            const char* a3 = a2 + kstep; const char* b3 = b2 + kstep;
            if (last && has_next) S.a_ready(nxt);
            if constexpr (SP2) {
            PG8_LDB(B0, 0, 0); PG8_LDB(B1, 0, 1); PG8_SCHED; PG8_LDA(At, 0, 0); PG8_STAGE(PG8_SA(1, 1), a1 + hstep, voffA);
            PG8_WAIT_V(8); PG8_WAIT_L(0); PG8_BAR; PG8_MMA(0, 0, At, B0); PG8_MMA(0, 1, At, B1); PG8_BAR; PG8_SCHED;
            PG8_LDA(At, 0, 1); PG8_STAGE(PG8_SB(0, 0), b2, voffB); PG8_STAGE(PG8_SB(0, 1), b2 + hstep, voffB); PG8_STAGE(PG8_SA(0, 0), a2, voffA);
            PG8_WAIT_V(8); PG8_WAIT_L(0); PG8_BAR; PG8_MMA(1, 0, At, B0); PG8_MMA(1, 1, At, B1); PG8_BAR; PG8_SCHED;
            PG8_LDB(B0, 1, 0); PG8_LDB(B1, 1, 1); PG8_SCHED; PG8_LDA(At, 1, 0); PG8_STAGE(PG8_SA(0, 1), a2 + hstep, voffA);
            PG8_WAIT_V(8); PG8_WAIT_L(0); PG8_BAR; PG8_MMA(0, 0, At, B0); PG8_MMA(0, 1, At, B1); PG8_BAR; PG8_SCHED;
            PG8_LDA(At, 1, 1); PG8_STAGE(PG8_SB(1, 0), b3, voffB); PG8_STAGE(PG8_SB(1, 1), b3 + hstep, voffB); PG8_STAGE(PG8_SA(1, 0), a3, voffA);
            PG8_WAIT_V(8); PG8_WAIT_L(0); PG8_BAR; PG8_MMA(1, 0, At, B0); PG8_MMA(1, 1, At, B1); PG8_BAR; PG8_SCHED;
            } else {
            PG8_LDB(B0, 0, 0); PG8_SCHED; PG8_LDA(At, 0, 0); PG8_STAGE(PG8_SA(1, 1), a1 + hstep, voffA);
            PG8_WAIT_L(8); PG8_BAR; PG8_WAIT_L(0); PG8_MMA(0, 0, At, B0); PG8_BAR; PG8_SCHED;
            PG8_LDB(B1, 0, 1); PG8_STAGE(PG8_SB(0, 0), b2, voffB);
            PG8_BAR; PG8_WAIT_L(0); PG8_MMA(0, 1, At, B1); PG8_BAR;
            PG8_LDA(At, 0, 1); PG8_STAGE(PG8_SA(0, 0), a2, voffA);
            PG8_BAR; PG8_WAIT_L(0); PG8_MMA(1, 0, At, B0); PG8_BAR; PG8_SCHED;
            PG8_STAGE(PG8_SB(0, 1), b2 + hstep, voffB);
            PG8_WAIT_V(6); PG8_BAR; PG8_MMA(1, 1, At, B1); PG8_BAR;
            PG8_LDB(B0, 1, 0); PG8_SCHED; PG8_LDA(At, 1, 0); PG8_STAGE(PG8_SA(0, 1), a2 + hstep, voffA);
            PG8_WAIT_L(8); PG8_BAR; PG8_WAIT_L(0); PG8_MMA(0, 0, At, B0); PG8_BAR; PG8_SCHED;
            PG8_LDB(B1, 1, 1); PG8_STAGE(PG8_SB(1, 0), b3, voffB);
            PG8_BAR; PG8_WAIT_L(0); PG8_MMA(0, 1, At, B1); PG8_BAR;
            PG8_LDA(At, 1, 1); PG8_STAGE(PG8_SA(1, 0), a3, voffA);
            PG8_BAR; PG8_WAIT_L(0); PG8_MMA(1, 0, At, B0); PG8_BAR; PG8_SCHED;
            PG8_STAGE(PG8_SB(1, 1), b3 + hstep, voffB);
            PG8_WAIT_V(6); PG8_BAR; PG8_MMA(1, 1, At, B1); PG8_BAR;
            }
        }
        if constexpr (ALIGN_EPI) { if (wr == 0) PG8_BAR; }
        if constexpr (!Epi::AFTER_DRAIN) { const int t2_ = tid_from_wave(g.wave);
            E(acc, cur, wr, wc, t2_ & 15, (t2_ >> 4) & 3); S.done(cur); }
        if (!has_next) break;
{ float zero_; asm volatile("v_mov_b32 %0, 0" : "=v"(zero_));
#pragma unroll
        for (int a = 0; a < 2; ++a)
#pragma unroll
            for (int b = 0; b < 2; ++b)
#pragma unroll
                for (int m = 0; m < 4; ++m)
#pragma unroll
                    for (int n = 0; n < 2; ++n) acc[a][b][m][n] = (f32x4){zero_, zero_, zero_, zero_}; }
        cur = nxt; cA = nA; cB = nB; ++ui;
        if constexpr (ALIGN_EPI) { if (wr == 1) PG8_BAR; }
    }
    PG8_WAIT_V(0);
    if constexpr (!ALIGN_EPI) { if (wr == 0) PG8_BAR; }
    PG8_BAR;
    if constexpr (Epi::AFTER_DRAIN) { E.fused(acc, cur, wr, wc, fr, fq, lds, wid, lane); S.done(cur); }
#undef PG8_SA
#undef PG8_SB
#undef PG8_STAGE
#undef PG8_LDA
#undef PG8_LDB
#undef PG8_MMA
#undef PG8_CAT
#undef PG8_WAIT_V
#undef PG8_WAIT_L
#undef PG8_BAR
#undef PG8_SCHED
}
}

namespace att {
#define ALAS __attribute__((address_space(3)))
typedef unsigned short bf16_t;
typedef short bf16x8 __attribute__((ext_vector_type(8)));
typedef short s16x4 __attribute__((ext_vector_type(4)));
typedef float f32x16 __attribute__((ext_vector_type(16)));
typedef float f32x4 __attribute__((ext_vector_type(4)));
typedef unsigned u32x4 __attribute__((ext_vector_type(4)));
typedef ALAS char* ldsp;
#ifndef WO_F8
#define WO_F8 1
#endif
constexpr float OB8_SCALE = 8.f;
constexpr int QP = 6144;
constexpr int OP = 2048;
constexpr int OBP = 2048;
constexpr int SHM_V = 16384, SHM_K = 16384;
constexpr int LDS_V = 0, LDS_K = 2 * SHM_V, LDS_WS = LDS_K + 2 * SHM_K, ATT_LDS_BYTES = LDS_WS + 8 * 256;
#define KSWZ(row, colB) ((row) * 256 + ((colB) ^ (((row) & 7) << 4)))
#define KSWZ64(row, colB) ((row) * 128 + ((colB) ^ (((row) & 7) << 4)))
#define SBAR() __builtin_amdgcn_sched_barrier(0)
__device__ __forceinline__ int v_st(int k, int c) { const int kk = (k & ~0xC) | ((k & 4) << 1) | ((k & 8) >> 1); return ((kk >> 3) * 4 + (c >> 5)) * 512 + ((kk & 7) * 32 + (c & 31)) * 2; }
__device__ __forceinline__ int v_rd_base(int lane) { return ((lane & 3) << 3) | (((lane >> 2) & 3) << 6) | (((lane >> 4) & 1) << 5) | (((lane >> 5) & 1) << 8); }
constexpr int v_rd_off(int d0, int ks, int half) { return d0 * 512 + ks * 4096 + half * 2048; }
__device__ __forceinline__ int crow(int r, int hi) { return (r & 3) + 8 * (r >> 2) + 4 * hi; }
__device__ __forceinline__ unsigned cvtpk(float lo, float hi) { unsigned r; asm volatile("v_cvt_pk_bf16_f32 %0, %1, %2" : "=v"(r) : "v"(lo), "v"(hi)); return r; }
__device__ __forceinline__ bf16x8 ldg8(const bf16_t* p) { return *reinterpret_cast<const bf16x8*>(p); }
__device__ __forceinline__ unsigned quad_pack_fp8(float v) {
    const int b = __builtin_bit_cast(int, v);
    const float v1 = __builtin_bit_cast(float, __builtin_amdgcn_update_dpp(b, b, 0x55, 0xf, 0xf, false));
    const float v2 = __builtin_bit_cast(float, __builtin_amdgcn_update_dpp(b, b, 0xAA, 0xf, 0xf, false));
    const float v3 = __builtin_bit_cast(float, __builtin_amdgcn_update_dpp(b, b, 0xFF, 0xf, 0xf, false));
    int w; asm volatile("" : "=v"(w));
    w = __builtin_amdgcn_cvt_pk_fp8_f32(v, v1, w, false); w = __builtin_amdgcn_cvt_pk_fp8_f32(v2, v3, w, true); return (unsigned)w;
}
__device__ __forceinline__ float xhalf(float v, int hi) {
    auto rr = __builtin_amdgcn_permlane32_swap(__float_as_uint(v), __float_as_uint(v), false, false);
    return __uint_as_float(hi ? rr[0] : rr[1]);
}
#define ATT_PK4(P, B_, OUT) do { unsigned a0 = cvtpk(P[B_+0], P[B_+1]), a1 = cvtpk(P[B_+2], P[B_+3]);                      \
        unsigned b0 = cvtpk(P[B_+4], P[B_+5]), b1 = cvtpk(P[B_+6], P[B_+7]);                                             \
        auto r0 = __builtin_amdgcn_permlane32_swap(a0, b0, false, false); auto r1 = __builtin_amdgcn_permlane32_swap(a1, b1, false, false); \
        u32x4 w = {r0[0], r1[0], r0[1], r1[1]}; OUT = *reinterpret_cast<bf16x8*>(&w); } while (0)
__device__ __forceinline__ void pv_tile(f32x16* o, int vb, bf16x8 pa0, bf16x8 pa1, bf16x8 pa2, bf16x8 pa3) {
#define TRRD(dst, off) asm volatile("ds_read_b64_tr_b16 %0, %1 offset:%2" : "=&v"(dst) : "v"(vb), "i"(off) : "memory")
#define PV_D0(d0) do { s16x4 l0, l1, l2, l3, h0, h1, h2, h3; constexpr int b_ = v_rd_off(d0, 0, 0); \
        TRRD(l0, b_); TRRD(h0, b_ + 2048); TRRD(l1, b_ + 4096); TRRD(h1, b_ + 6144); TRRD(l2, b_ + 8192); TRRD(h2, b_ + 10240); TRRD(l3, b_ + 12288); TRRD(h3, b_ + 14336); \
        asm volatile("s_waitcnt lgkmcnt(0)" ::: "memory"); SBAR(); \
        o[d0] = __builtin_amdgcn_mfma_f32_32x32x16_bf16(pa0, (bf16x8){l0[0], l0[1], l0[2], l0[3], h0[0], h0[1], h0[2], h0[3]}, o[d0], 0, 0, 0);   \
        o[d0] = __builtin_amdgcn_mfma_f32_32x32x16_bf16(pa1, (bf16x8){l1[0], l1[1], l1[2], l1[3], h1[0], h1[1], h1[2], h1[3]}, o[d0], 0, 0, 0);   \
        o[d0] = __builtin_amdgcn_mfma_f32_32x32x16_bf16(pa2, (bf16x8){l2[0], l2[1], l2[2], l2[3], h2[0], h2[1], h2[2], h2[3]}, o[d0], 0, 0, 0);   \
        o[d0] = __builtin_amdgcn_mfma_f32_32x32x16_bf16(pa3, (bf16x8){l3[0], l3[1], l3[2], l3[3], h3[0], h3[1], h3[2], h3[3]}, o[d0], 0, 0, 0); } while (0)
    PV_D0(0); PV_D0(1); PV_D0(2); PV_D0(3);
#undef PV_D0
#undef TRRD
}

__device__ __forceinline__ void sb_block(const bf16_t* __restrict__ Qg, const bf16_t* __restrict__ Kg, const bf16_t* __restrict__ Vg, bf16_t* __restrict__ Og, int qb, ldsp lds, int wave_) {
    int tid_ = tid_from_wave(wave_); asm volatile("" : "+v"(tid_));
    const int tid = tid_, wid = __builtin_amdgcn_readfirstlane(tid >> 6), lane = tid & 63, r32 = lane & 31, hi = lane >> 5;
    const int NT = 4 * qb + 4, R0 = 256 * qb + 32 * wid, myrow = R0 + r32;
    const ldsp V_lds = lds + LDS_V; const ldsp K_lds = lds + LDS_K;
    bf16x8 qr[8];
    { const bf16_t* Qw = Qg + (size_t)R0 * QP; const unsigned qoff = (unsigned)(r32 * QP + hi * 8);
#pragma unroll
      for (int d0 = 0; d0 < 8; ++d0) qr[d0] = ldg8(Qw + (qoff + d0 * 16)); }
    const int sr = tid >> 4, sc = (tid & 15) * 8, kws = KSWZ(sr, sc * 2), vst0 = v_st(sr, sc), vst1 = v_st(32 + sr, sc);
    const unsigned kvoff = (unsigned)(sr * QP + sc);
    const int vb0 = (int)(unsigned)(uintptr_t)V_lds + v_rd_base(lane);
    bf16x8 sk0, sk1, sv0, sv1;
#define SB_LOAD(j) do { const bf16_t* kp_ = Kg + (size_t)(64 * (j)) * QP; const bf16_t* vp_ = Vg + (size_t)(64 * (j)) * QP; \
        sk0 = ldg8(kp_ + kvoff); sk1 = ldg8(kp_ + (size_t)32 * QP + kvoff); sv0 = ldg8(vp_ + kvoff); sv1 = ldg8(vp_ + (size_t)32 * QP + kvoff); } while (0)
#define SB_WRITE(bf) do { *(ALAS bf16x8*)(K_lds + (bf) * SHM_K + kws) = sk0; *(ALAS bf16x8*)(K_lds + (bf) * SHM_K + kws + 32 * 256) = sk1; \
        *(ALAS bf16x8*)(V_lds + (bf) * SHM_V + vst0) = sv0; *(ALAS bf16x8*)(V_lds + (bf) * SHM_V + vst1) = sv1; } while (0)
    SB_LOAD(NT - 1); SB_WRITE(0);
    __syncthreads();
    float carry = 0.f; f32x16 o[4] = {};
    ALAS int* fl = (ALAS int*)(lds + LDS_WS); bool wdone = false;
    for (int t = 0; t < NT; ++t) {
        const int j = NT - 1 - t, buf = t & 1, kb = 64 * j;
        if (t + 1 < NT) SB_LOAD(j - 1);
        if (kb <= R0 + 30 && !wdone) {
            f32x16 p0 = {}, p1 = {};
            { const ldsp Kb = K_lds + buf * SHM_K;
#pragma unroll
              for (int d0 = 0; d0 < 8; ++d0) { const ldsp a = Kb + KSWZ(r32, ((d0 & 3) * 16 + hi * 8) * 2) + (d0 >> 2) * 128;
                  const bf16x8 b0 = *(const ALAS bf16x8*)a, b1 = *(const ALAS bf16x8*)(a + 32 * 256);
                  p0 = __builtin_amdgcn_mfma_f32_32x32x16_bf16(b0, qr[d0], p0, 0, 0, 0);
                  p1 = __builtin_amdgcn_mfma_f32_32x32x16_bf16(b1, qr[d0], p1, 0, 0, 0); } }
            f32x16 lb0, lb1;
#pragma unroll
            for (int r = 0; r < 16; ++r) {
                { const float z = p0[r]; const float e = __builtin_amdgcn_exp2f(-__builtin_fabsf(z)); const float sp = __builtin_fmaxf(z, 0.f) + __builtin_amdgcn_logf(1.f + e); p0[r] = -sp; lb0[r] = z - sp; }
                { const float z = p1[r]; const float e = __builtin_amdgcn_exp2f(-__builtin_fabsf(z)); const float sp = __builtin_fmaxf(z, 0.f) + __builtin_amdgcn_logf(1.f + e); p1[r] = -sp; lb1[r] = z - sp; }
            }
            if (kb + 63 >= R0) {
                const int dq = myrow - kb - 4 * hi; const float NEG = -__builtin_inff();
#pragma unroll
                for (int r = 0; r < 16; ++r) { const int c = (r & 3) + 8 * (r >> 2);
                    if (c >= dq) { p0[r] = 0.f; lb0[r] = NEG; }
                    if (c + 32 >= dq) { p1[r] = 0.f; lb1[r] = NEG; } }
            }
            float gs[8], go[8];
#pragma unroll
            for (int g = 0; g < 4; ++g) { gs[g] = (p0[4 * g] + p0[4 * g + 1]) + (p0[4 * g + 2] + p0[4 * g + 3]); gs[4 + g] = (p1[4 * g] + p1[4 * g + 1]) + (p1[4 * g + 2] + p1[4 * g + 3]); }
#pragma unroll
            for (int i = 0; i < 8; ++i) go[i] = xhalf(gs[i], hi);
            float acc = carry;
#pragma unroll
            for (int idx = 7; idx >= 0; --idx) { const int g = idx & 3; const float base = acc + (hi ? 0.f : go[idx]);
                if (idx >= 4) { const float t3 = base, t2 = t3 + p1[4 * g + 3], t1 = t2 + p1[4 * g + 2], t0 = t1 + p1[4 * g + 1];
                    lb1[4 * g + 3] = __builtin_amdgcn_exp2f(lb1[4 * g + 3] + t3); lb1[4 * g + 2] = __builtin_amdgcn_exp2f(lb1[4 * g + 2] + t2);
                    lb1[4 * g + 1] = __builtin_amdgcn_exp2f(lb1[4 * g + 1] + t1); lb1[4 * g] = __builtin_amdgcn_exp2f(lb1[4 * g] + t0); }
                else { const float t3 = base, t2 = t3 + p0[4 * g + 3], t1 = t2 + p0[4 * g + 2], t0 = t1 + p0[4 * g + 1];
                    lb0[4 * g + 3] = __builtin_amdgcn_exp2f(lb0[4 * g + 3] + t3); lb0[4 * g + 2] = __builtin_amdgcn_exp2f(lb0[4 * g + 2] + t2);
                    lb0[4 * g + 1] = __builtin_amdgcn_exp2f(lb0[4 * g + 1] + t1); lb0[4 * g] = __builtin_amdgcn_exp2f(lb0[4 * g] + t0); }
                acc += gs[idx] + go[idx]; }
            carry = acc;
            bf16x8 pa0, pa1, pa2, pa3;
            ATT_PK4(lb0, 0, pa0); ATT_PK4(lb0, 8, pa1); ATT_PK4(lb1, 0, pa2); ATT_PK4(lb1, 8, pa3);
            SBAR();
            pv_tile(o, vb0 + buf * SHM_V, pa0, pa1, pa2, pa3);
            wdone = __all(carry < -127.f);
        }
        if (lane == 0) fl[buf * 8 + wid] = wdone ? 1 : 0;
        if (t + 1 < NT) SB_WRITE(buf ^ 1);
        __syncthreads();
        { const ALAS int* f = fl + buf * 8; if ((f[0] & f[1] & f[2] & f[3] & f[4] & f[5] & f[6] & f[7]) != 0) break; }
    }
#undef SB_LOAD
#undef SB_WRITE
#if WO_F8
    unsigned char* Ow = (unsigned char*)Og + (size_t)R0 * OBP; const unsigned ooff = (unsigned)(4 * hi * OBP + r32);
#pragma unroll
    for (int r = 0; r < 16; ++r) { unsigned char* rowp = Ow + (size_t)((r & 3) + 8 * (r >> 2)) * OBP;
#pragma unroll
        for (int d0 = 0; d0 < 4; ++d0) { const unsigned w = quad_pack_fp8(o[d0][r] * OB8_SCALE);
            if ((r32 & 3) == 0) *(unsigned*)(rowp + (ooff + d0 * 32)) = w; } }
#else
    bf16_t* Ow = Og + (size_t)R0 * OP; const unsigned ooff = (unsigned)(4 * hi * OP + r32);
#pragma unroll
    for (int r = 0; r < 16; ++r) { bf16_t* rowp = Ow + (size_t)((r & 3) + 8 * (r >> 2)) * OP;
#pragma unroll
        for (int d0 = 0; d0 < 4; ++d0) { const float v = o[d0][r]; const float vn = __shfl_xor(v, 1);
            if ((r32 & 1) == 0) *(unsigned*)(rowp + (ooff + d0 * 32)) = cvtpk(v, vn); } }
#endif
}

constexpr float ATT_THR = 8.f;
__device__ __forceinline__ void qkt64(f32x16& p0, f32x16& p1, ldsp Kb, int r32, int hi, const bf16x8* qr) {
    p0 = f32x16{}; p1 = f32x16{};
#pragma unroll
    for (int d0 = 0; d0 < 4; ++d0) { const ldsp a = Kb + KSWZ64(r32, (d0 * 16 + hi * 8) * 2);
        const bf16x8 b0 = *(const ALAS bf16x8*)a, b1 = *(const ALAS bf16x8*)(a + 32 * 128);
        p0 = __builtin_amdgcn_mfma_f32_32x32x16_bf16(b0, qr[d0], p0, 0, 0, 0);
        p1 = __builtin_amdgcn_mfma_f32_32x32x16_bf16(b1, qr[d0], p1, 0, 0, 0); }
}
__device__ __forceinline__ void partial_sm(f32x16& p0, f32x16& p1, float& m_reg, float& alpha, int hi) {
    float pmax = p0[0];
#pragma unroll
    for (int r = 1; r < 16; ++r) pmax = __builtin_fmaxf(pmax, p0[r]);
#pragma unroll
    for (int r = 0; r < 16; ++r) pmax = __builtin_fmaxf(pmax, p1[r]);
    pmax = __builtin_fmaxf(pmax, xhalf(pmax, hi));
    float mn;
    if (__builtin_expect(__all(pmax - m_reg <= ATT_THR), 1)) { mn = m_reg; alpha = 1.f; }
    else { mn = __builtin_fmaxf(m_reg, pmax); alpha = __builtin_amdgcn_exp2f(m_reg - mn); m_reg = mn; }
#pragma unroll
    for (int r = 0; r < 16; ++r) { p0[r] -= mn; p1[r] -= mn; }
#pragma unroll
    for (int r = 0; r < 16; ++r) p0[r] = __builtin_amdgcn_exp2f(p0[r]);
}
__device__ __forceinline__ void finish_sm(f32x16& p0, f32x16& p1, float alpha, float& l_reg, bf16x8& pa0, bf16x8& pa1, bf16x8& pa2, bf16x8& pa3, int hi) {
#pragma unroll
    for (int r = 0; r < 16; ++r) p1[r] = __builtin_amdgcn_exp2f(p1[r]);
    float ps = 0.f;
#pragma unroll
    for (int r = 0; r < 16; ++r) ps += p0[r];
#pragma unroll
    for (int r = 0; r < 16; ++r) ps += p1[r];
    ps += xhalf(ps, hi);
    l_reg = l_reg * alpha + ps;
    ATT_PK4(p0, 0, pa0); ATT_PK4(p0, 8, pa1); ATT_PK4(p1, 0, pa2); ATT_PK4(p1, 8, pa3);
}
__device__ __forceinline__ void mask_gt(f32x16& p0, f32x16& p1, int dq) {
    const float NEG = -__builtin_inff();
#pragma unroll
    for (int r = 0; r < 16; ++r) { const int c = (r & 3) + 8 * (r >> 2);
        if (c > dq) p0[r] = NEG;
        if (c + 32 > dq) p1[r] = NEG; }
}
template <bool SECOND>
__device__ __forceinline__ void diff_pass(const bf16_t* __restrict__ Qg, const bf16_t* __restrict__ Kg, const bf16_t* __restrict__ Vg, float* S1, bf16_t* __restrict__ Og,
                                          int qb, float lam, const float* __restrict__ gsub, float gmul, ldsp lds, int wave_) {
    int tid_ = tid_from_wave(wave_); asm volatile("" : "+v"(tid_));
    const int tid = tid_, wid = __builtin_amdgcn_readfirstlane(tid >> 6), lane = tid & 63, r32 = lane & 31, hi = lane >> 5;
    const int NT = 4 * qb + 4, R0 = 256 * qb + 32 * wid, myrow = R0 + r32;
    const ldsp V_lds = lds + LDS_V; const ldsp K_lds = lds + LDS_K;
    ALAS float* wsf = (ALAS float*)(lds + LDS_WS) + wid * 64; ALAS float* li_l = wsf; ALAS float* al_l = wsf + 32;
    bf16x8 qr[4];
    { const bf16_t* Qw = Qg + (size_t)R0 * QP; const unsigned qoff = (unsigned)(r32 * QP + hi * 8);
#pragma unroll
      for (int d0 = 0; d0 < 4; ++d0) qr[d0] = ldg8(Qw + (qoff + d0 * 16)); }
    const int sr = tid >> 4, sc = (tid & 15) * 8, vst0 = v_st(sr, sc), vst1 = v_st(32 + sr, sc);
    const int kr = tid >> 3, kc = (tid & 7) * 8, kws = KSWZ64(kr, kc * 2);
    const unsigned voff = (unsigned)(sr * QP + sc), koff = (unsigned)(kr * QP + kc);
    const int vb0 = (int)(unsigned)(uintptr_t)V_lds + v_rd_base(lane);
    const int qm = myrow - 4 * hi;
    bf16x8 sk0A, sv0A, sv1A, sk0B, sv0B, sv1B;
#define DF_LOAD(S_, j) do { const bf16_t* vp_ = Vg + (size_t)(64 * (j)) * QP; sk0##S_ = ldg8(Kg + (size_t)(64 * (j)) * QP + koff); sv0##S_ = ldg8(vp_ + voff); sv1##S_ = ldg8(vp_ + (size_t)32 * QP + voff); } while (0)
#define DF_WRITE(S_, bf) do { *(ALAS bf16x8*)(K_lds + (bf) * SHM_K + kws) = sk0##S_; *(ALAS bf16x8*)(V_lds + (bf) * SHM_V + vst0) = sv0##S_; *(ALAS bf16x8*)(V_lds + (bf) * SHM_V + vst1) = sv1##S_; } while (0)
#define DF_MASK(P0, P1, t) do { if (64 * (t) + 63 > R0) mask_gt(P0, P1, qm - 64 * (t)); } while (0)
#define DF_RESC(a) do { if (__any((a) < 1.f)) { if (hi == 0) al_l[r32] = (a); asm volatile("s_waitcnt lgkmcnt(0)" ::: "memory"); \
        _Pragma("unroll") for (int d_ = 0; d_ < 4; ++d_) _Pragma("unroll") for (int r = 0; r < 16; ++r) o[d_][r] *= al_l[crow(r, hi)]; } } while (0)
    float m_reg = -1e30f, l_reg = 0.f; f32x16 o[4] = {};
    f32x16 pA0, pA1, pB0, pB1; float alA = 1.f, alB = 1.f; bf16x8 pa0, pa1, pa2, pa3;
    DF_LOAD(A, 0); DF_WRITE(A, 0);
    __syncthreads();
    DF_LOAD(A, 1); DF_LOAD(B, 2);
    qkt64(pA0, pA1, K_lds, r32, hi, qr); DF_MASK(pA0, pA1, 0); partial_sm(pA0, pA1, m_reg, alA, hi);
    DF_WRITE(A, 1);
    DF_RESC(alA);
    __syncthreads();
#define DF_HALF(PX0, PX1, alX, PY0, PY1, alY, t, KB, VB, SB, LS, WS) do { \
        SBAR(); qkt64(PX0, PX1, K_lds + (KB) * SHM_K, r32, hi, qr); \
        finish_sm(PY0, PY1, alY, l_reg, pa0, pa1, pa2, pa3, hi); SBAR(); \
        if ((t) + 2 < NT) { DF_LOAD(LS, (t) + 2); SBAR(); } \
        pv_tile(o, vb0 + (VB) * SHM_V, pa0, pa1, pa2, pa3); DF_MASK(PX0, PX1, (t)); partial_sm(PX0, PX1, m_reg, alX, hi); \
        __syncthreads(); \
        if ((t) + 1 < NT) DF_WRITE(WS, SB); \
        DF_RESC(alX); __syncthreads(); } while (0)
    for (int t = 1; t + 1 < NT; t += 2) {
        DF_HALF(pB0, pB1, alB, pA0, pA1, alA, t, 1, 0, 0, A, B);
        DF_HALF(pA0, pA1, alA, pB0, pB1, alB, t + 1, 0, 1, 1, B, A);
    }
    DF_HALF(pB0, pB1, alB, pA0, pA1, alA, NT - 1, 1, 0, 0, A, B);
    finish_sm(pB0, pB1, alB, l_reg, pa0, pa1, pa2, pa3, hi); SBAR();
    pv_tile(o, vb0 + 1 * SHM_V, pa0, pa1, pa2, pa3);
#undef DF_LOAD
#undef DF_WRITE
#undef DF_MASK
#undef DF_RESC
#undef DF_HALF
    if (hi == 0) li_l[r32] = l_reg; asm volatile("s_waitcnt lgkmcnt(0)" ::: "memory");
    float rli[16];
#pragma unroll
    for (int r = 0; r < 16; ++r) rli[r] = __builtin_amdgcn_rcpf(li_l[crow(r, hi)]);
    if constexpr (!SECOND) {
        float* Sw = S1 + (size_t)R0 * OP; const unsigned ooff = (unsigned)(4 * hi * OP + r32);
#pragma unroll
        for (int r = 0; r < 16; ++r) { float* rowp = Sw + (size_t)((r & 3) + 8 * (r >> 2)) * OP;
#pragma unroll
            for (int d0 = 0; d0 < 4; ++d0) rowp[ooff + d0 * 32] = o[d0][r] * rli[r]; }
    } else {
        const float* Sw = S1 + (size_t)R0 * OP; bf16_t* Ow = Og + (size_t)R0 * OP; (void)Ow; const unsigned ooff = (unsigned)(4 * hi * OP + r32), ooff8 = (unsigned)(4 * hi * OBP + r32);
        float gn[4];
#pragma unroll
        for (int d0 = 0; d0 < 4; ++d0) gn[d0] = gsub[d0 * 32 + r32] * gmul;
#pragma unroll
        for (int r = 0; r < 16; ++r) { const float* srow = Sw + (size_t)((r & 3) + 8 * (r >> 2)) * OP; float d[4]; float ss = 0.f;
#if WO_F8
            unsigned char* orowp = (unsigned char*)Og + (size_t)(R0 + (r & 3) + 8 * (r >> 2)) * OBP;
#else
            bf16_t* orowp = Ow + (size_t)((r & 3) + 8 * (r >> 2)) * OP;
#endif
#pragma unroll
            for (int d0 = 0; d0 < 4; ++d0) { d[d0] = srow[ooff + d0 * 32] - lam * (o[d0][r] * rli[r]); ss += d[d0] * d[d0]; }
            ss += __builtin_bit_cast(float, __builtin_amdgcn_update_dpp(0, __builtin_bit_cast(int, ss), 0xB1, 0xf, 0xf, true));
            ss += __builtin_bit_cast(float, __builtin_amdgcn_update_dpp(0, __builtin_bit_cast(int, ss), 0x4E, 0xf, 0xf, true));
            ss += __builtin_bit_cast(float, __builtin_amdgcn_update_dpp(0, __builtin_bit_cast(int, ss), 0x141, 0xf, 0xf, true));
            ss += __builtin_bit_cast(float, __builtin_amdgcn_update_dpp(0, __builtin_bit_cast(int, ss), 0x140, 0xf, 0xf, true));
            { auto rr = __builtin_amdgcn_permlane16_swap(__float_as_uint(ss), __float_as_uint(ss), false, false); ss = __uint_as_float(rr[0]) + __uint_as_float(rr[1]); }
            const float rs = __builtin_amdgcn_rsqf(ss * (1.f / 128.f) + 1e-5f);
#pragma unroll
#if WO_F8
            for (int d0 = 0; d0 < 4; ++d0) { const unsigned w = quad_pack_fp8(d[d0] * rs * gn[d0] * OB8_SCALE);
                if ((r32 & 3) == 0) *(unsigned*)(orowp + (ooff8 + d0 * 32)) = w; }
#else
            for (int d0 = 0; d0 < 4; ++d0) { const float v = d[d0] * rs * gn[d0]; const float vn = __shfl_xor(v, 1);
                if ((r32 & 1) == 0) *(unsigned*)(orowp + (ooff + d0 * 32)) = cvtpk(v, vn); }
#endif
            if ((r & 1) == 1) asm volatile("" ::: "memory"); }
    }
    __syncthreads();
}

#ifndef D2_NEGM
#define D2_NEGM 1
#endif
constexpr int D2_SLK = 8192, D2_SLV = 16384, D2_K = 0, D2_V = 3 * D2_SLK, D2_WS = D2_V + 3 * D2_SLV, D2_LDS_BYTES = D2_WS + 8 * 256;
typedef __attribute__((address_space(3))) const char* lds_cptr;
typedef short v4i16_t __attribute__((ext_vector_type(4)));
typedef float f32x2_t __attribute__((ext_vector_type(2))); typedef __bf16 bf16x2_t __attribute__((ext_vector_type(2)));
__device__ __forceinline__ unsigned cvtpk_s(float lo, float hi) { const f32x2_t v = {lo, hi}; const bf16x2_t b = __builtin_convertvector(v, bf16x2_t); return __builtin_bit_cast(unsigned, b); }
__device__ __forceinline__ s16x4 vtr(lds_cptr p) { return __builtin_bit_cast(s16x4, __builtin_amdgcn_ds_read_tr16_b64_v4i16((__attribute__((address_space(3))) v4i16_t*)p)); }
__device__ __forceinline__ void kload2(bf16x8* kf, lds_cptr kp, int j) { kf[2 * j] = *(const ALAS bf16x8*)(kp + j * 2048); kf[2 * j + 1] = *(const ALAS bf16x8*)(kp + j * 2048 + 512); }
__device__ __forceinline__ void glds16s(unsigned voff, const void* gbase, unsigned ldsdst) { unsigned keep;
    asm volatile("s_mov_b32 %0, m0\n\ts_mov_b32 m0, %3\n\ts_nop 0\n\tglobal_load_lds_dwordx4 %1, %2\n\ts_mov_b32 m0, %0" : "=&s"(keep) : "v"(voff), "s"(gbase), "s"(ldsdst) : "memory"); }
#define D2_MX3(a, b, c) __builtin_fmaxf(__builtin_fmaxf((a), (b)), (c))
__device__ __forceinline__ float rowmax2(const f32x16& p0, const f32x16& p1) {
    float a = D2_MX3(p0[0], p0[1], p1[0]), b = D2_MX3(p0[2], p0[3], p1[1]); a = D2_MX3(a, p1[2], p1[3]);
#pragma unroll
    for (int r = 4; r < 16; r += 4) { a = D2_MX3(a, p0[r], p0[r + 1]); b = D2_MX3(b, p0[r + 2], p0[r + 3]); a = D2_MX3(a, p1[r], p1[r + 1]); b = D2_MX3(b, p1[r + 2], p1[r + 3]); }
    const float m = __builtin_fmaxf(a, b); auto rr = __builtin_amdgcn_permlane32_swap(__float_as_uint(m), __float_as_uint(m), false, false);
    return __builtin_fmaxf(__uint_as_float(rr[0]), __uint_as_float(rr[1])); }
__device__ __forceinline__ void cmask2(f32x16& p0, f32x16& p1, int jb, int qrel, int hi) {
    const int kb = 64 * jb + 4 * hi; const float NEG = -__builtin_inff();
#pragma unroll
    for (int r = 0; r < 16; ++r) { const int kv = kb + (r & 3) + 8 * (r >> 2); if (kv > qrel) p0[r] = NEG; if (kv + 32 > qrel) p1[r] = NEG; } }
#define D2_WAIT_BAR(N) asm volatile("s_waitcnt vmcnt(" #N ") lgkmcnt(0)\n\ts_barrier" ::: "memory")
#define D2_PIN(x) asm volatile("" : "+v"(x))
#define D2_MF(a, b, c) __builtin_amdgcn_mfma_f32_32x32x16_bf16(a, b, c, 0, 0, 0)

template <bool SECOND>
__device__ __forceinline__ void diff_pass2(const bf16_t* __restrict__ Qg, const bf16_t* __restrict__ Kg, const bf16_t* __restrict__ Vg, float* S1, bf16_t* __restrict__ Og,
                                           int qb, float lam, const float* __restrict__ gsub, float gmul, ldsp lds, int wave_) {
    int tid_ = tid_from_wave(wave_); asm volatile("" : "+v"(tid_));
    const int tid = tid_, wid = __builtin_amdgcn_readfirstlane(tid >> 6), lane = tid & 63, r32 = lane & 31, hi = lane >> 5;
    const int NT = 4 * qb + 4, R0 = 256 * qb + 32 * wid;
    const unsigned lds0 = (unsigned)(uintptr_t)lds;
    ALAS float* wsf = (ALAS float*)(lds + D2_WS) + wid * 64;
    const unsigned kvo = (unsigned)(lane * QP + wid * 8) * 2u;
    const unsigned vvo = (unsigned)((16 * (wid & 3) + (lane >> 2)) * QP + (wid >> 2) * 32 + (lane & 3) * 8) * 2u;
    const unsigned kdst = lds0 + D2_K + wid * 1024, vdst = lds0 + D2_V + wid * 1024;
#define D2_DMA_K(t, slot) glds16s(kvo, Kg + (size_t)(t) * 64 * QP, (unsigned)__builtin_amdgcn_readfirstlane(kdst + (slot)))
#define D2_DMA_V(t, slot) do { glds16s(vvo, Vg + (size_t)(t) * 64 * QP, (unsigned)__builtin_amdgcn_readfirstlane(vdst + 2 * (slot))); \
                               glds16s(vvo, Vg + (size_t)(t) * 64 * QP + 64, (unsigned)__builtin_amdgcn_readfirstlane(vdst + 2 * (slot) + 8192)); } while (0)
    const lds_cptr kp0 = (lds_cptr)lds + D2_K + hi * 1024 + r32 * 16;
    const lds_cptr vp0 = (lds_cptr)lds + D2_V + ((lane >> 4) & 1) * 32 + (lane & 3) * 8 + (4 * hi + ((lane & 15) >> 2)) * 64;
    D2_DMA_K(0, 0); D2_DMA_V(0, 0); D2_DMA_K(1, D2_SLK);
    bf16x8 qr[4];
    { const bf16_t* Qw = Qg + (size_t)R0 * QP; const unsigned qoff = (unsigned)(r32 * QP + hi * 8);
#pragma unroll
      for (int d0 = 0; d0 < 4; ++d0) qr[d0] = ldg8(Qw + (qoff + d0 * 16)); }
    D2_DMA_K(2, 2 * D2_SLK);
    float mhat = 0.f, l_reg = 0.f; f32x16 o[4] = {};
    const int qrel = 32 * wid + r32; bool resc = false;
    f32x16 pA0, pA1, pB0, pB1; bf16x8 kf[8]; s16x4 vlo[4], vhi[4]; u32x4 pw0, pw1, pw2, pw3;
#if D2_NEGM
    f32x16 negm;
#endif
    int sl_prev = 0, sl_cur = 0, sl_next = D2_SLK;
#define D2_ROT() do { sl_prev = sl_cur; sl_cur = sl_next; sl_next = (sl_next == 2 * D2_SLK) ? 0 : sl_next + D2_SLK; } while (0)
#if D2_NEGM
#define D2_EX(v) __builtin_amdgcn_exp2f(v)
#define D2_C0 negm
#else
#define D2_EX(v) __builtin_amdgcn_exp2f((v) - mhat)
#define D2_C0 D2_Z16
#endif
#define D2_RESC() do { if (resc) { _Pragma("unroll") for (int d_ = 0; d_ < 4; ++d_) _Pragma("unroll") for (int r = 0; r < 16; ++r) o[d_][r] *= wsf[crow(r, hi)]; } } while (0)
#define D2_Z16 (f32x16){}
#if D2_NEGM
#define D2_RM(C0, C1) rowmax2(C0, C1)
#define D2_MOVE(C0, C1, dl) do { _Pragma("unroll") for (int r = 0; r < 16; ++r) { C0[r] -= dl; C1[r] -= dl; } _Pragma("unroll") for (int r = 0; r < 16; ++r) negm[r] = -mhat; D2_PIN(negm); } while (0)
#else
#define D2_RM(C0, C1) (rowmax2(C0, C1) - mhat)
#define D2_MOVE(C0, C1, dl) do { } while (0)
#endif
    D2_WAIT_BAR(4);
#pragma unroll
    for (int d0 = 0; d0 < 4; ++d0) kload2(kf, kp0, d0);
    pA0 = D2_MF(kf[0], qr[0], D2_Z16); pA1 = D2_MF(kf[1], qr[0], D2_Z16); pA0 = D2_MF(kf[2], qr[1], pA0); pA1 = D2_MF(kf[3], qr[1], pA1);
    pA0 = D2_MF(kf[4], qr[2], pA0); pA1 = D2_MF(kf[5], qr[2], pA1); pA0 = D2_MF(kf[6], qr[3], pA0); pA1 = D2_MF(kf[7], qr[3], pA1);
    if (NT == 4) cmask2(pA0, pA1, 0, qrel, hi);
    { mhat = rowmax2(pA0, pA1);
#pragma unroll
      for (int r = 0; r < 16; ++r) { pA0[r] = __builtin_amdgcn_exp2f(pA0[r] - mhat); pA1[r] = __builtin_amdgcn_exp2f(pA1[r] - mhat); }
#if D2_NEGM
#pragma unroll
      for (int r = 0; r < 16; ++r) negm[r] = -mhat;
      D2_PIN(negm);
#endif
    }
    D2_WAIT_BAR(0);
    D2_DMA_K(3, 0); D2_DMA_V(1, D2_SLK); D2_ROT();
#pragma unroll
    for (int d0 = 0; d0 < 4; ++d0) kload2(kf, kp0 + sl_cur, d0);
    D2_WAIT_BAR(3);
#define D2_PKW(P, i) cvtpk_s(P[i], P[(i) + 1])
#define D2_PAF(k) __builtin_bit_cast(bf16x8, pw##k)
#define D2_VFR(i) (bf16x8){vlo[i][0], vlo[i][1], vlo[i][2], vlo[i][3], vhi[i][0], vhi[i][1], vhi[i][2], vhi[i][3]}
#define D2_VRD(s, i) do { vlo[s] = vtr(vp_ + ((((i) & 3) * 4096) + (((i) >> 2) * 1024))); vhi[s] = vtr(vp_ + ((((i) & 3) * 4096) + (((i) >> 2) * 1024) + 512)); } while (0)
#define D2_KRD(G, d0) do { if (G) { kload2(kf, kp0 + sl_next, d0); SBAR(); } } while (0)
#define D2_GAPA(MF_, a0, a1, a2, a3, W0, W1, PW) do { MF_; sacc += a0; sacc += a1; sacc += a2; sacc += a3; D2_PIN(sacc); W0; W1; D2_PIN(PW); SBAR(); } while (0)
#define D2_GAPB(j, K_, X, e) do { o[(j) & 3] = D2_MF(D2_PAF(K_), D2_VFR((j) & 3), o[(j) & 3]); X[e] = D2_EX(X[e]); X[(e) + 1] = D2_EX(X[(e) + 1]); D2_PIN(X); SBAR(); } while (0)
#define D2_STEP(C0, C1, P0, P1, t, MASK, GK, GV, GL) do { SBAR(); \
    const lds_cptr vp_ = vp0 + 2 * sl_prev; \
    float sacc = P0[0] + P0[1]; \
                          D2_GAPA(C0 = D2_MF(kf[0], qr[0], D2_C0),  P0[2], P0[3], P0[4], P0[5],     pw0[0] = D2_PKW(P0, 0),  pw0[1] = D2_PKW(P0, 2),  pw0); \
                          D2_GAPA(C1 = D2_MF(kf[1], qr[0], D2_C0),  P0[6], P0[7], P0[8], P0[9],     pw0[2] = D2_PKW(P0, 4),  pw0[3] = D2_PKW(P0, 6),  pw0); \
                          D2_GAPA(C0 = D2_MF(kf[2], qr[1], C0),     P0[10], P0[11], P0[12], P0[13], pw1[0] = D2_PKW(P0, 8),  pw1[1] = D2_PKW(P0, 10), pw1); \
                          D2_GAPA(C1 = D2_MF(kf[3], qr[1], C1),     P0[14], P0[15], P1[0], P1[1],   pw1[2] = D2_PKW(P0, 12), pw1[3] = D2_PKW(P0, 14), pw1); \
    D2_VRD(0, 0); SBAR(); D2_GAPA(C0 = D2_MF(kf[4], qr[2], C0),     P1[2], P1[3], P1[4], P1[5],     pw2[0] = D2_PKW(P1, 0),  pw2[1] = D2_PKW(P1, 2),  pw2); \
    D2_VRD(1, 1); SBAR(); D2_GAPA(C1 = D2_MF(kf[5], qr[2], C1),     P1[6], P1[7], P1[8], P1[9],     pw2[2] = D2_PKW(P1, 4),  pw2[3] = D2_PKW(P1, 6),  pw2); \
    D2_VRD(2, 2); SBAR(); D2_GAPA(C0 = D2_MF(kf[6], qr[3], C0),     P1[10], P1[11], P1[12], P1[13], pw3[0] = D2_PKW(P1, 8),  pw3[1] = D2_PKW(P1, 10), pw3); \
    D2_VRD(3, 3); SBAR(); D2_GAPA(C1 = D2_MF(kf[7], qr[3], C1),     P1[14], P1[15], 0.f, 0.f,       pw3[2] = D2_PKW(P1, 12), pw3[3] = D2_PKW(P1, 14), pw3); \
    l_reg += sacc; \
    if (GK) D2_DMA_K((t) + 3, sl_cur); if (GV) D2_DMA_V((t) + 1, sl_next);                                                  \
    if (MASK) cmask2(C0, C1, (t) - (NT - 4), qrel, hi); \
    { const float rm = D2_RM(C0, C1); resc = false;                                                                          \
      if (__builtin_expect(__any(rm > ATT_THR), 0)) { const float dl = __builtin_fmaxf(rm, 0.f); mhat += dl;                \
          D2_MOVE(C0, C1, dl); \
          const float f = __builtin_amdgcn_exp2f(-dl); l_reg *= f; if (hi == 0) wsf[r32] = f; resc = true; } } \
    SBAR(); \
    D2_GAPB(0, 0, C0, 0);   D2_VRD(0, 4);  SBAR(); D2_GAPB(1, 0, C0, 2);   D2_VRD(1, 5);  SBAR(); D2_GAPB(2, 0, C0, 4);   D2_VRD(2, 6);  SBAR(); D2_GAPB(3, 0, C0, 6);   D2_VRD(3, 7);  SBAR(); \
    D2_GAPB(4, 1, C0, 8);   D2_VRD(0, 8);  SBAR(); D2_GAPB(5, 1, C0, 10);  D2_VRD(1, 9);  SBAR(); D2_GAPB(6, 1, C0, 12);  D2_VRD(2, 10); SBAR(); D2_GAPB(7, 1, C0, 14);  D2_VRD(3, 11); SBAR(); \
    D2_GAPB(8, 2, C1, 0);   D2_VRD(0, 12); SBAR(); D2_GAPB(9, 2, C1, 2);   D2_VRD(1, 13); SBAR(); D2_GAPB(10, 2, C1, 4);  D2_VRD(2, 14); SBAR(); D2_GAPB(11, 2, C1, 6);  D2_VRD(3, 15); SBAR(); \
    D2_KRD(GL, 0); D2_GAPB(12, 3, C1, 8);  D2_KRD(GL, 1); D2_GAPB(13, 3, C1, 10); D2_KRD(GL, 2); D2_GAPB(14, 3, C1, 12); D2_KRD(GL, 3); D2_GAPB(15, 3, C1, 14); \
    } while (0)
    int t = 1;
    for (; t + 5 < NT; t += 2) {
        D2_STEP(pB0, pB1, pA0, pA1, t, false, true, true, true);     D2_WAIT_BAR(3); D2_RESC(); D2_ROT();
        D2_STEP(pA0, pA1, pB0, pB1, t + 1, false, true, true, true); D2_WAIT_BAR(3); D2_RESC(); D2_ROT();
    }
#define D2_ENDW(tt) do { if ((tt) + 3 < NT) { D2_WAIT_BAR(3); } else if ((tt) + 2 < NT) { D2_WAIT_BAR(2); } else { D2_WAIT_BAR(0); } } while (0)
    for (; t + 1 < NT; t += 2) {
        D2_STEP(pB0, pB1, pA0, pA1, t, true, (t + 3 < NT), (t + 1 < NT), (t + 1 < NT));         D2_ENDW(t);     D2_RESC(); D2_ROT();
        D2_STEP(pA0, pA1, pB0, pB1, t + 1, true, (t + 4 < NT), (t + 2 < NT), (t + 2 < NT));     D2_ENDW(t + 1); D2_RESC(); D2_ROT();
    }
    D2_STEP(pB0, pB1, pA0, pA1, NT - 1, true, false, false, false); D2_RESC();
    { float sacc = pB0[0] + pB0[1];
#pragma unroll
      for (int r = 2; r < 16; ++r) sacc += pB0[r];
#pragma unroll
      for (int r = 0; r < 16; ++r) sacc += pB1[r];
      l_reg += sacc;
      pw0 = (u32x4){D2_PKW(pB0, 0), D2_PKW(pB0, 2), D2_PKW(pB0, 4), D2_PKW(pB0, 6)}; pw1 = (u32x4){D2_PKW(pB0, 8), D2_PKW(pB0, 10), D2_PKW(pB0, 12), D2_PKW(pB0, 14)};
      pw2 = (u32x4){D2_PKW(pB1, 0), D2_PKW(pB1, 2), D2_PKW(pB1, 4), D2_PKW(pB1, 6)}; pw3 = (u32x4){D2_PKW(pB1, 8), D2_PKW(pB1, 10), D2_PKW(pB1, 12), D2_PKW(pB1, 14)};
      const lds_cptr vp_ = vp0 + 2 * sl_cur; SBAR();
#pragma unroll
      for (int i = 0; i < 4; ++i) D2_VRD(i, i);
      o[0] = D2_MF(D2_PAF(0), D2_VFR(0), o[0]); o[1] = D2_MF(D2_PAF(0), D2_VFR(1), o[1]); o[2] = D2_MF(D2_PAF(0), D2_VFR(2), o[2]); o[3] = D2_MF(D2_PAF(0), D2_VFR(3), o[3]); SBAR();
#pragma unroll
      for (int i = 0; i < 4; ++i) D2_VRD(i, i + 4);
      o[0] = D2_MF(D2_PAF(1), D2_VFR(0), o[0]); o[1] = D2_MF(D2_PAF(1), D2_VFR(1), o[1]); o[2] = D2_MF(D2_PAF(1), D2_VFR(2), o[2]); o[3] = D2_MF(D2_PAF(1), D2_VFR(3), o[3]); SBAR();
#pragma unroll
      for (int i = 0; i < 4; ++i) D2_VRD(i, i + 8);
      o[0] = D2_MF(D2_PAF(2), D2_VFR(0), o[0]); o[1] = D2_MF(D2_PAF(2), D2_VFR(1), o[1]); o[2] = D2_MF(D2_PAF(2), D2_VFR(2), o[2]); o[3] = D2_MF(D2_PAF(2), D2_VFR(3), o[3]); SBAR();
#pragma unroll
      for (int i = 0; i < 4; ++i) D2_VRD(i, i + 12);
      o[0] = D2_MF(D2_PAF(3), D2_VFR(0), o[0]); o[1] = D2_MF(D2_PAF(3), D2_VFR(1), o[1]); o[2] = D2_MF(D2_PAF(3), D2_VFR(2), o[2]); o[3] = D2_MF(D2_PAF(3), D2_VFR(3), o[3]); }
#undef D2_DMA_K
#undef D2_DMA_V
#undef D2_ROT
#undef D2_EX
#undef D2_C0
#undef D2_RM
#undef D2_MOVE
#undef D2_RESC
#undef D2_PKW
#undef D2_PAF
#undef D2_VFR
#undef D2_VRD
#undef D2_KRD
#undef D2_ENDW
#undef D2_GAPA
#undef D2_GAPB
#undef D2_STEP
    { auto rr = __builtin_amdgcn_permlane32_swap(__float_as_uint(l_reg), __float_as_uint(l_reg), false, false); l_reg = __uint_as_float(rr[0]) + __uint_as_float(rr[1]); }
    ALAS float* li_l = wsf + 32;
    if (hi == 0) li_l[r32] = l_reg; asm volatile("s_waitcnt lgkmcnt(0)" ::: "memory");
    float rli[16];
#pragma unroll
    for (int r = 0; r < 16; ++r) rli[r] = __builtin_amdgcn_rcpf(li_l[crow(r, hi)]);
    if constexpr (!SECOND) {
        float* Sw = S1 + (size_t)R0 * OP; const unsigned ooff = (unsigned)(4 * hi * OP + r32);
#pragma unroll
        for (int r = 0; r < 16; ++r) { float* rowp = Sw + (size_t)((r & 3) + 8 * (r >> 2)) * OP;
#pragma unroll
            for (int d0 = 0; d0 < 4; ++d0) rowp[ooff + d0 * 32] = o[d0][r] * rli[r]; }
    } else {
        const float* Sw = S1 + (size_t)R0 * OP; const unsigned ooff = (unsigned)(4 * hi * OP + r32), ooff8 = (unsigned)(4 * hi * OBP + r32);
        float gn[4];
#pragma unroll
        for (int d0 = 0; d0 < 4; ++d0) gn[d0] = gsub[d0 * 32 + r32] * gmul;
#pragma unroll
        for (int r = 0; r < 16; ++r) { const float* srow = Sw + (size_t)((r & 3) + 8 * (r >> 2)) * OP; float d[4]; float ss = 0.f;
            unsigned char* orowp = (unsigned char*)Og + (size_t)(R0 + (r & 3) + 8 * (r >> 2)) * OBP;
#pragma unroll
            for (int d0 = 0; d0 < 4; ++d0) { d[d0] = srow[ooff + d0 * 32] - lam * (o[d0][r] * rli[r]); ss += d[d0] * d[d0]; }
            ss += __builtin_bit_cast(float, __builtin_amdgcn_update_dpp(0, __builtin_bit_cast(int, ss), 0xB1, 0xf, 0xf, true));
            ss += __builtin_bit_cast(float, __builtin_amdgcn_update_dpp(0, __builtin_bit_cast(int, ss), 0x4E, 0xf, 0xf, true));
            ss += __builtin_bit_cast(float, __builtin_amdgcn_update_dpp(0, __builtin_bit_cast(int, ss), 0x141, 0xf, 0xf, true));
            ss += __builtin_bit_cast(float, __builtin_amdgcn_update_dpp(0, __builtin_bit_cast(int, ss), 0x140, 0xf, 0xf, true));
            { auto rr = __builtin_amdgcn_permlane16_swap(__float_as_uint(ss), __float_as_uint(ss), false, false); ss = __uint_as_float(rr[0]) + __uint_as_float(rr[1]); }
            const float rs = __builtin_amdgcn_rsqf(ss * (1.f / 128.f) + 1e-5f);
#pragma unroll
            for (int d0 = 0; d0 < 4; ++d0) { const unsigned w = quad_pack_fp8(d[d0] * rs * gn[d0] * OB8_SCALE);
                if ((r32 & 3) == 0) *(unsigned*)(orowp + (ooff8 + d0 * 32)) = w; }
            if ((r & 1) == 1) asm volatile("" ::: "memory"); }
    }
    asm volatile("s_waitcnt lgkmcnt(0)\n\ts_barrier" ::: "memory");
}
#undef D2_WAIT_BAR
#undef D2_PIN
#undef D2_MF
#undef D2_MX3
#undef D2_Z16
#undef SBAR
}

#define LAS __attribute__((address_space(3)))

#define XB_TMO      128
#define XB_XCNT(j)  (256  + 64 * (j))
#define XB_XSUB(j)  (1280 + 64 * (j))
#define XB_XGEN(j)  (2304 + 64 * (j))
#define XB_TOP      3328
#define XB_TOPGEN   3392
#define XCD_BAR_WORDS 3456
#define XB_SPIN_CAP (1u << 18)

__device__ __forceinline__ unsigned xb_ld(unsigned* p)              { return __hip_atomic_load(p, __ATOMIC_RELAXED, __HIP_MEMORY_SCOPE_AGENT); }
__device__ __forceinline__ unsigned xb_add(unsigned* p, unsigned v) { return __hip_atomic_fetch_add(p, v, __ATOMIC_RELAXED, __HIP_MEMORY_SCOPE_AGENT); }
__device__ __forceinline__ unsigned xb_xcc_id() { return (unsigned)__builtin_amdgcn_s_getreg((3 << 11) | 20) & 0xFu; }
#define XB_SPIN(cond, bar) do { unsigned _sp = 0; while (cond) { __builtin_amdgcn_s_sleep(1); \
    if ((++_sp & 255u) == 0u) { if (xb_ld(&(bar)[XB_TMO])) break; if (_sp > XB_SPIN_CAP) { atomicAdd(&(bar)[XB_TMO], 1u); break; } } } } while (0)

struct XcdBarrier {
    unsigned* bar; unsigned x;
    volatile LAS unsigned* st;
};

__device__ __forceinline__ XcdBarrier xcd_barrier_post(unsigned* bar, volatile LAS unsigned* st, bool thread0) {
    XcdBarrier b; b.bar = bar; b.x = xb_xcc_id(); b.st = st;
    if (thread0) (void)xb_add(&bar[XB_XCNT(b.x)], 1u);
    return b;
}
__device__ __forceinline__ void xcd_barrier_complete(unsigned* bar, unsigned x, unsigned& nloc, unsigned& nx) {
    const unsigned G = gridDim.x * gridDim.y * gridDim.z;
    unsigned sum, cnt, mine, sp = 0u;
    for (;;) {
        sum = 0u; cnt = 0u; mine = 0u;
#pragma unroll
        for (unsigned j = 0; j < 16; ++j) { const unsigned c = xb_ld(&bar[XB_XCNT(j)]); sum += c; cnt += (c > 0u) ? 1u : 0u; mine = (j == x) ? c : mine; }
        if (sum == G) break;
        __builtin_amdgcn_s_sleep(1);
        if ((++sp & 255u) == 0u) { if (xb_ld(&bar[XB_TMO])) break; if (sp > XB_SPIN_CAP) { atomicAdd(&bar[XB_TMO], 1u); break; } }
    }
    nloc = mine > 0u ? mine : 1u; nx = cnt > 0u ? cnt : 1u;
}

__device__ __forceinline__ void xcd_barrier(const XcdBarrier& b, bool thread0) {
    asm volatile("s_waitcnt vmcnt(0)" ::: "memory");
    __syncthreads();
    if (thread0) {
        unsigned* bar = b.bar;
        __builtin_amdgcn_s_waitcnt(0);
        unsigned nloc = b.st[0], nx = b.st[1];
        if (nloc == 0u) { xcd_barrier_complete(bar, b.x, nloc, nx); b.st[0] = nloc; b.st[1] = nx; }
        const unsigned old = xb_add(&bar[XB_XSUB(b.x)], 1u);
        const unsigned gen = old / nloc;
        if (old + 1u == (gen + 1u) * nloc) {
            __builtin_amdgcn_fence(__ATOMIC_RELEASE, "agent");
            asm volatile("s_waitcnt vmcnt(0)" ::: "memory");
            const unsigned og = xb_add(&bar[XB_TOP], 1u);
            const unsigned tg = og / nx;
            if (og + 1u == (tg + 1u) * nx) xb_add(&bar[XB_TOPGEN], 1u);
            else XB_SPIN(xb_ld(&bar[XB_TOPGEN]) == tg, bar);
            __builtin_amdgcn_fence(__ATOMIC_ACQUIRE, "agent");
            xb_add(&bar[XB_XGEN(b.x)], 1u);
            asm volatile("s_waitcnt vmcnt(0)" ::: "memory");
        } else {
            XB_SPIN(xb_ld(&bar[XB_XGEN(b.x)]) == gen, bar);
            __builtin_amdgcn_fence(__ATOMIC_ACQUIRE, "agent");
            asm volatile("s_waitcnt vmcnt(0)" ::: "memory");
        }
    }
    __syncthreads();
}

constexpr int NWAVES = 8;
constexpr int NTOK = 16384, DM = 2048, SEQ = 2048, NHEAD = 16, NLAYER = 4, NEXP = 16, DEXP = 1024;
constexpr int XS_ROWS = 36864;
constexpr float LN_EPS = 1e-5f;
constexpr float DN_ALPHA = 1.6817928305074292f;
constexpr float LOG2E = 1.4426950408889634f;
constexpr float SB_QSCALE = 0.08838834764831845f * LOG2E;
constexpr float DF_QSCALE = 0.125f * LOG2E;
#ifndef MK_MULTI
#define MK_MULTI 0
#endif
#ifndef MOE_F8
#define MOE_F8 1
#endif
#ifndef QKV8_A
#define QKV8_A 1
#endif
#ifndef QKV8_B
#define QKV8_B 0
#endif
#ifndef DF_RING
#define DF_RING 1
#endif
constexpr int NSTEPS = 1 + 8 * NLAYER;

constexpr size_t MiB = 1u << 20;
constexpr size_t WS_CTL = 0, CTL_ZERO_BYTES = 256 * 1024;
constexpr size_t WS_COS = 1 * MiB, WS_SIN = WS_COS + 256 * 1024;
constexpr size_t WS_WR = 2 * MiB;
constexpr size_t WS_CNT = 3 * MiB;
constexpr size_t WS_RE = WS_CNT + 64 * 1024;
constexpr size_t WS_RW = WS_RE + 64 * 1024;
constexpr size_t WS_RP = WS_RW + 128 * 1024;
constexpr int LDH = 2048;
constexpr int P8K2 = 2048, P8K1 = 1024;
constexpr size_t WS_WQKVA = 4 * MiB;
constexpr size_t WS_WOA = WS_WQKVA + 56 * MiB;
constexpr size_t WS_WQKVB = WS_WOA + 16 * MiB;
constexpr size_t WS_WOB = WS_WQKVB + 36 * MiB;
constexpr size_t WS_WGU = WS_WOB + 16 * MiB;
constexpr size_t WS_WDN = WS_WGU + 512 * MiB;
constexpr size_t WS_H = WS_WDN + 256 * MiB;
constexpr size_t WS_HB = WS_H + 128 * MiB;
constexpr size_t WS_QKV = WS_HB + 68 * MiB;
constexpr size_t WS_OB = WS_QKV + 192 * MiB;
constexpr size_t WS_XS = WS_OB + 64 * MiB;
constexpr size_t WS_ACT = WS_XS + 144 * MiB;
constexpr size_t WS_YD = WS_ACT + 72 * MiB;
constexpr size_t WS_END = WS_YD + 144 * MiB;
static_assert(WS_END <= (size_t)2040 * MiB, "workspace map");
static_assert((size_t)2 * 6144 * LDH * 2 <= 56 * MiB && (size_t)8192 * LDH * 2 <= 36 * MiB && (size_t)2 * 2048 * P8K2 <= 16 * MiB && (size_t)64 * 2048 * P8K2 <= 512 * MiB && (size_t)64 * 2048 * P8K1 <= 256 * MiB, "weight regions");
static_assert((size_t)NTOK * LDH * 2 <= 68 * MiB && (size_t)NTOK * P8K2 <= 64 * MiB && (size_t)XS_ROWS * P8K2 <= 144 * MiB && (size_t)XS_ROWS * P8K1 <= 72 * MiB, "activation regions");
constexpr int CW_MTC = 8192;
constexpr int CW_BAR = 1024;
constexpr int LDS_BYTES = 147456;
constexpr int LDSCTL_OFF = 145408;
constexpr int RING_OFF = 0;
constexpr int LNX_OFF = 131072;

#define GAS __attribute__((address_space(1)))
typedef unsigned short bf16;
typedef unsigned v4u __attribute__((ext_vector_type(4)));
typedef unsigned v2u __attribute__((ext_vector_type(2)));
typedef float f32x4 __attribute__((ext_vector_type(4)));
typedef float f32x2 __attribute__((ext_vector_type(2)));
typedef _Float16 f16x4 __attribute__((ext_vector_type(4)));
__device__ __forceinline__ f32x4 ldh4(const _Float16* p) { return __builtin_convertvector(*(const f16x4*)p, f32x4); }
__device__ __forceinline__ void sth4(_Float16* p, f32x4 v) { __builtin_nontemporal_store(__builtin_convertvector(v, f16x4), (f16x4*)p); }
#define LDS_WAIT() asm volatile("s_waitcnt lgkmcnt(0)" ::: "memory")
#define VM_WAIT() asm volatile("s_waitcnt vmcnt(0)" ::: "memory")
__device__ __forceinline__ unsigned pk2(float lo, float hi) { unsigned r; asm volatile("v_cvt_pk_bf16_f32 %0, %1, %2" : "=v"(r) : "v"(lo), "v"(hi)); return r; }
__device__ __forceinline__ int opq_tid(int wave) { int t = tid_from_wave(wave); asm volatile("" : "+v"(t)); return t; }
__device__ __forceinline__ float dpp_sum(float v) {
    v += __builtin_bit_cast(float, __builtin_amdgcn_update_dpp(0, __builtin_bit_cast(int, v), 0xB1, 0xf, 0xf, true));
    v += __builtin_bit_cast(float, __builtin_amdgcn_update_dpp(0, __builtin_bit_cast(int, v), 0x4E, 0xf, 0xf, true));
    v += __builtin_bit_cast(float, __builtin_amdgcn_update_dpp(0, __builtin_bit_cast(int, v), 0x141, 0xf, 0xf, true));
    v += __builtin_bit_cast(float, __builtin_amdgcn_update_dpp(0, __builtin_bit_cast(int, v), 0x140, 0xf, 0xf, true));
    const int b = __builtin_bit_cast(int, v);
    const float s0 = __builtin_bit_cast(float, __builtin_amdgcn_readlane(b, 0)), s1 = __builtin_bit_cast(float, __builtin_amdgcn_readlane(b, 16));
    const float s2 = __builtin_bit_cast(float, __builtin_amdgcn_readlane(b, 32)), s3 = __builtin_bit_cast(float, __builtin_amdgcn_readlane(b, 48));
    return (s0 + s1) + (s2 + s3);
}
__device__ __forceinline__ float wave_sum(float v) {
#pragma unroll
    for (int o = 1; o < 64; o <<= 1) v += __shfl_xor(v, o);
    return v;
}

struct Args { const float* in[17]; float* out; unsigned char* ws; int s_lo, s_hi; };

__device__ __forceinline__ int map_row(int n, int mode) {
    if (mode == 0) return n;
    if (mode == 1) { const int c = n & 255, blk = c >> 6, d = c & 63; return (n & ~255) + ((d >> 5) << 7) + (blk << 5) + (d & 31); }
    return ((n >> 7) << 8) + (n & 127) + (mode == 3 ? 128 : 0);
}
__device__ __forceinline__ unsigned pk2h(float lo, float hi) { typedef _Float16 h2 __attribute__((ext_vector_type(2))); const f32x2 v = {lo, hi}; return __builtin_bit_cast(unsigned, __builtin_convertvector(v, h2)); }
__device__ __forceinline__ void cvt_load(f32x4 (&v)[16], const float* __restrict__ src, int pitch, int k0, int n0, int kind, int lane) {
    if (kind == 2) { const int kr = lane >> 3, n4 = (lane & 7) * 4; const float* p = src + (size_t)(k0 + kr) * pitch + n0 + n4;
#pragma unroll
        for (int i = 0; i < 16; ++i) v[i] = __builtin_nontemporal_load((const f32x4*)(p + (size_t)(8 * i) * pitch)); }
    else { const int kr = lane >> 4, n4 = (lane & 15) * 4; const float* p = src + (size_t)(k0 + kr) * pitch + n0 + n4;
#pragma unroll
        for (int i = 0; i < 16; ++i) v[i] = __builtin_nontemporal_load((const f32x4*)(p + (size_t)(4 * i) * pitch)); }
}
__device__ __forceinline__ void cvt_store(const f32x4 (&v)[16], unsigned char* __restrict__ dst, int dp, int mode, int k0, int n0, int kind, LAS float* scr, int lane) {
    if (kind == 2) {
        const int kr = lane >> 3, n4 = (lane & 7) * 4;
#pragma unroll
        for (int i = 0; i < 16; ++i) { LAS float* s = scr + (8 * i + kr) * 33 + n4; s[0] = v[i][0] * pg8::W8_SCALE; s[1] = v[i][1] * pg8::W8_SCALE; s[2] = v[i][2] * pg8::W8_SCALE; s[3] = v[i][3] * pg8::W8_SCALE; }
        LDS_WAIT();
        const int c = lane & 7;
#pragma unroll
        for (int j = 0; j < 4; ++j) { const int nl = (lane >> 3) + 8 * j; const int row = map_row(n0 + nl, mode);
            const LAS float* s = scr + (16 * c) * 33 + nl;
            v4u o; o.x = pg8::pack4_fp8(s[0], s[33], s[66], s[99]); o.y = pg8::pack4_fp8(s[132], s[165], s[198], s[231]);
            o.z = pg8::pack4_fp8(s[264], s[297], s[330], s[363]); o.w = pg8::pack4_fp8(s[396], s[429], s[462], s[495]);
            __builtin_nontemporal_store(o, (v4u*)(dst + (size_t)row * dp + k0 + 16 * c)); }
    } else {
        const int kr = lane >> 4, n4 = (lane & 15) * 4;
#pragma unroll
        for (int i = 0; i < 16; ++i) { LAS float* s = scr + (4 * i + kr) * 65 + n4; s[0] = v[i][0]; s[1] = v[i][1]; s[2] = v[i][2]; s[3] = v[i][3]; }
        LDS_WAIT();
        const int c = lane & 7;
#pragma unroll
        for (int j = 0; j < 8; ++j) { const int nl = (lane >> 3) + 8 * j; const int row = map_row(n0 + nl, mode);
            const LAS float* s = scr + (8 * c) * 65 + nl;
            v4u o; o.x = pk2h(s[0], s[65]); o.y = pk2h(s[130], s[195]); o.z = pk2h(s[260], s[325]); o.w = pk2h(s[390], s[455]);
            __builtin_nontemporal_store(o, (v4u*)(dst + (size_t)row * dp + (k0 + 8 * c) * 2)); }
    }
    LDS_WAIT();
}

__global__ void __launch_bounds__(NWAVES * 64, 2) yoco_fwd(Args args) {
    extern __shared__ __attribute__((aligned(16))) unsigned char lds_raw[];
    LAS unsigned char* const lds = (LAS unsigned char*)lds_raw;
    const int tid = threadIdx.x, lane = tid & 63, wave = __builtin_amdgcn_readfirstlane(tid >> 6);
    const int G = gridDim.x, bx = blockIdx.x;
    const int vcu = (G % 8 == 0) ? (bx % 8) * (G / 8) + bx / 8 : bx;
    unsigned char* const ws = args.ws;
    volatile LAS unsigned* const CTL = (volatile LAS unsigned*)(lds + LDSCTL_OFF);
    LAS int* const TAB = (LAS int*)(lds + LDSCTL_OFF + 64);
    for (int u = tid; u < (LDS_BYTES - LDSCTL_OFF) / 4; u += NWAVES * 64) ((LAS unsigned*)(lds + LDSCTL_OFF))[u] = 0u;
    __syncthreads();
    const int s_lo = args.s_lo, s_hi = args.s_hi;
    XcdBarrier bar; bar.bar = (unsigned*)(ws + WS_CTL) + CW_BAR; bar.x = 0; bar.st = nullptr;
    if (s_hi - s_lo > 1) bar = xcd_barrier_post((unsigned*)(ws + WS_CTL) + CW_BAR, CTL, tid == 0);
#ifndef PH_MASK
#define PH_MASK 0xFFFF
#endif
#define PHM(b) (((PH_MASK) >> (b)) & 1)
#ifndef PROBE_DUP
#define PROBE_DUP 0
#endif
#define PREP(b) _Pragma("unroll 1") for (int rep_ = 0; rep_ < ((((PROBE_DUP) >> (b)) & 1) ? 2 : 1); ++rep_) if ((rep_ == 1 && ((PROBE_DUP >> 12) & 1)) ? (xcd_barrier(bar, tid_from_wave(wave) == 0), true) : true)
#define IN(k) (s_lo <= (k) && (k) < s_hi)
#define SEAM(k) do { if ((k) + 1 < s_hi) xcd_barrier(bar, tid_from_wave(wave) == 0); } while (0)

    const float* const x_in = args.in[0];
    _Float16* const H = (_Float16*)(ws + WS_H); unsigned char* const HB8 = (unsigned char*)(ws + WS_OB + 32 * MiB);     bf16* const QKV = (bf16*)(ws + WS_QKV); bf16* const OB = (bf16*)(ws + WS_OB);
    bf16* const MIX = (bf16*)(ws + WS_YD);     bf16* const XS = (bf16*)(ws + WS_XS); float* const S1 = (float*)(ws + WS_XS); bf16* const ACT = (bf16*)(ws + WS_ACT); bf16* const YD = (bf16*)(ws + WS_YD);
    float* const WR = (float*)(ws + WS_WR);
    int* const CNT = (int*)(ws + WS_CNT); unsigned* const RE = (unsigned*)(ws + WS_RE); f32x2* const RW = (f32x2*)(ws + WS_RW); int* const RP = (int*)(ws + WS_RP);

    if (IN(0) && PHM(0)) { PREP(0) {
        const int tid = opq_tid(wave), lane = tid & 63;
        LAS float* scr = (LAS float*)(lds + RING_OFF + wave * 16896);
        const int gw = vcu * NWAVES + wave, NGW = G * NWAVES;
        constexpr int I0 = 2 * 3072, I1 = 8 * 1024, I2 = 128 * 512, I3 = 64 * 512, NITEMS = I0 + I1 + I2 + I3;
        static_assert(QKV8_A == 1 && QKV8_B == 0, "conversion table below: stick-breaking q|k|v and all other fp8 GEMM weights -> e4m3, differential q|k|v weights -> fp16");
#define CVT_DECODE(it_, SRC, PIT, DST, DP, MODE, K0, N0, KIND) do { int r = (it_); \
            if (r < I0) { const int job = r / 3072; r -= job * 3072; const int kb = r / 192, nb = r - kb * 192; \
                SRC = args.in[1] + (size_t)job * 2048 * 6144; PIT = 6144; DST = ws + WS_WQKVA + (size_t)job * 6144 * 2048; DP = 2048; MODE = 0; K0 = kb * 128; N0 = nb * 32; KIND = 2; break; } \
            r -= I0; \
            if (r < I1) { const int job = r >> 10; r &= 1023; const int r1_ = r; K0 = (r >> 6) * 128; N0 = (r & 63) * 32; PIT = 2048; MODE = 0; KIND = 2; DP = P8K2; \
                if (job < 2) { SRC = args.in[2] + (size_t)job * 2048 * 2048; DST = ws + WS_WOA + (size_t)job * 2048 * P8K2; } \
                else if (job >= 6) { SRC = args.in[5] + (size_t)(job - 6) * 2048 * 2048; DST = ws + WS_WOB + (size_t)(job - 6) * 2048 * P8K2; } \
                else { KIND = 1; DP = LDH * 2; K0 = (r1_ >> 5) * 64; N0 = (r1_ & 31) * 64; \
                    if (job == 2) { SRC = args.in[4]; DST = ws + WS_WQKVB; MODE = 1; } \
                    else if (job == 3) { SRC = args.in[3]; PIT = 4096; DST = ws + WS_WQKVB + (size_t)2048 * LDH * 2; MODE = 1; } \
                    else if (job == 4) { SRC = args.in[3] + 2048; PIT = 4096; DST = ws + WS_WQKVB + (size_t)4096 * LDH * 2; } \
                    else { SRC = args.in[4] + (size_t)2048 * 2048; DST = ws + WS_WQKVB + (size_t)6144 * LDH * 2; MODE = 1; } } \
                break; } \
            r -= I1; \
            if (r < I2) { const int job = r >> 9; r &= 511; const int le = job >> 1, up = job & 1;     \
                SRC = (up ? args.in[15] : args.in[14]) + (size_t)le * 2048 * 1024; PIT = 1024; DST = ws + WS_WGU + (size_t)le * 2048 * P8K2; DP = P8K2; MODE = 2 + up; K0 = (r >> 5) * 128; N0 = (r & 31) * 32; KIND = 2; break; } \
            r -= I2; \
            { const int le = r >> 9; r &= 511; SRC = args.in[16] + (size_t)le * 1024 * 2048; PIT = 2048; DST = ws + WS_WDN + (size_t)le * 2048 * P8K1; DP = P8K1; MODE = 0; K0 = (r >> 6) * 128; N0 = (r & 63) * 32; KIND = 2; } \
        } while (0)
        { const float* sA; const float* sB; unsigned char* dA; unsigned char* dB; int pA, pB, qA, qB, mA, mB, kA, kB, nA, nB, tA, tB; f32x4 va[16], vb[16];
          int it = gw;
          if (it < NITEMS) { CVT_DECODE(it, sA, pA, dA, qA, mA, kA, nA, tA); cvt_load(va, sA, pA, kA, nA, tA, lane);
            for (;;) {
                if (it + NGW < NITEMS) { CVT_DECODE(it + NGW, sB, pB, dB, qB, mB, kB, nB, tB); cvt_load(vb, sB, pB, kB, nB, tB, lane); }
                cvt_store(va, dA, qA, mA, kA, nA, tA, scr, lane); it += NGW; if (it >= NITEMS) break;
                if (it + NGW < NITEMS) { CVT_DECODE(it + NGW, sA, pA, dA, qA, mA, kA, nA, tA); cvt_load(va, sA, pA, kA, nA, tA, lane); }
                cvt_store(vb, dB, qB, mB, kB, nB, tB, scr, lane); it += NGW; if (it >= NITEMS) break;
            } } }
#undef CVT_DECODE
        for (size_t i = (size_t)gw * 64 + lane; i < (size_t)NTOK * DM / 4; i += (size_t)NGW * 64) {
            const f32x4 v = ((const f32x4*)x_in)[i];
            ((unsigned*)HB8)[i] = pg8::pack4_fp8(v[0], v[1], v[2], v[3]); }
        for (int i = bx * (NWAVES * 64) + tid; i < NLAYER * 20 * 2048; i += G * NWAVES * 64) { const int k = i & 2047, c = (i >> 11) % 20, l = i / (20 * 2048);
            WR[i] = c < 4 ? args.in[12][((size_t)l * 2048 + k) * 4 + c] : args.in[13][(((size_t)l * 4 + ((c - 4) >> 2)) * 2048 + k) * 4 + ((c - 4) & 3)]; }
        }
        SEAM(0);
    }

    for (int L = 0; L < NLAYER; ++L) {
        const int sb = 1 + 8 * L; const bool typeA = L < 2;
        if (IN(sb + 0)) {
            if (typeA && PHM(1)) { PREP(1) {
                pg8::StaticOrder S; S.init(NTOK, 6144, G, bx);
                if (QKV8_A) { pg8::Gemm g{(const bf16*)HB8, (const bf16*)(ws + WS_WQKVA + (size_t)L * 6144 * 2048), NTOK, 6144, DM / 2, DM / 2, wave}; pg8::EpiQkv E{QKV, 6144, 2048, SB_QSCALE, 1.f / pg8::W8_SCALE};
                    pg8::gemm_phase<pg8::EpiQkv, pg8::StaticOrder, true, true, true>(lds + RING_OFF, g, S, E); }
                } static_assert(QKV8_A == 1, "the stick-breaking layers' q|k|v GEMM takes the e4m3 copy of the stream");
            } else if (!typeA && PHM(2)) { PREP(2) {
                const int N = (L == 2) ? 6144 : 2048;
                pg8::StaticOrder S; S.init(NTOK, N, G, bx);
                if (QKV8_B) { pg8::Gemm g{(const bf16*)HB8, (const bf16*)(ws + WS_WQKVB + (L == 2 ? (size_t)0 : (size_t)6144 * 2048)), NTOK, N, DM / 2, DM / 2, wave};
                    pg8::EpiRope E{QKV, 6144, 2048, 4096, DF_QSCALE, 1.f / pg8::W8_SCALE};
                    pg8::gemm_phase<pg8::EpiRope, pg8::StaticOrder, true, true, true>(lds + RING_OFF, g, S, E); }
                else { pg8::Gemm g{(const bf16*)H, (const bf16*)(ws + WS_WQKVB) + (L == 2 ? (size_t)0 : (size_t)6144 * LDH), NTOK, N, DM, LDH, wave};
                    pg8::EpiRope E{QKV, 6144, 2048, 4096, DF_QSCALE, 1.f};
                    pg8::gemm_phase<pg8::EpiRope, pg8::StaticOrder, true, true, false, true>(lds + RING_OFF, g, S, E); } }
            }
            SEAM(sb + 0);
        }
        if (IN(sb + 1)) {
            if (typeA && PHM(3)) {
                for (int id_ = vcu; id_ < 512 * (1 + ((PROBE_DUP >> 3) & 1)); id_ += G) { if (((PROBE_DUP >> 12) & 1) && id_ >= 512 && id_ < 512 + G) xcd_barrier(bar, tid_from_wave(wave) == 0); const int id = id_ & 511; const int bh = id >> 2, p = id & 3, b = bh >> 4, h = bh & 15;
                    const bf16* Qg = QKV + (size_t)b * SEQ * 6144 + h * 128; bf16* Og = (bf16*)((unsigned char*)OB + (size_t)b * SEQ * P8K2 + h * 128);
                    att::sb_block(Qg, Qg + 2048, Qg + 4096, Og, 7 - p, (att::ldsp)(lds + RING_OFF), wave);
                    att::sb_block(Qg, Qg + 2048, Qg + 4096, Og, p, (att::ldsp)(lds + RING_OFF), wave); }
            } else if (!typeA && PHM(4)) {
                const int lane = opq_tid(wave) & 63;
                const int i = L - 2; const float lam_init = (L == 2) ? 0.47071301834264183f : 0.5560582041556061f;
                const float* lp = args.in[6] + (size_t)i * 256;
                const float sa = dpp_sum(lp[lane] * lp[64 + lane]), sb2 = dpp_sum(lp[128 + lane] * lp[192 + lane]);
                const float lam = __builtin_amdgcn_exp2f(sa * LOG2E) - __builtin_amdgcn_exp2f(sb2 * LOG2E) + lam_init;
                const float* gsub = args.in[7] + (size_t)i * 128; const float gmul = 1.f - lam_init;
                for (int id_ = vcu; id_ < 512 * (1 + ((PROBE_DUP >> 4) & 1)); id_ += G) { if (((PROBE_DUP >> 12) & 1) && id_ >= 512 && id_ < 512 + G) xcd_barrier(bar, tid_from_wave(wave) == 0); const int id = id_ & 511; const int bh = id >> 2, p = id & 3, b = bh >> 4, h = bh & 15;
                    const bf16* Qg = QKV + (size_t)b * SEQ * 6144 + h * 128; bf16* Og = (bf16*)((unsigned char*)OB + (size_t)b * SEQ * P8K2 + h * 128); float* Sg = S1 + (size_t)b * SEQ * DM + h * 128;
#pragma unroll 1
                    for (int w = 0; w < 2; ++w) { const int qb = w ? p : 7 - p;
#if DF_RING
                        att::diff_pass2<false>(Qg, Qg + 2048, Qg + 4096, Sg, Og, qb, lam, gsub, gmul, (att::ldsp)(lds + RING_OFF), wave);
                        att::diff_pass2<true>(Qg + 64, Qg + 2048 + 64, Qg + 4096, Sg, Og, qb, lam, gsub, gmul, (att::ldsp)(lds + RING_OFF), wave); } }
#else
                        att::diff_pass<false>(Qg, Qg + 2048, Qg + 4096, Sg, Og, qb, lam, gsub, gmul, (att::ldsp)(lds + RING_OFF), wave);
                        att::diff_pass<true>(Qg + 64, Qg + 2048 + 64, Qg + 4096, Sg, Og, qb, lam, gsub, gmul, (att::ldsp)(lds + RING_OFF), wave); } }
#endif
            }
            SEAM(sb + 1);
        }
        if (IN(sb + 2)) { if (PHM(5)) {
            pg8::Gemm g{OB, (const bf16*)(ws + (typeA ? WS_WOA : WS_WOB) + (size_t)(L & 1) * 2048 * P8K2), NTOK, DM, DM / 2, P8K2 / 2, wave}; pg8::StaticOrder S; S.init(NTOK, DM, G, bx);
            pg8::EpiQkv E{MIX, DM, 0, 1.f, 1.f / (pg8::W8_SCALE * att::OB8_SCALE)};
            pg8::gemm_phase<pg8::EpiQkv, pg8::StaticOrder, true, true, true>(lds + RING_OFF, g, S, E); }
            SEAM(sb + 2);
        }
        if (IN(sb + 3)) { if (PHM(6)) {
            const int tid = opq_tid(wave), lane = tid & 63;
            const float* lng = args.in[8] + (size_t)L * DM; const float* lnb = args.in[9] + (size_t)L * DM; const float* wr = WR + (size_t)L * 20 * 2048;
            LAS int* eid = (LAS int*)(lds + LNX_OFF + 2048);
            LAS float* lgt = (LAS float*)(lds + LNX_OFF + 4096);
            LAS unsigned* rows8 = (LAS unsigned*)(lds + RING_OFF);
            for (int c = bx; c < 256; c += G) {
#pragma unroll 1
                for (int grp = 0; grp < 4; ++grp) {
                    const int rloc = wave * 8 + grp * 2; const size_t row0 = (size_t)64 * c + rloc;
                    f32x4 v[2][8]; float mu[2], rstd[2];
#pragma unroll
                    for (int rr = 0; rr < 2; ++rr) {
                        if (L == 0) { const f32x4* hp = (const f32x4*)(x_in + (row0 + rr) * DM) + lane;
#pragma unroll
                            for (int j = 0; j < 8; ++j) v[rr][j] = hp[64 * j]; }
                        else { const _Float16* hq = H + (row0 + rr) * DM + 4 * lane;
#pragma unroll
                            for (int j = 0; j < 8; ++j) v[rr][j] = ldh4(hq + 256 * j); } }
#pragma unroll
                    for (int rr = 0; rr < 2; ++rr) { const v2u* mp = (const v2u*)(MIX + (row0 + rr) * DM) + lane;
#pragma unroll
                        for (int j = 0; j < 8; ++j) { const v2u a = mp[64 * j];
                            const f32x4 fa = {__uint_as_float(a.x << 16), __uint_as_float(a.x & 0xffff0000u), __uint_as_float(a.y << 16), __uint_as_float(a.y & 0xffff0000u)};
                            v[rr][j] = v[rr][j] * DN_ALPHA + fa; } }
#pragma unroll
                    for (int rr = 0; rr < 2; ++rr) { float s = 0.f;
#pragma unroll
                        for (int j = 0; j < 8; ++j) s += (v[rr][j][0] + v[rr][j][1]) + (v[rr][j][2] + v[rr][j][3]);
                        mu[rr] = dpp_sum(s) * (1.f / DM); float q = 0.f;
#pragma unroll
                        for (int j = 0; j < 8; ++j) { const f32x4 d = v[rr][j] - mu[rr]; q += (d[0] * d[0] + d[1] * d[1]) + (d[2] * d[2] + d[3] * d[3]); }
                        rstd[rr] = 1.f / sqrtf(dpp_sum(q) * (1.f / DM) + LN_EPS); }
#pragma unroll
                    for (int j = 0; j < 8; ++j) { const f32x4 gg = ((const f32x4*)lng)[64 * j + lane], bb = ((const f32x4*)lnb)[64 * j + lane];
#pragma unroll
                        for (int rr = 0; rr < 2; ++rr) { v[rr][j] = (v[rr][j] - mu[rr]) * rstd[rr] * gg + bb; sth4(H + (row0 + rr) * DM + 256 * j + 4 * lane, v[rr][j]);
                            if (c == bx) rows8[(rloc + rr) * 512 + 64 * j + lane] = pg8::pack4_fp8(v[rr][j][0], v[rr][j][1], v[rr][j][2], v[rr][j][3]); } }
                    f32x4 wn[8];
                    { const f32x4* wp = (const f32x4*)wr + lane;
#pragma unroll
                      for (int j = 0; j < 8; ++j) wn[j] = wp[64 * j]; }
#pragma unroll 1
                    for (int cc = 0; cc < 20; ++cc) { f32x4 w[8];
#pragma unroll
                        for (int j = 0; j < 8; ++j) w[j] = wn[j];
                        { const f32x4* wp = (const f32x4*)(wr + (cc < 19 ? cc + 1 : 19) * 2048) + lane;
#pragma unroll
                          for (int j = 0; j < 8; ++j) wn[j] = wp[64 * j]; }
                        float a[2] = {0.f, 0.f};
#pragma unroll
                        for (int j = 0; j < 8; ++j) {
#pragma unroll
                            for (int rr = 0; rr < 2; ++rr) a[rr] += (v[rr][j][0] * w[j][0] + v[rr][j][1] * w[j][1]) + (v[rr][j][2] * w[j][2] + v[rr][j][3] * w[j][3]); }
#pragma unroll
                        for (int rr = 0; rr < 2; ++rr) a[rr] = dpp_sum(a[rr]);
                        if (lane == 0) { lgt[rloc * 20 + cc] = a[0]; lgt[(rloc + 1) * 20 + cc] = a[1]; } }
                }
                LDS_WAIT();
                if (lane < 8) {
                    const int rl = wave * 8 + lane; const LAS float* lg = lgt + rl * 20;
                    int gsel = 0; float gm = lg[0];
#pragma unroll
                    for (int i = 1; i < 4; ++i) { const float x = lg[i]; if (x > gm) { gm = x; gsel = i; } }
                    float gden = 0.f;
#pragma unroll
                    for (int i = 0; i < 4; ++i) gden += __builtin_amdgcn_exp2f((lg[i] - gm) * LOG2E);
                    const float gw_ = 1.f / gden;
                    const LAS float* li = lg + 4 + 4 * gsel;
                    const float l0 = li[0], l1 = li[1], l2 = li[2], l3 = li[3];
                    int i0 = 0; float v0 = l0;
                    if (l1 > v0) { v0 = l1; i0 = 1; } if (l2 > v0) { v0 = l2; i0 = 2; } if (l3 > v0) { v0 = l3; i0 = 3; }
                    int i1 = -1; float v1 = 0.f;
                    if (i0 != 0) { v1 = l0; i1 = 0; }
                    if (i0 != 1 && (i1 < 0 || l1 > v1)) { v1 = l1; i1 = 1; }
                    if (i0 != 2 && (i1 < 0 || l2 > v1)) { v1 = l2; i1 = 2; }
                    if (i0 != 3 && (i1 < 0 || l3 > v1)) { v1 = l3; i1 = 3; }
                    const float t = __builtin_amdgcn_exp2f((v1 - v0) * LOG2E); const float w0 = gw_ / (1.f + t), w1 = gw_ * t / (1.f + t);
                    eid[2 * rl] = gsel * 4 + i0; eid[2 * rl + 1] = gsel * 4 + i1; RW[(size_t)64 * c + rl] = (f32x2){w0, w1};
                }
                __syncthreads();
                if (wave == 0) {
                    const int ea = eid[lane], eb = eid[64 + lane]; int ra = 0, rb = 0, cnt = 0; const unsigned long long lt = (1ull << lane) - 1ull;
#pragma unroll
                    for (int e = 0; e < 16; ++e) { const unsigned long long ma = __ballot(ea == e), mb = __ballot(eb == e);
                        if (ea == e) ra = __popcll(ma & lt); if (eb == e) rb = __popcll(ma) + __popcll(mb & lt); if (lane == e) cnt = __popcll(ma) + __popcll(mb); }
                    if (lane < 16) CNT[c * 16 + lane] = cnt;
                    LAS int* rk = (LAS int*)(lds + LNX_OFF + 3072); rk[lane] = ra; rk[64 + lane] = rb; LDS_WAIT();
                    const int r = lane; const unsigned word = (unsigned)eid[2 * r] | ((unsigned)eid[2 * r + 1] << 8) | ((unsigned)rk[2 * r] << 16) | ((unsigned)rk[2 * r + 1] << 24);
                    RE[(size_t)64 * c + r] = word;
                }
                __syncthreads();
            } }
            SEAM(sb + 3);
        }
        if ((IN(sb + 4) || IN(sb + 5) || IN(sb + 6)) && PHM(7)) {
            const int tid = opq_tid(wave);
            LAS int* part = (LAS int*)(lds + LNX_OFF);
            { const int e = tid & 15, s = tid >> 4; int a = 0;
#pragma unroll
              for (int i = 0; i < 8; ++i) a += CNT[(8 * s + i) * 16 + e];
              part[s * 16 + e] = a; }
            __syncthreads();
            if (tid < 16) { int run = 0;
#pragma clang loop vectorize(disable)
#pragma unroll 8
                for (int s = 0; s < 32; ++s) run += part[s * 16 + tid];
                TAB[tid] = run; }
            __syncthreads();
            if (tid < 192) { int off = 0, mt = 0, mine = 15;
#pragma unroll
                for (int e = 0; e < 16; ++e) { const int nt = (TAB[e] + 255) >> 8; if (tid == 0) TAB[16 + e] = off; if (tid >= mt && tid < mt + nt) mine = e; off += nt * 256; mt += nt; }
                if (tid < mt && tid < 160) TAB[64 + tid] = mine;
                if (tid == 0) { TAB[32] = off; TAB[33] = mt; } }
            __syncthreads();
        }
        if (IN(sb + 4)) { if (PHM(7)) PREP(7) {
            const int tid = opq_tid(wave), lane = tid & 63;
            LAS int* part = (LAS int*)(lds + LNX_OFF);
            for (int c = bx; c < 256; c += G) {
                if (tid < 16) { int pre = 0; int x[8];
#pragma unroll
                    for (int i = 0; i < 8; ++i) x[i] = CNT[((c & ~7) + i) * 16 + tid];
#pragma clang loop vectorize(disable) unroll(disable)
                    for (int s = 0; s < (c >> 3); ++s) pre += part[s * 16 + tid];
#pragma unroll
                    for (int i = 0; i < 8; ++i) pre += (i < (c & 7)) ? x[i] : 0;
                    TAB[48 + tid] = TAB[16 + tid] + pre; }
                __syncthreads();
#pragma unroll 1
                for (int rr = 0; rr < 8; ++rr) { const size_t row = (size_t)64 * c + wave * 8 + rr; const unsigned word = RE[row];
                    const int p0 = TAB[48 + (word & 255)] + ((word >> 16) & 255), p1 = TAB[48 + ((word >> 8) & 255)] + (word >> 24);
                    if (lane == 0) { RP[2 * row] = p0; RP[2 * row + 1] = p1; }
                    if (c == bx && IN(sb + 3)) {
                        const LAS v4u* src = (const LAS v4u*)(lds + RING_OFF + (wave * 8 + rr) * 2048) + lane; v4u* o0 = (v4u*)((unsigned char*)XS + (size_t)p0 * P8K2) + lane; v4u* o1 = (v4u*)((unsigned char*)XS + (size_t)p1 * P8K2) + lane;
                        const v4u a = src[0], b = src[64]; __builtin_nontemporal_store(a, o0); __builtin_nontemporal_store(b, o0 + 64); __builtin_nontemporal_store(a, o1); __builtin_nontemporal_store(b, o1 + 64);
                    } else {
                        const _Float16* hq = H + row * DM + 4 * lane; unsigned* o0 = (unsigned*)((unsigned char*)XS + (size_t)p0 * P8K2) + lane; unsigned* o1 = (unsigned*)((unsigned char*)XS + (size_t)p1 * P8K2) + lane;
#pragma unroll
                        for (int j = 0; j < 8; ++j) { const f32x4 v = ldh4(hq + 256 * j); const unsigned o = pg8::pack4_fp8(v[0], v[1], v[2], v[3]); o0[64 * j] = o; o1[64 * j] = o; } } }
                __syncthreads();
            } }
            SEAM(sb + 4);
        }
        if (IN(sb + 5)) { if (PHM(8)) PREP(8) {
            pg8::Gemm g{XS, (const bf16*)(ws + WS_WGU + (size_t)L * 16 * 2048 * P8K2), XS_ROWS, 2048, DM / 2, P8K2 / 2, wave};
            pg8::MoeOrder<0> S{TAB[33] * 8, G, bx, TAB + 64, nullptr, nullptr, wave}; pg8::EpiGateUp8 E{(unsigned char*)ACT};
            pg8::gemm_phase<pg8::EpiGateUp8, pg8::MoeOrder<0>, true, true, true>(lds + RING_OFF, g, S, E); }
            SEAM(sb + 5);
        }
        if (IN(sb + 6)) { if (PHM(9)) PREP(9) {
            pg8::Gemm g{ACT, (const bf16*)(ws + WS_WDN + (size_t)L * 16 * 2048 * P8K1), XS_ROWS, 2048, DEXP / 2, P8K1 / 2, wave};
            pg8::MoeOrder<0> S{TAB[33] * 8, G, bx, TAB + 64, nullptr, nullptr, wave}; pg8::EpiDown8 E{(unsigned char*)YD};
            pg8::gemm_phase<pg8::EpiDown8, pg8::MoeOrder<0>, true, true, true>(lds + RING_OFF, g, S, E); }
            SEAM(sb + 6);
        }
        if (IN(sb + 7)) { if (PHM(10)) for (int rep_ = 0; rep_ < ((((PROBE_DUP) >> 10) & 1) && L == NLAYER - 1 ? 5 : 1); ++rep_) {
            const int tid = opq_tid(wave), lane = tid & 63;
            const float* lng = args.in[10] + (size_t)L * DM; const float* lnb = args.in[11] + (size_t)L * DM; const bool last = (L == NLAYER - 1); const bool next8 = (L + 1 < 2) ? (QKV8_A != 0) : (QKV8_B != 0);
            const int gw = vcu * NWAVES + wave, NGW = G * NWAVES;
            for (int row0 = 4 * gw; row0 < NTOK; row0 += 4 * NGW) {
                f32x4 v[4][8]; float mu[4], rstd[4];
#pragma unroll
                for (int rr = 0; rr < 4; ++rr) { const int row = row0 + rr;
                    const int p0 = RP[2 * row], p1 = RP[2 * row + 1]; const f32x2 w = RW[row];
                    const _Float16* hq = H + (size_t)row * DM + 4 * lane; const unsigned* y0 = (const unsigned*)((const unsigned char*)YD + (size_t)p0 * DM) + lane; const unsigned* y1 = (const unsigned*)((const unsigned char*)YD + (size_t)p1 * DM) + lane;
                    const float w0s = w.x * (1.f / pg8::YD8_SCALE), w1s = w.y * (1.f / pg8::YD8_SCALE);
#pragma unroll
                    for (int j = 0; j < 8; ++j) { const f32x4 h = ldh4(hq + 256 * j); const unsigned a = y0[64 * j], b = y1[64 * j];
                        const f32x2 a0 = __builtin_amdgcn_cvt_pk_f32_fp8((int)a, false), a1 = __builtin_amdgcn_cvt_pk_f32_fp8((int)a, true), b0 = __builtin_amdgcn_cvt_pk_f32_fp8((int)b, false), b1 = __builtin_amdgcn_cvt_pk_f32_fp8((int)b, true);
                        const f32x4 fa = {a0[0], a0[1], a1[0], a1[1]}, fb = {b0[0], b0[1], b1[0], b1[1]};
                        v[rr][j] = h * DN_ALPHA + fa * w0s + fb * w1s; } }
#pragma unroll
                for (int rr = 0; rr < 4; ++rr) { float s = 0.f;
#pragma unroll
                    for (int j = 0; j < 8; ++j) s += (v[rr][j][0] + v[rr][j][1]) + (v[rr][j][2] + v[rr][j][3]);
                    mu[rr] = dpp_sum(s) * (1.f / DM); float q = 0.f;
#pragma unroll
                    for (int j = 0; j < 8; ++j) { const f32x4 dd = v[rr][j] - mu[rr]; q += (dd[0] * dd[0] + dd[1] * dd[1]) + (dd[2] * dd[2] + dd[3] * dd[3]); }
                    rstd[rr] = 1.f / sqrtf(dpp_sum(q) * (1.f / DM) + LN_EPS); }
#pragma unroll
                for (int j = 0; j < 8; ++j) { const f32x4 gg = ((const f32x4*)lng)[64 * j + lane], bb = ((const f32x4*)lnb)[64 * j + lane];
#pragma unroll
                    for (int rr = 0; rr < 4; ++rr) { const int row = row0 + rr; const f32x4 y = (v[rr][j] - mu[rr]) * rstd[rr] * gg + bb;
                        if (last) __builtin_nontemporal_store(y, (f32x4*)(args.out + (size_t)row * DM) + 64 * j + lane);
                        else { sth4(H + (size_t)row * DM + 256 * j + 4 * lane, y); if (next8) __builtin_nontemporal_store(pg8::pack4_fp8(y[0], y[1], y[2], y[3]), (unsigned*)(HB8 + (size_t)row * DM) + 64 * j + lane); } } }
            } }
            SEAM(sb + 7);
        }
    }
#undef IN
#undef SEAM
}

extern "C" void kernel_launch(void* const* d_in, const int* in_sizes, int n_in, void* d_out, int out_size, void* d_ws, size_t ws_size, hipStream_t stream) {
    static int grid = 0;
    if (grid == 0) {
        if (n_in != 17 || in_sizes[0] != NTOK * DM || out_size != NTOK * DM || ws_size < WS_END) { fprintf(stderr, "kernel_launch: unexpected shapes / workspace (n_in %d, ws %zu, need %zu)\n", n_in, ws_size, (size_t)WS_END); grid = -1; return; }
        int dev = 0, cus = 0, per_cu = 0;
        if (hipGetDevice(&dev) != hipSuccess || hipDeviceGetAttribute(&cus, hipDeviceAttributeMultiprocessorCount, dev) != hipSuccess) { grid = -1; return; }
        if (hipFuncSetAttribute((const void*)yoco_fwd, hipFuncAttributeMaxDynamicSharedMemorySize, LDS_BYTES) != hipSuccess) { fprintf(stderr, "kernel_launch: hipFuncSetAttribute failed\n"); grid = -1; return; }
        if (hipOccupancyMaxActiveBlocksPerMultiprocessor(&per_cu, (const void*)yoco_fwd, NWAVES * 64, LDS_BYTES) != hipSuccess || per_cu < 1) { fprintf(stderr, "kernel_launch: occupancy query says %d\n", per_cu); per_cu = 1; }
        (void)hipGetLastError();
        grid = cus;
    }
    if (grid < 0) return;
    (void)hipMemsetAsync((char*)d_ws + WS_CTL, 0, CTL_ZERO_BYTES, stream);
    Args a{};
    for (int i = 0; i < 17; ++i) a.in[i] = (const float*)d_in[i];
    a.out = (float*)d_out; a.ws = (unsigned char*)d_ws;
#if MK_MULTI
    for (int s = 0; s < NSTEPS; ++s) { a.s_lo = s; a.s_hi = s + 1; hipLaunchKernelGGL(yoco_fwd, dim3(grid), dim3(NWAVES * 64), LDS_BYTES, stream, a); }
#else
    a.s_lo = 0; a.s_hi = NSTEPS;
    hipLaunchKernelGGL(yoco_fwd, dim3(grid), dim3(NWAVES * 64), LDS_BYTES, stream, a);
#endif
    const hipError_t le = hipPeekAtLastError();
    if (le != hipSuccess) fprintf(stderr, "kernel_launch: launch failed: %s\n", hipGetErrorName(le));
}
```

```cpp
#include <hip/hip_runtime.h>
#include <cstdio>
#include <cstdint>

__device__ __forceinline__ int tid_from_wave(int wave) { int l; asm volatile("v_mbcnt_lo_u32_b32 %0, -1, 0\n\tv_mbcnt_hi_u32_b32 %0, -1, %0" : "=v"(l)); return wave * 64 + l; }
namespace pg8 {
#define PG8_LAS __attribute__((address_space(3)))
typedef unsigned short bf16_t;
typedef short bf16x8 __attribute__((ext_vector_type(8)));
typedef float f32x4 __attribute__((ext_vector_type(4)));
typedef unsigned u32x4 __attribute__((ext_vector_type(4)));
typedef int pg8_v8i __attribute__((ext_vector_type(8)));
typedef _Float16 pg8_h8 __attribute__((ext_vector_type(8)));
constexpr int BM = 256, BK = 64, HALF = 128, HTB = HALF * BK * 2  , STAGE_BYTES = 8 * HTB, NXCD = 8, WGM = 8;

__host__ __device__ __forceinline__ int lds_byte(int r, int c) { const int st = (r >> 4) * 2 + (c >> 5), rr = r & 15, cc = c & 31, ob = rr * 64 + cc * 2; return st * 1024 + (ob ^ (((ob >> 9) & 1) << 5)); }
__host__ __device__ __forceinline__ void stage_rc(int b, int& R, int& C) { const int st = b / 1024, sb = b % 1024, swz = sb ^ (((sb >> 9) & 1) << 5); R = (st >> 1) * 16 + swz / 64; C = (st & 1) * 32 + (swz % 64) / 2; }
__host__ __device__ __forceinline__ int perm32(int rho) { const int n = rho >> 4, i = rho & 15; return 8 * (i >> 2) + 4 * n + (i & 3); }

struct Unit { int pm, pn; };
struct Gemm { const bf16_t* A; const bf16_t* Bt; int M, N, K, ld, wave; };

struct StaticOrder {
    int nM, nN, nwg, G, c;
    __host__ __device__ void init(int M, int N, int G_, int c_) { nM = M / BM; nN = N / BM; nwg = nM * nN; G = G_; c = c_; }
    __host__ __device__ bool next(int i, Unit& u) const {
        const long L = (long)i * G + c; if (L >= nwg) return false;
        int wgid = (int)L; { const int q = nwg / NXCD, r = nwg % NXCD, xcd = wgid % NXCD, off = wgid / NXCD; wgid = (xcd < r ? xcd * (q + 1) : r * (q + 1) + (xcd - r) * q) + off; }
        const int nig = WGM * nN, gid = wgid / nig, fm = gid * WGM, gsz = (nM - fm) < WGM ? (nM - fm) : WGM;
        u.pm = fm + ((wgid % nig) % gsz); u.pn = (wgid % nig) / gsz; return true;
    }
    __device__ __forceinline__ void a_ready(const Unit&) const {}
    __device__ __forceinline__ void done(const Unit&) const {}
};

__device__ __forceinline__ unsigned cvt_pk_bf16(float lo, float hi) { unsigned r; asm volatile("v_cvt_pk_bf16_f32 %0, %1, %2" : "=v"(r) : "v"(lo), "v"(hi)); return r; }
typedef float f32x2 __attribute__((ext_vector_type(2)));

typedef unsigned u32x2 __attribute__((ext_vector_type(2)));
__device__ __forceinline__ u32x4 pack8_bf16(const f32x4 a, const f32x4 b) { u32x4 w; w.x = cvt_pk_bf16(a[0], a[1]); w.y = cvt_pk_bf16(a[2], a[3]); w.z = cvt_pk_bf16(b[0], b[1]); w.w = cvt_pk_bf16(b[2], b[3]); return w; }

struct EpiQkv {
    static constexpr bool PERM = true, AFTER_DRAIN = false;
    bf16_t* O; int ldc; int qcols; float qscale; float osc;
    __device__ __forceinline__ void operator()(const f32x4 (&acc)[2][2][4][2], const Unit& u, int wr, int wc, int fr, int fq) const {
        const int row0 = u.pm * BM + wr * 64 + fr, colt = u.pn * BM; const float sc = (colt < qcols ? qscale : 1.f) * osc;
        const int col0 = colt + wc * 32 + 8 * fq;
#pragma unroll
        for (int ai = 0; ai < 2; ++ai)
#pragma unroll
            for (int m = 0; m < 4; ++m) { bf16_t* rowp = O + (size_t)(row0 + ai * HALF + m * 16) * ldc + col0;
#pragma unroll
                for (int bj = 0; bj < 2; ++bj) *(u32x4*)(rowp + bj * HALF) = pack8_bf16(acc[ai][bj][m][0] * sc, acc[ai][bj][m][1] * sc); }
    }
};
template <int ACCS_INV> struct EpiResid {
    static constexpr bool PERM = false, AFTER_DRAIN = false;
    static constexpr int ldc = 2048; static constexpr float alpha = 1.6817928305074292f, accs = 1.f / (float)ACCS_INV;
    float* H; const float* Hsrc;
    __device__ __forceinline__ void operator()(const f32x4 (&acc)[2][2][4][2], const Unit& u, int wr, int wc, int fr, int fq) const {
        const int row0 = u.pm * BM + wr * 64 + fr, col0 = u.pn * BM + wc * 32 + 4 * fq;
#pragma unroll
        for (int ai = 0; ai < 2; ++ai)
#pragma unroll
            for (int m = 0; m < 4; ++m) { const size_t ro = (size_t)(row0 + ai * HALF + m * 16) * ldc + col0; float* rowp = H + ro; const float* srcp = Hsrc + ro;
#pragma unroll
                for (int bj = 0; bj < 2; ++bj)
#pragma unroll
                    for (int n = 0; n < 2; ++n) { const f32x4 h = *(const f32x4*)(srcp + bj * HALF + n * 16); *(f32x4*)(rowp + bj * HALF + n * 16) = h * alpha + acc[ai][bj][m][n] * accs; } }
    }
};
struct EpiRope {
    static constexpr bool PERM = true, AFTER_DRAIN = false;
    bf16_t* O; int ldc; int qcols, ropecols; float qscale; float osc;
    __device__ __forceinline__ void operator()(const f32x4 (&acc)[2][2][4][2], const Unit& u, int wr, int wc, int fr, int fq) const {
        const int row0 = u.pm * BM + wr * 64 + fr, colt = u.pn * BM;
        if (colt >= ropecols) {
            const int col0 = colt + wc * 32 + 8 * fq;
#pragma unroll
            for (int ai = 0; ai < 2; ++ai)
#pragma unroll
                for (int m = 0; m < 4; ++m) { bf16_t* rowp = O + (size_t)(row0 + ai * HALF + m * 16) * ldc + col0;
#pragma unroll
                    for (int bj = 0; bj < 2; ++bj) *(u32x4*)(rowp + bj * HALF) = pack8_bf16(acc[ai][bj][m][0] * osc, acc[ai][bj][m][1] * osc); }
        } else {
            const float sc = (colt < qcols ? qscale : 1.f) * osc;
            const int col0 = colt + wc * 64 + 8 * fq;
            float ir[8];
#pragma unroll
            for (int i = 0; i < 8; ++i) ir[i] = __builtin_amdgcn_exp2f(-(float)(8 * fq + i) * 0.4152410118609203f) * 0.15915494309189535f;
#pragma unroll
            for (int ai = 0; ai < 2; ++ai)
#pragma unroll
                for (int m = 0; m < 4; ++m) { const int row = row0 + ai * HALF + m * 16; const float pos = (float)(row & 2047);
                    f32x4 c0, c1, s0, s1;
#pragma unroll
                    for (int i = 0; i < 4; ++i) { const float f0 = __builtin_amdgcn_fractf(pos * ir[i]), f1 = __builtin_amdgcn_fractf(pos * ir[4 + i]);
                        c0[i] = __builtin_amdgcn_cosf(f0); s0[i] = __builtin_amdgcn_sinf(f0); c1[i] = __builtin_amdgcn_cosf(f1); s1[i] = __builtin_amdgcn_sinf(f1); }
                    const f32x4 a0 = acc[ai][0][m][0], a1 = acc[ai][0][m][1], b0 = acc[ai][1][m][0], b1 = acc[ai][1][m][1];
                    bf16_t* rowp = O + (size_t)row * ldc + col0;
                    *(u32x4*)(rowp) = pack8_bf16((a0 * c0 - b0 * s0) * sc, (a1 * c1 - b1 * s1) * sc);
                    *(u32x4*)(rowp + 32) = pack8_bf16((b0 * c0 + a0 * s0) * sc, (b1 * c1 + a1 * s1) * sc); }
        }
    }
};
struct EpiGateUp {
    static constexpr bool PERM = true, AFTER_DRAIN = false;
    bf16_t* O;
    __device__ __forceinline__ void operator()(const f32x4 (&acc)[2][2][4][2], const Unit& u, int wr, int wc, int fr, int fq) const {
        const int row0 = u.pm * BM + wr * 64 + fr, col0 = (u.pn & 7) * 128 + wc * 32 + 8 * fq;
#pragma unroll
        for (int ai = 0; ai < 2; ++ai)
#pragma unroll
            for (int m = 0; m < 4; ++m) { f32x4 r[2];
#pragma unroll
                for (int n = 0; n < 2; ++n) { const f32x4 g = acc[ai][0][m][n], up = acc[ai][1][m][n];
#pragma unroll
                    for (int i = 0; i < 4; ++i) { const float e = __builtin_amdgcn_exp2f(g[i] * -1.4426950408889634f); r[n][i] = g[i] * __builtin_amdgcn_rcpf(1.f + e) * up[i]; } }
                *(u32x4*)(O + (size_t)(row0 + ai * HALF + m * 16) * 1024 + col0) = pack8_bf16(r[0], r[1]); }
    }
};
struct EpiDown {
    static constexpr bool PERM = true, AFTER_DRAIN = false;
    bf16_t* O;
    __device__ __forceinline__ void operator()(const f32x4 (&acc)[2][2][4][2], const Unit& u, int wr, int wc, int fr, int fq) const {
        const int row0 = u.pm * BM + wr * 64 + fr, col0 = (u.pn & 7) * BM + wc * 32 + 8 * fq;
#pragma unroll
        for (int ai = 0; ai < 2; ++ai)
#pragma unroll
            for (int m = 0; m < 4; ++m) { bf16_t* rowp = O + (size_t)(row0 + ai * HALF + m * 16) * 2048 + col0;
#pragma unroll
                for (int bj = 0; bj < 2; ++bj) *(u32x4*)(rowp + bj * HALF) = pack8_bf16(acc[ai][bj][m][0], acc[ai][bj][m][1]); }
    }
};
#ifndef PROBE_MFMA2
#define PROBE_MFMA2 0
#endif
constexpr float W8_SCALE = 64.f, ACT8_SCALE = 4.f, W8_UNDO = W8_SCALE * (PROBE_MFMA2 ? 2.f : 1.f);
__device__ __forceinline__ unsigned pack4_fp8(float a, float b, float c, float d) { int w; asm volatile("" : "=v"(w));
    w = __builtin_amdgcn_cvt_pk_fp8_f32(a, b, w, false); w = __builtin_amdgcn_cvt_pk_fp8_f32(c, d, w, true); return (unsigned)w; }
struct EpiGateUp8 {
    static constexpr bool PERM = true, AFTER_DRAIN = false;
    unsigned char* O;
    __device__ __forceinline__ void operator()(const f32x4 (&acc)[2][2][4][2], const Unit& u, int wr, int wc, int fr, int fq) const {
        const int row0 = u.pm * BM + wr * 64 + fr, col0 = (u.pn & 7) * 128 + wc * 32 + 8 * fq;
        constexpr float SI = 1.f / W8_UNDO;
#pragma unroll
        for (int ai = 0; ai < 2; ++ai)
#pragma unroll
            for (int m = 0; m < 4; ++m) { f32x4 r[2];
#pragma unroll
                for (int n = 0; n < 2; ++n) { const f32x4 g = acc[ai][0][m][n] * SI, up = acc[ai][1][m][n] * (SI * ACT8_SCALE);
#pragma unroll
                    for (int i = 0; i < 4; ++i) { const float e = __builtin_amdgcn_exp2f(g[i] * -1.4426950408889634f); r[n][i] = g[i] * __builtin_amdgcn_rcpf(1.f + e) * up[i]; } }
                u32x2 w; w.x = pack4_fp8(r[0][0], r[0][1], r[0][2], r[0][3]); w.y = pack4_fp8(r[1][0], r[1][1], r[1][2], r[1][3]);
                *(u32x2*)(O + (size_t)(row0 + ai * HALF + m * 16) * 1024 + col0) = w; }
    }
};
constexpr float YD8_SCALE = 16.f;
struct EpiDown8 {
    static constexpr bool PERM = true, AFTER_DRAIN = false;
    unsigned char* O;
    __device__ __forceinline__ void operator()(const f32x4 (&acc)[2][2][4][2], const Unit& u, int wr, int wc, int fr, int fq) const {
        const int row0 = u.pm * BM + wr * 64 + fr, col0 = (u.pn & 7) * BM + wc * 32 + 8 * fq;
        constexpr float SI = YD8_SCALE / (W8_UNDO * ACT8_SCALE);
#pragma unroll
        for (int ai = 0; ai < 2; ++ai)
#pragma unroll
            for (int m = 0; m < 4; ++m) { unsigned char* rowp = O + (size_t)(row0 + ai * HALF + m * 16) * 2048 + col0;
#pragma unroll
                for (int bj = 0; bj < 2; ++bj) { const f32x4 a = acc[ai][bj][m][0] * SI, c = acc[ai][bj][m][1] * SI; u32x2 w; w.x = pack4_fp8(a[0], a[1], a[2], a[3]); w.y = pack4_fp8(c[0], c[1], c[2], c[3]);
                    *(u32x2*)(rowp + bj * HALF) = w; } }
    }
};
template <int ROLE> struct MoeOrder {
    int nunits, G, c; const PG8_LAS int* tile_e; unsigned* cnt; unsigned* tmo; int wave;
    __device__ __forceinline__ bool next(int i, Unit& u) const {
        const int cc = (ROLE == 2) ? G - 1 - c : c; int idx;
        if ((G & 7) == 0) { const int per = G >> 3; idx = (i * 8 + (cc & 7)) * per + (cc >> 3); } else idx = i * G + cc;
        if (idx >= nunits) return false;
        const int mt = idx >> 3; u.pm = mt; u.pn = tile_e[mt] * 8 + (idx & 7); return true;
    }
    __device__ __forceinline__ void a_ready(const Unit& u) const {
        if constexpr (ROLE == 2) {
            if (wave == 0) { const bool lane0 = (tid_from_wave(0) == 0);
                const unsigned long long t0 = __builtin_amdgcn_s_memrealtime(); unsigned polls = 0;
                while ((unsigned)__builtin_amdgcn_readfirstlane(__hip_atomic_load(cnt + 64 * u.pm, __ATOMIC_RELAXED, __HIP_MEMORY_SCOPE_AGENT)) < 64u) {
                    if ((++polls & 255u) == 0u && __builtin_amdgcn_readfirstlane(__hip_atomic_load(tmo, __ATOMIC_RELAXED, __HIP_MEMORY_SCOPE_AGENT)) != 0u) break;
                    if (__builtin_amdgcn_s_memrealtime() - t0 > 2000000ull) { if (lane0) __hip_atomic_store(tmo, 1u, __ATOMIC_RELAXED, __HIP_MEMORY_SCOPE_AGENT); break; }
                    __builtin_amdgcn_s_sleep(2); }
                __builtin_amdgcn_fence(__ATOMIC_ACQUIRE, "agent");
                asm volatile("s_waitcnt vmcnt(0)" ::: "memory");
            }
            asm volatile("" ::: "memory"); __builtin_amdgcn_s_barrier(); asm volatile("" ::: "memory");
        }
    }
    __device__ __forceinline__ void done(const Unit& u) const {
        if constexpr (ROLE == 1) {
            asm volatile("s_waitcnt vmcnt(0)" ::: "memory");
            if (tid_from_wave(0) == 0) __hip_atomic_fetch_add(cnt + 64 * u.pm, 1u, __ATOMIC_RELAXED, __HIP_MEMORY_SCOPE_AGENT);
        }
    }
};

#ifndef PROBE_MFMA2
#define PROBE_MFMA2 0
#endif
template <class Epi, class Sched, bool ALIGN_EPI = false, bool SP2 = false, bool F8 = false, bool F16 = false>
__device__ __forceinline__ void gemm_phase(PG8_LAS unsigned char* lds, const Gemm g, const Sched& S, const Epi& E) {
    int tid_ = tid_from_wave(g.wave); asm volatile("" : "+v"(tid_));
    const int tid = tid_, wid = __builtin_amdgcn_readfirstlane(tid >> 6), lane = tid & 63, wr = wid >> 2, wc = wid & 3, fr = lane & 15, fq = lane >> 4;
    const int K = g.K, LD = g.ld, nt = K / BK;
    unsigned voffA, voffB;
    { int R, C; stage_rc(tid * 16, R, C); const int Rb = Epi::PERM ? ((R & ~31) + perm32(R & 31)) : R;
        voffA = (unsigned)(R * LD + C) * 2u; voffB = (unsigned)(Rb * LD + C) * 2u; }
    const size_t pstep = (size_t)64 * LD * 2;
    const size_t kstep = (size_t)(BK * 2);
    const size_t hstep = (size_t)HALF * LD * 2;
    const size_t tstep = 2 * hstep;
    const unsigned ldsbase = (unsigned)(uintptr_t)lds;
    const unsigned ldsw = (unsigned)wid * 1024u;
    const int aoff = lds_byte(wr * 64 + fr, fq * 8), boff = lds_byte(wc * 32 + fr, fq * 8);
#define PG8_SA(b, h) (((b) * 2 + (h)) * HTB)
#define PG8_SB(b, h) ((4 + (b) * 2 + (h)) * HTB)
#define PG8_STAGE(bufoff, gbase, voff) do { _Pragma("unroll") for (int _i = 0; _i < 2; ++_i) { unsigned keep_; \
        asm volatile("s_mov_b32 %0, m0\n\ts_mov_b32 m0, %3\n\ts_nop 0\n\tglobal_load_lds_dwordx4 %1, %2\n\ts_mov_b32 m0, %0" : "=&s"(keep_) \
            : "v"(voff), "s"((const char*)(gbase) + _i * pstep), "s"(ldsbase + (unsigned)(bufoff) + ldsw + (unsigned)(_i * 8192))); } } while (0)
#define PG8_CAT(a, b) __builtin_bit_cast(pg8_v8i, __builtin_shufflevector(a, b, 0, 1, 2, 3, 4, 5, 6, 7, 8, 9, 10, 11, 12, 13, 14, 15))
#define PG8_LDA(dst, b, h) do { if constexpr (F8) { _Pragma("unroll") for (int m = 0; m < 4; ++m) { const bf16x8 lo_ = *(const PG8_LAS bf16x8*)(lds + PG8_SA(b, h) + aoff + m * 2048), hi_ = *(const PG8_LAS bf16x8*)(lds + PG8_SA(b, h) + aoff + m * 2048 + 1024); dst##8[m] = PG8_CAT(lo_, hi_); } } \
        else { _Pragma("unroll") for (int m = 0; m < 4; ++m) _Pragma("unroll") for (int k = 0; k < 2; ++k) dst[m][k] = *(const PG8_LAS bf16x8*)(lds + PG8_SA(b, h) + aoff + m * 2048 + k * 1024); } } while (0)
#define PG8_LDB(dst, b, h) do { if constexpr (F8) { _Pragma("unroll") for (int n = 0; n < 2; ++n) { const bf16x8 lo_ = *(const PG8_LAS bf16x8*)(lds + PG8_SB(b, h) + boff + n * 2048), hi_ = *(const PG8_LAS bf16x8*)(lds + PG8_SB(b, h) + boff + n * 2048 + 1024); dst##8[n] = PG8_CAT(lo_, hi_); } } \
        else { _Pragma("unroll") for (int n = 0; n < 2; ++n) _Pragma("unroll") for (int k = 0; k < 2; ++k) dst[n][k] = *(const PG8_LAS bf16x8*)(lds + PG8_SB(b, h) + boff + n * 2048 + k * 1024); } } while (0)
#define PG8_MMA(ai, bj, At, Bt) do { __builtin_amdgcn_s_setprio(1); \
        if constexpr (F8) { _Pragma("unroll") for (int m = 0; m < 4; ++m) _Pragma("unroll") for (int n = 0; n < 2; ++n) \
            { acc[ai][bj][m][n] = __builtin_amdgcn_mfma_scale_f32_16x16x128_f8f6f4(Bt##8[n], At##8[m], acc[ai][bj][m][n], 0, 0, 0, 0, 0, 0); \
              if (PROBE_MFMA2) acc[ai][bj][m][n] = __builtin_amdgcn_mfma_scale_f32_16x16x128_f8f6f4(Bt##8[n], At##8[m], acc[ai][bj][m][n], 0, 0, 0, 0, 0, 0); } } \
        else { _Pragma("unroll") for (int m = 0; m < 4; ++m) _Pragma("unroll") for (int n = 0; n < 2; ++n) _Pragma("unroll") for (int k = 0; k < 2; ++k) \
            acc[ai][bj][m][n] = F16 ? __builtin_amdgcn_mfma_f32_16x16x32_f16(__builtin_bit_cast(pg8_h8, Bt[n][k]), __builtin_bit_cast(pg8_h8, At[m][k]), acc[ai][bj][m][n], 0, 0, 0) \
                                    : __builtin_amdgcn_mfma_f32_16x16x32_bf16(Bt[n][k], At[m][k], acc[ai][bj][m][n], 0, 0, 0); } \
        __builtin_amdgcn_s_setprio(0); } while (0)
#define PG8_WAIT_V(n) asm volatile("s_waitcnt vmcnt(" #n ")" ::: "memory")
#define PG8_WAIT_L(n) asm volatile("s_waitcnt lgkmcnt(" #n ")" ::: "memory")
#define PG8_BAR __builtin_amdgcn_s_barrier()
#define PG8_SCHED __builtin_amdgcn_sched_barrier(0)
    Unit cur, nxt; int ui = 0;
    if (!S.next(0, cur)) return;
    f32x4 acc[2][2][4][2];
{ float zero_; asm volatile("v_mov_b32 %0, 0" : "=v"(zero_));
#pragma unroll
    for (int a = 0; a < 2; ++a)
#pragma unroll
        for (int b = 0; b < 2; ++b)
#pragma unroll
            for (int m = 0; m < 4; ++m)
#pragma unroll
                for (int n = 0; n < 2; ++n) acc[a][b][m][n] = (f32x4){zero_, zero_, zero_, zero_}; }
    bf16x8 At[4][2], B0[2][2], B1[2][2]; pg8_v8i At8[4], B08[2], B18[2];
    const char* cA = (const char*)g.A + (size_t)cur.pm * tstep; const char* cB = (const char*)g.Bt + (size_t)cur.pn * tstep;
    S.a_ready(cur);
    if constexpr (SP2) {
        PG8_STAGE(PG8_SB(0, 0), cB, voffB); PG8_STAGE(PG8_SB(0, 1), cB + hstep, voffB); PG8_STAGE(PG8_SA(0, 0), cA, voffA); PG8_STAGE(PG8_SA(0, 1), cA + hstep, voffA);
        if (wr == 1) PG8_BAR;
        PG8_WAIT_V(2); PG8_BAR;
        PG8_STAGE(PG8_SB(1, 0), cB + kstep, voffB); PG8_STAGE(PG8_SA(1, 0), cA + kstep, voffA); PG8_STAGE(PG8_SB(1, 1), cB + hstep + kstep, voffB);
        PG8_WAIT_V(6); PG8_BAR;
    } else {
        PG8_STAGE(PG8_SB(0, 0), cB, voffB); PG8_STAGE(PG8_SA(0, 0), cA, voffA); PG8_STAGE(PG8_SB(0, 1), cB + hstep, voffB); PG8_STAGE(PG8_SA(0, 1), cA + hstep, voffA);
        if (wr == 1) PG8_BAR;
        PG8_WAIT_V(4); PG8_BAR;
        PG8_STAGE(PG8_SB(1, 0), cB + kstep, voffB); PG8_STAGE(PG8_SA(1, 0), cA + kstep, voffA); PG8_STAGE(PG8_SB(1, 1), cB + hstep + kstep, voffB);
        PG8_WAIT_V(6); PG8_BAR;
    }
    for (;;) {
        const bool has_next = S.next(ui + 1, nxt);
        const char* nA = has_next ? (const char*)g.A + (size_t)nxt.pm * tstep : cA; const char* nB = has_next ? (const char*)g.Bt + (size_t)nxt.pn * tstep : cB;
#pragma unroll 1
        for (int t = 0; t < nt; t += 2) {
            const bool last = (t == nt - 2);
            const char* a1 = cA + (size_t)(t + 1) * kstep;
            const char* a2 = last ? nA : cA + (size_t)(t + 2) * kstep; const char* b2 = last ? nB : cB + (size_t)(t + 2) * kstep;
            const char* a3 = a2 + kstep; const char* b3 = b2 + kstep;
            if (last && has_next) S.a_ready(nxt);
            if constexpr (SP2) {
            PG8_LDB(B0, 0, 0); PG8_LDB(B1, 0, 1); PG8_SCHED; PG8_LDA(At, 0, 0); PG8_STAGE(PG8_SA(1, 1), a1 + hstep, voffA);
            PG8_WAIT_V(8); PG8_WAIT_L(0); PG8_BAR; PG8_MMA(0, 0, At, B0); PG8_MMA(0, 1, At, B1); PG8_BAR; PG8_SCHED;
            PG8_LDA(At, 0, 1); PG8_STAGE(PG8_SB(0, 0), b2, voffB); PG8_STAGE(PG8_SB(0, 1), b2 + hstep, voffB); PG8_STAGE(PG8_SA(0, 0), a2, voffA);
            PG8_WAIT_V(8); PG8_WAIT_L(0); PG8_BAR; PG8_MMA(1, 0, At, B0); PG8_MMA(1, 1, At, B1); PG8_BAR; PG8_SCHED;
            PG8_LDB(B0, 1, 0); PG8_LDB(B1, 1, 1); PG8_SCHED; PG8_LDA(At, 1, 0); PG8_STAGE(PG8_SA(0, 1), a2 + hstep, voffA);
            PG8_WAIT_V(8); PG8_WAIT_L(0); PG8_BAR; PG8_MMA(0, 0, At, B0); PG8_MMA(0, 1, At, B1); PG8_BAR; PG8_SCHED;
            PG8_LDA(At, 1, 1); PG8_STAGE(PG8_SB(1, 0), b3, voffB); PG8_STAGE(PG8_SB(1, 1), b3 + hstep, voffB); PG8_STAGE(PG8_SA(1, 0), a3, voffA);
            PG8_WAIT_V(8); PG8_WAIT_L(0); PG8_BAR; PG8_MMA(1, 0, At, B0); PG8_MMA(1, 1, At, B1); PG8_BAR; PG8_SCHED;
            } else {
            PG8_LDB(B0, 0, 0); PG8_SCHED; PG8_LDA(At, 0, 0); PG8_STAGE(PG8_SA(1, 1), a1 + hstep, voffA);
            PG8_WAIT_L(8); PG8_BAR; PG8_WAIT_L(0); PG8_MMA(0, 0, At, B0); PG8_BAR; PG8_SCHED;
            PG8_LDB(B1, 0, 1); PG8_STAGE(PG8_SB(0, 0), b2, voffB);
            PG8_BAR; PG8_WAIT_L(0); PG8_MMA(0, 1, At, B1); PG8_BAR;
            PG8_LDA(At, 0, 1); PG8_STAGE(PG8_SA(0, 0), a2, voffA);
            PG8_BAR; PG8_WAIT_L(0); PG8_MMA(1, 0, At, B0); PG8_BAR; PG8_SCHED;
            PG8_STAGE(PG8_SB(0, 1), b2 + hstep, voffB);
            PG8_WAIT_V(6); PG8_BAR; PG8_MMA(1, 1, At, B1); PG8_BAR;
            PG8_LDB(B0, 1, 0); PG8_SCHED; PG8_LDA(At, 1, 0); PG8_STAGE(PG8_SA(0, 1), a2 + hstep, voffA);
            PG8_WAIT_L(8); PG8_BAR; PG8_WAIT_L(0); PG8_MMA(0, 0, At, B0); PG8_BAR; PG8_SCHED;
            PG8_LDB(B1, 1, 1); PG8_STAGE(PG8_SB(1, 0), b3, voffB);
            PG8_BAR; PG8_WAIT_L(0); PG8_MMA(0, 1, At, B1); PG8_BAR;
            PG8_LDA(At, 1, 1); PG8_STAGE(PG8_SA(1, 0), a3, voffA);
            PG8_BAR; PG8_WAIT_L(0); PG8_MMA(1, 0, At, B0); PG8_BAR; PG8_SCHED;
            PG8_STAGE(PG8_SB(1, 1), b3 + hstep, voffB);
            PG8_WAIT_V(6); PG8_BAR; PG8_MMA(1, 1, At, B1); PG8_BAR;
            }
        }
        if constexpr (ALIGN_EPI) { if (wr == 0) PG8_BAR; }
        if constexpr (!Epi::AFTER_DRAIN) { const int t2_ = tid_from_wave(g.wave);
            E(acc, cur, wr, wc, t2_ & 15, (t2_ >> 4) & 3); S.done(cur); }
        if (!has_next) break;
{ float zero_; asm volatile("v_mov_b32 %0, 0" : "=v"(zero_));
#pragma unroll
        for (int a = 0; a < 2; ++a)
#pragma unroll
            for (int b = 0; b < 2; ++b)
#pragma unroll
                for (int m = 0; m < 4; ++m)
#pragma unroll
                    for (int n = 0; n < 2; ++n) acc[a][b][m][n] = (f32x4){zero_, zero_, zero_, zero_}; }
        cur = nxt; cA = nA; cB = nB; ++ui;
        if constexpr (ALIGN_EPI) { if (wr == 1) PG8_BAR; }
    }
    PG8_WAIT_V(0);
    if constexpr (!ALIGN_EPI) { if (wr == 0) PG8_BAR; }
    PG8_BAR;
    if constexpr (Epi::AFTER_DRAIN) { E.fused(acc, cur, wr, wc, fr, fq, lds, wid, lane); S.done(cur); }
#undef PG8_SA
#undef PG8_SB
#undef PG8_STAGE
#undef PG8_LDA
#undef PG8_LDB
#undef PG8_MMA
#undef PG8_CAT
#undef PG8_WAIT_V
#undef PG8_WAIT_L
#undef PG8_BAR
#undef PG8_SCHED
}
}

namespace att {
#define ALAS __attribute__((address_space(3)))
typedef unsigned short bf16_t;
typedef short bf16x8 __attribute__((ext_vector_type(8)));
typedef short s16x4 __attribute__((ext_vector_type(4)));
typedef float f32x16 __attribute__((ext_vector_type(16)));
typedef float f32x4 __attribute__((ext_vector_type(4)));
typedef unsigned u32x4 __attribute__((ext_vector_type(4)));
typedef ALAS char* ldsp;
#ifndef WO_F8
#define WO_F8 1
#endif
constexpr float OB8_SCALE = 8.f;
constexpr int QP = 6144;
constexpr int OP = 2048;
constexpr int OBP = 2048;
constexpr int SHM_V = 16384, SHM_K = 16384;
constexpr int LDS_V = 0, LDS_K = 2 * SHM_V, LDS_WS = LDS_K + 2 * SHM_K, ATT_LDS_BYTES = LDS_WS + 8 * 256;
#define KSWZ(row, colB) ((row) * 256 + ((colB) ^ (((row) & 7) << 4)))
#define KSWZ64(row, colB) ((row) * 128 + ((colB) ^ (((row) & 7) << 4)))
#define SBAR() __builtin_amdgcn_sched_barrier(0)
__device__ __forceinline__ int v_st(int k, int c) { const int kk = (k & ~0xC) | ((k & 4) << 1) | ((k & 8) >> 1); return ((kk >> 3) * 4 + (c >> 5)) * 512 + ((kk & 7) * 32 + (c & 31)) * 2; }
__device__ __forceinline__ int v_rd_base(int lane) { return ((lane & 3) << 3) | (((lane >> 2) & 3) << 6) | (((lane >> 4) & 1) << 5) | (((lane >> 5) & 1) << 8); }
constexpr int v_rd_off(int d0, int ks, int half) { return d0 * 512 + ks * 4096 + half * 2048; }
__device__ __forceinline__ int crow(int r, int hi) { return (r & 3) + 8 * (r >> 2) + 4 * hi; }
__device__ __forceinline__ unsigned cvtpk(float lo, float hi) { unsigned r; asm volatile("v_cvt_pk_bf16_f32 %0, %1, %2" : "=v"(r) : "v"(lo), "v"(hi)); return r; }
__device__ __forceinline__ bf16x8 ldg8(const bf16_t* p) { return *reinterpret_cast<const bf16x8*>(p); }
__device__ __forceinline__ unsigned quad_pack_fp8(float v) {
    const int b = __builtin_bit_cast(int, v);
    const float v1 = __builtin_bit_cast(float, __builtin_amdgcn_update_dpp(b, b, 0x55, 0xf, 0xf, false));
    const float v2 = __builtin_bit_cast(float, __builtin_amdgcn_update_dpp(b, b, 0xAA, 0xf, 0xf, false));
    const float v3 = __builtin_bit_cast(float, __builtin_amdgcn_update_dpp(b, b, 0xFF, 0xf, 0xf, false));
    int w; asm volatile("" : "=v"(w));
    w = __builtin_amdgcn_cvt_pk_fp8_f32(v, v1, w, false); w = __builtin_amdgcn_cvt_pk_fp8_f32(v2, v3, w, true); return (unsigned)w;
}
__device__ __forceinline__ float xhalf(float v, int hi) {
    auto rr = __builtin_amdgcn_permlane32_swap(__float_as_uint(v), __float_as_uint(v), false, false);
    return __uint_as_float(hi ? rr[0] : rr[1]);
}
#define ATT_PK4(P, B_, OUT) do { unsigned a0 = cvtpk(P[B_+0], P[B_+1]), a1 = cvtpk(P[B_+2], P[B_+3]);                      \
        unsigned b0 = cvtpk(P[B_+4], P[B_+5]), b1 = cvtpk(P[B_+6], P[B_+7]);                                             \
        auto r0 = __builtin_amdgcn_permlane32_swap(a0, b0, false, false); auto r1 = __builtin_amdgcn_permlane32_swap(a1, b1, false, false); \
        u32x4 w = {r0[0], r1[0], r0[1], r1[1]}; OUT = *reinterpret_cast<bf16x8*>(&w); } while (0)
__device__ __forceinline__ void pv_tile(f32x16* o, int vb, bf16x8 pa0, bf16x8 pa1, bf16x8 pa2, bf16x8 pa3) {
#define TRRD(dst, off) asm volatile("ds_read_b64_tr_b16 %0, %1 offset:%2" : "=&v"(dst) : "v"(vb), "i"(off) : "memory")
#define PV_D0(d0) do { s16x4 l0, l1, l2, l3, h0, h1, h2, h3; constexpr int b_ = v_rd_off(d0, 0, 0); \
        TRRD(l0, b_); TRRD(h0, b_ + 2048); TRRD(l1, b_ + 4096); TRRD(h1, b_ + 6144); TRRD(l2, b_ + 8192); TRRD(h2, b_ + 10240); TRRD(l3, b_ + 12288); TRRD(h3, b_ + 14336); \
        asm volatile("s_waitcnt lgkmcnt(0)" ::: "memory"); SBAR(); \
        o[d0] = __builtin_amdgcn_mfma_f32_32x32x16_bf16(pa0, (bf16x8){l0[0], l0[1], l0[2], l0[3], h0[0], h0[1], h0[2], h0[3]}, o[d0], 0, 0, 0);   \
        o[d0] = __builtin_amdgcn_mfma_f32_32x32x16_bf16(pa1, (bf16x8){l1[0], l1[1], l1[2], l1[3], h1[0], h1[1], h1[2], h1[3]}, o[d0], 0, 0, 0);   \
        o[d0] = __builtin_amdgcn_mfma_f32_32x32x16_bf16(pa2, (bf16x8){l2[0], l2[1], l2[2], l2[3], h2[0], h2[1], h2[2], h2[3]}, o[d0], 0, 0, 0);   \
        o[d0] = __builtin_amdgcn_mfma_f32_32x32x16_bf16(pa3, (bf16x8){l3[0], l3[1], l3[2], l3[3], h3[0], h3[1], h3[2], h3[3]}, o[d0], 0, 0, 0); } while (0)
    PV_D0(0); PV_D0(1); PV_D0(2); PV_D0(3);
#undef PV_D0
#undef TRRD
}

__device__ __forceinline__ void sb_block(const bf16_t* __restrict__ Qg, const bf16_t* __restrict__ Kg, const bf16_t* __restrict__ Vg, bf16_t* __restrict__ Og, int qb, ldsp lds, int wave_) {
    int tid_ = tid_from_wave(wave_); asm volatile("" : "+v"(tid_));
    const int tid = tid_, wid = __builtin_amdgcn_readfirstlane(tid >> 6), lane = tid & 63, r32 = lane & 31, hi = lane >> 5;
    const int NT = 4 * qb + 4, R0 = 256 * qb + 32 * wid, myrow = R0 + r32;
    const ldsp V_lds = lds + LDS_V; const ldsp K_lds = lds + LDS_K;
    bf16x8 qr[8];
    { const bf16_t* Qw = Qg + (size_t)R0 * QP; const unsigned qoff = (unsigned)(r32 * QP + hi * 8);
#pragma unroll
      for (int d0 = 0; d0 < 8; ++d0) qr[d0] = ldg8(Qw + (qoff + d0 * 16)); }
    const int sr = tid >> 4, sc = (tid & 15) * 8, kws = KSWZ(sr, sc * 2), vst0 = v_st(sr, sc), vst1 = v_st(32 + sr, sc);
    const unsigned kvoff = (unsigned)(sr * QP + sc);
    const int vb0 = (int)(unsigned)(uintptr_t)V_lds + v_rd_base(lane);
    bf16x8 sk0, sk1, sv0, sv1;
#define SB_LOAD(j) do { const bf16_t* kp_ = Kg + (size_t)(64 * (j)) * QP; const bf16_t* vp_ = Vg + (size_t)(64 * (j)) * QP; \
        sk0 = ldg8(kp_ + kvoff); sk1 = ldg8(kp_ + (size_t)32 * QP + kvoff); sv0 = ldg8(vp_ + kvoff); sv1 = ldg8(vp_ + (size_t)32 * QP + kvoff); } while (0)
#define SB_WRITE(bf) do { *(ALAS bf16x8*)(K_lds + (bf) * SHM_K + kws) = sk0; *(ALAS bf16x8*)(K_lds + (bf) * SHM_K + kws + 32 * 256) = sk1; \
        *(ALAS bf16x8*)(V_lds + (bf) * SHM_V + vst0) = sv0; *(ALAS bf16x8*)(V_lds + (bf) * SHM_V + vst1) = sv1; } while (0)
    SB_LOAD(NT - 1); SB_WRITE(0);
    __syncthreads();
    float carry = 0.f; f32x16 o[4] = {};
    ALAS int* fl = (ALAS int*)(lds + LDS_WS); bool wdone = false;
    for (int t = 0; t < NT; ++t) {
        const int j = NT - 1 - t, buf = t & 1, kb = 64 * j;
        if (t + 1 < NT) SB_LOAD(j - 1);
        if (kb <= R0 + 30 && !wdone) {
            f32x16 p0 = {}, p1 = {};
            { const ldsp Kb = K_lds + buf * SHM_K;
#pragma unroll
              for (int d0 = 0; d0 < 8; ++d0) { const ldsp a = Kb + KSWZ(r32, ((d0 & 3) * 16 + hi * 8) * 2) + (d0 >> 2) * 128;
                  const bf16x8 b0 = *(const ALAS bf16x8*)a, b1 = *(const ALAS bf16x8*)(a + 32 * 256);
                  p0 = __builtin_amdgcn_mfma_f32_32x32x16_bf16(b0, qr[d0], p0, 0, 0, 0);
                  p1 = __builtin_amdgcn_mfma_f32_32x32x16_bf16(b1, qr[d0], p1, 0, 0, 0); } }
            f32x16 lb0, lb1;
#pragma unroll
            for (int r = 0; r < 16; ++r) {
                { const float z = p0[r]; const float e = __builtin_amdgcn_exp2f(-__builtin_fabsf(z)); const float sp = __builtin_fmaxf(z, 0.f) + __builtin_amdgcn_logf(1.f + e); p0[r] = -sp; lb0[r] = z - sp; }
                { const float z = p1[r]; const float e = __builtin_amdgcn_exp2f(-__builtin_fabsf(z)); const float sp = __builtin_fmaxf(z, 0.f) + __builtin_amdgcn_logf(1.f + e); p1[r] = -sp; lb1[r] = z - sp; }
            }
            if (kb + 63 >= R0) {
                const int dq = myrow - kb - 4 * hi; const float NEG = -__builtin_inff();
#pragma unroll
                for (int r = 0; r < 16; ++r) { const int c = (r & 3) + 8 * (r >> 2);
                    if (c >= dq) { p0[r] = 0.f; lb0[r] = NEG; }
                    if (c + 32 >= dq) { p1[r] = 0.f; lb1[r] = NEG; } }
            }
            float gs[8], go[8];
#pragma unroll
            for (int g = 0; g < 4; ++g) { gs[g] = (p0[4 * g] + p0[4 * g + 1]) + (p0[4 * g + 2] + p0[4 * g + 3]); gs[4 + g] = (p1[4 * g] + p1[4 * g + 1]) + (p1[4 * g + 2] + p1[4 * g + 3]); }
#pragma unroll
            for (int i = 0; i < 8; ++i) go[i] = xhalf(gs[i], hi);
            float acc = carry;
#pragma unroll
            for (int idx = 7; idx >= 0; --idx) { const int g = idx & 3; const float base = acc + (hi ? 0.f : go[idx]);
                if (idx >= 4) { const float t3 = base, t2 = t3 + p1[4 * g + 3], t1 = t2 + p1[4 * g + 2], t0 = t1 + p1[4 * g + 1];
                    lb1[4 * g + 3] = __builtin_amdgcn_exp2f(lb1[4 * g + 3] + t3); lb1[4 * g + 2] = __builtin_amdgcn_exp2f(lb1[4 * g + 2] + t2);
                    lb1[4 * g + 1] = __builtin_amdgcn_exp2f(lb1[4 * g + 1] + t1); lb1[4 * g] = __builtin_amdgcn_exp2f(lb1[4 * g] + t0); }
                else { const float t3 = base, t2 = t3 + p0[4 * g + 3], t1 = t2 + p0[4 * g + 2], t0 = t1 + p0[4 * g + 1];
                    lb0[4 * g + 3] = __builtin_amdgcn_exp2f(lb0[4 * g + 3] + t3); lb0[4 * g + 2] = __builtin_amdgcn_exp2f(lb0[4 * g + 2] + t2);
                    lb0[4 * g + 1] = __builtin_amdgcn_exp2f(lb0[4 * g + 1] + t1); lb0[4 * g] = __builtin_amdgcn_exp2f(lb0[4 * g] + t0); }
                acc += gs[idx] + go[idx]; }
            carry = acc;
            bf16x8 pa0, pa1, pa2, pa3;
            ATT_PK4(lb0, 0, pa0); ATT_PK4(lb0, 8, pa1); ATT_PK4(lb1, 0, pa2); ATT_PK4(lb1, 8, pa3);
            SBAR();
            pv_tile(o, vb0 + buf * SHM_V, pa0, pa1, pa2, pa3);
            wdone = __all(carry < -127.f);
        }
        if (lane == 0) fl[buf * 8 + wid] = wdone ? 1 : 0;
        if (t + 1 < NT) SB_WRITE(buf ^ 1);
        __syncthreads();
        { const ALAS int* f = fl + buf * 8; if ((f[0] & f[1] & f[2] & f[3] & f[4] & f[5] & f[6] & f[7]) != 0) break; }
    }
#undef SB_LOAD
#undef SB_WRITE
#if WO_F8
    unsigned char* Ow = (unsigned char*)Og + (size_t)R0 * OBP; const unsigned ooff = (unsigned)(4 * hi * OBP + r32);
#pragma unroll
    for (int r = 0; r < 16; ++r) { unsigned char* rowp = Ow + (size_t)((r & 3) + 8 * (r >> 2)) * OBP;
#pragma unroll
        for (int d0 = 0; d0 < 4; ++d0) { const unsigned w = quad_pack_fp8(o[d0][r] * OB8_SCALE);
            if ((r32 & 3) == 0) *(unsigned*)(rowp + (ooff + d0 * 32)) = w; } }
#else
    bf16_t* Ow = Og + (size_t)R0 * OP; const unsigned ooff = (unsigned)(4 * hi * OP + r32);
#pragma unroll
    for (int r = 0; r < 16; ++r) { bf16_t* rowp = Ow + (size_t)((r & 3) + 8 * (r >> 2)) * OP;
#pragma unroll
        for (int d0 = 0; d0 < 4; ++d0) { const float v = o[d0][r]; const float vn = __shfl_xor(v, 1);
            if ((r32 & 1) == 0) *(unsigned*)(rowp + (ooff + d0 * 32)) = cvtpk(v, vn); } }
#endif
}

constexpr float ATT_THR = 8.f;
__device__ __forceinline__ void qkt64(f32x16& p0, f32x16& p1, ldsp Kb, int r32, int hi, const bf16x8* qr) {
    p0 = f32x16{}; p1 = f32x16{};
#pragma unroll
    for (int d0 = 0; d0 < 4; ++d0) { const ldsp a = Kb + KSWZ64(r32, (d0 * 16 + hi * 8) * 2);
        const bf16x8 b0 = *(const ALAS bf16x8*)a, b1 = *(const ALAS bf16x8*)(a + 32 * 128);
        p0 = __builtin_amdgcn_mfma_f32_32x32x16_bf16(b0, qr[d0], p0, 0, 0, 0);
        p1 = __builtin_amdgcn_mfma_f32_32x32x16_bf16(b1, qr[d0], p1, 0, 0, 0); }
}
__device__ __forceinline__ void partial_sm(f32x16& p0, f32x16& p1, float& m_reg, float& alpha, int hi) {
    float pmax = p0[0];
#pragma unroll
    for (int r = 1; r < 16; ++r) pmax = __builtin_fmaxf(pmax, p0[r]);
#pragma unroll
    for (int r = 0; r < 16; ++r) pmax = __builtin_fmaxf(pmax, p1[r]);
    pmax = __builtin_fmaxf(pmax, xhalf(pmax, hi));
    float mn;
    if (__builtin_expect(__all(pmax - m_reg <= ATT_THR), 1)) { mn = m_reg; alpha = 1.f; }
    else { mn = __builtin_fmaxf(m_reg, pmax); alpha = __builtin_amdgcn_exp2f(m_reg - mn); m_reg = mn; }
#pragma unroll
    for (int r = 0; r < 16; ++r) { p0[r] -= mn; p1[r] -= mn; }
#pragma unroll
    for (int r = 0; r < 16; ++r) p0[r] = __builtin_amdgcn_exp2f(p0[r]);
}
__device__ __forceinline__ void finish_sm(f32x16& p0, f32x16& p1, float alpha, float& l_reg, bf16x8& pa0, bf16x8& pa1, bf16x8& pa2, bf16x8& pa3, int hi) {
#pragma unroll
    for (int r = 0; r < 16; ++r) p1[r] = __builtin_amdgcn_exp2f(p1[r]);
    float ps = 0.f;
#pragma unroll
    for (int r = 0; r < 16; ++r) ps += p0[r];
#pragma unroll
    for (int r = 0; r < 16; ++r) ps += p1[r];
    ps += xhalf(ps, hi);
    l_reg = l_reg * alpha + ps;
    ATT_PK4(p0, 0, pa0); ATT_PK4(p0, 8, pa1); ATT_PK4(p1, 0, pa2); ATT_PK4(p1, 8, pa3);
}
__device__ __forceinline__ void mask_gt(f32x16& p0, f32x16& p1, int dq) {
    const float NEG = -__builtin_inff();
#pragma unroll
    for (int r = 0; r < 16; ++r) { const int c = (r & 3) + 8 * (r >> 2);
        if (c > dq) p0[r] = NEG;
        if (c + 32 > dq) p1[r] = NEG; }
}
template <bool SECOND>
__device__ __forceinline__ void diff_pass(const bf16_t* __restrict__ Qg, const bf16_t* __restrict__ Kg, const bf16_t* __restrict__ Vg, float* S1, bf16_t* __restrict__ Og,
                                          int qb, float lam, const float* __restrict__ gsub, float gmul, ldsp lds, int wave_) {
    int tid_ = tid_from_wave(wave_); asm volatile("" : "+v"(tid_));
    const int tid = tid_, wid = __builtin_amdgcn_readfirstlane(tid >> 6), lane = tid & 63, r32 = lane & 31, hi = lane >> 5;
    const int NT = 4 * qb + 4, R0 = 256 * qb + 32 * wid, myrow = R0 + r32;
    const ldsp V_lds = lds + LDS_V; const ldsp K_lds = lds + LDS_K;
    ALAS float* wsf = (ALAS float*)(lds + LDS_WS) + wid * 64; ALAS float* li_l = wsf; ALAS float* al_l = wsf + 32;
    bf16x8 qr[4];
    { const bf16_t* Qw = Qg + (size_t)R0 * QP; const unsigned qoff = (unsigned)(r32 * QP + hi * 8);
#pragma unroll
      for (int d0 = 0; d0 < 4; ++d0) qr[d0] = ldg8(Qw + (qoff + d0 * 16)); }
    const int sr = tid >> 4, sc = (tid & 15) * 8, vst0 = v_st(sr, sc), vst1 = v_st(32 + sr, sc);
    const int kr = tid >> 3, kc = (tid & 7) * 8, kws = KSWZ64(kr, kc * 2);
    const unsigned voff = (unsigned)(sr * QP + sc), koff = (unsigned)(kr * QP + kc);
    const int vb0 = (int)(unsigned)(uintptr_t)V_lds + v_rd_base(lane);
    const int qm = myrow - 4 * hi;
    bf16x8 sk0A, sv0A, sv1A, sk0B, sv0B, sv1B;
#define DF_LOAD(S_, j) do { const bf16_t* vp_ = Vg + (size_t)(64 * (j)) * QP; sk0##S_ = ldg8(Kg + (size_t)(64 * (j)) * QP + koff); sv0##S_ = ldg8(vp_ + voff); sv1##S_ = ldg8(vp_ + (size_t)32 * QP + voff); } while (0)
#define DF_WRITE(S_, bf) do { *(ALAS bf16x8*)(K_lds + (bf) * SHM_K + kws) = sk0##S_; *(ALAS bf16x8*)(V_lds + (bf) * SHM_V + vst0) = sv0##S_; *(ALAS bf16x8*)(V_lds + (bf) * SHM_V + vst1) = sv1##S_; } while (0)
#define DF_MASK(P0, P1, t) do { if (64 * (t) + 63 > R0) mask_gt(P0, P1, qm - 64 * (t)); } while (0)
#define DF_RESC(a) do { if (__any((a) < 1.f)) { if (hi == 0) al_l[r32] = (a); asm volatile("s_waitcnt lgkmcnt(0)" ::: "memory"); \
        _Pragma("unroll") for (int d_ = 0; d_ < 4; ++d_) _Pragma("unroll") for (int r = 0; r < 16; ++r) o[d_][r] *= al_l[crow(r, hi)]; } } while (0)
    float m_reg = -1e30f, l_reg = 0.f; f32x16 o[4] = {};
    f32x16 pA0, pA1, pB0, pB1; float alA = 1.f, alB = 1.f; bf16x8 pa0, pa1, pa2, pa3;
    DF_LOAD(A, 0); DF_WRITE(A, 0);
    __syncthreads();
    DF_LOAD(A, 1); DF_LOAD(B, 2);
    qkt64(pA0, pA1, K_lds, r32, hi, qr); DF_MASK(pA0, pA1, 0); partial_sm(pA0, pA1, m_reg, alA, hi);
    DF_WRITE(A, 1);
    DF_RESC(alA);
    __syncthreads();
#define DF_HALF(PX0, PX1, alX, PY0, PY1, alY, t, KB, VB, SB, LS, WS) do { \
        SBAR(); qkt64(PX0, PX1, K_lds + (KB) * SHM_K, r32, hi, qr); \
        finish_sm(PY0, PY1, alY, l_reg, pa0, pa1, pa2, pa3, hi); SBAR(); \
        if ((t) + 2 < NT) { DF_LOAD(LS, (t) + 2); SBAR(); } \
        pv_tile(o, vb0 + (VB) * SHM_V, pa0, pa1, pa2, pa3); DF_MASK(PX0, PX1, (t)); partial_sm(PX0, PX1, m_reg, alX, hi); \
        __syncthreads(); \
        if ((t) + 1 < NT) DF_WRITE(WS, SB); \
        DF_RESC(alX); __syncthreads(); } while (0)
    for (int t = 1; t + 1 < NT; t += 2) {
        DF_HALF(pB0, pB1, alB, pA0, pA1, alA, t, 1, 0, 0, A, B);
        DF_HALF(pA0, pA1, alA, pB0, pB1, alB, t + 1, 0, 1, 1, B, A);
    }
    DF_HALF(pB0, pB1, alB, pA0, pA1, alA, NT - 1, 1, 0, 0, A, B);
    finish_sm(pB0, pB1, alB, l_reg, pa0, pa1, pa2, pa3, hi); SBAR();
    pv_tile(o, vb0 + 1 * SHM_V, pa0, pa1, pa2, pa3);
#undef DF_LOAD
#undef DF_WRITE
#undef DF_MASK
#undef DF_RESC
#undef DF_HALF
    if (hi == 0) li_l[r32] = l_reg; asm volatile("s_waitcnt lgkmcnt(0)" ::: "memory");
    float rli[16];
#pragma unroll
    for (int r = 0; r < 16; ++r) rli[r] = __builtin_amdgcn_rcpf(li_l[crow(r, hi)]);
    if constexpr (!SECOND) {
        float* Sw = S1 + (size_t)R0 * OP; const unsigned ooff = (unsigned)(4 * hi * OP + r32);
#pragma unroll
        for (int r = 0; r < 16; ++r) { float* rowp = Sw + (size_t)((r & 3) + 8 * (r >> 2)) * OP;
#pragma unroll
            for (int d0 = 0; d0 < 4; ++d0) rowp[ooff + d0 * 32] = o[d0][r] * rli[r]; }
    } else {
        const float* Sw = S1 + (size_t)R0 * OP; bf16_t* Ow = Og + (size_t)R0 * OP; (void)Ow; const unsigned ooff = (unsigned)(4 * hi * OP + r32), ooff8 = (unsigned)(4 * hi * OBP + r32);
        float gn[4];
#pragma unroll
        for (int d0 = 0; d0 < 4; ++d0) gn[d0] = gsub[d0 * 32 + r32] * gmul;
#pragma unroll
        for (int r = 0; r < 16; ++r) { const float* srow = Sw + (size_t)((r & 3) + 8 * (r >> 2)) * OP; float d[4]; float ss = 0.f;
#if WO_F8
            unsigned char* orowp = (unsigned char*)Og + (size_t)(R0 + (r & 3) + 8 * (r >> 2)) * OBP;
#else
            bf16_t* orowp = Ow + (size_t)((r & 3) + 8 * (r >> 2)) * OP;
#endif
#pragma unroll
            for (int d0 = 0; d0 < 4; ++d0) { d[d0] = srow[ooff + d0 * 32] - lam * (o[d0][r] * rli[r]); ss += d[d0] * d[d0]; }
            ss += __builtin_bit_cast(float, __builtin_amdgcn_update_dpp(0, __builtin_bit_cast(int, ss), 0xB1, 0xf, 0xf, true));
            ss += __builtin_bit_cast(float, __builtin_amdgcn_update_dpp(0, __builtin_bit_cast(int, ss), 0x4E, 0xf, 0xf, true));
            ss += __builtin_bit_cast(float, __builtin_amdgcn_update_dpp(0, __builtin_bit_cast(int, ss), 0x141, 0xf, 0xf, true));
            ss += __builtin_bit_cast(float, __builtin_amdgcn_update_dpp(0, __builtin_bit_cast(int, ss), 0x140, 0xf, 0xf, true));
            { auto rr = __builtin_amdgcn_permlane16_swap(__float_as_uint(ss), __float_as_uint(ss), false, false); ss = __uint_as_float(rr[0]) + __uint_as_float(rr[1]); }
            const float rs = __builtin_amdgcn_rsqf(ss * (1.f / 128.f) + 1e-5f);
#pragma unroll
#if WO_F8
            for (int d0 = 0; d0 < 4; ++d0) { const unsigned w = quad_pack_fp8(d[d0] * rs * gn[d0] * OB8_SCALE);
                if ((r32 & 3) == 0) *(unsigned*)(orowp + (ooff8 + d0 * 32)) = w; }
#else
            for (int d0 = 0; d0 < 4; ++d0) { const float v = d[d0] * rs * gn[d0]; const float vn = __shfl_xor(v, 1);
                if ((r32 & 1) == 0) *(unsigned*)(orowp + (ooff + d0 * 32)) = cvtpk(v, vn); }
#endif
            if ((r & 1) == 1) asm volatile("" ::: "memory"); }
    }
    __syncthreads();
}

#ifndef D2_NEGM
#define D2_NEGM 1
#endif
constexpr int D2_SLK = 8192, D2_SLV = 16384, D2_K = 0, D2_V = 3 * D2_SLK, D2_WS = D2_V + 3 * D2_SLV, D2_LDS_BYTES = D2_WS + 8 * 256;
typedef __attribute__((address_space(3))) const char* lds_cptr;
typedef short v4i16_t __attribute__((ext_vector_type(4)));
typedef float f32x2_t __attribute__((ext_vector_type(2))); typedef __bf16 bf16x2_t __attribute__((ext_vector_type(2)));
__device__ __forceinline__ unsigned cvtpk_s(float lo, float hi) { const f32x2_t v = {lo, hi}; const bf16x2_t b = __builtin_convertvector(v, bf16x2_t); return __builtin_bit_cast(unsigned, b); }
__device__ __forceinline__ s16x4 vtr(lds_cptr p) { return __builtin_bit_cast(s16x4, __builtin_amdgcn_ds_read_tr16_b64_v4i16((__attribute__((address_space(3))) v4i16_t*)p)); }
__device__ __forceinline__ void kload2(bf16x8* kf, lds_cptr kp, int j) { kf[2 * j] = *(const ALAS bf16x8*)(kp + j * 2048); kf[2 * j + 1] = *(const ALAS bf16x8*)(kp + j * 2048 + 512); }
__device__ __forceinline__ void glds16s(unsigned voff, const void* gbase, unsigned ldsdst) { unsigned keep;
    asm volatile("s_mov_b32 %0, m0\n\ts_mov_b32 m0, %3\n\ts_nop 0\n\tglobal_load_lds_dwordx4 %1, %2\n\ts_mov_b32 m0, %0" : "=&s"(keep) : "v"(voff), "s"(gbase), "s"(ldsdst) : "memory"); }
#define D2_MX3(a, b, c) __builtin_fmaxf(__builtin_fmaxf((a), (b)), (c))
__device__ __forceinline__ float rowmax2(const f32x16& p0, const f32x16& p1) {
    float a = D2_MX3(p0[0], p0[1], p1[0]), b = D2_MX3(p0[2], p0[3], p1[1]); a = D2_MX3(a, p1[2], p1[3]);
#pragma unroll
    for (int r = 4; r < 16; r += 4) { a = D2_MX3(a, p0[r], p0[r + 1]); b = D2_MX3(b, p0[r + 2], p0[r + 3]); a = D2_MX3(a, p1[r], p1[r + 1]); b = D2_MX3(b, p1[r + 2], p1[r + 3]); }
    const float m = __builtin_fmaxf(a, b); auto rr = __builtin_amdgcn_permlane32_swap(__float_as_uint(m), __float_as_uint(m), false, false);
    return __builtin_fmaxf(__uint_as_float(rr[0]), __uint_as_float(rr[1])); }
__device__ __forceinline__ void cmask2(f32x16& p0, f32x16& p1, int jb, int qrel, int hi) {
    const int kb = 64 * jb + 4 * hi; const float NEG = -__builtin_inff();
#pragma unroll
    for (int r = 0; r < 16; ++r) { const int kv = kb + (r & 3) + 8 * (r >> 2); if (kv > qrel) p0[r] = NEG; if (kv + 32 > qrel) p1[r] = NEG; } }
#define D2_WAIT_BAR(N) asm volatile("s_waitcnt vmcnt(" #N ") lgkmcnt(0)\n\ts_barrier" ::: "memory")
#define D2_PIN(x) asm volatile("" : "+v"(x))
#define D2_MF(a, b, c) __builtin_amdgcn_mfma_f32_32x32x16_bf16(a, b, c, 0, 0, 0)

template <bool SECOND>
__device__ __forceinline__ void diff_pass2(const bf16_t* __restrict__ Qg, const bf16_t* __restrict__ Kg, const bf16_t* __restrict__ Vg, float* S1, bf16_t* __restrict__ Og,
                                           int qb, float lam, const float* __restrict__ gsub, float gmul, ldsp lds, int wave_) {
    int tid_ = tid_from_wave(wave_); asm volatile("" : "+v"(tid_));
    const int tid = tid_, wid = __builtin_amdgcn_readfirstlane(tid >> 6), lane = tid & 63, r32 = lane & 31, hi = lane >> 5;
    const int NT = 4 * qb + 4, R0 = 256 * qb + 32 * wid;
    const unsigned lds0 = (unsigned)(uintptr_t)lds;
    ALAS float* wsf = (ALAS float*)(lds + D2_WS) + wid * 64;
    const unsigned kvo = (unsigned)(lane * QP + wid * 8) * 2u;
    const unsigned vvo = (unsigned)((16 * (wid & 3) + (lane >> 2)) * QP + (wid >> 2) * 32 + (lane & 3) * 8) * 2u;
    const unsigned kdst = lds0 + D2_K + wid * 1024, vdst = lds0 + D2_V + wid * 1024;
#define D2_DMA_K(t, slot) glds16s(kvo, Kg + (size_t)(t) * 64 * QP, (unsigned)__builtin_amdgcn_readfirstlane(kdst + (slot)))
#define D2_DMA_V(t, slot) do { glds16s(vvo, Vg + (size_t)(t) * 64 * QP, (unsigned)__builtin_amdgcn_readfirstlane(vdst + 2 * (slot))); \
                               glds16s(vvo, Vg + (size_t)(t) * 64 * QP + 64, (unsigned)__builtin_amdgcn_readfirstlane(vdst + 2 * (slot) + 8192)); } while (0)
    const lds_cptr kp0 = (lds_cptr)lds + D2_K + hi * 1024 + r32 * 16;
    const lds_cptr vp0 = (lds_cptr)lds + D2_V + ((lane >> 4) & 1) * 32 + (lane & 3) * 8 + (4 * hi + ((lane & 15) >> 2)) * 64;
    D2_DMA_K(0, 0); D2_DMA_V(0, 0); D2_DMA_K(1, D2_SLK);
    bf16x8 qr[4];
    { const bf16_t* Qw = Qg + (size_t)R0 * QP; const unsigned qoff = (unsigned)(r32 * QP + hi * 8);
#pragma unroll
      for (int d0 = 0; d0 < 4; ++d0) qr[d0] = ldg8(Qw + (qoff + d0 * 16)); }
    D2_DMA_K(2, 2 * D2_SLK);
    float mhat = 0.f, l_reg = 0.f; f32x16 o[4] = {};
    const int qrel = 32 * wid + r32; bool resc = false;
    f32x16 pA0, pA1, pB0, pB1; bf16x8 kf[8]; s16x4 vlo[4], vhi[4]; u32x4 pw0, pw1, pw2, pw3;
#if D2_NEGM
    f32x16 negm;
#endif
    int sl_prev = 0, sl_cur = 0, sl_next = D2_SLK;
#define D2_ROT() do { sl_prev = sl_cur; sl_cur = sl_next; sl_next = (sl_next == 2 * D2_SLK) ? 0 : sl_next + D2_SLK; } while (0)
#if D2_NEGM
#define D2_EX(v) __builtin_amdgcn_exp2f(v)
#define D2_C0 negm
#else
#define D2_EX(v) __builtin_amdgcn_exp2f((v) - mhat)
#define D2_C0 D2_Z16
#endif
#define D2_RESC() do { if (resc) { _Pragma("unroll") for (int d_ = 0; d_ < 4; ++d_) _Pragma("unroll") for (int r = 0; r < 16; ++r) o[d_][r] *= wsf[crow(r, hi)]; } } while (0)
#define D2_Z16 (f32x16){}
#if D2_NEGM
#define D2_RM(C0, C1) rowmax2(C0, C1)
#define D2_MOVE(C0, C1, dl) do { _Pragma("unroll") for (int r = 0; r < 16; ++r) { C0[r] -= dl; C1[r] -= dl; } _Pragma("unroll") for (int r = 0; r < 16; ++r) negm[r] = -mhat; D2_PIN(negm); } while (0)
#else
#define D2_RM(C0, C1) (rowmax2(C0, C1) - mhat)
#define D2_MOVE(C0, C1, dl) do { } while (0)
#endif
    D2_WAIT_BAR(4);
#pragma unroll
    for (int d0 = 0; d0 < 4; ++d0) kload2(kf, kp0, d0);
    pA0 = D2_MF(kf[0], qr[0], D2_Z16); pA1 = D2_MF(kf[1], qr[0], D2_Z16); pA0 = D2_MF(kf[2], qr[1], pA0); pA1 = D2_MF(kf[3], qr[1], pA1);
    pA0 = D2_MF(kf[4], qr[2], pA0); pA1 = D2_MF(kf[5], qr[2], pA1); pA0 = D2_MF(kf[6], qr[3], pA0); pA1 = D2_MF(kf[7], qr[3], pA1);
    if (NT == 4) cmask2(pA0, pA1, 0, qrel, hi);
    { mhat = rowmax2(pA0, pA1);
#pragma unroll
      for (int r = 0; r < 16; ++r) { pA0[r] = __builtin_amdgcn_exp2f(pA0[r] - mhat); pA1[r] = __builtin_amdgcn_exp2f(pA1[r] - mhat); }
#if D2_NEGM
#pragma unroll
      for (int r = 0; r < 16; ++r) negm[r] = -mhat;
      D2_PIN(negm);
#endif
    }
    D2_WAIT_BAR(0);
    D2_DMA_K(3, 0); D2_DMA_V(1, D2_SLK); D2_ROT();
#pragma unroll
    for (int d0 = 0; d0 < 4; ++d0) kload2(kf, kp0 + sl_cur, d0);
    D2_WAIT_BAR(3);
#define D2_PKW(P, i) cvtpk_s(P[i], P[(i) + 1])
#define D2_PAF(k) __builtin_bit_cast(bf16x8, pw##k)
#define D2_VFR(i) (bf16x8){vlo[i][0], vlo[i][1], vlo[i][2], vlo[i][3], vhi[i][0], vhi[i][1], vhi[i][2], vhi[i][3]}
#define D2_VRD(s, i) do { vlo[s] = vtr(vp_ + ((((i) & 3) * 4096) + (((i) >> 2) * 1024))); vhi[s] = vtr(vp_ + ((((i) & 3) * 4096) + (((i) >> 2) * 1024) + 512)); } while (0)
#define D2_KRD(G, d0) do { if (G) { kload2(kf, kp0 + sl_next, d0); SBAR(); } } while (0)
#define D2_GAPA(MF_, a0, a1, a2, a3, W0, W1, PW) do { MF_; sacc += a0; sacc += a1; sacc += a2; sacc += a3; D2_PIN(sacc); W0; W1; D2_PIN(PW); SBAR(); } while (0)
#define D2_GAPB(j, K_, X, e) do { o[(j) & 3] = D2_MF(D2_PAF(K_), D2_VFR((j) & 3), o[(j) & 3]); X[e] = D2_EX(X[e]); X[(e) + 1] = D2_EX(X[(e) + 1]); D2_PIN(X); SBAR(); } while (0)
#define D2_STEP(C0, C1, P0, P1, t, MASK, GK, GV, GL) do { SBAR(); \
    const lds_cptr vp_ = vp0 + 2 * sl_prev; \
    float sacc = P0[0] + P0[1]; \
                          D2_GAPA(C0 = D2_MF(kf[0], qr[0], D2_C0),  P0[2], P0[3], P0[4], P0[5],     pw0[0] = D2_PKW(P0, 0),  pw0[1] = D2_PKW(P0, 2),  pw0); \
                          D2_GAPA(C1 = D2_MF(kf[1], qr[0], D2_C0),  P0[6], P0[7], P0[8], P0[9],     pw0[2] = D2_PKW(P0, 4),  pw0[3] = D2_PKW(P0, 6),  pw0); \
                          D2_GAPA(C0 = D2_MF(kf[2], qr[1], C0),     P0[10], P0[11], P0[12], P0[13], pw1[0] = D2_PKW(P0, 8),  pw1[1] = D2_PKW(P0, 10), pw1); \
                          D2_GAPA(C1 = D2_MF(kf[3], qr[1], C1),     P0[14], P0[15], P1[0], P1[1],   pw1[2] = D2_PKW(P0, 12), pw1[3] = D2_PKW(P0, 14), pw1); \
    D2_VRD(0, 0); SBAR(); D2_GAPA(C0 = D2_MF(kf[4], qr[2], C0),     P1[2], P1[3], P1[4], P1[5],     pw2[0] = D2_PKW(P1, 0),  pw2[1] = D2_PKW(P1, 2),  pw2); \
    D2_VRD(1, 1); SBAR(); D2_GAPA(C1 = D2_MF(kf[5], qr[2], C1),     P1[6], P1[7], P1[8], P1[9],     pw2[2] = D2_PKW(P1, 4),  pw2[3] = D2_PKW(P1, 6),  pw2); \
    D2_VRD(2, 2); SBAR(); D2_GAPA(C0 = D2_MF(kf[6], qr[3], C0),     P1[10], P1[11], P1[12], P1[13], pw3[0] = D2_PKW(P1, 8),  pw3[1] = D2_PKW(P1, 10), pw3); \
    D2_VRD(3, 3); SBAR(); D2_GAPA(C1 = D2_MF(kf[7], qr[3], C1),     P1[14], P1[15], 0.f, 0.f,       pw3[2] = D2_PKW(P1, 12), pw3[3] = D2_PKW(P1, 14), pw3); \
    l_reg += sacc; \
    if (GK) D2_DMA_K((t) + 3, sl_cur); if (GV) D2_DMA_V((t) + 1, sl_next);                                                  \
    if (MASK) cmask2(C0, C1, (t) - (NT - 4), qrel, hi); \
    { const float rm = D2_RM(C0, C1); resc = false;                                                                          \
      if (__builtin_expect(__any(rm > ATT_THR), 0)) { const float dl = __builtin_fmaxf(rm, 0.f); mhat += dl;                \
          D2_MOVE(C0, C1, dl); \
          const float f = __builtin_amdgcn_exp2f(-dl); l_reg *= f; if (hi == 0) wsf[r32] = f; resc = true; } } \
    SBAR(); \
    D2_GAPB(0, 0, C0, 0);   D2_VRD(0, 4);  SBAR(); D2_GAPB(1, 0, C0, 2);   D2_VRD(1, 5);  SBAR(); D2_GAPB(2, 0, C0, 4);   D2_VRD(2, 6);  SBAR(); D2_GAPB(3, 0, C0, 6);   D2_VRD(3, 7);  SBAR(); \
    D2_GAPB(4, 1, C0, 8);   D2_VRD(0, 8);  SBAR(); D2_GAPB(5, 1, C0, 10);  D2_VRD(1, 9);  SBAR(); D2_GAPB(6, 1, C0, 12);  D2_VRD(2, 10); SBAR(); D2_GAPB(7, 1, C0, 14);  D2_VRD(3, 11); SBAR(); \
    D2_GAPB(8, 2, C1, 0);   D2_VRD(0, 12); SBAR(); D2_GAPB(9, 2, C1, 2);   D2_VRD(1, 13); SBAR(); D2_GAPB(10, 2, C1, 4);  D2_VRD(2, 14); SBAR(); D2_GAPB(11, 2, C1, 6);  D2_VRD(3, 15); SBAR(); \
    D2_KRD(GL, 0); D2_GAPB(12, 3, C1, 8);  D2_KRD(GL, 1); D2_GAPB(13, 3, C1, 10); D2_KRD(GL, 2); D2_GAPB(14, 3, C1, 12); D2_KRD(GL, 3); D2_GAPB(15, 3, C1, 14); \
    } while (0)
    int t = 1;
    for (; t + 5 < NT; t += 2) {
        D2_STEP(pB0, pB1, pA0, pA1, t, false, true, true, true);     D2_WAIT_BAR(3); D2_RESC(); D2_ROT();
        D2_STEP(pA0, pA1, pB0, pB1, t + 1, false, true, true, true); D2_WAIT_BAR(3); D2_RESC(); D2_ROT();
    }
#define D2_ENDW(tt) do { if ((tt) + 3 < NT) { D2_WAIT_BAR(3); } else if ((tt) + 2 < NT) { D2_WAIT_BAR(2); } else { D2_WAIT_BAR(0); } } while (0)
    for (; t + 1 < NT; t += 2) {
        D2_STEP(pB0, pB1, pA0, pA1, t, true, (t + 3 < NT), (t + 1 < NT), (t + 1 < NT));         D2_ENDW(t);     D2_RESC(); D2_ROT();
        D2_STEP(pA0, pA1, pB0, pB1, t + 1, true, (t + 4 < NT), (t + 2 < NT), (t + 2 < NT));     D2_ENDW(t + 1); D2_RESC(); D2_ROT();
    }
    D2_STEP(pB0, pB1, pA0, pA1, NT - 1, true, false, false, false); D2_RESC();
    { float sacc = pB0[0] + pB0[1];
#pragma unroll
      for (int r = 2; r < 16; ++r) sacc += pB0[r];
#pragma unroll
      for (int r = 0; r < 16; ++r) sacc += pB1[r];
      l_reg += sacc;
      pw0 = (u32x4){D2_PKW(pB0, 0), D2_PKW(pB0, 2), D2_PKW(pB0, 4), D2_PKW(pB0, 6)}; pw1 = (u32x4){D2_PKW(pB0, 8), D2_PKW(pB0, 10), D2_PKW(pB0, 12), D2_PKW(pB0, 14)};
      pw2 = (u32x4){D2_PKW(pB1, 0), D2_PKW(pB1, 2), D2_PKW(pB1, 4), D2_PKW(pB1, 6)}; pw3 = (u32x4){D2_PKW(pB1, 8), D2_PKW(pB1, 10), D2_PKW(pB1, 12), D2_PKW(pB1, 14)};
      const lds_cptr vp_ = vp0 + 2 * sl_cur; SBAR();
#pragma unroll
      for (int i = 0; i < 4; ++i) D2_VRD(i, i);
      o[0] = D2_MF(D2_PAF(0), D2_VFR(0), o[0]); o[1] = D2_MF(D2_PAF(0), D2_VFR(1), o[1]); o[2] = D2_MF(D2_PAF(0), D2_VFR(2), o[2]); o[3] = D2_MF(D2_PAF(0), D2_VFR(3), o[3]); SBAR();
#pragma unroll
      for (int i = 0; i < 4; ++i) D2_VRD(i, i + 4);
      o[0] = D2_MF(D2_PAF(1), D2_VFR(0), o[0]); o[1] = D2_MF(D2_PAF(1), D2_VFR(1), o[1]); o[2] = D2_MF(D2_PAF(1), D2_VFR(2), o[2]); o[3] = D2_MF(D2_PAF(1), D2_VFR(3), o[3]); SBAR();
#pragma unroll
      for (int i = 0; i < 4; ++i) D2_VRD(i, i + 8);
      o[0] = D2_MF(D2_PAF(2), D2_VFR(0), o[0]); o[1] = D2_MF(D2_PAF(2), D2_VFR(1), o[1]); o[2] = D2_MF(D2_PAF(2), D2_VFR(2), o[2]); o[3] = D2_MF(D2_PAF(2), D2_VFR(3), o[3]); SBAR();
#pragma unroll
      for (int i = 0; i < 4; ++i) D2_VRD(i, i + 12);
      o[0] = D2_MF(D2_PAF(3), D2_VFR(0), o[0]); o[1] = D2_MF(D2_PAF(3), D2_VFR(1), o[1]); o[2] = D2_MF(D2_PAF(3), D2_VFR(2), o[2]); o[3] = D2_MF(D2_PAF(3), D2_VFR(3), o[3]); }
#undef D2_DMA_K
#undef D2_DMA_V
#undef D2_ROT
#undef D2_EX
#undef D2_C0
#undef D2_RM
#undef D2_MOVE
#undef D2_RESC
#undef D2_PKW
#undef D2_PAF
#undef D2_VFR
#undef D2_VRD
#undef D2_KRD
#undef D2_ENDW
#undef D2_GAPA
#undef D2_GAPB
#undef D2_STEP
    { auto rr = __builtin_amdgcn_permlane32_swap(__float_as_uint(l_reg), __float_as_uint(l_reg), false, false); l_reg = __uint_as_float(rr[0]) + __uint_as_float(rr[1]); }
    ALAS float* li_l = wsf + 32;
    if (hi == 0) li_l[r32] = l_reg; asm volatile("s_waitcnt lgkmcnt(0)" ::: "memory");
    float rli[16];
#pragma unroll
    for (int r = 0; r < 16; ++r) rli[r] = __builtin_amdgcn_rcpf(li_l[crow(r, hi)]);
    if constexpr (!SECOND) {
        float* Sw = S1 + (size_t)R0 * OP; const unsigned ooff = (unsigned)(4 * hi * OP + r32);
#pragma unroll
        for (int r = 0; r < 16; ++r) { float* rowp = Sw + (size_t)((r & 3) + 8 * (r >> 2)) * OP;
#pragma unroll
            for (int d0 = 0; d0 < 4; ++d0) rowp[ooff + d0 * 32] = o[d0][r] * rli[r]; }
    } else {
        const float* Sw = S1 + (size_t)R0 * OP; const unsigned ooff = (unsigned)(4 * hi * OP + r32), ooff8 = (unsigned)(4 * hi * OBP + r32);
        float gn[4];
#pragma unroll
        for (int d0 = 0; d0 < 4; ++d0) gn[d0] = gsub[d0 * 32 + r32] * gmul;
#pragma unroll
        for (int r = 0; r < 16; ++r) { const float* srow = Sw + (size_t)((r & 3) + 8 * (r >> 2)) * OP; float d[4]; float ss = 0.f;
            unsigned char* orowp = (unsigned char*)Og + (size_t)(R0 + (r & 3) + 8 * (r >> 2)) * OBP;
#pragma unroll
            for (int d0 = 0; d0 < 4; ++d0) { d[d0] = srow[ooff + d0 * 32] - lam * (o[d0][r] * rli[r]); ss += d[d0] * d[d0]; }
            ss += __builtin_bit_cast(float, __builtin_amdgcn_update_dpp(0, __builtin_bit_cast(int, ss), 0xB1, 0xf, 0xf, true));
            ss += __builtin_bit_cast(float, __builtin_amdgcn_update_dpp(0, __builtin_bit_cast(int, ss), 0x4E, 0xf, 0xf, true));
            ss += __builtin_bit_cast(float, __builtin_amdgcn_update_dpp(0, __builtin_bit_cast(int, ss), 0x141, 0xf, 0xf, true));
            ss += __builtin_bit_cast(float, __builtin_amdgcn_update_dpp(0, __builtin_bit_cast(int, ss), 0x140, 0xf, 0xf, true));
            { auto rr = __builtin_amdgcn_permlane16_swap(__float_as_uint(ss), __float_as_uint(ss), false, false); ss = __uint_as_float(rr[0]) + __uint_as_float(rr[1]); }
            const float rs = __builtin_amdgcn_rsqf(ss * (1.f / 128.f) + 1e-5f);
#pragma unroll
            for (int d0 = 0; d0 < 4; ++d0) { const unsigned w = quad_pack_fp8(d[d0] * rs * gn[d0] * OB8_SCALE);
                if ((r32 & 3) == 0) *(unsigned*)(orowp + (ooff8 + d0 * 32)) = w; }
            if ((r & 1) == 1) asm volatile("" ::: "memory"); }
    }
    asm volatile("s_waitcnt lgkmcnt(0)\n\ts_barrier" ::: "memory");
}
#undef D2_WAIT_BAR
#undef D2_PIN
#undef D2_MF
#undef D2_MX3
#undef D2_Z16
#undef SBAR
}

#define LAS __attribute__((address_space(3)))

#define XB_TMO      128
#define XB_XCNT(j)  (256  + 64 * (j))
#define XB_XSUB(j)  (1280 + 64 * (j))
#define XB_XGEN(j)  (2304 + 64 * (j))
#define XB_TOP      3328
#define XB_TOPGEN   3392
#define XCD_BAR_WORDS 3456
#define XB_SPIN_CAP (1u << 18)

__device__ __forceinline__ unsigned xb_ld(unsigned* p)              { return __hip_atomic_load(p, __ATOMIC_RELAXED, __HIP_MEMORY_SCOPE_AGENT); }
__device__ __forceinline__ unsigned xb_add(unsigned* p, unsigned v) { return __hip_atomic_fetch_add(p, v, __ATOMIC_RELAXED, __HIP_MEMORY_SCOPE_AGENT); }
__device__ __forceinline__ unsigned xb_xcc_id() { return (unsigned)__builtin_amdgcn_s_getreg((3 << 11) | 20) & 0xFu; }
#define XB_SPIN(cond, bar) do { unsigned _sp = 0; while (cond) { __builtin_amdgcn_s_sleep(1); \
    if ((++_sp & 255u) == 0u) { if (xb_ld(&(bar)[XB_TMO])) break; if (_sp > XB_SPIN_CAP) { atomicAdd(&(bar)[XB_TMO], 1u); break; } } } } while (0)

struct XcdBarrier {
    unsigned* bar; unsigned x;
    volatile LAS unsigned* st;
};

__device__ __forceinline__ XcdBarrier xcd_barrier_post(unsigned* bar, volatile LAS unsigned* st, bool thread0) {
    XcdBarrier b; b.bar = bar; b.x = xb_xcc_id(); b.st = st;
    if (thread0) (void)xb_add(&bar[XB_XCNT(b.x)], 1u);
    return b;
}
__device__ __forceinline__ void xcd_barrier_complete(unsigned* bar, unsigned x, unsigned& nloc, unsigned& nx) {
    const unsigned G = gridDim.x * gridDim.y * gridDim.z;
    unsigned sum, cnt, mine, sp = 0u;
    for (;;) {
        sum = 0u; cnt = 0u; mine = 0u;
#pragma unroll
        for (unsigned j = 0; j < 16; ++j) { const unsigned c = xb_ld(&bar[XB_XCNT(j)]); sum += c; cnt += (c > 0u) ? 1u : 0u; mine = (j == x) ? c : mine; }
        if (sum == G) break;
        __builtin_amdgcn_s_sleep(1);
        if ((++sp & 255u) == 0u) { if (xb_ld(&bar[XB_TMO])) break; if (sp > XB_SPIN_CAP) { atomicAdd(&bar[XB_TMO], 1u); break; } }
    }
    nloc = mine > 0u ? mine : 1u; nx = cnt > 0u ? cnt : 1u;
}

__device__ __forceinline__ void xcd_barrier(const XcdBarrier& b, bool thread0) {
    asm volatile("s_waitcnt vmcnt(0)" ::: "memory");
    __syncthreads();
    if (thread0) {
        unsigned* bar = b.bar;
        __builtin_amdgcn_s_waitcnt(0);
        unsigned nloc = b.st[0], nx = b.st[1];
        if (nloc == 0u) { xcd_barrier_complete(bar, b.x, nloc, nx); b.st[0] = nloc; b.st[1] = nx; }
        const unsigned old = xb_add(&bar[XB_XSUB(b.x)], 1u);
        const unsigned gen = old / nloc;
        if (old + 1u == (gen + 1u) * nloc) {
            __builtin_amdgcn_fence(__ATOMIC_RELEASE, "agent");
            asm volatile("s_waitcnt vmcnt(0)" ::: "memory");
            const unsigned og = xb_add(&bar[XB_TOP], 1u);
            const unsigned tg = og / nx;
            if (og + 1u == (tg + 1u) * nx) xb_add(&bar[XB_TOPGEN], 1u);
            else XB_SPIN(xb_ld(&bar[XB_TOPGEN]) == tg, bar);
            __builtin_amdgcn_fence(__ATOMIC_ACQUIRE, "agent");
            xb_add(&bar[XB_XGEN(b.x)], 1u);
            asm volatile("s_waitcnt vmcnt(0)" ::: "memory");
        } else {
            XB_SPIN(xb_ld(&bar[XB_XGEN(b.x)]) == gen, bar);
            __builtin_amdgcn_fence(__ATOMIC_ACQUIRE, "agent");
            asm volatile("s_waitcnt vmcnt(0)" ::: "memory");
        }
    }
    __syncthreads();
}

constexpr int NWAVES = 8;
constexpr int NTOK = 16384, DM = 2048, SEQ = 2048, NHEAD = 16, NLAYER = 4, NEXP = 16, DEXP = 1024;
constexpr int XS_ROWS = 36864;
constexpr float LN_EPS = 1e-5f;
constexpr float DN_ALPHA = 1.6817928305074292f;
constexpr float LOG2E = 1.4426950408889634f;
constexpr float SB_QSCALE = 0.08838834764831845f * LOG2E;
constexpr float DF_QSCALE = 0.125f * LOG2E;
#ifndef MK_MULTI
#define MK_MULTI 0
#endif
#ifndef MOE_F8
#define MOE_F8 1
#endif
#ifndef QKV8_A
#define QKV8_A 1
#endif
#ifndef QKV8_B
#define QKV8_B 0
#endif
#ifndef DF_RING
#define DF_RING 1
#endif
constexpr int NSTEPS = 1 + 8 * NLAYER;

constexpr size_t MiB = 1u << 20;
constexpr size_t WS_CTL = 0, CTL_ZERO_BYTES = 256 * 1024;
constexpr size_t WS_COS = 1 * MiB, WS_SIN = WS_COS + 256 * 1024;
constexpr size_t WS_WR = 2 * MiB;
constexpr size_t WS_CNT = 3 * MiB;
constexpr size_t WS_RE = WS_CNT + 64 * 1024;
constexpr size_t WS_RW = WS_RE + 64 * 1024;
constexpr size_t WS_RP = WS_RW + 128 * 1024;
constexpr int LDH = 2048;
constexpr int P8K2 = 2048, P8K1 = 1024;
constexpr size_t WS_WQKVA = 4 * MiB;
constexpr size_t WS_WOA = WS_WQKVA + 56 * MiB;
constexpr size_t WS_WQKVB = WS_WOA + 16 * MiB;
constexpr size_t WS_WOB = WS_WQKVB + 36 * MiB;
constexpr size_t WS_WGU = WS_WOB + 16 * MiB;
constexpr size_t WS_WDN = WS_WGU + 512 * MiB;
constexpr size_t WS_H = WS_WDN + 256 * MiB;
constexpr size_t WS_HB = WS_H + 128 * MiB;
constexpr size_t WS_QKV = WS_HB + 68 * MiB;
constexpr size_t WS_OB = WS_QKV + 192 * MiB;
constexpr size_t WS_XS = WS_OB + 64 * MiB;
constexpr size_t WS_ACT = WS_XS + 144 * MiB;
constexpr size_t WS_YD = WS_ACT + 72 * MiB;
constexpr size_t WS_END = WS_YD + 144 * MiB;
static_assert(WS_END <= (size_t)2040 * MiB, "workspace map");
static_assert((size_t)2 * 6144 * LDH * 2 <= 56 * MiB && (size_t)8192 * LDH * 2 <= 36 * MiB && (size_t)2 * 2048 * P8K2 <= 16 * MiB && (size_t)64 * 2048 * P8K2 <= 512 * MiB && (size_t)64 * 2048 * P8K1 <= 256 * MiB, "weight regions");
static_assert((size_t)NTOK * LDH * 2 <= 68 * MiB && (size_t)NTOK * P8K2 <= 64 * MiB && (size_t)XS_ROWS * P8K2 <= 144 * MiB && (size_t)XS_ROWS * P8K1 <= 72 * MiB, "activation regions");
constexpr int CW_MTC = 8192;
constexpr int CW_BAR = 1024;
constexpr int LDS_BYTES = 163840;
constexpr int WCOL_OFF = 147456;
constexpr int LDSCTL_OFF = 145408;
constexpr int RING_OFF = 0;
constexpr int LNX_OFF = 131072;

#define GAS __attribute__((address_space(1)))
typedef unsigned short bf16;
typedef unsigned v4u __attribute__((ext_vector_type(4)));
typedef unsigned v2u __attribute__((ext_vector_type(2)));
typedef float f32x4 __attribute__((ext_vector_type(4)));
typedef float f32x2 __attribute__((ext_vector_type(2)));
typedef _Float16 f16x4 __attribute__((ext_vector_type(4)));
__device__ __forceinline__ f32x4 ldh4(const _Float16* p) { return __builtin_convertvector(*(const f16x4*)p, f32x4); }
__device__ __forceinline__ void sth4(_Float16* p, f32x4 v) { __builtin_nontemporal_store(__builtin_convertvector(v, f16x4), (f16x4*)p); }
#define LDS_WAIT() asm volatile("s_waitcnt lgkmcnt(0)" ::: "memory")
#define VM_WAIT() asm volatile("s_waitcnt vmcnt(0)" ::: "memory")
__device__ __forceinline__ unsigned pk2(float lo, float hi) { unsigned r; asm volatile("v_cvt_pk_bf16_f32 %0, %1, %2" : "=v"(r) : "v"(lo), "v"(hi)); return r; }
__device__ __forceinline__ int opq_tid(int wave) { int t = tid_from_wave(wave); asm volatile("" : "+v"(t)); return t; }
__device__ __forceinline__ float dpp_sum(float v) {
    v += __builtin_bit_cast(float, __builtin_amdgcn_update_dpp(0, __builtin_bit_cast(int, v), 0xB1, 0xf, 0xf, true));
    v += __builtin_bit_cast(float, __builtin_amdgcn_update_dpp(0, __builtin_bit_cast(int, v), 0x4E, 0xf, 0xf, true));
    v += __builtin_bit_cast(float, __builtin_amdgcn_update_dpp(0, __builtin_bit_cast(int, v), 0x141, 0xf, 0xf, true));
    v += __builtin_bit_cast(float, __builtin_amdgcn_update_dpp(0, __builtin_bit_cast(int, v), 0x140, 0xf, 0xf, true));
    const int b = __builtin_bit_cast(int, v);
    const float s0 = __builtin_bit_cast(float, __builtin_amdgcn_readlane(b, 0)), s1 = __builtin_bit_cast(float, __builtin_amdgcn_readlane(b, 16));
    const float s2 = __builtin_bit_cast(float, __builtin_amdgcn_readlane(b, 32)), s3 = __builtin_bit_cast(float, __builtin_amdgcn_readlane(b, 48));
    return (s0 + s1) + (s2 + s3);
}
__device__ __forceinline__ float wave_sum(float v) {
#pragma unroll
    for (int o = 1; o < 64; o <<= 1) v += __shfl_xor(v, o);
    return v;
}

struct Args { const float* in[17]; float* out; unsigned char* ws; int s_lo, s_hi; };

__device__ __forceinline__ int map_row(int n, int mode) {
    if (mode == 0) return n;
    if (mode == 1) { const int c = n & 255, blk = c >> 6, d = c & 63; return (n & ~255) + ((d >> 5) << 7) + (blk << 5) + (d & 31); }
    return ((n >> 7) << 8) + (n & 127) + (mode == 3 ? 128 : 0);
}
__device__ __forceinline__ unsigned pk2h(float lo, float hi) { typedef _Float16 h2 __attribute__((ext_vector_type(2))); const f32x2 v = {lo, hi}; return __builtin_bit_cast(unsigned, __builtin_convertvector(v, h2)); }
__device__ __forceinline__ void cvt_load(f32x4 (&v)[16], const float* __restrict__ src, int pitch, int k0, int n0, int kind, int lane) {
    if (kind == 2) { const int kr = lane >> 3, n4 = (lane & 7) * 4; const float* p = src + (size_t)(k0 + kr) * pitch + n0 + n4;
#pragma unroll
        for (int i = 0; i < 16; ++i) v[i] = __builtin_nontemporal_load((const f32x4*)(p + (size_t)(8 * i) * pitch)); }
    else { const int kr = lane >> 4, n4 = (lane & 15) * 4; const float* p = src + (size_t)(k0 + kr) * pitch + n0 + n4;
#pragma unroll
        for (int i = 0; i < 16; ++i) v[i] = __builtin_nontemporal_load((const f32x4*)(p + (size_t)(4 * i) * pitch)); }
}
__device__ __forceinline__ void cvt_store(const f32x4 (&v)[16], unsigned char* __restrict__ dst, int dp, int mode, int k0, int n0, int kind, LAS float* scr, int lane) {
    if (kind == 2) {
        const int kr = lane >> 3, n4 = (lane & 7) * 4;
#pragma unroll
        for (int i = 0; i < 16; ++i) { LAS float* s = scr + (8 * i + kr) * 33 + n4; s[0] = v[i][0] * pg8::W8_SCALE; s[1] = v[i][1] * pg8::W8_SCALE; s[2] = v[i][2] * pg8::W8_SCALE; s[3] = v[i][3] * pg8::W8_SCALE; }
        LDS_WAIT();
        const int c = lane & 7;
#pragma unroll
        for (int j = 0; j < 4; ++j) { const int nl = (lane >> 3) + 8 * j; const int row = map_row(n0 + nl, mode);
            const LAS float* s = scr + (16 * c) * 33 + nl;
            v4u o; o.x = pg8::pack4_fp8(s[0], s[33], s[66], s[99]); o.y = pg8::pack4_fp8(s[132], s[165], s[198], s[231]);
            o.z = pg8::pack4_fp8(s[264], s[297], s[330], s[363]); o.w = pg8::pack4_fp8(s[396], s[429], s[462], s[495]);
            __builtin_nontemporal_store(o, (v4u*)(dst + (size_t)row * dp + k0 + 16 * c)); }
    } else {
        const int kr = lane >> 4, n4 = (lane & 15) * 4;
#pragma unroll
        for (int i = 0; i < 16; ++i) { LAS float* s = scr + (4 * i + kr) * 65 + n4; s[0] = v[i][0]; s[1] = v[i][1]; s[2] = v[i][2]; s[3] = v[i][3]; }
        LDS_WAIT();
        const int c = lane & 7;
#pragma unroll
        for (int j = 0; j < 8; ++j) { const int nl = (lane >> 3) + 8 * j; const int row = map_row(n0 + nl, mode);
            const LAS float* s = scr + (8 * c) * 65 + nl;
            v4u o; o.x = pk2h(s[0], s[65]); o.y = pk2h(s[130], s[195]); o.z = pk2h(s[260], s[325]); o.w = pk2h(s[390], s[455]);
            __builtin_nontemporal_store(o, (v4u*)(dst + (size_t)row * dp + (k0 + 8 * c) * 2)); }
    }
    LDS_WAIT();
}

__global__ void __launch_bounds__(NWAVES * 64, 2) yoco_fwd(Args args) {
    extern __shared__ __attribute__((aligned(16))) unsigned char lds_raw[];
    LAS unsigned char* const lds = (LAS unsigned char*)lds_raw;
    const int tid = threadIdx.x, lane = tid & 63, wave = __builtin_amdgcn_readfirstlane(tid >> 6);
    const int G = gridDim.x, bx = blockIdx.x;
    const int vcu = (G % 8 == 0) ? (bx % 8) * (G / 8) + bx / 8 : bx;
    unsigned char* const ws = args.ws;
    volatile LAS unsigned* const CTL = (volatile LAS unsigned*)(lds + LDSCTL_OFF);
    LAS int* const TAB = (LAS int*)(lds + LDSCTL_OFF + 64);
    for (int u = tid; u < (LDS_BYTES - LDSCTL_OFF) / 4; u += NWAVES * 64) ((LAS unsigned*)(lds + LDSCTL_OFF))[u] = 0u;
    __syncthreads();
    const int s_lo = args.s_lo, s_hi = args.s_hi;
    XcdBarrier bar; bar.bar = (unsigned*)(ws + WS_CTL) + CW_BAR; bar.x = 0; bar.st = nullptr;
    if (s_hi - s_lo > 1) bar = xcd_barrier_post((unsigned*)(ws + WS_CTL) + CW_BAR, CTL, tid == 0);
#ifndef PH_MASK
#define PH_MASK 0xFFFF
#endif
#define PHM(b) (((PH_MASK) >> (b)) & 1)
#ifndef PROBE_DUP
#define PROBE_DUP 0
#endif
#define PREP(b) _Pragma("unroll 1") for (int rep_ = 0; rep_ < ((((PROBE_DUP) >> (b)) & 1) ? 2 : 1); ++rep_) if ((rep_ == 1 && ((PROBE_DUP >> 12) & 1)) ? (xcd_barrier(bar, tid_from_wave(wave) == 0), true) : true)
#define IN(k) (s_lo <= (k) && (k) < s_hi)
#define SEAM(k) do { if ((k) + 1 < s_hi) xcd_barrier(bar, tid_from_wave(wave) == 0); } while (0)

    const float* const x_in = args.in[0];
    _Float16* const H = (_Float16*)(ws + WS_H); unsigned char* const HB8 = (unsigned char*)(ws + WS_OB + 32 * MiB);     bf16* const QKV = (bf16*)(ws + WS_QKV); bf16* const OB = (bf16*)(ws + WS_OB);
    bf16* const MIX = (bf16*)(ws + WS_YD);     bf16* const XS = (bf16*)(ws + WS_XS); float* const S1 = (float*)(ws + WS_XS); bf16* const ACT = (bf16*)(ws + WS_ACT); bf16* const YD = (bf16*)(ws + WS_YD);
    float* const WR = (float*)(ws + WS_WR);
    int* const CNT = (int*)(ws + WS_CNT); unsigned* const RE = (unsigned*)(ws + WS_RE); f32x2* const RW = (f32x2*)(ws + WS_RW); int* const RP = (int*)(ws + WS_RP);

    if (IN(0) && PHM(0)) { PREP(0) {
        const int tid = opq_tid(wave), lane = tid & 63;
        LAS float* scr = (LAS float*)(lds + RING_OFF + wave * 16896);
        const int gw = vcu * NWAVES + wave, NGW = G * NWAVES;
        constexpr int I0 = 2 * 3072, I1 = 8 * 1024, I2 = 128 * 512, I3 = 64 * 512, NITEMS = I0 + I1 + I2 + I3;
        static_assert(QKV8_A == 1 && QKV8_B == 0, "conversion table below: stick-breaking q|k|v and all other fp8 GEMM weights -> e4m3, differential q|k|v weights -> fp16");
#define CVT_DECODE(it_, SRC, PIT, DST, DP, MODE, K0, N0, KIND) do { int r = (it_); \
            if (r < I0) { const int job = r / 3072; r -= job * 3072; const int kb = r / 192, nb = r - kb * 192; \
                SRC = args.in[1] + (size_t)job * 2048 * 6144; PIT = 6144; DST = ws + WS_WQKVA + (size_t)job * 6144 * 2048; DP = 2048; MODE = 0; K0 = kb * 128; N0 = nb * 32; KIND = 2; break; } \
            r -= I0; \
            if (r < I1) { const int job = r >> 10; r &= 1023; const int r1_ = r; K0 = (r >> 6) * 128; N0 = (r & 63) * 32; PIT = 2048; MODE = 0; KIND = 2; DP = P8K2; \
                if (job < 2) { SRC = args.in[2] + (size_t)job * 2048 * 2048; DST = ws + WS_WOA + (size_t)job * 2048 * P8K2; } \
                else if (job >= 6) { SRC = args.in[5] + (size_t)(job - 6) * 2048 * 2048; DST = ws + WS_WOB + (size_t)(job - 6) * 2048 * P8K2; } \
                else { KIND = 1; DP = LDH * 2; K0 = (r1_ >> 5) * 64; N0 = (r1_ & 31) * 64; \
                    if (job == 2) { SRC = args.in[4]; DST = ws + WS_WQKVB; MODE = 1; } \
                    else if (job == 3) { SRC = args.in[3]; PIT = 4096; DST = ws + WS_WQKVB + (size_t)2048 * LDH * 2; MODE = 1; } \
                    else if (job == 4) { SRC = args.in[3] + 2048; PIT = 4096; DST = ws + WS_WQKVB + (size_t)4096 * LDH * 2; } \
                    else { SRC = args.in[4] + (size_t)2048 * 2048; DST = ws + WS_WQKVB + (size_t)6144 * LDH * 2; MODE = 1; } } \
                break; } \
            r -= I1; \
            if (r < I2) { const int job = r >> 9; r &= 511; const int le = job >> 1, up = job & 1;     \
                SRC = (up ? args.in[15] : args.in[14]) + (size_t)le * 2048 * 1024; PIT = 1024; DST = ws + WS_WGU + (size_t)le * 2048 * P8K2; DP = P8K2; MODE = 2 + up; K0 = (r >> 5) * 128; N0 = (r & 31) * 32; KIND = 2; break; } \
            r -= I2; \
            { const int le = r >> 9; r &= 511; SRC = args.in[16] + (size_t)le * 1024 * 2048; PIT = 2048; DST = ws + WS_WDN + (size_t)le * 2048 * P8K1; DP = P8K1; MODE = 0; K0 = (r >> 6) * 128; N0 = (r & 63) * 32; KIND = 2; } \
        } while (0)
        { const float* sA; const float* sB; unsigned char* dA; unsigned char* dB; int pA, pB, qA, qB, mA, mB, kA, kB, nA, nB, tA, tB; f32x4 va[16], vb[16];
          int it = gw;
          if (it < NITEMS) { CVT_DECODE(it, sA, pA, dA, qA, mA, kA, nA, tA); cvt_load(va, sA, pA, kA, nA, tA, lane);
            for (;;) {
                if (it + NGW < NITEMS) { CVT_DECODE(it + NGW, sB, pB, dB, qB, mB, kB, nB, tB); cvt_load(vb, sB, pB, kB, nB, tB, lane); }
                cvt_store(va, dA, qA, mA, kA, nA, tA, scr, lane); it += NGW; if (it >= NITEMS) break;
                if (it + NGW < NITEMS) { CVT_DECODE(it + NGW, sA, pA, dA, qA, mA, kA, nA, tA); cvt_load(va, sA, pA, kA, nA, tA, lane); }
                cvt_store(vb, dB, qB, mB, kB, nB, tB, scr, lane); it += NGW; if (it >= NITEMS) break;
            } } }
#undef CVT_DECODE
        for (size_t i = (size_t)gw * 64 + lane; i < (size_t)NTOK * DM / 4; i += (size_t)NGW * 64) {
            const f32x4 v = ((const f32x4*)x_in)[i];
            ((unsigned*)HB8)[i] = pg8::pack4_fp8(v[0], v[1], v[2], v[3]); }
        for (int i = bx * (NWAVES * 64) + tid; i < NLAYER * 20 * 2048; i += G * NWAVES * 64) { const int k = i & 2047, c = (i >> 11) % 20, l = i / (20 * 2048);
            WR[i] = c < 4 ? args.in[12][((size_t)l * 2048 + k) * 4 + c] : args.in[13][(((size_t)l * 4 + ((c - 4) >> 2)) * 2048 + k) * 4 + ((c - 4) & 3)]; }
        }
        SEAM(0);
    }

    for (int L = 0; L < NLAYER; ++L) {
        const int sb = 1 + 8 * L; const bool typeA = L < 2;
        if (IN(sb + 0)) {
            if (typeA && PHM(1)) { PREP(1) {
                pg8::StaticOrder S; S.init(NTOK, 6144, G, bx);
                if (QKV8_A) { pg8::Gemm g{(const bf16*)HB8, (const bf16*)(ws + WS_WQKVA + (size_t)L * 6144 * 2048), NTOK, 6144, DM / 2, DM / 2, wave}; pg8::EpiQkv E{QKV, 6144, 2048, SB_QSCALE, 1.f / pg8::W8_UNDO};
                    pg8::gemm_phase<pg8::EpiQkv, pg8::StaticOrder, true, true, true>(lds + RING_OFF, g, S, E); }
                } static_assert(QKV8_A == 1, "the stick-breaking layers' q|k|v GEMM takes the e4m3 copy of the stream");
            } else if (!typeA && PHM(2)) { PREP(2) {
                const int N = (L == 2) ? 6144 : 2048;
                pg8::StaticOrder S; S.init(NTOK, N, G, bx);
                if (QKV8_B) { pg8::Gemm g{(const bf16*)HB8, (const bf16*)(ws + WS_WQKVB + (L == 2 ? (size_t)0 : (size_t)6144 * 2048)), NTOK, N, DM / 2, DM / 2, wave};
                    pg8::EpiRope E{QKV, 6144, 2048, 4096, DF_QSCALE, 1.f / pg8::W8_UNDO};
                    pg8::gemm_phase<pg8::EpiRope, pg8::StaticOrder, true, true, true>(lds + RING_OFF, g, S, E); }
                else { pg8::Gemm g{(const bf16*)H, (const bf16*)(ws + WS_WQKVB) + (L == 2 ? (size_t)0 : (size_t)6144 * LDH), NTOK, N, DM, LDH, wave};
                    pg8::EpiRope E{QKV, 6144, 2048, 4096, DF_QSCALE, 1.f};
                    pg8::gemm_phase<pg8::EpiRope, pg8::StaticOrder, true, true, false, true>(lds + RING_OFF, g, S, E); } }
            }
            SEAM(sb + 0);
        }
        if (IN(sb + 1)) {
            if (typeA && PHM(3)) {
                for (int id_ = vcu; id_ < 512 * (1 + ((PROBE_DUP >> 3) & 1)); id_ += G) { if (((PROBE_DUP >> 12) & 1) && id_ >= 512 && id_ < 512 + G) xcd_barrier(bar, tid_from_wave(wave) == 0); const int id = id_ & 511; const int bh = id >> 2, p = id & 3, b = bh >> 4, h = bh & 15;
                    const bf16* Qg = QKV + (size_t)b * SEQ * 6144 + h * 128; bf16* Og = (bf16*)((unsigned char*)OB + (size_t)b * SEQ * P8K2 + h * 128);
                    att::sb_block(Qg, Qg + 2048, Qg + 4096, Og, 7 - p, (att::ldsp)(lds + RING_OFF), wave);
                    att::sb_block(Qg, Qg + 2048, Qg + 4096, Og, p, (att::ldsp)(lds + RING_OFF), wave); }
            } else if (!typeA && PHM(4)) {
                const int lane = opq_tid(wave) & 63;
                const int i = L - 2; const float lam_init = (L == 2) ? 0.47071301834264183f : 0.5560582041556061f;
                const float* lp = args.in[6] + (size_t)i * 256;
                const float sa = dpp_sum(lp[lane] * lp[64 + lane]), sb2 = dpp_sum(lp[128 + lane] * lp[192 + lane]);
                const float lam = __builtin_amdgcn_exp2f(sa * LOG2E) - __builtin_amdgcn_exp2f(sb2 * LOG2E) + lam_init;
                const float* gsub = args.in[7] + (size_t)i * 128; const float gmul = 1.f - lam_init;
                for (int id_ = vcu; id_ < 512 * (1 + ((PROBE_DUP >> 4) & 1)); id_ += G) { if (((PROBE_DUP >> 12) & 1) && id_ >= 512 && id_ < 512 + G) xcd_barrier(bar, tid_from_wave(wave) == 0); const int id = id_ & 511; const int bh = id >> 2, p = id & 3, b = bh >> 4, h = bh & 15;
                    const bf16* Qg = QKV + (size_t)b * SEQ * 6144 + h * 128; bf16* Og = (bf16*)((unsigned char*)OB + (size_t)b * SEQ * P8K2 + h * 128); float* Sg = S1 + (size_t)b * SEQ * DM + h * 128;
#pragma unroll 1
                    for (int w = 0; w < 2; ++w) { const int qb = w ? p : 7 - p;
#if DF_RING
                        att::diff_pass2<false>(Qg, Qg + 2048, Qg + 4096, Sg, Og, qb, lam, gsub, gmul, (att::ldsp)(lds + RING_OFF), wave);
                        att::diff_pass2<true>(Qg + 64, Qg + 2048 + 64, Qg + 4096, Sg, Og, qb, lam, gsub, gmul, (att::ldsp)(lds + RING_OFF), wave); } }
#else
                        att::diff_pass<false>(Qg, Qg + 2048, Qg + 4096, Sg, Og, qb, lam, gsub, gmul, (att::ldsp)(lds + RING_OFF), wave);
                        att::diff_pass<true>(Qg + 64, Qg + 2048 + 64, Qg + 4096, Sg, Og, qb, lam, gsub, gmul, (att::ldsp)(lds + RING_OFF), wave); } }
#endif
            }
            SEAM(sb + 1);
        }
        if (IN(sb + 2)) { if (PHM(5)) {
            pg8::Gemm g{OB, (const bf16*)(ws + (typeA ? WS_WOA : WS_WOB) + (size_t)(L & 1) * 2048 * P8K2), NTOK, DM, DM / 2, P8K2 / 2, wave}; pg8::StaticOrder S; S.init(NTOK, DM, G, bx);
            pg8::EpiQkv E{MIX, DM, 0, 1.f, 1.f / (pg8::W8_UNDO * att::OB8_SCALE)};
            pg8::gemm_phase<pg8::EpiQkv, pg8::StaticOrder, true, true, true>(lds + RING_OFF, g, S, E); }
            SEAM(sb + 2);
        }
        if (IN(sb + 3)) { if (PHM(6)) {
            const int tid = opq_tid(wave), lane = tid & 63;
            const float* lng = args.in[8] + (size_t)L * DM; const float* lnb = args.in[9] + (size_t)L * DM; const float* wr = WR + (size_t)L * 20 * 2048;
            LAS int* eid = (LAS int*)(lds + LNX_OFF + 2048);
            LAS float* lgt = (LAS float*)(lds + LNX_OFF + 4096);
            LAS unsigned* rows8 = (LAS unsigned*)(lds + RING_OFF);
            for (int c = bx; c < 256; c += G) {
                const unsigned wcl = (unsigned)(uintptr_t)(lds + WCOL_OFF) + (unsigned)wave * 1024u; const unsigned wvo = (unsigned)(wave * 256 + lane * 4) * 4u;
#define LN1_DMAW(col, buf) att::glds16s(wvo, wr + (size_t)(col) * 2048, (unsigned)__builtin_amdgcn_readfirstlane(wcl + (unsigned)(buf) * 8192u))
                LN1_DMAW(0, 0); LN1_DMAW(1, 1);
#pragma unroll 1
                for (int grp = 0; grp < 2; ++grp) {
                    const int rloc = wave * 8 + grp * 4; const size_t row0 = (size_t)64 * c + rloc;
                    f32x4 v[4][8]; float mu[4], rstd[4];
#pragma unroll
                    for (int rr = 0; rr < 4; ++rr) {
                        if (L == 0) { const f32x4* hp = (const f32x4*)(x_in + (row0 + rr) * DM) + lane;
#pragma unroll
                            for (int j = 0; j < 8; ++j) v[rr][j] = hp[64 * j]; }
                        else { const _Float16* hq = H + (row0 + rr) * DM + 4 * lane;
#pragma unroll
                            for (int j = 0; j < 8; ++j) v[rr][j] = ldh4(hq + 256 * j); } }
#pragma unroll
                    for (int rr = 0; rr < 4; ++rr) { const v2u* mp = (const v2u*)(MIX + (row0 + rr) * DM) + lane;
#pragma unroll
                        for (int j = 0; j < 8; ++j) { const v2u a = mp[64 * j];
                            const f32x4 fa = {__uint_as_float(a.x << 16), __uint_as_float(a.x & 0xffff0000u), __uint_as_float(a.y << 16), __uint_as_float(a.y & 0xffff0000u)};
                            v[rr][j] = v[rr][j] * DN_ALPHA + fa; } }
#pragma unroll
                    for (int rr = 0; rr < 4; ++rr) { float s = 0.f;
#pragma unroll
                        for (int j = 0; j < 8; ++j) s += (v[rr][j][0] + v[rr][j][1]) + (v[rr][j][2] + v[rr][j][3]);
                        mu[rr] = dpp_sum(s) * (1.f / DM); float q = 0.f;
#pragma unroll
                        for (int j = 0; j < 8; ++j) { const f32x4 d = v[rr][j] - mu[rr]; q += (d[0] * d[0] + d[1] * d[1]) + (d[2] * d[2] + d[3] * d[3]); }
                        rstd[rr] = 1.f / sqrtf(dpp_sum(q) * (1.f / DM) + LN_EPS); }
#pragma unroll
                    for (int j = 0; j < 8; ++j) { const f32x4 gg = ((const f32x4*)lng)[64 * j + lane], bb = ((const f32x4*)lnb)[64 * j + lane];
#pragma unroll
                        for (int rr = 0; rr < 4; ++rr) { v[rr][j] = (v[rr][j] - mu[rr]) * rstd[rr] * gg + bb; sth4(H + (row0 + rr) * DM + 256 * j + 4 * lane, v[rr][j]);
                            if (c == bx) rows8[(rloc + rr) * 512 + 64 * j + lane] = pg8::pack4_fp8(v[rr][j][0], v[rr][j][1], v[rr][j][2], v[rr][j][3]); } }
#pragma unroll 1
                    for (int cc = 0; cc < 20; ++cc) { const int q = grp * 20 + cc, bsel = q & 1;
                        if (q + 1 < 40) asm volatile("s_waitcnt vmcnt(1)\n\ts_barrier" ::: "memory"); else asm volatile("s_waitcnt vmcnt(0)\n\ts_barrier" ::: "memory");
                        f32x4 w[8];
                        { const LAS f32x4* wp = (const LAS f32x4*)(lds + WCOL_OFF + bsel * 8192) + lane;
#pragma unroll
                          for (int j = 0; j < 8; ++j) w[j] = wp[64 * j]; }
                        asm volatile("s_waitcnt lgkmcnt(0)\n\ts_barrier" ::: "memory");
                        if (q + 2 < 40) LN1_DMAW((q + 2) % 20, bsel);
                        f32x2 a2[4] = {{0.f, 0.f}, {0.f, 0.f}, {0.f, 0.f}, {0.f, 0.f}};
#pragma unroll
                        for (int j = 0; j < 8; ++j) { const f32x2 wlo = {w[j][0], w[j][1]}, whi = {w[j][2], w[j][3]};
#pragma unroll
                            for (int rr = 0; rr < 4; ++rr) { const f32x2 vlo = {v[rr][j][0], v[rr][j][1]}, vhi = {v[rr][j][2], v[rr][j][3]};
                                a2[rr] = __builtin_elementwise_fma(vlo, wlo, a2[rr]); a2[rr] = __builtin_elementwise_fma(vhi, whi, a2[rr]); } }
                        float a[4];
#pragma unroll
                        for (int rr = 0; rr < 4; ++rr) a[rr] = dpp_sum(a2[rr][0] + a2[rr][1]);
                        if (lane == 0) {
#pragma unroll
                            for (int rr = 0; rr < 4; ++rr) lgt[(rloc + rr) * 20 + cc] = a[rr]; } }
                }
#undef LN1_DMAW
                LDS_WAIT();
                if (lane < 8) {
                    const int rl = wave * 8 + lane; const LAS float* lg = lgt + rl * 20;
                    int gsel = 0; float gm = lg[0];
#pragma unroll
                    for (int i = 1; i < 4; ++i) { const float x = lg[i]; if (x > gm) { gm = x; gsel = i; } }
                    float gden = 0.f;
#pragma unroll
                    for (int i = 0; i < 4; ++i) gden += __builtin_amdgcn_exp2f((lg[i] - gm) * LOG2E);
                    const float gw_ = 1.f / gden;
                    const LAS float* li = lg + 4 + 4 * gsel;
                    const float l0 = li[0], l1 = li[1], l2 = li[2], l3 = li[3];
                    int i0 = 0; float v0 = l0;
                    if (l1 > v0) { v0 = l1; i0 = 1; } if (l2 > v0) { v0 = l2; i0 = 2; } if (l3 > v0) { v0 = l3; i0 = 3; }
                    int i1 = -1; float v1 = 0.f;
                    if (i0 != 0) { v1 = l0; i1 = 0; }
                    if (i0 != 1 && (i1 < 0 || l1 > v1)) { v1 = l1; i1 = 1; }
                    if (i0 != 2 && (i1 < 0 || l2 > v1)) { v1 = l2; i1 = 2; }
                    if (i0 != 3 && (i1 < 0 || l3 > v1)) { v1 = l3; i1 = 3; }
                    const float t = __builtin_amdgcn_exp2f((v1 - v0) * LOG2E); const float w0 = gw_ / (1.f + t), w1 = gw_ * t / (1.f + t);
                    eid[2 * rl] = gsel * 4 + i0; eid[2 * rl + 1] = gsel * 4 + i1; RW[(size_t)64 * c + rl] = (f32x2){w0, w1};
                }
                __syncthreads();
                if (wave == 0) {
                    const int ea = eid[lane], eb = eid[64 + lane]; int ra = 0, rb = 0, cnt = 0; const unsigned long long lt = (1ull << lane) - 1ull;
#pragma unroll
                    for (int e = 0; e < 16; ++e) { const unsigned long long ma = __ballot(ea == e), mb = __ballot(eb == e);
                        if (ea == e) ra = __popcll(ma & lt); if (eb == e) rb = __popcll(ma) + __popcll(mb & lt); if (lane == e) cnt = __popcll(ma) + __popcll(mb); }
                    if (lane < 16) CNT[c * 16 + lane] = cnt;
                    LAS int* rk = (LAS int*)(lds + LNX_OFF + 3072); rk[lane] = ra; rk[64 + lane] = rb; LDS_WAIT();
                    const int r = lane; const unsigned word = (unsigned)eid[2 * r] | ((unsigned)eid[2 * r + 1] << 8) | ((unsigned)rk[2 * r] << 16) | ((unsigned)rk[2 * r + 1] << 24);
                    RE[(size_t)64 * c + r] = word;
                }
                __syncthreads();
            } }
            SEAM(sb + 3);
        }
        if ((IN(sb + 4) || IN(sb + 5) || IN(sb + 6)) && PHM(7)) {
            const int tid = opq_tid(wave);
            LAS int* part = (LAS int*)(lds + LNX_OFF);
            { const int e = tid & 15, s = tid >> 4; int a = 0;
#pragma unroll
              for (int i = 0; i < 8; ++i) a += CNT[(8 * s + i) * 16 + e];
              part[s * 16 + e] = a; }
            __syncthreads();
            if (tid < 16) { int run = 0;
#pragma clang loop vectorize(disable)
#pragma unroll 8
                for (int s = 0; s < 32; ++s) run += part[s * 16 + tid];
                TAB[tid] = run; }
            __syncthreads();
            if (tid < 192) { int off = 0, mt = 0, mine = 15;
#pragma unroll
                for (int e = 0; e < 16; ++e) { const int nt = (TAB[e] + 255) >> 8; if (tid == 0) TAB[16 + e] = off; if (tid >= mt && tid < mt + nt) mine = e; off += nt * 256; mt += nt; }
                if (tid < mt && tid < 160) TAB[64 + tid] = mine;
                if (tid == 0) { TAB[32] = off; TAB[33] = mt; } }
            __syncthreads();
        }
        if (IN(sb + 4)) { if (PHM(7)) PREP(7) {
            const int tid = opq_tid(wave), lane = tid & 63;
            LAS int* part = (LAS int*)(lds + LNX_OFF);
            for (int c = bx; c < 256; c += G) {
                if (tid < 16) { int pre = 0; int x[8];
#pragma unroll
                    for (int i = 0; i < 8; ++i) x[i] = CNT[((c & ~7) + i) * 16 + tid];
#pragma clang loop vectorize(disable) unroll(disable)
                    for (int s = 0; s < (c >> 3); ++s) pre += part[s * 16 + tid];
#pragma unroll
                    for (int i = 0; i < 8; ++i) pre += (i < (c & 7)) ? x[i] : 0;
                    TAB[48 + tid] = TAB[16 + tid] + pre; }
                __syncthreads();
#pragma unroll 1
                for (int rr = 0; rr < 8; ++rr) { const size_t row = (size_t)64 * c + wave * 8 + rr; const unsigned word = RE[row];
                    const int p0 = TAB[48 + (word & 255)] + ((word >> 16) & 255), p1 = TAB[48 + ((word >> 8) & 255)] + (word >> 24);
                    if (lane == 0) { RP[2 * row] = p0; RP[2 * row + 1] = p1; }
                    if (c == bx && IN(sb + 3)) {
                        const LAS v4u* src = (const LAS v4u*)(lds + RING_OFF + (wave * 8 + rr) * 2048) + lane; v4u* o0 = (v4u*)((unsigned char*)XS + (size_t)p0 * P8K2) + lane; v4u* o1 = (v4u*)((unsigned char*)XS + (size_t)p1 * P8K2) + lane;
                        const v4u a = src[0], b = src[64]; __builtin_nontemporal_store(a, o0); __builtin_nontemporal_store(b, o0 + 64); __builtin_nontemporal_store(a, o1); __builtin_nontemporal_store(b, o1 + 64);
                    } else {
                        const _Float16* hq = H + row * DM + 4 * lane; unsigned* o0 = (unsigned*)((unsigned char*)XS + (size_t)p0 * P8K2) + lane; unsigned* o1 = (unsigned*)((unsigned char*)XS + (size_t)p1 * P8K2) + lane;
#pragma unroll
                        for (int j = 0; j < 8; ++j) { const f32x4 v = ldh4(hq + 256 * j); const unsigned o = pg8::pack4_fp8(v[0], v[1], v[2], v[3]); o0[64 * j] = o; o1[64 * j] = o; } } }
                __syncthreads();
            } }
            SEAM(sb + 4);
        }
        if (IN(sb + 5)) { if (PHM(8)) PREP(8) {
            pg8::Gemm g{XS, (const bf16*)(ws + WS_WGU + (size_t)L * 16 * 2048 * P8K2), XS_ROWS, 2048, DM / 2, P8K2 / 2, wave};
            pg8::MoeOrder<0> S{TAB[33] * 8, G, bx, TAB + 64, nullptr, nullptr, wave}; pg8::EpiGateUp8 E{(unsigned char*)ACT};
            pg8::gemm_phase<pg8::EpiGateUp8, pg8::MoeOrder<0>, true, true, true>(lds + RING_OFF, g, S, E); }
            SEAM(sb + 5);
        }
        if (IN(sb + 6)) { if (PHM(9)) PREP(9) {
            pg8::Gemm g{ACT, (const bf16*)(ws + WS_WDN + (size_t)L * 16 * 2048 * P8K1), XS_ROWS, 2048, DEXP / 2, P8K1 / 2, wave};
            pg8::MoeOrder<0> S{TAB[33] * 8, G, bx, TAB + 64, nullptr, nullptr, wave}; pg8::EpiDown8 E{(unsigned char*)YD};
            pg8::gemm_phase<pg8::EpiDown8, pg8::MoeOrder<0>, true, true, true>(lds + RING_OFF, g, S, E); }
            SEAM(sb + 6);
        }
        if (IN(sb + 7)) { if (PHM(10)) for (int rep_ = 0; rep_ < ((((PROBE_DUP) >> 10) & 1) && L == NLAYER - 1 ? 5 : 1); ++rep_) {
            const int tid = opq_tid(wave), lane = tid & 63;
            const float* lng = args.in[10] + (size_t)L * DM; const float* lnb = args.in[11] + (size_t)L * DM; const bool last = (L == NLAYER - 1); const bool next8 = (L + 1 < 2) ? (QKV8_A != 0) : (QKV8_B != 0);
            const int gw = vcu * NWAVES + wave, NGW = G * NWAVES;
            for (int row0 = 4 * gw; row0 < NTOK; row0 += 4 * NGW) {
                f32x4 v[4][8]; float mu[4], rstd[4];
#pragma unroll
                for (int rr = 0; rr < 4; ++rr) { const int row = row0 + rr;
                    const int p0 = RP[2 * row], p1 = RP[2 * row + 1]; const f32x2 w = RW[row];
                    const _Float16* hq = H + (size_t)row * DM + 4 * lane; const unsigned* y0 = (const unsigned*)((const unsigned char*)YD + (size_t)p0 * DM) + lane; const unsigned* y1 = (const unsigned*)((const unsigned char*)YD + (size_t)p1 * DM) + lane;
                    const float w0s = w.x * (1.f / pg8::YD8_SCALE), w1s = w.y * (1.f / pg8::YD8_SCALE);
#pragma unroll
                    for (int j = 0; j < 8; ++j) { const f32x4 h = ldh4(hq + 256 * j); const unsigned a = y0[64 * j], b = y1[64 * j];
                        const f32x2 a0 = __builtin_amdgcn_cvt_pk_f32_fp8((int)a, false), a1 = __builtin_amdgcn_cvt_pk_f32_fp8((int)a, true), b0 = __builtin_amdgcn_cvt_pk_f32_fp8((int)b, false), b1 = __builtin_amdgcn_cvt_pk_f32_fp8((int)b, true);
                        const f32x4 fa = {a0[0], a0[1], a1[0], a1[1]}, fb = {b0[0], b0[1], b1[0], b1[1]};
                        v[rr][j] = h * DN_ALPHA + fa * w0s + fb * w1s; } }
#pragma unroll
                for (int rr = 0; rr < 4; ++rr) { float s = 0.f;
#pragma unroll
                    for (int j = 0; j < 8; ++j) s += (v[rr][j][0] + v[rr][j][1]) + (v[rr][j][2] + v[rr][j][3]);
                    mu[rr] = dpp_sum(s) * (1.f / DM); float q = 0.f;
#pragma unroll
                    for (int j = 0; j < 8; ++j) { const f32x4 dd = v[rr][j] - mu[rr]; q += (dd[0] * dd[0] + dd[1] * dd[1]) + (dd[2] * dd[2] + dd[3] * dd[3]); }
                    rstd[rr] = 1.f / sqrtf(dpp_sum(q) * (1.f / DM) + LN_EPS); }
#pragma unroll
                for (int j = 0; j < 8; ++j) { const f32x4 gg = ((const f32x4*)lng)[64 * j + lane], bb = ((const f32x4*)lnb)[64 * j + lane];
#pragma unroll
                    for (int rr = 0; rr < 4; ++rr) { const int row = row0 + rr; const f32x4 y = (v[rr][j] - mu[rr]) * rstd[rr] * gg + bb;
                        if (last) __builtin_nontemporal_store(y, (f32x4*)(args.out + (size_t)row * DM) + 64 * j + lane);
                        else { sth4(H + (size_t)row * DM + 256 * j + 4 * lane, y); if (next8) __builtin_nontemporal_store(pg8::pack4_fp8(y[0], y[1], y[2], y[3]), (unsigned*)(HB8 + (size_t)row * DM) + 64 * j + lane); } } }
            } }
            SEAM(sb + 7);
        }
    }
#undef IN
#undef SEAM
}

extern "C" void kernel_launch(void* const* d_in, const int* in_sizes, int n_in, void* d_out, int out_size, void* d_ws, size_t ws_size, hipStream_t stream) {
    static int grid = 0;
    if (grid == 0) {
        if (n_in != 17 || in_sizes[0] != NTOK * DM || out_size != NTOK * DM || ws_size < WS_END) { fprintf(stderr, "kernel_launch: unexpected shapes / workspace (n_in %d, ws %zu, need %zu)\n", n_in, ws_size, (size_t)WS_END); grid = -1; return; }
        int dev = 0, cus = 0, per_cu = 0;
        if (hipGetDevice(&dev) != hipSuccess || hipDeviceGetAttribute(&cus, hipDeviceAttributeMultiprocessorCount, dev) != hipSuccess) { grid = -1; return; }
        if (hipFuncSetAttribute((const void*)yoco_fwd, hipFuncAttributeMaxDynamicSharedMemorySize, LDS_BYTES) != hipSuccess) { fprintf(stderr, "kernel_launch: hipFuncSetAttribute failed\n"); grid = -1; return; }
        if (hipOccupancyMaxActiveBlocksPerMultiprocessor(&per_cu, (const void*)yoco_fwd, NWAVES * 64, LDS_BYTES) != hipSuccess || per_cu < 1) { fprintf(stderr, "kernel_launch: occupancy query says %d\n", per_cu); per_cu = 1; }
        (void)hipGetLastError();
        grid = cus;
    }
    if (grid < 0) return;
    (void)hipMemsetAsync((char*)d_ws + WS_CTL, 0, CTL_ZERO_BYTES, stream);
    Args a{};
    for (int i = 0; i < 17; ++i) a.in[i] = (const float*)d_in[i];
    a.out = (float*)d_out; a.ws = (unsigned char*)d_ws;
#if MK_MULTI
    for (int s = 0; s < NSTEPS; ++s) { a.s_lo = s; a.s_hi = s + 1; hipLaunchKernelGGL(yoco_fwd, dim3(grid), dim3(NWAVES * 64), LDS_BYTES, stream, a); }
#else
    a.s_lo = 0; a.s_hi = NSTEPS;
    hipLaunchKernelGGL(yoco_fwd, dim3(grid), dim3(NWAVES * 64), LDS_BYTES, stream, a);
#endif
    const hipError_t le = hipPeekAtLastError();
    if (le != hipSuccess) fprintf(stderr, "kernel_launch: launch failed: %s\n", hipGetErrorName(le));
}
```

```cpp
#include <hip/hip_runtime.h>
#include <cstdio>
#include <cstdint>

__device__ __forceinline__ int tid_from_wave(int wave) { int l; asm volatile("v_mbcnt_lo_u32_b32 %0, -1, 0\n\tv_mbcnt_hi_u32_b32 %0, -1, %0" : "=v"(l)); return wave * 64 + l; }
namespace pg8 {
#define PG8_LAS __attribute__((address_space(3)))
typedef unsigned short bf16_t;
typedef short bf16x8 __attribute__((ext_vector_type(8)));
typedef float f32x4 __attribute__((ext_vector_type(4)));
typedef unsigned u32x4 __attribute__((ext_vector_type(4)));
typedef int pg8_v8i __attribute__((ext_vector_type(8)));
typedef _Float16 pg8_h8 __attribute__((ext_vector_type(8)));
constexpr int BM = 256, BK = 64, HALF = 128, HTB = HALF * BK * 2  , STAGE_BYTES = 8 * HTB, NXCD = 8, WGM = 8;

__host__ __device__ __forceinline__ int lds_byte(int r, int c) { const int st = (r >> 4) * 2 + (c >> 5), rr = r & 15, cc = c & 31, ob = rr * 64 + cc * 2; return st * 1024 + (ob ^ (((ob >> 9) & 1) << 5)); }
__host__ __device__ __forceinline__ void stage_rc(int b, int& R, int& C) { const int st = b / 1024, sb = b % 1024, swz = sb ^ (((sb >> 9) & 1) << 5); R = (st >> 1) * 16 + swz / 64; C = (st & 1) * 32 + (swz % 64) / 2; }
__host__ __device__ __forceinline__ int perm32(int rho) { const int n = rho >> 4, i = rho & 15; return 8 * (i >> 2) + 4 * n + (i & 3); }

struct Unit { int pm, pn; };
struct Gemm { const bf16_t* A; const bf16_t* Bt; int M, N, K, ld, wave; };

struct StaticOrder {
    int nM, nN, nwg, G, c;
    __host__ __device__ void init(int M, int N, int G_, int c_) { nM = M / BM; nN = N / BM; nwg = nM * nN; G = G_; c = c_; }
    __host__ __device__ bool next(int i, Unit& u) const {
        const long L = (long)i * G + c; if (L >= nwg) return false;
        int wgid = (int)L; { const int q = nwg / NXCD, r = nwg % NXCD, xcd = wgid % NXCD, off = wgid / NXCD; wgid = (xcd < r ? xcd * (q + 1) : r * (q + 1) + (xcd - r) * q) + off; }
        const int nig = WGM * nN, gid = wgid / nig, fm = gid * WGM, gsz = (nM - fm) < WGM ? (nM - fm) : WGM;
        u.pm = fm + ((wgid % nig) % gsz); u.pn = (wgid % nig) / gsz; return true;
    }
    __device__ __forceinline__ void a_ready(const Unit&) const {}
    __device__ __forceinline__ void done(const Unit&) const {}
};

__device__ __forceinline__ unsigned cvt_pk_bf16(float lo, float hi) { unsigned r; asm volatile("v_cvt_pk_bf16_f32 %0, %1, %2" : "=v"(r) : "v"(lo), "v"(hi)); return r; }
typedef float f32x2 __attribute__((ext_vector_type(2)));

typedef unsigned u32x2 __attribute__((ext_vector_type(2)));
__device__ __forceinline__ u32x4 pack8_bf16(const f32x4 a, const f32x4 b) { u32x4 w; w.x = cvt_pk_bf16(a[0], a[1]); w.y = cvt_pk_bf16(a[2], a[3]); w.z = cvt_pk_bf16(b[0], b[1]); w.w = cvt_pk_bf16(b[2], b[3]); return w; }

struct EpiQkv {
    static constexpr bool PERM = true, AFTER_DRAIN = false;
    bf16_t* O; int ldc; int qcols; float qscale; float osc;
    __device__ __forceinline__ void operator()(const f32x4 (&acc)[2][2][4][2], const Unit& u, int wr, int wc, int fr, int fq) const {
        const int row0 = u.pm * BM + wr * 64 + fr, colt = u.pn * BM; const float sc = (colt < qcols ? qscale : 1.f) * osc;
        const int col0 = colt + wc * 32 + 8 * fq;
#pragma unroll
        for (int ai = 0; ai < 2; ++ai)
#pragma unroll
            for (int m = 0; m < 4; ++m) { bf16_t* rowp = O + (size_t)(row0 + ai * HALF + m * 16) * ldc + col0;
#pragma unroll
                for (int bj = 0; bj < 2; ++bj) *(u32x4*)(rowp + bj * HALF) = pack8_bf16(acc[ai][bj][m][0] * sc, acc[ai][bj][m][1] * sc); }
    }
};
template <int ACCS_INV> struct EpiResid {
    static constexpr bool PERM = false, AFTER_DRAIN = false;
    static constexpr int ldc = 2048; static constexpr float alpha = 1.6817928305074292f, accs = 1.f / (float)ACCS_INV;
    float* H; const float* Hsrc;
    __device__ __forceinline__ void operator()(const f32x4 (&acc)[2][2][4][2], const Unit& u, int wr, int wc, int fr, int fq) const {
        const int row0 = u.pm * BM + wr * 64 + fr, col0 = u.pn * BM + wc * 32 + 4 * fq;
#pragma unroll
        for (int ai = 0; ai < 2; ++ai)
#pragma unroll
            for (int m = 0; m < 4; ++m) { const size_t ro = (size_t)(row0 + ai * HALF + m * 16) * ldc + col0; float* rowp = H + ro; const float* srcp = Hsrc + ro;
#pragma unroll
                for (int bj = 0; bj < 2; ++bj)
#pragma unroll
                    for (int n = 0; n < 2; ++n) { const f32x4 h = *(const f32x4*)(srcp + bj * HALF + n * 16); *(f32x4*)(rowp + bj * HALF + n * 16) = h * alpha + acc[ai][bj][m][n] * accs; } }
    }
};
struct EpiRope {
    static constexpr bool PERM = true, AFTER_DRAIN = false;
    bf16_t* O; int ldc; int qcols, ropecols; float qscale; float osc;
    __device__ __forceinline__ void operator()(const f32x4 (&acc)[2][2][4][2], const Unit& u, int wr, int wc, int fr, int fq) const {
        const int row0 = u.pm * BM + wr * 64 + fr, colt = u.pn * BM;
        if (colt >= ropecols) {
            const int col0 = colt + wc * 32 + 8 * fq;
#pragma unroll
            for (int ai = 0; ai < 2; ++ai)
#pragma unroll
                for (int m = 0; m < 4; ++m) { bf16_t* rowp = O + (size_t)(row0 + ai * HALF + m * 16) * ldc + col0;
#pragma unroll
                    for (int bj = 0; bj < 2; ++bj) *(u32x4*)(rowp + bj * HALF) = pack8_bf16(acc[ai][bj][m][0] * osc, acc[ai][bj][m][1] * osc); }
        } else {
            const float sc = (colt < qcols ? qscale : 1.f) * osc;
            const int col0 = colt + wc * 64 + 8 * fq;
            float ir[8];
#pragma unroll
            for (int i = 0; i < 8; ++i) ir[i] = __builtin_amdgcn_exp2f(-(float)(8 * fq + i) * 0.4152410118609203f) * 0.15915494309189535f;
#pragma unroll
            for (int ai = 0; ai < 2; ++ai)
#pragma unroll
                for (int m = 0; m < 4; ++m) { const int row = row0 + ai * HALF + m * 16; const float pos = (float)(row & 2047);
                    f32x4 c0, c1, s0, s1;
#pragma unroll
                    for (int i = 0; i < 4; ++i) { const float f0 = __builtin_amdgcn_fractf(pos * ir[i]), f1 = __builtin_amdgcn_fractf(pos * ir[4 + i]);
                        c0[i] = __builtin_amdgcn_cosf(f0); s0[i] = __builtin_amdgcn_sinf(f0); c1[i] = __builtin_amdgcn_cosf(f1); s1[i] = __builtin_amdgcn_sinf(f1); }
                    const f32x4 a0 = acc[ai][0][m][0], a1 = acc[ai][0][m][1], b0 = acc[ai][1][m][0], b1 = acc[ai][1][m][1];
                    bf16_t* rowp = O + (size_t)row * ldc + col0;
                    *(u32x4*)(rowp) = pack8_bf16((a0 * c0 - b0 * s0) * sc, (a1 * c1 - b1 * s1) * sc);
                    *(u32x4*)(rowp + 32) = pack8_bf16((b0 * c0 + a0 * s0) * sc, (b1 * c1 + a1 * s1) * sc); }
        }
    }
};
struct EpiGateUp {
    static constexpr bool PERM = true, AFTER_DRAIN = false;
    bf16_t* O;
    __device__ __forceinline__ void operator()(const f32x4 (&acc)[2][2][4][2], const Unit& u, int wr, int wc, int fr, int fq) const {
        const int row0 = u.pm * BM + wr * 64 + fr, col0 = (u.pn & 7) * 128 + wc * 32 + 8 * fq;
#pragma unroll
        for (int ai = 0; ai < 2; ++ai)
#pragma unroll
            for (int m = 0; m < 4; ++m) { f32x4 r[2];
#pragma unroll
                for (int n = 0; n < 2; ++n) { const f32x4 g = acc[ai][0][m][n], up = acc[ai][1][m][n];
#pragma unroll
                    for (int i = 0; i < 4; ++i) { const float e = __builtin_amdgcn_exp2f(g[i] * -1.4426950408889634f); r[n][i] = g[i] * __builtin_amdgcn_rcpf(1.f + e) * up[i]; } }
                *(u32x4*)(O + (size_t)(row0 + ai * HALF + m * 16) * 1024 + col0) = pack8_bf16(r[0], r[1]); }
    }
};
struct EpiDown {
    static constexpr bool PERM = true, AFTER_DRAIN = false;
    bf16_t* O;
    __device__ __forceinline__ void operator()(const f32x4 (&acc)[2][2][4][2], const Unit& u, int wr, int wc, int fr, int fq) const {
        const int row0 = u.pm * BM + wr * 64 + fr, col0 = (u.pn & 7) * BM + wc * 32 + 8 * fq;
#pragma unroll
        for (int ai = 0; ai < 2; ++ai)
#pragma unroll
            for (int m = 0; m < 4; ++m) { bf16_t* rowp = O + (size_t)(row0 + ai * HALF + m * 16) * 2048 + col0;
#pragma unroll
                for (int bj = 0; bj < 2; ++bj) *(u32x4*)(rowp + bj * HALF) = pack8_bf16(acc[ai][bj][m][0], acc[ai][bj][m][1]); }
    }
};
#ifndef PROBE_MFMA2
#define PROBE_MFMA2 0
#endif
constexpr float W8_SCALE = 64.f, ACT8_SCALE = 4.f, W8_UNDO = W8_SCALE * (PROBE_MFMA2 ? 2.f : 1.f);
__device__ __forceinline__ unsigned pack4_fp8(float a, float b, float c, float d) { int w; asm volatile("" : "=v"(w));
    w = __builtin_amdgcn_cvt_pk_fp8_f32(a, b, w, false); w = __builtin_amdgcn_cvt_pk_fp8_f32(c, d, w, true); return (unsigned)w; }
struct EpiGateUp8 {
    static constexpr bool PERM = true, AFTER_DRAIN = false;
    unsigned char* O;
    __device__ __forceinline__ void operator()(const f32x4 (&acc)[2][2][4][2], const Unit& u, int wr, int wc, int fr, int fq) const {
        const int row0 = u.pm * BM + wr * 64 + fr, col0 = (u.pn & 7) * 128 + wc * 32 + 8 * fq;
        constexpr float SI = 1.f / W8_UNDO;
#pragma unroll
        for (int ai = 0; ai < 2; ++ai)
#pragma unroll
            for (int m = 0; m < 4; ++m) { f32x4 r[2];
#pragma unroll
                for (int n = 0; n < 2; ++n) { const f32x4 g = acc[ai][0][m][n] * SI, up = acc[ai][1][m][n] * (SI * ACT8_SCALE);
#pragma unroll
                    for (int i = 0; i < 4; ++i) { const float e = __builtin_amdgcn_exp2f(g[i] * -1.4426950408889634f); r[n][i] = g[i] * __builtin_amdgcn_rcpf(1.f + e) * up[i]; } }
                u32x2 w; w.x = pack4_fp8(r[0][0], r[0][1], r[0][2], r[0][3]); w.y = pack4_fp8(r[1][0], r[1][1], r[1][2], r[1][3]);
                *(u32x2*)(O + (size_t)(row0 + ai * HALF + m * 16) * 1024 + col0) = w; }
    }
};
constexpr float YD8_SCALE = 16.f;
struct EpiDown8 {
    static constexpr bool PERM = true, AFTER_DRAIN = false;
    unsigned char* O;
    __device__ __forceinline__ void operator()(const f32x4 (&acc)[2][2][4][2], const Unit& u, int wr, int wc, int fr, int fq) const {
        const int row0 = u.pm * BM + wr * 64 + fr, col0 = (u.pn & 7) * BM + wc * 32 + 8 * fq;
        constexpr float SI = YD8_SCALE / (W8_UNDO * ACT8_SCALE);
#pragma unroll
        for (int ai = 0; ai < 2; ++ai)
#pragma unroll
            for (int m = 0; m < 4; ++m) { unsigned char* rowp = O + (size_t)(row0 + ai * HALF + m * 16) * 2048 + col0;
#pragma unroll
                for (int bj = 0; bj < 2; ++bj) { const f32x4 a = acc[ai][bj][m][0] * SI, c = acc[ai][bj][m][1] * SI; u32x2 w; w.x = pack4_fp8(a[0], a[1], a[2], a[3]); w.y = pack4_fp8(c[0], c[1], c[2], c[3]);
                    *(u32x2*)(rowp + bj * HALF) = w; } }
    }
};
template <int ROLE> struct MoeOrder {
    int nunits, G, c; const PG8_LAS int* tile_e; unsigned* cnt; unsigned* tmo; int wave;
    __device__ __forceinline__ bool next(int i, Unit& u) const {
        const int cc = (ROLE == 2) ? G - 1 - c : c; int idx;
        if ((G & 7) == 0) { const int per = G >> 3; idx = (i * 8 + (cc & 7)) * per + (cc >> 3); } else idx = i * G + cc;
        if (idx >= nunits) return false;
        const int mt = idx >> 3; u.pm = mt; u.pn = tile_e[mt] * 8 + (idx & 7); return true;
    }
    __device__ __forceinline__ void a_ready(const Unit& u) const {
        if constexpr (ROLE == 2) {
            if (wave == 0) { const bool lane0 = (tid_from_wave(0) == 0);
                const unsigned long long t0 = __builtin_amdgcn_s_memrealtime(); unsigned polls = 0;
                while ((unsigned)__builtin_amdgcn_readfirstlane(__hip_atomic_load(cnt + 64 * u.pm, __ATOMIC_RELAXED, __HIP_MEMORY_SCOPE_AGENT)) < 64u) {
                    if ((++polls & 255u) == 0u && __builtin_amdgcn_readfirstlane(__hip_atomic_load(tmo, __ATOMIC_RELAXED, __HIP_MEMORY_SCOPE_AGENT)) != 0u) break;
                    if (__builtin_amdgcn_s_memrealtime() - t0 > 2000000ull) { if (lane0) __hip_atomic_store(tmo, 1u, __ATOMIC_RELAXED, __HIP_MEMORY_SCOPE_AGENT); break; }
                    __builtin_amdgcn_s_sleep(2); }
                __builtin_amdgcn_fence(__ATOMIC_ACQUIRE, "agent");
                asm volatile("s_waitcnt vmcnt(0)" ::: "memory");
            }
            asm volatile("" ::: "memory"); __builtin_amdgcn_s_barrier(); asm volatile("" ::: "memory");
        }
    }
    __device__ __forceinline__ void done(const Unit& u) const {
        if constexpr (ROLE == 1) {
            asm volatile("s_waitcnt vmcnt(0)" ::: "memory");
            if (tid_from_wave(0) == 0) __hip_atomic_fetch_add(cnt + 64 * u.pm, 1u, __ATOMIC_RELAXED, __HIP_MEMORY_SCOPE_AGENT);
        }
    }
};

#ifndef PROBE_MFMA2
#define PROBE_MFMA2 0
#endif
template <class Epi, class Sched, bool ALIGN_EPI = false, bool SP2 = false, bool F8 = false, bool F16 = false>
__device__ __forceinline__ void gemm_phase(PG8_LAS unsigned char* lds, const Gemm g, const Sched& S, const Epi& E) {
    int tid_ = tid_from_wave(g.wave); asm volatile("" : "+v"(tid_));
    const int tid = tid_, wid = __builtin_amdgcn_readfirstlane(tid >> 6), lane = tid & 63, wr = wid >> 2, wc = wid & 3, fr = lane & 15, fq = lane >> 4;
    const int K = g.K, LD = g.ld, nt = K / BK;
    unsigned voffA, voffB;
    { int R, C; stage_rc(tid * 16, R, C); const int Rb = Epi::PERM ? ((R & ~31) + perm32(R & 31)) : R;
        voffA = (unsigned)(R * LD + C) * 2u; voffB = (unsigned)(Rb * LD + C) * 2u; }
    const size_t pstep = (size_t)64 * LD * 2;
    const size_t kstep = (size_t)(BK * 2);
    const size_t hstep = (size_t)HALF * LD * 2;
    const size_t tstep = 2 * hstep;
    const unsigned ldsbase = (unsigned)(uintptr_t)lds;
    const unsigned ldsw = (unsigned)wid * 1024u;
    const int aoff = lds_byte(wr * 64 + fr, fq * 8), boff = lds_byte(wc * 32 + fr, fq * 8);
#define PG8_SA(b, h) (((b) * 2 + (h)) * HTB)
#define PG8_SB(b, h) ((4 + (b) * 2 + (h)) * HTB)
#define PG8_STAGE(bufoff, gbase, voff) do { _Pragma("unroll") for (int _i = 0; _i < 2; ++_i) { unsigned keep_; \
        asm volatile("s_mov_b32 %0, m0\n\ts_mov_b32 m0, %3\n\ts_nop 0\n\tglobal_load_lds_dwordx4 %1, %2\n\ts_mov_b32 m0, %0" : "=&s"(keep_) \
            : "v"(voff), "s"((const char*)(gbase) + _i * pstep), "s"(ldsbase + (unsigned)(bufoff) + ldsw + (unsigned)(_i * 8192))); } } while (0)
#define PG8_CAT(a, b) __builtin_bit_cast(pg8_v8i, __builtin_shufflevector(a, b, 0, 1, 2, 3, 4, 5, 6, 7, 8, 9, 10, 11, 12, 13, 14, 15))
#define PG8_LDA(dst, b, h) do { if constexpr (F8) { _Pragma("unroll") for (int m = 0; m < 4; ++m) { const bf16x8 lo_ = *(const PG8_LAS bf16x8*)(lds + PG8_SA(b, h) + aoff + m * 2048), hi_ = *(const PG8_LAS bf16x8*)(lds + PG8_SA(b, h) + aoff + m * 2048 + 1024); dst##8[m] = PG8_CAT(lo_, hi_); } } \
        else { _Pragma("unroll") for (int m = 0; m < 4; ++m) _Pragma("unroll") for (int k = 0; k < 2; ++k) dst[m][k] = *(const PG8_LAS bf16x8*)(lds + PG8_SA(b, h) + aoff + m * 2048 + k * 1024); } } while (0)
#define PG8_LDB(dst, b, h) do { if constexpr (F8) { _Pragma("unroll") for (int n = 0; n < 2; ++n) { const bf16x8 lo_ = *(const PG8_LAS bf16x8*)(lds + PG8_SB(b, h) + boff + n * 2048), hi_ = *(const PG8_LAS bf16x8*)(lds + PG8_SB(b, h) + boff + n * 2048 + 1024); dst##8[n] = PG8_CAT(lo_, hi_); } } \
        else { _Pragma("unroll") for (int n = 0; n < 2; ++n) _Pragma("unroll") for (int k = 0; k < 2; ++k) dst[n][k] = *(const PG8_LAS bf16x8*)(lds + PG8_SB(b, h) + boff + n * 2048 + k * 1024); } } while (0)
#define PG8_MMA(ai, bj, At, Bt) do { __builtin_amdgcn_s_setprio(1); \
        if constexpr (F8) { _Pragma("unroll") for (int m = 0; m < 4; ++m) _Pragma("unroll") for (int n = 0; n < 2; ++n) \
            { acc[ai][bj][m][n] = __builtin_amdgcn_mfma_scale_f32_16x16x128_f8f6f4(Bt##8[n], At##8[m], acc[ai][bj][m][n], 0, 0, 0, 0, 0, 0); \
              if (PROBE_MFMA2) acc[ai][bj][m][n] = __builtin_amdgcn_mfma_scale_f32_16x16x128_f8f6f4(Bt##8[n], At##8[m], acc[ai][bj][m][n], 0, 0, 0, 0, 0, 0); } } \
        else { _Pragma("unroll") for (int m = 0; m < 4; ++m) _Pragma("unroll") for (int n = 0; n < 2; ++n) _Pragma("unroll") for (int k = 0; k < 2; ++k) \
            acc[ai][bj][m][n] = F16 ? __builtin_amdgcn_mfma_f32_16x16x32_f16(__builtin_bit_cast(pg8_h8, Bt[n][k]), __builtin_bit_cast(pg8_h8, At[m][k]), acc[ai][bj][m][n], 0, 0, 0) \
                                    : __builtin_amdgcn_mfma_f32_16x16x32_bf16(Bt[n][k], At[m][k], acc[ai][bj][m][n], 0, 0, 0); } \
        __builtin_amdgcn_s_setprio(0); } while (0)
#define PG8_WAIT_V(n) asm volatile("s_waitcnt vmcnt(" #n ")" ::: "memory")
#define PG8_WAIT_L(n) asm volatile("s_waitcnt lgkmcnt(" #n ")" ::: "memory")
#define PG8_BAR __builtin_amdgcn_s_barrier()
#define PG8_SCHED __builtin_amdgcn_sched_barrier(0)
    Unit cur, nxt; int ui = 0;
    if (!S.next(0, cur)) return;
    f32x4 acc[2][2][4][2];
{ float zero_; asm volatile("v_mov_b32 %0, 0" : "=v"(zero_));
#pragma unroll
    for (int a = 0; a < 2; ++a)
#pragma unroll
        for (int b = 0; b < 2; ++b)
#pragma unroll
            for (int m = 0; m < 4; ++m)
#pragma unroll
                for (int n = 0; n < 2; ++n) acc[a][b][m][n] = (f32x4){zero_, zero_, zero_, zero_}; }
    bf16x8 At[4][2], B0[2][2], B1[2][2]; pg8_v8i At8[4], B08[2], B18[2];
    const char* cA = (const char*)g.A + (size_t)cur.pm * tstep; const char* cB = (const char*)g.Bt + (size_t)cur.pn * tstep;
    S.a_ready(cur);
    if constexpr (SP2) {
        PG8_STAGE(PG8_SB(0, 0), cB, voffB); PG8_STAGE(PG8_SB(0, 1), cB + hstep, voffB); PG8_STAGE(PG8_SA(0, 0), cA, voffA); PG8_STAGE(PG8_SA(0, 1), cA + hstep, voffA);
        if (wr == 1) PG8_BAR;
        PG8_WAIT_V(2); PG8_BAR;
        PG8_STAGE(PG8_SB(1, 0), cB + kstep, voffB); PG8_STAGE(PG8_SA(1, 0), cA + kstep, voffA); PG8_STAGE(PG8_SB(1, 1), cB + hstep + kstep, voffB);
        PG8_WAIT_V(6); PG8_BAR;
    } else {
        PG8_STAGE(PG8_SB(0, 0), cB, voffB); PG8_STAGE(PG8_SA(0, 0), cA, voffA); PG8_STAGE(PG8_SB(0, 1), cB + hstep, voffB); PG8_STAGE(PG8_SA(0, 1), cA + hstep, voffA);
        if (wr == 1) PG8_BAR;
        PG8_WAIT_V(4); PG8_BAR;
        PG8_STAGE(PG8_SB(1, 0), cB + kstep, voffB); PG8_STAGE(PG8_SA(1, 0), cA + kstep, voffA); PG8_STAGE(PG8_SB(1, 1), cB + hstep + kstep, voffB);
        PG8_WAIT_V(6); PG8_BAR;
    }
    for (;;) {
        const bool has_next = S.next(ui + 1, nxt);
        const char* nA = has_next ? (const char*)g.A + (size_t)nxt.pm * tstep : cA; const char* nB = has_next ? (const char*)g.Bt + (size_t)nxt.pn * tstep : cB;
#pragma unroll 1
        for (int t = 0; t < nt; t += 2) {
            const bool last = (t == nt - 2);
            const char* a1 = cA + (size_t)(t + 1) * kstep;
            const char* a2 = last ? nA : cA + (size_t)(t + 2) * kstep; const char* b2 = last ? nB : cB + (size_t)(t + 2) * kstep;
            const char* a3 = a2 + kstep; const char* b3 = b2 + kstep;
            if (last && has_next) S.a_ready(nxt);
            if constexpr (SP2) {
            PG8_LDB(B0, 0, 0); PG8_LDB(B1, 0, 1); PG8_SCHED; PG8_LDA(At, 0, 0); PG8_STAGE(PG8_SA(1, 1), a1 + hstep, voffA);
            PG8_WAIT_V(8); PG8_WAIT_L(0); PG8_BAR; PG8_MMA(0, 0, At, B0); PG8_MMA(0, 1, At, B1); PG8_BAR; PG8_SCHED;
            PG8_LDA(At, 0, 1); PG8_STAGE(PG8_SB(0, 0), b2, voffB); PG8_STAGE(PG8_SB(0, 1), b2 + hstep, voffB); PG8_STAGE(PG8_SA(0, 0), a2, voffA);
            PG8_WAIT_V(8); PG8_WAIT_L(0); PG8_BAR; PG8_MMA(1, 0, At, B0); PG8_MMA(1, 1, At, B1); PG8_BAR; PG8_SCHED;
            PG8_LDB(B0, 1, 0); PG8_LDB(B1, 1, 1); PG8_SCHED; PG8_LDA(At, 1, 0); PG8_STAGE(PG8_SA(0, 1), a2 + hstep, voffA);
            PG8_WAIT_V(8); PG8_WAIT_L(0); PG8_BAR; PG8_MMA(0, 0, At, B0); PG8_MMA(0, 1, At, B1); PG8_BAR; PG8_SCHED;
            PG8_LDA(At, 1, 1); PG8_STAGE(PG8_SB(1, 0), b3, voffB); PG8_STAGE(PG8_SB(1, 1), b3 + hstep, voffB); PG8_STAGE(PG8_SA(1, 0), a3, voffA);
            PG8_WAIT_V(8); PG8_WAIT_L(0); PG8_BAR; PG8_MMA(1, 0, At, B0); PG8_MMA(1, 1, At, B1); PG8_BAR; PG8_SCHED;
            } else {
            PG8_LDB(B0, 0, 0); PG8_SCHED; PG8_LDA(At, 0, 0); PG8_STAGE(PG8_SA(1, 1), a1 + hstep, voffA);
            PG8_WAIT_L(8); PG8_BAR; PG8_WAIT_L(0); PG8_MMA(0, 0, At, B0); PG8_BAR; PG8_SCHED;
            PG8_LDB(B1, 0, 1); PG8_STAGE(PG8_SB(0, 0), b2, voffB);
            PG8_BAR; PG8_WAIT_L(0); PG8_MMA(0, 1, At, B1); PG8_BAR;
            PG8_LDA(At, 0, 1); PG8_STAGE(PG8_SA(0, 0), a2, voffA);
            PG8_BAR; PG8_WAIT_L(0); PG8_MMA(1, 0, At, B0); PG8_BAR; PG8_SCHED;
            PG8_STAGE(PG8_SB(0, 1), b2 + hstep, voffB);
            PG8_WAIT_V(6); PG8_BAR; PG8_MMA(1, 1, At, B1); PG8_BAR;
            PG8_LDB(B0, 1, 0); PG8_SCHED; PG8_LDA(At, 1, 0); PG8_STAGE(PG8_SA(0, 1), a2 + hstep, voffA);
            PG8_WAIT_L(8); PG8_BAR; PG8_WAIT_L(0); PG8_MMA(0, 0, At, B0); PG8_BAR; PG8_SCHED;
            PG8_LDB(B1, 1, 1); PG8_STAGE(PG8_SB(1, 0), b3, voffB);
            PG8_BAR; PG8_WAIT_L(0); PG8_MMA(0, 1, At, B1); PG8_BAR;
            PG8_LDA(At, 1, 1); PG8_STAGE(PG8_SA(1, 0), a3, voffA);
            PG8_BAR; PG8_WAIT_L(0); PG8_MMA(1, 0, At, B0); PG8_BAR; PG8_SCHED;
            PG8_STAGE(PG8_SB(1, 1), b3 + hstep, voffB);
            PG8_WAIT_V(6); PG8_BAR; PG8_MMA(1, 1, At, B1); PG8_BAR;
            }
        }
        if constexpr (ALIGN_EPI) { if (wr == 0) PG8_BAR; }
        if constexpr (!Epi::AFTER_DRAIN) { const int t2_ = tid_from_wave(g.wave);
            E(acc, cur, wr, wc, t2_ & 15, (t2_ >> 4) & 3); S.done(cur); }
        if (!has_next) break;
{ float zero_; asm volatile("v_mov_b32 %0, 0" : "=v"(zero_));
#pragma unroll
        for (int a = 0; a < 2; ++a)
#pragma unroll
            for (int b = 0; b < 2; ++b)
#pragma unroll
                for (int m = 0; m < 4; ++m)
#pragma unroll
                    for (int n = 0; n < 2; ++n) acc[a][b][m][n] = (f32x4){zero_, zero_, zero_, zero_}; }
        cur = nxt; cA = nA; cB = nB; ++ui;
        if constexpr (ALIGN_EPI) { if (wr == 1) PG8_BAR; }
    }
    PG8_WAIT_V(0);
    if constexpr (!ALIGN_EPI) { if (wr == 0) PG8_BAR; }
    PG8_BAR;
    if constexpr (Epi::AFTER_DRAIN) { E.fused(acc, cur, wr, wc, fr, fq, lds, wid, lane); S.done(cur); }
#undef PG8_SA
#undef PG8_SB
#undef PG8_STAGE
#undef PG8_LDA
#undef PG8_LDB
#undef PG8_MMA
#undef PG8_CAT
#undef PG8_WAIT_V
#undef PG8_WAIT_L
#undef PG8_BAR
#undef PG8_SCHED
}
}

namespace att {
#define ALAS __attribute__((address_space(3)))
typedef unsigned short bf16_t;
typedef short bf16x8 __attribute__((ext_vector_type(8)));
typedef short s16x4 __attribute__((ext_vector_type(4)));
typedef float f32x16 __attribute__((ext_vector_type(16)));
typedef float f32x4 __attribute__((ext_vector_type(4)));
typedef unsigned u32x4 __attribute__((ext_vector_type(4)));
typedef ALAS char* ldsp;
#ifndef WO_F8
#define WO_F8 1
#endif
constexpr float OB8_SCALE = 8.f;
constexpr int QP = 6144;
constexpr int OP = 2048;
constexpr int OBP = 2048;
constexpr int SHM_V = 16384, SHM_K = 16384;
constexpr int LDS_V = 0, LDS_K = 2 * SHM_V, LDS_WS = LDS_K + 2 * SHM_K, ATT_LDS_BYTES = LDS_WS + 8 * 256;
#define KSWZ(row, colB) ((row) * 256 + ((colB) ^ (((row) & 7) << 4)))
#define KSWZ64(row, colB) ((row) * 128 + ((colB) ^ (((row) & 7) << 4)))
#define SBAR() __builtin_amdgcn_sched_barrier(0)
__device__ __forceinline__ int v_st(int k, int c) { const int kk = (k & ~0xC) | ((k & 4) << 1) | ((k & 8) >> 1); return ((kk >> 3) * 4 + (c >> 5)) * 512 + ((kk & 7) * 32 + (c & 31)) * 2; }
__device__ __forceinline__ int v_rd_base(int lane) { return ((lane & 3) << 3) | (((lane >> 2) & 3) << 6) | (((lane >> 4) & 1) << 5) | (((lane >> 5) & 1) << 8); }
constexpr int v_rd_off(int d0, int ks, int half) { return d0 * 512 + ks * 4096 + half * 2048; }
__device__ __forceinline__ int crow(int r, int hi) { return (r & 3) + 8 * (r >> 2) + 4 * hi; }
__device__ __forceinline__ unsigned cvtpk(float lo, float hi) { unsigned r; asm volatile("v_cvt_pk_bf16_f32 %0, %1, %2" : "=v"(r) : "v"(lo), "v"(hi)); return r; }
__device__ __forceinline__ bf16x8 ldg8(const bf16_t* p) { return *reinterpret_cast<const bf16x8*>(p); }
__device__ __forceinline__ unsigned quad_pack_fp8(float v) {
    const int b = __builtin_bit_cast(int, v);
    const float v1 = __builtin_bit_cast(float, __builtin_amdgcn_update_dpp(b, b, 0x55, 0xf, 0xf, false));
    const float v2 = __builtin_bit_cast(float, __builtin_amdgcn_update_dpp(b, b, 0xAA, 0xf, 0xf, false));
    const float v3 = __builtin_bit_cast(float, __builtin_amdgcn_update_dpp(b, b, 0xFF, 0xf, 0xf, false));
    int w; asm volatile("" : "=v"(w));
    w = __builtin_amdgcn_cvt_pk_fp8_f32(v, v1, w, false); w = __builtin_amdgcn_cvt_pk_fp8_f32(v2, v3, w, true); return (unsigned)w;
}
__device__ __forceinline__ float xhalf(float v, int hi) {
    auto rr = __builtin_amdgcn_permlane32_swap(__float_as_uint(v), __float_as_uint(v), false, false);
    return __uint_as_float(hi ? rr[0] : rr[1]);
}
#define ATT_PK4(P, B_, OUT) do { unsigned a0 = cvtpk(P[B_+0], P[B_+1]), a1 = cvtpk(P[B_+2], P[B_+3]);                      \
        unsigned b0 = cvtpk(P[B_+4], P[B_+5]), b1 = cvtpk(P[B_+6], P[B_+7]);                                             \
        auto r0 = __builtin_amdgcn_permlane32_swap(a0, b0, false, false); auto r1 = __builtin_amdgcn_permlane32_swap(a1, b1, false, false); \
        u32x4 w = {r0[0], r1[0], r0[1], r1[1]}; OUT = *reinterpret_cast<bf16x8*>(&w); } while (0)
__device__ __forceinline__ void pv_tile(f32x16* o, int vb, bf16x8 pa0, bf16x8 pa1, bf16x8 pa2, bf16x8 pa3) {
#define TRRD(dst, off) asm volatile("ds_read_b64_tr_b16 %0, %1 offset:%2" : "=&v"(dst) : "v"(vb), "i"(off) : "memory")
#define PV_D0(d0) do { s16x4 l0, l1, l2, l3, h0, h1, h2, h3; constexpr int b_ = v_rd_off(d0, 0, 0); \
        TRRD(l0, b_); TRRD(h0, b_ + 2048); TRRD(l1, b_ + 4096); TRRD(h1, b_ + 6144); TRRD(l2, b_ + 8192); TRRD(h2, b_ + 10240); TRRD(l3, b_ + 12288); TRRD(h3, b_ + 14336); \
        asm volatile("s_waitcnt lgkmcnt(0)" ::: "memory"); SBAR(); \
        o[d0] = __builtin_amdgcn_mfma_f32_32x32x16_bf16(pa0, (bf16x8){l0[0], l0[1], l0[2], l0[3], h0[0], h0[1], h0[2], h0[3]}, o[d0], 0, 0, 0);   \
        o[d0] = __builtin_amdgcn_mfma_f32_32x32x16_bf16(pa1, (bf16x8){l1[0], l1[1], l1[2], l1[3], h1[0], h1[1], h1[2], h1[3]}, o[d0], 0, 0, 0);   \
        o[d0] = __builtin_amdgcn_mfma_f32_32x32x16_bf16(pa2, (bf16x8){l2[0], l2[1], l2[2], l2[3], h2[0], h2[1], h2[2], h2[3]}, o[d0], 0, 0, 0);   \
        o[d0] = __builtin_amdgcn_mfma_f32_32x32x16_bf16(pa3, (bf16x8){l3[0], l3[1], l3[2], l3[3], h3[0], h3[1], h3[2], h3[3]}, o[d0], 0, 0, 0); } while (0)
    PV_D0(0); PV_D0(1); PV_D0(2); PV_D0(3);
#undef PV_D0
#undef TRRD
}

__device__ __forceinline__ void sb_block(const bf16_t* __restrict__ Qg, const bf16_t* __restrict__ Kg, const bf16_t* __restrict__ Vg, bf16_t* __restrict__ Og, int qb, ldsp lds, int wave_) {
    int tid_ = tid_from_wave(wave_); asm volatile("" : "+v"(tid_));
    const int tid = tid_, wid = __builtin_amdgcn_readfirstlane(tid >> 6), lane = tid & 63, r32 = lane & 31, hi = lane >> 5;
    const int NT = 4 * qb + 4, R0 = 256 * qb + 32 * wid, myrow = R0 + r32;
    const ldsp V_lds = lds + LDS_V; const ldsp K_lds = lds + LDS_K;
    bf16x8 qr[8];
    { const bf16_t* Qw = Qg + (size_t)R0 * QP; const unsigned qoff = (unsigned)(r32 * QP + hi * 8);
#pragma unroll
      for (int d0 = 0; d0 < 8; ++d0) qr[d0] = ldg8(Qw + (qoff + d0 * 16)); }
    const int sr = tid >> 4, sc = (tid & 15) * 8, kws = KSWZ(sr, sc * 2), vst0 = v_st(sr, sc), vst1 = v_st(32 + sr, sc);
    const unsigned kvoff = (unsigned)(sr * QP + sc);
    const int vb0 = (int)(unsigned)(uintptr_t)V_lds + v_rd_base(lane);
    bf16x8 sk0, sk1, sv0, sv1;
#define SB_LOAD(j) do { const bf16_t* kp_ = Kg + (size_t)(64 * (j)) * QP; const bf16_t* vp_ = Vg + (size_t)(64 * (j)) * QP; \
        sk0 = ldg8(kp_ + kvoff); sk1 = ldg8(kp_ + (size_t)32 * QP + kvoff); sv0 = ldg8(vp_ + kvoff); sv1 = ldg8(vp_ + (size_t)32 * QP + kvoff); } while (0)
#define SB_WRITE(bf) do { *(ALAS bf16x8*)(K_lds + (bf) * SHM_K + kws) = sk0; *(ALAS bf16x8*)(K_lds + (bf) * SHM_K + kws + 32 * 256) = sk1; \
        *(ALAS bf16x8*)(V_lds + (bf) * SHM_V + vst0) = sv0; *(ALAS bf16x8*)(V_lds + (bf) * SHM_V + vst1) = sv1; } while (0)
    SB_LOAD(NT - 1); SB_WRITE(0);
    __syncthreads();
    float carry = 0.f; f32x16 o[4] = {};
    ALAS int* fl = (ALAS int*)(lds + LDS_WS); bool wdone = false;
    for (int t = 0; t < NT; ++t) {
        const int j = NT - 1 - t, buf = t & 1, kb = 64 * j;
        if (t + 1 < NT) SB_LOAD(j - 1);
        if (kb <= R0 + 30 && !wdone) {
            f32x16 p0 = {}, p1 = {};
            { const ldsp Kb = K_lds + buf * SHM_K;
#pragma unroll
              for (int d0 = 0; d0 < 8; ++d0) { const ldsp a = Kb + KSWZ(r32, ((d0 & 3) * 16 + hi * 8) * 2) + (d0 >> 2) * 128;
                  const bf16x8 b0 = *(const ALAS bf16x8*)a, b1 = *(const ALAS bf16x8*)(a + 32 * 256);
                  p0 = __builtin_amdgcn_mfma_f32_32x32x16_bf16(b0, qr[d0], p0, 0, 0, 0);
                  p1 = __builtin_amdgcn_mfma_f32_32x32x16_bf16(b1, qr[d0], p1, 0, 0, 0); } }
            f32x16 lb0, lb1;
#pragma unroll
            for (int r = 0; r < 16; ++r) {
                { const float z = p0[r]; const float e = __builtin_amdgcn_exp2f(-__builtin_fabsf(z)); const float sp = __builtin_fmaxf(z, 0.f) + __builtin_amdgcn_logf(1.f + e); p0[r] = -sp; lb0[r] = z - sp; }
                { const float z = p1[r]; const float e = __builtin_amdgcn_exp2f(-__builtin_fabsf(z)); const float sp = __builtin_fmaxf(z, 0.f) + __builtin_amdgcn_logf(1.f + e); p1[r] = -sp; lb1[r] = z - sp; }
            }
            if (kb + 63 >= R0) {
                const int dq = myrow - kb - 4 * hi; const float NEG = -__builtin_inff();
#pragma unroll
                for (int r = 0; r < 16; ++r) { const int c = (r & 3) + 8 * (r >> 2);
                    if (c >= dq) { p0[r] = 0.f; lb0[r] = NEG; }
                    if (c + 32 >= dq) { p1[r] = 0.f; lb1[r] = NEG; } }
            }
            float gs[8], go[8];
#pragma unroll
            for (int g = 0; g < 4; ++g) { gs[g] = (p0[4 * g] + p0[4 * g + 1]) + (p0[4 * g + 2] + p0[4 * g + 3]); gs[4 + g] = (p1[4 * g] + p1[4 * g + 1]) + (p1[4 * g + 2] + p1[4 * g + 3]); }
#pragma unroll
            for (int i = 0; i < 8; ++i) go[i] = xhalf(gs[i], hi);
            float acc = carry;
#pragma unroll
            for (int idx = 7; idx >= 0; --idx) { const int g = idx & 3; const float base = acc + (hi ? 0.f : go[idx]);
                if (idx >= 4) { const float t3 = base, t2 = t3 + p1[4 * g + 3], t1 = t2 + p1[4 * g + 2], t0 = t1 + p1[4 * g + 1];
                    lb1[4 * g + 3] = __builtin_amdgcn_exp2f(lb1[4 * g + 3] + t3); lb1[4 * g + 2] = __builtin_amdgcn_exp2f(lb1[4 * g + 2] + t2);
                    lb1[4 * g + 1] = __builtin_amdgcn_exp2f(lb1[4 * g + 1] + t1); lb1[4 * g] = __builtin_amdgcn_exp2f(lb1[4 * g] + t0); }
                else { const float t3 = base, t2 = t3 + p0[4 * g + 3], t1 = t2 + p0[4 * g + 2], t0 = t1 + p0[4 * g + 1];
                    lb0[4 * g + 3] = __builtin_amdgcn_exp2f(lb0[4 * g + 3] + t3); lb0[4 * g + 2] = __builtin_amdgcn_exp2f(lb0[4 * g + 2] + t2);
                    lb0[4 * g + 1] = __builtin_amdgcn_exp2f(lb0[4 * g + 1] + t1); lb0[4 * g] = __builtin_amdgcn_exp2f(lb0[4 * g] + t0); }
                acc += gs[idx] + go[idx]; }
            carry = acc;
            bf16x8 pa0, pa1, pa2, pa3;
            ATT_PK4(lb0, 0, pa0); ATT_PK4(lb0, 8, pa1); ATT_PK4(lb1, 0, pa2); ATT_PK4(lb1, 8, pa3);
            SBAR();
            pv_tile(o, vb0 + buf * SHM_V, pa0, pa1, pa2, pa3);
            wdone = __all(carry < -127.f);
        }
        if (lane == 0) fl[buf * 8 + wid] = wdone ? 1 : 0;
        if (t + 1 < NT) SB_WRITE(buf ^ 1);
        __syncthreads();
        { const ALAS int* f = fl + buf * 8; if ((f[0] & f[1] & f[2] & f[3] & f[4] & f[5] & f[6] & f[7]) != 0) break; }
    }
#undef SB_LOAD
#undef SB_WRITE
#if WO_F8
    unsigned char* Ow = (unsigned char*)Og + (size_t)R0 * OBP; const unsigned ooff = (unsigned)(4 * hi * OBP + r32);
#pragma unroll
    for (int r = 0; r < 16; ++r) { unsigned char* rowp = Ow + (size_t)((r & 3) + 8 * (r >> 2)) * OBP;
#pragma unroll
        for (int d0 = 0; d0 < 4; ++d0) { const unsigned w = quad_pack_fp8(o[d0][r] * OB8_SCALE);
            if ((r32 & 3) == 0) *(unsigned*)(rowp + (ooff + d0 * 32)) = w; } }
#else
    bf16_t* Ow = Og + (size_t)R0 * OP; const unsigned ooff = (unsigned)(4 * hi * OP + r32);
#pragma unroll
    for (int r = 0; r < 16; ++r) { bf16_t* rowp = Ow + (size_t)((r & 3) + 8 * (r >> 2)) * OP;
#pragma unroll
        for (int d0 = 0; d0 < 4; ++d0) { const float v = o[d0][r]; const float vn = __shfl_xor(v, 1);
            if ((r32 & 1) == 0) *(unsigned*)(rowp + (ooff + d0 * 32)) = cvtpk(v, vn); } }
#endif
}

constexpr float ATT_THR = 8.f;
__device__ __forceinline__ void qkt64(f32x16& p0, f32x16& p1, ldsp Kb, int r32, int hi, const bf16x8* qr) {
    p0 = f32x16{}; p1 = f32x16{};
#pragma unroll
    for (int d0 = 0; d0 < 4; ++d0) { const ldsp a = Kb + KSWZ64(r32, (d0 * 16 + hi * 8) * 2);
        const bf16x8 b0 = *(const ALAS bf16x8*)a, b1 = *(const ALAS bf16x8*)(a + 32 * 128);
        p0 = __builtin_amdgcn_mfma_f32_32x32x16_bf16(b0, qr[d0], p0, 0, 0, 0);
        p1 = __builtin_amdgcn_mfma_f32_32x32x16_bf16(b1, qr[d0], p1, 0, 0, 0); }
}
__device__ __forceinline__ void partial_sm(f32x16& p0, f32x16& p1, float& m_reg, float& alpha, int hi) {
    float pmax = p0[0];
#pragma unroll
    for (int r = 1; r < 16; ++r) pmax = __builtin_fmaxf(pmax, p0[r]);
#pragma unroll
    for (int r = 0; r < 16; ++r) pmax = __builtin_fmaxf(pmax, p1[r]);
    pmax = __builtin_fmaxf(pmax, xhalf(pmax, hi));
    float mn;
    if (__builtin_expect(__all(pmax - m_reg <= ATT_THR), 1)) { mn = m_reg; alpha = 1.f; }
    else { mn = __builtin_fmaxf(m_reg, pmax); alpha = __builtin_amdgcn_exp2f(m_reg - mn); m_reg = mn; }
#pragma unroll
    for (int r = 0; r < 16; ++r) { p0[r] -= mn; p1[r] -= mn; }
#pragma unroll
    for (int r = 0; r < 16; ++r) p0[r] = __builtin_amdgcn_exp2f(p0[r]);
}
__device__ __forceinline__ void finish_sm(f32x16& p0, f32x16& p1, float alpha, float& l_reg, bf16x8& pa0, bf16x8& pa1, bf16x8& pa2, bf16x8& pa3, int hi) {
#pragma unroll
    for (int r = 0; r < 16; ++r) p1[r] = __builtin_amdgcn_exp2f(p1[r]);
    float ps = 0.f;
#pragma unroll
    for (int r = 0; r < 16; ++r) ps += p0[r];
#pragma unroll
    for (int r = 0; r < 16; ++r) ps += p1[r];
    ps += xhalf(ps, hi);
    l_reg = l_reg * alpha + ps;
    ATT_PK4(p0, 0, pa0); ATT_PK4(p0, 8, pa1); ATT_PK4(p1, 0, pa2); ATT_PK4(p1, 8, pa3);
}
__device__ __forceinline__ void mask_gt(f32x16& p0, f32x16& p1, int dq) {
    const float NEG = -__builtin_inff();
#pragma unroll
    for (int r = 0; r < 16; ++r) { const int c = (r & 3) + 8 * (r >> 2);
        if (c > dq) p0[r] = NEG;
        if (c + 32 > dq) p1[r] = NEG; }
}
template <bool SECOND>
__device__ __forceinline__ void diff_pass(const bf16_t* __restrict__ Qg, const bf16_t* __restrict__ Kg, const bf16_t* __restrict__ Vg, float* S1, bf16_t* __restrict__ Og,
                                          int qb, float lam, const float* __restrict__ gsub, float gmul, ldsp lds, int wave_) {
    int tid_ = tid_from_wave(wave_); asm volatile("" : "+v"(tid_));
    const int tid = tid_, wid = __builtin_amdgcn_readfirstlane(tid >> 6), lane = tid & 63, r32 = lane & 31, hi = lane >> 5;
    const int NT = 4 * qb + 4, R0 = 256 * qb + 32 * wid, myrow = R0 + r32;
    const ldsp V_lds = lds + LDS_V; const ldsp K_lds = lds + LDS_K;
    ALAS float* wsf = (ALAS float*)(lds + LDS_WS) + wid * 64; ALAS float* li_l = wsf; ALAS float* al_l = wsf + 32;
    bf16x8 qr[4];
    { const bf16_t* Qw = Qg + (size_t)R0 * QP; const unsigned qoff = (unsigned)(r32 * QP + hi * 8);
#pragma unroll
      for (int d0 = 0; d0 < 4; ++d0) qr[d0] = ldg8(Qw + (qoff + d0 * 16)); }
    const int sr = tid >> 4, sc = (tid & 15) * 8, vst0 = v_st(sr, sc), vst1 = v_st(32 + sr, sc);
    const int kr = tid >> 3, kc = (tid & 7) * 8, kws = KSWZ64(kr, kc * 2);
    const unsigned voff = (unsigned)(sr * QP + sc), koff = (unsigned)(kr * QP + kc);
    const int vb0 = (int)(unsigned)(uintptr_t)V_lds + v_rd_base(lane);
    const int qm = myrow - 4 * hi;
    bf16x8 sk0A, sv0A, sv1A, sk0B, sv0B, sv1B;
#define DF_LOAD(S_, j) do { const bf16_t* vp_ = Vg + (size_t)(64 * (j)) * QP; sk0##S_ = ldg8(Kg + (size_t)(64 * (j)) * QP + koff); sv0##S_ = ldg8(vp_ + voff); sv1##S_ = ldg8(vp_ + (size_t)32 * QP + voff); } while (0)
#define DF_WRITE(S_, bf) do { *(ALAS bf16x8*)(K_lds + (bf) * SHM_K + kws) = sk0##S_; *(ALAS bf16x8*)(V_lds + (bf) * SHM_V + vst0) = sv0##S_; *(ALAS bf16x8*)(V_lds + (bf) * SHM_V + vst1) = sv1##S_; } while (0)
#define DF_MASK(P0, P1, t) do { if (64 * (t) + 63 > R0) mask_gt(P0, P1, qm - 64 * (t)); } while (0)
#define DF_RESC(a) do { if (__any((a) < 1.f)) { if (hi == 0) al_l[r32] = (a); asm volatile("s_waitcnt lgkmcnt(0)" ::: "memory"); \
        _Pragma("unroll") for (int d_ = 0; d_ < 4; ++d_) _Pragma("unroll") for (int r = 0; r < 16; ++r) o[d_][r] *= al_l[crow(r, hi)]; } } while (0)
    float m_reg = -1e30f, l_reg = 0.f; f32x16 o[4] = {};
    f32x16 pA0, pA1, pB0, pB1; float alA = 1.f, alB = 1.f; bf16x8 pa0, pa1, pa2, pa3;
    DF_LOAD(A, 0); DF_WRITE(A, 0);
    __syncthreads();
    DF_LOAD(A, 1); DF_LOAD(B, 2);
    qkt64(pA0, pA1, K_lds, r32, hi, qr); DF_MASK(pA0, pA1, 0); partial_sm(pA0, pA1, m_reg, alA, hi);
    DF_WRITE(A, 1);
    DF_RESC(alA);
    __syncthreads();
#define DF_HALF(PX0, PX1, alX, PY0, PY1, alY, t, KB, VB, SB, LS, WS) do { \
        SBAR(); qkt64(PX0, PX1, K_lds + (KB) * SHM_K, r32, hi, qr); \
        finish_sm(PY0, PY1, alY, l_reg, pa0, pa1, pa2, pa3, hi); SBAR(); \
        if ((t) + 2 < NT) { DF_LOAD(LS, (t) + 2); SBAR(); } \
        pv_tile(o, vb0 + (VB) * SHM_V, pa0, pa1, pa2, pa3); DF_MASK(PX0, PX1, (t)); partial_sm(PX0, PX1, m_reg, alX, hi); \
        __syncthreads(); \
        if ((t) + 1 < NT) DF_WRITE(WS, SB); \
        DF_RESC(alX); __syncthreads(); } while (0)
    for (int t = 1; t + 1 < NT; t += 2) {
        DF_HALF(pB0, pB1, alB, pA0, pA1, alA, t, 1, 0, 0, A, B);
        DF_HALF(pA0, pA1, alA, pB0, pB1, alB, t + 1, 0, 1, 1, B, A);
    }
    DF_HALF(pB0, pB1, alB, pA0, pA1, alA, NT - 1, 1, 0, 0, A, B);
    finish_sm(pB0, pB1, alB, l_reg, pa0, pa1, pa2, pa3, hi); SBAR();
    pv_tile(o, vb0 + 1 * SHM_V, pa0, pa1, pa2, pa3);
#undef DF_LOAD
#undef DF_WRITE
#undef DF_MASK
#undef DF_RESC
#undef DF_HALF
    if (hi == 0) li_l[r32] = l_reg; asm volatile("s_waitcnt lgkmcnt(0)" ::: "memory");
    float rli[16];
#pragma unroll
    for (int r = 0; r < 16; ++r) rli[r] = __builtin_amdgcn_rcpf(li_l[crow(r, hi)]);
    if constexpr (!SECOND) {
        float* Sw = S1 + (size_t)R0 * OP; const unsigned ooff = (unsigned)(4 * hi * OP + r32);
#pragma unroll
        for (int r = 0; r < 16; ++r) { float* rowp = Sw + (size_t)((r & 3) + 8 * (r >> 2)) * OP;
#pragma unroll
            for (int d0 = 0; d0 < 4; ++d0) rowp[ooff + d0 * 32] = o[d0][r] * rli[r]; }
    } else {
        const float* Sw = S1 + (size_t)R0 * OP; bf16_t* Ow = Og + (size_t)R0 * OP; (void)Ow; const unsigned ooff = (unsigned)(4 * hi * OP + r32), ooff8 = (unsigned)(4 * hi * OBP + r32);
        float gn[4];
#pragma unroll
        for (int d0 = 0; d0 < 4; ++d0) gn[d0] = gsub[d0 * 32 + r32] * gmul;
#pragma unroll
        for (int r = 0; r < 16; ++r) { const float* srow = Sw + (size_t)((r & 3) + 8 * (r >> 2)) * OP; float d[4]; float ss = 0.f;
#if WO_F8
            unsigned char* orowp = (unsigned char*)Og + (size_t)(R0 + (r & 3) + 8 * (r >> 2)) * OBP;
#else
            bf16_t* orowp = Ow + (size_t)((r & 3) + 8 * (r >> 2)) * OP;
#endif
#pragma unroll
            for (int d0 = 0; d0 < 4; ++d0) { d[d0] = srow[ooff + d0 * 32] - lam * (o[d0][r] * rli[r]); ss += d[d0] * d[d0]; }
            ss += __builtin_bit_cast(float, __builtin_amdgcn_update_dpp(0, __builtin_bit_cast(int, ss), 0xB1, 0xf, 0xf, true));
            ss += __builtin_bit_cast(float, __builtin_amdgcn_update_dpp(0, __builtin_bit_cast(int, ss), 0x4E, 0xf, 0xf, true));
            ss += __builtin_bit_cast(float, __builtin_amdgcn_update_dpp(0, __builtin_bit_cast(int, ss), 0x141, 0xf, 0xf, true));
            ss += __builtin_bit_cast(float, __builtin_amdgcn_update_dpp(0, __builtin_bit_cast(int, ss), 0x140, 0xf, 0xf, true));
            { auto rr = __builtin_amdgcn_permlane16_swap(__float_as_uint(ss), __float_as_uint(ss), false, false); ss = __uint_as_float(rr[0]) + __uint_as_float(rr[1]); }
            const float rs = __builtin_amdgcn_rsqf(ss * (1.f / 128.f) + 1e-5f);
#pragma unroll
#if WO_F8
            for (int d0 = 0; d0 < 4; ++d0) { const unsigned w = quad_pack_fp8(d[d0] * rs * gn[d0] * OB8_SCALE);
                if ((r32 & 3) == 0) *(unsigned*)(orowp + (ooff8 + d0 * 32)) = w; }
#else
            for (int d0 = 0; d0 < 4; ++d0) { const float v = d[d0] * rs * gn[d0]; const float vn = __shfl_xor(v, 1);
                if ((r32 & 1) == 0) *(unsigned*)(orowp + (ooff + d0 * 32)) = cvtpk(v, vn); }
#endif
            if ((r & 1) == 1) asm volatile("" ::: "memory"); }
    }
    __syncthreads();
}

#ifndef D2_NEGM
#define D2_NEGM 1
#endif
constexpr int D2_SLK = 8192, D2_SLV = 16384, D2_K = 0, D2_V = 3 * D2_SLK, D2_WS = D2_V + 3 * D2_SLV, D2_LDS_BYTES = D2_WS + 8 * 256;
typedef __attribute__((address_space(3))) const char* lds_cptr;
typedef short v4i16_t __attribute__((ext_vector_type(4)));
typedef float f32x2_t __attribute__((ext_vector_type(2))); typedef __bf16 bf16x2_t __attribute__((ext_vector_type(2)));
__device__ __forceinline__ unsigned cvtpk_s(float lo, float hi) { const f32x2_t v = {lo, hi}; const bf16x2_t b = __builtin_convertvector(v, bf16x2_t); return __builtin_bit_cast(unsigned, b); }
__device__ __forceinline__ s16x4 vtr(lds_cptr p) { return __builtin_bit_cast(s16x4, __builtin_amdgcn_ds_read_tr16_b64_v4i16((__attribute__((address_space(3))) v4i16_t*)p)); }
__device__ __forceinline__ void kload2(bf16x8* kf, lds_cptr kp, int j) { kf[2 * j] = *(const ALAS bf16x8*)(kp + j * 2048); kf[2 * j + 1] = *(const ALAS bf16x8*)(kp + j * 2048 + 512); }
__device__ __forceinline__ void glds16s(unsigned voff, const void* gbase, unsigned ldsdst) { unsigned keep;
    asm volatile("s_mov_b32 %0, m0\n\ts_mov_b32 m0, %3\n\ts_nop 0\n\tglobal_load_lds_dwordx4 %1, %2\n\ts_mov_b32 m0, %0" : "=&s"(keep) : "v"(voff), "s"(gbase), "s"(ldsdst) : "memory"); }
#define D2_MX3(a, b, c) __builtin_fmaxf(__builtin_fmaxf((a), (b)), (c))
__device__ __forceinline__ float rowmax2(const f32x16& p0, const f32x16& p1) {
    float a = D2_MX3(p0[0], p0[1], p1[0]), b = D2_MX3(p0[2], p0[3], p1[1]); a = D2_MX3(a, p1[2], p1[3]);
#pragma unroll
    for (int r = 4; r < 16; r += 4) { a = D2_MX3(a, p0[r], p0[r + 1]); b = D2_MX3(b, p0[r + 2], p0[r + 3]); a = D2_MX3(a, p1[r], p1[r + 1]); b = D2_MX3(b, p1[r + 2], p1[r + 3]); }
    const float m = __builtin_fmaxf(a, b); auto rr = __builtin_amdgcn_permlane32_swap(__float_as_uint(m), __float_as_uint(m), false, false);
    return __builtin_fmaxf(__uint_as_float(rr[0]), __uint_as_float(rr[1])); }
__device__ __forceinline__ void cmask2(f32x16& p0, f32x16& p1, int jb, int qrel, int hi) {
    const int kb = 64 * jb + 4 * hi; const float NEG = -__builtin_inff();
#pragma unroll
    for (int r = 0; r < 16; ++r) { const int kv = kb + (r & 3) + 8 * (r >> 2); if (kv > qrel) p0[r] = NEG; if (kv + 32 > qrel) p1[r] = NEG; } }
#define D2_WAIT_BAR(N) asm volatile("s_waitcnt vmcnt(" #N ") lgkmcnt(0)\n\ts_barrier" ::: "memory")
#define D2_PIN(x) asm volatile("" : "+v"(x))
#define D2_MF(a, b, c) __builtin_amdgcn_mfma_f32_32x32x16_bf16(a, b, c, 0, 0, 0)

template <bool SECOND>
__device__ __forceinline__ void diff_pass2(const bf16_t* __restrict__ Qg, const bf16_t* __restrict__ Kg, const bf16_t* __restrict__ Vg, float* S1, bf16_t* __restrict__ Og,
                                           int qb, float lam, const float* __restrict__ gsub, float gmul, ldsp lds, int wave_) {
    int tid_ = tid_from_wave(wave_); asm volatile("" : "+v"(tid_));
    const int tid = tid_, wid = __builtin_amdgcn_readfirstlane(tid >> 6), lane = tid & 63, r32 = lane & 31, hi = lane >> 5;
    const int NT = 4 * qb + 4, R0 = 256 * qb + 32 * wid;
    const unsigned lds0 = (unsigned)(uintptr_t)lds;
    ALAS float* wsf = (ALAS float*)(lds + D2_WS) + wid * 64;
    const unsigned kvo = (unsigned)(lane * QP + wid * 8) * 2u;
    const unsigned vvo = (unsigned)((16 * (wid & 3) + (lane >> 2)) * QP + (wid >> 2) * 32 + (lane & 3) * 8) * 2u;
    const unsigned kdst = lds0 + D2_K + wid * 1024, vdst = lds0 + D2_V + wid * 1024;
#define D2_DMA_K(t, slot) glds16s(kvo, Kg + (size_t)(t) * 64 * QP, (unsigned)__builtin_amdgcn_readfirstlane(kdst + (slot)))
#define D2_DMA_V(t, slot) do { glds16s(vvo, Vg + (size_t)(t) * 64 * QP, (unsigned)__builtin_amdgcn_readfirstlane(vdst + 2 * (slot))); \
                               glds16s(vvo, Vg + (size_t)(t) * 64 * QP + 64, (unsigned)__builtin_amdgcn_readfirstlane(vdst + 2 * (slot) + 8192)); } while (0)
    const lds_cptr kp0 = (lds_cptr)lds + D2_K + hi * 1024 + r32 * 16;
    const lds_cptr vp0 = (lds_cptr)lds + D2_V + ((lane >> 4) & 1) * 32 + (lane & 3) * 8 + (4 * hi + ((lane & 15) >> 2)) * 64;
    D2_DMA_K(0, 0); D2_DMA_V(0, 0); D2_DMA_K(1, D2_SLK);
    bf16x8 qr[4];
    { const bf16_t* Qw = Qg + (size_t)R0 * QP; const unsigned qoff = (unsigned)(r32 * QP + hi * 8);
#pragma unroll
      for (int d0 = 0; d0 < 4; ++d0) qr[d0] = ldg8(Qw + (qoff + d0 * 16)); }
    D2_DMA_K(2, 2 * D2_SLK);
    float mhat = 0.f, l_reg = 0.f; f32x16 o[4] = {};
    const int qrel = 32 * wid + r32; bool resc = false;
    f32x16 pA0, pA1, pB0, pB1; bf16x8 kf[8]; s16x4 vlo[4], vhi[4]; u32x4 pw0, pw1, pw2, pw3;
#if D2_NEGM
    f32x16 negm;
#endif
    int sl_prev = 0, sl_cur = 0, sl_next = D2_SLK;
#define D2_ROT() do { sl_prev = sl_cur; sl_cur = sl_next; sl_next = (sl_next == 2 * D2_SLK) ? 0 : sl_next + D2_SLK; } while (0)
#if D2_NEGM
#define D2_EX(v) __builtin_amdgcn_exp2f(v)
#define D2_C0 negm
#else
#define D2_EX(v) __builtin_amdgcn_exp2f((v) - mhat)
#define D2_C0 D2_Z16
#endif
#define D2_RESC() do { if (resc) { _Pragma("unroll") for (int d_ = 0; d_ < 4; ++d_) _Pragma("unroll") for (int r = 0; r < 16; ++r) o[d_][r] *= wsf[crow(r, hi)]; } } while (0)
#define D2_Z16 (f32x16){}
#if D2_NEGM
#define D2_RM(C0, C1) rowmax2(C0, C1)
#define D2_MOVE(C0, C1, dl) do { _Pragma("unroll") for (int r = 0; r < 16; ++r) { C0[r] -= dl; C1[r] -= dl; } _Pragma("unroll") for (int r = 0; r < 16; ++r) negm[r] = -mhat; D2_PIN(negm); } while (0)
#else
#define D2_RM(C0, C1) (rowmax2(C0, C1) - mhat)
#define D2_MOVE(C0, C1, dl) do { } while (0)
#endif
    D2_WAIT_BAR(4);
#pragma unroll
    for (int d0 = 0; d0 < 4; ++d0) kload2(kf, kp0, d0);
    pA0 = D2_MF(kf[0], qr[0], D2_Z16); pA1 = D2_MF(kf[1], qr[0], D2_Z16); pA0 = D2_MF(kf[2], qr[1], pA0); pA1 = D2_MF(kf[3], qr[1], pA1);
    pA0 = D2_MF(kf[4], qr[2], pA0); pA1 = D2_MF(kf[5], qr[2], pA1); pA0 = D2_MF(kf[6], qr[3], pA0); pA1 = D2_MF(kf[7], qr[3], pA1);
    if (NT == 4) cmask2(pA0, pA1, 0, qrel, hi);
    { mhat = rowmax2(pA0, pA1);
#pragma unroll
      for (int r = 0; r < 16; ++r) { pA0[r] = __builtin_amdgcn_exp2f(pA0[r] - mhat); pA1[r] = __builtin_amdgcn_exp2f(pA1[r] - mhat); }
#if D2_NEGM
#pragma unroll
      for (int r = 0; r < 16; ++r) negm[r] = -mhat;
      D2_PIN(negm);
#endif
    }
    D2_WAIT_BAR(0);
    D2_DMA_K(3, 0); D2_DMA_V(1, D2_SLK); D2_ROT();
#pragma unroll
    for (int d0 = 0; d0 < 4; ++d0) kload2(kf, kp0 + sl_cur, d0);
    D2_WAIT_BAR(3);
#define D2_PKW(P, i) cvtpk_s(P[i], P[(i) + 1])
#define D2_PAF(k) __builtin_bit_cast(bf16x8, pw##k)
#define D2_VFR(i) (bf16x8){vlo[i][0], vlo[i][1], vlo[i][2], vlo[i][3], vhi[i][0], vhi[i][1], vhi[i][2], vhi[i][3]}
#define D2_VRD(s, i) do { vlo[s] = vtr(vp_ + ((((i) & 3) * 4096) + (((i) >> 2) * 1024))); vhi[s] = vtr(vp_ + ((((i) & 3) * 4096) + (((i) >> 2) * 1024) + 512)); } while (0)
#define D2_KRD(G, d0) do { if (G) { kload2(kf, kp0 + sl_next, d0); SBAR(); } } while (0)
#define D2_GAPA(MF_, a0, a1, a2, a3, W0, W1, PW) do { MF_; sacc += a0; sacc += a1; sacc += a2; sacc += a3; D2_PIN(sacc); W0; W1; D2_PIN(PW); SBAR(); } while (0)
#define D2_GAPB(j, K_, X, e) do { o[(j) & 3] = D2_MF(D2_PAF(K_), D2_VFR((j) & 3), o[(j) & 3]); X[e] = D2_EX(X[e]); X[(e) + 1] = D2_EX(X[(e) + 1]); D2_PIN(X); SBAR(); } while (0)
#define D2_STEP(C0, C1, P0, P1, t, MASK, GK, GV, GL) do { SBAR(); \
    const lds_cptr vp_ = vp0 + 2 * sl_prev; \
    float sacc = P0[0] + P0[1]; \
                          D2_GAPA(C0 = D2_MF(kf[0], qr[0], D2_C0),  P0[2], P0[3], P0[4], P0[5],     pw0[0] = D2_PKW(P0, 0),  pw0[1] = D2_PKW(P0, 2),  pw0); \
                          D2_GAPA(C1 = D2_MF(kf[1], qr[0], D2_C0),  P0[6], P0[7], P0[8], P0[9],     pw0[2] = D2_PKW(P0, 4),  pw0[3] = D2_PKW(P0, 6),  pw0); \
                          D2_GAPA(C0 = D2_MF(kf[2], qr[1], C0),     P0[10], P0[11], P0[12], P0[13], pw1[0] = D2_PKW(P0, 8),  pw1[1] = D2_PKW(P0, 10), pw1); \
                          D2_GAPA(C1 = D2_MF(kf[3], qr[1], C1),     P0[14], P0[15], P1[0], P1[1],   pw1[2] = D2_PKW(P0, 12), pw1[3] = D2_PKW(P0, 14), pw1); \
    D2_VRD(0, 0); SBAR(); D2_GAPA(C0 = D2_MF(kf[4], qr[2], C0),     P1[2], P1[3], P1[4], P1[5],     pw2[0] = D2_PKW(P1, 0),  pw2[1] = D2_PKW(P1, 2),  pw2); \
    D2_VRD(1, 1); SBAR(); D2_GAPA(C1 = D2_MF(kf[5], qr[2], C1),     P1[6], P1[7], P1[8], P1[9],     pw2[2] = D2_PKW(P1, 4),  pw2[3] = D2_PKW(P1, 6),  pw2); \
    D2_VRD(2, 2); SBAR(); D2_GAPA(C0 = D2_MF(kf[6], qr[3], C0),     P1[10], P1[11], P1[12], P1[13], pw3[0] = D2_PKW(P1, 8),  pw3[1] = D2_PKW(P1, 10), pw3); \
    D2_VRD(3, 3); SBAR(); D2_GAPA(C1 = D2_MF(kf[7], qr[3], C1),     P1[14], P1[15], 0.f, 0.f,       pw3[2] = D2_PKW(P1, 12), pw3[3] = D2_PKW(P1, 14), pw3); \
    l_reg += sacc; \
    if (GK) D2_DMA_K((t) + 3, sl_cur); if (GV) D2_DMA_V((t) + 1, sl_next);                                                  \
    if (MASK) cmask2(C0, C1, (t) - (NT - 4), qrel, hi); \
    { const float rm = D2_RM(C0, C1); resc = false;                                                                          \
      if (__builtin_expect(__any(rm > ATT_THR), 0)) { const float dl = __builtin_fmaxf(rm, 0.f); mhat += dl;                \
          D2_MOVE(C0, C1, dl); \
          const float f = __builtin_amdgcn_exp2f(-dl); l_reg *= f; if (hi == 0) wsf[r32] = f; resc = true; } } \
    SBAR(); \
    D2_GAPB(0, 0, C0, 0);   D2_VRD(0, 4);  SBAR(); D2_GAPB(1, 0, C0, 2);   D2_VRD(1, 5);  SBAR(); D2_GAPB(2, 0, C0, 4);   D2_VRD(2, 6);  SBAR(); D2_GAPB(3, 0, C0, 6);   D2_VRD(3, 7);  SBAR(); \
    D2_GAPB(4, 1, C0, 8);   D2_VRD(0, 8);  SBAR(); D2_GAPB(5, 1, C0, 10);  D2_VRD(1, 9);  SBAR(); D2_GAPB(6, 1, C0, 12);  D2_VRD(2, 10); SBAR(); D2_GAPB(7, 1, C0, 14);  D2_VRD(3, 11); SBAR(); \
    D2_GAPB(8, 2, C1, 0);   D2_VRD(0, 12); SBAR(); D2_GAPB(9, 2, C1, 2);   D2_VRD(1, 13); SBAR(); D2_GAPB(10, 2, C1, 4);  D2_VRD(2, 14); SBAR(); D2_GAPB(11, 2, C1, 6);  D2_VRD(3, 15); SBAR(); \
    D2_KRD(GL, 0); D2_GAPB(12, 3, C1, 8);  D2_KRD(GL, 1); D2_GAPB(13, 3, C1, 10); D2_KRD(GL, 2); D2_GAPB(14, 3, C1, 12); D2_KRD(GL, 3); D2_GAPB(15, 3, C1, 14); \
    } while (0)
    int t = 1;
    for (; t + 5 < NT; t += 2) {
        D2_STEP(pB0, pB1, pA0, pA1, t, false, true, true, true);     D2_WAIT_BAR(3); D2_RESC(); D2_ROT();
        D2_STEP(pA0, pA1, pB0, pB1, t + 1, false, true, true, true); D2_WAIT_BAR(3); D2_RESC(); D2_ROT();
    }
#define D2_ENDW(tt) do { if ((tt) + 3 < NT) { D2_WAIT_BAR(3); } else if ((tt) + 2 < NT) { D2_WAIT_BAR(2); } else { D2_WAIT_BAR(0); } } while (0)
    for (; t + 1 < NT; t += 2) {
        D2_STEP(pB0, pB1, pA0, pA1, t, true, (t + 3 < NT), (t + 1 < NT), (t + 1 < NT));         D2_ENDW(t);     D2_RESC(); D2_ROT();
        D2_STEP(pA0, pA1, pB0, pB1, t + 1, true, (t + 4 < NT), (t + 2 < NT), (t + 2 < NT));     D2_ENDW(t + 1); D2_RESC(); D2_ROT();
    }
    D2_STEP(pB0, pB1, pA0, pA1, NT - 1, true, false, false, false); D2_RESC();
    { float sacc = pB0[0] + pB0[1];
#pragma unroll
      for (int r = 2; r < 16; ++r) sacc += pB0[r];
#pragma unroll
      for (int r = 0; r < 16; ++r) sacc += pB1[r];
      l_reg += sacc;
      pw0 = (u32x4){D2_PKW(pB0, 0), D2_PKW(pB0, 2), D2_PKW(pB0, 4), D2_PKW(pB0, 6)}; pw1 = (u32x4){D2_PKW(pB0, 8), D2_PKW(pB0, 10), D2_PKW(pB0, 12), D2_PKW(pB0, 14)};
      pw2 = (u32x4){D2_PKW(pB1, 0), D2_PKW(pB1, 2), D2_PKW(pB1, 4), D2_PKW(pB1, 6)}; pw3 = (u32x4){D2_PKW(pB1, 8), D2_PKW(pB1, 10), D2_PKW(pB1, 12), D2_PKW(pB1, 14)};
      const lds_cptr vp_ = vp0 + 2 * sl_cur; SBAR();
#pragma unroll
      for (int i = 0; i < 4; ++i) D2_VRD(i, i);
      o[0] = D2_MF(D2_PAF(0), D2_VFR(0), o[0]); o[1] = D2_MF(D2_PAF(0), D2_VFR(1), o[1]); o[2] = D2_MF(D2_PAF(0), D2_VFR(2), o[2]); o[3] = D2_MF(D2_PAF(0), D2_VFR(3), o[3]); SBAR();
#pragma unroll
      for (int i = 0; i < 4; ++i) D2_VRD(i, i + 4);
      o[0] = D2_MF(D2_PAF(1), D2_VFR(0), o[0]); o[1] = D2_MF(D2_PAF(1), D2_VFR(1), o[1]); o[2] = D2_MF(D2_PAF(1), D2_VFR(2), o[2]); o[3] = D2_MF(D2_PAF(1), D2_VFR(3), o[3]); SBAR();
#pragma unroll
      for (int i = 0; i < 4; ++i) D2_VRD(i, i + 8);
      o[0] = D2_MF(D2_PAF(2), D2_VFR(0), o[0]); o[1] = D2_MF(D2_PAF(2), D2_VFR(1), o[1]); o[2] = D2_MF(D2_PAF(2), D2_VFR(2), o[2]); o[3] = D2_MF(D2_PAF(2), D2_VFR(3), o[3]); SBAR();
#pragma unroll
      for (int i = 0; i < 4; ++i) D2_VRD(i, i + 12);
      o[0] = D2_MF(D2_PAF(3), D2_VFR(0), o[0]); o[1] = D2_MF(D2_PAF(3), D2_VFR(1), o[1]); o[2] = D2_MF(D2_PAF(3), D2_VFR(2), o[2]); o[3] = D2_MF(D2_PAF(3), D2_VFR(3), o[3]); }
#undef D2_DMA_K
#undef D2_DMA_V
#undef D2_ROT
#undef D2_EX
#undef D2_C0
#undef D2_RM
#undef D2_MOVE
#undef D2_RESC
#undef D2_PKW
#undef D2_PAF
#undef D2_VFR
#undef D2_VRD
#undef D2_KRD
#undef D2_ENDW
#undef D2_GAPA
#undef D2_GAPB
#undef D2_STEP
    { auto rr = __builtin_amdgcn_permlane32_swap(__float_as_uint(l_reg), __float_as_uint(l_reg), false, false); l_reg = __uint_as_float(rr[0]) + __uint_as_float(rr[1]); }
    ALAS float* li_l = wsf + 32;
    if (hi == 0) li_l[r32] = l_reg; asm volatile("s_waitcnt lgkmcnt(0)" ::: "memory");
    float rli[16];
#pragma unroll
    for (int r = 0; r < 16; ++r) rli[r] = __builtin_amdgcn_rcpf(li_l[crow(r, hi)]);
    if constexpr (!SECOND) {
        float* Sw = S1 + (size_t)R0 * OP; const unsigned ooff = (unsigned)(4 * hi * OP + r32);
#pragma unroll
        for (int r = 0; r < 16; ++r) { float* rowp = Sw + (size_t)((r & 3) + 8 * (r >> 2)) * OP;
#pragma unroll
            for (int d0 = 0; d0 < 4; ++d0) rowp[ooff + d0 * 32] = o[d0][r] * rli[r]; }
    } else {
        const float* Sw = S1 + (size_t)R0 * OP; const unsigned ooff = (unsigned)(4 * hi * OP + r32), ooff8 = (unsigned)(4 * hi * OBP + r32);
        float gn[4];
#pragma unroll
        for (int d0 = 0; d0 < 4; ++d0) gn[d0] = gsub[d0 * 32 + r32] * gmul;
#pragma unroll
        for (int r = 0; r < 16; ++r) { const float* srow = Sw + (size_t)((r & 3) + 8 * (r >> 2)) * OP; float d[4]; float ss = 0.f;
            unsigned char* orowp = (unsigned char*)Og + (size_t)(R0 + (r & 3) + 8 * (r >> 2)) * OBP;
#pragma unroll
            for (int d0 = 0; d0 < 4; ++d0) { d[d0] = srow[ooff + d0 * 32] - lam * (o[d0][r] * rli[r]); ss += d[d0] * d[d0]; }
            ss += __builtin_bit_cast(float, __builtin_amdgcn_update_dpp(0, __builtin_bit_cast(int, ss), 0xB1, 0xf, 0xf, true));
            ss += __builtin_bit_cast(float, __builtin_amdgcn_update_dpp(0, __builtin_bit_cast(int, ss), 0x4E, 0xf, 0xf, true));
            ss += __builtin_bit_cast(float, __builtin_amdgcn_update_dpp(0, __builtin_bit_cast(int, ss), 0x141, 0xf, 0xf, true));
            ss += __builtin_bit_cast(float, __builtin_amdgcn_update_dpp(0, __builtin_bit_cast(int, ss), 0x140, 0xf, 0xf, true));
            { auto rr = __builtin_amdgcn_permlane16_swap(__float_as_uint(ss), __float_as_uint(ss), false, false); ss = __uint_as_float(rr[0]) + __uint_as_float(rr[1]); }
            const float rs = __builtin_amdgcn_rsqf(ss * (1.f / 128.f) + 1e-5f);
#pragma unroll
            for (int d0 = 0; d0 < 4; ++d0) { const unsigned w = quad_pack_fp8(d[d0] * rs * gn[d0] * OB8_SCALE);
                if ((r32 & 3) == 0) *(unsigned*)(orowp + (ooff8 + d0 * 32)) = w; }
            if ((r & 1) == 1) asm volatile("" ::: "memory"); }
    }
    asm volatile("s_waitcnt lgkmcnt(0)\n\ts_barrier" ::: "memory");
}
#undef D2_WAIT_BAR
#undef D2_PIN
#undef D2_MF
#undef D2_MX3
#undef D2_Z16
#undef SBAR
}

#define LAS __attribute__((address_space(3)))

#define XB_TMO      128
#define XB_XCNT(j)  (256  + 64 * (j))
#define XB_XSUB(j)  (1280 + 64 * (j))
#define XB_XGEN(j)  (2304 + 64 * (j))
#define XB_TOP      3328
#define XB_TOPGEN   3392
#define XCD_BAR_WORDS 3456
#define XB_SPIN_CAP (1u << 18)

__device__ __forceinline__ unsigned xb_ld(unsigned* p)              { return __hip_atomic_load(p, __ATOMIC_RELAXED, __HIP_MEMORY_SCOPE_AGENT); }
__device__ __forceinline__ unsigned xb_add(unsigned* p, unsigned v) { return __hip_atomic_fetch_add(p, v, __ATOMIC_RELAXED, __HIP_MEMORY_SCOPE_AGENT); }
__device__ __forceinline__ unsigned xb_xcc_id() { return (unsigned)__builtin_amdgcn_s_getreg((3 << 11) | 20) & 0xFu; }
#define XB_SPIN(cond, bar) do { unsigned _sp = 0; while (cond) { __builtin_amdgcn_s_sleep(1); \
    if ((++_sp & 255u) == 0u) { if (xb_ld(&(bar)[XB_TMO])) break; if (_sp > XB_SPIN_CAP) { atomicAdd(&(bar)[XB_TMO], 1u); break; } } } } while (0)

struct XcdBarrier {
    unsigned* bar; unsigned x;
    volatile LAS unsigned* st;
};

__device__ __forceinline__ XcdBarrier xcd_barrier_post(unsigned* bar, volatile LAS unsigned* st, bool thread0) {
    XcdBarrier b; b.bar = bar; b.x = xb_xcc_id(); b.st = st;
    if (thread0) (void)xb_add(&bar[XB_XCNT(b.x)], 1u);
    return b;
}
__device__ __forceinline__ void xcd_barrier_complete(unsigned* bar, unsigned x, unsigned& nloc, unsigned& nx) {
    const unsigned G = gridDim.x * gridDim.y * gridDim.z;
    unsigned sum, cnt, mine, sp = 0u;
    for (;;) {
        sum = 0u; cnt = 0u; mine = 0u;
#pragma unroll
        for (unsigned j = 0; j < 16; ++j) { const unsigned c = xb_ld(&bar[XB_XCNT(j)]); sum += c; cnt += (c > 0u) ? 1u : 0u; mine = (j == x) ? c : mine; }
        if (sum == G) break;
        __builtin_amdgcn_s_sleep(1);
        if ((++sp & 255u) == 0u) { if (xb_ld(&bar[XB_TMO])) break; if (sp > XB_SPIN_CAP) { atomicAdd(&bar[XB_TMO], 1u); break; } }
    }
    nloc = mine > 0u ? mine : 1u; nx = cnt > 0u ? cnt : 1u;
}

__device__ __forceinline__ void xcd_barrier(const XcdBarrier& b, bool thread0) {
    asm volatile("s_waitcnt vmcnt(0)" ::: "memory");
    __syncthreads();
    if (thread0) {
        unsigned* bar = b.bar;
        __builtin_amdgcn_s_waitcnt(0);
        unsigned nloc = b.st[0], nx = b.st[1];
        if (nloc == 0u) { xcd_barrier_complete(bar, b.x, nloc, nx); b.st[0] = nloc; b.st[1] = nx; }
        const unsigned old = xb_add(&bar[XB_XSUB(b.x)], 1u);
        const unsigned gen = old / nloc;
        if (old + 1u == (gen + 1u) * nloc) {
            __builtin_amdgcn_fence(__ATOMIC_RELEASE, "agent");
            asm volatile("s_waitcnt vmcnt(0)" ::: "memory");
            const unsigned og = xb_add(&bar[XB_TOP], 1u);
            const unsigned tg = og / nx;
            if (og + 1u == (tg + 1u) * nx) xb_add(&bar[XB_TOPGEN], 1u);
            else XB_SPIN(xb_ld(&bar[XB_TOPGEN]) == tg, bar);
            __builtin_amdgcn_fence(__ATOMIC_ACQUIRE, "agent");
            xb_add(&bar[XB_XGEN(b.x)], 1u);
            asm volatile("s_waitcnt vmcnt(0)" ::: "memory");
        } else {
            XB_SPIN(xb_ld(&bar[XB_XGEN(b.x)]) == gen, bar);
            __builtin_amdgcn_fence(__ATOMIC_ACQUIRE, "agent");
            asm volatile("s_waitcnt vmcnt(0)" ::: "memory");
        }
    }
    __syncthreads();
}

constexpr int NWAVES = 8;
constexpr int NTOK = 16384, DM = 2048, SEQ = 2048, NHEAD = 16, NLAYER = 4, NEXP = 16, DEXP = 1024;
constexpr int XS_ROWS = 36864;
constexpr float LN_EPS = 1e-5f;
constexpr float DN_ALPHA = 1.6817928305074292f;
constexpr float LOG2E = 1.4426950408889634f;
constexpr float SB_QSCALE = 0.08838834764831845f * LOG2E;
constexpr float DF_QSCALE = 0.125f * LOG2E;
#ifndef MK_MULTI
#define MK_MULTI 0
#endif
#ifndef MOE_F8
#define MOE_F8 1
#endif
#ifndef QKV8_A
#define QKV8_A 1
#endif
#ifndef QKV8_B
#define QKV8_B 0
#endif
#ifndef DF_RING
#define DF_RING 1
#endif
constexpr int NSTEPS = 1 + 8 * NLAYER;

constexpr size_t MiB = 1u << 20;
constexpr size_t WS_CTL = 0, CTL_ZERO_BYTES = 256 * 1024;
constexpr size_t WS_COS = 1 * MiB, WS_SIN = WS_COS + 256 * 1024;
constexpr size_t WS_WR = 2 * MiB;
constexpr size_t WS_CNT = 3 * MiB;
constexpr size_t WS_RE = WS_CNT + 64 * 1024;
constexpr size_t WS_RW = WS_RE + 64 * 1024;
constexpr size_t WS_RP = WS_RW + 128 * 1024;
constexpr int LDH = 2048;
constexpr int P8K2 = 2048, P8K1 = 1024;
constexpr size_t WS_WQKVA = 4 * MiB;
constexpr size_t WS_WOA = WS_WQKVA + 56 * MiB;
constexpr size_t WS_WQKVB = WS_WOA + 16 * MiB;
constexpr size_t WS_WOB = WS_WQKVB + 36 * MiB;
constexpr size_t WS_WGU = WS_WOB + 16 * MiB;
constexpr size_t WS_WDN = WS_WGU + 512 * MiB;
constexpr size_t WS_H = WS_WDN + 256 * MiB;
constexpr size_t WS_HB = WS_H + 128 * MiB;
constexpr size_t WS_QKV = WS_HB + 68 * MiB;
constexpr size_t WS_OB = WS_QKV + 192 * MiB;
constexpr size_t WS_XS = WS_OB + 64 * MiB;
constexpr size_t WS_ACT = WS_XS + 144 * MiB;
constexpr size_t WS_YD = WS_ACT + 72 * MiB;
constexpr size_t WS_END = WS_YD + 144 * MiB;
static_assert(WS_END <= (size_t)2040 * MiB, "workspace map");
static_assert((size_t)2 * 6144 * LDH * 2 <= 56 * MiB && (size_t)8192 * LDH * 2 <= 36 * MiB && (size_t)2 * 2048 * P8K2 <= 16 * MiB && (size_t)64 * 2048 * P8K2 <= 512 * MiB && (size_t)64 * 2048 * P8K1 <= 256 * MiB, "weight regions");
static_assert((size_t)NTOK * LDH * 2 <= 68 * MiB && (size_t)NTOK * P8K2 <= 64 * MiB && (size_t)XS_ROWS * P8K2 <= 144 * MiB && (size_t)XS_ROWS * P8K1 <= 72 * MiB, "activation regions");
constexpr int CW_MTC = 8192;
constexpr int CW_BAR = 1024;
constexpr int LDS_BYTES = 163840;
constexpr int WCOL_OFF = 147456;
constexpr int LDSCTL_OFF = 145408;
constexpr int RING_OFF = 0;
constexpr int LNX_OFF = 131072;

#define GAS __attribute__((address_space(1)))
typedef unsigned short bf16;
typedef unsigned v4u __attribute__((ext_vector_type(4)));
typedef unsigned v2u __attribute__((ext_vector_type(2)));
typedef float f32x4 __attribute__((ext_vector_type(4)));
typedef float f32x2 __attribute__((ext_vector_type(2)));
typedef _Float16 f16x4 __attribute__((ext_vector_type(4)));
__device__ __forceinline__ f32x4 ldh4(const _Float16* p) { return __builtin_convertvector(*(const f16x4*)p, f32x4); }
__device__ __forceinline__ void sth4(_Float16* p, f32x4 v) { __builtin_nontemporal_store(__builtin_convertvector(v, f16x4), (f16x4*)p); }
#define LDS_WAIT() asm volatile("s_waitcnt lgkmcnt(0)" ::: "memory")
#define VM_WAIT() asm volatile("s_waitcnt vmcnt(0)" ::: "memory")
__device__ __forceinline__ unsigned pk2(float lo, float hi) { unsigned r; asm volatile("v_cvt_pk_bf16_f32 %0, %1, %2" : "=v"(r) : "v"(lo), "v"(hi)); return r; }
__device__ __forceinline__ int opq_tid(int wave) { int t = tid_from_wave(wave); asm volatile("" : "+v"(t)); return t; }
__device__ __forceinline__ float dpp_sum(float v) {
    v += __builtin_bit_cast(float, __builtin_amdgcn_update_dpp(0, __builtin_bit_cast(int, v), 0xB1, 0xf, 0xf, true));
    v += __builtin_bit_cast(float, __builtin_amdgcn_update_dpp(0, __builtin_bit_cast(int, v), 0x4E, 0xf, 0xf, true));
    v += __builtin_bit_cast(float, __builtin_amdgcn_update_dpp(0, __builtin_bit_cast(int, v), 0x141, 0xf, 0xf, true));
    v += __builtin_bit_cast(float, __builtin_amdgcn_update_dpp(0, __builtin_bit_cast(int, v), 0x140, 0xf, 0xf, true));
    const int b = __builtin_bit_cast(int, v);
    const float s0 = __builtin_bit_cast(float, __builtin_amdgcn_readlane(b, 0)), s1 = __builtin_bit_cast(float, __builtin_amdgcn_readlane(b, 16));
    const float s2 = __builtin_bit_cast(float, __builtin_amdgcn_readlane(b, 32)), s3 = __builtin_bit_cast(float, __builtin_amdgcn_readlane(b, 48));
    return (s0 + s1) + (s2 + s3);
}
__device__ __forceinline__ float wave_sum(float v) {
#pragma unroll
    for (int o = 1; o < 64; o <<= 1) v += __shfl_xor(v, o);
    return v;
}

struct Args { const float* in[17]; float* out; unsigned char* ws; int s_lo, s_hi; };

__device__ __forceinline__ int map_row(int n, int mode) {
    if (mode == 0) return n;
    if (mode == 1) { const int c = n & 255, blk = c >> 6, d = c & 63; return (n & ~255) + ((d >> 5) << 7) + (blk << 5) + (d & 31); }
    return ((n >> 7) << 8) + (n & 127) + (mode == 3 ? 128 : 0);
}
__device__ __forceinline__ unsigned pk2h(float lo, float hi) { typedef _Float16 h2 __attribute__((ext_vector_type(2))); const f32x2 v = {lo, hi}; return __builtin_bit_cast(unsigned, __builtin_convertvector(v, h2)); }
__device__ __forceinline__ void cvt_load(f32x4 (&v)[16], const float* __restrict__ src, int pitch, int k0, int n0, int kind, int lane) {
    if (kind == 2) { const int kr = lane >> 3, n4 = (lane & 7) * 4; const float* p = src + (size_t)(k0 + kr) * pitch + n0 + n4;
#pragma unroll
        for (int i = 0; i < 16; ++i) v[i] = __builtin_nontemporal_load((const f32x4*)(p + (size_t)(8 * i) * pitch)); }
    else { const int kr = lane >> 4, n4 = (lane & 15) * 4; const float* p = src + (size_t)(k0 + kr) * pitch + n0 + n4;
#pragma unroll
        for (int i = 0; i < 16; ++i) v[i] = __builtin_nontemporal_load((const f32x4*)(p + (size_t)(4 * i) * pitch)); }
}
__device__ __forceinline__ void cvt_store(const f32x4 (&v)[16], unsigned char* __restrict__ dst, int dp, int mode, int k0, int n0, int kind, LAS float* scr, int lane) {
    if (kind == 2) {
        const int kr = lane >> 3, n4 = (lane & 7) * 4;
#pragma unroll
        for (int i = 0; i < 16; ++i) { LAS float* s = scr + (8 * i + kr) * 33 + n4; s[0] = v[i][0] * pg8::W8_SCALE; s[1] = v[i][1] * pg8::W8_SCALE; s[2] = v[i][2] * pg8::W8_SCALE; s[3] = v[i][3] * pg8::W8_SCALE; }
        LDS_WAIT();
        const int c = lane & 7;
#pragma unroll
        for (int j = 0; j < 4; ++j) { const int nl = (lane >> 3) + 8 * j; const int row = map_row(n0 + nl, mode);
            const LAS float* s = scr + (16 * c) * 33 + nl;
            v4u o; o.x = pg8::pack4_fp8(s[0], s[33], s[66], s[99]); o.y = pg8::pack4_fp8(s[132], s[165], s[198], s[231]);
            o.z = pg8::pack4_fp8(s[264], s[297], s[330], s[363]); o.w = pg8::pack4_fp8(s[396], s[429], s[462], s[495]);
            __builtin_nontemporal_store(o, (v4u*)(dst + (size_t)row * dp + k0 + 16 * c)); }
    } else {
        const int kr = lane >> 4, n4 = (lane & 15) * 4;
#pragma unroll
        for (int i = 0; i < 16; ++i) { LAS float* s = scr + (4 * i + kr) * 65 + n4; s[0] = v[i][0]; s[1] = v[i][1]; s[2] = v[i][2]; s[3] = v[i][3]; }
        LDS_WAIT();
        const int c = lane & 7;
#pragma unroll
        for (int j = 0; j < 8; ++j) { const int nl = (lane >> 3) + 8 * j; const int row = map_row(n0 + nl, mode);
            const LAS float* s = scr + (8 * c) * 65 + nl;
            v4u o; o.x = pk2h(s[0], s[65]); o.y = pk2h(s[130], s[195]); o.z = pk2h(s[260], s[325]); o.w = pk2h(s[390], s[455]);
            __builtin_nontemporal_store(o, (v4u*)(dst + (size_t)row * dp + (k0 + 8 * c) * 2)); }
    }
    LDS_WAIT();
}

__global__ void __launch_bounds__(NWAVES * 64, 2) yoco_fwd(Args args) {
    extern __shared__ __attribute__((aligned(16))) unsigned char lds_raw[];
    LAS unsigned char* const lds = (LAS unsigned char*)lds_raw;
    const int tid = threadIdx.x, lane = tid & 63, wave = __builtin_amdgcn_readfirstlane(tid >> 6);
    const int G = gridDim.x, bx = blockIdx.x;
    const int vcu = (G % 8 == 0) ? (bx % 8) * (G / 8) + bx / 8 : bx;
    unsigned char* const ws = args.ws;
    volatile LAS unsigned* const CTL = (volatile LAS unsigned*)(lds + LDSCTL_OFF);
    LAS int* const TAB = (LAS int*)(lds + LDSCTL_OFF + 64);
    for (int u = tid; u < (LDS_BYTES - LDSCTL_OFF) / 4; u += NWAVES * 64) ((LAS unsigned*)(lds + LDSCTL_OFF))[u] = 0u;
    __syncthreads();
    const int s_lo = args.s_lo, s_hi = args.s_hi;
    XcdBarrier bar; bar.bar = (unsigned*)(ws + WS_CTL) + CW_BAR; bar.x = 0; bar.st = nullptr;
    if (s_hi - s_lo > 1) bar = xcd_barrier_post((unsigned*)(ws + WS_CTL) + CW_BAR, CTL, tid == 0);
#ifndef PH_MASK
#define PH_MASK 0xFFFF
#endif
#define PHM(b) (((PH_MASK) >> (b)) & 1)
#ifndef PROBE_DUP
#define PROBE_DUP 0
#endif
#define PREP(b) _Pragma("unroll 1") for (int rep_ = 0; rep_ < ((((PROBE_DUP) >> (b)) & 1) ? 2 : 1); ++rep_) if ((rep_ == 1 && ((PROBE_DUP >> 12) & 1)) ? (xcd_barrier(bar, tid_from_wave(wave) == 0), true) : true)
#define IN(k) (s_lo <= (k) && (k) < s_hi)
#define SEAM(k) do { if ((k) + 1 < s_hi) xcd_barrier(bar, tid_from_wave(wave) == 0); } while (0)

    const float* const x_in = args.in[0];
    _Float16* const H = (_Float16*)(ws + WS_H); unsigned char* const HB8 = (unsigned char*)(ws + WS_OB + 32 * MiB);     bf16* const QKV = (bf16*)(ws + WS_QKV); bf16* const OB = (bf16*)(ws + WS_OB);
    bf16* const MIX = (bf16*)(ws + WS_YD);     bf16* const XS = (bf16*)(ws + WS_XS); float* const S1 = (float*)(ws + WS_XS); bf16* const ACT = (bf16*)(ws + WS_ACT); bf16* const YD = (bf16*)(ws + WS_YD);
    float* const WR = (float*)(ws + WS_WR);
    int* const CNT = (int*)(ws + WS_CNT); unsigned* const RE = (unsigned*)(ws + WS_RE); f32x2* const RW = (f32x2*)(ws + WS_RW); int* const RP = (int*)(ws + WS_RP);

    if (IN(0) && PHM(0)) { PREP(0) {
        const int tid = opq_tid(wave), lane = tid & 63;
        LAS float* scr = (LAS float*)(lds + RING_OFF + wave * 16896);
        const int gw = vcu * NWAVES + wave, NGW = G * NWAVES;
        constexpr int I0 = 2 * 3072, I1 = 8 * 1024, I2 = 128 * 512, I3 = 64 * 512, NITEMS = I0 + I1 + I2 + I3;
        static_assert(QKV8_A == 1 && QKV8_B == 0, "conversion table below: stick-breaking q|k|v and all other fp8 GEMM weights -> e4m3, differential q|k|v weights -> fp16");
#define CVT_DECODE(it_, SRC, PIT, DST, DP, MODE, K0, N0, KIND) do { int r = (it_); \
            if (r < I0) { const int job = r / 3072; r -= job * 3072; const int kb = r / 192, nb = r - kb * 192; \
                SRC = args.in[1] + (size_t)job * 2048 * 6144; PIT = 6144; DST = ws + WS_WQKVA + (size_t)job * 6144 * 2048; DP = 2048; MODE = 0; K0 = kb * 128; N0 = nb * 32; KIND = 2; break; } \
            r -= I0; \
            if (r < I1) { const int job = r >> 10; r &= 1023; const int r1_ = r; K0 = (r >> 6) * 128; N0 = (r & 63) * 32; PIT = 2048; MODE = 0; KIND = 2; DP = P8K2; \
                if (job < 2) { SRC = args.in[2] + (size_t)job * 2048 * 2048; DST = ws + WS_WOA + (size_t)job * 2048 * P8K2; } \
                else if (job >= 6) { SRC = args.in[5] + (size_t)(job - 6) * 2048 * 2048; DST = ws + WS_WOB + (size_t)(job - 6) * 2048 * P8K2; } \
                else { KIND = 1; DP = LDH * 2; K0 = (r1_ >> 5) * 64; N0 = (r1_ & 31) * 64; \
                    if (job == 2) { SRC = args.in[4]; DST = ws + WS_WQKVB; MODE = 1; } \
                    else if (job == 3) { SRC = args.in[3]; PIT = 4096; DST = ws + WS_WQKVB + (size_t)2048 * LDH * 2; MODE = 1; } \
                    else if (job == 4) { SRC = args.in[3] + 2048; PIT = 4096; DST = ws + WS_WQKVB + (size_t)4096 * LDH * 2; } \
                    else { SRC = args.in[4] + (size_t)2048 * 2048; DST = ws + WS_WQKVB + (size_t)6144 * LDH * 2; MODE = 1; } } \
                break; } \
            r -= I1; \
            if (r < I2) { const int job = r >> 9; r &= 511; const int le = job >> 1, up = job & 1;     \
                SRC = (up ? args.in[15] : args.in[14]) + (size_t)le * 2048 * 1024; PIT = 1024; DST = ws + WS_WGU + (size_t)le * 2048 * P8K2; DP = P8K2; MODE = 2 + up; K0 = (r >> 5) * 128; N0 = (r & 31) * 32; KIND = 2; break; } \
            r -= I2; \
            { const int le = r >> 9; r &= 511; SRC = args.in[16] + (size_t)le * 1024 * 2048; PIT = 2048; DST = ws + WS_WDN + (size_t)le * 2048 * P8K1; DP = P8K1; MODE = 0; K0 = (r >> 6) * 128; N0 = (r & 63) * 32; KIND = 2; } \
        } while (0)
        { const float* sA; const float* sB; unsigned char* dA; unsigned char* dB; int pA, pB, qA, qB, mA, mB, kA, kB, nA, nB, tA, tB; f32x4 va[16], vb[16];
          int it = gw;
          if (it < NITEMS) { CVT_DECODE(it, sA, pA, dA, qA, mA, kA, nA, tA); cvt_load(va, sA, pA, kA, nA, tA, lane);
            for (;;) {
                if (it + NGW < NITEMS) { CVT_DECODE(it + NGW, sB, pB, dB, qB, mB, kB, nB, tB); cvt_load(vb, sB, pB, kB, nB, tB, lane); }
                cvt_store(va, dA, qA, mA, kA, nA, tA, scr, lane); it += NGW; if (it >= NITEMS) break;
                if (it + NGW < NITEMS) { CVT_DECODE(it + NGW, sA, pA, dA, qA, mA, kA, nA, tA); cvt_load(va, sA, pA, kA, nA, tA, lane); }
                cvt_store(vb, dB, qB, mB, kB, nB, tB, scr, lane); it += NGW; if (it >= NITEMS) break;
            } } }
#undef CVT_DECODE
        for (size_t i = (size_t)gw * 64 + lane; i < (size_t)NTOK * DM / 4; i += (size_t)NGW * 64) {
            const f32x4 v = ((const f32x4*)x_in)[i];
            ((unsigned*)HB8)[i] = pg8::pack4_fp8(v[0], v[1], v[2], v[3]); }
        for (int i = bx * (NWAVES * 64) + tid; i < NLAYER * 20 * 2048; i += G * NWAVES * 64) { const int k = i & 2047, c = (i >> 11) % 20, l = i / (20 * 2048);
            WR[i] = c < 4 ? args.in[12][((size_t)l * 2048 + k) * 4 + c] : args.in[13][(((size_t)l * 4 + ((c - 4) >> 2)) * 2048 + k) * 4 + ((c - 4) & 3)]; }
        }
        SEAM(0);
    }

    for (int L = 0; L < NLAYER; ++L) {
        const int sb = 1 + 8 * L; const bool typeA = L < 2;
        if (IN(sb + 0)) {
            if (typeA && PHM(1)) { PREP(1) {
                pg8::StaticOrder S; S.init(NTOK, 6144, G, bx);
                if (QKV8_A) { pg8::Gemm g{(const bf16*)HB8, (const bf16*)(ws + WS_WQKVA + (size_t)L * 6144 * 2048), NTOK, 6144, DM / 2, DM / 2, wave}; pg8::EpiQkv E{QKV, 6144, 2048, SB_QSCALE, 1.f / pg8::W8_UNDO};
                    pg8::gemm_phase<pg8::EpiQkv, pg8::StaticOrder, true, true, true>(lds + RING_OFF, g, S, E); }
                } static_assert(QKV8_A == 1, "the stick-breaking layers' q|k|v GEMM takes the e4m3 copy of the stream");
            } else if (!typeA && PHM(2)) { PREP(2) {
                const int N = (L == 2) ? 6144 : 2048;
                pg8::StaticOrder S; S.init(NTOK, N, G, bx);
                if (QKV8_B) { pg8::Gemm g{(const bf16*)HB8, (const bf16*)(ws + WS_WQKVB + (L == 2 ? (size_t)0 : (size_t)6144 * 2048)), NTOK, N, DM / 2, DM / 2, wave};
                    pg8::EpiRope E{QKV, 6144, 2048, 4096, DF_QSCALE, 1.f / pg8::W8_UNDO};
                    pg8::gemm_phase<pg8::EpiRope, pg8::StaticOrder, true, true, true>(lds + RING_OFF, g, S, E); }
                else { pg8::Gemm g{(const bf16*)H, (const bf16*)(ws + WS_WQKVB) + (L == 2 ? (size_t)0 : (size_t)6144 * LDH), NTOK, N, DM, LDH, wave};
                    pg8::EpiRope E{QKV, 6144, 2048, 4096, DF_QSCALE, 1.f};
                    pg8::gemm_phase<pg8::EpiRope, pg8::StaticOrder, true, true, false, true>(lds + RING_OFF, g, S, E); } }
            }
            SEAM(sb + 0);
        }
        if (IN(sb + 1)) {
            if (typeA && PHM(3)) {
                for (int id_ = vcu; id_ < 512 * (1 + ((PROBE_DUP >> 3) & 1)); id_ += G) { if (((PROBE_DUP >> 12) & 1) && id_ >= 512 && id_ < 512 + G) xcd_barrier(bar, tid_from_wave(wave) == 0); const int id = id_ & 511; const int bh = id >> 2, p = id & 3, b = bh >> 4, h = bh & 15;
                    const bf16* Qg = QKV + (size_t)b * SEQ * 6144 + h * 128; bf16* Og = (bf16*)((unsigned char*)OB + (size_t)b * SEQ * P8K2 + h * 128);
                    att::sb_block(Qg, Qg + 2048, Qg + 4096, Og, 7 - p, (att::ldsp)(lds + RING_OFF), wave);
                    att::sb_block(Qg, Qg + 2048, Qg + 4096, Og, p, (att::ldsp)(lds + RING_OFF), wave); }
            } else if (!typeA && PHM(4)) {
                const int lane = opq_tid(wave) & 63;
                const int i = L - 2; const float lam_init = (L == 2) ? 0.47071301834264183f : 0.5560582041556061f;
                const float* lp = args.in[6] + (size_t)i * 256;
                const float sa = dpp_sum(lp[lane] * lp[64 + lane]), sb2 = dpp_sum(lp[128 + lane] * lp[192 + lane]);
                const float lam = __builtin_amdgcn_exp2f(sa * LOG2E) - __builtin_amdgcn_exp2f(sb2 * LOG2E) + lam_init;
                const float* gsub = args.in[7] + (size_t)i * 128; const float gmul = 1.f - lam_init;
                for (int id_ = vcu; id_ < 512 * (1 + ((PROBE_DUP >> 4) & 1)); id_ += G) { if (((PROBE_DUP >> 12) & 1) && id_ >= 512 && id_ < 512 + G) xcd_barrier(bar, tid_from_wave(wave) == 0); const int id = id_ & 511; const int bh = id >> 2, p = id & 3, b = bh >> 4, h = bh & 15;
                    const bf16* Qg = QKV + (size_t)b * SEQ * 6144 + h * 128; bf16* Og = (bf16*)((unsigned char*)OB + (size_t)b * SEQ * P8K2 + h * 128); float* Sg = S1 + (size_t)b * SEQ * DM + h * 128;
#pragma unroll 1
                    for (int w = 0; w < 2; ++w) { const int qb = w ? p : 7 - p;
#if DF_RING
                        att::diff_pass2<false>(Qg, Qg + 2048, Qg + 4096, Sg, Og, qb, lam, gsub, gmul, (att::ldsp)(lds + RING_OFF), wave);
                        att::diff_pass2<true>(Qg + 64, Qg + 2048 + 64, Qg + 4096, Sg, Og, qb, lam, gsub, gmul, (att::ldsp)(lds + RING_OFF), wave); } }
#else
                        att::diff_pass<false>(Qg, Qg + 2048, Qg + 4096, Sg, Og, qb, lam, gsub, gmul, (att::ldsp)(lds + RING_OFF), wave);
                        att::diff_pass<true>(Qg + 64, Qg + 2048 + 64, Qg + 4096, Sg, Og, qb, lam, gsub, gmul, (att::ldsp)(lds + RING_OFF), wave); } }
#endif
            }
            SEAM(sb + 1);
        }
        if (IN(sb + 2)) { if (PHM(5)) {
            pg8::Gemm g{OB, (const bf16*)(ws + (typeA ? WS_WOA : WS_WOB) + (size_t)(L & 1) * 2048 * P8K2), NTOK, DM, DM / 2, P8K2 / 2, wave}; pg8::StaticOrder S; S.init(NTOK, DM, G, bx);
            pg8::EpiQkv E{MIX, DM, 0, 1.f, 1.f / (pg8::W8_UNDO * att::OB8_SCALE)};
            pg8::gemm_phase<pg8::EpiQkv, pg8::StaticOrder, true, true, true>(lds + RING_OFF, g, S, E); }
            SEAM(sb + 2);
        }
        if (IN(sb + 3)) { if (PHM(6)) {
            const int tid = opq_tid(wave), lane = tid & 63;
            const float* lng = args.in[8] + (size_t)L * DM; const float* lnb = args.in[9] + (size_t)L * DM; const float* wr = WR + (size_t)L * 20 * 2048;
            LAS int* eid = (LAS int*)(lds + LNX_OFF + 2048);
            LAS float* lgt = (LAS float*)(lds + LNX_OFF + 4096);
            LAS unsigned* rows8 = (LAS unsigned*)(lds + RING_OFF);
            for (int c = bx; c < 256; c += G) {
                const unsigned wcl = (unsigned)(uintptr_t)(lds + WCOL_OFF) + (unsigned)wave * 1024u; const unsigned wvo = (unsigned)(wave * 256 + lane * 4) * 4u;
#define LN1_DMAW(col, buf) att::glds16s(wvo, wr + (size_t)(col) * 2048, (unsigned)__builtin_amdgcn_readfirstlane(wcl + (unsigned)(buf) * 8192u))
                LN1_DMAW(0, 0); LN1_DMAW(1, 1);
#pragma unroll 1
                for (int grp = 0; grp < 2; ++grp) {
                    const int rloc = wave * 8 + grp * 4; const size_t row0 = (size_t)64 * c + rloc;
                    f32x4 v[4][8]; float mu[4], rstd[4];
#pragma unroll
                    for (int rr = 0; rr < 4; ++rr) {
                        if (L == 0) { const f32x4* hp = (const f32x4*)(x_in + (row0 + rr) * DM) + lane;
#pragma unroll
                            for (int j = 0; j < 8; ++j) v[rr][j] = hp[64 * j]; }
                        else { const _Float16* hq = H + (row0 + rr) * DM + 4 * lane;
#pragma unroll
                            for (int j = 0; j < 8; ++j) v[rr][j] = ldh4(hq + 256 * j); } }
#pragma unroll
                    for (int rr = 0; rr < 4; ++rr) { const v2u* mp = (const v2u*)(MIX + (row0 + rr) * DM) + lane;
#pragma unroll
                        for (int j = 0; j < 8; ++j) { const v2u a = mp[64 * j];
                            const f32x4 fa = {__uint_as_float(a.x << 16), __uint_as_float(a.x & 0xffff0000u), __uint_as_float(a.y << 16), __uint_as_float(a.y & 0xffff0000u)};
                            v[rr][j] = v[rr][j] * DN_ALPHA + fa; } }
#pragma unroll
                    for (int rr = 0; rr < 4; ++rr) { float s = 0.f;
#pragma unroll
                        for (int j = 0; j < 8; ++j) s += (v[rr][j][0] + v[rr][j][1]) + (v[rr][j][2] + v[rr][j][3]);
                        mu[rr] = dpp_sum(s) * (1.f / DM); float q = 0.f;
#pragma unroll
                        for (int j = 0; j < 8; ++j) { const f32x4 d = v[rr][j] - mu[rr]; q += (d[0] * d[0] + d[1] * d[1]) + (d[2] * d[2] + d[3] * d[3]); }
                        rstd[rr] = 1.f / sqrtf(dpp_sum(q) * (1.f / DM) + LN_EPS); }
#pragma unroll
                    for (int j = 0; j < 8; ++j) { const f32x4 gg = ((const f32x4*)lng)[64 * j + lane], bb = ((const f32x4*)lnb)[64 * j + lane];
#pragma unroll
                        for (int rr = 0; rr < 4; ++rr) { v[rr][j] = (v[rr][j] - mu[rr]) * rstd[rr] * gg + bb; sth4(H + (row0 + rr) * DM + 256 * j + 4 * lane, v[rr][j]);
                            if (c == bx) rows8[(rloc + rr) * 512 + 64 * j + lane] = pg8::pack4_fp8(v[rr][j][0], v[rr][j][1], v[rr][j][2], v[rr][j][3]); } }
                    int gs[4] = {0, 0, 0, 0};
#pragma unroll 1
                    for (int cc = 0; cc < 20; ++cc) { const int q = grp * 20 + cc, bsel = q & 1;
                        if (q + 1 < 40) asm volatile("s_waitcnt vmcnt(1)\n\ts_barrier" ::: "memory"); else asm volatile("s_waitcnt vmcnt(0)\n\ts_barrier" ::: "memory");
                        f32x4 w[8];
                        { const LAS f32x4* wp = (const LAS f32x4*)(lds + WCOL_OFF + bsel * 8192) + lane;
#pragma unroll
                          for (int j = 0; j < 8; ++j) w[j] = wp[64 * j]; }
                        asm volatile("s_waitcnt lgkmcnt(0)\n\ts_barrier" ::: "memory");
                        if (q + 2 < 40) LN1_DMAW((q + 2) % 20, bsel);
#pragma unroll
                        for (int rr = 0; rr < 4; ++rr) { if (cc < 4 || gs[rr] == ((cc - 4) >> 2)) {
                            f32x2 a2 = {0.f, 0.f};
#pragma unroll
                            for (int j = 0; j < 8; ++j) { const f32x2 wlo = {w[j][0], w[j][1]}, whi = {w[j][2], w[j][3]}, vlo = {v[rr][j][0], v[rr][j][1]}, vhi = {v[rr][j][2], v[rr][j][3]};
                                a2 = __builtin_elementwise_fma(vlo, wlo, a2); a2 = __builtin_elementwise_fma(vhi, whi, a2); }
                            const float a = dpp_sum(a2[0] + a2[1]);
                            if (lane == 0) lgt[(rloc + rr) * 20 + cc] = a; } }
                        if (cc == 3) { LDS_WAIT();
#pragma unroll
                            for (int rr = 0; rr < 4; ++rr) { const LAS float* lg = lgt + (rloc + rr) * 20; int g = 0; float gm = lg[0];
#pragma unroll
                                for (int i = 1; i < 4; ++i) { const float x = lg[i]; if (x > gm) { gm = x; g = i; } }
                                gs[rr] = __builtin_amdgcn_readfirstlane(g); } } }
                }
#undef LN1_DMAW
                LDS_WAIT();
                if (lane < 8) {
                    const int rl = wave * 8 + lane; const LAS float* lg = lgt + rl * 20;
                    int gsel = 0; float gm = lg[0];
#pragma unroll
                    for (int i = 1; i < 4; ++i) { const float x = lg[i]; if (x > gm) { gm = x; gsel = i; } }
                    float gden = 0.f;
#pragma unroll
                    for (int i = 0; i < 4; ++i) gden += __builtin_amdgcn_exp2f((lg[i] - gm) * LOG2E);
                    const float gw_ = 1.f / gden;
                    const LAS float* li = lg + 4 + 4 * gsel;
                    const float l0 = li[0], l1 = li[1], l2 = li[2], l3 = li[3];
                    int i0 = 0; float v0 = l0;
                    if (l1 > v0) { v0 = l1; i0 = 1; } if (l2 > v0) { v0 = l2; i0 = 2; } if (l3 > v0) { v0 = l3; i0 = 3; }
                    int i1 = -1; float v1 = 0.f;
                    if (i0 != 0) { v1 = l0; i1 = 0; }
                    if (i0 != 1 && (i1 < 0 || l1 > v1)) { v1 = l1; i1 = 1; }
                    if (i0 != 2 && (i1 < 0 || l2 > v1)) { v1 = l2; i1 = 2; }
                    if (i0 != 3 && (i1 < 0 || l3 > v1)) { v1 = l3; i1 = 3; }
                    const float t = __builtin_amdgcn_exp2f((v1 - v0) * LOG2E); const float w0 = gw_ / (1.f + t), w1 = gw_ * t / (1.f + t);
                    eid[2 * rl] = gsel * 4 + i0; eid[2 * rl + 1] = gsel * 4 + i1; RW[(size_t)64 * c + rl] = (f32x2){w0, w1};
                }
                __syncthreads();
                if (wave == 0) {
                    const int ea = eid[lane], eb = eid[64 + lane]; int ra = 0, rb = 0, cnt = 0; const unsigned long long lt = (1ull << lane) - 1ull;
#pragma unroll
                    for (int e = 0; e < 16; ++e) { const unsigned long long ma = __ballot(ea == e), mb = __ballot(eb == e);
                        if (ea == e) ra = __popcll(ma & lt); if (eb == e) rb = __popcll(ma) + __popcll(mb & lt); if (lane == e) cnt = __popcll(ma) + __popcll(mb); }
                    if (lane < 16) CNT[c * 16 + lane] = cnt;
                    LAS int* rk = (LAS int*)(lds + LNX_OFF + 3072); rk[lane] = ra; rk[64 + lane] = rb; LDS_WAIT();
                    const int r = lane; const unsigned word = (unsigned)eid[2 * r] | ((unsigned)eid[2 * r + 1] << 8) | ((unsigned)rk[2 * r] << 16) | ((unsigned)rk[2 * r + 1] << 24);
                    RE[(size_t)64 * c + r] = word;
                }
                __syncthreads();
            } }
            SEAM(sb + 3);
        }
        if ((IN(sb + 4) || IN(sb + 5) || IN(sb + 6)) && PHM(7)) {
            const int tid = opq_tid(wave);
            LAS int* part = (LAS int*)(lds + LNX_OFF);
            { const int e = tid & 15, s = tid >> 4; int a = 0;
#pragma unroll
              for (int i = 0; i < 8; ++i) a += CNT[(8 * s + i) * 16 + e];
              part[s * 16 + e] = a; }
            __syncthreads();
            if (tid < 16) { int run = 0;
#pragma clang loop vectorize(disable)
#pragma unroll 8
                for (int s = 0; s < 32; ++s) run += part[s * 16 + tid];
                TAB[tid] = run; }
            __syncthreads();
            if (tid < 192) { int off = 0, mt = 0, mine = 15;
#pragma unroll
                for (int e = 0; e < 16; ++e) { const int nt = (TAB[e] + 255) >> 8; if (tid == 0) TAB[16 + e] = off; if (tid >= mt && tid < mt + nt) mine = e; off += nt * 256; mt += nt; }
                if (tid < mt && tid < 160) TAB[64 + tid] = mine;
                if (tid == 0) { TAB[32] = off; TAB[33] = mt; } }
            __syncthreads();
        }
        if (IN(sb + 4)) { if (PHM(7)) PREP(7) {
            const int tid = opq_tid(wave), lane = tid & 63;
            LAS int* part = (LAS int*)(lds + LNX_OFF);
            for (int c = bx; c < 256; c += G) {
                if (tid < 16) { int pre = 0; int x[8];
#pragma unroll
                    for (int i = 0; i < 8; ++i) x[i] = CNT[((c & ~7) + i) * 16 + tid];
#pragma clang loop vectorize(disable) unroll(disable)
                    for (int s = 0; s < (c >> 3); ++s) pre += part[s * 16 + tid];
#pragma unroll
                    for (int i = 0; i < 8; ++i) pre += (i < (c & 7)) ? x[i] : 0;
                    TAB[48 + tid] = TAB[16 + tid] + pre; }
                __syncthreads();
#pragma unroll 1
                for (int rr = 0; rr < 8; ++rr) { const size_t row = (size_t)64 * c + wave * 8 + rr; const unsigned word = RE[row];
                    const int p0 = TAB[48 + (word & 255)] + ((word >> 16) & 255), p1 = TAB[48 + ((word >> 8) & 255)] + (word >> 24);
                    if (lane == 0) { RP[2 * row] = p0; RP[2 * row + 1] = p1; }
                    if (c == bx && IN(sb + 3)) {
                        const LAS v4u* src = (const LAS v4u*)(lds + RING_OFF + (wave * 8 + rr) * 2048) + lane; v4u* o0 = (v4u*)((unsigned char*)XS + (size_t)p0 * P8K2) + lane; v4u* o1 = (v4u*)((unsigned char*)XS + (size_t)p1 * P8K2) + lane;
                        const v4u a = src[0], b = src[64]; __builtin_nontemporal_store(a, o0); __builtin_nontemporal_store(b, o0 + 64); __builtin_nontemporal_store(a, o1); __builtin_nontemporal_store(b, o1 + 64);
                    } else {
                        const _Float16* hq = H + row * DM + 4 * lane; unsigned* o0 = (unsigned*)((unsigned char*)XS + (size_t)p0 * P8K2) + lane; unsigned* o1 = (unsigned*)((unsigned char*)XS + (size_t)p1 * P8K2) + lane;
#pragma unroll
                        for (int j = 0; j < 8; ++j) { const f32x4 v = ldh4(hq + 256 * j); const unsigned o = pg8::pack4_fp8(v[0], v[1], v[2], v[3]); o0[64 * j] = o; o1[64 * j] = o; } } }
                __syncthreads();
            } }
            SEAM(sb + 4);
        }
        if (IN(sb + 5)) { if (PHM(8)) PREP(8) {
            pg8::Gemm g{XS, (const bf16*)(ws + WS_WGU + (size_t)L * 16 * 2048 * P8K2), XS_ROWS, 2048, DM / 2, P8K2 / 2, wave};
            pg8::MoeOrder<0> S{TAB[33] * 8, G, bx, TAB + 64, nullptr, nullptr, wave}; pg8::EpiGateUp8 E{(unsigned char*)ACT};
            pg8::gemm_phase<pg8::EpiGateUp8, pg8::MoeOrder<0>, true, true, true>(lds + RING_OFF, g, S, E); }
            SEAM(sb + 5);
        }
        if (IN(sb + 6)) { if (PHM(9)) PREP(9) {
            pg8::Gemm g{ACT, (const bf16*)(ws + WS_WDN + (size_t)L * 16 * 2048 * P8K1), XS_ROWS, 2048, DEXP / 2, P8K1 / 2, wave};
            pg8::MoeOrder<0> S{TAB[33] * 8, G, bx, TAB + 64, nullptr, nullptr, wave}; pg8::EpiDown8 E{(unsigned char*)YD};
            pg8::gemm_phase<pg8::EpiDown8, pg8::MoeOrder<0>, true, true, true>(lds + RING_OFF, g, S, E); }
            SEAM(sb + 6);
        }
        if (IN(sb + 7)) { if (PHM(10)) for (int rep_ = 0; rep_ < ((((PROBE_DUP) >> 10) & 1) && L == NLAYER - 1 ? 5 : 1); ++rep_) {
            const int tid = opq_tid(wave), lane = tid & 63;
            const float* lng = args.in[10] + (size_t)L * DM; const float* lnb = args.in[11] + (size_t)L * DM; const bool last = (L == NLAYER - 1); const bool next8 = (L + 1 < 2) ? (QKV8_A != 0) : (QKV8_B != 0);
            const int gw = vcu * NWAVES + wave, NGW = G * NWAVES;
            for (int row0 = 4 * gw; row0 < NTOK; row0 += 4 * NGW) {
                f32x4 v[4][8]; float mu[4], rstd[4];
#pragma unroll
                for (int rr = 0; rr < 4; ++rr) { const int row = row0 + rr;
                    const int p0 = RP[2 * row], p1 = RP[2 * row + 1]; const f32x2 w = RW[row];
                    const _Float16* hq = H + (size_t)row * DM + 4 * lane; const unsigned* y0 = (const unsigned*)((const unsigned char*)YD + (size_t)p0 * DM) + lane; const unsigned* y1 = (const unsigned*)((const unsigned char*)YD + (size_t)p1 * DM) + lane;
                    const float w0s = w.x * (1.f / pg8::YD8_SCALE), w1s = w.y * (1.f / pg8::YD8_SCALE);
#pragma unroll
                    for (int j = 0; j < 8; ++j) { const f32x4 h = ldh4(hq + 256 * j); const unsigned a = y0[64 * j], b = y1[64 * j];
                        const f32x2 a0 = __builtin_amdgcn_cvt_pk_f32_fp8((int)a, false), a1 = __builtin_amdgcn_cvt_pk_f32_fp8((int)a, true), b0 = __builtin_amdgcn_cvt_pk_f32_fp8((int)b, false), b1 = __builtin_amdgcn_cvt_pk_f32_fp8((int)b, true);
                        const f32x4 fa = {a0[0], a0[1], a1[0], a1[1]}, fb = {b0[0], b0[1], b1[0], b1[1]};
                        v[rr][j] = h * DN_ALPHA + fa * w0s + fb * w1s; } }
#pragma unroll
                for (int rr = 0; rr < 4; ++rr) { float s = 0.f;
#pragma unroll
                    for (int j = 0; j < 8; ++j) s += (v[rr][j][0] + v[rr][j][1]) + (v[rr][j][2] + v[rr][j][3]);
                    mu[rr] = dpp_sum(s) * (1.f / DM); float q = 0.f;
#pragma unroll
                    for (int j = 0; j < 8; ++j) { const f32x4 dd = v[rr][j] - mu[rr]; q += (dd[0] * dd[0] + dd[1] * dd[1]) + (dd[2] * dd[2] + dd[3] * dd[3]); }
                    rstd[rr] = 1.f / sqrtf(dpp_sum(q) * (1.f / DM) + LN_EPS); }
#pragma unroll
                for (int j = 0; j < 8; ++j) { const f32x4 gg = ((const f32x4*)lng)[64 * j + lane], bb = ((const f32x4*)lnb)[64 * j + lane];
#pragma unroll
                    for (int rr = 0; rr < 4; ++rr) { const int row = row0 + rr; const f32x4 y = (v[rr][j] - mu[rr]) * rstd[rr] * gg + bb;
                        if (last) __builtin_nontemporal_store(y, (f32x4*)(args.out + (size_t)row * DM) + 64 * j + lane);
                        else { sth4(H + (size_t)row * DM + 256 * j + 4 * lane, y); if (next8) __builtin_nontemporal_store(pg8::pack4_fp8(y[0], y[1], y[2], y[3]), (unsigned*)(HB8 + (size_t)row * DM) + 64 * j + lane); } } }
            } }
            SEAM(sb + 7);
        }
    }
#undef IN
#undef SEAM
}

extern "C" void kernel_launch(void* const* d_in, const int* in_sizes, int n_in, void* d_out, int out_size, void* d_ws, size_t ws_size, hipStream_t stream) {
    static int grid = 0;
    if (grid == 0) {
        if (n_in != 17 || in_sizes[0] != NTOK * DM || out_size != NTOK * DM || ws_size < WS_END) { fprintf(stderr, "kernel_launch: unexpected shapes / workspace (n_in %d, ws %zu, need %zu)\n", n_in, ws_size, (size_t)WS_END); grid = -1; return; }
        int dev = 0, cus = 0, per_cu = 0;
        if (hipGetDevice(&dev) != hipSuccess || hipDeviceGetAttribute(&cus, hipDeviceAttributeMultiprocessorCount, dev) != hipSuccess) { grid = -1; return; }
        if (hipFuncSetAttribute((const void*)yoco_fwd, hipFuncAttributeMaxDynamicSharedMemorySize, LDS_BYTES) != hipSuccess) { fprintf(stderr, "kernel_launch: hipFuncSetAttribute failed\n"); grid = -1; return; }
        if (hipOccupancyMaxActiveBlocksPerMultiprocessor(&per_cu, (const void*)yoco_fwd, NWAVES * 64, LDS_BYTES) != hipSuccess || per_cu < 1) { fprintf(stderr, "kernel_launch: occupancy query says %d\n", per_cu); per_cu = 1; }
        (void)hipGetLastError();
        grid = cus;
    }
    if (grid < 0) return;
    (void)hipMemsetAsync((char*)d_ws + WS_CTL, 0, CTL_ZERO_BYTES, stream);
    Args a{};
    for (int i = 0; i < 17; ++i) a.in[i] = (const float*)d_in[i];
    a.out = (float*)d_out; a.ws = (unsigned char*)d_ws;
#if MK_MULTI
    for (int s = 0; s < NSTEPS; ++s) { a.s_lo = s; a.s_hi = s + 1; hipLaunchKernelGGL(yoco_fwd, dim3(grid), dim3(NWAVES * 64), LDS_BYTES, stream, a); }
#else
    a.s_lo = 0; a.s_hi = NSTEPS;
    hipLaunchKernelGGL(yoco_fwd, dim3(grid), dim3(NWAVES * 64), LDS_BYTES, stream, a);
#endif
    const hipError_t le = hipPeekAtLastError();
    if (le != hipSuccess) fprintf(stderr, "kernel_launch: launch failed: %s\n", hipGetErrorName(le));
}
```

```cpp
#include <hip/hip_runtime.h>
#include <cstdio>
#include <cstdint>

__device__ __forceinline__ int tid_from_wave(int wave) { int l; asm volatile("v_mbcnt_lo_u32_b32 %0, -1, 0\n\tv_mbcnt_hi_u32_b32 %0, -1, %0" : "=v"(l)); return wave * 64 + l; }
namespace pg8 {
#define PG8_LAS __attribute__((address_space(3)))
typedef unsigned short bf16_t;
typedef short bf16x8 __attribute__((ext_vector_type(8)));
typedef float f32x4 __attribute__((ext_vector_type(4)));
typedef unsigned u32x4 __attribute__((ext_vector_type(4)));
typedef int pg8_v8i __attribute__((ext_vector_type(8)));
typedef _Float16 pg8_h8 __attribute__((ext_vector_type(8)));
constexpr int BM = 256, BK = 64, HALF = 128, HTB = HALF * BK * 2  , STAGE_BYTES = 8 * HTB, NXCD = 8, WGM = 8;

__host__ __device__ __forceinline__ int lds_byte(int r, int c) { const int st = (r >> 4) * 2 + (c >> 5), rr = r & 15, cc = c & 31, ob = rr * 64 + cc * 2; return st * 1024 + (ob ^ (((ob >> 9) & 1) << 5)); }
__host__ __device__ __forceinline__ void stage_rc(int b, int& R, int& C) { const int st = b / 1024, sb = b % 1024, swz = sb ^ (((sb >> 9) & 1) << 5); R = (st >> 1) * 16 + swz / 64; C = (st & 1) * 32 + (swz % 64) / 2; }
__host__ __device__ __forceinline__ int perm32(int rho) { const int n = rho >> 4, i = rho & 15; return 8 * (i >> 2) + 4 * n + (i & 3); }

struct Unit { int pm, pn; };
struct Gemm { const bf16_t* A; const bf16_t* Bt; int M, N, K, ld, wave; };

struct StaticOrder {
    int nM, nN, nwg, G, c;
    __host__ __device__ void init(int M, int N, int G_, int c_) { nM = M / BM; nN = N / BM; nwg = nM * nN; G = G_; c = c_; }
    __host__ __device__ bool next(int i, Unit& u) const {
        const long L = (long)i * G + c; if (L >= nwg) return false;
        int wgid = (int)L; { const int q = nwg / NXCD, r = nwg % NXCD, xcd = wgid % NXCD, off = wgid / NXCD; wgid = (xcd < r ? xcd * (q + 1) : r * (q + 1) + (xcd - r) * q) + off; }
        const int nig = WGM * nN, gid = wgid / nig, fm = gid * WGM, gsz = (nM - fm) < WGM ? (nM - fm) : WGM;
        u.pm = fm + ((wgid % nig) % gsz); u.pn = (wgid % nig) / gsz; return true;
    }
    __device__ __forceinline__ void a_ready(const Unit&) const {}
    __device__ __forceinline__ void done(const Unit&) const {}
};

__device__ __forceinline__ unsigned cvt_pk_bf16(float lo, float hi) { unsigned r; asm volatile("v_cvt_pk_bf16_f32 %0, %1, %2" : "=v"(r) : "v"(lo), "v"(hi)); return r; }
typedef float f32x2 __attribute__((ext_vector_type(2)));

typedef unsigned u32x2 __attribute__((ext_vector_type(2)));
__device__ __forceinline__ u32x4 pack8_bf16(const f32x4 a, const f32x4 b) { u32x4 w; w.x = cvt_pk_bf16(a[0], a[1]); w.y = cvt_pk_bf16(a[2], a[3]); w.z = cvt_pk_bf16(b[0], b[1]); w.w = cvt_pk_bf16(b[2], b[3]); return w; }

struct EpiQkv {
    static constexpr bool PERM = true, AFTER_DRAIN = false;
    bf16_t* O; int ldc; int qcols; float qscale; float osc;
    __device__ __forceinline__ void operator()(const f32x4 (&acc)[2][2][4][2], const Unit& u, int wr, int wc, int fr, int fq) const {
        const int row0 = u.pm * BM + wr * 64 + fr, colt = u.pn * BM; const float sc = (colt < qcols ? qscale : 1.f) * osc;
        const int col0 = colt + wc * 32 + 8 * fq;
#pragma unroll
        for (int ai = 0; ai < 2; ++ai)
#pragma unroll
            for (int m = 0; m < 4; ++m) { bf16_t* rowp = O + (size_t)(row0 + ai * HALF + m * 16) * ldc + col0;
#pragma unroll
                for (int bj = 0; bj < 2; ++bj) *(u32x4*)(rowp + bj * HALF) = pack8_bf16(acc[ai][bj][m][0] * sc, acc[ai][bj][m][1] * sc); }
    }
};
template <int ACCS_INV> struct EpiResid {
    static constexpr bool PERM = false, AFTER_DRAIN = false;
    static constexpr int ldc = 2048; static constexpr float alpha = 1.6817928305074292f, accs = 1.f / (float)ACCS_INV;
    float* H; const float* Hsrc;
    __device__ __forceinline__ void operator()(const f32x4 (&acc)[2][2][4][2], const Unit& u, int wr, int wc, int fr, int fq) const {
        const int row0 = u.pm * BM + wr * 64 + fr, col0 = u.pn * BM + wc * 32 + 4 * fq;
#pragma unroll
        for (int ai = 0; ai < 2; ++ai)
#pragma unroll
            for (int m = 0; m < 4; ++m) { const size_t ro = (size_t)(row0 + ai * HALF + m * 16) * ldc + col0; float* rowp = H + ro; const float* srcp = Hsrc + ro;
#pragma unroll
                for (int bj = 0; bj < 2; ++bj)
#pragma unroll
                    for (int n = 0; n < 2; ++n) { const f32x4 h = *(const f32x4*)(srcp + bj * HALF + n * 16); *(f32x4*)(rowp + bj * HALF + n * 16) = h * alpha + acc[ai][bj][m][n] * accs; } }
    }
};
struct EpiRope {
    static constexpr bool PERM = true, AFTER_DRAIN = false;
    bf16_t* O; int ldc; int qcols, ropecols; float qscale; float osc;
    __device__ __forceinline__ void operator()(const f32x4 (&acc)[2][2][4][2], const Unit& u, int wr, int wc, int fr, int fq) const {
        const int row0 = u.pm * BM + wr * 64 + fr, colt = u.pn * BM;
        if (colt >= ropecols) {
            const int col0 = colt + wc * 32 + 8 * fq;
#pragma unroll
            for (int ai = 0; ai < 2; ++ai)
#pragma unroll
                for (int m = 0; m < 4; ++m) { bf16_t* rowp = O + (size_t)(row0 + ai * HALF + m * 16) * ldc + col0;
#pragma unroll
                    for (int bj = 0; bj < 2; ++bj) *(u32x4*)(rowp + bj * HALF) = pack8_bf16(acc[ai][bj][m][0] * osc, acc[ai][bj][m][1] * osc); }
        } else {
            const float sc = (colt < qcols ? qscale : 1.f) * osc;
            const int col0 = colt + wc * 64 + 8 * fq;
            float ir[8];
#pragma unroll
            for (int i = 0; i < 8; ++i) ir[i] = __builtin_amdgcn_exp2f(-(float)(8 * fq + i) * 0.4152410118609203f) * 0.15915494309189535f;
#pragma unroll
            for (int ai = 0; ai < 2; ++ai)
#pragma unroll
                for (int m = 0; m < 4; ++m) { const int row = row0 + ai * HALF + m * 16; const float pos = (float)(row & 2047);
                    f32x4 c0, c1, s0, s1;
#pragma unroll
                    for (int i = 0; i < 4; ++i) { const float f0 = __builtin_amdgcn_fractf(pos * ir[i]), f1 = __builtin_amdgcn_fractf(pos * ir[4 + i]);
                        c0[i] = __builtin_amdgcn_cosf(f0); s0[i] = __builtin_amdgcn_sinf(f0); c1[i] = __builtin_amdgcn_cosf(f1); s1[i] = __builtin_amdgcn_sinf(f1); }
                    const f32x4 a0 = acc[ai][0][m][0], a1 = acc[ai][0][m][1], b0 = acc[ai][1][m][0], b1 = acc[ai][1][m][1];
                    bf16_t* rowp = O + (size_t)row * ldc + col0;
                    *(u32x4*)(rowp) = pack8_bf16((a0 * c0 - b0 * s0) * sc, (a1 * c1 - b1 * s1) * sc);
                    *(u32x4*)(rowp + 32) = pack8_bf16((b0 * c0 + a0 * s0) * sc, (b1 * c1 + a1 * s1) * sc); }
        }
    }
};
struct EpiGateUp {
    static constexpr bool PERM = true, AFTER_DRAIN = false;
    bf16_t* O;
    __device__ __forceinline__ void operator()(const f32x4 (&acc)[2][2][4][2], const Unit& u, int wr, int wc, int fr, int fq) const {
        const int row0 = u.pm * BM + wr * 64 + fr, col0 = (u.pn & 7) * 128 + wc * 32 + 8 * fq;
#pragma unroll
        for (int ai = 0; ai < 2; ++ai)
#pragma unroll
            for (int m = 0; m < 4; ++m) { f32x4 r[2];
#pragma unroll
                for (int n = 0; n < 2; ++n) { const f32x4 g = acc[ai][0][m][n], up = acc[ai][1][m][n];
#pragma unroll
                    for (int i = 0; i < 4; ++i) { const float e = __builtin_amdgcn_exp2f(g[i] * -1.4426950408889634f); r[n][i] = g[i] * __builtin_amdgcn_rcpf(1.f + e) * up[i]; } }
                *(u32x4*)(O + (size_t)(row0 + ai * HALF + m * 16) * 1024 + col0) = pack8_bf16(r[0], r[1]); }
    }
};
struct EpiDown {
    static constexpr bool PERM = true, AFTER_DRAIN = false;
    bf16_t* O;
    __device__ __forceinline__ void operator()(const f32x4 (&acc)[2][2][4][2], const Unit& u, int wr, int wc, int fr, int fq) const {
        const int row0 = u.pm * BM + wr * 64 + fr, col0 = (u.pn & 7) * BM + wc * 32 + 8 * fq;
#pragma unroll
        for (int ai = 0; ai < 2; ++ai)
#pragma unroll
            for (int m = 0; m < 4; ++m) { bf16_t* rowp = O + (size_t)(row0 + ai * HALF + m * 16) * 2048 + col0;
#pragma unroll
                for (int bj = 0; bj < 2; ++bj) *(u32x4*)(rowp + bj * HALF) = pack8_bf16(acc[ai][bj][m][0], acc[ai][bj][m][1]); }
    }
};
#ifndef PROBE_MFMA2
#define PROBE_MFMA2 0
#endif
constexpr float W8_SCALE = 64.f, ACT8_SCALE = 4.f, W8_UNDO = W8_SCALE * (PROBE_MFMA2 ? 2.f : 1.f);
__device__ __forceinline__ unsigned pack4_fp8(float a, float b, float c, float d) { int w; asm volatile("" : "=v"(w));
    w = __builtin_amdgcn_cvt_pk_fp8_f32(a, b, w, false); w = __builtin_amdgcn_cvt_pk_fp8_f32(c, d, w, true); return (unsigned)w; }
struct EpiGateUp8 {
    static constexpr bool PERM = true, AFTER_DRAIN = false;
    unsigned char* O;
    __device__ __forceinline__ void operator()(const f32x4 (&acc)[2][2][4][2], const Unit& u, int wr, int wc, int fr, int fq) const {
        const int row0 = u.pm * BM + wr * 64 + fr, col0 = (u.pn & 7) * 128 + wc * 32 + 8 * fq;
        constexpr float SI = 1.f / W8_UNDO;
#pragma unroll
        for (int ai = 0; ai < 2; ++ai)
#pragma unroll
            for (int m = 0; m < 4; ++m) { f32x4 r[2];
#pragma unroll
                for (int n = 0; n < 2; ++n) { const f32x4 g = acc[ai][0][m][n] * SI, up = acc[ai][1][m][n] * (SI * ACT8_SCALE);
#pragma unroll
                    for (int i = 0; i < 4; ++i) { const float e = __builtin_amdgcn_exp2f(g[i] * -1.4426950408889634f); r[n][i] = g[i] * __builtin_amdgcn_rcpf(1.f + e) * up[i]; } }
                u32x2 w; w.x = pack4_fp8(r[0][0], r[0][1], r[0][2], r[0][3]); w.y = pack4_fp8(r[1][0], r[1][1], r[1][2], r[1][3]);
                *(u32x2*)(O + (size_t)(row0 + ai * HALF + m * 16) * 1024 + col0) = w; }
    }
};
constexpr float YD8_SCALE = 16.f;
struct EpiDown8 {
    static constexpr bool PERM = true, AFTER_DRAIN = false;
    unsigned char* O;
    __device__ __forceinline__ void operator()(const f32x4 (&acc)[2][2][4][2], const Unit& u, int wr, int wc, int fr, int fq) const {
        const int row0 = u.pm * BM + wr * 64 + fr, col0 = (u.pn & 7) * BM + wc * 32 + 8 * fq;
        constexpr float SI = YD8_SCALE / (W8_UNDO * ACT8_SCALE);
#pragma unroll
        for (int ai = 0; ai < 2; ++ai)
#pragma unroll
            for (int m = 0; m < 4; ++m) { unsigned char* rowp = O + (size_t)(row0 + ai * HALF + m * 16) * 2048 + col0;
#pragma unroll
                for (int bj = 0; bj < 2; ++bj) { const f32x4 a = acc[ai][bj][m][0] * SI, c = acc[ai][bj][m][1] * SI; u32x2 w; w.x = pack4_fp8(a[0], a[1], a[2], a[3]); w.y = pack4_fp8(c[0], c[1], c[2], c[3]);
                    *(u32x2*)(rowp + bj * HALF) = w; } }
    }
};
template <int ROLE> struct MoeOrder {
    int nunits, G, c; const PG8_LAS int* tile_e; unsigned* cnt; unsigned* tmo; int wave;
    __device__ __forceinline__ bool next(int i, Unit& u) const {
        const int cc = (ROLE == 2) ? G - 1 - c : c; int idx;
        if ((G & 7) == 0) { const int per = G >> 3; idx = (i * 8 + (cc & 7)) * per + (cc >> 3); } else idx = i * G + cc;
        if (idx >= nunits) return false;
        const int mt = idx >> 3; u.pm = mt; u.pn = tile_e[mt] * 8 + (idx & 7); return true;
    }
    __device__ __forceinline__ void a_ready(const Unit& u) const {
        if constexpr (ROLE == 2) {
            if (wave == 0) { const bool lane0 = (tid_from_wave(0) == 0);
                const unsigned long long t0 = __builtin_amdgcn_s_memrealtime(); unsigned polls = 0;
                while ((unsigned)__builtin_amdgcn_readfirstlane(__hip_atomic_load(cnt + 64 * u.pm, __ATOMIC_RELAXED, __HIP_MEMORY_SCOPE_AGENT)) < 64u) {
                    if ((++polls & 255u) == 0u && __builtin_amdgcn_readfirstlane(__hip_atomic_load(tmo, __ATOMIC_RELAXED, __HIP_MEMORY_SCOPE_AGENT)) != 0u) break;
                    if (__builtin_amdgcn_s_memrealtime() - t0 > 2000000ull) { if (lane0) __hip_atomic_store(tmo, 1u, __ATOMIC_RELAXED, __HIP_MEMORY_SCOPE_AGENT); break; }
                    __builtin_amdgcn_s_sleep(2); }
                __builtin_amdgcn_fence(__ATOMIC_ACQUIRE, "agent");
                asm volatile("s_waitcnt vmcnt(0)" ::: "memory");
            }
            asm volatile("" ::: "memory"); __builtin_amdgcn_s_barrier(); asm volatile("" ::: "memory");
        }
    }
    __device__ __forceinline__ void done(const Unit& u) const {
        if constexpr (ROLE == 1) {
            asm volatile("s_waitcnt vmcnt(0)" ::: "memory");
            if (tid_from_wave(0) == 0) __hip_atomic_fetch_add(cnt + 64 * u.pm, 1u, __ATOMIC_RELAXED, __HIP_MEMORY_SCOPE_AGENT);
        }
    }
};

#ifndef PROBE_MFMA2
#define PROBE_MFMA2 0
#endif
template <class Epi, class Sched, bool ALIGN_EPI = false, bool SP2 = false, bool F8 = false, bool F16 = false>
__device__ __forceinline__ void gemm_phase(PG8_LAS unsigned char* lds, const Gemm g, const Sched& S, const Epi& E) {
    int tid_ = tid_from_wave(g.wave); asm volatile("" : "+v"(tid_));
    const int tid = tid_, wid = __builtin_amdgcn_readfirstlane(tid >> 6), lane = tid & 63, wr = wid >> 2, wc = wid & 3, fr = lane & 15, fq = lane >> 4;
    const int K = g.K, LD = g.ld, nt = K / BK;
    unsigned voffA, voffB;
    { int R, C; stage_rc(tid * 16, R, C); const int Rb = Epi::PERM ? ((R & ~31) + perm32(R & 31)) : R;
        voffA = (unsigned)(R * LD + C) * 2u; voffB = (unsigned)(Rb * LD + C) * 2u; }
    const size_t pstep = (size_t)64 * LD * 2;
    const size_t kstep = (size_t)(BK * 2);
    const size_t hstep = (size_t)HALF * LD * 2;
    const size_t tstep = 2 * hstep;
    const unsigned ldsbase = (unsigned)(uintptr_t)lds;
    const unsigned ldsw = (unsigned)wid * 1024u;
    const int aoff = lds_byte(wr * 64 + fr, fq * 8), boff = lds_byte(wc * 32 + fr, fq * 8);
#define PG8_SA(b, h) (((b) * 2 + (h)) * HTB)
#define PG8_SB(b, h) ((4 + (b) * 2 + (h)) * HTB)
#define PG8_STAGE(bufoff, gbase, voff) do { _Pragma("unroll") for (int _i = 0; _i < 2; ++_i) { unsigned keep_; \
        asm volatile("s_mov_b32 %0, m0\n\ts_mov_b32 m0, %3\n\ts_nop 0\n\tglobal_load_lds_dwordx4 %1, %2\n\ts_mov_b32 m0, %0" : "=&s"(keep_) \
            : "v"(voff), "s"((const char*)(gbase) + _i * pstep), "s"(ldsbase + (unsigned)(bufoff) + ldsw + (unsigned)(_i * 8192))); } } while (0)
#define PG8_CAT(a, b) __builtin_bit_cast(pg8_v8i, __builtin_shufflevector(a, b, 0, 1, 2, 3, 4, 5, 6, 7, 8, 9, 10, 11, 12, 13, 14, 15))
#define PG8_LDA(dst, b, h) do { if constexpr (F8) { _Pragma("unroll") for (int m = 0; m < 4; ++m) { const bf16x8 lo_ = *(const PG8_LAS bf16x8*)(lds + PG8_SA(b, h) + aoff + m * 2048), hi_ = *(const PG8_LAS bf16x8*)(lds + PG8_SA(b, h) + aoff + m * 2048 + 1024); dst##8[m] = PG8_CAT(lo_, hi_); } } \
        else { _Pragma("unroll") for (int m = 0; m < 4; ++m) _Pragma("unroll") for (int k = 0; k < 2; ++k) dst[m][k] = *(const PG8_LAS bf16x8*)(lds + PG8_SA(b, h) + aoff + m * 2048 + k * 1024); } } while (0)
#define PG8_LDB(dst, b, h) do { if constexpr (F8) { _Pragma("unroll") for (int n = 0; n < 2; ++n) { const bf16x8 lo_ = *(const PG8_LAS bf16x8*)(lds + PG8_SB(b, h) + boff + n * 2048), hi_ = *(const PG8_LAS bf16x8*)(lds + PG8_SB(b, h) + boff + n * 2048 + 1024); dst##8[n] = PG8_CAT(lo_, hi_); } } \
        else { _Pragma("unroll") for (int n = 0; n < 2; ++n) _Pragma("unroll") for (int k = 0; k < 2; ++k) dst[n][k] = *(const PG8_LAS bf16x8*)(lds + PG8_SB(b, h) + boff + n * 2048 + k * 1024); } } while (0)
#define PG8_MMA(ai, bj, At, Bt) do { __builtin_amdgcn_s_setprio(1); \
        if constexpr (F8) { _Pragma("unroll") for (int m = 0; m < 4; ++m) _Pragma("unroll") for (int n = 0; n < 2; ++n) \
            { acc[ai][bj][m][n] = __builtin_amdgcn_mfma_scale_f32_16x16x128_f8f6f4(Bt##8[n], At##8[m], acc[ai][bj][m][n], 0, 0, 0, 0, 0, 0); \
              if (PROBE_MFMA2) acc[ai][bj][m][n] = __builtin_amdgcn_mfma_scale_f32_16x16x128_f8f6f4(Bt##8[n], At##8[m], acc[ai][bj][m][n], 0, 0, 0, 0, 0, 0); } } \
        else { _Pragma("unroll") for (int m = 0; m < 4; ++m) _Pragma("unroll") for (int n = 0; n < 2; ++n) _Pragma("unroll") for (int k = 0; k < 2; ++k) \
            acc[ai][bj][m][n] = F16 ? __builtin_amdgcn_mfma_f32_16x16x32_f16(__builtin_bit_cast(pg8_h8, Bt[n][k]), __builtin_bit_cast(pg8_h8, At[m][k]), acc[ai][bj][m][n], 0, 0, 0) \
                                    : __builtin_amdgcn_mfma_f32_16x16x32_bf16(Bt[n][k], At[m][k], acc[ai][bj][m][n], 0, 0, 0); } \
        __builtin_amdgcn_s_setprio(0); } while (0)
#define PG8_WAIT_V(n) asm volatile("s_waitcnt vmcnt(" #n ")" ::: "memory")
#define PG8_WAIT_L(n) asm volatile("s_waitcnt lgkmcnt(" #n ")" ::: "memory")
#define PG8_BAR __builtin_amdgcn_s_barrier()
#define PG8_SCHED __builtin_amdgcn_sched_barrier(0)
    Unit cur, nxt; int ui = 0;
    if (!S.next(0, cur)) return;
    f32x4 acc[2][2][4][2];
{ float zero_; asm volatile("v_mov_b32 %0, 0" : "=v"(zero_));
#pragma unroll
    for (int a = 0; a < 2; ++a)
#pragma unroll
        for (int b = 0; b < 2; ++b)
#pragma unroll
            for (int m = 0; m < 4; ++m)
#pragma unroll
                for (int n = 0; n < 2; ++n) acc[a][b][m][n] = (f32x4){zero_, zero_, zero_, zero_}; }
    bf16x8 At[4][2], B0[2][2], B1[2][2]; pg8_v8i At8[4], B08[2], B18[2];
    const char* cA = (const char*)g.A + (size_t)cur.pm * tstep; const char* cB = (const char*)g.Bt + (size_t)cur.pn * tstep;
    S.a_ready(cur);
    if constexpr (SP2) {
        PG8_STAGE(PG8_SB(0, 0), cB, voffB); PG8_STAGE(PG8_SB(0, 1), cB + hstep, voffB); PG8_STAGE(PG8_SA(0, 0), cA, voffA); PG8_STAGE(PG8_SA(0, 1), cA + hstep, voffA);
        if (wr == 1) PG8_BAR;
        PG8_WAIT_V(2); PG8_BAR;
        PG8_STAGE(PG8_SB(1, 0), cB + kstep, voffB); PG8_STAGE(PG8_SA(1, 0), cA + kstep, voffA); PG8_STAGE(PG8_SB(1, 1), cB + hstep + kstep, voffB);
        PG8_WAIT_V(6); PG8_BAR;
    } else {
        PG8_STAGE(PG8_SB(0, 0), cB, voffB); PG8_STAGE(PG8_SA(0, 0), cA, voffA); PG8_STAGE(PG8_SB(0, 1), cB + hstep, voffB); PG8_STAGE(PG8_SA(0, 1), cA + hstep, voffA);
        if (wr == 1) PG8_BAR;
        PG8_WAIT_V(4); PG8_BAR;
        PG8_STAGE(PG8_SB(1, 0), cB + kstep, voffB); PG8_STAGE(PG8_SA(1, 0), cA + kstep, voffA); PG8_STAGE(PG8_SB(1, 1), cB + hstep + kstep, voffB);
        PG8_WAIT_V(6); PG8_BAR;
    }
    for (;;) {
        const bool has_next = S.next(ui + 1, nxt);
        const char* nA = has_next ? (const char*)g.A + (size_t)nxt.pm * tstep : cA; const char* nB = has_next ? (const char*)g.Bt + (size_t)nxt.pn * tstep : cB;
#pragma unroll 1
        for (int t = 0; t < nt; t += 2) {
            const bool last = (t == nt - 2);
            const char* a1 = cA + (size_t)(t + 1) * kstep;
            const char* a2 = last ? nA : cA + (size_t)(t + 2) * kstep; const char* b2 = last ? nB : cB + (size_t)(t + 2) * kstep;
            const char* a3 = a2 + kstep; const char* b3 = b2 + kstep;
            if (last && has_next) S.a_ready(nxt);
            if constexpr (SP2) {
            PG8_LDB(B0, 0, 0); PG8_LDB(B1, 0, 1); PG8_SCHED; PG8_LDA(At, 0, 0); PG8_STAGE(PG8_SA(1, 1), a1 + hstep, voffA);
            PG8_WAIT_V(8); PG8_WAIT_L(0); PG8_BAR; PG8_MMA(0, 0, At, B0); PG8_MMA(0, 1, At, B1); PG8_BAR; PG8_SCHED;
            PG8_LDA(At, 0, 1); PG8_STAGE(PG8_SB(0, 0), b2, voffB); PG8_STAGE(PG8_SB(0, 1), b2 + hstep, voffB); PG8_STAGE(PG8_SA(0, 0), a2, voffA);
            PG8_WAIT_V(8); PG8_WAIT_L(0); PG8_BAR; PG8_MMA(1, 0, At, B0); PG8_MMA(1, 1, At, B1); PG8_BAR; PG8_SCHED;
            PG8_LDB(B0, 1, 0); PG8_LDB(B1, 1, 1); PG8_SCHED; PG8_LDA(At, 1, 0); PG8_STAGE(PG8_SA(0, 1), a2 + hstep, voffA);
            PG8_WAIT_V(8); PG8_WAIT_L(0); PG8_BAR; PG8_MMA(0, 0, At, B0); PG8_MMA(0, 1, At, B1); PG8_BAR; PG8_SCHED;
            PG8_LDA(At, 1, 1); PG8_STAGE(PG8_SB(1, 0), b3, voffB); PG8_STAGE(PG8_SB(1, 1), b3 + hstep, voffB); PG8_STAGE(PG8_SA(1, 0), a3, voffA);
            PG8_WAIT_V(8); PG8_WAIT_L(0); PG8_BAR; PG8_MMA(1, 0, At, B0); PG8_MMA(1, 1, At, B1); PG8_BAR; PG8_SCHED;
            } else {
            PG8_LDB(B0, 0, 0); PG8_SCHED; PG8_LDA(At, 0, 0); PG8_STAGE(PG8_SA(1, 1), a1 + hstep, voffA);
            PG8_WAIT_L(8); PG8_BAR; PG8_WAIT_L(0); PG8_MMA(0, 0, At, B0); PG8_BAR; PG8_SCHED;
            PG8_LDB(B1, 0, 1); PG8_STAGE(PG8_SB(0, 0), b2, voffB);
            PG8_BAR; PG8_WAIT_L(0); PG8_MMA(0, 1, At, B1); PG8_BAR;
            PG8_LDA(At, 0, 1); PG8_STAGE(PG8_SA(0, 0), a2, voffA);
            PG8_BAR; PG8_WAIT_L(0); PG8_MMA(1, 0, At, B0); PG8_BAR; PG8_SCHED;
            PG8_STAGE(PG8_SB(0, 1), b2 + hstep, voffB);
            PG8_WAIT_V(6); PG8_BAR; PG8_MMA(1, 1, At, B1); PG8_BAR;
            PG8_LDB(B0, 1, 0); PG8_SCHED; PG8_LDA(At, 1, 0); PG8_STAGE(PG8_SA(0, 1), a2 + hstep, voffA);
            PG8_WAIT_L(8); PG8_BAR; PG8_WAIT_L(0); PG8_MMA(0, 0, At, B0); PG8_BAR; PG8_SCHED;
            PG8_LDB(B1, 1, 1); PG8_STAGE(PG8_SB(1, 0), b3, voffB);
            PG8_BAR; PG8_WAIT_L(0); PG8_MMA(0, 1, At, B1); PG8_BAR;
            PG8_LDA(At, 1, 1); PG8_STAGE(PG8_SA(1, 0), a3, voffA);
            PG8_BAR; PG8_WAIT_L(0); PG8_MMA(1, 0, At, B0); PG8_BAR; PG8_SCHED;
            PG8_STAGE(PG8_SB(1, 1), b3 + hstep, voffB);
            PG8_WAIT_V(6); PG8_BAR; PG8_MMA(1, 1, At, B1); PG8_BAR;
            }
        }
        if constexpr (ALIGN_EPI) { if (wr == 0) PG8_BAR; }
        if constexpr (!Epi::AFTER_DRAIN) { const int t2_ = tid_from_wave(g.wave);
            E(acc, cur, wr, wc, t2_ & 15, (t2_ >> 4) & 3); S.done(cur); }
        if (!has_next) break;
{ float zero_; asm volatile("v_mov_b32 %0, 0" : "=v"(zero_));
#pragma unroll
        for (int a = 0; a < 2; ++a)
#pragma unroll
            for (int b = 0; b < 2; ++b)
#pragma unroll
                for (int m = 0; m < 4; ++m)
#pragma unroll
                    for (int n = 0; n < 2; ++n) acc[a][b][m][n] = (f32x4){zero_, zero_, zero_, zero_}; }
        cur = nxt; cA = nA; cB = nB; ++ui;
        if constexpr (ALIGN_EPI) { if (wr == 1) PG8_BAR; }
    }
    PG8_WAIT_V(0);
    if constexpr (!ALIGN_EPI) { if (wr == 0) PG8_BAR; }
    PG8_BAR;
    if constexpr (Epi::AFTER_DRAIN) { E.fused(acc, cur, wr, wc, fr, fq, lds, wid, lane); S.done(cur); }
#undef PG8_SA
#undef PG8_SB
#undef PG8_STAGE
#undef PG8_LDA
#undef PG8_LDB
#undef PG8_MMA
#undef PG8_CAT
#undef PG8_WAIT_V
#undef PG8_WAIT_L
#undef PG8_BAR
#undef PG8_SCHED
}
}

namespace att {
#define ALAS __attribute__((address_space(3)))
typedef unsigned short bf16_t;
typedef short bf16x8 __attribute__((ext_vector_type(8)));
typedef short s16x4 __attribute__((ext_vector_type(4)));
typedef float f32x16 __attribute__((ext_vector_type(16)));
typedef float f32x4 __attribute__((ext_vector_type(4)));
typedef unsigned u32x4 __attribute__((ext_vector_type(4)));
typedef ALAS char* ldsp;
#ifndef WO_F8
#define WO_F8 1
#endif
constexpr float OB8_SCALE = 8.f;
constexpr int QP = 6144;
constexpr int OP = 2048;
constexpr int OBP = 2048;
constexpr int SHM_V = 16384, SHM_K = 16384;
constexpr int LDS_V = 0, LDS_K = 2 * SHM_V, LDS_WS = LDS_K + 2 * SHM_K, ATT_LDS_BYTES = LDS_WS + 8 * 256;
#define KSWZ(row, colB) ((row) * 256 + ((colB) ^ (((row) & 7) << 4)))
#define KSWZ64(row, colB) ((row) * 128 + ((colB) ^ (((row) & 7) << 4)))
#define SBAR() __builtin_amdgcn_sched_barrier(0)
__device__ __forceinline__ int v_st(int k, int c) { const int kk = (k & ~0xC) | ((k & 4) << 1) | ((k & 8) >> 1); return ((kk >> 3) * 4 + (c >> 5)) * 512 + ((kk & 7) * 32 + (c & 31)) * 2; }
__device__ __forceinline__ int v_rd_base(int lane) { return ((lane & 3) << 3) | (((lane >> 2) & 3) << 6) | (((lane >> 4) & 1) << 5) | (((lane >> 5) & 1) << 8); }
constexpr int v_rd_off(int d0, int ks, int half) { return d0 * 512 + ks * 4096 + half * 2048; }
__device__ __forceinline__ int crow(int r, int hi) { return (r & 3) + 8 * (r >> 2) + 4 * hi; }
__device__ __forceinline__ unsigned cvtpk(float lo, float hi) { unsigned r; asm volatile("v_cvt_pk_bf16_f32 %0, %1, %2" : "=v"(r) : "v"(lo), "v"(hi)); return r; }
__device__ __forceinline__ bf16x8 ldg8(const bf16_t* p) { return *reinterpret_cast<const bf16x8*>(p); }
__device__ __forceinline__ unsigned quad_pack_fp8(float v) {
    const int b = __builtin_bit_cast(int, v);
    const float v1 = __builtin_bit_cast(float, __builtin_amdgcn_update_dpp(b, b, 0x55, 0xf, 0xf, false));
    const float v2 = __builtin_bit_cast(float, __builtin_amdgcn_update_dpp(b, b, 0xAA, 0xf, 0xf, false));
    const float v3 = __builtin_bit_cast(float, __builtin_amdgcn_update_dpp(b, b, 0xFF, 0xf, 0xf, false));
    int w; asm volatile("" : "=v"(w));
    w = __builtin_amdgcn_cvt_pk_fp8_f32(v, v1, w, false); w = __builtin_amdgcn_cvt_pk_fp8_f32(v2, v3, w, true); return (unsigned)w;
}
__device__ __forceinline__ float xhalf(float v, int hi) {
    auto rr = __builtin_amdgcn_permlane32_swap(__float_as_uint(v), __float_as_uint(v), false, false);
    return __uint_as_float(hi ? rr[0] : rr[1]);
}
#define ATT_PK4(P, B_, OUT) do { unsigned a0 = cvtpk(P[B_+0], P[B_+1]), a1 = cvtpk(P[B_+2], P[B_+3]);                      \
        unsigned b0 = cvtpk(P[B_+4], P[B_+5]), b1 = cvtpk(P[B_+6], P[B_+7]);                                             \
        auto r0 = __builtin_amdgcn_permlane32_swap(a0, b0, false, false); auto r1 = __builtin_amdgcn_permlane32_swap(a1, b1, false, false); \
        u32x4 w = {r0[0], r1[0], r0[1], r1[1]}; OUT = *reinterpret_cast<bf16x8*>(&w); } while (0)
__device__ __forceinline__ void pv_tile(f32x16* o, int vb, bf16x8 pa0, bf16x8 pa1, bf16x8 pa2, bf16x8 pa3) {
#define TRRD(dst, off) asm volatile("ds_read_b64_tr_b16 %0, %1 offset:%2" : "=&v"(dst) : "v"(vb), "i"(off) : "memory")
#define PV_D0(d0) do { s16x4 l0, l1, l2, l3, h0, h1, h2, h3; constexpr int b_ = v_rd_off(d0, 0, 0); \
        TRRD(l0, b_); TRRD(h0, b_ + 2048); TRRD(l1, b_ + 4096); TRRD(h1, b_ + 6144); TRRD(l2, b_ + 8192); TRRD(h2, b_ + 10240); TRRD(l3, b_ + 12288); TRRD(h3, b_ + 14336); \
        asm volatile("s_waitcnt lgkmcnt(0)" ::: "memory"); SBAR(); \
        o[d0] = __builtin_amdgcn_mfma_f32_32x32x16_bf16(pa0, (bf16x8){l0[0], l0[1], l0[2], l0[3], h0[0], h0[1], h0[2], h0[3]}, o[d0], 0, 0, 0);   \
        o[d0] = __builtin_amdgcn_mfma_f32_32x32x16_bf16(pa1, (bf16x8){l1[0], l1[1], l1[2], l1[3], h1[0], h1[1], h1[2], h1[3]}, o[d0], 0, 0, 0);   \
        o[d0] = __builtin_amdgcn_mfma_f32_32x32x16_bf16(pa2, (bf16x8){l2[0], l2[1], l2[2], l2[3], h2[0], h2[1], h2[2], h2[3]}, o[d0], 0, 0, 0);   \
        o[d0] = __builtin_amdgcn_mfma_f32_32x32x16_bf16(pa3, (bf16x8){l3[0], l3[1], l3[2], l3[3], h3[0], h3[1], h3[2], h3[3]}, o[d0], 0, 0, 0); } while (0)
    PV_D0(0); PV_D0(1); PV_D0(2); PV_D0(3);
#undef PV_D0
#undef TRRD
}

__device__ __forceinline__ void sb_block(const bf16_t* __restrict__ Qg, const bf16_t* __restrict__ Kg, const bf16_t* __restrict__ Vg, bf16_t* __restrict__ Og, int qb, ldsp lds, int wave_) {
    int tid_ = tid_from_wave(wave_); asm volatile("" : "+v"(tid_));
    const int tid = tid_, wid = __builtin_amdgcn_readfirstlane(tid >> 6), lane = tid & 63, r32 = lane & 31, hi = lane >> 5;
    const int NT = 4 * qb + 4, R0 = 256 * qb + 32 * wid, myrow = R0 + r32;
    const ldsp V_lds = lds + LDS_V; const ldsp K_lds = lds + LDS_K;
    bf16x8 qr[8];
    { const bf16_t* Qw = Qg + (size_t)R0 * QP; const unsigned qoff = (unsigned)(r32 * QP + hi * 8);
#pragma unroll
      for (int d0 = 0; d0 < 8; ++d0) qr[d0] = ldg8(Qw + (qoff + d0 * 16)); }
    const int sr = tid >> 4, sc = (tid & 15) * 8, kws = KSWZ(sr, sc * 2), vst0 = v_st(sr, sc), vst1 = v_st(32 + sr, sc);
    const unsigned kvoff = (unsigned)(sr * QP + sc);
    const int vb0 = (int)(unsigned)(uintptr_t)V_lds + v_rd_base(lane);
    bf16x8 sk0, sk1, sv0, sv1;
#define SB_LOAD(j) do { const bf16_t* kp_ = Kg + (size_t)(64 * (j)) * QP; const bf16_t* vp_ = Vg + (size_t)(64 * (j)) * QP; \
        sk0 = ldg8(kp_ + kvoff); sk1 = ldg8(kp_ + (size_t)32 * QP + kvoff); sv0 = ldg8(vp_ + kvoff); sv1 = ldg8(vp_ + (size_t)32 * QP + kvoff); } while (0)
#define SB_WRITE(bf) do { *(ALAS bf16x8*)(K_lds + (bf) * SHM_K + kws) = sk0; *(ALAS bf16x8*)(K_lds + (bf) * SHM_K + kws + 32 * 256) = sk1; \
        *(ALAS bf16x8*)(V_lds + (bf) * SHM_V + vst0) = sv0; *(ALAS bf16x8*)(V_lds + (bf) * SHM_V + vst1) = sv1; } while (0)
    SB_LOAD(NT - 1); SB_WRITE(0);
    __syncthreads();
    float carry = 0.f; f32x16 o[4] = {};
    ALAS int* fl = (ALAS int*)(lds + LDS_WS); bool wdone = false;
    for (int t = 0; t < NT; ++t) {
        const int j = NT - 1 - t, buf = t & 1, kb = 64 * j;
        if (t + 1 < NT) SB_LOAD(j - 1);
        if (kb <= R0 + 30 && !wdone) {
            f32x16 p0 = {}, p1 = {};
            { const ldsp Kb = K_lds + buf * SHM_K;
#pragma unroll
              for (int d0 = 0; d0 < 8; ++d0) { const ldsp a = Kb + KSWZ(r32, ((d0 & 3) * 16 + hi * 8) * 2) + (d0 >> 2) * 128;
                  const bf16x8 b0 = *(const ALAS bf16x8*)a, b1 = *(const ALAS bf16x8*)(a + 32 * 256);
                  p0 = __builtin_amdgcn_mfma_f32_32x32x16_bf16(b0, qr[d0], p0, 0, 0, 0);
                  p1 = __builtin_amdgcn_mfma_f32_32x32x16_bf16(b1, qr[d0], p1, 0, 0, 0); } }
            f32x16 lb0, lb1;
#pragma unroll
            for (int r = 0; r < 16; ++r) {
                { const float z = p0[r]; const float e = __builtin_amdgcn_exp2f(-__builtin_fabsf(z)); const float sp = __builtin_fmaxf(z, 0.f) + __builtin_amdgcn_logf(1.f + e); p0[r] = -sp; lb0[r] = z - sp; }
                { const float z = p1[r]; const float e = __builtin_amdgcn_exp2f(-__builtin_fabsf(z)); const float sp = __builtin_fmaxf(z, 0.f) + __builtin_amdgcn_logf(1.f + e); p1[r] = -sp; lb1[r] = z - sp; }
            }
            if (kb + 63 >= R0) {
                const int dq = myrow - kb - 4 * hi; const float NEG = -__builtin_inff();
#pragma unroll
                for (int r = 0; r < 16; ++r) { const int c = (r & 3) + 8 * (r >> 2);
                    if (c >= dq) { p0[r] = 0.f; lb0[r] = NEG; }
                    if (c + 32 >= dq) { p1[r] = 0.f; lb1[r] = NEG; } }
            }
            float gs[8], go[8];
#pragma unroll
            for (int g = 0; g < 4; ++g) { gs[g] = (p0[4 * g] + p0[4 * g + 1]) + (p0[4 * g + 2] + p0[4 * g + 3]); gs[4 + g] = (p1[4 * g] + p1[4 * g + 1]) + (p1[4 * g + 2] + p1[4 * g + 3]); }
#pragma unroll
            for (int i = 0; i < 8; ++i) go[i] = xhalf(gs[i], hi);
            float acc = carry;
#pragma unroll
            for (int idx = 7; idx >= 0; --idx) { const int g = idx & 3; const float base = acc + (hi ? 0.f : go[idx]);
                if (idx >= 4) { const float t3 = base, t2 = t3 + p1[4 * g + 3], t1 = t2 + p1[4 * g + 2], t0 = t1 + p1[4 * g + 1];
                    lb1[4 * g + 3] = __builtin_amdgcn_exp2f(lb1[4 * g + 3] + t3); lb1[4 * g + 2] = __builtin_amdgcn_exp2f(lb1[4 * g + 2] + t2);
                    lb1[4 * g + 1] = __builtin_amdgcn_exp2f(lb1[4 * g + 1] + t1); lb1[4 * g] = __builtin_amdgcn_exp2f(lb1[4 * g] + t0); }
                else { const float t3 = base, t2 = t3 + p0[4 * g + 3], t1 = t2 + p0[4 * g + 2], t0 = t1 + p0[4 * g + 1];
                    lb0[4 * g + 3] = __builtin_amdgcn_exp2f(lb0[4 * g + 3] + t3); lb0[4 * g + 2] = __builtin_amdgcn_exp2f(lb0[4 * g + 2] + t2);
                    lb0[4 * g + 1] = __builtin_amdgcn_exp2f(lb0[4 * g + 1] + t1); lb0[4 * g] = __builtin_amdgcn_exp2f(lb0[4 * g] + t0); }
                acc += gs[idx] + go[idx]; }
            carry = acc;
            bf16x8 pa0, pa1, pa2, pa3;
            ATT_PK4(lb0, 0, pa0); ATT_PK4(lb0, 8, pa1); ATT_PK4(lb1, 0, pa2); ATT_PK4(lb1, 8, pa3);
            SBAR();
            pv_tile(o, vb0 + buf * SHM_V, pa0, pa1, pa2, pa3);
            wdone = __all(carry < -127.f);
        }
        if (lane == 0) fl[buf * 8 + wid] = wdone ? 1 : 0;
        if (t + 1 < NT) SB_WRITE(buf ^ 1);
        __syncthreads();
        { const ALAS int* f = fl + buf * 8; if ((f[0] & f[1] & f[2] & f[3] & f[4] & f[5] & f[6] & f[7]) != 0) break; }
    }
#undef SB_LOAD
#undef SB_WRITE
#if WO_F8
    unsigned char* Ow = (unsigned char*)Og + (size_t)R0 * OBP; const unsigned ooff = (unsigned)(4 * hi * OBP + r32);
#pragma unroll
    for (int r = 0; r < 16; ++r) { unsigned char* rowp = Ow + (size_t)((r & 3) + 8 * (r >> 2)) * OBP;
#pragma unroll
        for (int d0 = 0; d0 < 4; ++d0) { const unsigned w = quad_pack_fp8(o[d0][r] * OB8_SCALE);
            if ((r32 & 3) == 0) *(unsigned*)(rowp + (ooff + d0 * 32)) = w; } }
#else
    bf16_t* Ow = Og + (size_t)R0 * OP; const unsigned ooff = (unsigned)(4 * hi * OP + r32);
#pragma unroll
    for (int r = 0; r < 16; ++r) { bf16_t* rowp = Ow + (size_t)((r & 3) + 8 * (r >> 2)) * OP;
#pragma unroll
        for (int d0 = 0; d0 < 4; ++d0) { const float v = o[d0][r]; const float vn = __shfl_xor(v, 1);
            if ((r32 & 1) == 0) *(unsigned*)(rowp + (ooff + d0 * 32)) = cvtpk(v, vn); } }
#endif
}

constexpr float ATT_THR = 8.f;
__device__ __forceinline__ void qkt64(f32x16& p0, f32x16& p1, ldsp Kb, int r32, int hi, const bf16x8* qr) {
    p0 = f32x16{}; p1 = f32x16{};
#pragma unroll
    for (int d0 = 0; d0 < 4; ++d0) { const ldsp a = Kb + KSWZ64(r32, (d0 * 16 + hi * 8) * 2);
        const bf16x8 b0 = *(const ALAS bf16x8*)a, b1 = *(const ALAS bf16x8*)(a + 32 * 128);
        p0 = __builtin_amdgcn_mfma_f32_32x32x16_bf16(b0, qr[d0], p0, 0, 0, 0);
        p1 = __builtin_amdgcn_mfma_f32_32x32x16_bf16(b1, qr[d0], p1, 0, 0, 0); }
}
__device__ __forceinline__ void partial_sm(f32x16& p0, f32x16& p1, float& m_reg, float& alpha, int hi) {
    float pmax = p0[0];
#pragma unroll
    for (int r = 1; r < 16; ++r) pmax = __builtin_fmaxf(pmax, p0[r]);
#pragma unroll
    for (int r = 0; r < 16; ++r) pmax = __builtin_fmaxf(pmax, p1[r]);
    pmax = __builtin_fmaxf(pmax, xhalf(pmax, hi));
    float mn;
    if (__builtin_expect(__all(pmax - m_reg <= ATT_THR), 1)) { mn = m_reg; alpha = 1.f; }
    else { mn = __builtin_fmaxf(m_reg, pmax); alpha = __builtin_amdgcn_exp2f(m_reg - mn); m_reg = mn; }
#pragma unroll
    for (int r = 0; r < 16; ++r) { p0[r] -= mn; p1[r] -= mn; }
#pragma unroll
    for (int r = 0; r < 16; ++r) p0[r] = __builtin_amdgcn_exp2f(p0[r]);
}
__device__ __forceinline__ void finish_sm(f32x16& p0, f32x16& p1, float alpha, float& l_reg, bf16x8& pa0, bf16x8& pa1, bf16x8& pa2, bf16x8& pa3, int hi) {
#pragma unroll
    for (int r = 0; r < 16; ++r) p1[r] = __builtin_amdgcn_exp2f(p1[r]);
    float ps = 0.f;
#pragma unroll
    for (int r = 0; r < 16; ++r) ps += p0[r];
#pragma unroll
    for (int r = 0; r < 16; ++r) ps += p1[r];
    ps += xhalf(ps, hi);
    l_reg = l_reg * alpha + ps;
    ATT_PK4(p0, 0, pa0); ATT_PK4(p0, 8, pa1); ATT_PK4(p1, 0, pa2); ATT_PK4(p1, 8, pa3);
}
__device__ __forceinline__ void mask_gt(f32x16& p0, f32x16& p1, int dq) {
    const float NEG = -__builtin_inff();
#pragma unroll
    for (int r = 0; r < 16; ++r) { const int c = (r & 3) + 8 * (r >> 2);
        if (c > dq) p0[r] = NEG;
        if (c + 32 > dq) p1[r] = NEG; }
}
template <bool SECOND>
__device__ __forceinline__ void diff_pass(const bf16_t* __restrict__ Qg, const bf16_t* __restrict__ Kg, const bf16_t* __restrict__ Vg, float* S1, bf16_t* __restrict__ Og,
                                          int qb, float lam, const float* __restrict__ gsub, float gmul, ldsp lds, int wave_) {
    int tid_ = tid_from_wave(wave_); asm volatile("" : "+v"(tid_));
    const int tid = tid_, wid = __builtin_amdgcn_readfirstlane(tid >> 6), lane = tid & 63, r32 = lane & 31, hi = lane >> 5;
    const int NT = 4 * qb + 4, R0 = 256 * qb + 32 * wid, myrow = R0 + r32;
    const ldsp V_lds = lds + LDS_V; const ldsp K_lds = lds + LDS_K;
    ALAS float* wsf = (ALAS float*)(lds + LDS_WS) + wid * 64; ALAS float* li_l = wsf; ALAS float* al_l = wsf + 32;
    bf16x8 qr[4];
    { const bf16_t* Qw = Qg + (size_t)R0 * QP; const unsigned qoff = (unsigned)(r32 * QP + hi * 8);
#pragma unroll
      for (int d0 = 0; d0 < 4; ++d0) qr[d0] = ldg8(Qw + (qoff + d0 * 16)); }
    const int sr = tid >> 4, sc = (tid & 15) * 8, vst0 = v_st(sr, sc), vst1 = v_st(32 + sr, sc);
    const int kr = tid >> 3, kc = (tid & 7) * 8, kws = KSWZ64(kr, kc * 2);
    const unsigned voff = (unsigned)(sr * QP + sc), koff = (unsigned)(kr * QP + kc);
    const int vb0 = (int)(unsigned)(uintptr_t)V_lds + v_rd_base(lane);
    const int qm = myrow - 4 * hi;
    bf16x8 sk0A, sv0A, sv1A, sk0B, sv0B, sv1B;
#define DF_LOAD(S_, j) do { const bf16_t* vp_ = Vg + (size_t)(64 * (j)) * QP; sk0##S_ = ldg8(Kg + (size_t)(64 * (j)) * QP + koff); sv0##S_ = ldg8(vp_ + voff); sv1##S_ = ldg8(vp_ + (size_t)32 * QP + voff); } while (0)
#define DF_WRITE(S_, bf) do { *(ALAS bf16x8*)(K_lds + (bf) * SHM_K + kws) = sk0##S_; *(ALAS bf16x8*)(V_lds + (bf) * SHM_V + vst0) = sv0##S_; *(ALAS bf16x8*)(V_lds + (bf) * SHM_V + vst1) = sv1##S_; } while (0)
#define DF_MASK(P0, P1, t) do { if (64 * (t) + 63 > R0) mask_gt(P0, P1, qm - 64 * (t)); } while (0)
#define DF_RESC(a) do { if (__any((a) < 1.f)) { if (hi == 0) al_l[r32] = (a); asm volatile("s_waitcnt lgkmcnt(0)" ::: "memory"); \
        _Pragma("unroll") for (int d_ = 0; d_ < 4; ++d_) _Pragma("unroll") for (int r = 0; r < 16; ++r) o[d_][r] *= al_l[crow(r, hi)]; } } while (0)
    float m_reg = -1e30f, l_reg = 0.f; f32x16 o[4] = {};
    f32x16 pA0, pA1, pB0, pB1; float alA = 1.f, alB = 1.f; bf16x8 pa0, pa1, pa2, pa3;
    DF_LOAD(A, 0); DF_WRITE(A, 0);
    __syncthreads();
    DF_LOAD(A, 1); DF_LOAD(B, 2);
    qkt64(pA0, pA1, K_lds, r32, hi, qr); DF_MASK(pA0, pA1, 0); partial_sm(pA0, pA1, m_reg, alA, hi);
    DF_WRITE(A, 1);
    DF_RESC(alA);
    __syncthreads();
#define DF_HALF(PX0, PX1, alX, PY0, PY1, alY, t, KB, VB, SB, LS, WS) do { \
        SBAR(); qkt64(PX0, PX1, K_lds + (KB) * SHM_K, r32, hi, qr); \
        finish_sm(PY0, PY1, alY, l_reg, pa0, pa1, pa2, pa3, hi); SBAR(); \
        if ((t) + 2 < NT) { DF_LOAD(LS, (t) + 2); SBAR(); } \
        pv_tile(o, vb0 + (VB) * SHM_V, pa0, pa1, pa2, pa3); DF_MASK(PX0, PX1, (t)); partial_sm(PX0, PX1, m_reg, alX, hi); \
        __syncthreads(); \
        if ((t) + 1 < NT) DF_WRITE(WS, SB); \
        DF_RESC(alX); __syncthreads(); } while (0)
    for (int t = 1; t + 1 < NT; t += 2) {
        DF_HALF(pB0, pB1, alB, pA0, pA1, alA, t, 1, 0, 0, A, B);
        DF_HALF(pA0, pA1, alA, pB0, pB1, alB, t + 1, 0, 1, 1, B, A);
    }
    DF_HALF(pB0, pB1, alB, pA0, pA1, alA, NT - 1, 1, 0, 0, A, B);
    finish_sm(pB0, pB1, alB, l_reg, pa0, pa1, pa2, pa3, hi); SBAR();
    pv_tile(o, vb0 + 1 * SHM_V, pa0, pa1, pa2, pa3);
#undef DF_LOAD
#undef DF_WRITE
#undef DF_MASK
#undef DF_RESC
#undef DF_HALF
    if (hi == 0) li_l[r32] = l_reg; asm volatile("s_waitcnt lgkmcnt(0)" ::: "memory");
    float rli[16];
#pragma unroll
    for (int r = 0; r < 16; ++r) rli[r] = __builtin_amdgcn_rcpf(li_l[crow(r, hi)]);
    if constexpr (!SECOND) {
        float* Sw = S1 + (size_t)R0 * OP; const unsigned ooff = (unsigned)(4 * hi * OP + r32);
#pragma unroll
        for (int r = 0; r < 16; ++r) { float* rowp = Sw + (size_t)((r & 3) + 8 * (r >> 2)) * OP;
#pragma unroll
            for (int d0 = 0; d0 < 4; ++d0) rowp[ooff + d0 * 32] = o[d0][r] * rli[r]; }
    } else {
        const float* Sw = S1 + (size_t)R0 * OP; bf16_t* Ow = Og + (size_t)R0 * OP; (void)Ow; const unsigned ooff = (unsigned)(4 * hi * OP + r32), ooff8 = (unsigned)(4 * hi * OBP + r32);
        float gn[4];
#pragma unroll
        for (int d0 = 0; d0 < 4; ++d0) gn[d0] = gsub[d0 * 32 + r32] * gmul;
#pragma unroll
        for (int r = 0; r < 16; ++r) { const float* srow = Sw + (size_t)((r & 3) + 8 * (r >> 2)) * OP; float d[4]; float ss = 0.f;
#if WO_F8
            unsigned char* orowp = (unsigned char*)Og + (size_t)(R0 + (r & 3) + 8 * (r >> 2)) * OBP;
#else
            bf16_t* orowp = Ow + (size_t)((r & 3) + 8 * (r >> 2)) * OP;
#endif
#pragma unroll
            for (int d0 = 0; d0 < 4; ++d0) { d[d0] = srow[ooff + d0 * 32] - lam * (o[d0][r] * rli[r]); ss += d[d0] * d[d0]; }
            ss += __builtin_bit_cast(float, __builtin_amdgcn_update_dpp(0, __builtin_bit_cast(int, ss), 0xB1, 0xf, 0xf, true));
            ss += __builtin_bit_cast(float, __builtin_amdgcn_update_dpp(0, __builtin_bit_cast(int, ss), 0x4E, 0xf, 0xf, true));
            ss += __builtin_bit_cast(float, __builtin_amdgcn_update_dpp(0, __builtin_bit_cast(int, ss), 0x141, 0xf, 0xf, true));
            ss += __builtin_bit_cast(float, __builtin_amdgcn_update_dpp(0, __builtin_bit_cast(int, ss), 0x140, 0xf, 0xf, true));
            { auto rr = __builtin_amdgcn_permlane16_swap(__float_as_uint(ss), __float_as_uint(ss), false, false); ss = __uint_as_float(rr[0]) + __uint_as_float(rr[1]); }
            const float rs = __builtin_amdgcn_rsqf(ss * (1.f / 128.f) + 1e-5f);
#pragma unroll
#if WO_F8
            for (int d0 = 0; d0 < 4; ++d0) { const unsigned w = quad_pack_fp8(d[d0] * rs * gn[d0] * OB8_SCALE);
                if ((r32 & 3) == 0) *(unsigned*)(orowp + (ooff8 + d0 * 32)) = w; }
#else
            for (int d0 = 0; d0 < 4; ++d0) { const float v = d[d0] * rs * gn[d0]; const float vn = __shfl_xor(v, 1);
                if ((r32 & 1) == 0) *(unsigned*)(orowp + (ooff + d0 * 32)) = cvtpk(v, vn); }
#endif
            if ((r & 1) == 1) asm volatile("" ::: "memory"); }
    }
    __syncthreads();
}

#ifndef D2_NEGM
#define D2_NEGM 1
#endif
constexpr int D2_SLK = 8192, D2_SLV = 16384, D2_K = 0, D2_V = 3 * D2_SLK, D2_WS = D2_V + 3 * D2_SLV, D2_LDS_BYTES = D2_WS + 8 * 256;
typedef __attribute__((address_space(3))) const char* lds_cptr;
typedef short v4i16_t __attribute__((ext_vector_type(4)));
typedef float f32x2_t __attribute__((ext_vector_type(2))); typedef __bf16 bf16x2_t __attribute__((ext_vector_type(2)));
__device__ __forceinline__ unsigned cvtpk_s(float lo, float hi) { const f32x2_t v = {lo, hi}; const bf16x2_t b = __builtin_convertvector(v, bf16x2_t); return __builtin_bit_cast(unsigned, b); }
__device__ __forceinline__ s16x4 vtr(lds_cptr p) { return __builtin_bit_cast(s16x4, __builtin_amdgcn_ds_read_tr16_b64_v4i16((__attribute__((address_space(3))) v4i16_t*)p)); }
__device__ __forceinline__ void kload2(bf16x8* kf, lds_cptr kp, int j) { kf[2 * j] = *(const ALAS bf16x8*)(kp + j * 2048); kf[2 * j + 1] = *(const ALAS bf16x8*)(kp + j * 2048 + 512); }
__device__ __forceinline__ void glds16s(unsigned voff, const void* gbase, unsigned ldsdst) { unsigned keep;
    asm volatile("s_mov_b32 %0, m0\n\ts_mov_b32 m0, %3\n\ts_nop 0\n\tglobal_load_lds_dwordx4 %1, %2\n\ts_mov_b32 m0, %0" : "=&s"(keep) : "v"(voff), "s"(gbase), "s"(ldsdst) : "memory"); }
#define D2_MX3(a, b, c) __builtin_fmaxf(__builtin_fmaxf((a), (b)), (c))
__device__ __forceinline__ float rowmax2(const f32x16& p0, const f32x16& p1) {
    float a = D2_MX3(p0[0], p0[1], p1[0]), b = D2_MX3(p0[2], p0[3], p1[1]); a = D2_MX3(a, p1[2], p1[3]);
#pragma unroll
    for (int r = 4; r < 16; r += 4) { a = D2_MX3(a, p0[r], p0[r + 1]); b = D2_MX3(b, p0[r + 2], p0[r + 3]); a = D2_MX3(a, p1[r], p1[r + 1]); b = D2_MX3(b, p1[r + 2], p1[r + 3]); }
    const float m = __builtin_fmaxf(a, b); auto rr = __builtin_amdgcn_permlane32_swap(__float_as_uint(m), __float_as_uint(m), false, false);
    return __builtin_fmaxf(__uint_as_float(rr[0]), __uint_as_float(rr[1])); }
__device__ __forceinline__ void cmask2(f32x16& p0, f32x16& p1, int jb, int qrel, int hi) {
    const int kb = 64 * jb + 4 * hi; const float NEG = -__builtin_inff();
#pragma unroll
    for (int r = 0; r < 16; ++r) { const int kv = kb + (r & 3) + 8 * (r >> 2); if (kv > qrel) p0[r] = NEG; if (kv + 32 > qrel) p1[r] = NEG; } }
#define D2_WAIT_BAR(N) asm volatile("s_waitcnt vmcnt(" #N ") lgkmcnt(0)\n\ts_barrier" ::: "memory")
#define D2_PIN(x) asm volatile("" : "+v"(x))
#define D2_MF(a, b, c) __builtin_amdgcn_mfma_f32_32x32x16_bf16(a, b, c, 0, 0, 0)

template <bool SECOND>
__device__ __forceinline__ void diff_pass2(const bf16_t* __restrict__ Qg, const bf16_t* __restrict__ Kg, const bf16_t* __restrict__ Vg, float* S1, bf16_t* __restrict__ Og,
                                           int qb, float lam, const float* __restrict__ gsub, float gmul, ldsp lds, int wave_) {
    int tid_ = tid_from_wave(wave_); asm volatile("" : "+v"(tid_));
    const int tid = tid_, wid = __builtin_amdgcn_readfirstlane(tid >> 6), lane = tid & 63, r32 = lane & 31, hi = lane >> 5;
    const int NT = 4 * qb + 4, R0 = 256 * qb + 32 * wid;
    const unsigned lds0 = (unsigned)(uintptr_t)lds;
    ALAS float* wsf = (ALAS float*)(lds + D2_WS) + wid * 64;
    const unsigned kvo = (unsigned)(lane * QP + wid * 8) * 2u;
    const unsigned vvo = (unsigned)((16 * (wid & 3) + (lane >> 2)) * QP + (wid >> 2) * 32 + (lane & 3) * 8) * 2u;
    const unsigned kdst = lds0 + D2_K + wid * 1024, vdst = lds0 + D2_V + wid * 1024;
#define D2_DMA_K(t, slot) glds16s(kvo, Kg + (size_t)(t) * 64 * QP, (unsigned)__builtin_amdgcn_readfirstlane(kdst + (slot)))
#define D2_DMA_V(t, slot) do { glds16s(vvo, Vg + (size_t)(t) * 64 * QP, (unsigned)__builtin_amdgcn_readfirstlane(vdst + 2 * (slot))); \
                               glds16s(vvo, Vg + (size_t)(t) * 64 * QP + 64, (unsigned)__builtin_amdgcn_readfirstlane(vdst + 2 * (slot) + 8192)); } while (0)
    const lds_cptr kp0 = (lds_cptr)lds + D2_K + hi * 1024 + r32 * 16;
    const lds_cptr vp0 = (lds_cptr)lds + D2_V + ((lane >> 4) & 1) * 32 + (lane & 3) * 8 + (4 * hi + ((lane & 15) >> 2)) * 64;
    D2_DMA_K(0, 0); D2_DMA_V(0, 0); D2_DMA_K(1, D2_SLK);
    bf16x8 qr[4];
    { const bf16_t* Qw = Qg + (size_t)R0 * QP; const unsigned qoff = (unsigned)(r32 * QP + hi * 8);
#pragma unroll
      for (int d0 = 0; d0 < 4; ++d0) qr[d0] = ldg8(Qw + (qoff + d0 * 16)); }
    D2_DMA_K(2, 2 * D2_SLK);
    float mhat = 0.f, l_reg = 0.f; f32x16 o[4] = {};
    const int qrel = 32 * wid + r32; bool resc = false;
    f32x16 pA0, pA1, pB0, pB1; bf16x8 kf[8]; s16x4 vlo[4], vhi[4]; u32x4 pw0, pw1, pw2, pw3;
#if D2_NEGM
    f32x16 negm;
#endif
    int sl_prev = 0, sl_cur = 0, sl_next = D2_SLK;
#define D2_ROT() do { sl_prev = sl_cur; sl_cur = sl_next; sl_next = (sl_next == 2 * D2_SLK) ? 0 : sl_next + D2_SLK; } while (0)
#if D2_NEGM
#define D2_EX(v) __builtin_amdgcn_exp2f(v)
#define D2_C0 negm
#else
#define D2_EX(v) __builtin_amdgcn_exp2f((v) - mhat)
#define D2_C0 D2_Z16
#endif
#define D2_RESC() do { if (resc) { _Pragma("unroll") for (int d_ = 0; d_ < 4; ++d_) _Pragma("unroll") for (int r = 0; r < 16; ++r) o[d_][r] *= wsf[crow(r, hi)]; } } while (0)
#define D2_Z16 (f32x16){}
#if D2_NEGM
#define D2_RM(C0, C1) rowmax2(C0, C1)
#define D2_MOVE(C0, C1, dl) do { _Pragma("unroll") for (int r = 0; r < 16; ++r) { C0[r] -= dl; C1[r] -= dl; } _Pragma("unroll") for (int r = 0; r < 16; ++r) negm[r] = -mhat; D2_PIN(negm); } while (0)
#else
#define D2_RM(C0, C1) (rowmax2(C0, C1) - mhat)
#define D2_MOVE(C0, C1, dl) do { } while (0)
#endif
    D2_WAIT_BAR(4);
#pragma unroll
    for (int d0 = 0; d0 < 4; ++d0) kload2(kf, kp0, d0);
    pA0 = D2_MF(kf[0], qr[0], D2_Z16); pA1 = D2_MF(kf[1], qr[0], D2_Z16); pA0 = D2_MF(kf[2], qr[1], pA0); pA1 = D2_MF(kf[3], qr[1], pA1);
    pA0 = D2_MF(kf[4], qr[2], pA0); pA1 = D2_MF(kf[5], qr[2], pA1); pA0 = D2_MF(kf[6], qr[3], pA0); pA1 = D2_MF(kf[7], qr[3], pA1);
    if (NT == 4) cmask2(pA0, pA1, 0, qrel, hi);
    { mhat = rowmax2(pA0, pA1);
#pragma unroll
      for (int r = 0; r < 16; ++r) { pA0[r] = __builtin_amdgcn_exp2f(pA0[r] - mhat); pA1[r] = __builtin_amdgcn_exp2f(pA1[r] - mhat); }
#if D2_NEGM
#pragma unroll
      for (int r = 0; r < 16; ++r) negm[r] = -mhat;
      D2_PIN(negm);
#endif
    }
    D2_WAIT_BAR(0);
    D2_DMA_K(3, 0); D2_DMA_V(1, D2_SLK); D2_ROT();
#pragma unroll
    for (int d0 = 0; d0 < 4; ++d0) kload2(kf, kp0 + sl_cur, d0);
    D2_WAIT_BAR(3);
#define D2_PKW(P, i) cvtpk_s(P[i], P[(i) + 1])
#define D2_PAF(k) __builtin_bit_cast(bf16x8, pw##k)
#define D2_VFR(i) (bf16x8){vlo[i][0], vlo[i][1], vlo[i][2], vlo[i][3], vhi[i][0], vhi[i][1], vhi[i][2], vhi[i][3]}
#define D2_VRD(s, i) do { vlo[s] = vtr(vp_ + ((((i) & 3) * 4096) + (((i) >> 2) * 1024))); vhi[s] = vtr(vp_ + ((((i) & 3) * 4096) + (((i) >> 2) * 1024) + 512)); } while (0)
#define D2_KRD(G, d0) do { if (G) { kload2(kf, kp0 + sl_next, d0); SBAR(); } } while (0)
#define D2_GAPA(MF_, a0, a1, a2, a3, W0, W1, PW) do { MF_; sacc += a0; sacc += a1; sacc += a2; sacc += a3; D2_PIN(sacc); W0; W1; D2_PIN(PW); SBAR(); } while (0)
#define D2_GAPB(j, K_, X, e) do { o[(j) & 3] = D2_MF(D2_PAF(K_), D2_VFR((j) & 3), o[(j) & 3]); X[e] = D2_EX(X[e]); X[(e) + 1] = D2_EX(X[(e) + 1]); D2_PIN(X); SBAR(); } while (0)
#define D2_STEP(C0, C1, P0, P1, t, MASK, GK, GV, GL) do { SBAR(); \
    const lds_cptr vp_ = vp0 + 2 * sl_prev; \
    float sacc = P0[0] + P0[1]; \
                          D2_GAPA(C0 = D2_MF(kf[0], qr[0], D2_C0),  P0[2], P0[3], P0[4], P0[5],     pw0[0] = D2_PKW(P0, 0),  pw0[1] = D2_PKW(P0, 2),  pw0); \
                          D2_GAPA(C1 = D2_MF(kf[1], qr[0], D2_C0),  P0[6], P0[7], P0[8], P0[9],     pw0[2] = D2_PKW(P0, 4),  pw0[3] = D2_PKW(P0, 6),  pw0); \
                          D2_GAPA(C0 = D2_MF(kf[2], qr[1], C0),     P0[10], P0[11], P0[12], P0[13], pw1[0] = D2_PKW(P0, 8),  pw1[1] = D2_PKW(P0, 10), pw1); \
                          D2_GAPA(C1 = D2_MF(kf[3], qr[1], C1),     P0[14], P0[15], P1[0], P1[1],   pw1[2] = D2_PKW(P0, 12), pw1[3] = D2_PKW(P0, 14), pw1); \
    D2_VRD(0, 0); SBAR(); D2_GAPA(C0 = D2_MF(kf[4], qr[2], C0),     P1[2], P1[3], P1[4], P1[5],     pw2[0] = D2_PKW(P1, 0),  pw2[1] = D2_PKW(P1, 2),  pw2); \
    D2_VRD(1, 1); SBAR(); D2_GAPA(C1 = D2_MF(kf[5], qr[2], C1),     P1[6], P1[7], P1[8], P1[9],     pw2[2] = D2_PKW(P1, 4),  pw2[3] = D2_PKW(P1, 6),  pw2); \
    D2_VRD(2, 2); SBAR(); D2_GAPA(C0 = D2_MF(kf[6], qr[3], C0),     P1[10], P1[11], P1[12], P1[13], pw3[0] = D2_PKW(P1, 8),  pw3[1] = D2_PKW(P1, 10), pw3); \
    D2_VRD(3, 3); SBAR(); D2_GAPA(C1 = D2_MF(kf[7], qr[3], C1),     P1[14], P1[15], 0.f, 0.f,       pw3[2] = D2_PKW(P1, 12), pw3[3] = D2_PKW(P1, 14), pw3); \
    l_reg += sacc; \
    if (GK) D2_DMA_K((t) + 3, sl_cur); if (GV) D2_DMA_V((t) + 1, sl_next);                                                  \
    if (MASK) cmask2(C0, C1, (t) - (NT - 4), qrel, hi); \
    { const float rm = D2_RM(C0, C1); resc = false;                                                                          \
      if (__builtin_expect(__any(rm > ATT_THR), 0)) { const float dl = __builtin_fmaxf(rm, 0.f); mhat += dl;                \
          D2_MOVE(C0, C1, dl); \
          const float f = __builtin_amdgcn_exp2f(-dl); l_reg *= f; if (hi == 0) wsf[r32] = f; resc = true; } } \
    SBAR(); \
    D2_GAPB(0, 0, C0, 0);   D2_VRD(0, 4);  SBAR(); D2_GAPB(1, 0, C0, 2);   D2_VRD(1, 5);  SBAR(); D2_GAPB(2, 0, C0, 4);   D2_VRD(2, 6);  SBAR(); D2_GAPB(3, 0, C0, 6);   D2_VRD(3, 7);  SBAR(); \
    D2_GAPB(4, 1, C0, 8);   D2_VRD(0, 8);  SBAR(); D2_GAPB(5, 1, C0, 10);  D2_VRD(1, 9);  SBAR(); D2_GAPB(6, 1, C0, 12);  D2_VRD(2, 10); SBAR(); D2_GAPB(7, 1, C0, 14);  D2_VRD(3, 11); SBAR(); \
    D2_GAPB(8, 2, C1, 0);   D2_VRD(0, 12); SBAR(); D2_GAPB(9, 2, C1, 2);   D2_VRD(1, 13); SBAR(); D2_GAPB(10, 2, C1, 4);  D2_VRD(2, 14); SBAR(); D2_GAPB(11, 2, C1, 6);  D2_VRD(3, 15); SBAR(); \
    D2_KRD(GL, 0); D2_GAPB(12, 3, C1, 8);  D2_KRD(GL, 1); D2_GAPB(13, 3, C1, 10); D2_KRD(GL, 2); D2_GAPB(14, 3, C1, 12); D2_KRD(GL, 3); D2_GAPB(15, 3, C1, 14); \
    } while (0)
    int t = 1;
    for (; t + 5 < NT; t += 2) {
        D2_STEP(pB0, pB1, pA0, pA1, t, false, true, true, true);     D2_WAIT_BAR(3); D2_RESC(); D2_ROT();
        D2_STEP(pA0, pA1, pB0, pB1, t + 1, false, true, true, true); D2_WAIT_BAR(3); D2_RESC(); D2_ROT();
    }
#define D2_ENDW(tt) do { if ((tt) + 3 < NT) { D2_WAIT_BAR(3); } else if ((tt) + 2 < NT) { D2_WAIT_BAR(2); } else { D2_WAIT_BAR(0); } } while (0)
    for (; t + 1 < NT; t += 2) {
        D2_STEP(pB0, pB1, pA0, pA1, t, true, (t + 3 < NT), (t + 1 < NT), (t + 1 < NT));         D2_ENDW(t);     D2_RESC(); D2_ROT();
        D2_STEP(pA0, pA1, pB0, pB1, t + 1, true, (t + 4 < NT), (t + 2 < NT), (t + 2 < NT));     D2_ENDW(t + 1); D2_RESC(); D2_ROT();
    }
    D2_STEP(pB0, pB1, pA0, pA1, NT - 1, true, false, false, false); D2_RESC();
    { float sacc = pB0[0] + pB0[1];
#pragma unroll
      for (int r = 2; r < 16; ++r) sacc += pB0[r];
#pragma unroll
      for (int r = 0; r < 16; ++r) sacc += pB1[r];
      l_reg += sacc;
      pw0 = (u32x4){D2_PKW(pB0, 0), D2_PKW(pB0, 2), D2_PKW(pB0, 4), D2_PKW(pB0, 6)}; pw1 = (u32x4){D2_PKW(pB0, 8), D2_PKW(pB0, 10), D2_PKW(pB0, 12), D2_PKW(pB0, 14)};
      pw2 = (u32x4){D2_PKW(pB1, 0), D2_PKW(pB1, 2), D2_PKW(pB1, 4), D2_PKW(pB1, 6)}; pw3 = (u32x4){D2_PKW(pB1, 8), D2_PKW(pB1, 10), D2_PKW(pB1, 12), D2_PKW(pB1, 14)};
      const lds_cptr vp_ = vp0 + 2 * sl_cur; SBAR();
#pragma unroll
      for (int i = 0; i < 4; ++i) D2_VRD(i, i);
      o[0] = D2_MF(D2_PAF(0), D2_VFR(0), o[0]); o[1] = D2_MF(D2_PAF(0), D2_VFR(1), o[1]); o[2] = D2_MF(D2_PAF(0), D2_VFR(2), o[2]); o[3] = D2_MF(D2_PAF(0), D2_VFR(3), o[3]); SBAR();
#pragma unroll
      for (int i = 0; i < 4; ++i) D2_VRD(i, i + 4);
      o[0] = D2_MF(D2_PAF(1), D2_VFR(0), o[0]); o[1] = D2_MF(D2_PAF(1), D2_VFR(1), o[1]); o[2] = D2_MF(D2_PAF(1), D2_VFR(2), o[2]); o[3] = D2_MF(D2_PAF(1), D2_VFR(3), o[3]); SBAR();
#pragma unroll
      for (int i = 0; i < 4; ++i) D2_VRD(i, i + 8);
      o[0] = D2_MF(D2_PAF(2), D2_VFR(0), o[0]); o[1] = D2_MF(D2_PAF(2), D2_VFR(1), o[1]); o[2] = D2_MF(D2_PAF(2), D2_VFR(2), o[2]); o[3] = D2_MF(D2_PAF(2), D2_VFR(3), o[3]); SBAR();
#pragma unroll
      for (int i = 0; i < 4; ++i) D2_VRD(i, i + 12);
      o[0] = D2_MF(D2_PAF(3), D2_VFR(0), o[0]); o[1] = D2_MF(D2_PAF(3), D2_VFR(1), o[1]); o[2] = D2_MF(D2_PAF(3), D2_VFR(2), o[2]); o[3] = D2_MF(D2_PAF(3), D2_VFR(3), o[3]); }
#undef D2_DMA_K
#undef D2_DMA_V
#undef D2_ROT
#undef D2_EX
#undef D2_C0
#undef D2_RM
#undef D2_MOVE
#undef D2_RESC
#undef D2_PKW
#undef D2_PAF
#undef D2_VFR
#undef D2_VRD
#undef D2_KRD
#undef D2_ENDW
#undef D2_GAPA
#undef D2_GAPB
#undef D2_STEP
    { auto rr = __builtin_amdgcn_permlane32_swap(__float_as_uint(l_reg), __float_as_uint(l_reg), false, false); l_reg = __uint_as_float(rr[0]) + __uint_as_float(rr[1]); }
    ALAS float* li_l = wsf + 32;
    if (hi == 0) li_l[r32] = l_reg; asm volatile("s_waitcnt lgkmcnt(0)" ::: "memory");
    float rli[16];
#pragma unroll
    for (int r = 0; r < 16; ++r) rli[r] = __builtin_amdgcn_rcpf(li_l[crow(r, hi)]);
    if constexpr (!SECOND) {
        float* Sw = S1 + (size_t)R0 * OP; const unsigned ooff = (unsigned)(4 * hi * OP + r32);
#pragma unroll
        for (int r = 0; r < 16; ++r) { float* rowp = Sw + (size_t)((r & 3) + 8 * (r >> 2)) * OP;
#pragma unroll
            for (int d0 = 0; d0 < 4; ++d0) rowp[ooff + d0 * 32] = o[d0][r] * rli[r]; }
    } else {
        const float* Sw = S1 + (size_t)R0 * OP; const unsigned ooff = (unsigned)(4 * hi * OP + r32), ooff8 = (unsigned)(4 * hi * OBP + r32);
        float gn[4];
#pragma unroll
        for (int d0 = 0; d0 < 4; ++d0) gn[d0] = gsub[d0 * 32 + r32] * gmul;
#pragma unroll
        for (int r = 0; r < 16; ++r) { const float* srow = Sw + (size_t)((r & 3) + 8 * (r >> 2)) * OP; float d[4]; float ss = 0.f;
            unsigned char* orowp = (unsigned char*)Og + (size_t)(R0 + (r & 3) + 8 * (r >> 2)) * OBP;
#pragma unroll
            for (int d0 = 0; d0 < 4; ++d0) { d[d0] = srow[ooff + d0 * 32] - lam * (o[d0][r] * rli[r]); ss += d[d0] * d[d0]; }
            ss += __builtin_bit_cast(float, __builtin_amdgcn_update_dpp(0, __builtin_bit_cast(int, ss), 0xB1, 0xf, 0xf, true));
            ss += __builtin_bit_cast(float, __builtin_amdgcn_update_dpp(0, __builtin_bit_cast(int, ss), 0x4E, 0xf, 0xf, true));
            ss += __builtin_bit_cast(float, __builtin_amdgcn_update_dpp(0, __builtin_bit_cast(int, ss), 0x141, 0xf, 0xf, true));
            ss += __builtin_bit_cast(float, __builtin_amdgcn_update_dpp(0, __builtin_bit_cast(int, ss), 0x140, 0xf, 0xf, true));
            { auto rr = __builtin_amdgcn_permlane16_swap(__float_as_uint(ss), __float_as_uint(ss), false, false); ss = __uint_as_float(rr[0]) + __uint_as_float(rr[1]); }
            const float rs = __builtin_amdgcn_rsqf(ss * (1.f / 128.f) + 1e-5f);
#pragma unroll
            for (int d0 = 0; d0 < 4; ++d0) { const unsigned w = quad_pack_fp8(d[d0] * rs * gn[d0] * OB8_SCALE);
                if ((r32 & 3) == 0) *(unsigned*)(orowp + (ooff8 + d0 * 32)) = w; }
            if ((r & 1) == 1) asm volatile("" ::: "memory"); }
    }
    asm volatile("s_waitcnt lgkmcnt(0)\n\ts_barrier" ::: "memory");
}
#undef D2_WAIT_BAR
#undef D2_PIN
#undef D2_MF
#undef D2_MX3
#undef D2_Z16
#undef SBAR
}

#define LAS __attribute__((address_space(3)))

#define XB_TMO      128
#define XB_XCNT(j)  (256  + 64 * (j))
#define XB_XSUB(j)  (1280 + 64 * (j))
#define XB_XGEN(j)  (2304 + 64 * (j))
#define XB_TOP      3328
#define XB_TOPGEN   3392
#define XCD_BAR_WORDS 3456
#define XB_SPIN_CAP (1u << 18)

__device__ __forceinline__ unsigned xb_ld(unsigned* p)              { return __hip_atomic_load(p, __ATOMIC_RELAXED, __HIP_MEMORY_SCOPE_AGENT); }
__device__ __forceinline__ unsigned xb_add(unsigned* p, unsigned v) { return __hip_atomic_fetch_add(p, v, __ATOMIC_RELAXED, __HIP_MEMORY_SCOPE_AGENT); }
__device__ __forceinline__ unsigned xb_xcc_id() { return (unsigned)__builtin_amdgcn_s_getreg((3 << 11) | 20) & 0xFu; }
#define XB_SPIN(cond, bar) do { unsigned _sp = 0; while (cond) { __builtin_amdgcn_s_sleep(1); \
    if ((++_sp & 255u) == 0u) { if (xb_ld(&(bar)[XB_TMO])) break; if (_sp > XB_SPIN_CAP) { atomicAdd(&(bar)[XB_TMO], 1u); break; } } } } while (0)

struct XcdBarrier {
    unsigned* bar; unsigned x;
    volatile LAS unsigned* st;
};

__device__ __forceinline__ XcdBarrier xcd_barrier_post(unsigned* bar, volatile LAS unsigned* st, bool thread0) {
    XcdBarrier b; b.bar = bar; b.x = xb_xcc_id(); b.st = st;
    if (thread0) (void)xb_add(&bar[XB_XCNT(b.x)], 1u);
    return b;
}
__device__ __forceinline__ void xcd_barrier_complete(unsigned* bar, unsigned x, unsigned& nloc, unsigned& nx) {
    const unsigned G = gridDim.x * gridDim.y * gridDim.z;
    unsigned sum, cnt, mine, sp = 0u;
    for (;;) {
        sum = 0u; cnt = 0u; mine = 0u;
#pragma unroll
        for (unsigned j = 0; j < 16; ++j) { const unsigned c = xb_ld(&bar[XB_XCNT(j)]); sum += c; cnt += (c > 0u) ? 1u : 0u; mine = (j == x) ? c : mine; }
        if (sum == G) break;
        __builtin_amdgcn_s_sleep(1);
        if ((++sp & 255u) == 0u) { if (xb_ld(&bar[XB_TMO])) break; if (sp > XB_SPIN_CAP) { atomicAdd(&bar[XB_TMO], 1u); break; } }
    }
    nloc = mine > 0u ? mine : 1u; nx = cnt > 0u ? cnt : 1u;
}

__device__ __forceinline__ void xcd_barrier(const XcdBarrier& b, bool thread0) {
    asm volatile("s_waitcnt vmcnt(0)" ::: "memory");
    __syncthreads();
    if (thread0) {
        unsigned* bar = b.bar;
        __builtin_amdgcn_s_waitcnt(0);
        unsigned nloc = b.st[0], nx = b.st[1];
        if (nloc == 0u) { xcd_barrier_complete(bar, b.x, nloc, nx); b.st[0] = nloc; b.st[1] = nx; }
        const unsigned old = xb_add(&bar[XB_XSUB(b.x)], 1u);
        const unsigned gen = old / nloc;
        if (old + 1u == (gen + 1u) * nloc) {
            __builtin_amdgcn_fence(__ATOMIC_RELEASE, "agent");
            asm volatile("s_waitcnt vmcnt(0)" ::: "memory");
            const unsigned og = xb_add(&bar[XB_TOP], 1u);
            const unsigned tg = og / nx;
            if (og + 1u == (tg + 1u) * nx) xb_add(&bar[XB_TOPGEN], 1u);
            else XB_SPIN(xb_ld(&bar[XB_TOPGEN]) == tg, bar);
            __builtin_amdgcn_fence(__ATOMIC_ACQUIRE, "agent");
            xb_add(&bar[XB_XGEN(b.x)], 1u);
            asm volatile("s_waitcnt vmcnt(0)" ::: "memory");
        } else {
            XB_SPIN(xb_ld(&bar[XB_XGEN(b.x)]) == gen, bar);
            __builtin_amdgcn_fence(__ATOMIC_ACQUIRE, "agent");
            asm volatile("s_waitcnt vmcnt(0)" ::: "memory");
        }
    }
    __syncthreads();
}

constexpr int NWAVES = 8;
constexpr int NTOK = 16384, DM = 2048, SEQ = 2048, NHEAD = 16, NLAYER = 4, NEXP = 16, DEXP = 1024;
constexpr int XS_ROWS = 36864;
constexpr float LN_EPS = 1e-5f;
constexpr float DN_ALPHA = 1.6817928305074292f;
constexpr float LOG2E = 1.4426950408889634f;
constexpr float SB_QSCALE = 0.08838834764831845f * LOG2E;
constexpr float DF_QSCALE = 0.125f * LOG2E;
#ifndef MK_MULTI
#define MK_MULTI 0
#endif
#ifndef MOE_F8
#define MOE_F8 1
#endif
#ifndef QKV8_A
#define QKV8_A 1
#endif
#ifndef QKV8_B
#define QKV8_B 0
#endif
#ifndef V8_B
#define V8_B 1
#endif
#ifndef DF_RING
#define DF_RING 1
#endif
constexpr int NSTEPS = 1 + 8 * NLAYER;

constexpr size_t MiB = 1u << 20;
constexpr size_t WS_CTL = 0, CTL_ZERO_BYTES = 256 * 1024;
constexpr size_t WS_COS = 1 * MiB, WS_SIN = WS_COS + 256 * 1024;
constexpr size_t WS_WR = 2 * MiB;
constexpr size_t WS_CNT = 3 * MiB;
constexpr size_t WS_RE = WS_CNT + 64 * 1024;
constexpr size_t WS_RW = WS_RE + 64 * 1024;
constexpr size_t WS_RP = WS_RW + 128 * 1024;
constexpr int LDH = 2048;
constexpr int P8K2 = 2048, P8K1 = 1024;
constexpr size_t WS_WQKVA = 4 * MiB;
constexpr size_t WS_WOA = WS_WQKVA + 56 * MiB;
constexpr size_t WS_WQKVB = WS_WOA + 16 * MiB;
constexpr size_t WS_WOB = WS_WQKVB + 36 * MiB;
constexpr size_t WS_WGU = WS_WOB + 16 * MiB;
constexpr size_t WS_WDN = WS_WGU + 512 * MiB;
constexpr size_t WS_H = WS_WDN + 256 * MiB;
constexpr size_t WS_HB = WS_H + 128 * MiB;
constexpr size_t WS_QKV = WS_HB + 68 * MiB;
constexpr size_t WS_OB = WS_QKV + 192 * MiB;
constexpr size_t WS_XS = WS_OB + 64 * MiB;
constexpr size_t WS_ACT = WS_XS + 144 * MiB;
constexpr size_t WS_YD = WS_ACT + 72 * MiB;
constexpr size_t WS_END = WS_YD + 144 * MiB;
static_assert(WS_END <= (size_t)2040 * MiB, "workspace map");
static_assert((size_t)2 * 6144 * LDH * 2 <= 56 * MiB && (size_t)8192 * LDH * 2 <= 36 * MiB && (size_t)2 * 2048 * P8K2 <= 16 * MiB && (size_t)64 * 2048 * P8K2 <= 512 * MiB && (size_t)64 * 2048 * P8K1 <= 256 * MiB, "weight regions");
static_assert((size_t)NTOK * LDH * 2 <= 68 * MiB && (size_t)NTOK * P8K2 <= 64 * MiB && (size_t)XS_ROWS * P8K2 <= 144 * MiB && (size_t)XS_ROWS * P8K1 <= 72 * MiB, "activation regions");
constexpr int CW_MTC = 8192;
constexpr int CW_BAR = 1024;
constexpr int LDS_BYTES = 163840;
constexpr int WCOL_OFF = 147456;
constexpr int LDSCTL_OFF = 145408;
constexpr int RING_OFF = 0;
constexpr int LNX_OFF = 131072;

#define GAS __attribute__((address_space(1)))
typedef unsigned short bf16;
typedef unsigned v4u __attribute__((ext_vector_type(4)));
typedef unsigned v2u __attribute__((ext_vector_type(2)));
typedef float f32x4 __attribute__((ext_vector_type(4)));
typedef float f32x2 __attribute__((ext_vector_type(2)));
typedef _Float16 f16x4 __attribute__((ext_vector_type(4)));
__device__ __forceinline__ f32x4 ldh4(const _Float16* p) { return __builtin_convertvector(*(const f16x4*)p, f32x4); }
__device__ __forceinline__ void sth4(_Float16* p, f32x4 v) { __builtin_nontemporal_store(__builtin_convertvector(v, f16x4), (f16x4*)p); }
#define LDS_WAIT() asm volatile("s_waitcnt lgkmcnt(0)" ::: "memory")
#define VM_WAIT() asm volatile("s_waitcnt vmcnt(0)" ::: "memory")
__device__ __forceinline__ unsigned pk2(float lo, float hi) { unsigned r; asm volatile("v_cvt_pk_bf16_f32 %0, %1, %2" : "=v"(r) : "v"(lo), "v"(hi)); return r; }
__device__ __forceinline__ int opq_tid(int wave) { int t = tid_from_wave(wave); asm volatile("" : "+v"(t)); return t; }
__device__ __forceinline__ float dpp_sum(float v) {
    v += __builtin_bit_cast(float, __builtin_amdgcn_update_dpp(0, __builtin_bit_cast(int, v), 0xB1, 0xf, 0xf, true));
    v += __builtin_bit_cast(float, __builtin_amdgcn_update_dpp(0, __builtin_bit_cast(int, v), 0x4E, 0xf, 0xf, true));
    v += __builtin_bit_cast(float, __builtin_amdgcn_update_dpp(0, __builtin_bit_cast(int, v), 0x141, 0xf, 0xf, true));
    v += __builtin_bit_cast(float, __builtin_amdgcn_update_dpp(0, __builtin_bit_cast(int, v), 0x140, 0xf, 0xf, true));
    const int b = __builtin_bit_cast(int, v);
    const float s0 = __builtin_bit_cast(float, __builtin_amdgcn_readlane(b, 0)), s1 = __builtin_bit_cast(float, __builtin_amdgcn_readlane(b, 16));
    const float s2 = __builtin_bit_cast(float, __builtin_amdgcn_readlane(b, 32)), s3 = __builtin_bit_cast(float, __builtin_amdgcn_readlane(b, 48));
    return (s0 + s1) + (s2 + s3);
}
__device__ __forceinline__ float wave_sum(float v) {
#pragma unroll
    for (int o = 1; o < 64; o <<= 1) v += __shfl_xor(v, o);
    return v;
}

struct Args { const float* in[17]; float* out; unsigned char* ws; int s_lo, s_hi; };

__device__ __forceinline__ int map_row(int n, int mode) {
    if (mode == 0) return n;
    if (mode == 1) { const int c = n & 255, blk = c >> 6, d = c & 63; return (n & ~255) + ((d >> 5) << 7) + (blk << 5) + (d & 31); }
    return ((n >> 7) << 8) + (n & 127) + (mode == 3 ? 128 : 0);
}
__device__ __forceinline__ unsigned pk2h(float lo, float hi) { typedef _Float16 h2 __attribute__((ext_vector_type(2))); const f32x2 v = {lo, hi}; return __builtin_bit_cast(unsigned, __builtin_convertvector(v, h2)); }
__device__ __forceinline__ void cvt_load(f32x4 (&v)[16], const float* __restrict__ src, int pitch, int k0, int n0, int kind, int lane) {
    if (kind == 2) { const int kr = lane >> 3, n4 = (lane & 7) * 4; const float* p = src + (size_t)(k0 + kr) * pitch + n0 + n4;
#pragma unroll
        for (int i = 0; i < 16; ++i) v[i] = __builtin_nontemporal_load((const f32x4*)(p + (size_t)(8 * i) * pitch)); }
    else { const int kr = lane >> 4, n4 = (lane & 15) * 4; const float* p = src + (size_t)(k0 + kr) * pitch + n0 + n4;
#pragma unroll
        for (int i = 0; i < 16; ++i) v[i] = __builtin_nontemporal_load((const f32x4*)(p + (size_t)(4 * i) * pitch)); }
}
__device__ __forceinline__ void cvt_store(const f32x4 (&v)[16], unsigned char* __restrict__ dst, int dp, int mode, int k0, int n0, int kind, LAS float* scr, int lane) {
    if (kind == 2) {
        const int kr = lane >> 3, n4 = (lane & 7) * 4;
#pragma unroll
        for (int i = 0; i < 16; ++i) { LAS float* s = scr + (8 * i + kr) * 33 + n4; s[0] = v[i][0] * pg8::W8_SCALE; s[1] = v[i][1] * pg8::W8_SCALE; s[2] = v[i][2] * pg8::W8_SCALE; s[3] = v[i][3] * pg8::W8_SCALE; }
        LDS_WAIT();
        const int c = lane & 7;
#pragma unroll
        for (int j = 0; j < 4; ++j) { const int nl = (lane >> 3) + 8 * j; const int row = map_row(n0 + nl, mode);
            const LAS float* s = scr + (16 * c) * 33 + nl;
            v4u o; o.x = pg8::pack4_fp8(s[0], s[33], s[66], s[99]); o.y = pg8::pack4_fp8(s[132], s[165], s[198], s[231]);
            o.z = pg8::pack4_fp8(s[264], s[297], s[330], s[363]); o.w = pg8::pack4_fp8(s[396], s[429], s[462], s[495]);
            __builtin_nontemporal_store(o, (v4u*)(dst + (size_t)row * dp + k0 + 16 * c)); }
    } else {
        const int kr = lane >> 4, n4 = (lane & 15) * 4;
#pragma unroll
        for (int i = 0; i < 16; ++i) { LAS float* s = scr + (4 * i + kr) * 65 + n4; s[0] = v[i][0]; s[1] = v[i][1]; s[2] = v[i][2]; s[3] = v[i][3]; }
        LDS_WAIT();
        const int c = lane & 7;
#pragma unroll
        for (int j = 0; j < 8; ++j) { const int nl = (lane >> 3) + 8 * j; const int row = map_row(n0 + nl, mode);
            const LAS float* s = scr + (8 * c) * 65 + nl;
            v4u o; o.x = pk2h(s[0], s[65]); o.y = pk2h(s[130], s[195]); o.z = pk2h(s[260], s[325]); o.w = pk2h(s[390], s[455]);
            __builtin_nontemporal_store(o, (v4u*)(dst + (size_t)row * dp + (k0 + 8 * c) * 2)); }
    }
    LDS_WAIT();
}

__global__ void __launch_bounds__(NWAVES * 64, 2) yoco_fwd(Args args) {
    extern __shared__ __attribute__((aligned(16))) unsigned char lds_raw[];
    LAS unsigned char* const lds = (LAS unsigned char*)lds_raw;
    const int tid = threadIdx.x, lane = tid & 63, wave = __builtin_amdgcn_readfirstlane(tid >> 6);
    const int G = gridDim.x, bx = blockIdx.x;
    const int vcu = (G % 8 == 0) ? (bx % 8) * (G / 8) + bx / 8 : bx;
    unsigned char* const ws = args.ws;
    volatile LAS unsigned* const CTL = (volatile LAS unsigned*)(lds + LDSCTL_OFF);
    LAS int* const TAB = (LAS int*)(lds + LDSCTL_OFF + 64);
    for (int u = tid; u < (LDS_BYTES - LDSCTL_OFF) / 4; u += NWAVES * 64) ((LAS unsigned*)(lds + LDSCTL_OFF))[u] = 0u;
    __syncthreads();
    const int s_lo = args.s_lo, s_hi = args.s_hi;
    XcdBarrier bar; bar.bar = (unsigned*)(ws + WS_CTL) + CW_BAR; bar.x = 0; bar.st = nullptr;
    if (s_hi - s_lo > 1) bar = xcd_barrier_post((unsigned*)(ws + WS_CTL) + CW_BAR, CTL, tid == 0);
#ifndef PH_MASK
#define PH_MASK 0xFFFF
#endif
#define PHM(b) (((PH_MASK) >> (b)) & 1)
#ifndef PROBE_DUP
#define PROBE_DUP 0
#endif
#define PREP(b) _Pragma("unroll 1") for (int rep_ = 0; rep_ < ((((PROBE_DUP) >> (b)) & 1) ? 2 : 1); ++rep_) if ((rep_ == 1 && ((PROBE_DUP >> 12) & 1)) ? (xcd_barrier(bar, tid_from_wave(wave) == 0), true) : true)
#define IN(k) (s_lo <= (k) && (k) < s_hi)
#define SEAM(k) do { if ((k) + 1 < s_hi) xcd_barrier(bar, tid_from_wave(wave) == 0); } while (0)

    const float* const x_in = args.in[0];
    _Float16* const H = (_Float16*)(ws + WS_H); unsigned char* const HB8 = (unsigned char*)(ws + WS_OB + 32 * MiB);     bf16* const QKV = (bf16*)(ws + WS_QKV); bf16* const OB = (bf16*)(ws + WS_OB);
    bf16* const MIX = (bf16*)(ws + WS_YD);     bf16* const XS = (bf16*)(ws + WS_XS); float* const S1 = (float*)(ws + WS_XS); bf16* const ACT = (bf16*)(ws + WS_ACT); bf16* const YD = (bf16*)(ws + WS_YD);
    float* const WR = (float*)(ws + WS_WR);
    int* const CNT = (int*)(ws + WS_CNT); unsigned* const RE = (unsigned*)(ws + WS_RE); f32x2* const RW = (f32x2*)(ws + WS_RW); int* const RP = (int*)(ws + WS_RP);

    if (IN(0) && PHM(0)) { PREP(0) {
        const int tid = opq_tid(wave), lane = tid & 63;
        LAS float* scr = (LAS float*)(lds + RING_OFF + wave * 16896);
        const int gw = vcu * NWAVES + wave, NGW = G * NWAVES;
        constexpr int I0 = 2 * 3072, I1 = 8 * 1024, I2 = 128 * 512, I3 = 64 * 512, NITEMS = I0 + I1 + I2 + I3;
        static_assert(QKV8_A == 1 && QKV8_B == 0, "conversion table below: stick-breaking q|k|v and all other fp8 GEMM weights -> e4m3, differential q|k|v weights -> fp16");
#define CVT_DECODE(it_, SRC, PIT, DST, DP, MODE, K0, N0, KIND) do { int r = (it_); \
            if (r < I0) { const int job = r / 3072; r -= job * 3072; const int kb = r / 192, nb = r - kb * 192; \
                SRC = args.in[1] + (size_t)job * 2048 * 6144; PIT = 6144; DST = ws + WS_WQKVA + (size_t)job * 6144 * 2048; DP = 2048; MODE = 0; K0 = kb * 128; N0 = nb * 32; KIND = 2; break; } \
            r -= I0; \
            if (r < I1) { const int job = r >> 10; r &= 1023; const int r1_ = r; K0 = (r >> 6) * 128; N0 = (r & 63) * 32; PIT = 2048; MODE = 0; KIND = 2; DP = P8K2; \
                if (job < 2) { SRC = args.in[2] + (size_t)job * 2048 * 2048; DST = ws + WS_WOA + (size_t)job * 2048 * P8K2; } \
                else if (job >= 6) { SRC = args.in[5] + (size_t)(job - 6) * 2048 * 2048; DST = ws + WS_WOB + (size_t)(job - 6) * 2048 * P8K2; } \
                else if (V8_B && job == 4) { SRC = args.in[3] + 2048; PIT = 4096; DST = ws + WS_WQKVB + (size_t)4096 * LDH * 2; }     \
                else { KIND = 1; DP = LDH * 2; K0 = (r1_ >> 5) * 64; N0 = (r1_ & 31) * 64; \
                    if (job == 2) { SRC = args.in[4]; DST = ws + WS_WQKVB; MODE = 1; } \
                    else if (job == 3) { SRC = args.in[3]; PIT = 4096; DST = ws + WS_WQKVB + (size_t)2048 * LDH * 2; MODE = 1; } \
                    else if (job == 4) { SRC = args.in[3] + 2048; PIT = 4096; DST = ws + WS_WQKVB + (size_t)4096 * LDH * 2; } \
                    else { SRC = args.in[4] + (size_t)2048 * 2048; DST = ws + WS_WQKVB + (size_t)6144 * LDH * 2; MODE = 1; } } \
                break; } \
            r -= I1; \
            if (r < I2) { const int job = r >> 9; r &= 511; const int le = job >> 1, up = job & 1;     \
                SRC = (up ? args.in[15] : args.in[14]) + (size_t)le * 2048 * 1024; PIT = 1024; DST = ws + WS_WGU + (size_t)le * 2048 * P8K2; DP = P8K2; MODE = 2 + up; K0 = (r >> 5) * 128; N0 = (r & 31) * 32; KIND = 2; break; } \
            r -= I2; \
            { const int le = r >> 9; r &= 511; SRC = args.in[16] + (size_t)le * 1024 * 2048; PIT = 2048; DST = ws + WS_WDN + (size_t)le * 2048 * P8K1; DP = P8K1; MODE = 0; K0 = (r >> 6) * 128; N0 = (r & 63) * 32; KIND = 2; } \
        } while (0)
        { const float* sA; const float* sB; unsigned char* dA; unsigned char* dB; int pA, pB, qA, qB, mA, mB, kA, kB, nA, nB, tA, tB; f32x4 va[16], vb[16];
          int it = gw;
          if (it < NITEMS) { CVT_DECODE(it, sA, pA, dA, qA, mA, kA, nA, tA); cvt_load(va, sA, pA, kA, nA, tA, lane);
            for (;;) {
                if (it + NGW < NITEMS) { CVT_DECODE(it + NGW, sB, pB, dB, qB, mB, kB, nB, tB); cvt_load(vb, sB, pB, kB, nB, tB, lane); }
                cvt_store(va, dA, qA, mA, kA, nA, tA, scr, lane); it += NGW; if (it >= NITEMS) break;
                if (it + NGW < NITEMS) { CVT_DECODE(it + NGW, sA, pA, dA, qA, mA, kA, nA, tA); cvt_load(va, sA, pA, kA, nA, tA, lane); }
                cvt_store(vb, dB, qB, mB, kB, nB, tB, scr, lane); it += NGW; if (it >= NITEMS) break;
            } } }
#undef CVT_DECODE
        for (size_t i = (size_t)gw * 64 + lane; i < (size_t)NTOK * DM / 4; i += (size_t)NGW * 64) {
            const f32x4 v = ((const f32x4*)x_in)[i];
            ((unsigned*)HB8)[i] = pg8::pack4_fp8(v[0], v[1], v[2], v[3]); }
        for (int i = bx * (NWAVES * 64) + tid; i < NLAYER * 20 * 2048; i += G * NWAVES * 64) { const int k = i & 2047, c = (i >> 11) % 20, l = i / (20 * 2048);
            WR[i] = c < 4 ? args.in[12][((size_t)l * 2048 + k) * 4 + c] : args.in[13][(((size_t)l * 4 + ((c - 4) >> 2)) * 2048 + k) * 4 + ((c - 4) & 3)]; }
        }
        SEAM(0);
    }

    for (int L = 0; L < NLAYER; ++L) {
        const int sb = 1 + 8 * L; const bool typeA = L < 2;
        if (IN(sb + 0)) {
            if (typeA && PHM(1)) { PREP(1) {
                pg8::StaticOrder S; S.init(NTOK, 6144, G, bx);
                if (QKV8_A) { pg8::Gemm g{(const bf16*)HB8, (const bf16*)(ws + WS_WQKVA + (size_t)L * 6144 * 2048), NTOK, 6144, DM / 2, DM / 2, wave}; pg8::EpiQkv E{QKV, 6144, 2048, SB_QSCALE, 1.f / pg8::W8_UNDO};
                    pg8::gemm_phase<pg8::EpiQkv, pg8::StaticOrder, true, true, true>(lds + RING_OFF, g, S, E); }
                } static_assert(QKV8_A == 1, "the stick-breaking layers' q|k|v GEMM takes the e4m3 copy of the stream");
            } else if (!typeA && PHM(2)) { PREP(2) {
                const int N = (L == 2) ? 6144 : 2048;
                pg8::StaticOrder S; S.init(NTOK, N, G, bx);
                if (QKV8_B) { pg8::Gemm g{(const bf16*)HB8, (const bf16*)(ws + WS_WQKVB + (L == 2 ? (size_t)0 : (size_t)6144 * 2048)), NTOK, N, DM / 2, DM / 2, wave};
                    pg8::EpiRope E{QKV, 6144, 2048, 4096, DF_QSCALE, 1.f / pg8::W8_UNDO};
                    pg8::gemm_phase<pg8::EpiRope, pg8::StaticOrder, true, true, true>(lds + RING_OFF, g, S, E); }
                else { const int Nh = (V8_B && L == 2) ? 4096 : N; if (V8_B) S.init(NTOK, Nh, G, bx);
                    pg8::Gemm g{(const bf16*)H, (const bf16*)(ws + WS_WQKVB) + (L == 2 ? (size_t)0 : (size_t)6144 * LDH), NTOK, Nh, DM, LDH, wave};
                    pg8::EpiRope E{QKV, 6144, 2048, 4096, DF_QSCALE, 1.f};
                    pg8::gemm_phase<pg8::EpiRope, pg8::StaticOrder, true, true, false, true>(lds + RING_OFF, g, S, E);
                    if (V8_B && L == 2) {
                        pg8::StaticOrder S2; S2.init(NTOK, 2048, G, bx);
                        pg8::Gemm g2{(const bf16*)HB8, (const bf16*)(ws + WS_WQKVB + (size_t)4096 * LDH * 2), NTOK, 2048, DM / 2, P8K2 / 2, wave}; pg8::EpiQkv E2{QKV + 4096, 6144, 0, 1.f, 1.f / pg8::W8_UNDO};
                        pg8::gemm_phase<pg8::EpiQkv, pg8::StaticOrder, true, true, true>(lds + RING_OFF, g2, S2, E2); } } }
            }
            SEAM(sb + 0);
        }
        if (IN(sb + 1)) {
            if (typeA && PHM(3)) {
                for (int id_ = vcu; id_ < 512 * (1 + ((PROBE_DUP >> 3) & 1)); id_ += G) { if (((PROBE_DUP >> 12) & 1) && id_ >= 512 && id_ < 512 + G) xcd_barrier(bar, tid_from_wave(wave) == 0); const int id = id_ & 511; const int bh = id >> 2, p = id & 3, b = bh >> 4, h = bh & 15;
                    const bf16* Qg = QKV + (size_t)b * SEQ * 6144 + h * 128; bf16* Og = (bf16*)((unsigned char*)OB + (size_t)b * SEQ * P8K2 + h * 128);
                    att::sb_block(Qg, Qg + 2048, Qg + 4096, Og, 7 - p, (att::ldsp)(lds + RING_OFF), wave);
                    att::sb_block(Qg, Qg + 2048, Qg + 4096, Og, p, (att::ldsp)(lds + RING_OFF), wave); }
            } else if (!typeA && PHM(4)) {
                const int lane = opq_tid(wave) & 63;
                const int i = L - 2; const float lam_init = (L == 2) ? 0.47071301834264183f : 0.5560582041556061f;
                const float* lp = args.in[6] + (size_t)i * 256;
                const float sa = dpp_sum(lp[lane] * lp[64 + lane]), sb2 = dpp_sum(lp[128 + lane] * lp[192 + lane]);
                const float lam = __builtin_amdgcn_exp2f(sa * LOG2E) - __builtin_amdgcn_exp2f(sb2 * LOG2E) + lam_init;
                const float* gsub = args.in[7] + (size_t)i * 128; const float gmul = 1.f - lam_init;
                for (int id_ = vcu; id_ < 512 * (1 + ((PROBE_DUP >> 4) & 1)); id_ += G) { if (((PROBE_DUP >> 12) & 1) && id_ >= 512 && id_ < 512 + G) xcd_barrier(bar, tid_from_wave(wave) == 0); const int id = id_ & 511; const int bh = id >> 2, p = id & 3, b = bh >> 4, h = bh & 15;
                    const bf16* Qg = QKV + (size_t)b * SEQ * 6144 + h * 128; bf16* Og = (bf16*)((unsigned char*)OB + (size_t)b * SEQ * P8K2 + h * 128); float* Sg = S1 + (size_t)b * SEQ * DM + h * 128;
#pragma unroll 1
                    for (int w = 0; w < 2; ++w) { const int qb = w ? p : 7 - p;
#if DF_RING
                        att::diff_pass2<false>(Qg, Qg + 2048, Qg + 4096, Sg, Og, qb, lam, gsub, gmul, (att::ldsp)(lds + RING_OFF), wave);
                        att::diff_pass2<true>(Qg + 64, Qg + 2048 + 64, Qg + 4096, Sg, Og, qb, lam, gsub, gmul, (att::ldsp)(lds + RING_OFF), wave); } }
#else
                        att::diff_pass<false>(Qg, Qg + 2048, Qg + 4096, Sg, Og, qb, lam, gsub, gmul, (att::ldsp)(lds + RING_OFF), wave);
                        att::diff_pass<true>(Qg + 64, Qg + 2048 + 64, Qg + 4096, Sg, Og, qb, lam, gsub, gmul, (att::ldsp)(lds + RING_OFF), wave); } }
#endif
            }
            SEAM(sb + 1);
        }
        if (IN(sb + 2)) { if (PHM(5)) {
            pg8::Gemm g{OB, (const bf16*)(ws + (typeA ? WS_WOA : WS_WOB) + (size_t)(L & 1) * 2048 * P8K2), NTOK, DM, DM / 2, P8K2 / 2, wave}; pg8::StaticOrder S; S.init(NTOK, DM, G, bx);
            pg8::EpiQkv E{MIX, DM, 0, 1.f, 1.f / (pg8::W8_UNDO * att::OB8_SCALE)};
            pg8::gemm_phase<pg8::EpiQkv, pg8::StaticOrder, true, true, true>(lds + RING_OFF, g, S, E); }
            SEAM(sb + 2);
        }
        if (IN(sb + 3)) { if (PHM(6)) {
            const int tid = opq_tid(wave), lane = tid & 63;
            const float* lng = args.in[8] + (size_t)L * DM; const float* lnb = args.in[9] + (size_t)L * DM; const float* wr = WR + (size_t)L * 20 * 2048;
            LAS int* eid = (LAS int*)(lds + LNX_OFF + 2048);
            LAS float* lgt = (LAS float*)(lds + LNX_OFF + 4096);
            LAS unsigned* rows8 = (LAS unsigned*)(lds + RING_OFF);
            for (int c = bx; c < 256; c += G) {
                const unsigned wcl = (unsigned)(uintptr_t)(lds + WCOL_OFF) + (unsigned)wave * 1024u; const unsigned wvo = (unsigned)(wave * 256 + lane * 4) * 4u;
#define LN1_DMAW(col, buf) att::glds16s(wvo, wr + (size_t)(col) * 2048, (unsigned)__builtin_amdgcn_readfirstlane(wcl + (unsigned)(buf) * 8192u))
                LN1_DMAW(0, 0); LN1_DMAW(1, 1);
#pragma unroll 1
                for (int grp = 0; grp < 2; ++grp) {
                    const int rloc = wave * 8 + grp * 4; const size_t row0 = (size_t)64 * c + rloc;
                    f32x4 v[4][8]; float mu[4], rstd[4];
#pragma unroll
                    for (int rr = 0; rr < 4; ++rr) {
                        if (L == 0) { const f32x4* hp = (const f32x4*)(x_in + (row0 + rr) * DM) + lane;
#pragma unroll
                            for (int j = 0; j < 8; ++j) v[rr][j] = hp[64 * j]; }
                        else { const _Float16* hq = H + (row0 + rr) * DM + 4 * lane;
#pragma unroll
                            for (int j = 0; j < 8; ++j) v[rr][j] = ldh4(hq + 256 * j); } }
#pragma unroll
                    for (int rr = 0; rr < 4; ++rr) { const v2u* mp = (const v2u*)(MIX + (row0 + rr) * DM) + lane;
#pragma unroll
                        for (int j = 0; j < 8; ++j) { const v2u a = mp[64 * j];
                            const f32x4 fa = {__uint_as_float(a.x << 16), __uint_as_float(a.x & 0xffff0000u), __uint_as_float(a.y << 16), __uint_as_float(a.y & 0xffff0000u)};
                            v[rr][j] = v[rr][j] * DN_ALPHA + fa; } }
#pragma unroll
                    for (int rr = 0; rr < 4; ++rr) { float s = 0.f;
#pragma unroll
                        for (int j = 0; j < 8; ++j) s += (v[rr][j][0] + v[rr][j][1]) + (v[rr][j][2] + v[rr][j][3]);
                        mu[rr] = dpp_sum(s) * (1.f / DM); float q = 0.f;
#pragma unroll
                        for (int j = 0; j < 8; ++j) { const f32x4 d = v[rr][j] - mu[rr]; q += (d[0] * d[0] + d[1] * d[1]) + (d[2] * d[2] + d[3] * d[3]); }
                        rstd[rr] = 1.f / sqrtf(dpp_sum(q) * (1.f / DM) + LN_EPS); }
#pragma unroll
                    for (int j = 0; j < 8; ++j) { const f32x4 gg = ((const f32x4*)lng)[64 * j + lane], bb = ((const f32x4*)lnb)[64 * j + lane];
#pragma unroll
                        for (int rr = 0; rr < 4; ++rr) { v[rr][j] = (v[rr][j] - mu[rr]) * rstd[rr] * gg + bb; sth4(H + (row0 + rr) * DM + 256 * j + 4 * lane, v[rr][j]);
                            if (c == bx) rows8[(rloc + rr) * 512 + 64 * j + lane] = pg8::pack4_fp8(v[rr][j][0], v[rr][j][1], v[rr][j][2], v[rr][j][3]); } }
                    int gs[4] = {0, 0, 0, 0};
#pragma unroll 1
                    for (int cc = 0; cc < 20; ++cc) { const int q = grp * 20 + cc, bsel = q & 1;
                        if (q + 1 < 40) asm volatile("s_waitcnt vmcnt(1)\n\ts_barrier" ::: "memory"); else asm volatile("s_waitcnt vmcnt(0)\n\ts_barrier" ::: "memory");
                        f32x4 w[8];
                        { const LAS f32x4* wp = (const LAS f32x4*)(lds + WCOL_OFF + bsel * 8192) + lane;
#pragma unroll
                          for (int j = 0; j < 8; ++j) w[j] = wp[64 * j]; }
                        asm volatile("s_waitcnt lgkmcnt(0)\n\ts_barrier" ::: "memory");
                        if (q + 2 < 40) LN1_DMAW((q + 2) % 20, bsel);
#pragma unroll
                        for (int rr = 0; rr < 4; ++rr) { if (cc < 4 || gs[rr] == ((cc - 4) >> 2)) {
                            f32x2 a2 = {0.f, 0.f};
#pragma unroll
                            for (int j = 0; j < 8; ++j) { const f32x2 wlo = {w[j][0], w[j][1]}, whi = {w[j][2], w[j][3]}, vlo = {v[rr][j][0], v[rr][j][1]}, vhi = {v[rr][j][2], v[rr][j][3]};
                                a2 = __builtin_elementwise_fma(vlo, wlo, a2); a2 = __builtin_elementwise_fma(vhi, whi, a2); }
                            const float a = dpp_sum(a2[0] + a2[1]);
                            if (lane == 0) lgt[(rloc + rr) * 20 + cc] = a; } }
                        if (cc == 3) { LDS_WAIT();
#pragma unroll
                            for (int rr = 0; rr < 4; ++rr) { const LAS float* lg = lgt + (rloc + rr) * 20; int g = 0; float gm = lg[0];
#pragma unroll
                                for (int i = 1; i < 4; ++i) { const float x = lg[i]; if (x > gm) { gm = x; g = i; } }
                                gs[rr] = __builtin_amdgcn_readfirstlane(g); } } }
                }
#undef LN1_DMAW
                LDS_WAIT();
                if (lane < 8) {
                    const int rl = wave * 8 + lane; const LAS float* lg = lgt + rl * 20;
                    int gsel = 0; float gm = lg[0];
#pragma unroll
                    for (int i = 1; i < 4; ++i) { const float x = lg[i]; if (x > gm) { gm = x; gsel = i; } }
                    float gden = 0.f;
#pragma unroll
                    for (int i = 0; i < 4; ++i) gden += __builtin_amdgcn_exp2f((lg[i] - gm) * LOG2E);
                    const float gw_ = 1.f / gden;
                    const LAS float* li = lg + 4 + 4 * gsel;
                    const float l0 = li[0], l1 = li[1], l2 = li[2], l3 = li[3];
                    int i0 = 0; float v0 = l0;
                    if (l1 > v0) { v0 = l1; i0 = 1; } if (l2 > v0) { v0 = l2; i0 = 2; } if (l3 > v0) { v0 = l3; i0 = 3; }
                    int i1 = -1; float v1 = 0.f;
                    if (i0 != 0) { v1 = l0; i1 = 0; }
                    if (i0 != 1 && (i1 < 0 || l1 > v1)) { v1 = l1; i1 = 1; }
                    if (i0 != 2 && (i1 < 0 || l2 > v1)) { v1 = l2; i1 = 2; }
                    if (i0 != 3 && (i1 < 0 || l3 > v1)) { v1 = l3; i1 = 3; }
                    const float t = __builtin_amdgcn_exp2f((v1 - v0) * LOG2E); const float w0 = gw_ / (1.f + t), w1 = gw_ * t / (1.f + t);
                    eid[2 * rl] = gsel * 4 + i0; eid[2 * rl + 1] = gsel * 4 + i1; RW[(size_t)64 * c + rl] = (f32x2){w0, w1};
                }
                __syncthreads();
                if (wave == 0) {
                    const int ea = eid[lane], eb = eid[64 + lane]; int ra = 0, rb = 0, cnt = 0; const unsigned long long lt = (1ull << lane) - 1ull;
#pragma unroll
                    for (int e = 0; e < 16; ++e) { const unsigned long long ma = __ballot(ea == e), mb = __ballot(eb == e);
                        if (ea == e) ra = __popcll(ma & lt); if (eb == e) rb = __popcll(ma) + __popcll(mb & lt); if (lane == e) cnt = __popcll(ma) + __popcll(mb); }
                    if (lane < 16) CNT[c * 16 + lane] = cnt;
                    LAS int* rk = (LAS int*)(lds + LNX_OFF + 3072); rk[lane] = ra; rk[64 + lane] = rb; LDS_WAIT();
                    const int r = lane; const unsigned word = (unsigned)eid[2 * r] | ((unsigned)eid[2 * r + 1] << 8) | ((unsigned)rk[2 * r] << 16) | ((unsigned)rk[2 * r + 1] << 24);
                    RE[(size_t)64 * c + r] = word;
                }
                __syncthreads();
            } }
            SEAM(sb + 3);
        }
        if ((IN(sb + 4) || IN(sb + 5) || IN(sb + 6)) && PHM(7)) {
            const int tid = opq_tid(wave);
            LAS int* part = (LAS int*)(lds + LNX_OFF);
            { const int e = tid & 15, s = tid >> 4; int a = 0;
#pragma unroll
              for (int i = 0; i < 8; ++i) a += CNT[(8 * s + i) * 16 + e];
              part[s * 16 + e] = a; }
            __syncthreads();
            if (tid < 16) { int run = 0;
#pragma clang loop vectorize(disable)
#pragma unroll 8
                for (int s = 0; s < 32; ++s) run += part[s * 16 + tid];
                TAB[tid] = run; }
            __syncthreads();
            if (tid < 192) { int off = 0, mt = 0, mine = 15;
#pragma unroll
                for (int e = 0; e < 16; ++e) { const int nt = (TAB[e] + 255) >> 8; if (tid == 0) TAB[16 + e] = off; if (tid >= mt && tid < mt + nt) mine = e; off += nt * 256; mt += nt; }
                if (tid < mt && tid < 160) TAB[64 + tid] = mine;
                if (tid == 0) { TAB[32] = off; TAB[33] = mt; } }
            __syncthreads();
        }
        if (IN(sb + 4)) { if (PHM(7)) PREP(7) {
            const int tid = opq_tid(wave), lane = tid & 63;
            LAS int* part = (LAS int*)(lds + LNX_OFF);
            for (int c = bx; c < 256; c += G) {
                if (tid < 16) { int pre = 0; int x[8];
#pragma unroll
                    for (int i = 0; i < 8; ++i) x[i] = CNT[((c & ~7) + i) * 16 + tid];
#pragma clang loop vectorize(disable) unroll(disable)
                    for (int s = 0; s < (c >> 3); ++s) pre += part[s * 16 + tid];
#pragma unroll
                    for (int i = 0; i < 8; ++i) pre += (i < (c & 7)) ? x[i] : 0;
                    TAB[48 + tid] = TAB[16 + tid] + pre; }
                __syncthreads();
#pragma unroll 1
                for (int rr = 0; rr < 8; ++rr) { const size_t row = (size_t)64 * c + wave * 8 + rr; const unsigned word = RE[row];
                    const int p0 = TAB[48 + (word & 255)] + ((word >> 16) & 255), p1 = TAB[48 + ((word >> 8) & 255)] + (word >> 24);
                    if (lane == 0) { RP[2 * row] = p0; RP[2 * row + 1] = p1; }
                    if (c == bx && IN(sb + 3)) {
                        const LAS v4u* src = (const LAS v4u*)(lds + RING_OFF + (wave * 8 + rr) * 2048) + lane; v4u* o0 = (v4u*)((unsigned char*)XS + (size_t)p0 * P8K2) + lane; v4u* o1 = (v4u*)((unsigned char*)XS + (size_t)p1 * P8K2) + lane;
                        const v4u a = src[0], b = src[64]; __builtin_nontemporal_store(a, o0); __builtin_nontemporal_store(b, o0 + 64); __builtin_nontemporal_store(a, o1); __builtin_nontemporal_store(b, o1 + 64);
                    } else {
                        const _Float16* hq = H + row * DM + 4 * lane; unsigned* o0 = (unsigned*)((unsigned char*)XS + (size_t)p0 * P8K2) + lane; unsigned* o1 = (unsigned*)((unsigned char*)XS + (size_t)p1 * P8K2) + lane;
#pragma unroll
                        for (int j = 0; j < 8; ++j) { const f32x4 v = ldh4(hq + 256 * j); const unsigned o = pg8::pack4_fp8(v[0], v[1], v[2], v[3]); o0[64 * j] = o; o1[64 * j] = o; } } }
                __syncthreads();
            } }
            SEAM(sb + 4);
        }
        if (IN(sb + 5)) { if (PHM(8)) PREP(8) {
            pg8::Gemm g{XS, (const bf16*)(ws + WS_WGU + (size_t)L * 16 * 2048 * P8K2), XS_ROWS, 2048, DM / 2, P8K2 / 2, wave};
            pg8::MoeOrder<0> S{TAB[33] * 8, G, bx, TAB + 64, nullptr, nullptr, wave}; pg8::EpiGateUp8 E{(unsigned char*)ACT};
            pg8::gemm_phase<pg8::EpiGateUp8, pg8::MoeOrder<0>, true, true, true>(lds + RING_OFF, g, S, E); }
            SEAM(sb + 5);
        }
        if (IN(sb + 6)) { if (PHM(9)) PREP(9) {
            pg8::Gemm g{ACT, (const bf16*)(ws + WS_WDN + (size_t)L * 16 * 2048 * P8K1), XS_ROWS, 2048, DEXP / 2, P8K1 / 2, wave};
            pg8::MoeOrder<0> S{TAB[33] * 8, G, bx, TAB + 64, nullptr, nullptr, wave}; pg8::EpiDown8 E{(unsigned char*)YD};
            pg8::gemm_phase<pg8::EpiDown8, pg8::MoeOrder<0>, true, true, true>(lds + RING_OFF, g, S, E); }
            SEAM(sb + 6);
        }
        if (IN(sb + 7)) { if (PHM(10)) for (int rep_ = 0; rep_ < ((((PROBE_DUP) >> 10) & 1) && L == NLAYER - 1 ? 5 : 1); ++rep_) {
            const int tid = opq_tid(wave), lane = tid & 63;
            const float* lng = args.in[10] + (size_t)L * DM; const float* lnb = args.in[11] + (size_t)L * DM; const bool last = (L == NLAYER - 1); const bool next8 = (L + 1 < 2) ? (QKV8_A != 0) : (QKV8_B != 0 || (V8_B != 0 && L + 1 == 2));
            const int gw = vcu * NWAVES + wave, NGW = G * NWAVES;
            for (int row0 = 4 * gw; row0 < NTOK; row0 += 4 * NGW) {
                f32x4 v[4][8]; float mu[4], rstd[4];
#pragma unroll
                for (int rr = 0; rr < 4; ++rr) { const int row = row0 + rr;
                    const int p0 = RP[2 * row], p1 = RP[2 * row + 1]; const f32x2 w = RW[row];
                    const _Float16* hq = H + (size_t)row * DM + 4 * lane; const unsigned* y0 = (const unsigned*)((const unsigned char*)YD + (size_t)p0 * DM) + lane; const unsigned* y1 = (const unsigned*)((const unsigned char*)YD + (size_t)p1 * DM) + lane;
                    const float w0s = w.x * (1.f / pg8::YD8_SCALE), w1s = w.y * (1.f / pg8::YD8_SCALE);
#pragma unroll
                    for (int j = 0; j < 8; ++j) { const f32x4 h = ldh4(hq + 256 * j); const unsigned a = y0[64 * j], b = y1[64 * j];
                        const f32x2 a0 = __builtin_amdgcn_cvt_pk_f32_fp8((int)a, false), a1 = __builtin_amdgcn_cvt_pk_f32_fp8((int)a, true), b0 = __builtin_amdgcn_cvt_pk_f32_fp8((int)b, false), b1 = __builtin_amdgcn_cvt_pk_f32_fp8((int)b, true);
                        const f32x4 fa = {a0[0], a0[1], a1[0], a1[1]}, fb = {b0[0], b0[1], b1[0], b1[1]};
                        v[rr][j] = h * DN_ALPHA + fa * w0s + fb * w1s; } }
#pragma unroll
                for (int rr = 0; rr < 4; ++rr) { float s = 0.f;
#pragma unroll
                    for (int j = 0; j < 8; ++j) s += (v[rr][j][0] + v[rr][j][1]) + (v[rr][j][2] + v[rr][j][3]);
                    mu[rr] = dpp_sum(s) * (1.f / DM); float q = 0.f;
#pragma unroll
                    for (int j = 0; j < 8; ++j) { const f32x4 dd = v[rr][j] - mu[rr]; q += (dd[0] * dd[0] + dd[1] * dd[1]) + (dd[2] * dd[2] + dd[3] * dd[3]); }
                    rstd[rr] = 1.f / sqrtf(dpp_sum(q) * (1.f / DM) + LN_EPS); }
#pragma unroll
                for (int j = 0; j < 8; ++j) { const f32x4 gg = ((const f32x4*)lng)[64 * j + lane], bb = ((const f32x4*)lnb)[64 * j + lane];
#pragma unroll
                    for (int rr = 0; rr < 4; ++rr) { const int row = row0 + rr; const f32x4 y = (v[rr][j] - mu[rr]) * rstd[rr] * gg + bb;
                        if (last) __builtin_nontemporal_store(y, (f32x4*)(args.out + (size_t)row * DM) + 64 * j + lane);
                        else { sth4(H + (size_t)row * DM + 256 * j + 4 * lane, y); if (next8) __builtin_nontemporal_store(pg8::pack4_fp8(y[0], y[1], y[2], y[3]), (unsigned*)(HB8 + (size_t)row * DM) + 64 * j + lane); } } }
            } }
            SEAM(sb + 7);
        }
    }
#undef IN
#undef SEAM
}

extern "C" void kernel_launch(void* const* d_in, const int* in_sizes, int n_in, void* d_out, int out_size, void* d_ws, size_t ws_size, hipStream_t stream) {
    static int grid = 0;
    if (grid == 0) {
        if (n_in != 17 || in_sizes[0] != NTOK * DM || out_size != NTOK * DM || ws_size < WS_END) { fprintf(stderr, "kernel_launch: unexpected shapes / workspace (n_in %d, ws %zu, need %zu)\n", n_in, ws_size, (size_t)WS_END); grid = -1; return; }
        int dev = 0, cus = 0, per_cu = 0;
        if (hipGetDevice(&dev) != hipSuccess || hipDeviceGetAttribute(&cus, hipDeviceAttributeMultiprocessorCount, dev) != hipSuccess) { grid = -1; return; }
        if (hipFuncSetAttribute((const void*)yoco_fwd, hipFuncAttributeMaxDynamicSharedMemorySize, LDS_BYTES) != hipSuccess) { fprintf(stderr, "kernel_launch: hipFuncSetAttribute failed\n"); grid = -1; return; }
        if (hipOccupancyMaxActiveBlocksPerMultiprocessor(&per_cu, (const void*)yoco_fwd, NWAVES * 64, LDS_BYTES) != hipSuccess || per_cu < 1) { fprintf(stderr, "kernel_launch: occupancy query says %d\n", per_cu); per_cu = 1; }
        (void)hipGetLastError();
        grid = cus;
    }
    if (grid < 0) return;
    (void)hipMemsetAsync((char*)d_ws + WS_CTL, 0, CTL_ZERO_BYTES, stream);
    Args a{};
    for (int i = 0; i < 17; ++i) a.in[i] = (const float*)d_in[i];
    a.out = (float*)d_out; a.ws = (unsigned char*)d_ws;
#if MK_MULTI
    for (int s = 0; s < NSTEPS; ++s) { a.s_lo = s; a.s_hi = s + 1; hipLaunchKernelGGL(yoco_fwd, dim3(grid), dim3(NWAVES * 64), LDS_BYTES, stream, a); }
#else
    a.s_lo = 0; a.s_hi = NSTEPS;
    hipLaunchKernelGGL(yoco_fwd, dim3(grid), dim3(NWAVES * 64), LDS_BYTES, stream, a);
#endif
    const hipError_t le = hipPeekAtLastError();
    if (le != hipSuccess) fprintf(stderr, "kernel_launch: launch failed: %s\n", hipGetErrorName(le));
}
```

```cpp
#include <hip/hip_runtime.h>
#include <cstdio>
#include <cstdint>

__device__ __forceinline__ int tid_from_wave(int wave) { int l; asm volatile("v_mbcnt_lo_u32_b32 %0, -1, 0\n\tv_mbcnt_hi_u32_b32 %0, -1, %0" : "=v"(l)); return wave * 64 + l; }
namespace pg8 {
#define PG8_LAS __attribute__((address_space(3)))
typedef unsigned short bf16_t;
typedef short bf16x8 __attribute__((ext_vector_type(8)));
typedef float f32x4 __attribute__((ext_vector_type(4)));
typedef unsigned u32x4 __attribute__((ext_vector_type(4)));
typedef int pg8_v8i __attribute__((ext_vector_type(8)));
typedef _Float16 pg8_h8 __attribute__((ext_vector_type(8)));
constexpr int BM = 256, BK = 64, HALF = 128, HTB = HALF * BK * 2  , STAGE_BYTES = 8 * HTB, NXCD = 8, WGM = 8;

__host__ __device__ __forceinline__ int lds_byte(int r, int c) { const int st = (r >> 4) * 2 + (c >> 5), rr = r & 15, cc = c & 31, ob = rr * 64 + cc * 2; return st * 1024 + (ob ^ (((ob >> 9) & 1) << 5)); }
__host__ __device__ __forceinline__ void stage_rc(int b, int& R, int& C) { const int st = b / 1024, sb = b % 1024, swz = sb ^ (((sb >> 9) & 1) << 5); R = (st >> 1) * 16 + swz / 64; C = (st & 1) * 32 + (swz % 64) / 2; }
__host__ __device__ __forceinline__ int perm32(int rho) { const int n = rho >> 4, i = rho & 15; return 8 * (i >> 2) + 4 * n + (i & 3); }

struct Unit { int pm, pn; };
struct Gemm { const bf16_t* A; const bf16_t* Bt; int M, N, K, ld, wave; };

struct StaticOrder {
    int nM, nN, nwg, G, c;
    __host__ __device__ void init(int M, int N, int G_, int c_) { nM = M / BM; nN = N / BM; nwg = nM * nN; G = G_; c = c_; }
    __host__ __device__ bool next(int i, Unit& u) const {
        const long L = (long)i * G + c; if (L >= nwg) return false;
        int wgid = (int)L; { const int q = nwg / NXCD, r = nwg % NXCD, xcd = wgid % NXCD, off = wgid / NXCD; wgid = (xcd < r ? xcd * (q + 1) : r * (q + 1) + (xcd - r) * q) + off; }
        const int nig = WGM * nN, gid = wgid / nig, fm = gid * WGM, gsz = (nM - fm) < WGM ? (nM - fm) : WGM;
        u.pm = fm + ((wgid % nig) % gsz); u.pn = (wgid % nig) / gsz; return true;
    }
    __device__ __forceinline__ void a_ready(const Unit&) const {}
    __device__ __forceinline__ void done(const Unit&) const {}
};

__device__ __forceinline__ unsigned cvt_pk_bf16(float lo, float hi) { unsigned r; asm volatile("v_cvt_pk_bf16_f32 %0, %1, %2" : "=v"(r) : "v"(lo), "v"(hi)); return r; }
typedef float f32x2 __attribute__((ext_vector_type(2)));

typedef unsigned u32x2 __attribute__((ext_vector_type(2)));
__device__ __forceinline__ u32x4 pack8_bf16(const f32x4 a, const f32x4 b) { u32x4 w; w.x = cvt_pk_bf16(a[0], a[1]); w.y = cvt_pk_bf16(a[2], a[3]); w.z = cvt_pk_bf16(b[0], b[1]); w.w = cvt_pk_bf16(b[2], b[3]); return w; }

struct EpiQkv {
    static constexpr bool PERM = true, AFTER_DRAIN = false;
    bf16_t* O; int ldc; int qcols; float qscale; float osc;
    __device__ __forceinline__ void operator()(const f32x4 (&acc)[2][2][4][2], const Unit& u, int wr, int wc, int fr, int fq) const {
        const int row0 = u.pm * BM + wr * 64 + fr, colt = u.pn * BM; const float sc = (colt < qcols ? qscale : 1.f) * osc;
        const int col0 = colt + wc * 32 + 8 * fq;
#pragma unroll
        for (int ai = 0; ai < 2; ++ai)
#pragma unroll
            for (int m = 0; m < 4; ++m) { bf16_t* rowp = O + (size_t)(row0 + ai * HALF + m * 16) * ldc + col0;
#pragma unroll
                for (int bj = 0; bj < 2; ++bj) *(u32x4*)(rowp + bj * HALF) = pack8_bf16(acc[ai][bj][m][0] * sc, acc[ai][bj][m][1] * sc); }
    }
};
template <int ACCS_INV> struct EpiResid {
    static constexpr bool PERM = false, AFTER_DRAIN = false;
    static constexpr int ldc = 2048; static constexpr float alpha = 1.6817928305074292f, accs = 1.f / (float)ACCS_INV;
    float* H; const float* Hsrc;
    __device__ __forceinline__ void operator()(const f32x4 (&acc)[2][2][4][2], const Unit& u, int wr, int wc, int fr, int fq) const {
        const int row0 = u.pm * BM + wr * 64 + fr, col0 = u.pn * BM + wc * 32 + 4 * fq;
#pragma unroll
        for (int ai = 0; ai < 2; ++ai)
#pragma unroll
            for (int m = 0; m < 4; ++m) { const size_t ro = (size_t)(row0 + ai * HALF + m * 16) * ldc + col0; float* rowp = H + ro; const float* srcp = Hsrc + ro;
#pragma unroll
                for (int bj = 0; bj < 2; ++bj)
#pragma unroll
                    for (int n = 0; n < 2; ++n) { const f32x4 h = *(const f32x4*)(srcp + bj * HALF + n * 16); *(f32x4*)(rowp + bj * HALF + n * 16) = h * alpha + acc[ai][bj][m][n] * accs; } }
    }
};
struct EpiRope {
    static constexpr bool PERM = true, AFTER_DRAIN = false;
    bf16_t* O; int ldc; int qcols, ropecols; float qscale; float osc;
    __device__ __forceinline__ void operator()(const f32x4 (&acc)[2][2][4][2], const Unit& u, int wr, int wc, int fr, int fq) const {
        const int row0 = u.pm * BM + wr * 64 + fr, colt = u.pn * BM;
        if (colt >= ropecols) {
            const int col0 = colt + wc * 32 + 8 * fq;
#pragma unroll
            for (int ai = 0; ai < 2; ++ai)
#pragma unroll
                for (int m = 0; m < 4; ++m) { bf16_t* rowp = O + (size_t)(row0 + ai * HALF + m * 16) * ldc + col0;
#pragma unroll
                    for (int bj = 0; bj < 2; ++bj) *(u32x4*)(rowp + bj * HALF) = pack8_bf16(acc[ai][bj][m][0] * osc, acc[ai][bj][m][1] * osc); }
        } else {
            const float sc = (colt < qcols ? qscale : 1.f) * osc;
            const int col0 = colt + wc * 64 + 8 * fq;
            float ir[8];
#pragma unroll
            for (int i = 0; i < 8; ++i) ir[i] = __builtin_amdgcn_exp2f(-(float)(8 * fq + i) * 0.4152410118609203f) * 0.15915494309189535f;
#pragma unroll
            for (int ai = 0; ai < 2; ++ai)
#pragma unroll
                for (int m = 0; m < 4; ++m) { const int row = row0 + ai * HALF + m * 16; const float pos = (float)(row & 2047);
                    f32x4 c0, c1, s0, s1;
#pragma unroll
                    for (int i = 0; i < 4; ++i) { const float f0 = __builtin_amdgcn_fractf(pos * ir[i]), f1 = __builtin_amdgcn_fractf(pos * ir[4 + i]);
                        c0[i] = __builtin_amdgcn_cosf(f0); s0[i] = __builtin_amdgcn_sinf(f0); c1[i] = __builtin_amdgcn_cosf(f1); s1[i] = __builtin_amdgcn_sinf(f1); }
                    const f32x4 a0 = acc[ai][0][m][0], a1 = acc[ai][0][m][1], b0 = acc[ai][1][m][0], b1 = acc[ai][1][m][1];
                    bf16_t* rowp = O + (size_t)row * ldc + col0;
                    *(u32x4*)(rowp) = pack8_bf16((a0 * c0 - b0 * s0) * sc, (a1 * c1 - b1 * s1) * sc);
                    *(u32x4*)(rowp + 32) = pack8_bf16((b0 * c0 + a0 * s0) * sc, (b1 * c1 + a1 * s1) * sc); }
        }
    }
};
struct EpiGateUp {
    static constexpr bool PERM = true, AFTER_DRAIN = false;
    bf16_t* O;
    __device__ __forceinline__ void operator()(const f32x4 (&acc)[2][2][4][2], const Unit& u, int wr, int wc, int fr, int fq) const {
        const int row0 = u.pm * BM + wr * 64 + fr, col0 = (u.pn & 7) * 128 + wc * 32 + 8 * fq;
#pragma unroll
        for (int ai = 0; ai < 2; ++ai)
#pragma unroll
            for (int m = 0; m < 4; ++m) { f32x4 r[2];
#pragma unroll
                for (int n = 0; n < 2; ++n) { const f32x4 g = acc[ai][0][m][n], up = acc[ai][1][m][n];
#pragma unroll
                    for (int i = 0; i < 4; ++i) { const float e = __builtin_amdgcn_exp2f(g[i] * -1.4426950408889634f); r[n][i] = g[i] * __builtin_amdgcn_rcpf(1.f + e) * up[i]; } }
                *(u32x4*)(O + (size_t)(row0 + ai * HALF + m * 16) * 1024 + col0) = pack8_bf16(r[0], r[1]); }
    }
};
struct EpiDown {
    static constexpr bool PERM = true, AFTER_DRAIN = false;
    bf16_t* O;
    __device__ __forceinline__ void operator()(const f32x4 (&acc)[2][2][4][2], const Unit& u, int wr, int wc, int fr, int fq) const {
        const int row0 = u.pm * BM + wr * 64 + fr, col0 = (u.pn & 7) * BM + wc * 32 + 8 * fq;
#pragma unroll
        for (int ai = 0; ai < 2; ++ai)
#pragma unroll
            for (int m = 0; m < 4; ++m) { bf16_t* rowp = O + (size_t)(row0 + ai * HALF + m * 16) * 2048 + col0;
#pragma unroll
                for (int bj = 0; bj < 2; ++bj) *(u32x4*)(rowp + bj * HALF) = pack8_bf16(acc[ai][bj][m][0], acc[ai][bj][m][1]); }
    }
};
#ifndef PROBE_MFMA2
#define PROBE_MFMA2 0
#endif
constexpr float W8_SCALE = 64.f, ACT8_SCALE = 4.f, W8_UNDO = W8_SCALE * (PROBE_MFMA2 ? 2.f : 1.f);
__device__ __forceinline__ unsigned pack4_fp8(float a, float b, float c, float d) { int w; asm volatile("" : "=v"(w));
    w = __builtin_amdgcn_cvt_pk_fp8_f32(a, b, w, false); w = __builtin_amdgcn_cvt_pk_fp8_f32(c, d, w, true); return (unsigned)w; }
struct EpiGateUp8 {
    static constexpr bool PERM = true, AFTER_DRAIN = false;
    unsigned char* O;
    __device__ __forceinline__ void operator()(const f32x4 (&acc)[2][2][4][2], const Unit& u, int wr, int wc, int fr, int fq) const {
        const int row0 = u.pm * BM + wr * 64 + fr, col0 = (u.pn & 7) * 128 + wc * 32 + 8 * fq;
        constexpr float SI = 1.f / W8_UNDO;
#pragma unroll
        for (int ai = 0; ai < 2; ++ai)
#pragma unroll
            for (int m = 0; m < 4; ++m) { f32x4 r[2];
#pragma unroll
                for (int n = 0; n < 2; ++n) { const f32x4 g = acc[ai][0][m][n] * SI, up = acc[ai][1][m][n] * (SI * ACT8_SCALE);
#pragma unroll
                    for (int i = 0; i < 4; ++i) { const float e = __builtin_amdgcn_exp2f(g[i] * -1.4426950408889634f); r[n][i] = g[i] * __builtin_amdgcn_rcpf(1.f + e) * up[i]; } }
                u32x2 w; w.x = pack4_fp8(r[0][0], r[0][1], r[0][2], r[0][3]); w.y = pack4_fp8(r[1][0], r[1][1], r[1][2], r[1][3]);
                *(u32x2*)(O + (size_t)(row0 + ai * HALF + m * 16) * 1024 + col0) = w; }
    }
};
constexpr float YD8_SCALE = 16.f;
struct EpiDown8 {
    static constexpr bool PERM = true, AFTER_DRAIN = false;
    unsigned char* O;
    __device__ __forceinline__ void operator()(const f32x4 (&acc)[2][2][4][2], const Unit& u, int wr, int wc, int fr, int fq) const {
        const int row0 = u.pm * BM + wr * 64 + fr, col0 = (u.pn & 7) * BM + wc * 32 + 8 * fq;
        constexpr float SI = YD8_SCALE / (W8_UNDO * ACT8_SCALE);
#pragma unroll
        for (int ai = 0; ai < 2; ++ai)
#pragma unroll
            for (int m = 0; m < 4; ++m) { unsigned char* rowp = O + (size_t)(row0 + ai * HALF + m * 16) * 2048 + col0;
#pragma unroll
                for (int bj = 0; bj < 2; ++bj) { const f32x4 a = acc[ai][bj][m][0] * SI, c = acc[ai][bj][m][1] * SI; u32x2 w; w.x = pack4_fp8(a[0], a[1], a[2], a[3]); w.y = pack4_fp8(c[0], c[1], c[2], c[3]);
                    *(u32x2*)(rowp + bj * HALF) = w; } }
    }
};
template <int ROLE> struct MoeOrder {
    int nunits, G, c; const PG8_LAS int* tile_e; unsigned* cnt; unsigned* tmo; int wave;
    __device__ __forceinline__ bool next(int i, Unit& u) const {
        const int cc = (ROLE == 2) ? G - 1 - c : c; int idx;
        if ((G & 7) == 0) { const int per = G >> 3; idx = (i * 8 + (cc & 7)) * per + (cc >> 3); } else idx = i * G + cc;
        if (idx >= nunits) return false;
        const int mt = idx >> 3; u.pm = mt; u.pn = tile_e[mt] * 8 + (idx & 7); return true;
    }
    __device__ __forceinline__ void a_ready(const Unit& u) const {
        if constexpr (ROLE == 2) {
            if (wave == 0) { const bool lane0 = (tid_from_wave(0) == 0);
                const unsigned long long t0 = __builtin_amdgcn_s_memrealtime(); unsigned polls = 0;
                while ((unsigned)__builtin_amdgcn_readfirstlane(__hip_atomic_load(cnt + 64 * u.pm, __ATOMIC_RELAXED, __HIP_MEMORY_SCOPE_AGENT)) < 64u) {
                    if ((++polls & 255u) == 0u && __builtin_amdgcn_readfirstlane(__hip_atomic_load(tmo, __ATOMIC_RELAXED, __HIP_MEMORY_SCOPE_AGENT)) != 0u) break;
                    if (__builtin_amdgcn_s_memrealtime() - t0 > 2000000ull) { if (lane0) __hip_atomic_store(tmo, 1u, __ATOMIC_RELAXED, __HIP_MEMORY_SCOPE_AGENT); break; }
                    __builtin_amdgcn_s_sleep(2); }
                __builtin_amdgcn_fence(__ATOMIC_ACQUIRE, "agent");
                asm volatile("s_waitcnt vmcnt(0)" ::: "memory");
            }
            asm volatile("" ::: "memory"); __builtin_amdgcn_s_barrier(); asm volatile("" ::: "memory");
        }
    }
    __device__ __forceinline__ void done(const Unit& u) const {
        if constexpr (ROLE == 1) {
            asm volatile("s_waitcnt vmcnt(0)" ::: "memory");
            if (tid_from_wave(0) == 0) __hip_atomic_fetch_add(cnt + 64 * u.pm, 1u, __ATOMIC_RELAXED, __HIP_MEMORY_SCOPE_AGENT);
        }
    }
};

#ifndef PROBE_MFMA2
#define PROBE_MFMA2 0
#endif
template <class Epi, class Sched, bool ALIGN_EPI = false, bool SP2 = false, bool F8 = false, bool F16 = false>
__device__ __forceinline__ void gemm_phase(PG8_LAS unsigned char* lds, const Gemm g, const Sched& S, const Epi& E) {
    int tid_ = tid_from_wave(g.wave); asm volatile("" : "+v"(tid_));
    const int tid = tid_, wid = __builtin_amdgcn_readfirstlane(tid >> 6), lane = tid & 63, wr = wid >> 2, wc = wid & 3, fr = lane & 15, fq = lane >> 4;
    const int K = g.K, LD = g.ld, nt = K / BK;
    unsigned voffA, voffB;
    { int R, C; stage_rc(tid * 16, R, C); const int Rb = Epi::PERM ? ((R & ~31) + perm32(R & 31)) : R;
        voffA = (unsigned)(R * LD + C) * 2u; voffB = (unsigned)(Rb * LD + C) * 2u; }
    const size_t pstep = (size_t)64 * LD * 2;
    const size_t kstep = (size_t)(BK * 2);
    const size_t hstep = (size_t)HALF * LD * 2;
    const size_t tstep = 2 * hstep;
    const unsigned ldsbase = (unsigned)(uintptr_t)lds;
    const unsigned ldsw = (unsigned)wid * 1024u;
    const int aoff = lds_byte(wr * 64 + fr, fq * 8), boff = lds_byte(wc * 32 + fr, fq * 8);
#define PG8_SA(b, h) (((b) * 2 + (h)) * HTB)
#define PG8_SB(b, h) ((4 + (b) * 2 + (h)) * HTB)
#define PG8_STAGE(bufoff, gbase, voff) do { _Pragma("unroll") for (int _i = 0; _i < 2; ++_i) { unsigned keep_; \
        asm volatile("s_mov_b32 %0, m0\n\ts_mov_b32 m0, %3\n\ts_nop 0\n\tglobal_load_lds_dwordx4 %1, %2\n\ts_mov_b32 m0, %0" : "=&s"(keep_) \
            : "v"(voff), "s"((const char*)(gbase) + _i * pstep), "s"(ldsbase + (unsigned)(bufoff) + ldsw + (unsigned)(_i * 8192))); } } while (0)
#define PG8_CAT(a, b) __builtin_bit_cast(pg8_v8i, __builtin_shufflevector(a, b, 0, 1, 2, 3, 4, 5, 6, 7, 8, 9, 10, 11, 12, 13, 14, 15))
#define PG8_LDA(dst, b, h) do { if constexpr (F8) { _Pragma("unroll") for (int m = 0; m < 4; ++m) { const bf16x8 lo_ = *(const PG8_LAS bf16x8*)(lds + PG8_SA(b, h) + aoff + m * 2048), hi_ = *(const PG8_LAS bf16x8*)(lds + PG8_SA(b, h) + aoff + m * 2048 + 1024); dst##8[m] = PG8_CAT(lo_, hi_); } } \
        else { _Pragma("unroll") for (int m = 0; m < 4; ++m) _Pragma("unroll") for (int k = 0; k < 2; ++k) dst[m][k] = *(const PG8_LAS bf16x8*)(lds + PG8_SA(b, h) + aoff + m * 2048 + k * 1024); } } while (0)
#define PG8_LDB(dst, b, h) do { if constexpr (F8) { _Pragma("unroll") for (int n = 0; n < 2; ++n) { const bf16x8 lo_ = *(const PG8_LAS bf16x8*)(lds + PG8_SB(b, h) + boff + n * 2048), hi_ = *(const PG8_LAS bf16x8*)(lds + PG8_SB(b, h) + boff + n * 2048 + 1024); dst##8[n] = PG8_CAT(lo_, hi_); } } \
        else { _Pragma("unroll") for (int n = 0; n < 2; ++n) _Pragma("unroll") for (int k = 0; k < 2; ++k) dst[n][k] = *(const PG8_LAS bf16x8*)(lds + PG8_SB(b, h) + boff + n * 2048 + k * 1024); } } while (0)
#define PG8_MMA(ai, bj, At, Bt) do { __builtin_amdgcn_s_setprio(1); \
        if constexpr (F8) { _Pragma("unroll") for (int m = 0; m < 4; ++m) _Pragma("unroll") for (int n = 0; n < 2; ++n) \
            { acc[ai][bj][m][n] = __builtin_amdgcn_mfma_scale_f32_16x16x128_f8f6f4(Bt##8[n], At##8[m], acc[ai][bj][m][n], 0, 0, 0, 0, 0, 0); \
              if (PROBE_MFMA2) acc[ai][bj][m][n] = __builtin_amdgcn_mfma_scale_f32_16x16x128_f8f6f4(Bt##8[n], At##8[m], acc[ai][bj][m][n], 0, 0, 0, 0, 0, 0); } } \
        else { _Pragma("unroll") for (int m = 0; m < 4; ++m) _Pragma("unroll") for (int n = 0; n < 2; ++n) _Pragma("unroll") for (int k = 0; k < 2; ++k) \
            acc[ai][bj][m][n] = F16 ? __builtin_amdgcn_mfma_f32_16x16x32_f16(__builtin_bit_cast(pg8_h8, Bt[n][k]), __builtin_bit_cast(pg8_h8, At[m][k]), acc[ai][bj][m][n], 0, 0, 0) \
                                    : __builtin_amdgcn_mfma_f32_16x16x32_bf16(Bt[n][k], At[m][k], acc[ai][bj][m][n], 0, 0, 0); } \
        __builtin_amdgcn_s_setprio(0); } while (0)
#define PG8_WAIT_V(n) asm volatile("s_waitcnt vmcnt(" #n ")" ::: "memory")
#define PG8_WAIT_L(n) asm volatile("s_waitcnt lgkmcnt(" #n ")" ::: "memory")
#define PG8_BAR __builtin_amdgcn_s_barrier()
#define PG8_SCHED __builtin_amdgcn_sched_barrier(0)
    Unit cur, nxt; int ui = 0;
    if (!S.next(0, cur)) return;
    f32x4 acc[2][2][4][2];
{ float zero_; asm volatile("v_mov_b32 %0, 0" : "=v"(zero_));
#pragma unroll
    for (int a = 0; a < 2; ++a)
#pragma unroll
        for (int b = 0; b < 2; ++b)
#pragma unroll
            for (int m = 0; m < 4; ++m)
#pragma unroll
                for (int n = 0; n < 2; ++n) acc[a][b][m][n] = (f32x4){zero_, zero_, zero_, zero_}; }
    bf16x8 At[4][2], B0[2][2], B1[2][2]; pg8_v8i At8[4], B08[2], B18[2];
    const char* cA = (const char*)g.A + (size_t)cur.pm * tstep; const char* cB = (const char*)g.Bt + (size_t)cur.pn * tstep;
    S.a_ready(cur);
    if constexpr (SP2) {
        PG8_STAGE(PG8_SB(0, 0), cB, voffB); PG8_STAGE(PG8_SB(0, 1), cB + hstep, voffB); PG8_STAGE(PG8_SA(0, 0), cA, voffA); PG8_STAGE(PG8_SA(0, 1), cA + hstep, voffA);
        if (wr == 1) PG8_BAR;
        PG8_WAIT_V(2); PG8_BAR;
        PG8_STAGE(PG8_SB(1, 0), cB + kstep, voffB); PG8_STAGE(PG8_SA(1, 0), cA + kstep, voffA); PG8_STAGE(PG8_SB(1, 1), cB + hstep + kstep, voffB);
        PG8_WAIT_V(6); PG8_BAR;
    } else {
        PG8_STAGE(PG8_SB(0, 0), cB, voffB); PG8_STAGE(PG8_SA(0, 0), cA, voffA); PG8_STAGE(PG8_SB(0, 1), cB + hstep, voffB); PG8_STAGE(PG8_SA(0, 1), cA + hstep, voffA);
        if (wr == 1) PG8_BAR;
        PG8_WAIT_V(4); PG8_BAR;
        PG8_STAGE(PG8_SB(1, 0), cB + kstep, voffB); PG8_STAGE(PG8_SA(1, 0), cA + kstep, voffA); PG8_STAGE(PG8_SB(1, 1), cB + hstep + kstep, voffB);
        PG8_WAIT_V(6); PG8_BAR;
    }
    for (;;) {
        const bool has_next = S.next(ui + 1, nxt);
        const char* nA = has_next ? (const char*)g.A + (size_t)nxt.pm * tstep : cA; const char* nB = has_next ? (const char*)g.Bt + (size_t)nxt.pn * tstep : cB;
#pragma unroll 1
        for (int t = 0; t < nt; t += 2) {
            const bool last = (t == nt - 2);
            const char* a1 = cA + (size_t)(t + 1) * kstep;
            const char* a2 = last ? nA : cA + (size_t)(t + 2) * kstep; const char* b2 = last ? nB : cB + (size_t)(t + 2) * kstep;
            const char* a3 = a2 + kstep; const char* b3 = b2 + kstep;
            if (last && has_next) S.a_ready(nxt);
            if constexpr (SP2) {
            PG8_LDB(B0, 0, 0); PG8_LDB(B1, 0, 1); PG8_SCHED; PG8_LDA(At, 0, 0); PG8_STAGE(PG8_SA(1, 1), a1 + hstep, voffA);
            PG8_WAIT_V(8); PG8_WAIT_L(0); PG8_BAR; PG8_MMA(0, 0, At, B0); PG8_MMA(0, 1, At, B1); PG8_BAR; PG8_SCHED;
            PG8_LDA(At, 0, 1); PG8_STAGE(PG8_SB(0, 0), b2, voffB); PG8_STAGE(PG8_SB(0, 1), b2 + hstep, voffB); PG8_STAGE(PG8_SA(0, 0), a2, voffA);
            PG8_WAIT_V(8); PG8_WAIT_L(0); PG8_BAR; PG8_MMA(1, 0, At, B0); PG8_MMA(1, 1, At, B1); PG8_BAR; PG8_SCHED;
            PG8_LDB(B0, 1, 0); PG8_LDB(B1, 1, 1); PG8_SCHED; PG8_LDA(At, 1, 0); PG8_STAGE(PG8_SA(0, 1), a2 + hstep, voffA);
            PG8_WAIT_V(8); PG8_WAIT_L(0); PG8_BAR; PG8_MMA(0, 0, At, B0); PG8_MMA(0, 1, At, B1); PG8_BAR; PG8_SCHED;
            PG8_LDA(At, 1, 1); PG8_STAGE(PG8_SB(1, 0), b3, voffB); PG8_STAGE(PG8_SB(1, 1), b3 + hstep, voffB); PG8_STAGE(PG8_SA(1, 0), a3, voffA);
            PG8_WAIT_V(8); PG8_WAIT_L(0); PG8_BAR; PG8_MMA(1, 0, At, B0); PG8_MMA(1, 1, At, B1); PG8_BAR; PG8_SCHED;
            } else {
            PG8_LDB(B0, 0, 0); PG8_SCHED; PG8_LDA(At, 0, 0); PG8_STAGE(PG8_SA(1, 1), a1 + hstep, voffA);
            PG8_WAIT_L(8); PG8_BAR; PG8_WAIT_L(0); PG8_MMA(0, 0, At, B0); PG8_BAR; PG8_SCHED;
            PG8_LDB(B1, 0, 1); PG8_STAGE(PG8_SB(0, 0), b2, voffB);
            PG8_BAR; PG8_WAIT_L(0); PG8_MMA(0, 1, At, B1); PG8_BAR;
            PG8_LDA(At, 0, 1); PG8_STAGE(PG8_SA(0, 0), a2, voffA);
            PG8_BAR; PG8_WAIT_L(0); PG8_MMA(1, 0, At, B0); PG8_BAR; PG8_SCHED;
            PG8_STAGE(PG8_SB(0, 1), b2 + hstep, voffB);
            PG8_WAIT_V(6); PG8_BAR; PG8_MMA(1, 1, At, B1); PG8_BAR;
            PG8_LDB(B0, 1, 0); PG8_SCHED; PG8_LDA(At, 1, 0); PG8_STAGE(PG8_SA(0, 1), a2 + hstep, voffA);
            PG8_WAIT_L(8); PG8_BAR; PG8_WAIT_L(0); PG8_MMA(0, 0, At, B0); PG8_BAR; PG8_SCHED;
            PG8_LDB(B1, 1, 1); PG8_STAGE(PG8_SB(1, 0), b3, voffB);
            PG8_BAR; PG8_WAIT_L(0); PG8_MMA(0, 1, At, B1); PG8_BAR;
            PG8_LDA(At, 1, 1); PG8_STAGE(PG8_SA(1, 0), a3, voffA);
            PG8_BAR; PG8_WAIT_L(0); PG8_MMA(1, 0, At, B0); PG8_BAR; PG8_SCHED;
            PG8_STAGE(PG8_SB(1, 1), b3 + hstep, voffB);
            PG8_WAIT_V(6); PG8_BAR; PG8_MMA(1, 1, At, B1); PG8_BAR;
            }
        }
        if constexpr (ALIGN_EPI) { if (wr == 0) PG8_BAR; }
        if constexpr (!Epi::AFTER_DRAIN) { const int t2_ = tid_from_wave(g.wave);
            E(acc, cur, wr, wc, t2_ & 15, (t2_ >> 4) & 3); S.done(cur); }
        if (!has_next) break;
{ float zero_; asm volatile("v_mov_b32 %0, 0" : "=v"(zero_));
#pragma unroll
        for (int a = 0; a < 2; ++a)
#pragma unroll
            for (int b = 0; b < 2; ++b)
#pragma unroll
                for (int m = 0; m < 4; ++m)
#pragma unroll
                    for (int n = 0; n < 2; ++n) acc[a][b][m][n] = (f32x4){zero_, zero_, zero_, zero_}; }
        cur = nxt; cA = nA; cB = nB; ++ui;
        if constexpr (ALIGN_EPI) { if (wr == 1) PG8_BAR; }
    }
    PG8_WAIT_V(0);
    if constexpr (!ALIGN_EPI) { if (wr == 0) PG8_BAR; }
    PG8_BAR;
    if constexpr (Epi::AFTER_DRAIN) { E.fused(acc, cur, wr, wc, fr, fq, lds, wid, lane); S.done(cur); }
#undef PG8_SA
#undef PG8_SB
#undef PG8_STAGE
#undef PG8_LDA
#undef PG8_LDB
#undef PG8_MMA
#undef PG8_CAT
#undef PG8_WAIT_V
#undef PG8_WAIT_L
#undef PG8_BAR
#undef PG8_SCHED
}
}

namespace att {
#define ALAS __attribute__((address_space(3)))
typedef unsigned short bf16_t;
typedef short bf16x8 __attribute__((ext_vector_type(8)));
typedef short s16x4 __attribute__((ext_vector_type(4)));
typedef float f32x16 __attribute__((ext_vector_type(16)));
typedef float f32x4 __attribute__((ext_vector_type(4)));
typedef unsigned u32x4 __attribute__((ext_vector_type(4)));
typedef ALAS char* ldsp;
#ifndef WO_F8
#define WO_F8 1
#endif
constexpr float OB8_SCALE = 8.f;
constexpr int QP = 6144;
constexpr int OP = 2048;
constexpr int OBP = 2048;
constexpr int SHM_V = 16384, SHM_K = 16384;
constexpr int LDS_V = 0, LDS_K = 2 * SHM_V, LDS_WS = LDS_K + 2 * SHM_K, ATT_LDS_BYTES = LDS_WS + 8 * 256;
#define KSWZ(row, colB) ((row) * 256 + ((colB) ^ (((row) & 7) << 4)))
#define KSWZ64(row, colB) ((row) * 128 + ((colB) ^ (((row) & 7) << 4)))
#define SBAR() __builtin_amdgcn_sched_barrier(0)
__device__ __forceinline__ int v_st(int k, int c) { const int kk = (k & ~0xC) | ((k & 4) << 1) | ((k & 8) >> 1); return ((kk >> 3) * 4 + (c >> 5)) * 512 + ((kk & 7) * 32 + (c & 31)) * 2; }
__device__ __forceinline__ int v_rd_base(int lane) { return ((lane & 3) << 3) | (((lane >> 2) & 3) << 6) | (((lane >> 4) & 1) << 5) | (((lane >> 5) & 1) << 8); }
constexpr int v_rd_off(int d0, int ks, int half) { return d0 * 512 + ks * 4096 + half * 2048; }
__device__ __forceinline__ int crow(int r, int hi) { return (r & 3) + 8 * (r >> 2) + 4 * hi; }
__device__ __forceinline__ unsigned cvtpk(float lo, float hi) { unsigned r; asm volatile("v_cvt_pk_bf16_f32 %0, %1, %2" : "=v"(r) : "v"(lo), "v"(hi)); return r; }
__device__ __forceinline__ bf16x8 ldg8(const bf16_t* p) { return *reinterpret_cast<const bf16x8*>(p); }
__device__ __forceinline__ unsigned quad_pack_fp8(float v) {
    const int b = __builtin_bit_cast(int, v);
    const float v1 = __builtin_bit_cast(float, __builtin_amdgcn_update_dpp(b, b, 0x55, 0xf, 0xf, false));
    const float v2 = __builtin_bit_cast(float, __builtin_amdgcn_update_dpp(b, b, 0xAA, 0xf, 0xf, false));
    const float v3 = __builtin_bit_cast(float, __builtin_amdgcn_update_dpp(b, b, 0xFF, 0xf, 0xf, false));
    int w; asm volatile("" : "=v"(w));
    w = __builtin_amdgcn_cvt_pk_fp8_f32(v, v1, w, false); w = __builtin_amdgcn_cvt_pk_fp8_f32(v2, v3, w, true); return (unsigned)w;
}
__device__ __forceinline__ float xhalf(float v, int hi) {
    auto rr = __builtin_amdgcn_permlane32_swap(__float_as_uint(v), __float_as_uint(v), false, false);
    return __uint_as_float(hi ? rr[0] : rr[1]);
}
#define ATT_PK4(P, B_, OUT) do { unsigned a0 = cvtpk(P[B_+0], P[B_+1]), a1 = cvtpk(P[B_+2], P[B_+3]);                      \
        unsigned b0 = cvtpk(P[B_+4], P[B_+5]), b1 = cvtpk(P[B_+6], P[B_+7]);                                             \
        auto r0 = __builtin_amdgcn_permlane32_swap(a0, b0, false, false); auto r1 = __builtin_amdgcn_permlane32_swap(a1, b1, false, false); \
        u32x4 w = {r0[0], r1[0], r0[1], r1[1]}; OUT = *reinterpret_cast<bf16x8*>(&w); } while (0)
__device__ __forceinline__ void pv_tile(f32x16* o, int vb, bf16x8 pa0, bf16x8 pa1, bf16x8 pa2, bf16x8 pa3) {
#define TRRD(dst, off) asm volatile("ds_read_b64_tr_b16 %0, %1 offset:%2" : "=&v"(dst) : "v"(vb), "i"(off) : "memory")
#define PV_D0(d0) do { s16x4 l0, l1, l2, l3, h0, h1, h2, h3; constexpr int b_ = v_rd_off(d0, 0, 0); \
        TRRD(l0, b_); TRRD(h0, b_ + 2048); TRRD(l1, b_ + 4096); TRRD(h1, b_ + 6144); TRRD(l2, b_ + 8192); TRRD(h2, b_ + 10240); TRRD(l3, b_ + 12288); TRRD(h3, b_ + 14336); \
        asm volatile("s_waitcnt lgkmcnt(0)" ::: "memory"); SBAR(); \
        o[d0] = __builtin_amdgcn_mfma_f32_32x32x16_bf16(pa0, (bf16x8){l0[0], l0[1], l0[2], l0[3], h0[0], h0[1], h0[2], h0[3]}, o[d0], 0, 0, 0);   \
        o[d0] = __builtin_amdgcn_mfma_f32_32x32x16_bf16(pa1, (bf16x8){l1[0], l1[1], l1[2], l1[3], h1[0], h1[1], h1[2], h1[3]}, o[d0], 0, 0, 0);   \
        o[d0] = __builtin_amdgcn_mfma_f32_32x32x16_bf16(pa2, (bf16x8){l2[0], l2[1], l2[2], l2[3], h2[0], h2[1], h2[2], h2[3]}, o[d0], 0, 0, 0);   \
        o[d0] = __builtin_amdgcn_mfma_f32_32x32x16_bf16(pa3, (bf16x8){l3[0], l3[1], l3[2], l3[3], h3[0], h3[1], h3[2], h3[3]}, o[d0], 0, 0, 0); } while (0)
    PV_D0(0); PV_D0(1); PV_D0(2); PV_D0(3);
#undef PV_D0
#undef TRRD
}

__device__ __forceinline__ void sb_block(const bf16_t* __restrict__ Qg, const bf16_t* __restrict__ Kg, const bf16_t* __restrict__ Vg, bf16_t* __restrict__ Og, int qb, ldsp lds, int wave_) {
    int tid_ = tid_from_wave(wave_); asm volatile("" : "+v"(tid_));
    const int tid = tid_, wid = __builtin_amdgcn_readfirstlane(tid >> 6), lane = tid & 63, r32 = lane & 31, hi = lane >> 5;
    const int NT = 4 * qb + 4, R0 = 256 * qb + 32 * wid, myrow = R0 + r32;
    const ldsp V_lds = lds + LDS_V; const ldsp K_lds = lds + LDS_K;
    bf16x8 qr[8];
    { const bf16_t* Qw = Qg + (size_t)R0 * QP; const unsigned qoff = (unsigned)(r32 * QP + hi * 8);
#pragma unroll
      for (int d0 = 0; d0 < 8; ++d0) qr[d0] = ldg8(Qw + (qoff + d0 * 16)); }
    const int sr = tid >> 4, sc = (tid & 15) * 8, kws = KSWZ(sr, sc * 2), vst0 = v_st(sr, sc), vst1 = v_st(32 + sr, sc);
    const unsigned kvoff = (unsigned)(sr * QP + sc);
    const int vb0 = (int)(unsigned)(uintptr_t)V_lds + v_rd_base(lane);
    bf16x8 sk0, sk1, sv0, sv1;
#define SB_LOAD(j) do { const bf16_t* kp_ = Kg + (size_t)(64 * (j)) * QP; const bf16_t* vp_ = Vg + (size_t)(64 * (j)) * QP; \
        sk0 = ldg8(kp_ + kvoff); sk1 = ldg8(kp_ + (size_t)32 * QP + kvoff); sv0 = ldg8(vp_ + kvoff); sv1 = ldg8(vp_ + (size_t)32 * QP + kvoff); } while (0)
#define SB_WRITE(bf) do { *(ALAS bf16x8*)(K_lds + (bf) * SHM_K + kws) = sk0; *(ALAS bf16x8*)(K_lds + (bf) * SHM_K + kws + 32 * 256) = sk1; \
        *(ALAS bf16x8*)(V_lds + (bf) * SHM_V + vst0) = sv0; *(ALAS bf16x8*)(V_lds + (bf) * SHM_V + vst1) = sv1; } while (0)
    SB_LOAD(NT - 1); SB_WRITE(0);
    __syncthreads();
    float carry = 0.f; f32x16 o[4] = {};
    ALAS int* fl = (ALAS int*)(lds + LDS_WS); bool wdone = false;
    for (int t = 0; t < NT; ++t) {
        const int j = NT - 1 - t, buf = t & 1, kb = 64 * j;
        if (t + 1 < NT) SB_LOAD(j - 1);
        if (kb <= R0 + 30 && !wdone) {
            f32x16 p0 = {}, p1 = {};
            { const ldsp Kb = K_lds + buf * SHM_K;
#pragma unroll
              for (int d0 = 0; d0 < 8; ++d0) { const ldsp a = Kb + KSWZ(r32, ((d0 & 3) * 16 + hi * 8) * 2) + (d0 >> 2) * 128;
                  const bf16x8 b0 = *(const ALAS bf16x8*)a, b1 = *(const ALAS bf16x8*)(a + 32 * 256);
                  p0 = __builtin_amdgcn_mfma_f32_32x32x16_bf16(b0, qr[d0], p0, 0, 0, 0);
                  p1 = __builtin_amdgcn_mfma_f32_32x32x16_bf16(b1, qr[d0], p1, 0, 0, 0); } }
            f32x16 lb0, lb1;
#pragma unroll
            for (int r = 0; r < 16; ++r) {
                { const float z = p0[r]; const float e = __builtin_amdgcn_exp2f(-__builtin_fabsf(z)); const float sp = __builtin_fmaxf(z, 0.f) + __builtin_amdgcn_logf(1.f + e); p0[r] = -sp; lb0[r] = z - sp; }
                { const float z = p1[r]; const float e = __builtin_amdgcn_exp2f(-__builtin_fabsf(z)); const float sp = __builtin_fmaxf(z, 0.f) + __builtin_amdgcn_logf(1.f + e); p1[r] = -sp; lb1[r] = z - sp; }
            }
            if (kb + 63 >= R0) {
                const int dq = myrow - kb - 4 * hi; const float NEG = -__builtin_inff();
#pragma unroll
                for (int r = 0; r < 16; ++r) { const int c = (r & 3) + 8 * (r >> 2);
                    if (c >= dq) { p0[r] = 0.f; lb0[r] = NEG; }
                    if (c + 32 >= dq) { p1[r] = 0.f; lb1[r] = NEG; } }
            }
            float gs[8], go[8];
#pragma unroll
            for (int g = 0; g < 4; ++g) { gs[g] = (p0[4 * g] + p0[4 * g + 1]) + (p0[4 * g + 2] + p0[4 * g + 3]); gs[4 + g] = (p1[4 * g] + p1[4 * g + 1]) + (p1[4 * g + 2] + p1[4 * g + 3]); }
#pragma unroll
            for (int i = 0; i < 8; ++i) go[i] = xhalf(gs[i], hi);
            float acc = carry;
#pragma unroll
            for (int idx = 7; idx >= 0; --idx) { const int g = idx & 3; const float base = acc + (hi ? 0.f : go[idx]);
                if (idx >= 4) { const float t3 = base, t2 = t3 + p1[4 * g + 3], t1 = t2 + p1[4 * g + 2], t0 = t1 + p1[4 * g + 1];
                    lb1[4 * g + 3] = __builtin_amdgcn_exp2f(lb1[4 * g + 3] + t3); lb1[4 * g + 2] = __builtin_amdgcn_exp2f(lb1[4 * g + 2] + t2);
                    lb1[4 * g + 1] = __builtin_amdgcn_exp2f(lb1[4 * g + 1] + t1); lb1[4 * g] = __builtin_amdgcn_exp2f(lb1[4 * g] + t0); }
                else { const float t3 = base, t2 = t3 + p0[4 * g + 3], t1 = t2 + p0[4 * g + 2], t0 = t1 + p0[4 * g + 1];
                    lb0[4 * g + 3] = __builtin_amdgcn_exp2f(lb0[4 * g + 3] + t3); lb0[4 * g + 2] = __builtin_amdgcn_exp2f(lb0[4 * g + 2] + t2);
                    lb0[4 * g + 1] = __builtin_amdgcn_exp2f(lb0[4 * g + 1] + t1); lb0[4 * g] = __builtin_amdgcn_exp2f(lb0[4 * g] + t0); }
                acc += gs[idx] + go[idx]; }
            carry = acc;
            bf16x8 pa0, pa1, pa2, pa3;
            ATT_PK4(lb0, 0, pa0); ATT_PK4(lb0, 8, pa1); ATT_PK4(lb1, 0, pa2); ATT_PK4(lb1, 8, pa3);
            SBAR();
            pv_tile(o, vb0 + buf * SHM_V, pa0, pa1, pa2, pa3);
            wdone = __all(carry < -127.f);
        }
        if (lane == 0) fl[buf * 8 + wid] = wdone ? 1 : 0;
        if (t + 1 < NT) SB_WRITE(buf ^ 1);
        __syncthreads();
        { const ALAS int* f = fl + buf * 8; if ((f[0] & f[1] & f[2] & f[3] & f[4] & f[5] & f[6] & f[7]) != 0) break; }
    }
#undef SB_LOAD
#undef SB_WRITE
#if WO_F8
    unsigned char* Ow = (unsigned char*)Og + (size_t)R0 * OBP; const unsigned ooff = (unsigned)(4 * hi * OBP + r32);
#pragma unroll
    for (int r = 0; r < 16; ++r) { unsigned char* rowp = Ow + (size_t)((r & 3) + 8 * (r >> 2)) * OBP;
#pragma unroll
        for (int d0 = 0; d0 < 4; ++d0) { const unsigned w = quad_pack_fp8(o[d0][r] * OB8_SCALE);
            if ((r32 & 3) == 0) *(unsigned*)(rowp + (ooff + d0 * 32)) = w; } }
#else
    bf16_t* Ow = Og + (size_t)R0 * OP; const unsigned ooff = (unsigned)(4 * hi * OP + r32);
#pragma unroll
    for (int r = 0; r < 16; ++r) { bf16_t* rowp = Ow + (size_t)((r & 3) + 8 * (r >> 2)) * OP;
#pragma unroll
        for (int d0 = 0; d0 < 4; ++d0) { const float v = o[d0][r]; const float vn = __shfl_xor(v, 1);
            if ((r32 & 1) == 0) *(unsigned*)(rowp + (ooff + d0 * 32)) = cvtpk(v, vn); } }
#endif
}

constexpr float ATT_THR = 8.f;
__device__ __forceinline__ void qkt64(f32x16& p0, f32x16& p1, ldsp Kb, int r32, int hi, const bf16x8* qr) {
    p0 = f32x16{}; p1 = f32x16{};
#pragma unroll
    for (int d0 = 0; d0 < 4; ++d0) { const ldsp a = Kb + KSWZ64(r32, (d0 * 16 + hi * 8) * 2);
        const bf16x8 b0 = *(const ALAS bf16x8*)a, b1 = *(const ALAS bf16x8*)(a + 32 * 128);
        p0 = __builtin_amdgcn_mfma_f32_32x32x16_bf16(b0, qr[d0], p0, 0, 0, 0);
        p1 = __builtin_amdgcn_mfma_f32_32x32x16_bf16(b1, qr[d0], p1, 0, 0, 0); }
}
__device__ __forceinline__ void partial_sm(f32x16& p0, f32x16& p1, float& m_reg, float& alpha, int hi) {
    float pmax = p0[0];
#pragma unroll
    for (int r = 1; r < 16; ++r) pmax = __builtin_fmaxf(pmax, p0[r]);
#pragma unroll
    for (int r = 0; r < 16; ++r) pmax = __builtin_fmaxf(pmax, p1[r]);
    pmax = __builtin_fmaxf(pmax, xhalf(pmax, hi));
    float mn;
    if (__builtin_expect(__all(pmax - m_reg <= ATT_THR), 1)) { mn = m_reg; alpha = 1.f; }
    else { mn = __builtin_fmaxf(m_reg, pmax); alpha = __builtin_amdgcn_exp2f(m_reg - mn); m_reg = mn; }
#pragma unroll
    for (int r = 0; r < 16; ++r) { p0[r] -= mn; p1[r] -= mn; }
#pragma unroll
    for (int r = 0; r < 16; ++r) p0[r] = __builtin_amdgcn_exp2f(p0[r]);
}
__device__ __forceinline__ void finish_sm(f32x16& p0, f32x16& p1, float alpha, float& l_reg, bf16x8& pa0, bf16x8& pa1, bf16x8& pa2, bf16x8& pa3, int hi) {
#pragma unroll
    for (int r = 0; r < 16; ++r) p1[r] = __builtin_amdgcn_exp2f(p1[r]);
    float ps = 0.f;
#pragma unroll
    for (int r = 0; r < 16; ++r) ps += p0[r];
#pragma unroll
    for (int r = 0; r < 16; ++r) ps += p1[r];
    ps += xhalf(ps, hi);
    l_reg = l_reg * alpha + ps;
    ATT_PK4(p0, 0, pa0); ATT_PK4(p0, 8, pa1); ATT_PK4(p1, 0, pa2); ATT_PK4(p1, 8, pa3);
}
__device__ __forceinline__ void mask_gt(f32x16& p0, f32x16& p1, int dq) {
    const float NEG = -__builtin_inff();
#pragma unroll
    for (int r = 0; r < 16; ++r) { const int c = (r & 3) + 8 * (r >> 2);
        if (c > dq) p0[r] = NEG;
        if (c + 32 > dq) p1[r] = NEG; }
}
template <bool SECOND>
__device__ __forceinline__ void diff_pass(const bf16_t* __restrict__ Qg, const bf16_t* __restrict__ Kg, const bf16_t* __restrict__ Vg, float* S1, bf16_t* __restrict__ Og,
                                          int qb, float lam, const float* __restrict__ gsub, float gmul, ldsp lds, int wave_) {
    int tid_ = tid_from_wave(wave_); asm volatile("" : "+v"(tid_));
    const int tid = tid_, wid = __builtin_amdgcn_readfirstlane(tid >> 6), lane = tid & 63, r32 = lane & 31, hi = lane >> 5;
    const int NT = 4 * qb + 4, R0 = 256 * qb + 32 * wid, myrow = R0 + r32;
    const ldsp V_lds = lds + LDS_V; const ldsp K_lds = lds + LDS_K;
    ALAS float* wsf = (ALAS float*)(lds + LDS_WS) + wid * 64; ALAS float* li_l = wsf; ALAS float* al_l = wsf + 32;
    bf16x8 qr[4];
    { const bf16_t* Qw = Qg + (size_t)R0 * QP; const unsigned qoff = (unsigned)(r32 * QP + hi * 8);
#pragma unroll
      for (int d0 = 0; d0 < 4; ++d0) qr[d0] = ldg8(Qw + (qoff + d0 * 16)); }
    const int sr = tid >> 4, sc = (tid & 15) * 8, vst0 = v_st(sr, sc), vst1 = v_st(32 + sr, sc);
    const int kr = tid >> 3, kc = (tid & 7) * 8, kws = KSWZ64(kr, kc * 2);
    const unsigned voff = (unsigned)(sr * QP + sc), koff = (unsigned)(kr * QP + kc);
    const int vb0 = (int)(unsigned)(uintptr_t)V_lds + v_rd_base(lane);
    const int qm = myrow - 4 * hi;
    bf16x8 sk0A, sv0A, sv1A, sk0B, sv0B, sv1B;
#define DF_LOAD(S_, j) do { const bf16_t* vp_ = Vg + (size_t)(64 * (j)) * QP; sk0##S_ = ldg8(Kg + (size_t)(64 * (j)) * QP + koff); sv0##S_ = ldg8(vp_ + voff); sv1##S_ = ldg8(vp_ + (size_t)32 * QP + voff); } while (0)
#define DF_WRITE(S_, bf) do { *(ALAS bf16x8*)(K_lds + (bf) * SHM_K + kws) = sk0##S_; *(ALAS bf16x8*)(V_lds + (bf) * SHM_V + vst0) = sv0##S_; *(ALAS bf16x8*)(V_lds + (bf) * SHM_V + vst1) = sv1##S_; } while (0)
#define DF_MASK(P0, P1, t) do { if (64 * (t) + 63 > R0) mask_gt(P0, P1, qm - 64 * (t)); } while (0)
#define DF_RESC(a) do { if (__any((a) < 1.f)) { if (hi == 0) al_l[r32] = (a); asm volatile("s_waitcnt lgkmcnt(0)" ::: "memory"); \
        _Pragma("unroll") for (int d_ = 0; d_ < 4; ++d_) _Pragma("unroll") for (int r = 0; r < 16; ++r) o[d_][r] *= al_l[crow(r, hi)]; } } while (0)
    float m_reg = -1e30f, l_reg = 0.f; f32x16 o[4] = {};
    f32x16 pA0, pA1, pB0, pB1; float alA = 1.f, alB = 1.f; bf16x8 pa0, pa1, pa2, pa3;
    DF_LOAD(A, 0); DF_WRITE(A, 0);
    __syncthreads();
    DF_LOAD(A, 1); DF_LOAD(B, 2);
    qkt64(pA0, pA1, K_lds, r32, hi, qr); DF_MASK(pA0, pA1, 0); partial_sm(pA0, pA1, m_reg, alA, hi);
    DF_WRITE(A, 1);
    DF_RESC(alA);
    __syncthreads();
#define DF_HALF(PX0, PX1, alX, PY0, PY1, alY, t, KB, VB, SB, LS, WS) do { \
        SBAR(); qkt64(PX0, PX1, K_lds + (KB) * SHM_K, r32, hi, qr); \
        finish_sm(PY0, PY1, alY, l_reg, pa0, pa1, pa2, pa3, hi); SBAR(); \
        if ((t) + 2 < NT) { DF_LOAD(LS, (t) + 2); SBAR(); } \
        pv_tile(o, vb0 + (VB) * SHM_V, pa0, pa1, pa2, pa3); DF_MASK(PX0, PX1, (t)); partial_sm(PX0, PX1, m_reg, alX, hi); \
        __syncthreads(); \
        if ((t) + 1 < NT) DF_WRITE(WS, SB); \
        DF_RESC(alX); __syncthreads(); } while (0)
    for (int t = 1; t + 1 < NT; t += 2) {
        DF_HALF(pB0, pB1, alB, pA0, pA1, alA, t, 1, 0, 0, A, B);
        DF_HALF(pA0, pA1, alA, pB0, pB1, alB, t + 1, 0, 1, 1, B, A);
    }
    DF_HALF(pB0, pB1, alB, pA0, pA1, alA, NT - 1, 1, 0, 0, A, B);
    finish_sm(pB0, pB1, alB, l_reg, pa0, pa1, pa2, pa3, hi); SBAR();
    pv_tile(o, vb0 + 1 * SHM_V, pa0, pa1, pa2, pa3);
#undef DF_LOAD
#undef DF_WRITE
#undef DF_MASK
#undef DF_RESC
#undef DF_HALF
    if (hi == 0) li_l[r32] = l_reg; asm volatile("s_waitcnt lgkmcnt(0)" ::: "memory");
    float rli[16];
#pragma unroll
    for (int r = 0; r < 16; ++r) rli[r] = __builtin_amdgcn_rcpf(li_l[crow(r, hi)]);
    if constexpr (!SECOND) {
        float* Sw = S1 + (size_t)R0 * OP; const unsigned ooff = (unsigned)(4 * hi * OP + r32);
#pragma unroll
        for (int r = 0; r < 16; ++r) { float* rowp = Sw + (size_t)((r & 3) + 8 * (r >> 2)) * OP;
#pragma unroll
            for (int d0 = 0; d0 < 4; ++d0) rowp[ooff + d0 * 32] = o[d0][r] * rli[r]; }
    } else {
        const float* Sw = S1 + (size_t)R0 * OP; bf16_t* Ow = Og + (size_t)R0 * OP; (void)Ow; const unsigned ooff = (unsigned)(4 * hi * OP + r32), ooff8 = (unsigned)(4 * hi * OBP + r32);
        float gn[4];
#pragma unroll
        for (int d0 = 0; d0 < 4; ++d0) gn[d0] = gsub[d0 * 32 + r32] * gmul;
#pragma unroll
        for (int r = 0; r < 16; ++r) { const float* srow = Sw + (size_t)((r & 3) + 8 * (r >> 2)) * OP; float d[4]; float ss = 0.f;
#if WO_F8
            unsigned char* orowp = (unsigned char*)Og + (size_t)(R0 + (r & 3) + 8 * (r >> 2)) * OBP;
#else
            bf16_t* orowp = Ow + (size_t)((r & 3) + 8 * (r >> 2)) * OP;
#endif
#pragma unroll
            for (int d0 = 0; d0 < 4; ++d0) { d[d0] = srow[ooff + d0 * 32] - lam * (o[d0][r] * rli[r]); ss += d[d0] * d[d0]; }
            ss += __builtin_bit_cast(float, __builtin_amdgcn_update_dpp(0, __builtin_bit_cast(int, ss), 0xB1, 0xf, 0xf, true));
            ss += __builtin_bit_cast(float, __builtin_amdgcn_update_dpp(0, __builtin_bit_cast(int, ss), 0x4E, 0xf, 0xf, true));
            ss += __builtin_bit_cast(float, __builtin_amdgcn_update_dpp(0, __builtin_bit_cast(int, ss), 0x141, 0xf, 0xf, true));
            ss += __builtin_bit_cast(float, __builtin_amdgcn_update_dpp(0, __builtin_bit_cast(int, ss), 0x140, 0xf, 0xf, true));
            { auto rr = __builtin_amdgcn_permlane16_swap(__float_as_uint(ss), __float_as_uint(ss), false, false); ss = __uint_as_float(rr[0]) + __uint_as_float(rr[1]); }
            const float rs = __builtin_amdgcn_rsqf(ss * (1.f / 128.f) + 1e-5f);
#pragma unroll
#if WO_F8
            for (int d0 = 0; d0 < 4; ++d0) { const unsigned w = quad_pack_fp8(d[d0] * rs * gn[d0] * OB8_SCALE);
                if ((r32 & 3) == 0) *(unsigned*)(orowp + (ooff8 + d0 * 32)) = w; }
#else
            for (int d0 = 0; d0 < 4; ++d0) { const float v = d[d0] * rs * gn[d0]; const float vn = __shfl_xor(v, 1);
                if ((r32 & 1) == 0) *(unsigned*)(orowp + (ooff + d0 * 32)) = cvtpk(v, vn); }
#endif
            if ((r & 1) == 1) asm volatile("" ::: "memory"); }
    }
    __syncthreads();
}

#ifndef D2_NEGM
#define D2_NEGM 1
#endif
constexpr int D2_SLK = 8192, D2_SLV = 16384, D2_K = 0, D2_V = 3 * D2_SLK, D2_WS = D2_V + 3 * D2_SLV, D2_S1 = D2_WS + 8 * 256, D2_LDS_BYTES = D2_S1 + 8 * 8192;
typedef __attribute__((address_space(3))) const char* lds_cptr;
typedef short v4i16_t __attribute__((ext_vector_type(4)));
typedef float f32x2_t __attribute__((ext_vector_type(2))); typedef __bf16 bf16x2_t __attribute__((ext_vector_type(2)));
__device__ __forceinline__ unsigned cvtpk_s(float lo, float hi) { const f32x2_t v = {lo, hi}; const bf16x2_t b = __builtin_convertvector(v, bf16x2_t); return __builtin_bit_cast(unsigned, b); }
__device__ __forceinline__ s16x4 vtr(lds_cptr p) { return __builtin_bit_cast(s16x4, __builtin_amdgcn_ds_read_tr16_b64_v4i16((__attribute__((address_space(3))) v4i16_t*)p)); }
__device__ __forceinline__ void kload2(bf16x8* kf, lds_cptr kp, int j) { kf[2 * j] = *(const ALAS bf16x8*)(kp + j * 2048); kf[2 * j + 1] = *(const ALAS bf16x8*)(kp + j * 2048 + 512); }
__device__ __forceinline__ void glds16s(unsigned voff, const void* gbase, unsigned ldsdst) { unsigned keep;
    asm volatile("s_mov_b32 %0, m0\n\ts_mov_b32 m0, %3\n\ts_nop 0\n\tglobal_load_lds_dwordx4 %1, %2\n\ts_mov_b32 m0, %0" : "=&s"(keep) : "v"(voff), "s"(gbase), "s"(ldsdst) : "memory"); }
typedef _Float16 d2_h2 __attribute__((ext_vector_type(2)));
__device__ __forceinline__ unsigned d2_pkh(float a, float b) { const f32x2_t v = {a, b}; return __builtin_bit_cast(unsigned, __builtin_convertvector(v, d2_h2)); }
__device__ __forceinline__ f32x2_t d2_unh(unsigned w) { return __builtin_convertvector(__builtin_bit_cast(d2_h2, w), f32x2_t); }
#define D2_MX3(a, b, c) __builtin_fmaxf(__builtin_fmaxf((a), (b)), (c))
__device__ __forceinline__ float rowmax2(const f32x16& p0, const f32x16& p1) {
    float a = D2_MX3(p0[0], p0[1], p1[0]), b = D2_MX3(p0[2], p0[3], p1[1]); a = D2_MX3(a, p1[2], p1[3]);
#pragma unroll
    for (int r = 4; r < 16; r += 4) { a = D2_MX3(a, p0[r], p0[r + 1]); b = D2_MX3(b, p0[r + 2], p0[r + 3]); a = D2_MX3(a, p1[r], p1[r + 1]); b = D2_MX3(b, p1[r + 2], p1[r + 3]); }
    const float m = __builtin_fmaxf(a, b); auto rr = __builtin_amdgcn_permlane32_swap(__float_as_uint(m), __float_as_uint(m), false, false);
    return __builtin_fmaxf(__uint_as_float(rr[0]), __uint_as_float(rr[1])); }
__device__ __forceinline__ void cmask2(f32x16& p0, f32x16& p1, int jb, int qrel, int hi) {
    const int kb = 64 * jb + 4 * hi; const float NEG = -__builtin_inff();
#pragma unroll
    for (int r = 0; r < 16; ++r) { const int kv = kb + (r & 3) + 8 * (r >> 2); if (kv > qrel) p0[r] = NEG; if (kv + 32 > qrel) p1[r] = NEG; } }
#define D2_WAIT_BAR(N) asm volatile("s_waitcnt vmcnt(" #N ") lgkmcnt(0)\n\ts_barrier" ::: "memory")
#define D2_PIN(x) asm volatile("" : "+v"(x))
#define D2_MF(a, b, c) __builtin_amdgcn_mfma_f32_32x32x16_bf16(a, b, c, 0, 0, 0)

template <bool SECOND>
__device__ __forceinline__ void diff_pass2(const bf16_t* __restrict__ Qg, const bf16_t* __restrict__ Kg, const bf16_t* __restrict__ Vg, float* S1, bf16_t* __restrict__ Og,
                                           int qb, float lam, const float* __restrict__ gsub, float gmul, ldsp lds, int wave_) {
    int tid_ = tid_from_wave(wave_); asm volatile("" : "+v"(tid_));
    const int tid = tid_, wid = __builtin_amdgcn_readfirstlane(tid >> 6), lane = tid & 63, r32 = lane & 31, hi = lane >> 5;
    const int NT = 4 * qb + 4, R0 = 256 * qb + 32 * wid;
    const unsigned lds0 = (unsigned)(uintptr_t)lds;
    ALAS float* wsf = (ALAS float*)(lds + D2_WS) + wid * 64;
    const unsigned kvo = (unsigned)(lane * QP + wid * 8) * 2u;
    const unsigned vvo = (unsigned)((16 * (wid & 3) + (lane >> 2)) * QP + (wid >> 2) * 32 + (lane & 3) * 8) * 2u;
    const unsigned kdst = lds0 + D2_K + wid * 1024, vdst = lds0 + D2_V + wid * 1024;
#define D2_DMA_K(t, slot) glds16s(kvo, Kg + (size_t)(t) * 64 * QP, (unsigned)__builtin_amdgcn_readfirstlane(kdst + (slot)))
#define D2_DMA_V(t, slot) do { glds16s(vvo, Vg + (size_t)(t) * 64 * QP, (unsigned)__builtin_amdgcn_readfirstlane(vdst + 2 * (slot))); \
                               glds16s(vvo, Vg + (size_t)(t) * 64 * QP + 64, (unsigned)__builtin_amdgcn_readfirstlane(vdst + 2 * (slot) + 8192)); } while (0)
    const lds_cptr kp0 = (lds_cptr)lds + D2_K + hi * 1024 + r32 * 16;
    const lds_cptr vp0 = (lds_cptr)lds + D2_V + ((lane >> 4) & 1) * 32 + (lane & 3) * 8 + (4 * hi + ((lane & 15) >> 2)) * 64;
    D2_DMA_K(0, 0); D2_DMA_V(0, 0); D2_DMA_K(1, D2_SLK);
    bf16x8 qr[4];
    { const bf16_t* Qw = Qg + (size_t)R0 * QP; const unsigned qoff = (unsigned)(r32 * QP + hi * 8);
#pragma unroll
      for (int d0 = 0; d0 < 4; ++d0) qr[d0] = ldg8(Qw + (qoff + d0 * 16)); }
    D2_DMA_K(2, 2 * D2_SLK);
    float mhat = 0.f, l_reg = 0.f; f32x16 o[4] = {};
    const int qrel = 32 * wid + r32; bool resc = false;
    f32x16 pA0, pA1, pB0, pB1; bf16x8 kf[8]; s16x4 vlo[4], vhi[4]; u32x4 pw0, pw1, pw2, pw3;
#if D2_NEGM
    f32x16 negm;
#endif
    int sl_prev = 0, sl_cur = 0, sl_next = D2_SLK;
#define D2_ROT() do { sl_prev = sl_cur; sl_cur = sl_next; sl_next = (sl_next == 2 * D2_SLK) ? 0 : sl_next + D2_SLK; } while (0)
#if D2_NEGM
#define D2_EX(v) __builtin_amdgcn_exp2f(v)
#define D2_C0 negm
#else
#define D2_EX(v) __builtin_amdgcn_exp2f((v) - mhat)
#define D2_C0 D2_Z16
#endif
#define D2_RESC() do { if (resc) { _Pragma("unroll") for (int d_ = 0; d_ < 4; ++d_) _Pragma("unroll") for (int r = 0; r < 16; ++r) o[d_][r] *= wsf[crow(r, hi)]; } } while (0)
#define D2_Z16 (f32x16){}
#if D2_NEGM
#define D2_RM(C0, C1) rowmax2(C0, C1)
#define D2_MOVE(C0, C1, dl) do { _Pragma("unroll") for (int r = 0; r < 16; ++r) { C0[r] -= dl; C1[r] -= dl; } _Pragma("unroll") for (int r = 0; r < 16; ++r) negm[r] = -mhat; D2_PIN(negm); } while (0)
#else
#define D2_RM(C0, C1) (rowmax2(C0, C1) - mhat)
#define D2_MOVE(C0, C1, dl) do { } while (0)
#endif
    D2_WAIT_BAR(4);
#pragma unroll
    for (int d0 = 0; d0 < 4; ++d0) kload2(kf, kp0, d0);
    pA0 = D2_MF(kf[0], qr[0], D2_Z16); pA1 = D2_MF(kf[1], qr[0], D2_Z16); pA0 = D2_MF(kf[2], qr[1], pA0); pA1 = D2_MF(kf[3], qr[1], pA1);
    pA0 = D2_MF(kf[4], qr[2], pA0); pA1 = D2_MF(kf[5], qr[2], pA1); pA0 = D2_MF(kf[6], qr[3], pA0); pA1 = D2_MF(kf[7], qr[3], pA1);
    if (NT == 4) cmask2(pA0, pA1, 0, qrel, hi);
    { mhat = rowmax2(pA0, pA1);
#pragma unroll
      for (int r = 0; r < 16; ++r) { pA0[r] = __builtin_amdgcn_exp2f(pA0[r] - mhat); pA1[r] = __builtin_amdgcn_exp2f(pA1[r] - mhat); }
#if D2_NEGM
#pragma unroll
      for (int r = 0; r < 16; ++r) negm[r] = -mhat;
      D2_PIN(negm);
#endif
    }
    D2_WAIT_BAR(0);
    D2_DMA_K(3, 0); D2_DMA_V(1, D2_SLK); D2_ROT();
#pragma unroll
    for (int d0 = 0; d0 < 4; ++d0) kload2(kf, kp0 + sl_cur, d0);
    D2_WAIT_BAR(3);
#define D2_PKW(P, i) cvtpk_s(P[i], P[(i) + 1])
#define D2_PAF(k) __builtin_bit_cast(bf16x8, pw##k)
#define D2_VFR(i) (bf16x8){vlo[i][0], vlo[i][1], vlo[i][2], vlo[i][3], vhi[i][0], vhi[i][1], vhi[i][2], vhi[i][3]}
#define D2_VRD(s, i) do { vlo[s] = vtr(vp_ + ((((i) & 3) * 4096) + (((i) >> 2) * 1024))); vhi[s] = vtr(vp_ + ((((i) & 3) * 4096) + (((i) >> 2) * 1024) + 512)); } while (0)
#define D2_KRD(G, d0) do { if (G) { kload2(kf, kp0 + sl_next, d0); SBAR(); } } while (0)
#define D2_GAPA(MF_, a0, a1, a2, a3, W0, W1, PW) do { MF_; sacc += a0; sacc += a1; sacc += a2; sacc += a3; D2_PIN(sacc); W0; W1; D2_PIN(PW); SBAR(); } while (0)
#define D2_GAPB(j, K_, X, e) do { o[(j) & 3] = D2_MF(D2_PAF(K_), D2_VFR((j) & 3), o[(j) & 3]); X[e] = D2_EX(X[e]); X[(e) + 1] = D2_EX(X[(e) + 1]); D2_PIN(X); SBAR(); } while (0)
#define D2_STEP(C0, C1, P0, P1, t, MASK, GK, GV, GL) do { SBAR(); \
    const lds_cptr vp_ = vp0 + 2 * sl_prev; \
    float sacc = P0[0] + P0[1]; \
                          D2_GAPA(C0 = D2_MF(kf[0], qr[0], D2_C0),  P0[2], P0[3], P0[4], P0[5],     pw0[0] = D2_PKW(P0, 0),  pw0[1] = D2_PKW(P0, 2),  pw0); \
                          D2_GAPA(C1 = D2_MF(kf[1], qr[0], D2_C0),  P0[6], P0[7], P0[8], P0[9],     pw0[2] = D2_PKW(P0, 4),  pw0[3] = D2_PKW(P0, 6),  pw0); \
                          D2_GAPA(C0 = D2_MF(kf[2], qr[1], C0),     P0[10], P0[11], P0[12], P0[13], pw1[0] = D2_PKW(P0, 8),  pw1[1] = D2_PKW(P0, 10), pw1); \
                          D2_GAPA(C1 = D2_MF(kf[3], qr[1], C1),     P0[14], P0[15], P1[0], P1[1],   pw1[2] = D2_PKW(P0, 12), pw1[3] = D2_PKW(P0, 14), pw1); \
    D2_VRD(0, 0); SBAR(); D2_GAPA(C0 = D2_MF(kf[4], qr[2], C0),     P1[2], P1[3], P1[4], P1[5],     pw2[0] = D2_PKW(P1, 0),  pw2[1] = D2_PKW(P1, 2),  pw2); \
    D2_VRD(1, 1); SBAR(); D2_GAPA(C1 = D2_MF(kf[5], qr[2], C1),     P1[6], P1[7], P1[8], P1[9],     pw2[2] = D2_PKW(P1, 4),  pw2[3] = D2_PKW(P1, 6),  pw2); \
    D2_VRD(2, 2); SBAR(); D2_GAPA(C0 = D2_MF(kf[6], qr[3], C0),     P1[10], P1[11], P1[12], P1[13], pw3[0] = D2_PKW(P1, 8),  pw3[1] = D2_PKW(P1, 10), pw3); \
    D2_VRD(3, 3); SBAR(); D2_GAPA(C1 = D2_MF(kf[7], qr[3], C1),     P1[14], P1[15], 0.f, 0.f,       pw3[2] = D2_PKW(P1, 12), pw3[3] = D2_PKW(P1, 14), pw3); \
    l_reg += sacc; \
    if (GK) D2_DMA_K((t) + 3, sl_cur); if (GV) D2_DMA_V((t) + 1, sl_next);                                                  \
    if (MASK) cmask2(C0, C1, (t) - (NT - 4), qrel, hi); \
    { const float rm = D2_RM(C0, C1); resc = false;                                                                          \
      if (__builtin_expect(__any(rm > ATT_THR), 0)) { const float dl = __builtin_fmaxf(rm, 0.f); mhat += dl;                \
          D2_MOVE(C0, C1, dl); \
          const float f = __builtin_amdgcn_exp2f(-dl); l_reg *= f; if (hi == 0) wsf[r32] = f; resc = true; } } \
    SBAR(); \
    D2_GAPB(0, 0, C0, 0);   D2_VRD(0, 4);  SBAR(); D2_GAPB(1, 0, C0, 2);   D2_VRD(1, 5);  SBAR(); D2_GAPB(2, 0, C0, 4);   D2_VRD(2, 6);  SBAR(); D2_GAPB(3, 0, C0, 6);   D2_VRD(3, 7);  SBAR(); \
    D2_GAPB(4, 1, C0, 8);   D2_VRD(0, 8);  SBAR(); D2_GAPB(5, 1, C0, 10);  D2_VRD(1, 9);  SBAR(); D2_GAPB(6, 1, C0, 12);  D2_VRD(2, 10); SBAR(); D2_GAPB(7, 1, C0, 14);  D2_VRD(3, 11); SBAR(); \
    D2_GAPB(8, 2, C1, 0);   D2_VRD(0, 12); SBAR(); D2_GAPB(9, 2, C1, 2);   D2_VRD(1, 13); SBAR(); D2_GAPB(10, 2, C1, 4);  D2_VRD(2, 14); SBAR(); D2_GAPB(11, 2, C1, 6);  D2_VRD(3, 15); SBAR(); \
    D2_KRD(GL, 0); D2_GAPB(12, 3, C1, 8);  D2_KRD(GL, 1); D2_GAPB(13, 3, C1, 10); D2_KRD(GL, 2); D2_GAPB(14, 3, C1, 12); D2_KRD(GL, 3); D2_GAPB(15, 3, C1, 14); \
    } while (0)
    int t = 1;
    for (; t + 5 < NT; t += 2) {
        D2_STEP(pB0, pB1, pA0, pA1, t, false, true, true, true);     D2_WAIT_BAR(3); D2_RESC(); D2_ROT();
        D2_STEP(pA0, pA1, pB0, pB1, t + 1, false, true, true, true); D2_WAIT_BAR(3); D2_RESC(); D2_ROT();
    }
#define D2_ENDW(tt) do { if ((tt) + 3 < NT) { D2_WAIT_BAR(3); } else if ((tt) + 2 < NT) { D2_WAIT_BAR(2); } else { D2_WAIT_BAR(0); } } while (0)
    for (; t + 1 < NT; t += 2) {
        D2_STEP(pB0, pB1, pA0, pA1, t, true, (t + 3 < NT), (t + 1 < NT), (t + 1 < NT));         D2_ENDW(t);     D2_RESC(); D2_ROT();
        D2_STEP(pA0, pA1, pB0, pB1, t + 1, true, (t + 4 < NT), (t + 2 < NT), (t + 2 < NT));     D2_ENDW(t + 1); D2_RESC(); D2_ROT();
    }
    D2_STEP(pB0, pB1, pA0, pA1, NT - 1, true, false, false, false); D2_RESC();
    { float sacc = pB0[0] + pB0[1];
#pragma unroll
      for (int r = 2; r < 16; ++r) sacc += pB0[r];
#pragma unroll
      for (int r = 0; r < 16; ++r) sacc += pB1[r];
      l_reg += sacc;
      pw0 = (u32x4){D2_PKW(pB0, 0), D2_PKW(pB0, 2), D2_PKW(pB0, 4), D2_PKW(pB0, 6)}; pw1 = (u32x4){D2_PKW(pB0, 8), D2_PKW(pB0, 10), D2_PKW(pB0, 12), D2_PKW(pB0, 14)};
      pw2 = (u32x4){D2_PKW(pB1, 0), D2_PKW(pB1, 2), D2_PKW(pB1, 4), D2_PKW(pB1, 6)}; pw3 = (u32x4){D2_PKW(pB1, 8), D2_PKW(pB1, 10), D2_PKW(pB1, 12), D2_PKW(pB1, 14)};
      const lds_cptr vp_ = vp0 + 2 * sl_cur; SBAR();
#pragma unroll
      for (int i = 0; i < 4; ++i) D2_VRD(i, i);
      o[0] = D2_MF(D2_PAF(0), D2_VFR(0), o[0]); o[1] = D2_MF(D2_PAF(0), D2_VFR(1), o[1]); o[2] = D2_MF(D2_PAF(0), D2_VFR(2), o[2]); o[3] = D2_MF(D2_PAF(0), D2_VFR(3), o[3]); SBAR();
#pragma unroll
      for (int i = 0; i < 4; ++i) D2_VRD(i, i + 4);
      o[0] = D2_MF(D2_PAF(1), D2_VFR(0), o[0]); o[1] = D2_MF(D2_PAF(1), D2_VFR(1), o[1]); o[2] = D2_MF(D2_PAF(1), D2_VFR(2), o[2]); o[3] = D2_MF(D2_PAF(1), D2_VFR(3), o[3]); SBAR();
#pragma unroll
      for (int i = 0; i < 4; ++i) D2_VRD(i, i + 8);
      o[0] = D2_MF(D2_PAF(2), D2_VFR(0), o[0]); o[1] = D2_MF(D2_PAF(2), D2_VFR(1), o[1]); o[2] = D2_MF(D2_PAF(2), D2_VFR(2), o[2]); o[3] = D2_MF(D2_PAF(2), D2_VFR(3), o[3]); SBAR();
#pragma unroll
      for (int i = 0; i < 4; ++i) D2_VRD(i, i + 12);
      o[0] = D2_MF(D2_PAF(3), D2_VFR(0), o[0]); o[1] = D2_MF(D2_PAF(3), D2_VFR(1), o[1]); o[2] = D2_MF(D2_PAF(3), D2_VFR(2), o[2]); o[3] = D2_MF(D2_PAF(3), D2_VFR(3), o[3]); }
#undef D2_DMA_K
#undef D2_DMA_V
#undef D2_ROT
#undef D2_EX
#undef D2_C0
#undef D2_RM
#undef D2_MOVE
#undef D2_RESC
#undef D2_PKW
#undef D2_PAF
#undef D2_VFR
#undef D2_VRD
#undef D2_KRD
#undef D2_ENDW
#undef D2_GAPA
#undef D2_GAPB
#undef D2_STEP
    { auto rr = __builtin_amdgcn_permlane32_swap(__float_as_uint(l_reg), __float_as_uint(l_reg), false, false); l_reg = __uint_as_float(rr[0]) + __uint_as_float(rr[1]); }
    ALAS float* li_l = wsf + 32;
    if (hi == 0) li_l[r32] = l_reg; asm volatile("s_waitcnt lgkmcnt(0)" ::: "memory");
    float rli[16];
#pragma unroll
    for (int r = 0; r < 16; ++r) rli[r] = __builtin_amdgcn_rcpf(li_l[crow(r, hi)]);
    ldsp s1l = lds + D2_S1 + wid * 8192 + lane * 16;
    if constexpr (!SECOND) {
#pragma unroll
        for (int r = 0; r < 16; r += 2) { u32x4 w; w.x = d2_pkh(o[0][r] * rli[r], o[1][r] * rli[r]); w.y = d2_pkh(o[2][r] * rli[r], o[3][r] * rli[r]);
            w.z = d2_pkh(o[0][r + 1] * rli[r + 1], o[1][r + 1] * rli[r + 1]); w.w = d2_pkh(o[2][r + 1] * rli[r + 1], o[3][r + 1] * rli[r + 1]);
            *(ALAS u32x4*)(s1l + (r >> 1) * 1024) = w; }
    } else {
        const unsigned ooff8 = (unsigned)(4 * hi * OBP + r32);
        float gn[4];
#pragma unroll
        for (int d0 = 0; d0 < 4; ++d0) gn[d0] = gsub[d0 * 32 + r32] * gmul;
#pragma unroll
        for (int r = 0; r < 16; ++r) { float d[4]; float ss = 0.f;
            unsigned char* orowp = (unsigned char*)Og + (size_t)(R0 + (r & 3) + 8 * (r >> 2)) * OBP;
            { const u32x4 w = *(const ALAS u32x4*)(s1l + (r >> 1) * 1024); const f32x2_t s01 = d2_unh((r & 1) ? w.z : w.x), s23 = d2_unh((r & 1) ? w.w : w.y);
              d[0] = s01[0] - lam * (o[0][r] * rli[r]); d[1] = s01[1] - lam * (o[1][r] * rli[r]); d[2] = s23[0] - lam * (o[2][r] * rli[r]); d[3] = s23[1] - lam * (o[3][r] * rli[r]); }
#pragma unroll
            for (int d0 = 0; d0 < 4; ++d0) ss += d[d0] * d[d0];
            ss += __builtin_bit_cast(float, __builtin_amdgcn_update_dpp(0, __builtin_bit_cast(int, ss), 0xB1, 0xf, 0xf, true));
            ss += __builtin_bit_cast(float, __builtin_amdgcn_update_dpp(0, __builtin_bit_cast(int, ss), 0x4E, 0xf, 0xf, true));
            ss += __builtin_bit_cast(float, __builtin_amdgcn_update_dpp(0, __builtin_bit_cast(int, ss), 0x141, 0xf, 0xf, true));
            ss += __builtin_bit_cast(float, __builtin_amdgcn_update_dpp(0, __builtin_bit_cast(int, ss), 0x140, 0xf, 0xf, true));
            { auto rr = __builtin_amdgcn_permlane16_swap(__float_as_uint(ss), __float_as_uint(ss), false, false); ss = __uint_as_float(rr[0]) + __uint_as_float(rr[1]); }
            const float rs = __builtin_amdgcn_rsqf(ss * (1.f / 128.f) + 1e-5f);
#pragma unroll
            for (int d0 = 0; d0 < 4; ++d0) { const unsigned w = quad_pack_fp8(d[d0] * rs * gn[d0] * OB8_SCALE);
                if ((r32 & 3) == 0) *(unsigned*)(orowp + (ooff8 + d0 * 32)) = w; }
            if ((r & 1) == 1) asm volatile("" ::: "memory"); }
    }
    asm volatile("s_waitcnt lgkmcnt(0)\n\ts_barrier" ::: "memory");
}
#undef D2_WAIT_BAR
#undef D2_PIN
#undef D2_MF
#undef D2_MX3
#undef D2_Z16
#undef SBAR
}

#define LAS __attribute__((address_space(3)))

#define XB_TMO      128
#define XB_XCNT(j)  (256  + 64 * (j))
#define XB_XSUB(j)  (1280 + 64 * (j))
#define XB_XGEN(j)  (2304 + 64 * (j))
#define XB_TOP      3328
#define XB_TOPGEN   3392
#define XCD_BAR_WORDS 3456
#define XB_SPIN_CAP (1u << 18)

__device__ __forceinline__ unsigned xb_ld(unsigned* p)              { return __hip_atomic_load(p, __ATOMIC_RELAXED, __HIP_MEMORY_SCOPE_AGENT); }
__device__ __forceinline__ unsigned xb_add(unsigned* p, unsigned v) { return __hip_atomic_fetch_add(p, v, __ATOMIC_RELAXED, __HIP_MEMORY_SCOPE_AGENT); }
__device__ __forceinline__ unsigned xb_xcc_id() { return (unsigned)__builtin_amdgcn_s_getreg((3 << 11) | 20) & 0xFu; }
#define XB_SPIN(cond, bar) do { unsigned _sp = 0; while (cond) { __builtin_amdgcn_s_sleep(1); \
    if ((++_sp & 255u) == 0u) { if (xb_ld(&(bar)[XB_TMO])) break; if (_sp > XB_SPIN_CAP) { atomicAdd(&(bar)[XB_TMO], 1u); break; } } } } while (0)

struct XcdBarrier {
    unsigned* bar; unsigned x;
    volatile LAS unsigned* st;
};

__device__ __forceinline__ XcdBarrier xcd_barrier_post(unsigned* bar, volatile LAS unsigned* st, bool thread0) {
    XcdBarrier b; b.bar = bar; b.x = xb_xcc_id(); b.st = st;
    if (thread0) (void)xb_add(&bar[XB_XCNT(b.x)], 1u);
    return b;
}
__device__ __forceinline__ void xcd_barrier_complete(unsigned* bar, unsigned x, unsigned& nloc, unsigned& nx) {
    const unsigned G = gridDim.x * gridDim.y * gridDim.z;
    unsigned sum, cnt, mine, sp = 0u;
    for (;;) {
        sum = 0u; cnt = 0u; mine = 0u;
#pragma unroll
        for (unsigned j = 0; j < 16; ++j) { const unsigned c = xb_ld(&bar[XB_XCNT(j)]); sum += c; cnt += (c > 0u) ? 1u : 0u; mine = (j == x) ? c : mine; }
        if (sum == G) break;
        __builtin_amdgcn_s_sleep(1);
        if ((++sp & 255u) == 0u) { if (xb_ld(&bar[XB_TMO])) break; if (sp > XB_SPIN_CAP) { atomicAdd(&bar[XB_TMO], 1u); break; } }
    }
    nloc = mine > 0u ? mine : 1u; nx = cnt > 0u ? cnt : 1u;
}

__device__ __forceinline__ void xcd_barrier(const XcdBarrier& b, bool thread0) {
    asm volatile("s_waitcnt vmcnt(0)" ::: "memory");
    __syncthreads();
    if (thread0) {
        unsigned* bar = b.bar;
        __builtin_amdgcn_s_waitcnt(0);
        unsigned nloc = b.st[0], nx = b.st[1];
        if (nloc == 0u) { xcd_barrier_complete(bar, b.x, nloc, nx); b.st[0] = nloc; b.st[1] = nx; }
        const unsigned old = xb_add(&bar[XB_XSUB(b.x)], 1u);
        const unsigned gen = old / nloc;
        if (old + 1u == (gen + 1u) * nloc) {
            __builtin_amdgcn_fence(__ATOMIC_RELEASE, "agent");
            asm volatile("s_waitcnt vmcnt(0)" ::: "memory");
            const unsigned og = xb_add(&bar[XB_TOP], 1u);
            const unsigned tg = og / nx;
            if (og + 1u == (tg + 1u) * nx) xb_add(&bar[XB_TOPGEN], 1u);
            else XB_SPIN(xb_ld(&bar[XB_TOPGEN]) == tg, bar);
            __builtin_amdgcn_fence(__ATOMIC_ACQUIRE, "agent");
            xb_add(&bar[XB_XGEN(b.x)], 1u);
            asm volatile("s_waitcnt vmcnt(0)" ::: "memory");
        } else {
            XB_SPIN(xb_ld(&bar[XB_XGEN(b.x)]) == gen, bar);
            __builtin_amdgcn_fence(__ATOMIC_ACQUIRE, "agent");
            asm volatile("s_waitcnt vmcnt(0)" ::: "memory");
        }
    }
    __syncthreads();
}

constexpr int NWAVES = 8;
constexpr int NTOK = 16384, DM = 2048, SEQ = 2048, NHEAD = 16, NLAYER = 4, NEXP = 16, DEXP = 1024;
constexpr int XS_ROWS = 36864;
constexpr float LN_EPS = 1e-5f;
constexpr float DN_ALPHA = 1.6817928305074292f;
constexpr float LOG2E = 1.4426950408889634f;
constexpr float SB_QSCALE = 0.08838834764831845f * LOG2E;
constexpr float DF_QSCALE = 0.125f * LOG2E;
#ifndef MK_MULTI
#define MK_MULTI 0
#endif
#ifndef MOE_F8
#define MOE_F8 1
#endif
#ifndef QKV8_A
#define QKV8_A 1
#endif
#ifndef QKV8_B
#define QKV8_B 0
#endif
#ifndef V8_B
#define V8_B 1
#endif
#ifndef DF_RING
#define DF_RING 1
#endif
constexpr int NSTEPS = 1 + 8 * NLAYER;

constexpr size_t MiB = 1u << 20;
constexpr size_t WS_CTL = 0, CTL_ZERO_BYTES = 256 * 1024;
constexpr size_t WS_COS = 1 * MiB, WS_SIN = WS_COS + 256 * 1024;
constexpr size_t WS_WR = 2 * MiB;
constexpr size_t WS_CNT = 3 * MiB;
constexpr size_t WS_RE = WS_CNT + 64 * 1024;
constexpr size_t WS_RW = WS_RE + 64 * 1024;
constexpr size_t WS_RP = WS_RW + 128 * 1024;
constexpr int LDH = 2048;
constexpr int P8K2 = 2048, P8K1 = 1024;
constexpr size_t WS_WQKVA = 4 * MiB;
constexpr size_t WS_WOA = WS_WQKVA + 56 * MiB;
constexpr size_t WS_WQKVB = WS_WOA + 16 * MiB;
constexpr size_t WS_WOB = WS_WQKVB + 36 * MiB;
constexpr size_t WS_WGU = WS_WOB + 16 * MiB;
constexpr size_t WS_WDN = WS_WGU + 512 * MiB;
constexpr size_t WS_H = WS_WDN + 256 * MiB;
constexpr size_t WS_HB = WS_H + 128 * MiB;
constexpr size_t WS_QKV = WS_HB + 68 * MiB;
constexpr size_t WS_OB = WS_QKV + 192 * MiB;
constexpr size_t WS_XS = WS_OB + 64 * MiB;
constexpr size_t WS_ACT = WS_XS + 144 * MiB;
constexpr size_t WS_YD = WS_ACT + 72 * MiB;
constexpr size_t WS_END = WS_YD + 144 * MiB;
static_assert(WS_END <= (size_t)2040 * MiB, "workspace map");
static_assert((size_t)2 * 6144 * LDH * 2 <= 56 * MiB && (size_t)8192 * LDH * 2 <= 36 * MiB && (size_t)2 * 2048 * P8K2 <= 16 * MiB && (size_t)64 * 2048 * P8K2 <= 512 * MiB && (size_t)64 * 2048 * P8K1 <= 256 * MiB, "weight regions");
static_assert((size_t)NTOK * LDH * 2 <= 68 * MiB && (size_t)NTOK * P8K2 <= 64 * MiB && (size_t)XS_ROWS * P8K2 <= 144 * MiB && (size_t)XS_ROWS * P8K1 <= 72 * MiB, "activation regions");
constexpr int CW_MTC = 8192;
constexpr int CW_BAR = 1024;
constexpr int LDS_BYTES = 163840;
constexpr int WCOL_OFF = 147456;
constexpr int LDSCTL_OFF = 145408;
constexpr int RING_OFF = 0;
constexpr int LNX_OFF = 131072;

#define GAS __attribute__((address_space(1)))
typedef unsigned short bf16;
typedef unsigned v4u __attribute__((ext_vector_type(4)));
typedef unsigned v2u __attribute__((ext_vector_type(2)));
typedef float f32x4 __attribute__((ext_vector_type(4)));
typedef float f32x2 __attribute__((ext_vector_type(2)));
typedef _Float16 f16x4 __attribute__((ext_vector_type(4)));
__device__ __forceinline__ f32x4 ldh4(const _Float16* p) { return __builtin_convertvector(*(const f16x4*)p, f32x4); }
__device__ __forceinline__ void sth4(_Float16* p, f32x4 v) { __builtin_nontemporal_store(__builtin_convertvector(v, f16x4), (f16x4*)p); }
#define LDS_WAIT() asm volatile("s_waitcnt lgkmcnt(0)" ::: "memory")
#define VM_WAIT() asm volatile("s_waitcnt vmcnt(0)" ::: "memory")
__device__ __forceinline__ unsigned pk2(float lo, float hi) { unsigned r; asm volatile("v_cvt_pk_bf16_f32 %0, %1, %2" : "=v"(r) : "v"(lo), "v"(hi)); return r; }
__device__ __forceinline__ int opq_tid(int wave) { int t = tid_from_wave(wave); asm volatile("" : "+v"(t)); return t; }
__device__ __forceinline__ float dpp_sum(float v) {
    v += __builtin_bit_cast(float, __builtin_amdgcn_update_dpp(0, __builtin_bit_cast(int, v), 0xB1, 0xf, 0xf, true));
    v += __builtin_bit_cast(float, __builtin_amdgcn_update_dpp(0, __builtin_bit_cast(int, v), 0x4E, 0xf, 0xf, true));
    v += __builtin_bit_cast(float, __builtin_amdgcn_update_dpp(0, __builtin_bit_cast(int, v), 0x141, 0xf, 0xf, true));
    v += __builtin_bit_cast(float, __builtin_amdgcn_update_dpp(0, __builtin_bit_cast(int, v), 0x140, 0xf, 0xf, true));
    const int b = __builtin_bit_cast(int, v);
    const float s0 = __builtin_bit_cast(float, __builtin_amdgcn_readlane(b, 0)), s1 = __builtin_bit_cast(float, __builtin_amdgcn_readlane(b, 16));
    const float s2 = __builtin_bit_cast(float, __builtin_amdgcn_readlane(b, 32)), s3 = __builtin_bit_cast(float, __builtin_amdgcn_readlane(b, 48));
    return (s0 + s1) + (s2 + s3);
}
__device__ __forceinline__ float wave_sum(float v) {
#pragma unroll
    for (int o = 1; o < 64; o <<= 1) v += __shfl_xor(v, o);
    return v;
}

struct Args { const float* in[17]; float* out; unsigned char* ws; int s_lo, s_hi; };

__device__ __forceinline__ int map_row(int n, int mode) {
    if (mode == 0) return n;
    if (mode == 1) { const int c = n & 255, blk = c >> 6, d = c & 63; return (n & ~255) + ((d >> 5) << 7) + (blk << 5) + (d & 31); }
    return ((n >> 7) << 8) + (n & 127) + (mode == 3 ? 128 : 0);
}
__device__ __forceinline__ unsigned pk2h(float lo, float hi) { typedef _Float16 h2 __attribute__((ext_vector_type(2))); const f32x2 v = {lo, hi}; return __builtin_bit_cast(unsigned, __builtin_convertvector(v, h2)); }
__device__ __forceinline__ void cvt_load(f32x4 (&v)[16], const float* __restrict__ src, int pitch, int k0, int n0, int kind, int lane) {
    if (kind == 2) { const int kr = lane >> 3, n4 = (lane & 7) * 4; const float* p = src + (size_t)(k0 + kr) * pitch + n0 + n4;
#pragma unroll
        for (int i = 0; i < 16; ++i) v[i] = __builtin_nontemporal_load((const f32x4*)(p + (size_t)(8 * i) * pitch)); }
    else { const int kr = lane >> 4, n4 = (lane & 15) * 4; const float* p = src + (size_t)(k0 + kr) * pitch + n0 + n4;
#pragma unroll
        for (int i = 0; i < 16; ++i) v[i] = __builtin_nontemporal_load((const f32x4*)(p + (size_t)(4 * i) * pitch)); }
}
__device__ __forceinline__ void cvt_store(const f32x4 (&v)[16], unsigned char* __restrict__ dst, int dp, int mode, int k0, int n0, int kind, LAS float* scr, int lane) {
    if (kind == 2) {
        const int kr = lane >> 3, n4 = (lane & 7) * 4;
#pragma unroll
        for (int i = 0; i < 16; ++i) { LAS float* s = scr + (8 * i + kr) * 33 + n4; s[0] = v[i][0] * pg8::W8_SCALE; s[1] = v[i][1] * pg8::W8_SCALE; s[2] = v[i][2] * pg8::W8_SCALE; s[3] = v[i][3] * pg8::W8_SCALE; }
        LDS_WAIT();
        const int c = lane & 7;
#pragma unroll
        for (int j = 0; j < 4; ++j) { const int nl = (lane >> 3) + 8 * j; const int row = map_row(n0 + nl, mode);
            const LAS float* s = scr + (16 * c) * 33 + nl;
            v4u o; o.x = pg8::pack4_fp8(s[0], s[33], s[66], s[99]); o.y = pg8::pack4_fp8(s[132], s[165], s[198], s[231]);
            o.z = pg8::pack4_fp8(s[264], s[297], s[330], s[363]); o.w = pg8::pack4_fp8(s[396], s[429], s[462], s[495]);
            __builtin_nontemporal_store(o, (v4u*)(dst + (size_t)row * dp + k0 + 16 * c)); }
    } else {
        const int kr = lane >> 4, n4 = (lane & 15) * 4;
#pragma unroll
        for (int i = 0; i < 16; ++i) { LAS float* s = scr + (4 * i + kr) * 65 + n4; s[0] = v[i][0]; s[1] = v[i][1]; s[2] = v[i][2]; s[3] = v[i][3]; }
        LDS_WAIT();
        const int c = lane & 7;
#pragma unroll
        for (int j = 0; j < 8; ++j) { const int nl = (lane >> 3) + 8 * j; const int row = map_row(n0 + nl, mode);
            const LAS float* s = scr + (8 * c) * 65 + nl;
            v4u o; o.x = pk2h(s[0], s[65]); o.y = pk2h(s[130], s[195]); o.z = pk2h(s[260], s[325]); o.w = pk2h(s[390], s[455]);
            __builtin_nontemporal_store(o, (v4u*)(dst + (size_t)row * dp + (k0 + 8 * c) * 2)); }
    }
    LDS_WAIT();
}

__global__ void __launch_bounds__(NWAVES * 64, 2) yoco_fwd(Args args) {
    extern __shared__ __attribute__((aligned(16))) unsigned char lds_raw[];
    LAS unsigned char* const lds = (LAS unsigned char*)lds_raw;
    const int tid = threadIdx.x, lane = tid & 63, wave = __builtin_amdgcn_readfirstlane(tid >> 6);
    const int G = gridDim.x, bx = blockIdx.x;
    const int vcu = (G % 8 == 0) ? (bx % 8) * (G / 8) + bx / 8 : bx;
    unsigned char* const ws = args.ws;
    volatile LAS unsigned* const CTL = (volatile LAS unsigned*)(lds + LDSCTL_OFF);
    LAS int* const TAB = (LAS int*)(lds + LDSCTL_OFF + 64);
    for (int u = tid; u < (LDS_BYTES - LDSCTL_OFF) / 4; u += NWAVES * 64) ((LAS unsigned*)(lds + LDSCTL_OFF))[u] = 0u;
    __syncthreads();
    const int s_lo = args.s_lo, s_hi = args.s_hi;
    XcdBarrier bar; bar.bar = (unsigned*)(ws + WS_CTL) + CW_BAR; bar.x = 0; bar.st = nullptr;
    if (s_hi - s_lo > 1) bar = xcd_barrier_post((unsigned*)(ws + WS_CTL) + CW_BAR, CTL, tid == 0);
#ifndef PH_MASK
#define PH_MASK 0xFFFF
#endif
#define PHM(b) (((PH_MASK) >> (b)) & 1)
#ifndef PROBE_DUP
#define PROBE_DUP 0
#endif
#define PREP(b) _Pragma("unroll 1") for (int rep_ = 0; rep_ < ((((PROBE_DUP) >> (b)) & 1) ? 2 : 1); ++rep_) if ((rep_ == 1 && ((PROBE_DUP >> 12) & 1)) ? (xcd_barrier(bar, tid_from_wave(wave) == 0), true) : true)
#define IN(k) (s_lo <= (k) && (k) < s_hi)
#define SEAM(k) do { if ((k) + 1 < s_hi) xcd_barrier(bar, tid_from_wave(wave) == 0); } while (0)

    const float* const x_in = args.in[0];
    _Float16* const H = (_Float16*)(ws + WS_H); unsigned char* const HB8 = (unsigned char*)(ws + WS_OB + 32 * MiB);     bf16* const QKV = (bf16*)(ws + WS_QKV); bf16* const OB = (bf16*)(ws + WS_OB);
    bf16* const MIX = (bf16*)(ws + WS_YD);     bf16* const XS = (bf16*)(ws + WS_XS); float* const S1 = (float*)(ws + WS_XS); bf16* const ACT = (bf16*)(ws + WS_ACT); bf16* const YD = (bf16*)(ws + WS_YD);
    float* const WR = (float*)(ws + WS_WR);
    int* const CNT = (int*)(ws + WS_CNT); unsigned* const RE = (unsigned*)(ws + WS_RE); f32x2* const RW = (f32x2*)(ws + WS_RW); int* const RP = (int*)(ws + WS_RP);

    if (IN(0) && PHM(0)) { PREP(0) {
        const int tid = opq_tid(wave), lane = tid & 63;
        LAS float* scr = (LAS float*)(lds + RING_OFF + wave * 16896);
        const int gw = vcu * NWAVES + wave, NGW = G * NWAVES;
        constexpr int I0 = 2 * 3072, I1 = 8 * 1024, I2 = 128 * 512, I3 = 64 * 512, NITEMS = I0 + I1 + I2 + I3;
        static_assert(QKV8_A == 1 && QKV8_B == 0, "conversion table below: stick-breaking q|k|v and all other fp8 GEMM weights -> e4m3, differential q|k|v weights -> fp16");
#define CVT_DECODE(it_, SRC, PIT, DST, DP, MODE, K0, N0, KIND) do { int r = (it_); \
            if (r < I0) { const int job = r / 3072; r -= job * 3072; const int kb = r / 192, nb = r - kb * 192; \
                SRC = args.in[1] + (size_t)job * 2048 * 6144; PIT = 6144; DST = ws + WS_WQKVA + (size_t)job * 6144 * 2048; DP = 2048; MODE = 0; K0 = kb * 128; N0 = nb * 32; KIND = 2; break; } \
            r -= I0; \
            if (r < I1) { const int job = r >> 10; r &= 1023; const int r1_ = r; K0 = (r >> 6) * 128; N0 = (r & 63) * 32; PIT = 2048; MODE = 0; KIND = 2; DP = P8K2; \
                if (job < 2) { SRC = args.in[2] + (size_t)job * 2048 * 2048; DST = ws + WS_WOA + (size_t)job * 2048 * P8K2; } \
                else if (job >= 6) { SRC = args.in[5] + (size_t)(job - 6) * 2048 * 2048; DST = ws + WS_WOB + (size_t)(job - 6) * 2048 * P8K2; } \
                else if (V8_B && job == 4) { SRC = args.in[3] + 2048; PIT = 4096; DST = ws + WS_WQKVB + (size_t)4096 * LDH * 2; }     \
                else { KIND = 1; DP = LDH * 2; K0 = (r1_ >> 5) * 64; N0 = (r1_ & 31) * 64; \
                    if (job == 2) { SRC = args.in[4]; DST = ws + WS_WQKVB; MODE = 1; } \
                    else if (job == 3) { SRC = args.in[3]; PIT = 4096; DST = ws + WS_WQKVB + (size_t)2048 * LDH * 2; MODE = 1; } \
                    else if (job == 4) { SRC = args.in[3] + 2048; PIT = 4096; DST = ws + WS_WQKVB + (size_t)4096 * LDH * 2; } \
                    else { SRC = args.in[4] + (size_t)2048 * 2048; DST = ws + WS_WQKVB + (size_t)6144 * LDH * 2; MODE = 1; } } \
                break; } \
            r -= I1; \
            if (r < I2) { const int job = r >> 9; r &= 511; const int le = job >> 1, up = job & 1;     \
                SRC = (up ? args.in[15] : args.in[14]) + (size_t)le * 2048 * 1024; PIT = 1024; DST = ws + WS_WGU + (size_t)le * 2048 * P8K2; DP = P8K2; MODE = 2 + up; K0 = (r >> 5) * 128; N0 = (r & 31) * 32; KIND = 2; break; } \
            r -= I2; \
            { const int le = r >> 9; r &= 511; SRC = args.in[16] + (size_t)le * 1024 * 2048; PIT = 2048; DST = ws + WS_WDN + (size_t)le * 2048 * P8K1; DP = P8K1; MODE = 0; K0 = (r >> 6) * 128; N0 = (r & 63) * 32; KIND = 2; } \
        } while (0)
        { const float* sA; const float* sB; unsigned char* dA; unsigned char* dB; int pA, pB, qA, qB, mA, mB, kA, kB, nA, nB, tA, tB; f32x4 va[16], vb[16];
          int it = gw;
          if (it < NITEMS) { CVT_DECODE(it, sA, pA, dA, qA, mA, kA, nA, tA); cvt_load(va, sA, pA, kA, nA, tA, lane);
            for (;;) {
                if (it + NGW < NITEMS) { CVT_DECODE(it + NGW, sB, pB, dB, qB, mB, kB, nB, tB); cvt_load(vb, sB, pB, kB, nB, tB, lane); }
                cvt_store(va, dA, qA, mA, kA, nA, tA, scr, lane); it += NGW; if (it >= NITEMS) break;
                if (it + NGW < NITEMS) { CVT_DECODE(it + NGW, sA, pA, dA, qA, mA, kA, nA, tA); cvt_load(va, sA, pA, kA, nA, tA, lane); }
                cvt_store(vb, dB, qB, mB, kB, nB, tB, scr, lane); it += NGW; if (it >= NITEMS) break;
            } } }
#undef CVT_DECODE
        for (size_t i = (size_t)gw * 64 + lane; i < (size_t)NTOK * DM / 4; i += (size_t)NGW * 64) {
            const f32x4 v = ((const f32x4*)x_in)[i];
            ((unsigned*)HB8)[i] = pg8::pack4_fp8(v[0], v[1], v[2], v[3]); }
        for (int i = bx * (NWAVES * 64) + tid; i < NLAYER * 20 * 2048; i += G * NWAVES * 64) { const int k = i & 2047, c = (i >> 11) % 20, l = i / (20 * 2048);
            WR[i] = c < 4 ? args.in[12][((size_t)l * 2048 + k) * 4 + c] : args.in[13][(((size_t)l * 4 + ((c - 4) >> 2)) * 2048 + k) * 4 + ((c - 4) & 3)]; }
        }
        SEAM(0);
    }

    for (int L = 0; L < NLAYER; ++L) {
        const int sb = 1 + 8 * L; const bool typeA = L < 2;
        if (IN(sb + 0)) {
            if (typeA && PHM(1)) { PREP(1) {
                pg8::StaticOrder S; S.init(NTOK, 6144, G, bx);
                if (QKV8_A) { pg8::Gemm g{(const bf16*)HB8, (const bf16*)(ws + WS_WQKVA + (size_t)L * 6144 * 2048), NTOK, 6144, DM / 2, DM / 2, wave}; pg8::EpiQkv E{QKV, 6144, 2048, SB_QSCALE, 1.f / pg8::W8_UNDO};
                    pg8::gemm_phase<pg8::EpiQkv, pg8::StaticOrder, true, true, true>(lds + RING_OFF, g, S, E); }
                } static_assert(QKV8_A == 1, "the stick-breaking layers' q|k|v GEMM takes the e4m3 copy of the stream");
            } else if (!typeA && PHM(2)) { PREP(2) {
                const int N = (L == 2) ? 6144 : 2048;
                pg8::StaticOrder S; S.init(NTOK, N, G, bx);
                if (QKV8_B) { pg8::Gemm g{(const bf16*)HB8, (const bf16*)(ws + WS_WQKVB + (L == 2 ? (size_t)0 : (size_t)6144 * 2048)), NTOK, N, DM / 2, DM / 2, wave};
                    pg8::EpiRope E{QKV, 6144, 2048, 4096, DF_QSCALE, 1.f / pg8::W8_UNDO};
                    pg8::gemm_phase<pg8::EpiRope, pg8::StaticOrder, true, true, true>(lds + RING_OFF, g, S, E); }
                else { const int Nh = (V8_B && L == 2) ? 4096 : N; if (V8_B) S.init(NTOK, Nh, G, bx);
                    pg8::Gemm g{(const bf16*)H, (const bf16*)(ws + WS_WQKVB) + (L == 2 ? (size_t)0 : (size_t)6144 * LDH), NTOK, Nh, DM, LDH, wave};
                    pg8::EpiRope E{QKV, 6144, 2048, 4096, DF_QSCALE, 1.f};
                    pg8::gemm_phase<pg8::EpiRope, pg8::StaticOrder, true, true, false, true>(lds + RING_OFF, g, S, E);
                    if (V8_B && L == 2) {
                        pg8::StaticOrder S2; S2.init(NTOK, 2048, G, bx);
                        pg8::Gemm g2{(const bf16*)HB8, (const bf16*)(ws + WS_WQKVB + (size_t)4096 * LDH * 2), NTOK, 2048, DM / 2, P8K2 / 2, wave}; pg8::EpiQkv E2{QKV + 4096, 6144, 0, 1.f, 1.f / pg8::W8_UNDO};
                        pg8::gemm_phase<pg8::EpiQkv, pg8::StaticOrder, true, true, true>(lds + RING_OFF, g2, S2, E2); } } }
            }
            SEAM(sb + 0);
        }
        if (IN(sb + 1)) {
            if (typeA && PHM(3)) {
                for (int id_ = vcu; id_ < 512 * (1 + ((PROBE_DUP >> 3) & 1)); id_ += G) { if (((PROBE_DUP >> 12) & 1) && id_ >= 512 && id_ < 512 + G) xcd_barrier(bar, tid_from_wave(wave) == 0); const int id = id_ & 511; const int bh = id >> 2, p = id & 3, b = bh >> 4, h = bh & 15;
                    const bf16* Qg = QKV + (size_t)b * SEQ * 6144 + h * 128; bf16* Og = (bf16*)((unsigned char*)OB + (size_t)b * SEQ * P8K2 + h * 128);
                    att::sb_block(Qg, Qg + 2048, Qg + 4096, Og, 7 - p, (att::ldsp)(lds + RING_OFF), wave);
                    att::sb_block(Qg, Qg + 2048, Qg + 4096, Og, p, (att::ldsp)(lds + RING_OFF), wave); }
            } else if (!typeA && PHM(4)) {
                const int lane = opq_tid(wave) & 63;
                const int i = L - 2; const float lam_init = (L == 2) ? 0.47071301834264183f : 0.5560582041556061f;
                const float* lp = args.in[6] + (size_t)i * 256;
                const float sa = dpp_sum(lp[lane] * lp[64 + lane]), sb2 = dpp_sum(lp[128 + lane] * lp[192 + lane]);
                const float lam = __builtin_amdgcn_exp2f(sa * LOG2E) - __builtin_amdgcn_exp2f(sb2 * LOG2E) + lam_init;
                const float* gsub = args.in[7] + (size_t)i * 128; const float gmul = 1.f - lam_init;
                for (int id_ = vcu; id_ < 512 * (1 + ((PROBE_DUP >> 4) & 1)); id_ += G) { if (((PROBE_DUP >> 12) & 1) && id_ >= 512 && id_ < 512 + G) xcd_barrier(bar, tid_from_wave(wave) == 0); const int id = id_ & 511; const int bh = id >> 2, p = id & 3, b = bh >> 4, h = bh & 15;
                    const bf16* Qg = QKV + (size_t)b * SEQ * 6144 + h * 128; bf16* Og = (bf16*)((unsigned char*)OB + (size_t)b * SEQ * P8K2 + h * 128); float* Sg = S1 + (size_t)b * SEQ * DM + h * 128;
#pragma unroll 1
                    for (int w = 0; w < 2; ++w) { const int qb = w ? p : 7 - p;
#if DF_RING
                        att::diff_pass2<false>(Qg, Qg + 2048, Qg + 4096, Sg, Og, qb, lam, gsub, gmul, (att::ldsp)(lds + RING_OFF), wave);
                        att::diff_pass2<true>(Qg + 64, Qg + 2048 + 64, Qg + 4096, Sg, Og, qb, lam, gsub, gmul, (att::ldsp)(lds + RING_OFF), wave); } }
#else
                        att::diff_pass<false>(Qg, Qg + 2048, Qg + 4096, Sg, Og, qb, lam, gsub, gmul, (att::ldsp)(lds + RING_OFF), wave);
                        att::diff_pass<true>(Qg + 64, Qg + 2048 + 64, Qg + 4096, Sg, Og, qb, lam, gsub, gmul, (att::ldsp)(lds + RING_OFF), wave); } }
#endif
            }
            SEAM(sb + 1);
        }
        if (IN(sb + 2)) { if (PHM(5)) {
            pg8::Gemm g{OB, (const bf16*)(ws + (typeA ? WS_WOA : WS_WOB) + (size_t)(L & 1) * 2048 * P8K2), NTOK, DM, DM / 2, P8K2 / 2, wave}; pg8::StaticOrder S; S.init(NTOK, DM, G, bx);
            pg8::EpiQkv E{MIX, DM, 0, 1.f, 1.f / (pg8::W8_UNDO * att::OB8_SCALE)};
            pg8::gemm_phase<pg8::EpiQkv, pg8::StaticOrder, true, true, true>(lds + RING_OFF, g, S, E); }
            SEAM(sb + 2);
        }
        if (IN(sb + 3)) { if (PHM(6)) {
            const int tid = opq_tid(wave), lane = tid & 63;
            const float* lng = args.in[8] + (size_t)L * DM; const float* lnb = args.in[9] + (size_t)L * DM; const float* wr = WR + (size_t)L * 20 * 2048;
            LAS int* eid = (LAS int*)(lds + LNX_OFF + 2048);
            LAS float* lgt = (LAS float*)(lds + LNX_OFF + 4096);
            LAS unsigned* rows8 = (LAS unsigned*)(lds + RING_OFF);
            for (int c = bx; c < 256; c += G) {
                const unsigned wcl = (unsigned)(uintptr_t)(lds + WCOL_OFF) + (unsigned)wave * 1024u; const unsigned wvo = (unsigned)(wave * 256 + lane * 4) * 4u;
#define LN1_DMAW(col, buf) att::glds16s(wvo, wr + (size_t)(col) * 2048, (unsigned)__builtin_amdgcn_readfirstlane(wcl + (unsigned)(buf) * 8192u))
                LN1_DMAW(0, 0); LN1_DMAW(1, 1);
#pragma unroll 1
                for (int grp = 0; grp < 2; ++grp) {
                    const int rloc = wave * 8 + grp * 4; const size_t row0 = (size_t)64 * c + rloc;
                    f32x4 v[4][8]; float mu[4], rstd[4];
#pragma unroll
                    for (int rr = 0; rr < 4; ++rr) {
                        if (L == 0) { const f32x4* hp = (const f32x4*)(x_in + (row0 + rr) * DM) + lane;
#pragma unroll
                            for (int j = 0; j < 8; ++j) v[rr][j] = hp[64 * j]; }
                        else { const _Float16* hq = H + (row0 + rr) * DM + 4 * lane;
#pragma unroll
                            for (int j = 0; j < 8; ++j) v[rr][j] = ldh4(hq + 256 * j); } }
#pragma unroll
                    for (int rr = 0; rr < 4; ++rr) { const v2u* mp = (const v2u*)(MIX + (row0 + rr) * DM) + lane;
#pragma unroll
                        for (int j = 0; j < 8; ++j) { const v2u a = mp[64 * j];
                            const f32x4 fa = {__uint_as_float(a.x << 16), __uint_as_float(a.x & 0xffff0000u), __uint_as_float(a.y << 16), __uint_as_float(a.y & 0xffff0000u)};
                            v[rr][j] = v[rr][j] * DN_ALPHA + fa; } }
#pragma unroll
                    for (int rr = 0; rr < 4; ++rr) { float s = 0.f;
#pragma unroll
                        for (int j = 0; j < 8; ++j) s += (v[rr][j][0] + v[rr][j][1]) + (v[rr][j][2] + v[rr][j][3]);
                        mu[rr] = dpp_sum(s) * (1.f / DM); float q = 0.f;
#pragma unroll
                        for (int j = 0; j < 8; ++j) { const f32x4 d = v[rr][j] - mu[rr]; q += (d[0] * d[0] + d[1] * d[1]) + (d[2] * d[2] + d[3] * d[3]); }
                        rstd[rr] = 1.f / sqrtf(dpp_sum(q) * (1.f / DM) + LN_EPS); }
#pragma unroll
                    for (int j = 0; j < 8; ++j) { const f32x4 gg = ((const f32x4*)lng)[64 * j + lane], bb = ((const f32x4*)lnb)[64 * j + lane];
#pragma unroll
                        for (int rr = 0; rr < 4; ++rr) { v[rr][j] = (v[rr][j] - mu[rr]) * rstd[rr] * gg + bb; sth4(H + (row0 + rr) * DM + 256 * j + 4 * lane, v[rr][j]);
                            if (c == bx) rows8[(rloc + rr) * 512 + 64 * j + lane] = pg8::pack4_fp8(v[rr][j][0], v[rr][j][1], v[rr][j][2], v[rr][j][3]); } }
                    int gs[4] = {0, 0, 0, 0};
#pragma unroll 1
                    for (int cc = 0; cc < 20; ++cc) { const int q = grp * 20 + cc, bsel = q & 1;
                        if (q + 1 < 40) asm volatile("s_waitcnt vmcnt(1)\n\ts_barrier" ::: "memory"); else asm volatile("s_waitcnt vmcnt(0)\n\ts_barrier" ::: "memory");
                        f32x4 w[8];
                        { const LAS f32x4* wp = (const LAS f32x4*)(lds + WCOL_OFF + bsel * 8192) + lane;
#pragma unroll
                          for (int j = 0; j < 8; ++j) w[j] = wp[64 * j]; }
                        asm volatile("s_waitcnt lgkmcnt(0)\n\ts_barrier" ::: "memory");
                        if (q + 2 < 40) LN1_DMAW((q + 2) % 20, bsel);
#pragma unroll
                        for (int rr = 0; rr < 4; ++rr) { if (cc < 4 || gs[rr] == ((cc - 4) >> 2)) {
                            f32x2 a2 = {0.f, 0.f};
#pragma unroll
                            for (int j = 0; j < 8; ++j) { const f32x2 wlo = {w[j][0], w[j][1]}, whi = {w[j][2], w[j][3]}, vlo = {v[rr][j][0], v[rr][j][1]}, vhi = {v[rr][j][2], v[rr][j][3]};
                                a2 = __builtin_elementwise_fma(vlo, wlo, a2); a2 = __builtin_elementwise_fma(vhi, whi, a2); }
                            const float a = dpp_sum(a2[0] + a2[1]);
                            if (lane == 0) lgt[(rloc + rr) * 20 + cc] = a; } }
                        if (cc == 3) { LDS_WAIT();
#pragma unroll
                            for (int rr = 0; rr < 4; ++rr) { const LAS float* lg = lgt + (rloc + rr) * 20; int g = 0; float gm = lg[0];
#pragma unroll
                                for (int i = 1; i < 4; ++i) { const float x = lg[i]; if (x > gm) { gm = x; g = i; } }
                                gs[rr] = __builtin_amdgcn_readfirstlane(g); } } }
                }
#undef LN1_DMAW
                LDS_WAIT();
                if (lane < 8) {
                    const int rl = wave * 8 + lane; const LAS float* lg = lgt + rl * 20;
                    int gsel = 0; float gm = lg[0];
#pragma unroll
                    for (int i = 1; i < 4; ++i) { const float x = lg[i]; if (x > gm) { gm = x; gsel = i; } }
                    float gden = 0.f;
#pragma unroll
                    for (int i = 0; i < 4; ++i) gden += __builtin_amdgcn_exp2f((lg[i] - gm) * LOG2E);
                    const float gw_ = 1.f / gden;
                    const LAS float* li = lg + 4 + 4 * gsel;
                    const float l0 = li[0], l1 = li[1], l2 = li[2], l3 = li[3];
                    int i0 = 0; float v0 = l0;
                    if (l1 > v0) { v0 = l1; i0 = 1; } if (l2 > v0) { v0 = l2; i0 = 2; } if (l3 > v0) { v0 = l3; i0 = 3; }
                    int i1 = -1; float v1 = 0.f;
                    if (i0 != 0) { v1 = l0; i1 = 0; }
                    if (i0 != 1 && (i1 < 0 || l1 > v1)) { v1 = l1; i1 = 1; }
                    if (i0 != 2 && (i1 < 0 || l2 > v1)) { v1 = l2; i1 = 2; }
                    if (i0 != 3 && (i1 < 0 || l3 > v1)) { v1 = l3; i1 = 3; }
                    const float t = __builtin_amdgcn_exp2f((v1 - v0) * LOG2E); const float w0 = gw_ / (1.f + t), w1 = gw_ * t / (1.f + t);
                    eid[2 * rl] = gsel * 4 + i0; eid[2 * rl + 1] = gsel * 4 + i1; RW[(size_t)64 * c + rl] = (f32x2){w0, w1};
                }
                __syncthreads();
                if (wave == 0) {
                    const int ea = eid[lane], eb = eid[64 + lane]; int ra = 0, rb = 0, cnt = 0; const unsigned long long lt = (1ull << lane) - 1ull;
#pragma unroll
                    for (int e = 0; e < 16; ++e) { const unsigned long long ma = __ballot(ea == e), mb = __ballot(eb == e);
                        if (ea == e) ra = __popcll(ma & lt); if (eb == e) rb = __popcll(ma) + __popcll(mb & lt); if (lane == e) cnt = __popcll(ma) + __popcll(mb); }
                    if (lane < 16) CNT[c * 16 + lane] = cnt;
                    LAS int* rk = (LAS int*)(lds + LNX_OFF + 3072); rk[lane] = ra; rk[64 + lane] = rb; LDS_WAIT();
                    const int r = lane; const unsigned word = (unsigned)eid[2 * r] | ((unsigned)eid[2 * r + 1] << 8) | ((unsigned)rk[2 * r] << 16) | ((unsigned)rk[2 * r + 1] << 24);
                    RE[(size_t)64 * c + r] = word;
                }
                __syncthreads();
            } }
            SEAM(sb + 3);
        }
        if ((IN(sb + 4) || IN(sb + 5) || IN(sb + 6)) && PHM(7)) {
            const int tid = opq_tid(wave);
            LAS int* part = (LAS int*)(lds + LNX_OFF);
            { const int e = tid & 15, s = tid >> 4; int a = 0;
#pragma unroll
              for (int i = 0; i < 8; ++i) a += CNT[(8 * s + i) * 16 + e];
              part[s * 16 + e] = a; }
            __syncthreads();
            if (tid < 16) { int run = 0;
#pragma clang loop vectorize(disable)
#pragma unroll 8
                for (int s = 0; s < 32; ++s) run += part[s * 16 + tid];
                TAB[tid] = run; }
            __syncthreads();
            if (tid < 192) { int off = 0, mt = 0, mine = 15;
#pragma unroll
                for (int e = 0; e < 16; ++e) { const int nt = (TAB[e] + 255) >> 8; if (tid == 0) TAB[16 + e] = off; if (tid >= mt && tid < mt + nt) mine = e; off += nt * 256; mt += nt; }
                if (tid < mt && tid < 160) TAB[64 + tid] = mine;
                if (tid == 0) { TAB[32] = off; TAB[33] = mt; } }
            __syncthreads();
        }
        if (IN(sb + 4)) { if (PHM(7)) PREP(7) {
            const int tid = opq_tid(wave), lane = tid & 63;
            LAS int* part = (LAS int*)(lds + LNX_OFF);
            for (int c = bx; c < 256; c += G) {
                if (tid < 16) { int pre = 0; int x[8];
#pragma unroll
                    for (int i = 0; i < 8; ++i) x[i] = CNT[((c & ~7) + i) * 16 + tid];
#pragma clang loop vectorize(disable) unroll(disable)
                    for (int s = 0; s < (c >> 3); ++s) pre += part[s * 16 + tid];
#pragma unroll
                    for (int i = 0; i < 8; ++i) pre += (i < (c & 7)) ? x[i] : 0;
                    TAB[48 + tid] = TAB[16 + tid] + pre; }
                __syncthreads();
#pragma unroll 1
                for (int rr = 0; rr < 8; ++rr) { const size_t row = (size_t)64 * c + wave * 8 + rr; const unsigned word = RE[row];
                    const int p0 = TAB[48 + (word & 255)] + ((word >> 16) & 255), p1 = TAB[48 + ((word >> 8) & 255)] + (word >> 24);
                    if (lane == 0) { RP[2 * row] = p0; RP[2 * row + 1] = p1; }
                    if (c == bx && IN(sb + 3)) {
                        const LAS v4u* src = (const LAS v4u*)(lds + RING_OFF + (wave * 8 + rr) * 2048) + lane; v4u* o0 = (v4u*)((unsigned char*)XS + (size_t)p0 * P8K2) + lane; v4u* o1 = (v4u*)((unsigned char*)XS + (size_t)p1 * P8K2) + lane;
                        const v4u a = src[0], b = src[64]; __builtin_nontemporal_store(a, o0); __builtin_nontemporal_store(b, o0 + 64); __builtin_nontemporal_store(a, o1); __builtin_nontemporal_store(b, o1 + 64);
                    } else {
                        const _Float16* hq = H + row * DM + 4 * lane; unsigned* o0 = (unsigned*)((unsigned char*)XS + (size_t)p0 * P8K2) + lane; unsigned* o1 = (unsigned*)((unsigned char*)XS + (size_t)p1 * P8K2) + lane;
#pragma unroll
                        for (int j = 0; j < 8; ++j) { const f32x4 v = ldh4(hq + 256 * j); const unsigned o = pg8::pack4_fp8(v[0], v[1], v[2], v[3]); o0[64 * j] = o; o1[64 * j] = o; } } }
                __syncthreads();
            } }
            SEAM(sb + 4);
        }
        if (IN(sb + 5)) { if (PHM(8)) PREP(8) {
            pg8::Gemm g{XS, (const bf16*)(ws + WS_WGU + (size_t)L * 16 * 2048 * P8K2), XS_ROWS, 2048, DM / 2, P8K2 / 2, wave};
            pg8::MoeOrder<0> S{TAB[33] * 8, G, bx, TAB + 64, nullptr, nullptr, wave}; pg8::EpiGateUp8 E{(unsigned char*)ACT};
            pg8::gemm_phase<pg8::EpiGateUp8, pg8::MoeOrder<0>, true, true, true>(lds + RING_OFF, g, S, E); }
            SEAM(sb + 5);
        }
        if (IN(sb + 6)) { if (PHM(9)) PREP(9) {
            pg8::Gemm g{ACT, (const bf16*)(ws + WS_WDN + (size_t)L * 16 * 2048 * P8K1), XS_ROWS, 2048, DEXP / 2, P8K1 / 2, wave};
            pg8::MoeOrder<0> S{TAB[33] * 8, G, bx, TAB + 64, nullptr, nullptr, wave}; pg8::EpiDown8 E{(unsigned char*)YD};
            pg8::gemm_phase<pg8::EpiDown8, pg8::MoeOrder<0>, true, true, true>(lds + RING_OFF, g, S, E); }
            SEAM(sb + 6);
        }
        if (IN(sb + 7)) { if (PHM(10)) for (int rep_ = 0; rep_ < ((((PROBE_DUP) >> 10) & 1) && L == NLAYER - 1 ? 5 : 1); ++rep_) {
            const int tid = opq_tid(wave), lane = tid & 63;
            const float* lng = args.in[10] + (size_t)L * DM; const float* lnb = args.in[11] + (size_t)L * DM; const bool last = (L == NLAYER - 1); const bool next8 = (L + 1 < 2) ? (QKV8_A != 0) : (QKV8_B != 0 || (V8_B != 0 && L + 1 == 2));
            const int gw = vcu * NWAVES + wave, NGW = G * NWAVES;
            for (int row0 = 4 * gw; row0 < NTOK; row0 += 4 * NGW) {
                f32x4 v[4][8]; float mu[4], rstd[4];
#pragma unroll
                for (int rr = 0; rr < 4; ++rr) { const int row = row0 + rr;
                    const int p0 = RP[2 * row], p1 = RP[2 * row + 1]; const f32x2 w = RW[row];
                    const _Float16* hq = H + (size_t)row * DM + 4 * lane; const unsigned* y0 = (const unsigned*)((const unsigned char*)YD + (size_t)p0 * DM) + lane; const unsigned* y1 = (const unsigned*)((const unsigned char*)YD + (size_t)p1 * DM) + lane;
                    const float w0s = w.x * (1.f / pg8::YD8_SCALE), w1s = w.y * (1.f / pg8::YD8_SCALE);
#pragma unroll
                    for (int j = 0; j < 8; ++j) { const f32x4 h = ldh4(hq + 256 * j); const unsigned a = y0[64 * j], b = y1[64 * j];
                        const f32x2 a0 = __builtin_amdgcn_cvt_pk_f32_fp8((int)a, false), a1 = __builtin_amdgcn_cvt_pk_f32_fp8((int)a, true), b0 = __builtin_amdgcn_cvt_pk_f32_fp8((int)b, false), b1 = __builtin_amdgcn_cvt_pk_f32_fp8((int)b, true);
                        const f32x4 fa = {a0[0], a0[1], a1[0], a1[1]}, fb = {b0[0], b0[1], b1[0], b1[1]};
                        v[rr][j] = h * DN_ALPHA + fa * w0s + fb * w1s; } }
#pragma unroll
                for (int rr = 0; rr < 4; ++rr) { float s = 0.f;
#pragma unroll
                    for (int j = 0; j < 8; ++j) s += (v[rr][j][0] + v[rr][j][1]) + (v[rr][j][2] + v[rr][j][3]);
                    mu[rr] = dpp_sum(s) * (1.f / DM); float q = 0.f;
#pragma unroll
                    for (int j = 0; j < 8; ++j) { const f32x4 dd = v[rr][j] - mu[rr]; q += (dd[0] * dd[0] + dd[1] * dd[1]) + (dd[2] * dd[2] + dd[3] * dd[3]); }
                    rstd[rr] = 1.f / sqrtf(dpp_sum(q) * (1.f / DM) + LN_EPS); }
#pragma unroll
                for (int j = 0; j < 8; ++j) { const f32x4 gg = ((const f32x4*)lng)[64 * j + lane], bb = ((const f32x4*)lnb)[64 * j + lane];
#pragma unroll
                    for (int rr = 0; rr < 4; ++rr) { const int row = row0 + rr; const f32x4 y = (v[rr][j] - mu[rr]) * rstd[rr] * gg + bb;
                        if (last) __builtin_nontemporal_store(y, (f32x4*)(args.out + (size_t)row * DM) + 64 * j + lane);
                        else { sth4(H + (size_t)row * DM + 256 * j + 4 * lane, y); if (next8) __builtin_nontemporal_store(pg8::pack4_fp8(y[0], y[1], y[2], y[3]), (unsigned*)(HB8 + (size_t)row * DM) + 64 * j + lane); } } }
            } }
            SEAM(sb + 7);
        }
    }
#undef IN
#undef SEAM
}

extern "C" void kernel_launch(void* const* d_in, const int* in_sizes, int n_in, void* d_out, int out_size, void* d_ws, size_t ws_size, hipStream_t stream) {
    static int grid = 0;
    if (grid == 0) {
        if (n_in != 17 || in_sizes[0] != NTOK * DM || out_size != NTOK * DM || ws_size < WS_END) { fprintf(stderr, "kernel_launch: unexpected shapes / workspace (n_in %d, ws %zu, need %zu)\n", n_in, ws_size, (size_t)WS_END); grid = -1; return; }
        int dev = 0, cus = 0, per_cu = 0;
        if (hipGetDevice(&dev) != hipSuccess || hipDeviceGetAttribute(&cus, hipDeviceAttributeMultiprocessorCount, dev) != hipSuccess) { grid = -1; return; }
        if (hipFuncSetAttribute((const void*)yoco_fwd, hipFuncAttributeMaxDynamicSharedMemorySize, LDS_BYTES) != hipSuccess) { fprintf(stderr, "kernel_launch: hipFuncSetAttribute failed\n"); grid = -1; return; }
        if (hipOccupancyMaxActiveBlocksPerMultiprocessor(&per_cu, (const void*)yoco_fwd, NWAVES * 64, LDS_BYTES) != hipSuccess || per_cu < 1) { fprintf(stderr, "kernel_launch: occupancy query says %d\n", per_cu); per_cu = 1; }
        (void)hipGetLastError();
        grid = cus;
    }
    if (grid < 0) return;
    (void)hipMemsetAsync((char*)d_ws + WS_CTL, 0, CTL_ZERO_BYTES, stream);
    Args a{};
    for (int i = 0; i < 17; ++i) a.in[i] = (const float*)d_in[i];
    a.out = (float*)d_out; a.ws = (unsigned char*)d_ws;
#if MK_MULTI
    for (int s = 0; s < NSTEPS; ++s) { a.s_lo = s; a.s_hi = s + 1; hipLaunchKernelGGL(yoco_fwd, dim3(grid), dim3(NWAVES * 64), LDS_BYTES, stream, a); }
#else
    a.s_lo = 0; a.s_hi = NSTEPS;
    hipLaunchKernelGGL(yoco_fwd, dim3(grid), dim3(NWAVES * 64), LDS_BYTES, stream, a);
#endif
    const hipError_t le = hipPeekAtLastError();
    if (le != hipSuccess) fprintf(stderr, "kernel_launch: launch failed: %s\n", hipGetErrorName(le));
}
```

```cpp
#include <hip/hip_runtime.h>
#include <cstdio>
#include <cstdint>

__device__ __forceinline__ int tid_from_wave(int wave) { int l; asm volatile("v_mbcnt_lo_u32_b32 %0, -1, 0\n\tv_mbcnt_hi_u32_b32 %0, -1, %0" : "=v"(l)); return wave * 64 + l; }
namespace pg8 {
#define PG8_LAS __attribute__((address_space(3)))
typedef unsigned short bf16_t;
typedef short bf16x8 __attribute__((ext_vector_type(8)));
typedef float f32x4 __attribute__((ext_vector_type(4)));
typedef unsigned u32x4 __attribute__((ext_vector_type(4)));
typedef int pg8_v8i __attribute__((ext_vector_type(8)));
typedef _Float16 pg8_h8 __attribute__((ext_vector_type(8)));
constexpr int BM = 256, BK = 64, HALF = 128, HTB = HALF * BK * 2  , STAGE_BYTES = 8 * HTB, NXCD = 8, WGM = 8;

__host__ __device__ __forceinline__ int lds_byte(int r, int c) { const int st = (r >> 4) * 2 + (c >> 5), rr = r & 15, cc = c & 31, ob = rr * 64 + cc * 2; return st * 1024 + (ob ^ (((ob >> 9) & 1) << 5)); }
__host__ __device__ __forceinline__ void stage_rc(int b, int& R, int& C) { const int st = b / 1024, sb = b % 1024, swz = sb ^ (((sb >> 9) & 1) << 5); R = (st >> 1) * 16 + swz / 64; C = (st & 1) * 32 + (swz % 64) / 2; }
__host__ __device__ __forceinline__ int perm32(int rho) { const int n = rho >> 4, i = rho & 15; return 8 * (i >> 2) + 4 * n + (i & 3); }

struct Unit { int pm, pn; };
struct Gemm { const bf16_t* A; const bf16_t* Bt; int M, N, K, ld, wave; };

struct StaticOrder {
    int nM, nN, nwg, G, c;
    __host__ __device__ void init(int M, int N, int G_, int c_) { nM = M / BM; nN = N / BM; nwg = nM * nN; G = G_; c = c_; }
    __host__ __device__ bool next(int i, Unit& u) const {
        const long L = (long)i * G + c; if (L >= nwg) return false;
        int wgid = (int)L; { const int q = nwg / NXCD, r = nwg % NXCD, xcd = wgid % NXCD, off = wgid / NXCD; wgid = (xcd < r ? xcd * (q + 1) : r * (q + 1) + (xcd - r) * q) + off; }
        const int nig = WGM * nN, gid = wgid / nig, fm = gid * WGM, gsz = (nM - fm) < WGM ? (nM - fm) : WGM;
        u.pm = fm + ((wgid % nig) % gsz); u.pn = (wgid % nig) / gsz; return true;
    }
    __device__ __forceinline__ void a_ready(const Unit&) const {}
    __device__ __forceinline__ void done(const Unit&) const {}
};

__device__ __forceinline__ unsigned cvt_pk_bf16(float lo, float hi) { unsigned r; asm volatile("v_cvt_pk_bf16_f32 %0, %1, %2" : "=v"(r) : "v"(lo), "v"(hi)); return r; }
typedef float f32x2 __attribute__((ext_vector_type(2)));

typedef unsigned u32x2 __attribute__((ext_vector_type(2)));
__device__ __forceinline__ u32x4 pack8_bf16(const f32x4 a, const f32x4 b) { u32x4 w; w.x = cvt_pk_bf16(a[0], a[1]); w.y = cvt_pk_bf16(a[2], a[3]); w.z = cvt_pk_bf16(b[0], b[1]); w.w = cvt_pk_bf16(b[2], b[3]); return w; }

struct EpiQkv {
    static constexpr bool PERM = true, AFTER_DRAIN = false;
    bf16_t* O; int ldc; int qcols; float qscale; float osc;
    __device__ __forceinline__ void operator()(const f32x4 (&acc)[2][2][4][2], const Unit& u, int wr, int wc, int fr, int fq) const {
        const int row0 = u.pm * BM + wr * 64 + fr, colt = u.pn * BM; const float sc = (colt < qcols ? qscale : 1.f) * osc;
        const int col0 = colt + wc * 32 + 8 * fq;
#pragma unroll
        for (int ai = 0; ai < 2; ++ai)
#pragma unroll
            for (int m = 0; m < 4; ++m) { bf16_t* rowp = O + (size_t)(row0 + ai * HALF + m * 16) * ldc + col0;
#pragma unroll
                for (int bj = 0; bj < 2; ++bj) *(u32x4*)(rowp + bj * HALF) = pack8_bf16(acc[ai][bj][m][0] * sc, acc[ai][bj][m][1] * sc); }
    }
};
template <int ACCS_INV> struct EpiResid {
    static constexpr bool PERM = false, AFTER_DRAIN = false;
    static constexpr int ldc = 2048; static constexpr float alpha = 1.6817928305074292f, accs = 1.f / (float)ACCS_INV;
    float* H; const float* Hsrc;
    __device__ __forceinline__ void operator()(const f32x4 (&acc)[2][2][4][2], const Unit& u, int wr, int wc, int fr, int fq) const {
        const int row0 = u.pm * BM + wr * 64 + fr, col0 = u.pn * BM + wc * 32 + 4 * fq;
#pragma unroll
        for (int ai = 0; ai < 2; ++ai)
#pragma unroll
            for (int m = 0; m < 4; ++m) { const size_t ro = (size_t)(row0 + ai * HALF + m * 16) * ldc + col0; float* rowp = H + ro; const float* srcp = Hsrc + ro;
#pragma unroll
                for (int bj = 0; bj < 2; ++bj)
#pragma unroll
                    for (int n = 0; n < 2; ++n) { const f32x4 h = *(const f32x4*)(srcp + bj * HALF + n * 16); *(f32x4*)(rowp + bj * HALF + n * 16) = h * alpha + acc[ai][bj][m][n] * accs; } }
    }
};
struct EpiRope {
    static constexpr bool PERM = true, AFTER_DRAIN = false;
    bf16_t* O; int ldc; int qcols, ropecols; float qscale; float osc;
    __device__ __forceinline__ void operator()(const f32x4 (&acc)[2][2][4][2], const Unit& u, int wr, int wc, int fr, int fq) const {
        const int row0 = u.pm * BM + wr * 64 + fr, colt = u.pn * BM;
        if (colt >= ropecols) {
            const int col0 = colt + wc * 32 + 8 * fq;
#pragma unroll
            for (int ai = 0; ai < 2; ++ai)
#pragma unroll
                for (int m = 0; m < 4; ++m) { bf16_t* rowp = O + (size_t)(row0 + ai * HALF + m * 16) * ldc + col0;
#pragma unroll
                    for (int bj = 0; bj < 2; ++bj) *(u32x4*)(rowp + bj * HALF) = pack8_bf16(acc[ai][bj][m][0] * osc, acc[ai][bj][m][1] * osc); }
        } else {
            const float sc = (colt < qcols ? qscale : 1.f) * osc;
            const int col0 = colt + wc * 64 + 8 * fq;
            float ir[8];
#pragma unroll
            for (int i = 0; i < 8; ++i) ir[i] = __builtin_amdgcn_exp2f(-(float)(8 * fq + i) * 0.4152410118609203f) * 0.15915494309189535f;
#pragma unroll
            for (int ai = 0; ai < 2; ++ai)
#pragma unroll
                for (int m = 0; m < 4; ++m) { const int row = row0 + ai * HALF + m * 16; const float pos = (float)(row & 2047);
                    f32x4 c0, c1, s0, s1;
#pragma unroll
                    for (int i = 0; i < 4; ++i) { const float f0 = __builtin_amdgcn_fractf(pos * ir[i]), f1 = __builtin_amdgcn_fractf(pos * ir[4 + i]);
                        c0[i] = __builtin_amdgcn_cosf(f0); s0[i] = __builtin_amdgcn_sinf(f0); c1[i] = __builtin_amdgcn_cosf(f1); s1[i] = __builtin_amdgcn_sinf(f1); }
                    const f32x4 a0 = acc[ai][0][m][0], a1 = acc[ai][0][m][1], b0 = acc[ai][1][m][0], b1 = acc[ai][1][m][1];
                    bf16_t* rowp = O + (size_t)row * ldc + col0;
                    *(u32x4*)(rowp) = pack8_bf16((a0 * c0 - b0 * s0) * sc, (a1 * c1 - b1 * s1) * sc);
                    *(u32x4*)(rowp + 32) = pack8_bf16((b0 * c0 + a0 * s0) * sc, (b1 * c1 + a1 * s1) * sc); }
        }
    }
};
struct EpiGateUp {
    static constexpr bool PERM = true, AFTER_DRAIN = false;
    bf16_t* O;
    __device__ __forceinline__ void operator()(const f32x4 (&acc)[2][2][4][2], const Unit& u, int wr, int wc, int fr, int fq) const {
        const int row0 = u.pm * BM + wr * 64 + fr, col0 = (u.pn & 7) * 128 + wc * 32 + 8 * fq;
#pragma unroll
        for (int ai = 0; ai < 2; ++ai)
#pragma unroll
            for (int m = 0; m < 4; ++m) { f32x4 r[2];
#pragma unroll
                for (int n = 0; n < 2; ++n) { const f32x4 g = acc[ai][0][m][n], up = acc[ai][1][m][n];
#pragma unroll
                    for (int i = 0; i < 4; ++i) { const float e = __builtin_amdgcn_exp2f(g[i] * -1.4426950408889634f); r[n][i] = g[i] * __builtin_amdgcn_rcpf(1.f + e) * up[i]; } }
                *(u32x4*)(O + (size_t)(row0 + ai * HALF + m * 16) * 1024 + col0) = pack8_bf16(r[0], r[1]); }
    }
};
struct EpiDown {
    static constexpr bool PERM = true, AFTER_DRAIN = false;
    bf16_t* O;
    __device__ __forceinline__ void operator()(const f32x4 (&acc)[2][2][4][2], const Unit& u, int wr, int wc, int fr, int fq) const {
        const int row0 = u.pm * BM + wr * 64 + fr, col0 = (u.pn & 7) * BM + wc * 32 + 8 * fq;
#pragma unroll
        for (int ai = 0; ai < 2; ++ai)
#pragma unroll
            for (int m = 0; m < 4; ++m) { bf16_t* rowp = O + (size_t)(row0 + ai * HALF + m * 16) * 2048 + col0;
#pragma unroll
                for (int bj = 0; bj < 2; ++bj) *(u32x4*)(rowp + bj * HALF) = pack8_bf16(acc[ai][bj][m][0], acc[ai][bj][m][1]); }
    }
};
#ifndef PROBE_MFMA2
#define PROBE_MFMA2 0
#endif
constexpr float W8_SCALE = 64.f, ACT8_SCALE = 4.f, W8_UNDO = W8_SCALE * (PROBE_MFMA2 ? 2.f : 1.f);
__device__ __forceinline__ unsigned pack4_fp8(float a, float b, float c, float d) { int w; asm volatile("" : "=v"(w));
    w = __builtin_amdgcn_cvt_pk_fp8_f32(a, b, w, false); w = __builtin_amdgcn_cvt_pk_fp8_f32(c, d, w, true); return (unsigned)w; }
struct EpiGateUp8 {
    static constexpr bool PERM = true, AFTER_DRAIN = false;
    unsigned char* O;
    __device__ __forceinline__ void operator()(const f32x4 (&acc)[2][2][4][2], const Unit& u, int wr, int wc, int fr, int fq) const {
        const int row0 = u.pm * BM + wr * 64 + fr, col0 = (u.pn & 7) * 128 + wc * 32 + 8 * fq;
        constexpr float SI = 1.f / W8_UNDO;
#pragma unroll
        for (int ai = 0; ai < 2; ++ai)
#pragma unroll
            for (int m = 0; m < 4; ++m) { f32x4 r[2];
#pragma unroll
                for (int n = 0; n < 2; ++n) { const f32x4 g = acc[ai][0][m][n] * SI, up = acc[ai][1][m][n] * (SI * ACT8_SCALE);
#pragma unroll
                    for (int i = 0; i < 4; ++i) { const float e = __builtin_amdgcn_exp2f(g[i] * -1.4426950408889634f); r[n][i] = g[i] * __builtin_amdgcn_rcpf(1.f + e) * up[i]; } }
                u32x2 w; w.x = pack4_fp8(r[0][0], r[0][1], r[0][2], r[0][3]); w.y = pack4_fp8(r[1][0], r[1][1], r[1][2], r[1][3]);
                *(u32x2*)(O + (size_t)(row0 + ai * HALF + m * 16) * 1024 + col0) = w; }
    }
};
constexpr float YD8_SCALE = 16.f;
struct EpiDown8 {
    static constexpr bool PERM = true, AFTER_DRAIN = false;
    unsigned char* O;
    __device__ __forceinline__ void operator()(const f32x4 (&acc)[2][2][4][2], const Unit& u, int wr, int wc, int fr, int fq) const {
        const int row0 = u.pm * BM + wr * 64 + fr, col0 = (u.pn & 7) * BM + wc * 32 + 8 * fq;
        constexpr float SI = YD8_SCALE / (W8_UNDO * ACT8_SCALE);
#pragma unroll
        for (int ai = 0; ai < 2; ++ai)
#pragma unroll
            for (int m = 0; m < 4; ++m) { unsigned char* rowp = O + (size_t)(row0 + ai * HALF + m * 16) * 2048 + col0;
#pragma unroll
                for (int bj = 0; bj < 2; ++bj) { const f32x4 a = acc[ai][bj][m][0] * SI, c = acc[ai][bj][m][1] * SI; u32x2 w; w.x = pack4_fp8(a[0], a[1], a[2], a[3]); w.y = pack4_fp8(c[0], c[1], c[2], c[3]);
                    *(u32x2*)(rowp + bj * HALF) = w; } }
    }
};
template <int ROLE> struct MoeOrder {
    int nunits, G, c; const PG8_LAS int* tile_e; unsigned* cnt; unsigned* tmo; int wave;
    __device__ __forceinline__ bool next(int i, Unit& u) const {
        const int cc = (ROLE == 2) ? G - 1 - c : c; int idx;
        if ((G & 7) == 0) { const int per = G >> 3; idx = (i * 8 + (cc & 7)) * per + (cc >> 3); } else idx = i * G + cc;
        if (idx >= nunits) return false;
        const int mt = idx >> 3; u.pm = mt; u.pn = tile_e[mt] * 8 + (idx & 7); return true;
    }
    __device__ __forceinline__ void a_ready(const Unit& u) const {
        if constexpr (ROLE == 2) {
            if (wave == 0) { const bool lane0 = (tid_from_wave(0) == 0);
                const unsigned long long t0 = __builtin_amdgcn_s_memrealtime(); unsigned polls = 0;
                while ((unsigned)__builtin_amdgcn_readfirstlane(__hip_atomic_load(cnt + 64 * u.pm, __ATOMIC_RELAXED, __HIP_MEMORY_SCOPE_AGENT)) < 64u) {
                    if ((++polls & 255u) == 0u && __builtin_amdgcn_readfirstlane(__hip_atomic_load(tmo, __ATOMIC_RELAXED, __HIP_MEMORY_SCOPE_AGENT)) != 0u) break;
                    if (__builtin_amdgcn_s_memrealtime() - t0 > 2000000ull) { if (lane0) __hip_atomic_store(tmo, 1u, __ATOMIC_RELAXED, __HIP_MEMORY_SCOPE_AGENT); break; }
                    __builtin_amdgcn_s_sleep(2); }
                __builtin_amdgcn_fence(__ATOMIC_ACQUIRE, "agent");
                asm volatile("s_waitcnt vmcnt(0)" ::: "memory");
            }
            asm volatile("" ::: "memory"); __builtin_amdgcn_s_barrier(); asm volatile("" ::: "memory");
        }
    }
    __device__ __forceinline__ void done(const Unit& u) const {
        if constexpr (ROLE == 1) {
            asm volatile("s_waitcnt vmcnt(0)" ::: "memory");
            if (tid_from_wave(0) == 0) __hip_atomic_fetch_add(cnt + 64 * u.pm, 1u, __ATOMIC_RELAXED, __HIP_MEMORY_SCOPE_AGENT);
        }
    }
};

#ifndef PROBE_MFMA2
#define PROBE_MFMA2 0
#endif
template <class Epi, class Sched, bool ALIGN_EPI = false, bool SP2 = false, bool F8 = false, bool F16 = false>
__device__ __forceinline__ void gemm_phase(PG8_LAS unsigned char* lds, const Gemm g, const Sched& S, const Epi& E) {
    int tid_ = tid_from_wave(g.wave); asm volatile("" : "+v"(tid_));
    const int tid = tid_, wid = __builtin_amdgcn_readfirstlane(tid >> 6), lane = tid & 63, wr = wid >> 2, wc = wid & 3, fr = lane & 15, fq = lane >> 4;
    const int K = g.K, LD = g.ld, nt = K / BK;
    unsigned voffA, voffB;
    { int R, C; stage_rc(tid * 16, R, C); const int Rb = Epi::PERM ? ((R & ~31) + perm32(R & 31)) : R;
        voffA = (unsigned)(R * LD + C) * 2u; voffB = (unsigned)(Rb * LD + C) * 2u; }
    const size_t pstep = (size_t)64 * LD * 2;
    const size_t kstep = (size_t)(BK * 2);
    const size_t hstep = (size_t)HALF * LD * 2;
    const size_t tstep = 2 * hstep;
    const unsigned ldsbase = (unsigned)(uintptr_t)lds;
    const unsigned ldsw = (unsigned)wid * 1024u;
    const int aoff = lds_byte(wr * 64 + fr, fq * 8), boff = lds_byte(wc * 32 + fr, fq * 8);
#define PG8_SA(b, h) (((b) * 2 + (h)) * HTB)
#define PG8_SB(b, h) ((4 + (b) * 2 + (h)) * HTB)
#define PG8_STAGE(bufoff, gbase, voff) do { _Pragma("unroll") for (int _i = 0; _i < 2; ++_i) { unsigned keep_; \
        asm volatile("s_mov_b32 %0, m0\n\ts_mov_b32 m0, %3\n\ts_nop 0\n\tglobal_load_lds_dwordx4 %1, %2\n\ts_mov_b32 m0, %0" : "=&s"(keep_) \
            : "v"(voff), "s"((const char*)(gbase) + _i * pstep), "s"(ldsbase + (unsigned)(bufoff) + ldsw + (unsigned)(_i * 8192))); } } while (0)
#define PG8_CAT(a, b) __builtin_bit_cast(pg8_v8i, __builtin_shufflevector(a, b, 0, 1, 2, 3, 4, 5, 6, 7, 8, 9, 10, 11, 12, 13, 14, 15))
#define PG8_LDA(dst, b, h) do { if constexpr (F8) { _Pragma("unroll") for (int m = 0; m < 4; ++m) { const bf16x8 lo_ = *(const PG8_LAS bf16x8*)(lds + PG8_SA(b, h) + aoff + m * 2048), hi_ = *(const PG8_LAS bf16x8*)(lds + PG8_SA(b, h) + aoff + m * 2048 + 1024); dst##8[m] = PG8_CAT(lo_, hi_); } } \
        else { _Pragma("unroll") for (int m = 0; m < 4; ++m) _Pragma("unroll") for (int k = 0; k < 2; ++k) dst[m][k] = *(const PG8_LAS bf16x8*)(lds + PG8_SA(b, h) + aoff + m * 2048 + k * 1024); } } while (0)
#define PG8_LDB(dst, b, h) do { if constexpr (F8) { _Pragma("unroll") for (int n = 0; n < 2; ++n) { const bf16x8 lo_ = *(const PG8_LAS bf16x8*)(lds + PG8_SB(b, h) + boff + n * 2048), hi_ = *(const PG8_LAS bf16x8*)(lds + PG8_SB(b, h) + boff + n * 2048 + 1024); dst##8[n] = PG8_CAT(lo_, hi_); } } \
        else { _Pragma("unroll") for (int n = 0; n < 2; ++n) _Pragma("unroll") for (int k = 0; k < 2; ++k) dst[n][k] = *(const PG8_LAS bf16x8*)(lds + PG8_SB(b, h) + boff + n * 2048 + k * 1024); } } while (0)
#define PG8_MMA(ai, bj, At, Bt) do { __builtin_amdgcn_s_setprio(1); \
        if constexpr (F8) { _Pragma("unroll") for (int m = 0; m < 4; ++m) _Pragma("unroll") for (int n = 0; n < 2; ++n) \
            { acc[ai][bj][m][n] = __builtin_amdgcn_mfma_scale_f32_16x16x128_f8f6f4(Bt##8[n], At##8[m], acc[ai][bj][m][n], 0, 0, 0, 0, 0, 0); \
              if (PROBE_MFMA2) acc[ai][bj][m][n] = __builtin_amdgcn_mfma_scale_f32_16x16x128_f8f6f4(Bt##8[n], At##8[m], acc[ai][bj][m][n], 0, 0, 0, 0, 0, 0); } } \
        else { _Pragma("unroll") for (int m = 0; m < 4; ++m) _Pragma("unroll") for (int n = 0; n < 2; ++n) _Pragma("unroll") for (int k = 0; k < 2; ++k) \
            acc[ai][bj][m][n] = F16 ? __builtin_amdgcn_mfma_f32_16x16x32_f16(__builtin_bit_cast(pg8_h8, Bt[n][k]), __builtin_bit_cast(pg8_h8, At[m][k]), acc[ai][bj][m][n], 0, 0, 0) \
                                    : __builtin_amdgcn_mfma_f32_16x16x32_bf16(Bt[n][k], At[m][k], acc[ai][bj][m][n], 0, 0, 0); } \
        __builtin_amdgcn_s_setprio(0); } while (0)
#define PG8_WAIT_V(n) asm volatile("s_waitcnt vmcnt(" #n ")" ::: "memory")
#define PG8_WAIT_L(n) asm volatile("s_waitcnt lgkmcnt(" #n ")" ::: "memory")
#define PG8_BAR __builtin_amdgcn_s_barrier()
#define PG8_SCHED __builtin_amdgcn_sched_barrier(0)
    Unit cur, nxt; int ui = 0;
    if (!S.next(0, cur)) return;
    f32x4 acc[2][2][4][2];
{ float zero_; asm volatile("v_mov_b32 %0, 0" : "=v"(zero_));
#pragma unroll
    for (int a = 0; a < 2; ++a)
#pragma unroll
        for (int b = 0; b < 2; ++b)
#pragma unroll
            for (int m = 0; m < 4; ++m)
#pragma unroll
                for (int n = 0; n < 2; ++n) acc[a][b][m][n] = (f32x4){zero_, zero_, zero_, zero_}; }
    bf16x8 At[4][2], B0[2][2], B1[2][2]; pg8_v8i At8[4], B08[2], B18[2];
    const char* cA = (const char*)g.A + (size_t)cur.pm * tstep; const char* cB = (const char*)g.Bt + (size_t)cur.pn * tstep;
    S.a_ready(cur);
    if constexpr (SP2) {
        PG8_STAGE(PG8_SB(0, 0), cB, voffB); PG8_STAGE(PG8_SB(0, 1), cB + hstep, voffB); PG8_STAGE(PG8_SA(0, 0), cA, voffA); PG8_STAGE(PG8_SA(0, 1), cA + hstep, voffA);
        if (wr == 1) PG8_BAR;
        PG8_WAIT_V(2); PG8_BAR;
        PG8_STAGE(PG8_SB(1, 0), cB + kstep, voffB); PG8_STAGE(PG8_SA(1, 0), cA + kstep, voffA); PG8_STAGE(PG8_SB(1, 1), cB + hstep + kstep, voffB);
        PG8_WAIT_V(6); PG8_BAR;
    } else {
        PG8_STAGE(PG8_SB(0, 0), cB, voffB); PG8_STAGE(PG8_SA(0, 0), cA, voffA); PG8_STAGE(PG8_SB(0, 1), cB + hstep, voffB); PG8_STAGE(PG8_SA(0, 1), cA + hstep, voffA);
        if (wr == 1) PG8_BAR;
        PG8_WAIT_V(4); PG8_BAR;
        PG8_STAGE(PG8_SB(1, 0), cB + kstep, voffB); PG8_STAGE(PG8_SA(1, 0), cA + kstep, voffA); PG8_STAGE(PG8_SB(1, 1), cB + hstep + kstep, voffB);
        PG8_WAIT_V(6); PG8_BAR;
    }
    for (;;) {
        const bool has_next = S.next(ui + 1, nxt);
        const char* nA = has_next ? (const char*)g.A + (size_t)nxt.pm * tstep : cA; const char* nB = has_next ? (const char*)g.Bt + (size_t)nxt.pn * tstep : cB;
#pragma unroll 1
        for (int t = 0; t < nt; t += 2) {
            const bool last = (t == nt - 2);
            const char* a1 = cA + (size_t)(t + 1) * kstep;
            const char* a2 = last ? nA : cA + (size_t)(t + 2) * kstep; const char* b2 = last ? nB : cB + (size_t)(t + 2) * kstep;
            const char* a3 = a2 + kstep; const char* b3 = b2 + kstep;
            if (last && has_next) S.a_ready(nxt);
            if constexpr (SP2) {
            PG8_LDB(B0, 0, 0); PG8_LDB(B1, 0, 1); PG8_SCHED; PG8_LDA(At, 0, 0); PG8_STAGE(PG8_SA(1, 1), a1 + hstep, voffA);
            PG8_WAIT_V(8); PG8_WAIT_L(0); PG8_BAR; PG8_MMA(0, 0, At, B0); PG8_MMA(0, 1, At, B1); PG8_BAR; PG8_SCHED;
            PG8_LDA(At, 0, 1); PG8_STAGE(PG8_SB(0, 0), b2, voffB); PG8_STAGE(PG8_SB(0, 1), b2 + hstep, voffB); PG8_STAGE(PG8_SA(0, 0), a2, voffA);
            PG8_WAIT_V(8); PG8_WAIT_L(0); PG8_BAR; PG8_MMA(1, 0, At, B0); PG8_MMA(1, 1, At, B1); PG8_BAR; PG8_SCHED;
            PG8_LDB(B0, 1, 0); PG8_LDB(B1, 1, 1); PG8_SCHED; PG8_LDA(At, 1, 0); PG8_STAGE(PG8_SA(0, 1), a2 + hstep, voffA);
            PG8_WAIT_V(8); PG8_WAIT_L(0); PG8_BAR; PG8_MMA(0, 0, At, B0); PG8_MMA(0, 1, At, B1); PG8_BAR; PG8_SCHED;
            PG8_LDA(At, 1, 1); PG8_STAGE(PG8_SB(1, 0), b3, voffB); PG8_STAGE(PG8_SB(1, 1), b3 + hstep, voffB); PG8_STAGE(PG8_SA(1, 0), a3, voffA);
            PG8_WAIT_V(8); PG8_WAIT_L(0); PG8_BAR; PG8_MMA(1, 0, At, B0); PG8_MMA(1, 1, At, B1); PG8_BAR; PG8_SCHED;
            } else {
            PG8_LDB(B0, 0, 0); PG8_SCHED; PG8_LDA(At, 0, 0); PG8_STAGE(PG8_SA(1, 1), a1 + hstep, voffA);
            PG8_WAIT_L(8); PG8_BAR; PG8_WAIT_L(0); PG8_MMA(0, 0, At, B0); PG8_BAR; PG8_SCHED;
            PG8_LDB(B1, 0, 1); PG8_STAGE(PG8_SB(0, 0), b2, voffB);
            PG8_BAR; PG8_WAIT_L(0); PG8_MMA(0, 1, At, B1); PG8_BAR;
            PG8_LDA(At, 0, 1); PG8_STAGE(PG8_SA(0, 0), a2, voffA);
            PG8_BAR; PG8_WAIT_L(0); PG8_MMA(1, 0, At, B0); PG8_BAR; PG8_SCHED;
            PG8_STAGE(PG8_SB(0, 1), b2 + hstep, voffB);
            PG8_WAIT_V(6); PG8_BAR; PG8_MMA(1, 1, At, B1); PG8_BAR;
            PG8_LDB(B0, 1, 0); PG8_SCHED; PG8_LDA(At, 1, 0); PG8_STAGE(PG8_SA(0, 1), a2 + hstep, voffA);
            PG8_WAIT_L(8); PG8_BAR; PG8_WAIT_L(0); PG8_MMA(0, 0, At, B0); PG8_BAR; PG8_SCHED;
            PG8_LDB(B1, 1, 1); PG8_STAGE(PG8_SB(1, 0), b3, voffB);
            PG8_BAR; PG8_WAIT_L(0); PG8_MMA(0, 1, At, B1); PG8_BAR;
            PG8_LDA(At, 1, 1); PG8_STAGE(PG8_SA(1, 0), a3, voffA);
            PG8_BAR; PG8_WAIT_L(0); PG8_MMA(1, 0, At, B0); PG8_BAR; PG8_SCHED;
            PG8_STAGE(PG8_SB(1, 1), b3 + hstep, voffB);
            PG8_WAIT_V(6); PG8_BAR; PG8_MMA(1, 1, At, B1); PG8_BAR;
            }
        }
        if constexpr (ALIGN_EPI) { if (wr == 0) PG8_BAR; }
        if constexpr (!Epi::AFTER_DRAIN) { const int t2_ = tid_from_wave(g.wave);
            E(acc, cur, wr, wc, t2_ & 15, (t2_ >> 4) & 3); S.done(cur); }
        if (!has_next) break;
{ float zero_; asm volatile("v_mov_b32 %0, 0" : "=v"(zero_));
#pragma unroll
        for (int a = 0; a < 2; ++a)
#pragma unroll
            for (int b = 0; b < 2; ++b)
#pragma unroll
                for (int m = 0; m < 4; ++m)
#pragma unroll
                    for (int n = 0; n < 2; ++n) acc[a][b][m][n] = (f32x4){zero_, zero_, zero_, zero_}; }
        cur = nxt; cA = nA; cB = nB; ++ui;
        if constexpr (ALIGN_EPI) { if (wr == 1) PG8_BAR; }
    }
    PG8_WAIT_V(0);
    if constexpr (!ALIGN_EPI) { if (wr == 0) PG8_BAR; }
    PG8_BAR;
    if constexpr (Epi::AFTER_DRAIN) { E.fused(acc, cur, wr, wc, fr, fq, lds, wid, lane); S.done(cur); }
#undef PG8_SA
#undef PG8_SB
#undef PG8_STAGE
#undef PG8_LDA
#undef PG8_LDB
#undef PG8_MMA
#undef PG8_CAT
#undef PG8_WAIT_V
#undef PG8_WAIT_L
#undef PG8_BAR
#undef PG8_SCHED
}
}

namespace att {
#define ALAS __attribute__((address_space(3)))
typedef unsigned short bf16_t;
typedef short bf16x8 __attribute__((ext_vector_type(8)));
typedef short s16x4 __attribute__((ext_vector_type(4)));
typedef float f32x16 __attribute__((ext_vector_type(16)));
typedef float f32x4 __attribute__((ext_vector_type(4)));
typedef unsigned u32x4 __attribute__((ext_vector_type(4)));
typedef ALAS char* ldsp;
#ifndef WO_F8
#define WO_F8 1
#endif
constexpr float OB8_SCALE = 8.f;
constexpr int QP = 6144;
constexpr int OP = 2048;
constexpr int OBP = 2048;
constexpr int SHM_V = 16384, SHM_K = 16384;
constexpr int LDS_V = 0, LDS_K = 2 * SHM_V, LDS_WS = LDS_K + 2 * SHM_K, ATT_LDS_BYTES = LDS_WS + 8 * 256;
#define KSWZ(row, colB) ((row) * 256 + ((colB) ^ (((row) & 7) << 4)))
#define KSWZ64(row, colB) ((row) * 128 + ((colB) ^ (((row) & 7) << 4)))
#define SBAR() __builtin_amdgcn_sched_barrier(0)
__device__ __forceinline__ int v_st(int k, int c) { const int kk = (k & ~0xC) | ((k & 4) << 1) | ((k & 8) >> 1); return ((kk >> 3) * 4 + (c >> 5)) * 512 + ((kk & 7) * 32 + (c & 31)) * 2; }
__device__ __forceinline__ int v_rd_base(int lane) { return ((lane & 3) << 3) | (((lane >> 2) & 3) << 6) | (((lane >> 4) & 1) << 5) | (((lane >> 5) & 1) << 8); }
constexpr int v_rd_off(int d0, int ks, int half) { return d0 * 512 + ks * 4096 + half * 2048; }
__device__ __forceinline__ int crow(int r, int hi) { return (r & 3) + 8 * (r >> 2) + 4 * hi; }
__device__ __forceinline__ unsigned cvtpk(float lo, float hi) { unsigned r; asm volatile("v_cvt_pk_bf16_f32 %0, %1, %2" : "=v"(r) : "v"(lo), "v"(hi)); return r; }
__device__ __forceinline__ bf16x8 ldg8(const bf16_t* p) { return *reinterpret_cast<const bf16x8*>(p); }
__device__ __forceinline__ unsigned quad_pack_fp8(float v) {
    const int b = __builtin_bit_cast(int, v);
    const float v1 = __builtin_bit_cast(float, __builtin_amdgcn_update_dpp(b, b, 0x55, 0xf, 0xf, false));
    const float v2 = __builtin_bit_cast(float, __builtin_amdgcn_update_dpp(b, b, 0xAA, 0xf, 0xf, false));
    const float v3 = __builtin_bit_cast(float, __builtin_amdgcn_update_dpp(b, b, 0xFF, 0xf, 0xf, false));
    int w; asm volatile("" : "=v"(w));
    w = __builtin_amdgcn_cvt_pk_fp8_f32(v, v1, w, false); w = __builtin_amdgcn_cvt_pk_fp8_f32(v2, v3, w, true); return (unsigned)w;
}
__device__ __forceinline__ float xhalf(float v, int hi) {
    auto rr = __builtin_amdgcn_permlane32_swap(__float_as_uint(v), __float_as_uint(v), false, false);
    return __uint_as_float(hi ? rr[0] : rr[1]);
}
#define ATT_PK4(P, B_, OUT) do { unsigned a0 = cvtpk(P[B_+0], P[B_+1]), a1 = cvtpk(P[B_+2], P[B_+3]);                      \
        unsigned b0 = cvtpk(P[B_+4], P[B_+5]), b1 = cvtpk(P[B_+6], P[B_+7]);                                             \
        auto r0 = __builtin_amdgcn_permlane32_swap(a0, b0, false, false); auto r1 = __builtin_amdgcn_permlane32_swap(a1, b1, false, false); \
        u32x4 w = {r0[0], r1[0], r0[1], r1[1]}; OUT = *reinterpret_cast<bf16x8*>(&w); } while (0)
__device__ __forceinline__ void pv_tile(f32x16* o, int vb, bf16x8 pa0, bf16x8 pa1, bf16x8 pa2, bf16x8 pa3) {
#define TRRD(dst, off) asm volatile("ds_read_b64_tr_b16 %0, %1 offset:%2" : "=&v"(dst) : "v"(vb), "i"(off) : "memory")
#define PV_D0(d0) do { s16x4 l0, l1, l2, l3, h0, h1, h2, h3; constexpr int b_ = v_rd_off(d0, 0, 0); \
        TRRD(l0, b_); TRRD(h0, b_ + 2048); TRRD(l1, b_ + 4096); TRRD(h1, b_ + 6144); TRRD(l2, b_ + 8192); TRRD(h2, b_ + 10240); TRRD(l3, b_ + 12288); TRRD(h3, b_ + 14336); \
        asm volatile("s_waitcnt lgkmcnt(0)" ::: "memory"); SBAR(); \
        o[d0] = __builtin_amdgcn_mfma_f32_32x32x16_bf16(pa0, (bf16x8){l0[0], l0[1], l0[2], l0[3], h0[0], h0[1], h0[2], h0[3]}, o[d0], 0, 0, 0);   \
        o[d0] = __builtin_amdgcn_mfma_f32_32x32x16_bf16(pa1, (bf16x8){l1[0], l1[1], l1[2], l1[3], h1[0], h1[1], h1[2], h1[3]}, o[d0], 0, 0, 0);   \
        o[d0] = __builtin_amdgcn_mfma_f32_32x32x16_bf16(pa2, (bf16x8){l2[0], l2[1], l2[2], l2[3], h2[0], h2[1], h2[2], h2[3]}, o[d0], 0, 0, 0);   \
        o[d0] = __builtin_amdgcn_mfma_f32_32x32x16_bf16(pa3, (bf16x8){l3[0], l3[1], l3[2], l3[3], h3[0], h3[1], h3[2], h3[3]}, o[d0], 0, 0, 0); } while (0)
    PV_D0(0); PV_D0(1); PV_D0(2); PV_D0(3);
#undef PV_D0
#undef TRRD
}

__device__ __forceinline__ void sb_block(const bf16_t* __restrict__ Qg, const bf16_t* __restrict__ Kg, const bf16_t* __restrict__ Vg, bf16_t* __restrict__ Og, int qb, ldsp lds, int wave_) {
    int tid_ = tid_from_wave(wave_); asm volatile("" : "+v"(tid_));
    const int tid = tid_, wid = __builtin_amdgcn_readfirstlane(tid >> 6), lane = tid & 63, r32 = lane & 31, hi = lane >> 5;
    const int NT = 4 * qb + 4, R0 = 256 * qb + 32 * wid, myrow = R0 + r32;
    const ldsp V_lds = lds + LDS_V; const ldsp K_lds = lds + LDS_K;
    bf16x8 qr[8];
    { const bf16_t* Qw = Qg + (size_t)R0 * QP; const unsigned qoff = (unsigned)(r32 * QP + hi * 8);
#pragma unroll
      for (int d0 = 0; d0 < 8; ++d0) qr[d0] = ldg8(Qw + (qoff + d0 * 16)); }
    const int sr = tid >> 4, sc = (tid & 15) * 8, kws = KSWZ(sr, sc * 2), vst0 = v_st(sr, sc), vst1 = v_st(32 + sr, sc);
    const unsigned kvoff = (unsigned)(sr * QP + sc);
    const int vb0 = (int)(unsigned)(uintptr_t)V_lds + v_rd_base(lane);
    bf16x8 sk0, sk1, sv0, sv1;
#define SB_LOAD(j) do { const bf16_t* kp_ = Kg + (size_t)(64 * (j)) * QP; const bf16_t* vp_ = Vg + (size_t)(64 * (j)) * QP; \
        sk0 = ldg8(kp_ + kvoff); sk1 = ldg8(kp_ + (size_t)32 * QP + kvoff); sv0 = ldg8(vp_ + kvoff); sv1 = ldg8(vp_ + (size_t)32 * QP + kvoff); } while (0)
#define SB_WRITE(bf) do { *(ALAS bf16x8*)(K_lds + (bf) * SHM_K + kws) = sk0; *(ALAS bf16x8*)(K_lds + (bf) * SHM_K + kws + 32 * 256) = sk1; \
        *(ALAS bf16x8*)(V_lds + (bf) * SHM_V + vst0) = sv0; *(ALAS bf16x8*)(V_lds + (bf) * SHM_V + vst1) = sv1; } while (0)
    SB_LOAD(NT - 1); SB_WRITE(0);
    __syncthreads();
    float carry = 0.f; f32x16 o[4] = {};
    ALAS int* fl = (ALAS int*)(lds + LDS_WS); bool wdone = false;
    for (int t = 0; t < NT; ++t) {
        const int j = NT - 1 - t, buf = t & 1, kb = 64 * j;
        if (t + 1 < NT) SB_LOAD(j - 1);
        if (kb <= R0 + 30 && !wdone) {
            f32x16 p0 = {}, p1 = {};
            { const ldsp Kb = K_lds + buf * SHM_K;
#pragma unroll
              for (int d0 = 0; d0 < 8; ++d0) { const ldsp a = Kb + KSWZ(r32, ((d0 & 3) * 16 + hi * 8) * 2) + (d0 >> 2) * 128;
                  const bf16x8 b0 = *(const ALAS bf16x8*)a, b1 = *(const ALAS bf16x8*)(a + 32 * 256);
                  p0 = __builtin_amdgcn_mfma_f32_32x32x16_bf16(b0, qr[d0], p0, 0, 0, 0);
                  p1 = __builtin_amdgcn_mfma_f32_32x32x16_bf16(b1, qr[d0], p1, 0, 0, 0); } }
            f32x16 lb0, lb1;
#pragma unroll
            for (int r = 0; r < 16; ++r) {
                { const float z = p0[r]; const float e = __builtin_amdgcn_exp2f(-__builtin_fabsf(z)); const float sp = __builtin_fmaxf(z, 0.f) + __builtin_amdgcn_logf(1.f + e); p0[r] = -sp; lb0[r] = z - sp; }
                { const float z = p1[r]; const float e = __builtin_amdgcn_exp2f(-__builtin_fabsf(z)); const float sp = __builtin_fmaxf(z, 0.f) + __builtin_amdgcn_logf(1.f + e); p1[r] = -sp; lb1[r] = z - sp; }
            }
            if (kb + 63 >= R0) {
                const int dq = myrow - kb - 4 * hi; const float NEG = -__builtin_inff();
#pragma unroll
                for (int r = 0; r < 16; ++r) { const int c = (r & 3) + 8 * (r >> 2);
                    if (c >= dq) { p0[r] = 0.f; lb0[r] = NEG; }
                    if (c + 32 >= dq) { p1[r] = 0.f; lb1[r] = NEG; } }
            }
            float gs[8], go[8];
#pragma unroll
            for (int g = 0; g < 4; ++g) { gs[g] = (p0[4 * g] + p0[4 * g + 1]) + (p0[4 * g + 2] + p0[4 * g + 3]); gs[4 + g] = (p1[4 * g] + p1[4 * g + 1]) + (p1[4 * g + 2] + p1[4 * g + 3]); }
#pragma unroll
            for (int i = 0; i < 8; ++i) go[i] = xhalf(gs[i], hi);
            float acc = carry;
#pragma unroll
            for (int idx = 7; idx >= 0; --idx) { const int g = idx & 3; const float base = acc + (hi ? 0.f : go[idx]);
                if (idx >= 4) { const float t3 = base, t2 = t3 + p1[4 * g + 3], t1 = t2 + p1[4 * g + 2], t0 = t1 + p1[4 * g + 1];
                    lb1[4 * g + 3] = __builtin_amdgcn_exp2f(lb1[4 * g + 3] + t3); lb1[4 * g + 2] = __builtin_amdgcn_exp2f(lb1[4 * g + 2] + t2);
                    lb1[4 * g + 1] = __builtin_amdgcn_exp2f(lb1[4 * g + 1] + t1); lb1[4 * g] = __builtin_amdgcn_exp2f(lb1[4 * g] + t0); }
                else { const float t3 = base, t2 = t3 + p0[4 * g + 3], t1 = t2 + p0[4 * g + 2], t0 = t1 + p0[4 * g + 1];
                    lb0[4 * g + 3] = __builtin_amdgcn_exp2f(lb0[4 * g + 3] + t3); lb0[4 * g + 2] = __builtin_amdgcn_exp2f(lb0[4 * g + 2] + t2);
                    lb0[4 * g + 1] = __builtin_amdgcn_exp2f(lb0[4 * g + 1] + t1); lb0[4 * g] = __builtin_amdgcn_exp2f(lb0[4 * g] + t0); }
                acc += gs[idx] + go[idx]; }
            carry = acc;
            bf16x8 pa0, pa1, pa2, pa3;
            ATT_PK4(lb0, 0, pa0); ATT_PK4(lb0, 8, pa1); ATT_PK4(lb1, 0, pa2); ATT_PK4(lb1, 8, pa3);
            SBAR();
            pv_tile(o, vb0 + buf * SHM_V, pa0, pa1, pa2, pa3);
            wdone = __all(carry < -127.f);
        }
        if (lane == 0) fl[buf * 8 + wid] = wdone ? 1 : 0;
        if (t + 1 < NT) SB_WRITE(buf ^ 1);
        __syncthreads();
        { const ALAS int* f = fl + buf * 8; if ((f[0] & f[1] & f[2] & f[3] & f[4] & f[5] & f[6] & f[7]) != 0) break; }
    }
#undef SB_LOAD
#undef SB_WRITE
#if WO_F8
    unsigned char* Ow = (unsigned char*)Og + (size_t)R0 * OBP; const unsigned ooff = (unsigned)(4 * hi * OBP + r32);
#pragma unroll
    for (int r = 0; r < 16; ++r) { unsigned char* rowp = Ow + (size_t)((r & 3) + 8 * (r >> 2)) * OBP;
#pragma unroll
        for (int d0 = 0; d0 < 4; ++d0) { const unsigned w = quad_pack_fp8(o[d0][r] * OB8_SCALE);
            if ((r32 & 3) == 0) *(unsigned*)(rowp + (ooff + d0 * 32)) = w; } }
#else
    bf16_t* Ow = Og + (size_t)R0 * OP; const unsigned ooff = (unsigned)(4 * hi * OP + r32);
#pragma unroll
    for (int r = 0; r < 16; ++r) { bf16_t* rowp = Ow + (size_t)((r & 3) + 8 * (r >> 2)) * OP;
#pragma unroll
        for (int d0 = 0; d0 < 4; ++d0) { const float v = o[d0][r]; const float vn = __shfl_xor(v, 1);
            if ((r32 & 1) == 0) *(unsigned*)(rowp + (ooff + d0 * 32)) = cvtpk(v, vn); } }
#endif
}

constexpr float ATT_THR = 8.f;
__device__ __forceinline__ void qkt64(f32x16& p0, f32x16& p1, ldsp Kb, int r32, int hi, const bf16x8* qr) {
    p0 = f32x16{}; p1 = f32x16{};
#pragma unroll
    for (int d0 = 0; d0 < 4; ++d0) { const ldsp a = Kb + KSWZ64(r32, (d0 * 16 + hi * 8) * 2);
        const bf16x8 b0 = *(const ALAS bf16x8*)a, b1 = *(const ALAS bf16x8*)(a + 32 * 128);
        p0 = __builtin_amdgcn_mfma_f32_32x32x16_bf16(b0, qr[d0], p0, 0, 0, 0);
        p1 = __builtin_amdgcn_mfma_f32_32x32x16_bf16(b1, qr[d0], p1, 0, 0, 0); }
}
__device__ __forceinline__ void partial_sm(f32x16& p0, f32x16& p1, float& m_reg, float& alpha, int hi) {
    float pmax = p0[0];
#pragma unroll
    for (int r = 1; r < 16; ++r) pmax = __builtin_fmaxf(pmax, p0[r]);
#pragma unroll
    for (int r = 0; r < 16; ++r) pmax = __builtin_fmaxf(pmax, p1[r]);
    pmax = __builtin_fmaxf(pmax, xhalf(pmax, hi));
    float mn;
    if (__builtin_expect(__all(pmax - m_reg <= ATT_THR), 1)) { mn = m_reg; alpha = 1.f; }
    else { mn = __builtin_fmaxf(m_reg, pmax); alpha = __builtin_amdgcn_exp2f(m_reg - mn); m_reg = mn; }
#pragma unroll
    for (int r = 0; r < 16; ++r) { p0[r] -= mn; p1[r] -= mn; }
#pragma unroll
    for (int r = 0; r < 16; ++r) p0[r] = __builtin_amdgcn_exp2f(p0[r]);
}
__device__ __forceinline__ void finish_sm(f32x16& p0, f32x16& p1, float alpha, float& l_reg, bf16x8& pa0, bf16x8& pa1, bf16x8& pa2, bf16x8& pa3, int hi) {
#pragma unroll
    for (int r = 0; r < 16; ++r) p1[r] = __builtin_amdgcn_exp2f(p1[r]);
    float ps = 0.f;
#pragma unroll
    for (int r = 0; r < 16; ++r) ps += p0[r];
#pragma unroll
    for (int r = 0; r < 16; ++r) ps += p1[r];
    ps += xhalf(ps, hi);
    l_reg = l_reg * alpha + ps;
    ATT_PK4(p0, 0, pa0); ATT_PK4(p0, 8, pa1); ATT_PK4(p1, 0, pa2); ATT_PK4(p1, 8, pa3);
}
__device__ __forceinline__ void mask_gt(f32x16& p0, f32x16& p1, int dq) {
    const float NEG = -__builtin_inff();
#pragma unroll
    for (int r = 0; r < 16; ++r) { const int c = (r & 3) + 8 * (r >> 2);
        if (c > dq) p0[r] = NEG;
        if (c + 32 > dq) p1[r] = NEG; }
}
template <bool SECOND>
__device__ __forceinline__ void diff_pass(const bf16_t* __restrict__ Qg, const bf16_t* __restrict__ Kg, const bf16_t* __restrict__ Vg, float* S1, bf16_t* __restrict__ Og,
                                          int qb, float lam, const float* __restrict__ gsub, float gmul, ldsp lds, int wave_) {
    int tid_ = tid_from_wave(wave_); asm volatile("" : "+v"(tid_));
    const int tid = tid_, wid = __builtin_amdgcn_readfirstlane(tid >> 6), lane = tid & 63, r32 = lane & 31, hi = lane >> 5;
    const int NT = 4 * qb + 4, R0 = 256 * qb + 32 * wid, myrow = R0 + r32;
    const ldsp V_lds = lds + LDS_V; const ldsp K_lds = lds + LDS_K;
    ALAS float* wsf = (ALAS float*)(lds + LDS_WS) + wid * 64; ALAS float* li_l = wsf; ALAS float* al_l = wsf + 32;
    bf16x8 qr[4];
    { const bf16_t* Qw = Qg + (size_t)R0 * QP; const unsigned qoff = (unsigned)(r32 * QP + hi * 8);
#pragma unroll
      for (int d0 = 0; d0 < 4; ++d0) qr[d0] = ldg8(Qw + (qoff + d0 * 16)); }
    const int sr = tid >> 4, sc = (tid & 15) * 8, vst0 = v_st(sr, sc), vst1 = v_st(32 + sr, sc);
    const int kr = tid >> 3, kc = (tid & 7) * 8, kws = KSWZ64(kr, kc * 2);
    const unsigned voff = (unsigned)(sr * QP + sc), koff = (unsigned)(kr * QP + kc);
    const int vb0 = (int)(unsigned)(uintptr_t)V_lds + v_rd_base(lane);
    const int qm = myrow - 4 * hi;
    bf16x8 sk0A, sv0A, sv1A, sk0B, sv0B, sv1B;
#define DF_LOAD(S_, j) do { const bf16_t* vp_ = Vg + (size_t)(64 * (j)) * QP; sk0##S_ = ldg8(Kg + (size_t)(64 * (j)) * QP + koff); sv0##S_ = ldg8(vp_ + voff); sv1##S_ = ldg8(vp_ + (size_t)32 * QP + voff); } while (0)
#define DF_WRITE(S_, bf) do { *(ALAS bf16x8*)(K_lds + (bf) * SHM_K + kws) = sk0##S_; *(ALAS bf16x8*)(V_lds + (bf) * SHM_V + vst0) = sv0##S_; *(ALAS bf16x8*)(V_lds + (bf) * SHM_V + vst1) = sv1##S_; } while (0)
#define DF_MASK(P0, P1, t) do { if (64 * (t) + 63 > R0) mask_gt(P0, P1, qm - 64 * (t)); } while (0)
#define DF_RESC(a) do { if (__any((a) < 1.f)) { if (hi == 0) al_l[r32] = (a); asm volatile("s_waitcnt lgkmcnt(0)" ::: "memory"); \
        _Pragma("unroll") for (int d_ = 0; d_ < 4; ++d_) _Pragma("unroll") for (int r = 0; r < 16; ++r) o[d_][r] *= al_l[crow(r, hi)]; } } while (0)
    float m_reg = -1e30f, l_reg = 0.f; f32x16 o[4] = {};
    f32x16 pA0, pA1, pB0, pB1; float alA = 1.f, alB = 1.f; bf16x8 pa0, pa1, pa2, pa3;
    DF_LOAD(A, 0); DF_WRITE(A, 0);
    __syncthreads();
    DF_LOAD(A, 1); DF_LOAD(B, 2);
    qkt64(pA0, pA1, K_lds, r32, hi, qr); DF_MASK(pA0, pA1, 0); partial_sm(pA0, pA1, m_reg, alA, hi);
    DF_WRITE(A, 1);
    DF_RESC(alA);
    __syncthreads();
#define DF_HALF(PX0, PX1, alX, PY0, PY1, alY, t, KB, VB, SB, LS, WS) do { \
        SBAR(); qkt64(PX0, PX1, K_lds + (KB) * SHM_K, r32, hi, qr); \
        finish_sm(PY0, PY1, alY, l_reg, pa0, pa1, pa2, pa3, hi); SBAR(); \
        if ((t) + 2 < NT) { DF_LOAD(LS, (t) + 2); SBAR(); } \
        pv_tile(o, vb0 + (VB) * SHM_V, pa0, pa1, pa2, pa3); DF_MASK(PX0, PX1, (t)); partial_sm(PX0, PX1, m_reg, alX, hi); \
        __syncthreads(); \
        if ((t) + 1 < NT) DF_WRITE(WS, SB); \
        DF_RESC(alX); __syncthreads(); } while (0)
    for (int t = 1; t + 1 < NT; t += 2) {
        DF_HALF(pB0, pB1, alB, pA0, pA1, alA, t, 1, 0, 0, A, B);
        DF_HALF(pA0, pA1, alA, pB0, pB1, alB, t + 1, 0, 1, 1, B, A);
    }
    DF_HALF(pB0, pB1, alB, pA0, pA1, alA, NT - 1, 1, 0, 0, A, B);
    finish_sm(pB0, pB1, alB, l_reg, pa0, pa1, pa2, pa3, hi); SBAR();
    pv_tile(o, vb0 + 1 * SHM_V, pa0, pa1, pa2, pa3);
#undef DF_LOAD
#undef DF_WRITE
#undef DF_MASK
#undef DF_RESC
#undef DF_HALF
    if (hi == 0) li_l[r32] = l_reg; asm volatile("s_waitcnt lgkmcnt(0)" ::: "memory");
    float rli[16];
#pragma unroll
    for (int r = 0; r < 16; ++r) rli[r] = __builtin_amdgcn_rcpf(li_l[crow(r, hi)]);
    if constexpr (!SECOND) {
        float* Sw = S1 + (size_t)R0 * OP; const unsigned ooff = (unsigned)(4 * hi * OP + r32);
#pragma unroll
        for (int r = 0; r < 16; ++r) { float* rowp = Sw + (size_t)((r & 3) + 8 * (r >> 2)) * OP;
#pragma unroll
            for (int d0 = 0; d0 < 4; ++d0) rowp[ooff + d0 * 32] = o[d0][r] * rli[r]; }
    } else {
        const float* Sw = S1 + (size_t)R0 * OP; bf16_t* Ow = Og + (size_t)R0 * OP; (void)Ow; const unsigned ooff = (unsigned)(4 * hi * OP + r32), ooff8 = (unsigned)(4 * hi * OBP + r32);
        float gn[4];
#pragma unroll
        for (int d0 = 0; d0 < 4; ++d0) gn[d0] = gsub[d0 * 32 + r32] * gmul;
#pragma unroll
        for (int r = 0; r < 16; ++r) { const float* srow = Sw + (size_t)((r & 3) + 8 * (r >> 2)) * OP; float d[4]; float ss = 0.f;
#if WO_F8
            unsigned char* orowp = (unsigned char*)Og + (size_t)(R0 + (r & 3) + 8 * (r >> 2)) * OBP;
#else
            bf16_t* orowp = Ow + (size_t)((r & 3) + 8 * (r >> 2)) * OP;
#endif
#pragma unroll
            for (int d0 = 0; d0 < 4; ++d0) { d[d0] = srow[ooff + d0 * 32] - lam * (o[d0][r] * rli[r]); ss += d[d0] * d[d0]; }
            ss += __builtin_bit_cast(float, __builtin_amdgcn_update_dpp(0, __builtin_bit_cast(int, ss), 0xB1, 0xf, 0xf, true));
            ss += __builtin_bit_cast(float, __builtin_amdgcn_update_dpp(0, __builtin_bit_cast(int, ss), 0x4E, 0xf, 0xf, true));
            ss += __builtin_bit_cast(float, __builtin_amdgcn_update_dpp(0, __builtin_bit_cast(int, ss), 0x141, 0xf, 0xf, true));
            ss += __builtin_bit_cast(float, __builtin_amdgcn_update_dpp(0, __builtin_bit_cast(int, ss), 0x140, 0xf, 0xf, true));
            { auto rr = __builtin_amdgcn_permlane16_swap(__float_as_uint(ss), __float_as_uint(ss), false, false); ss = __uint_as_float(rr[0]) + __uint_as_float(rr[1]); }
            const float rs = __builtin_amdgcn_rsqf(ss * (1.f / 128.f) + 1e-5f);
#pragma unroll
#if WO_F8
            for (int d0 = 0; d0 < 4; ++d0) { const unsigned w = quad_pack_fp8(d[d0] * rs * gn[d0] * OB8_SCALE);
                if ((r32 & 3) == 0) *(unsigned*)(orowp + (ooff8 + d0 * 32)) = w; }
#else
            for (int d0 = 0; d0 < 4; ++d0) { const float v = d[d0] * rs * gn[d0]; const float vn = __shfl_xor(v, 1);
                if ((r32 & 1) == 0) *(unsigned*)(orowp + (ooff + d0 * 32)) = cvtpk(v, vn); }
#endif
            if ((r & 1) == 1) asm volatile("" ::: "memory"); }
    }
    __syncthreads();
}

#ifndef D2_NEGM
#define D2_NEGM 1
#endif
constexpr int D2_SLK = 8192, D2_SLV = 16384, D2_K = 0, D2_V = 3 * D2_SLK, D2_WS = D2_V + 3 * D2_SLV, D2_S1 = D2_WS + 8 * 256, D2_LDS_BYTES = D2_S1 + 8 * 8192;
typedef __attribute__((address_space(3))) const char* lds_cptr;
typedef short v4i16_t __attribute__((ext_vector_type(4)));
typedef float f32x2_t __attribute__((ext_vector_type(2))); typedef __bf16 bf16x2_t __attribute__((ext_vector_type(2)));
__device__ __forceinline__ unsigned cvtpk_s(float lo, float hi) { const f32x2_t v = {lo, hi}; const bf16x2_t b = __builtin_convertvector(v, bf16x2_t); return __builtin_bit_cast(unsigned, b); }
__device__ __forceinline__ s16x4 vtr(lds_cptr p) { return __builtin_bit_cast(s16x4, __builtin_amdgcn_ds_read_tr16_b64_v4i16((__attribute__((address_space(3))) v4i16_t*)p)); }
__device__ __forceinline__ void kload2(bf16x8* kf, lds_cptr kp, int j) { kf[2 * j] = *(const ALAS bf16x8*)(kp + j * 2048); kf[2 * j + 1] = *(const ALAS bf16x8*)(kp + j * 2048 + 512); }
__device__ __forceinline__ void glds16s(unsigned voff, const void* gbase, unsigned ldsdst) { unsigned keep;
    asm volatile("s_mov_b32 %0, m0\n\ts_mov_b32 m0, %3\n\ts_nop 0\n\tglobal_load_lds_dwordx4 %1, %2\n\ts_mov_b32 m0, %0" : "=&s"(keep) : "v"(voff), "s"(gbase), "s"(ldsdst) : "memory"); }
typedef _Float16 d2_h2 __attribute__((ext_vector_type(2)));
__device__ __forceinline__ unsigned d2_pkh(float a, float b) { const f32x2_t v = {a, b}; return __builtin_bit_cast(unsigned, __builtin_convertvector(v, d2_h2)); }
__device__ __forceinline__ f32x2_t d2_unh(unsigned w) { return __builtin_convertvector(__builtin_bit_cast(d2_h2, w), f32x2_t); }
#define D2_MX3(a, b, c) __builtin_fmaxf(__builtin_fmaxf((a), (b)), (c))
__device__ __forceinline__ float rowmax2(const f32x16& p0, const f32x16& p1) {
    float a = D2_MX3(p0[0], p0[1], p1[0]), b = D2_MX3(p0[2], p0[3], p1[1]); a = D2_MX3(a, p1[2], p1[3]);
#pragma unroll
    for (int r = 4; r < 16; r += 4) { a = D2_MX3(a, p0[r], p0[r + 1]); b = D2_MX3(b, p0[r + 2], p0[r + 3]); a = D2_MX3(a, p1[r], p1[r + 1]); b = D2_MX3(b, p1[r + 2], p1[r + 3]); }
    const float m = __builtin_fmaxf(a, b); auto rr = __builtin_amdgcn_permlane32_swap(__float_as_uint(m), __float_as_uint(m), false, false);
    return __builtin_fmaxf(__uint_as_float(rr[0]), __uint_as_float(rr[1])); }
__device__ __forceinline__ void cmask2(f32x16& p0, f32x16& p1, int jb, int qrel, int hi) {
    const int kb = 64 * jb + 4 * hi; const float NEG = -__builtin_inff();
#pragma unroll
    for (int r = 0; r < 16; ++r) { const int kv = kb + (r & 3) + 8 * (r >> 2); if (kv > qrel) p0[r] = NEG; if (kv + 32 > qrel) p1[r] = NEG; } }
#define D2_WAIT_BAR(N) asm volatile("s_waitcnt vmcnt(" #N ") lgkmcnt(0)\n\ts_barrier" ::: "memory")
#define D2_PIN(x) asm volatile("" : "+v"(x))
#define D2_MF(a, b, c) __builtin_amdgcn_mfma_f32_32x32x16_bf16(a, b, c, 0, 0, 0)

template <bool SECOND>
__device__ __forceinline__ void diff_pass2(const bf16_t* __restrict__ Qg, const bf16_t* __restrict__ Kg, const bf16_t* __restrict__ Vg, float* S1, bf16_t* __restrict__ Og,
                                           int qb, float lam, const float* __restrict__ gsub, float gmul, ldsp lds, int wave_) {
    int tid_ = tid_from_wave(wave_); asm volatile("" : "+v"(tid_));
    const int tid = tid_, wid = __builtin_amdgcn_readfirstlane(tid >> 6), lane = tid & 63, r32 = lane & 31, hi = lane >> 5;
    const int NT = 4 * qb + 4, R0 = 256 * qb + 32 * wid;
    const unsigned lds0 = (unsigned)(uintptr_t)lds;
    ALAS float* wsf = (ALAS float*)(lds + D2_WS) + wid * 64;
    const unsigned kvo = (unsigned)(lane * QP + wid * 8) * 2u;
    const unsigned vvo = (unsigned)((16 * (wid & 3) + (lane >> 2)) * QP + (wid >> 2) * 32 + (lane & 3) * 8) * 2u;
    const unsigned kdst = lds0 + D2_K + wid * 1024, vdst = lds0 + D2_V + wid * 1024;
#define D2_DMA_K(t, slot) glds16s(kvo, Kg + (size_t)(t) * 64 * QP, (unsigned)__builtin_amdgcn_readfirstlane(kdst + (slot)))
#define D2_DMA_V(t, slot) do { glds16s(vvo, Vg + (size_t)(t) * 64 * QP, (unsigned)__builtin_amdgcn_readfirstlane(vdst + 2 * (slot))); \
                               glds16s(vvo, Vg + (size_t)(t) * 64 * QP + 64, (unsigned)__builtin_amdgcn_readfirstlane(vdst + 2 * (slot) + 8192)); } while (0)
    const lds_cptr kp0 = (lds_cptr)lds + D2_K + hi * 1024 + r32 * 16;
    const lds_cptr vp0 = (lds_cptr)lds + D2_V + ((lane >> 4) & 1) * 32 + (lane & 3) * 8 + (4 * hi + ((lane & 15) >> 2)) * 64;
    D2_DMA_K(0, 0); D2_DMA_V(0, 0); D2_DMA_K(1, D2_SLK);
    bf16x8 qr[4];
    { const bf16_t* Qw = Qg + (size_t)R0 * QP; const unsigned qoff = (unsigned)(r32 * QP + hi * 8);
#pragma unroll
      for (int d0 = 0; d0 < 4; ++d0) qr[d0] = ldg8(Qw + (qoff + d0 * 16)); }
    D2_DMA_K(2, 2 * D2_SLK);
    float mhat = 0.f, l_reg = 0.f; f32x16 o[4] = {};
    const int qrel = 32 * wid + r32; bool resc = false;
    f32x16 pA0, pA1, pB0, pB1; bf16x8 kf[8]; s16x4 vlo[4], vhi[4]; u32x4 pw0, pw1, pw2, pw3;
#if D2_NEGM
    f32x16 negm;
#endif
    int sl_prev = 0, sl_cur = 0, sl_next = D2_SLK;
#define D2_ROT() do { sl_prev = sl_cur; sl_cur = sl_next; sl_next = (sl_next == 2 * D2_SLK) ? 0 : sl_next + D2_SLK; } while (0)
#if D2_NEGM
#define D2_EX(v) __builtin_amdgcn_exp2f(v)
#define D2_C0 negm
#else
#define D2_EX(v) __builtin_amdgcn_exp2f((v) - mhat)
#define D2_C0 D2_Z16
#endif
#define D2_RESC() do { if (resc) { _Pragma("unroll") for (int d_ = 0; d_ < 4; ++d_) _Pragma("unroll") for (int r = 0; r < 16; ++r) o[d_][r] *= wsf[crow(r, hi)]; } } while (0)
#define D2_Z16 (f32x16){}
#if D2_NEGM
#define D2_RM(C0, C1) rowmax2(C0, C1)
#define D2_MOVE(C0, C1, dl) do { _Pragma("unroll") for (int r = 0; r < 16; ++r) { C0[r] -= dl; C1[r] -= dl; } _Pragma("unroll") for (int r = 0; r < 16; ++r) negm[r] = -mhat; D2_PIN(negm); } while (0)
#else
#define D2_RM(C0, C1) (rowmax2(C0, C1) - mhat)
#define D2_MOVE(C0, C1, dl) do { } while (0)
#endif
    D2_WAIT_BAR(4);
#pragma unroll
    for (int d0 = 0; d0 < 4; ++d0) kload2(kf, kp0, d0);
    pA0 = D2_MF(kf[0], qr[0], D2_Z16); pA1 = D2_MF(kf[1], qr[0], D2_Z16); pA0 = D2_MF(kf[2], qr[1], pA0); pA1 = D2_MF(kf[3], qr[1], pA1);
    pA0 = D2_MF(kf[4], qr[2], pA0); pA1 = D2_MF(kf[5], qr[2], pA1); pA0 = D2_MF(kf[6], qr[3], pA0); pA1 = D2_MF(kf[7], qr[3], pA1);
    if (NT == 4) cmask2(pA0, pA1, 0, qrel, hi);
    { mhat = rowmax2(pA0, pA1);
#pragma unroll
      for (int r = 0; r < 16; ++r) { pA0[r] = __builtin_amdgcn_exp2f(pA0[r] - mhat); pA1[r] = __builtin_amdgcn_exp2f(pA1[r] - mhat); }
#if D2_NEGM
#pragma unroll
      for (int r = 0; r < 16; ++r) negm[r] = -mhat;
      D2_PIN(negm);
#endif
    }
    D2_WAIT_BAR(0);
    D2_DMA_K(3, 0); D2_DMA_V(1, D2_SLK); D2_ROT();
#pragma unroll
    for (int d0 = 0; d0 < 4; ++d0) kload2(kf, kp0 + sl_cur, d0);
    D2_WAIT_BAR(3);
#define D2_PKW(P, i) cvtpk_s(P[i], P[(i) + 1])
#define D2_PAF(k) __builtin_bit_cast(bf16x8, pw##k)
#define D2_VFR(i) (bf16x8){vlo[i][0], vlo[i][1], vlo[i][2], vlo[i][3], vhi[i][0], vhi[i][1], vhi[i][2], vhi[i][3]}
#define D2_VRD(s, i) do { vlo[s] = vtr(vp_ + ((((i) & 3) * 4096) + (((i) >> 2) * 1024))); vhi[s] = vtr(vp_ + ((((i) & 3) * 4096) + (((i) >> 2) * 1024) + 512)); } while (0)
#define D2_KRD(G, d0) do { if (G) { kload2(kf, kp0 + sl_next, d0); SBAR(); } } while (0)
#define D2_GAPA(MF_, a0, a1, a2, a3, W0, W1, PW) do { MF_; sacc += a0; sacc += a1; sacc += a2; sacc += a3; D2_PIN(sacc); W0; W1; D2_PIN(PW); SBAR(); } while (0)
#define D2_GAPB(j, K_, X, e) do { o[(j) & 3] = D2_MF(D2_PAF(K_), D2_VFR((j) & 3), o[(j) & 3]); X[e] = D2_EX(X[e]); X[(e) + 1] = D2_EX(X[(e) + 1]); D2_PIN(X); SBAR(); } while (0)
#define D2_STEP(C0, C1, P0, P1, t, MASK, GK, GV, GL) do { SBAR(); \
    const lds_cptr vp_ = vp0 + 2 * sl_prev; \
    float sacc = P0[0] + P0[1]; \
                          D2_GAPA(C0 = D2_MF(kf[0], qr[0], D2_C0),  P0[2], P0[3], P0[4], P0[5],     pw0[0] = D2_PKW(P0, 0),  pw0[1] = D2_PKW(P0, 2),  pw0); \
                          D2_GAPA(C1 = D2_MF(kf[1], qr[0], D2_C0),  P0[6], P0[7], P0[8], P0[9],     pw0[2] = D2_PKW(P0, 4),  pw0[3] = D2_PKW(P0, 6),  pw0); \
                          D2_GAPA(C0 = D2_MF(kf[2], qr[1], C0),     P0[10], P0[11], P0[12], P0[13], pw1[0] = D2_PKW(P0, 8),  pw1[1] = D2_PKW(P0, 10), pw1); \
                          D2_GAPA(C1 = D2_MF(kf[3], qr[1], C1),     P0[14], P0[15], P1[0], P1[1],   pw1[2] = D2_PKW(P0, 12), pw1[3] = D2_PKW(P0, 14), pw1); \
    D2_VRD(0, 0); SBAR(); D2_GAPA(C0 = D2_MF(kf[4], qr[2], C0),     P1[2], P1[3], P1[4], P1[5],     pw2[0] = D2_PKW(P1, 0),  pw2[1] = D2_PKW(P1, 2),  pw2); \
    D2_VRD(1, 1); SBAR(); D2_GAPA(C1 = D2_MF(kf[5], qr[2], C1),     P1[6], P1[7], P1[8], P1[9],     pw2[2] = D2_PKW(P1, 4),  pw2[3] = D2_PKW(P1, 6),  pw2); \
    D2_VRD(2, 2); SBAR(); D2_GAPA(C0 = D2_MF(kf[6], qr[3], C0),     P1[10], P1[11], P1[12], P1[13], pw3[0] = D2_PKW(P1, 8),  pw3[1] = D2_PKW(P1, 10), pw3); \
    D2_VRD(3, 3); SBAR(); D2_GAPA(C1 = D2_MF(kf[7], qr[3], C1),     P1[14], P1[15], 0.f, 0.f,       pw3[2] = D2_PKW(P1, 12), pw3[3] = D2_PKW(P1, 14), pw3); \
    l_reg += sacc; \
    if (GK) D2_DMA_K((t) + 3, sl_cur); if (GV) D2_DMA_V((t) + 1, sl_next);                                                  \
    if (MASK) cmask2(C0, C1, (t) - (NT - 4), qrel, hi); \
    { const float rm = D2_RM(C0, C1); resc = false;                                                                          \
      if (__builtin_expect(__any(rm > ATT_THR), 0)) { const float dl = __builtin_fmaxf(rm, 0.f); mhat += dl;                \
          D2_MOVE(C0, C1, dl); \
          const float f = __builtin_amdgcn_exp2f(-dl); l_reg *= f; if (hi == 0) wsf[r32] = f; resc = true; } } \
    SBAR(); \
    D2_GAPB(0, 0, C0, 0);   D2_VRD(0, 4);  SBAR(); D2_GAPB(1, 0, C0, 2);   D2_VRD(1, 5);  SBAR(); D2_GAPB(2, 0, C0, 4);   D2_VRD(2, 6);  SBAR(); D2_GAPB(3, 0, C0, 6);   D2_VRD(3, 7);  SBAR(); \
    D2_GAPB(4, 1, C0, 8);   D2_VRD(0, 8);  SBAR(); D2_GAPB(5, 1, C0, 10);  D2_VRD(1, 9);  SBAR(); D2_GAPB(6, 1, C0, 12);  D2_VRD(2, 10); SBAR(); D2_GAPB(7, 1, C0, 14);  D2_VRD(3, 11); SBAR(); \
    D2_GAPB(8, 2, C1, 0);   D2_VRD(0, 12); SBAR(); D2_GAPB(9, 2, C1, 2);   D2_VRD(1, 13); SBAR(); D2_GAPB(10, 2, C1, 4);  D2_VRD(2, 14); SBAR(); D2_GAPB(11, 2, C1, 6);  D2_VRD(3, 15); SBAR(); \
    D2_KRD(GL, 0); D2_GAPB(12, 3, C1, 8);  D2_KRD(GL, 1); D2_GAPB(13, 3, C1, 10); D2_KRD(GL, 2); D2_GAPB(14, 3, C1, 12); D2_KRD(GL, 3); D2_GAPB(15, 3, C1, 14); \
    } while (0)
    int t = 1;
    for (; t + 5 < NT; t += 2) {
        D2_STEP(pB0, pB1, pA0, pA1, t, false, true, true, true);     D2_WAIT_BAR(3); D2_RESC(); D2_ROT();
        D2_STEP(pA0, pA1, pB0, pB1, t + 1, false, true, true, true); D2_WAIT_BAR(3); D2_RESC(); D2_ROT();
    }
#define D2_ENDW(tt) do { if ((tt) + 3 < NT) { D2_WAIT_BAR(3); } else if ((tt) + 2 < NT) { D2_WAIT_BAR(2); } else { D2_WAIT_BAR(0); } } while (0)
    for (; t + 1 < NT; t += 2) {
        D2_STEP(pB0, pB1, pA0, pA1, t, true, (t + 3 < NT), (t + 1 < NT), (t + 1 < NT));         D2_ENDW(t);     D2_RESC(); D2_ROT();
        D2_STEP(pA0, pA1, pB0, pB1, t + 1, true, (t + 4 < NT), (t + 2 < NT), (t + 2 < NT));     D2_ENDW(t + 1); D2_RESC(); D2_ROT();
    }
    D2_STEP(pB0, pB1, pA0, pA1, NT - 1, true, false, false, false); D2_RESC();
    { float sacc = pB0[0] + pB0[1];
#pragma unroll
      for (int r = 2; r < 16; ++r) sacc += pB0[r];
#pragma unroll
      for (int r = 0; r < 16; ++r) sacc += pB1[r];
      l_reg += sacc;
      pw0 = (u32x4){D2_PKW(pB0, 0), D2_PKW(pB0, 2), D2_PKW(pB0, 4), D2_PKW(pB0, 6)}; pw1 = (u32x4){D2_PKW(pB0, 8), D2_PKW(pB0, 10), D2_PKW(pB0, 12), D2_PKW(pB0, 14)};
      pw2 = (u32x4){D2_PKW(pB1, 0), D2_PKW(pB1, 2), D2_PKW(pB1, 4), D2_PKW(pB1, 6)}; pw3 = (u32x4){D2_PKW(pB1, 8), D2_PKW(pB1, 10), D2_PKW(pB1, 12), D2_PKW(pB1, 14)};
      const lds_cptr vp_ = vp0 + 2 * sl_cur; SBAR();
#pragma unroll
      for (int i = 0; i < 4; ++i) D2_VRD(i, i);
      o[0] = D2_MF(D2_PAF(0), D2_VFR(0), o[0]); o[1] = D2_MF(D2_PAF(0), D2_VFR(1), o[1]); o[2] = D2_MF(D2_PAF(0), D2_VFR(2), o[2]); o[3] = D2_MF(D2_PAF(0), D2_VFR(3), o[3]); SBAR();
#pragma unroll
      for (int i = 0; i < 4; ++i) D2_VRD(i, i + 4);
      o[0] = D2_MF(D2_PAF(1), D2_VFR(0), o[0]); o[1] = D2_MF(D2_PAF(1), D2_VFR(1), o[1]); o[2] = D2_MF(D2_PAF(1), D2_VFR(2), o[2]); o[3] = D2_MF(D2_PAF(1), D2_VFR(3), o[3]); SBAR();
#pragma unroll
      for (int i = 0; i < 4; ++i) D2_VRD(i, i + 8);
      o[0] = D2_MF(D2_PAF(2), D2_VFR(0), o[0]); o[1] = D2_MF(D2_PAF(2), D2_VFR(1), o[1]); o[2] = D2_MF(D2_PAF(2), D2_VFR(2), o[2]); o[3] = D2_MF(D2_PAF(2), D2_VFR(3), o[3]); SBAR();
#pragma unroll
      for (int i = 0; i < 4; ++i) D2_VRD(i, i + 12);
      o[0] = D2_MF(D2_PAF(3), D2_VFR(0), o[0]); o[1] = D2_MF(D2_PAF(3), D2_VFR(1), o[1]); o[2] = D2_MF(D2_PAF(3), D2_VFR(2), o[2]); o[3] = D2_MF(D2_PAF(3), D2_VFR(3), o[3]); }
#undef D2_DMA_K
#undef D2_DMA_V
#undef D2_ROT
#undef D2_EX
#undef D2_C0
#undef D2_RM
#undef D2_MOVE
#undef D2_RESC
#undef D2_PKW
#undef D2_PAF
#undef D2_VFR
#undef D2_VRD
#undef D2_KRD
#undef D2_ENDW
#undef D2_GAPA
#undef D2_GAPB
#undef D2_STEP
    { auto rr = __builtin_amdgcn_permlane32_swap(__float_as_uint(l_reg), __float_as_uint(l_reg), false, false); l_reg = __uint_as_float(rr[0]) + __uint_as_float(rr[1]); }
    ALAS float* li_l = wsf + 32;
    if (hi == 0) li_l[r32] = l_reg; asm volatile("s_waitcnt lgkmcnt(0)" ::: "memory");
    float rli[16];
#pragma unroll
    for (int r = 0; r < 16; ++r) rli[r] = __builtin_amdgcn_rcpf(li_l[crow(r, hi)]);
    ldsp s1l = lds + D2_S1 + wid * 8192 + lane * 16;
    if constexpr (!SECOND) {
#pragma unroll
        for (int r = 0; r < 16; r += 2) { u32x4 w; w.x = d2_pkh(o[0][r] * rli[r], o[1][r] * rli[r]); w.y = d2_pkh(o[2][r] * rli[r], o[3][r] * rli[r]);
            w.z = d2_pkh(o[0][r + 1] * rli[r + 1], o[1][r + 1] * rli[r + 1]); w.w = d2_pkh(o[2][r + 1] * rli[r + 1], o[3][r + 1] * rli[r + 1]);
            *(ALAS u32x4*)(s1l + (r >> 1) * 1024) = w; }
    } else {
        const unsigned ooff8 = (unsigned)(4 * hi * OBP + r32);
        float gn[4];
#pragma unroll
        for (int d0 = 0; d0 < 4; ++d0) gn[d0] = gsub[d0 * 32 + r32] * gmul;
#pragma unroll
        for (int r = 0; r < 16; ++r) { float d[4]; float ss = 0.f;
            unsigned char* orowp = (unsigned char*)Og + (size_t)(R0 + (r & 3) + 8 * (r >> 2)) * OBP;
            { const u32x4 w = *(const ALAS u32x4*)(s1l + (r >> 1) * 1024); const f32x2_t s01 = d2_unh((r & 1) ? w.z : w.x), s23 = d2_unh((r & 1) ? w.w : w.y);
              d[0] = s01[0] - lam * (o[0][r] * rli[r]); d[1] = s01[1] - lam * (o[1][r] * rli[r]); d[2] = s23[0] - lam * (o[2][r] * rli[r]); d[3] = s23[1] - lam * (o[3][r] * rli[r]); }
#pragma unroll
            for (int d0 = 0; d0 < 4; ++d0) ss += d[d0] * d[d0];
            ss += __builtin_bit_cast(float, __builtin_amdgcn_update_dpp(0, __builtin_bit_cast(int, ss), 0xB1, 0xf, 0xf, true));
            ss += __builtin_bit_cast(float, __builtin_amdgcn_update_dpp(0, __builtin_bit_cast(int, ss), 0x4E, 0xf, 0xf, true));
            ss += __builtin_bit_cast(float, __builtin_amdgcn_update_dpp(0, __builtin_bit_cast(int, ss), 0x141, 0xf, 0xf, true));
            ss += __builtin_bit_cast(float, __builtin_amdgcn_update_dpp(0, __builtin_bit_cast(int, ss), 0x140, 0xf, 0xf, true));
            { auto rr = __builtin_amdgcn_permlane16_swap(__float_as_uint(ss), __float_as_uint(ss), false, false); ss = __uint_as_float(rr[0]) + __uint_as_float(rr[1]); }
            const float rs = __builtin_amdgcn_rsqf(ss * (1.f / 128.f) + 1e-5f);
#pragma unroll
            for (int d0 = 0; d0 < 4; ++d0) { const unsigned w = quad_pack_fp8(d[d0] * rs * gn[d0] * OB8_SCALE);
                if ((r32 & 3) == 0) *(unsigned*)(orowp + (ooff8 + d0 * 32)) = w; }
            if ((r & 1) == 1) asm volatile("" ::: "memory"); }
    }
    asm volatile("s_waitcnt lgkmcnt(0)\n\ts_barrier" ::: "memory");
}
#undef D2_WAIT_BAR
#undef D2_PIN
#undef D2_MF
#undef D2_MX3
#undef D2_Z16
#undef SBAR
}

#define LAS __attribute__((address_space(3)))

#define XB_TMO      128
#define XB_XCNT(j)  (256  + 64 * (j))
#define XB_XSUB(j)  (1280 + 64 * (j))
#define XB_XGEN(j)  (2304 + 64 * (j))
#define XB_TOP      3328
#define XB_TOPGEN   3392
#define XCD_BAR_WORDS 3456
#define XB_SPIN_CAP (1u << 18)

__device__ __forceinline__ unsigned xb_ld(unsigned* p)              { return __hip_atomic_load(p, __ATOMIC_RELAXED, __HIP_MEMORY_SCOPE_AGENT); }
__device__ __forceinline__ unsigned xb_add(unsigned* p, unsigned v) { return __hip_atomic_fetch_add(p, v, __ATOMIC_RELAXED, __HIP_MEMORY_SCOPE_AGENT); }
__device__ __forceinline__ unsigned xb_xcc_id() { return (unsigned)__builtin_amdgcn_s_getreg((3 << 11) | 20) & 0xFu; }
#define XB_SPIN(cond, bar) do { unsigned _sp = 0; while (cond) { __builtin_amdgcn_s_sleep(1); \
    if ((++_sp & 255u) == 0u) { if (xb_ld(&(bar)[XB_TMO])) break; if (_sp > XB_SPIN_CAP) { atomicAdd(&(bar)[XB_TMO], 1u); break; } } } } while (0)

struct XcdBarrier {
    unsigned* bar; unsigned x;
    volatile LAS unsigned* st;
};

__device__ __forceinline__ XcdBarrier xcd_barrier_post(unsigned* bar, volatile LAS unsigned* st, bool thread0) {
    XcdBarrier b; b.bar = bar; b.x = xb_xcc_id(); b.st = st;
    if (thread0) (void)xb_add(&bar[XB_XCNT(b.x)], 1u);
    return b;
}
__device__ __forceinline__ void xcd_barrier_complete(unsigned* bar, unsigned x, unsigned& nloc, unsigned& nx) {
    const unsigned G = gridDim.x * gridDim.y * gridDim.z;
    unsigned sum, cnt, mine, sp = 0u;
    for (;;) {
        sum = 0u; cnt = 0u; mine = 0u;
#pragma unroll
        for (unsigned j = 0; j < 16; ++j) { const unsigned c = xb_ld(&bar[XB_XCNT(j)]); sum += c; cnt += (c > 0u) ? 1u : 0u; mine = (j == x) ? c : mine; }
        if (sum == G) break;
        __builtin_amdgcn_s_sleep(1);
        if ((++sp & 255u) == 0u) { if (xb_ld(&bar[XB_TMO])) break; if (sp > XB_SPIN_CAP) { atomicAdd(&bar[XB_TMO], 1u); break; } }
    }
    nloc = mine > 0u ? mine : 1u; nx = cnt > 0u ? cnt : 1u;
}

__device__ __forceinline__ void xcd_barrier(const XcdBarrier& b, bool thread0) {
    asm volatile("s_waitcnt vmcnt(0)" ::: "memory");
    __syncthreads();
    if (thread0) {
        unsigned* bar = b.bar;
        __builtin_amdgcn_s_waitcnt(0);
        unsigned nloc = b.st[0], nx = b.st[1];
        if (nloc == 0u) { xcd_barrier_complete(bar, b.x, nloc, nx); b.st[0] = nloc; b.st[1] = nx; }
        const unsigned old = xb_add(&bar[XB_XSUB(b.x)], 1u);
        const unsigned gen = old / nloc;
        if (old + 1u == (gen + 1u) * nloc) {
            __builtin_amdgcn_fence(__ATOMIC_RELEASE, "agent");
            asm volatile("s_waitcnt vmcnt(0)" ::: "memory");
            const unsigned og = xb_add(&bar[XB_TOP], 1u);
            const unsigned tg = og / nx;
            if (og + 1u == (tg + 1u) * nx) xb_add(&bar[XB_TOPGEN], 1u);
            else XB_SPIN(xb_ld(&bar[XB_TOPGEN]) == tg, bar);
            __builtin_amdgcn_fence(__ATOMIC_ACQUIRE, "agent");
            xb_add(&bar[XB_XGEN(b.x)], 1u);
            asm volatile("s_waitcnt vmcnt(0)" ::: "memory");
        } else {
            XB_SPIN(xb_ld(&bar[XB_XGEN(b.x)]) == gen, bar);
            __builtin_amdgcn_fence(__ATOMIC_ACQUIRE, "agent");
            asm volatile("s_waitcnt vmcnt(0)" ::: "memory");
        }
    }
    __syncthreads();
}

constexpr int NWAVES = 8;
constexpr int NTOK = 16384, DM = 2048, SEQ = 2048, NHEAD = 16, NLAYER = 4, NEXP = 16, DEXP = 1024;
constexpr int XS_ROWS = 36864;
constexpr float LN_EPS = 1e-5f;
constexpr float DN_ALPHA = 1.6817928305074292f;
constexpr float LOG2E = 1.4426950408889634f;
constexpr float SB_QSCALE = 0.08838834764831845f * LOG2E;
constexpr float DF_QSCALE = 0.125f * LOG2E;
#ifndef MK_MULTI
#define MK_MULTI 0
#endif
#ifndef MOE_F8
#define MOE_F8 1
#endif
#ifndef QKV8_A
#define QKV8_A 1
#endif
#ifndef QKV8_B
#define QKV8_B 0
#endif
#ifndef V8_B
#define V8_B 1
#endif
#ifndef DF_RING
#define DF_RING 1
#endif
constexpr int NSTEPS = 1 + 8 * NLAYER;

constexpr size_t MiB = 1u << 20;
constexpr size_t WS_CTL = 0, CTL_ZERO_BYTES = 256 * 1024;
constexpr size_t WS_COS = 1 * MiB, WS_SIN = WS_COS + 256 * 1024;
constexpr size_t WS_WR = 2 * MiB;
constexpr size_t WS_CNT = 3 * MiB;
constexpr size_t WS_RE = WS_CNT + 64 * 1024;
constexpr size_t WS_RW = WS_RE + 64 * 1024;
constexpr size_t WS_RP = WS_RW + 128 * 1024;
constexpr int LDH = 2048;
constexpr int P8K2 = 2048, P8K1 = 1024;
constexpr size_t WS_WQKVA = 4 * MiB;
constexpr size_t WS_WOA = WS_WQKVA + 56 * MiB;
constexpr size_t WS_WQKVB = WS_WOA + 16 * MiB;
constexpr size_t WS_WOB = WS_WQKVB + 36 * MiB;
constexpr size_t WS_WGU = WS_WOB + 16 * MiB;
constexpr size_t WS_WDN = WS_WGU + 512 * MiB;
constexpr size_t WS_H = WS_WDN + 256 * MiB;
constexpr size_t WS_HB = WS_H + 128 * MiB;
constexpr size_t WS_QKV = WS_HB + 68 * MiB;
constexpr size_t WS_OB = WS_QKV + 192 * MiB;
constexpr size_t WS_XS = WS_OB + 64 * MiB;
constexpr size_t WS_ACT = WS_XS + 144 * MiB;
constexpr size_t WS_YD = WS_ACT + 72 * MiB;
constexpr size_t WS_END = WS_YD + 144 * MiB;
static_assert(WS_END <= (size_t)2040 * MiB, "workspace map");
static_assert((size_t)2 * 6144 * LDH * 2 <= 56 * MiB && (size_t)8192 * LDH * 2 <= 36 * MiB && (size_t)2 * 2048 * P8K2 <= 16 * MiB && (size_t)64 * 2048 * P8K2 <= 512 * MiB && (size_t)64 * 2048 * P8K1 <= 256 * MiB, "weight regions");
static_assert((size_t)NTOK * LDH * 2 <= 68 * MiB && (size_t)NTOK * P8K2 <= 64 * MiB && (size_t)XS_ROWS * P8K2 <= 144 * MiB && (size_t)XS_ROWS * P8K1 <= 72 * MiB, "activation regions");
constexpr int CW_MTC = 8192;
constexpr int CW_BAR = 1024;
constexpr int LDS_BYTES = 163840;
constexpr int WCOL_OFF = 147456;
constexpr int LDSCTL_OFF = 145408;
constexpr int RING_OFF = 0;
constexpr int LNX_OFF = 131072;

#define GAS __attribute__((address_space(1)))
typedef unsigned short bf16;
typedef unsigned v4u __attribute__((ext_vector_type(4)));
typedef unsigned v2u __attribute__((ext_vector_type(2)));
typedef float f32x4 __attribute__((ext_vector_type(4)));
typedef float f32x2 __attribute__((ext_vector_type(2)));
typedef _Float16 f16x4 __attribute__((ext_vector_type(4)));
__device__ __forceinline__ f32x4 ldh4(const _Float16* p) { return __builtin_convertvector(*(const f16x4*)p, f32x4); }
__device__ __forceinline__ void sth4(_Float16* p, f32x4 v) { __builtin_nontemporal_store(__builtin_convertvector(v, f16x4), (f16x4*)p); }
#define LDS_WAIT() asm volatile("s_waitcnt lgkmcnt(0)" ::: "memory")
#define VM_WAIT() asm volatile("s_waitcnt vmcnt(0)" ::: "memory")
__device__ __forceinline__ unsigned pk2(float lo, float hi) { unsigned r; asm volatile("v_cvt_pk_bf16_f32 %0, %1, %2" : "=v"(r) : "v"(lo), "v"(hi)); return r; }
__device__ __forceinline__ int opq_tid(int wave) { int t = tid_from_wave(wave); asm volatile("" : "+v"(t)); return t; }
__device__ __forceinline__ float dpp_sum(float v) {
    v += __builtin_bit_cast(float, __builtin_amdgcn_update_dpp(0, __builtin_bit_cast(int, v), 0xB1, 0xf, 0xf, true));
    v += __builtin_bit_cast(float, __builtin_amdgcn_update_dpp(0, __builtin_bit_cast(int, v), 0x4E, 0xf, 0xf, true));
    v += __builtin_bit_cast(float, __builtin_amdgcn_update_dpp(0, __builtin_bit_cast(int, v), 0x141, 0xf, 0xf, true));
    v += __builtin_bit_cast(float, __builtin_amdgcn_update_dpp(0, __builtin_bit_cast(int, v), 0x140, 0xf, 0xf, true));
    const int b = __builtin_bit_cast(int, v);
    const float s0 = __builtin_bit_cast(float, __builtin_amdgcn_readlane(b, 0)), s1 = __builtin_bit_cast(float, __builtin_amdgcn_readlane(b, 16));
    const float s2 = __builtin_bit_cast(float, __builtin_amdgcn_readlane(b, 32)), s3 = __builtin_bit_cast(float, __builtin_amdgcn_readlane(b, 48));
    return (s0 + s1) + (s2 + s3);
}
__device__ __forceinline__ float wave_sum(float v) {
#pragma unroll
    for (int o = 1; o < 64; o <<= 1) v += __shfl_xor(v, o);
    return v;
}

struct Args { const float* in[17]; float* out; unsigned char* ws; int s_lo, s_hi; };

__device__ __forceinline__ int map_row(int n, int mode) {
    if (mode == 0) return n;
    if (mode == 1) { const int c = n & 255, blk = c >> 6, d = c & 63; return (n & ~255) + ((d >> 5) << 7) + (blk << 5) + (d & 31); }
    return ((n >> 7) << 8) + (n & 127) + (mode == 3 ? 128 : 0);
}
__device__ __forceinline__ unsigned pk2h(float lo, float hi) { typedef _Float16 h2 __attribute__((ext_vector_type(2))); const f32x2 v = {lo, hi}; return __builtin_bit_cast(unsigned, __builtin_convertvector(v, h2)); }
__device__ __forceinline__ void cvt_load(f32x4 (&v)[16], const float* __restrict__ src, int pitch, int k0, int n0, int kind, int lane) {
    if (kind == 2) { const int kr = lane >> 3, n4 = (lane & 7) * 4; const float* p = src + (size_t)(k0 + kr) * pitch + n0 + n4;
#pragma unroll
        for (int i = 0; i < 16; ++i) v[i] = __builtin_nontemporal_load((const f32x4*)(p + (size_t)(8 * i) * pitch)); }
    else { const int kr = lane >> 4, n4 = (lane & 15) * 4; const float* p = src + (size_t)(k0 + kr) * pitch + n0 + n4;
#pragma unroll
        for (int i = 0; i < 16; ++i) v[i] = __builtin_nontemporal_load((const f32x4*)(p + (size_t)(4 * i) * pitch)); }
}
__device__ __forceinline__ void cvt_store(const f32x4 (&v)[16], unsigned char* __restrict__ dst, int dp, int mode, int k0, int n0, int kind, LAS float* scr, int lane) {
    if (kind == 2) {
        const int kr = lane >> 3, n4 = (lane & 7) * 4;
#pragma unroll
        for (int i = 0; i < 16; ++i) { LAS float* s = scr + (8 * i + kr) * 33 + n4; s[0] = v[i][0] * pg8::W8_SCALE; s[1] = v[i][1] * pg8::W8_SCALE; s[2] = v[i][2] * pg8::W8_SCALE; s[3] = v[i][3] * pg8::W8_SCALE; }
        LDS_WAIT();
        const int c = lane & 7;
#pragma unroll
        for (int j = 0; j < 4; ++j) { const int nl = (lane >> 3) + 8 * j; const int row = map_row(n0 + nl, mode);
            const LAS float* s = scr + (16 * c) * 33 + nl;
            v4u o; o.x = pg8::pack4_fp8(s[0], s[33], s[66], s[99]); o.y = pg8::pack4_fp8(s[132], s[165], s[198], s[231]);
            o.z = pg8::pack4_fp8(s[264], s[297], s[330], s[363]); o.w = pg8::pack4_fp8(s[396], s[429], s[462], s[495]);
            __builtin_nontemporal_store(o, (v4u*)(dst + (size_t)row * dp + k0 + 16 * c)); }
    } else {
        const int kr = lane >> 4, n4 = (lane & 15) * 4;
#pragma unroll
        for (int i = 0; i < 16; ++i) { LAS float* s = scr + (4 * i + kr) * 65 + n4; s[0] = v[i][0]; s[1] = v[i][1]; s[2] = v[i][2]; s[3] = v[i][3]; }
        LDS_WAIT();
        const int c = lane & 7;
#pragma unroll
        for (int j = 0; j < 8; ++j) { const int nl = (lane >> 3) + 8 * j; const int row = map_row(n0 + nl, mode);
            const LAS float* s = scr + (8 * c) * 65 + nl;
            v4u o; o.x = pk2h(s[0], s[65]); o.y = pk2h(s[130], s[195]); o.z = pk2h(s[260], s[325]); o.w = pk2h(s[390], s[455]);
            __builtin_nontemporal_store(o, (v4u*)(dst + (size_t)row * dp + (k0 + 8 * c) * 2)); }
    }
    LDS_WAIT();
}

__global__ void __launch_bounds__(NWAVES * 64, 2) yoco_fwd(Args args) {
    extern __shared__ __attribute__((aligned(16))) unsigned char lds_raw[];
    LAS unsigned char* const lds = (LAS unsigned char*)lds_raw;
    const int tid = threadIdx.x, lane = tid & 63, wave = __builtin_amdgcn_readfirstlane(tid >> 6);
    const int G = gridDim.x, bx = blockIdx.x;
    const int vcu = (G % 8 == 0) ? (bx % 8) * (G / 8) + bx / 8 : bx;
    unsigned char* const ws = args.ws;
    volatile LAS unsigned* const CTL = (volatile LAS unsigned*)(lds + LDSCTL_OFF);
    LAS int* const TAB = (LAS int*)(lds + LDSCTL_OFF + 64);
    for (int u = tid; u < (LDS_BYTES - LDSCTL_OFF) / 4; u += NWAVES * 64) ((LAS unsigned*)(lds + LDSCTL_OFF))[u] = 0u;
    __syncthreads();
    const int s_lo = args.s_lo, s_hi = args.s_hi;
    XcdBarrier bar; bar.bar = (unsigned*)(ws + WS_CTL) + CW_BAR; bar.x = 0; bar.st = nullptr;
    if (s_hi - s_lo > 1) bar = xcd_barrier_post((unsigned*)(ws + WS_CTL) + CW_BAR, CTL, tid == 0);
#ifndef PH_MASK
#define PH_MASK 0xFFFF
#endif
#define PHM(b) (((PH_MASK) >> (b)) & 1)
#ifndef PROBE_DUP
#define PROBE_DUP 0
#endif
#define PREP(b) _Pragma("unroll 1") for (int rep_ = 0; rep_ < ((((PROBE_DUP) >> (b)) & 1) ? 2 : 1); ++rep_) if ((rep_ == 1 && ((PROBE_DUP >> 12) & 1)) ? (xcd_barrier(bar, tid_from_wave(wave) == 0), true) : true)
#define IN(k) (s_lo <= (k) && (k) < s_hi)
#define SEAM(k) do { if ((k) + 1 < s_hi) xcd_barrier(bar, tid_from_wave(wave) == 0); } while (0)

    const float* const x_in = args.in[0];
    _Float16* const H = (_Float16*)(ws + WS_H); unsigned char* const HB8 = (unsigned char*)(ws + WS_OB + 32 * MiB);     bf16* const QKV = (bf16*)(ws + WS_QKV); bf16* const OB = (bf16*)(ws + WS_OB);
    bf16* const MIX = (bf16*)(ws + WS_YD);     bf16* const XS = (bf16*)(ws + WS_XS); float* const S1 = (float*)(ws + WS_XS); bf16* const ACT = (bf16*)(ws + WS_ACT); bf16* const YD = (bf16*)(ws + WS_YD);
    float* const WR = (float*)(ws + WS_WR);
    int* const CNT = (int*)(ws + WS_CNT); unsigned* const RE = (unsigned*)(ws + WS_RE); f32x2* const RW = (f32x2*)(ws + WS_RW); int* const RP = (int*)(ws + WS_RP);

    if (IN(0) && PHM(0)) { PREP(0) {
        const int tid = opq_tid(wave), lane = tid & 63;
        LAS float* scr = (LAS float*)(lds + RING_OFF + wave * 16896);
        const int gw = vcu * NWAVES + wave, NGW = G * NWAVES;
        constexpr int I0 = 2 * 3072, I1 = 8 * 1024, I2 = 128 * 512, I3 = 64 * 512, NITEMS = I0 + I1 + I2 + I3;
        static_assert(QKV8_A == 1 && QKV8_B == 0, "conversion table below: stick-breaking q|k|v and all other fp8 GEMM weights -> e4m3, differential q|k|v weights -> fp16");
#define CVT_DECODE(it_, SRC, PIT, DST, DP, MODE, K0, N0, KIND) do { int r = (it_); \
            if (r < I0) { const int job = r / 3072; r -= job * 3072; const int kb = r / 192, nb = r - kb * 192; \
                SRC = args.in[1] + (size_t)job * 2048 * 6144; PIT = 6144; DST = ws + WS_WQKVA + (size_t)job * 6144 * 2048; DP = 2048; MODE = 0; K0 = kb * 128; N0 = nb * 32; KIND = 2; break; } \
            r -= I0; \
            if (r < I1) { const int job = r >> 10; r &= 1023; const int r1_ = r; K0 = (r >> 6) * 128; N0 = (r & 63) * 32; PIT = 2048; MODE = 0; KIND = 2; DP = P8K2; \
                if (job < 2) { SRC = args.in[2] + (size_t)job * 2048 * 2048; DST = ws + WS_WOA + (size_t)job * 2048 * P8K2; } \
                else if (job >= 6) { SRC = args.in[5] + (size_t)(job - 6) * 2048 * 2048; DST = ws + WS_WOB + (size_t)(job - 6) * 2048 * P8K2; } \
                else if (V8_B && job == 4) { SRC = args.in[3] + 2048; PIT = 4096; DST = ws + WS_WQKVB + (size_t)4096 * LDH * 2; }     \
                else { KIND = 1; DP = LDH * 2; K0 = (r1_ >> 5) * 64; N0 = (r1_ & 31) * 64; \
                    if (job == 2) { SRC = args.in[4]; DST = ws + WS_WQKVB; MODE = 1; } \
                    else if (job == 3) { SRC = args.in[3]; PIT = 4096; DST = ws + WS_WQKVB + (size_t)2048 * LDH * 2; MODE = 1; } \
                    else if (job == 4) { SRC = args.in[3] + 2048; PIT = 4096; DST = ws + WS_WQKVB + (size_t)4096 * LDH * 2; } \
                    else { SRC = args.in[4] + (size_t)2048 * 2048; DST = ws + WS_WQKVB + (size_t)6144 * LDH * 2; MODE = 1; } } \
                break; } \
            r -= I1; \
            if (r < I2) { const int job = r >> 9; r &= 511; const int le = job >> 1, up = job & 1;     \
                SRC = (up ? args.in[15] : args.in[14]) + (size_t)le * 2048 * 1024; PIT = 1024; DST = ws + WS_WGU + (size_t)le * 2048 * P8K2; DP = P8K2; MODE = 2 + up; K0 = (r >> 5) * 128; N0 = (r & 31) * 32; KIND = 2; break; } \
            r -= I2; \
            { const int le = r >> 9; r &= 511; SRC = args.in[16] + (size_t)le * 1024 * 2048; PIT = 2048; DST = ws + WS_WDN + (size_t)le * 2048 * P8K1; DP = P8K1; MODE = 0; K0 = (r >> 6) * 128; N0 = (r & 63) * 32; KIND = 2; } \
        } while (0)
        { const float* sA; const float* sB; unsigned char* dA; unsigned char* dB; int pA, pB, qA, qB, mA, mB, kA, kB, nA, nB, tA, tB; f32x4 va[16], vb[16];
          int it = gw;
          if (it < NITEMS) { CVT_DECODE(it, sA, pA, dA, qA, mA, kA, nA, tA); cvt_load(va, sA, pA, kA, nA, tA, lane);
            for (;;) {
                if (it + NGW < NITEMS) { CVT_DECODE(it + NGW, sB, pB, dB, qB, mB, kB, nB, tB); cvt_load(vb, sB, pB, kB, nB, tB, lane); }
                cvt_store(va, dA, qA, mA, kA, nA, tA, scr, lane); it += NGW; if (it >= NITEMS) break;
                if (it + NGW < NITEMS) { CVT_DECODE(it + NGW, sA, pA, dA, qA, mA, kA, nA, tA); cvt_load(va, sA, pA, kA, nA, tA, lane); }
                cvt_store(vb, dB, qB, mB, kB, nB, tB, scr, lane); it += NGW; if (it >= NITEMS) break;
            } } }
#undef CVT_DECODE
        for (size_t i = (size_t)gw * 64 + lane; i < (size_t)NTOK * DM / 4; i += (size_t)NGW * 64) {
            const f32x4 v = ((const f32x4*)x_in)[i];
            ((unsigned*)HB8)[i] = pg8::pack4_fp8(v[0], v[1], v[2], v[3]); }
        for (int i = bx * (NWAVES * 64) + tid; i < NLAYER * 20 * 2048; i += G * NWAVES * 64) { const int k = i & 2047, c = (i >> 11) % 20, l = i / (20 * 2048);
            WR[i] = c < 4 ? args.in[12][((size_t)l * 2048 + k) * 4 + c] : args.in[13][(((size_t)l * 4 + ((c - 4) >> 2)) * 2048 + k) * 4 + ((c - 4) & 3)]; }
        }
        SEAM(0);
    }

    for (int L = 0; L < NLAYER; ++L) {
        const int sb = 1 + 8 * L; const bool typeA = L < 2;
        if (IN(sb + 0)) {
            if (typeA && PHM(1)) { PREP(1) {
                pg8::StaticOrder S; S.init(NTOK, 6144, G, bx);
                if (QKV8_A) { pg8::Gemm g{(const bf16*)HB8, (const bf16*)(ws + WS_WQKVA + (size_t)L * 6144 * 2048), NTOK, 6144, DM / 2, DM / 2, wave}; pg8::EpiQkv E{QKV, 6144, 2048, SB_QSCALE, 1.f / pg8::W8_UNDO};
                    pg8::gemm_phase<pg8::EpiQkv, pg8::StaticOrder, true, true, true>(lds + RING_OFF, g, S, E); }
                } static_assert(QKV8_A == 1, "the stick-breaking layers' q|k|v GEMM takes the e4m3 copy of the stream");
            } else if (!typeA && PHM(2)) { PREP(2) {
                const int N = (L == 2) ? 6144 : 2048;
                pg8::StaticOrder S; S.init(NTOK, N, G, bx);
                if (QKV8_B) { pg8::Gemm g{(const bf16*)HB8, (const bf16*)(ws + WS_WQKVB + (L == 2 ? (size_t)0 : (size_t)6144 * 2048)), NTOK, N, DM / 2, DM / 2, wave};
                    pg8::EpiRope E{QKV, 6144, 2048, 4096, DF_QSCALE, 1.f / pg8::W8_UNDO};
                    pg8::gemm_phase<pg8::EpiRope, pg8::StaticOrder, true, true, true>(lds + RING_OFF, g, S, E); }
                else { const int Nh = (V8_B && L == 2) ? 4096 : N; if (V8_B) S.init(NTOK, Nh, G, bx);
                    pg8::Gemm g{(const bf16*)H, (const bf16*)(ws + WS_WQKVB) + (L == 2 ? (size_t)0 : (size_t)6144 * LDH), NTOK, Nh, DM, LDH, wave};
                    pg8::EpiRope E{QKV, 6144, 2048, 4096, DF_QSCALE, 1.f};
                    pg8::gemm_phase<pg8::EpiRope, pg8::StaticOrder, true, true, false, true>(lds + RING_OFF, g, S, E);
                    if (V8_B && L == 2) {
                        pg8::StaticOrder S2; S2.init(NTOK, 2048, G, bx);
                        pg8::Gemm g2{(const bf16*)HB8, (const bf16*)(ws + WS_WQKVB + (size_t)4096 * LDH * 2), NTOK, 2048, DM / 2, P8K2 / 2, wave}; pg8::EpiQkv E2{QKV + 4096, 6144, 0, 1.f, 1.f / pg8::W8_UNDO};
                        pg8::gemm_phase<pg8::EpiQkv, pg8::StaticOrder, true, true, true>(lds + RING_OFF, g2, S2, E2); } } }
            }
            SEAM(sb + 0);
        }
        if (IN(sb + 1)) {
            if (typeA && PHM(3)) {
                for (int id_ = vcu; id_ < 512 * (1 + ((PROBE_DUP >> 3) & 1)); id_ += G) { if (((PROBE_DUP >> 12) & 1) && id_ >= 512 && id_ < 512 + G) xcd_barrier(bar, tid_from_wave(wave) == 0); const int id = id_ & 511; const int bh = id >> 2, p = id & 3, b = bh >> 4, h = bh & 15;
                    const bf16* Qg = QKV + (size_t)b * SEQ * 6144 + h * 128; bf16* Og = (bf16*)((unsigned char*)OB + (size_t)b * SEQ * P8K2 + h * 128);
                    att::sb_block(Qg, Qg + 2048, Qg + 4096, Og, 7 - p, (att::ldsp)(lds + RING_OFF), wave);
                    att::sb_block(Qg, Qg + 2048, Qg + 4096, Og, p, (att::ldsp)(lds + RING_OFF), wave); }
            } else if (!typeA && PHM(4)) {
                const int lane = opq_tid(wave) & 63;
                const int i = L - 2; const float lam_init = (L == 2) ? 0.47071301834264183f : 0.5560582041556061f;
                const float* lp = args.in[6] + (size_t)i * 256;
                const float sa = dpp_sum(lp[lane] * lp[64 + lane]), sb2 = dpp_sum(lp[128 + lane] * lp[192 + lane]);
                const float lam = __builtin_amdgcn_exp2f(sa * LOG2E) - __builtin_amdgcn_exp2f(sb2 * LOG2E) + lam_init;
                const float* gsub = args.in[7] + (size_t)i * 128; const float gmul = 1.f - lam_init;
                for (int id_ = vcu; id_ < 512 * (1 + ((PROBE_DUP >> 4) & 1)); id_ += G) { if (((PROBE_DUP >> 12) & 1) && id_ >= 512 && id_ < 512 + G) xcd_barrier(bar, tid_from_wave(wave) == 0); const int id = id_ & 511; const int bh = id >> 2, p = id & 3, b = bh >> 4, h = bh & 15;
                    const bf16* Qg = QKV + (size_t)b * SEQ * 6144 + h * 128; bf16* Og = (bf16*)((unsigned char*)OB + (size_t)b * SEQ * P8K2 + h * 128); float* Sg = S1 + (size_t)b * SEQ * DM + h * 128;
#pragma unroll 1
                    for (int w = 0; w < 2; ++w) { const int qb = w ? p : 7 - p;
#if DF_RING
                        att::diff_pass2<false>(Qg, Qg + 2048, Qg + 4096, Sg, Og, qb, lam, gsub, gmul, (att::ldsp)(lds + RING_OFF), wave);
                        att::diff_pass2<true>(Qg + 64, Qg + 2048 + 64, Qg + 4096, Sg, Og, qb, lam, gsub, gmul, (att::ldsp)(lds + RING_OFF), wave); } }
#else
                        att::diff_pass<false>(Qg, Qg + 2048, Qg + 4096, Sg, Og, qb, lam, gsub, gmul, (att::ldsp)(lds + RING_OFF), wave);
                        att::diff_pass<true>(Qg + 64, Qg + 2048 + 64, Qg + 4096, Sg, Og, qb, lam, gsub, gmul, (att::ldsp)(lds + RING_OFF), wave); } }
#endif
            }
            SEAM(sb + 1);
        }
        if (IN(sb + 2)) { if (PHM(5)) {
            pg8::Gemm g{OB, (const bf16*)(ws + (typeA ? WS_WOA : WS_WOB) + (size_t)(L & 1) * 2048 * P8K2), NTOK, DM, DM / 2, P8K2 / 2, wave}; pg8::StaticOrder S; S.init(NTOK, DM, G, bx);
            pg8::EpiQkv E{MIX, DM, 0, 1.f, 1.f / (pg8::W8_UNDO * att::OB8_SCALE)};
            pg8::gemm_phase<pg8::EpiQkv, pg8::StaticOrder, true, true, true>(lds + RING_OFF, g, S, E); }
            SEAM(sb + 2);
        }
        if (IN(sb + 3)) { if (PHM(6)) {
            const int tid = opq_tid(wave), lane = tid & 63;
            const float* lng = args.in[8] + (size_t)L * DM; const float* lnb = args.in[9] + (size_t)L * DM; const float* wr = WR + (size_t)L * 20 * 2048;
            LAS int* eid = (LAS int*)(lds + LNX_OFF + 2048);
            LAS float* lgt = (LAS float*)(lds + LNX_OFF + 4096);
            LAS unsigned* rows8 = (LAS unsigned*)(lds + RING_OFF);
            for (int c = bx; c < 256; c += G) {
                const unsigned wcl = (unsigned)(uintptr_t)(lds + WCOL_OFF) + (unsigned)wave * 1024u; const unsigned wvo = (unsigned)(wave * 256 + lane * 4) * 4u;
#define LN1_DMAW(col, buf) att::glds16s(wvo, wr + (size_t)(col) * 2048, (unsigned)__builtin_amdgcn_readfirstlane(wcl + (unsigned)(buf) * 8192u))
                LN1_DMAW(0, 0); LN1_DMAW(1, 1);
#pragma unroll 1
                for (int grp = 0; grp < 2; ++grp) {
                    const int rloc = wave * 8 + grp * 4; const size_t row0 = (size_t)64 * c + rloc;
                    f32x4 v[4][8]; float mu[4], rstd[4];
#pragma unroll
                    for (int rr = 0; rr < 4; ++rr) {
                        if (L == 0) { const f32x4* hp = (const f32x4*)(x_in + (row0 + rr) * DM) + lane;
#pragma unroll
                            for (int j = 0; j < 8; ++j) v[rr][j] = hp[64 * j]; }
                        else { const _Float16* hq = H + (row0 + rr) * DM + 4 * lane;
#pragma unroll
                            for (int j = 0; j < 8; ++j) v[rr][j] = ldh4(hq + 256 * j); } }
#pragma unroll
                    for (int rr = 0; rr < 4; ++rr) { const v2u* mp = (const v2u*)(MIX + (row0 + rr) * DM) + lane;
#pragma unroll
                        for (int j = 0; j < 8; ++j) { const v2u a = mp[64 * j];
                            const f32x4 fa = {__uint_as_float(a.x << 16), __uint_as_float(a.x & 0xffff0000u), __uint_as_float(a.y << 16), __uint_as_float(a.y & 0xffff0000u)};
                            v[rr][j] = v[rr][j] * DN_ALPHA + fa; } }
#pragma unroll
                    for (int rr = 0; rr < 4; ++rr) { float s = 0.f;
#pragma unroll
                        for (int j = 0; j < 8; ++j) s += (v[rr][j][0] + v[rr][j][1]) + (v[rr][j][2] + v[rr][j][3]);
                        mu[rr] = dpp_sum(s) * (1.f / DM); float q = 0.f;
#pragma unroll
                        for (int j = 0; j < 8; ++j) { const f32x4 d = v[rr][j] - mu[rr]; q += (d[0] * d[0] + d[1] * d[1]) + (d[2] * d[2] + d[3] * d[3]); }
                        rstd[rr] = 1.f / sqrtf(dpp_sum(q) * (1.f / DM) + LN_EPS); }
#pragma unroll
                    for (int j = 0; j < 8; ++j) { const f32x4 gg = ((const f32x4*)lng)[64 * j + lane], bb = ((const f32x4*)lnb)[64 * j + lane];
#pragma unroll
                        for (int rr = 0; rr < 4; ++rr) { v[rr][j] = (v[rr][j] - mu[rr]) * rstd[rr] * gg + bb; sth4(H + (row0 + rr) * DM + 256 * j + 4 * lane, v[rr][j]);
                            if (c == bx) rows8[(rloc + rr) * 512 + 64 * j + lane] = pg8::pack4_fp8(v[rr][j][0], v[rr][j][1], v[rr][j][2], v[rr][j][3]); } }
                    int gs[4] = {0, 0, 0, 0};
#pragma unroll 1
                    for (int cc = 0; cc < 20; ++cc) { const int q = grp * 20 + cc, bsel = q & 1;
                        if (q + 1 < 40) asm volatile("s_waitcnt vmcnt(1)\n\ts_barrier" ::: "memory"); else asm volatile("s_waitcnt vmcnt(0)\n\ts_barrier" ::: "memory");
                        f32x4 w[8];
                        { const LAS f32x4* wp = (const LAS f32x4*)(lds + WCOL_OFF + bsel * 8192) + lane;
#pragma unroll
                          for (int j = 0; j < 8; ++j) w[j] = wp[64 * j]; }
                        asm volatile("s_waitcnt lgkmcnt(0)\n\ts_barrier" ::: "memory");
                        if (q + 2 < 40) LN1_DMAW((q + 2) % 20, bsel);
#pragma unroll
                        for (int rr = 0; rr < 4; ++rr) { if (cc < 4 || gs[rr] == ((cc - 4) >> 2)) {
                            f32x2 a2 = {0.f, 0.f};
#pragma unroll
                            for (int j = 0; j < 8; ++j) { const f32x2 wlo = {w[j][0], w[j][1]}, whi = {w[j][2], w[j][3]}, vlo = {v[rr][j][0], v[rr][j][1]}, vhi = {v[rr][j][2], v[rr][j][3]};
                                a2 = __builtin_elementwise_fma(vlo, wlo, a2); a2 = __builtin_elementwise_fma(vhi, whi, a2); }
                            const float a = dpp_sum(a2[0] + a2[1]);
                            if (lane == 0) lgt[(rloc + rr) * 20 + cc] = a; } }
                        if (cc == 3) { LDS_WAIT();
#pragma unroll
                            for (int rr = 0; rr < 4; ++rr) { const LAS float* lg = lgt + (rloc + rr) * 20; int g = 0; float gm = lg[0];
#pragma unroll
                                for (int i = 1; i < 4; ++i) { const float x = lg[i]; if (x > gm) { gm = x; g = i; } }
                                gs[rr] = __builtin_amdgcn_readfirstlane(g); } } }
                }
#undef LN1_DMAW
                LDS_WAIT();
                if (lane < 8) {
                    const int rl = wave * 8 + lane; const LAS float* lg = lgt + rl * 20;
                    int gsel = 0; float gm = lg[0];
#pragma unroll
                    for (int i = 1; i < 4; ++i) { const float x = lg[i]; if (x > gm) { gm = x; gsel = i; } }
                    float gden = 0.f;
#pragma unroll
                    for (int i = 0; i < 4; ++i) gden += __builtin_amdgcn_exp2f((lg[i] - gm) * LOG2E);
                    const float gw_ = 1.f / gden;
                    const LAS float* li = lg + 4 + 4 * gsel;
                    const float l0 = li[0], l1 = li[1], l2 = li[2], l3 = li[3];
                    int i0 = 0; float v0 = l0;
                    if (l1 > v0) { v0 = l1; i0 = 1; } if (l2 > v0) { v0 = l2; i0 = 2; } if (l3 > v0) { v0 = l3; i0 = 3; }
                    int i1 = -1; float v1 = 0.f;
                    if (i0 != 0) { v1 = l0; i1 = 0; }
                    if (i0 != 1 && (i1 < 0 || l1 > v1)) { v1 = l1; i1 = 1; }
                    if (i0 != 2 && (i1 < 0 || l2 > v1)) { v1 = l2; i1 = 2; }
                    if (i0 != 3 && (i1 < 0 || l3 > v1)) { v1 = l3; i1 = 3; }
                    const float t = __builtin_amdgcn_exp2f((v1 - v0) * LOG2E); const float w0 = gw_ / (1.f + t), w1 = gw_ * t / (1.f + t);
                    eid[2 * rl] = gsel * 4 + i0; eid[2 * rl + 1] = gsel * 4 + i1; RW[(size_t)64 * c + rl] = (f32x2){w0, w1};
                }
                __syncthreads();
                if (wave == 0) {
                    const int ea = eid[lane], eb = eid[64 + lane]; int ra = 0, rb = 0, cnt = 0; const unsigned long long lt = (1ull << lane) - 1ull;
#pragma unroll
                    for (int e = 0; e < 16; ++e) { const unsigned long long ma = __ballot(ea == e), mb = __ballot(eb == e);
                        if (ea == e) ra = __popcll(ma & lt); if (eb == e) rb = __popcll(ma) + __popcll(mb & lt); if (lane == e) cnt = __popcll(ma) + __popcll(mb); }
                    if (lane < 16) CNT[c * 16 + lane] = cnt;
                    LAS int* rk = (LAS int*)(lds + LNX_OFF + 3072); rk[lane] = ra; rk[64 + lane] = rb; LDS_WAIT();
                    const int r = lane; const unsigned word = (unsigned)eid[2 * r] | ((unsigned)eid[2 * r + 1] << 8) | ((unsigned)rk[2 * r] << 16) | ((unsigned)rk[2 * r + 1] << 24);
                    RE[(size_t)64 * c + r] = word;
                }
                __syncthreads();
            } }
            SEAM(sb + 3);
        }
        if ((IN(sb + 4) || IN(sb + 5) || IN(sb + 6)) && PHM(7)) {
            const int tid = opq_tid(wave);
            LAS int* part = (LAS int*)(lds + LNX_OFF);
            { const int e = tid & 15, s = tid >> 4; int a = 0;
#pragma unroll
              for (int i = 0; i < 8; ++i) a += CNT[(8 * s + i) * 16 + e];
              part[s * 16 + e] = a; }
            __syncthreads();
            if (tid < 16) { int run = 0;
#pragma clang loop vectorize(disable)
#pragma unroll 8
                for (int s = 0; s < 32; ++s) run += part[s * 16 + tid];
                TAB[tid] = run; }
            __syncthreads();
            if (tid < 192) { int off = 0, mt = 0, mine = 15;
#pragma unroll
                for (int e = 0; e < 16; ++e) { const int nt = (TAB[e] + 255) >> 8; if (tid == 0) TAB[16 + e] = off; if (tid >= mt && tid < mt + nt) mine = e; off += nt * 256; mt += nt; }
                if (tid < mt && tid < 160) TAB[64 + tid] = mine;
                if (tid == 0) { TAB[32] = off; TAB[33] = mt; } }
            __syncthreads();
        }
        if (IN(sb + 4)) { if (PHM(7)) PREP(7) {
            const int tid = opq_tid(wave), lane = tid & 63;
            LAS int* part = (LAS int*)(lds + LNX_OFF);
            for (int c = bx; c < 256; c += G) {
                unsigned wd[8];
#pragma unroll
                for (int rr = 0; rr < 8; ++rr) wd[rr] = RE[(size_t)64 * c + wave * 8 + rr];
                if (tid < 16) { int pre = 0; int x[8];
#pragma unroll
                    for (int i = 0; i < 8; ++i) x[i] = CNT[((c & ~7) + i) * 16 + tid];
#pragma clang loop vectorize(disable) unroll(disable)
                    for (int s = 0; s < (c >> 3); ++s) pre += part[s * 16 + tid];
#pragma unroll
                    for (int i = 0; i < 8; ++i) pre += (i < (c & 7)) ? x[i] : 0;
                    TAB[48 + tid] = TAB[16 + tid] + pre; }
                __syncthreads();
#pragma unroll
                for (int rr = 0; rr < 8; ++rr) { const size_t row = (size_t)64 * c + wave * 8 + rr; const unsigned word = wd[rr];
                    const int p0 = TAB[48 + (word & 255)] + ((word >> 16) & 255), p1 = TAB[48 + ((word >> 8) & 255)] + (word >> 24);
                    if (lane == 0) { RP[2 * row] = p0; RP[2 * row + 1] = p1; }
                    if (c == bx && IN(sb + 3)) {
                        const LAS v4u* src = (const LAS v4u*)(lds + RING_OFF + (wave * 8 + rr) * 2048) + lane; v4u* o0 = (v4u*)((unsigned char*)XS + (size_t)p0 * P8K2) + lane; v4u* o1 = (v4u*)((unsigned char*)XS + (size_t)p1 * P8K2) + lane;
                        const v4u a = src[0], b = src[64]; __builtin_nontemporal_store(a, o0); __builtin_nontemporal_store(b, o0 + 64); __builtin_nontemporal_store(a, o1); __builtin_nontemporal_store(b, o1 + 64);
                    } else {
                        const _Float16* hq = H + row * DM + 4 * lane; unsigned* o0 = (unsigned*)((unsigned char*)XS + (size_t)p0 * P8K2) + lane; unsigned* o1 = (unsigned*)((unsigned char*)XS + (size_t)p1 * P8K2) + lane;
#pragma unroll
                        for (int j = 0; j < 8; ++j) { const f32x4 v = ldh4(hq + 256 * j); const unsigned o = pg8::pack4_fp8(v[0], v[1], v[2], v[3]); o0[64 * j] = o; o1[64 * j] = o; } } }
                __syncthreads();
            } }
            SEAM(sb + 4);
        }
        if (IN(sb + 5)) { if (PHM(8)) PREP(8) {
            pg8::Gemm g{XS, (const bf16*)(ws + WS_WGU + (size_t)L * 16 * 2048 * P8K2), XS_ROWS, 2048, DM / 2, P8K2 / 2, wave};
            pg8::MoeOrder<0> S{TAB[33] * 8, G, bx, TAB + 64, nullptr, nullptr, wave}; pg8::EpiGateUp8 E{(unsigned char*)ACT};
            pg8::gemm_phase<pg8::EpiGateUp8, pg8::MoeOrder<0>, true, true, true>(lds + RING_OFF, g, S, E); }
            SEAM(sb + 5);
        }
        if (IN(sb + 6)) { if (PHM(9)) PREP(9) {
            pg8::Gemm g{ACT, (const bf16*)(ws + WS_WDN + (size_t)L * 16 * 2048 * P8K1), XS_ROWS, 2048, DEXP / 2, P8K1 / 2, wave};
            pg8::MoeOrder<0> S{TAB[33] * 8, G, bx, TAB + 64, nullptr, nullptr, wave}; pg8::EpiDown8 E{(unsigned char*)YD};
            pg8::gemm_phase<pg8::EpiDown8, pg8::MoeOrder<0>, true, true, true>(lds + RING_OFF, g, S, E); }
            SEAM(sb + 6);
        }
        if (IN(sb + 7)) { if (PHM(10)) for (int rep_ = 0; rep_ < ((((PROBE_DUP) >> 10) & 1) && L == NLAYER - 1 ? 5 : 1); ++rep_) {
            const int tid = opq_tid(wave), lane = tid & 63;
            const float* lng = args.in[10] + (size_t)L * DM; const float* lnb = args.in[11] + (size_t)L * DM; const bool last = (L == NLAYER - 1); const bool next8 = (L + 1 < 2) ? (QKV8_A != 0) : (QKV8_B != 0 || (V8_B != 0 && L + 1 == 2));
            const int gw = vcu * NWAVES + wave, NGW = G * NWAVES;
            for (int row0 = 4 * gw; row0 < NTOK; row0 += 4 * NGW) {
                f32x4 v[4][8]; float mu[4], rstd[4];
#pragma unroll
                for (int rr = 0; rr < 4; ++rr) { const int row = row0 + rr;
                    const int p0 = RP[2 * row], p1 = RP[2 * row + 1]; const f32x2 w = RW[row];
                    const _Float16* hq = H + (size_t)row * DM + 4 * lane; const unsigned* y0 = (const unsigned*)((const unsigned char*)YD + (size_t)p0 * DM) + lane; const unsigned* y1 = (const unsigned*)((const unsigned char*)YD + (size_t)p1 * DM) + lane;
                    const float w0s = w.x * (1.f / pg8::YD8_SCALE), w1s = w.y * (1.f / pg8::YD8_SCALE);
#pragma unroll
                    for (int j = 0; j < 8; ++j) { const f32x4 h = ldh4(hq + 256 * j); const unsigned a = y0[64 * j], b = y1[64 * j];
                        const f32x2 a0 = __builtin_amdgcn_cvt_pk_f32_fp8((int)a, false), a1 = __builtin_amdgcn_cvt_pk_f32_fp8((int)a, true), b0 = __builtin_amdgcn_cvt_pk_f32_fp8((int)b, false), b1 = __builtin_amdgcn_cvt_pk_f32_fp8((int)b, true);
                        const f32x4 fa = {a0[0], a0[1], a1[0], a1[1]}, fb = {b0[0], b0[1], b1[0], b1[1]};
                        v[rr][j] = h * DN_ALPHA + fa * w0s + fb * w1s; } }
#pragma unroll
                for (int rr = 0; rr < 4; ++rr) { float s = 0.f;
#pragma unroll
                    for (int j = 0; j < 8; ++j) s += (v[rr][j][0] + v[rr][j][1]) + (v[rr][j][2] + v[rr][j][3]);
                    mu[rr] = dpp_sum(s) * (1.f / DM); float q = 0.f;
#pragma unroll
                    for (int j = 0; j < 8; ++j) { const f32x4 dd = v[rr][j] - mu[rr]; q += (dd[0] * dd[0] + dd[1] * dd[1]) + (dd[2] * dd[2] + dd[3] * dd[3]); }
                    rstd[rr] = 1.f / sqrtf(dpp_sum(q) * (1.f / DM) + LN_EPS); }
#pragma unroll
                for (int j = 0; j < 8; ++j) { const f32x4 gg = ((const f32x4*)lng)[64 * j + lane], bb = ((const f32x4*)lnb)[64 * j + lane];
#pragma unroll
                    for (int rr = 0; rr < 4; ++rr) { const int row = row0 + rr; const f32x4 y = (v[rr][j] - mu[rr]) * rstd[rr] * gg + bb;
                        if (last) __builtin_nontemporal_store(y, (f32x4*)(args.out + (size_t)row * DM) + 64 * j + lane);
                        else { sth4(H + (size_t)row * DM + 256 * j + 4 * lane, y); if (next8) __builtin_nontemporal_store(pg8::pack4_fp8(y[0], y[1], y[2], y[3]), (unsigned*)(HB8 + (size_t)row * DM) + 64 * j + lane); } } }
            } }
            SEAM(sb + 7);
        }
    }
#undef IN
#undef SEAM
}

extern "C" void kernel_launch(void* const* d_in, const int* in_sizes, int n_in, void* d_out, int out_size, void* d_ws, size_t ws_size, hipStream_t stream) {
    static int grid = 0;
    if (grid == 0) {
        if (n_in != 17 || in_sizes[0] != NTOK * DM || out_size != NTOK * DM || ws_size < WS_END) { fprintf(stderr, "kernel_launch: unexpected shapes / workspace (n_in %d, ws %zu, need %zu)\n", n_in, ws_size, (size_t)WS_END); grid = -1; return; }
        int dev = 0, cus = 0, per_cu = 0;
        if (hipGetDevice(&dev) != hipSuccess || hipDeviceGetAttribute(&cus, hipDeviceAttributeMultiprocessorCount, dev) != hipSuccess) { grid = -1; return; }
        if (hipFuncSetAttribute((const void*)yoco_fwd, hipFuncAttributeMaxDynamicSharedMemorySize, LDS_BYTES) != hipSuccess) { fprintf(stderr, "kernel_launch: hipFuncSetAttribute failed\n"); grid = -1; return; }
        if (hipOccupancyMaxActiveBlocksPerMultiprocessor(&per_cu, (const void*)yoco_fwd, NWAVES * 64, LDS_BYTES) != hipSuccess || per_cu < 1) { fprintf(stderr, "kernel_launch: occupancy query says %d\n", per_cu); per_cu = 1; }
        (void)hipGetLastError();
        grid = cus;
    }
    if (grid < 0) return;
    (void)hipMemsetAsync((char*)d_ws + WS_CTL, 0, CTL_ZERO_BYTES, stream);
    Args a{};
    for (int i = 0; i < 17; ++i) a.in[i] = (const float*)d_in[i];
    a.out = (float*)d_out; a.ws = (unsigned char*)d_ws;
#if MK_MULTI
    for (int s = 0; s < NSTEPS; ++s) { a.s_lo = s; a.s_hi = s + 1; hipLaunchKernelGGL(yoco_fwd, dim3(grid), dim3(NWAVES * 64), LDS_BYTES, stream, a); }
#else
    a.s_lo = 0; a.s_hi = NSTEPS;
    hipLaunchKernelGGL(yoco_fwd, dim3(grid), dim3(NWAVES * 64), LDS_BYTES, stream, a);
#endif
    const hipError_t le = hipPeekAtLastError();
    if (le != hipSuccess) fprintf(stderr, "kernel_launch: launch failed: %s\n", hipGetErrorName(le));
}
```
